# Optimizing an MI355X kernel written in HIP

```python
import math
import jax, jax.numpy as jnp
from jax import lax
import numpy as np

D_MODEL = 1024
BATCH = 4
SEQ = 4096
DEPTH = 2

GRID_W = 64
CTX_LEN = 256
N_MIXERS = 2
Q_BLOCK = 128
NORM_EPS = 1e-6
ROPE_THETA = 10000.0
N_MOD = 6

MLA_HEADS = 8
MLA_Q_RANK = 384
MLA_KV_RANK = 256
MLA_NOPE_DIM = 128
MLA_ROPE_DIM = 64
MLA_V_DIM = 128

GQA_HEADS = 8
GQA_KV_HEADS = 2
GQA_GROUP = GQA_HEADS // GQA_KV_HEADS
GQA_HEAD_DIM = 128

PEER_HEADS = 8
PEER_N_KEYS = 128
PEER_N_EXPERTS = PEER_N_KEYS * PEER_N_KEYS
PEER_KEY_DIM = 256
PEER_HALF_DIM = PEER_KEY_DIM // 2
PEER_TOPK = 16
PEER_CHUNK = 128

kernel_name = 'hybrid_mla_gqa_peer_dit'


def rmsnorm(x, g):
    xf = x.astype(jnp.float32)
    y = xf * lax.rsqrt(jnp.mean(xf * xf, axis=-1, keepdims=True) + NORM_EPS)
    return (y * g.astype(jnp.float32)).astype(x.dtype)


def modulate(h, shift, scale):
    return h * (1 + scale) + shift


def axial_rope_tables(n_tokens, rot_dim, dtype):
    rows = n_tokens // GRID_W
    row = jnp.repeat(jnp.arange(rows, dtype=jnp.float32), GRID_W)
    col = jnp.tile(jnp.arange(GRID_W, dtype=jnp.float32), rows)
    d_axis = rot_dim // 2
    inv_freq = ROPE_THETA ** (-jnp.arange(0, d_axis, 2, dtype=jnp.float32) / d_axis)
    ang_r = row[:, None] * inv_freq
    ang_c = col[:, None] * inv_freq
    ang = jnp.concatenate([ang_r, ang_r, ang_c, ang_c], axis=-1)
    return jnp.cos(ang).astype(dtype), jnp.sin(ang).astype(dtype)


def apply_axial_rope(x, cos, sin):
    a1, a2, b1, b2 = jnp.split(x, 4, axis=-1)
    rot = jnp.concatenate([-a2, a1, -b2, b1], axis=-1)
    return x * cos + rot * sin


def sweep_query_blocks(fn, *qs):
    b, n = qs[0].shape[:2]
    nb = n // Q_BLOCK
    blocks = tuple(jnp.swapaxes(q.reshape((b, nb, Q_BLOCK) + q.shape[2:]), 0, 1) for q in qs)
    out = lax.map(lambda args: fn(*args), blocks)
    out = jnp.swapaxes(out, 0, 1)
    return out.reshape((b, n) + out.shape[3:])


def mla_project(h, w_in, q_norm, w_uq, kv_norm, w_ukv):
    b, n, _ = h.shape
    a = h @ w_in
    cq, ckv, k_rope = jnp.split(a, [MLA_Q_RANK, MLA_Q_RANK + MLA_KV_RANK], axis=-1)
    q = (rmsnorm(cq, q_norm) @ w_uq).reshape(b, n, MLA_HEADS, MLA_NOPE_DIM + MLA_ROPE_DIM)
    kv = (rmsnorm(ckv, kv_norm) @ w_ukv).reshape(b, n, MLA_HEADS, MLA_NOPE_DIM + MLA_V_DIM)
    q_nope, q_rope = jnp.split(q, [MLA_NOPE_DIM], axis=-1)
    k_nope, v = jnp.split(kv, [MLA_NOPE_DIM], axis=-1)
    return q_nope, q_rope, k_nope, k_rope, v


def mla_attend(q_n, q_r, k_n, k_r, v):
    scale = 1.0 / math.sqrt(MLA_NOPE_DIM + MLA_ROPE_DIM)
    s = (jnp.einsum('bqhd,bkhd->bhqk', q_n, k_n, preferred_element_type=jnp.float32)
         + jnp.einsum('bqhd,bkd->bhqk', q_r, k_r, preferred_element_type=jnp.float32))
    p = jax.nn.softmax(s * scale, axis=-1).astype(v.dtype)
    return jnp.einsum('bhqk,bkhd->bqhd', p, v)


def mla_mixer(h, hc, w_in, q_norm, w_uq, kv_norm, w_ukv, w_o, need_ctx):
    b, n, _ = h.shape
    cos, sin = axial_rope_tables(n, MLA_ROPE_DIM, h.dtype)
    qn, qr, kn, kr, v = mla_project(h, w_in, q_norm, w_uq, kv_norm, w_ukv)
    qr = apply_axial_rope(qr, cos[:, None, :], sin[:, None, :])
    kr = apply_axial_rope(kr, cos, sin)
    qn_c, qr_c, kn_c, kr_c, v_c = mla_project(hc, w_in, q_norm, w_uq, kv_norm, w_ukv)
    kn_all = jnp.concatenate([kn_c, kn], axis=1)
    kr_all = jnp.concatenate([kr_c, kr], axis=1)
    v_all = jnp.concatenate([v_c, v], axis=1)
    y = sweep_query_blocks(lambda a, r: mla_attend(a, r, kn_all, kr_all, v_all), qn, qr)
    y = y.reshape(b, n, MLA_HEADS * MLA_V_DIM) @ w_o
    y_c = None
    if need_ctx:
        y_c = mla_attend(qn_c, qr_c, kn_c, kr_c, v_c).reshape(b, hc.shape[1], MLA_HEADS * MLA_V_DIM) @ w_o
    return y, y_c


def gqa_project(h, w_qkv, q_norm, k_norm):
    b, n, _ = h.shape
    q, k, v = jnp.split(h @ w_qkv, [GQA_HEADS * GQA_HEAD_DIM, (GQA_HEADS + GQA_KV_HEADS) * GQA_HEAD_DIM], axis=-1)
    q = rmsnorm(q.reshape(b, n, GQA_KV_HEADS, GQA_GROUP, GQA_HEAD_DIM), q_norm)
    k = rmsnorm(k.reshape(b, n, GQA_KV_HEADS, GQA_HEAD_DIM), k_norm)
    v = v.reshape(b, n, GQA_KV_HEADS, GQA_HEAD_DIM)
    return q, k, v


def gqa_attend(q, k, v):
    scale = 1.0 / math.sqrt(GQA_HEAD_DIM)
    s = jnp.einsum('bqgrd,bkgd->bgrqk', q, k, preferred_element_type=jnp.float32)
    p = jax.nn.softmax(s * scale, axis=-1).astype(v.dtype)
    return jnp.einsum('bgrqk,bkgd->bqgrd', p, v)


def gqa_mixer(h, hc, w_qkv, q_norm, k_norm, w_o, need_ctx):
    b, n, _ = h.shape
    cos, sin = axial_rope_tables(n, GQA_HEAD_DIM, h.dtype)
    q, k, v = gqa_project(h, w_qkv, q_norm, k_norm)
    q = apply_axial_rope(q, cos[:, None, None, :], sin[:, None, None, :])
    k = apply_axial_rope(k, cos[:, None, :], sin[:, None, :])
    q_c, k_c, v_c = gqa_project(hc, w_qkv, q_norm, k_norm)
    k_all = jnp.concatenate([k_c, k], axis=1)
    v_all = jnp.concatenate([v_c, v], axis=1)
    y = sweep_query_blocks(lambda qb: gqa_attend(qb, k_all, v_all), q)
    y = y.reshape(b, n, GQA_HEADS * GQA_HEAD_DIM) @ w_o
    y_c = None
    if need_ctx:
        y_c = gqa_attend(q_c, k_c, v_c).reshape(b, hc.shape[1], GQA_HEADS * GQA_HEAD_DIM) @ w_o
    return y, y_c


def peer_ffn(h, w_query, sub_k1, sub_k2, u_tab, v_tab):
    b, n, d = h.shape
    nt = b * n
    t = h.reshape(nt, d)
    q = (t @ w_query).reshape(nt, PEER_HEADS, 2, PEER_HALF_DIM)
    s1 = jnp.einsum('thd,hkd->thk', q[:, :, 0], sub_k1, preferred_element_type=jnp.float32)
    s2 = jnp.einsum('thd,hkd->thk', q[:, :, 1], sub_k2, preferred_element_type=jnp.float32)
    v1, i1 = lax.top_k(s1, PEER_TOPK)
    v2, i2 = lax.top_k(s2, PEER_TOPK)
    cand = (v1[..., :, None] + v2[..., None, :]).reshape(nt, PEER_HEADS, PEER_TOPK * PEER_TOPK)
    cand_idx = (i1[..., :, None] * PEER_N_KEYS + i2[..., None, :]).reshape(nt, PEER_HEADS, PEER_TOPK * PEER_TOPK)
    top_s, top_pos = lax.top_k(cand, PEER_TOPK)
    expert_idx = jnp.take_along_axis(cand_idx, top_pos, axis=-1)
    gates = jax.nn.softmax(top_s, axis=-1).astype(h.dtype)

    def chunk(args):
        tc, ec, gc = args
        a = jax.nn.gelu(jnp.einsum('td,thkd->thk', tc, u_tab[ec]), approximate=False)
        return jnp.einsum('thk,thkd->td', gc * a, v_tab[ec])

    nc = nt // PEER_CHUNK
    out = lax.map(chunk, (t.reshape(nc, PEER_CHUNK, d),
                          expert_idx.reshape(nc, PEER_CHUNK, PEER_HEADS, PEER_TOPK),
                          gates.reshape(nc, PEER_CHUNK, PEER_HEADS, PEER_TOPK)))
    return out.reshape(b, n, d)


def setup_inputs(seed: int = 0) -> dict:
    key = jax.random.key(seed)
    ks = jax.random.split(key, 64)
    counter = [0]

    def nrm(shape, scale):
        k = ks[counter[0]]
        counter[0] += 1
        return jax.random.normal(k, shape, jnp.float32) * scale

    def gain(n):
        return 1.0 + nrm((n,), 0.02)

    d = D_MODEL
    inp = {
        'x': nrm((BATCH, SEQ, d), 1.0),
        'c': nrm((BATCH, d), 1.0),
        'ctx': nrm((BATCH, CTX_LEN, d), 1.0),
        'c_ctx': nrm((d,), 1.0),
    }
    for i in range(DEPTH):
        pre = 'l%d_' % i
        inp[pre + 'ada_w'] = nrm((d, N_MOD * d), 0.5 * d ** -0.5)
        inp[pre + 'ada_b'] = nrm((N_MOD * d,), 0.01)
        inp[pre + 'norm_mix'] = gain(d)
        inp[pre + 'norm_ffn'] = gain(d)
        if i % N_MIXERS == 0:
            inp[pre + 'mla_w_in'] = nrm((d, MLA_Q_RANK + MLA_KV_RANK + MLA_ROPE_DIM), d ** -0.5)
            inp[pre + 'mla_q_norm'] = gain(MLA_Q_RANK)
            inp[pre + 'mla_w_uq'] = nrm((MLA_Q_RANK, MLA_HEADS * (MLA_NOPE_DIM + MLA_ROPE_DIM)), MLA_Q_RANK ** -0.5)
            inp[pre + 'mla_kv_norm'] = gain(MLA_KV_RANK)
            inp[pre + 'mla_w_ukv'] = nrm((MLA_KV_RANK, MLA_HEADS * (MLA_NOPE_DIM + MLA_V_DIM)), MLA_KV_RANK ** -0.5)
            inp[pre + 'mla_w_o'] = nrm((MLA_HEADS * MLA_V_DIM, d), (MLA_HEADS * MLA_V_DIM) ** -0.5)
        else:
            inp[pre + 'gqa_w_qkv'] = nrm((d, (GQA_HEADS + 2 * GQA_KV_HEADS) * GQA_HEAD_DIM), d ** -0.5)
            inp[pre + 'gqa_q_norm'] = gain(GQA_HEAD_DIM)
            inp[pre + 'gqa_k_norm'] = gain(GQA_HEAD_DIM)
            inp[pre + 'gqa_w_o'] = nrm((GQA_HEADS * GQA_HEAD_DIM, d), (GQA_HEADS * GQA_HEAD_DIM) ** -0.5)
        inp[pre + 'peer_w_query'] = nrm((d, PEER_HEADS * PEER_KEY_DIM), d ** -0.5)
        inp[pre + 'peer_k1'] = nrm((PEER_HEADS, PEER_N_KEYS, PEER_HALF_DIM), PEER_HALF_DIM ** -0.5)
        inp[pre + 'peer_k2'] = nrm((PEER_HEADS, PEER_N_KEYS, PEER_HALF_DIM), PEER_HALF_DIM ** -0.5)
        inp[pre + 'peer_u'] = nrm((PEER_N_EXPERTS, d), d ** -0.5)
        inp[pre + 'peer_v'] = nrm((PEER_N_EXPERTS, d), 1.0)
    inp['norm_out'] = gain(d)
    return inp


def reference(x, c, ctx, c_ctx,
              l0_ada_w, l0_ada_b, l0_norm_mix, l0_norm_ffn,
              l0_mla_w_in, l0_mla_q_norm, l0_mla_w_uq, l0_mla_kv_norm, l0_mla_w_ukv, l0_mla_w_o,
              l0_peer_w_query, l0_peer_k1, l0_peer_k2, l0_peer_u, l0_peer_v,
              l1_ada_w, l1_ada_b, l1_norm_mix, l1_norm_ffn,
              l1_gqa_w_qkv, l1_gqa_q_norm, l1_gqa_k_norm, l1_gqa_w_o,
              l1_peer_w_query, l1_peer_k1, l1_peer_k2, l1_peer_u, l1_peer_v,
              norm_out):
    layers = [
        dict(ada_w=l0_ada_w, ada_b=l0_ada_b, norm_mix=l0_norm_mix, norm_ffn=l0_norm_ffn,
             mixer=(l0_mla_w_in, l0_mla_q_norm, l0_mla_w_uq, l0_mla_kv_norm, l0_mla_w_ukv, l0_mla_w_o),
             peer=(l0_peer_w_query, l0_peer_k1, l0_peer_k2, l0_peer_u, l0_peer_v)),
        dict(ada_w=l1_ada_w, ada_b=l1_ada_b, norm_mix=l1_norm_mix, norm_ffn=l1_norm_ffn,
             mixer=(l1_gqa_w_qkv, l1_gqa_q_norm, l1_gqa_k_norm, l1_gqa_w_o),
             peer=(l1_peer_w_query, l1_peer_k1, l1_peer_k2, l1_peer_u, l1_peer_v)),
    ]
    mixers = (mla_mixer, gqa_mixer)
    xc = ctx
    for i in range(DEPTH):
        p = layers[i]
        need_ctx = i < DEPTH - 1
        mod = jax.nn.silu(c) @ p['ada_w'] + p['ada_b']
        mod_c = jax.nn.silu(c_ctx) @ p['ada_w'] + p['ada_b']
        sh_a, sc_a, g_a, sh_f, sc_f, g_f = [m[:, None, :] for m in jnp.split(mod, N_MOD, axis=-1)]
        csh_a, csc_a, cg_a, csh_f, csc_f, cg_f = jnp.split(mod_c, N_MOD, axis=-1)
        h = modulate(rmsnorm(x, p['norm_mix']), sh_a, sc_a)
        hc = modulate(rmsnorm(xc, p['norm_mix']), csh_a, csc_a)
        y, y_c = mixers[i % N_MIXERS](h, hc, *p['mixer'], need_ctx=need_ctx)
        x = x + g_a * y
        h = modulate(rmsnorm(x, p['norm_ffn']), sh_f, sc_f)
        x = x + g_f * peer_ffn(h, *p['peer'])
        if need_ctx:
            xc = xc + cg_a * y_c
            hc = modulate(rmsnorm(xc, p['norm_ffn']), csh_f, csc_f)
            xc = xc + cg_f * peer_ffn(hc, *p['peer'])
    return rmsnorm(x, norm_out)
```

```cpp
#include <hip/hip_runtime.h>
#include <hip/hip_cooperative_groups.h>
#include <cstdio>
#include <cstdint>
namespace cg = cooperative_groups;

#ifndef PROBE_MASK
#define PROBE_MASK 0u
#endif
#ifndef PROBE_P0
#define PROBE_P0 0u
#endif
#ifndef MK_PER_PHASE
#define MK_PER_PHASE 0
#endif

typedef unsigned short bf16_t;
typedef short bf16x8 __attribute__((ext_vector_type(8)));
typedef short s16x4 __attribute__((ext_vector_type(4)));
typedef float f32x4 __attribute__((ext_vector_type(4)));
typedef float f32x2 __attribute__((ext_vector_type(2)));
typedef float f32x16 __attribute__((ext_vector_type(16)));
typedef unsigned u32x4 __attribute__((ext_vector_type(4)));
typedef unsigned u32x2 __attribute__((ext_vector_type(2)));
#define LAS __attribute__((address_space(3)))
#define SBAR() __builtin_amdgcn_sched_barrier(0)

__device__ __forceinline__ unsigned f2bf(float f) { unsigned u = __builtin_bit_cast(unsigned, f); return (u + 0x7fffu + ((u >> 16) & 1u)) >> 16; }
__device__ __forceinline__ unsigned pk2(float lo, float hi) { return f2bf(lo) | (f2bf(hi) << 16); }
__device__ __forceinline__ float bf2f(unsigned short h) { return __builtin_bit_cast(float, (unsigned)h << 16); }
__device__ __forceinline__ float bflo(unsigned w) { return __builtin_bit_cast(float, w << 16); }
__device__ __forceinline__ float bfhi(unsigned w) { return __builtin_bit_cast(float, w & 0xffff0000u); }
__device__ __forceinline__ unsigned cvtpk(float lo, float hi) { unsigned r; asm volatile("v_cvt_pk_bf16_f32 %0, %1, %2" : "=v"(r) : "v"(lo), "v"(hi)); return r; }
#define WDPP(v, ctrl) __builtin_bit_cast(float, __builtin_amdgcn_update_dpp(0, __builtin_bit_cast(int, v), ctrl, 0xf, 0xf, false))
__device__ __forceinline__ float wave_sum(float v) {
    v += WDPP(v, 0xB1); v += WDPP(v, 0x4E); v += WDPP(v, 0x141); v += WDPP(v, 0x140);
    { auto rr = __builtin_amdgcn_permlane16_swap(__float_as_uint(v), __float_as_uint(v), false, false); v = __uint_as_float(rr[0]) + __uint_as_float(rr[1]); }
    { auto rr = __builtin_amdgcn_permlane32_swap(__float_as_uint(v), __float_as_uint(v), false, false); v = __uint_as_float(rr[0]) + __uint_as_float(rr[1]); }
    return v;
}
__device__ __forceinline__ float wave_max(float v) {
    v = fmaxf(v, WDPP(v, 0xB1)); v = fmaxf(v, WDPP(v, 0x4E)); v = fmaxf(v, WDPP(v, 0x141)); v = fmaxf(v, WDPP(v, 0x140));
    { auto rr = __builtin_amdgcn_permlane16_swap(__float_as_uint(v), __float_as_uint(v), false, false); v = fmaxf(__uint_as_float(rr[0]), __uint_as_float(rr[1])); }
    { auto rr = __builtin_amdgcn_permlane32_swap(__float_as_uint(v), __float_as_uint(v), false, false); v = fmaxf(__uint_as_float(rr[0]), __uint_as_float(rr[1])); }
    return v;
}

constexpr int DM = 1024, NB = 4, SEQ = 4096, CTXL = 256;
constexpr int RPB = SEQ + CTXL;
constexpr int R = NB * RPB;
constexpr float EPS = 1e-6f;
constexpr int NTHREADS = 512, NWAVES = 8;
constexpr int LDS_BYTES = 147456;

enum { I_X = 0, I_C, I_CTX, I_CCTX,
       I0_ADAW, I0_ADAB, I0_NMIX, I0_NFFN, I0_WIN, I0_QN, I0_WUQ, I0_KVN, I0_WUKV, I0_WO, I0_PWQ, I0_PK1, I0_PK2, I0_PU, I0_PV,
       I1_ADAW, I1_ADAB, I1_NMIX, I1_NFFN, I1_WQKV, I1_QN, I1_KN, I1_WO, I1_PWQ, I1_PK1, I1_PK2, I1_PU, I1_PV,
       I_NOUT, N_IN };

constexpr size_t MiB = 1u << 20;
constexpr size_t WS_CTL   = 0;
constexpr size_t WS_MOD   = 1 * MiB;
constexpr size_t WS_WIN   = 2 * MiB;
constexpr size_t WS_WUQ   = WS_WIN + 768 * 1024 * 2;
constexpr size_t WS_WUKV  = WS_WUQ + 1536 * 384 * 2;
constexpr size_t WS_WO0   = WS_WUKV + 2048 * 256 * 2;
constexpr size_t WS_WQ0   = WS_WO0 + 1024 * 1024 * 2;
constexpr size_t WS_KK0   = WS_WQ0 + 2048 * 1024 * 2;
constexpr size_t WS_WQKV  = WS_KK0 + 16 * 128 * 128 * 2;
constexpr size_t WS_WO1   = WS_WQKV + 1536 * 1024 * 2;
constexpr size_t WS_WQ1   = WS_WO1 + 1024 * 1024 * 2;
constexpr size_t WS_KK1   = WS_WQ1 + 2048 * 1024 * 2;
constexpr size_t WS_WEND  = WS_KK1 + 16 * 128 * 128 * 2;
static_assert(WS_WEND <= 24 * MiB, "weights region");
constexpr size_t WS_H     = 24 * MiB;
constexpr size_t WS_X     = WS_H + (size_t)R * 1024 * 2;
constexpr size_t WS_QKV   = WS_X + (size_t)R * 1024 * 4;
constexpr size_t WS_Q     = WS_QKV;
constexpr size_t WS_K     = WS_Q + (size_t)R * 1536 * 2;
constexpr size_t WS_V     = WS_K + (size_t)R * 1536 * 2;
constexpr size_t WS_S     = WS_QKV;
constexpr size_t WS_B     = WS_QKV + (size_t)R * 2048 * 4;
constexpr size_t WS_CQ    = WS_B;
constexpr size_t WS_CKV   = WS_CQ + (size_t)R * 384 * 2;
constexpr size_t WS_KR    = WS_CKV + (size_t)R * 256 * 2;
constexpr size_t WS_SSP   = WS_KR + (size_t)R * 64 * 2;
static_assert(WS_SSP + (size_t)R * 24 * 4 <= WS_B + 40 * MiB, "MLA latents inside region B");
constexpr size_t WS_O     = WS_B;
constexpr size_t WS_QP    = WS_B;
constexpr size_t WS_RAW1  = WS_B;
constexpr size_t WS_PK    = WS_B + (size_t)R * 2048 * 2;
constexpr size_t WS_TAB   = WS_PK + (size_t)R * 128 * 4;
constexpr size_t WS_PD    = WS_S;
constexpr size_t WS_WQ8   = WS_PD + (size_t)8 * R * 128 * 4;
constexpr size_t WS_WSC   = WS_WQ8 + (size_t)R * 128;
constexpr size_t WS_SSV   = WS_WSC + (size_t)R * 4;
static_assert(WS_SSV + (size_t)R * 8 * 4 <= WS_B, "expert scratch inside the S region");
constexpr size_t WS_SHW1  = WS_MOD + 512 * 1024;
constexpr size_t WS_HQ    = WS_B + 40 * MiB;
constexpr size_t WS_HS    = WS_HQ + (size_t)R * 1024;
static_assert(WS_HS + (size_t)R * 4 <= WS_PK, "HQ inside region B");
constexpr size_t WS_TSC   = WS_TAB + (size_t)4 * 16384 * 1024;
constexpr size_t WS_END   = WS_TSC + (size_t)4 * 16384 * 4;
constexpr size_t WS_Q1    = WS_QKV;
constexpr size_t WS_K1    = WS_Q1 + (size_t)R * 1024 * 2;
constexpr size_t WS_V1    = WS_K1 + (size_t)R * 256 * 2;

#define XB_TMO      128
#define XB_XCNT(j)  (256  + 64 * (j))
#define XB_XSUB(j)  (1280 + 64 * (j))
#define XB_XGEN(j)  (2304 + 64 * (j))
#define XB_TOP      3328
#define XB_TOPGEN   3392
#define XCD_BAR_WORDS 3456
#define XB_SPIN_CAP (1u << 20)
__device__ __forceinline__ unsigned xb_ld(unsigned* p)              { return __hip_atomic_load(p, __ATOMIC_RELAXED, __HIP_MEMORY_SCOPE_AGENT); }
__device__ __forceinline__ unsigned xb_add(unsigned* p, unsigned v) { return __hip_atomic_fetch_add(p, v, __ATOMIC_RELAXED, __HIP_MEMORY_SCOPE_AGENT); }
__device__ __forceinline__ unsigned xb_xcc_id() { return (unsigned)__builtin_amdgcn_s_getreg((3 << 11) | 20) & 0xFu; }
#define XB_SPIN(cond, bar) do { unsigned _sp = 0; while (cond) { __builtin_amdgcn_s_sleep(1); \
    if ((++_sp & 255u) == 0u) { if (xb_ld(&(bar)[XB_TMO])) break; if (_sp > XB_SPIN_CAP) { atomicAdd(&(bar)[XB_TMO], 1u); break; } } } } while (0)
struct XcdBarrier { unsigned* bar; unsigned x; volatile LAS unsigned* st; };
__device__ __forceinline__ XcdBarrier xcd_barrier_post(unsigned* bar, volatile LAS unsigned* st) {
    XcdBarrier b; b.bar = bar; b.x = xb_xcc_id(); b.st = st;
    if (threadIdx.x == 0) (void)xb_add(&bar[XB_XCNT(b.x)], 1u);
    return b;
}
__device__ __forceinline__ void xcd_barrier_complete(unsigned* bar, unsigned x, unsigned& nloc, unsigned& nx) {
    const unsigned G = gridDim.x * gridDim.y * gridDim.z;
    unsigned sum, cnt, mine, sp = 0u;
    for (;;) {
        sum = 0u; cnt = 0u; mine = 0u;
#pragma unroll
        for (unsigned j = 0; j < 16; ++j) { const unsigned c = xb_ld(&bar[XB_XCNT(j)]); sum += c; cnt += (c > 0u) ? 1u : 0u; mine = (j == x) ? c : mine; }
        if (sum == G) break;
        __builtin_amdgcn_s_sleep(1);
        if ((++sp & 255u) == 0u) { if (xb_ld(&bar[XB_TMO])) break; if (sp > XB_SPIN_CAP) { atomicAdd(&bar[XB_TMO], 1u); break; } }
    }
    nloc = mine > 0u ? mine : 1u; nx = cnt > 0u ? cnt : 1u;
}
__device__ __forceinline__ void xcd_barrier(const XcdBarrier& b) {
    asm volatile("s_waitcnt vmcnt(0)" ::: "memory");
    __syncthreads();
    if (threadIdx.x == 0) {
        unsigned* bar = b.bar;
        __builtin_amdgcn_s_waitcnt(0);
        unsigned nloc = b.st[0], nx = b.st[1];
        if (nloc == 0u) { xcd_barrier_complete(bar, b.x, nloc, nx); b.st[0] = nloc; b.st[1] = nx; }
        const unsigned old = xb_add(&bar[XB_XSUB(b.x)], 1u);
        const unsigned gen = old / nloc;
        if (old + 1u == (gen + 1u) * nloc) {
            __builtin_amdgcn_fence(__ATOMIC_RELEASE, "agent");
            asm volatile("s_waitcnt vmcnt(0)" ::: "memory");
            const unsigned og = xb_add(&bar[XB_TOP], 1u);
            const unsigned tg = og / nx;
            if (og + 1u == (tg + 1u) * nx) xb_add(&bar[XB_TOPGEN], 1u);
            else XB_SPIN(xb_ld(&bar[XB_TOPGEN]) == tg, bar);
            __builtin_amdgcn_fence(__ATOMIC_ACQUIRE, "agent");
            xb_add(&bar[XB_XGEN(b.x)], 1u);
            asm volatile("s_waitcnt vmcnt(0)" ::: "memory");
        } else {
            XB_SPIN(xb_ld(&bar[XB_XGEN(b.x)]) == gen, bar);
            __builtin_amdgcn_fence(__ATOMIC_ACQUIRE, "agent");
            asm volatile("s_waitcnt vmcnt(0)" ::: "memory");
        }
    }
    __syncthreads();
}


struct Args { const float* in[N_IN]; float* out; unsigned char* ws; int ph_lo, ph_hi; };
static_assert(sizeof(Args) == (N_IN + 2) * 8 + 8, "Args has no padding");

struct Frame {
    const float* x; const float* ctx; float* out; unsigned char* ws; char* lds;
    int tid, lane, wave, bid, nblk, vcu;
};

__device__ __forceinline__ const float* xin_row(const Frame& F, int r) {
    const int b = r / RPB, j = r - b * RPB;
    return (j < CTXL) ? F.ctx + ((size_t)b * CTXL + j) * DM : F.x + ((size_t)b * SEQ + (j - CTXL)) * DM;
}
__device__ __forceinline__ int mod_index(int r) { const int b = r / RPB, j = r - b * RPB; return (j < CTXL) ? 4 : b; }
__device__ __forceinline__ bool is_ctx_row(int r) { return (r % RPB) < CTXL; }

__device__ __forceinline__ void p0_mod(const Args& A, const Frame& F) {
    float* sv = (float*)F.lds;
    float* red = sv + 5 * 1024;
    float* MOD = (float*)(F.ws + WS_MOD);
    bool have = false;
    for (int it = F.bid; it < 2 * 96; it += F.nblk) {
        if (!have) {
            for (int i = F.tid; i < 5 * 1024; i += NTHREADS) { const int m = i >> 10, k = i & 1023;
                const float c = (m < 4) ? A.in[I_C][m * 1024 + k] : A.in[I_CCTX][k]; sv[i] = c / (1.f + __expf(-c)); }
            __syncthreads(); have = true;
        }
        const int l = it / 96, n = (it % 96) * 64 + F.lane;
        const float* W = A.in[l ? I1_ADAW : I0_ADAW]; const float* Bv = A.in[l ? I1_ADAB : I0_ADAB];
        float acc[5] = {0.f, 0.f, 0.f, 0.f, 0.f};
        const int k0 = F.wave * 128;
#pragma unroll 16
        for (int k = k0; k < k0 + 128; ++k) { const float w = W[(size_t)k * 6144 + n];
#pragma unroll
            for (int m = 0; m < 5; ++m) acc[m] += sv[m * 1024 + k] * w; }
#pragma unroll
        for (int m = 0; m < 5; ++m) red[(F.wave * 5 + m) * 64 + F.lane] = acc[m];
        __syncthreads();
        if (F.tid < 320) { const int m = F.tid >> 6, ln = F.tid & 63; float s = 0.f;
#pragma unroll
            for (int w = 0; w < 8; ++w) s += red[(w * 5 + m) * 64 + ln];
            const int nn = (it % 96) * 64 + ln;
            MOD[((size_t)l * 5 + m) * 6144 + nn] = s + Bv[nn]; }
        __syncthreads();
    }
}
__device__ __forceinline__ void transpose_item(const float* W, int K, int N, bf16_t* WT, const float* gain, float* scr, int item, int lane) {
    const int nblk = N / 32, kb = item / nblk, nb = item % nblk, k0 = 64 * kb, n0 = 32 * nb;
#pragma unroll 8
    for (int i = 0; i < 32; ++i) { const int kk = 2 * i + (lane >> 5); float v = W[(size_t)(k0 + kk) * N + n0 + (lane & 31)]; if (gain) v *= gain[k0 + kk]; scr[kk * 33 + (lane & 31)] = v; }
    asm volatile("s_waitcnt lgkmcnt(0)" ::: "memory");
    const int c = lane & 7;
#pragma unroll
    for (int j = 0; j < 4; ++j) { const int n = (lane >> 3) + 8 * j; const float* s = scr + (8 * c) * 33 + n;
        u32x4 o; o.x = pk2(s[0 * 33], s[1 * 33]); o.y = pk2(s[2 * 33], s[3 * 33]); o.z = pk2(s[4 * 33], s[5 * 33]); o.w = pk2(s[6 * 33], s[7 * 33]);
        *(u32x4*)(WT + (size_t)(n0 + n) * K + k0 + 8 * c) = o; }
    asm volatile("s_waitcnt lgkmcnt(0)" ::: "memory");
}
__device__ __forceinline__ void p0_weights(const Args& A, const Frame& F) {
    float* scr = (float*)(F.lds + 32768) + F.wave * (64 * 33);
    const int gw = F.bid * NWAVES + F.wave, NGW = F.nblk * NWAVES;
#define TJOB(IN_, K_, N_, OFF_, GAIN_) do { const float* W = A.in[IN_]; bf16_t* WT = (bf16_t*)(F.ws + (OFF_)); \
        for (int it = gw; it < ((K_) / 64) * ((N_) / 32); it += NGW) transpose_item(W, K_, N_, WT, GAIN_, scr, it, F.lane); } while (0)
    TJOB(I0_WIN, 1024, 704, WS_WIN, nullptr); TJOB(I0_WUQ, 384, 1536, WS_WUQ, A.in[I0_QN]); TJOB(I0_WUKV, 256, 2048, WS_WUKV, A.in[I0_KVN]); TJOB(I0_WO, 1024, 1024, WS_WO0, nullptr);
    TJOB(I1_WQKV, 1024, 1536, WS_WQKV, nullptr); TJOB(I1_WO, 1024, 1024, WS_WO1, nullptr);
#undef TJOB
    { u32x4* z = (u32x4*)(F.ws + WS_WIN + (size_t)704 * 1024 * 2); const int n16 = 64 * 1024 * 2 / 16;
      for (int i = F.bid * NTHREADS + F.tid; i < n16; i += F.nblk * NTHREADS) z[i] = (u32x4){0u, 0u, 0u, 0u}; }
}
__device__ __forceinline__ void p0_weff(const Args& A, const Frame& F) {
    float* kkT = (float*)F.lds; float* wqs = kkT + 128 * 129;
    const int tid = F.tid, lane = F.lane, w = F.wave;
    for (int item = F.bid; item < 512; item += F.nblk) {
        const int layer = item >> 8, z = (item >> 4) & 15, kc = item & 15, h = z >> 1;
        const float* kk = ((z & 1) ? (layer ? A.in[I1_PK2] : A.in[I0_PK2]) : (layer ? A.in[I1_PK1] : A.in[I0_PK1])) + (size_t)h * 16384;
        const float* wq = (layer ? A.in[I1_PWQ] : A.in[I0_PWQ]) + (size_t)(kc * 64) * 2048 + z * 128;
        bf16_t* WT = (bf16_t*)(F.ws + (layer ? WS_WQ1 : WS_WQ0));
        __syncthreads();
        { f32x4 kv[8], wv4[4];
#pragma unroll
          for (int i = 0; i < 8; ++i) kv[i] = *(const f32x4*)(kk + 4 * (tid + i * NTHREADS));
#pragma unroll
          for (int i = 0; i < 4; ++i) { const int e = 4 * (tid + i * NTHREADS); wv4[i] = *(const f32x4*)(wq + (size_t)(e >> 7) * 2048 + (e & 127)); }
#pragma unroll
          for (int i = 0; i < 8; ++i) { const int e = 4 * (tid + i * NTHREADS), key = e >> 7, d = e & 127; kkT[d * 129 + key] = kv[i].x; kkT[(d + 1) * 129 + key] = kv[i].y; kkT[(d + 2) * 129 + key] = kv[i].z; kkT[(d + 3) * 129 + key] = kv[i].w; }
#pragma unroll
          for (int i = 0; i < 4; ++i) *(f32x4*)(wqs + 4 * (tid + i * NTHREADS)) = wv4[i]; }
        __syncthreads();
        float acc[8][2];
#pragma unroll
        for (int j = 0; j < 8; ++j) { acc[j][0] = 0.f; acc[j][1] = 0.f; }
#pragma unroll 2
        for (int d = 0; d < 128; ++d) { const float a0 = kkT[d * 129 + lane], a1 = kkT[d * 129 + lane + 64];
#pragma unroll
            for (int j = 0; j < 8; ++j) { const float wv = wqs[(w * 8 + j) * 128 + d]; acc[j][0] += wv * a0; acc[j][1] += wv * a1; } }
        u32x4 o0, o1;
        o0.x = pk2(acc[0][0], acc[1][0]); o0.y = pk2(acc[2][0], acc[3][0]); o0.z = pk2(acc[4][0], acc[5][0]); o0.w = pk2(acc[6][0], acc[7][0]);
        o1.x = pk2(acc[0][1], acc[1][1]); o1.y = pk2(acc[2][1], acc[3][1]); o1.z = pk2(acc[4][1], acc[5][1]); o1.w = pk2(acc[6][1], acc[7][1]);
        *(u32x4*)(WT + (size_t)(z * 128 + lane) * 1024 + kc * 64 + w * 8) = o0;
        *(u32x4*)(WT + (size_t)(z * 128 + lane + 64) * 1024 + kc * 64 + w * 8) = o1;
    }
    __syncthreads();
}

__device__ __forceinline__ void p0_tables(const Args& A, const Frame& F) {
    const int gw = F.bid * NWAVES + F.wave, NGW = F.nblk * NWAVES, lane = F.lane;
    unsigned char* TAB = F.ws + WS_TAB; float* TSC = (float*)(F.ws + WS_TSC);
    for (int it = gw; it < 4 * 16384 / 4; it += NGW) {
        const int t = it >> 12, row0 = (it & 4095) * 4;
        const float* src = (t == 0 ? A.in[I0_PU] : t == 1 ? A.in[I0_PV] : t == 2 ? A.in[I1_PU] : A.in[I1_PV]) + (size_t)row0 * 1024 + 4 * lane;
        f32x4 v[4][4];
#pragma unroll
        for (int rr = 0; rr < 4; ++rr)
#pragma unroll
            for (int j = 0; j < 4; ++j) v[rr][j] = *(const f32x4*)(src + (size_t)rr * 1024 + 256 * j);
#pragma unroll
        for (int rr = 0; rr < 4; ++rr) {
            float am = 0.f;
#pragma unroll
            for (int j = 0; j < 4; ++j) am = fmaxf(am, fmaxf(fmaxf(fabsf(v[rr][j].x), fabsf(v[rr][j].y)), fmaxf(fabsf(v[rr][j].z), fabsf(v[rr][j].w))));
            am = wave_max(am);
            const float sc = am > 0.f ? am * (1.f / 127.f) : 1.f, inv = am > 0.f ? 127.f / am : 0.f;
            const int row = row0 + rr;
#pragma unroll
            for (int j = 0; j < 4; ++j) { const unsigned b0 = (unsigned)((int)rintf(v[rr][j].x * inv)) & 0xffu, b1 = (unsigned)((int)rintf(v[rr][j].y * inv)) & 0xffu, b2 = (unsigned)((int)rintf(v[rr][j].z * inv)) & 0xffu, b3 = (unsigned)((int)rintf(v[rr][j].w * inv)) & 0xffu;
                *(unsigned*)(TAB + (((size_t)t * 8 + 2 * j + (lane >> 5)) * 16384 + row) * 128 + 4 * (lane & 31)) = b0 | (b1 << 8) | (b2 << 16) | (b3 << 24); }
            if (lane == 0) TSC[t * 16384 + row] = sc;
        }
    }
}

__device__ __forceinline__ void norm_mod_store(const f32x4 (&v)[4], float rinv, const float* g, const float* sh, const float* sc, bf16_t* orow, int lane) {
#pragma unroll
    for (int j = 0; j < 4; ++j) { const int c = 4 * lane + 256 * j;
        const f32x4 gg = *(const f32x4*)(g + c), s1 = *(const f32x4*)(sc + c), s0 = *(const f32x4*)(sh + c);
        const f32x4 y = (v[j] * rinv * gg) * (s1 + 1.f) + s0;
        u32x2 o; o.x = pk2(y.x, y.y); o.y = pk2(y.z, y.w); *(u32x2*)(orow + c) = o; }
}
__device__ __forceinline__ int tok_row(int layer, int n);
__device__ __forceinline__ void norm_row_out(const Frame& F, const f32x4 (&v)[4], float rinv, const float* g, const float* mm, int r, int which) {
    norm_mod_store(v, rinv, g, mm, mm + 1024, (bf16_t*)(F.ws + WS_H) + (size_t)r * DM, F.lane);
    if (which) {
        f32x4 y[4]; float am = 0.f;
#pragma unroll
        for (int j = 0; j < 4; ++j) { const int c = 4 * F.lane + 256 * j; y[j] = (v[j] * rinv * *(const f32x4*)(g + c)) * (*(const f32x4*)(mm + 1024 + c) + 1.f) + *(const f32x4*)(mm + c);
            am = fmaxf(am, fmaxf(fmaxf(fabsf(y[j].x), fabsf(y[j].y)), fmaxf(fabsf(y[j].z), fabsf(y[j].w)))); }
        am = wave_max(am);
        const float inv = am > 0.f ? 127.f / am : 0.f;
#pragma unroll
        for (int j = 0; j < 4; ++j) { const unsigned b0 = (unsigned)((int)rintf(y[j].x * inv)) & 0xffu, b1 = (unsigned)((int)rintf(y[j].y * inv)) & 0xffu, b2 = (unsigned)((int)rintf(y[j].z * inv)) & 0xffu, b3 = (unsigned)((int)rintf(y[j].w * inv)) & 0xffu;
            *(unsigned*)(F.ws + WS_HQ + (size_t)r * DM + 4 * F.lane + 256 * j) = b0 | (b1 << 8) | (b2 << 16) | (b3 << 24); }
        if (F.lane == 0) ((float*)(F.ws + WS_HS))[r] = am > 0.f ? am * (1.f / 127.f) : 1.f;
    }
}
__device__ __forceinline__ void p_norm_rows(const Args& A, const Frame& F, int layer, int which, bool from_input, bool skip_ctx) {
    const int gw = F.bid * NWAVES + F.wave, NGW = F.nblk * NWAVES;
    const float* g = A.in[layer ? (which ? I1_NFFN : I1_NMIX) : (which ? I0_NFFN : I0_NMIX)];
    const float* MOD = (const float*)(F.ws + WS_MOD) + (size_t)layer * 5 * 6144;
    const float* X = (const float*)(F.ws + WS_X);
    const int ntok = skip_ctx ? NB * SEQ : R;
    for (int n = gw; n < ntok; n += 2 * NGW) {
        const bool has1 = (n + NGW) < ntok;
        const int r0 = skip_ctx ? tok_row(1, n) : n, r1 = has1 ? (skip_ctx ? tok_row(1, n + NGW) : n + NGW) : r0;
        const float* x0 = from_input ? xin_row(F, r0) : X + (size_t)r0 * DM; const float* x1 = from_input ? xin_row(F, r1) : X + (size_t)r1 * DM;
        f32x4 v0[4], v1[4]; float s0 = 0.f, s1 = 0.f;
#pragma unroll
        for (int j = 0; j < 4; ++j) { v0[j] = *(const f32x4*)(x0 + 4 * F.lane + 256 * j); v1[j] = *(const f32x4*)(x1 + 4 * F.lane + 256 * j); }
#pragma unroll
        for (int j = 0; j < 4; ++j) { s0 += (v0[j].x * v0[j].x + v0[j].y * v0[j].y) + (v0[j].z * v0[j].z + v0[j].w * v0[j].w); s1 += (v1[j].x * v1[j].x + v1[j].y * v1[j].y) + (v1[j].z * v1[j].z + v1[j].w * v1[j].w); }
        const float ri0 = rsqrtf(wave_sum(s0) * (1.f / DM) + EPS), ri1 = rsqrtf(wave_sum(s1) * (1.f / DM) + EPS);
        norm_row_out(F, v0, ri0, g, MOD + (size_t)mod_index(r0) * 6144 + (which ? 3 * 1024 : 0), r0, which);
        if (has1) norm_row_out(F, v1, ri1, g, MOD + (size_t)mod_index(r1) * 6144 + (which ? 3 * 1024 : 0), r1, which);
    }
}

namespace pg8 {
#define PG8_LAS __attribute__((address_space(3)))
typedef unsigned short bf16_t;
typedef short bf16x8 __attribute__((ext_vector_type(8)));
typedef float f32x4 __attribute__((ext_vector_type(4)));
typedef unsigned u32x4 __attribute__((ext_vector_type(4)));
constexpr int BM = 256, BK = 64, HALF = 128, HTB = HALF * BK * 2  , STAGE_BYTES = 8 * HTB, NXCD = 8, WGM = 8;

__host__ __device__ __forceinline__ int lds_byte(int r, int c) { const int st = (r >> 4) * 2 + (c >> 5), rr = r & 15, cc = c & 31, ob = rr * 64 + cc * 2; return st * 1024 + (ob ^ (((ob >> 9) & 1) << 5)); }
__host__ __device__ __forceinline__ void stage_rc(int b, int& R, int& C) { const int st = b / 1024, sb = b % 1024, swz = sb ^ (((sb >> 9) & 1) << 5); R = (st >> 1) * 16 + swz / 64; C = (st & 1) * 32 + (swz % 64) / 2; }
__host__ __device__ __forceinline__ int perm32(int rho) { const int n = rho >> 4, i = rho & 15; return 8 * (i >> 2) + 4 * n + (i & 3); }

struct Unit { int pm, pn; };
struct Gemm { const bf16_t* A; const bf16_t* Bt; int M, N, K; };

struct StaticOrder {
    int nM, nN, nwg, G, c;
    __host__ __device__ void init(int M, int N, int G_, int c_) { nM = M / BM; nN = N / BM; nwg = nM * nN; G = G_; c = c_; }
    __host__ __device__ bool next(int i, Unit& u) const {
        const long L = (long)i * G + c; if (L >= nwg) return false;
        int wgid = (int)L; { const int q = nwg / NXCD, r = nwg % NXCD, xcd = wgid % NXCD, off = wgid / NXCD; wgid = (xcd < r ? xcd * (q + 1) : r * (q + 1) + (xcd - r) * q) + off; }
        const int nig = WGM * nN, gid = wgid / nig, fm = gid * WGM, gsz = (nM - fm) < WGM ? (nM - fm) : WGM;
        u.pm = fm + ((wgid % nig) % gsz); u.pn = (wgid % nig) / gsz; return true;
    }
    __device__ __forceinline__ void a_ready(const Unit&) const {}
    __device__ __forceinline__ void done(const Unit&) const {}
};

template <class Epi, class Sched, bool ALIGN_EPI = false, bool SP2 = false>
__device__ __forceinline__ void gemm_phase(PG8_LAS unsigned char* lds, const Gemm g, const Sched& S, const Epi& E) {
    const int tid = threadIdx.x, wid = __builtin_amdgcn_readfirstlane(tid >> 6), lane = tid & 63, wr = wid >> 2, wc = wid & 3, fr = lane & 15, fq = lane >> 4;
    const int K = g.K, nt = K / BK;
    unsigned voffA[2], voffB[2];
#pragma unroll
    for (int i = 0; i < 2; ++i) { int R, C; stage_rc(tid * 16 + i * 8192, R, C); const int Rb = Epi::PERM ? ((R & ~31) + perm32(R & 31)) : R;
        voffA[i] = (unsigned)(R * K + C) * 2u; voffB[i] = (unsigned)(Rb * K + C) * 2u; }
    const size_t kstep = (size_t)(BK * 2);
    const size_t hstep = (size_t)HALF * K * 2;
    const size_t tstep = 2 * hstep;
    const unsigned ldsw = (unsigned)wid * 1024u;
    const int aoff = lds_byte(wr * 64 + fr, fq * 8), boff = lds_byte(wc * 32 + fr, fq * 8);
#define PG8_SA(b, h) (((b) * 2 + (h)) * HTB)
#define PG8_SB(b, h) ((4 + (b) * 2 + (h)) * HTB)
#define PG8_STAGE(bufoff, gbase, voff) do { _Pragma("unroll") for (int _i = 0; _i < 2; ++_i) \
        __builtin_amdgcn_global_load_lds((const unsigned*)((const char*)(gbase) + (voff)[_i]), (PG8_LAS unsigned*)(lds + (bufoff) + ldsw + _i * 8192), 16, 0, 0); } while (0)
#define PG8_LDA(dst, b, h) do { _Pragma("unroll") for (int m = 0; m < 4; ++m) _Pragma("unroll") for (int k = 0; k < 2; ++k) dst[m][k] = *(const PG8_LAS bf16x8*)(lds + PG8_SA(b, h) + aoff + m * 2048 + k * 1024); } while (0)
#define PG8_LDB(dst, b, h) do { _Pragma("unroll") for (int n = 0; n < 2; ++n) _Pragma("unroll") for (int k = 0; k < 2; ++k) dst[n][k] = *(const PG8_LAS bf16x8*)(lds + PG8_SB(b, h) + boff + n * 2048 + k * 1024); } while (0)
#define PG8_MMA(ai, bj, At, Bt) do { __builtin_amdgcn_s_setprio(1); _Pragma("unroll") for (int m = 0; m < 4; ++m) _Pragma("unroll") for (int n = 0; n < 2; ++n) _Pragma("unroll") for (int k = 0; k < 2; ++k) \
        acc[ai][bj][m][n] = __builtin_amdgcn_mfma_f32_16x16x32_bf16(Bt[n][k], At[m][k], acc[ai][bj][m][n], 0, 0, 0); __builtin_amdgcn_s_setprio(0); } while (0)
#define PG8_WAIT_V(n) asm volatile("s_waitcnt vmcnt(" #n ")" ::: "memory")
#define PG8_WAIT_L(n) asm volatile("s_waitcnt lgkmcnt(" #n ")" ::: "memory")
#define PG8_BAR __builtin_amdgcn_s_barrier()
#define PG8_SCHED __builtin_amdgcn_sched_barrier(0)
    Unit cur, nxt; int ui = 0;
    if (!S.next(0, cur)) return;
    f32x4 acc[2][2][4][2];
#pragma unroll
    for (int a = 0; a < 2; ++a)
#pragma unroll
        for (int b = 0; b < 2; ++b)
#pragma unroll
            for (int m = 0; m < 4; ++m)
#pragma unroll
                for (int n = 0; n < 2; ++n) acc[a][b][m][n] = (f32x4){0.f, 0.f, 0.f, 0.f};
    bf16x8 At[4][2], B0[2][2], B1[2][2];
    const char* cA = (const char*)g.A + (size_t)cur.pm * tstep; const char* cB = (const char*)g.Bt + (size_t)cur.pn * tstep;
    S.a_ready(cur);
    if constexpr (SP2) {
        PG8_STAGE(PG8_SB(0, 0), cB, voffB); PG8_STAGE(PG8_SB(0, 1), cB + hstep, voffB); PG8_STAGE(PG8_SA(0, 0), cA, voffA); PG8_STAGE(PG8_SA(0, 1), cA + hstep, voffA);
        if (wr == 1) PG8_BAR;
        PG8_WAIT_V(2); PG8_BAR;
        PG8_STAGE(PG8_SB(1, 0), cB + kstep, voffB); PG8_STAGE(PG8_SA(1, 0), cA + kstep, voffA); PG8_STAGE(PG8_SB(1, 1), cB + hstep + kstep, voffB);
        PG8_WAIT_V(6); PG8_BAR;
    } else {
        PG8_STAGE(PG8_SB(0, 0), cB, voffB); PG8_STAGE(PG8_SA(0, 0), cA, voffA); PG8_STAGE(PG8_SB(0, 1), cB + hstep, voffB); PG8_STAGE(PG8_SA(0, 1), cA + hstep, voffA);
        if (wr == 1) PG8_BAR;
        PG8_WAIT_V(4); PG8_BAR;
        PG8_STAGE(PG8_SB(1, 0), cB + kstep, voffB); PG8_STAGE(PG8_SA(1, 0), cA + kstep, voffA); PG8_STAGE(PG8_SB(1, 1), cB + hstep + kstep, voffB);
        PG8_WAIT_V(6); PG8_BAR;
    }
    for (;;) {
        const bool has_next = S.next(ui + 1, nxt);
        const char* nA = has_next ? (const char*)g.A + (size_t)nxt.pm * tstep : cA; const char* nB = has_next ? (const char*)g.Bt + (size_t)nxt.pn * tstep : cB;
        for (int t = 0; t < nt; t += 2) {
            const bool last = (t == nt - 2);
            const char* a1 = cA + (size_t)(t + 1) * kstep;
            const char* a2 = last ? nA : cA + (size_t)(t + 2) * kstep; const char* b2 = last ? nB : cB + (size_t)(t + 2) * kstep;
            const char* a3 = a2 + kstep; const char* b3 = b2 + kstep;
            if (last && has_next) S.a_ready(nxt);
            if constexpr (SP2) {
            PG8_LDB(B0, 0, 0); PG8_LDB(B1, 0, 1); PG8_SCHED; PG8_LDA(At, 0, 0); PG8_STAGE(PG8_SA(1, 1), a1 + hstep, voffA);
            PG8_WAIT_V(8); PG8_WAIT_L(0); PG8_BAR; PG8_MMA(0, 0, At, B0); PG8_MMA(0, 1, At, B1); PG8_BAR; PG8_SCHED;
            PG8_LDA(At, 0, 1); PG8_STAGE(PG8_SB(0, 0), b2, voffB); PG8_STAGE(PG8_SB(0, 1), b2 + hstep, voffB); PG8_STAGE(PG8_SA(0, 0), a2, voffA);
            PG8_WAIT_V(8); PG8_WAIT_L(0); PG8_BAR; PG8_MMA(1, 0, At, B0); PG8_MMA(1, 1, At, B1); PG8_BAR; PG8_SCHED;
            PG8_LDB(B0, 1, 0); PG8_LDB(B1, 1, 1); PG8_SCHED; PG8_LDA(At, 1, 0); PG8_STAGE(PG8_SA(0, 1), a2 + hstep, voffA);
            PG8_WAIT_V(8); PG8_WAIT_L(0); PG8_BAR; PG8_MMA(0, 0, At, B0); PG8_MMA(0, 1, At, B1); PG8_BAR; PG8_SCHED;
            PG8_LDA(At, 1, 1); PG8_STAGE(PG8_SB(1, 0), b3, voffB); PG8_STAGE(PG8_SB(1, 1), b3 + hstep, voffB); PG8_STAGE(PG8_SA(1, 0), a3, voffA);
            PG8_WAIT_V(8); PG8_WAIT_L(0); PG8_BAR; PG8_MMA(1, 0, At, B0); PG8_MMA(1, 1, At, B1); PG8_BAR; PG8_SCHED;
            } else {
            PG8_LDB(B0, 0, 0); PG8_SCHED; PG8_LDA(At, 0, 0); PG8_STAGE(PG8_SA(1, 1), a1 + hstep, voffA);
            PG8_WAIT_L(8); PG8_BAR; PG8_WAIT_L(0); PG8_MMA(0, 0, At, B0); PG8_BAR; PG8_SCHED;
            PG8_LDB(B1, 0, 1); PG8_STAGE(PG8_SB(0, 0), b2, voffB);
            PG8_BAR; PG8_WAIT_L(0); PG8_MMA(0, 1, At, B1); PG8_BAR;
            PG8_LDA(At, 0, 1); PG8_STAGE(PG8_SA(0, 0), a2, voffA);
            PG8_BAR; PG8_WAIT_L(0); PG8_MMA(1, 0, At, B0); PG8_BAR; PG8_SCHED;
            PG8_STAGE(PG8_SB(0, 1), b2 + hstep, voffB);
            PG8_WAIT_V(6); PG8_BAR; PG8_MMA(1, 1, At, B1); PG8_BAR;
            PG8_LDB(B0, 1, 0); PG8_SCHED; PG8_LDA(At, 1, 0); PG8_STAGE(PG8_SA(0, 1), a2 + hstep, voffA);
            PG8_WAIT_L(8); PG8_BAR; PG8_WAIT_L(0); PG8_MMA(0, 0, At, B0); PG8_BAR; PG8_SCHED;
            PG8_LDB(B1, 1, 1); PG8_STAGE(PG8_SB(1, 0), b3, voffB);
            PG8_BAR; PG8_WAIT_L(0); PG8_MMA(0, 1, At, B1); PG8_BAR;
            PG8_LDA(At, 1, 1); PG8_STAGE(PG8_SA(1, 0), a3, voffA);
            PG8_BAR; PG8_WAIT_L(0); PG8_MMA(1, 0, At, B0); PG8_BAR; PG8_SCHED;
            PG8_STAGE(PG8_SB(1, 1), b3 + hstep, voffB);
            PG8_WAIT_V(6); PG8_BAR; PG8_MMA(1, 1, At, B1); PG8_BAR;
            }
        }
        if constexpr (ALIGN_EPI) { if (wr == 0) PG8_BAR; }
        if constexpr (!Epi::AFTER_DRAIN) { E(acc, cur, wr, wc, fr, fq); S.done(cur); }
        if (!has_next) break;
#pragma unroll
        for (int a = 0; a < 2; ++a)
#pragma unroll
            for (int b = 0; b < 2; ++b)
#pragma unroll
                for (int m = 0; m < 4; ++m)
#pragma unroll
                    for (int n = 0; n < 2; ++n) acc[a][b][m][n] = (f32x4){0.f, 0.f, 0.f, 0.f};
        cur = nxt; cA = nA; cB = nB; ++ui;
        if constexpr (ALIGN_EPI) { if (wr == 1) PG8_BAR; }
    }
    PG8_WAIT_V(0);
    if constexpr (!ALIGN_EPI) { if (wr == 0) PG8_BAR; }
    PG8_BAR;
    if constexpr (Epi::AFTER_DRAIN) { E.fused(acc, cur, wr, wc, fr, fq, lds, wid, lane); S.done(cur); }
#undef PG8_SA
#undef PG8_SB
#undef PG8_STAGE
#undef PG8_LDA
#undef PG8_LDB
#undef PG8_MMA
#undef PG8_WAIT_V
#undef PG8_WAIT_L
#undef PG8_BAR
#undef PG8_SCHED
}
}

template <class Inner> struct EpiTile { static constexpr bool PERM = true, AFTER_DRAIN = false; Inner in;
    __device__ __forceinline__ void operator()(const pg8::f32x4 (&acc)[2][2][4][2], const pg8::Unit& u, int wr, int wc, int fr, int fq) const {
#pragma unroll
        for (int ai = 0; ai < 2; ++ai)
#pragma unroll
            for (int m = 0; m < 4; ++m) { const int row = u.pm * 256 + ai * 128 + wr * 64 + m * 16 + fr;
#pragma unroll
                for (int bj = 0; bj < 2; ++bj) in(row, u.pn * 256 + bj * 128 + wc * 32 + 8 * fq, acc[ai][bj][m][0], acc[ai][bj][m][1]); }
    } };
struct In8Bf16 { bf16_t* C; int ldc;
    __device__ __forceinline__ void operator()(int row, int col, f32x4 a, f32x4 b) const { u32x4 o; o.x = cvtpk(a.x, a.y); o.y = cvtpk(a.z, a.w); o.z = cvtpk(b.x, b.y); o.w = cvtpk(b.z, b.w); *(u32x4*)(C + (size_t)row * ldc + col) = o; } };
struct In8KV { bf16_t* Kb; bf16_t* Vb;
    __device__ __forceinline__ void operator()(int row, int col, f32x4 a, f32x4 b) const { const int h = col >> 8, c = col & 255; u32x4 o; o.x = cvtpk(a.x, a.y); o.y = cvtpk(a.z, a.w); o.z = cvtpk(b.x, b.y); o.w = cvtpk(b.z, b.w);
        bf16_t* p = (c < 128) ? Kb + (size_t)row * 1536 + h * 192 + c : Vb + (size_t)row * 1024 + h * 128 + (c - 128);
        *(u32x4*)p = o; } };
struct In8F32 { float* C; int ldc;
    __device__ __forceinline__ void operator()(int row, int col, f32x4 a, f32x4 b) const { float* p = C + (size_t)row * ldc + col; *(f32x4*)p = a; *(f32x4*)(p + 4) = b; } };
struct In8Resid { const float* x; const float* ctx; float* X; const float* gate; bool from_input;
    __device__ __forceinline__ void operator()(int row, int col, f32x4 a, f32x4 b) const {
        const int bb = row / RPB, j = row - bb * RPB; float* xo = X + (size_t)row * DM + col;
        const float* xi = !from_input ? xo : ((j < CTXL) ? ctx + ((size_t)bb * CTXL + j) * DM : x + ((size_t)bb * SEQ + (j - CTXL)) * DM) + col;
        const float* g = gate + (size_t)((j < CTXL) ? 4 : bb) * 6144 + col;
        *(f32x4*)xo = *(const f32x4*)xi + *(const f32x4*)g * a; *(f32x4*)(xo + 4) = *(const f32x4*)(xi + 4) + *(const f32x4*)(g + 4) * b; } };
struct EpiMlaDown { static constexpr bool PERM = true, AFTER_DRAIN = false; bf16_t* CQ; bf16_t* CKV; bf16_t* KR; float* SSP;
    __device__ __forceinline__ void operator()(const pg8::f32x4 (&acc)[2][2][4][2], const pg8::Unit& u, int wr, int wc, int fr, int fq) const {
#pragma unroll
        for (int ai = 0; ai < 2; ++ai)
#pragma unroll
            for (int m = 0; m < 4; ++m) { const int row = u.pm * 256 + ai * 128 + wr * 64 + m * 16 + fr;
#pragma unroll
                for (int bj = 0; bj < 2; ++bj) { const int col = u.pn * 256 + bj * 128 + wc * 32 + 8 * fq; const f32x4 a = acc[ai][bj][m][0], b = acc[ai][bj][m][1];
                    u32x4 o; o.x = cvtpk(a.x, a.y); o.y = cvtpk(a.z, a.w); o.z = cvtpk(b.x, b.y); o.w = cvtpk(b.z, b.w);
                    const int cls = (u.pn * 2 + bj);
                    if (cls < 5) { float sq = (a.x * a.x + a.y * a.y) + (a.z * a.z + a.w * a.w) + (b.x * b.x + b.y * b.y) + (b.z * b.z + b.w * b.w);
                        sq += __shfl_xor(sq, 16); sq += __shfl_xor(sq, 32);
                        if (cls < 3) *(u32x4*)(CQ + (size_t)row * 384 + col) = o; else *(u32x4*)(CKV + (size_t)row * 256 + (col - 384)) = o;
                        if (fq == 0) SSP[(size_t)row * 24 + cls * 4 + wc] = sq; }
                    else if (col < 704) *(u32x4*)(KR + (size_t)row * 64 + (col - 640)) = o; } }
    } };
struct In8Bf16Rs { bf16_t* C; int ldc; const float* ssp;
    __device__ __forceinline__ void operator()(int row, int col, f32x4 a, f32x4 b) const { const f32x4 s0 = *(const f32x4*)(ssp + (size_t)row * 24), s1 = *(const f32x4*)(ssp + (size_t)row * 24 + 4), s2 = *(const f32x4*)(ssp + (size_t)row * 24 + 8);
        const float ssum = (((s0.x + s0.y) + (s0.z + s0.w)) + ((s1.x + s1.y) + (s1.z + s1.w))) + ((s2.x + s2.y) + (s2.z + s2.w));
        const float rs = rsqrtf(ssum * (1.f / 384.f) + EPS); a *= rs; b *= rs;
        u32x4 o; o.x = cvtpk(a.x, a.y); o.y = cvtpk(a.z, a.w); o.z = cvtpk(b.x, b.y); o.w = cvtpk(b.z, b.w); *(u32x4*)(C + (size_t)row * ldc + col) = o; } };
struct In8QkvFold { bf16_t* C; const float* ssv; const float* shw;
    __device__ __forceinline__ void operator()(int row, int col, f32x4 a, f32x4 b) const { const f32x4 s0 = *(const f32x4*)(ssv + (size_t)row * 8), s1 = *(const f32x4*)(ssv + (size_t)row * 8 + 4);
        const float rs = rsqrtf((((s0.x + s0.y) + (s0.z + s0.w)) + ((s1.x + s1.y) + (s1.z + s1.w))) * (1.f / DM) + EPS);
        const float* sp = shw + mod_index(row) * 1536 + col; a = a * rs + *(const f32x4*)sp; b = b * rs + *(const f32x4*)(sp + 4);
        u32x4 o; o.x = cvtpk(a.x, a.y); o.y = cvtpk(a.z, a.w); o.z = cvtpk(b.x, b.y); o.w = cvtpk(b.z, b.w); *(u32x4*)(C + (size_t)row * 1536 + col) = o; } };
struct In8KVRs { bf16_t* Kb; bf16_t* Vb; const float* ssp;
    __device__ __forceinline__ void operator()(int row, int col, f32x4 a, f32x4 b) const { const f32x4 s0 = *(const f32x4*)(ssp + (size_t)row * 24 + 12), s1 = *(const f32x4*)(ssp + (size_t)row * 24 + 16);
        const float ssum = ((s0.x + s0.y) + (s0.z + s0.w)) + ((s1.x + s1.y) + (s1.z + s1.w));
        const float rs = rsqrtf(ssum * (1.f / 256.f) + EPS); a *= rs; b *= rs;
        const int h = col >> 8, c = col & 255; u32x4 o; o.x = cvtpk(a.x, a.y); o.y = cvtpk(a.z, a.w); o.z = cvtpk(b.x, b.y); o.w = cvtpk(b.z, b.w);
        bf16_t* p = (c < 128) ? Kb + (size_t)row * 1536 + h * 192 + c : Vb + (size_t)row * 1024 + h * 128 + (c - 128);
        *(u32x4*)p = o; } };
struct RowSched { pg8::StaticOrder so; bool latent_only;
    __device__ __forceinline__ void init(int N, int G, int c, bool lat) { latent_only = lat; so.init(lat ? NB * SEQ : R, N, G, c); }
    __device__ __forceinline__ bool next(int i, pg8::Unit& u) const { if (!so.next(i, u)) return false; if (latent_only) u.pm = (u.pm >> 4) * 17 + 1 + (u.pm & 15); return true; }
    __device__ __forceinline__ void a_ready(const pg8::Unit&) const {}
    __device__ __forceinline__ void done(const pg8::Unit&) const {} };
template <class Inner> __device__ __forceinline__ void gemm8(const Frame& F, const bf16_t* Ap, const bf16_t* Bt, int N, int K, bool latent_only, const Inner& in) {
    asm volatile("" : "+s"(K));
    pg8::Gemm g{Ap, Bt, R, N, K}; RowSched S; S.init(N, F.nblk, F.bid, latent_only);
    EpiTile<Inner> E{in};
    pg8::gemm_phase<EpiTile<Inner>, RowSched, true, true>((PG8_LAS unsigned char*)F.lds, g, S, E);
}

template <class Epi> __device__ __forceinline__ void gemm8e(const Frame& F, const bf16_t* Ap, const bf16_t* Bt, int N, int K, bool latent_only, const Epi& E) {
    asm volatile("" : "+s"(K));
    pg8::Gemm g{Ap, Bt, R, N, K}; RowSched S; S.init(N, F.nblk, F.bid, latent_only);
    pg8::gemm_phase<Epi, RowSched, true, true>((PG8_LAS unsigned char*)F.lds, g, S, E);
}

struct GemmDesc { const bf16_t* A; int lda; long sA; const bf16_t* Bt; int ldb; long sB; int M, N, K, nz; };
template <class Epi>
__device__ __forceinline__ void gemm_simple(const Frame& F, const GemmDesc& g, const Epi& epi, bool skip_ctx) {
    const int wm = F.wave >> 1, wn = F.wave & 1, fr = F.lane & 15, fq = F.lane >> 4;
    const int tM = g.M / 128, tN = g.N / 128, per = tM * tN, total = per * g.nz;
    for (int u = F.bid; u < total; u += F.nblk) {
        const int z = u / per, uu = u - z * per, tm = uu / tN, tn = uu - tm * tN;
        if (skip_ctx && ((tm * 128) % RPB) < CTXL) continue;
        const int row0 = tm * 128 + wm * 32, col0 = tn * 128 + wn * 64;
        const bf16_t* ap = g.A + z * g.sA + (size_t)(row0 + fr) * g.lda + fq * 8;
        const bf16_t* bp = g.Bt + z * g.sB + (size_t)(col0 + fr) * g.ldb + fq * 8;
        f32x4 acc[2][4];
#pragma unroll
        for (int mi = 0; mi < 2; ++mi)
#pragma unroll
            for (int ni = 0; ni < 4; ++ni) acc[mi][ni] = (f32x4){0.f, 0.f, 0.f, 0.f};
        for (int k0 = 0; k0 < g.K; k0 += 32) {
            bf16x8 a[2], b[4];
#pragma unroll
            for (int mi = 0; mi < 2; ++mi) a[mi] = *(const bf16x8*)(ap + (size_t)mi * 16 * g.lda + k0);
#pragma unroll
            for (int ni = 0; ni < 4; ++ni) b[ni] = *(const bf16x8*)(bp + (size_t)ni * 16 * g.ldb + k0);
#pragma unroll
            for (int mi = 0; mi < 2; ++mi)
#pragma unroll
                for (int ni = 0; ni < 4; ++ni) acc[mi][ni] = __builtin_amdgcn_mfma_f32_16x16x32_bf16(b[ni], a[mi], acc[mi][ni], 0, 0, 0);
        }
#pragma unroll
        for (int mi = 0; mi < 2; ++mi)
#pragma unroll
            for (int ni = 0; ni < 4; ++ni) epi(z, row0 + mi * 16 + fr, col0 + ni * 16 + fq * 4, acc[mi][ni]);
    }
}
struct EpiBf16 { bf16_t* C; int ldc;
    __device__ __forceinline__ void operator()(int, int row, int col, f32x4 v) const { u32x2 o; o.x = pk2(v.x, v.y); o.y = pk2(v.z, v.w); *(u32x2*)(C + (size_t)row * ldc + col) = o; } };
struct EpiKV { bf16_t* Kb; bf16_t* Vb;
    __device__ __forceinline__ void operator()(int, int row, int col, f32x4 v) const { const int h = col >> 8, c = col & 255; u32x2 o; o.x = pk2(v.x, v.y); o.y = pk2(v.z, v.w);
        if (c < 128) *(u32x2*)(Kb + (size_t)row * 1536 + h * 192 + c) = o; else *(u32x2*)(Vb + (size_t)row * 1024 + h * 128 + (c - 128)) = o; } };
struct EpiF32Z { float* C; int ldc;
    __device__ __forceinline__ void operator()(int z, int row, int col, f32x4 v) const { *(f32x4*)(C + (size_t)row * ldc + z * 128 + col) = v; } };
struct EpiResid { const Frame* F; const float* gate; bool from_input;
    __device__ __forceinline__ void operator()(int, int row, int col, f32x4 v) const {
        float* X = (float*)(F->ws + WS_X) + (size_t)row * DM + col;
        const float* xi = from_input ? xin_row(*F, row) + col : X;
        const f32x4 g = *(const f32x4*)(gate + (size_t)mod_index(row) * 6144 + col);
        *(f32x4*)X = *(const f32x4*)xi + g * v; } };

__device__ __forceinline__ void rope_angles(int r, int& prow, int& pcol) { const int t = (r % RPB) - CTXL; prow = t >> 6; pcol = t & 63; }
__device__ __forceinline__ void p_mla_krope(const Args& A, const Frame& F) {
    const int gw = F.bid * NWAVES + F.wave, NGW = F.nblk * NWAVES, lane = F.lane;
    const bf16_t* KR = (const bf16_t*)(F.ws + WS_KR); bf16_t* Kb = (bf16_t*)(F.ws + WS_K);
    const float invf = __powf(10000.f, -(float)(lane & 15) * (1.f / 16.f));
    for (int r = gw; r < R; r += NGW) {
        float kr = bf2f(KR[(size_t)r * 64 + lane]);
        if (!is_ctx_row(r)) {
            int prow, pcol; rope_angles(r, prow, pcol);
            const float ang = (float)((lane & 32) ? pcol : prow) * invf;
            const float cs = cosf(ang), sn = sinf(ang);
            const float partner = __shfl_xor(kr, 16);
            kr = kr * cs + ((lane & 16) ? partner : -partner) * sn;
        }
        const bf16_t kb = (bf16_t)f2bf(kr);
#pragma unroll
        for (int h = 0; h < 8; ++h) Kb[(size_t)r * 1536 + h * 192 + 128 + lane] = kb;
    }
}
__device__ __forceinline__ void p_gqa_rows(const Args& A, const Frame& F) {
    const int gw = F.bid * NWAVES + F.wave, NGW = F.nblk * NWAVES, lane = F.lane;
    const bf16_t* RAW = (const bf16_t*)(F.ws + WS_RAW1); bf16_t* Q1 = (bf16_t*)(F.ws + WS_Q1); bf16_t* K1 = (bf16_t*)(F.ws + WS_K1); bf16_t* V1 = (bf16_t*)(F.ws + WS_V1);
    const float* qg = A.in[I1_QN]; const float* kg = A.in[I1_KN];
    for (int r = gw; r < R; r += NGW) {
        const bool ctx = is_ctx_row(r);
        const bf16_t* a = RAW + (size_t)r * 1536;
        float cs0 = 1.f, sn0 = 0.f, cs1 = 1.f, sn1 = 0.f;
        if (!ctx) { int prow, pcol; rope_angles(r, prow, pcol);
            const float invf = __powf(10000.f, -(float)(lane & 31) * (1.f / 32.f));
            const float a0 = (float)prow * invf, a1 = (float)pcol * invf; cs0 = cosf(a0); sn0 = sinf(a0); cs1 = cosf(a1); sn1 = sinf(a1); }
#pragma unroll 1
        for (int hh = 0; hh < 10; ++hh) {
            if (ctx && hh < 8) continue;
            const bf16_t* src = a + hh * 128; const float* gn = hh < 8 ? qg : kg;
            float x0 = bf2f(src[lane]), x1 = bf2f(src[lane + 64]);
            const float rinv = rsqrtf(wave_sum(x0 * x0 + x1 * x1) * (1.f / 128.f) + EPS);
            x0 = x0 * rinv * gn[lane]; x1 = x1 * rinv * gn[lane + 64];
            const float p0 = __shfl_xor(x0, 32), p1 = __shfl_xor(x1, 32);
            const float y0 = x0 * cs0 + ((lane & 32) ? p0 : -p0) * sn0, y1 = x1 * cs1 + ((lane & 32) ? p1 : -p1) * sn1;
            bf16_t* dst = hh < 8 ? Q1 + (size_t)r * 1024 + hh * 128 : K1 + (size_t)r * 256 + (hh - 8) * 128;
            dst[lane] = (bf16_t)f2bf(y0); dst[lane + 64] = (bf16_t)f2bf(y1);
        }
        *(u32x2*)(V1 + (size_t)r * 256 + 4 * lane) = *(const u32x2*)(a + 1280 + 4 * lane);
    }
}

__device__ __forceinline__ int crow(int r, int hi) { return (r & 3) + 8 * (r >> 2) + 4 * hi; }
__device__ __forceinline__ int v_st(int k, int c) { const int kk = (k & ~0xC) | ((k & 4) << 1) | ((k & 8) >> 1); return ((kk >> 3) * 4 + (c >> 5)) * 512 + ((kk & 7) * 32 + (c & 31)) * 2; }
__device__ __forceinline__ int v_rd_base(int lane) { return ((lane & 3) << 3) | (((lane >> 2) & 3) << 6) | (((lane >> 4) & 1) << 5) | (((lane >> 5) & 1) << 8); }
constexpr int v_rd_off(int d0, int ks, int half) { return d0 * 512 + ks * 4096 + half * 2048; }
template <int OFF> __device__ __forceinline__ s16x4 tr_read(int vb) { s16x4 r; asm volatile("ds_read_b64_tr_b16 %0, %1 offset:%2" : "=&v"(r) : "v"(vb), "i"(OFF) : "memory"); return r; }
template <int D0> __device__ __forceinline__ void pv_one(f32x16& od, int vb, bf16x8 pa0, bf16x8 pa1, bf16x8 pa2, bf16x8 pa3) {
    const s16x4 l0 = tr_read<v_rd_off(D0, 0, 0)>(vb), h0 = tr_read<v_rd_off(D0, 0, 1)>(vb), l1 = tr_read<v_rd_off(D0, 1, 0)>(vb), h1 = tr_read<v_rd_off(D0, 1, 1)>(vb);
    const s16x4 l2 = tr_read<v_rd_off(D0, 2, 0)>(vb), h2 = tr_read<v_rd_off(D0, 2, 1)>(vb), l3 = tr_read<v_rd_off(D0, 3, 0)>(vb), h3 = tr_read<v_rd_off(D0, 3, 1)>(vb);
    asm volatile("s_waitcnt lgkmcnt(0)" ::: "memory"); SBAR();
#define PK(L, H) (bf16x8){L[0], L[1], L[2], L[3], H[0], H[1], H[2], H[3]}
    od = __builtin_amdgcn_mfma_f32_32x32x16_bf16(pa0, PK(l0, h0), od, 0, 0, 0);
    od = __builtin_amdgcn_mfma_f32_32x32x16_bf16(pa1, PK(l1, h1), od, 0, 0, 0);
    od = __builtin_amdgcn_mfma_f32_32x32x16_bf16(pa2, PK(l2, h2), od, 0, 0, 0);
    od = __builtin_amdgcn_mfma_f32_32x32x16_bf16(pa3, PK(l3, h3), od, 0, 0, 0);
#undef PK
}
__device__ __forceinline__ void pv_d0(f32x16* o, int vb, bf16x8 pa0, bf16x8 pa1, bf16x8 pa2, bf16x8 pa3) {
    pv_one<0>(o[0], vb, pa0, pa1, pa2, pa3); pv_one<1>(o[1], vb, pa0, pa1, pa2, pa3); pv_one<2>(o[2], vb, pa0, pa1, pa2, pa3); pv_one<3>(o[3], vb, pa0, pa1, pa2, pa3);
}
constexpr float ATT_THR = 8.f;
__device__ __forceinline__ void partialSM(f32x16& p0, f32x16& p1, float& m_reg, float& mn, float& alpha, float C, float thr_raw) {
    float pmax = p0[0];
#pragma unroll
    for (int r = 1; r < 16; ++r) pmax = fmaxf(pmax, p0[r]);
#pragma unroll
    for (int r = 0; r < 16; ++r) pmax = fmaxf(pmax, p1[r]);
    { auto rr = __builtin_amdgcn_permlane32_swap(__float_as_uint(pmax), __float_as_uint(pmax), false, false);
      pmax = fmaxf(__uint_as_float(rr[0]), __uint_as_float(rr[1])); }
    if (__builtin_expect(__all(pmax - m_reg <= thr_raw), 1)) { mn = m_reg; alpha = 1.f; }
    else { mn = fmaxf(m_reg, pmax); alpha = __builtin_amdgcn_exp2f((m_reg - mn) * C); m_reg = mn; }
    const float mnC = -mn * C;
#pragma unroll
    for (int r = 0; r < 16; ++r) p0[r] = fmaf(p0[r], C, mnC);
#pragma unroll
    for (int r = 0; r < 16; ++r) p1[r] = fmaf(p1[r], C, mnC);
#pragma unroll
    for (int r = 0; r < 16; ++r) p0[r] = __builtin_amdgcn_exp2f(p0[r]);
}
__device__ __forceinline__ void finishSM(f32x16& p0, f32x16& p1, float alpha, float& l_reg, bf16x8& pa0, bf16x8& pa1, bf16x8& pa2, bf16x8& pa3) {
#pragma unroll
    for (int r = 0; r < 16; ++r) p1[r] = __builtin_amdgcn_exp2f(p1[r]);
    float ps = 0;
#pragma unroll
    for (int r = 0; r < 16; ++r) ps += p0[r];
#pragma unroll
    for (int r = 0; r < 16; ++r) ps += p1[r];
    { auto rr = __builtin_amdgcn_permlane32_swap(__float_as_uint(ps), __float_as_uint(ps), false, false);
      ps = __uint_as_float(rr[0]) + __uint_as_float(rr[1]); }
    l_reg = l_reg * alpha + ps;
#define PK4(P, BASE, OUT) do { unsigned a0 = cvtpk(P[BASE + 0], P[BASE + 1]), a1 = cvtpk(P[BASE + 2], P[BASE + 3]);   \
    unsigned b0 = cvtpk(P[BASE + 4], P[BASE + 5]), b1 = cvtpk(P[BASE + 6], P[BASE + 7]);                              \
    auto r0 = __builtin_amdgcn_permlane32_swap(a0, b0, false, false); auto r1 = __builtin_amdgcn_permlane32_swap(a1, b1, false, false); \
    u32x4 w = {r0[0], r1[0], r0[1], r1[1]}; OUT = *reinterpret_cast<bf16x8*>(&w); } while (0)
    PK4(p0, 0, pa0); PK4(p0, 8, pa1); PK4(p1, 0, pa2); PK4(p1, 8, pa3);
#undef PK4
}
template <int DQK> __device__ __forceinline__ void qkt(f32x16& p0, f32x16& p1, const char* Ks, const bf16x8* qr, int r32, int hi) {
    constexpr int KP = DQK * 2 + 16;
    p0 = f32x16{}; p1 = f32x16{};
#pragma unroll
    for (int d0 = 0; d0 < DQK / 16; ++d0) { const int cb = (d0 * 16 + hi * 8) * 2;
        const bf16x8 b0 = *reinterpret_cast<const bf16x8*>(Ks + r32 * KP + cb);
        const bf16x8 b1 = *reinterpret_cast<const bf16x8*>(Ks + (32 + r32) * KP + cb);
        p0 = __builtin_amdgcn_mfma_f32_32x32x16_bf16(b0, qr[d0], p0, 0, 0, 0);
        p1 = __builtin_amdgcn_mfma_f32_32x32x16_bf16(b1, qr[d0], p1, 0, 0, 0); }
}
template <int DQK> constexpr int att_lds_bytes() { return 2 * 64 * 128 * 2 + 2 * 64 * (DQK * 2 + 16) + NWAVES * 64 * 4; }
template <int DQK, int LDQ, int LDK, int LDV, int LDO>
__device__ __forceinline__ void attn_body(const bf16_t* __restrict__ Qb, const bf16_t* __restrict__ Kh, const bf16_t* __restrict__ Vh, bf16_t* __restrict__ Ob, int seq, float scale, char* lds) {
    constexpr int KP = DQK * 2 + 16, SHM_V = 64 * 128 * 2, SHM_K = 64 * KP, ND = DQK / 16, CH = DQK / 8, NKL = CH * 64 / NTHREADS;
    const float C = scale * 1.4426950408889634f, thr_raw = ATT_THR / scale;
    const int tid = threadIdx.x, wid = tid >> 6, lane = tid & 63, r32 = lane & 31, hi = lane >> 5;
    char* V_lds = lds; char* K_lds = lds + 2 * SHM_V;
    float* wsf = (float*)(lds + 2 * SHM_V + 2 * SHM_K) + wid * 64; float* li_l = wsf; float* al_l = wsf + 32;
    float m_reg = -1e30f, l_reg = 0; f32x16 o[4] = {}; bf16x8 qr[ND];
    const bf16_t* Qw = Qb + (long)(wid * 32 + r32) * LDQ + hi * 8;
#pragma unroll
    for (int d0 = 0; d0 < ND; ++d0) qr[d0] = *reinterpret_cast<const bf16x8*>(Qw + d0 * 16);
    const int sr = tid >> 4, sc = (tid & 15) * 8, vst0 = v_st(sr, sc), vst1 = v_st(32 + sr, sc);
    static_assert(DQK == 128, "double-pipelined body: 128-wide q.k only");
    const int vb0 = (int)(uintptr_t)V_lds + v_rd_base(lane);
    bf16x8 vs0, vs1, ks[NKL];
#define SLOAD(k0) do { vs0 = *reinterpret_cast<const bf16x8*>(&Vh[(long)((k0) + sr) * LDV + sc]); vs1 = *reinterpret_cast<const bf16x8*>(&Vh[(long)((k0) + 32 + sr) * LDV + sc]); \
    _Pragma("unroll") for (int i_ = 0; i_ < NKL; ++i_) ks[i_] = *reinterpret_cast<const bf16x8*>(&Kh[(long)((k0) + sr + 32 * i_) * LDK + sc]); } while (0)
#define SWRITE(b) do { *(bf16x8*)(V_lds + (b) * SHM_V + vst0) = vs0; *(bf16x8*)(V_lds + (b) * SHM_V + vst1) = vs1; \
    _Pragma("unroll") for (int i_ = 0; i_ < NKL; ++i_) *(bf16x8*)(K_lds + (b) * SHM_K + (sr + 32 * i_) * KP + sc * 2) = ks[i_]; } while (0)
#define RESC(a) do { if (__any((a) < 1.f)) { if (hi == 0) al_l[r32] = (a); asm volatile("s_waitcnt lgkmcnt(0)" ::: "memory"); \
    _Pragma("unroll") for (int d = 0; d < 4; ++d) _Pragma("unroll") for (int r = 0; r < 16; ++r) o[d][r] *= al_l[crow(r, hi)]; } } while (0)
    f32x16 pA0, pA1, pB0, pB1; float mnA, mnB, alA, alB; bf16x8 pa0, pa1, pa2, pa3; const int NT = seq / 64;
    SLOAD(0); asm volatile("s_waitcnt vmcnt(0)" ::: "memory"); SWRITE(0); __syncthreads();
    qkt<DQK>(pA0, pA1, K_lds, qr, r32, hi); partialSM(pA0, pA1, m_reg, mnA, alA, C, thr_raw);
    SLOAD(64);
    asm volatile("s_waitcnt vmcnt(0)" ::: "memory"); SWRITE(1); __syncthreads();
    for (int j = 1; j + 1 < NT; j += 2) {
        SBAR(); qkt<DQK>(pB0, pB1, K_lds + SHM_K, qr, r32, hi);
        finishSM(pA0, pA1, alA, l_reg, pa0, pa1, pa2, pa3); SBAR();
        SLOAD((j + 1) * 64); SBAR();
        pv_d0(o, vb0, pa0, pa1, pa2, pa3); partialSM(pB0, pB1, m_reg, mnB, alB, C, thr_raw);
        __syncthreads(); asm volatile("s_waitcnt vmcnt(0)" ::: "memory"); SWRITE(0);
        RESC(alB); __syncthreads();
        SBAR(); qkt<DQK>(pA0, pA1, K_lds, qr, r32, hi);
        finishSM(pB0, pB1, alB, l_reg, pa0, pa1, pa2, pa3); SBAR();
        SLOAD((j + 2) * 64); SBAR();
        pv_d0(o, vb0 + SHM_V, pa0, pa1, pa2, pa3); partialSM(pA0, pA1, m_reg, mnA, alA, C, thr_raw);
        __syncthreads(); asm volatile("s_waitcnt vmcnt(0)" ::: "memory"); SWRITE(1);
        RESC(alA); __syncthreads();
    }
    SBAR(); qkt<DQK>(pB0, pB1, K_lds + SHM_K, qr, r32, hi);
    finishSM(pA0, pA1, alA, l_reg, pa0, pa1, pa2, pa3); SBAR();
    pv_d0(o, vb0, pa0, pa1, pa2, pa3); partialSM(pB0, pB1, m_reg, mnB, alB, C, thr_raw);
    __syncthreads(); RESC(alB);
    finishSM(pB0, pB1, alB, l_reg, pa0, pa1, pa2, pa3); SBAR();
    pv_d0(o, vb0 + SHM_V, pa0, pa1, pa2, pa3);
    if (hi == 0) li_l[r32] = l_reg; asm volatile("s_waitcnt lgkmcnt(0)" ::: "memory");
    float rli[16];
#pragma unroll
    for (int r = 0; r < 16; ++r) rli[r] = __builtin_amdgcn_rcpf(li_l[crow(r, hi)]);
    bf16_t* Ow = Ob + (long)(wid * 32) * LDO;
#pragma unroll
    for (int r = 0; r < 16; ++r) { const int orow = crow(r, hi);
#pragma unroll
        for (int d0 = 0; d0 < 4; ++d0) Ow[(long)orow * LDO + d0 * 32 + r32] = (bf16_t)f2bf(o[d0][r] * rli[r]); }
    __syncthreads();
#undef SLOAD
#undef SWRITE
#undef RESC
}
template <int DQK, int LDQ, int LDK, int LDV, int LDO>
__device__ __forceinline__ void attn_body_single(const bf16_t* __restrict__ Qb, const bf16_t* __restrict__ Kh, const bf16_t* __restrict__ Vh, bf16_t* __restrict__ Ob, int seq, float scale, char* lds, int rope_t0) {
    constexpr int KP = DQK * 2 + 16, SHM_V = 64 * 128 * 2, SHM_K = 64 * KP, ND = DQK / 16, CH = DQK / 8, NKL = CH * 64 / NTHREADS;
    const float C = scale * 1.4426950408889634f, thr_raw = ATT_THR / scale;
    const int tid = threadIdx.x, wid = tid >> 6, lane = tid & 63, r32 = lane & 31, hi = lane >> 5;
    char* V_lds = lds; char* K_lds = lds + 2 * SHM_V;
    float* wsf = (float*)(lds + 2 * SHM_V + 2 * SHM_K) + wid * 64; float* li_l = wsf; float* al_l = wsf + 32;
    float m_reg = -1e30f, l_reg = 0; f32x16 o[4] = {}; bf16x8 qr[ND];
    const bf16_t* Qw = Qb + (long)(wid * 32 + r32) * LDQ + hi * 8;
#pragma unroll
    for (int d0 = 8; d0 < ND; ++d0) qr[d0] = *reinterpret_cast<const bf16x8*>(Qw + d0 * 16);
    if constexpr (DQK == 192) {
        if (rope_t0 >= 0) {
            const int tq = rope_t0 + wid * 32 + r32; const float prow = (float)(tq >> 6), pcol = (float)(tq & 63);
            u32x4 fa1 = __builtin_bit_cast(u32x4, qr[8]), fa2 = __builtin_bit_cast(u32x4, qr[9]), fb1 = __builtin_bit_cast(u32x4, qr[10]), fb2 = __builtin_bit_cast(u32x4, qr[11]);
#pragma unroll
            for (int jj = 0; jj < 4; ++jj) {
                float na1[2], na2[2], nb1[2], nb2[2];
#pragma unroll
                for (int e = 0; e < 2; ++e) { const float invf = __powf(10000.f, -(float)(hi * 8 + 2 * jj + e) * (1.f / 16.f));
                    const float ar = prow * invf, ac = pcol * invf, cr = __cosf(ar), sr_ = __sinf(ar), cc = __cosf(ac), sc_ = __sinf(ac);
                    const float a1 = e ? bfhi(fa1[jj]) : bflo(fa1[jj]), a2 = e ? bfhi(fa2[jj]) : bflo(fa2[jj]), b1 = e ? bfhi(fb1[jj]) : bflo(fb1[jj]), b2 = e ? bfhi(fb2[jj]) : bflo(fb2[jj]);
                    na1[e] = a1 * cr - a2 * sr_; na2[e] = a2 * cr + a1 * sr_; nb1[e] = b1 * cc - b2 * sc_; nb2[e] = b2 * cc + b1 * sc_; }
                fa1[jj] = pk2(na1[0], na1[1]); fa2[jj] = pk2(na2[0], na2[1]); fb1[jj] = pk2(nb1[0], nb1[1]); fb2[jj] = pk2(nb2[0], nb2[1]);
            }
            qr[8] = __builtin_bit_cast(bf16x8, fa1); qr[9] = __builtin_bit_cast(bf16x8, fa2); qr[10] = __builtin_bit_cast(bf16x8, fb1); qr[11] = __builtin_bit_cast(bf16x8, fb2);
        }
    }
    asm volatile("" ::: "memory");
#pragma unroll
    for (int d0 = 0; d0 < 8; ++d0) qr[d0] = *reinterpret_cast<const bf16x8*>(Qw + d0 * 16);
    const int sr = tid >> 4, sc = (tid & 15) * 8, vst0 = v_st(sr, sc), vst1 = v_st(32 + sr, sc);
    int krow[NKL], kch[NKL];
#pragma unroll
    for (int i = 0; i < NKL; ++i) { const int id = tid + i * NTHREADS; krow[i] = id / CH; kch[i] = id % CH; }
    const int vb0 = (int)(uintptr_t)V_lds + v_rd_base(lane);
    bf16x8 vs0, vs1, ks[NKL];
#define SLOAD(k0) do { vs0 = *reinterpret_cast<const bf16x8*>(&Vh[(long)((k0) + sr) * LDV + sc]); vs1 = *reinterpret_cast<const bf16x8*>(&Vh[(long)((k0) + 32 + sr) * LDV + sc]); \
    _Pragma("unroll") for (int i_ = 0; i_ < NKL; ++i_) ks[i_] = *reinterpret_cast<const bf16x8*>(&Kh[(long)((k0) + krow[i_]) * LDK + kch[i_] * 8]); } while (0)
#define SWRITE(b) do { *(bf16x8*)(V_lds + (b) * SHM_V + vst0) = vs0; *(bf16x8*)(V_lds + (b) * SHM_V + vst1) = vs1; \
    _Pragma("unroll") for (int i_ = 0; i_ < NKL; ++i_) *(bf16x8*)(K_lds + (b) * SHM_K + krow[i_] * KP + kch[i_] * 16) = ks[i_]; } while (0)
#define RESC(a) do { if (__any((a) < 1.f)) { if (hi == 0) al_l[r32] = (a); asm volatile("s_waitcnt lgkmcnt(0)" ::: "memory"); \
    _Pragma("unroll") for (int d = 0; d < 4; ++d) _Pragma("unroll") for (int r = 0; r < 16; ++r) o[d][r] *= al_l[crow(r, hi)]; } } while (0)
    f32x16 p0, p1; float mn, al; bf16x8 pa0, pa1, pa2, pa3; const int NT = seq / 64;
    SLOAD(0); asm volatile("s_waitcnt vmcnt(0)" ::: "memory"); SWRITE(0); __syncthreads();
    SLOAD(64);
    for (int j = 0; j < NT; ++j) {
        const int b = j & 1;
        SBAR(); qkt<DQK>(p0, p1, K_lds + b * SHM_K, qr, r32, hi);
        partialSM(p0, p1, m_reg, mn, al, C, thr_raw);
        RESC(al);
        finishSM(p0, p1, al, l_reg, pa0, pa1, pa2, pa3); SBAR();
        pv_d0(o, vb0 + b * SHM_V, pa0, pa1, pa2, pa3);
        if (j + 1 < NT) { asm volatile("s_waitcnt vmcnt(0)" ::: "memory"); SWRITE(b ^ 1); }
        __syncthreads();
        if (j + 2 < NT) SLOAD((j + 2) * 64);
    }
    if (hi == 0) li_l[r32] = l_reg; asm volatile("s_waitcnt lgkmcnt(0)" ::: "memory");
    float rli[16];
#pragma unroll
    for (int r = 0; r < 16; ++r) rli[r] = __builtin_amdgcn_rcpf(li_l[crow(r, hi)]);
    bf16_t* Ow = Ob + (long)(wid * 32) * LDO;
#pragma unroll
    for (int r = 0; r < 16; ++r) { const int orow = crow(r, hi);
#pragma unroll
        for (int d0 = 0; d0 < 4; ++d0) Ow[(long)orow * LDO + d0 * 32 + r32] = (bf16_t)f2bf(o[d0][r] * rli[r]); }
    __syncthreads();
#undef SLOAD
#undef SWRITE
#undef RESC
}
__device__ __forceinline__ void p_attn_mla(const Args& A, const Frame& F) {
    const bf16_t* Q = (const bf16_t*)(F.ws + WS_Q); const bf16_t* Kb = (const bf16_t*)(F.ws + WS_K); const bf16_t* Vb = (const bf16_t*)(F.ws + WS_V); bf16_t* O = (bf16_t*)(F.ws + WS_O);
    const float scale = 0.07216878364870322f;
    for (int u = F.vcu; u < 544; u += F.nblk) {
        int b, h, q0, seq;
        int rope_t0;
        if (u < 512) { const int qb = u & 15; h = (u >> 4) & 7; b = u >> 7; q0 = CTXL + qb * 256; seq = RPB; rope_t0 = qb * 256; }
        else { const int v = u - 512; h = v & 7; b = v >> 3; q0 = 0; seq = CTXL; rope_t0 = -1; }
        const size_t rb = (size_t)b * RPB;
        attn_body_single<192, 1536, 1536, 1024, 1024>(Q + (rb + q0) * 1536 + h * 192, Kb + rb * 1536 + h * 192, Vb + rb * 1024 + h * 128, O + (rb + q0) * 1024 + h * 128, seq, scale, F.lds, rope_t0);
    }
}
__device__ __forceinline__ void p_attn_gqa(const Args& A, const Frame& F) {
    const bf16_t* Q = (const bf16_t*)(F.ws + WS_Q1); const bf16_t* Kb = (const bf16_t*)(F.ws + WS_K1); const bf16_t* Vb = (const bf16_t*)(F.ws + WS_V1); bf16_t* O = (bf16_t*)(F.ws + WS_O);
    const float scale = 0.08838834764831845f;
    for (int u = F.vcu; u < 512; u += F.nblk) {
        const int qb = u & 15, h = (u >> 4) & 7, b = u >> 7, q0 = CTXL + qb * 256, kvh = h >> 2;
        const size_t rb = (size_t)b * RPB;
        attn_body<128, 1024, 256, 256, 1024>(Q + (rb + q0) * 1024 + h * 128, Kb + rb * 256 + kvh * 128, Vb + rb * 256 + kvh * 128, O + (rb + q0) * 1024 + h * 128, RPB, scale, F.lds);
    }
}

#define DPP_XOR1 0xB1
#define DPP_XOR2 0x4E
#define DPP_HMIRROR 0x141
#define DPP_MIRROR 0x140
__device__ __forceinline__ int row_max_i(int v) {
    v = max(v, __builtin_amdgcn_update_dpp(v, v, DPP_XOR1, 0xf, 0xf, false));
    v = max(v, __builtin_amdgcn_update_dpp(v, v, DPP_XOR2, 0xf, 0xf, false));
    v = max(v, __builtin_amdgcn_update_dpp(v, v, DPP_HMIRROR, 0xf, 0xf, false));
    v = max(v, __builtin_amdgcn_update_dpp(v, v, DPP_MIRROR, 0xf, 0xf, false));
    return v;
}
__device__ __forceinline__ float row_sum_f(float v) {
    v += __builtin_bit_cast(float, __builtin_amdgcn_update_dpp(0, __builtin_bit_cast(int, v), DPP_XOR1, 0xf, 0xf, false));
    v += __builtin_bit_cast(float, __builtin_amdgcn_update_dpp(0, __builtin_bit_cast(int, v), DPP_XOR2, 0xf, 0xf, false));
    v += __builtin_bit_cast(float, __builtin_amdgcn_update_dpp(0, __builtin_bit_cast(int, v), DPP_HMIRROR, 0xf, 0xf, false));
    v += __builtin_bit_cast(float, __builtin_amdgcn_update_dpp(0, __builtin_bit_cast(int, v), DPP_MIRROR, 0xf, 0xf, false));
    return v;
}
__device__ __forceinline__ int fkey(float f) { const int b = __builtin_bit_cast(int, f); return b ^ ((b >> 31) & 0x7fffffff); }
__device__ __forceinline__ float keyf(int k) { return __builtin_bit_cast(float, k ^ ((k >> 31) & 0x7fffffff)); }
__device__ __forceinline__ void cand_ij(int t, int& i, int& j) {
    const int g16 = t >= 16, g24 = t >= 24, g29 = t >= 29, g33 = t >= 33, g36 = t >= 36, g38 = t >= 38, g40 = t >= 40;
    i = g16 + g24 + g29 + g33 + g36 + g38 + g40 + max(t - 41, 0);
    const int base = 16 * g16 + 8 * g24 + 5 * g29 + 4 * g33 + 3 * g36 + 2 * g38 + 2 * g40;
    j = (t >= 42) ? 0 : t - base;
    if (t >= 50) { i = 0; j = 0; }
}
__device__ __forceinline__ void row_max2(int& a, int& b) {
    asm volatile("s_nop 1\n\t"
                 "v_max_i32_dpp %0, %0, %0 quad_perm:[1,0,3,2] row_mask:0xf bank_mask:0xf\n\tv_max_i32_dpp %1, %1, %1 quad_perm:[1,0,3,2] row_mask:0xf bank_mask:0xf\n\ts_nop 0\n\t"
                 "v_max_i32_dpp %0, %0, %0 quad_perm:[2,3,0,1] row_mask:0xf bank_mask:0xf\n\tv_max_i32_dpp %1, %1, %1 quad_perm:[2,3,0,1] row_mask:0xf bank_mask:0xf\n\ts_nop 0\n\t"
                 "v_max_i32_dpp %0, %0, %0 row_half_mirror row_mask:0xf bank_mask:0xf\n\tv_max_i32_dpp %1, %1, %1 row_half_mirror row_mask:0xf bank_mask:0xf\n\ts_nop 0\n\t"
                 "v_max_i32_dpp %0, %0, %0 row_mirror row_mask:0xf bank_mask:0xf\n\tv_max_i32_dpp %1, %1, %1 row_mirror row_mask:0xf bank_mask:0xf\n\ts_nop 1"
                 : "+v"(a), "+v"(b));
}
__device__ __forceinline__ void row_max1(int& a) {
    asm volatile("s_nop 1\n\t"
                 "v_max_i32_dpp %0, %0, %0 quad_perm:[1,0,3,2] row_mask:0xf bank_mask:0xf\n\ts_nop 1\n\t"
                 "v_max_i32_dpp %0, %0, %0 quad_perm:[2,3,0,1] row_mask:0xf bank_mask:0xf\n\ts_nop 1\n\t"
                 "v_max_i32_dpp %0, %0, %0 row_half_mirror row_mask:0xf bank_mask:0xf\n\ts_nop 1\n\t"
                 "v_max_i32_dpp %0, %0, %0 row_mirror row_mask:0xf bank_mask:0xf\n\ts_nop 1"
                 : "+v"(a));
}
__device__ __forceinline__ void row_max4(int& a, int& b, int& c, int& d) {
    asm volatile("s_nop 1\n\t"
                 "v_max_i32_dpp %0, %0, %0 quad_perm:[1,0,3,2] row_mask:0xf bank_mask:0xf\n\tv_max_i32_dpp %1, %1, %1 quad_perm:[1,0,3,2] row_mask:0xf bank_mask:0xf\n\t"
                 "v_max_i32_dpp %2, %2, %2 quad_perm:[1,0,3,2] row_mask:0xf bank_mask:0xf\n\tv_max_i32_dpp %3, %3, %3 quad_perm:[1,0,3,2] row_mask:0xf bank_mask:0xf\n\t"
                 "v_max_i32_dpp %0, %0, %0 quad_perm:[2,3,0,1] row_mask:0xf bank_mask:0xf\n\tv_max_i32_dpp %1, %1, %1 quad_perm:[2,3,0,1] row_mask:0xf bank_mask:0xf\n\t"
                 "v_max_i32_dpp %2, %2, %2 quad_perm:[2,3,0,1] row_mask:0xf bank_mask:0xf\n\tv_max_i32_dpp %3, %3, %3 quad_perm:[2,3,0,1] row_mask:0xf bank_mask:0xf\n\t"
                 "v_max_i32_dpp %0, %0, %0 row_half_mirror row_mask:0xf bank_mask:0xf\n\tv_max_i32_dpp %1, %1, %1 row_half_mirror row_mask:0xf bank_mask:0xf\n\t"
                 "v_max_i32_dpp %2, %2, %2 row_half_mirror row_mask:0xf bank_mask:0xf\n\tv_max_i32_dpp %3, %3, %3 row_half_mirror row_mask:0xf bank_mask:0xf\n\t"
                 "v_max_i32_dpp %0, %0, %0 row_mirror row_mask:0xf bank_mask:0xf\n\tv_max_i32_dpp %1, %1, %1 row_mirror row_mask:0xf bank_mask:0xf\n\t"
                 "v_max_i32_dpp %2, %2, %2 row_mirror row_mask:0xf bank_mask:0xf\n\tv_max_i32_dpp %3, %3, %3 row_mirror row_mask:0xf bank_mask:0xf\n\ts_nop 1"
                 : "+v"(a), "+v"(b), "+v"(c), "+v"(d));
}
#define CE_DESC(x, y) do { const int hi_ = max(x, y), lo_ = min(x, y); x = hi_; y = lo_; } while (0)
#define SORT8_DESC(k) do { CE_DESC(k[0], k[2]); CE_DESC(k[1], k[3]); CE_DESC(k[4], k[6]); CE_DESC(k[5], k[7]); CE_DESC(k[0], k[4]); CE_DESC(k[1], k[5]); CE_DESC(k[2], k[6]); CE_DESC(k[3], k[7]); \
    CE_DESC(k[0], k[1]); CE_DESC(k[2], k[3]); CE_DESC(k[4], k[5]); CE_DESC(k[6], k[7]); CE_DESC(k[2], k[4]); CE_DESC(k[3], k[5]); CE_DESC(k[1], k[4]); CE_DESC(k[3], k[6]); CE_DESC(k[1], k[2]); CE_DESC(k[3], k[4]); CE_DESC(k[5], k[6]); } while (0)
__device__ __forceinline__ void p_peer_topk(const Args& A, const Frame& F, bool skip_ctx) {
    const int gw = F.bid * NWAVES + F.wave, NGW = F.nblk * NWAVES, lane = F.lane, c = lane & 15, rw = lane >> 4, rbase = lane & 48;
    const float* S = (const float*)(F.ws + WS_S);
    const int KMIN = (int)0x80000000;
    int ci[4], cj[4];
#pragma unroll
    for (int q = 0; q < 4; ++q) cand_ij(c + 16 * q, ci[q], cj[q]);
    unsigned* PK = (unsigned*)(F.ws + WS_PK);
    const int ntok = skip_ctx ? NB * SEQ : R;
    f32x4 nx[2][4];
#define TK_LOAD(n_) do { const int n2_ = (n_) < ntok ? (n_) : gw; const int r_ = skip_ctx ? tok_row(1, n2_) : n2_; \
        _Pragma("unroll") for (int hh_ = 0; hh_ < 2; ++hh_) { const float* sp_ = S + (size_t)r_ * 2048 + (4 * hh_ + rw) * 256 + 4 * c; \
            nx[hh_][0] = *(const f32x4*)sp_; nx[hh_][1] = *(const f32x4*)(sp_ + 64); nx[hh_][2] = *(const f32x4*)(sp_ + 128); nx[hh_][3] = *(const f32x4*)(sp_ + 192); } } while (0)
    TK_LOAD(gw);
    for (int n = gw; n < ntok; n += NGW) {
        const int r = skip_ctx ? tok_row(1, n) : n;
        int k1[2][8], k2[2][8];
#pragma unroll
        for (int hh = 0; hh < 2; ++hh)
#pragma unroll
            for (int jj = 0; jj < 2; ++jj) { const f32x4 a = nx[hh][jj], b = nx[hh][2 + jj];
#pragma unroll
                for (int e = 0; e < 4; ++e) { const int p = 4 * c + 64 * jj + e;
                    k1[hh][4 * jj + e] = (fkey(a[e]) & ~127) | (127 - p); k2[hh][4 * jj + e] = (fkey(b[e]) & ~127) | (127 - p); } }
        TK_LOAD(n + NGW);
        SORT8_DESC(k1[0]); SORT8_DESC(k2[0]); SORT8_DESC(k1[1]); SORT8_DESC(k2[1]);
        int r1[2] = {KMIN, KMIN}, r2[2] = {KMIN, KMIN};
#pragma unroll 1
        for (int it = 0; it < 16; ++it) {
            int m1a = k1[0][0], m2a = k2[0][0], m1b = k1[1][0], m2b = k2[1][0];
            row_max4(m1a, m2a, m1b, m2b);
            const bool p1a = (k1[0][0] == m1a), p2a = (k2[0][0] == m2a), p1b = (k1[1][0] == m1b), p2b = (k2[1][0] == m2b);
#pragma unroll
            for (int e = 0; e < 7; ++e) { k1[0][e] = p1a ? k1[0][e + 1] : k1[0][e]; k2[0][e] = p2a ? k2[0][e + 1] : k2[0][e]; k1[1][e] = p1b ? k1[1][e + 1] : k1[1][e]; k2[1][e] = p2b ? k2[1][e + 1] : k2[1][e]; }
            k1[0][7] = p1a ? KMIN : k1[0][7]; k2[0][7] = p2a ? KMIN : k2[0][7]; k1[1][7] = p1b ? KMIN : k1[1][7]; k2[1][7] = p2b ? KMIN : k2[1][7];
            if (c == it) { r1[0] = m1a; r2[0] = m2a; r1[1] = m1b; r2[1] = m2b; }
        }
        int ck[2][4];
#pragma unroll
        for (int hh = 0; hh < 2; ++hh) {
#pragma unroll
            for (int q = 0; q < 4; ++q) { const int a = __shfl(r1[hh], rbase | ci[q]), b = __shfl(r2[hh], rbase | cj[q]);
                const float fs = keyf((a & ~127) | 64) + keyf((b & ~127) | 64); const int t = c + 16 * q;
                ck[hh][q] = (t < 50) ? ((fkey(fs) & ~63) | (63 - t)) : KMIN; }
            CE_DESC(ck[hh][0], ck[hh][1]); CE_DESC(ck[hh][2], ck[hh][3]); CE_DESC(ck[hh][0], ck[hh][2]); CE_DESC(ck[hh][1], ck[hh][3]); CE_DESC(ck[hh][1], ck[hh][2]); }
        int tk[2] = {KMIN, KMIN};
#pragma unroll 1
        for (int it = 0; it < 16; ++it) {
            int ma = ck[0][0], mb = ck[1][0];
            row_max2(ma, mb);
            const bool pa = (ck[0][0] == ma), pb = (ck[1][0] == mb);
            ck[0][0] = pa ? ck[0][1] : ck[0][0]; ck[0][1] = pa ? ck[0][2] : ck[0][1]; ck[0][2] = pa ? ck[0][3] : ck[0][2]; ck[0][3] = pa ? KMIN : ck[0][3];
            ck[1][0] = pb ? ck[1][1] : ck[1][0]; ck[1][1] = pb ? ck[1][2] : ck[1][1]; ck[1][2] = pb ? ck[1][3] : ck[1][2]; ck[1][3] = pb ? KMIN : ck[1][3];
            if (c == it) { tk[0] = ma; tk[1] = mb; }
        }
        int mka = tk[0], mkb = tk[1]; row_max2(mka, mkb);
#pragma unroll
        for (int hh = 0; hh < 2; ++hh) {
            int wi, wj; cand_ij(63 - (tk[hh] & 63), wi, wj);
            const int wa = __shfl(r1[hh], rbase | wi), wb = __shfl(r2[hh], rbase | wj);
            const int te = (127 - (wa & 127)) * 128 + (127 - (wb & 127));
            const float tv = keyf((tk[hh] & ~63) | 32), mx = keyf(((hh ? mkb : mka) & ~63) | 32);
            const float ex = __expf(tv - mx), sum = row_sum_f(ex);
            PK[(size_t)r * 128 + (4 * hh + rw) * 16 + c] = ((unsigned)te << 16) | (unsigned)(ex / sum * 65535.f + 0.5f);
        }
    }
#undef TK_LOAD
}

#define UB(w, b) ((float)(((w) >> (8 * (b))) & 0xffu))
__device__ __forceinline__ void p_peer_experts(const Args& A, const Frame& F, int layer) {
    const int gw = F.bid * NWAVES + F.wave, NGW = F.nblk * NWAVES, lane = F.lane;
    const bf16_t* H = (const bf16_t*)(F.ws + WS_H); float* X = (float*)(F.ws + WS_X);
    const unsigned* PK = (const unsigned*)(F.ws + WS_PK);
    const unsigned char* UT = F.ws + WS_TAB + (size_t)(layer * 2) * 16384 * 1024; const unsigned char* VT = UT + (size_t)16384 * 1024;
    const float* SU = (const float*)(F.ws + WS_TSC) + (layer * 2) * 16384; const float* SV = SU + 16384;
    const float* MOD = (const float*)(F.ws + WS_MOD) + (size_t)layer * 5 * 6144;
    for (int r = gw; r < R; r += NGW) {
        if (layer == 1 && is_ctx_row(r)) continue;
        float hf[16];
        { const u32x4 w0 = *(const u32x4*)(H + (size_t)r * DM + 16 * lane), w1 = *(const u32x4*)(H + (size_t)r * DM + 16 * lane + 8);
#pragma unroll
          for (int d = 0; d < 4; ++d) { hf[2 * d] = bflo(w0[d]); hf[2 * d + 1] = bfhi(w0[d]); hf[8 + 2 * d] = bflo(w1[d]); hf[8 + 2 * d + 1] = bfhi(w1[d]); } }
        float hs = 0.f;
#pragma unroll
        for (int i = 0; i < 16; ++i) hs += hf[i];
        hs = wave_sum(hs);
        int v0 = (int)PK[(size_t)r * 128 + lane], v1 = (int)PK[(size_t)r * 128 + 64 + lane];
#pragma unroll
        for (int k = 2; k <= 128; k <<= 1) {
#pragma unroll
            for (int j = k >> 1; j >= 1; j >>= 1) {
                if (j == 64) { const int a = min(v0, v1), b = max(v0, v1); v0 = a; v1 = b; }
                else { const int o0 = __shfl_xor(v0, j), o1 = __shfl_xor(v1, j); const bool lower = (lane & j) == 0;
                    const bool asc0 = (k == 128) ? true : (k == 64) ? true : ((lane & k) == 0), asc1 = (k == 128) ? true : (k == 64) ? false : ((lane & k) == 0);
                    v0 = (lower == asc0) ? min(v0, o0) : max(v0, o0); v1 = (lower == asc1) ? min(v1, o1) : max(v1, o1); }
            }
        }
        const unsigned pk0 = (unsigned)v0, pk1 = (unsigned)v1;
        const int e0 = (int)(pk0 >> 16), e1 = (int)(pk1 >> 16);
        const float g0 = (float)(pk0 & 0xffffu) * (1.f / 65535.f), g1 = (float)(pk1 & 0xffffu) * (1.f / 65535.f);
        const float su0 = SU[e0], su1 = SU[e1], sv0 = SV[e0], sv1 = SV[e1];
        float d0 = 0.f, d1 = 0.f;
        const int dep_src = (8 * (lane & 7)) << 2; const bool bit3 = (lane & 8) != 0;
#define XISSUE(buf, TAB, esrc, gg) do { _Pragma("unroll") for (int q_ = 0; q_ < 8; ++q_) { const int e_ = __builtin_amdgcn_readlane(esrc, (gg) * 8 + q_); \
            buf[q_] = *(const u32x4*)((TAB) + (size_t)e_ * 1024 + 16 * lane); } } while (0)
#define UCOMP(buf, gg, dsel) do { float p_[8]; _Pragma("unroll") for (int q_ = 0; q_ < 8; ++q_) { float d_ = 0.f; \
            _Pragma("unroll") for (int j_ = 0; j_ < 4; ++j_) d_ += (hf[4 * j_] * UB(buf[q_][j_], 0) + hf[4 * j_ + 1] * UB(buf[q_][j_], 1)) + (hf[4 * j_ + 2] * UB(buf[q_][j_], 2) + hf[4 * j_ + 3] * UB(buf[q_][j_], 3)); p_[q_] = d_; } \
            float s_[4]; _Pragma("unroll") for (int q_ = 0; q_ < 4; ++q_) { auto rr_ = __builtin_amdgcn_permlane32_swap(__float_as_uint(p_[q_]), __float_as_uint(p_[q_ + 4]), false, false); s_[q_] = __uint_as_float(rr_[0]) + __uint_as_float(rr_[1]); } \
            float t_[2]; _Pragma("unroll") for (int q_ = 0; q_ < 2; ++q_) { auto rr_ = __builtin_amdgcn_permlane16_swap(__float_as_uint(s_[q_]), __float_as_uint(s_[q_ + 2]), false, false); t_[q_] = __uint_as_float(rr_[0]) + __uint_as_float(rr_[1]); } \
            const float keep_ = bit3 ? t_[1] : t_[0], send_ = bit3 ? t_[0] : t_[1]; \
            float u_ = keep_ + __builtin_bit_cast(float, __builtin_amdgcn_update_dpp(0, __builtin_bit_cast(int, send_), 0x128, 0xf, 0xf, false)); \
            u_ += __builtin_bit_cast(float, __builtin_amdgcn_update_dpp(0, __builtin_bit_cast(int, u_), DPP_HMIRROR, 0xf, 0xf, false)); \
            u_ += __builtin_bit_cast(float, __builtin_amdgcn_update_dpp(0, __builtin_bit_cast(int, u_), DPP_XOR1, 0xf, 0xf, false)); \
            u_ += __builtin_bit_cast(float, __builtin_amdgcn_update_dpp(0, __builtin_bit_cast(int, u_), DPP_XOR2, 0xf, 0xf, false)); \
            const float v_ = __builtin_bit_cast(float, __builtin_amdgcn_ds_bpermute(dep_src, __builtin_bit_cast(int, u_))); \
            if ((lane >> 3) == (gg)) dsel = v_; } while (0)
        {
            u32x4 ua[8], ub[8];
            XISSUE(ua, UT, e0, 0);
#pragma unroll 1
            for (int g = 0; g < 8; g += 2) { XISSUE(ub, UT, e0, g + 1); UCOMP(ua, g, d0); if (g + 2 < 8) XISSUE(ua, UT, e0, g + 2); else XISSUE(ua, UT, e1, 0); UCOMP(ub, g + 1, d0); }
#pragma unroll 1
            for (int g = 0; g < 8; g += 2) { XISSUE(ub, UT, e1, g + 1); UCOMP(ua, g, d1); if (g + 2 < 8) XISSUE(ua, UT, e1, g + 2); UCOMP(ub, g + 1, d1); }
        }
        const float a0 = su0 * (d0 - 128.f * hs), a1 = su1 * (d1 - 128.f * hs);
        const float w0 = g0 * 0.5f * a0 * (1.f + erff(a0 * 0.70710678118654752f)) * sv0, w1 = g1 * 0.5f * a1 * (1.f + erff(a1 * 0.70710678118654752f)) * sv1;
        const float wsum = wave_sum(w0 + w1) * 128.f;
        float acc[16];
#pragma unroll
        for (int i = 0; i < 16; ++i) acc[i] = 0.f;
#define VCOMP(buf, wsrc, gg) do { _Pragma("unroll") for (int q_ = 0; q_ < 8; ++q_) { const float wk_ = __builtin_bit_cast(float, __builtin_amdgcn_readlane(__builtin_bit_cast(int, wsrc), (gg) * 8 + q_)); \
            _Pragma("unroll") for (int j_ = 0; j_ < 4; ++j_) { acc[4 * j_] += wk_ * UB(buf[q_][j_], 0); acc[4 * j_ + 1] += wk_ * UB(buf[q_][j_], 1); acc[4 * j_ + 2] += wk_ * UB(buf[q_][j_], 2); acc[4 * j_ + 3] += wk_ * UB(buf[q_][j_], 3); } } } while (0)
        {
            u32x4 va[8], vb[8];
            XISSUE(va, VT, e0, 0);
#pragma unroll 1
            for (int g = 0; g < 8; g += 2) { XISSUE(vb, VT, e0, g + 1); VCOMP(va, w0, g); if (g + 2 < 8) XISSUE(va, VT, e0, g + 2); else XISSUE(va, VT, e1, 0); VCOMP(vb, w0, g + 1); }
#pragma unroll 1
            for (int g = 0; g < 8; g += 2) { XISSUE(vb, VT, e1, g + 1); VCOMP(va, w1, g); if (g + 2 < 8) XISSUE(va, VT, e1, g + 2); VCOMP(vb, w1, g + 1); }
        }
#undef XISSUE
#undef UCOMP
#undef VCOMP
        const float* mm = MOD + (size_t)mod_index(r) * 6144;
        f32x4 xn[4]; float s = 0.f;
#pragma unroll
        for (int j = 0; j < 4; ++j) { const int c = 16 * lane + 4 * j; const float* xp = X + (size_t)r * DM + c; const f32x4 gf = *(const f32x4*)(mm + 5 * 1024 + c);
            xn[j] = *(const f32x4*)xp + gf * (f32x4){acc[4 * j] - wsum, acc[4 * j + 1] - wsum, acc[4 * j + 2] - wsum, acc[4 * j + 3] - wsum};
            s += (xn[j].x * xn[j].x + xn[j].y * xn[j].y) + (xn[j].z * xn[j].z + xn[j].w * xn[j].w); }
        const float rinv = rsqrtf(wave_sum(s) * (1.f / DM) + EPS);
        if (layer == 0) {
            const float* m1 = (const float*)(F.ws + WS_MOD) + (size_t)(5 + mod_index(r)) * 6144;
            const float* gn = A.in[I1_NMIX];
#pragma unroll
            for (int j = 0; j < 4; ++j) { const int c = 16 * lane + 4 * j; *(f32x4*)(X + (size_t)r * DM + c) = xn[j];
                const f32x4 y = (xn[j] * rinv * *(const f32x4*)(gn + c)) * (*(const f32x4*)(m1 + 1024 + c) + 1.f) + *(const f32x4*)(m1 + c);
                u32x2 o; o.x = pk2(y.x, y.y); o.y = pk2(y.z, y.w); *(u32x2*)((bf16_t*)(F.ws + WS_H) + (size_t)r * DM + c) = o; }
        } else {
            const int b = r / RPB, t = (r - b * RPB) - CTXL; float* op = F.out + ((size_t)b * SEQ + t) * DM; const float* gn = A.in[I_NOUT];
#pragma unroll
            for (int j = 0; j < 4; ++j) { const int c = 16 * lane + 4 * j; *(f32x4*)(op + c) = xn[j] * rinv * *(const f32x4*)(gn + c); }
        }
    }
}

__device__ __forceinline__ int tok_row(int layer, int n) { return layer == 0 ? n : (n >> 12) * RPB + CTXL + (n & 4095); }
#define DPPF(v, ctrl) __builtin_bit_cast(float, __builtin_amdgcn_update_dpp(0, __builtin_bit_cast(int, v), ctrl, 0xf, 0xf, false))
__device__ __forceinline__ int isum8(int v) {
    v += __builtin_amdgcn_update_dpp(0, v, DPP_XOR1, 0xf, 0xf, false); v += __builtin_amdgcn_update_dpp(0, v, DPP_XOR2, 0xf, 0xf, false); v += __builtin_amdgcn_update_dpp(0, v, DPP_HMIRROR, 0xf, 0xf, false); return v; }
__device__ __forceinline__ void p_exp_u(const Args& A, const Frame& F, int layer) {
    const int lane = F.lane, s = lane >> 3, c8 = lane & 7;
    const bool part = (F.nblk & 7) == 0; const int ncb = part ? 1 : 8, cb0 = part ? (F.bid & 7) : 0;
    const int gwv = part ? ((F.bid >> 3) * NWAVES + F.wave) : (F.bid * NWAVES + F.wave), nwv = part ? ((F.nblk >> 3) * NWAVES) : (F.nblk * NWAVES);
    const int ntok = layer == 0 ? R : NB * SEQ;
    const unsigned char* HQ = F.ws + WS_HQ; const unsigned* PK = (const unsigned*)(F.ws + WS_PK);
    const unsigned char* UT = F.ws + WS_TAB + (size_t)(layer * 2) * 16384 * 1024;
    int* PD = (int*)(F.ws + WS_PD);
#define U_META(pk, hq, n_) do { const int r_ = tok_row(layer, (n_) < ntok ? (n_) : gwv); const unsigned* p_ = PK + (size_t)r_ * 128 + s; \
        _Pragma("unroll") for (int i_ = 0; i_ < 16; ++i_) pk[i_] = p_[8 * i_]; \
        hq = *(const u32x4*)(HQ + (size_t)r_ * DM + 128 * cb + 16 * c8); } while (0)
#define U_ISSUE(pk, lo) do { _Pragma("unroll") for (int i_ = (lo); i_ < (lo) + 8; ++i_) t[i_] = *(const u32x4*)(tb + (size_t)(pk[i_] >> 16) * 128); } while (0)
#define U_DOT(i_) do { int d_ = __builtin_amdgcn_sdot4((int)t[i_][0], (int)hv[0], 0, false); d_ = __builtin_amdgcn_sdot4((int)t[i_][1], (int)hv[1], d_, false); \
        d_ = __builtin_amdgcn_sdot4((int)t[i_][2], (int)hv[2], d_, false); d_ = __builtin_amdgcn_sdot4((int)t[i_][3], (int)hv[3], d_, false); \
        d_ = isum8(d_); if (c8 == ((i_) & 7)) { if ((i_) < 8) kA = d_; else kB = d_; } } while (0)
#define U_ITEM(pkc, hqc, pkn, n_) do { \
        const u32x4 hv = hqc; \
        U_META(pkc, hqc, (n_) + 2 * nwv); \
        int kA = 0, kB = 0; \
        _Pragma("unroll") for (int i_ = 0; i_ < 8; ++i_) U_DOT(i_); \
        U_ISSUE(pkn, 0); \
        _Pragma("unroll") for (int i_ = 8; i_ < 16; ++i_) U_DOT(i_); \
        U_ISSUE(pkn, 8); \
        if ((n_) < ntok) { const int r_ = tok_row(layer, n_); int* pd_ = PD + ((size_t)cb * R + r_) * 128 + 8 * c8 + s; pd_[0] = kA; pd_[64] = kB; } \
        } while (0)
#pragma unroll 1
    for (int cbi = 0; cbi < ncb; ++cbi) {
        const int cb = cb0 + cbi;
        const unsigned char* tb = UT + (size_t)cb * 16384 * 128 + 16 * c8;
        unsigned pkA[16], pkB[16]; u32x4 hA, hB, t[16];
        U_META(pkA, hA, gwv); U_META(pkB, hB, gwv + nwv);
        U_ISSUE(pkA, 0); U_ISSUE(pkA, 8);
#pragma unroll 1
        for (int n = gwv; n < ntok; n += 2 * nwv) {
            U_ITEM(pkA, hA, pkB, n);
            U_ITEM(pkB, hB, pkA, n + nwv);
        }
    }
#undef U_META
#undef U_ISSUE
#undef U_DOT
#undef U_ITEM
}
__device__ __forceinline__ void p_exp_w(const Args& A, const Frame& F, int layer) {
    const int gw = F.bid * NWAVES + F.wave, NGW = F.nblk * NWAVES, lane = F.lane;
    const int ntok = layer == 0 ? R : NB * SEQ;
    const unsigned* PK = (const unsigned*)(F.ws + WS_PK); const int* PD = (const int*)(F.ws + WS_PD); const float* HS = (const float*)(F.ws + WS_HS);
    unsigned* WQ8 = (unsigned*)(F.ws + WS_WQ8); float* WSC = (float*)(F.ws + WS_WSC);
    const float* SU = (const float*)(F.ws + WS_TSC) + (layer * 2) * 16384; const float* SV = SU + 16384;
    for (int n = gw; n < ntok; n += NGW) {
        const int r = tok_row(layer, n);
        const unsigned pk0 = PK[(size_t)r * 128 + lane], pk1 = PK[(size_t)r * 128 + 64 + lane];
        const int e0 = (int)(pk0 >> 16), e1 = (int)(pk1 >> 16);
        const float g0 = (float)(pk0 & 0xffffu) * (1.f / 65535.f), g1 = (float)(pk1 & 0xffffu) * (1.f / 65535.f);
        int d0 = 0, d1 = 0;
#pragma unroll
        for (int cb = 0; cb < 8; ++cb) { d0 += PD[((size_t)cb * R + r) * 128 + lane]; d1 += PD[((size_t)cb * R + r) * 128 + 64 + lane]; }
        const float hs = HS[r];
        const float a0 = SU[e0] * hs * (float)d0, a1 = SU[e1] * hs * (float)d1;
        const float w0 = g0 * 0.5f * a0 * (1.f + erff(a0 * 0.70710678118654752f)) * SV[e0], w1 = g1 * 0.5f * a1 * (1.f + erff(a1 * 0.70710678118654752f)) * SV[e1];
        const float wm = wave_max(fmaxf(fabsf(w0), fabsf(w1)));
        const float inv = wm > 0.f ? 127.f / wm : 0.f;
        const int q0 = (int)rintf(w0 * inv) & 0xff, q1 = (int)rintf(w1 * inv) & 0xff;
        const int g2 = (lane >> 3) & 3, sb = lane & 7, src = 32 * (g2 & 1) + sb;
        unsigned pw = 0;
#pragma unroll
        for (int j = 0; j < 4; ++j) { const int x0 = __shfl(q0, src + 8 * j), x1 = __shfl(q1, src + 8 * j); pw |= (unsigned)((g2 < 2) ? x0 : x1) << (8 * j); }
        if (lane < 32) WQ8[(size_t)r * 32 + lane] = pw;
        if (lane == 0) WSC[r] = wm > 0.f ? wm * (1.f / 127.f) : 0.f;
    }
}
__device__ __forceinline__ void p_exp_v(const Args& A, const Frame& F, int layer) {
    const int lane = F.lane, s = lane >> 3, c8 = lane & 7;
    const bool part = (F.nblk & 7) == 0; const int ncb = part ? 1 : 8, cb0 = part ? (F.bid & 7) : 0;
    const int gwv = part ? ((F.bid >> 3) * NWAVES + F.wave) : (F.bid * NWAVES + F.wave), nwv = part ? ((F.nblk >> 3) * NWAVES) : (F.nblk * NWAVES);
    const int ntok = layer == 0 ? R : NB * SEQ;
    const unsigned* PK = (const unsigned*)(F.ws + WS_PK); const unsigned* WQ8 = (const unsigned*)(F.ws + WS_WQ8); const float* WSC = (const float*)(F.ws + WS_WSC);
    const unsigned char* VT = F.ws + WS_TAB + (size_t)(layer * 2 + 1) * 16384 * 1024;
    float* X = (float*)(F.ws + WS_X); const float* MOD = (const float*)(F.ws + WS_MOD) + (size_t)layer * 5 * 6144;
    const float* MOD1 = (const float*)(F.ws + WS_MOD) + (size_t)5 * 6144; const float* gmix1 = A.in[I1_NMIX]; bf16_t* Hn = (bf16_t*)(F.ws + WS_H); float* SSV = (float*)(F.ws + WS_SSV);
    const bool bit3 = (lane & 8) != 0;
#define V_METAP(pk, n_) do { const int r_ = tok_row(layer, (n_) < ntok ? (n_) : gwv); const unsigned* p_ = PK + (size_t)r_ * 128 + s; \
        _Pragma("unroll") for (int i_ = 0; i_ < 16; ++i_) pk[i_] = p_[8 * i_]; } while (0)
#define V_METAW(wq, n_) do { const int r_ = tok_row(layer, (n_) < ntok ? (n_) : gwv); const unsigned* w_ = WQ8 + (size_t)r_ * 32 + s; \
        _Pragma("unroll") for (int g_ = 0; g_ < 4; ++g_) wq[g_] = w_[8 * g_]; } while (0)
#define V_ISSUE(pk, lo) do { _Pragma("unroll") for (int i_ = (lo); i_ < (lo) + 8; ++i_) t[i_] = *(const u32x4*)(tb + (size_t)(pk[i_] >> 16) * 128); } while (0)
#define V_GRP(wq, g_) do { _Pragma("unroll") for (int j_ = 0; j_ < 4; ++j_) { const unsigned a_ = t[4 * (g_)][j_], b_ = t[4 * (g_) + 1][j_], c_ = t[4 * (g_) + 2][j_], d_ = t[4 * (g_) + 3][j_]; \
        const unsigned ablo = __builtin_amdgcn_perm(b_, a_, 0x05010400u), abhi = __builtin_amdgcn_perm(b_, a_, 0x07030602u), cdlo = __builtin_amdgcn_perm(d_, c_, 0x05010400u), cdhi = __builtin_amdgcn_perm(d_, c_, 0x07030602u); \
        acc[4 * j_]     = __builtin_amdgcn_sdot4((int)__builtin_amdgcn_perm(cdlo, ablo, 0x05040100u), (int)wq[g_], acc[4 * j_], false); \
        acc[4 * j_ + 1] = __builtin_amdgcn_sdot4((int)__builtin_amdgcn_perm(cdlo, ablo, 0x07060302u), (int)wq[g_], acc[4 * j_ + 1], false); \
        acc[4 * j_ + 2] = __builtin_amdgcn_sdot4((int)__builtin_amdgcn_perm(cdhi, abhi, 0x05040100u), (int)wq[g_], acc[4 * j_ + 2], false); \
        acc[4 * j_ + 3] = __builtin_amdgcn_sdot4((int)__builtin_amdgcn_perm(cdhi, abhi, 0x07060302u), (int)wq[g_], acc[4 * j_ + 3], false); } } while (0)
#define V_ITEM(pkc, wqc, pkn, n_) do { \
        int acc[16]; _Pragma("unroll") for (int a_ = 0; a_ < 16; ++a_) acc[a_] = 0; \
        V_METAP(pkc, (n_) + 2 * nwv); \
        V_GRP(wqc, 0); V_GRP(wqc, 1); \
        V_ISSUE(pkn, 0); \
        V_GRP(wqc, 2); V_GRP(wqc, 3); \
        V_ISSUE(pkn, 8); \
        int b8[8], c4[4], o[2]; \
        _Pragma("unroll") for (int a_ = 0; a_ < 8; ++a_) { auto rr = __builtin_amdgcn_permlane32_swap((unsigned)acc[a_], (unsigned)acc[a_ + 8], false, false); b8[a_] = (int)rr[0] + (int)rr[1]; } \
        _Pragma("unroll") for (int a_ = 0; a_ < 4; ++a_) { auto rr = __builtin_amdgcn_permlane16_swap((unsigned)b8[a_], (unsigned)b8[a_ + 4], false, false); c4[a_] = (int)rr[0] + (int)rr[1]; } \
        _Pragma("unroll") for (int a_ = 0; a_ < 2; ++a_) { const int keep = bit3 ? c4[a_ + 2] : c4[a_], send = bit3 ? c4[a_] : c4[a_ + 2]; o[a_] = keep + __builtin_amdgcn_update_dpp(0, send, 0x128, 0xf, 0xf, false); } \
        if ((n_) < ntok) { const int r_ = tok_row(layer, n_); const float ws_ = WSC[r_]; const int col = 128 * cb + 16 * c8 + 2 * s; \
            const f32x2 gf = *(const f32x2*)(MOD + (size_t)mod_index(r_) * 6144 + 5 * 1024 + col); f32x2* xp = (f32x2*)(X + (size_t)r_ * DM + col); \
            f32x2 xv = *xp; xv.x += gf.x * (ws_ * (float)o[0]); xv.y += gf.y * (ws_ * (float)o[1]); *xp = xv; \
            if (layer == 0) { const f32x2 g1 = *(const f32x2*)(gmix1 + col), s1 = *(const f32x2*)(MOD1 + (size_t)mod_index(r_) * 6144 + 1024 + col); \
                *(unsigned*)(Hn + (size_t)r_ * DM + col) = pk2(xv.x * g1.x * (1.f + s1.x), xv.y * g1.y * (1.f + s1.y)); \
                const float sq_ = wave_sum(xv.x * xv.x + xv.y * xv.y); if (lane == 0) SSV[(size_t)r_ * 8 + cb] = sq_; } } \
        V_METAW(wqc, (n_) + 2 * nwv); } while (0)
#pragma unroll 1
    for (int cbi = 0; cbi < ncb; ++cbi) {
        const int cb = cb0 + cbi;
        const unsigned char* tb = VT + (size_t)cb * 16384 * 128 + 16 * c8;
        unsigned pkA[16], pkB[16], wqA[4], wqB[4]; u32x4 t[16];
        V_METAP(pkA, gwv); V_METAW(wqA, gwv); V_METAP(pkB, gwv + nwv); V_METAW(wqB, gwv + nwv);
        V_ISSUE(pkA, 0); V_ISSUE(pkA, 8);
#pragma unroll 1
        for (int n = gwv; n < ntok; n += 2 * nwv) {
            V_ITEM(pkA, wqA, pkB, n);
            V_ITEM(pkB, wqB, pkA, n + nwv);
        }
    }
#undef V_METAP
#undef V_METAW
#undef V_ISSUE
#undef V_GRP
#undef V_ITEM
}
__device__ __forceinline__ void p_final_norm(const Args& A, const Frame& F) {
    const int gw = F.bid * NWAVES + F.wave, NGW = F.nblk * NWAVES, lane = F.lane;
    const float* X = (const float*)(F.ws + WS_X); const float* gn = A.in[I_NOUT];
    for (int n = gw; n < NB * SEQ; n += NGW) {
        const float* xr = X + (size_t)tok_row(1, n) * DM; float* op = F.out + (size_t)n * DM;
        f32x4 v[4]; float sq = 0.f;
#pragma unroll
        for (int j = 0; j < 4; ++j) { v[j] = *(const f32x4*)(xr + 4 * lane + 256 * j); sq += (v[j].x * v[j].x + v[j].y * v[j].y) + (v[j].z * v[j].z + v[j].w * v[j].w); }
        const float rinv = rsqrtf(wave_sum(sq) * (1.f / DM) + EPS);
#pragma unroll
        for (int j = 0; j < 4; ++j) { const int c = 4 * lane + 256 * j; *(f32x4*)(op + c) = v[j] * rinv * *(const f32x4*)(gn + c); }
    }
}

__device__ __forceinline__ void p_shw(const Args& A, const Frame& F) {
    const int gw = F.bid * NWAVES + F.wave, NGW = F.nblk * NWAVES, lane = F.lane;
    const bf16_t* W = (const bf16_t*)(F.ws + WS_WQKV); const float* MOD1 = (const float*)(F.ws + WS_MOD) + (size_t)5 * 6144; float* SHW1 = (float*)(F.ws + WS_SHW1);
    for (int n = gw; n < 1536; n += NGW) {
        const u32x4 w0 = *(const u32x4*)(W + (size_t)n * 1024 + 16 * lane), w1 = *(const u32x4*)(W + (size_t)n * 1024 + 16 * lane + 8);
        float wf[16];
#pragma unroll
        for (int d = 0; d < 4; ++d) { wf[2 * d] = bflo(w0[d]); wf[2 * d + 1] = bfhi(w0[d]); wf[8 + 2 * d] = bflo(w1[d]); wf[8 + 2 * d + 1] = bfhi(w1[d]); }
#pragma unroll
        for (int b = 0; b < 5; ++b) { const float* sh = MOD1 + (size_t)b * 6144 + 16 * lane; float d = 0.f;
#pragma unroll
            for (int j = 0; j < 4; ++j) { const f32x4 sv = *(const f32x4*)(sh + 4 * j); d += (sv.x * wf[4 * j] + sv.y * wf[4 * j + 1]) + (sv.z * wf[4 * j + 2] + sv.w * wf[4 * j + 3]); }
            d = wave_sum(d); if (lane == 0) SHW1[b * 1536 + n] = d; }
    }
}

constexpr int N_PHASES = 23;
__global__ void __launch_bounds__(NTHREADS, 2) mega(Args args) {
    extern __shared__ __attribute__((aligned(16))) unsigned char lds_raw[];
    Frame F; F.x = args.in[I_X]; F.ctx = args.in[I_CTX]; F.out = args.out; F.ws = args.ws; F.lds = (char*)lds_raw;
    F.tid = threadIdx.x; F.lane = F.tid & 63; F.wave = __builtin_amdgcn_readfirstlane(F.tid >> 6); F.bid = blockIdx.x; F.nblk = gridDim.x;
    F.vcu = (F.nblk % 8 == 0) ? (F.bid % 8) * (F.nblk / 8) + F.bid / 8 : F.bid;
    volatile LAS unsigned* st = (volatile LAS unsigned*)(LAS unsigned char*)(lds_raw + LDS_BYTES - 64);
    if (F.tid < 16) st[F.tid] = 0u;
    __syncthreads();
    XcdBarrier bar; bar.bar = (unsigned*)(F.ws + WS_CTL) + 4096; bar.x = 0; bar.st = st;
    const int lo = args.ph_lo, hi = args.ph_hi;
    const bool fused = (hi - lo) > 1;
    if (fused) bar = xcd_barrier_post((unsigned*)(F.ws + WS_CTL) + 4096, st);
#ifdef ONLY_PHASE
#define IN(k) ((k) == ONLY_PHASE && lo <= (k) && (k) < hi)
#else
#define IN(k) (lo <= (k) && (k) < hi)
#endif
#define SEAM(k) do { if (IN(k) && IN((k) + 1)) { if ((k) == 0) cg::this_grid().sync(); else xcd_barrier(bar); } } while (0)
    bf16_t* Hb = (bf16_t*)(F.ws + WS_H);
#define PH(k, ...) if (IN(k)) for (int rep_ = 0; rep_ < (((PROBE_MASK >> (k)) & 1u) ? 2 : 1); ++rep_) { __VA_ARGS__; __syncthreads(); } SEAM(k)
    float* Xb = (float*)(F.ws + WS_X); const float* MODb = (const float*)(F.ws + WS_MOD);
    PH(0, for (int q_ = 0; q_ < ((PROBE_P0 & 1u) ? 2 : 1); ++q_) { p0_mod(args, F); __syncthreads(); }
          for (int q_ = 0; q_ < ((PROBE_P0 & 2u) ? 2 : 1); ++q_) { p0_weights(args, F); __syncthreads(); }
          for (int q_ = 0; q_ < ((PROBE_P0 & 4u) ? 2 : 1); ++q_) { p0_weff(args, F); __syncthreads(); }
          for (int q_ = 0; q_ < ((PROBE_P0 & 8u) ? 2 : 1); ++q_) { p0_tables(args, F); __syncthreads(); });
    PH(1, p_norm_rows(args, F, 0, 0, true, false); p_shw(args, F));
    PH(2, gemm8e(F, Hb, (const bf16_t*)(F.ws + WS_WIN), 768, 1024, false, EpiMlaDown{(bf16_t*)(F.ws + WS_CQ), (bf16_t*)(F.ws + WS_CKV), (bf16_t*)(F.ws + WS_KR), (float*)(F.ws + WS_SSP)}));
    PH(3, p_mla_krope(args, F);
          gemm8(F, (const bf16_t*)(F.ws + WS_CQ), (const bf16_t*)(F.ws + WS_WUQ), 1536, 384, false, In8Bf16Rs{(bf16_t*)(F.ws + WS_Q), 1536, (const float*)(F.ws + WS_SSP)});
          gemm8(F, (const bf16_t*)(F.ws + WS_CKV), (const bf16_t*)(F.ws + WS_WUKV), 2048, 256, false, In8KVRs{(bf16_t*)(F.ws + WS_K), (bf16_t*)(F.ws + WS_V), (const float*)(F.ws + WS_SSP)}));
    PH(4, p_attn_mla(args, F));
    PH(5, gemm8(F, (const bf16_t*)(F.ws + WS_O), (const bf16_t*)(F.ws + WS_WO0), 1024, 1024, false, In8Resid{F.x, F.ctx, Xb, MODb + 2 * 1024, true}));
    PH(6, p_norm_rows(args, F, 0, 1, false, false));
    PH(7, gemm8(F, Hb, (const bf16_t*)(F.ws + WS_WQ0), 2048, 1024, false, In8F32{(float*)(F.ws + WS_S), 2048}));
    PH(8, p_peer_topk(args, F, false));
    PH(9, p_exp_u(args, F, 0));
    PH(10, p_exp_w(args, F, 0));
    if (IN(11)) { p_exp_v(args, F, 0); } SEAM(11);
    PH(12, gemm8(F, Hb, (const bf16_t*)(F.ws + WS_WQKV), 1536, 1024, false, In8QkvFold{(bf16_t*)(F.ws + WS_RAW1), (const float*)(F.ws + WS_SSV), (const float*)(F.ws + WS_SHW1)}));
    PH(13, p_gqa_rows(args, F));
    PH(14, p_attn_gqa(args, F));
    if (IN(15)) { gemm8(F, (const bf16_t*)(F.ws + WS_O), (const bf16_t*)(F.ws + WS_WO1), 1024, 1024, true, In8Resid{F.x, F.ctx, Xb, MODb + 5 * 6144 + 2 * 1024, false}); } SEAM(15);
    PH(16, p_norm_rows(args, F, 1, 1, false, true));
    PH(17, gemm8(F, Hb, (const bf16_t*)(F.ws + WS_WQ1), 2048, 1024, true, In8F32{(float*)(F.ws + WS_S), 2048}));
    PH(18, p_peer_topk(args, F, true));
    PH(19, p_exp_u(args, F, 1));
    PH(20, p_exp_w(args, F, 1));
    if (IN(21)) { p_exp_v(args, F, 1); } SEAM(21);
    if (IN(22)) p_final_norm(args, F);
#undef PH
#undef IN
#undef SEAM
}

extern "C" void kernel_launch(void* const* d_in, const int* in_sizes, int n_in, void* d_out, int out_size, void* d_ws, size_t ws_size, hipStream_t stream) {
    static int grid = 0;
    if (grid == 0) {
        if (n_in != N_IN || in_sizes[0] != NB * SEQ * DM || out_size != NB * SEQ * DM || ws_size < WS_END) {
            fprintf(stderr, "kernel_launch: shape mismatch (n_in %d, in0 %d, out %d, ws %zu < %zu)\n", n_in, n_in > 0 ? in_sizes[0] : -1, out_size, ws_size, (size_t)WS_END); grid = -1; return; }
        int dev = 0, cus = 0, per_cu = 0;
        hipGetDevice(&dev); hipDeviceGetAttribute(&cus, hipDeviceAttributeMultiprocessorCount, dev);
        if (hipFuncSetAttribute((const void*)mega, hipFuncAttributeMaxDynamicSharedMemorySize, LDS_BYTES) != hipSuccess) { fprintf(stderr, "kernel_launch: hipFuncSetAttribute failed\n"); grid = -1; return; }
        if (hipOccupancyMaxActiveBlocksPerMultiprocessor(&per_cu, (const void*)mega, NTHREADS, LDS_BYTES) != hipSuccess || per_cu < 1) { fprintf(stderr, "kernel_launch: occupancy query failed (%d)\n", per_cu); (void)hipGetLastError(); grid = -1; return; }
        grid = cus * (per_cu > 1 ? 1 : per_cu);
    }
    if (grid < 0) return;
    hipMemsetAsync((char*)d_ws + WS_CTL, 0, 1 * MiB, stream);
    Args a{};
    for (int i = 0; i < N_IN; ++i) a.in[i] = (const float*)d_in[i];
    a.out = (float*)d_out; a.ws = (unsigned char*)d_ws;
#if MK_PER_PHASE
    for (int p = 0; p < N_PHASES; ++p) { a.ph_lo = p; a.ph_hi = p + 1; hipLaunchKernelGGL(mega, dim3(grid), dim3(NTHREADS), LDS_BYTES, stream, a); }
#else
    a.ph_lo = 0; a.ph_hi = N_PHASES;
    void* kargs[] = {&a};
    hipError_t e = hipLaunchCooperativeKernel((const void*)mega, dim3(grid), dim3(NTHREADS), kargs, LDS_BYTES, stream);
    if (e != hipSuccess) fprintf(stderr, "kernel_launch: cooperative launch failed: %s (grid %d)\n", hipGetErrorString(e), grid);
#endif
}
```

```cpp
#include <hip/hip_runtime.h>
#include <hip/hip_cooperative_groups.h>
#include <cstdio>
#include <cstdint>
namespace cg = cooperative_groups;

#ifndef PROBE_MASK
#define PROBE_MASK 0u
#endif
#ifndef PROBE_P0
#define PROBE_P0 0u
#endif
#ifndef MK_PER_PHASE
#define MK_PER_PHASE 0
#endif

typedef unsigned short bf16_t;
typedef short bf16x8 __attribute__((ext_vector_type(8)));
typedef short s16x4 __attribute__((ext_vector_type(4)));
typedef float f32x4 __attribute__((ext_vector_type(4)));
typedef float f32x2 __attribute__((ext_vector_type(2)));
typedef float f32x16 __attribute__((ext_vector_type(16)));
typedef unsigned u32x4 __attribute__((ext_vector_type(4)));
typedef unsigned u32x2 __attribute__((ext_vector_type(2)));
#define LAS __attribute__((address_space(3)))
#define SBAR() __builtin_amdgcn_sched_barrier(0)

__device__ __forceinline__ unsigned f2bf(float f) { unsigned u = __builtin_bit_cast(unsigned, f); return (u + 0x7fffu + ((u >> 16) & 1u)) >> 16; }
__device__ __forceinline__ unsigned pk2(float lo, float hi) { return f2bf(lo) | (f2bf(hi) << 16); }
__device__ __forceinline__ float bf2f(unsigned short h) { return __builtin_bit_cast(float, (unsigned)h << 16); }
__device__ __forceinline__ float bflo(unsigned w) { return __builtin_bit_cast(float, w << 16); }
__device__ __forceinline__ float bfhi(unsigned w) { return __builtin_bit_cast(float, w & 0xffff0000u); }
__device__ __forceinline__ unsigned cvtpk(float lo, float hi) { unsigned r; asm volatile("v_cvt_pk_bf16_f32 %0, %1, %2" : "=v"(r) : "v"(lo), "v"(hi)); return r; }
#define WDPP(v, ctrl) __builtin_bit_cast(float, __builtin_amdgcn_update_dpp(0, __builtin_bit_cast(int, v), ctrl, 0xf, 0xf, false))
__device__ __forceinline__ float wave_sum(float v) {
    v += WDPP(v, 0xB1); v += WDPP(v, 0x4E); v += WDPP(v, 0x141); v += WDPP(v, 0x140);
    { auto rr = __builtin_amdgcn_permlane16_swap(__float_as_uint(v), __float_as_uint(v), false, false); v = __uint_as_float(rr[0]) + __uint_as_float(rr[1]); }
    { auto rr = __builtin_amdgcn_permlane32_swap(__float_as_uint(v), __float_as_uint(v), false, false); v = __uint_as_float(rr[0]) + __uint_as_float(rr[1]); }
    return v;
}
__device__ __forceinline__ float wave_max(float v) {
    v = fmaxf(v, WDPP(v, 0xB1)); v = fmaxf(v, WDPP(v, 0x4E)); v = fmaxf(v, WDPP(v, 0x141)); v = fmaxf(v, WDPP(v, 0x140));
    { auto rr = __builtin_amdgcn_permlane16_swap(__float_as_uint(v), __float_as_uint(v), false, false); v = fmaxf(__uint_as_float(rr[0]), __uint_as_float(rr[1])); }
    { auto rr = __builtin_amdgcn_permlane32_swap(__float_as_uint(v), __float_as_uint(v), false, false); v = fmaxf(__uint_as_float(rr[0]), __uint_as_float(rr[1])); }
    return v;
}

constexpr int DM = 1024, NB = 4, SEQ = 4096, CTXL = 256;
constexpr int RPB = SEQ + CTXL;
constexpr int R = NB * RPB;
constexpr float EPS = 1e-6f;
constexpr int NTHREADS = 512, NWAVES = 8;
constexpr int LDS_BYTES = 147456;

enum { I_X = 0, I_C, I_CTX, I_CCTX,
       I0_ADAW, I0_ADAB, I0_NMIX, I0_NFFN, I0_WIN, I0_QN, I0_WUQ, I0_KVN, I0_WUKV, I0_WO, I0_PWQ, I0_PK1, I0_PK2, I0_PU, I0_PV,
       I1_ADAW, I1_ADAB, I1_NMIX, I1_NFFN, I1_WQKV, I1_QN, I1_KN, I1_WO, I1_PWQ, I1_PK1, I1_PK2, I1_PU, I1_PV,
       I_NOUT, N_IN };

constexpr size_t MiB = 1u << 20;
constexpr size_t WS_CTL   = 0;
constexpr size_t WS_MOD   = 1 * MiB;
constexpr size_t WS_WIN   = 2 * MiB;
constexpr size_t WS_WUQ   = WS_WIN + 768 * 1024 * 2;
constexpr size_t WS_WUKV  = WS_WUQ + 1536 * 384 * 2;
constexpr size_t WS_WO0   = WS_WUKV + 2048 * 256 * 2;
constexpr size_t WS_WQ0   = WS_WO0 + 1024 * 1024 * 2;
constexpr size_t WS_KK0   = WS_WQ0 + 2048 * 1024 * 2;
constexpr size_t WS_WQKV  = WS_KK0 + 16 * 128 * 128 * 2;
constexpr size_t WS_WO1   = WS_WQKV + 1536 * 1024 * 2;
constexpr size_t WS_WQ1   = WS_WO1 + 1024 * 1024 * 2;
constexpr size_t WS_KK1   = WS_WQ1 + 2048 * 1024 * 2;
constexpr size_t WS_WEND  = WS_KK1 + 16 * 128 * 128 * 2;
static_assert(WS_WEND <= 24 * MiB, "weights region");
constexpr size_t WS_H     = 24 * MiB;
constexpr size_t WS_X     = WS_H + (size_t)R * 1024 * 2;
constexpr size_t WS_QKV   = WS_X + (size_t)R * 1024 * 4;
constexpr size_t WS_Q     = WS_QKV;
constexpr size_t WS_K     = WS_Q + (size_t)R * 1536 * 2;
constexpr size_t WS_V     = WS_K + (size_t)R * 1536 * 2;
constexpr size_t WS_S     = WS_QKV;
constexpr size_t WS_B     = WS_QKV + (size_t)R * 2048 * 4;
constexpr size_t WS_CQ    = WS_B;
constexpr size_t WS_CKV   = WS_CQ + (size_t)R * 384 * 2;
constexpr size_t WS_KR    = WS_CKV + (size_t)R * 256 * 2;
constexpr size_t WS_SSP   = WS_KR + (size_t)R * 64 * 2;
static_assert(WS_SSP + (size_t)R * 24 * 4 <= WS_B + 40 * MiB, "MLA latents inside region B");
constexpr size_t WS_O     = WS_B;
constexpr size_t WS_QP    = WS_B;
constexpr size_t WS_RAW1  = WS_B;
constexpr size_t WS_PK    = WS_B + (size_t)R * 2048 * 2;
constexpr size_t WS_TAB   = WS_PK + (size_t)R * 128 * 4;
constexpr size_t WS_PD    = WS_S;
constexpr size_t WS_WQ8   = WS_PD + (size_t)8 * R * 128 * 4;
constexpr size_t WS_WSC   = WS_WQ8 + (size_t)R * 128;
static_assert(WS_WSC + (size_t)R * 4 <= WS_B, "expert scratch inside the S region");
constexpr size_t WS_HQ    = WS_B + 40 * MiB;
constexpr size_t WS_HS    = WS_HQ + (size_t)R * 1024;
static_assert(WS_HS + (size_t)R * 4 <= WS_PK, "HQ inside region B");
constexpr size_t WS_TSC   = WS_TAB + (size_t)4 * 16384 * 1024;
constexpr size_t WS_END   = WS_TSC + (size_t)4 * 16384 * 4;
constexpr size_t WS_Q1    = WS_QKV;
constexpr size_t WS_K1    = WS_Q1 + (size_t)R * 1024 * 2;
constexpr size_t WS_V1    = WS_K1 + (size_t)R * 256 * 2;

#define XB_TMO      128
#define XB_XCNT(j)  (256  + 64 * (j))
#define XB_XSUB(j)  (1280 + 64 * (j))
#define XB_XGEN(j)  (2304 + 64 * (j))
#define XB_TOP      3328
#define XB_TOPGEN   3392
#define XCD_BAR_WORDS 3456
#define XB_SPIN_CAP (1u << 20)
__device__ __forceinline__ unsigned xb_ld(unsigned* p)              { return __hip_atomic_load(p, __ATOMIC_RELAXED, __HIP_MEMORY_SCOPE_AGENT); }
__device__ __forceinline__ unsigned xb_add(unsigned* p, unsigned v) { return __hip_atomic_fetch_add(p, v, __ATOMIC_RELAXED, __HIP_MEMORY_SCOPE_AGENT); }
__device__ __forceinline__ unsigned xb_xcc_id() { return (unsigned)__builtin_amdgcn_s_getreg((3 << 11) | 20) & 0xFu; }
#define XB_SPIN(cond, bar) do { unsigned _sp = 0; while (cond) { __builtin_amdgcn_s_sleep(1); \
    if ((++_sp & 255u) == 0u) { if (xb_ld(&(bar)[XB_TMO])) break; if (_sp > XB_SPIN_CAP) { atomicAdd(&(bar)[XB_TMO], 1u); break; } } } } while (0)
struct XcdBarrier { unsigned* bar; unsigned x; volatile LAS unsigned* st; };
__device__ __forceinline__ XcdBarrier xcd_barrier_post(unsigned* bar, volatile LAS unsigned* st) {
    XcdBarrier b; b.bar = bar; b.x = xb_xcc_id(); b.st = st;
    if (threadIdx.x == 0) (void)xb_add(&bar[XB_XCNT(b.x)], 1u);
    return b;
}
__device__ __forceinline__ void xcd_barrier_complete(unsigned* bar, unsigned x, unsigned& nloc, unsigned& nx) {
    const unsigned G = gridDim.x * gridDim.y * gridDim.z;
    unsigned sum, cnt, mine, sp = 0u;
    for (;;) {
        sum = 0u; cnt = 0u; mine = 0u;
#pragma unroll
        for (unsigned j = 0; j < 16; ++j) { const unsigned c = xb_ld(&bar[XB_XCNT(j)]); sum += c; cnt += (c > 0u) ? 1u : 0u; mine = (j == x) ? c : mine; }
        if (sum == G) break;
        __builtin_amdgcn_s_sleep(1);
        if ((++sp & 255u) == 0u) { if (xb_ld(&bar[XB_TMO])) break; if (sp > XB_SPIN_CAP) { atomicAdd(&bar[XB_TMO], 1u); break; } }
    }
    nloc = mine > 0u ? mine : 1u; nx = cnt > 0u ? cnt : 1u;
}
__device__ __forceinline__ void xcd_barrier(const XcdBarrier& b) {
    asm volatile("s_waitcnt vmcnt(0)" ::: "memory");
    __syncthreads();
    if (threadIdx.x == 0) {
        unsigned* bar = b.bar;
        __builtin_amdgcn_s_waitcnt(0);
        unsigned nloc = b.st[0], nx = b.st[1];
        if (nloc == 0u) { xcd_barrier_complete(bar, b.x, nloc, nx); b.st[0] = nloc; b.st[1] = nx; }
        const unsigned old = xb_add(&bar[XB_XSUB(b.x)], 1u);
        const unsigned gen = old / nloc;
        if (old + 1u == (gen + 1u) * nloc) {
            __builtin_amdgcn_fence(__ATOMIC_RELEASE, "agent");
            asm volatile("s_waitcnt vmcnt(0)" ::: "memory");
            const unsigned og = xb_add(&bar[XB_TOP], 1u);
            const unsigned tg = og / nx;
            if (og + 1u == (tg + 1u) * nx) xb_add(&bar[XB_TOPGEN], 1u);
            else XB_SPIN(xb_ld(&bar[XB_TOPGEN]) == tg, bar);
            __builtin_amdgcn_fence(__ATOMIC_ACQUIRE, "agent");
            xb_add(&bar[XB_XGEN(b.x)], 1u);
            asm volatile("s_waitcnt vmcnt(0)" ::: "memory");
        } else {
            XB_SPIN(xb_ld(&bar[XB_XGEN(b.x)]) == gen, bar);
            __builtin_amdgcn_fence(__ATOMIC_ACQUIRE, "agent");
            asm volatile("s_waitcnt vmcnt(0)" ::: "memory");
        }
    }
    __syncthreads();
}


struct Args { const float* in[N_IN]; float* out; unsigned char* ws; int ph_lo, ph_hi; };
static_assert(sizeof(Args) == (N_IN + 2) * 8 + 8, "Args has no padding");

struct Frame {
    const float* x; const float* ctx; float* out; unsigned char* ws; char* lds;
    int tid, lane, wave, bid, nblk, vcu;
};

__device__ __forceinline__ const float* xin_row(const Frame& F, int r) {
    const int b = r / RPB, j = r - b * RPB;
    return (j < CTXL) ? F.ctx + ((size_t)b * CTXL + j) * DM : F.x + ((size_t)b * SEQ + (j - CTXL)) * DM;
}
__device__ __forceinline__ int mod_index(int r) { const int b = r / RPB, j = r - b * RPB; return (j < CTXL) ? 4 : b; }
__device__ __forceinline__ bool is_ctx_row(int r) { return (r % RPB) < CTXL; }

__device__ __forceinline__ void p0_mod(const Args& A, const Frame& F) {
    float* sv = (float*)F.lds;
    float* red = sv + 5 * 1024;
    float* MOD = (float*)(F.ws + WS_MOD);
    bool have = false;
    for (int it = F.bid; it < 2 * 96; it += F.nblk) {
        if (!have) {
            for (int i = F.tid; i < 5 * 1024; i += NTHREADS) { const int m = i >> 10, k = i & 1023;
                const float c = (m < 4) ? A.in[I_C][m * 1024 + k] : A.in[I_CCTX][k]; sv[i] = c / (1.f + __expf(-c)); }
            __syncthreads(); have = true;
        }
        const int l = it / 96, n = (it % 96) * 64 + F.lane;
        const float* W = A.in[l ? I1_ADAW : I0_ADAW]; const float* Bv = A.in[l ? I1_ADAB : I0_ADAB];
        float acc[5] = {0.f, 0.f, 0.f, 0.f, 0.f};
        const int k0 = F.wave * 128;
#pragma unroll 16
        for (int k = k0; k < k0 + 128; ++k) { const float w = W[(size_t)k * 6144 + n];
#pragma unroll
            for (int m = 0; m < 5; ++m) acc[m] += sv[m * 1024 + k] * w; }
#pragma unroll
        for (int m = 0; m < 5; ++m) red[(F.wave * 5 + m) * 64 + F.lane] = acc[m];
        __syncthreads();
        if (F.tid < 320) { const int m = F.tid >> 6, ln = F.tid & 63; float s = 0.f;
#pragma unroll
            for (int w = 0; w < 8; ++w) s += red[(w * 5 + m) * 64 + ln];
            const int nn = (it % 96) * 64 + ln;
            MOD[((size_t)l * 5 + m) * 6144 + nn] = s + Bv[nn]; }
        __syncthreads();
    }
}
__device__ __forceinline__ void transpose_item(const float* W, int K, int N, bf16_t* WT, const float* gain, float* scr, int item, int lane) {
    const int nblk = N / 32, kb = item / nblk, nb = item % nblk, k0 = 64 * kb, n0 = 32 * nb;
#pragma unroll 8
    for (int i = 0; i < 32; ++i) { const int kk = 2 * i + (lane >> 5); float v = W[(size_t)(k0 + kk) * N + n0 + (lane & 31)]; if (gain) v *= gain[k0 + kk]; scr[kk * 33 + (lane & 31)] = v; }
    asm volatile("s_waitcnt lgkmcnt(0)" ::: "memory");
    const int c = lane & 7;
#pragma unroll
    for (int j = 0; j < 4; ++j) { const int n = (lane >> 3) + 8 * j; const float* s = scr + (8 * c) * 33 + n;
        u32x4 o; o.x = pk2(s[0 * 33], s[1 * 33]); o.y = pk2(s[2 * 33], s[3 * 33]); o.z = pk2(s[4 * 33], s[5 * 33]); o.w = pk2(s[6 * 33], s[7 * 33]);
        *(u32x4*)(WT + (size_t)(n0 + n) * K + k0 + 8 * c) = o; }
    asm volatile("s_waitcnt lgkmcnt(0)" ::: "memory");
}
__device__ __forceinline__ void p0_weights(const Args& A, const Frame& F) {
    float* scr = (float*)(F.lds + 32768) + F.wave * (64 * 33);
    const int gw = F.bid * NWAVES + F.wave, NGW = F.nblk * NWAVES;
#define TJOB(IN_, K_, N_, OFF_, GAIN_) do { const float* W = A.in[IN_]; bf16_t* WT = (bf16_t*)(F.ws + (OFF_)); \
        for (int it = gw; it < ((K_) / 64) * ((N_) / 32); it += NGW) transpose_item(W, K_, N_, WT, GAIN_, scr, it, F.lane); } while (0)
    TJOB(I0_WIN, 1024, 704, WS_WIN, nullptr); TJOB(I0_WUQ, 384, 1536, WS_WUQ, A.in[I0_QN]); TJOB(I0_WUKV, 256, 2048, WS_WUKV, A.in[I0_KVN]); TJOB(I0_WO, 1024, 1024, WS_WO0, nullptr);
    TJOB(I1_WQKV, 1024, 1536, WS_WQKV, nullptr); TJOB(I1_WO, 1024, 1024, WS_WO1, nullptr);
#undef TJOB
    { u32x4* z = (u32x4*)(F.ws + WS_WIN + (size_t)704 * 1024 * 2); const int n16 = 64 * 1024 * 2 / 16;
      for (int i = F.bid * NTHREADS + F.tid; i < n16; i += F.nblk * NTHREADS) z[i] = (u32x4){0u, 0u, 0u, 0u}; }
}
__device__ __forceinline__ void p0_weff(const Args& A, const Frame& F) {
    float* kkT = (float*)F.lds; float* wqs = kkT + 128 * 129;
    const int tid = F.tid, lane = F.lane, w = F.wave;
    for (int item = F.bid; item < 512; item += F.nblk) {
        const int layer = item >> 8, z = (item >> 4) & 15, kc = item & 15, h = z >> 1;
        const float* kk = ((z & 1) ? (layer ? A.in[I1_PK2] : A.in[I0_PK2]) : (layer ? A.in[I1_PK1] : A.in[I0_PK1])) + (size_t)h * 16384;
        const float* wq = (layer ? A.in[I1_PWQ] : A.in[I0_PWQ]) + (size_t)(kc * 64) * 2048 + z * 128;
        bf16_t* WT = (bf16_t*)(F.ws + (layer ? WS_WQ1 : WS_WQ0));
        __syncthreads();
        { f32x4 kv[8], wv4[4];
#pragma unroll
          for (int i = 0; i < 8; ++i) kv[i] = *(const f32x4*)(kk + 4 * (tid + i * NTHREADS));
#pragma unroll
          for (int i = 0; i < 4; ++i) { const int e = 4 * (tid + i * NTHREADS); wv4[i] = *(const f32x4*)(wq + (size_t)(e >> 7) * 2048 + (e & 127)); }
#pragma unroll
          for (int i = 0; i < 8; ++i) { const int e = 4 * (tid + i * NTHREADS), key = e >> 7, d = e & 127; kkT[d * 129 + key] = kv[i].x; kkT[(d + 1) * 129 + key] = kv[i].y; kkT[(d + 2) * 129 + key] = kv[i].z; kkT[(d + 3) * 129 + key] = kv[i].w; }
#pragma unroll
          for (int i = 0; i < 4; ++i) *(f32x4*)(wqs + 4 * (tid + i * NTHREADS)) = wv4[i]; }
        __syncthreads();
        float acc[8][2];
#pragma unroll
        for (int j = 0; j < 8; ++j) { acc[j][0] = 0.f; acc[j][1] = 0.f; }
#pragma unroll 2
        for (int d = 0; d < 128; ++d) { const float a0 = kkT[d * 129 + lane], a1 = kkT[d * 129 + lane + 64];
#pragma unroll
            for (int j = 0; j < 8; ++j) { const float wv = wqs[(w * 8 + j) * 128 + d]; acc[j][0] += wv * a0; acc[j][1] += wv * a1; } }
        u32x4 o0, o1;
        o0.x = pk2(acc[0][0], acc[1][0]); o0.y = pk2(acc[2][0], acc[3][0]); o0.z = pk2(acc[4][0], acc[5][0]); o0.w = pk2(acc[6][0], acc[7][0]);
        o1.x = pk2(acc[0][1], acc[1][1]); o1.y = pk2(acc[2][1], acc[3][1]); o1.z = pk2(acc[4][1], acc[5][1]); o1.w = pk2(acc[6][1], acc[7][1]);
        *(u32x4*)(WT + (size_t)(z * 128 + lane) * 1024 + kc * 64 + w * 8) = o0;
        *(u32x4*)(WT + (size_t)(z * 128 + lane + 64) * 1024 + kc * 64 + w * 8) = o1;
    }
    __syncthreads();
}

__device__ __forceinline__ void p0_tables(const Args& A, const Frame& F) {
    const int gw = F.bid * NWAVES + F.wave, NGW = F.nblk * NWAVES, lane = F.lane;
    unsigned char* TAB = F.ws + WS_TAB; float* TSC = (float*)(F.ws + WS_TSC);
    for (int it = gw; it < 4 * 16384 / 4; it += NGW) {
        const int t = it >> 12, row0 = (it & 4095) * 4;
        const float* src = (t == 0 ? A.in[I0_PU] : t == 1 ? A.in[I0_PV] : t == 2 ? A.in[I1_PU] : A.in[I1_PV]) + (size_t)row0 * 1024 + 4 * lane;
        f32x4 v[4][4];
#pragma unroll
        for (int rr = 0; rr < 4; ++rr)
#pragma unroll
            for (int j = 0; j < 4; ++j) v[rr][j] = *(const f32x4*)(src + (size_t)rr * 1024 + 256 * j);
#pragma unroll
        for (int rr = 0; rr < 4; ++rr) {
            float am = 0.f;
#pragma unroll
            for (int j = 0; j < 4; ++j) am = fmaxf(am, fmaxf(fmaxf(fabsf(v[rr][j].x), fabsf(v[rr][j].y)), fmaxf(fabsf(v[rr][j].z), fabsf(v[rr][j].w))));
            am = wave_max(am);
            const float sc = am > 0.f ? am * (1.f / 127.f) : 1.f, inv = am > 0.f ? 127.f / am : 0.f;
            const int row = row0 + rr;
#pragma unroll
            for (int j = 0; j < 4; ++j) { const unsigned b0 = (unsigned)((int)rintf(v[rr][j].x * inv)) & 0xffu, b1 = (unsigned)((int)rintf(v[rr][j].y * inv)) & 0xffu, b2 = (unsigned)((int)rintf(v[rr][j].z * inv)) & 0xffu, b3 = (unsigned)((int)rintf(v[rr][j].w * inv)) & 0xffu;
                *(unsigned*)(TAB + (((size_t)t * 8 + 2 * j + (lane >> 5)) * 16384 + row) * 128 + 4 * (lane & 31)) = b0 | (b1 << 8) | (b2 << 16) | (b3 << 24); }
            if (lane == 0) TSC[t * 16384 + row] = sc;
        }
    }
}

__device__ __forceinline__ void norm_mod_store(const f32x4 (&v)[4], float rinv, const float* g, const float* sh, const float* sc, bf16_t* orow, int lane) {
#pragma unroll
    for (int j = 0; j < 4; ++j) { const int c = 4 * lane + 256 * j;
        const f32x4 gg = *(const f32x4*)(g + c), s1 = *(const f32x4*)(sc + c), s0 = *(const f32x4*)(sh + c);
        const f32x4 y = (v[j] * rinv * gg) * (s1 + 1.f) + s0;
        u32x2 o; o.x = pk2(y.x, y.y); o.y = pk2(y.z, y.w); *(u32x2*)(orow + c) = o; }
}
__device__ __forceinline__ int tok_row(int layer, int n);
__device__ __forceinline__ void norm_row_out(const Frame& F, const f32x4 (&v)[4], float rinv, const float* g, const float* mm, int r, int which) {
    norm_mod_store(v, rinv, g, mm, mm + 1024, (bf16_t*)(F.ws + WS_H) + (size_t)r * DM, F.lane);
    if (which) {
        f32x4 y[4]; float am = 0.f;
#pragma unroll
        for (int j = 0; j < 4; ++j) { const int c = 4 * F.lane + 256 * j; y[j] = (v[j] * rinv * *(const f32x4*)(g + c)) * (*(const f32x4*)(mm + 1024 + c) + 1.f) + *(const f32x4*)(mm + c);
            am = fmaxf(am, fmaxf(fmaxf(fabsf(y[j].x), fabsf(y[j].y)), fmaxf(fabsf(y[j].z), fabsf(y[j].w)))); }
        am = wave_max(am);
        const float inv = am > 0.f ? 127.f / am : 0.f;
#pragma unroll
        for (int j = 0; j < 4; ++j) { const unsigned b0 = (unsigned)((int)rintf(y[j].x * inv)) & 0xffu, b1 = (unsigned)((int)rintf(y[j].y * inv)) & 0xffu, b2 = (unsigned)((int)rintf(y[j].z * inv)) & 0xffu, b3 = (unsigned)((int)rintf(y[j].w * inv)) & 0xffu;
            *(unsigned*)(F.ws + WS_HQ + (size_t)r * DM + 4 * F.lane + 256 * j) = b0 | (b1 << 8) | (b2 << 16) | (b3 << 24); }
        if (F.lane == 0) ((float*)(F.ws + WS_HS))[r] = am > 0.f ? am * (1.f / 127.f) : 1.f;
    }
}
__device__ __forceinline__ void p_norm_rows(const Args& A, const Frame& F, int layer, int which, bool from_input, bool skip_ctx) {
    const int gw = F.bid * NWAVES + F.wave, NGW = F.nblk * NWAVES;
    const float* g = A.in[layer ? (which ? I1_NFFN : I1_NMIX) : (which ? I0_NFFN : I0_NMIX)];
    const float* MOD = (const float*)(F.ws + WS_MOD) + (size_t)layer * 5 * 6144;
    const float* X = (const float*)(F.ws + WS_X);
    const int ntok = skip_ctx ? NB * SEQ : R;
    for (int n = gw; n < ntok; n += 2 * NGW) {
        const bool has1 = (n + NGW) < ntok;
        const int r0 = skip_ctx ? tok_row(1, n) : n, r1 = has1 ? (skip_ctx ? tok_row(1, n + NGW) : n + NGW) : r0;
        const float* x0 = from_input ? xin_row(F, r0) : X + (size_t)r0 * DM; const float* x1 = from_input ? xin_row(F, r1) : X + (size_t)r1 * DM;
        f32x4 v0[4], v1[4]; float s0 = 0.f, s1 = 0.f;
#pragma unroll
        for (int j = 0; j < 4; ++j) { v0[j] = *(const f32x4*)(x0 + 4 * F.lane + 256 * j); v1[j] = *(const f32x4*)(x1 + 4 * F.lane + 256 * j); }
#pragma unroll
        for (int j = 0; j < 4; ++j) { s0 += (v0[j].x * v0[j].x + v0[j].y * v0[j].y) + (v0[j].z * v0[j].z + v0[j].w * v0[j].w); s1 += (v1[j].x * v1[j].x + v1[j].y * v1[j].y) + (v1[j].z * v1[j].z + v1[j].w * v1[j].w); }
        const float ri0 = rsqrtf(wave_sum(s0) * (1.f / DM) + EPS), ri1 = rsqrtf(wave_sum(s1) * (1.f / DM) + EPS);
        norm_row_out(F, v0, ri0, g, MOD + (size_t)mod_index(r0) * 6144 + (which ? 3 * 1024 : 0), r0, which);
        if (has1) norm_row_out(F, v1, ri1, g, MOD + (size_t)mod_index(r1) * 6144 + (which ? 3 * 1024 : 0), r1, which);
    }
}

namespace pg8 {
#define PG8_LAS __attribute__((address_space(3)))
typedef unsigned short bf16_t;
typedef short bf16x8 __attribute__((ext_vector_type(8)));
typedef float f32x4 __attribute__((ext_vector_type(4)));
typedef unsigned u32x4 __attribute__((ext_vector_type(4)));
constexpr int BM = 256, BK = 64, HALF = 128, HTB = HALF * BK * 2  , STAGE_BYTES = 8 * HTB, NXCD = 8, WGM = 8;

__host__ __device__ __forceinline__ int lds_byte(int r, int c) { const int st = (r >> 4) * 2 + (c >> 5), rr = r & 15, cc = c & 31, ob = rr * 64 + cc * 2; return st * 1024 + (ob ^ (((ob >> 9) & 1) << 5)); }
__host__ __device__ __forceinline__ void stage_rc(int b, int& R, int& C) { const int st = b / 1024, sb = b % 1024, swz = sb ^ (((sb >> 9) & 1) << 5); R = (st >> 1) * 16 + swz / 64; C = (st & 1) * 32 + (swz % 64) / 2; }
__host__ __device__ __forceinline__ int perm32(int rho) { const int n = rho >> 4, i = rho & 15; return 8 * (i >> 2) + 4 * n + (i & 3); }

struct Unit { int pm, pn; };
struct Gemm { const bf16_t* A; const bf16_t* Bt; int M, N, K; };

struct StaticOrder {
    int nM, nN, nwg, G, c;
    __host__ __device__ void init(int M, int N, int G_, int c_) { nM = M / BM; nN = N / BM; nwg = nM * nN; G = G_; c = c_; }
    __host__ __device__ bool next(int i, Unit& u) const {
        const long L = (long)i * G + c; if (L >= nwg) return false;
        int wgid = (int)L; { const int q = nwg / NXCD, r = nwg % NXCD, xcd = wgid % NXCD, off = wgid / NXCD; wgid = (xcd < r ? xcd * (q + 1) : r * (q + 1) + (xcd - r) * q) + off; }
        const int nig = WGM * nN, gid = wgid / nig, fm = gid * WGM, gsz = (nM - fm) < WGM ? (nM - fm) : WGM;
        u.pm = fm + ((wgid % nig) % gsz); u.pn = (wgid % nig) / gsz; return true;
    }
    __device__ __forceinline__ void a_ready(const Unit&) const {}
    __device__ __forceinline__ void done(const Unit&) const {}
};

template <class Epi, class Sched, bool ALIGN_EPI = false, bool SP2 = false>
__device__ __forceinline__ void gemm_phase(PG8_LAS unsigned char* lds, const Gemm g, const Sched& S, const Epi& E) {
    const int tid = threadIdx.x, wid = __builtin_amdgcn_readfirstlane(tid >> 6), lane = tid & 63, wr = wid >> 2, wc = wid & 3, fr = lane & 15, fq = lane >> 4;
    const int K = g.K, nt = K / BK;
    unsigned voffA[2], voffB[2];
#pragma unroll
    for (int i = 0; i < 2; ++i) { int R, C; stage_rc(tid * 16 + i * 8192, R, C); const int Rb = Epi::PERM ? ((R & ~31) + perm32(R & 31)) : R;
        voffA[i] = (unsigned)(R * K + C) * 2u; voffB[i] = (unsigned)(Rb * K + C) * 2u; }
    const size_t kstep = (size_t)(BK * 2);
    const size_t hstep = (size_t)HALF * K * 2;
    const size_t tstep = 2 * hstep;
    const unsigned ldsw = (unsigned)wid * 1024u;
    const int aoff = lds_byte(wr * 64 + fr, fq * 8), boff = lds_byte(wc * 32 + fr, fq * 8);
#define PG8_SA(b, h) (((b) * 2 + (h)) * HTB)
#define PG8_SB(b, h) ((4 + (b) * 2 + (h)) * HTB)
#define PG8_STAGE(bufoff, gbase, voff) do { _Pragma("unroll") for (int _i = 0; _i < 2; ++_i) \
        __builtin_amdgcn_global_load_lds((const unsigned*)((const char*)(gbase) + (voff)[_i]), (PG8_LAS unsigned*)(lds + (bufoff) + ldsw + _i * 8192), 16, 0, 0); } while (0)
#define PG8_LDA(dst, b, h) do { _Pragma("unroll") for (int m = 0; m < 4; ++m) _Pragma("unroll") for (int k = 0; k < 2; ++k) dst[m][k] = *(const PG8_LAS bf16x8*)(lds + PG8_SA(b, h) + aoff + m * 2048 + k * 1024); } while (0)
#define PG8_LDB(dst, b, h) do { _Pragma("unroll") for (int n = 0; n < 2; ++n) _Pragma("unroll") for (int k = 0; k < 2; ++k) dst[n][k] = *(const PG8_LAS bf16x8*)(lds + PG8_SB(b, h) + boff + n * 2048 + k * 1024); } while (0)
#define PG8_MMA(ai, bj, At, Bt) do { __builtin_amdgcn_s_setprio(1); _Pragma("unroll") for (int m = 0; m < 4; ++m) _Pragma("unroll") for (int n = 0; n < 2; ++n) _Pragma("unroll") for (int k = 0; k < 2; ++k) \
        acc[ai][bj][m][n] = __builtin_amdgcn_mfma_f32_16x16x32_bf16(Bt[n][k], At[m][k], acc[ai][bj][m][n], 0, 0, 0); __builtin_amdgcn_s_setprio(0); } while (0)
#define PG8_WAIT_V(n) asm volatile("s_waitcnt vmcnt(" #n ")" ::: "memory")
#define PG8_WAIT_L(n) asm volatile("s_waitcnt lgkmcnt(" #n ")" ::: "memory")
#define PG8_BAR __builtin_amdgcn_s_barrier()
#define PG8_SCHED __builtin_amdgcn_sched_barrier(0)
    Unit cur, nxt; int ui = 0;
    if (!S.next(0, cur)) return;
    f32x4 acc[2][2][4][2];
#pragma unroll
    for (int a = 0; a < 2; ++a)
#pragma unroll
        for (int b = 0; b < 2; ++b)
#pragma unroll
            for (int m = 0; m < 4; ++m)
#pragma unroll
                for (int n = 0; n < 2; ++n) acc[a][b][m][n] = (f32x4){0.f, 0.f, 0.f, 0.f};
    bf16x8 At[4][2], B0[2][2], B1[2][2];
    const char* cA = (const char*)g.A + (size_t)cur.pm * tstep; const char* cB = (const char*)g.Bt + (size_t)cur.pn * tstep;
    S.a_ready(cur);
    if constexpr (SP2) {
        PG8_STAGE(PG8_SB(0, 0), cB, voffB); PG8_STAGE(PG8_SB(0, 1), cB + hstep, voffB); PG8_STAGE(PG8_SA(0, 0), cA, voffA); PG8_STAGE(PG8_SA(0, 1), cA + hstep, voffA);
        if (wr == 1) PG8_BAR;
        PG8_WAIT_V(2); PG8_BAR;
        PG8_STAGE(PG8_SB(1, 0), cB + kstep, voffB); PG8_STAGE(PG8_SA(1, 0), cA + kstep, voffA); PG8_STAGE(PG8_SB(1, 1), cB + hstep + kstep, voffB);
        PG8_WAIT_V(6); PG8_BAR;
    } else {
        PG8_STAGE(PG8_SB(0, 0), cB, voffB); PG8_STAGE(PG8_SA(0, 0), cA, voffA); PG8_STAGE(PG8_SB(0, 1), cB + hstep, voffB); PG8_STAGE(PG8_SA(0, 1), cA + hstep, voffA);
        if (wr == 1) PG8_BAR;
        PG8_WAIT_V(4); PG8_BAR;
        PG8_STAGE(PG8_SB(1, 0), cB + kstep, voffB); PG8_STAGE(PG8_SA(1, 0), cA + kstep, voffA); PG8_STAGE(PG8_SB(1, 1), cB + hstep + kstep, voffB);
        PG8_WAIT_V(6); PG8_BAR;
    }
    for (;;) {
        const bool has_next = S.next(ui + 1, nxt);
        const char* nA = has_next ? (const char*)g.A + (size_t)nxt.pm * tstep : cA; const char* nB = has_next ? (const char*)g.Bt + (size_t)nxt.pn * tstep : cB;
        for (int t = 0; t < nt; t += 2) {
            const bool last = (t == nt - 2);
            const char* a1 = cA + (size_t)(t + 1) * kstep;
            const char* a2 = last ? nA : cA + (size_t)(t + 2) * kstep; const char* b2 = last ? nB : cB + (size_t)(t + 2) * kstep;
            const char* a3 = a2 + kstep; const char* b3 = b2 + kstep;
            if (last && has_next) S.a_ready(nxt);
            if constexpr (SP2) {
            PG8_LDB(B0, 0, 0); PG8_LDB(B1, 0, 1); PG8_SCHED; PG8_LDA(At, 0, 0); PG8_STAGE(PG8_SA(1, 1), a1 + hstep, voffA);
            PG8_WAIT_V(8); PG8_WAIT_L(0); PG8_BAR; PG8_MMA(0, 0, At, B0); PG8_MMA(0, 1, At, B1); PG8_BAR; PG8_SCHED;
            PG8_LDA(At, 0, 1); PG8_STAGE(PG8_SB(0, 0), b2, voffB); PG8_STAGE(PG8_SB(0, 1), b2 + hstep, voffB); PG8_STAGE(PG8_SA(0, 0), a2, voffA);
            PG8_WAIT_V(8); PG8_WAIT_L(0); PG8_BAR; PG8_MMA(1, 0, At, B0); PG8_MMA(1, 1, At, B1); PG8_BAR; PG8_SCHED;
            PG8_LDB(B0, 1, 0); PG8_LDB(B1, 1, 1); PG8_SCHED; PG8_LDA(At, 1, 0); PG8_STAGE(PG8_SA(0, 1), a2 + hstep, voffA);
            PG8_WAIT_V(8); PG8_WAIT_L(0); PG8_BAR; PG8_MMA(0, 0, At, B0); PG8_MMA(0, 1, At, B1); PG8_BAR; PG8_SCHED;
            PG8_LDA(At, 1, 1); PG8_STAGE(PG8_SB(1, 0), b3, voffB); PG8_STAGE(PG8_SB(1, 1), b3 + hstep, voffB); PG8_STAGE(PG8_SA(1, 0), a3, voffA);
            PG8_WAIT_V(8); PG8_WAIT_L(0); PG8_BAR; PG8_MMA(1, 0, At, B0); PG8_MMA(1, 1, At, B1); PG8_BAR; PG8_SCHED;
            } else {
            PG8_LDB(B0, 0, 0); PG8_SCHED; PG8_LDA(At, 0, 0); PG8_STAGE(PG8_SA(1, 1), a1 + hstep, voffA);
            PG8_WAIT_L(8); PG8_BAR; PG8_WAIT_L(0); PG8_MMA(0, 0, At, B0); PG8_BAR; PG8_SCHED;
            PG8_LDB(B1, 0, 1); PG8_STAGE(PG8_SB(0, 0), b2, voffB);
            PG8_BAR; PG8_WAIT_L(0); PG8_MMA(0, 1, At, B1); PG8_BAR;
            PG8_LDA(At, 0, 1); PG8_STAGE(PG8_SA(0, 0), a2, voffA);
            PG8_BAR; PG8_WAIT_L(0); PG8_MMA(1, 0, At, B0); PG8_BAR; PG8_SCHED;
            PG8_STAGE(PG8_SB(0, 1), b2 + hstep, voffB);
            PG8_WAIT_V(6); PG8_BAR; PG8_MMA(1, 1, At, B1); PG8_BAR;
            PG8_LDB(B0, 1, 0); PG8_SCHED; PG8_LDA(At, 1, 0); PG8_STAGE(PG8_SA(0, 1), a2 + hstep, voffA);
            PG8_WAIT_L(8); PG8_BAR; PG8_WAIT_L(0); PG8_MMA(0, 0, At, B0); PG8_BAR; PG8_SCHED;
            PG8_LDB(B1, 1, 1); PG8_STAGE(PG8_SB(1, 0), b3, voffB);
            PG8_BAR; PG8_WAIT_L(0); PG8_MMA(0, 1, At, B1); PG8_BAR;
            PG8_LDA(At, 1, 1); PG8_STAGE(PG8_SA(1, 0), a3, voffA);
            PG8_BAR; PG8_WAIT_L(0); PG8_MMA(1, 0, At, B0); PG8_BAR; PG8_SCHED;
            PG8_STAGE(PG8_SB(1, 1), b3 + hstep, voffB);
            PG8_WAIT_V(6); PG8_BAR; PG8_MMA(1, 1, At, B1); PG8_BAR;
            }
        }
        if constexpr (ALIGN_EPI) { if (wr == 0) PG8_BAR; }
        if constexpr (!Epi::AFTER_DRAIN) { E(acc, cur, wr, wc, fr, fq); S.done(cur); }
        if (!has_next) break;
#pragma unroll
        for (int a = 0; a < 2; ++a)
#pragma unroll
            for (int b = 0; b < 2; ++b)
#pragma unroll
                for (int m = 0; m < 4; ++m)
#pragma unroll
                    for (int n = 0; n < 2; ++n) acc[a][b][m][n] = (f32x4){0.f, 0.f, 0.f, 0.f};
        cur = nxt; cA = nA; cB = nB; ++ui;
        if constexpr (ALIGN_EPI) { if (wr == 1) PG8_BAR; }
    }
    PG8_WAIT_V(0);
    if constexpr (!ALIGN_EPI) { if (wr == 0) PG8_BAR; }
    PG8_BAR;
    if constexpr (Epi::AFTER_DRAIN) { E.fused(acc, cur, wr, wc, fr, fq, lds, wid, lane); S.done(cur); }
#undef PG8_SA
#undef PG8_SB
#undef PG8_STAGE
#undef PG8_LDA
#undef PG8_LDB
#undef PG8_MMA
#undef PG8_WAIT_V
#undef PG8_WAIT_L
#undef PG8_BAR
#undef PG8_SCHED
}
}

template <class Inner> struct EpiTile { static constexpr bool PERM = true, AFTER_DRAIN = false; Inner in;
    __device__ __forceinline__ void operator()(const pg8::f32x4 (&acc)[2][2][4][2], const pg8::Unit& u, int wr, int wc, int fr, int fq) const {
#pragma unroll
        for (int ai = 0; ai < 2; ++ai)
#pragma unroll
            for (int m = 0; m < 4; ++m) { const int row = u.pm * 256 + ai * 128 + wr * 64 + m * 16 + fr;
#pragma unroll
                for (int bj = 0; bj < 2; ++bj) in(row, u.pn * 256 + bj * 128 + wc * 32 + 8 * fq, acc[ai][bj][m][0], acc[ai][bj][m][1]); }
    } };
struct In8Bf16 { bf16_t* C; int ldc;
    __device__ __forceinline__ void operator()(int row, int col, f32x4 a, f32x4 b) const { u32x4 o; o.x = cvtpk(a.x, a.y); o.y = cvtpk(a.z, a.w); o.z = cvtpk(b.x, b.y); o.w = cvtpk(b.z, b.w); *(u32x4*)(C + (size_t)row * ldc + col) = o; } };
struct In8KV { bf16_t* Kb; bf16_t* Vb;
    __device__ __forceinline__ void operator()(int row, int col, f32x4 a, f32x4 b) const { const int h = col >> 8, c = col & 255; u32x4 o; o.x = cvtpk(a.x, a.y); o.y = cvtpk(a.z, a.w); o.z = cvtpk(b.x, b.y); o.w = cvtpk(b.z, b.w);
        bf16_t* p = (c < 128) ? Kb + (size_t)row * 1536 + h * 192 + c : Vb + (size_t)row * 1024 + h * 128 + (c - 128);
        *(u32x4*)p = o; } };
struct In8F32 { float* C; int ldc;
    __device__ __forceinline__ void operator()(int row, int col, f32x4 a, f32x4 b) const { float* p = C + (size_t)row * ldc + col; *(f32x4*)p = a; *(f32x4*)(p + 4) = b; } };
struct In8Resid { const float* x; const float* ctx; float* X; const float* gate; bool from_input;
    __device__ __forceinline__ void operator()(int row, int col, f32x4 a, f32x4 b) const {
        const int bb = row / RPB, j = row - bb * RPB; float* xo = X + (size_t)row * DM + col;
        const float* xi = !from_input ? xo : ((j < CTXL) ? ctx + ((size_t)bb * CTXL + j) * DM : x + ((size_t)bb * SEQ + (j - CTXL)) * DM) + col;
        const float* g = gate + (size_t)((j < CTXL) ? 4 : bb) * 6144 + col;
        *(f32x4*)xo = *(const f32x4*)xi + *(const f32x4*)g * a; *(f32x4*)(xo + 4) = *(const f32x4*)(xi + 4) + *(const f32x4*)(g + 4) * b; } };
struct EpiMlaDown { static constexpr bool PERM = true, AFTER_DRAIN = false; bf16_t* CQ; bf16_t* CKV; bf16_t* KR; float* SSP;
    __device__ __forceinline__ void operator()(const pg8::f32x4 (&acc)[2][2][4][2], const pg8::Unit& u, int wr, int wc, int fr, int fq) const {
#pragma unroll
        for (int ai = 0; ai < 2; ++ai)
#pragma unroll
            for (int m = 0; m < 4; ++m) { const int row = u.pm * 256 + ai * 128 + wr * 64 + m * 16 + fr;
#pragma unroll
                for (int bj = 0; bj < 2; ++bj) { const int col = u.pn * 256 + bj * 128 + wc * 32 + 8 * fq; const f32x4 a = acc[ai][bj][m][0], b = acc[ai][bj][m][1];
                    u32x4 o; o.x = cvtpk(a.x, a.y); o.y = cvtpk(a.z, a.w); o.z = cvtpk(b.x, b.y); o.w = cvtpk(b.z, b.w);
                    const int cls = (u.pn * 2 + bj);
                    if (cls < 5) { float sq = (a.x * a.x + a.y * a.y) + (a.z * a.z + a.w * a.w) + (b.x * b.x + b.y * b.y) + (b.z * b.z + b.w * b.w);
                        sq += __shfl_xor(sq, 16); sq += __shfl_xor(sq, 32);
                        if (cls < 3) *(u32x4*)(CQ + (size_t)row * 384 + col) = o; else *(u32x4*)(CKV + (size_t)row * 256 + (col - 384)) = o;
                        if (fq == 0) SSP[(size_t)row * 24 + cls * 4 + wc] = sq; }
                    else if (col < 704) *(u32x4*)(KR + (size_t)row * 64 + (col - 640)) = o; } }
    } };
struct In8Bf16Rs { bf16_t* C; int ldc; const float* ssp;
    __device__ __forceinline__ void operator()(int row, int col, f32x4 a, f32x4 b) const { const f32x4 s0 = *(const f32x4*)(ssp + (size_t)row * 24), s1 = *(const f32x4*)(ssp + (size_t)row * 24 + 4), s2 = *(const f32x4*)(ssp + (size_t)row * 24 + 8);
        const float ssum = (((s0.x + s0.y) + (s0.z + s0.w)) + ((s1.x + s1.y) + (s1.z + s1.w))) + ((s2.x + s2.y) + (s2.z + s2.w));
        const float rs = rsqrtf(ssum * (1.f / 384.f) + EPS); a *= rs; b *= rs;
        u32x4 o; o.x = cvtpk(a.x, a.y); o.y = cvtpk(a.z, a.w); o.z = cvtpk(b.x, b.y); o.w = cvtpk(b.z, b.w); *(u32x4*)(C + (size_t)row * ldc + col) = o; } };
struct In8KVRs { bf16_t* Kb; bf16_t* Vb; const float* ssp;
    __device__ __forceinline__ void operator()(int row, int col, f32x4 a, f32x4 b) const { const f32x4 s0 = *(const f32x4*)(ssp + (size_t)row * 24 + 12), s1 = *(const f32x4*)(ssp + (size_t)row * 24 + 16);
        const float ssum = ((s0.x + s0.y) + (s0.z + s0.w)) + ((s1.x + s1.y) + (s1.z + s1.w));
        const float rs = rsqrtf(ssum * (1.f / 256.f) + EPS); a *= rs; b *= rs;
        const int h = col >> 8, c = col & 255; u32x4 o; o.x = cvtpk(a.x, a.y); o.y = cvtpk(a.z, a.w); o.z = cvtpk(b.x, b.y); o.w = cvtpk(b.z, b.w);
        bf16_t* p = (c < 128) ? Kb + (size_t)row * 1536 + h * 192 + c : Vb + (size_t)row * 1024 + h * 128 + (c - 128);
        *(u32x4*)p = o; } };
struct RowSched { pg8::StaticOrder so; bool latent_only;
    __device__ __forceinline__ void init(int N, int G, int c, bool lat) { latent_only = lat; so.init(lat ? NB * SEQ : R, N, G, c); }
    __device__ __forceinline__ bool next(int i, pg8::Unit& u) const { if (!so.next(i, u)) return false; if (latent_only) u.pm = (u.pm >> 4) * 17 + 1 + (u.pm & 15); return true; }
    __device__ __forceinline__ void a_ready(const pg8::Unit&) const {}
    __device__ __forceinline__ void done(const pg8::Unit&) const {} };
template <class Inner> __device__ __forceinline__ void gemm8(const Frame& F, const bf16_t* Ap, const bf16_t* Bt, int N, int K, bool latent_only, const Inner& in) {
    asm volatile("" : "+s"(K));
    pg8::Gemm g{Ap, Bt, R, N, K}; RowSched S; S.init(N, F.nblk, F.bid, latent_only);
    EpiTile<Inner> E{in};
    pg8::gemm_phase<EpiTile<Inner>, RowSched, true, true>((PG8_LAS unsigned char*)F.lds, g, S, E);
}

template <class Epi> __device__ __forceinline__ void gemm8e(const Frame& F, const bf16_t* Ap, const bf16_t* Bt, int N, int K, bool latent_only, const Epi& E) {
    asm volatile("" : "+s"(K));
    pg8::Gemm g{Ap, Bt, R, N, K}; RowSched S; S.init(N, F.nblk, F.bid, latent_only);
    pg8::gemm_phase<Epi, RowSched, true, true>((PG8_LAS unsigned char*)F.lds, g, S, E);
}

struct GemmDesc { const bf16_t* A; int lda; long sA; const bf16_t* Bt; int ldb; long sB; int M, N, K, nz; };
template <class Epi>
__device__ __forceinline__ void gemm_simple(const Frame& F, const GemmDesc& g, const Epi& epi, bool skip_ctx) {
    const int wm = F.wave >> 1, wn = F.wave & 1, fr = F.lane & 15, fq = F.lane >> 4;
    const int tM = g.M / 128, tN = g.N / 128, per = tM * tN, total = per * g.nz;
    for (int u = F.bid; u < total; u += F.nblk) {
        const int z = u / per, uu = u - z * per, tm = uu / tN, tn = uu - tm * tN;
        if (skip_ctx && ((tm * 128) % RPB) < CTXL) continue;
        const int row0 = tm * 128 + wm * 32, col0 = tn * 128 + wn * 64;
        const bf16_t* ap = g.A + z * g.sA + (size_t)(row0 + fr) * g.lda + fq * 8;
        const bf16_t* bp = g.Bt + z * g.sB + (size_t)(col0 + fr) * g.ldb + fq * 8;
        f32x4 acc[2][4];
#pragma unroll
        for (int mi = 0; mi < 2; ++mi)
#pragma unroll
            for (int ni = 0; ni < 4; ++ni) acc[mi][ni] = (f32x4){0.f, 0.f, 0.f, 0.f};
        for (int k0 = 0; k0 < g.K; k0 += 32) {
            bf16x8 a[2], b[4];
#pragma unroll
            for (int mi = 0; mi < 2; ++mi) a[mi] = *(const bf16x8*)(ap + (size_t)mi * 16 * g.lda + k0);
#pragma unroll
            for (int ni = 0; ni < 4; ++ni) b[ni] = *(const bf16x8*)(bp + (size_t)ni * 16 * g.ldb + k0);
#pragma unroll
            for (int mi = 0; mi < 2; ++mi)
#pragma unroll
                for (int ni = 0; ni < 4; ++ni) acc[mi][ni] = __builtin_amdgcn_mfma_f32_16x16x32_bf16(b[ni], a[mi], acc[mi][ni], 0, 0, 0);
        }
#pragma unroll
        for (int mi = 0; mi < 2; ++mi)
#pragma unroll
            for (int ni = 0; ni < 4; ++ni) epi(z, row0 + mi * 16 + fr, col0 + ni * 16 + fq * 4, acc[mi][ni]);
    }
}
struct EpiBf16 { bf16_t* C; int ldc;
    __device__ __forceinline__ void operator()(int, int row, int col, f32x4 v) const { u32x2 o; o.x = pk2(v.x, v.y); o.y = pk2(v.z, v.w); *(u32x2*)(C + (size_t)row * ldc + col) = o; } };
struct EpiKV { bf16_t* Kb; bf16_t* Vb;
    __device__ __forceinline__ void operator()(int, int row, int col, f32x4 v) const { const int h = col >> 8, c = col & 255; u32x2 o; o.x = pk2(v.x, v.y); o.y = pk2(v.z, v.w);
        if (c < 128) *(u32x2*)(Kb + (size_t)row * 1536 + h * 192 + c) = o; else *(u32x2*)(Vb + (size_t)row * 1024 + h * 128 + (c - 128)) = o; } };
struct EpiF32Z { float* C; int ldc;
    __device__ __forceinline__ void operator()(int z, int row, int col, f32x4 v) const { *(f32x4*)(C + (size_t)row * ldc + z * 128 + col) = v; } };
struct EpiResid { const Frame* F; const float* gate; bool from_input;
    __device__ __forceinline__ void operator()(int, int row, int col, f32x4 v) const {
        float* X = (float*)(F->ws + WS_X) + (size_t)row * DM + col;
        const float* xi = from_input ? xin_row(*F, row) + col : X;
        const f32x4 g = *(const f32x4*)(gate + (size_t)mod_index(row) * 6144 + col);
        *(f32x4*)X = *(const f32x4*)xi + g * v; } };

__device__ __forceinline__ void rope_angles(int r, int& prow, int& pcol) { const int t = (r % RPB) - CTXL; prow = t >> 6; pcol = t & 63; }
__device__ __forceinline__ void p_mla_krope(const Args& A, const Frame& F) {
    const int gw = F.bid * NWAVES + F.wave, NGW = F.nblk * NWAVES, lane = F.lane;
    const bf16_t* KR = (const bf16_t*)(F.ws + WS_KR); bf16_t* Kb = (bf16_t*)(F.ws + WS_K);
    const float invf = __powf(10000.f, -(float)(lane & 15) * (1.f / 16.f));
    for (int r = gw; r < R; r += NGW) {
        float kr = bf2f(KR[(size_t)r * 64 + lane]);
        if (!is_ctx_row(r)) {
            int prow, pcol; rope_angles(r, prow, pcol);
            const float ang = (float)((lane & 32) ? pcol : prow) * invf;
            const float cs = cosf(ang), sn = sinf(ang);
            const float partner = __shfl_xor(kr, 16);
            kr = kr * cs + ((lane & 16) ? partner : -partner) * sn;
        }
        const bf16_t kb = (bf16_t)f2bf(kr);
#pragma unroll
        for (int h = 0; h < 8; ++h) Kb[(size_t)r * 1536 + h * 192 + 128 + lane] = kb;
    }
}
__device__ __forceinline__ float row16_sum(float v) { v += WDPP(v, 0xB1); v += WDPP(v, 0x4E); v += WDPP(v, 0x141); v += WDPP(v, 0x140); return v; }
__device__ __forceinline__ void p_gqa_rows(const Args& A, const Frame& F) {
    const int gw = F.bid * NWAVES + F.wave, NGW = F.nblk * NWAVES, lane = F.lane, c16 = lane & 15, hrow = lane >> 4;
    const bf16_t* RAW = (const bf16_t*)(F.ws + WS_RAW1); bf16_t* Q1 = (bf16_t*)(F.ws + WS_Q1); bf16_t* K1 = (bf16_t*)(F.ws + WS_K1); bf16_t* V1 = (bf16_t*)(F.ws + WS_V1);
    float qg[8], kg[8], invf[8];
#pragma unroll
    for (int e = 0; e < 8; ++e) { qg[e] = A.in[I1_QN][8 * c16 + e]; kg[e] = A.in[I1_KN][8 * c16 + e]; invf[e] = __powf(10000.f, -(float)(8 * (c16 & 3) + e) * (1.f / 32.f)); }
    const bool colaxis = (c16 & 8) != 0, hi32 = (c16 & 4) != 0;
    for (int r = gw; r < R; r += NGW) {
        const bool ctx = is_ctx_row(r);
        const bf16_t* a = RAW + (size_t)r * 1536 + 8 * lane;
        u32x4 ch[3];
#pragma unroll
        for (int j = 0; j < 3; ++j) ch[j] = (ctx && j < 2) ? (u32x4){0u, 0u, 0u, 0u} : *(const u32x4*)(a + 512 * j);
        float cs[8], sn[8];
        { int prow = 0, pcol = 0; if (!ctx) rope_angles(r, prow, pcol); const float pos = (float)(colaxis ? pcol : prow);
#pragma unroll
          for (int e = 0; e < 8; ++e) { const float ang = pos * invf[e]; cs[e] = ctx ? 1.f : __cosf(ang); sn[e] = ctx ? 0.f : __sinf(ang); } }
#pragma unroll
        for (int j = 0; j < 3; ++j) {
            if (ctx && j < 2) continue;
            const bool isv = (j == 2) && (hrow >= 2);
            float x[8];
#pragma unroll
            for (int d = 0; d < 4; ++d) { x[2 * d] = bflo(ch[j][d]); x[2 * d + 1] = bfhi(ch[j][d]); }
            float sq = 0.f;
#pragma unroll
            for (int e = 0; e < 8; ++e) sq += x[e] * x[e];
            const float rinv = rsqrtf(row16_sum(sq) * (1.f / 128.f) + EPS);
            u32x4 o;
            float y[8];
#pragma unroll
            for (int e = 0; e < 8; ++e) y[e] = x[e] * rinv * (j < 2 ? qg[e] : kg[e]);
            u32x4 yp; yp.x = pk2(y[0], y[1]); yp.y = pk2(y[2], y[3]); yp.z = pk2(y[4], y[5]); yp.w = pk2(y[6], y[7]);
            float pr[8];
#pragma unroll
            for (int d = 0; d < 4; ++d) { const float lo = __shfl_xor(y[2 * d], 4), hi2 = __shfl_xor(y[2 * d + 1], 4); pr[2 * d] = lo; pr[2 * d + 1] = hi2; }
            float z[8];
#pragma unroll
            for (int e = 0; e < 8; ++e) z[e] = y[e] * cs[e] + (hi32 ? pr[e] : -pr[e]) * sn[e];
            o.x = pk2(z[0], z[1]); o.y = pk2(z[2], z[3]); o.z = pk2(z[4], z[5]); o.w = pk2(z[6], z[7]);
            (void)yp;
            if (isv) o = ch[j];
            if (j < 2) *(u32x4*)(Q1 + (size_t)r * 1024 + 512 * j + 8 * lane) = o;
            else { bf16_t* dst = (hrow < 2) ? K1 + (size_t)r * 256 + 8 * lane : V1 + (size_t)r * 256 + 8 * (lane - 32); *(u32x4*)dst = o; }
        }
    }
}

__device__ __forceinline__ int crow(int r, int hi) { return (r & 3) + 8 * (r >> 2) + 4 * hi; }
__device__ __forceinline__ int v_st(int k, int c) { const int kk = (k & ~0xC) | ((k & 4) << 1) | ((k & 8) >> 1); return ((kk >> 3) * 4 + (c >> 5)) * 512 + ((kk & 7) * 32 + (c & 31)) * 2; }
__device__ __forceinline__ int v_rd_base(int lane) { return ((lane & 3) << 3) | (((lane >> 2) & 3) << 6) | (((lane >> 4) & 1) << 5) | (((lane >> 5) & 1) << 8); }
constexpr int v_rd_off(int d0, int ks, int half) { return d0 * 512 + ks * 4096 + half * 2048; }
template <int OFF> __device__ __forceinline__ s16x4 tr_read(int vb) { s16x4 r; asm volatile("ds_read_b64_tr_b16 %0, %1 offset:%2" : "=&v"(r) : "v"(vb), "i"(OFF) : "memory"); return r; }
template <int D0> __device__ __forceinline__ void pv_one(f32x16& od, int vb, bf16x8 pa0, bf16x8 pa1, bf16x8 pa2, bf16x8 pa3) {
    const s16x4 l0 = tr_read<v_rd_off(D0, 0, 0)>(vb), h0 = tr_read<v_rd_off(D0, 0, 1)>(vb), l1 = tr_read<v_rd_off(D0, 1, 0)>(vb), h1 = tr_read<v_rd_off(D0, 1, 1)>(vb);
    const s16x4 l2 = tr_read<v_rd_off(D0, 2, 0)>(vb), h2 = tr_read<v_rd_off(D0, 2, 1)>(vb), l3 = tr_read<v_rd_off(D0, 3, 0)>(vb), h3 = tr_read<v_rd_off(D0, 3, 1)>(vb);
    asm volatile("s_waitcnt lgkmcnt(0)" ::: "memory"); SBAR();
#define PK(L, H) (bf16x8){L[0], L[1], L[2], L[3], H[0], H[1], H[2], H[3]}
    od = __builtin_amdgcn_mfma_f32_32x32x16_bf16(pa0, PK(l0, h0), od, 0, 0, 0);
    od = __builtin_amdgcn_mfma_f32_32x32x16_bf16(pa1, PK(l1, h1), od, 0, 0, 0);
    od = __builtin_amdgcn_mfma_f32_32x32x16_bf16(pa2, PK(l2, h2), od, 0, 0, 0);
    od = __builtin_amdgcn_mfma_f32_32x32x16_bf16(pa3, PK(l3, h3), od, 0, 0, 0);
#undef PK
}
__device__ __forceinline__ void pv_d0(f32x16* o, int vb, bf16x8 pa0, bf16x8 pa1, bf16x8 pa2, bf16x8 pa3) {
    pv_one<0>(o[0], vb, pa0, pa1, pa2, pa3); pv_one<1>(o[1], vb, pa0, pa1, pa2, pa3); pv_one<2>(o[2], vb, pa0, pa1, pa2, pa3); pv_one<3>(o[3], vb, pa0, pa1, pa2, pa3);
}
constexpr float ATT_THR = 8.f;
__device__ __forceinline__ void partialSM(f32x16& p0, f32x16& p1, float& m_reg, float& mn, float& alpha, float C, float thr_raw) {
    float pmax = p0[0];
#pragma unroll
    for (int r = 1; r < 16; ++r) pmax = fmaxf(pmax, p0[r]);
#pragma unroll
    for (int r = 0; r < 16; ++r) pmax = fmaxf(pmax, p1[r]);
    { auto rr = __builtin_amdgcn_permlane32_swap(__float_as_uint(pmax), __float_as_uint(pmax), false, false);
      pmax = fmaxf(__uint_as_float(rr[0]), __uint_as_float(rr[1])); }
    if (__builtin_expect(__all(pmax - m_reg <= thr_raw), 1)) { mn = m_reg; alpha = 1.f; }
    else { mn = fmaxf(m_reg, pmax); alpha = __builtin_amdgcn_exp2f((m_reg - mn) * C); m_reg = mn; }
    const float mnC = -mn * C;
#pragma unroll
    for (int r = 0; r < 16; ++r) p0[r] = fmaf(p0[r], C, mnC);
#pragma unroll
    for (int r = 0; r < 16; ++r) p1[r] = fmaf(p1[r], C, mnC);
#pragma unroll
    for (int r = 0; r < 16; ++r) p0[r] = __builtin_amdgcn_exp2f(p0[r]);
}
__device__ __forceinline__ void finishSM(f32x16& p0, f32x16& p1, float alpha, float& l_reg, bf16x8& pa0, bf16x8& pa1, bf16x8& pa2, bf16x8& pa3) {
#pragma unroll
    for (int r = 0; r < 16; ++r) p1[r] = __builtin_amdgcn_exp2f(p1[r]);
    float ps = 0;
#pragma unroll
    for (int r = 0; r < 16; ++r) ps += p0[r];
#pragma unroll
    for (int r = 0; r < 16; ++r) ps += p1[r];
    { auto rr = __builtin_amdgcn_permlane32_swap(__float_as_uint(ps), __float_as_uint(ps), false, false);
      ps = __uint_as_float(rr[0]) + __uint_as_float(rr[1]); }
    l_reg = l_reg * alpha + ps;
#define PK4(P, BASE, OUT) do { unsigned a0 = cvtpk(P[BASE + 0], P[BASE + 1]), a1 = cvtpk(P[BASE + 2], P[BASE + 3]);   \
    unsigned b0 = cvtpk(P[BASE + 4], P[BASE + 5]), b1 = cvtpk(P[BASE + 6], P[BASE + 7]);                              \
    auto r0 = __builtin_amdgcn_permlane32_swap(a0, b0, false, false); auto r1 = __builtin_amdgcn_permlane32_swap(a1, b1, false, false); \
    u32x4 w = {r0[0], r1[0], r0[1], r1[1]}; OUT = *reinterpret_cast<bf16x8*>(&w); } while (0)
    PK4(p0, 0, pa0); PK4(p0, 8, pa1); PK4(p1, 0, pa2); PK4(p1, 8, pa3);
#undef PK4
}
template <int DQK> __device__ __forceinline__ void qkt(f32x16& p0, f32x16& p1, const char* Ks, const bf16x8* qr, int r32, int hi) {
    constexpr int KP = DQK * 2 + 16;
    p0 = f32x16{}; p1 = f32x16{};
#pragma unroll
    for (int d0 = 0; d0 < DQK / 16; ++d0) { const int cb = (d0 * 16 + hi * 8) * 2;
        const bf16x8 b0 = *reinterpret_cast<const bf16x8*>(Ks + r32 * KP + cb);
        const bf16x8 b1 = *reinterpret_cast<const bf16x8*>(Ks + (32 + r32) * KP + cb);
        p0 = __builtin_amdgcn_mfma_f32_32x32x16_bf16(b0, qr[d0], p0, 0, 0, 0);
        p1 = __builtin_amdgcn_mfma_f32_32x32x16_bf16(b1, qr[d0], p1, 0, 0, 0); }
}
template <int DQK> constexpr int att_lds_bytes() { return 2 * 64 * 128 * 2 + 2 * 64 * (DQK * 2 + 16) + NWAVES * 64 * 4; }
template <int DQK, int LDQ, int LDK, int LDV, int LDO>
__device__ __forceinline__ void attn_body(const bf16_t* __restrict__ Qb, const bf16_t* __restrict__ Kh, const bf16_t* __restrict__ Vh, bf16_t* __restrict__ Ob, int seq, float scale, char* lds) {
    constexpr int KP = DQK * 2 + 16, SHM_V = 64 * 128 * 2, SHM_K = 64 * KP, ND = DQK / 16, CH = DQK / 8, NKL = CH * 64 / NTHREADS;
    const float C = scale * 1.4426950408889634f, thr_raw = ATT_THR / scale;
    const int tid = threadIdx.x, wid = tid >> 6, lane = tid & 63, r32 = lane & 31, hi = lane >> 5;
    char* V_lds = lds; char* K_lds = lds + 2 * SHM_V;
    float* wsf = (float*)(lds + 2 * SHM_V + 2 * SHM_K) + wid * 64; float* li_l = wsf; float* al_l = wsf + 32;
    float m_reg = -1e30f, l_reg = 0; f32x16 o[4] = {}; bf16x8 qr[ND];
    const bf16_t* Qw = Qb + (long)(wid * 32 + r32) * LDQ + hi * 8;
#pragma unroll
    for (int d0 = 0; d0 < ND; ++d0) qr[d0] = *reinterpret_cast<const bf16x8*>(Qw + d0 * 16);
    const int sr = tid >> 4, sc = (tid & 15) * 8, vst0 = v_st(sr, sc), vst1 = v_st(32 + sr, sc);
    static_assert(DQK == 128, "double-pipelined body: 128-wide q.k only");
    const int vb0 = (int)(uintptr_t)V_lds + v_rd_base(lane);
    bf16x8 vs0, vs1, ks[NKL];
#define SLOAD(k0) do { vs0 = *reinterpret_cast<const bf16x8*>(&Vh[(long)((k0) + sr) * LDV + sc]); vs1 = *reinterpret_cast<const bf16x8*>(&Vh[(long)((k0) + 32 + sr) * LDV + sc]); \
    _Pragma("unroll") for (int i_ = 0; i_ < NKL; ++i_) ks[i_] = *reinterpret_cast<const bf16x8*>(&Kh[(long)((k0) + sr + 32 * i_) * LDK + sc]); } while (0)
#define SWRITE(b) do { *(bf16x8*)(V_lds + (b) * SHM_V + vst0) = vs0; *(bf16x8*)(V_lds + (b) * SHM_V + vst1) = vs1; \
    _Pragma("unroll") for (int i_ = 0; i_ < NKL; ++i_) *(bf16x8*)(K_lds + (b) * SHM_K + (sr + 32 * i_) * KP + sc * 2) = ks[i_]; } while (0)
#define RESC(a) do { if (__any((a) < 1.f)) { if (hi == 0) al_l[r32] = (a); asm volatile("s_waitcnt lgkmcnt(0)" ::: "memory"); \
    _Pragma("unroll") for (int d = 0; d < 4; ++d) _Pragma("unroll") for (int r = 0; r < 16; ++r) o[d][r] *= al_l[crow(r, hi)]; } } while (0)
    f32x16 pA0, pA1, pB0, pB1; float mnA, mnB, alA, alB; bf16x8 pa0, pa1, pa2, pa3; const int NT = seq / 64;
    SLOAD(0); asm volatile("s_waitcnt vmcnt(0)" ::: "memory"); SWRITE(0); __syncthreads();
    qkt<DQK>(pA0, pA1, K_lds, qr, r32, hi); partialSM(pA0, pA1, m_reg, mnA, alA, C, thr_raw);
    SLOAD(64);
    asm volatile("s_waitcnt vmcnt(0)" ::: "memory"); SWRITE(1); __syncthreads();
    for (int j = 1; j + 1 < NT; j += 2) {
        SBAR(); qkt<DQK>(pB0, pB1, K_lds + SHM_K, qr, r32, hi);
        finishSM(pA0, pA1, alA, l_reg, pa0, pa1, pa2, pa3); SBAR();
        SLOAD((j + 1) * 64); SBAR();
        pv_d0(o, vb0, pa0, pa1, pa2, pa3); partialSM(pB0, pB1, m_reg, mnB, alB, C, thr_raw);
        __syncthreads(); asm volatile("s_waitcnt vmcnt(0)" ::: "memory"); SWRITE(0);
        RESC(alB); __syncthreads();
        SBAR(); qkt<DQK>(pA0, pA1, K_lds, qr, r32, hi);
        finishSM(pB0, pB1, alB, l_reg, pa0, pa1, pa2, pa3); SBAR();
        SLOAD((j + 2) * 64); SBAR();
        pv_d0(o, vb0 + SHM_V, pa0, pa1, pa2, pa3); partialSM(pA0, pA1, m_reg, mnA, alA, C, thr_raw);
        __syncthreads(); asm volatile("s_waitcnt vmcnt(0)" ::: "memory"); SWRITE(1);
        RESC(alA); __syncthreads();
    }
    SBAR(); qkt<DQK>(pB0, pB1, K_lds + SHM_K, qr, r32, hi);
    finishSM(pA0, pA1, alA, l_reg, pa0, pa1, pa2, pa3); SBAR();
    pv_d0(o, vb0, pa0, pa1, pa2, pa3); partialSM(pB0, pB1, m_reg, mnB, alB, C, thr_raw);
    __syncthreads(); RESC(alB);
    finishSM(pB0, pB1, alB, l_reg, pa0, pa1, pa2, pa3); SBAR();
    pv_d0(o, vb0 + SHM_V, pa0, pa1, pa2, pa3);
    if (hi == 0) li_l[r32] = l_reg; asm volatile("s_waitcnt lgkmcnt(0)" ::: "memory");
    float rli[16];
#pragma unroll
    for (int r = 0; r < 16; ++r) rli[r] = __builtin_amdgcn_rcpf(li_l[crow(r, hi)]);
    bf16_t* Ow = Ob + (long)(wid * 32) * LDO;
#pragma unroll
    for (int r = 0; r < 16; ++r) { const int orow = crow(r, hi);
#pragma unroll
        for (int d0 = 0; d0 < 4; ++d0) Ow[(long)orow * LDO + d0 * 32 + r32] = (bf16_t)f2bf(o[d0][r] * rli[r]); }
    __syncthreads();
#undef SLOAD
#undef SWRITE
#undef RESC
}
template <int DQK, int LDQ, int LDK, int LDV, int LDO>
__device__ __forceinline__ void attn_body_single(const bf16_t* __restrict__ Qb, const bf16_t* __restrict__ Kh, const bf16_t* __restrict__ Vh, bf16_t* __restrict__ Ob, int seq, float scale, char* lds, int rope_t0) {
    constexpr int KP = DQK * 2 + 16, SHM_V = 64 * 128 * 2, SHM_K = 64 * KP, ND = DQK / 16, CH = DQK / 8, NKL = CH * 64 / NTHREADS;
    const float C = scale * 1.4426950408889634f, thr_raw = ATT_THR / scale;
    const int tid = threadIdx.x, wid = tid >> 6, lane = tid & 63, r32 = lane & 31, hi = lane >> 5;
    char* V_lds = lds; char* K_lds = lds + 2 * SHM_V;
    float* wsf = (float*)(lds + 2 * SHM_V + 2 * SHM_K) + wid * 64; float* li_l = wsf; float* al_l = wsf + 32;
    float m_reg = -1e30f, l_reg = 0; f32x16 o[4] = {}; bf16x8 qr[ND];
    const bf16_t* Qw = Qb + (long)(wid * 32 + r32) * LDQ + hi * 8;
#pragma unroll
    for (int d0 = 8; d0 < ND; ++d0) qr[d0] = *reinterpret_cast<const bf16x8*>(Qw + d0 * 16);
    if constexpr (DQK == 192) {
        if (rope_t0 >= 0) {
            const int tq = rope_t0 + wid * 32 + r32; const float prow = (float)(tq >> 6), pcol = (float)(tq & 63);
            u32x4 fa1 = __builtin_bit_cast(u32x4, qr[8]), fa2 = __builtin_bit_cast(u32x4, qr[9]), fb1 = __builtin_bit_cast(u32x4, qr[10]), fb2 = __builtin_bit_cast(u32x4, qr[11]);
#pragma unroll
            for (int jj = 0; jj < 4; ++jj) {
                float na1[2], na2[2], nb1[2], nb2[2];
#pragma unroll
                for (int e = 0; e < 2; ++e) { const float invf = __powf(10000.f, -(float)(hi * 8 + 2 * jj + e) * (1.f / 16.f));
                    const float ar = prow * invf, ac = pcol * invf, cr = __cosf(ar), sr_ = __sinf(ar), cc = __cosf(ac), sc_ = __sinf(ac);
                    const float a1 = e ? bfhi(fa1[jj]) : bflo(fa1[jj]), a2 = e ? bfhi(fa2[jj]) : bflo(fa2[jj]), b1 = e ? bfhi(fb1[jj]) : bflo(fb1[jj]), b2 = e ? bfhi(fb2[jj]) : bflo(fb2[jj]);
                    na1[e] = a1 * cr - a2 * sr_; na2[e] = a2 * cr + a1 * sr_; nb1[e] = b1 * cc - b2 * sc_; nb2[e] = b2 * cc + b1 * sc_; }
                fa1[jj] = pk2(na1[0], na1[1]); fa2[jj] = pk2(na2[0], na2[1]); fb1[jj] = pk2(nb1[0], nb1[1]); fb2[jj] = pk2(nb2[0], nb2[1]);
            }
            qr[8] = __builtin_bit_cast(bf16x8, fa1); qr[9] = __builtin_bit_cast(bf16x8, fa2); qr[10] = __builtin_bit_cast(bf16x8, fb1); qr[11] = __builtin_bit_cast(bf16x8, fb2);
        }
    }
    asm volatile("" ::: "memory");
#pragma unroll
    for (int d0 = 0; d0 < 8; ++d0) qr[d0] = *reinterpret_cast<const bf16x8*>(Qw + d0 * 16);
    const int sr = tid >> 4, sc = (tid & 15) * 8, vst0 = v_st(sr, sc), vst1 = v_st(32 + sr, sc);
    int krow[NKL], kch[NKL];
#pragma unroll
    for (int i = 0; i < NKL; ++i) { const int id = tid + i * NTHREADS; krow[i] = id / CH; kch[i] = id % CH; }
    const int vb0 = (int)(uintptr_t)V_lds + v_rd_base(lane);
    bf16x8 vs0, vs1, ks[NKL];
#define SLOAD(k0) do { vs0 = *reinterpret_cast<const bf16x8*>(&Vh[(long)((k0) + sr) * LDV + sc]); vs1 = *reinterpret_cast<const bf16x8*>(&Vh[(long)((k0) + 32 + sr) * LDV + sc]); \
    _Pragma("unroll") for (int i_ = 0; i_ < NKL; ++i_) ks[i_] = *reinterpret_cast<const bf16x8*>(&Kh[(long)((k0) + krow[i_]) * LDK + kch[i_] * 8]); } while (0)
#define SWRITE(b) do { *(bf16x8*)(V_lds + (b) * SHM_V + vst0) = vs0; *(bf16x8*)(V_lds + (b) * SHM_V + vst1) = vs1; \
    _Pragma("unroll") for (int i_ = 0; i_ < NKL; ++i_) *(bf16x8*)(K_lds + (b) * SHM_K + krow[i_] * KP + kch[i_] * 16) = ks[i_]; } while (0)
#define RESC(a) do { if (__any((a) < 1.f)) { if (hi == 0) al_l[r32] = (a); asm volatile("s_waitcnt lgkmcnt(0)" ::: "memory"); \
    _Pragma("unroll") for (int d = 0; d < 4; ++d) _Pragma("unroll") for (int r = 0; r < 16; ++r) o[d][r] *= al_l[crow(r, hi)]; } } while (0)
    f32x16 p0, p1; float mn, al; bf16x8 pa0, pa1, pa2, pa3; const int NT = seq / 64;
    SLOAD(0); asm volatile("s_waitcnt vmcnt(0)" ::: "memory"); SWRITE(0); __syncthreads();
    SLOAD(64);
    for (int j = 0; j < NT; ++j) {
        const int b = j & 1;
        SBAR(); qkt<DQK>(p0, p1, K_lds + b * SHM_K, qr, r32, hi);
        partialSM(p0, p1, m_reg, mn, al, C, thr_raw);
        RESC(al);
        finishSM(p0, p1, al, l_reg, pa0, pa1, pa2, pa3); SBAR();
        pv_d0(o, vb0 + b * SHM_V, pa0, pa1, pa2, pa3);
        if (j + 1 < NT) { asm volatile("s_waitcnt vmcnt(0)" ::: "memory"); SWRITE(b ^ 1); }
        __syncthreads();
        if (j + 2 < NT) SLOAD((j + 2) * 64);
    }
    if (hi == 0) li_l[r32] = l_reg; asm volatile("s_waitcnt lgkmcnt(0)" ::: "memory");
    float rli[16];
#pragma unroll
    for (int r = 0; r < 16; ++r) rli[r] = __builtin_amdgcn_rcpf(li_l[crow(r, hi)]);
    bf16_t* Ow = Ob + (long)(wid * 32) * LDO;
#pragma unroll
    for (int r = 0; r < 16; ++r) { const int orow = crow(r, hi);
#pragma unroll
        for (int d0 = 0; d0 < 4; ++d0) Ow[(long)orow * LDO + d0 * 32 + r32] = (bf16_t)f2bf(o[d0][r] * rli[r]); }
    __syncthreads();
#undef SLOAD
#undef SWRITE
#undef RESC
}
__device__ __forceinline__ void p_attn_mla(const Args& A, const Frame& F) {
    const bf16_t* Q = (const bf16_t*)(F.ws + WS_Q); const bf16_t* Kb = (const bf16_t*)(F.ws + WS_K); const bf16_t* Vb = (const bf16_t*)(F.ws + WS_V); bf16_t* O = (bf16_t*)(F.ws + WS_O);
    const float scale = 0.07216878364870322f;
    for (int u = F.vcu; u < 544; u += F.nblk) {
        int b, h, q0, seq;
        int rope_t0;
        if (u < 512) { const int qb = u & 15; h = (u >> 4) & 7; b = u >> 7; q0 = CTXL + qb * 256; seq = RPB; rope_t0 = qb * 256; }
        else { const int v = u - 512; h = v & 7; b = v >> 3; q0 = 0; seq = CTXL; rope_t0 = -1; }
        const size_t rb = (size_t)b * RPB;
        attn_body_single<192, 1536, 1536, 1024, 1024>(Q + (rb + q0) * 1536 + h * 192, Kb + rb * 1536 + h * 192, Vb + rb * 1024 + h * 128, O + (rb + q0) * 1024 + h * 128, seq, scale, F.lds, rope_t0);
    }
}
__device__ __forceinline__ void p_attn_gqa(const Args& A, const Frame& F) {
    const bf16_t* Q = (const bf16_t*)(F.ws + WS_Q1); const bf16_t* Kb = (const bf16_t*)(F.ws + WS_K1); const bf16_t* Vb = (const bf16_t*)(F.ws + WS_V1); bf16_t* O = (bf16_t*)(F.ws + WS_O);
    const float scale = 0.08838834764831845f;
    for (int u = F.vcu; u < 512; u += F.nblk) {
        const int qb = u & 15, h = (u >> 4) & 7, b = u >> 7, q0 = CTXL + qb * 256, kvh = h >> 2;
        const size_t rb = (size_t)b * RPB;
        attn_body<128, 1024, 256, 256, 1024>(Q + (rb + q0) * 1024 + h * 128, Kb + rb * 256 + kvh * 128, Vb + rb * 256 + kvh * 128, O + (rb + q0) * 1024 + h * 128, RPB, scale, F.lds);
    }
}

#define DPP_XOR1 0xB1
#define DPP_XOR2 0x4E
#define DPP_HMIRROR 0x141
#define DPP_MIRROR 0x140
__device__ __forceinline__ int row_max_i(int v) {
    v = max(v, __builtin_amdgcn_update_dpp(v, v, DPP_XOR1, 0xf, 0xf, false));
    v = max(v, __builtin_amdgcn_update_dpp(v, v, DPP_XOR2, 0xf, 0xf, false));
    v = max(v, __builtin_amdgcn_update_dpp(v, v, DPP_HMIRROR, 0xf, 0xf, false));
    v = max(v, __builtin_amdgcn_update_dpp(v, v, DPP_MIRROR, 0xf, 0xf, false));
    return v;
}
__device__ __forceinline__ float row_sum_f(float v) {
    v += __builtin_bit_cast(float, __builtin_amdgcn_update_dpp(0, __builtin_bit_cast(int, v), DPP_XOR1, 0xf, 0xf, false));
    v += __builtin_bit_cast(float, __builtin_amdgcn_update_dpp(0, __builtin_bit_cast(int, v), DPP_XOR2, 0xf, 0xf, false));
    v += __builtin_bit_cast(float, __builtin_amdgcn_update_dpp(0, __builtin_bit_cast(int, v), DPP_HMIRROR, 0xf, 0xf, false));
    v += __builtin_bit_cast(float, __builtin_amdgcn_update_dpp(0, __builtin_bit_cast(int, v), DPP_MIRROR, 0xf, 0xf, false));
    return v;
}
__device__ __forceinline__ int fkey(float f) { const int b = __builtin_bit_cast(int, f); return b ^ ((b >> 31) & 0x7fffffff); }
__device__ __forceinline__ float keyf(int k) { return __builtin_bit_cast(float, k ^ ((k >> 31) & 0x7fffffff)); }
__device__ __forceinline__ void cand_ij(int t, int& i, int& j) {
    const int g16 = t >= 16, g24 = t >= 24, g29 = t >= 29, g33 = t >= 33, g36 = t >= 36, g38 = t >= 38, g40 = t >= 40;
    i = g16 + g24 + g29 + g33 + g36 + g38 + g40 + max(t - 41, 0);
    const int base = 16 * g16 + 8 * g24 + 5 * g29 + 4 * g33 + 3 * g36 + 2 * g38 + 2 * g40;
    j = (t >= 42) ? 0 : t - base;
    if (t >= 50) { i = 0; j = 0; }
}
__device__ __forceinline__ void row_max2(int& a, int& b) {
    asm volatile("s_nop 1\n\t"
                 "v_max_i32_dpp %0, %0, %0 quad_perm:[1,0,3,2] row_mask:0xf bank_mask:0xf\n\tv_max_i32_dpp %1, %1, %1 quad_perm:[1,0,3,2] row_mask:0xf bank_mask:0xf\n\ts_nop 0\n\t"
                 "v_max_i32_dpp %0, %0, %0 quad_perm:[2,3,0,1] row_mask:0xf bank_mask:0xf\n\tv_max_i32_dpp %1, %1, %1 quad_perm:[2,3,0,1] row_mask:0xf bank_mask:0xf\n\ts_nop 0\n\t"
                 "v_max_i32_dpp %0, %0, %0 row_half_mirror row_mask:0xf bank_mask:0xf\n\tv_max_i32_dpp %1, %1, %1 row_half_mirror row_mask:0xf bank_mask:0xf\n\ts_nop 0\n\t"
                 "v_max_i32_dpp %0, %0, %0 row_mirror row_mask:0xf bank_mask:0xf\n\tv_max_i32_dpp %1, %1, %1 row_mirror row_mask:0xf bank_mask:0xf\n\ts_nop 1"
                 : "+v"(a), "+v"(b));
}
__device__ __forceinline__ void row_max1(int& a) {
    asm volatile("s_nop 1\n\t"
                 "v_max_i32_dpp %0, %0, %0 quad_perm:[1,0,3,2] row_mask:0xf bank_mask:0xf\n\ts_nop 1\n\t"
                 "v_max_i32_dpp %0, %0, %0 quad_perm:[2,3,0,1] row_mask:0xf bank_mask:0xf\n\ts_nop 1\n\t"
                 "v_max_i32_dpp %0, %0, %0 row_half_mirror row_mask:0xf bank_mask:0xf\n\ts_nop 1\n\t"
                 "v_max_i32_dpp %0, %0, %0 row_mirror row_mask:0xf bank_mask:0xf\n\ts_nop 1"
                 : "+v"(a));
}
__device__ __forceinline__ void row_max4(int& a, int& b, int& c, int& d) {
    asm volatile("s_nop 1\n\t"
                 "v_max_i32_dpp %0, %0, %0 quad_perm:[1,0,3,2] row_mask:0xf bank_mask:0xf\n\tv_max_i32_dpp %1, %1, %1 quad_perm:[1,0,3,2] row_mask:0xf bank_mask:0xf\n\t"
                 "v_max_i32_dpp %2, %2, %2 quad_perm:[1,0,3,2] row_mask:0xf bank_mask:0xf\n\tv_max_i32_dpp %3, %3, %3 quad_perm:[1,0,3,2] row_mask:0xf bank_mask:0xf\n\t"
                 "v_max_i32_dpp %0, %0, %0 quad_perm:[2,3,0,1] row_mask:0xf bank_mask:0xf\n\tv_max_i32_dpp %1, %1, %1 quad_perm:[2,3,0,1] row_mask:0xf bank_mask:0xf\n\t"
                 "v_max_i32_dpp %2, %2, %2 quad_perm:[2,3,0,1] row_mask:0xf bank_mask:0xf\n\tv_max_i32_dpp %3, %3, %3 quad_perm:[2,3,0,1] row_mask:0xf bank_mask:0xf\n\t"
                 "v_max_i32_dpp %0, %0, %0 row_half_mirror row_mask:0xf bank_mask:0xf\n\tv_max_i32_dpp %1, %1, %1 row_half_mirror row_mask:0xf bank_mask:0xf\n\t"
                 "v_max_i32_dpp %2, %2, %2 row_half_mirror row_mask:0xf bank_mask:0xf\n\tv_max_i32_dpp %3, %3, %3 row_half_mirror row_mask:0xf bank_mask:0xf\n\t"
                 "v_max_i32_dpp %0, %0, %0 row_mirror row_mask:0xf bank_mask:0xf\n\tv_max_i32_dpp %1, %1, %1 row_mirror row_mask:0xf bank_mask:0xf\n\t"
                 "v_max_i32_dpp %2, %2, %2 row_mirror row_mask:0xf bank_mask:0xf\n\tv_max_i32_dpp %3, %3, %3 row_mirror row_mask:0xf bank_mask:0xf\n\ts_nop 1"
                 : "+v"(a), "+v"(b), "+v"(c), "+v"(d));
}
#define CE_DESC(x, y) do { const int hi_ = max(x, y), lo_ = min(x, y); x = hi_; y = lo_; } while (0)
#define SORT8_DESC(k) do { CE_DESC(k[0], k[2]); CE_DESC(k[1], k[3]); CE_DESC(k[4], k[6]); CE_DESC(k[5], k[7]); CE_DESC(k[0], k[4]); CE_DESC(k[1], k[5]); CE_DESC(k[2], k[6]); CE_DESC(k[3], k[7]); \
    CE_DESC(k[0], k[1]); CE_DESC(k[2], k[3]); CE_DESC(k[4], k[5]); CE_DESC(k[6], k[7]); CE_DESC(k[2], k[4]); CE_DESC(k[3], k[5]); CE_DESC(k[1], k[4]); CE_DESC(k[3], k[6]); CE_DESC(k[1], k[2]); CE_DESC(k[3], k[4]); CE_DESC(k[5], k[6]); } while (0)
__device__ __forceinline__ void p_peer_topk(const Args& A, const Frame& F, bool skip_ctx) {
    const int gw = F.bid * NWAVES + F.wave, NGW = F.nblk * NWAVES, lane = F.lane, c = lane & 15, rw = lane >> 4, rbase = lane & 48;
    const float* S = (const float*)(F.ws + WS_S);
    const int KMIN = (int)0x80000000;
    int ci[4], cj[4];
#pragma unroll
    for (int q = 0; q < 4; ++q) cand_ij(c + 16 * q, ci[q], cj[q]);
    unsigned* PK = (unsigned*)(F.ws + WS_PK);
    const int ntok = skip_ctx ? NB * SEQ : R;
    f32x4 nx[2][4];
#define TK_LOAD(n_) do { const int n2_ = (n_) < ntok ? (n_) : gw; const int r_ = skip_ctx ? tok_row(1, n2_) : n2_; \
        _Pragma("unroll") for (int hh_ = 0; hh_ < 2; ++hh_) { const float* sp_ = S + (size_t)r_ * 2048 + (4 * hh_ + rw) * 256 + 4 * c; \
            nx[hh_][0] = *(const f32x4*)sp_; nx[hh_][1] = *(const f32x4*)(sp_ + 64); nx[hh_][2] = *(const f32x4*)(sp_ + 128); nx[hh_][3] = *(const f32x4*)(sp_ + 192); } } while (0)
    TK_LOAD(gw);
    for (int n = gw; n < ntok; n += NGW) {
        const int r = skip_ctx ? tok_row(1, n) : n;
        int k1[2][8], k2[2][8];
#pragma unroll
        for (int hh = 0; hh < 2; ++hh)
#pragma unroll
            for (int jj = 0; jj < 2; ++jj) { const f32x4 a = nx[hh][jj], b = nx[hh][2 + jj];
#pragma unroll
                for (int e = 0; e < 4; ++e) { const int p = 4 * c + 64 * jj + e;
                    k1[hh][4 * jj + e] = (fkey(a[e]) & ~127) | (127 - p); k2[hh][4 * jj + e] = (fkey(b[e]) & ~127) | (127 - p); } }
        TK_LOAD(n + NGW);
        SORT8_DESC(k1[0]); SORT8_DESC(k2[0]); SORT8_DESC(k1[1]); SORT8_DESC(k2[1]);
        int r1[2] = {KMIN, KMIN}, r2[2] = {KMIN, KMIN};
#pragma unroll 1
        for (int it = 0; it < 16; ++it) {
            int m1a = k1[0][0], m2a = k2[0][0], m1b = k1[1][0], m2b = k2[1][0];
            row_max4(m1a, m2a, m1b, m2b);
            const bool p1a = (k1[0][0] == m1a), p2a = (k2[0][0] == m2a), p1b = (k1[1][0] == m1b), p2b = (k2[1][0] == m2b);
#pragma unroll
            for (int e = 0; e < 7; ++e) { k1[0][e] = p1a ? k1[0][e + 1] : k1[0][e]; k2[0][e] = p2a ? k2[0][e + 1] : k2[0][e]; k1[1][e] = p1b ? k1[1][e + 1] : k1[1][e]; k2[1][e] = p2b ? k2[1][e + 1] : k2[1][e]; }
            k1[0][7] = p1a ? KMIN : k1[0][7]; k2[0][7] = p2a ? KMIN : k2[0][7]; k1[1][7] = p1b ? KMIN : k1[1][7]; k2[1][7] = p2b ? KMIN : k2[1][7];
            if (c == it) { r1[0] = m1a; r2[0] = m2a; r1[1] = m1b; r2[1] = m2b; }
        }
        int ck[2][4];
#pragma unroll
        for (int hh = 0; hh < 2; ++hh) {
#pragma unroll
            for (int q = 0; q < 4; ++q) { const int a = __shfl(r1[hh], rbase | ci[q]), b = __shfl(r2[hh], rbase | cj[q]);
                const float fs = keyf((a & ~127) | 64) + keyf((b & ~127) | 64); const int t = c + 16 * q;
                ck[hh][q] = (t < 50) ? ((fkey(fs) & ~63) | (63 - t)) : KMIN; }
            CE_DESC(ck[hh][0], ck[hh][1]); CE_DESC(ck[hh][2], ck[hh][3]); CE_DESC(ck[hh][0], ck[hh][2]); CE_DESC(ck[hh][1], ck[hh][3]); CE_DESC(ck[hh][1], ck[hh][2]); }
        int tk[2] = {KMIN, KMIN};
#pragma unroll 1
        for (int it = 0; it < 16; ++it) {
            int ma = ck[0][0], mb = ck[1][0];
            row_max2(ma, mb);
            const bool pa = (ck[0][0] == ma), pb = (ck[1][0] == mb);
            ck[0][0] = pa ? ck[0][1] : ck[0][0]; ck[0][1] = pa ? ck[0][2] : ck[0][1]; ck[0][2] = pa ? ck[0][3] : ck[0][2]; ck[0][3] = pa ? KMIN : ck[0][3];
            ck[1][0] = pb ? ck[1][1] : ck[1][0]; ck[1][1] = pb ? ck[1][2] : ck[1][1]; ck[1][2] = pb ? ck[1][3] : ck[1][2]; ck[1][3] = pb ? KMIN : ck[1][3];
            if (c == it) { tk[0] = ma; tk[1] = mb; }
        }
        int mka = tk[0], mkb = tk[1]; row_max2(mka, mkb);
#pragma unroll
        for (int hh = 0; hh < 2; ++hh) {
            int wi, wj; cand_ij(63 - (tk[hh] & 63), wi, wj);
            const int wa = __shfl(r1[hh], rbase | wi), wb = __shfl(r2[hh], rbase | wj);
            const int te = (127 - (wa & 127)) * 128 + (127 - (wb & 127));
            const float tv = keyf((tk[hh] & ~63) | 32), mx = keyf(((hh ? mkb : mka) & ~63) | 32);
            const float ex = __expf(tv - mx), sum = row_sum_f(ex);
            PK[(size_t)r * 128 + (4 * hh + rw) * 16 + c] = ((unsigned)te << 16) | (unsigned)(ex / sum * 65535.f + 0.5f);
        }
    }
#undef TK_LOAD
}

#define UB(w, b) ((float)(((w) >> (8 * (b))) & 0xffu))
__device__ __forceinline__ void p_peer_experts(const Args& A, const Frame& F, int layer) {
    const int gw = F.bid * NWAVES + F.wave, NGW = F.nblk * NWAVES, lane = F.lane;
    const bf16_t* H = (const bf16_t*)(F.ws + WS_H); float* X = (float*)(F.ws + WS_X);
    const unsigned* PK = (const unsigned*)(F.ws + WS_PK);
    const unsigned char* UT = F.ws + WS_TAB + (size_t)(layer * 2) * 16384 * 1024; const unsigned char* VT = UT + (size_t)16384 * 1024;
    const float* SU = (const float*)(F.ws + WS_TSC) + (layer * 2) * 16384; const float* SV = SU + 16384;
    const float* MOD = (const float*)(F.ws + WS_MOD) + (size_t)layer * 5 * 6144;
    for (int r = gw; r < R; r += NGW) {
        if (layer == 1 && is_ctx_row(r)) continue;
        float hf[16];
        { const u32x4 w0 = *(const u32x4*)(H + (size_t)r * DM + 16 * lane), w1 = *(const u32x4*)(H + (size_t)r * DM + 16 * lane + 8);
#pragma unroll
          for (int d = 0; d < 4; ++d) { hf[2 * d] = bflo(w0[d]); hf[2 * d + 1] = bfhi(w0[d]); hf[8 + 2 * d] = bflo(w1[d]); hf[8 + 2 * d + 1] = bfhi(w1[d]); } }
        float hs = 0.f;
#pragma unroll
        for (int i = 0; i < 16; ++i) hs += hf[i];
        hs = wave_sum(hs);
        int v0 = (int)PK[(size_t)r * 128 + lane], v1 = (int)PK[(size_t)r * 128 + 64 + lane];
#pragma unroll
        for (int k = 2; k <= 128; k <<= 1) {
#pragma unroll
            for (int j = k >> 1; j >= 1; j >>= 1) {
                if (j == 64) { const int a = min(v0, v1), b = max(v0, v1); v0 = a; v1 = b; }
                else { const int o0 = __shfl_xor(v0, j), o1 = __shfl_xor(v1, j); const bool lower = (lane & j) == 0;
                    const bool asc0 = (k == 128) ? true : (k == 64) ? true : ((lane & k) == 0), asc1 = (k == 128) ? true : (k == 64) ? false : ((lane & k) == 0);
                    v0 = (lower == asc0) ? min(v0, o0) : max(v0, o0); v1 = (lower == asc1) ? min(v1, o1) : max(v1, o1); }
            }
        }
        const unsigned pk0 = (unsigned)v0, pk1 = (unsigned)v1;
        const int e0 = (int)(pk0 >> 16), e1 = (int)(pk1 >> 16);
        const float g0 = (float)(pk0 & 0xffffu) * (1.f / 65535.f), g1 = (float)(pk1 & 0xffffu) * (1.f / 65535.f);
        const float su0 = SU[e0], su1 = SU[e1], sv0 = SV[e0], sv1 = SV[e1];
        float d0 = 0.f, d1 = 0.f;
        const int dep_src = (8 * (lane & 7)) << 2; const bool bit3 = (lane & 8) != 0;
#define XISSUE(buf, TAB, esrc, gg) do { _Pragma("unroll") for (int q_ = 0; q_ < 8; ++q_) { const int e_ = __builtin_amdgcn_readlane(esrc, (gg) * 8 + q_); \
            buf[q_] = *(const u32x4*)((TAB) + (size_t)e_ * 1024 + 16 * lane); } } while (0)
#define UCOMP(buf, gg, dsel) do { float p_[8]; _Pragma("unroll") for (int q_ = 0; q_ < 8; ++q_) { float d_ = 0.f; \
            _Pragma("unroll") for (int j_ = 0; j_ < 4; ++j_) d_ += (hf[4 * j_] * UB(buf[q_][j_], 0) + hf[4 * j_ + 1] * UB(buf[q_][j_], 1)) + (hf[4 * j_ + 2] * UB(buf[q_][j_], 2) + hf[4 * j_ + 3] * UB(buf[q_][j_], 3)); p_[q_] = d_; } \
            float s_[4]; _Pragma("unroll") for (int q_ = 0; q_ < 4; ++q_) { auto rr_ = __builtin_amdgcn_permlane32_swap(__float_as_uint(p_[q_]), __float_as_uint(p_[q_ + 4]), false, false); s_[q_] = __uint_as_float(rr_[0]) + __uint_as_float(rr_[1]); } \
            float t_[2]; _Pragma("unroll") for (int q_ = 0; q_ < 2; ++q_) { auto rr_ = __builtin_amdgcn_permlane16_swap(__float_as_uint(s_[q_]), __float_as_uint(s_[q_ + 2]), false, false); t_[q_] = __uint_as_float(rr_[0]) + __uint_as_float(rr_[1]); } \
            const float keep_ = bit3 ? t_[1] : t_[0], send_ = bit3 ? t_[0] : t_[1]; \
            float u_ = keep_ + __builtin_bit_cast(float, __builtin_amdgcn_update_dpp(0, __builtin_bit_cast(int, send_), 0x128, 0xf, 0xf, false)); \
            u_ += __builtin_bit_cast(float, __builtin_amdgcn_update_dpp(0, __builtin_bit_cast(int, u_), DPP_HMIRROR, 0xf, 0xf, false)); \
            u_ += __builtin_bit_cast(float, __builtin_amdgcn_update_dpp(0, __builtin_bit_cast(int, u_), DPP_XOR1, 0xf, 0xf, false)); \
            u_ += __builtin_bit_cast(float, __builtin_amdgcn_update_dpp(0, __builtin_bit_cast(int, u_), DPP_XOR2, 0xf, 0xf, false)); \
            const float v_ = __builtin_bit_cast(float, __builtin_amdgcn_ds_bpermute(dep_src, __builtin_bit_cast(int, u_))); \
            if ((lane >> 3) == (gg)) dsel = v_; } while (0)
        {
            u32x4 ua[8], ub[8];
            XISSUE(ua, UT, e0, 0);
#pragma unroll 1
            for (int g = 0; g < 8; g += 2) { XISSUE(ub, UT, e0, g + 1); UCOMP(ua, g, d0); if (g + 2 < 8) XISSUE(ua, UT, e0, g + 2); else XISSUE(ua, UT, e1, 0); UCOMP(ub, g + 1, d0); }
#pragma unroll 1
            for (int g = 0; g < 8; g += 2) { XISSUE(ub, UT, e1, g + 1); UCOMP(ua, g, d1); if (g + 2 < 8) XISSUE(ua, UT, e1, g + 2); UCOMP(ub, g + 1, d1); }
        }
        const float a0 = su0 * (d0 - 128.f * hs), a1 = su1 * (d1 - 128.f * hs);
        const float w0 = g0 * 0.5f * a0 * (1.f + erff(a0 * 0.70710678118654752f)) * sv0, w1 = g1 * 0.5f * a1 * (1.f + erff(a1 * 0.70710678118654752f)) * sv1;
        const float wsum = wave_sum(w0 + w1) * 128.f;
        float acc[16];
#pragma unroll
        for (int i = 0; i < 16; ++i) acc[i] = 0.f;
#define VCOMP(buf, wsrc, gg) do { _Pragma("unroll") for (int q_ = 0; q_ < 8; ++q_) { const float wk_ = __builtin_bit_cast(float, __builtin_amdgcn_readlane(__builtin_bit_cast(int, wsrc), (gg) * 8 + q_)); \
            _Pragma("unroll") for (int j_ = 0; j_ < 4; ++j_) { acc[4 * j_] += wk_ * UB(buf[q_][j_], 0); acc[4 * j_ + 1] += wk_ * UB(buf[q_][j_], 1); acc[4 * j_ + 2] += wk_ * UB(buf[q_][j_], 2); acc[4 * j_ + 3] += wk_ * UB(buf[q_][j_], 3); } } } while (0)
        {
            u32x4 va[8], vb[8];
            XISSUE(va, VT, e0, 0);
#pragma unroll 1
            for (int g = 0; g < 8; g += 2) { XISSUE(vb, VT, e0, g + 1); VCOMP(va, w0, g); if (g + 2 < 8) XISSUE(va, VT, e0, g + 2); else XISSUE(va, VT, e1, 0); VCOMP(vb, w0, g + 1); }
#pragma unroll 1
            for (int g = 0; g < 8; g += 2) { XISSUE(vb, VT, e1, g + 1); VCOMP(va, w1, g); if (g + 2 < 8) XISSUE(va, VT, e1, g + 2); VCOMP(vb, w1, g + 1); }
        }
#undef XISSUE
#undef UCOMP
#undef VCOMP
        const float* mm = MOD + (size_t)mod_index(r) * 6144;
        f32x4 xn[4]; float s = 0.f;
#pragma unroll
        for (int j = 0; j < 4; ++j) { const int c = 16 * lane + 4 * j; const float* xp = X + (size_t)r * DM + c; const f32x4 gf = *(const f32x4*)(mm + 5 * 1024 + c);
            xn[j] = *(const f32x4*)xp + gf * (f32x4){acc[4 * j] - wsum, acc[4 * j + 1] - wsum, acc[4 * j + 2] - wsum, acc[4 * j + 3] - wsum};
            s += (xn[j].x * xn[j].x + xn[j].y * xn[j].y) + (xn[j].z * xn[j].z + xn[j].w * xn[j].w); }
        const float rinv = rsqrtf(wave_sum(s) * (1.f / DM) + EPS);
        if (layer == 0) {
            const float* m1 = (const float*)(F.ws + WS_MOD) + (size_t)(5 + mod_index(r)) * 6144;
            const float* gn = A.in[I1_NMIX];
#pragma unroll
            for (int j = 0; j < 4; ++j) { const int c = 16 * lane + 4 * j; *(f32x4*)(X + (size_t)r * DM + c) = xn[j];
                const f32x4 y = (xn[j] * rinv * *(const f32x4*)(gn + c)) * (*(const f32x4*)(m1 + 1024 + c) + 1.f) + *(const f32x4*)(m1 + c);
                u32x2 o; o.x = pk2(y.x, y.y); o.y = pk2(y.z, y.w); *(u32x2*)((bf16_t*)(F.ws + WS_H) + (size_t)r * DM + c) = o; }
        } else {
            const int b = r / RPB, t = (r - b * RPB) - CTXL; float* op = F.out + ((size_t)b * SEQ + t) * DM; const float* gn = A.in[I_NOUT];
#pragma unroll
            for (int j = 0; j < 4; ++j) { const int c = 16 * lane + 4 * j; *(f32x4*)(op + c) = xn[j] * rinv * *(const f32x4*)(gn + c); }
        }
    }
}

__device__ __forceinline__ int tok_row(int layer, int n) { return layer == 0 ? n : (n >> 12) * RPB + CTXL + (n & 4095); }
#define DPPF(v, ctrl) __builtin_bit_cast(float, __builtin_amdgcn_update_dpp(0, __builtin_bit_cast(int, v), ctrl, 0xf, 0xf, false))
__device__ __forceinline__ int isum8(int v) {
    v += __builtin_amdgcn_update_dpp(0, v, DPP_XOR1, 0xf, 0xf, false); v += __builtin_amdgcn_update_dpp(0, v, DPP_XOR2, 0xf, 0xf, false); v += __builtin_amdgcn_update_dpp(0, v, DPP_HMIRROR, 0xf, 0xf, false); return v; }
__device__ __forceinline__ void p_exp_u(const Args& A, const Frame& F, int layer) {
    const int lane = F.lane, s = lane >> 3, c8 = lane & 7;
    const bool part = (F.nblk & 7) == 0; const int ncb = part ? 1 : 8, cb0 = part ? (F.bid & 7) : 0;
    const int gwv = part ? ((F.bid >> 3) * NWAVES + F.wave) : (F.bid * NWAVES + F.wave), nwv = part ? ((F.nblk >> 3) * NWAVES) : (F.nblk * NWAVES);
    const int ntok = layer == 0 ? R : NB * SEQ;
    const unsigned char* HQ = F.ws + WS_HQ; const unsigned* PK = (const unsigned*)(F.ws + WS_PK);
    const unsigned char* UT = F.ws + WS_TAB + (size_t)(layer * 2) * 16384 * 1024;
    int* PD = (int*)(F.ws + WS_PD);
#define U_META(pk, hq, n_) do { const int r_ = tok_row(layer, (n_) < ntok ? (n_) : gwv); const unsigned* p_ = PK + (size_t)r_ * 128 + s; \
        _Pragma("unroll") for (int i_ = 0; i_ < 16; ++i_) pk[i_] = p_[8 * i_]; \
        hq = *(const u32x4*)(HQ + (size_t)r_ * DM + 128 * cb + 16 * c8); } while (0)
#define U_ISSUE(pk, lo) do { _Pragma("unroll") for (int i_ = (lo); i_ < (lo) + 8; ++i_) t[i_] = *(const u32x4*)(tb + (size_t)(pk[i_] >> 16) * 128); } while (0)
#define U_DOT(i_) do { int d_ = __builtin_amdgcn_sdot4((int)t[i_][0], (int)hv[0], 0, false); d_ = __builtin_amdgcn_sdot4((int)t[i_][1], (int)hv[1], d_, false); \
        d_ = __builtin_amdgcn_sdot4((int)t[i_][2], (int)hv[2], d_, false); d_ = __builtin_amdgcn_sdot4((int)t[i_][3], (int)hv[3], d_, false); \
        d_ = isum8(d_); if (c8 == ((i_) & 7)) { if ((i_) < 8) kA = d_; else kB = d_; } } while (0)
#define U_ITEM(pkc, hqc, pkn, n_) do { \
        const u32x4 hv = hqc; \
        U_META(pkc, hqc, (n_) + 2 * nwv); \
        int kA = 0, kB = 0; \
        _Pragma("unroll") for (int i_ = 0; i_ < 8; ++i_) U_DOT(i_); \
        U_ISSUE(pkn, 0); \
        _Pragma("unroll") for (int i_ = 8; i_ < 16; ++i_) U_DOT(i_); \
        U_ISSUE(pkn, 8); \
        if ((n_) < ntok) { const int r_ = tok_row(layer, n_); int* pd_ = PD + ((size_t)cb * R + r_) * 128 + 8 * c8 + s; pd_[0] = kA; pd_[64] = kB; } \
        } while (0)
#pragma unroll 1
    for (int cbi = 0; cbi < ncb; ++cbi) {
        const int cb = cb0 + cbi;
        const unsigned char* tb = UT + (size_t)cb * 16384 * 128 + 16 * c8;
        unsigned pkA[16], pkB[16]; u32x4 hA, hB, t[16];
        U_META(pkA, hA, gwv); U_META(pkB, hB, gwv + nwv);
        U_ISSUE(pkA, 0); U_ISSUE(pkA, 8);
#pragma unroll 1
        for (int n = gwv; n < ntok; n += 2 * nwv) {
            U_ITEM(pkA, hA, pkB, n);
            U_ITEM(pkB, hB, pkA, n + nwv);
        }
    }
#undef U_META
#undef U_ISSUE
#undef U_DOT
#undef U_ITEM
}
__device__ __forceinline__ void p_exp_w(const Args& A, const Frame& F, int layer) {
    const int gw = F.bid * NWAVES + F.wave, NGW = F.nblk * NWAVES, lane = F.lane;
    const int ntok = layer == 0 ? R : NB * SEQ;
    const unsigned* PK = (const unsigned*)(F.ws + WS_PK); const int* PD = (const int*)(F.ws + WS_PD); const float* HS = (const float*)(F.ws + WS_HS);
    unsigned* WQ8 = (unsigned*)(F.ws + WS_WQ8); float* WSC = (float*)(F.ws + WS_WSC);
    const float* SU = (const float*)(F.ws + WS_TSC) + (layer * 2) * 16384; const float* SV = SU + 16384;
    const int g2 = (lane >> 3) & 3, sb = lane & 7, src = 32 * (g2 & 1) + sb;
    for (int n = gw; n < ntok; n += 2 * NGW) {
        int r[2]; r[0] = tok_row(layer, n); r[1] = (n + NGW) < ntok ? tok_row(layer, n + NGW) : r[0];
        unsigned pk0[2], pk1[2]; int d0[2], d1[2]; float hs[2];
#pragma unroll
        for (int q = 0; q < 2; ++q) { pk0[q] = PK[(size_t)r[q] * 128 + lane]; pk1[q] = PK[(size_t)r[q] * 128 + 64 + lane]; hs[q] = HS[r[q]]; d0[q] = 0; d1[q] = 0;
#pragma unroll
            for (int cb = 0; cb < 8; ++cb) { d0[q] += PD[((size_t)cb * R + r[q]) * 128 + lane]; d1[q] += PD[((size_t)cb * R + r[q]) * 128 + 64 + lane]; } }
        float su0[2], su1[2], sv0[2], sv1[2];
#pragma unroll
        for (int q = 0; q < 2; ++q) { const int e0 = (int)(pk0[q] >> 16), e1 = (int)(pk1[q] >> 16); su0[q] = SU[e0]; su1[q] = SU[e1]; sv0[q] = SV[e0]; sv1[q] = SV[e1]; }
#pragma unroll
        for (int q = 0; q < 2; ++q) {
            const float g0 = (float)(pk0[q] & 0xffffu) * (1.f / 65535.f), g1 = (float)(pk1[q] & 0xffffu) * (1.f / 65535.f);
            const float a0 = su0[q] * hs[q] * (float)d0[q], a1 = su1[q] * hs[q] * (float)d1[q];
            const float w0 = g0 * 0.5f * a0 * (1.f + erff(a0 * 0.70710678118654752f)) * sv0[q], w1 = g1 * 0.5f * a1 * (1.f + erff(a1 * 0.70710678118654752f)) * sv1[q];
            const float wm = wave_max(fmaxf(fabsf(w0), fabsf(w1)));
            const float inv = wm > 0.f ? 127.f / wm : 0.f;
            const int q0 = (int)rintf(w0 * inv) & 0xff, q1 = (int)rintf(w1 * inv) & 0xff;
            unsigned pw = 0;
#pragma unroll
            for (int j = 0; j < 4; ++j) { const int x0 = __shfl(q0, src + 8 * j), x1 = __shfl(q1, src + 8 * j); pw |= (unsigned)((g2 < 2) ? x0 : x1) << (8 * j); }
            if (q == 0 || (n + NGW) < ntok) { if (lane < 32) WQ8[(size_t)r[q] * 32 + lane] = pw; if (lane == 0) WSC[r[q]] = wm > 0.f ? wm * (1.f / 127.f) : 0.f; }
        }
    }
}
__device__ __forceinline__ void p_exp_v(const Args& A, const Frame& F, int layer) {
    const int lane = F.lane, s = lane >> 3, c8 = lane & 7;
    const bool part = (F.nblk & 7) == 0; const int ncb = part ? 1 : 8, cb0 = part ? (F.bid & 7) : 0;
    const int gwv = part ? ((F.bid >> 3) * NWAVES + F.wave) : (F.bid * NWAVES + F.wave), nwv = part ? ((F.nblk >> 3) * NWAVES) : (F.nblk * NWAVES);
    const int ntok = layer == 0 ? R : NB * SEQ;
    const unsigned* PK = (const unsigned*)(F.ws + WS_PK); const unsigned* WQ8 = (const unsigned*)(F.ws + WS_WQ8); const float* WSC = (const float*)(F.ws + WS_WSC);
    const unsigned char* VT = F.ws + WS_TAB + (size_t)(layer * 2 + 1) * 16384 * 1024;
    float* X = (float*)(F.ws + WS_X); const float* MOD = (const float*)(F.ws + WS_MOD) + (size_t)layer * 5 * 6144;
    const bool bit3 = (lane & 8) != 0;
#define V_METAP(pk, n_) do { const int r_ = tok_row(layer, (n_) < ntok ? (n_) : gwv); const unsigned* p_ = PK + (size_t)r_ * 128 + s; \
        _Pragma("unroll") for (int i_ = 0; i_ < 16; ++i_) pk[i_] = p_[8 * i_]; } while (0)
#define V_METAW(wq, n_) do { const int r_ = tok_row(layer, (n_) < ntok ? (n_) : gwv); const unsigned* w_ = WQ8 + (size_t)r_ * 32 + s; \
        _Pragma("unroll") for (int g_ = 0; g_ < 4; ++g_) wq[g_] = w_[8 * g_]; } while (0)
#define V_ISSUE(pk, lo) do { _Pragma("unroll") for (int i_ = (lo); i_ < (lo) + 8; ++i_) t[i_] = *(const u32x4*)(tb + (size_t)(pk[i_] >> 16) * 128); } while (0)
#define V_GRP(wq, g_) do { _Pragma("unroll") for (int j_ = 0; j_ < 4; ++j_) { const unsigned a_ = t[4 * (g_)][j_], b_ = t[4 * (g_) + 1][j_], c_ = t[4 * (g_) + 2][j_], d_ = t[4 * (g_) + 3][j_]; \
        const unsigned ablo = __builtin_amdgcn_perm(b_, a_, 0x05010400u), abhi = __builtin_amdgcn_perm(b_, a_, 0x07030602u), cdlo = __builtin_amdgcn_perm(d_, c_, 0x05010400u), cdhi = __builtin_amdgcn_perm(d_, c_, 0x07030602u); \
        acc[4 * j_]     = __builtin_amdgcn_sdot4((int)__builtin_amdgcn_perm(cdlo, ablo, 0x05040100u), (int)wq[g_], acc[4 * j_], false); \
        acc[4 * j_ + 1] = __builtin_amdgcn_sdot4((int)__builtin_amdgcn_perm(cdlo, ablo, 0x07060302u), (int)wq[g_], acc[4 * j_ + 1], false); \
        acc[4 * j_ + 2] = __builtin_amdgcn_sdot4((int)__builtin_amdgcn_perm(cdhi, abhi, 0x05040100u), (int)wq[g_], acc[4 * j_ + 2], false); \
        acc[4 * j_ + 3] = __builtin_amdgcn_sdot4((int)__builtin_amdgcn_perm(cdhi, abhi, 0x07060302u), (int)wq[g_], acc[4 * j_ + 3], false); } } while (0)
#define V_ITEM(pkc, wqc, pkn, n_) do { \
        int acc[16]; _Pragma("unroll") for (int a_ = 0; a_ < 16; ++a_) acc[a_] = 0; \
        V_METAP(pkc, (n_) + 2 * nwv); \
        V_GRP(wqc, 0); V_GRP(wqc, 1); \
        V_ISSUE(pkn, 0); \
        V_GRP(wqc, 2); V_GRP(wqc, 3); \
        V_ISSUE(pkn, 8); \
        int b8[8], c4[4], o[2]; \
        _Pragma("unroll") for (int a_ = 0; a_ < 8; ++a_) { auto rr = __builtin_amdgcn_permlane32_swap((unsigned)acc[a_], (unsigned)acc[a_ + 8], false, false); b8[a_] = (int)rr[0] + (int)rr[1]; } \
        _Pragma("unroll") for (int a_ = 0; a_ < 4; ++a_) { auto rr = __builtin_amdgcn_permlane16_swap((unsigned)b8[a_], (unsigned)b8[a_ + 4], false, false); c4[a_] = (int)rr[0] + (int)rr[1]; } \
        _Pragma("unroll") for (int a_ = 0; a_ < 2; ++a_) { const int keep = bit3 ? c4[a_ + 2] : c4[a_], send = bit3 ? c4[a_] : c4[a_ + 2]; o[a_] = keep + __builtin_amdgcn_update_dpp(0, send, 0x128, 0xf, 0xf, false); } \
        if ((n_) < ntok) { const int r_ = tok_row(layer, n_); const float ws_ = WSC[r_]; const int col = 128 * cb + 16 * c8 + 2 * s; \
            const f32x2 gf = *(const f32x2*)(MOD + (size_t)mod_index(r_) * 6144 + 5 * 1024 + col); f32x2* xp = (f32x2*)(X + (size_t)r_ * DM + col); \
            f32x2 xv = *xp; xv.x += gf.x * (ws_ * (float)o[0]); xv.y += gf.y * (ws_ * (float)o[1]); *xp = xv; } \
        V_METAW(wqc, (n_) + 2 * nwv); } while (0)
#pragma unroll 1
    for (int cbi = 0; cbi < ncb; ++cbi) {
        const int cb = cb0 + cbi;
        const unsigned char* tb = VT + (size_t)cb * 16384 * 128 + 16 * c8;
        unsigned pkA[16], pkB[16], wqA[4], wqB[4]; u32x4 t[16];
        V_METAP(pkA, gwv); V_METAW(wqA, gwv); V_METAP(pkB, gwv + nwv); V_METAW(wqB, gwv + nwv);
        V_ISSUE(pkA, 0); V_ISSUE(pkA, 8);
#pragma unroll 1
        for (int n = gwv; n < ntok; n += 2 * nwv) {
            V_ITEM(pkA, wqA, pkB, n);
            V_ITEM(pkB, wqB, pkA, n + nwv);
        }
    }
#undef V_METAP
#undef V_METAW
#undef V_ISSUE
#undef V_GRP
#undef V_ITEM
}
__device__ __forceinline__ void p_final_norm(const Args& A, const Frame& F) {
    const int gw = F.bid * NWAVES + F.wave, NGW = F.nblk * NWAVES, lane = F.lane;
    const float* X = (const float*)(F.ws + WS_X); const float* gn = A.in[I_NOUT];
    for (int n = gw; n < NB * SEQ; n += NGW) {
        const float* xr = X + (size_t)tok_row(1, n) * DM; float* op = F.out + (size_t)n * DM;
        f32x4 v[4]; float sq = 0.f;
#pragma unroll
        for (int j = 0; j < 4; ++j) { v[j] = *(const f32x4*)(xr + 4 * lane + 256 * j); sq += (v[j].x * v[j].x + v[j].y * v[j].y) + (v[j].z * v[j].z + v[j].w * v[j].w); }
        const float rinv = rsqrtf(wave_sum(sq) * (1.f / DM) + EPS);
#pragma unroll
        for (int j = 0; j < 4; ++j) { const int c = 4 * lane + 256 * j; *(f32x4*)(op + c) = v[j] * rinv * *(const f32x4*)(gn + c); }
    }
}

constexpr int N_PHASES = 24;
__global__ void __launch_bounds__(NTHREADS, 2) mega(Args args) {
    extern __shared__ __attribute__((aligned(16))) unsigned char lds_raw[];
    Frame F; F.x = args.in[I_X]; F.ctx = args.in[I_CTX]; F.out = args.out; F.ws = args.ws; F.lds = (char*)lds_raw;
    F.tid = threadIdx.x; F.lane = F.tid & 63; F.wave = __builtin_amdgcn_readfirstlane(F.tid >> 6); F.bid = blockIdx.x; F.nblk = gridDim.x;
    F.vcu = (F.nblk % 8 == 0) ? (F.bid % 8) * (F.nblk / 8) + F.bid / 8 : F.bid;
    volatile LAS unsigned* st = (volatile LAS unsigned*)(LAS unsigned char*)(lds_raw + LDS_BYTES - 64);
    if (F.tid < 16) st[F.tid] = 0u;
    __syncthreads();
    XcdBarrier bar; bar.bar = (unsigned*)(F.ws + WS_CTL) + 4096; bar.x = 0; bar.st = st;
    const int lo = args.ph_lo, hi = args.ph_hi;
    const bool fused = (hi - lo) > 1;
    if (fused) bar = xcd_barrier_post((unsigned*)(F.ws + WS_CTL) + 4096, st);
#ifdef ONLY_PHASE
#define IN(k) ((k) == ONLY_PHASE && lo <= (k) && (k) < hi)
#else
#define IN(k) (lo <= (k) && (k) < hi)
#endif
#define SEAM(k) do { if (IN(k) && IN((k) + 1)) { if ((k) == 0) cg::this_grid().sync(); else xcd_barrier(bar); } } while (0)
    bf16_t* Hb = (bf16_t*)(F.ws + WS_H);
#define PH(k, ...) if (IN(k)) for (int rep_ = 0; rep_ < (((PROBE_MASK >> (k)) & 1u) ? 2 : 1); ++rep_) { __VA_ARGS__; __syncthreads(); } SEAM(k)
    float* Xb = (float*)(F.ws + WS_X); const float* MODb = (const float*)(F.ws + WS_MOD);
    PH(0, for (int q_ = 0; q_ < ((PROBE_P0 & 1u) ? 2 : 1); ++q_) { p0_mod(args, F); __syncthreads(); }
          for (int q_ = 0; q_ < ((PROBE_P0 & 2u) ? 2 : 1); ++q_) { p0_weights(args, F); __syncthreads(); }
          for (int q_ = 0; q_ < ((PROBE_P0 & 4u) ? 2 : 1); ++q_) { p0_weff(args, F); __syncthreads(); }
          for (int q_ = 0; q_ < ((PROBE_P0 & 8u) ? 2 : 1); ++q_) { p0_tables(args, F); __syncthreads(); });
    PH(1, p_norm_rows(args, F, 0, 0, true, false));
    PH(2, gemm8e(F, Hb, (const bf16_t*)(F.ws + WS_WIN), 768, 1024, false, EpiMlaDown{(bf16_t*)(F.ws + WS_CQ), (bf16_t*)(F.ws + WS_CKV), (bf16_t*)(F.ws + WS_KR), (float*)(F.ws + WS_SSP)}));
    PH(3, p_mla_krope(args, F);
          gemm8(F, (const bf16_t*)(F.ws + WS_CQ), (const bf16_t*)(F.ws + WS_WUQ), 1536, 384, false, In8Bf16Rs{(bf16_t*)(F.ws + WS_Q), 1536, (const float*)(F.ws + WS_SSP)});
          gemm8(F, (const bf16_t*)(F.ws + WS_CKV), (const bf16_t*)(F.ws + WS_WUKV), 2048, 256, false, In8KVRs{(bf16_t*)(F.ws + WS_K), (bf16_t*)(F.ws + WS_V), (const float*)(F.ws + WS_SSP)}));
    PH(4, p_attn_mla(args, F));
    PH(5, gemm8(F, (const bf16_t*)(F.ws + WS_O), (const bf16_t*)(F.ws + WS_WO0), 1024, 1024, false, In8Resid{F.x, F.ctx, Xb, MODb + 2 * 1024, true}));
    PH(6, p_norm_rows(args, F, 0, 1, false, false));
    PH(7, gemm8(F, Hb, (const bf16_t*)(F.ws + WS_WQ0), 2048, 1024, false, In8F32{(float*)(F.ws + WS_S), 2048}));
    PH(8, p_peer_topk(args, F, false));
    PH(9, p_exp_u(args, F, 0));
    PH(10, p_exp_w(args, F, 0));
    if (IN(11)) { p_exp_v(args, F, 0); } SEAM(11);
    PH(12, p_norm_rows(args, F, 1, 0, false, false));
    PH(13, gemm8(F, Hb, (const bf16_t*)(F.ws + WS_WQKV), 1536, 1024, false, In8Bf16{(bf16_t*)(F.ws + WS_RAW1), 1536}));
    PH(14, p_gqa_rows(args, F));
    PH(15, p_attn_gqa(args, F));
    if (IN(16)) { gemm8(F, (const bf16_t*)(F.ws + WS_O), (const bf16_t*)(F.ws + WS_WO1), 1024, 1024, true, In8Resid{F.x, F.ctx, Xb, MODb + 5 * 6144 + 2 * 1024, false}); } SEAM(16);
    PH(17, p_norm_rows(args, F, 1, 1, false, true));
    PH(18, gemm8(F, Hb, (const bf16_t*)(F.ws + WS_WQ1), 2048, 1024, true, In8F32{(float*)(F.ws + WS_S), 2048}));
    PH(19, p_peer_topk(args, F, true));
    PH(20, p_exp_u(args, F, 1));
    PH(21, p_exp_w(args, F, 1));
    if (IN(22)) { p_exp_v(args, F, 1); } SEAM(22);
    if (IN(23)) p_final_norm(args, F);
#undef PH
#undef IN
#undef SEAM
}

extern "C" void kernel_launch(void* const* d_in, const int* in_sizes, int n_in, void* d_out, int out_size, void* d_ws, size_t ws_size, hipStream_t stream) {
    static int grid = 0;
    if (grid == 0) {
        if (n_in != N_IN || in_sizes[0] != NB * SEQ * DM || out_size != NB * SEQ * DM || ws_size < WS_END) {
            fprintf(stderr, "kernel_launch: shape mismatch (n_in %d, in0 %d, out %d, ws %zu < %zu)\n", n_in, n_in > 0 ? in_sizes[0] : -1, out_size, ws_size, (size_t)WS_END); grid = -1; return; }
        int dev = 0, cus = 0, per_cu = 0;
        hipGetDevice(&dev); hipDeviceGetAttribute(&cus, hipDeviceAttributeMultiprocessorCount, dev);
        if (hipFuncSetAttribute((const void*)mega, hipFuncAttributeMaxDynamicSharedMemorySize, LDS_BYTES) != hipSuccess) { fprintf(stderr, "kernel_launch: hipFuncSetAttribute failed\n"); grid = -1; return; }
        if (hipOccupancyMaxActiveBlocksPerMultiprocessor(&per_cu, (const void*)mega, NTHREADS, LDS_BYTES) != hipSuccess || per_cu < 1) { fprintf(stderr, "kernel_launch: occupancy query failed (%d)\n", per_cu); (void)hipGetLastError(); grid = -1; return; }
        grid = cus * (per_cu > 1 ? 1 : per_cu);
    }
    if (grid < 0) return;
    hipMemsetAsync((char*)d_ws + WS_CTL, 0, 1 * MiB, stream);
    Args a{};
    for (int i = 0; i < N_IN; ++i) a.in[i] = (const float*)d_in[i];
    a.out = (float*)d_out; a.ws = (unsigned char*)d_ws;
#if MK_PER_PHASE
    for (int p = 0; p < N_PHASES; ++p) { a.ph_lo = p; a.ph_hi = p + 1; hipLaunchKernelGGL(mega, dim3(grid), dim3(NTHREADS), LDS_BYTES, stream, a); }
#else
    a.ph_lo = 0; a.ph_hi = N_PHASES;
    void* kargs[] = {&a};
    hipError_t e = hipLaunchCooperativeKernel((const void*)mega, dim3(grid), dim3(NTHREADS), kargs, LDS_BYTES, stream);
    if (e != hipSuccess) fprintf(stderr, "kernel_launch: cooperative launch failed: %s (grid %d)\n", hipGetErrorString(e), grid);
#endif
}
```

```cpp
#include <hip/hip_runtime.h>
#include <hip/hip_cooperative_groups.h>
#include <cstdio>
#include <cstdint>
namespace cg = cooperative_groups;

#ifndef PROBE_MASK
#define PROBE_MASK 0u
#endif
#ifndef PROBE_P0
#define PROBE_P0 0u
#endif
#ifndef MK_PER_PHASE
#define MK_PER_PHASE 0
#endif

typedef unsigned short bf16_t;
typedef short bf16x8 __attribute__((ext_vector_type(8)));
typedef short s16x4 __attribute__((ext_vector_type(4)));
typedef float f32x4 __attribute__((ext_vector_type(4)));
typedef float f32x2 __attribute__((ext_vector_type(2)));
typedef float f32x16 __attribute__((ext_vector_type(16)));
typedef unsigned u32x4 __attribute__((ext_vector_type(4)));
typedef unsigned u32x2 __attribute__((ext_vector_type(2)));
#define LAS __attribute__((address_space(3)))
#define SBAR() __builtin_amdgcn_sched_barrier(0)

__device__ __forceinline__ unsigned f2bf(float f) { unsigned u = __builtin_bit_cast(unsigned, f); return (u + 0x7fffu + ((u >> 16) & 1u)) >> 16; }
__device__ __forceinline__ unsigned pk2(float lo, float hi) { return f2bf(lo) | (f2bf(hi) << 16); }
__device__ __forceinline__ float bf2f(unsigned short h) { return __builtin_bit_cast(float, (unsigned)h << 16); }
__device__ __forceinline__ float bflo(unsigned w) { return __builtin_bit_cast(float, w << 16); }
__device__ __forceinline__ float bfhi(unsigned w) { return __builtin_bit_cast(float, w & 0xffff0000u); }
__device__ __forceinline__ unsigned cvtpk(float lo, float hi) { unsigned r; asm volatile("v_cvt_pk_bf16_f32 %0, %1, %2" : "=v"(r) : "v"(lo), "v"(hi)); return r; }
#define WDPP(v, ctrl) __builtin_bit_cast(float, __builtin_amdgcn_update_dpp(0, __builtin_bit_cast(int, v), ctrl, 0xf, 0xf, false))
__device__ __forceinline__ float wave_sum(float v) {
    v += WDPP(v, 0xB1); v += WDPP(v, 0x4E); v += WDPP(v, 0x141); v += WDPP(v, 0x140);
    { auto rr = __builtin_amdgcn_permlane16_swap(__float_as_uint(v), __float_as_uint(v), false, false); v = __uint_as_float(rr[0]) + __uint_as_float(rr[1]); }
    { auto rr = __builtin_amdgcn_permlane32_swap(__float_as_uint(v), __float_as_uint(v), false, false); v = __uint_as_float(rr[0]) + __uint_as_float(rr[1]); }
    return v;
}
__device__ __forceinline__ float wave_max(float v) {
    v = fmaxf(v, WDPP(v, 0xB1)); v = fmaxf(v, WDPP(v, 0x4E)); v = fmaxf(v, WDPP(v, 0x141)); v = fmaxf(v, WDPP(v, 0x140));
    { auto rr = __builtin_amdgcn_permlane16_swap(__float_as_uint(v), __float_as_uint(v), false, false); v = fmaxf(__uint_as_float(rr[0]), __uint_as_float(rr[1])); }
    { auto rr = __builtin_amdgcn_permlane32_swap(__float_as_uint(v), __float_as_uint(v), false, false); v = fmaxf(__uint_as_float(rr[0]), __uint_as_float(rr[1])); }
    return v;
}

constexpr int DM = 1024, NB = 4, SEQ = 4096, CTXL = 256;
constexpr int RPB = SEQ + CTXL;
constexpr int R = NB * RPB;
constexpr float EPS = 1e-6f;
constexpr int NTHREADS = 512, NWAVES = 8;
constexpr int LDS_BYTES = 147456;

enum { I_X = 0, I_C, I_CTX, I_CCTX,
       I0_ADAW, I0_ADAB, I0_NMIX, I0_NFFN, I0_WIN, I0_QN, I0_WUQ, I0_KVN, I0_WUKV, I0_WO, I0_PWQ, I0_PK1, I0_PK2, I0_PU, I0_PV,
       I1_ADAW, I1_ADAB, I1_NMIX, I1_NFFN, I1_WQKV, I1_QN, I1_KN, I1_WO, I1_PWQ, I1_PK1, I1_PK2, I1_PU, I1_PV,
       I_NOUT, N_IN };

constexpr size_t MiB = 1u << 20;
constexpr size_t WS_CTL   = 0;
constexpr size_t WS_MOD   = 1 * MiB;
constexpr size_t WS_WIN   = 2 * MiB;
constexpr size_t WS_WUQ   = WS_WIN + 768 * 1024 * 2;
constexpr size_t WS_WUKV  = WS_WUQ + 1536 * 384 * 2;
constexpr size_t WS_WO0   = WS_WUKV + 2048 * 256 * 2;
constexpr size_t WS_WQ0   = WS_WO0 + 1024 * 1024 * 2;
constexpr size_t WS_KK0   = WS_WQ0 + 2048 * 1024 * 2;
constexpr size_t WS_WQKV  = WS_KK0 + 16 * 128 * 128 * 2;
constexpr size_t WS_WO1   = WS_WQKV + 1536 * 1024 * 2;
constexpr size_t WS_WQ1   = WS_WO1 + 1024 * 1024 * 2;
constexpr size_t WS_KK1   = WS_WQ1 + 2048 * 1024 * 2;
constexpr size_t WS_WEND  = WS_KK1 + 16 * 128 * 128 * 2;
static_assert(WS_WEND <= 24 * MiB, "weights region");
constexpr size_t WS_H     = 24 * MiB;
constexpr size_t WS_X     = WS_H + (size_t)R * 1024 * 2;
constexpr size_t WS_QKV   = WS_X + (size_t)R * 1024 * 4;
constexpr size_t WS_Q     = WS_QKV;
constexpr size_t WS_K     = WS_Q + (size_t)R * 1536 * 2;
constexpr size_t WS_V     = WS_K + (size_t)R * 1536 * 2;
constexpr size_t WS_S     = WS_QKV;
constexpr size_t WS_B     = WS_QKV + (size_t)R * 2048 * 4;
constexpr size_t WS_CQ    = WS_B;
constexpr size_t WS_CKV   = WS_CQ + (size_t)R * 384 * 2;
constexpr size_t WS_KR    = WS_CKV + (size_t)R * 256 * 2;
constexpr size_t WS_SSP   = WS_KR + (size_t)R * 64 * 2;
static_assert(WS_SSP + (size_t)R * 24 * 4 <= WS_B + 40 * MiB, "MLA latents inside region B");
constexpr size_t WS_O     = WS_B;
constexpr size_t WS_QP    = WS_B;
constexpr size_t WS_RAW1  = WS_B;
constexpr size_t WS_PK    = WS_B + (size_t)R * 2048 * 2;
constexpr size_t WS_TAB   = WS_PK + (size_t)R * 128 * 4;
constexpr size_t WS_PD    = WS_S;
constexpr size_t WS_WQ8   = WS_PD + (size_t)8 * R * 128 * 4;
constexpr size_t WS_WSC   = WS_WQ8 + (size_t)R * 128;
static_assert(WS_WSC + (size_t)R * 4 <= WS_B, "expert scratch inside the S region");
constexpr size_t WS_HQ    = WS_B + 40 * MiB;
constexpr size_t WS_HS    = WS_HQ + (size_t)R * 1024;
static_assert(WS_HS + (size_t)R * 4 <= WS_PK, "HQ inside region B");
constexpr size_t WS_TSC   = WS_TAB + (size_t)4 * 16384 * 1024;
constexpr size_t WS_END   = WS_TSC + (size_t)4 * 16384 * 4;
constexpr size_t WS_Q1    = WS_QKV;
constexpr size_t WS_K1    = WS_Q1 + (size_t)R * 1024 * 2;
constexpr size_t WS_V1    = WS_K1 + (size_t)R * 256 * 2;

#define XB_TMO      128
#define XB_XCNT(j)  (256  + 64 * (j))
#define XB_XSUB(j)  (1280 + 64 * (j))
#define XB_XGEN(j)  (2304 + 64 * (j))
#define XB_TOP      3328
#define XB_TOPGEN   3392
#define XCD_BAR_WORDS 3456
#define XB_SPIN_CAP (1u << 20)
__device__ __forceinline__ unsigned xb_ld(unsigned* p)              { return __hip_atomic_load(p, __ATOMIC_RELAXED, __HIP_MEMORY_SCOPE_AGENT); }
__device__ __forceinline__ unsigned xb_add(unsigned* p, unsigned v) { return __hip_atomic_fetch_add(p, v, __ATOMIC_RELAXED, __HIP_MEMORY_SCOPE_AGENT); }
__device__ __forceinline__ unsigned xb_xcc_id() { return (unsigned)__builtin_amdgcn_s_getreg((3 << 11) | 20) & 0xFu; }
#define XB_SPIN(cond, bar) do { unsigned _sp = 0; while (cond) { __builtin_amdgcn_s_sleep(1); \
    if ((++_sp & 255u) == 0u) { if (xb_ld(&(bar)[XB_TMO])) break; if (_sp > XB_SPIN_CAP) { atomicAdd(&(bar)[XB_TMO], 1u); break; } } } } while (0)
struct XcdBarrier { unsigned* bar; unsigned x; volatile LAS unsigned* st; };
__device__ __forceinline__ XcdBarrier xcd_barrier_post(unsigned* bar, volatile LAS unsigned* st) {
    XcdBarrier b; b.bar = bar; b.x = xb_xcc_id(); b.st = st;
    if (threadIdx.x == 0) (void)xb_add(&bar[XB_XCNT(b.x)], 1u);
    return b;
}
__device__ __forceinline__ void xcd_barrier_complete(unsigned* bar, unsigned x, unsigned& nloc, unsigned& nx) {
    const unsigned G = gridDim.x * gridDim.y * gridDim.z;
    unsigned sum, cnt, mine, sp = 0u;
    for (;;) {
        sum = 0u; cnt = 0u; mine = 0u;
#pragma unroll
        for (unsigned j = 0; j < 16; ++j) { const unsigned c = xb_ld(&bar[XB_XCNT(j)]); sum += c; cnt += (c > 0u) ? 1u : 0u; mine = (j == x) ? c : mine; }
        if (sum == G) break;
        __builtin_amdgcn_s_sleep(1);
        if ((++sp & 255u) == 0u) { if (xb_ld(&bar[XB_TMO])) break; if (sp > XB_SPIN_CAP) { atomicAdd(&bar[XB_TMO], 1u); break; } }
    }
    nloc = mine > 0u ? mine : 1u; nx = cnt > 0u ? cnt : 1u;
}
__device__ __forceinline__ void xcd_barrier(const XcdBarrier& b) {
    asm volatile("s_waitcnt vmcnt(0)" ::: "memory");
    __syncthreads();
    if (threadIdx.x == 0) {
        unsigned* bar = b.bar;
        __builtin_amdgcn_s_waitcnt(0);
        unsigned nloc = b.st[0], nx = b.st[1];
        if (nloc == 0u) { xcd_barrier_complete(bar, b.x, nloc, nx); b.st[0] = nloc; b.st[1] = nx; }
        const unsigned old = xb_add(&bar[XB_XSUB(b.x)], 1u);
        const unsigned gen = old / nloc;
        if (old + 1u == (gen + 1u) * nloc) {
            __builtin_amdgcn_fence(__ATOMIC_RELEASE, "agent");
            asm volatile("s_waitcnt vmcnt(0)" ::: "memory");
            const unsigned og = xb_add(&bar[XB_TOP], 1u);
            const unsigned tg = og / nx;
            if (og + 1u == (tg + 1u) * nx) xb_add(&bar[XB_TOPGEN], 1u);
            else XB_SPIN(xb_ld(&bar[XB_TOPGEN]) == tg, bar);
            __builtin_amdgcn_fence(__ATOMIC_ACQUIRE, "agent");
            xb_add(&bar[XB_XGEN(b.x)], 1u);
            asm volatile("s_waitcnt vmcnt(0)" ::: "memory");
        } else {
            XB_SPIN(xb_ld(&bar[XB_XGEN(b.x)]) == gen, bar);
            __builtin_amdgcn_fence(__ATOMIC_ACQUIRE, "agent");
            asm volatile("s_waitcnt vmcnt(0)" ::: "memory");
        }
    }
    __syncthreads();
}


struct Args { const float* in[N_IN]; float* out; unsigned char* ws; int ph_lo, ph_hi; };
static_assert(sizeof(Args) == (N_IN + 2) * 8 + 8, "Args has no padding");

struct Frame {
    const float* x; const float* ctx; float* out; unsigned char* ws; char* lds;
    int tid, lane, wave, bid, nblk, vcu;
};

__device__ __forceinline__ const float* xin_row(const Frame& F, int r) {
    const int b = r / RPB, j = r - b * RPB;
    return (j < CTXL) ? F.ctx + ((size_t)b * CTXL + j) * DM : F.x + ((size_t)b * SEQ + (j - CTXL)) * DM;
}
__device__ __forceinline__ int mod_index(int r) { const int b = r / RPB, j = r - b * RPB; return (j < CTXL) ? 4 : b; }
__device__ __forceinline__ bool is_ctx_row(int r) { return (r % RPB) < CTXL; }

__device__ __forceinline__ void p0_mod(const Args& A, const Frame& F) {
    float* sv = (float*)F.lds;
    float* red = sv + 5 * 1024;
    float* MOD = (float*)(F.ws + WS_MOD);
    bool have = false;
    for (int it = F.bid; it < 2 * 96; it += F.nblk) {
        if (!have) {
            for (int i = F.tid; i < 5 * 1024; i += NTHREADS) { const int m = i >> 10, k = i & 1023;
                const float c = (m < 4) ? A.in[I_C][m * 1024 + k] : A.in[I_CCTX][k]; sv[i] = c / (1.f + __expf(-c)); }
            __syncthreads(); have = true;
        }
        const int l = it / 96, n = (it % 96) * 64 + F.lane;
        const float* W = A.in[l ? I1_ADAW : I0_ADAW]; const float* Bv = A.in[l ? I1_ADAB : I0_ADAB];
        float acc[5] = {0.f, 0.f, 0.f, 0.f, 0.f};
        const int k0 = F.wave * 128;
#pragma unroll 16
        for (int k = k0; k < k0 + 128; ++k) { const float w = W[(size_t)k * 6144 + n];
#pragma unroll
            for (int m = 0; m < 5; ++m) acc[m] += sv[m * 1024 + k] * w; }
#pragma unroll
        for (int m = 0; m < 5; ++m) red[(F.wave * 5 + m) * 64 + F.lane] = acc[m];
        __syncthreads();
        if (F.tid < 320) { const int m = F.tid >> 6, ln = F.tid & 63; float s = 0.f;
#pragma unroll
            for (int w = 0; w < 8; ++w) s += red[(w * 5 + m) * 64 + ln];
            const int nn = (it % 96) * 64 + ln;
            MOD[((size_t)l * 5 + m) * 6144 + nn] = s + Bv[nn]; }
        __syncthreads();
    }
}
__device__ __forceinline__ void transpose_item(const float* W, int K, int N, bf16_t* WT, const float* gain, float* scr, int item, int lane) {
    const int nblk = N / 32, kb = item / nblk, nb = item % nblk, k0 = 64 * kb, n0 = 32 * nb;
#pragma unroll 8
    for (int i = 0; i < 32; ++i) { const int kk = 2 * i + (lane >> 5); float v = W[(size_t)(k0 + kk) * N + n0 + (lane & 31)]; if (gain) v *= gain[k0 + kk]; scr[kk * 33 + (lane & 31)] = v; }
    asm volatile("s_waitcnt lgkmcnt(0)" ::: "memory");
    const int c = lane & 7;
#pragma unroll
    for (int j = 0; j < 4; ++j) { const int n = (lane >> 3) + 8 * j; const float* s = scr + (8 * c) * 33 + n;
        u32x4 o; o.x = pk2(s[0 * 33], s[1 * 33]); o.y = pk2(s[2 * 33], s[3 * 33]); o.z = pk2(s[4 * 33], s[5 * 33]); o.w = pk2(s[6 * 33], s[7 * 33]);
        *(u32x4*)(WT + (size_t)(n0 + n) * K + k0 + 8 * c) = o; }
    asm volatile("s_waitcnt lgkmcnt(0)" ::: "memory");
}
__device__ __forceinline__ void p0_weights(const Args& A, const Frame& F) {
    float* scr = (float*)(F.lds + 32768) + F.wave * (64 * 33);
    const int gw = F.bid * NWAVES + F.wave, NGW = F.nblk * NWAVES;
#define TJOB(IN_, K_, N_, OFF_, GAIN_) do { const float* W = A.in[IN_]; bf16_t* WT = (bf16_t*)(F.ws + (OFF_)); \
        for (int it = gw; it < ((K_) / 64) * ((N_) / 32); it += NGW) transpose_item(W, K_, N_, WT, GAIN_, scr, it, F.lane); } while (0)
    TJOB(I0_WIN, 1024, 704, WS_WIN, nullptr); TJOB(I0_WUQ, 384, 1536, WS_WUQ, A.in[I0_QN]); TJOB(I0_WUKV, 256, 2048, WS_WUKV, A.in[I0_KVN]); TJOB(I0_WO, 1024, 1024, WS_WO0, nullptr);
    TJOB(I1_WQKV, 1024, 1536, WS_WQKV, nullptr); TJOB(I1_WO, 1024, 1024, WS_WO1, nullptr);
#undef TJOB
    { u32x4* z = (u32x4*)(F.ws + WS_WIN + (size_t)704 * 1024 * 2); const int n16 = 64 * 1024 * 2 / 16;
      for (int i = F.bid * NTHREADS + F.tid; i < n16; i += F.nblk * NTHREADS) z[i] = (u32x4){0u, 0u, 0u, 0u}; }
}
__device__ __forceinline__ void p0_weff(const Args& A, const Frame& F) {
    float* kkT = (float*)F.lds; float* wqs = kkT + 128 * 129;
    const int tid = F.tid, lane = F.lane, w = F.wave;
    for (int item = F.bid; item < 512; item += F.nblk) {
        const int layer = item >> 8, z = (item >> 4) & 15, kc = item & 15, h = z >> 1;
        const float* kk = ((z & 1) ? (layer ? A.in[I1_PK2] : A.in[I0_PK2]) : (layer ? A.in[I1_PK1] : A.in[I0_PK1])) + (size_t)h * 16384;
        const float* wq = (layer ? A.in[I1_PWQ] : A.in[I0_PWQ]) + (size_t)(kc * 64) * 2048 + z * 128;
        bf16_t* WT = (bf16_t*)(F.ws + (layer ? WS_WQ1 : WS_WQ0));
        __syncthreads();
        { f32x4 kv[8], wv4[4];
#pragma unroll
          for (int i = 0; i < 8; ++i) kv[i] = *(const f32x4*)(kk + 4 * (tid + i * NTHREADS));
#pragma unroll
          for (int i = 0; i < 4; ++i) { const int e = 4 * (tid + i * NTHREADS); wv4[i] = *(const f32x4*)(wq + (size_t)(e >> 7) * 2048 + (e & 127)); }
#pragma unroll
          for (int i = 0; i < 8; ++i) { const int e = 4 * (tid + i * NTHREADS), key = e >> 7, d = e & 127; kkT[d * 129 + key] = kv[i].x; kkT[(d + 1) * 129 + key] = kv[i].y; kkT[(d + 2) * 129 + key] = kv[i].z; kkT[(d + 3) * 129 + key] = kv[i].w; }
#pragma unroll
          for (int i = 0; i < 4; ++i) *(f32x4*)(wqs + 4 * (tid + i * NTHREADS)) = wv4[i]; }
        __syncthreads();
        float acc[8][2];
#pragma unroll
        for (int j = 0; j < 8; ++j) { acc[j][0] = 0.f; acc[j][1] = 0.f; }
#pragma unroll 2
        for (int d = 0; d < 128; ++d) { const float a0 = kkT[d * 129 + lane], a1 = kkT[d * 129 + lane + 64];
#pragma unroll
            for (int j = 0; j < 8; ++j) { const float wv = wqs[(w * 8 + j) * 128 + d]; acc[j][0] += wv * a0; acc[j][1] += wv * a1; } }
        u32x4 o0, o1;
        o0.x = pk2(acc[0][0], acc[1][0]); o0.y = pk2(acc[2][0], acc[3][0]); o0.z = pk2(acc[4][0], acc[5][0]); o0.w = pk2(acc[6][0], acc[7][0]);
        o1.x = pk2(acc[0][1], acc[1][1]); o1.y = pk2(acc[2][1], acc[3][1]); o1.z = pk2(acc[4][1], acc[5][1]); o1.w = pk2(acc[6][1], acc[7][1]);
        *(u32x4*)(WT + (size_t)(z * 128 + lane) * 1024 + kc * 64 + w * 8) = o0;
        *(u32x4*)(WT + (size_t)(z * 128 + lane + 64) * 1024 + kc * 64 + w * 8) = o1;
    }
    __syncthreads();
}

__device__ __forceinline__ void p0_tables(const Args& A, const Frame& F) {
    const int gw = F.bid * NWAVES + F.wave, NGW = F.nblk * NWAVES, lane = F.lane;
    unsigned char* TAB = F.ws + WS_TAB; float* TSC = (float*)(F.ws + WS_TSC);
    for (int it = gw; it < 4 * 16384 / 4; it += NGW) {
        const int t = it >> 12, row0 = (it & 4095) * 4;
        const float* src = (t == 0 ? A.in[I0_PU] : t == 1 ? A.in[I0_PV] : t == 2 ? A.in[I1_PU] : A.in[I1_PV]) + (size_t)row0 * 1024 + 4 * lane;
        f32x4 v[4][4];
#pragma unroll
        for (int rr = 0; rr < 4; ++rr)
#pragma unroll
            for (int j = 0; j < 4; ++j) v[rr][j] = *(const f32x4*)(src + (size_t)rr * 1024 + 256 * j);
#pragma unroll
        for (int rr = 0; rr < 4; ++rr) {
            float am = 0.f;
#pragma unroll
            for (int j = 0; j < 4; ++j) am = fmaxf(am, fmaxf(fmaxf(fabsf(v[rr][j].x), fabsf(v[rr][j].y)), fmaxf(fabsf(v[rr][j].z), fabsf(v[rr][j].w))));
            am = wave_max(am);
            const float sc = am > 0.f ? am * (1.f / 127.f) : 1.f, inv = am > 0.f ? 127.f / am : 0.f;
            const int row = row0 + rr;
#pragma unroll
            for (int j = 0; j < 4; ++j) { const unsigned b0 = (unsigned)((int)rintf(v[rr][j].x * inv)) & 0xffu, b1 = (unsigned)((int)rintf(v[rr][j].y * inv)) & 0xffu, b2 = (unsigned)((int)rintf(v[rr][j].z * inv)) & 0xffu, b3 = (unsigned)((int)rintf(v[rr][j].w * inv)) & 0xffu;
                *(unsigned*)(TAB + (((size_t)t * 8 + 2 * j + (lane >> 5)) * 16384 + row) * 128 + 4 * (lane & 31)) = b0 | (b1 << 8) | (b2 << 16) | (b3 << 24); }
            if (lane == 0) TSC[t * 16384 + row] = sc;
        }
    }
}

__device__ __forceinline__ void norm_mod_store(const f32x4 (&v)[4], float rinv, const float* g, const float* sh, const float* sc, bf16_t* orow, int lane) {
#pragma unroll
    for (int j = 0; j < 4; ++j) { const int c = 4 * lane + 256 * j;
        const f32x4 gg = *(const f32x4*)(g + c), s1 = *(const f32x4*)(sc + c), s0 = *(const f32x4*)(sh + c);
        const f32x4 y = (v[j] * rinv * gg) * (s1 + 1.f) + s0;
        u32x2 o; o.x = pk2(y.x, y.y); o.y = pk2(y.z, y.w); *(u32x2*)(orow + c) = o; }
}
__device__ __forceinline__ int tok_row(int layer, int n);
__device__ __forceinline__ void norm_row_out(const Frame& F, const f32x4 (&v)[4], float rinv, const float* g, const float* mm, int r, int which) {
    norm_mod_store(v, rinv, g, mm, mm + 1024, (bf16_t*)(F.ws + WS_H) + (size_t)r * DM, F.lane);
    if (which) {
        f32x4 y[4]; float am = 0.f;
#pragma unroll
        for (int j = 0; j < 4; ++j) { const int c = 4 * F.lane + 256 * j; y[j] = (v[j] * rinv * *(const f32x4*)(g + c)) * (*(const f32x4*)(mm + 1024 + c) + 1.f) + *(const f32x4*)(mm + c);
            am = fmaxf(am, fmaxf(fmaxf(fabsf(y[j].x), fabsf(y[j].y)), fmaxf(fabsf(y[j].z), fabsf(y[j].w)))); }
        am = wave_max(am);
        const float inv = am > 0.f ? 127.f / am : 0.f;
#pragma unroll
        for (int j = 0; j < 4; ++j) { const unsigned b0 = (unsigned)((int)rintf(y[j].x * inv)) & 0xffu, b1 = (unsigned)((int)rintf(y[j].y * inv)) & 0xffu, b2 = (unsigned)((int)rintf(y[j].z * inv)) & 0xffu, b3 = (unsigned)((int)rintf(y[j].w * inv)) & 0xffu;
            *(unsigned*)(F.ws + WS_HQ + (size_t)r * DM + 4 * F.lane + 256 * j) = b0 | (b1 << 8) | (b2 << 16) | (b3 << 24); }
        if (F.lane == 0) ((float*)(F.ws + WS_HS))[r] = am > 0.f ? am * (1.f / 127.f) : 1.f;
    }
}
__device__ __forceinline__ void p_norm_rows(const Args& A, const Frame& F, int layer, int which, bool from_input, bool skip_ctx) {
    const int gw = F.bid * NWAVES + F.wave, NGW = F.nblk * NWAVES;
    const float* g = A.in[layer ? (which ? I1_NFFN : I1_NMIX) : (which ? I0_NFFN : I0_NMIX)];
    const float* MOD = (const float*)(F.ws + WS_MOD) + (size_t)layer * 5 * 6144;
    const float* X = (const float*)(F.ws + WS_X);
    const int ntok = skip_ctx ? NB * SEQ : R;
    for (int n = gw; n < ntok; n += 2 * NGW) {
        const bool has1 = (n + NGW) < ntok;
        const int r0 = skip_ctx ? tok_row(1, n) : n, r1 = has1 ? (skip_ctx ? tok_row(1, n + NGW) : n + NGW) : r0;
        const float* x0 = from_input ? xin_row(F, r0) : X + (size_t)r0 * DM; const float* x1 = from_input ? xin_row(F, r1) : X + (size_t)r1 * DM;
        f32x4 v0[4], v1[4]; float s0 = 0.f, s1 = 0.f;
#pragma unroll
        for (int j = 0; j < 4; ++j) { v0[j] = *(const f32x4*)(x0 + 4 * F.lane + 256 * j); v1[j] = *(const f32x4*)(x1 + 4 * F.lane + 256 * j); }
#pragma unroll
        for (int j = 0; j < 4; ++j) { s0 += (v0[j].x * v0[j].x + v0[j].y * v0[j].y) + (v0[j].z * v0[j].z + v0[j].w * v0[j].w); s1 += (v1[j].x * v1[j].x + v1[j].y * v1[j].y) + (v1[j].z * v1[j].z + v1[j].w * v1[j].w); }
        const float ri0 = rsqrtf(wave_sum(s0) * (1.f / DM) + EPS), ri1 = rsqrtf(wave_sum(s1) * (1.f / DM) + EPS);
        norm_row_out(F, v0, ri0, g, MOD + (size_t)mod_index(r0) * 6144 + (which ? 3 * 1024 : 0), r0, which);
        if (has1) norm_row_out(F, v1, ri1, g, MOD + (size_t)mod_index(r1) * 6144 + (which ? 3 * 1024 : 0), r1, which);
    }
}

namespace pg8 {
#define PG8_LAS __attribute__((address_space(3)))
typedef unsigned short bf16_t;
typedef short bf16x8 __attribute__((ext_vector_type(8)));
typedef float f32x4 __attribute__((ext_vector_type(4)));
typedef unsigned u32x4 __attribute__((ext_vector_type(4)));
constexpr int BM = 256, BK = 64, HALF = 128, HTB = HALF * BK * 2  , STAGE_BYTES = 8 * HTB, NXCD = 8, WGM = 8;

__host__ __device__ __forceinline__ int lds_byte(int r, int c) { const int st = (r >> 4) * 2 + (c >> 5), rr = r & 15, cc = c & 31, ob = rr * 64 + cc * 2; return st * 1024 + (ob ^ (((ob >> 9) & 1) << 5)); }
__host__ __device__ __forceinline__ void stage_rc(int b, int& R, int& C) { const int st = b / 1024, sb = b % 1024, swz = sb ^ (((sb >> 9) & 1) << 5); R = (st >> 1) * 16 + swz / 64; C = (st & 1) * 32 + (swz % 64) / 2; }
__host__ __device__ __forceinline__ int perm32(int rho) { const int n = rho >> 4, i = rho & 15; return 8 * (i >> 2) + 4 * n + (i & 3); }

struct Unit { int pm, pn; };
struct Gemm { const bf16_t* A; const bf16_t* Bt; int M, N, K; };

struct StaticOrder {
    int nM, nN, nwg, G, c;
    __host__ __device__ void init(int M, int N, int G_, int c_) { nM = M / BM; nN = N / BM; nwg = nM * nN; G = G_; c = c_; }
    __host__ __device__ bool next(int i, Unit& u) const {
        const long L = (long)i * G + c; if (L >= nwg) return false;
        int wgid = (int)L; { const int q = nwg / NXCD, r = nwg % NXCD, xcd = wgid % NXCD, off = wgid / NXCD; wgid = (xcd < r ? xcd * (q + 1) : r * (q + 1) + (xcd - r) * q) + off; }
        const int nig = WGM * nN, gid = wgid / nig, fm = gid * WGM, gsz = (nM - fm) < WGM ? (nM - fm) : WGM;
        u.pm = fm + ((wgid % nig) % gsz); u.pn = (wgid % nig) / gsz; return true;
    }
    __device__ __forceinline__ void a_ready(const Unit&) const {}
    __device__ __forceinline__ void done(const Unit&) const {}
};

template <class Epi, class Sched, bool ALIGN_EPI = false, bool SP2 = false>
__device__ __forceinline__ void gemm_phase(PG8_LAS unsigned char* lds, const Gemm g, const Sched& S, const Epi& E) {
    const int tid = threadIdx.x, wid = __builtin_amdgcn_readfirstlane(tid >> 6), lane = tid & 63, wr = wid >> 2, wc = wid & 3, fr = lane & 15, fq = lane >> 4;
    const int K = g.K, nt = K / BK;
    unsigned voffA[2], voffB[2];
#pragma unroll
    for (int i = 0; i < 2; ++i) { int R, C; stage_rc(tid * 16 + i * 8192, R, C); const int Rb = Epi::PERM ? ((R & ~31) + perm32(R & 31)) : R;
        voffA[i] = (unsigned)(R * K + C) * 2u; voffB[i] = (unsigned)(Rb * K + C) * 2u; }
    const size_t kstep = (size_t)(BK * 2);
    const size_t hstep = (size_t)HALF * K * 2;
    const size_t tstep = 2 * hstep;
    const unsigned ldsw = (unsigned)wid * 1024u;
    const int aoff = lds_byte(wr * 64 + fr, fq * 8), boff = lds_byte(wc * 32 + fr, fq * 8);
#define PG8_SA(b, h) (((b) * 2 + (h)) * HTB)
#define PG8_SB(b, h) ((4 + (b) * 2 + (h)) * HTB)
#define PG8_STAGE(bufoff, gbase, voff) do { _Pragma("unroll") for (int _i = 0; _i < 2; ++_i) \
        __builtin_amdgcn_global_load_lds((const unsigned*)((const char*)(gbase) + (voff)[_i]), (PG8_LAS unsigned*)(lds + (bufoff) + ldsw + _i * 8192), 16, 0, 0); } while (0)
#define PG8_LDA(dst, b, h) do { _Pragma("unroll") for (int m = 0; m < 4; ++m) _Pragma("unroll") for (int k = 0; k < 2; ++k) dst[m][k] = *(const PG8_LAS bf16x8*)(lds + PG8_SA(b, h) + aoff + m * 2048 + k * 1024); } while (0)
#define PG8_LDB(dst, b, h) do { _Pragma("unroll") for (int n = 0; n < 2; ++n) _Pragma("unroll") for (int k = 0; k < 2; ++k) dst[n][k] = *(const PG8_LAS bf16x8*)(lds + PG8_SB(b, h) + boff + n * 2048 + k * 1024); } while (0)
#define PG8_MMA(ai, bj, At, Bt) do { __builtin_amdgcn_s_setprio(1); _Pragma("unroll") for (int m = 0; m < 4; ++m) _Pragma("unroll") for (int n = 0; n < 2; ++n) _Pragma("unroll") for (int k = 0; k < 2; ++k) \
        acc[ai][bj][m][n] = __builtin_amdgcn_mfma_f32_16x16x32_bf16(Bt[n][k], At[m][k], acc[ai][bj][m][n], 0, 0, 0); __builtin_amdgcn_s_setprio(0); } while (0)
#define PG8_WAIT_V(n) asm volatile("s_waitcnt vmcnt(" #n ")" ::: "memory")
#define PG8_WAIT_L(n) asm volatile("s_waitcnt lgkmcnt(" #n ")" ::: "memory")
#define PG8_BAR __builtin_amdgcn_s_barrier()
#define PG8_SCHED __builtin_amdgcn_sched_barrier(0)
    Unit cur, nxt; int ui = 0;
    if (!S.next(0, cur)) return;
    f32x4 acc[2][2][4][2];
#pragma unroll
    for (int a = 0; a < 2; ++a)
#pragma unroll
        for (int b = 0; b < 2; ++b)
#pragma unroll
            for (int m = 0; m < 4; ++m)
#pragma unroll
                for (int n = 0; n < 2; ++n) acc[a][b][m][n] = (f32x4){0.f, 0.f, 0.f, 0.f};
    bf16x8 At[4][2], B0[2][2], B1[2][2];
    const char* cA = (const char*)g.A + (size_t)cur.pm * tstep; const char* cB = (const char*)g.Bt + (size_t)cur.pn * tstep;
    S.a_ready(cur);
    if constexpr (SP2) {
        PG8_STAGE(PG8_SB(0, 0), cB, voffB); PG8_STAGE(PG8_SB(0, 1), cB + hstep, voffB); PG8_STAGE(PG8_SA(0, 0), cA, voffA); PG8_STAGE(PG8_SA(0, 1), cA + hstep, voffA);
        if (wr == 1) PG8_BAR;
        PG8_WAIT_V(2); PG8_BAR;
        PG8_STAGE(PG8_SB(1, 0), cB + kstep, voffB); PG8_STAGE(PG8_SA(1, 0), cA + kstep, voffA); PG8_STAGE(PG8_SB(1, 1), cB + hstep + kstep, voffB);
        PG8_WAIT_V(6); PG8_BAR;
    } else {
        PG8_STAGE(PG8_SB(0, 0), cB, voffB); PG8_STAGE(PG8_SA(0, 0), cA, voffA); PG8_STAGE(PG8_SB(0, 1), cB + hstep, voffB); PG8_STAGE(PG8_SA(0, 1), cA + hstep, voffA);
        if (wr == 1) PG8_BAR;
        PG8_WAIT_V(4); PG8_BAR;
        PG8_STAGE(PG8_SB(1, 0), cB + kstep, voffB); PG8_STAGE(PG8_SA(1, 0), cA + kstep, voffA); PG8_STAGE(PG8_SB(1, 1), cB + hstep + kstep, voffB);
        PG8_WAIT_V(6); PG8_BAR;
    }
    for (;;) {
        const bool has_next = S.next(ui + 1, nxt);
        const char* nA = has_next ? (const char*)g.A + (size_t)nxt.pm * tstep : cA; const char* nB = has_next ? (const char*)g.Bt + (size_t)nxt.pn * tstep : cB;
        for (int t = 0; t < nt; t += 2) {
            const bool last = (t == nt - 2);
            const char* a1 = cA + (size_t)(t + 1) * kstep;
            const char* a2 = last ? nA : cA + (size_t)(t + 2) * kstep; const char* b2 = last ? nB : cB + (size_t)(t + 2) * kstep;
            const char* a3 = a2 + kstep; const char* b3 = b2 + kstep;
            if (last && has_next) S.a_ready(nxt);
            if constexpr (SP2) {
            PG8_LDB(B0, 0, 0); PG8_LDB(B1, 0, 1); PG8_SCHED; PG8_LDA(At, 0, 0); PG8_STAGE(PG8_SA(1, 1), a1 + hstep, voffA);
            PG8_WAIT_V(8); PG8_WAIT_L(0); PG8_BAR; PG8_MMA(0, 0, At, B0); PG8_MMA(0, 1, At, B1); PG8_BAR; PG8_SCHED;
            PG8_LDA(At, 0, 1); PG8_STAGE(PG8_SB(0, 0), b2, voffB); PG8_STAGE(PG8_SB(0, 1), b2 + hstep, voffB); PG8_STAGE(PG8_SA(0, 0), a2, voffA);
            PG8_WAIT_V(8); PG8_WAIT_L(0); PG8_BAR; PG8_MMA(1, 0, At, B0); PG8_MMA(1, 1, At, B1); PG8_BAR; PG8_SCHED;
            PG8_LDB(B0, 1, 0); PG8_LDB(B1, 1, 1); PG8_SCHED; PG8_LDA(At, 1, 0); PG8_STAGE(PG8_SA(0, 1), a2 + hstep, voffA);
            PG8_WAIT_V(8); PG8_WAIT_L(0); PG8_BAR; PG8_MMA(0, 0, At, B0); PG8_MMA(0, 1, At, B1); PG8_BAR; PG8_SCHED;
            PG8_LDA(At, 1, 1); PG8_STAGE(PG8_SB(1, 0), b3, voffB); PG8_STAGE(PG8_SB(1, 1), b3 + hstep, voffB); PG8_STAGE(PG8_SA(1, 0), a3, voffA);
            PG8_WAIT_V(8); PG8_WAIT_L(0); PG8_BAR; PG8_MMA(1, 0, At, B0); PG8_MMA(1, 1, At, B1); PG8_BAR; PG8_SCHED;
            } else {
            PG8_LDB(B0, 0, 0); PG8_SCHED; PG8_LDA(At, 0, 0); PG8_STAGE(PG8_SA(1, 1), a1 + hstep, voffA);
            PG8_WAIT_L(8); PG8_BAR; PG8_WAIT_L(0); PG8_MMA(0, 0, At, B0); PG8_BAR; PG8_SCHED;
            PG8_LDB(B1, 0, 1); PG8_STAGE(PG8_SB(0, 0), b2, voffB);
            PG8_BAR; PG8_WAIT_L(0); PG8_MMA(0, 1, At, B1); PG8_BAR;
            PG8_LDA(At, 0, 1); PG8_STAGE(PG8_SA(0, 0), a2, voffA);
            PG8_BAR; PG8_WAIT_L(0); PG8_MMA(1, 0, At, B0); PG8_BAR; PG8_SCHED;
            PG8_STAGE(PG8_SB(0, 1), b2 + hstep, voffB);
            PG8_WAIT_V(6); PG8_BAR; PG8_MMA(1, 1, At, B1); PG8_BAR;
            PG8_LDB(B0, 1, 0); PG8_SCHED; PG8_LDA(At, 1, 0); PG8_STAGE(PG8_SA(0, 1), a2 + hstep, voffA);
            PG8_WAIT_L(8); PG8_BAR; PG8_WAIT_L(0); PG8_MMA(0, 0, At, B0); PG8_BAR; PG8_SCHED;
            PG8_LDB(B1, 1, 1); PG8_STAGE(PG8_SB(1, 0), b3, voffB);
            PG8_BAR; PG8_WAIT_L(0); PG8_MMA(0, 1, At, B1); PG8_BAR;
            PG8_LDA(At, 1, 1); PG8_STAGE(PG8_SA(1, 0), a3, voffA);
            PG8_BAR; PG8_WAIT_L(0); PG8_MMA(1, 0, At, B0); PG8_BAR; PG8_SCHED;
            PG8_STAGE(PG8_SB(1, 1), b3 + hstep, voffB);
            PG8_WAIT_V(6); PG8_BAR; PG8_MMA(1, 1, At, B1); PG8_BAR;
            }
        }
        if constexpr (ALIGN_EPI) { if (wr == 0) PG8_BAR; }
        if constexpr (!Epi::AFTER_DRAIN) { E(acc, cur, wr, wc, fr, fq); S.done(cur); }
        if (!has_next) break;
#pragma unroll
        for (int a = 0; a < 2; ++a)
#pragma unroll
            for (int b = 0; b < 2; ++b)
#pragma unroll
                for (int m = 0; m < 4; ++m)
#pragma unroll
                    for (int n = 0; n < 2; ++n) acc[a][b][m][n] = (f32x4){0.f, 0.f, 0.f, 0.f};
        cur = nxt; cA = nA; cB = nB; ++ui;
        if constexpr (ALIGN_EPI) { if (wr == 1) PG8_BAR; }
    }
    PG8_WAIT_V(0);
    if constexpr (!ALIGN_EPI) { if (wr == 0) PG8_BAR; }
    PG8_BAR;
    if constexpr (Epi::AFTER_DRAIN) { E.fused(acc, cur, wr, wc, fr, fq, lds, wid, lane); S.done(cur); }
#undef PG8_SA
#undef PG8_SB
#undef PG8_STAGE
#undef PG8_LDA
#undef PG8_LDB
#undef PG8_MMA
#undef PG8_WAIT_V
#undef PG8_WAIT_L
#undef PG8_BAR
#undef PG8_SCHED
}
}

template <class Inner> struct EpiTile { static constexpr bool PERM = true, AFTER_DRAIN = false; Inner in;
    __device__ __forceinline__ void operator()(const pg8::f32x4 (&acc)[2][2][4][2], const pg8::Unit& u, int wr, int wc, int fr, int fq) const {
#pragma unroll
        for (int ai = 0; ai < 2; ++ai)
#pragma unroll
            for (int m = 0; m < 4; ++m) { const int row = u.pm * 256 + ai * 128 + wr * 64 + m * 16 + fr;
#pragma unroll
                for (int bj = 0; bj < 2; ++bj) in(row, u.pn * 256 + bj * 128 + wc * 32 + 8 * fq, acc[ai][bj][m][0], acc[ai][bj][m][1]); }
    } };
struct In8Bf16 { bf16_t* C; int ldc;
    __device__ __forceinline__ void operator()(int row, int col, f32x4 a, f32x4 b) const { u32x4 o; o.x = cvtpk(a.x, a.y); o.y = cvtpk(a.z, a.w); o.z = cvtpk(b.x, b.y); o.w = cvtpk(b.z, b.w); *(u32x4*)(C + (size_t)row * ldc + col) = o; } };
struct In8KV { bf16_t* Kb; bf16_t* Vb;
    __device__ __forceinline__ void operator()(int row, int col, f32x4 a, f32x4 b) const { const int h = col >> 8, c = col & 255; u32x4 o; o.x = cvtpk(a.x, a.y); o.y = cvtpk(a.z, a.w); o.z = cvtpk(b.x, b.y); o.w = cvtpk(b.z, b.w);
        bf16_t* p = (c < 128) ? Kb + (size_t)row * 1536 + h * 192 + c : Vb + (size_t)row * 1024 + h * 128 + (c - 128);
        *(u32x4*)p = o; } };
typedef _Float16 f16x2_t __attribute__((ext_vector_type(2)));
__device__ __forceinline__ unsigned pkh2(float lo, float hi) { f32x2 v = {lo, hi}; return __builtin_bit_cast(unsigned, __builtin_convertvector(v, f16x2_t)); }
struct In8F16 { unsigned short* C; int ldc;
    __device__ __forceinline__ void operator()(int row, int col, f32x4 a, f32x4 b) const { u32x4 o; o.x = pkh2(a.x, a.y); o.y = pkh2(a.z, a.w); o.z = pkh2(b.x, b.y); o.w = pkh2(b.z, b.w); *(u32x4*)(C + (size_t)row * ldc + col) = o; } };
struct In8F32 { float* C; int ldc;
    __device__ __forceinline__ void operator()(int row, int col, f32x4 a, f32x4 b) const { float* p = C + (size_t)row * ldc + col; *(f32x4*)p = a; *(f32x4*)(p + 4) = b; } };
struct In8Resid { const float* x; const float* ctx; float* X; const float* gate; bool from_input;
    __device__ __forceinline__ void operator()(int row, int col, f32x4 a, f32x4 b) const {
        const int bb = row / RPB, j = row - bb * RPB; float* xo = X + (size_t)row * DM + col;
        const float* xi = !from_input ? xo : ((j < CTXL) ? ctx + ((size_t)bb * CTXL + j) * DM : x + ((size_t)bb * SEQ + (j - CTXL)) * DM) + col;
        const float* g = gate + (size_t)((j < CTXL) ? 4 : bb) * 6144 + col;
        *(f32x4*)xo = *(const f32x4*)xi + *(const f32x4*)g * a; *(f32x4*)(xo + 4) = *(const f32x4*)(xi + 4) + *(const f32x4*)(g + 4) * b; } };
struct EpiMlaDown { static constexpr bool PERM = true, AFTER_DRAIN = false; bf16_t* CQ; bf16_t* CKV; bf16_t* KR; float* SSP;
    __device__ __forceinline__ void operator()(const pg8::f32x4 (&acc)[2][2][4][2], const pg8::Unit& u, int wr, int wc, int fr, int fq) const {
#pragma unroll
        for (int ai = 0; ai < 2; ++ai)
#pragma unroll
            for (int m = 0; m < 4; ++m) { const int row = u.pm * 256 + ai * 128 + wr * 64 + m * 16 + fr;
#pragma unroll
                for (int bj = 0; bj < 2; ++bj) { const int col = u.pn * 256 + bj * 128 + wc * 32 + 8 * fq; const f32x4 a = acc[ai][bj][m][0], b = acc[ai][bj][m][1];
                    u32x4 o; o.x = cvtpk(a.x, a.y); o.y = cvtpk(a.z, a.w); o.z = cvtpk(b.x, b.y); o.w = cvtpk(b.z, b.w);
                    const int cls = (u.pn * 2 + bj);
                    if (cls < 5) { float sq = (a.x * a.x + a.y * a.y) + (a.z * a.z + a.w * a.w) + (b.x * b.x + b.y * b.y) + (b.z * b.z + b.w * b.w);
                        sq += __shfl_xor(sq, 16); sq += __shfl_xor(sq, 32);
                        if (cls < 3) *(u32x4*)(CQ + (size_t)row * 384 + col) = o; else *(u32x4*)(CKV + (size_t)row * 256 + (col - 384)) = o;
                        if (fq == 0) SSP[(size_t)row * 24 + cls * 4 + wc] = sq; }
                    else if (col < 704) *(u32x4*)(KR + (size_t)row * 64 + (col - 640)) = o; } }
    } };
struct In8Bf16Rs { bf16_t* C; int ldc; const float* ssp;
    __device__ __forceinline__ void operator()(int row, int col, f32x4 a, f32x4 b) const { const f32x4 s0 = *(const f32x4*)(ssp + (size_t)row * 24), s1 = *(const f32x4*)(ssp + (size_t)row * 24 + 4), s2 = *(const f32x4*)(ssp + (size_t)row * 24 + 8);
        const float ssum = (((s0.x + s0.y) + (s0.z + s0.w)) + ((s1.x + s1.y) + (s1.z + s1.w))) + ((s2.x + s2.y) + (s2.z + s2.w));
        const float rs = rsqrtf(ssum * (1.f / 384.f) + EPS); a *= rs; b *= rs;
        u32x4 o; o.x = cvtpk(a.x, a.y); o.y = cvtpk(a.z, a.w); o.z = cvtpk(b.x, b.y); o.w = cvtpk(b.z, b.w); *(u32x4*)(C + (size_t)row * ldc + col) = o; } };
struct In8KVRs { bf16_t* Kb; bf16_t* Vb; const float* ssp;
    __device__ __forceinline__ void operator()(int row, int col, f32x4 a, f32x4 b) const { const f32x4 s0 = *(const f32x4*)(ssp + (size_t)row * 24 + 12), s1 = *(const f32x4*)(ssp + (size_t)row * 24 + 16);
        const float ssum = ((s0.x + s0.y) + (s0.z + s0.w)) + ((s1.x + s1.y) + (s1.z + s1.w));
        const float rs = rsqrtf(ssum * (1.f / 256.f) + EPS); a *= rs; b *= rs;
        const int h = col >> 8, c = col & 255; u32x4 o; o.x = cvtpk(a.x, a.y); o.y = cvtpk(a.z, a.w); o.z = cvtpk(b.x, b.y); o.w = cvtpk(b.z, b.w);
        bf16_t* p = (c < 128) ? Kb + (size_t)row * 1536 + h * 192 + c : Vb + (size_t)row * 1024 + h * 128 + (c - 128);
        *(u32x4*)p = o; } };
struct RowSched { pg8::StaticOrder so; bool latent_only;
    __device__ __forceinline__ void init(int N, int G, int c, bool lat) { latent_only = lat; so.init(lat ? NB * SEQ : R, N, G, c); }
    __device__ __forceinline__ bool next(int i, pg8::Unit& u) const { if (!so.next(i, u)) return false; if (latent_only) u.pm = (u.pm >> 4) * 17 + 1 + (u.pm & 15); return true; }
    __device__ __forceinline__ void a_ready(const pg8::Unit&) const {}
    __device__ __forceinline__ void done(const pg8::Unit&) const {} };
template <class Inner> __device__ __forceinline__ void gemm8(const Frame& F, const bf16_t* Ap, const bf16_t* Bt, int N, int K, bool latent_only, const Inner& in) {
    asm volatile("" : "+s"(K));
    pg8::Gemm g{Ap, Bt, R, N, K}; RowSched S; S.init(N, F.nblk, F.bid, latent_only);
    EpiTile<Inner> E{in};
    pg8::gemm_phase<EpiTile<Inner>, RowSched, true, true>((PG8_LAS unsigned char*)F.lds, g, S, E);
}

template <class Epi> __device__ __forceinline__ void gemm8e(const Frame& F, const bf16_t* Ap, const bf16_t* Bt, int N, int K, bool latent_only, const Epi& E) {
    asm volatile("" : "+s"(K));
    pg8::Gemm g{Ap, Bt, R, N, K}; RowSched S; S.init(N, F.nblk, F.bid, latent_only);
    pg8::gemm_phase<Epi, RowSched, true, true>((PG8_LAS unsigned char*)F.lds, g, S, E);
}

struct GemmDesc { const bf16_t* A; int lda; long sA; const bf16_t* Bt; int ldb; long sB; int M, N, K, nz; };
template <class Epi>
__device__ __forceinline__ void gemm_simple(const Frame& F, const GemmDesc& g, const Epi& epi, bool skip_ctx) {
    const int wm = F.wave >> 1, wn = F.wave & 1, fr = F.lane & 15, fq = F.lane >> 4;
    const int tM = g.M / 128, tN = g.N / 128, per = tM * tN, total = per * g.nz;
    for (int u = F.bid; u < total; u += F.nblk) {
        const int z = u / per, uu = u - z * per, tm = uu / tN, tn = uu - tm * tN;
        if (skip_ctx && ((tm * 128) % RPB) < CTXL) continue;
        const int row0 = tm * 128 + wm * 32, col0 = tn * 128 + wn * 64;
        const bf16_t* ap = g.A + z * g.sA + (size_t)(row0 + fr) * g.lda + fq * 8;
        const bf16_t* bp = g.Bt + z * g.sB + (size_t)(col0 + fr) * g.ldb + fq * 8;
        f32x4 acc[2][4];
#pragma unroll
        for (int mi = 0; mi < 2; ++mi)
#pragma unroll
            for (int ni = 0; ni < 4; ++ni) acc[mi][ni] = (f32x4){0.f, 0.f, 0.f, 0.f};
        for (int k0 = 0; k0 < g.K; k0 += 32) {
            bf16x8 a[2], b[4];
#pragma unroll
            for (int mi = 0; mi < 2; ++mi) a[mi] = *(const bf16x8*)(ap + (size_t)mi * 16 * g.lda + k0);
#pragma unroll
            for (int ni = 0; ni < 4; ++ni) b[ni] = *(const bf16x8*)(bp + (size_t)ni * 16 * g.ldb + k0);
#pragma unroll
            for (int mi = 0; mi < 2; ++mi)
#pragma unroll
                for (int ni = 0; ni < 4; ++ni) acc[mi][ni] = __builtin_amdgcn_mfma_f32_16x16x32_bf16(b[ni], a[mi], acc[mi][ni], 0, 0, 0);
        }
#pragma unroll
        for (int mi = 0; mi < 2; ++mi)
#pragma unroll
            for (int ni = 0; ni < 4; ++ni) epi(z, row0 + mi * 16 + fr, col0 + ni * 16 + fq * 4, acc[mi][ni]);
    }
}
struct EpiBf16 { bf16_t* C; int ldc;
    __device__ __forceinline__ void operator()(int, int row, int col, f32x4 v) const { u32x2 o; o.x = pk2(v.x, v.y); o.y = pk2(v.z, v.w); *(u32x2*)(C + (size_t)row * ldc + col) = o; } };
struct EpiKV { bf16_t* Kb; bf16_t* Vb;
    __device__ __forceinline__ void operator()(int, int row, int col, f32x4 v) const { const int h = col >> 8, c = col & 255; u32x2 o; o.x = pk2(v.x, v.y); o.y = pk2(v.z, v.w);
        if (c < 128) *(u32x2*)(Kb + (size_t)row * 1536 + h * 192 + c) = o; else *(u32x2*)(Vb + (size_t)row * 1024 + h * 128 + (c - 128)) = o; } };
struct EpiF32Z { float* C; int ldc;
    __device__ __forceinline__ void operator()(int z, int row, int col, f32x4 v) const { *(f32x4*)(C + (size_t)row * ldc + z * 128 + col) = v; } };
struct EpiResid { const Frame* F; const float* gate; bool from_input;
    __device__ __forceinline__ void operator()(int, int row, int col, f32x4 v) const {
        float* X = (float*)(F->ws + WS_X) + (size_t)row * DM + col;
        const float* xi = from_input ? xin_row(*F, row) + col : X;
        const f32x4 g = *(const f32x4*)(gate + (size_t)mod_index(row) * 6144 + col);
        *(f32x4*)X = *(const f32x4*)xi + g * v; } };

__device__ __forceinline__ void rope_angles(int r, int& prow, int& pcol) { const int t = (r % RPB) - CTXL; prow = t >> 6; pcol = t & 63; }
__device__ __forceinline__ void p_mla_krope(const Args& A, const Frame& F) {
    const int gw = F.bid * NWAVES + F.wave, NGW = F.nblk * NWAVES, lane = F.lane;
    const bf16_t* KR = (const bf16_t*)(F.ws + WS_KR); bf16_t* Kb = (bf16_t*)(F.ws + WS_K);
    const float invf = __powf(10000.f, -(float)(lane & 15) * (1.f / 16.f));
    for (int r = gw; r < R; r += NGW) {
        float kr = bf2f(KR[(size_t)r * 64 + lane]);
        if (!is_ctx_row(r)) {
            int prow, pcol; rope_angles(r, prow, pcol);
            const float ang = (float)((lane & 32) ? pcol : prow) * invf;
            const float cs = cosf(ang), sn = sinf(ang);
            const float partner = __shfl_xor(kr, 16);
            kr = kr * cs + ((lane & 16) ? partner : -partner) * sn;
        }
        const bf16_t kb = (bf16_t)f2bf(kr);
#pragma unroll
        for (int h = 0; h < 8; ++h) Kb[(size_t)r * 1536 + h * 192 + 128 + lane] = kb;
    }
}
__device__ __forceinline__ float row16_sum(float v) { v += WDPP(v, 0xB1); v += WDPP(v, 0x4E); v += WDPP(v, 0x141); v += WDPP(v, 0x140); return v; }
__device__ __forceinline__ void p_gqa_rows(const Args& A, const Frame& F) {
    const int gw = F.bid * NWAVES + F.wave, NGW = F.nblk * NWAVES, lane = F.lane, c16 = lane & 15, hrow = lane >> 4;
    const bf16_t* RAW = (const bf16_t*)(F.ws + WS_RAW1); bf16_t* Q1 = (bf16_t*)(F.ws + WS_Q1); bf16_t* K1 = (bf16_t*)(F.ws + WS_K1); bf16_t* V1 = (bf16_t*)(F.ws + WS_V1);
    float qg[8], kg[8], invf[8];
#pragma unroll
    for (int e = 0; e < 8; ++e) { qg[e] = A.in[I1_QN][8 * c16 + e]; kg[e] = A.in[I1_KN][8 * c16 + e]; invf[e] = __powf(10000.f, -(float)(8 * (c16 & 3) + e) * (1.f / 32.f)); }
    const bool colaxis = (c16 & 8) != 0, hi32 = (c16 & 4) != 0;
    for (int r = gw; r < R; r += NGW) {
        const bool ctx = is_ctx_row(r);
        const bf16_t* a = RAW + (size_t)r * 1536 + 8 * lane;
        u32x4 ch[3];
#pragma unroll
        for (int j = 0; j < 3; ++j) ch[j] = (ctx && j < 2) ? (u32x4){0u, 0u, 0u, 0u} : *(const u32x4*)(a + 512 * j);
        float cs[8], sn[8];
        { int prow = 0, pcol = 0; if (!ctx) rope_angles(r, prow, pcol); const float pos = (float)(colaxis ? pcol : prow);
#pragma unroll
          for (int e = 0; e < 8; ++e) { const float ang = pos * invf[e]; cs[e] = ctx ? 1.f : __cosf(ang); sn[e] = ctx ? 0.f : __sinf(ang); } }
#pragma unroll
        for (int j = 0; j < 3; ++j) {
            if (ctx && j < 2) continue;
            const bool isv = (j == 2) && (hrow >= 2);
            float x[8];
#pragma unroll
            for (int d = 0; d < 4; ++d) { x[2 * d] = bflo(ch[j][d]); x[2 * d + 1] = bfhi(ch[j][d]); }
            float sq = 0.f;
#pragma unroll
            for (int e = 0; e < 8; ++e) sq += x[e] * x[e];
            const float rinv = rsqrtf(row16_sum(sq) * (1.f / 128.f) + EPS);
            u32x4 o;
            float y[8];
#pragma unroll
            for (int e = 0; e < 8; ++e) y[e] = x[e] * rinv * (j < 2 ? qg[e] : kg[e]);
            u32x4 yp; yp.x = pk2(y[0], y[1]); yp.y = pk2(y[2], y[3]); yp.z = pk2(y[4], y[5]); yp.w = pk2(y[6], y[7]);
            float pr[8];
#pragma unroll
            for (int d = 0; d < 4; ++d) { const float lo = __shfl_xor(y[2 * d], 4), hi2 = __shfl_xor(y[2 * d + 1], 4); pr[2 * d] = lo; pr[2 * d + 1] = hi2; }
            float z[8];
#pragma unroll
            for (int e = 0; e < 8; ++e) z[e] = y[e] * cs[e] + (hi32 ? pr[e] : -pr[e]) * sn[e];
            o.x = pk2(z[0], z[1]); o.y = pk2(z[2], z[3]); o.z = pk2(z[4], z[5]); o.w = pk2(z[6], z[7]);
            (void)yp;
            if (isv) o = ch[j];
            if (j < 2) *(u32x4*)(Q1 + (size_t)r * 1024 + 512 * j + 8 * lane) = o;
            else { bf16_t* dst = (hrow < 2) ? K1 + (size_t)r * 256 + 8 * lane : V1 + (size_t)r * 256 + 8 * (lane - 32); *(u32x4*)dst = o; }
        }
    }
}

__device__ __forceinline__ int crow(int r, int hi) { return (r & 3) + 8 * (r >> 2) + 4 * hi; }
__device__ __forceinline__ int v_st(int k, int c) { const int kk = (k & ~0xC) | ((k & 4) << 1) | ((k & 8) >> 1); return ((kk >> 3) * 4 + (c >> 5)) * 512 + ((kk & 7) * 32 + (c & 31)) * 2; }
__device__ __forceinline__ int v_rd_base(int lane) { return ((lane & 3) << 3) | (((lane >> 2) & 3) << 6) | (((lane >> 4) & 1) << 5) | (((lane >> 5) & 1) << 8); }
constexpr int v_rd_off(int d0, int ks, int half) { return d0 * 512 + ks * 4096 + half * 2048; }
template <int OFF> __device__ __forceinline__ s16x4 tr_read(int vb) { s16x4 r; asm volatile("ds_read_b64_tr_b16 %0, %1 offset:%2" : "=&v"(r) : "v"(vb), "i"(OFF) : "memory"); return r; }
template <int D0> __device__ __forceinline__ void pv_one(f32x16& od, int vb, bf16x8 pa0, bf16x8 pa1, bf16x8 pa2, bf16x8 pa3) {
    const s16x4 l0 = tr_read<v_rd_off(D0, 0, 0)>(vb), h0 = tr_read<v_rd_off(D0, 0, 1)>(vb), l1 = tr_read<v_rd_off(D0, 1, 0)>(vb), h1 = tr_read<v_rd_off(D0, 1, 1)>(vb);
    const s16x4 l2 = tr_read<v_rd_off(D0, 2, 0)>(vb), h2 = tr_read<v_rd_off(D0, 2, 1)>(vb), l3 = tr_read<v_rd_off(D0, 3, 0)>(vb), h3 = tr_read<v_rd_off(D0, 3, 1)>(vb);
    asm volatile("s_waitcnt lgkmcnt(0)" ::: "memory"); SBAR();
#define PK(L, H) (bf16x8){L[0], L[1], L[2], L[3], H[0], H[1], H[2], H[3]}
    od = __builtin_amdgcn_mfma_f32_32x32x16_bf16(pa0, PK(l0, h0), od, 0, 0, 0);
    od = __builtin_amdgcn_mfma_f32_32x32x16_bf16(pa1, PK(l1, h1), od, 0, 0, 0);
    od = __builtin_amdgcn_mfma_f32_32x32x16_bf16(pa2, PK(l2, h2), od, 0, 0, 0);
    od = __builtin_amdgcn_mfma_f32_32x32x16_bf16(pa3, PK(l3, h3), od, 0, 0, 0);
#undef PK
}
__device__ __forceinline__ void pv_d0(f32x16* o, int vb, bf16x8 pa0, bf16x8 pa1, bf16x8 pa2, bf16x8 pa3) {
    pv_one<0>(o[0], vb, pa0, pa1, pa2, pa3); pv_one<1>(o[1], vb, pa0, pa1, pa2, pa3); pv_one<2>(o[2], vb, pa0, pa1, pa2, pa3); pv_one<3>(o[3], vb, pa0, pa1, pa2, pa3);
}
constexpr float ATT_THR = 8.f;
__device__ __forceinline__ void partialSM(f32x16& p0, f32x16& p1, float& m_reg, float& mn, float& alpha, float C, float thr_raw) {
    float pmax = p0[0];
#pragma unroll
    for (int r = 1; r < 16; ++r) pmax = fmaxf(pmax, p0[r]);
#pragma unroll
    for (int r = 0; r < 16; ++r) pmax = fmaxf(pmax, p1[r]);
    { auto rr = __builtin_amdgcn_permlane32_swap(__float_as_uint(pmax), __float_as_uint(pmax), false, false);
      pmax = fmaxf(__uint_as_float(rr[0]), __uint_as_float(rr[1])); }
    if (__builtin_expect(__all(pmax - m_reg <= thr_raw), 1)) { mn = m_reg; alpha = 1.f; }
    else { mn = fmaxf(m_reg, pmax); alpha = __builtin_amdgcn_exp2f((m_reg - mn) * C); m_reg = mn; }
    const float mnC = -mn * C;
#pragma unroll
    for (int r = 0; r < 16; ++r) p0[r] = fmaf(p0[r], C, mnC);
#pragma unroll
    for (int r = 0; r < 16; ++r) p1[r] = fmaf(p1[r], C, mnC);
#pragma unroll
    for (int r = 0; r < 16; ++r) p0[r] = __builtin_amdgcn_exp2f(p0[r]);
}
__device__ __forceinline__ void finishSM(f32x16& p0, f32x16& p1, float alpha, float& l_reg, bf16x8& pa0, bf16x8& pa1, bf16x8& pa2, bf16x8& pa3) {
#pragma unroll
    for (int r = 0; r < 16; ++r) p1[r] = __builtin_amdgcn_exp2f(p1[r]);
    float ps = 0;
#pragma unroll
    for (int r = 0; r < 16; ++r) ps += p0[r];
#pragma unroll
    for (int r = 0; r < 16; ++r) ps += p1[r];
    { auto rr = __builtin_amdgcn_permlane32_swap(__float_as_uint(ps), __float_as_uint(ps), false, false);
      ps = __uint_as_float(rr[0]) + __uint_as_float(rr[1]); }
    l_reg = l_reg * alpha + ps;
#define PK4(P, BASE, OUT) do { unsigned a0 = cvtpk(P[BASE + 0], P[BASE + 1]), a1 = cvtpk(P[BASE + 2], P[BASE + 3]);   \
    unsigned b0 = cvtpk(P[BASE + 4], P[BASE + 5]), b1 = cvtpk(P[BASE + 6], P[BASE + 7]);                              \
    auto r0 = __builtin_amdgcn_permlane32_swap(a0, b0, false, false); auto r1 = __builtin_amdgcn_permlane32_swap(a1, b1, false, false); \
    u32x4 w = {r0[0], r1[0], r0[1], r1[1]}; OUT = *reinterpret_cast<bf16x8*>(&w); } while (0)
    PK4(p0, 0, pa0); PK4(p0, 8, pa1); PK4(p1, 0, pa2); PK4(p1, 8, pa3);
#undef PK4
}
template <int DQK> __device__ __forceinline__ void qkt(f32x16& p0, f32x16& p1, const char* Ks, const bf16x8* qr, int r32, int hi) {
    constexpr int KP = DQK * 2 + 16;
    p0 = f32x16{}; p1 = f32x16{};
#pragma unroll
    for (int d0 = 0; d0 < DQK / 16; ++d0) { const int cb = (d0 * 16 + hi * 8) * 2;
        const bf16x8 b0 = *reinterpret_cast<const bf16x8*>(Ks + r32 * KP + cb);
        const bf16x8 b1 = *reinterpret_cast<const bf16x8*>(Ks + (32 + r32) * KP + cb);
        p0 = __builtin_amdgcn_mfma_f32_32x32x16_bf16(b0, qr[d0], p0, 0, 0, 0);
        p1 = __builtin_amdgcn_mfma_f32_32x32x16_bf16(b1, qr[d0], p1, 0, 0, 0); }
}
template <int DQK> constexpr int att_lds_bytes() { return 2 * 64 * 128 * 2 + 2 * 64 * (DQK * 2 + 16) + NWAVES * 64 * 4; }
template <int DQK, int LDQ, int LDK, int LDV, int LDO>
__device__ __forceinline__ void attn_body(const bf16_t* __restrict__ Qb, const bf16_t* __restrict__ Kh, const bf16_t* __restrict__ Vh, bf16_t* __restrict__ Ob, int seq, float scale, char* lds) {
    constexpr int KP = DQK * 2 + 16, SHM_V = 64 * 128 * 2, SHM_K = 64 * KP, ND = DQK / 16, CH = DQK / 8, NKL = CH * 64 / NTHREADS;
    const float C = scale * 1.4426950408889634f, thr_raw = ATT_THR / scale;
    const int tid = threadIdx.x, wid = tid >> 6, lane = tid & 63, r32 = lane & 31, hi = lane >> 5;
    char* V_lds = lds; char* K_lds = lds + 2 * SHM_V;
    float* wsf = (float*)(lds + 2 * SHM_V + 2 * SHM_K) + wid * 64; float* li_l = wsf; float* al_l = wsf + 32;
    float m_reg = -1e30f, l_reg = 0; f32x16 o[4] = {}; bf16x8 qr[ND];
    const bf16_t* Qw = Qb + (long)(wid * 32 + r32) * LDQ + hi * 8;
#pragma unroll
    for (int d0 = 0; d0 < ND; ++d0) qr[d0] = *reinterpret_cast<const bf16x8*>(Qw + d0 * 16);
    const int sr = tid >> 4, sc = (tid & 15) * 8, vst0 = v_st(sr, sc), vst1 = v_st(32 + sr, sc);
    static_assert(DQK == 128, "double-pipelined body: 128-wide q.k only");
    const int vb0 = (int)(uintptr_t)V_lds + v_rd_base(lane);
    bf16x8 vs0, vs1, ks[NKL];
#define SLOAD(k0) do { vs0 = *reinterpret_cast<const bf16x8*>(&Vh[(long)((k0) + sr) * LDV + sc]); vs1 = *reinterpret_cast<const bf16x8*>(&Vh[(long)((k0) + 32 + sr) * LDV + sc]); \
    _Pragma("unroll") for (int i_ = 0; i_ < NKL; ++i_) ks[i_] = *reinterpret_cast<const bf16x8*>(&Kh[(long)((k0) + sr + 32 * i_) * LDK + sc]); } while (0)
#define SWRITE(b) do { *(bf16x8*)(V_lds + (b) * SHM_V + vst0) = vs0; *(bf16x8*)(V_lds + (b) * SHM_V + vst1) = vs1; \
    _Pragma("unroll") for (int i_ = 0; i_ < NKL; ++i_) *(bf16x8*)(K_lds + (b) * SHM_K + (sr + 32 * i_) * KP + sc * 2) = ks[i_]; } while (0)
#define RESC(a) do { if (__any((a) < 1.f)) { if (hi == 0) al_l[r32] = (a); asm volatile("s_waitcnt lgkmcnt(0)" ::: "memory"); \
    _Pragma("unroll") for (int d = 0; d < 4; ++d) _Pragma("unroll") for (int r = 0; r < 16; ++r) o[d][r] *= al_l[crow(r, hi)]; } } while (0)
    f32x16 pA0, pA1, pB0, pB1; float mnA, mnB, alA, alB; bf16x8 pa0, pa1, pa2, pa3; const int NT = seq / 64;
    SLOAD(0); asm volatile("s_waitcnt vmcnt(0)" ::: "memory"); SWRITE(0); __syncthreads();
    qkt<DQK>(pA0, pA1, K_lds, qr, r32, hi); partialSM(pA0, pA1, m_reg, mnA, alA, C, thr_raw);
    SLOAD(64);
    asm volatile("s_waitcnt vmcnt(0)" ::: "memory"); SWRITE(1); __syncthreads();
    for (int j = 1; j + 1 < NT; j += 2) {
        SBAR(); qkt<DQK>(pB0, pB1, K_lds + SHM_K, qr, r32, hi);
        finishSM(pA0, pA1, alA, l_reg, pa0, pa1, pa2, pa3); SBAR();
        SLOAD((j + 1) * 64); SBAR();
        pv_d0(o, vb0, pa0, pa1, pa2, pa3); partialSM(pB0, pB1, m_reg, mnB, alB, C, thr_raw);
        __syncthreads(); asm volatile("s_waitcnt vmcnt(0)" ::: "memory"); SWRITE(0);
        RESC(alB); __syncthreads();
        SBAR(); qkt<DQK>(pA0, pA1, K_lds, qr, r32, hi);
        finishSM(pB0, pB1, alB, l_reg, pa0, pa1, pa2, pa3); SBAR();
        SLOAD((j + 2) * 64); SBAR();
        pv_d0(o, vb0 + SHM_V, pa0, pa1, pa2, pa3); partialSM(pA0, pA1, m_reg, mnA, alA, C, thr_raw);
        __syncthreads(); asm volatile("s_waitcnt vmcnt(0)" ::: "memory"); SWRITE(1);
        RESC(alA); __syncthreads();
    }
    SBAR(); qkt<DQK>(pB0, pB1, K_lds + SHM_K, qr, r32, hi);
    finishSM(pA0, pA1, alA, l_reg, pa0, pa1, pa2, pa3); SBAR();
    pv_d0(o, vb0, pa0, pa1, pa2, pa3); partialSM(pB0, pB1, m_reg, mnB, alB, C, thr_raw);
    __syncthreads(); RESC(alB);
    finishSM(pB0, pB1, alB, l_reg, pa0, pa1, pa2, pa3); SBAR();
    pv_d0(o, vb0 + SHM_V, pa0, pa1, pa2, pa3);
    if (hi == 0) li_l[r32] = l_reg; asm volatile("s_waitcnt lgkmcnt(0)" ::: "memory");
    float rli[16];
#pragma unroll
    for (int r = 0; r < 16; ++r) rli[r] = __builtin_amdgcn_rcpf(li_l[crow(r, hi)]);
    bf16_t* Ow = Ob + (long)(wid * 32) * LDO;
#pragma unroll
    for (int r = 0; r < 16; ++r) { const int orow = crow(r, hi);
#pragma unroll
        for (int d0 = 0; d0 < 4; ++d0) Ow[(long)orow * LDO + d0 * 32 + r32] = (bf16_t)f2bf(o[d0][r] * rli[r]); }
    __syncthreads();
#undef SLOAD
#undef SWRITE
#undef RESC
}
template <int DQK, int LDQ, int LDK, int LDV, int LDO>
__device__ __forceinline__ void attn_body_single(const bf16_t* __restrict__ Qb, const bf16_t* __restrict__ Kh, const bf16_t* __restrict__ Vh, bf16_t* __restrict__ Ob, int seq, float scale, char* lds, int rope_t0) {
    constexpr int KP = DQK * 2 + 16, SHM_V = 64 * 128 * 2, SHM_K = 64 * KP, ND = DQK / 16, CH = DQK / 8, NKL = CH * 64 / NTHREADS;
    const float C = scale * 1.4426950408889634f, thr_raw = ATT_THR / scale;
    const int tid = threadIdx.x, wid = tid >> 6, lane = tid & 63, r32 = lane & 31, hi = lane >> 5;
    char* V_lds = lds; char* K_lds = lds + 2 * SHM_V;
    float* wsf = (float*)(lds + 2 * SHM_V + 2 * SHM_K) + wid * 64; float* li_l = wsf; float* al_l = wsf + 32;
    float m_reg = -1e30f, l_reg = 0; f32x16 o[4] = {}; bf16x8 qr[ND];
    const bf16_t* Qw = Qb + (long)(wid * 32 + r32) * LDQ + hi * 8;
#pragma unroll
    for (int d0 = 8; d0 < ND; ++d0) qr[d0] = *reinterpret_cast<const bf16x8*>(Qw + d0 * 16);
    if constexpr (DQK == 192) {
        if (rope_t0 >= 0) {
            const int tq = rope_t0 + wid * 32 + r32; const float prow = (float)(tq >> 6), pcol = (float)(tq & 63);
            u32x4 fa1 = __builtin_bit_cast(u32x4, qr[8]), fa2 = __builtin_bit_cast(u32x4, qr[9]), fb1 = __builtin_bit_cast(u32x4, qr[10]), fb2 = __builtin_bit_cast(u32x4, qr[11]);
#pragma unroll
            for (int jj = 0; jj < 4; ++jj) {
                float na1[2], na2[2], nb1[2], nb2[2];
#pragma unroll
                for (int e = 0; e < 2; ++e) { const float invf = __powf(10000.f, -(float)(hi * 8 + 2 * jj + e) * (1.f / 16.f));
                    const float ar = prow * invf, ac = pcol * invf, cr = __cosf(ar), sr_ = __sinf(ar), cc = __cosf(ac), sc_ = __sinf(ac);
                    const float a1 = e ? bfhi(fa1[jj]) : bflo(fa1[jj]), a2 = e ? bfhi(fa2[jj]) : bflo(fa2[jj]), b1 = e ? bfhi(fb1[jj]) : bflo(fb1[jj]), b2 = e ? bfhi(fb2[jj]) : bflo(fb2[jj]);
                    na1[e] = a1 * cr - a2 * sr_; na2[e] = a2 * cr + a1 * sr_; nb1[e] = b1 * cc - b2 * sc_; nb2[e] = b2 * cc + b1 * sc_; }
                fa1[jj] = pk2(na1[0], na1[1]); fa2[jj] = pk2(na2[0], na2[1]); fb1[jj] = pk2(nb1[0], nb1[1]); fb2[jj] = pk2(nb2[0], nb2[1]);
            }
            qr[8] = __builtin_bit_cast(bf16x8, fa1); qr[9] = __builtin_bit_cast(bf16x8, fa2); qr[10] = __builtin_bit_cast(bf16x8, fb1); qr[11] = __builtin_bit_cast(bf16x8, fb2);
        }
    }
    asm volatile("" ::: "memory");
#pragma unroll
    for (int d0 = 0; d0 < 8; ++d0) qr[d0] = *reinterpret_cast<const bf16x8*>(Qw + d0 * 16);
    const int sr = tid >> 4, sc = (tid & 15) * 8, vst0 = v_st(sr, sc), vst1 = v_st(32 + sr, sc);
    int krow[NKL], kch[NKL];
#pragma unroll
    for (int i = 0; i < NKL; ++i) { const int id = tid + i * NTHREADS; krow[i] = id / CH; kch[i] = id % CH; }
    const int vb0 = (int)(uintptr_t)V_lds + v_rd_base(lane);
    bf16x8 vs0, vs1, ks[NKL];
#define SLOAD(k0) do { vs0 = *reinterpret_cast<const bf16x8*>(&Vh[(long)((k0) + sr) * LDV + sc]); vs1 = *reinterpret_cast<const bf16x8*>(&Vh[(long)((k0) + 32 + sr) * LDV + sc]); \
    _Pragma("unroll") for (int i_ = 0; i_ < NKL; ++i_) ks[i_] = *reinterpret_cast<const bf16x8*>(&Kh[(long)((k0) + krow[i_]) * LDK + kch[i_] * 8]); } while (0)
#define SWRITE(b) do { *(bf16x8*)(V_lds + (b) * SHM_V + vst0) = vs0; *(bf16x8*)(V_lds + (b) * SHM_V + vst1) = vs1; \
    _Pragma("unroll") for (int i_ = 0; i_ < NKL; ++i_) *(bf16x8*)(K_lds + (b) * SHM_K + krow[i_] * KP + kch[i_] * 16) = ks[i_]; } while (0)
#define RESC(a) do { if (__any((a) < 1.f)) { if (hi == 0) al_l[r32] = (a); asm volatile("s_waitcnt lgkmcnt(0)" ::: "memory"); \
    _Pragma("unroll") for (int d = 0; d < 4; ++d) _Pragma("unroll") for (int r = 0; r < 16; ++r) o[d][r] *= al_l[crow(r, hi)]; } } while (0)
    f32x16 p0, p1; float mn, al; bf16x8 pa0, pa1, pa2, pa3; const int NT = seq / 64;
    SLOAD(0); asm volatile("s_waitcnt vmcnt(0)" ::: "memory"); SWRITE(0); __syncthreads();
    SLOAD(64);
    for (int j = 0; j < NT; ++j) {
        const int b = j & 1;
        SBAR(); qkt<DQK>(p0, p1, K_lds + b * SHM_K, qr, r32, hi);
        partialSM(p0, p1, m_reg, mn, al, C, thr_raw);
        RESC(al);
        finishSM(p0, p1, al, l_reg, pa0, pa1, pa2, pa3); SBAR();
        pv_d0(o, vb0 + b * SHM_V, pa0, pa1, pa2, pa3);
        if (j + 1 < NT) { asm volatile("s_waitcnt vmcnt(0)" ::: "memory"); SWRITE(b ^ 1); }
        __syncthreads();
        if (j + 2 < NT) SLOAD((j + 2) * 64);
    }
    if (hi == 0) li_l[r32] = l_reg; asm volatile("s_waitcnt lgkmcnt(0)" ::: "memory");
    float rli[16];
#pragma unroll
    for (int r = 0; r < 16; ++r) rli[r] = __builtin_amdgcn_rcpf(li_l[crow(r, hi)]);
    bf16_t* Ow = Ob + (long)(wid * 32) * LDO;
#pragma unroll
    for (int r = 0; r < 16; ++r) { const int orow = crow(r, hi);
#pragma unroll
        for (int d0 = 0; d0 < 4; ++d0) Ow[(long)orow * LDO + d0 * 32 + r32] = (bf16_t)f2bf(o[d0][r] * rli[r]); }
    __syncthreads();
#undef SLOAD
#undef SWRITE
#undef RESC
}
__device__ __forceinline__ void p_attn_mla(const Args& A, const Frame& F) {
    const bf16_t* Q = (const bf16_t*)(F.ws + WS_Q); const bf16_t* Kb = (const bf16_t*)(F.ws + WS_K); const bf16_t* Vb = (const bf16_t*)(F.ws + WS_V); bf16_t* O = (bf16_t*)(F.ws + WS_O);
    const float scale = 0.07216878364870322f;
    for (int u = F.vcu; u < 544; u += F.nblk) {
        int b, h, q0, seq;
        int rope_t0;
        if (u < 512) { const int qb = u & 15; h = (u >> 4) & 7; b = u >> 7; q0 = CTXL + qb * 256; seq = RPB; rope_t0 = qb * 256; }
        else { const int v = u - 512; h = v & 7; b = v >> 3; q0 = 0; seq = CTXL; rope_t0 = -1; }
        const size_t rb = (size_t)b * RPB;
        attn_body_single<192, 1536, 1536, 1024, 1024>(Q + (rb + q0) * 1536 + h * 192, Kb + rb * 1536 + h * 192, Vb + rb * 1024 + h * 128, O + (rb + q0) * 1024 + h * 128, seq, scale, F.lds, rope_t0);
    }
}
__device__ __forceinline__ void p_attn_gqa(const Args& A, const Frame& F) {
    const bf16_t* Q = (const bf16_t*)(F.ws + WS_Q1); const bf16_t* Kb = (const bf16_t*)(F.ws + WS_K1); const bf16_t* Vb = (const bf16_t*)(F.ws + WS_V1); bf16_t* O = (bf16_t*)(F.ws + WS_O);
    const float scale = 0.08838834764831845f;
    for (int u = F.vcu; u < 512; u += F.nblk) {
        const int qb = u & 15, h = (u >> 4) & 7, b = u >> 7, q0 = CTXL + qb * 256, kvh = h >> 2;
        const size_t rb = (size_t)b * RPB;
        attn_body<128, 1024, 256, 256, 1024>(Q + (rb + q0) * 1024 + h * 128, Kb + rb * 256 + kvh * 128, Vb + rb * 256 + kvh * 128, O + (rb + q0) * 1024 + h * 128, RPB, scale, F.lds);
    }
}

#define DPP_XOR1 0xB1
#define DPP_XOR2 0x4E
#define DPP_HMIRROR 0x141
#define DPP_MIRROR 0x140
__device__ __forceinline__ int row_max_i(int v) {
    v = max(v, __builtin_amdgcn_update_dpp(v, v, DPP_XOR1, 0xf, 0xf, false));
    v = max(v, __builtin_amdgcn_update_dpp(v, v, DPP_XOR2, 0xf, 0xf, false));
    v = max(v, __builtin_amdgcn_update_dpp(v, v, DPP_HMIRROR, 0xf, 0xf, false));
    v = max(v, __builtin_amdgcn_update_dpp(v, v, DPP_MIRROR, 0xf, 0xf, false));
    return v;
}
__device__ __forceinline__ float row_sum_f(float v) {
    v += __builtin_bit_cast(float, __builtin_amdgcn_update_dpp(0, __builtin_bit_cast(int, v), DPP_XOR1, 0xf, 0xf, false));
    v += __builtin_bit_cast(float, __builtin_amdgcn_update_dpp(0, __builtin_bit_cast(int, v), DPP_XOR2, 0xf, 0xf, false));
    v += __builtin_bit_cast(float, __builtin_amdgcn_update_dpp(0, __builtin_bit_cast(int, v), DPP_HMIRROR, 0xf, 0xf, false));
    v += __builtin_bit_cast(float, __builtin_amdgcn_update_dpp(0, __builtin_bit_cast(int, v), DPP_MIRROR, 0xf, 0xf, false));
    return v;
}
__device__ __forceinline__ int fkey(float f) { const int b = __builtin_bit_cast(int, f); return b ^ ((b >> 31) & 0x7fffffff); }
__device__ __forceinline__ float keyf(int k) { return __builtin_bit_cast(float, k ^ ((k >> 31) & 0x7fffffff)); }
__device__ __forceinline__ void cand_ij(int t, int& i, int& j) {
    const int g16 = t >= 16, g24 = t >= 24, g29 = t >= 29, g33 = t >= 33, g36 = t >= 36, g38 = t >= 38, g40 = t >= 40;
    i = g16 + g24 + g29 + g33 + g36 + g38 + g40 + max(t - 41, 0);
    const int base = 16 * g16 + 8 * g24 + 5 * g29 + 4 * g33 + 3 * g36 + 2 * g38 + 2 * g40;
    j = (t >= 42) ? 0 : t - base;
    if (t >= 50) { i = 0; j = 0; }
}
__device__ __forceinline__ void row_max2(int& a, int& b) {
    asm volatile("s_nop 1\n\t"
                 "v_max_i32_dpp %0, %0, %0 quad_perm:[1,0,3,2] row_mask:0xf bank_mask:0xf\n\tv_max_i32_dpp %1, %1, %1 quad_perm:[1,0,3,2] row_mask:0xf bank_mask:0xf\n\ts_nop 0\n\t"
                 "v_max_i32_dpp %0, %0, %0 quad_perm:[2,3,0,1] row_mask:0xf bank_mask:0xf\n\tv_max_i32_dpp %1, %1, %1 quad_perm:[2,3,0,1] row_mask:0xf bank_mask:0xf\n\ts_nop 0\n\t"
                 "v_max_i32_dpp %0, %0, %0 row_half_mirror row_mask:0xf bank_mask:0xf\n\tv_max_i32_dpp %1, %1, %1 row_half_mirror row_mask:0xf bank_mask:0xf\n\ts_nop 0\n\t"
                 "v_max_i32_dpp %0, %0, %0 row_mirror row_mask:0xf bank_mask:0xf\n\tv_max_i32_dpp %1, %1, %1 row_mirror row_mask:0xf bank_mask:0xf\n\ts_nop 1"
                 : "+v"(a), "+v"(b));
}
__device__ __forceinline__ void row_max1(int& a) {
    asm volatile("s_nop 1\n\t"
                 "v_max_i32_dpp %0, %0, %0 quad_perm:[1,0,3,2] row_mask:0xf bank_mask:0xf\n\ts_nop 1\n\t"
                 "v_max_i32_dpp %0, %0, %0 quad_perm:[2,3,0,1] row_mask:0xf bank_mask:0xf\n\ts_nop 1\n\t"
                 "v_max_i32_dpp %0, %0, %0 row_half_mirror row_mask:0xf bank_mask:0xf\n\ts_nop 1\n\t"
                 "v_max_i32_dpp %0, %0, %0 row_mirror row_mask:0xf bank_mask:0xf\n\ts_nop 1"
                 : "+v"(a));
}
__device__ __forceinline__ void row_max4(int& a, int& b, int& c, int& d) {
    asm volatile("s_nop 1\n\t"
                 "v_max_i32_dpp %0, %0, %0 quad_perm:[1,0,3,2] row_mask:0xf bank_mask:0xf\n\tv_max_i32_dpp %1, %1, %1 quad_perm:[1,0,3,2] row_mask:0xf bank_mask:0xf\n\t"
                 "v_max_i32_dpp %2, %2, %2 quad_perm:[1,0,3,2] row_mask:0xf bank_mask:0xf\n\tv_max_i32_dpp %3, %3, %3 quad_perm:[1,0,3,2] row_mask:0xf bank_mask:0xf\n\t"
                 "v_max_i32_dpp %0, %0, %0 quad_perm:[2,3,0,1] row_mask:0xf bank_mask:0xf\n\tv_max_i32_dpp %1, %1, %1 quad_perm:[2,3,0,1] row_mask:0xf bank_mask:0xf\n\t"
                 "v_max_i32_dpp %2, %2, %2 quad_perm:[2,3,0,1] row_mask:0xf bank_mask:0xf\n\tv_max_i32_dpp %3, %3, %3 quad_perm:[2,3,0,1] row_mask:0xf bank_mask:0xf\n\t"
                 "v_max_i32_dpp %0, %0, %0 row_half_mirror row_mask:0xf bank_mask:0xf\n\tv_max_i32_dpp %1, %1, %1 row_half_mirror row_mask:0xf bank_mask:0xf\n\t"
                 "v_max_i32_dpp %2, %2, %2 row_half_mirror row_mask:0xf bank_mask:0xf\n\tv_max_i32_dpp %3, %3, %3 row_half_mirror row_mask:0xf bank_mask:0xf\n\t"
                 "v_max_i32_dpp %0, %0, %0 row_mirror row_mask:0xf bank_mask:0xf\n\tv_max_i32_dpp %1, %1, %1 row_mirror row_mask:0xf bank_mask:0xf\n\t"
                 "v_max_i32_dpp %2, %2, %2 row_mirror row_mask:0xf bank_mask:0xf\n\tv_max_i32_dpp %3, %3, %3 row_mirror row_mask:0xf bank_mask:0xf\n\ts_nop 1"
                 : "+v"(a), "+v"(b), "+v"(c), "+v"(d));
}
#define CE_DESC(x, y) do { const int hi_ = max(x, y), lo_ = min(x, y); x = hi_; y = lo_; } while (0)
#define SORT8_DESC(k) do { CE_DESC(k[0], k[2]); CE_DESC(k[1], k[3]); CE_DESC(k[4], k[6]); CE_DESC(k[5], k[7]); CE_DESC(k[0], k[4]); CE_DESC(k[1], k[5]); CE_DESC(k[2], k[6]); CE_DESC(k[3], k[7]); \
    CE_DESC(k[0], k[1]); CE_DESC(k[2], k[3]); CE_DESC(k[4], k[5]); CE_DESC(k[6], k[7]); CE_DESC(k[2], k[4]); CE_DESC(k[3], k[5]); CE_DESC(k[1], k[4]); CE_DESC(k[3], k[6]); CE_DESC(k[1], k[2]); CE_DESC(k[3], k[4]); CE_DESC(k[5], k[6]); } while (0)
__device__ __forceinline__ void p_peer_topk(const Args& A, const Frame& F, bool skip_ctx) {
    const int gw = F.bid * NWAVES + F.wave, NGW = F.nblk * NWAVES, lane = F.lane, c = lane & 15, rw = lane >> 4, rbase = lane & 48;
    const unsigned short* S = (const unsigned short*)(F.ws + WS_S);
    const int KMIN = (int)0x80000000;
    int ci[4], cj[4];
#pragma unroll
    for (int q = 0; q < 4; ++q) cand_ij(c + 16 * q, ci[q], cj[q]);
    unsigned* PK = (unsigned*)(F.ws + WS_PK);
    const int ntok = skip_ctx ? NB * SEQ : R;
    u32x2 nx[2][4];
#define TK_LOAD(n_) do { const int n2_ = (n_) < ntok ? (n_) : gw; const int r_ = skip_ctx ? tok_row(1, n2_) : n2_; \
        _Pragma("unroll") for (int hh_ = 0; hh_ < 2; ++hh_) { const unsigned short* sp_ = S + (size_t)r_ * 2048 + (4 * hh_ + rw) * 256 + 4 * c; \
            nx[hh_][0] = *(const u32x2*)sp_; nx[hh_][1] = *(const u32x2*)(sp_ + 64); nx[hh_][2] = *(const u32x2*)(sp_ + 128); nx[hh_][3] = *(const u32x2*)(sp_ + 192); } } while (0)
    TK_LOAD(gw);
    for (int n = gw; n < ntok; n += NGW) {
        const int r = skip_ctx ? tok_row(1, n) : n;
        int k1[2][8], k2[2][8];
#pragma unroll
        for (int hh = 0; hh < 2; ++hh)
#pragma unroll
            for (int jj = 0; jj < 2; ++jj) { const u32x2 a = nx[hh][jj], b = nx[hh][2 + jj];
#pragma unroll
                for (int e = 0; e < 4; ++e) { const int p = 4 * c + 64 * jj + e;
                    const float fa = (float)__builtin_bit_cast(_Float16, (unsigned short)(a[e >> 1] >> (16 * (e & 1)))), fb = (float)__builtin_bit_cast(_Float16, (unsigned short)(b[e >> 1] >> (16 * (e & 1))));
                    k1[hh][4 * jj + e] = (fkey(fa) & ~127) | (127 - p); k2[hh][4 * jj + e] = (fkey(fb) & ~127) | (127 - p); } }
        TK_LOAD(n + NGW);
        SORT8_DESC(k1[0]); SORT8_DESC(k2[0]); SORT8_DESC(k1[1]); SORT8_DESC(k2[1]);
        int r1[2] = {KMIN, KMIN}, r2[2] = {KMIN, KMIN};
#pragma unroll 1
        for (int it = 0; it < 16; ++it) {
            int m1a = k1[0][0], m2a = k2[0][0], m1b = k1[1][0], m2b = k2[1][0];
            row_max4(m1a, m2a, m1b, m2b);
            const bool p1a = (k1[0][0] == m1a), p2a = (k2[0][0] == m2a), p1b = (k1[1][0] == m1b), p2b = (k2[1][0] == m2b);
#pragma unroll
            for (int e = 0; e < 7; ++e) { k1[0][e] = p1a ? k1[0][e + 1] : k1[0][e]; k2[0][e] = p2a ? k2[0][e + 1] : k2[0][e]; k1[1][e] = p1b ? k1[1][e + 1] : k1[1][e]; k2[1][e] = p2b ? k2[1][e + 1] : k2[1][e]; }
            k1[0][7] = p1a ? KMIN : k1[0][7]; k2[0][7] = p2a ? KMIN : k2[0][7]; k1[1][7] = p1b ? KMIN : k1[1][7]; k2[1][7] = p2b ? KMIN : k2[1][7];
            if (c == it) { r1[0] = m1a; r2[0] = m2a; r1[1] = m1b; r2[1] = m2b; }
        }
        int ck[2][4];
#pragma unroll
        for (int hh = 0; hh < 2; ++hh) {
#pragma unroll
            for (int q = 0; q < 4; ++q) { const int a = __shfl(r1[hh], rbase | ci[q]), b = __shfl(r2[hh], rbase | cj[q]);
                const float fs = keyf((a & ~127) | 64) + keyf((b & ~127) | 64); const int t = c + 16 * q;
                ck[hh][q] = (t < 50) ? ((fkey(fs) & ~63) | (63 - t)) : KMIN; }
            CE_DESC(ck[hh][0], ck[hh][1]); CE_DESC(ck[hh][2], ck[hh][3]); CE_DESC(ck[hh][0], ck[hh][2]); CE_DESC(ck[hh][1], ck[hh][3]); CE_DESC(ck[hh][1], ck[hh][2]); }
        int tk[2] = {KMIN, KMIN};
#pragma unroll 1
        for (int it = 0; it < 16; ++it) {
            int ma = ck[0][0], mb = ck[1][0];
            row_max2(ma, mb);
            const bool pa = (ck[0][0] == ma), pb = (ck[1][0] == mb);
            ck[0][0] = pa ? ck[0][1] : ck[0][0]; ck[0][1] = pa ? ck[0][2] : ck[0][1]; ck[0][2] = pa ? ck[0][3] : ck[0][2]; ck[0][3] = pa ? KMIN : ck[0][3];
            ck[1][0] = pb ? ck[1][1] : ck[1][0]; ck[1][1] = pb ? ck[1][2] : ck[1][1]; ck[1][2] = pb ? ck[1][3] : ck[1][2]; ck[1][3] = pb ? KMIN : ck[1][3];
            if (c == it) { tk[0] = ma; tk[1] = mb; }
        }
        int mka = tk[0], mkb = tk[1]; row_max2(mka, mkb);
#pragma unroll
        for (int hh = 0; hh < 2; ++hh) {
            int wi, wj; cand_ij(63 - (tk[hh] & 63), wi, wj);
            const int wa = __shfl(r1[hh], rbase | wi), wb = __shfl(r2[hh], rbase | wj);
            const int te = (127 - (wa & 127)) * 128 + (127 - (wb & 127));
            const float tv = keyf((tk[hh] & ~63) | 32), mx = keyf(((hh ? mkb : mka) & ~63) | 32);
            const float ex = __expf(tv - mx), sum = row_sum_f(ex);
            PK[(size_t)r * 128 + (4 * hh + rw) * 16 + c] = ((unsigned)te << 16) | (unsigned)(ex / sum * 65535.f + 0.5f);
        }
    }
#undef TK_LOAD
}

#define UB(w, b) ((float)(((w) >> (8 * (b))) & 0xffu))
__device__ __forceinline__ void p_peer_experts(const Args& A, const Frame& F, int layer) {
    const int gw = F.bid * NWAVES + F.wave, NGW = F.nblk * NWAVES, lane = F.lane;
    const bf16_t* H = (const bf16_t*)(F.ws + WS_H); float* X = (float*)(F.ws + WS_X);
    const unsigned* PK = (const unsigned*)(F.ws + WS_PK);
    const unsigned char* UT = F.ws + WS_TAB + (size_t)(layer * 2) * 16384 * 1024; const unsigned char* VT = UT + (size_t)16384 * 1024;
    const float* SU = (const float*)(F.ws + WS_TSC) + (layer * 2) * 16384; const float* SV = SU + 16384;
    const float* MOD = (const float*)(F.ws + WS_MOD) + (size_t)layer * 5 * 6144;
    for (int r = gw; r < R; r += NGW) {
        if (layer == 1 && is_ctx_row(r)) continue;
        float hf[16];
        { const u32x4 w0 = *(const u32x4*)(H + (size_t)r * DM + 16 * lane), w1 = *(const u32x4*)(H + (size_t)r * DM + 16 * lane + 8);
#pragma unroll
          for (int d = 0; d < 4; ++d) { hf[2 * d] = bflo(w0[d]); hf[2 * d + 1] = bfhi(w0[d]); hf[8 + 2 * d] = bflo(w1[d]); hf[8 + 2 * d + 1] = bfhi(w1[d]); } }
        float hs = 0.f;
#pragma unroll
        for (int i = 0; i < 16; ++i) hs += hf[i];
        hs = wave_sum(hs);
        int v0 = (int)PK[(size_t)r * 128 + lane], v1 = (int)PK[(size_t)r * 128 + 64 + lane];
#pragma unroll
        for (int k = 2; k <= 128; k <<= 1) {
#pragma unroll
            for (int j = k >> 1; j >= 1; j >>= 1) {
                if (j == 64) { const int a = min(v0, v1), b = max(v0, v1); v0 = a; v1 = b; }
                else { const int o0 = __shfl_xor(v0, j), o1 = __shfl_xor(v1, j); const bool lower = (lane & j) == 0;
                    const bool asc0 = (k == 128) ? true : (k == 64) ? true : ((lane & k) == 0), asc1 = (k == 128) ? true : (k == 64) ? false : ((lane & k) == 0);
                    v0 = (lower == asc0) ? min(v0, o0) : max(v0, o0); v1 = (lower == asc1) ? min(v1, o1) : max(v1, o1); }
            }
        }
        const unsigned pk0 = (unsigned)v0, pk1 = (unsigned)v1;
        const int e0 = (int)(pk0 >> 16), e1 = (int)(pk1 >> 16);
        const float g0 = (float)(pk0 & 0xffffu) * (1.f / 65535.f), g1 = (float)(pk1 & 0xffffu) * (1.f / 65535.f);
        const float su0 = SU[e0], su1 = SU[e1], sv0 = SV[e0], sv1 = SV[e1];
        float d0 = 0.f, d1 = 0.f;
        const int dep_src = (8 * (lane & 7)) << 2; const bool bit3 = (lane & 8) != 0;
#define XISSUE(buf, TAB, esrc, gg) do { _Pragma("unroll") for (int q_ = 0; q_ < 8; ++q_) { const int e_ = __builtin_amdgcn_readlane(esrc, (gg) * 8 + q_); \
            buf[q_] = *(const u32x4*)((TAB) + (size_t)e_ * 1024 + 16 * lane); } } while (0)
#define UCOMP(buf, gg, dsel) do { float p_[8]; _Pragma("unroll") for (int q_ = 0; q_ < 8; ++q_) { float d_ = 0.f; \
            _Pragma("unroll") for (int j_ = 0; j_ < 4; ++j_) d_ += (hf[4 * j_] * UB(buf[q_][j_], 0) + hf[4 * j_ + 1] * UB(buf[q_][j_], 1)) + (hf[4 * j_ + 2] * UB(buf[q_][j_], 2) + hf[4 * j_ + 3] * UB(buf[q_][j_], 3)); p_[q_] = d_; } \
            float s_[4]; _Pragma("unroll") for (int q_ = 0; q_ < 4; ++q_) { auto rr_ = __builtin_amdgcn_permlane32_swap(__float_as_uint(p_[q_]), __float_as_uint(p_[q_ + 4]), false, false); s_[q_] = __uint_as_float(rr_[0]) + __uint_as_float(rr_[1]); } \
            float t_[2]; _Pragma("unroll") for (int q_ = 0; q_ < 2; ++q_) { auto rr_ = __builtin_amdgcn_permlane16_swap(__float_as_uint(s_[q_]), __float_as_uint(s_[q_ + 2]), false, false); t_[q_] = __uint_as_float(rr_[0]) + __uint_as_float(rr_[1]); } \
            const float keep_ = bit3 ? t_[1] : t_[0], send_ = bit3 ? t_[0] : t_[1]; \
            float u_ = keep_ + __builtin_bit_cast(float, __builtin_amdgcn_update_dpp(0, __builtin_bit_cast(int, send_), 0x128, 0xf, 0xf, false)); \
            u_ += __builtin_bit_cast(float, __builtin_amdgcn_update_dpp(0, __builtin_bit_cast(int, u_), DPP_HMIRROR, 0xf, 0xf, false)); \
            u_ += __builtin_bit_cast(float, __builtin_amdgcn_update_dpp(0, __builtin_bit_cast(int, u_), DPP_XOR1, 0xf, 0xf, false)); \
            u_ += __builtin_bit_cast(float, __builtin_amdgcn_update_dpp(0, __builtin_bit_cast(int, u_), DPP_XOR2, 0xf, 0xf, false)); \
            const float v_ = __builtin_bit_cast(float, __builtin_amdgcn_ds_bpermute(dep_src, __builtin_bit_cast(int, u_))); \
            if ((lane >> 3) == (gg)) dsel = v_; } while (0)
        {
            u32x4 ua[8], ub[8];
            XISSUE(ua, UT, e0, 0);
#pragma unroll 1
            for (int g = 0; g < 8; g += 2) { XISSUE(ub, UT, e0, g + 1); UCOMP(ua, g, d0); if (g + 2 < 8) XISSUE(ua, UT, e0, g + 2); else XISSUE(ua, UT, e1, 0); UCOMP(ub, g + 1, d0); }
#pragma unroll 1
            for (int g = 0; g < 8; g += 2) { XISSUE(ub, UT, e1, g + 1); UCOMP(ua, g, d1); if (g + 2 < 8) XISSUE(ua, UT, e1, g + 2); UCOMP(ub, g + 1, d1); }
        }
        const float a0 = su0 * (d0 - 128.f * hs), a1 = su1 * (d1 - 128.f * hs);
        const float w0 = g0 * 0.5f * a0 * (1.f + erff(a0 * 0.70710678118654752f)) * sv0, w1 = g1 * 0.5f * a1 * (1.f + erff(a1 * 0.70710678118654752f)) * sv1;
        const float wsum = wave_sum(w0 + w1) * 128.f;
        float acc[16];
#pragma unroll
        for (int i = 0; i < 16; ++i) acc[i] = 0.f;
#define VCOMP(buf, wsrc, gg) do { _Pragma("unroll") for (int q_ = 0; q_ < 8; ++q_) { const float wk_ = __builtin_bit_cast(float, __builtin_amdgcn_readlane(__builtin_bit_cast(int, wsrc), (gg) * 8 + q_)); \
            _Pragma("unroll") for (int j_ = 0; j_ < 4; ++j_) { acc[4 * j_] += wk_ * UB(buf[q_][j_], 0); acc[4 * j_ + 1] += wk_ * UB(buf[q_][j_], 1); acc[4 * j_ + 2] += wk_ * UB(buf[q_][j_], 2); acc[4 * j_ + 3] += wk_ * UB(buf[q_][j_], 3); } } } while (0)
        {
            u32x4 va[8], vb[8];
            XISSUE(va, VT, e0, 0);
#pragma unroll 1
            for (int g = 0; g < 8; g += 2) { XISSUE(vb, VT, e0, g + 1); VCOMP(va, w0, g); if (g + 2 < 8) XISSUE(va, VT, e0, g + 2); else XISSUE(va, VT, e1, 0); VCOMP(vb, w0, g + 1); }
#pragma unroll 1
            for (int g = 0; g < 8; g += 2) { XISSUE(vb, VT, e1, g + 1); VCOMP(va, w1, g); if (g + 2 < 8) XISSUE(va, VT, e1, g + 2); VCOMP(vb, w1, g + 1); }
        }
#undef XISSUE
#undef UCOMP
#undef VCOMP
        const float* mm = MOD + (size_t)mod_index(r) * 6144;
        f32x4 xn[4]; float s = 0.f;
#pragma unroll
        for (int j = 0; j < 4; ++j) { const int c = 16 * lane + 4 * j; const float* xp = X + (size_t)r * DM + c; const f32x4 gf = *(const f32x4*)(mm + 5 * 1024 + c);
            xn[j] = *(const f32x4*)xp + gf * (f32x4){acc[4 * j] - wsum, acc[4 * j + 1] - wsum, acc[4 * j + 2] - wsum, acc[4 * j + 3] - wsum};
            s += (xn[j].x * xn[j].x + xn[j].y * xn[j].y) + (xn[j].z * xn[j].z + xn[j].w * xn[j].w); }
        const float rinv = rsqrtf(wave_sum(s) * (1.f / DM) + EPS);
        if (layer == 0) {
            const float* m1 = (const float*)(F.ws + WS_MOD) + (size_t)(5 + mod_index(r)) * 6144;
            const float* gn = A.in[I1_NMIX];
#pragma unroll
            for (int j = 0; j < 4; ++j) { const int c = 16 * lane + 4 * j; *(f32x4*)(X + (size_t)r * DM + c) = xn[j];
                const f32x4 y = (xn[j] * rinv * *(const f32x4*)(gn + c)) * (*(const f32x4*)(m1 + 1024 + c) + 1.f) + *(const f32x4*)(m1 + c);
                u32x2 o; o.x = pk2(y.x, y.y); o.y = pk2(y.z, y.w); *(u32x2*)((bf16_t*)(F.ws + WS_H) + (size_t)r * DM + c) = o; }
        } else {
            const int b = r / RPB, t = (r - b * RPB) - CTXL; float* op = F.out + ((size_t)b * SEQ + t) * DM; const float* gn = A.in[I_NOUT];
#pragma unroll
            for (int j = 0; j < 4; ++j) { const int c = 16 * lane + 4 * j; *(f32x4*)(op + c) = xn[j] * rinv * *(const f32x4*)(gn + c); }
        }
    }
}

__device__ __forceinline__ int tok_row(int layer, int n) { return layer == 0 ? n : (n >> 12) * RPB + CTXL + (n & 4095); }
#define DPPF(v, ctrl) __builtin_bit_cast(float, __builtin_amdgcn_update_dpp(0, __builtin_bit_cast(int, v), ctrl, 0xf, 0xf, false))
__device__ __forceinline__ int isum8(int v) {
    v += __builtin_amdgcn_update_dpp(0, v, DPP_XOR1, 0xf, 0xf, false); v += __builtin_amdgcn_update_dpp(0, v, DPP_XOR2, 0xf, 0xf, false); v += __builtin_amdgcn_update_dpp(0, v, DPP_HMIRROR, 0xf, 0xf, false); return v; }
__device__ __forceinline__ void p_exp_u(const Args& A, const Frame& F, int layer) {
    const int lane = F.lane, s = lane >> 3, c8 = lane & 7;
    const bool part = (F.nblk & 7) == 0; const int ncb = part ? 1 : 8, cb0 = part ? (F.bid & 7) : 0;
    const int gwv = part ? ((F.bid >> 3) * NWAVES + F.wave) : (F.bid * NWAVES + F.wave), nwv = part ? ((F.nblk >> 3) * NWAVES) : (F.nblk * NWAVES);
    const int ntok = layer == 0 ? R : NB * SEQ;
    const unsigned char* HQ = F.ws + WS_HQ; const unsigned* PK = (const unsigned*)(F.ws + WS_PK);
    const unsigned char* UT = F.ws + WS_TAB + (size_t)(layer * 2) * 16384 * 1024;
    int* PD = (int*)(F.ws + WS_PD);
#define U_META(pk, hq, n_) do { const int r_ = tok_row(layer, (n_) < ntok ? (n_) : gwv); const unsigned* p_ = PK + (size_t)r_ * 128 + s; \
        _Pragma("unroll") for (int i_ = 0; i_ < 16; ++i_) pk[i_] = p_[8 * i_]; \
        hq = *(const u32x4*)(HQ + (size_t)r_ * DM + 128 * cb + 16 * c8); } while (0)
#define U_ISSUE(pk, lo) do { _Pragma("unroll") for (int i_ = (lo); i_ < (lo) + 8; ++i_) t[i_] = *(const u32x4*)(tb + (size_t)(pk[i_] >> 16) * 128); } while (0)
#define U_DOT(i_) do { int d_ = __builtin_amdgcn_sdot4((int)t[i_][0], (int)hv[0], 0, false); d_ = __builtin_amdgcn_sdot4((int)t[i_][1], (int)hv[1], d_, false); \
        d_ = __builtin_amdgcn_sdot4((int)t[i_][2], (int)hv[2], d_, false); d_ = __builtin_amdgcn_sdot4((int)t[i_][3], (int)hv[3], d_, false); \
        d_ = isum8(d_); if (c8 == ((i_) & 7)) { if ((i_) < 8) kA = d_; else kB = d_; } } while (0)
#define U_ITEM(pkc, hqc, pkn, n_) do { \
        const u32x4 hv = hqc; \
        U_META(pkc, hqc, (n_) + 2 * nwv); \
        int kA = 0, kB = 0; \
        _Pragma("unroll") for (int i_ = 0; i_ < 8; ++i_) U_DOT(i_); \
        U_ISSUE(pkn, 0); \
        _Pragma("unroll") for (int i_ = 8; i_ < 16; ++i_) U_DOT(i_); \
        U_ISSUE(pkn, 8); \
        if ((n_) < ntok) { const int r_ = tok_row(layer, n_); int* pd_ = PD + ((size_t)cb * R + r_) * 128 + 8 * c8 + s; pd_[0] = kA; pd_[64] = kB; } \
        } while (0)
#pragma unroll 1
    for (int cbi = 0; cbi < ncb; ++cbi) {
        const int cb = cb0 + cbi;
        const unsigned char* tb = UT + (size_t)cb * 16384 * 128 + 16 * c8;
        unsigned pkA[16], pkB[16]; u32x4 hA, hB, t[16];
        U_META(pkA, hA, gwv); U_META(pkB, hB, gwv + nwv);
        U_ISSUE(pkA, 0); U_ISSUE(pkA, 8);
#pragma unroll 1
        for (int n = gwv; n < ntok; n += 2 * nwv) {
            U_ITEM(pkA, hA, pkB, n);
            U_ITEM(pkB, hB, pkA, n + nwv);
        }
    }
#undef U_META
#undef U_ISSUE
#undef U_DOT
#undef U_ITEM
}
__device__ __forceinline__ void p_exp_w(const Args& A, const Frame& F, int layer) {
    const int gw = F.bid * NWAVES + F.wave, NGW = F.nblk * NWAVES, lane = F.lane;
    const int ntok = layer == 0 ? R : NB * SEQ;
    const unsigned* PK = (const unsigned*)(F.ws + WS_PK); const int* PD = (const int*)(F.ws + WS_PD); const float* HS = (const float*)(F.ws + WS_HS);
    unsigned* WQ8 = (unsigned*)(F.ws + WS_WQ8); float* WSC = (float*)(F.ws + WS_WSC);
    const float* SU = (const float*)(F.ws + WS_TSC) + (layer * 2) * 16384; const float* SV = SU + 16384;
    const int g2 = (lane >> 3) & 3, sb = lane & 7, src = 32 * (g2 & 1) + sb;
    for (int n = gw; n < ntok; n += 2 * NGW) {
        int r[2]; r[0] = tok_row(layer, n); r[1] = (n + NGW) < ntok ? tok_row(layer, n + NGW) : r[0];
        unsigned pk0[2], pk1[2]; int d0[2], d1[2]; float hs[2];
#pragma unroll
        for (int q = 0; q < 2; ++q) { pk0[q] = PK[(size_t)r[q] * 128 + lane]; pk1[q] = PK[(size_t)r[q] * 128 + 64 + lane]; hs[q] = HS[r[q]]; d0[q] = 0; d1[q] = 0;
#pragma unroll
            for (int cb = 0; cb < 8; ++cb) { d0[q] += PD[((size_t)cb * R + r[q]) * 128 + lane]; d1[q] += PD[((size_t)cb * R + r[q]) * 128 + 64 + lane]; } }
        float su0[2], su1[2], sv0[2], sv1[2];
#pragma unroll
        for (int q = 0; q < 2; ++q) { const int e0 = (int)(pk0[q] >> 16), e1 = (int)(pk1[q] >> 16); su0[q] = SU[e0]; su1[q] = SU[e1]; sv0[q] = SV[e0]; sv1[q] = SV[e1]; }
#pragma unroll
        for (int q = 0; q < 2; ++q) {
            const float g0 = (float)(pk0[q] & 0xffffu) * (1.f / 65535.f), g1 = (float)(pk1[q] & 0xffffu) * (1.f / 65535.f);
            const float a0 = su0[q] * hs[q] * (float)d0[q], a1 = su1[q] * hs[q] * (float)d1[q];
            const float w0 = g0 * 0.5f * a0 * (1.f + erff(a0 * 0.70710678118654752f)) * sv0[q], w1 = g1 * 0.5f * a1 * (1.f + erff(a1 * 0.70710678118654752f)) * sv1[q];
            const float wm = wave_max(fmaxf(fabsf(w0), fabsf(w1)));
            const float inv = wm > 0.f ? 127.f / wm : 0.f;
            const int q0 = (int)rintf(w0 * inv) & 0xff, q1 = (int)rintf(w1 * inv) & 0xff;
            unsigned pw = 0;
#pragma unroll
            for (int j = 0; j < 4; ++j) { const int x0 = __shfl(q0, src + 8 * j), x1 = __shfl(q1, src + 8 * j); pw |= (unsigned)((g2 < 2) ? x0 : x1) << (8 * j); }
            if (q == 0 || (n + NGW) < ntok) { if (lane < 32) WQ8[(size_t)r[q] * 32 + lane] = pw; if (lane == 0) WSC[r[q]] = wm > 0.f ? wm * (1.f / 127.f) : 0.f; }
        }
    }
}
__device__ __forceinline__ void p_exp_v(const Args& A, const Frame& F, int layer) {
    const int lane = F.lane, s = lane >> 3, c8 = lane & 7;
    const bool part = (F.nblk & 7) == 0; const int ncb = part ? 1 : 8, cb0 = part ? (F.bid & 7) : 0;
    const int gwv = part ? ((F.bid >> 3) * NWAVES + F.wave) : (F.bid * NWAVES + F.wave), nwv = part ? ((F.nblk >> 3) * NWAVES) : (F.nblk * NWAVES);
    const int ntok = layer == 0 ? R : NB * SEQ;
    const unsigned* PK = (const unsigned*)(F.ws + WS_PK); const unsigned* WQ8 = (const unsigned*)(F.ws + WS_WQ8); const float* WSC = (const float*)(F.ws + WS_WSC);
    const unsigned char* VT = F.ws + WS_TAB + (size_t)(layer * 2 + 1) * 16384 * 1024;
    float* X = (float*)(F.ws + WS_X); const float* MOD = (const float*)(F.ws + WS_MOD) + (size_t)layer * 5 * 6144;
    const bool bit3 = (lane & 8) != 0;
#define V_METAP(pk, n_) do { const int r_ = tok_row(layer, (n_) < ntok ? (n_) : gwv); const unsigned* p_ = PK + (size_t)r_ * 128 + s; \
        _Pragma("unroll") for (int i_ = 0; i_ < 16; ++i_) pk[i_] = p_[8 * i_]; } while (0)
#define V_METAW(wq, n_) do { const int r_ = tok_row(layer, (n_) < ntok ? (n_) : gwv); const unsigned* w_ = WQ8 + (size_t)r_ * 32 + s; \
        _Pragma("unroll") for (int g_ = 0; g_ < 4; ++g_) wq[g_] = w_[8 * g_]; } while (0)
#define V_ISSUE(pk, lo) do { _Pragma("unroll") for (int i_ = (lo); i_ < (lo) + 8; ++i_) t[i_] = *(const u32x4*)(tb + (size_t)(pk[i_] >> 16) * 128); } while (0)
#define V_GRP(wq, g_) do { _Pragma("unroll") for (int j_ = 0; j_ < 4; ++j_) { const unsigned a_ = t[4 * (g_)][j_], b_ = t[4 * (g_) + 1][j_], c_ = t[4 * (g_) + 2][j_], d_ = t[4 * (g_) + 3][j_]; \
        const unsigned ablo = __builtin_amdgcn_perm(b_, a_, 0x05010400u), abhi = __builtin_amdgcn_perm(b_, a_, 0x07030602u), cdlo = __builtin_amdgcn_perm(d_, c_, 0x05010400u), cdhi = __builtin_amdgcn_perm(d_, c_, 0x07030602u); \
        acc[4 * j_]     = __builtin_amdgcn_sdot4((int)__builtin_amdgcn_perm(cdlo, ablo, 0x05040100u), (int)wq[g_], acc[4 * j_], false); \
        acc[4 * j_ + 1] = __builtin_amdgcn_sdot4((int)__builtin_amdgcn_perm(cdlo, ablo, 0x07060302u), (int)wq[g_], acc[4 * j_ + 1], false); \
        acc[4 * j_ + 2] = __builtin_amdgcn_sdot4((int)__builtin_amdgcn_perm(cdhi, abhi, 0x05040100u), (int)wq[g_], acc[4 * j_ + 2], false); \
        acc[4 * j_ + 3] = __builtin_amdgcn_sdot4((int)__builtin_amdgcn_perm(cdhi, abhi, 0x07060302u), (int)wq[g_], acc[4 * j_ + 3], false); } } while (0)
#define V_ITEM(pkc, wqc, pkn, n_) do { \
        int acc[16]; _Pragma("unroll") for (int a_ = 0; a_ < 16; ++a_) acc[a_] = 0; \
        V_METAP(pkc, (n_) + 2 * nwv); \
        V_GRP(wqc, 0); V_GRP(wqc, 1); \
        V_ISSUE(pkn, 0); \
        V_GRP(wqc, 2); V_GRP(wqc, 3); \
        V_ISSUE(pkn, 8); \
        int b8[8], c4[4], o[2]; \
        _Pragma("unroll") for (int a_ = 0; a_ < 8; ++a_) { auto rr = __builtin_amdgcn_permlane32_swap((unsigned)acc[a_], (unsigned)acc[a_ + 8], false, false); b8[a_] = (int)rr[0] + (int)rr[1]; } \
        _Pragma("unroll") for (int a_ = 0; a_ < 4; ++a_) { auto rr = __builtin_amdgcn_permlane16_swap((unsigned)b8[a_], (unsigned)b8[a_ + 4], false, false); c4[a_] = (int)rr[0] + (int)rr[1]; } \
        _Pragma("unroll") for (int a_ = 0; a_ < 2; ++a_) { const int keep = bit3 ? c4[a_ + 2] : c4[a_], send = bit3 ? c4[a_] : c4[a_ + 2]; o[a_] = keep + __builtin_amdgcn_update_dpp(0, send, 0x128, 0xf, 0xf, false); } \
        if ((n_) < ntok) { const int r_ = tok_row(layer, n_); const float ws_ = WSC[r_]; const int col = 128 * cb + 16 * c8 + 2 * s; \
            const f32x2 gf = *(const f32x2*)(MOD + (size_t)mod_index(r_) * 6144 + 5 * 1024 + col); f32x2* xp = (f32x2*)(X + (size_t)r_ * DM + col); \
            f32x2 xv = *xp; xv.x += gf.x * (ws_ * (float)o[0]); xv.y += gf.y * (ws_ * (float)o[1]); *xp = xv; } \
        V_METAW(wqc, (n_) + 2 * nwv); } while (0)
#pragma unroll 1
    for (int cbi = 0; cbi < ncb; ++cbi) {
        const int cb = cb0 + cbi;
        const unsigned char* tb = VT + (size_t)cb * 16384 * 128 + 16 * c8;
        unsigned pkA[16], pkB[16], wqA[4], wqB[4]; u32x4 t[16];
        V_METAP(pkA, gwv); V_METAW(wqA, gwv); V_METAP(pkB, gwv + nwv); V_METAW(wqB, gwv + nwv);
        V_ISSUE(pkA, 0); V_ISSUE(pkA, 8);
#pragma unroll 1
        for (int n = gwv; n < ntok; n += 2 * nwv) {
            V_ITEM(pkA, wqA, pkB, n);
            V_ITEM(pkB, wqB, pkA, n + nwv);
        }
    }
#undef V_METAP
#undef V_METAW
#undef V_ISSUE
#undef V_GRP
#undef V_ITEM
}
__device__ __forceinline__ void p_final_norm(const Args& A, const Frame& F) {
    const int gw = F.bid * NWAVES + F.wave, NGW = F.nblk * NWAVES, lane = F.lane;
    const float* X = (const float*)(F.ws + WS_X); const float* gn = A.in[I_NOUT];
    for (int n = gw; n < NB * SEQ; n += NGW) {
        const float* xr = X + (size_t)tok_row(1, n) * DM; float* op = F.out + (size_t)n * DM;
        f32x4 v[4]; float sq = 0.f;
#pragma unroll
        for (int j = 0; j < 4; ++j) { v[j] = *(const f32x4*)(xr + 4 * lane + 256 * j); sq += (v[j].x * v[j].x + v[j].y * v[j].y) + (v[j].z * v[j].z + v[j].w * v[j].w); }
        const float rinv = rsqrtf(wave_sum(sq) * (1.f / DM) + EPS);
#pragma unroll
        for (int j = 0; j < 4; ++j) { const int c = 4 * lane + 256 * j; *(f32x4*)(op + c) = v[j] * rinv * *(const f32x4*)(gn + c); }
    }
}

constexpr int N_PHASES = 24;
__global__ void __launch_bounds__(NTHREADS, 2) mega(Args args) {
    extern __shared__ __attribute__((aligned(16))) unsigned char lds_raw[];
    Frame F; F.x = args.in[I_X]; F.ctx = args.in[I_CTX]; F.out = args.out; F.ws = args.ws; F.lds = (char*)lds_raw;
    F.tid = threadIdx.x; F.lane = F.tid & 63; F.wave = __builtin_amdgcn_readfirstlane(F.tid >> 6); F.bid = blockIdx.x; F.nblk = gridDim.x;
    F.vcu = (F.nblk % 8 == 0) ? (F.bid % 8) * (F.nblk / 8) + F.bid / 8 : F.bid;
    volatile LAS unsigned* st = (volatile LAS unsigned*)(LAS unsigned char*)(lds_raw + LDS_BYTES - 64);
    if (F.tid < 16) st[F.tid] = 0u;
    __syncthreads();
    XcdBarrier bar; bar.bar = (unsigned*)(F.ws + WS_CTL) + 4096; bar.x = 0; bar.st = st;
    const int lo = args.ph_lo, hi = args.ph_hi;
    const bool fused = (hi - lo) > 1;
    if (fused) bar = xcd_barrier_post((unsigned*)(F.ws + WS_CTL) + 4096, st);
#ifdef ONLY_PHASE
#define IN(k) ((k) == ONLY_PHASE && lo <= (k) && (k) < hi)
#else
#define IN(k) (lo <= (k) && (k) < hi)
#endif
#define SEAM(k) do { if (IN(k) && IN((k) + 1)) { if ((k) == 0) cg::this_grid().sync(); else xcd_barrier(bar); } } while (0)
    bf16_t* Hb = (bf16_t*)(F.ws + WS_H);
#define PH(k, ...) if (IN(k)) for (int rep_ = 0; rep_ < (((PROBE_MASK >> (k)) & 1u) ? 2 : 1); ++rep_) { __VA_ARGS__; __syncthreads(); } SEAM(k)
    float* Xb = (float*)(F.ws + WS_X); const float* MODb = (const float*)(F.ws + WS_MOD);
    PH(0, for (int q_ = 0; q_ < ((PROBE_P0 & 1u) ? 2 : 1); ++q_) { p0_mod(args, F); __syncthreads(); }
          for (int q_ = 0; q_ < ((PROBE_P0 & 2u) ? 2 : 1); ++q_) { p0_weights(args, F); __syncthreads(); }
          for (int q_ = 0; q_ < ((PROBE_P0 & 4u) ? 2 : 1); ++q_) { p0_weff(args, F); __syncthreads(); }
          for (int q_ = 0; q_ < ((PROBE_P0 & 8u) ? 2 : 1); ++q_) { p0_tables(args, F); __syncthreads(); });
    PH(1, p_norm_rows(args, F, 0, 0, true, false));
    PH(2, gemm8e(F, Hb, (const bf16_t*)(F.ws + WS_WIN), 768, 1024, false, EpiMlaDown{(bf16_t*)(F.ws + WS_CQ), (bf16_t*)(F.ws + WS_CKV), (bf16_t*)(F.ws + WS_KR), (float*)(F.ws + WS_SSP)}));
    PH(3, p_mla_krope(args, F);
          gemm8(F, (const bf16_t*)(F.ws + WS_CQ), (const bf16_t*)(F.ws + WS_WUQ), 1536, 384, false, In8Bf16Rs{(bf16_t*)(F.ws + WS_Q), 1536, (const float*)(F.ws + WS_SSP)});
          gemm8(F, (const bf16_t*)(F.ws + WS_CKV), (const bf16_t*)(F.ws + WS_WUKV), 2048, 256, false, In8KVRs{(bf16_t*)(F.ws + WS_K), (bf16_t*)(F.ws + WS_V), (const float*)(F.ws + WS_SSP)}));
    PH(4, p_attn_mla(args, F));
    PH(5, gemm8(F, (const bf16_t*)(F.ws + WS_O), (const bf16_t*)(F.ws + WS_WO0), 1024, 1024, false, In8Resid{F.x, F.ctx, Xb, MODb + 2 * 1024, true}));
    PH(6, p_norm_rows(args, F, 0, 1, false, false));
    PH(7, gemm8(F, Hb, (const bf16_t*)(F.ws + WS_WQ0), 2048, 1024, false, In8F16{(unsigned short*)(F.ws + WS_S), 2048}));
    PH(8, p_peer_topk(args, F, false));
    PH(9, p_exp_u(args, F, 0));
    PH(10, p_exp_w(args, F, 0));
    if (IN(11)) { p_exp_v(args, F, 0); } SEAM(11);
    PH(12, p_norm_rows(args, F, 1, 0, false, false));
    PH(13, gemm8(F, Hb, (const bf16_t*)(F.ws + WS_WQKV), 1536, 1024, false, In8Bf16{(bf16_t*)(F.ws + WS_RAW1), 1536}));
    PH(14, p_gqa_rows(args, F));
    PH(15, p_attn_gqa(args, F));
    if (IN(16)) { gemm8(F, (const bf16_t*)(F.ws + WS_O), (const bf16_t*)(F.ws + WS_WO1), 1024, 1024, true, In8Resid{F.x, F.ctx, Xb, MODb + 5 * 6144 + 2 * 1024, false}); } SEAM(16);
    PH(17, p_norm_rows(args, F, 1, 1, false, true));
    PH(18, gemm8(F, Hb, (const bf16_t*)(F.ws + WS_WQ1), 2048, 1024, true, In8F16{(unsigned short*)(F.ws + WS_S), 2048}));
    PH(19, p_peer_topk(args, F, true));
    PH(20, p_exp_u(args, F, 1));
    PH(21, p_exp_w(args, F, 1));
    if (IN(22)) { p_exp_v(args, F, 1); } SEAM(22);
    if (IN(23)) p_final_norm(args, F);
#undef PH
#undef IN
#undef SEAM
}

extern "C" void kernel_launch(void* const* d_in, const int* in_sizes, int n_in, void* d_out, int out_size, void* d_ws, size_t ws_size, hipStream_t stream) {
    static int grid = 0;
    if (grid == 0) {
        if (n_in != N_IN || in_sizes[0] != NB * SEQ * DM || out_size != NB * SEQ * DM || ws_size < WS_END) {
            fprintf(stderr, "kernel_launch: shape mismatch (n_in %d, in0 %d, out %d, ws %zu < %zu)\n", n_in, n_in > 0 ? in_sizes[0] : -1, out_size, ws_size, (size_t)WS_END); grid = -1; return; }
        int dev = 0, cus = 0, per_cu = 0;
        hipGetDevice(&dev); hipDeviceGetAttribute(&cus, hipDeviceAttributeMultiprocessorCount, dev);
        if (hipFuncSetAttribute((const void*)mega, hipFuncAttributeMaxDynamicSharedMemorySize, LDS_BYTES) != hipSuccess) { fprintf(stderr, "kernel_launch: hipFuncSetAttribute failed\n"); grid = -1; return; }
        if (hipOccupancyMaxActiveBlocksPerMultiprocessor(&per_cu, (const void*)mega, NTHREADS, LDS_BYTES) != hipSuccess || per_cu < 1) { fprintf(stderr, "kernel_launch: occupancy query failed (%d)\n", per_cu); (void)hipGetLastError(); grid = -1; return; }
        grid = cus * (per_cu > 1 ? 1 : per_cu);
    }
    if (grid < 0) return;
    hipMemsetAsync((char*)d_ws + WS_CTL, 0, 1 * MiB, stream);
    Args a{};
    for (int i = 0; i < N_IN; ++i) a.in[i] = (const float*)d_in[i];
    a.out = (float*)d_out; a.ws = (unsigned char*)d_ws;
#if MK_PER_PHASE
    for (int p = 0; p < N_PHASES; ++p) { a.ph_lo = p; a.ph_hi = p + 1; hipLaunchKernelGGL(mega, dim3(grid), dim3(NTHREADS), LDS_BYTES, stream, a); }
#else
    a.ph_lo = 0; a.ph_hi = N_PHASES;
    void* kargs[] = {&a};
    hipError_t e = hipLaunchCooperativeKernel((const void*)mega, dim3(grid), dim3(NTHREADS), kargs, LDS_BYTES, stream);
    if (e != hipSuccess) fprintf(stderr, "kernel_launch: cooperative launch failed: %s (grid %d)\n", hipGetErrorString(e), grid);
#endif
}
```

```cpp
#include <hip/hip_runtime.h>
#include <hip/hip_cooperative_groups.h>
#include <cstdio>
#include <cstdint>
namespace cg = cooperative_groups;

#ifndef PROBE_MASK
#define PROBE_MASK 0u
#endif
#ifndef PROBE_P0
#define PROBE_P0 0u
#endif
#ifndef MK_PER_PHASE
#define MK_PER_PHASE 0
#endif

typedef unsigned short bf16_t;
typedef short bf16x8 __attribute__((ext_vector_type(8)));
typedef short s16x4 __attribute__((ext_vector_type(4)));
typedef float f32x4 __attribute__((ext_vector_type(4)));
typedef float f32x2 __attribute__((ext_vector_type(2)));
typedef float f32x16 __attribute__((ext_vector_type(16)));
typedef unsigned u32x4 __attribute__((ext_vector_type(4)));
typedef unsigned u32x2 __attribute__((ext_vector_type(2)));
#define LAS __attribute__((address_space(3)))
#define SBAR() __builtin_amdgcn_sched_barrier(0)

__device__ __forceinline__ unsigned f2bf(float f) { unsigned u = __builtin_bit_cast(unsigned, f); return (u + 0x7fffu + ((u >> 16) & 1u)) >> 16; }
__device__ __forceinline__ unsigned pk2(float lo, float hi) { return f2bf(lo) | (f2bf(hi) << 16); }
typedef _Float16 f16x2_t __attribute__((ext_vector_type(2)));
__device__ __forceinline__ unsigned pkh2(float lo, float hi) { f32x2 v = {lo, hi}; return __builtin_bit_cast(unsigned, __builtin_convertvector(v, f16x2_t)); }
__device__ __forceinline__ float h2f_lo(unsigned w) { return (float)__builtin_bit_cast(_Float16, (unsigned short)(w & 0xffffu)); }
__device__ __forceinline__ float h2f_hi(unsigned w) { return (float)__builtin_bit_cast(_Float16, (unsigned short)(w >> 16)); }
__device__ __forceinline__ float bf2f(unsigned short h) { return __builtin_bit_cast(float, (unsigned)h << 16); }
__device__ __forceinline__ float bflo(unsigned w) { return __builtin_bit_cast(float, w << 16); }
__device__ __forceinline__ float bfhi(unsigned w) { return __builtin_bit_cast(float, w & 0xffff0000u); }
__device__ __forceinline__ unsigned cvtpk(float lo, float hi) { unsigned r; asm volatile("v_cvt_pk_bf16_f32 %0, %1, %2" : "=v"(r) : "v"(lo), "v"(hi)); return r; }
#define WDPP(v, ctrl) __builtin_bit_cast(float, __builtin_amdgcn_update_dpp(0, __builtin_bit_cast(int, v), ctrl, 0xf, 0xf, false))
__device__ __forceinline__ float wave_sum(float v) {
    v += WDPP(v, 0xB1); v += WDPP(v, 0x4E); v += WDPP(v, 0x141); v += WDPP(v, 0x140);
    { auto rr = __builtin_amdgcn_permlane16_swap(__float_as_uint(v), __float_as_uint(v), false, false); v = __uint_as_float(rr[0]) + __uint_as_float(rr[1]); }
    { auto rr = __builtin_amdgcn_permlane32_swap(__float_as_uint(v), __float_as_uint(v), false, false); v = __uint_as_float(rr[0]) + __uint_as_float(rr[1]); }
    return v;
}
__device__ __forceinline__ float wave_max(float v) {
    v = fmaxf(v, WDPP(v, 0xB1)); v = fmaxf(v, WDPP(v, 0x4E)); v = fmaxf(v, WDPP(v, 0x141)); v = fmaxf(v, WDPP(v, 0x140));
    { auto rr = __builtin_amdgcn_permlane16_swap(__float_as_uint(v), __float_as_uint(v), false, false); v = fmaxf(__uint_as_float(rr[0]), __uint_as_float(rr[1])); }
    { auto rr = __builtin_amdgcn_permlane32_swap(__float_as_uint(v), __float_as_uint(v), false, false); v = fmaxf(__uint_as_float(rr[0]), __uint_as_float(rr[1])); }
    return v;
}

constexpr int DM = 1024, NB = 4, SEQ = 4096, CTXL = 256;
constexpr int RPB = SEQ + CTXL;
constexpr int R = NB * RPB;
constexpr float EPS = 1e-6f;
constexpr int NTHREADS = 512, NWAVES = 8;
constexpr int LDS_BYTES = 147456;

enum { I_X = 0, I_C, I_CTX, I_CCTX,
       I0_ADAW, I0_ADAB, I0_NMIX, I0_NFFN, I0_WIN, I0_QN, I0_WUQ, I0_KVN, I0_WUKV, I0_WO, I0_PWQ, I0_PK1, I0_PK2, I0_PU, I0_PV,
       I1_ADAW, I1_ADAB, I1_NMIX, I1_NFFN, I1_WQKV, I1_QN, I1_KN, I1_WO, I1_PWQ, I1_PK1, I1_PK2, I1_PU, I1_PV,
       I_NOUT, N_IN };

constexpr size_t MiB = 1u << 20;
constexpr size_t WS_CTL   = 0;
constexpr size_t WS_MOD   = 1 * MiB;
constexpr size_t WS_WIN   = 2 * MiB;
constexpr size_t WS_WUQ   = WS_WIN + 768 * 1024 * 2;
constexpr size_t WS_WUKV  = WS_WUQ + 1536 * 384 * 2;
constexpr size_t WS_WO0   = WS_WUKV + 2048 * 256 * 2;
constexpr size_t WS_WQ0   = WS_WO0 + 1024 * 1024 * 2;
constexpr size_t WS_KK0   = WS_WQ0 + 2048 * 1024 * 2;
constexpr size_t WS_WQKV  = WS_KK0 + 16 * 128 * 128 * 2;
constexpr size_t WS_WO1   = WS_WQKV + 1536 * 1024 * 2;
constexpr size_t WS_WQ1   = WS_WO1 + 1024 * 1024 * 2;
constexpr size_t WS_KK1   = WS_WQ1 + 2048 * 1024 * 2;
constexpr size_t WS_WEND  = WS_KK1 + 16 * 128 * 128 * 2;
static_assert(WS_WEND <= 24 * MiB, "weights region");
constexpr size_t WS_H     = 24 * MiB;
constexpr size_t WS_X     = WS_H + (size_t)R * 1024 * 2;
constexpr size_t WS_QKV   = WS_X + (size_t)R * 1024 * 4;
constexpr size_t WS_Q     = WS_QKV;
constexpr size_t WS_K     = WS_Q + (size_t)R * 1536 * 2;
constexpr size_t WS_V     = WS_K + (size_t)R * 1536 * 2;
constexpr size_t WS_S     = WS_QKV;
constexpr size_t WS_B     = WS_QKV + (size_t)R * 2048 * 4;
constexpr size_t WS_CQ    = WS_B;
constexpr size_t WS_CKV   = WS_CQ + (size_t)R * 384 * 2;
constexpr size_t WS_KR    = WS_CKV + (size_t)R * 256 * 2;
constexpr size_t WS_SSP   = WS_KR + (size_t)R * 64 * 2;
static_assert(WS_SSP + (size_t)R * 24 * 4 <= WS_B + 40 * MiB, "MLA latents inside region B");
constexpr size_t WS_O     = WS_B;
constexpr size_t WS_QP    = WS_B;
constexpr size_t WS_RAW1  = WS_B;
constexpr size_t WS_PK    = WS_B + (size_t)R * 2048 * 2;
constexpr size_t WS_TAB   = WS_PK + (size_t)R * 128 * 4;
constexpr size_t WS_PD    = WS_S;
constexpr size_t WS_WQ8   = WS_PD + (size_t)8 * R * 128 * 4;
constexpr size_t WS_WSC   = WS_WQ8 + (size_t)R * 128;
static_assert(WS_WSC + (size_t)R * 4 <= WS_B, "expert scratch inside the S region");
constexpr size_t WS_HQ    = WS_B + 40 * MiB;
constexpr size_t WS_HS    = WS_HQ + (size_t)R * 1024;
static_assert(WS_HS + (size_t)R * 4 <= WS_PK, "HQ inside region B");
constexpr size_t WS_TSC   = WS_TAB + (size_t)4 * 16384 * 1024;
constexpr size_t WS_END   = WS_TSC + (size_t)4 * 16384 * 4;
constexpr size_t WS_Q1    = WS_QKV;
constexpr size_t WS_K1    = WS_Q1 + (size_t)R * 1024 * 2;
constexpr size_t WS_V1    = WS_K1 + (size_t)R * 256 * 2;

#define XB_TMO      128
#define XB_XCNT(j)  (256  + 64 * (j))
#define XB_XSUB(j)  (1280 + 64 * (j))
#define XB_XGEN(j)  (2304 + 64 * (j))
#define XB_TOP      3328
#define XB_TOPGEN   3392
#define XCD_BAR_WORDS 3456
#define XB_SPIN_CAP (1u << 20)
__device__ __forceinline__ unsigned xb_ld(unsigned* p)              { return __hip_atomic_load(p, __ATOMIC_RELAXED, __HIP_MEMORY_SCOPE_AGENT); }
__device__ __forceinline__ unsigned xb_add(unsigned* p, unsigned v) { return __hip_atomic_fetch_add(p, v, __ATOMIC_RELAXED, __HIP_MEMORY_SCOPE_AGENT); }
__device__ __forceinline__ unsigned xb_xcc_id() { return (unsigned)__builtin_amdgcn_s_getreg((3 << 11) | 20) & 0xFu; }
#define XB_SPIN(cond, bar) do { unsigned _sp = 0; while (cond) { __builtin_amdgcn_s_sleep(1); \
    if ((++_sp & 255u) == 0u) { if (xb_ld(&(bar)[XB_TMO])) break; if (_sp > XB_SPIN_CAP) { atomicAdd(&(bar)[XB_TMO], 1u); break; } } } } while (0)
struct XcdBarrier { unsigned* bar; unsigned x; volatile LAS unsigned* st; };
__device__ __forceinline__ XcdBarrier xcd_barrier_post(unsigned* bar, volatile LAS unsigned* st) {
    XcdBarrier b; b.bar = bar; b.x = xb_xcc_id(); b.st = st;
    if (threadIdx.x == 0) (void)xb_add(&bar[XB_XCNT(b.x)], 1u);
    return b;
}
__device__ __forceinline__ void xcd_barrier_complete(unsigned* bar, unsigned x, unsigned& nloc, unsigned& nx) {
    const unsigned G = gridDim.x * gridDim.y * gridDim.z;
    unsigned sum, cnt, mine, sp = 0u;
    for (;;) {
        sum = 0u; cnt = 0u; mine = 0u;
#pragma unroll
        for (unsigned j = 0; j < 16; ++j) { const unsigned c = xb_ld(&bar[XB_XCNT(j)]); sum += c; cnt += (c > 0u) ? 1u : 0u; mine = (j == x) ? c : mine; }
        if (sum == G) break;
        __builtin_amdgcn_s_sleep(1);
        if ((++sp & 255u) == 0u) { if (xb_ld(&bar[XB_TMO])) break; if (sp > XB_SPIN_CAP) { atomicAdd(&bar[XB_TMO], 1u); break; } }
    }
    nloc = mine > 0u ? mine : 1u; nx = cnt > 0u ? cnt : 1u;
}
__device__ __forceinline__ void xcd_barrier(const XcdBarrier& b) {
    asm volatile("s_waitcnt vmcnt(0)" ::: "memory");
    __syncthreads();
    if (threadIdx.x == 0) {
        unsigned* bar = b.bar;
        __builtin_amdgcn_s_waitcnt(0);
        unsigned nloc = b.st[0], nx = b.st[1];
        if (nloc == 0u) { xcd_barrier_complete(bar, b.x, nloc, nx); b.st[0] = nloc; b.st[1] = nx; }
        const unsigned old = xb_add(&bar[XB_XSUB(b.x)], 1u);
        const unsigned gen = old / nloc;
        if (old + 1u == (gen + 1u) * nloc) {
            __builtin_amdgcn_fence(__ATOMIC_RELEASE, "agent");
            asm volatile("s_waitcnt vmcnt(0)" ::: "memory");
            const unsigned og = xb_add(&bar[XB_TOP], 1u);
            const unsigned tg = og / nx;
            if (og + 1u == (tg + 1u) * nx) xb_add(&bar[XB_TOPGEN], 1u);
            else XB_SPIN(xb_ld(&bar[XB_TOPGEN]) == tg, bar);
            __builtin_amdgcn_fence(__ATOMIC_ACQUIRE, "agent");
            xb_add(&bar[XB_XGEN(b.x)], 1u);
            asm volatile("s_waitcnt vmcnt(0)" ::: "memory");
        } else {
            XB_SPIN(xb_ld(&bar[XB_XGEN(b.x)]) == gen, bar);
            __builtin_amdgcn_fence(__ATOMIC_ACQUIRE, "agent");
            asm volatile("s_waitcnt vmcnt(0)" ::: "memory");
        }
    }
    __syncthreads();
}


struct Args { const float* in[N_IN]; float* out; unsigned char* ws; int ph_lo, ph_hi; };
static_assert(sizeof(Args) == (N_IN + 2) * 8 + 8, "Args has no padding");

struct Frame {
    const float* x; const float* ctx; float* out; unsigned char* ws; char* lds;
    int tid, lane, wave, bid, nblk, vcu;
};

__device__ __forceinline__ const float* xin_row(const Frame& F, int r) {
    const int b = r / RPB, j = r - b * RPB;
    return (j < CTXL) ? F.ctx + ((size_t)b * CTXL + j) * DM : F.x + ((size_t)b * SEQ + (j - CTXL)) * DM;
}
__device__ __forceinline__ int mod_index(int r) { const int b = r / RPB, j = r - b * RPB; return (j < CTXL) ? 4 : b; }
__device__ __forceinline__ bool is_ctx_row(int r) { return (r % RPB) < CTXL; }

__device__ __forceinline__ void p0_mod(const Args& A, const Frame& F) {
    float* sv = (float*)F.lds;
    float* red = sv + 5 * 1024;
    float* MOD = (float*)(F.ws + WS_MOD);
    bool have = false;
    for (int it = F.bid; it < 2 * 96; it += F.nblk) {
        if (!have) {
            for (int i = F.tid; i < 5 * 1024; i += NTHREADS) { const int m = i >> 10, k = i & 1023;
                const float c = (m < 4) ? A.in[I_C][m * 1024 + k] : A.in[I_CCTX][k]; sv[i] = c / (1.f + __expf(-c)); }
            __syncthreads(); have = true;
        }
        const int l = it / 96, n = (it % 96) * 64 + F.lane;
        const float* W = A.in[l ? I1_ADAW : I0_ADAW]; const float* Bv = A.in[l ? I1_ADAB : I0_ADAB];
        float acc[5] = {0.f, 0.f, 0.f, 0.f, 0.f};
        const int k0 = F.wave * 128;
#pragma unroll 16
        for (int k = k0; k < k0 + 128; ++k) { const float w = W[(size_t)k * 6144 + n];
#pragma unroll
            for (int m = 0; m < 5; ++m) acc[m] += sv[m * 1024 + k] * w; }
#pragma unroll
        for (int m = 0; m < 5; ++m) red[(F.wave * 5 + m) * 64 + F.lane] = acc[m];
        __syncthreads();
        if (F.tid < 320) { const int m = F.tid >> 6, ln = F.tid & 63; float s = 0.f;
#pragma unroll
            for (int w = 0; w < 8; ++w) s += red[(w * 5 + m) * 64 + ln];
            const int nn = (it % 96) * 64 + ln;
            MOD[((size_t)l * 5 + m) * 6144 + nn] = s + Bv[nn]; }
        __syncthreads();
    }
}
__device__ __forceinline__ void transpose_item(const float* W, int K, int N, bf16_t* WT, const float* gain, float* scr, int item, int lane) {
    const int nblk = N / 32, kb = item / nblk, nb = item % nblk, k0 = 64 * kb, n0 = 32 * nb;
#pragma unroll 8
    for (int i = 0; i < 32; ++i) { const int kk = 2 * i + (lane >> 5); float v = W[(size_t)(k0 + kk) * N + n0 + (lane & 31)]; if (gain) v *= gain[k0 + kk]; scr[kk * 33 + (lane & 31)] = v; }
    asm volatile("s_waitcnt lgkmcnt(0)" ::: "memory");
    const int c = lane & 7;
#pragma unroll
    for (int j = 0; j < 4; ++j) { const int n = (lane >> 3) + 8 * j; const float* s = scr + (8 * c) * 33 + n;
        u32x4 o; o.x = pk2(s[0 * 33], s[1 * 33]); o.y = pk2(s[2 * 33], s[3 * 33]); o.z = pk2(s[4 * 33], s[5 * 33]); o.w = pk2(s[6 * 33], s[7 * 33]);
        *(u32x4*)(WT + (size_t)(n0 + n) * K + k0 + 8 * c) = o; }
    asm volatile("s_waitcnt lgkmcnt(0)" ::: "memory");
}
__device__ __forceinline__ void p0_weights(const Args& A, const Frame& F) {
    float* scr = (float*)(F.lds + 32768) + F.wave * (64 * 33);
    const int gw = F.bid * NWAVES + F.wave, NGW = F.nblk * NWAVES;
#define TJOB(IN_, K_, N_, OFF_, GAIN_) do { const float* W = A.in[IN_]; bf16_t* WT = (bf16_t*)(F.ws + (OFF_)); \
        for (int it = gw; it < ((K_) / 64) * ((N_) / 32); it += NGW) transpose_item(W, K_, N_, WT, GAIN_, scr, it, F.lane); } while (0)
    TJOB(I0_WIN, 1024, 704, WS_WIN, nullptr); TJOB(I0_WUQ, 384, 1536, WS_WUQ, A.in[I0_QN]); TJOB(I0_WUKV, 256, 2048, WS_WUKV, A.in[I0_KVN]); TJOB(I0_WO, 1024, 1024, WS_WO0, nullptr);
    TJOB(I1_WQKV, 1024, 1536, WS_WQKV, nullptr); TJOB(I1_WO, 1024, 1024, WS_WO1, nullptr);
#undef TJOB
    { u32x4* z = (u32x4*)(F.ws + WS_WIN + (size_t)704 * 1024 * 2); const int n16 = 64 * 1024 * 2 / 16;
      for (int i = F.bid * NTHREADS + F.tid; i < n16; i += F.nblk * NTHREADS) z[i] = (u32x4){0u, 0u, 0u, 0u}; }
}
__device__ __forceinline__ void p0_weff(const Args& A, const Frame& F) {
    float* kkT = (float*)F.lds; float* wqs = kkT + 128 * 129;
    const int tid = F.tid, lane = F.lane, w = F.wave;
    for (int item = F.bid; item < 512; item += F.nblk) {
        const int layer = item >> 8, z = (item >> 4) & 15, kc = item & 15, h = z >> 1;
        const float* kk = ((z & 1) ? (layer ? A.in[I1_PK2] : A.in[I0_PK2]) : (layer ? A.in[I1_PK1] : A.in[I0_PK1])) + (size_t)h * 16384;
        const float* wq = (layer ? A.in[I1_PWQ] : A.in[I0_PWQ]) + (size_t)(kc * 64) * 2048 + z * 128;
        bf16_t* WT = (bf16_t*)(F.ws + (layer ? WS_WQ1 : WS_WQ0));
        __syncthreads();
        { f32x4 kv[8], wv4[4];
#pragma unroll
          for (int i = 0; i < 8; ++i) kv[i] = *(const f32x4*)(kk + 4 * (tid + i * NTHREADS));
#pragma unroll
          for (int i = 0; i < 4; ++i) { const int e = 4 * (tid + i * NTHREADS); wv4[i] = *(const f32x4*)(wq + (size_t)(e >> 7) * 2048 + (e & 127)); }
#pragma unroll
          for (int i = 0; i < 8; ++i) { const int e = 4 * (tid + i * NTHREADS), key = e >> 7, d = e & 127; kkT[d * 129 + key] = kv[i].x; kkT[(d + 1) * 129 + key] = kv[i].y; kkT[(d + 2) * 129 + key] = kv[i].z; kkT[(d + 3) * 129 + key] = kv[i].w; }
#pragma unroll
          for (int i = 0; i < 4; ++i) *(f32x4*)(wqs + 4 * (tid + i * NTHREADS)) = wv4[i]; }
        __syncthreads();
        float acc[8][2];
#pragma unroll
        for (int j = 0; j < 8; ++j) { acc[j][0] = 0.f; acc[j][1] = 0.f; }
#pragma unroll 2
        for (int d = 0; d < 128; ++d) { const float a0 = kkT[d * 129 + lane], a1 = kkT[d * 129 + lane + 64];
#pragma unroll
            for (int j = 0; j < 8; ++j) { const float wv = wqs[(w * 8 + j) * 128 + d]; acc[j][0] += wv * a0; acc[j][1] += wv * a1; } }
        u32x4 o0, o1;
        o0.x = pk2(acc[0][0], acc[1][0]); o0.y = pk2(acc[2][0], acc[3][0]); o0.z = pk2(acc[4][0], acc[5][0]); o0.w = pk2(acc[6][0], acc[7][0]);
        o1.x = pk2(acc[0][1], acc[1][1]); o1.y = pk2(acc[2][1], acc[3][1]); o1.z = pk2(acc[4][1], acc[5][1]); o1.w = pk2(acc[6][1], acc[7][1]);
        *(u32x4*)(WT + (size_t)(z * 128 + lane) * 1024 + kc * 64 + w * 8) = o0;
        *(u32x4*)(WT + (size_t)(z * 128 + lane + 64) * 1024 + kc * 64 + w * 8) = o1;
    }
    __syncthreads();
}

__device__ __forceinline__ void p0_tables(const Args& A, const Frame& F) {
    const int gw = F.bid * NWAVES + F.wave, NGW = F.nblk * NWAVES, lane = F.lane;
    unsigned char* TAB = F.ws + WS_TAB; float* TSC = (float*)(F.ws + WS_TSC);
    for (int it = gw; it < 4 * 16384 / 4; it += NGW) {
        const int t = it >> 12, row0 = (it & 4095) * 4;
        const float* src = (t == 0 ? A.in[I0_PU] : t == 1 ? A.in[I0_PV] : t == 2 ? A.in[I1_PU] : A.in[I1_PV]) + (size_t)row0 * 1024 + 4 * lane;
        f32x4 v[4][4];
#pragma unroll
        for (int rr = 0; rr < 4; ++rr)
#pragma unroll
            for (int j = 0; j < 4; ++j) v[rr][j] = *(const f32x4*)(src + (size_t)rr * 1024 + 256 * j);
#pragma unroll
        for (int rr = 0; rr < 4; ++rr) {
            float am = 0.f;
#pragma unroll
            for (int j = 0; j < 4; ++j) am = fmaxf(am, fmaxf(fmaxf(fabsf(v[rr][j].x), fabsf(v[rr][j].y)), fmaxf(fabsf(v[rr][j].z), fabsf(v[rr][j].w))));
            am = wave_max(am);
            const float sc = am > 0.f ? am * (1.f / 127.f) : 1.f, inv = am > 0.f ? 127.f / am : 0.f;
            const int row = row0 + rr;
#pragma unroll
            for (int j = 0; j < 4; ++j) { const unsigned b0 = (unsigned)((int)rintf(v[rr][j].x * inv)) & 0xffu, b1 = (unsigned)((int)rintf(v[rr][j].y * inv)) & 0xffu, b2 = (unsigned)((int)rintf(v[rr][j].z * inv)) & 0xffu, b3 = (unsigned)((int)rintf(v[rr][j].w * inv)) & 0xffu;
                *(unsigned*)(TAB + (((size_t)t * 8 + 2 * j + (lane >> 5)) * 16384 + row) * 128 + 4 * (lane & 31)) = b0 | (b1 << 8) | (b2 << 16) | (b3 << 24); }
            if (lane == 0) TSC[t * 16384 + row] = sc;
        }
    }
}

__device__ __forceinline__ void norm_mod_store(const f32x4 (&v)[4], float rinv, const float* g, const float* sh, const float* sc, bf16_t* orow, int lane) {
#pragma unroll
    for (int j = 0; j < 4; ++j) { const int c = 4 * lane + 256 * j;
        const f32x4 gg = *(const f32x4*)(g + c), s1 = *(const f32x4*)(sc + c), s0 = *(const f32x4*)(sh + c);
        const f32x4 y = (v[j] * rinv * gg) * (s1 + 1.f) + s0;
        u32x2 o; o.x = pk2(y.x, y.y); o.y = pk2(y.z, y.w); *(u32x2*)(orow + c) = o; }
}
__device__ __forceinline__ int tok_row(int layer, int n);
__device__ __forceinline__ void norm_row_out(const Frame& F, const f32x4 (&v)[4], float rinv, const float* g, const float* mm, int r, int which) {
    norm_mod_store(v, rinv, g, mm, mm + 1024, (bf16_t*)(F.ws + WS_H) + (size_t)r * DM, F.lane);
    if (which) {
        f32x4 y[4]; float am = 0.f;
#pragma unroll
        for (int j = 0; j < 4; ++j) { const int c = 4 * F.lane + 256 * j; y[j] = (v[j] * rinv * *(const f32x4*)(g + c)) * (*(const f32x4*)(mm + 1024 + c) + 1.f) + *(const f32x4*)(mm + c);
            am = fmaxf(am, fmaxf(fmaxf(fabsf(y[j].x), fabsf(y[j].y)), fmaxf(fabsf(y[j].z), fabsf(y[j].w)))); }
        am = wave_max(am);
        const float inv = am > 0.f ? 127.f / am : 0.f;
#pragma unroll
        for (int j = 0; j < 4; ++j) { const unsigned b0 = (unsigned)((int)rintf(y[j].x * inv)) & 0xffu, b1 = (unsigned)((int)rintf(y[j].y * inv)) & 0xffu, b2 = (unsigned)((int)rintf(y[j].z * inv)) & 0xffu, b3 = (unsigned)((int)rintf(y[j].w * inv)) & 0xffu;
            *(unsigned*)(F.ws + WS_HQ + (size_t)r * DM + 4 * F.lane + 256 * j) = b0 | (b1 << 8) | (b2 << 16) | (b3 << 24); }
        if (F.lane == 0) ((float*)(F.ws + WS_HS))[r] = am > 0.f ? am * (1.f / 127.f) : 1.f;
    }
}
__device__ __forceinline__ void p_norm_rows(const Args& A, const Frame& F, int layer, int which, bool from_input, bool skip_ctx) {
    const int gw = F.bid * NWAVES + F.wave, NGW = F.nblk * NWAVES;
    const float* g = A.in[layer ? (which ? I1_NFFN : I1_NMIX) : (which ? I0_NFFN : I0_NMIX)];
    const float* MOD = (const float*)(F.ws + WS_MOD) + (size_t)layer * 5 * 6144;
    const unsigned short* X = (const unsigned short*)(F.ws + WS_X);
    const int ntok = skip_ctx ? NB * SEQ : R;
    for (int n = gw; n < ntok; n += 2 * NGW) {
        const bool has1 = (n + NGW) < ntok;
        const int r0 = skip_ctx ? tok_row(1, n) : n, r1 = has1 ? (skip_ctx ? tok_row(1, n + NGW) : n + NGW) : r0;
        f32x4 v0[4], v1[4]; float s0 = 0.f, s1 = 0.f;
        if (from_input) { const float* x0 = xin_row(F, r0); const float* x1 = xin_row(F, r1);
#pragma unroll
            for (int j = 0; j < 4; ++j) { v0[j] = *(const f32x4*)(x0 + 4 * F.lane + 256 * j); v1[j] = *(const f32x4*)(x1 + 4 * F.lane + 256 * j); } }
        else {
#pragma unroll
            for (int j = 0; j < 4; ++j) { const u32x2 a = *(const u32x2*)(X + (size_t)r0 * DM + 4 * F.lane + 256 * j), b = *(const u32x2*)(X + (size_t)r1 * DM + 4 * F.lane + 256 * j);
                v0[j] = (f32x4){h2f_lo(a.x), h2f_hi(a.x), h2f_lo(a.y), h2f_hi(a.y)}; v1[j] = (f32x4){h2f_lo(b.x), h2f_hi(b.x), h2f_lo(b.y), h2f_hi(b.y)}; } }
#pragma unroll
        for (int j = 0; j < 4; ++j) { s0 += (v0[j].x * v0[j].x + v0[j].y * v0[j].y) + (v0[j].z * v0[j].z + v0[j].w * v0[j].w); s1 += (v1[j].x * v1[j].x + v1[j].y * v1[j].y) + (v1[j].z * v1[j].z + v1[j].w * v1[j].w); }
        const float ri0 = rsqrtf(wave_sum(s0) * (1.f / DM) + EPS), ri1 = rsqrtf(wave_sum(s1) * (1.f / DM) + EPS);
        norm_row_out(F, v0, ri0, g, MOD + (size_t)mod_index(r0) * 6144 + (which ? 3 * 1024 : 0), r0, which);
        if (has1) norm_row_out(F, v1, ri1, g, MOD + (size_t)mod_index(r1) * 6144 + (which ? 3 * 1024 : 0), r1, which);
    }
}

namespace pg8 {
#define PG8_LAS __attribute__((address_space(3)))
typedef unsigned short bf16_t;
typedef short bf16x8 __attribute__((ext_vector_type(8)));
typedef float f32x4 __attribute__((ext_vector_type(4)));
typedef unsigned u32x4 __attribute__((ext_vector_type(4)));
constexpr int BM = 256, BK = 64, HALF = 128, HTB = HALF * BK * 2  , STAGE_BYTES = 8 * HTB, NXCD = 8, WGM = 8;

__host__ __device__ __forceinline__ int lds_byte(int r, int c) { const int st = (r >> 4) * 2 + (c >> 5), rr = r & 15, cc = c & 31, ob = rr * 64 + cc * 2; return st * 1024 + (ob ^ (((ob >> 9) & 1) << 5)); }
__host__ __device__ __forceinline__ void stage_rc(int b, int& R, int& C) { const int st = b / 1024, sb = b % 1024, swz = sb ^ (((sb >> 9) & 1) << 5); R = (st >> 1) * 16 + swz / 64; C = (st & 1) * 32 + (swz % 64) / 2; }
__host__ __device__ __forceinline__ int perm32(int rho) { const int n = rho >> 4, i = rho & 15; return 8 * (i >> 2) + 4 * n + (i & 3); }

struct Unit { int pm, pn; };
struct Gemm { const bf16_t* A; const bf16_t* Bt; int M, N, K; };

struct StaticOrder {
    int nM, nN, nwg, G, c;
    __host__ __device__ void init(int M, int N, int G_, int c_) { nM = M / BM; nN = N / BM; nwg = nM * nN; G = G_; c = c_; }
    __host__ __device__ bool next(int i, Unit& u) const {
        const long L = (long)i * G + c; if (L >= nwg) return false;
        int wgid = (int)L; { const int q = nwg / NXCD, r = nwg % NXCD, xcd = wgid % NXCD, off = wgid / NXCD; wgid = (xcd < r ? xcd * (q + 1) : r * (q + 1) + (xcd - r) * q) + off; }
        const int nig = WGM * nN, gid = wgid / nig, fm = gid * WGM, gsz = (nM - fm) < WGM ? (nM - fm) : WGM;
        u.pm = fm + ((wgid % nig) % gsz); u.pn = (wgid % nig) / gsz; return true;
    }
    __device__ __forceinline__ void a_ready(const Unit&) const {}
    __device__ __forceinline__ void done(const Unit&) const {}
};

template <class Epi, class Sched, bool ALIGN_EPI = false, bool SP2 = false>
__device__ __forceinline__ void gemm_phase(PG8_LAS unsigned char* lds, const Gemm g, const Sched& S, const Epi& E) {
    const int tid = threadIdx.x, wid = __builtin_amdgcn_readfirstlane(tid >> 6), lane = tid & 63, wr = wid >> 2, wc = wid & 3, fr = lane & 15, fq = lane >> 4;
    const int K = g.K, nt = K / BK;
    unsigned voffA[2], voffB[2];
#pragma unroll
    for (int i = 0; i < 2; ++i) { int R, C; stage_rc(tid * 16 + i * 8192, R, C); const int Rb = Epi::PERM ? ((R & ~31) + perm32(R & 31)) : R;
        voffA[i] = (unsigned)(R * K + C) * 2u; voffB[i] = (unsigned)(Rb * K + C) * 2u; }
    const size_t kstep = (size_t)(BK * 2);
    const size_t hstep = (size_t)HALF * K * 2;
    const size_t tstep = 2 * hstep;
    const unsigned ldsw = (unsigned)wid * 1024u;
    const int aoff = lds_byte(wr * 64 + fr, fq * 8), boff = lds_byte(wc * 32 + fr, fq * 8);
#define PG8_SA(b, h) (((b) * 2 + (h)) * HTB)
#define PG8_SB(b, h) ((4 + (b) * 2 + (h)) * HTB)
#define PG8_STAGE(bufoff, gbase, voff) do { _Pragma("unroll") for (int _i = 0; _i < 2; ++_i) \
        __builtin_amdgcn_global_load_lds((const unsigned*)((const char*)(gbase) + (voff)[_i]), (PG8_LAS unsigned*)(lds + (bufoff) + ldsw + _i * 8192), 16, 0, 0); } while (0)
#define PG8_LDA(dst, b, h) do { _Pragma("unroll") for (int m = 0; m < 4; ++m) _Pragma("unroll") for (int k = 0; k < 2; ++k) dst[m][k] = *(const PG8_LAS bf16x8*)(lds + PG8_SA(b, h) + aoff + m * 2048 + k * 1024); } while (0)
#define PG8_LDB(dst, b, h) do { _Pragma("unroll") for (int n = 0; n < 2; ++n) _Pragma("unroll") for (int k = 0; k < 2; ++k) dst[n][k] = *(const PG8_LAS bf16x8*)(lds + PG8_SB(b, h) + boff + n * 2048 + k * 1024); } while (0)
#define PG8_MMA(ai, bj, At, Bt) do { __builtin_amdgcn_s_setprio(1); _Pragma("unroll") for (int m = 0; m < 4; ++m) _Pragma("unroll") for (int n = 0; n < 2; ++n) _Pragma("unroll") for (int k = 0; k < 2; ++k) \
        acc[ai][bj][m][n] = __builtin_amdgcn_mfma_f32_16x16x32_bf16(Bt[n][k], At[m][k], acc[ai][bj][m][n], 0, 0, 0); __builtin_amdgcn_s_setprio(0); } while (0)
#define PG8_WAIT_V(n) asm volatile("s_waitcnt vmcnt(" #n ")" ::: "memory")
#define PG8_WAIT_L(n) asm volatile("s_waitcnt lgkmcnt(" #n ")" ::: "memory")
#define PG8_BAR __builtin_amdgcn_s_barrier()
#define PG8_SCHED __builtin_amdgcn_sched_barrier(0)
    Unit cur, nxt; int ui = 0;
    if (!S.next(0, cur)) return;
    f32x4 acc[2][2][4][2];
#pragma unroll
    for (int a = 0; a < 2; ++a)
#pragma unroll
        for (int b = 0; b < 2; ++b)
#pragma unroll
            for (int m = 0; m < 4; ++m)
#pragma unroll
                for (int n = 0; n < 2; ++n) acc[a][b][m][n] = (f32x4){0.f, 0.f, 0.f, 0.f};
    bf16x8 At[4][2], B0[2][2], B1[2][2];
    const char* cA = (const char*)g.A + (size_t)cur.pm * tstep; const char* cB = (const char*)g.Bt + (size_t)cur.pn * tstep;
    S.a_ready(cur);
    if constexpr (SP2) {
        PG8_STAGE(PG8_SB(0, 0), cB, voffB); PG8_STAGE(PG8_SB(0, 1), cB + hstep, voffB); PG8_STAGE(PG8_SA(0, 0), cA, voffA); PG8_STAGE(PG8_SA(0, 1), cA + hstep, voffA);
        if (wr == 1) PG8_BAR;
        PG8_WAIT_V(2); PG8_BAR;
        PG8_STAGE(PG8_SB(1, 0), cB + kstep, voffB); PG8_STAGE(PG8_SA(1, 0), cA + kstep, voffA); PG8_STAGE(PG8_SB(1, 1), cB + hstep + kstep, voffB);
        PG8_WAIT_V(6); PG8_BAR;
    } else {
        PG8_STAGE(PG8_SB(0, 0), cB, voffB); PG8_STAGE(PG8_SA(0, 0), cA, voffA); PG8_STAGE(PG8_SB(0, 1), cB + hstep, voffB); PG8_STAGE(PG8_SA(0, 1), cA + hstep, voffA);
        if (wr == 1) PG8_BAR;
        PG8_WAIT_V(4); PG8_BAR;
        PG8_STAGE(PG8_SB(1, 0), cB + kstep, voffB); PG8_STAGE(PG8_SA(1, 0), cA + kstep, voffA); PG8_STAGE(PG8_SB(1, 1), cB + hstep + kstep, voffB);
        PG8_WAIT_V(6); PG8_BAR;
    }
    for (;;) {
        const bool has_next = S.next(ui + 1, nxt);
        const char* nA = has_next ? (const char*)g.A + (size_t)nxt.pm * tstep : cA; const char* nB = has_next ? (const char*)g.Bt + (size_t)nxt.pn * tstep : cB;
        for (int t = 0; t < nt; t += 2) {
            const bool last = (t == nt - 2);
            const char* a1 = cA + (size_t)(t + 1) * kstep;
            const char* a2 = last ? nA : cA + (size_t)(t + 2) * kstep; const char* b2 = last ? nB : cB + (size_t)(t + 2) * kstep;
            const char* a3 = a2 + kstep; const char* b3 = b2 + kstep;
            if (last && has_next) S.a_ready(nxt);
            if constexpr (SP2) {
            PG8_LDB(B0, 0, 0); PG8_LDB(B1, 0, 1); PG8_SCHED; PG8_LDA(At, 0, 0); PG8_STAGE(PG8_SA(1, 1), a1 + hstep, voffA);
            PG8_WAIT_V(8); PG8_WAIT_L(0); PG8_BAR; PG8_MMA(0, 0, At, B0); PG8_MMA(0, 1, At, B1); PG8_BAR; PG8_SCHED;
            PG8_LDA(At, 0, 1); PG8_STAGE(PG8_SB(0, 0), b2, voffB); PG8_STAGE(PG8_SB(0, 1), b2 + hstep, voffB); PG8_STAGE(PG8_SA(0, 0), a2, voffA);
            PG8_WAIT_V(8); PG8_WAIT_L(0); PG8_BAR; PG8_MMA(1, 0, At, B0); PG8_MMA(1, 1, At, B1); PG8_BAR; PG8_SCHED;
            PG8_LDB(B0, 1, 0); PG8_LDB(B1, 1, 1); PG8_SCHED; PG8_LDA(At, 1, 0); PG8_STAGE(PG8_SA(0, 1), a2 + hstep, voffA);
            PG8_WAIT_V(8); PG8_WAIT_L(0); PG8_BAR; PG8_MMA(0, 0, At, B0); PG8_MMA(0, 1, At, B1); PG8_BAR; PG8_SCHED;
            PG8_LDA(At, 1, 1); PG8_STAGE(PG8_SB(1, 0), b3, voffB); PG8_STAGE(PG8_SB(1, 1), b3 + hstep, voffB); PG8_STAGE(PG8_SA(1, 0), a3, voffA);
            PG8_WAIT_V(8); PG8_WAIT_L(0); PG8_BAR; PG8_MMA(1, 0, At, B0); PG8_MMA(1, 1, At, B1); PG8_BAR; PG8_SCHED;
            } else {
            PG8_LDB(B0, 0, 0); PG8_SCHED; PG8_LDA(At, 0, 0); PG8_STAGE(PG8_SA(1, 1), a1 + hstep, voffA);
            PG8_WAIT_L(8); PG8_BAR; PG8_WAIT_L(0); PG8_MMA(0, 0, At, B0); PG8_BAR; PG8_SCHED;
            PG8_LDB(B1, 0, 1); PG8_STAGE(PG8_SB(0, 0), b2, voffB);
            PG8_BAR; PG8_WAIT_L(0); PG8_MMA(0, 1, At, B1); PG8_BAR;
            PG8_LDA(At, 0, 1); PG8_STAGE(PG8_SA(0, 0), a2, voffA);
            PG8_BAR; PG8_WAIT_L(0); PG8_MMA(1, 0, At, B0); PG8_BAR; PG8_SCHED;
            PG8_STAGE(PG8_SB(0, 1), b2 + hstep, voffB);
            PG8_WAIT_V(6); PG8_BAR; PG8_MMA(1, 1, At, B1); PG8_BAR;
            PG8_LDB(B0, 1, 0); PG8_SCHED; PG8_LDA(At, 1, 0); PG8_STAGE(PG8_SA(0, 1), a2 + hstep, voffA);
            PG8_WAIT_L(8); PG8_BAR; PG8_WAIT_L(0); PG8_MMA(0, 0, At, B0); PG8_BAR; PG8_SCHED;
            PG8_LDB(B1, 1, 1); PG8_STAGE(PG8_SB(1, 0), b3, voffB);
            PG8_BAR; PG8_WAIT_L(0); PG8_MMA(0, 1, At, B1); PG8_BAR;
            PG8_LDA(At, 1, 1); PG8_STAGE(PG8_SA(1, 0), a3, voffA);
            PG8_BAR; PG8_WAIT_L(0); PG8_MMA(1, 0, At, B0); PG8_BAR; PG8_SCHED;
            PG8_STAGE(PG8_SB(1, 1), b3 + hstep, voffB);
            PG8_WAIT_V(6); PG8_BAR; PG8_MMA(1, 1, At, B1); PG8_BAR;
            }
        }
        if constexpr (ALIGN_EPI) { if (wr == 0) PG8_BAR; }
        if constexpr (!Epi::AFTER_DRAIN) { E(acc, cur, wr, wc, fr, fq); S.done(cur); }
        if (!has_next) break;
#pragma unroll
        for (int a = 0; a < 2; ++a)
#pragma unroll
            for (int b = 0; b < 2; ++b)
#pragma unroll
                for (int m = 0; m < 4; ++m)
#pragma unroll
                    for (int n = 0; n < 2; ++n) acc[a][b][m][n] = (f32x4){0.f, 0.f, 0.f, 0.f};
        cur = nxt; cA = nA; cB = nB; ++ui;
        if constexpr (ALIGN_EPI) { if (wr == 1) PG8_BAR; }
    }
    PG8_WAIT_V(0);
    if constexpr (!ALIGN_EPI) { if (wr == 0) PG8_BAR; }
    PG8_BAR;
    if constexpr (Epi::AFTER_DRAIN) { E.fused(acc, cur, wr, wc, fr, fq, lds, wid, lane); S.done(cur); }
#undef PG8_SA
#undef PG8_SB
#undef PG8_STAGE
#undef PG8_LDA
#undef PG8_LDB
#undef PG8_MMA
#undef PG8_WAIT_V
#undef PG8_WAIT_L
#undef PG8_BAR
#undef PG8_SCHED
}
}

template <class Inner> struct EpiTile { static constexpr bool PERM = true, AFTER_DRAIN = false; Inner in;
    __device__ __forceinline__ void operator()(const pg8::f32x4 (&acc)[2][2][4][2], const pg8::Unit& u, int wr, int wc, int fr, int fq) const {
#pragma unroll
        for (int ai = 0; ai < 2; ++ai)
#pragma unroll
            for (int m = 0; m < 4; ++m) { const int row = u.pm * 256 + ai * 128 + wr * 64 + m * 16 + fr;
#pragma unroll
                for (int bj = 0; bj < 2; ++bj) in(row, u.pn * 256 + bj * 128 + wc * 32 + 8 * fq, acc[ai][bj][m][0], acc[ai][bj][m][1]); }
    } };
struct In8Bf16 { bf16_t* C; int ldc;
    __device__ __forceinline__ void operator()(int row, int col, f32x4 a, f32x4 b) const { u32x4 o; o.x = cvtpk(a.x, a.y); o.y = cvtpk(a.z, a.w); o.z = cvtpk(b.x, b.y); o.w = cvtpk(b.z, b.w); *(u32x4*)(C + (size_t)row * ldc + col) = o; } };
struct In8KV { bf16_t* Kb; bf16_t* Vb;
    __device__ __forceinline__ void operator()(int row, int col, f32x4 a, f32x4 b) const { const int h = col >> 8, c = col & 255; u32x4 o; o.x = cvtpk(a.x, a.y); o.y = cvtpk(a.z, a.w); o.z = cvtpk(b.x, b.y); o.w = cvtpk(b.z, b.w);
        bf16_t* p = (c < 128) ? Kb + (size_t)row * 1536 + h * 192 + c : Vb + (size_t)row * 1024 + h * 128 + (c - 128);
        *(u32x4*)p = o; } };
struct In8F16 { unsigned short* C; int ldc;
    __device__ __forceinline__ void operator()(int row, int col, f32x4 a, f32x4 b) const { u32x4 o; o.x = pkh2(a.x, a.y); o.y = pkh2(a.z, a.w); o.z = pkh2(b.x, b.y); o.w = pkh2(b.z, b.w); *(u32x4*)(C + (size_t)row * ldc + col) = o; } };
struct In8F32 { float* C; int ldc;
    __device__ __forceinline__ void operator()(int row, int col, f32x4 a, f32x4 b) const { float* p = C + (size_t)row * ldc + col; *(f32x4*)p = a; *(f32x4*)(p + 4) = b; } };
struct In8Resid { const float* x; const float* ctx; unsigned short* X; const float* gate; bool from_input;
    __device__ __forceinline__ void operator()(int row, int col, f32x4 a, f32x4 b) const {
        const int bb = row / RPB, j = row - bb * RPB; unsigned short* xo = X + (size_t)row * DM + col;
        f32x4 x0, x1;
        if (from_input) { const float* xi = ((j < CTXL) ? ctx + ((size_t)bb * CTXL + j) * DM : x + ((size_t)bb * SEQ + (j - CTXL)) * DM) + col; x0 = *(const f32x4*)xi; x1 = *(const f32x4*)(xi + 4); }
        else { const u32x4 w = *(const u32x4*)xo; x0 = (f32x4){h2f_lo(w.x), h2f_hi(w.x), h2f_lo(w.y), h2f_hi(w.y)}; x1 = (f32x4){h2f_lo(w.z), h2f_hi(w.z), h2f_lo(w.w), h2f_hi(w.w)}; }
        const float* g = gate + (size_t)((j < CTXL) ? 4 : bb) * 6144 + col;
        x0 += *(const f32x4*)g * a; x1 += *(const f32x4*)(g + 4) * b;
        u32x4 o; o.x = pkh2(x0.x, x0.y); o.y = pkh2(x0.z, x0.w); o.z = pkh2(x1.x, x1.y); o.w = pkh2(x1.z, x1.w); *(u32x4*)xo = o; } };
struct EpiMlaDown { static constexpr bool PERM = true, AFTER_DRAIN = false; bf16_t* CQ; bf16_t* CKV; bf16_t* KR; float* SSP;
    __device__ __forceinline__ void operator()(const pg8::f32x4 (&acc)[2][2][4][2], const pg8::Unit& u, int wr, int wc, int fr, int fq) const {
#pragma unroll
        for (int ai = 0; ai < 2; ++ai)
#pragma unroll
            for (int m = 0; m < 4; ++m) { const int row = u.pm * 256 + ai * 128 + wr * 64 + m * 16 + fr;
#pragma unroll
                for (int bj = 0; bj < 2; ++bj) { const int col = u.pn * 256 + bj * 128 + wc * 32 + 8 * fq; const f32x4 a = acc[ai][bj][m][0], b = acc[ai][bj][m][1];
                    u32x4 o; o.x = cvtpk(a.x, a.y); o.y = cvtpk(a.z, a.w); o.z = cvtpk(b.x, b.y); o.w = cvtpk(b.z, b.w);
                    const int cls = (u.pn * 2 + bj);
                    if (cls < 5) { float sq = (a.x * a.x + a.y * a.y) + (a.z * a.z + a.w * a.w) + (b.x * b.x + b.y * b.y) + (b.z * b.z + b.w * b.w);
                        sq += __shfl_xor(sq, 16); sq += __shfl_xor(sq, 32);
                        if (cls < 3) *(u32x4*)(CQ + (size_t)row * 384 + col) = o; else *(u32x4*)(CKV + (size_t)row * 256 + (col - 384)) = o;
                        if (fq == 0) SSP[(size_t)row * 24 + cls * 4 + wc] = sq; }
                    else if (col < 704) *(u32x4*)(KR + (size_t)row * 64 + (col - 640)) = o; } }
    } };
struct In8Bf16Rs { bf16_t* C; int ldc; const float* ssp;
    __device__ __forceinline__ void operator()(int row, int col, f32x4 a, f32x4 b) const { const f32x4 s0 = *(const f32x4*)(ssp + (size_t)row * 24), s1 = *(const f32x4*)(ssp + (size_t)row * 24 + 4), s2 = *(const f32x4*)(ssp + (size_t)row * 24 + 8);
        const float ssum = (((s0.x + s0.y) + (s0.z + s0.w)) + ((s1.x + s1.y) + (s1.z + s1.w))) + ((s2.x + s2.y) + (s2.z + s2.w));
        const float rs = rsqrtf(ssum * (1.f / 384.f) + EPS); a *= rs; b *= rs;
        u32x4 o; o.x = cvtpk(a.x, a.y); o.y = cvtpk(a.z, a.w); o.z = cvtpk(b.x, b.y); o.w = cvtpk(b.z, b.w); *(u32x4*)(C + (size_t)row * ldc + col) = o; } };
struct In8KVRs { bf16_t* Kb; bf16_t* Vb; const float* ssp;
    __device__ __forceinline__ void operator()(int row, int col, f32x4 a, f32x4 b) const { const f32x4 s0 = *(const f32x4*)(ssp + (size_t)row * 24 + 12), s1 = *(const f32x4*)(ssp + (size_t)row * 24 + 16);
        const float ssum = ((s0.x + s0.y) + (s0.z + s0.w)) + ((s1.x + s1.y) + (s1.z + s1.w));
        const float rs = rsqrtf(ssum * (1.f / 256.f) + EPS); a *= rs; b *= rs;
        const int h = col >> 8, c = col & 255; u32x4 o; o.x = cvtpk(a.x, a.y); o.y = cvtpk(a.z, a.w); o.z = cvtpk(b.x, b.y); o.w = cvtpk(b.z, b.w);
        bf16_t* p = (c < 128) ? Kb + (size_t)row * 1536 + h * 192 + c : Vb + (size_t)row * 1024 + h * 128 + (c - 128);
        *(u32x4*)p = o; } };
struct RowSched { pg8::StaticOrder so; bool latent_only;
    __device__ __forceinline__ void init(int N, int G, int c, bool lat) { latent_only = lat; so.init(lat ? NB * SEQ : R, N, G, c); }
    __device__ __forceinline__ bool next(int i, pg8::Unit& u) const { if (!so.next(i, u)) return false; if (latent_only) u.pm = (u.pm >> 4) * 17 + 1 + (u.pm & 15); return true; }
    __device__ __forceinline__ void a_ready(const pg8::Unit&) const {}
    __device__ __forceinline__ void done(const pg8::Unit&) const {} };
template <class Inner> __device__ __forceinline__ void gemm8(const Frame& F, const bf16_t* Ap, const bf16_t* Bt, int N, int K, bool latent_only, const Inner& in) {
    asm volatile("" : "+s"(K));
    pg8::Gemm g{Ap, Bt, R, N, K}; RowSched S; S.init(N, F.nblk, F.bid, latent_only);
    EpiTile<Inner> E{in};
    pg8::gemm_phase<EpiTile<Inner>, RowSched, true, true>((PG8_LAS unsigned char*)F.lds, g, S, E);
}

template <class Epi> __device__ __forceinline__ void gemm8e(const Frame& F, const bf16_t* Ap, const bf16_t* Bt, int N, int K, bool latent_only, const Epi& E) {
    asm volatile("" : "+s"(K));
    pg8::Gemm g{Ap, Bt, R, N, K}; RowSched S; S.init(N, F.nblk, F.bid, latent_only);
    pg8::gemm_phase<Epi, RowSched, true, true>((PG8_LAS unsigned char*)F.lds, g, S, E);
}

struct GemmDesc { const bf16_t* A; int lda; long sA; const bf16_t* Bt; int ldb; long sB; int M, N, K, nz; };
template <class Epi>
__device__ __forceinline__ void gemm_simple(const Frame& F, const GemmDesc& g, const Epi& epi, bool skip_ctx) {
    const int wm = F.wave >> 1, wn = F.wave & 1, fr = F.lane & 15, fq = F.lane >> 4;
    const int tM = g.M / 128, tN = g.N / 128, per = tM * tN, total = per * g.nz;
    for (int u = F.bid; u < total; u += F.nblk) {
        const int z = u / per, uu = u - z * per, tm = uu / tN, tn = uu - tm * tN;
        if (skip_ctx && ((tm * 128) % RPB) < CTXL) continue;
        const int row0 = tm * 128 + wm * 32, col0 = tn * 128 + wn * 64;
        const bf16_t* ap = g.A + z * g.sA + (size_t)(row0 + fr) * g.lda + fq * 8;
        const bf16_t* bp = g.Bt + z * g.sB + (size_t)(col0 + fr) * g.ldb + fq * 8;
        f32x4 acc[2][4];
#pragma unroll
        for (int mi = 0; mi < 2; ++mi)
#pragma unroll
            for (int ni = 0; ni < 4; ++ni) acc[mi][ni] = (f32x4){0.f, 0.f, 0.f, 0.f};
        for (int k0 = 0; k0 < g.K; k0 += 32) {
            bf16x8 a[2], b[4];
#pragma unroll
            for (int mi = 0; mi < 2; ++mi) a[mi] = *(const bf16x8*)(ap + (size_t)mi * 16 * g.lda + k0);
#pragma unroll
            for (int ni = 0; ni < 4; ++ni) b[ni] = *(const bf16x8*)(bp + (size_t)ni * 16 * g.ldb + k0);
#pragma unroll
            for (int mi = 0; mi < 2; ++mi)
#pragma unroll
                for (int ni = 0; ni < 4; ++ni) acc[mi][ni] = __builtin_amdgcn_mfma_f32_16x16x32_bf16(b[ni], a[mi], acc[mi][ni], 0, 0, 0);
        }
#pragma unroll
        for (int mi = 0; mi < 2; ++mi)
#pragma unroll
            for (int ni = 0; ni < 4; ++ni) epi(z, row0 + mi * 16 + fr, col0 + ni * 16 + fq * 4, acc[mi][ni]);
    }
}
struct EpiBf16 { bf16_t* C; int ldc;
    __device__ __forceinline__ void operator()(int, int row, int col, f32x4 v) const { u32x2 o; o.x = pk2(v.x, v.y); o.y = pk2(v.z, v.w); *(u32x2*)(C + (size_t)row * ldc + col) = o; } };
struct EpiKV { bf16_t* Kb; bf16_t* Vb;
    __device__ __forceinline__ void operator()(int, int row, int col, f32x4 v) const { const int h = col >> 8, c = col & 255; u32x2 o; o.x = pk2(v.x, v.y); o.y = pk2(v.z, v.w);
        if (c < 128) *(u32x2*)(Kb + (size_t)row * 1536 + h * 192 + c) = o; else *(u32x2*)(Vb + (size_t)row * 1024 + h * 128 + (c - 128)) = o; } };
struct EpiF32Z { float* C; int ldc;
    __device__ __forceinline__ void operator()(int z, int row, int col, f32x4 v) const { *(f32x4*)(C + (size_t)row * ldc + z * 128 + col) = v; } };
struct EpiResid { const Frame* F; const float* gate; bool from_input;
    __device__ __forceinline__ void operator()(int, int row, int col, f32x4 v) const {
        float* X = (float*)(F->ws + WS_X) + (size_t)row * DM + col;
        const float* xi = from_input ? xin_row(*F, row) + col : X;
        const f32x4 g = *(const f32x4*)(gate + (size_t)mod_index(row) * 6144 + col);
        *(f32x4*)X = *(const f32x4*)xi + g * v; } };

__device__ __forceinline__ void rope_angles(int r, int& prow, int& pcol) { const int t = (r % RPB) - CTXL; prow = t >> 6; pcol = t & 63; }
__device__ __forceinline__ void p_mla_krope(const Args& A, const Frame& F) {
    const int gw = F.bid * NWAVES + F.wave, NGW = F.nblk * NWAVES, lane = F.lane;
    const bf16_t* KR = (const bf16_t*)(F.ws + WS_KR); bf16_t* Kb = (bf16_t*)(F.ws + WS_K);
    const float invf = __powf(10000.f, -(float)(lane & 15) * (1.f / 16.f));
    for (int r = gw; r < R; r += NGW) {
        float kr = bf2f(KR[(size_t)r * 64 + lane]);
        if (!is_ctx_row(r)) {
            int prow, pcol; rope_angles(r, prow, pcol);
            const float ang = (float)((lane & 32) ? pcol : prow) * invf;
            const float cs = cosf(ang), sn = sinf(ang);
            const float partner = __shfl_xor(kr, 16);
            kr = kr * cs + ((lane & 16) ? partner : -partner) * sn;
        }
        const bf16_t kb = (bf16_t)f2bf(kr);
#pragma unroll
        for (int h = 0; h < 8; ++h) Kb[(size_t)r * 1536 + h * 192 + 128 + lane] = kb;
    }
}
__device__ __forceinline__ float row16_sum(float v) { v += WDPP(v, 0xB1); v += WDPP(v, 0x4E); v += WDPP(v, 0x141); v += WDPP(v, 0x140); return v; }
__device__ __forceinline__ void p_gqa_rows(const Args& A, const Frame& F) {
    const int gw = F.bid * NWAVES + F.wave, NGW = F.nblk * NWAVES, lane = F.lane, c16 = lane & 15, hrow = lane >> 4;
    const bf16_t* RAW = (const bf16_t*)(F.ws + WS_RAW1); bf16_t* Q1 = (bf16_t*)(F.ws + WS_Q1); bf16_t* K1 = (bf16_t*)(F.ws + WS_K1); bf16_t* V1 = (bf16_t*)(F.ws + WS_V1);
    float qg[8], kg[8], invf[8];
#pragma unroll
    for (int e = 0; e < 8; ++e) { qg[e] = A.in[I1_QN][8 * c16 + e]; kg[e] = A.in[I1_KN][8 * c16 + e]; invf[e] = __powf(10000.f, -(float)(8 * (c16 & 3) + e) * (1.f / 32.f)); }
    const bool colaxis = (c16 & 8) != 0, hi32 = (c16 & 4) != 0;
    for (int r = gw; r < R; r += NGW) {
        const bool ctx = is_ctx_row(r);
        const bf16_t* a = RAW + (size_t)r * 1536 + 8 * lane;
        u32x4 ch[3];
#pragma unroll
        for (int j = 0; j < 3; ++j) ch[j] = (ctx && j < 2) ? (u32x4){0u, 0u, 0u, 0u} : *(const u32x4*)(a + 512 * j);
        float cs[8], sn[8];
        { int prow = 0, pcol = 0; if (!ctx) rope_angles(r, prow, pcol); const float pos = (float)(colaxis ? pcol : prow);
#pragma unroll
          for (int e = 0; e < 8; ++e) { const float ang = pos * invf[e]; cs[e] = ctx ? 1.f : __cosf(ang); sn[e] = ctx ? 0.f : __sinf(ang); } }
#pragma unroll
        for (int j = 0; j < 3; ++j) {
            if (ctx && j < 2) continue;
            const bool isv = (j == 2) && (hrow >= 2);
            float x[8];
#pragma unroll
            for (int d = 0; d < 4; ++d) { x[2 * d] = bflo(ch[j][d]); x[2 * d + 1] = bfhi(ch[j][d]); }
            float sq = 0.f;
#pragma unroll
            for (int e = 0; e < 8; ++e) sq += x[e] * x[e];
            const float rinv = rsqrtf(row16_sum(sq) * (1.f / 128.f) + EPS);
            u32x4 o;
            float y[8];
#pragma unroll
            for (int e = 0; e < 8; ++e) y[e] = x[e] * rinv * (j < 2 ? qg[e] : kg[e]);
            u32x4 yp; yp.x = pk2(y[0], y[1]); yp.y = pk2(y[2], y[3]); yp.z = pk2(y[4], y[5]); yp.w = pk2(y[6], y[7]);
            float pr[8];
#pragma unroll
            for (int d = 0; d < 4; ++d) { const float lo = __shfl_xor(y[2 * d], 4), hi2 = __shfl_xor(y[2 * d + 1], 4); pr[2 * d] = lo; pr[2 * d + 1] = hi2; }
            float z[8];
#pragma unroll
            for (int e = 0; e < 8; ++e) z[e] = y[e] * cs[e] + (hi32 ? pr[e] : -pr[e]) * sn[e];
            o.x = pk2(z[0], z[1]); o.y = pk2(z[2], z[3]); o.z = pk2(z[4], z[5]); o.w = pk2(z[6], z[7]);
            (void)yp;
            if (isv) o = ch[j];
            if (j < 2) *(u32x4*)(Q1 + (size_t)r * 1024 + 512 * j + 8 * lane) = o;
            else { bf16_t* dst = (hrow < 2) ? K1 + (size_t)r * 256 + 8 * lane : V1 + (size_t)r * 256 + 8 * (lane - 32); *(u32x4*)dst = o; }
        }
    }
}

__device__ __forceinline__ int crow(int r, int hi) { return (r & 3) + 8 * (r >> 2) + 4 * hi; }
__device__ __forceinline__ int v_st(int k, int c) { const int kk = (k & ~0xC) | ((k & 4) << 1) | ((k & 8) >> 1); return ((kk >> 3) * 4 + (c >> 5)) * 512 + ((kk & 7) * 32 + (c & 31)) * 2; }
__device__ __forceinline__ int v_rd_base(int lane) { return ((lane & 3) << 3) | (((lane >> 2) & 3) << 6) | (((lane >> 4) & 1) << 5) | (((lane >> 5) & 1) << 8); }
constexpr int v_rd_off(int d0, int ks, int half) { return d0 * 512 + ks * 4096 + half * 2048; }
template <int OFF> __device__ __forceinline__ s16x4 tr_read(int vb) { s16x4 r; asm volatile("ds_read_b64_tr_b16 %0, %1 offset:%2" : "=&v"(r) : "v"(vb), "i"(OFF) : "memory"); return r; }
template <int D0> __device__ __forceinline__ void pv_one(f32x16& od, int vb, bf16x8 pa0, bf16x8 pa1, bf16x8 pa2, bf16x8 pa3) {
    const s16x4 l0 = tr_read<v_rd_off(D0, 0, 0)>(vb), h0 = tr_read<v_rd_off(D0, 0, 1)>(vb), l1 = tr_read<v_rd_off(D0, 1, 0)>(vb), h1 = tr_read<v_rd_off(D0, 1, 1)>(vb);
    const s16x4 l2 = tr_read<v_rd_off(D0, 2, 0)>(vb), h2 = tr_read<v_rd_off(D0, 2, 1)>(vb), l3 = tr_read<v_rd_off(D0, 3, 0)>(vb), h3 = tr_read<v_rd_off(D0, 3, 1)>(vb);
    asm volatile("s_waitcnt lgkmcnt(0)" ::: "memory"); SBAR();
#define PK(L, H) (bf16x8){L[0], L[1], L[2], L[3], H[0], H[1], H[2], H[3]}
    od = __builtin_amdgcn_mfma_f32_32x32x16_bf16(pa0, PK(l0, h0), od, 0, 0, 0);
    od = __builtin_amdgcn_mfma_f32_32x32x16_bf16(pa1, PK(l1, h1), od, 0, 0, 0);
    od = __builtin_amdgcn_mfma_f32_32x32x16_bf16(pa2, PK(l2, h2), od, 0, 0, 0);
    od = __builtin_amdgcn_mfma_f32_32x32x16_bf16(pa3, PK(l3, h3), od, 0, 0, 0);
#undef PK
}
__device__ __forceinline__ void pv_d0(f32x16* o, int vb, bf16x8 pa0, bf16x8 pa1, bf16x8 pa2, bf16x8 pa3) {
    pv_one<0>(o[0], vb, pa0, pa1, pa2, pa3); pv_one<1>(o[1], vb, pa0, pa1, pa2, pa3); pv_one<2>(o[2], vb, pa0, pa1, pa2, pa3); pv_one<3>(o[3], vb, pa0, pa1, pa2, pa3);
}
constexpr float ATT_THR = 8.f;
__device__ __forceinline__ void partialSM(f32x16& p0, f32x16& p1, float& m_reg, float& mn, float& alpha, float C, float thr_raw) {
    float pmax = p0[0];
#pragma unroll
    for (int r = 1; r < 16; ++r) pmax = fmaxf(pmax, p0[r]);
#pragma unroll
    for (int r = 0; r < 16; ++r) pmax = fmaxf(pmax, p1[r]);
    { auto rr = __builtin_amdgcn_permlane32_swap(__float_as_uint(pmax), __float_as_uint(pmax), false, false);
      pmax = fmaxf(__uint_as_float(rr[0]), __uint_as_float(rr[1])); }
    if (__builtin_expect(__all(pmax - m_reg <= thr_raw), 1)) { mn = m_reg; alpha = 1.f; }
    else { mn = fmaxf(m_reg, pmax); alpha = __builtin_amdgcn_exp2f((m_reg - mn) * C); m_reg = mn; }
    const float mnC = -mn * C;
#pragma unroll
    for (int r = 0; r < 16; ++r) p0[r] = fmaf(p0[r], C, mnC);
#pragma unroll
    for (int r = 0; r < 16; ++r) p1[r] = fmaf(p1[r], C, mnC);
#pragma unroll
    for (int r = 0; r < 16; ++r) p0[r] = __builtin_amdgcn_exp2f(p0[r]);
}
__device__ __forceinline__ void finishSM(f32x16& p0, f32x16& p1, float alpha, float& l_reg, bf16x8& pa0, bf16x8& pa1, bf16x8& pa2, bf16x8& pa3) {
#pragma unroll
    for (int r = 0; r < 16; ++r) p1[r] = __builtin_amdgcn_exp2f(p1[r]);
    float ps = 0;
#pragma unroll
    for (int r = 0; r < 16; ++r) ps += p0[r];
#pragma unroll
    for (int r = 0; r < 16; ++r) ps += p1[r];
    { auto rr = __builtin_amdgcn_permlane32_swap(__float_as_uint(ps), __float_as_uint(ps), false, false);
      ps = __uint_as_float(rr[0]) + __uint_as_float(rr[1]); }
    l_reg = l_reg * alpha + ps;
#define PK4(P, BASE, OUT) do { unsigned a0 = cvtpk(P[BASE + 0], P[BASE + 1]), a1 = cvtpk(P[BASE + 2], P[BASE + 3]);   \
    unsigned b0 = cvtpk(P[BASE + 4], P[BASE + 5]), b1 = cvtpk(P[BASE + 6], P[BASE + 7]);                              \
    auto r0 = __builtin_amdgcn_permlane32_swap(a0, b0, false, false); auto r1 = __builtin_amdgcn_permlane32_swap(a1, b1, false, false); \
    u32x4 w = {r0[0], r1[0], r0[1], r1[1]}; OUT = *reinterpret_cast<bf16x8*>(&w); } while (0)
    PK4(p0, 0, pa0); PK4(p0, 8, pa1); PK4(p1, 0, pa2); PK4(p1, 8, pa3);
#undef PK4
}
template <int DQK> __device__ __forceinline__ void qkt(f32x16& p0, f32x16& p1, const char* Ks, const bf16x8* qr, int r32, int hi) {
    constexpr int KP = DQK * 2 + 16;
    p0 = f32x16{}; p1 = f32x16{};
#pragma unroll
    for (int d0 = 0; d0 < DQK / 16; ++d0) { const int cb = (d0 * 16 + hi * 8) * 2;
        const bf16x8 b0 = *reinterpret_cast<const bf16x8*>(Ks + r32 * KP + cb);
        const bf16x8 b1 = *reinterpret_cast<const bf16x8*>(Ks + (32 + r32) * KP + cb);
        p0 = __builtin_amdgcn_mfma_f32_32x32x16_bf16(b0, qr[d0], p0, 0, 0, 0);
        p1 = __builtin_amdgcn_mfma_f32_32x32x16_bf16(b1, qr[d0], p1, 0, 0, 0); }
}
template <int DQK> constexpr int att_lds_bytes() { return 2 * 64 * 128 * 2 + 2 * 64 * (DQK * 2 + 16) + NWAVES * 64 * 4; }
template <int DQK, int LDQ, int LDK, int LDV, int LDO>
__device__ __forceinline__ void attn_body(const bf16_t* __restrict__ Qb, const bf16_t* __restrict__ Kh, const bf16_t* __restrict__ Vh, bf16_t* __restrict__ Ob, int seq, float scale, char* lds) {
    constexpr int KP = DQK * 2 + 16, SHM_V = 64 * 128 * 2, SHM_K = 64 * KP, ND = DQK / 16, CH = DQK / 8, NKL = CH * 64 / NTHREADS;
    const float C = scale * 1.4426950408889634f, thr_raw = ATT_THR / scale;
    const int tid = threadIdx.x, wid = tid >> 6, lane = tid & 63, r32 = lane & 31, hi = lane >> 5;
    char* V_lds = lds; char* K_lds = lds + 2 * SHM_V;
    float* wsf = (float*)(lds + 2 * SHM_V + 2 * SHM_K) + wid * 64; float* li_l = wsf; float* al_l = wsf + 32;
    float m_reg = -1e30f, l_reg = 0; f32x16 o[4] = {}; bf16x8 qr[ND];
    const bf16_t* Qw = Qb + (long)(wid * 32 + r32) * LDQ + hi * 8;
#pragma unroll
    for (int d0 = 0; d0 < ND; ++d0) qr[d0] = *reinterpret_cast<const bf16x8*>(Qw + d0 * 16);
    const int sr = tid >> 4, sc = (tid & 15) * 8, vst0 = v_st(sr, sc), vst1 = v_st(32 + sr, sc);
    static_assert(DQK == 128, "double-pipelined body: 128-wide q.k only");
    const int vb0 = (int)(uintptr_t)V_lds + v_rd_base(lane);
    bf16x8 vs0, vs1, ks[NKL];
#define SLOAD(k0) do { vs0 = *reinterpret_cast<const bf16x8*>(&Vh[(long)((k0) + sr) * LDV + sc]); vs1 = *reinterpret_cast<const bf16x8*>(&Vh[(long)((k0) + 32 + sr) * LDV + sc]); \
    _Pragma("unroll") for (int i_ = 0; i_ < NKL; ++i_) ks[i_] = *reinterpret_cast<const bf16x8*>(&Kh[(long)((k0) + sr + 32 * i_) * LDK + sc]); } while (0)
#define SWRITE(b) do { *(bf16x8*)(V_lds + (b) * SHM_V + vst0) = vs0; *(bf16x8*)(V_lds + (b) * SHM_V + vst1) = vs1; \
    _Pragma("unroll") for (int i_ = 0; i_ < NKL; ++i_) *(bf16x8*)(K_lds + (b) * SHM_K + (sr + 32 * i_) * KP + sc * 2) = ks[i_]; } while (0)
#define RESC(a) do { if (__any((a) < 1.f)) { if (hi == 0) al_l[r32] = (a); asm volatile("s_waitcnt lgkmcnt(0)" ::: "memory"); \
    _Pragma("unroll") for (int d = 0; d < 4; ++d) _Pragma("unroll") for (int r = 0; r < 16; ++r) o[d][r] *= al_l[crow(r, hi)]; } } while (0)
    f32x16 pA0, pA1, pB0, pB1; float mnA, mnB, alA, alB; bf16x8 pa0, pa1, pa2, pa3; const int NT = seq / 64;
    SLOAD(0); asm volatile("s_waitcnt vmcnt(0)" ::: "memory"); SWRITE(0); __syncthreads();
    qkt<DQK>(pA0, pA1, K_lds, qr, r32, hi); partialSM(pA0, pA1, m_reg, mnA, alA, C, thr_raw);
    SLOAD(64);
    asm volatile("s_waitcnt vmcnt(0)" ::: "memory"); SWRITE(1); __syncthreads();
    for (int j = 1; j + 1 < NT; j += 2) {
        SBAR(); qkt<DQK>(pB0, pB1, K_lds + SHM_K, qr, r32, hi);
        finishSM(pA0, pA1, alA, l_reg, pa0, pa1, pa2, pa3); SBAR();
        SLOAD((j + 1) * 64); SBAR();
        pv_d0(o, vb0, pa0, pa1, pa2, pa3); partialSM(pB0, pB1, m_reg, mnB, alB, C, thr_raw);
        __syncthreads(); asm volatile("s_waitcnt vmcnt(0)" ::: "memory"); SWRITE(0);
        RESC(alB); __syncthreads();
        SBAR(); qkt<DQK>(pA0, pA1, K_lds, qr, r32, hi);
        finishSM(pB0, pB1, alB, l_reg, pa0, pa1, pa2, pa3); SBAR();
        SLOAD((j + 2) * 64); SBAR();
        pv_d0(o, vb0 + SHM_V, pa0, pa1, pa2, pa3); partialSM(pA0, pA1, m_reg, mnA, alA, C, thr_raw);
        __syncthreads(); asm volatile("s_waitcnt vmcnt(0)" ::: "memory"); SWRITE(1);
        RESC(alA); __syncthreads();
    }
    SBAR(); qkt<DQK>(pB0, pB1, K_lds + SHM_K, qr, r32, hi);
    finishSM(pA0, pA1, alA, l_reg, pa0, pa1, pa2, pa3); SBAR();
    pv_d0(o, vb0, pa0, pa1, pa2, pa3); partialSM(pB0, pB1, m_reg, mnB, alB, C, thr_raw);
    __syncthreads(); RESC(alB);
    finishSM(pB0, pB1, alB, l_reg, pa0, pa1, pa2, pa3); SBAR();
    pv_d0(o, vb0 + SHM_V, pa0, pa1, pa2, pa3);
    if (hi == 0) li_l[r32] = l_reg; asm volatile("s_waitcnt lgkmcnt(0)" ::: "memory");
    float rli[16];
#pragma unroll
    for (int r = 0; r < 16; ++r) rli[r] = __builtin_amdgcn_rcpf(li_l[crow(r, hi)]);
    bf16_t* Ow = Ob + (long)(wid * 32) * LDO;
#pragma unroll
    for (int r = 0; r < 16; ++r) { const int orow = crow(r, hi);
#pragma unroll
        for (int d0 = 0; d0 < 4; ++d0) Ow[(long)orow * LDO + d0 * 32 + r32] = (bf16_t)f2bf(o[d0][r] * rli[r]); }
    __syncthreads();
#undef SLOAD
#undef SWRITE
#undef RESC
}
template <int DQK, int LDQ, int LDK, int LDV, int LDO>
__device__ __forceinline__ void attn_body_single(const bf16_t* __restrict__ Qb, const bf16_t* __restrict__ Kh, const bf16_t* __restrict__ Vh, bf16_t* __restrict__ Ob, int seq, float scale, char* lds, int rope_t0) {
    constexpr int KP = DQK * 2 + 16, SHM_V = 64 * 128 * 2, SHM_K = 64 * KP, ND = DQK / 16, CH = DQK / 8, NKL = CH * 64 / NTHREADS;
    const float C = scale * 1.4426950408889634f, thr_raw = ATT_THR / scale;
    const int tid = threadIdx.x, wid = tid >> 6, lane = tid & 63, r32 = lane & 31, hi = lane >> 5;
    char* V_lds = lds; char* K_lds = lds + 2 * SHM_V;
    float* wsf = (float*)(lds + 2 * SHM_V + 2 * SHM_K) + wid * 64; float* li_l = wsf; float* al_l = wsf + 32;
    float m_reg = -1e30f, l_reg = 0; f32x16 o[4] = {}; bf16x8 qr[ND];
    const bf16_t* Qw = Qb + (long)(wid * 32 + r32) * LDQ + hi * 8;
#pragma unroll
    for (int d0 = 8; d0 < ND; ++d0) qr[d0] = *reinterpret_cast<const bf16x8*>(Qw + d0 * 16);
    if constexpr (DQK == 192) {
        if (rope_t0 >= 0) {
            const int tq = rope_t0 + wid * 32 + r32; const float prow = (float)(tq >> 6), pcol = (float)(tq & 63);
            u32x4 fa1 = __builtin_bit_cast(u32x4, qr[8]), fa2 = __builtin_bit_cast(u32x4, qr[9]), fb1 = __builtin_bit_cast(u32x4, qr[10]), fb2 = __builtin_bit_cast(u32x4, qr[11]);
#pragma unroll
            for (int jj = 0; jj < 4; ++jj) {
                float na1[2], na2[2], nb1[2], nb2[2];
#pragma unroll
                for (int e = 0; e < 2; ++e) { const float invf = __powf(10000.f, -(float)(hi * 8 + 2 * jj + e) * (1.f / 16.f));
                    const float ar = prow * invf, ac = pcol * invf, cr = __cosf(ar), sr_ = __sinf(ar), cc = __cosf(ac), sc_ = __sinf(ac);
                    const float a1 = e ? bfhi(fa1[jj]) : bflo(fa1[jj]), a2 = e ? bfhi(fa2[jj]) : bflo(fa2[jj]), b1 = e ? bfhi(fb1[jj]) : bflo(fb1[jj]), b2 = e ? bfhi(fb2[jj]) : bflo(fb2[jj]);
                    na1[e] = a1 * cr - a2 * sr_; na2[e] = a2 * cr + a1 * sr_; nb1[e] = b1 * cc - b2 * sc_; nb2[e] = b2 * cc + b1 * sc_; }
                fa1[jj] = pk2(na1[0], na1[1]); fa2[jj] = pk2(na2[0], na2[1]); fb1[jj] = pk2(nb1[0], nb1[1]); fb2[jj] = pk2(nb2[0], nb2[1]);
            }
            qr[8] = __builtin_bit_cast(bf16x8, fa1); qr[9] = __builtin_bit_cast(bf16x8, fa2); qr[10] = __builtin_bit_cast(bf16x8, fb1); qr[11] = __builtin_bit_cast(bf16x8, fb2);
        }
    }
    asm volatile("" ::: "memory");
#pragma unroll
    for (int d0 = 0; d0 < 8; ++d0) qr[d0] = *reinterpret_cast<const bf16x8*>(Qw + d0 * 16);
    const int sr = tid >> 4, sc = (tid & 15) * 8, vst0 = v_st(sr, sc), vst1 = v_st(32 + sr, sc);
    int krow[NKL], kch[NKL];
#pragma unroll
    for (int i = 0; i < NKL; ++i) { const int id = tid + i * NTHREADS; krow[i] = id / CH; kch[i] = id % CH; }
    const int vb0 = (int)(uintptr_t)V_lds + v_rd_base(lane);
    bf16x8 vs0, vs1, ks[NKL];
#define SLOAD(k0) do { vs0 = *reinterpret_cast<const bf16x8*>(&Vh[(long)((k0) + sr) * LDV + sc]); vs1 = *reinterpret_cast<const bf16x8*>(&Vh[(long)((k0) + 32 + sr) * LDV + sc]); \
    _Pragma("unroll") for (int i_ = 0; i_ < NKL; ++i_) ks[i_] = *reinterpret_cast<const bf16x8*>(&Kh[(long)((k0) + krow[i_]) * LDK + kch[i_] * 8]); } while (0)
#define SWRITE(b) do { *(bf16x8*)(V_lds + (b) * SHM_V + vst0) = vs0; *(bf16x8*)(V_lds + (b) * SHM_V + vst1) = vs1; \
    _Pragma("unroll") for (int i_ = 0; i_ < NKL; ++i_) *(bf16x8*)(K_lds + (b) * SHM_K + krow[i_] * KP + kch[i_] * 16) = ks[i_]; } while (0)
#define RESC(a) do { if (__any((a) < 1.f)) { if (hi == 0) al_l[r32] = (a); asm volatile("s_waitcnt lgkmcnt(0)" ::: "memory"); \
    _Pragma("unroll") for (int d = 0; d < 4; ++d) _Pragma("unroll") for (int r = 0; r < 16; ++r) o[d][r] *= al_l[crow(r, hi)]; } } while (0)
    f32x16 p0, p1; float mn, al; bf16x8 pa0, pa1, pa2, pa3; const int NT = seq / 64;
    SLOAD(0); asm volatile("s_waitcnt vmcnt(0)" ::: "memory"); SWRITE(0); __syncthreads();
    SLOAD(64);
    for (int j = 0; j < NT; ++j) {
        const int b = j & 1;
        SBAR(); qkt<DQK>(p0, p1, K_lds + b * SHM_K, qr, r32, hi);
        partialSM(p0, p1, m_reg, mn, al, C, thr_raw);
        RESC(al);
        finishSM(p0, p1, al, l_reg, pa0, pa1, pa2, pa3); SBAR();
        pv_d0(o, vb0 + b * SHM_V, pa0, pa1, pa2, pa3);
        if (j + 1 < NT) { asm volatile("s_waitcnt vmcnt(0)" ::: "memory"); SWRITE(b ^ 1); }
        __syncthreads();
        if (j + 2 < NT) SLOAD((j + 2) * 64);
    }
    if (hi == 0) li_l[r32] = l_reg; asm volatile("s_waitcnt lgkmcnt(0)" ::: "memory");
    float rli[16];
#pragma unroll
    for (int r = 0; r < 16; ++r) rli[r] = __builtin_amdgcn_rcpf(li_l[crow(r, hi)]);
    bf16_t* Ow = Ob + (long)(wid * 32) * LDO;
#pragma unroll
    for (int r = 0; r < 16; ++r) { const int orow = crow(r, hi);
#pragma unroll
        for (int d0 = 0; d0 < 4; ++d0) Ow[(long)orow * LDO + d0 * 32 + r32] = (bf16_t)f2bf(o[d0][r] * rli[r]); }
    __syncthreads();
#undef SLOAD
#undef SWRITE
#undef RESC
}
__device__ __forceinline__ void p_attn_mla(const Args& A, const Frame& F) {
    const bf16_t* Q = (const bf16_t*)(F.ws + WS_Q); const bf16_t* Kb = (const bf16_t*)(F.ws + WS_K); const bf16_t* Vb = (const bf16_t*)(F.ws + WS_V); bf16_t* O = (bf16_t*)(F.ws + WS_O);
    const float scale = 0.07216878364870322f;
    for (int u = F.vcu; u < 544; u += F.nblk) {
        int b, h, q0, seq;
        int rope_t0;
        if (u < 512) { const int qb = u & 15; h = (u >> 4) & 7; b = u >> 7; q0 = CTXL + qb * 256; seq = RPB; rope_t0 = qb * 256; }
        else { const int v = u - 512; h = v & 7; b = v >> 3; q0 = 0; seq = CTXL; rope_t0 = -1; }
        const size_t rb = (size_t)b * RPB;
        attn_body_single<192, 1536, 1536, 1024, 1024>(Q + (rb + q0) * 1536 + h * 192, Kb + rb * 1536 + h * 192, Vb + rb * 1024 + h * 128, O + (rb + q0) * 1024 + h * 128, seq, scale, F.lds, rope_t0);
    }
}
__device__ __forceinline__ void p_attn_gqa(const Args& A, const Frame& F) {
    const bf16_t* Q = (const bf16_t*)(F.ws + WS_Q1); const bf16_t* Kb = (const bf16_t*)(F.ws + WS_K1); const bf16_t* Vb = (const bf16_t*)(F.ws + WS_V1); bf16_t* O = (bf16_t*)(F.ws + WS_O);
    const float scale = 0.08838834764831845f;
    for (int u = F.vcu; u < 512; u += F.nblk) {
        const int qb = u & 15, h = (u >> 4) & 7, b = u >> 7, q0 = CTXL + qb * 256, kvh = h >> 2;
        const size_t rb = (size_t)b * RPB;
        attn_body<128, 1024, 256, 256, 1024>(Q + (rb + q0) * 1024 + h * 128, Kb + rb * 256 + kvh * 128, Vb + rb * 256 + kvh * 128, O + (rb + q0) * 1024 + h * 128, RPB, scale, F.lds);
    }
}

#define DPP_XOR1 0xB1
#define DPP_XOR2 0x4E
#define DPP_HMIRROR 0x141
#define DPP_MIRROR 0x140
__device__ __forceinline__ int row_max_i(int v) {
    v = max(v, __builtin_amdgcn_update_dpp(v, v, DPP_XOR1, 0xf, 0xf, false));
    v = max(v, __builtin_amdgcn_update_dpp(v, v, DPP_XOR2, 0xf, 0xf, false));
    v = max(v, __builtin_amdgcn_update_dpp(v, v, DPP_HMIRROR, 0xf, 0xf, false));
    v = max(v, __builtin_amdgcn_update_dpp(v, v, DPP_MIRROR, 0xf, 0xf, false));
    return v;
}
__device__ __forceinline__ float row_sum_f(float v) {
    v += __builtin_bit_cast(float, __builtin_amdgcn_update_dpp(0, __builtin_bit_cast(int, v), DPP_XOR1, 0xf, 0xf, false));
    v += __builtin_bit_cast(float, __builtin_amdgcn_update_dpp(0, __builtin_bit_cast(int, v), DPP_XOR2, 0xf, 0xf, false));
    v += __builtin_bit_cast(float, __builtin_amdgcn_update_dpp(0, __builtin_bit_cast(int, v), DPP_HMIRROR, 0xf, 0xf, false));
    v += __builtin_bit_cast(float, __builtin_amdgcn_update_dpp(0, __builtin_bit_cast(int, v), DPP_MIRROR, 0xf, 0xf, false));
    return v;
}
__device__ __forceinline__ int fkey(float f) { const int b = __builtin_bit_cast(int, f); return b ^ ((b >> 31) & 0x7fffffff); }
__device__ __forceinline__ float keyf(int k) { return __builtin_bit_cast(float, k ^ ((k >> 31) & 0x7fffffff)); }
__device__ __forceinline__ void cand_ij(int t, int& i, int& j) {
    const int g16 = t >= 16, g24 = t >= 24, g29 = t >= 29, g33 = t >= 33, g36 = t >= 36, g38 = t >= 38, g40 = t >= 40;
    i = g16 + g24 + g29 + g33 + g36 + g38 + g40 + max(t - 41, 0);
    const int base = 16 * g16 + 8 * g24 + 5 * g29 + 4 * g33 + 3 * g36 + 2 * g38 + 2 * g40;
    j = (t >= 42) ? 0 : t - base;
    if (t >= 50) { i = 0; j = 0; }
}
__device__ __forceinline__ void row_max2(int& a, int& b) {
    asm volatile("s_nop 1\n\t"
                 "v_max_i32_dpp %0, %0, %0 quad_perm:[1,0,3,2] row_mask:0xf bank_mask:0xf\n\tv_max_i32_dpp %1, %1, %1 quad_perm:[1,0,3,2] row_mask:0xf bank_mask:0xf\n\ts_nop 0\n\t"
                 "v_max_i32_dpp %0, %0, %0 quad_perm:[2,3,0,1] row_mask:0xf bank_mask:0xf\n\tv_max_i32_dpp %1, %1, %1 quad_perm:[2,3,0,1] row_mask:0xf bank_mask:0xf\n\ts_nop 0\n\t"
                 "v_max_i32_dpp %0, %0, %0 row_half_mirror row_mask:0xf bank_mask:0xf\n\tv_max_i32_dpp %1, %1, %1 row_half_mirror row_mask:0xf bank_mask:0xf\n\ts_nop 0\n\t"
                 "v_max_i32_dpp %0, %0, %0 row_mirror row_mask:0xf bank_mask:0xf\n\tv_max_i32_dpp %1, %1, %1 row_mirror row_mask:0xf bank_mask:0xf\n\ts_nop 1"
                 : "+v"(a), "+v"(b));
}
__device__ __forceinline__ void row_max1(int& a) {
    asm volatile("s_nop 1\n\t"
                 "v_max_i32_dpp %0, %0, %0 quad_perm:[1,0,3,2] row_mask:0xf bank_mask:0xf\n\ts_nop 1\n\t"
                 "v_max_i32_dpp %0, %0, %0 quad_perm:[2,3,0,1] row_mask:0xf bank_mask:0xf\n\ts_nop 1\n\t"
                 "v_max_i32_dpp %0, %0, %0 row_half_mirror row_mask:0xf bank_mask:0xf\n\ts_nop 1\n\t"
                 "v_max_i32_dpp %0, %0, %0 row_mirror row_mask:0xf bank_mask:0xf\n\ts_nop 1"
                 : "+v"(a));
}
__device__ __forceinline__ void row_max4(int& a, int& b, int& c, int& d) {
    asm volatile("s_nop 1\n\t"
                 "v_max_i32_dpp %0, %0, %0 quad_perm:[1,0,3,2] row_mask:0xf bank_mask:0xf\n\tv_max_i32_dpp %1, %1, %1 quad_perm:[1,0,3,2] row_mask:0xf bank_mask:0xf\n\t"
                 "v_max_i32_dpp %2, %2, %2 quad_perm:[1,0,3,2] row_mask:0xf bank_mask:0xf\n\tv_max_i32_dpp %3, %3, %3 quad_perm:[1,0,3,2] row_mask:0xf bank_mask:0xf\n\t"
                 "v_max_i32_dpp %0, %0, %0 quad_perm:[2,3,0,1] row_mask:0xf bank_mask:0xf\n\tv_max_i32_dpp %1, %1, %1 quad_perm:[2,3,0,1] row_mask:0xf bank_mask:0xf\n\t"
                 "v_max_i32_dpp %2, %2, %2 quad_perm:[2,3,0,1] row_mask:0xf bank_mask:0xf\n\tv_max_i32_dpp %3, %3, %3 quad_perm:[2,3,0,1] row_mask:0xf bank_mask:0xf\n\t"
                 "v_max_i32_dpp %0, %0, %0 row_half_mirror row_mask:0xf bank_mask:0xf\n\tv_max_i32_dpp %1, %1, %1 row_half_mirror row_mask:0xf bank_mask:0xf\n\t"
                 "v_max_i32_dpp %2, %2, %2 row_half_mirror row_mask:0xf bank_mask:0xf\n\tv_max_i32_dpp %3, %3, %3 row_half_mirror row_mask:0xf bank_mask:0xf\n\t"
                 "v_max_i32_dpp %0, %0, %0 row_mirror row_mask:0xf bank_mask:0xf\n\tv_max_i32_dpp %1, %1, %1 row_mirror row_mask:0xf bank_mask:0xf\n\t"
                 "v_max_i32_dpp %2, %2, %2 row_mirror row_mask:0xf bank_mask:0xf\n\tv_max_i32_dpp %3, %3, %3 row_mirror row_mask:0xf bank_mask:0xf\n\ts_nop 1"
                 : "+v"(a), "+v"(b), "+v"(c), "+v"(d));
}
#define CE_DESC(x, y) do { const int hi_ = max(x, y), lo_ = min(x, y); x = hi_; y = lo_; } while (0)
#define SORT8_DESC(k) do { CE_DESC(k[0], k[2]); CE_DESC(k[1], k[3]); CE_DESC(k[4], k[6]); CE_DESC(k[5], k[7]); CE_DESC(k[0], k[4]); CE_DESC(k[1], k[5]); CE_DESC(k[2], k[6]); CE_DESC(k[3], k[7]); \
    CE_DESC(k[0], k[1]); CE_DESC(k[2], k[3]); CE_DESC(k[4], k[5]); CE_DESC(k[6], k[7]); CE_DESC(k[2], k[4]); CE_DESC(k[3], k[5]); CE_DESC(k[1], k[4]); CE_DESC(k[3], k[6]); CE_DESC(k[1], k[2]); CE_DESC(k[3], k[4]); CE_DESC(k[5], k[6]); } while (0)
__device__ __forceinline__ void p_peer_topk(const Args& A, const Frame& F, bool skip_ctx) {
    const int gw = F.bid * NWAVES + F.wave, NGW = F.nblk * NWAVES, lane = F.lane, c = lane & 15, rw = lane >> 4, rbase = lane & 48;
    const unsigned short* S = (const unsigned short*)(F.ws + WS_S);
    const int KMIN = (int)0x80000000;
    int ci[4], cj[4];
#pragma unroll
    for (int q = 0; q < 4; ++q) cand_ij(c + 16 * q, ci[q], cj[q]);
    unsigned* PK = (unsigned*)(F.ws + WS_PK);
    const int ntok = skip_ctx ? NB * SEQ : R;
    u32x2 nx[2][4];
#define TK_LOAD(n_) do { const int n2_ = (n_) < ntok ? (n_) : gw; const int r_ = skip_ctx ? tok_row(1, n2_) : n2_; \
        _Pragma("unroll") for (int hh_ = 0; hh_ < 2; ++hh_) { const unsigned short* sp_ = S + (size_t)r_ * 2048 + (4 * hh_ + rw) * 256 + 4 * c; \
            nx[hh_][0] = *(const u32x2*)sp_; nx[hh_][1] = *(const u32x2*)(sp_ + 64); nx[hh_][2] = *(const u32x2*)(sp_ + 128); nx[hh_][3] = *(const u32x2*)(sp_ + 192); } } while (0)
    TK_LOAD(gw);
    for (int n = gw; n < ntok; n += NGW) {
        const int r = skip_ctx ? tok_row(1, n) : n;
        int k1[2][8], k2[2][8];
#pragma unroll
        for (int hh = 0; hh < 2; ++hh)
#pragma unroll
            for (int jj = 0; jj < 2; ++jj) { const u32x2 a = nx[hh][jj], b = nx[hh][2 + jj];
#pragma unroll
                for (int e = 0; e < 4; ++e) { const int p = 4 * c + 64 * jj + e;
                    const float fa = (float)__builtin_bit_cast(_Float16, (unsigned short)(a[e >> 1] >> (16 * (e & 1)))), fb = (float)__builtin_bit_cast(_Float16, (unsigned short)(b[e >> 1] >> (16 * (e & 1))));
                    k1[hh][4 * jj + e] = (fkey(fa) & ~127) | (127 - p); k2[hh][4 * jj + e] = (fkey(fb) & ~127) | (127 - p); } }
        TK_LOAD(n + NGW);
        SORT8_DESC(k1[0]); SORT8_DESC(k2[0]); SORT8_DESC(k1[1]); SORT8_DESC(k2[1]);
        int r1[2] = {KMIN, KMIN}, r2[2] = {KMIN, KMIN};
#pragma unroll 1
        for (int it = 0; it < 16; ++it) {
            int m1a = k1[0][0], m2a = k2[0][0], m1b = k1[1][0], m2b = k2[1][0];
            row_max4(m1a, m2a, m1b, m2b);
            const bool p1a = (k1[0][0] == m1a), p2a = (k2[0][0] == m2a), p1b = (k1[1][0] == m1b), p2b = (k2[1][0] == m2b);
#pragma unroll
            for (int e = 0; e < 7; ++e) { k1[0][e] = p1a ? k1[0][e + 1] : k1[0][e]; k2[0][e] = p2a ? k2[0][e + 1] : k2[0][e]; k1[1][e] = p1b ? k1[1][e + 1] : k1[1][e]; k2[1][e] = p2b ? k2[1][e + 1] : k2[1][e]; }
            k1[0][7] = p1a ? KMIN : k1[0][7]; k2[0][7] = p2a ? KMIN : k2[0][7]; k1[1][7] = p1b ? KMIN : k1[1][7]; k2[1][7] = p2b ? KMIN : k2[1][7];
            if (c == it) { r1[0] = m1a; r2[0] = m2a; r1[1] = m1b; r2[1] = m2b; }
        }
        int ck[2][4];
#pragma unroll
        for (int hh = 0; hh < 2; ++hh) {
#pragma unroll
            for (int q = 0; q < 4; ++q) { const int a = __shfl(r1[hh], rbase | ci[q]), b = __shfl(r2[hh], rbase | cj[q]);
                const float fs = keyf((a & ~127) | 64) + keyf((b & ~127) | 64); const int t = c + 16 * q;
                ck[hh][q] = (t < 50) ? ((fkey(fs) & ~63) | (63 - t)) : KMIN; }
            CE_DESC(ck[hh][0], ck[hh][1]); CE_DESC(ck[hh][2], ck[hh][3]); CE_DESC(ck[hh][0], ck[hh][2]); CE_DESC(ck[hh][1], ck[hh][3]); CE_DESC(ck[hh][1], ck[hh][2]); }
        int tk[2] = {KMIN, KMIN};
#pragma unroll 1
        for (int it = 0; it < 16; ++it) {
            int ma = ck[0][0], mb = ck[1][0];
            row_max2(ma, mb);
            const bool pa = (ck[0][0] == ma), pb = (ck[1][0] == mb);
            ck[0][0] = pa ? ck[0][1] : ck[0][0]; ck[0][1] = pa ? ck[0][2] : ck[0][1]; ck[0][2] = pa ? ck[0][3] : ck[0][2]; ck[0][3] = pa ? KMIN : ck[0][3];
            ck[1][0] = pb ? ck[1][1] : ck[1][0]; ck[1][1] = pb ? ck[1][2] : ck[1][1]; ck[1][2] = pb ? ck[1][3] : ck[1][2]; ck[1][3] = pb ? KMIN : ck[1][3];
            if (c == it) { tk[0] = ma; tk[1] = mb; }
        }
        int mka = tk[0], mkb = tk[1]; row_max2(mka, mkb);
#pragma unroll
        for (int hh = 0; hh < 2; ++hh) {
            int wi, wj; cand_ij(63 - (tk[hh] & 63), wi, wj);
            const int wa = __shfl(r1[hh], rbase | wi), wb = __shfl(r2[hh], rbase | wj);
            const int te = (127 - (wa & 127)) * 128 + (127 - (wb & 127));
            const float tv = keyf((tk[hh] & ~63) | 32), mx = keyf(((hh ? mkb : mka) & ~63) | 32);
            const float ex = __expf(tv - mx), sum = row_sum_f(ex);
            PK[(size_t)r * 128 + (4 * hh + rw) * 16 + c] = ((unsigned)te << 16) | (unsigned)(ex / sum * 65535.f + 0.5f);
        }
    }
#undef TK_LOAD
}

#define UB(w, b) ((float)(((w) >> (8 * (b))) & 0xffu))
__device__ __forceinline__ void p_peer_experts(const Args& A, const Frame& F, int layer) {
    const int gw = F.bid * NWAVES + F.wave, NGW = F.nblk * NWAVES, lane = F.lane;
    const bf16_t* H = (const bf16_t*)(F.ws + WS_H); float* X = (float*)(F.ws + WS_X);
    const unsigned* PK = (const unsigned*)(F.ws + WS_PK);
    const unsigned char* UT = F.ws + WS_TAB + (size_t)(layer * 2) * 16384 * 1024; const unsigned char* VT = UT + (size_t)16384 * 1024;
    const float* SU = (const float*)(F.ws + WS_TSC) + (layer * 2) * 16384; const float* SV = SU + 16384;
    const float* MOD = (const float*)(F.ws + WS_MOD) + (size_t)layer * 5 * 6144;
    for (int r = gw; r < R; r += NGW) {
        if (layer == 1 && is_ctx_row(r)) continue;
        float hf[16];
        { const u32x4 w0 = *(const u32x4*)(H + (size_t)r * DM + 16 * lane), w1 = *(const u32x4*)(H + (size_t)r * DM + 16 * lane + 8);
#pragma unroll
          for (int d = 0; d < 4; ++d) { hf[2 * d] = bflo(w0[d]); hf[2 * d + 1] = bfhi(w0[d]); hf[8 + 2 * d] = bflo(w1[d]); hf[8 + 2 * d + 1] = bfhi(w1[d]); } }
        float hs = 0.f;
#pragma unroll
        for (int i = 0; i < 16; ++i) hs += hf[i];
        hs = wave_sum(hs);
        int v0 = (int)PK[(size_t)r * 128 + lane], v1 = (int)PK[(size_t)r * 128 + 64 + lane];
#pragma unroll
        for (int k = 2; k <= 128; k <<= 1) {
#pragma unroll
            for (int j = k >> 1; j >= 1; j >>= 1) {
                if (j == 64) { const int a = min(v0, v1), b = max(v0, v1); v0 = a; v1 = b; }
                else { const int o0 = __shfl_xor(v0, j), o1 = __shfl_xor(v1, j); const bool lower = (lane & j) == 0;
                    const bool asc0 = (k == 128) ? true : (k == 64) ? true : ((lane & k) == 0), asc1 = (k == 128) ? true : (k == 64) ? false : ((lane & k) == 0);
                    v0 = (lower == asc0) ? min(v0, o0) : max(v0, o0); v1 = (lower == asc1) ? min(v1, o1) : max(v1, o1); }
            }
        }
        const unsigned pk0 = (unsigned)v0, pk1 = (unsigned)v1;
        const int e0 = (int)(pk0 >> 16), e1 = (int)(pk1 >> 16);
        const float g0 = (float)(pk0 & 0xffffu) * (1.f / 65535.f), g1 = (float)(pk1 & 0xffffu) * (1.f / 65535.f);
        const float su0 = SU[e0], su1 = SU[e1], sv0 = SV[e0], sv1 = SV[e1];
        float d0 = 0.f, d1 = 0.f;
        const int dep_src = (8 * (lane & 7)) << 2; const bool bit3 = (lane & 8) != 0;
#define XISSUE(buf, TAB, esrc, gg) do { _Pragma("unroll") for (int q_ = 0; q_ < 8; ++q_) { const int e_ = __builtin_amdgcn_readlane(esrc, (gg) * 8 + q_); \
            buf[q_] = *(const u32x4*)((TAB) + (size_t)e_ * 1024 + 16 * lane); } } while (0)
#define UCOMP(buf, gg, dsel) do { float p_[8]; _Pragma("unroll") for (int q_ = 0; q_ < 8; ++q_) { float d_ = 0.f; \
            _Pragma("unroll") for (int j_ = 0; j_ < 4; ++j_) d_ += (hf[4 * j_] * UB(buf[q_][j_], 0) + hf[4 * j_ + 1] * UB(buf[q_][j_], 1)) + (hf[4 * j_ + 2] * UB(buf[q_][j_], 2) + hf[4 * j_ + 3] * UB(buf[q_][j_], 3)); p_[q_] = d_; } \
            float s_[4]; _Pragma("unroll") for (int q_ = 0; q_ < 4; ++q_) { auto rr_ = __builtin_amdgcn_permlane32_swap(__float_as_uint(p_[q_]), __float_as_uint(p_[q_ + 4]), false, false); s_[q_] = __uint_as_float(rr_[0]) + __uint_as_float(rr_[1]); } \
            float t_[2]; _Pragma("unroll") for (int q_ = 0; q_ < 2; ++q_) { auto rr_ = __builtin_amdgcn_permlane16_swap(__float_as_uint(s_[q_]), __float_as_uint(s_[q_ + 2]), false, false); t_[q_] = __uint_as_float(rr_[0]) + __uint_as_float(rr_[1]); } \
            const float keep_ = bit3 ? t_[1] : t_[0], send_ = bit3 ? t_[0] : t_[1]; \
            float u_ = keep_ + __builtin_bit_cast(float, __builtin_amdgcn_update_dpp(0, __builtin_bit_cast(int, send_), 0x128, 0xf, 0xf, false)); \
            u_ += __builtin_bit_cast(float, __builtin_amdgcn_update_dpp(0, __builtin_bit_cast(int, u_), DPP_HMIRROR, 0xf, 0xf, false)); \
            u_ += __builtin_bit_cast(float, __builtin_amdgcn_update_dpp(0, __builtin_bit_cast(int, u_), DPP_XOR1, 0xf, 0xf, false)); \
            u_ += __builtin_bit_cast(float, __builtin_amdgcn_update_dpp(0, __builtin_bit_cast(int, u_), DPP_XOR2, 0xf, 0xf, false)); \
            const float v_ = __builtin_bit_cast(float, __builtin_amdgcn_ds_bpermute(dep_src, __builtin_bit_cast(int, u_))); \
            if ((lane >> 3) == (gg)) dsel = v_; } while (0)
        {
            u32x4 ua[8], ub[8];
            XISSUE(ua, UT, e0, 0);
#pragma unroll 1
            for (int g = 0; g < 8; g += 2) { XISSUE(ub, UT, e0, g + 1); UCOMP(ua, g, d0); if (g + 2 < 8) XISSUE(ua, UT, e0, g + 2); else XISSUE(ua, UT, e1, 0); UCOMP(ub, g + 1, d0); }
#pragma unroll 1
            for (int g = 0; g < 8; g += 2) { XISSUE(ub, UT, e1, g + 1); UCOMP(ua, g, d1); if (g + 2 < 8) XISSUE(ua, UT, e1, g + 2); UCOMP(ub, g + 1, d1); }
        }
        const float a0 = su0 * (d0 - 128.f * hs), a1 = su1 * (d1 - 128.f * hs);
        const float w0 = g0 * 0.5f * a0 * (1.f + erff(a0 * 0.70710678118654752f)) * sv0, w1 = g1 * 0.5f * a1 * (1.f + erff(a1 * 0.70710678118654752f)) * sv1;
        const float wsum = wave_sum(w0 + w1) * 128.f;
        float acc[16];
#pragma unroll
        for (int i = 0; i < 16; ++i) acc[i] = 0.f;
#define VCOMP(buf, wsrc, gg) do { _Pragma("unroll") for (int q_ = 0; q_ < 8; ++q_) { const float wk_ = __builtin_bit_cast(float, __builtin_amdgcn_readlane(__builtin_bit_cast(int, wsrc), (gg) * 8 + q_)); \
            _Pragma("unroll") for (int j_ = 0; j_ < 4; ++j_) { acc[4 * j_] += wk_ * UB(buf[q_][j_], 0); acc[4 * j_ + 1] += wk_ * UB(buf[q_][j_], 1); acc[4 * j_ + 2] += wk_ * UB(buf[q_][j_], 2); acc[4 * j_ + 3] += wk_ * UB(buf[q_][j_], 3); } } } while (0)
        {
            u32x4 va[8], vb[8];
            XISSUE(va, VT, e0, 0);
#pragma unroll 1
            for (int g = 0; g < 8; g += 2) { XISSUE(vb, VT, e0, g + 1); VCOMP(va, w0, g); if (g + 2 < 8) XISSUE(va, VT, e0, g + 2); else XISSUE(va, VT, e1, 0); VCOMP(vb, w0, g + 1); }
#pragma unroll 1
            for (int g = 0; g < 8; g += 2) { XISSUE(vb, VT, e1, g + 1); VCOMP(va, w1, g); if (g + 2 < 8) XISSUE(va, VT, e1, g + 2); VCOMP(vb, w1, g + 1); }
        }
#undef XISSUE
#undef UCOMP
#undef VCOMP
        const float* mm = MOD + (size_t)mod_index(r) * 6144;
        f32x4 xn[4]; float s = 0.f;
#pragma unroll
        for (int j = 0; j < 4; ++j) { const int c = 16 * lane + 4 * j; const float* xp = X + (size_t)r * DM + c; const f32x4 gf = *(const f32x4*)(mm + 5 * 1024 + c);
            xn[j] = *(const f32x4*)xp + gf * (f32x4){acc[4 * j] - wsum, acc[4 * j + 1] - wsum, acc[4 * j + 2] - wsum, acc[4 * j + 3] - wsum};
            s += (xn[j].x * xn[j].x + xn[j].y * xn[j].y) + (xn[j].z * xn[j].z + xn[j].w * xn[j].w); }
        const float rinv = rsqrtf(wave_sum(s) * (1.f / DM) + EPS);
        if (layer == 0) {
            const float* m1 = (const float*)(F.ws + WS_MOD) + (size_t)(5 + mod_index(r)) * 6144;
            const float* gn = A.in[I1_NMIX];
#pragma unroll
            for (int j = 0; j < 4; ++j) { const int c = 16 * lane + 4 * j; *(f32x4*)(X + (size_t)r * DM + c) = xn[j];
                const f32x4 y = (xn[j] * rinv * *(const f32x4*)(gn + c)) * (*(const f32x4*)(m1 + 1024 + c) + 1.f) + *(const f32x4*)(m1 + c);
                u32x2 o; o.x = pk2(y.x, y.y); o.y = pk2(y.z, y.w); *(u32x2*)((bf16_t*)(F.ws + WS_H) + (size_t)r * DM + c) = o; }
        } else {
            const int b = r / RPB, t = (r - b * RPB) - CTXL; float* op = F.out + ((size_t)b * SEQ + t) * DM; const float* gn = A.in[I_NOUT];
#pragma unroll
            for (int j = 0; j < 4; ++j) { const int c = 16 * lane + 4 * j; *(f32x4*)(op + c) = xn[j] * rinv * *(const f32x4*)(gn + c); }
        }
    }
}

__device__ __forceinline__ int tok_row(int layer, int n) { return layer == 0 ? n : (n >> 12) * RPB + CTXL + (n & 4095); }
#define DPPF(v, ctrl) __builtin_bit_cast(float, __builtin_amdgcn_update_dpp(0, __builtin_bit_cast(int, v), ctrl, 0xf, 0xf, false))
__device__ __forceinline__ int isum8(int v) {
    v += __builtin_amdgcn_update_dpp(0, v, DPP_XOR1, 0xf, 0xf, false); v += __builtin_amdgcn_update_dpp(0, v, DPP_XOR2, 0xf, 0xf, false); v += __builtin_amdgcn_update_dpp(0, v, DPP_HMIRROR, 0xf, 0xf, false); return v; }
__device__ __forceinline__ void p_exp_u(const Args& A, const Frame& F, int layer) {
    const int lane = F.lane, s = lane >> 3, c8 = lane & 7;
    const bool part = (F.nblk & 7) == 0; const int ncb = part ? 1 : 8, cb0 = part ? (F.bid & 7) : 0;
    const int gwv = part ? ((F.bid >> 3) * NWAVES + F.wave) : (F.bid * NWAVES + F.wave), nwv = part ? ((F.nblk >> 3) * NWAVES) : (F.nblk * NWAVES);
    const int ntok = layer == 0 ? R : NB * SEQ;
    const unsigned char* HQ = F.ws + WS_HQ; const unsigned* PK = (const unsigned*)(F.ws + WS_PK);
    const unsigned char* UT = F.ws + WS_TAB + (size_t)(layer * 2) * 16384 * 1024;
    int* PD = (int*)(F.ws + WS_PD);
#define U_META(pk, hq, n_) do { const int r_ = tok_row(layer, (n_) < ntok ? (n_) : gwv); const unsigned* p_ = PK + (size_t)r_ * 128 + s; \
        _Pragma("unroll") for (int i_ = 0; i_ < 16; ++i_) pk[i_] = p_[8 * i_]; \
        hq = *(const u32x4*)(HQ + (size_t)r_ * DM + 128 * cb + 16 * c8); } while (0)
#define U_ISSUE(pk, lo) do { _Pragma("unroll") for (int i_ = (lo); i_ < (lo) + 8; ++i_) t[i_] = *(const u32x4*)(tb + (size_t)(pk[i_] >> 16) * 128); } while (0)
#define U_DOT(i_) do { int d_ = __builtin_amdgcn_sdot4((int)t[i_][0], (int)hv[0], 0, false); d_ = __builtin_amdgcn_sdot4((int)t[i_][1], (int)hv[1], d_, false); \
        d_ = __builtin_amdgcn_sdot4((int)t[i_][2], (int)hv[2], d_, false); d_ = __builtin_amdgcn_sdot4((int)t[i_][3], (int)hv[3], d_, false); \
        d_ = isum8(d_); if (c8 == ((i_) & 7)) { if ((i_) < 8) kA = d_; else kB = d_; } } while (0)
#define U_ITEM(pkc, hqc, pkn, n_) do { \
        const u32x4 hv = hqc; \
        U_META(pkc, hqc, (n_) + 2 * nwv); \
        int kA = 0, kB = 0; \
        _Pragma("unroll") for (int i_ = 0; i_ < 8; ++i_) U_DOT(i_); \
        U_ISSUE(pkn, 0); \
        _Pragma("unroll") for (int i_ = 8; i_ < 16; ++i_) U_DOT(i_); \
        U_ISSUE(pkn, 8); \
        if ((n_) < ntok) { const int r_ = tok_row(layer, n_); int* pd_ = PD + ((size_t)cb * R + r_) * 128 + 8 * c8 + s; pd_[0] = kA; pd_[64] = kB; } \
        } while (0)
#pragma unroll 1
    for (int cbi = 0; cbi < ncb; ++cbi) {
        const int cb = cb0 + cbi;
        const unsigned char* tb = UT + (size_t)cb * 16384 * 128 + 16 * c8;
        unsigned pkA[16], pkB[16]; u32x4 hA, hB, t[16];
        U_META(pkA, hA, gwv); U_META(pkB, hB, gwv + nwv);
        U_ISSUE(pkA, 0); U_ISSUE(pkA, 8);
#pragma unroll 1
        for (int n = gwv; n < ntok; n += 2 * nwv) {
            U_ITEM(pkA, hA, pkB, n);
            U_ITEM(pkB, hB, pkA, n + nwv);
        }
    }
#undef U_META
#undef U_ISSUE
#undef U_DOT
#undef U_ITEM
}
__device__ __forceinline__ void p_exp_w(const Args& A, const Frame& F, int layer) {
    const int gw = F.bid * NWAVES + F.wave, NGW = F.nblk * NWAVES, lane = F.lane;
    const int ntok = layer == 0 ? R : NB * SEQ;
    const unsigned* PK = (const unsigned*)(F.ws + WS_PK); const int* PD = (const int*)(F.ws + WS_PD); const float* HS = (const float*)(F.ws + WS_HS);
    unsigned* WQ8 = (unsigned*)(F.ws + WS_WQ8); float* WSC = (float*)(F.ws + WS_WSC);
    const float* SU = (const float*)(F.ws + WS_TSC) + (layer * 2) * 16384; const float* SV = SU + 16384;
    const int g2 = (lane >> 3) & 3, sb = lane & 7, src = 32 * (g2 & 1) + sb;
    for (int n = gw; n < ntok; n += 2 * NGW) {
        int r[2]; r[0] = tok_row(layer, n); r[1] = (n + NGW) < ntok ? tok_row(layer, n + NGW) : r[0];
        unsigned pk0[2], pk1[2]; int d0[2], d1[2]; float hs[2];
#pragma unroll
        for (int q = 0; q < 2; ++q) { pk0[q] = PK[(size_t)r[q] * 128 + lane]; pk1[q] = PK[(size_t)r[q] * 128 + 64 + lane]; hs[q] = HS[r[q]]; d0[q] = 0; d1[q] = 0;
#pragma unroll
            for (int cb = 0; cb < 8; ++cb) { d0[q] += PD[((size_t)cb * R + r[q]) * 128 + lane]; d1[q] += PD[((size_t)cb * R + r[q]) * 128 + 64 + lane]; } }
        float su0[2], su1[2], sv0[2], sv1[2];
#pragma unroll
        for (int q = 0; q < 2; ++q) { const int e0 = (int)(pk0[q] >> 16), e1 = (int)(pk1[q] >> 16); su0[q] = SU[e0]; su1[q] = SU[e1]; sv0[q] = SV[e0]; sv1[q] = SV[e1]; }
#pragma unroll
        for (int q = 0; q < 2; ++q) {
            const float g0 = (float)(pk0[q] & 0xffffu) * (1.f / 65535.f), g1 = (float)(pk1[q] & 0xffffu) * (1.f / 65535.f);
            const float a0 = su0[q] * hs[q] * (float)d0[q], a1 = su1[q] * hs[q] * (float)d1[q];
            const float w0 = g0 * 0.5f * a0 * (1.f + erff(a0 * 0.70710678118654752f)) * sv0[q], w1 = g1 * 0.5f * a1 * (1.f + erff(a1 * 0.70710678118654752f)) * sv1[q];
            const float wm = wave_max(fmaxf(fabsf(w0), fabsf(w1)));
            const float inv = wm > 0.f ? 127.f / wm : 0.f;
            const int q0 = (int)rintf(w0 * inv) & 0xff, q1 = (int)rintf(w1 * inv) & 0xff;
            unsigned pw = 0;
#pragma unroll
            for (int j = 0; j < 4; ++j) { const int x0 = __shfl(q0, src + 8 * j), x1 = __shfl(q1, src + 8 * j); pw |= (unsigned)((g2 < 2) ? x0 : x1) << (8 * j); }
            if (q == 0 || (n + NGW) < ntok) { if (lane < 32) WQ8[(size_t)r[q] * 32 + lane] = pw; if (lane == 0) WSC[r[q]] = wm > 0.f ? wm * (1.f / 127.f) : 0.f; }
        }
    }
}
__device__ __forceinline__ void p_exp_v(const Args& A, const Frame& F, int layer) {
    const int lane = F.lane, s = lane >> 3, c8 = lane & 7;
    const bool part = (F.nblk & 7) == 0; const int ncb = part ? 1 : 8, cb0 = part ? (F.bid & 7) : 0;
    const int gwv = part ? ((F.bid >> 3) * NWAVES + F.wave) : (F.bid * NWAVES + F.wave), nwv = part ? ((F.nblk >> 3) * NWAVES) : (F.nblk * NWAVES);
    const int ntok = layer == 0 ? R : NB * SEQ;
    const unsigned* PK = (const unsigned*)(F.ws + WS_PK); const unsigned* WQ8 = (const unsigned*)(F.ws + WS_WQ8); const float* WSC = (const float*)(F.ws + WS_WSC);
    const unsigned char* VT = F.ws + WS_TAB + (size_t)(layer * 2 + 1) * 16384 * 1024;
    unsigned short* X = (unsigned short*)(F.ws + WS_X); const float* MOD = (const float*)(F.ws + WS_MOD) + (size_t)layer * 5 * 6144;
    const bool bit3 = (lane & 8) != 0;
#define V_METAP(pk, n_) do { const int r_ = tok_row(layer, (n_) < ntok ? (n_) : gwv); const unsigned* p_ = PK + (size_t)r_ * 128 + s; \
        _Pragma("unroll") for (int i_ = 0; i_ < 16; ++i_) pk[i_] = p_[8 * i_]; } while (0)
#define V_METAW(wq, n_) do { const int r_ = tok_row(layer, (n_) < ntok ? (n_) : gwv); const unsigned* w_ = WQ8 + (size_t)r_ * 32 + s; \
        _Pragma("unroll") for (int g_ = 0; g_ < 4; ++g_) wq[g_] = w_[8 * g_]; } while (0)
#define V_ISSUE(pk, lo) do { _Pragma("unroll") for (int i_ = (lo); i_ < (lo) + 8; ++i_) t[i_] = *(const u32x4*)(tb + (size_t)(pk[i_] >> 16) * 128); } while (0)
#define V_GRP(wq, g_) do { _Pragma("unroll") for (int j_ = 0; j_ < 4; ++j_) { const unsigned a_ = t[4 * (g_)][j_], b_ = t[4 * (g_) + 1][j_], c_ = t[4 * (g_) + 2][j_], d_ = t[4 * (g_) + 3][j_]; \
        const unsigned ablo = __builtin_amdgcn_perm(b_, a_, 0x05010400u), abhi = __builtin_amdgcn_perm(b_, a_, 0x07030602u), cdlo = __builtin_amdgcn_perm(d_, c_, 0x05010400u), cdhi = __builtin_amdgcn_perm(d_, c_, 0x07030602u); \
        acc[4 * j_]     = __builtin_amdgcn_sdot4((int)__builtin_amdgcn_perm(cdlo, ablo, 0x05040100u), (int)wq[g_], acc[4 * j_], false); \
        acc[4 * j_ + 1] = __builtin_amdgcn_sdot4((int)__builtin_amdgcn_perm(cdlo, ablo, 0x07060302u), (int)wq[g_], acc[4 * j_ + 1], false); \
        acc[4 * j_ + 2] = __builtin_amdgcn_sdot4((int)__builtin_amdgcn_perm(cdhi, abhi, 0x05040100u), (int)wq[g_], acc[4 * j_ + 2], false); \
        acc[4 * j_ + 3] = __builtin_amdgcn_sdot4((int)__builtin_amdgcn_perm(cdhi, abhi, 0x07060302u), (int)wq[g_], acc[4 * j_ + 3], false); } } while (0)
#define V_ITEM(pkc, wqc, pkn, n_) do { \
        int acc[16]; _Pragma("unroll") for (int a_ = 0; a_ < 16; ++a_) acc[a_] = 0; \
        V_METAP(pkc, (n_) + 2 * nwv); \
        V_GRP(wqc, 0); V_GRP(wqc, 1); \
        V_ISSUE(pkn, 0); \
        V_GRP(wqc, 2); V_GRP(wqc, 3); \
        V_ISSUE(pkn, 8); \
        int b8[8], c4[4], o[2]; \
        _Pragma("unroll") for (int a_ = 0; a_ < 8; ++a_) { auto rr = __builtin_amdgcn_permlane32_swap((unsigned)acc[a_], (unsigned)acc[a_ + 8], false, false); b8[a_] = (int)rr[0] + (int)rr[1]; } \
        _Pragma("unroll") for (int a_ = 0; a_ < 4; ++a_) { auto rr = __builtin_amdgcn_permlane16_swap((unsigned)b8[a_], (unsigned)b8[a_ + 4], false, false); c4[a_] = (int)rr[0] + (int)rr[1]; } \
        _Pragma("unroll") for (int a_ = 0; a_ < 2; ++a_) { const int keep = bit3 ? c4[a_ + 2] : c4[a_], send = bit3 ? c4[a_] : c4[a_ + 2]; o[a_] = keep + __builtin_amdgcn_update_dpp(0, send, 0x128, 0xf, 0xf, false); } \
        if ((n_) < ntok) { const int r_ = tok_row(layer, n_); const float ws_ = WSC[r_]; const int col = 128 * cb + 16 * c8 + 2 * s; \
            const f32x2 gf = *(const f32x2*)(MOD + (size_t)mod_index(r_) * 6144 + 5 * 1024 + col); unsigned* xp = (unsigned*)(X + (size_t)r_ * DM + col); \
            const unsigned xw = *xp; *xp = pkh2(h2f_lo(xw) + gf.x * (ws_ * (float)o[0]), h2f_hi(xw) + gf.y * (ws_ * (float)o[1])); } \
        V_METAW(wqc, (n_) + 2 * nwv); } while (0)
#pragma unroll 1
    for (int cbi = 0; cbi < ncb; ++cbi) {
        const int cb = cb0 + cbi;
        const unsigned char* tb = VT + (size_t)cb * 16384 * 128 + 16 * c8;
        unsigned pkA[16], pkB[16], wqA[4], wqB[4]; u32x4 t[16];
        V_METAP(pkA, gwv); V_METAW(wqA, gwv); V_METAP(pkB, gwv + nwv); V_METAW(wqB, gwv + nwv);
        V_ISSUE(pkA, 0); V_ISSUE(pkA, 8);
#pragma unroll 1
        for (int n = gwv; n < ntok; n += 2 * nwv) {
            V_ITEM(pkA, wqA, pkB, n);
            V_ITEM(pkB, wqB, pkA, n + nwv);
        }
    }
#undef V_METAP
#undef V_METAW
#undef V_ISSUE
#undef V_GRP
#undef V_ITEM
}
__device__ __forceinline__ void p_final_norm(const Args& A, const Frame& F) {
    const int gw = F.bid * NWAVES + F.wave, NGW = F.nblk * NWAVES, lane = F.lane;
    const unsigned short* X = (const unsigned short*)(F.ws + WS_X); const float* gn = A.in[I_NOUT];
    for (int n = gw; n < NB * SEQ; n += NGW) {
        const unsigned short* xr = X + (size_t)tok_row(1, n) * DM; float* op = F.out + (size_t)n * DM;
        f32x4 v[4]; float sq = 0.f;
#pragma unroll
        for (int j = 0; j < 4; ++j) { const u32x2 a = *(const u32x2*)(xr + 4 * lane + 256 * j); v[j] = (f32x4){h2f_lo(a.x), h2f_hi(a.x), h2f_lo(a.y), h2f_hi(a.y)}; sq += (v[j].x * v[j].x + v[j].y * v[j].y) + (v[j].z * v[j].z + v[j].w * v[j].w); }
        const float rinv = rsqrtf(wave_sum(sq) * (1.f / DM) + EPS);
#pragma unroll
        for (int j = 0; j < 4; ++j) { const int c = 4 * lane + 256 * j; *(f32x4*)(op + c) = v[j] * rinv * *(const f32x4*)(gn + c); }
    }
}

constexpr int N_PHASES = 24;
__global__ void __launch_bounds__(NTHREADS, 2) mega(Args args) {
    extern __shared__ __attribute__((aligned(16))) unsigned char lds_raw[];
    Frame F; F.x = args.in[I_X]; F.ctx = args.in[I_CTX]; F.out = args.out; F.ws = args.ws; F.lds = (char*)lds_raw;
    F.tid = threadIdx.x; F.lane = F.tid & 63; F.wave = __builtin_amdgcn_readfirstlane(F.tid >> 6); F.bid = blockIdx.x; F.nblk = gridDim.x;
    F.vcu = (F.nblk % 8 == 0) ? (F.bid % 8) * (F.nblk / 8) + F.bid / 8 : F.bid;
    volatile LAS unsigned* st = (volatile LAS unsigned*)(LAS unsigned char*)(lds_raw + LDS_BYTES - 64);
    if (F.tid < 16) st[F.tid] = 0u;
    __syncthreads();
    XcdBarrier bar; bar.bar = (unsigned*)(F.ws + WS_CTL) + 4096; bar.x = 0; bar.st = st;
    const int lo = args.ph_lo, hi = args.ph_hi;
    const bool fused = (hi - lo) > 1;
    if (fused) bar = xcd_barrier_post((unsigned*)(F.ws + WS_CTL) + 4096, st);
#ifdef ONLY_PHASE
#define IN(k) ((k) == ONLY_PHASE && lo <= (k) && (k) < hi)
#else
#define IN(k) (lo <= (k) && (k) < hi)
#endif
#define SEAM(k) do { if (IN(k) && IN((k) + 1)) { if ((k) == 0) cg::this_grid().sync(); else xcd_barrier(bar); } } while (0)
    bf16_t* Hb = (bf16_t*)(F.ws + WS_H);
#define PH(k, ...) if (IN(k)) for (int rep_ = 0; rep_ < (((PROBE_MASK >> (k)) & 1u) ? 2 : 1); ++rep_) { __VA_ARGS__; __syncthreads(); } SEAM(k)
    unsigned short* Xb = (unsigned short*)(F.ws + WS_X); const float* MODb = (const float*)(F.ws + WS_MOD);
    PH(0, for (int q_ = 0; q_ < ((PROBE_P0 & 1u) ? 2 : 1); ++q_) { p0_mod(args, F); __syncthreads(); }
          for (int q_ = 0; q_ < ((PROBE_P0 & 2u) ? 2 : 1); ++q_) { p0_weights(args, F); __syncthreads(); }
          for (int q_ = 0; q_ < ((PROBE_P0 & 4u) ? 2 : 1); ++q_) { p0_weff(args, F); __syncthreads(); }
          for (int q_ = 0; q_ < ((PROBE_P0 & 8u) ? 2 : 1); ++q_) { p0_tables(args, F); __syncthreads(); });
    PH(1, p_norm_rows(args, F, 0, 0, true, false));
    PH(2, gemm8e(F, Hb, (const bf16_t*)(F.ws + WS_WIN), 768, 1024, false, EpiMlaDown{(bf16_t*)(F.ws + WS_CQ), (bf16_t*)(F.ws + WS_CKV), (bf16_t*)(F.ws + WS_KR), (float*)(F.ws + WS_SSP)}));
    PH(3, p_mla_krope(args, F);
          gemm8(F, (const bf16_t*)(F.ws + WS_CQ), (const bf16_t*)(F.ws + WS_WUQ), 1536, 384, false, In8Bf16Rs{(bf16_t*)(F.ws + WS_Q), 1536, (const float*)(F.ws + WS_SSP)});
          gemm8(F, (const bf16_t*)(F.ws + WS_CKV), (const bf16_t*)(F.ws + WS_WUKV), 2048, 256, false, In8KVRs{(bf16_t*)(F.ws + WS_K), (bf16_t*)(F.ws + WS_V), (const float*)(F.ws + WS_SSP)}));
    PH(4, p_attn_mla(args, F));
    PH(5, gemm8(F, (const bf16_t*)(F.ws + WS_O), (const bf16_t*)(F.ws + WS_WO0), 1024, 1024, false, In8Resid{F.x, F.ctx, Xb, MODb + 2 * 1024, true}));
    PH(6, p_norm_rows(args, F, 0, 1, false, false));
    PH(7, gemm8(F, Hb, (const bf16_t*)(F.ws + WS_WQ0), 2048, 1024, false, In8F16{(unsigned short*)(F.ws + WS_S), 2048}));
    PH(8, p_peer_topk(args, F, false));
    PH(9, p_exp_u(args, F, 0));
    PH(10, p_exp_w(args, F, 0));
    if (IN(11)) { p_exp_v(args, F, 0); } SEAM(11);
    PH(12, p_norm_rows(args, F, 1, 0, false, false));
    PH(13, gemm8(F, Hb, (const bf16_t*)(F.ws + WS_WQKV), 1536, 1024, false, In8Bf16{(bf16_t*)(F.ws + WS_RAW1), 1536}));
    PH(14, p_gqa_rows(args, F));
    PH(15, p_attn_gqa(args, F));
    if (IN(16)) { gemm8(F, (const bf16_t*)(F.ws + WS_O), (const bf16_t*)(F.ws + WS_WO1), 1024, 1024, true, In8Resid{F.x, F.ctx, Xb, MODb + 5 * 6144 + 2 * 1024, false}); } SEAM(16);
    PH(17, p_norm_rows(args, F, 1, 1, false, true));
    PH(18, gemm8(F, Hb, (const bf16_t*)(F.ws + WS_WQ1), 2048, 1024, true, In8F16{(unsigned short*)(F.ws + WS_S), 2048}));
    PH(19, p_peer_topk(args, F, true));
    PH(20, p_exp_u(args, F, 1));
    PH(21, p_exp_w(args, F, 1));
    if (IN(22)) { p_exp_v(args, F, 1); } SEAM(22);
    if (IN(23)) p_final_norm(args, F);
#undef PH
#undef IN
#undef SEAM
}

extern "C" void kernel_launch(void* const* d_in, const int* in_sizes, int n_in, void* d_out, int out_size, void* d_ws, size_t ws_size, hipStream_t stream) {
    static int grid = 0;
    if (grid == 0) {
        if (n_in != N_IN || in_sizes[0] != NB * SEQ * DM || out_size != NB * SEQ * DM || ws_size < WS_END) {
            fprintf(stderr, "kernel_launch: shape mismatch (n_in %d, in0 %d, out %d, ws %zu < %zu)\n", n_in, n_in > 0 ? in_sizes[0] : -1, out_size, ws_size, (size_t)WS_END); grid = -1; return; }
        int dev = 0, cus = 0, per_cu = 0;
        hipGetDevice(&dev); hipDeviceGetAttribute(&cus, hipDeviceAttributeMultiprocessorCount, dev);
        if (hipFuncSetAttribute((const void*)mega, hipFuncAttributeMaxDynamicSharedMemorySize, LDS_BYTES) != hipSuccess) { fprintf(stderr, "kernel_launch: hipFuncSetAttribute failed\n"); grid = -1; return; }
        if (hipOccupancyMaxActiveBlocksPerMultiprocessor(&per_cu, (const void*)mega, NTHREADS, LDS_BYTES) != hipSuccess || per_cu < 1) { fprintf(stderr, "kernel_launch: occupancy query failed (%d)\n", per_cu); (void)hipGetLastError(); grid = -1; return; }
        grid = cus * (per_cu > 1 ? 1 : per_cu);
    }
    if (grid < 0) return;
    hipMemsetAsync((char*)d_ws + WS_CTL, 0, 1 * MiB, stream);
    Args a{};
    for (int i = 0; i < N_IN; ++i) a.in[i] = (const float*)d_in[i];
    a.out = (float*)d_out; a.ws = (unsigned char*)d_ws;
#if MK_PER_PHASE
    for (int p = 0; p < N_PHASES; ++p) { a.ph_lo = p; a.ph_hi = p + 1; hipLaunchKernelGGL(mega, dim3(grid), dim3(NTHREADS), LDS_BYTES, stream, a); }
#else
    a.ph_lo = 0; a.ph_hi = N_PHASES;
    void* kargs[] = {&a};
    hipError_t e = hipLaunchCooperativeKernel((const void*)mega, dim3(grid), dim3(NTHREADS), kargs, LDS_BYTES, stream);
    if (e != hipSuccess) fprintf(stderr, "kernel_launch: cooperative launch failed: %s (grid %d)\n", hipGetErrorString(e), grid);
#endif
}
```

```cpp
#include <hip/hip_runtime.h>
#include <hip/hip_cooperative_groups.h>
#include <cstdio>
#include <cstdint>
namespace cg = cooperative_groups;

#ifndef PROBE_MASK
#define PROBE_MASK 0u
#endif
#ifndef PROBE_P0
#define PROBE_P0 0u
#endif
#ifndef MK_PER_PHASE
#define MK_PER_PHASE 0
#endif

typedef unsigned short bf16_t;
typedef short bf16x8 __attribute__((ext_vector_type(8)));
typedef short s16x4 __attribute__((ext_vector_type(4)));
typedef float f32x4 __attribute__((ext_vector_type(4)));
typedef float f32x2 __attribute__((ext_vector_type(2)));
typedef float f32x16 __attribute__((ext_vector_type(16)));
typedef unsigned u32x4 __attribute__((ext_vector_type(4)));
typedef unsigned u32x2 __attribute__((ext_vector_type(2)));
#define LAS __attribute__((address_space(3)))
#define SBAR() __builtin_amdgcn_sched_barrier(0)

__device__ __forceinline__ unsigned f2bf(float f) { unsigned u = __builtin_bit_cast(unsigned, f); return (u + 0x7fffu + ((u >> 16) & 1u)) >> 16; }
__device__ __forceinline__ unsigned pk2(float lo, float hi) { return f2bf(lo) | (f2bf(hi) << 16); }
typedef _Float16 f16x2_t __attribute__((ext_vector_type(2)));
__device__ __forceinline__ unsigned pkh2(float lo, float hi) { f32x2 v = {lo, hi}; return __builtin_bit_cast(unsigned, __builtin_convertvector(v, f16x2_t)); }
__device__ __forceinline__ float h2f_lo(unsigned w) { return (float)__builtin_bit_cast(_Float16, (unsigned short)(w & 0xffffu)); }
__device__ __forceinline__ float h2f_hi(unsigned w) { return (float)__builtin_bit_cast(_Float16, (unsigned short)(w >> 16)); }
__device__ __forceinline__ float bf2f(unsigned short h) { return __builtin_bit_cast(float, (unsigned)h << 16); }
__device__ __forceinline__ float bflo(unsigned w) { return __builtin_bit_cast(float, w << 16); }
__device__ __forceinline__ float bfhi(unsigned w) { return __builtin_bit_cast(float, w & 0xffff0000u); }
__device__ __forceinline__ unsigned cvtpk(float lo, float hi) { unsigned r; asm volatile("v_cvt_pk_bf16_f32 %0, %1, %2" : "=v"(r) : "v"(lo), "v"(hi)); return r; }
#define WDPP(v, ctrl) __builtin_bit_cast(float, __builtin_amdgcn_update_dpp(0, __builtin_bit_cast(int, v), ctrl, 0xf, 0xf, false))
__device__ __forceinline__ float wave_sum(float v) {
    v += WDPP(v, 0xB1); v += WDPP(v, 0x4E); v += WDPP(v, 0x141); v += WDPP(v, 0x140);
    { auto rr = __builtin_amdgcn_permlane16_swap(__float_as_uint(v), __float_as_uint(v), false, false); v = __uint_as_float(rr[0]) + __uint_as_float(rr[1]); }
    { auto rr = __builtin_amdgcn_permlane32_swap(__float_as_uint(v), __float_as_uint(v), false, false); v = __uint_as_float(rr[0]) + __uint_as_float(rr[1]); }
    return v;
}
__device__ __forceinline__ float wave_max(float v) {
    v = fmaxf(v, WDPP(v, 0xB1)); v = fmaxf(v, WDPP(v, 0x4E)); v = fmaxf(v, WDPP(v, 0x141)); v = fmaxf(v, WDPP(v, 0x140));
    { auto rr = __builtin_amdgcn_permlane16_swap(__float_as_uint(v), __float_as_uint(v), false, false); v = fmaxf(__uint_as_float(rr[0]), __uint_as_float(rr[1])); }
    { auto rr = __builtin_amdgcn_permlane32_swap(__float_as_uint(v), __float_as_uint(v), false, false); v = fmaxf(__uint_as_float(rr[0]), __uint_as_float(rr[1])); }
    return v;
}

constexpr int DM = 1024, NB = 4, SEQ = 4096, CTXL = 256;
constexpr int RPB = SEQ + CTXL;
constexpr int R = NB * RPB;
constexpr float EPS = 1e-6f;
constexpr int NTHREADS = 512, NWAVES = 8;
constexpr int LDS_BYTES = 147456;

enum { I_X = 0, I_C, I_CTX, I_CCTX,
       I0_ADAW, I0_ADAB, I0_NMIX, I0_NFFN, I0_WIN, I0_QN, I0_WUQ, I0_KVN, I0_WUKV, I0_WO, I0_PWQ, I0_PK1, I0_PK2, I0_PU, I0_PV,
       I1_ADAW, I1_ADAB, I1_NMIX, I1_NFFN, I1_WQKV, I1_QN, I1_KN, I1_WO, I1_PWQ, I1_PK1, I1_PK2, I1_PU, I1_PV,
       I_NOUT, N_IN };

constexpr size_t MiB = 1u << 20;
constexpr size_t WS_CTL   = 0;
constexpr size_t WS_MOD   = 1 * MiB;
constexpr size_t WS_WIN   = 2 * MiB;
constexpr size_t WS_WUQ   = WS_WIN + 768 * 1024 * 2;
constexpr size_t WS_WUKV  = WS_WUQ + 1536 * 384 * 2;
constexpr size_t WS_WO0   = WS_WUKV + 2048 * 256 * 2;
constexpr size_t WS_WQ0   = WS_WO0 + 1024 * 1024 * 2;
constexpr size_t WS_KK0   = WS_WQ0 + 2048 * 1024 * 2;
constexpr size_t WS_WQKV  = WS_KK0 + 16 * 128 * 128 * 2;
constexpr size_t WS_WO1   = WS_WQKV + 1536 * 1024 * 2;
constexpr size_t WS_WQ1   = WS_WO1 + 1024 * 1024 * 2;
constexpr size_t WS_KK1   = WS_WQ1 + 2048 * 1024 * 2;
constexpr size_t WS_WEND  = WS_KK1 + 16 * 128 * 128 * 2;
static_assert(WS_WEND <= 24 * MiB, "weights region");
constexpr size_t WS_H     = 24 * MiB;
constexpr size_t WS_X     = WS_H + (size_t)R * 1024 * 2;
constexpr size_t WS_QKV   = WS_X + (size_t)R * 1024 * 4;
constexpr size_t WS_Q     = WS_QKV;
constexpr size_t WS_K     = WS_Q + (size_t)R * 1536 * 2;
constexpr size_t WS_V     = WS_K + (size_t)R * 1536 * 2;
constexpr size_t WS_S     = WS_QKV;
constexpr size_t WS_B     = WS_QKV + (size_t)R * 2048 * 4;
constexpr size_t WS_CQ    = WS_B;
constexpr size_t WS_CKV   = WS_CQ + (size_t)R * 384 * 2;
constexpr size_t WS_KR    = WS_CKV + (size_t)R * 256 * 2;
constexpr size_t WS_SSP   = WS_KR + (size_t)R * 64 * 2;
static_assert(WS_SSP + (size_t)R * 24 * 4 <= WS_B + 40 * MiB, "MLA latents inside region B");
constexpr size_t WS_O     = WS_B;
constexpr size_t WS_QP    = WS_B;
constexpr size_t WS_RAW1  = WS_B;
constexpr size_t WS_PK    = WS_B + (size_t)R * 2048 * 2;
constexpr size_t WS_TAB   = WS_PK + (size_t)R * 128 * 4;
constexpr size_t WS_PD    = WS_S;
constexpr size_t WS_WQ8   = WS_PD + (size_t)8 * R * 128 * 4;
constexpr size_t WS_WSC   = WS_WQ8 + (size_t)R * 128;
static_assert(WS_WSC + (size_t)R * 4 <= WS_B, "expert scratch inside the S region");
constexpr size_t WS_HQ    = WS_B + 40 * MiB;
constexpr size_t WS_HS    = WS_HQ + (size_t)R * 1024;
static_assert(WS_HS + (size_t)R * 4 <= WS_PK, "HQ inside region B");
constexpr size_t WS_TSC   = WS_TAB + (size_t)4 * 16384 * 1024;
constexpr size_t WS_END   = WS_TSC + (size_t)4 * 16384 * 4;
constexpr size_t WS_Q1    = WS_QKV;
constexpr size_t WS_K1    = WS_Q1 + (size_t)R * 1024 * 2;
constexpr size_t WS_V1    = WS_K1 + (size_t)R * 256 * 2;

#define XB_TMO      128
#define XB_XCNT(j)  (256  + 64 * (j))
#define XB_XSUB(j)  (1280 + 64 * (j))
#define XB_XGEN(j)  (2304 + 64 * (j))
#define XB_TOP      3328
#define XB_TOPGEN   3392
#define XCD_BAR_WORDS 3456
#define XB_SPIN_CAP (1u << 20)
__device__ __forceinline__ unsigned xb_ld(unsigned* p)              { return __hip_atomic_load(p, __ATOMIC_RELAXED, __HIP_MEMORY_SCOPE_AGENT); }
__device__ __forceinline__ unsigned xb_add(unsigned* p, unsigned v) { return __hip_atomic_fetch_add(p, v, __ATOMIC_RELAXED, __HIP_MEMORY_SCOPE_AGENT); }
__device__ __forceinline__ unsigned xb_xcc_id() { return (unsigned)__builtin_amdgcn_s_getreg((3 << 11) | 20) & 0xFu; }
#define XB_SPIN(cond, bar) do { unsigned _sp = 0; while (cond) { __builtin_amdgcn_s_sleep(1); \
    if ((++_sp & 255u) == 0u) { if (xb_ld(&(bar)[XB_TMO])) break; if (_sp > XB_SPIN_CAP) { atomicAdd(&(bar)[XB_TMO], 1u); break; } } } } while (0)
struct XcdBarrier { unsigned* bar; unsigned x; volatile LAS unsigned* st; };
__device__ __forceinline__ XcdBarrier xcd_barrier_post(unsigned* bar, volatile LAS unsigned* st) {
    XcdBarrier b; b.bar = bar; b.x = xb_xcc_id(); b.st = st;
    if (threadIdx.x == 0) (void)xb_add(&bar[XB_XCNT(b.x)], 1u);
    return b;
}
__device__ __forceinline__ void xcd_barrier_complete(unsigned* bar, unsigned x, unsigned& nloc, unsigned& nx) {
    const unsigned G = gridDim.x * gridDim.y * gridDim.z;
    unsigned sum, cnt, mine, sp = 0u;
    for (;;) {
        sum = 0u; cnt = 0u; mine = 0u;
#pragma unroll
        for (unsigned j = 0; j < 16; ++j) { const unsigned c = xb_ld(&bar[XB_XCNT(j)]); sum += c; cnt += (c > 0u) ? 1u : 0u; mine = (j == x) ? c : mine; }
        if (sum == G) break;
        __builtin_amdgcn_s_sleep(1);
        if ((++sp & 255u) == 0u) { if (xb_ld(&bar[XB_TMO])) break; if (sp > XB_SPIN_CAP) { atomicAdd(&bar[XB_TMO], 1u); break; } }
    }
    nloc = mine > 0u ? mine : 1u; nx = cnt > 0u ? cnt : 1u;
}
__device__ __forceinline__ void xcd_barrier(const XcdBarrier& b) {
    asm volatile("s_waitcnt vmcnt(0)" ::: "memory");
    __syncthreads();
    if (threadIdx.x == 0) {
        unsigned* bar = b.bar;
        __builtin_amdgcn_s_waitcnt(0);
        unsigned nloc = b.st[0], nx = b.st[1];
        if (nloc == 0u) { xcd_barrier_complete(bar, b.x, nloc, nx); b.st[0] = nloc; b.st[1] = nx; }
        const unsigned old = xb_add(&bar[XB_XSUB(b.x)], 1u);
        const unsigned gen = old / nloc;
        if (old + 1u == (gen + 1u) * nloc) {
            __builtin_amdgcn_fence(__ATOMIC_RELEASE, "agent");
            asm volatile("s_waitcnt vmcnt(0)" ::: "memory");
            const unsigned og = xb_add(&bar[XB_TOP], 1u);
            const unsigned tg = og / nx;
            if (og + 1u == (tg + 1u) * nx) xb_add(&bar[XB_TOPGEN], 1u);
            else XB_SPIN(xb_ld(&bar[XB_TOPGEN]) == tg, bar);
            __builtin_amdgcn_fence(__ATOMIC_ACQUIRE, "agent");
            xb_add(&bar[XB_XGEN(b.x)], 1u);
            asm volatile("s_waitcnt vmcnt(0)" ::: "memory");
        } else {
            XB_SPIN(xb_ld(&bar[XB_XGEN(b.x)]) == gen, bar);
            __builtin_amdgcn_fence(__ATOMIC_ACQUIRE, "agent");
            asm volatile("s_waitcnt vmcnt(0)" ::: "memory");
        }
    }
    __syncthreads();
}


struct Args { const float* in[N_IN]; float* out; unsigned char* ws; int ph_lo, ph_hi; };
static_assert(sizeof(Args) == (N_IN + 2) * 8 + 8, "Args has no padding");

struct Frame {
    const float* x; const float* ctx; float* out; unsigned char* ws; char* lds;
    int tid, lane, wave, bid, nblk, vcu;
};

__device__ __forceinline__ const float* xin_row(const Frame& F, int r) {
    const int b = r / RPB, j = r - b * RPB;
    return (j < CTXL) ? F.ctx + ((size_t)b * CTXL + j) * DM : F.x + ((size_t)b * SEQ + (j - CTXL)) * DM;
}
__device__ __forceinline__ int mod_index(int r) { const int b = r / RPB, j = r - b * RPB; return (j < CTXL) ? 4 : b; }
__device__ __forceinline__ bool is_ctx_row(int r) { return (r % RPB) < CTXL; }

__device__ __forceinline__ void p0_mod(const Args& A, const Frame& F) {
    float* sv = (float*)F.lds;
    float* red = sv + 5 * 1024;
    float* MOD = (float*)(F.ws + WS_MOD);
    bool have = false;
    for (int it = F.bid; it < 2 * 96; it += F.nblk) {
        if (!have) {
            for (int i = F.tid; i < 5 * 1024; i += NTHREADS) { const int m = i >> 10, k = i & 1023;
                const float c = (m < 4) ? A.in[I_C][m * 1024 + k] : A.in[I_CCTX][k]; sv[i] = c / (1.f + __expf(-c)); }
            __syncthreads(); have = true;
        }
        const int l = it / 96, n = (it % 96) * 64 + F.lane;
        const float* W = A.in[l ? I1_ADAW : I0_ADAW]; const float* Bv = A.in[l ? I1_ADAB : I0_ADAB];
        float acc[5] = {0.f, 0.f, 0.f, 0.f, 0.f};
        const int k0 = F.wave * 128;
#pragma unroll 16
        for (int k = k0; k < k0 + 128; ++k) { const float w = W[(size_t)k * 6144 + n];
#pragma unroll
            for (int m = 0; m < 5; ++m) acc[m] += sv[m * 1024 + k] * w; }
#pragma unroll
        for (int m = 0; m < 5; ++m) red[(F.wave * 5 + m) * 64 + F.lane] = acc[m];
        __syncthreads();
        if (F.tid < 320) { const int m = F.tid >> 6, ln = F.tid & 63; float s = 0.f;
#pragma unroll
            for (int w = 0; w < 8; ++w) s += red[(w * 5 + m) * 64 + ln];
            const int nn = (it % 96) * 64 + ln;
            MOD[((size_t)l * 5 + m) * 6144 + nn] = s + Bv[nn]; }
        __syncthreads();
    }
}
__device__ __forceinline__ void transpose_item(const float* W, int K, int N, bf16_t* WT, const float* gain, float* scr, int item, int lane) {
    const int nblk = N / 32, kb = item / nblk, nb = item % nblk, k0 = 64 * kb, n0 = 32 * nb;
#pragma unroll 8
    for (int i = 0; i < 32; ++i) { const int kk = 2 * i + (lane >> 5); float v = W[(size_t)(k0 + kk) * N + n0 + (lane & 31)]; if (gain) v *= gain[k0 + kk]; scr[kk * 33 + (lane & 31)] = v; }
    asm volatile("s_waitcnt lgkmcnt(0)" ::: "memory");
    const int c = lane & 7;
#pragma unroll
    for (int j = 0; j < 4; ++j) { const int n = (lane >> 3) + 8 * j; const float* s = scr + (8 * c) * 33 + n;
        u32x4 o; o.x = pk2(s[0 * 33], s[1 * 33]); o.y = pk2(s[2 * 33], s[3 * 33]); o.z = pk2(s[4 * 33], s[5 * 33]); o.w = pk2(s[6 * 33], s[7 * 33]);
        *(u32x4*)(WT + (size_t)(n0 + n) * K + k0 + 8 * c) = o; }
    asm volatile("s_waitcnt lgkmcnt(0)" ::: "memory");
}
__device__ __forceinline__ void p0_weights(const Args& A, const Frame& F) {
    float* scr = (float*)(F.lds + 32768) + F.wave * (64 * 33);
    const int gw = F.bid * NWAVES + F.wave, NGW = F.nblk * NWAVES;
#define TJOB(IN_, K_, N_, OFF_, GAIN_) do { const float* W = A.in[IN_]; bf16_t* WT = (bf16_t*)(F.ws + (OFF_)); \
        for (int it = gw; it < ((K_) / 64) * ((N_) / 32); it += NGW) transpose_item(W, K_, N_, WT, GAIN_, scr, it, F.lane); } while (0)
    TJOB(I0_WIN, 1024, 704, WS_WIN, nullptr); TJOB(I0_WUQ, 384, 1536, WS_WUQ, A.in[I0_QN]); TJOB(I0_WUKV, 256, 2048, WS_WUKV, A.in[I0_KVN]); TJOB(I0_WO, 1024, 1024, WS_WO0, nullptr);
    TJOB(I1_WQKV, 1024, 1536, WS_WQKV, nullptr); TJOB(I1_WO, 1024, 1024, WS_WO1, nullptr);
#undef TJOB
    { u32x4* z = (u32x4*)(F.ws + WS_WIN + (size_t)704 * 1024 * 2); const int n16 = 64 * 1024 * 2 / 16;
      for (int i = F.bid * NTHREADS + F.tid; i < n16; i += F.nblk * NTHREADS) z[i] = (u32x4){0u, 0u, 0u, 0u}; }
}
__device__ __forceinline__ void p0_weff(const Args& A, const Frame& F) {
    float* kkT = (float*)F.lds; float* wqs = kkT + 128 * 129;
    const int tid = F.tid, lane = F.lane, w = F.wave;
    for (int item = F.bid; item < 512; item += F.nblk) {
        const int layer = item >> 8, z = (item >> 4) & 15, kc = item & 15, h = z >> 1;
        const float* kk = ((z & 1) ? (layer ? A.in[I1_PK2] : A.in[I0_PK2]) : (layer ? A.in[I1_PK1] : A.in[I0_PK1])) + (size_t)h * 16384;
        const float* wq = (layer ? A.in[I1_PWQ] : A.in[I0_PWQ]) + (size_t)(kc * 64) * 2048 + z * 128;
        bf16_t* WT = (bf16_t*)(F.ws + (layer ? WS_WQ1 : WS_WQ0));
        __syncthreads();
        { f32x4 kv[8], wv4[4];
#pragma unroll
          for (int i = 0; i < 8; ++i) kv[i] = *(const f32x4*)(kk + 4 * (tid + i * NTHREADS));
#pragma unroll
          for (int i = 0; i < 4; ++i) { const int e = 4 * (tid + i * NTHREADS); wv4[i] = *(const f32x4*)(wq + (size_t)(e >> 7) * 2048 + (e & 127)); }
#pragma unroll
          for (int i = 0; i < 8; ++i) { const int e = 4 * (tid + i * NTHREADS), key = e >> 7, d = e & 127; kkT[d * 129 + key] = kv[i].x; kkT[(d + 1) * 129 + key] = kv[i].y; kkT[(d + 2) * 129 + key] = kv[i].z; kkT[(d + 3) * 129 + key] = kv[i].w; }
#pragma unroll
          for (int i = 0; i < 4; ++i) *(f32x4*)(wqs + 4 * (tid + i * NTHREADS)) = wv4[i]; }
        __syncthreads();
        float acc[8][2];
#pragma unroll
        for (int j = 0; j < 8; ++j) { acc[j][0] = 0.f; acc[j][1] = 0.f; }
#pragma unroll 2
        for (int d = 0; d < 128; ++d) { const float a0 = kkT[d * 129 + lane], a1 = kkT[d * 129 + lane + 64];
#pragma unroll
            for (int j = 0; j < 8; ++j) { const float wv = wqs[(w * 8 + j) * 128 + d]; acc[j][0] += wv * a0; acc[j][1] += wv * a1; } }
        u32x4 o0, o1;
        o0.x = pk2(acc[0][0], acc[1][0]); o0.y = pk2(acc[2][0], acc[3][0]); o0.z = pk2(acc[4][0], acc[5][0]); o0.w = pk2(acc[6][0], acc[7][0]);
        o1.x = pk2(acc[0][1], acc[1][1]); o1.y = pk2(acc[2][1], acc[3][1]); o1.z = pk2(acc[4][1], acc[5][1]); o1.w = pk2(acc[6][1], acc[7][1]);
        *(u32x4*)(WT + (size_t)(z * 128 + lane) * 1024 + kc * 64 + w * 8) = o0;
        *(u32x4*)(WT + (size_t)(z * 128 + lane + 64) * 1024 + kc * 64 + w * 8) = o1;
    }
    __syncthreads();
}

__device__ __forceinline__ void p0_tables(const Args& A, const Frame& F) {
    const int gw = F.bid * NWAVES + F.wave, NGW = F.nblk * NWAVES, lane = F.lane;
    unsigned char* TAB = F.ws + WS_TAB; float* TSC = (float*)(F.ws + WS_TSC);
    for (int it = gw; it < 4 * 16384 / 4; it += NGW) {
        const int t = it >> 12, row0 = (it & 4095) * 4;
        const float* src = (t == 0 ? A.in[I0_PU] : t == 1 ? A.in[I0_PV] : t == 2 ? A.in[I1_PU] : A.in[I1_PV]) + (size_t)row0 * 1024 + 4 * lane;
        f32x4 v[4][4];
#pragma unroll
        for (int rr = 0; rr < 4; ++rr)
#pragma unroll
            for (int j = 0; j < 4; ++j) v[rr][j] = *(const f32x4*)(src + (size_t)rr * 1024 + 256 * j);
#pragma unroll
        for (int rr = 0; rr < 4; ++rr) {
            float am = 0.f;
#pragma unroll
            for (int j = 0; j < 4; ++j) am = fmaxf(am, fmaxf(fmaxf(fabsf(v[rr][j].x), fabsf(v[rr][j].y)), fmaxf(fabsf(v[rr][j].z), fabsf(v[rr][j].w))));
            am = wave_max(am);
            const float sc = am > 0.f ? am * (1.f / 127.f) : 1.f, inv = am > 0.f ? 127.f / am : 0.f;
            const int row = row0 + rr;
#pragma unroll
            for (int j = 0; j < 4; ++j) { const unsigned b0 = (unsigned)((int)rintf(v[rr][j].x * inv)) & 0xffu, b1 = (unsigned)((int)rintf(v[rr][j].y * inv)) & 0xffu, b2 = (unsigned)((int)rintf(v[rr][j].z * inv)) & 0xffu, b3 = (unsigned)((int)rintf(v[rr][j].w * inv)) & 0xffu;
                *(unsigned*)(TAB + (((size_t)t * 8 + 2 * j + (lane >> 5)) * 16384 + row) * 128 + 4 * (lane & 31)) = b0 | (b1 << 8) | (b2 << 16) | (b3 << 24); }
            if (lane == 0) TSC[t * 16384 + row] = sc;
        }
    }
}

__device__ __forceinline__ void norm_mod_store(const f32x4 (&v)[4], float rinv, const float* g, const float* sh, const float* sc, bf16_t* orow, int lane) {
#pragma unroll
    for (int j = 0; j < 4; ++j) { const int c = 4 * lane + 256 * j;
        const f32x4 gg = *(const f32x4*)(g + c), s1 = *(const f32x4*)(sc + c), s0 = *(const f32x4*)(sh + c);
        const f32x4 y = (v[j] * rinv * gg) * (s1 + 1.f) + s0;
        u32x2 o; o.x = pk2(y.x, y.y); o.y = pk2(y.z, y.w); *(u32x2*)(orow + c) = o; }
}
__device__ __forceinline__ int tok_row(int layer, int n);
__device__ __forceinline__ void norm_row_out(const Frame& F, const f32x4 (&v)[4], float rinv, const float* g, const float* mm, int r, int which) {
    norm_mod_store(v, rinv, g, mm, mm + 1024, (bf16_t*)(F.ws + WS_H) + (size_t)r * DM, F.lane);
    if (which) {
        f32x4 y[4]; float am = 0.f;
#pragma unroll
        for (int j = 0; j < 4; ++j) { const int c = 4 * F.lane + 256 * j; y[j] = (v[j] * rinv * *(const f32x4*)(g + c)) * (*(const f32x4*)(mm + 1024 + c) + 1.f) + *(const f32x4*)(mm + c);
            am = fmaxf(am, fmaxf(fmaxf(fabsf(y[j].x), fabsf(y[j].y)), fmaxf(fabsf(y[j].z), fabsf(y[j].w)))); }
        am = wave_max(am);
        const float inv = am > 0.f ? 127.f / am : 0.f;
#pragma unroll
        for (int j = 0; j < 4; ++j) { const unsigned b0 = (unsigned)((int)rintf(y[j].x * inv)) & 0xffu, b1 = (unsigned)((int)rintf(y[j].y * inv)) & 0xffu, b2 = (unsigned)((int)rintf(y[j].z * inv)) & 0xffu, b3 = (unsigned)((int)rintf(y[j].w * inv)) & 0xffu;
            *(unsigned*)(F.ws + WS_HQ + (size_t)r * DM + 4 * F.lane + 256 * j) = b0 | (b1 << 8) | (b2 << 16) | (b3 << 24); }
        if (F.lane == 0) ((float*)(F.ws + WS_HS))[r] = am > 0.f ? am * (1.f / 127.f) : 1.f;
    }
}
__device__ __forceinline__ void p_norm_rows(const Args& A, const Frame& F, int layer, int which, bool from_input, bool skip_ctx) {
    const int gw = F.bid * NWAVES + F.wave, NGW = F.nblk * NWAVES;
    const float* g = A.in[layer ? (which ? I1_NFFN : I1_NMIX) : (which ? I0_NFFN : I0_NMIX)];
    const float* MOD = (const float*)(F.ws + WS_MOD) + (size_t)layer * 5 * 6144;
    const unsigned short* X = (const unsigned short*)(F.ws + WS_X);
    const int ntok = skip_ctx ? NB * SEQ : R;
    for (int n = gw; n < ntok; n += 2 * NGW) {
        const bool has1 = (n + NGW) < ntok;
        const int r0 = skip_ctx ? tok_row(1, n) : n, r1 = has1 ? (skip_ctx ? tok_row(1, n + NGW) : n + NGW) : r0;
        f32x4 v0[4], v1[4]; float s0 = 0.f, s1 = 0.f;
        if (from_input) { const float* x0 = xin_row(F, r0); const float* x1 = xin_row(F, r1);
#pragma unroll
            for (int j = 0; j < 4; ++j) { v0[j] = *(const f32x4*)(x0 + 4 * F.lane + 256 * j); v1[j] = *(const f32x4*)(x1 + 4 * F.lane + 256 * j); } }
        else {
#pragma unroll
            for (int j = 0; j < 4; ++j) { const u32x2 a = *(const u32x2*)(X + (size_t)r0 * DM + 4 * F.lane + 256 * j), b = *(const u32x2*)(X + (size_t)r1 * DM + 4 * F.lane + 256 * j);
                v0[j] = (f32x4){h2f_lo(a.x), h2f_hi(a.x), h2f_lo(a.y), h2f_hi(a.y)}; v1[j] = (f32x4){h2f_lo(b.x), h2f_hi(b.x), h2f_lo(b.y), h2f_hi(b.y)}; } }
#pragma unroll
        for (int j = 0; j < 4; ++j) { s0 += (v0[j].x * v0[j].x + v0[j].y * v0[j].y) + (v0[j].z * v0[j].z + v0[j].w * v0[j].w); s1 += (v1[j].x * v1[j].x + v1[j].y * v1[j].y) + (v1[j].z * v1[j].z + v1[j].w * v1[j].w); }
        const float ri0 = rsqrtf(wave_sum(s0) * (1.f / DM) + EPS), ri1 = rsqrtf(wave_sum(s1) * (1.f / DM) + EPS);
        norm_row_out(F, v0, ri0, g, MOD + (size_t)mod_index(r0) * 6144 + (which ? 3 * 1024 : 0), r0, which);
        if (has1) norm_row_out(F, v1, ri1, g, MOD + (size_t)mod_index(r1) * 6144 + (which ? 3 * 1024 : 0), r1, which);
    }
}

namespace pg8 {
#define PG8_LAS __attribute__((address_space(3)))
typedef unsigned short bf16_t;
typedef short bf16x8 __attribute__((ext_vector_type(8)));
typedef float f32x4 __attribute__((ext_vector_type(4)));
typedef unsigned u32x4 __attribute__((ext_vector_type(4)));
constexpr int BM = 256, BK = 64, HALF = 128, HTB = HALF * BK * 2  , STAGE_BYTES = 8 * HTB, NXCD = 8, WGM = 8;

__host__ __device__ __forceinline__ int lds_byte(int r, int c) { const int st = (r >> 4) * 2 + (c >> 5), rr = r & 15, cc = c & 31, ob = rr * 64 + cc * 2; return st * 1024 + (ob ^ (((ob >> 9) & 1) << 5)); }
__host__ __device__ __forceinline__ void stage_rc(int b, int& R, int& C) { const int st = b / 1024, sb = b % 1024, swz = sb ^ (((sb >> 9) & 1) << 5); R = (st >> 1) * 16 + swz / 64; C = (st & 1) * 32 + (swz % 64) / 2; }
__host__ __device__ __forceinline__ int perm32(int rho) { const int n = rho >> 4, i = rho & 15; return 8 * (i >> 2) + 4 * n + (i & 3); }

struct Unit { int pm, pn; };
struct Gemm { const bf16_t* A; const bf16_t* Bt; int M, N, K; };

struct StaticOrder {
    int nM, nN, nwg, G, c;
    __host__ __device__ void init(int M, int N, int G_, int c_) { nM = M / BM; nN = N / BM; nwg = nM * nN; G = G_; c = c_; }
    __host__ __device__ bool next(int i, Unit& u) const {
        const long L = (long)i * G + c; if (L >= nwg) return false;
        int wgid = (int)L; { const int q = nwg / NXCD, r = nwg % NXCD, xcd = wgid % NXCD, off = wgid / NXCD; wgid = (xcd < r ? xcd * (q + 1) : r * (q + 1) + (xcd - r) * q) + off; }
        const int nig = WGM * nN, gid = wgid / nig, fm = gid * WGM, gsz = (nM - fm) < WGM ? (nM - fm) : WGM;
        u.pm = fm + ((wgid % nig) % gsz); u.pn = (wgid % nig) / gsz; return true;
    }
    __device__ __forceinline__ void a_ready(const Unit&) const {}
    __device__ __forceinline__ void done(const Unit&) const {}
};

template <class Epi, class Sched, bool ALIGN_EPI = false, bool SP2 = false>
__device__ __forceinline__ void gemm_phase(PG8_LAS unsigned char* lds, const Gemm g, const Sched& S, const Epi& E) {
    const int tid = threadIdx.x, wid = __builtin_amdgcn_readfirstlane(tid >> 6), lane = tid & 63, wr = wid >> 2, wc = wid & 3, fr = lane & 15, fq = lane >> 4;
    const int K = g.K, nt = K / BK;
    unsigned voffA[2], voffB[2];
#pragma unroll
    for (int i = 0; i < 2; ++i) { int R, C; stage_rc(tid * 16 + i * 8192, R, C); const int Rb = Epi::PERM ? ((R & ~31) + perm32(R & 31)) : R;
        voffA[i] = (unsigned)(R * K + C) * 2u; voffB[i] = (unsigned)(Rb * K + C) * 2u; }
    const size_t kstep = (size_t)(BK * 2);
    const size_t hstep = (size_t)HALF * K * 2;
    const size_t tstep = 2 * hstep;
    const unsigned ldsw = (unsigned)wid * 1024u;
    const int aoff = lds_byte(wr * 64 + fr, fq * 8), boff = lds_byte(wc * 32 + fr, fq * 8);
#define PG8_SA(b, h) (((b) * 2 + (h)) * HTB)
#define PG8_SB(b, h) ((4 + (b) * 2 + (h)) * HTB)
#define PG8_STAGE(bufoff, gbase, voff) do { _Pragma("unroll") for (int _i = 0; _i < 2; ++_i) \
        __builtin_amdgcn_global_load_lds((const unsigned*)((const char*)(gbase) + (voff)[_i]), (PG8_LAS unsigned*)(lds + (bufoff) + ldsw + _i * 8192), 16, 0, 0); } while (0)
#define PG8_LDA(dst, b, h) do { _Pragma("unroll") for (int m = 0; m < 4; ++m) _Pragma("unroll") for (int k = 0; k < 2; ++k) dst[m][k] = *(const PG8_LAS bf16x8*)(lds + PG8_SA(b, h) + aoff + m * 2048 + k * 1024); } while (0)
#define PG8_LDB(dst, b, h) do { _Pragma("unroll") for (int n = 0; n < 2; ++n) _Pragma("unroll") for (int k = 0; k < 2; ++k) dst[n][k] = *(const PG8_LAS bf16x8*)(lds + PG8_SB(b, h) + boff + n * 2048 + k * 1024); } while (0)
#define PG8_MMA(ai, bj, At, Bt) do { __builtin_amdgcn_s_setprio(1); _Pragma("unroll") for (int m = 0; m < 4; ++m) _Pragma("unroll") for (int n = 0; n < 2; ++n) _Pragma("unroll") for (int k = 0; k < 2; ++k) \
        acc[ai][bj][m][n] = __builtin_amdgcn_mfma_f32_16x16x32_bf16(Bt[n][k], At[m][k], acc[ai][bj][m][n], 0, 0, 0); __builtin_amdgcn_s_setprio(0); } while (0)
#define PG8_WAIT_V(n) asm volatile("s_waitcnt vmcnt(" #n ")" ::: "memory")
#define PG8_WAIT_L(n) asm volatile("s_waitcnt lgkmcnt(" #n ")" ::: "memory")
#define PG8_BAR __builtin_amdgcn_s_barrier()
#define PG8_SCHED __builtin_amdgcn_sched_barrier(0)
    Unit cur, nxt; int ui = 0;
    if (!S.next(0, cur)) return;
    f32x4 acc[2][2][4][2];
#pragma unroll
    for (int a = 0; a < 2; ++a)
#pragma unroll
        for (int b = 0; b < 2; ++b)
#pragma unroll
            for (int m = 0; m < 4; ++m)
#pragma unroll
                for (int n = 0; n < 2; ++n) acc[a][b][m][n] = (f32x4){0.f, 0.f, 0.f, 0.f};
    bf16x8 At[4][2], B0[2][2], B1[2][2];
    const char* cA = (const char*)g.A + (size_t)cur.pm * tstep; const char* cB = (const char*)g.Bt + (size_t)cur.pn * tstep;
    S.a_ready(cur);
    if constexpr (SP2) {
        PG8_STAGE(PG8_SB(0, 0), cB, voffB); PG8_STAGE(PG8_SB(0, 1), cB + hstep, voffB); PG8_STAGE(PG8_SA(0, 0), cA, voffA); PG8_STAGE(PG8_SA(0, 1), cA + hstep, voffA);
        if (wr == 1) PG8_BAR;
        PG8_WAIT_V(2); PG8_BAR;
        PG8_STAGE(PG8_SB(1, 0), cB + kstep, voffB); PG8_STAGE(PG8_SA(1, 0), cA + kstep, voffA); PG8_STAGE(PG8_SB(1, 1), cB + hstep + kstep, voffB);
        PG8_WAIT_V(6); PG8_BAR;
    } else {
        PG8_STAGE(PG8_SB(0, 0), cB, voffB); PG8_STAGE(PG8_SA(0, 0), cA, voffA); PG8_STAGE(PG8_SB(0, 1), cB + hstep, voffB); PG8_STAGE(PG8_SA(0, 1), cA + hstep, voffA);
        if (wr == 1) PG8_BAR;
        PG8_WAIT_V(4); PG8_BAR;
        PG8_STAGE(PG8_SB(1, 0), cB + kstep, voffB); PG8_STAGE(PG8_SA(1, 0), cA + kstep, voffA); PG8_STAGE(PG8_SB(1, 1), cB + hstep + kstep, voffB);
        PG8_WAIT_V(6); PG8_BAR;
    }
    for (;;) {
        const bool has_next = S.next(ui + 1, nxt);
        const char* nA = has_next ? (const char*)g.A + (size_t)nxt.pm * tstep : cA; const char* nB = has_next ? (const char*)g.Bt + (size_t)nxt.pn * tstep : cB;
        for (int t = 0; t < nt; t += 2) {
            const bool last = (t == nt - 2);
            const char* a1 = cA + (size_t)(t + 1) * kstep;
            const char* a2 = last ? nA : cA + (size_t)(t + 2) * kstep; const char* b2 = last ? nB : cB + (size_t)(t + 2) * kstep;
            const char* a3 = a2 + kstep; const char* b3 = b2 + kstep;
            if (last && has_next) S.a_ready(nxt);
            if constexpr (SP2) {
            PG8_LDB(B0, 0, 0); PG8_LDB(B1, 0, 1); PG8_SCHED; PG8_LDA(At, 0, 0); PG8_STAGE(PG8_SA(1, 1), a1 + hstep, voffA);
            PG8_WAIT_V(8); PG8_WAIT_L(0); PG8_BAR; PG8_MMA(0, 0, At, B0); PG8_MMA(0, 1, At, B1); PG8_BAR; PG8_SCHED;
            PG8_LDA(At, 0, 1); PG8_STAGE(PG8_SB(0, 0), b2, voffB); PG8_STAGE(PG8_SB(0, 1), b2 + hstep, voffB); PG8_STAGE(PG8_SA(0, 0), a2, voffA);
            PG8_WAIT_V(8); PG8_WAIT_L(0); PG8_BAR; PG8_MMA(1, 0, At, B0); PG8_MMA(1, 1, At, B1); PG8_BAR; PG8_SCHED;
            PG8_LDB(B0, 1, 0); PG8_LDB(B1, 1, 1); PG8_SCHED; PG8_LDA(At, 1, 0); PG8_STAGE(PG8_SA(0, 1), a2 + hstep, voffA);
            PG8_WAIT_V(8); PG8_WAIT_L(0); PG8_BAR; PG8_MMA(0, 0, At, B0); PG8_MMA(0, 1, At, B1); PG8_BAR; PG8_SCHED;
            PG8_LDA(At, 1, 1); PG8_STAGE(PG8_SB(1, 0), b3, voffB); PG8_STAGE(PG8_SB(1, 1), b3 + hstep, voffB); PG8_STAGE(PG8_SA(1, 0), a3, voffA);
            PG8_WAIT_V(8); PG8_WAIT_L(0); PG8_BAR; PG8_MMA(1, 0, At, B0); PG8_MMA(1, 1, At, B1); PG8_BAR; PG8_SCHED;
            } else {
            PG8_LDB(B0, 0, 0); PG8_SCHED; PG8_LDA(At, 0, 0); PG8_STAGE(PG8_SA(1, 1), a1 + hstep, voffA);
            PG8_WAIT_L(8); PG8_BAR; PG8_WAIT_L(0); PG8_MMA(0, 0, At, B0); PG8_BAR; PG8_SCHED;
            PG8_LDB(B1, 0, 1); PG8_STAGE(PG8_SB(0, 0), b2, voffB);
            PG8_BAR; PG8_WAIT_L(0); PG8_MMA(0, 1, At, B1); PG8_BAR;
            PG8_LDA(At, 0, 1); PG8_STAGE(PG8_SA(0, 0), a2, voffA);
            PG8_BAR; PG8_WAIT_L(0); PG8_MMA(1, 0, At, B0); PG8_BAR; PG8_SCHED;
            PG8_STAGE(PG8_SB(0, 1), b2 + hstep, voffB);
            PG8_WAIT_V(6); PG8_BAR; PG8_MMA(1, 1, At, B1); PG8_BAR;
            PG8_LDB(B0, 1, 0); PG8_SCHED; PG8_LDA(At, 1, 0); PG8_STAGE(PG8_SA(0, 1), a2 + hstep, voffA);
            PG8_WAIT_L(8); PG8_BAR; PG8_WAIT_L(0); PG8_MMA(0, 0, At, B0); PG8_BAR; PG8_SCHED;
            PG8_LDB(B1, 1, 1); PG8_STAGE(PG8_SB(1, 0), b3, voffB);
            PG8_BAR; PG8_WAIT_L(0); PG8_MMA(0, 1, At, B1); PG8_BAR;
            PG8_LDA(At, 1, 1); PG8_STAGE(PG8_SA(1, 0), a3, voffA);
            PG8_BAR; PG8_WAIT_L(0); PG8_MMA(1, 0, At, B0); PG8_BAR; PG8_SCHED;
            PG8_STAGE(PG8_SB(1, 1), b3 + hstep, voffB);
            PG8_WAIT_V(6); PG8_BAR; PG8_MMA(1, 1, At, B1); PG8_BAR;
            }
        }
        if constexpr (ALIGN_EPI) { if (wr == 0) PG8_BAR; }
        if constexpr (!Epi::AFTER_DRAIN) { E(acc, cur, wr, wc, fr, fq); S.done(cur); }
        if (!has_next) break;
#pragma unroll
        for (int a = 0; a < 2; ++a)
#pragma unroll
            for (int b = 0; b < 2; ++b)
#pragma unroll
                for (int m = 0; m < 4; ++m)
#pragma unroll
                    for (int n = 0; n < 2; ++n) acc[a][b][m][n] = (f32x4){0.f, 0.f, 0.f, 0.f};
        cur = nxt; cA = nA; cB = nB; ++ui;
        if constexpr (ALIGN_EPI) { if (wr == 1) PG8_BAR; }
    }
    PG8_WAIT_V(0);
    if constexpr (!ALIGN_EPI) { if (wr == 0) PG8_BAR; }
    PG8_BAR;
    if constexpr (Epi::AFTER_DRAIN) { E.fused(acc, cur, wr, wc, fr, fq, lds, wid, lane); S.done(cur); }
#undef PG8_SA
#undef PG8_SB
#undef PG8_STAGE
#undef PG8_LDA
#undef PG8_LDB
#undef PG8_MMA
#undef PG8_WAIT_V
#undef PG8_WAIT_L
#undef PG8_BAR
#undef PG8_SCHED
}
}

template <class Inner> struct EpiTile { static constexpr bool PERM = true, AFTER_DRAIN = false; Inner in;
    __device__ __forceinline__ void operator()(const pg8::f32x4 (&acc)[2][2][4][2], const pg8::Unit& u, int wr, int wc, int fr, int fq) const {
#pragma unroll
        for (int ai = 0; ai < 2; ++ai)
#pragma unroll
            for (int m = 0; m < 4; ++m) { const int row = u.pm * 256 + ai * 128 + wr * 64 + m * 16 + fr;
#pragma unroll
                for (int bj = 0; bj < 2; ++bj) in(row, u.pn * 256 + bj * 128 + wc * 32 + 8 * fq, acc[ai][bj][m][0], acc[ai][bj][m][1]); }
    } };
struct In8Bf16 { bf16_t* C; int ldc;
    __device__ __forceinline__ void operator()(int row, int col, f32x4 a, f32x4 b) const { u32x4 o; o.x = cvtpk(a.x, a.y); o.y = cvtpk(a.z, a.w); o.z = cvtpk(b.x, b.y); o.w = cvtpk(b.z, b.w); *(u32x4*)(C + (size_t)row * ldc + col) = o; } };
struct In8KV { bf16_t* Kb; bf16_t* Vb;
    __device__ __forceinline__ void operator()(int row, int col, f32x4 a, f32x4 b) const { const int h = col >> 8, c = col & 255; u32x4 o; o.x = cvtpk(a.x, a.y); o.y = cvtpk(a.z, a.w); o.z = cvtpk(b.x, b.y); o.w = cvtpk(b.z, b.w);
        bf16_t* p = (c < 128) ? Kb + (size_t)row * 1536 + h * 192 + c : Vb + (size_t)row * 1024 + h * 128 + (c - 128);
        *(u32x4*)p = o; } };
struct In8F16 { unsigned short* C; int ldc;
    __device__ __forceinline__ void operator()(int row, int col, f32x4 a, f32x4 b) const { u32x4 o; o.x = pkh2(a.x, a.y); o.y = pkh2(a.z, a.w); o.z = pkh2(b.x, b.y); o.w = pkh2(b.z, b.w); *(u32x4*)(C + (size_t)row * ldc + col) = o; } };
struct In8F32 { float* C; int ldc;
    __device__ __forceinline__ void operator()(int row, int col, f32x4 a, f32x4 b) const { float* p = C + (size_t)row * ldc + col; *(f32x4*)p = a; *(f32x4*)(p + 4) = b; } };
struct In8Resid { const float* x; const float* ctx; unsigned short* X; const float* gate; bool from_input;
    __device__ __forceinline__ void operator()(int row, int col, f32x4 a, f32x4 b) const {
        const int bb = row / RPB, j = row - bb * RPB; unsigned short* xo = X + (size_t)row * DM + col;
        f32x4 x0, x1;
        if (from_input) { const float* xi = ((j < CTXL) ? ctx + ((size_t)bb * CTXL + j) * DM : x + ((size_t)bb * SEQ + (j - CTXL)) * DM) + col; x0 = *(const f32x4*)xi; x1 = *(const f32x4*)(xi + 4); }
        else { const u32x4 w = *(const u32x4*)xo; x0 = (f32x4){h2f_lo(w.x), h2f_hi(w.x), h2f_lo(w.y), h2f_hi(w.y)}; x1 = (f32x4){h2f_lo(w.z), h2f_hi(w.z), h2f_lo(w.w), h2f_hi(w.w)}; }
        const float* g = gate + (size_t)((j < CTXL) ? 4 : bb) * 6144 + col;
        x0 += *(const f32x4*)g * a; x1 += *(const f32x4*)(g + 4) * b;
        u32x4 o; o.x = pkh2(x0.x, x0.y); o.y = pkh2(x0.z, x0.w); o.z = pkh2(x1.x, x1.y); o.w = pkh2(x1.z, x1.w); *(u32x4*)xo = o; } };
struct EpiMlaDown { static constexpr bool PERM = true, AFTER_DRAIN = false; bf16_t* CQ; bf16_t* CKV; bf16_t* KR; float* SSP;
    __device__ __forceinline__ void operator()(const pg8::f32x4 (&acc)[2][2][4][2], const pg8::Unit& u, int wr, int wc, int fr, int fq) const {
#pragma unroll
        for (int ai = 0; ai < 2; ++ai)
#pragma unroll
            for (int m = 0; m < 4; ++m) { const int row = u.pm * 256 + ai * 128 + wr * 64 + m * 16 + fr;
#pragma unroll
                for (int bj = 0; bj < 2; ++bj) { const int col = u.pn * 256 + bj * 128 + wc * 32 + 8 * fq; const f32x4 a = acc[ai][bj][m][0], b = acc[ai][bj][m][1];
                    u32x4 o; o.x = cvtpk(a.x, a.y); o.y = cvtpk(a.z, a.w); o.z = cvtpk(b.x, b.y); o.w = cvtpk(b.z, b.w);
                    const int cls = (u.pn * 2 + bj);
                    if (cls < 5) { float sq = (a.x * a.x + a.y * a.y) + (a.z * a.z + a.w * a.w) + (b.x * b.x + b.y * b.y) + (b.z * b.z + b.w * b.w);
                        sq += __shfl_xor(sq, 16); sq += __shfl_xor(sq, 32);
                        if (cls < 3) *(u32x4*)(CQ + (size_t)row * 384 + col) = o; else *(u32x4*)(CKV + (size_t)row * 256 + (col - 384)) = o;
                        if (fq == 0) SSP[(size_t)row * 24 + cls * 4 + wc] = sq; }
                    else if (col < 704) *(u32x4*)(KR + (size_t)row * 64 + (col - 640)) = o; } }
    } };
struct In8Bf16Rs { bf16_t* C; int ldc; const float* ssp;
    __device__ __forceinline__ void operator()(int row, int col, f32x4 a, f32x4 b) const { const f32x4 s0 = *(const f32x4*)(ssp + (size_t)row * 24), s1 = *(const f32x4*)(ssp + (size_t)row * 24 + 4), s2 = *(const f32x4*)(ssp + (size_t)row * 24 + 8);
        const float ssum = (((s0.x + s0.y) + (s0.z + s0.w)) + ((s1.x + s1.y) + (s1.z + s1.w))) + ((s2.x + s2.y) + (s2.z + s2.w));
        const float rs = rsqrtf(ssum * (1.f / 384.f) + EPS); a *= rs; b *= rs;
        u32x4 o; o.x = cvtpk(a.x, a.y); o.y = cvtpk(a.z, a.w); o.z = cvtpk(b.x, b.y); o.w = cvtpk(b.z, b.w); *(u32x4*)(C + (size_t)row * ldc + col) = o; } };
struct In8KVRs { bf16_t* Kb; bf16_t* Vb; const float* ssp;
    __device__ __forceinline__ void operator()(int row, int col, f32x4 a, f32x4 b) const { const f32x4 s0 = *(const f32x4*)(ssp + (size_t)row * 24 + 12), s1 = *(const f32x4*)(ssp + (size_t)row * 24 + 16);
        const float ssum = ((s0.x + s0.y) + (s0.z + s0.w)) + ((s1.x + s1.y) + (s1.z + s1.w));
        const float rs = rsqrtf(ssum * (1.f / 256.f) + EPS); a *= rs; b *= rs;
        const int h = col >> 8, c = col & 255; u32x4 o; o.x = cvtpk(a.x, a.y); o.y = cvtpk(a.z, a.w); o.z = cvtpk(b.x, b.y); o.w = cvtpk(b.z, b.w);
        bf16_t* p = (c < 128) ? Kb + (size_t)row * 1536 + h * 192 + c : Vb + (size_t)row * 1024 + h * 128 + (c - 128);
        *(u32x4*)p = o; } };
struct RowSched { pg8::StaticOrder so; bool latent_only;
    __device__ __forceinline__ void init(int N, int G, int c, bool lat) { latent_only = lat; so.init(lat ? NB * SEQ : R, N, G, c); }
    __device__ __forceinline__ bool next(int i, pg8::Unit& u) const { if (!so.next(i, u)) return false; if (latent_only) u.pm = (u.pm >> 4) * 17 + 1 + (u.pm & 15); return true; }
    __device__ __forceinline__ void a_ready(const pg8::Unit&) const {}
    __device__ __forceinline__ void done(const pg8::Unit&) const {} };
template <class Inner> __device__ __forceinline__ void gemm8(const Frame& F, const bf16_t* Ap, const bf16_t* Bt, int N, int K, bool latent_only, const Inner& in) {
    asm volatile("" : "+s"(K));
    pg8::Gemm g{Ap, Bt, R, N, K}; RowSched S; S.init(N, F.nblk, F.bid, latent_only);
    EpiTile<Inner> E{in};
    pg8::gemm_phase<EpiTile<Inner>, RowSched, true, true>((PG8_LAS unsigned char*)F.lds, g, S, E);
}

template <class Epi> __device__ __forceinline__ void gemm8e(const Frame& F, const bf16_t* Ap, const bf16_t* Bt, int N, int K, bool latent_only, const Epi& E) {
    asm volatile("" : "+s"(K));
    pg8::Gemm g{Ap, Bt, R, N, K}; RowSched S; S.init(N, F.nblk, F.bid, latent_only);
    pg8::gemm_phase<Epi, RowSched, true, true>((PG8_LAS unsigned char*)F.lds, g, S, E);
}

struct GemmDesc { const bf16_t* A; int lda; long sA; const bf16_t* Bt; int ldb; long sB; int M, N, K, nz; };
template <class Epi>
__device__ __forceinline__ void gemm_simple(const Frame& F, const GemmDesc& g, const Epi& epi, bool skip_ctx) {
    const int wm = F.wave >> 1, wn = F.wave & 1, fr = F.lane & 15, fq = F.lane >> 4;
    const int tM = g.M / 128, tN = g.N / 128, per = tM * tN, total = per * g.nz;
    for (int u = F.bid; u < total; u += F.nblk) {
        const int z = u / per, uu = u - z * per, tm = uu / tN, tn = uu - tm * tN;
        if (skip_ctx && ((tm * 128) % RPB) < CTXL) continue;
        const int row0 = tm * 128 + wm * 32, col0 = tn * 128 + wn * 64;
        const bf16_t* ap = g.A + z * g.sA + (size_t)(row0 + fr) * g.lda + fq * 8;
        const bf16_t* bp = g.Bt + z * g.sB + (size_t)(col0 + fr) * g.ldb + fq * 8;
        f32x4 acc[2][4];
#pragma unroll
        for (int mi = 0; mi < 2; ++mi)
#pragma unroll
            for (int ni = 0; ni < 4; ++ni) acc[mi][ni] = (f32x4){0.f, 0.f, 0.f, 0.f};
        for (int k0 = 0; k0 < g.K; k0 += 32) {
            bf16x8 a[2], b[4];
#pragma unroll
            for (int mi = 0; mi < 2; ++mi) a[mi] = *(const bf16x8*)(ap + (size_t)mi * 16 * g.lda + k0);
#pragma unroll
            for (int ni = 0; ni < 4; ++ni) b[ni] = *(const bf16x8*)(bp + (size_t)ni * 16 * g.ldb + k0);
#pragma unroll
            for (int mi = 0; mi < 2; ++mi)
#pragma unroll
                for (int ni = 0; ni < 4; ++ni) acc[mi][ni] = __builtin_amdgcn_mfma_f32_16x16x32_bf16(b[ni], a[mi], acc[mi][ni], 0, 0, 0);
        }
#pragma unroll
        for (int mi = 0; mi < 2; ++mi)
#pragma unroll
            for (int ni = 0; ni < 4; ++ni) epi(z, row0 + mi * 16 + fr, col0 + ni * 16 + fq * 4, acc[mi][ni]);
    }
}
struct EpiBf16 { bf16_t* C; int ldc;
    __device__ __forceinline__ void operator()(int, int row, int col, f32x4 v) const { u32x2 o; o.x = pk2(v.x, v.y); o.y = pk2(v.z, v.w); *(u32x2*)(C + (size_t)row * ldc + col) = o; } };
struct EpiKV { bf16_t* Kb; bf16_t* Vb;
    __device__ __forceinline__ void operator()(int, int row, int col, f32x4 v) const { const int h = col >> 8, c = col & 255; u32x2 o; o.x = pk2(v.x, v.y); o.y = pk2(v.z, v.w);
        if (c < 128) *(u32x2*)(Kb + (size_t)row * 1536 + h * 192 + c) = o; else *(u32x2*)(Vb + (size_t)row * 1024 + h * 128 + (c - 128)) = o; } };
struct EpiF32Z { float* C; int ldc;
    __device__ __forceinline__ void operator()(int z, int row, int col, f32x4 v) const { *(f32x4*)(C + (size_t)row * ldc + z * 128 + col) = v; } };
struct EpiResid { const Frame* F; const float* gate; bool from_input;
    __device__ __forceinline__ void operator()(int, int row, int col, f32x4 v) const {
        float* X = (float*)(F->ws + WS_X) + (size_t)row * DM + col;
        const float* xi = from_input ? xin_row(*F, row) + col : X;
        const f32x4 g = *(const f32x4*)(gate + (size_t)mod_index(row) * 6144 + col);
        *(f32x4*)X = *(const f32x4*)xi + g * v; } };

__device__ __forceinline__ void rope_angles(int r, int& prow, int& pcol) { const int t = (r % RPB) - CTXL; prow = t >> 6; pcol = t & 63; }
__device__ __forceinline__ void p_mla_krope(const Args& A, const Frame& F) {
    const int gw = F.bid * NWAVES + F.wave, NGW = F.nblk * NWAVES, lane = F.lane;
    const bf16_t* KR = (const bf16_t*)(F.ws + WS_KR); bf16_t* Kb = (bf16_t*)(F.ws + WS_K);
    const float invf = __powf(10000.f, -(float)(lane & 15) * (1.f / 16.f));
    for (int r = gw; r < R; r += NGW) {
        float kr = bf2f(KR[(size_t)r * 64 + lane]);
        if (!is_ctx_row(r)) {
            int prow, pcol; rope_angles(r, prow, pcol);
            const float ang = (float)((lane & 32) ? pcol : prow) * invf;
            const float cs = cosf(ang), sn = sinf(ang);
            const float partner = __shfl_xor(kr, 16);
            kr = kr * cs + ((lane & 16) ? partner : -partner) * sn;
        }
        const bf16_t kb = (bf16_t)f2bf(kr);
#pragma unroll
        for (int h = 0; h < 8; ++h) Kb[(size_t)r * 1536 + h * 192 + 128 + lane] = kb;
    }
}
__device__ __forceinline__ float row16_sum(float v) { v += WDPP(v, 0xB1); v += WDPP(v, 0x4E); v += WDPP(v, 0x141); v += WDPP(v, 0x140); return v; }
__device__ __forceinline__ void p_gqa_rows(const Args& A, const Frame& F) {
    const int gw = F.bid * NWAVES + F.wave, NGW = F.nblk * NWAVES, lane = F.lane, c16 = lane & 15, hrow = lane >> 4;
    const bf16_t* RAW = (const bf16_t*)(F.ws + WS_RAW1); bf16_t* Q1 = (bf16_t*)(F.ws + WS_Q1); bf16_t* K1 = (bf16_t*)(F.ws + WS_K1); bf16_t* V1 = (bf16_t*)(F.ws + WS_V1);
    float qg[8], kg[8], invf[8];
#pragma unroll
    for (int e = 0; e < 8; ++e) { qg[e] = A.in[I1_QN][8 * c16 + e]; kg[e] = A.in[I1_KN][8 * c16 + e]; invf[e] = __powf(10000.f, -(float)(8 * (c16 & 3) + e) * (1.f / 32.f)); }
    const bool colaxis = (c16 & 8) != 0, hi32 = (c16 & 4) != 0;
    for (int r = gw; r < R; r += NGW) {
        const bool ctx = is_ctx_row(r);
        const bf16_t* a = RAW + (size_t)r * 1536 + 8 * lane;
        u32x4 ch[3];
#pragma unroll
        for (int j = 0; j < 3; ++j) ch[j] = (ctx && j < 2) ? (u32x4){0u, 0u, 0u, 0u} : *(const u32x4*)(a + 512 * j);
        float cs[8], sn[8];
        { int prow = 0, pcol = 0; if (!ctx) rope_angles(r, prow, pcol); const float pos = (float)(colaxis ? pcol : prow);
#pragma unroll
          for (int e = 0; e < 8; ++e) { const float ang = pos * invf[e]; cs[e] = ctx ? 1.f : __cosf(ang); sn[e] = ctx ? 0.f : __sinf(ang); } }
#pragma unroll
        for (int j = 0; j < 3; ++j) {
            if (ctx && j < 2) continue;
            const bool isv = (j == 2) && (hrow >= 2);
            float x[8];
#pragma unroll
            for (int d = 0; d < 4; ++d) { x[2 * d] = bflo(ch[j][d]); x[2 * d + 1] = bfhi(ch[j][d]); }
            float sq = 0.f;
#pragma unroll
            for (int e = 0; e < 8; ++e) sq += x[e] * x[e];
            const float rinv = rsqrtf(row16_sum(sq) * (1.f / 128.f) + EPS);
            u32x4 o;
            float y[8];
#pragma unroll
            for (int e = 0; e < 8; ++e) y[e] = x[e] * rinv * (j < 2 ? qg[e] : kg[e]);
            u32x4 yp; yp.x = pk2(y[0], y[1]); yp.y = pk2(y[2], y[3]); yp.z = pk2(y[4], y[5]); yp.w = pk2(y[6], y[7]);
            float pr[8];
#pragma unroll
            for (int d = 0; d < 4; ++d) { const float lo = __shfl_xor(y[2 * d], 4), hi2 = __shfl_xor(y[2 * d + 1], 4); pr[2 * d] = lo; pr[2 * d + 1] = hi2; }
            float z[8];
#pragma unroll
            for (int e = 0; e < 8; ++e) z[e] = y[e] * cs[e] + (hi32 ? pr[e] : -pr[e]) * sn[e];
            o.x = pk2(z[0], z[1]); o.y = pk2(z[2], z[3]); o.z = pk2(z[4], z[5]); o.w = pk2(z[6], z[7]);
            (void)yp;
            if (isv) o = ch[j];
            if (j < 2) *(u32x4*)(Q1 + (size_t)r * 1024 + 512 * j + 8 * lane) = o;
            else { bf16_t* dst = (hrow < 2) ? K1 + (size_t)r * 256 + 8 * lane : V1 + (size_t)r * 256 + 8 * (lane - 32); *(u32x4*)dst = o; }
        }
    }
}

__device__ __forceinline__ int crow(int r, int hi) { return (r & 3) + 8 * (r >> 2) + 4 * hi; }
__device__ __forceinline__ int v_st(int k, int c) { const int kk = (k & ~0xC) | ((k & 4) << 1) | ((k & 8) >> 1); return ((kk >> 3) * 4 + (c >> 5)) * 512 + ((kk & 7) * 32 + (c & 31)) * 2; }
__device__ __forceinline__ int v_rd_base(int lane) { return ((lane & 3) << 3) | (((lane >> 2) & 3) << 6) | (((lane >> 4) & 1) << 5) | (((lane >> 5) & 1) << 8); }
constexpr int v_rd_off(int d0, int ks, int half) { return d0 * 512 + ks * 4096 + half * 2048; }
template <int OFF> __device__ __forceinline__ s16x4 tr_read(int vb) { s16x4 r; asm volatile("ds_read_b64_tr_b16 %0, %1 offset:%2" : "=&v"(r) : "v"(vb), "i"(OFF) : "memory"); return r; }
template <int D0> __device__ __forceinline__ void pv_one(f32x16& od, int vb, bf16x8 pa0, bf16x8 pa1, bf16x8 pa2, bf16x8 pa3) {
    const s16x4 l0 = tr_read<v_rd_off(D0, 0, 0)>(vb), h0 = tr_read<v_rd_off(D0, 0, 1)>(vb), l1 = tr_read<v_rd_off(D0, 1, 0)>(vb), h1 = tr_read<v_rd_off(D0, 1, 1)>(vb);
    const s16x4 l2 = tr_read<v_rd_off(D0, 2, 0)>(vb), h2 = tr_read<v_rd_off(D0, 2, 1)>(vb), l3 = tr_read<v_rd_off(D0, 3, 0)>(vb), h3 = tr_read<v_rd_off(D0, 3, 1)>(vb);
    asm volatile("s_waitcnt lgkmcnt(0)" ::: "memory"); SBAR();
#define PK(L, H) (bf16x8){L[0], L[1], L[2], L[3], H[0], H[1], H[2], H[3]}
    od = __builtin_amdgcn_mfma_f32_32x32x16_bf16(pa0, PK(l0, h0), od, 0, 0, 0);
    od = __builtin_amdgcn_mfma_f32_32x32x16_bf16(pa1, PK(l1, h1), od, 0, 0, 0);
    od = __builtin_amdgcn_mfma_f32_32x32x16_bf16(pa2, PK(l2, h2), od, 0, 0, 0);
    od = __builtin_amdgcn_mfma_f32_32x32x16_bf16(pa3, PK(l3, h3), od, 0, 0, 0);
#undef PK
}
__device__ __forceinline__ void pv_d0(f32x16* o, int vb, bf16x8 pa0, bf16x8 pa1, bf16x8 pa2, bf16x8 pa3) {
    pv_one<0>(o[0], vb, pa0, pa1, pa2, pa3); pv_one<1>(o[1], vb, pa0, pa1, pa2, pa3); pv_one<2>(o[2], vb, pa0, pa1, pa2, pa3); pv_one<3>(o[3], vb, pa0, pa1, pa2, pa3);
}
constexpr float ATT_THR = 8.f;
__device__ __forceinline__ void partialSM(f32x16& p0, f32x16& p1, float& m_reg, float& mn, float& alpha, float C, float thr_raw) {
    float pmax = p0[0];
#pragma unroll
    for (int r = 1; r < 16; ++r) pmax = fmaxf(pmax, p0[r]);
#pragma unroll
    for (int r = 0; r < 16; ++r) pmax = fmaxf(pmax, p1[r]);
    { auto rr = __builtin_amdgcn_permlane32_swap(__float_as_uint(pmax), __float_as_uint(pmax), false, false);
      pmax = fmaxf(__uint_as_float(rr[0]), __uint_as_float(rr[1])); }
    if (__builtin_expect(__all(pmax - m_reg <= thr_raw), 1)) { mn = m_reg; alpha = 1.f; }
    else { mn = fmaxf(m_reg, pmax); alpha = __builtin_amdgcn_exp2f((m_reg - mn) * C); m_reg = mn; }
    const float mnC = -mn * C;
#pragma unroll
    for (int r = 0; r < 16; ++r) p0[r] = fmaf(p0[r], C, mnC);
#pragma unroll
    for (int r = 0; r < 16; ++r) p1[r] = fmaf(p1[r], C, mnC);
#pragma unroll
    for (int r = 0; r < 16; ++r) p0[r] = __builtin_amdgcn_exp2f(p0[r]);
}
__device__ __forceinline__ void finishSM(f32x16& p0, f32x16& p1, float alpha, float& l_reg, bf16x8& pa0, bf16x8& pa1, bf16x8& pa2, bf16x8& pa3) {
#pragma unroll
    for (int r = 0; r < 16; ++r) p1[r] = __builtin_amdgcn_exp2f(p1[r]);
    float ps = 0;
#pragma unroll
    for (int r = 0; r < 16; ++r) ps += p0[r];
#pragma unroll
    for (int r = 0; r < 16; ++r) ps += p1[r];
    { auto rr = __builtin_amdgcn_permlane32_swap(__float_as_uint(ps), __float_as_uint(ps), false, false);
      ps = __uint_as_float(rr[0]) + __uint_as_float(rr[1]); }
    l_reg = l_reg * alpha + ps;
#define PK4(P, BASE, OUT) do { unsigned a0 = cvtpk(P[BASE + 0], P[BASE + 1]), a1 = cvtpk(P[BASE + 2], P[BASE + 3]);   \
    unsigned b0 = cvtpk(P[BASE + 4], P[BASE + 5]), b1 = cvtpk(P[BASE + 6], P[BASE + 7]);                              \
    auto r0 = __builtin_amdgcn_permlane32_swap(a0, b0, false, false); auto r1 = __builtin_amdgcn_permlane32_swap(a1, b1, false, false); \
    u32x4 w = {r0[0], r1[0], r0[1], r1[1]}; OUT = *reinterpret_cast<bf16x8*>(&w); } while (0)
    PK4(p0, 0, pa0); PK4(p0, 8, pa1); PK4(p1, 0, pa2); PK4(p1, 8, pa3);
#undef PK4
}
template <int DQK> __device__ __forceinline__ void qkt(f32x16& p0, f32x16& p1, const char* Ks, const bf16x8* qr, int r32, int hi) {
    constexpr int KP = DQK * 2 + 16;
    p0 = f32x16{}; p1 = f32x16{};
#pragma unroll
    for (int d0 = 0; d0 < DQK / 16; ++d0) { const int cb = (d0 * 16 + hi * 8) * 2;
        const bf16x8 b0 = *reinterpret_cast<const bf16x8*>(Ks + r32 * KP + cb);
        const bf16x8 b1 = *reinterpret_cast<const bf16x8*>(Ks + (32 + r32) * KP + cb);
        p0 = __builtin_amdgcn_mfma_f32_32x32x16_bf16(b0, qr[d0], p0, 0, 0, 0);
        p1 = __builtin_amdgcn_mfma_f32_32x32x16_bf16(b1, qr[d0], p1, 0, 0, 0); }
}
template <int DQK> constexpr int att_lds_bytes() { return 2 * 64 * 128 * 2 + 2 * 64 * (DQK * 2 + 16) + NWAVES * 64 * 4; }
template <int DQK, int LDQ, int LDK, int LDV, int LDO>
__device__ __forceinline__ void attn_body(const bf16_t* __restrict__ Qb, const bf16_t* __restrict__ Kh, const bf16_t* __restrict__ Vh, bf16_t* __restrict__ Ob, int seq, float scale, char* lds) {
    constexpr int KP = DQK * 2 + 16, SHM_V = 64 * 128 * 2, SHM_K = 64 * KP, ND = DQK / 16, CH = DQK / 8, NKL = CH * 64 / NTHREADS;
    const float C = scale * 1.4426950408889634f, thr_raw = ATT_THR / scale;
    const int tid = threadIdx.x, wid = tid >> 6, lane = tid & 63, r32 = lane & 31, hi = lane >> 5;
    char* V_lds = lds; char* K_lds = lds + 2 * SHM_V;
    float* wsf = (float*)(lds + 2 * SHM_V + 2 * SHM_K) + wid * 64; float* li_l = wsf; float* al_l = wsf + 32;
    float m_reg = -1e30f, l_reg = 0; f32x16 o[4] = {}; bf16x8 qr[ND];
    const bf16_t* Qw = Qb + (long)(wid * 32 + r32) * LDQ + hi * 8;
#pragma unroll
    for (int d0 = 0; d0 < ND; ++d0) qr[d0] = *reinterpret_cast<const bf16x8*>(Qw + d0 * 16);
    const int sr = tid >> 4, sc = (tid & 15) * 8, vst0 = v_st(sr, sc), vst1 = v_st(32 + sr, sc);
    static_assert(DQK == 128, "double-pipelined body: 128-wide q.k only");
    const int vb0 = (int)(uintptr_t)V_lds + v_rd_base(lane);
    bf16x8 vs0, vs1, ks[NKL];
#define SLOAD(k0) do { vs0 = *reinterpret_cast<const bf16x8*>(&Vh[(long)((k0) + sr) * LDV + sc]); vs1 = *reinterpret_cast<const bf16x8*>(&Vh[(long)((k0) + 32 + sr) * LDV + sc]); \
    _Pragma("unroll") for (int i_ = 0; i_ < NKL; ++i_) ks[i_] = *reinterpret_cast<const bf16x8*>(&Kh[(long)((k0) + sr + 32 * i_) * LDK + sc]); } while (0)
#define SWRITE(b) do { *(bf16x8*)(V_lds + (b) * SHM_V + vst0) = vs0; *(bf16x8*)(V_lds + (b) * SHM_V + vst1) = vs1; \
    _Pragma("unroll") for (int i_ = 0; i_ < NKL; ++i_) *(bf16x8*)(K_lds + (b) * SHM_K + (sr + 32 * i_) * KP + sc * 2) = ks[i_]; } while (0)
#define RESC(a) do { if (__any((a) < 1.f)) { if (hi == 0) al_l[r32] = (a); asm volatile("s_waitcnt lgkmcnt(0)" ::: "memory"); \
    _Pragma("unroll") for (int d = 0; d < 4; ++d) _Pragma("unroll") for (int r = 0; r < 16; ++r) o[d][r] *= al_l[crow(r, hi)]; } } while (0)
    f32x16 pA0, pA1, pB0, pB1; float mnA, mnB, alA, alB; bf16x8 pa0, pa1, pa2, pa3; const int NT = seq / 64;
    SLOAD(0); asm volatile("s_waitcnt vmcnt(0)" ::: "memory"); SWRITE(0); __syncthreads();
    qkt<DQK>(pA0, pA1, K_lds, qr, r32, hi); partialSM(pA0, pA1, m_reg, mnA, alA, C, thr_raw);
    SLOAD(64);
    asm volatile("s_waitcnt vmcnt(0)" ::: "memory"); SWRITE(1); __syncthreads();
    for (int j = 1; j + 1 < NT; j += 2) {
        SBAR(); qkt<DQK>(pB0, pB1, K_lds + SHM_K, qr, r32, hi);
        finishSM(pA0, pA1, alA, l_reg, pa0, pa1, pa2, pa3); SBAR();
        SLOAD((j + 1) * 64); SBAR();
        pv_d0(o, vb0, pa0, pa1, pa2, pa3); partialSM(pB0, pB1, m_reg, mnB, alB, C, thr_raw);
        __syncthreads(); asm volatile("s_waitcnt vmcnt(0)" ::: "memory"); SWRITE(0);
        RESC(alB); __syncthreads();
        SBAR(); qkt<DQK>(pA0, pA1, K_lds, qr, r32, hi);
        finishSM(pB0, pB1, alB, l_reg, pa0, pa1, pa2, pa3); SBAR();
        SLOAD((j + 2) * 64); SBAR();
        pv_d0(o, vb0 + SHM_V, pa0, pa1, pa2, pa3); partialSM(pA0, pA1, m_reg, mnA, alA, C, thr_raw);
        __syncthreads(); asm volatile("s_waitcnt vmcnt(0)" ::: "memory"); SWRITE(1);
        RESC(alA); __syncthreads();
    }
    SBAR(); qkt<DQK>(pB0, pB1, K_lds + SHM_K, qr, r32, hi);
    finishSM(pA0, pA1, alA, l_reg, pa0, pa1, pa2, pa3); SBAR();
    pv_d0(o, vb0, pa0, pa1, pa2, pa3); partialSM(pB0, pB1, m_reg, mnB, alB, C, thr_raw);
    __syncthreads(); RESC(alB);
    finishSM(pB0, pB1, alB, l_reg, pa0, pa1, pa2, pa3); SBAR();
    pv_d0(o, vb0 + SHM_V, pa0, pa1, pa2, pa3);
    if (hi == 0) li_l[r32] = l_reg; asm volatile("s_waitcnt lgkmcnt(0)" ::: "memory");
    float rli[16];
#pragma unroll
    for (int r = 0; r < 16; ++r) rli[r] = __builtin_amdgcn_rcpf(li_l[crow(r, hi)]);
    bf16_t* Ow = Ob + (long)(wid * 32) * LDO;
#pragma unroll
    for (int r = 0; r < 16; ++r) { const int orow = crow(r, hi);
#pragma unroll
        for (int d0 = 0; d0 < 4; ++d0) Ow[(long)orow * LDO + d0 * 32 + r32] = (bf16_t)f2bf(o[d0][r] * rli[r]); }
    __syncthreads();
#undef SLOAD
#undef SWRITE
#undef RESC
}
template <int DQK, int LDQ, int LDK, int LDV, int LDO>
__device__ __forceinline__ void attn_body_single(const bf16_t* __restrict__ Qb, const bf16_t* __restrict__ Kh, const bf16_t* __restrict__ Vh, bf16_t* __restrict__ Ob, int seq, float scale, char* lds, int rope_t0) {
    constexpr int KP = DQK * 2 + 16, SHM_V = 64 * 128 * 2, SHM_K = 64 * KP, ND = DQK / 16, CH = DQK / 8, NKL = CH * 64 / NTHREADS;
    const float C = scale * 1.4426950408889634f, thr_raw = ATT_THR / scale;
    const int tid = threadIdx.x, wid = tid >> 6, lane = tid & 63, r32 = lane & 31, hi = lane >> 5;
    char* V_lds = lds; char* K_lds = lds + 2 * SHM_V;
    float* wsf = (float*)(lds + 2 * SHM_V + 2 * SHM_K) + wid * 64; float* li_l = wsf; float* al_l = wsf + 32;
    float m_reg = -1e30f, l_reg = 0; f32x16 o[4] = {}; bf16x8 qr[ND];
    const bf16_t* Qw = Qb + (long)(wid * 32 + r32) * LDQ + hi * 8;
#pragma unroll
    for (int d0 = 8; d0 < ND; ++d0) qr[d0] = *reinterpret_cast<const bf16x8*>(Qw + d0 * 16);
    if constexpr (DQK == 192) {
        if (rope_t0 >= 0) {
            const int tq = rope_t0 + wid * 32 + r32; const float prow = (float)(tq >> 6), pcol = (float)(tq & 63);
            u32x4 fa1 = __builtin_bit_cast(u32x4, qr[8]), fa2 = __builtin_bit_cast(u32x4, qr[9]), fb1 = __builtin_bit_cast(u32x4, qr[10]), fb2 = __builtin_bit_cast(u32x4, qr[11]);
#pragma unroll
            for (int jj = 0; jj < 4; ++jj) {
                float na1[2], na2[2], nb1[2], nb2[2];
#pragma unroll
                for (int e = 0; e < 2; ++e) { const float invf = __powf(10000.f, -(float)(hi * 8 + 2 * jj + e) * (1.f / 16.f));
                    const float ar = prow * invf, ac = pcol * invf, cr = __cosf(ar), sr_ = __sinf(ar), cc = __cosf(ac), sc_ = __sinf(ac);
                    const float a1 = e ? bfhi(fa1[jj]) : bflo(fa1[jj]), a2 = e ? bfhi(fa2[jj]) : bflo(fa2[jj]), b1 = e ? bfhi(fb1[jj]) : bflo(fb1[jj]), b2 = e ? bfhi(fb2[jj]) : bflo(fb2[jj]);
                    na1[e] = a1 * cr - a2 * sr_; na2[e] = a2 * cr + a1 * sr_; nb1[e] = b1 * cc - b2 * sc_; nb2[e] = b2 * cc + b1 * sc_; }
                fa1[jj] = pk2(na1[0], na1[1]); fa2[jj] = pk2(na2[0], na2[1]); fb1[jj] = pk2(nb1[0], nb1[1]); fb2[jj] = pk2(nb2[0], nb2[1]);
            }
            qr[8] = __builtin_bit_cast(bf16x8, fa1); qr[9] = __builtin_bit_cast(bf16x8, fa2); qr[10] = __builtin_bit_cast(bf16x8, fb1); qr[11] = __builtin_bit_cast(bf16x8, fb2);
        }
    }
    asm volatile("" ::: "memory");
#pragma unroll
    for (int d0 = 0; d0 < 8; ++d0) qr[d0] = *reinterpret_cast<const bf16x8*>(Qw + d0 * 16);
    const int sr = tid >> 4, sc = (tid & 15) * 8, vst0 = v_st(sr, sc), vst1 = v_st(32 + sr, sc);
    int krow[NKL], kch[NKL];
#pragma unroll
    for (int i = 0; i < NKL; ++i) { const int id = tid + i * NTHREADS; krow[i] = id / CH; kch[i] = id % CH; }
    const int vb0 = (int)(uintptr_t)V_lds + v_rd_base(lane);
    bf16x8 vs0, vs1, ks[NKL];
#define SLOAD(k0) do { vs0 = *reinterpret_cast<const bf16x8*>(&Vh[(long)((k0) + sr) * LDV + sc]); vs1 = *reinterpret_cast<const bf16x8*>(&Vh[(long)((k0) + 32 + sr) * LDV + sc]); \
    _Pragma("unroll") for (int i_ = 0; i_ < NKL; ++i_) ks[i_] = *reinterpret_cast<const bf16x8*>(&Kh[(long)((k0) + krow[i_]) * LDK + kch[i_] * 8]); } while (0)
#define SWRITE(b) do { *(bf16x8*)(V_lds + (b) * SHM_V + vst0) = vs0; *(bf16x8*)(V_lds + (b) * SHM_V + vst1) = vs1; \
    _Pragma("unroll") for (int i_ = 0; i_ < NKL; ++i_) *(bf16x8*)(K_lds + (b) * SHM_K + krow[i_] * KP + kch[i_] * 16) = ks[i_]; } while (0)
#define RESC(a) do { if (__any((a) < 1.f)) { if (hi == 0) al_l[r32] = (a); asm volatile("s_waitcnt lgkmcnt(0)" ::: "memory"); \
    _Pragma("unroll") for (int d = 0; d < 4; ++d) _Pragma("unroll") for (int r = 0; r < 16; ++r) o[d][r] *= al_l[crow(r, hi)]; } } while (0)
    f32x16 p0, p1; float mn, al; bf16x8 pa0, pa1, pa2, pa3; const int NT = seq / 64;
    SLOAD(0); asm volatile("s_waitcnt vmcnt(0)" ::: "memory"); SWRITE(0); __syncthreads();
    SLOAD(64);
    for (int j = 0; j < NT; ++j) {
        const int b = j & 1;
        SBAR(); qkt<DQK>(p0, p1, K_lds + b * SHM_K, qr, r32, hi);
        partialSM(p0, p1, m_reg, mn, al, C, thr_raw);
        RESC(al);
        finishSM(p0, p1, al, l_reg, pa0, pa1, pa2, pa3); SBAR();
        pv_d0(o, vb0 + b * SHM_V, pa0, pa1, pa2, pa3);
        if (j + 1 < NT) { asm volatile("s_waitcnt vmcnt(0)" ::: "memory"); SWRITE(b ^ 1); }
        __syncthreads();
        if (j + 2 < NT) SLOAD((j + 2) * 64);
    }
    if (hi == 0) li_l[r32] = l_reg; asm volatile("s_waitcnt lgkmcnt(0)" ::: "memory");
    float rli[16];
#pragma unroll
    for (int r = 0; r < 16; ++r) rli[r] = __builtin_amdgcn_rcpf(li_l[crow(r, hi)]);
    bf16_t* Ow = Ob + (long)(wid * 32) * LDO;
#pragma unroll
    for (int r = 0; r < 16; ++r) { const int orow = crow(r, hi);
#pragma unroll
        for (int d0 = 0; d0 < 4; ++d0) Ow[(long)orow * LDO + d0 * 32 + r32] = (bf16_t)f2bf(o[d0][r] * rli[r]); }
    __syncthreads();
#undef SLOAD
#undef SWRITE
#undef RESC
}
__device__ __forceinline__ void p_attn_mla(const Args& A, const Frame& F) {
    const bf16_t* Q = (const bf16_t*)(F.ws + WS_Q); const bf16_t* Kb = (const bf16_t*)(F.ws + WS_K); const bf16_t* Vb = (const bf16_t*)(F.ws + WS_V); bf16_t* O = (bf16_t*)(F.ws + WS_O);
    const float scale = 0.07216878364870322f;
    for (int u = F.vcu; u < 544; u += F.nblk) {
        int b, h, q0, seq;
        int rope_t0;
        if (u < 512) { const int qb = u & 15; h = (u >> 4) & 7; b = u >> 7; q0 = CTXL + qb * 256; seq = RPB; rope_t0 = qb * 256; }
        else { const int v = u - 512; h = v & 7; b = v >> 3; q0 = 0; seq = CTXL; rope_t0 = -1; }
        const size_t rb = (size_t)b * RPB;
        attn_body_single<192, 1536, 1536, 1024, 1024>(Q + (rb + q0) * 1536 + h * 192, Kb + rb * 1536 + h * 192, Vb + rb * 1024 + h * 128, O + (rb + q0) * 1024 + h * 128, seq, scale, F.lds, rope_t0);
    }
}
__device__ __forceinline__ void p_attn_gqa(const Args& A, const Frame& F) {
    const bf16_t* Q = (const bf16_t*)(F.ws + WS_Q1); const bf16_t* Kb = (const bf16_t*)(F.ws + WS_K1); const bf16_t* Vb = (const bf16_t*)(F.ws + WS_V1); bf16_t* O = (bf16_t*)(F.ws + WS_O);
    const float scale = 0.08838834764831845f;
    for (int u = F.vcu; u < 512; u += F.nblk) {
        const int qb = u & 15, h = (u >> 4) & 7, b = u >> 7, q0 = CTXL + qb * 256, kvh = h >> 2;
        const size_t rb = (size_t)b * RPB;
        attn_body<128, 1024, 256, 256, 1024>(Q + (rb + q0) * 1024 + h * 128, Kb + rb * 256 + kvh * 128, Vb + rb * 256 + kvh * 128, O + (rb + q0) * 1024 + h * 128, RPB, scale, F.lds);
    }
}

#define DPP_XOR1 0xB1
#define DPP_XOR2 0x4E
#define DPP_HMIRROR 0x141
#define DPP_MIRROR 0x140
__device__ __forceinline__ int row_max_i(int v) {
    v = max(v, __builtin_amdgcn_update_dpp(v, v, DPP_XOR1, 0xf, 0xf, false));
    v = max(v, __builtin_amdgcn_update_dpp(v, v, DPP_XOR2, 0xf, 0xf, false));
    v = max(v, __builtin_amdgcn_update_dpp(v, v, DPP_HMIRROR, 0xf, 0xf, false));
    v = max(v, __builtin_amdgcn_update_dpp(v, v, DPP_MIRROR, 0xf, 0xf, false));
    return v;
}
__device__ __forceinline__ float row_sum_f(float v) {
    v += __builtin_bit_cast(float, __builtin_amdgcn_update_dpp(0, __builtin_bit_cast(int, v), DPP_XOR1, 0xf, 0xf, false));
    v += __builtin_bit_cast(float, __builtin_amdgcn_update_dpp(0, __builtin_bit_cast(int, v), DPP_XOR2, 0xf, 0xf, false));
    v += __builtin_bit_cast(float, __builtin_amdgcn_update_dpp(0, __builtin_bit_cast(int, v), DPP_HMIRROR, 0xf, 0xf, false));
    v += __builtin_bit_cast(float, __builtin_amdgcn_update_dpp(0, __builtin_bit_cast(int, v), DPP_MIRROR, 0xf, 0xf, false));
    return v;
}
__device__ __forceinline__ int fkey(float f) { const int b = __builtin_bit_cast(int, f); return b ^ ((b >> 31) & 0x7fffffff); }
__device__ __forceinline__ float keyf(int k) { return __builtin_bit_cast(float, k ^ ((k >> 31) & 0x7fffffff)); }
__device__ __forceinline__ void cand_ij(int t, int& i, int& j) {
    const int g16 = t >= 16, g24 = t >= 24, g29 = t >= 29, g33 = t >= 33, g36 = t >= 36, g38 = t >= 38, g40 = t >= 40;
    i = g16 + g24 + g29 + g33 + g36 + g38 + g40 + max(t - 41, 0);
    const int base = 16 * g16 + 8 * g24 + 5 * g29 + 4 * g33 + 3 * g36 + 2 * g38 + 2 * g40;
    j = (t >= 42) ? 0 : t - base;
    if (t >= 50) { i = 0; j = 0; }
}
__device__ __forceinline__ void row_max2(int& a, int& b) {
    asm volatile("s_nop 1\n\t"
                 "v_max_i32_dpp %0, %0, %0 quad_perm:[1,0,3,2] row_mask:0xf bank_mask:0xf\n\tv_max_i32_dpp %1, %1, %1 quad_perm:[1,0,3,2] row_mask:0xf bank_mask:0xf\n\ts_nop 0\n\t"
                 "v_max_i32_dpp %0, %0, %0 quad_perm:[2,3,0,1] row_mask:0xf bank_mask:0xf\n\tv_max_i32_dpp %1, %1, %1 quad_perm:[2,3,0,1] row_mask:0xf bank_mask:0xf\n\ts_nop 0\n\t"
                 "v_max_i32_dpp %0, %0, %0 row_half_mirror row_mask:0xf bank_mask:0xf\n\tv_max_i32_dpp %1, %1, %1 row_half_mirror row_mask:0xf bank_mask:0xf\n\ts_nop 0\n\t"
                 "v_max_i32_dpp %0, %0, %0 row_mirror row_mask:0xf bank_mask:0xf\n\tv_max_i32_dpp %1, %1, %1 row_mirror row_mask:0xf bank_mask:0xf\n\ts_nop 1"
                 : "+v"(a), "+v"(b));
}
__device__ __forceinline__ void row_max1(int& a) {
    asm volatile("s_nop 1\n\t"
                 "v_max_i32_dpp %0, %0, %0 quad_perm:[1,0,3,2] row_mask:0xf bank_mask:0xf\n\ts_nop 1\n\t"
                 "v_max_i32_dpp %0, %0, %0 quad_perm:[2,3,0,1] row_mask:0xf bank_mask:0xf\n\ts_nop 1\n\t"
                 "v_max_i32_dpp %0, %0, %0 row_half_mirror row_mask:0xf bank_mask:0xf\n\ts_nop 1\n\t"
                 "v_max_i32_dpp %0, %0, %0 row_mirror row_mask:0xf bank_mask:0xf\n\ts_nop 1"
                 : "+v"(a));
}
__device__ __forceinline__ void row_max4(int& a, int& b, int& c, int& d) {
    asm volatile("s_nop 1\n\t"
                 "v_max_i32_dpp %0, %0, %0 quad_perm:[1,0,3,2] row_mask:0xf bank_mask:0xf\n\tv_max_i32_dpp %1, %1, %1 quad_perm:[1,0,3,2] row_mask:0xf bank_mask:0xf\n\t"
                 "v_max_i32_dpp %2, %2, %2 quad_perm:[1,0,3,2] row_mask:0xf bank_mask:0xf\n\tv_max_i32_dpp %3, %3, %3 quad_perm:[1,0,3,2] row_mask:0xf bank_mask:0xf\n\t"
                 "v_max_i32_dpp %0, %0, %0 quad_perm:[2,3,0,1] row_mask:0xf bank_mask:0xf\n\tv_max_i32_dpp %1, %1, %1 quad_perm:[2,3,0,1] row_mask:0xf bank_mask:0xf\n\t"
                 "v_max_i32_dpp %2, %2, %2 quad_perm:[2,3,0,1] row_mask:0xf bank_mask:0xf\n\tv_max_i32_dpp %3, %3, %3 quad_perm:[2,3,0,1] row_mask:0xf bank_mask:0xf\n\t"
                 "v_max_i32_dpp %0, %0, %0 row_half_mirror row_mask:0xf bank_mask:0xf\n\tv_max_i32_dpp %1, %1, %1 row_half_mirror row_mask:0xf bank_mask:0xf\n\t"
                 "v_max_i32_dpp %2, %2, %2 row_half_mirror row_mask:0xf bank_mask:0xf\n\tv_max_i32_dpp %3, %3, %3 row_half_mirror row_mask:0xf bank_mask:0xf\n\t"
                 "v_max_i32_dpp %0, %0, %0 row_mirror row_mask:0xf bank_mask:0xf\n\tv_max_i32_dpp %1, %1, %1 row_mirror row_mask:0xf bank_mask:0xf\n\t"
                 "v_max_i32_dpp %2, %2, %2 row_mirror row_mask:0xf bank_mask:0xf\n\tv_max_i32_dpp %3, %3, %3 row_mirror row_mask:0xf bank_mask:0xf\n\ts_nop 1"
                 : "+v"(a), "+v"(b), "+v"(c), "+v"(d));
}
#define CE_DESC(x, y) do { const int hi_ = max(x, y), lo_ = min(x, y); x = hi_; y = lo_; } while (0)
#define SORT8_DESC(k) do { CE_DESC(k[0], k[2]); CE_DESC(k[1], k[3]); CE_DESC(k[4], k[6]); CE_DESC(k[5], k[7]); CE_DESC(k[0], k[4]); CE_DESC(k[1], k[5]); CE_DESC(k[2], k[6]); CE_DESC(k[3], k[7]); \
    CE_DESC(k[0], k[1]); CE_DESC(k[2], k[3]); CE_DESC(k[4], k[5]); CE_DESC(k[6], k[7]); CE_DESC(k[2], k[4]); CE_DESC(k[3], k[5]); CE_DESC(k[1], k[4]); CE_DESC(k[3], k[6]); CE_DESC(k[1], k[2]); CE_DESC(k[3], k[4]); CE_DESC(k[5], k[6]); } while (0)
#define SORT16_DESC(K) do { CE_DESC(K[0], K[1]); CE_DESC(K[2], K[3]); CE_DESC(K[0], K[2]); CE_DESC(K[1], K[3]); CE_DESC(K[1], K[2]); CE_DESC(K[4], K[5]); CE_DESC(K[6], K[7]); CE_DESC(K[4], K[6]); CE_DESC(K[5], K[7]); CE_DESC(K[5], K[6]); CE_DESC(K[0], K[4]); CE_DESC(K[2], K[6]); CE_DESC(K[2], K[4]); CE_DESC(K[1], K[5]); CE_DESC(K[3], K[7]); CE_DESC(K[3], K[5]); CE_DESC(K[1], K[2]); CE_DESC(K[3], K[4]); CE_DESC(K[5], K[6]); CE_DESC(K[8], K[9]); CE_DESC(K[10], K[11]); CE_DESC(K[8], K[10]); CE_DESC(K[9], K[11]); CE_DESC(K[9], K[10]); CE_DESC(K[12], K[13]); CE_DESC(K[14], K[15]); CE_DESC(K[12], K[14]); CE_DESC(K[13], K[15]); CE_DESC(K[13], K[14]); CE_DESC(K[8], K[12]); CE_DESC(K[10], K[14]); CE_DESC(K[10], K[12]); CE_DESC(K[9], K[13]); CE_DESC(K[11], K[15]); CE_DESC(K[11], K[13]); CE_DESC(K[9], K[10]); CE_DESC(K[11], K[12]); CE_DESC(K[13], K[14]); CE_DESC(K[0], K[8]); CE_DESC(K[4], K[12]); CE_DESC(K[4], K[8]); CE_DESC(K[2], K[10]); CE_DESC(K[6], K[14]); CE_DESC(K[6], K[10]); CE_DESC(K[2], K[4]); CE_DESC(K[6], K[8]); CE_DESC(K[10], K[12]); CE_DESC(K[1], K[9]); CE_DESC(K[5], K[13]); CE_DESC(K[5], K[9]); CE_DESC(K[3], K[11]); CE_DESC(K[7], K[15]); CE_DESC(K[7], K[11]); CE_DESC(K[3], K[5]); CE_DESC(K[7], K[9]); CE_DESC(K[11], K[13]); CE_DESC(K[1], K[2]); CE_DESC(K[3], K[4]); CE_DESC(K[5], K[6]); CE_DESC(K[7], K[8]); CE_DESC(K[9], K[10]); CE_DESC(K[11], K[12]); CE_DESC(K[13], K[14]); } while (0)
#define MERGE16_DESC(T, K) do { _Pragma("unroll") for (int i_ = 0; i_ < 16; ++i_) T[i_] = max(T[i_], K[15 - i_]); CE_DESC(T[0], T[8]); CE_DESC(T[1], T[9]); CE_DESC(T[2], T[10]); CE_DESC(T[3], T[11]); CE_DESC(T[4], T[12]); CE_DESC(T[5], T[13]); CE_DESC(T[6], T[14]); CE_DESC(T[7], T[15]); CE_DESC(T[0], T[4]); CE_DESC(T[1], T[5]); CE_DESC(T[2], T[6]); CE_DESC(T[3], T[7]); CE_DESC(T[8], T[12]); CE_DESC(T[9], T[13]); CE_DESC(T[10], T[14]); CE_DESC(T[11], T[15]); CE_DESC(T[0], T[2]); CE_DESC(T[1], T[3]); CE_DESC(T[4], T[6]); CE_DESC(T[5], T[7]); CE_DESC(T[8], T[10]); CE_DESC(T[9], T[11]); CE_DESC(T[12], T[14]); CE_DESC(T[13], T[15]); CE_DESC(T[0], T[1]); CE_DESC(T[2], T[3]); CE_DESC(T[4], T[5]); CE_DESC(T[6], T[7]); CE_DESC(T[8], T[9]); CE_DESC(T[10], T[11]); CE_DESC(T[12], T[13]); CE_DESC(T[14], T[15]); } while (0)
__device__ __forceinline__ int hkey_hi(unsigned w) { const int x = (int)(w & 0xffff0000u); return x ^ ((x >> 31) & 0x7fff0000); }
__device__ __forceinline__ float hkey_val(int k) { const int y = k & (int)0xffff0000; const unsigned b = (unsigned)(y ^ ((y >> 31) & 0x7fff0000)); return (float)__builtin_bit_cast(_Float16, (unsigned short)(b >> 16)); }
__device__ __forceinline__ int cnd(int a, int b, unsigned long long m) { int r; asm("v_cndmask_b32_e64 %0, %1, %2, %3" : "=v"(r) : "v"(a), "v"(b), "s"(m)); return r; }
__device__ __forceinline__ unsigned long long bitmask(int v, int bit) { unsigned long long m; asm("v_cmp_ne_u32_e64 %0, 0, %1\n\ts_nop 1" : "=s"(m) : "v"(v & bit)); return m; }
__device__ __forceinline__ int sel16(const int (&a)[16], int i) {
    const unsigned long long m0 = bitmask(i, 1), m1 = bitmask(i, 2), m2 = bitmask(i, 4), m3 = bitmask(i, 8);
    int l1[8], l2[4], l3[2];
#pragma unroll
    for (int m = 0; m < 8; ++m) l1[m] = cnd(a[2 * m], a[2 * m + 1], m0);
#pragma unroll
    for (int m = 0; m < 4; ++m) l2[m] = cnd(l1[2 * m], l1[2 * m + 1], m1);
#pragma unroll
    for (int m = 0; m < 2; ++m) l3[m] = cnd(l2[2 * m], l2[2 * m + 1], m2);
    return cnd(l3[0], l3[1], m3);
}
__device__ __forceinline__ void p_peer_topk(const Args& A, const Frame& F, bool skip_ctx) {
    const int gw = F.bid * NWAVES + F.wave, NGW = F.nblk * NWAVES, lane = F.lane;
    const unsigned short* S = (const unsigned short*)(F.ws + WS_S); unsigned* PK = (unsigned*)(F.ws + WS_PK);
    const int KMIN = (int)0x80000000;
    const int nitem = (skip_ctx ? NB * SEQ : R) * 8;
    for (int base = gw * 64; base < nitem; base += NGW * 64) {
        const int item = base + lane, n = item >> 3, h = item & 7, r = skip_ctx ? tok_row(1, n) : n;
        const unsigned short* sp = S + (size_t)r * 2048 + h * 256;
        int t1[16], t2[16];
#pragma unroll
        for (int list = 0; list < 2; ++list) {
            int T[16];
#pragma unroll
            for (int i = 0; i < 16; ++i) T[i] = KMIN;
            const unsigned short* lp = sp + 128 * list;
            u32x4 ra = *(const u32x4*)lp, rb = *(const u32x4*)(lp + 8);
#pragma unroll 1
            for (int c = 0; c < 8; ++c) {
                const int cn = c < 7 ? c + 1 : 7;
                const u32x4 na = *(const u32x4*)(lp + 16 * cn), nb = *(const u32x4*)(lp + 16 * cn + 8);
                const int pb = 127 - 16 * c;
                int K[16];
#pragma unroll
                for (int d = 0; d < 4; ++d) { K[2 * d] = hkey_hi(ra[d] << 16) | (pb - 2 * d); K[2 * d + 1] = hkey_hi(ra[d]) | (pb - 2 * d - 1);
                    K[8 + 2 * d] = hkey_hi(rb[d] << 16) | (pb - 8 - 2 * d); K[8 + 2 * d + 1] = hkey_hi(rb[d]) | (pb - 9 - 2 * d); }
                SORT16_DESC(K);
                MERGE16_DESC(T, K);
                ra = na; rb = nb;
            }
#pragma unroll
            for (int i = 0; i < 16; ++i) { if (list == 0) t1[i] = T[i]; else t2[i] = T[i]; }
        }
        float f1[16], f2[16];
#pragma unroll
        for (int i = 0; i < 16; ++i) { f1[i] = hkey_val(t1[i]); f2[i] = hkey_val(t2[i]); }
        int CA[16], CB[16], CC[16], CD[16];
        CA[0] = (fkey(f1[0] + f2[0]) & ~63) | 63; CA[1] = (fkey(f1[0] + f2[1]) & ~63) | 62; CA[2] = (fkey(f1[0] + f2[2]) & ~63) | 61; CA[3] = (fkey(f1[0] + f2[3]) & ~63) | 60; CA[4] = (fkey(f1[0] + f2[4]) & ~63) | 59; CA[5] = (fkey(f1[0] + f2[5]) & ~63) | 58; CA[6] = (fkey(f1[0] + f2[6]) & ~63) | 57; CA[7] = (fkey(f1[0] + f2[7]) & ~63) | 56; CA[8] = (fkey(f1[0] + f2[8]) & ~63) | 55; CA[9] = (fkey(f1[0] + f2[9]) & ~63) | 54; CA[10] = (fkey(f1[0] + f2[10]) & ~63) | 53; CA[11] = (fkey(f1[0] + f2[11]) & ~63) | 52; CA[12] = (fkey(f1[0] + f2[12]) & ~63) | 51; CA[13] = (fkey(f1[0] + f2[13]) & ~63) | 50; CA[14] = (fkey(f1[0] + f2[14]) & ~63) | 49; CA[15] = (fkey(f1[0] + f2[15]) & ~63) | 48; CB[0] = (fkey(f1[1] + f2[0]) & ~63) | 47; CB[1] = (fkey(f1[1] + f2[1]) & ~63) | 46; CB[2] = (fkey(f1[1] + f2[2]) & ~63) | 45; CB[3] = (fkey(f1[1] + f2[3]) & ~63) | 44; CB[4] = (fkey(f1[1] + f2[4]) & ~63) | 43; CB[5] = (fkey(f1[1] + f2[5]) & ~63) | 42; CB[6] = (fkey(f1[1] + f2[6]) & ~63) | 41; CB[7] = (fkey(f1[1] + f2[7]) & ~63) | 40; CB[8] = (fkey(f1[2] + f2[0]) & ~63) | 39; CB[9] = (fkey(f1[2] + f2[1]) & ~63) | 38; CB[10] = (fkey(f1[2] + f2[2]) & ~63) | 37; CB[11] = (fkey(f1[2] + f2[3]) & ~63) | 36; CB[12] = (fkey(f1[2] + f2[4]) & ~63) | 35; CB[13] = (fkey(f1[3] + f2[0]) & ~63) | 34; CB[14] = (fkey(f1[3] + f2[1]) & ~63) | 33; CB[15] = (fkey(f1[3] + f2[2]) & ~63) | 32; CC[0] = (fkey(f1[3] + f2[3]) & ~63) | 31; CC[1] = (fkey(f1[4] + f2[0]) & ~63) | 30; CC[2] = (fkey(f1[4] + f2[1]) & ~63) | 29; CC[3] = (fkey(f1[4] + f2[2]) & ~63) | 28; CC[4] = (fkey(f1[5] + f2[0]) & ~63) | 27; CC[5] = (fkey(f1[5] + f2[1]) & ~63) | 26; CC[6] = (fkey(f1[6] + f2[0]) & ~63) | 25; CC[7] = (fkey(f1[6] + f2[1]) & ~63) | 24; CC[8] = (fkey(f1[7] + f2[0]) & ~63) | 23; CC[9] = (fkey(f1[7] + f2[1]) & ~63) | 22; CC[10] = (fkey(f1[8] + f2[0]) & ~63) | 21; CC[11] = (fkey(f1[9] + f2[0]) & ~63) | 20; CC[12] = (fkey(f1[10] + f2[0]) & ~63) | 19; CC[13] = (fkey(f1[11] + f2[0]) & ~63) | 18; CC[14] = (fkey(f1[12] + f2[0]) & ~63) | 17; CC[15] = (fkey(f1[13] + f2[0]) & ~63) | 16; CD[0] = (fkey(f1[14] + f2[0]) & ~63) | 15; CD[1] = (fkey(f1[15] + f2[0]) & ~63) | 14; CD[2] = KMIN; CD[3] = KMIN; CD[4] = KMIN; CD[5] = KMIN; CD[6] = KMIN; CD[7] = KMIN; CD[8] = KMIN; CD[9] = KMIN; CD[10] = KMIN; CD[11] = KMIN; CD[12] = KMIN; CD[13] = KMIN; CD[14] = KMIN; CD[15] = KMIN;
        SORT16_DESC(CB); SORT16_DESC(CC); CE_DESC(CD[0], CD[1]);
        MERGE16_DESC(CA, CB); MERGE16_DESC(CA, CC); MERGE16_DESC(CA, CD);
        const float mx = keyf((CA[0] & ~63) | 32);
        float ex[16], sum = 0.f; unsigned te[16];
#pragma unroll
        for (int k = 0; k < 16; ++k) { int wi, wj; cand_ij(63 - (CA[k] & 63), wi, wj);
            const int wa = sel16(t1, wi), wb = sel16(t2, wj);
            te[k] = (unsigned)((127 - (wa & 127)) * 128 + (127 - (wb & 127)));
            ex[k] = __expf(keyf((CA[k] & ~63) | 32) - mx); sum += ex[k]; }
        const float rs = 65535.f / sum;
        u32x4* dst = (u32x4*)(PK + (size_t)r * 128 + h * 16);
#pragma unroll
        for (int q = 0; q < 4; ++q) { u32x4 o;
#pragma unroll
            for (int d = 0; d < 4; ++d) o[d] = (te[4 * q + d] << 16) | (unsigned)(ex[4 * q + d] * rs + 0.5f);
            dst[q] = o; }
    }
}

#define UB(w, b) ((float)(((w) >> (8 * (b))) & 0xffu))
__device__ __forceinline__ void p_peer_experts(const Args& A, const Frame& F, int layer) {
    const int gw = F.bid * NWAVES + F.wave, NGW = F.nblk * NWAVES, lane = F.lane;
    const bf16_t* H = (const bf16_t*)(F.ws + WS_H); float* X = (float*)(F.ws + WS_X);
    const unsigned* PK = (const unsigned*)(F.ws + WS_PK);
    const unsigned char* UT = F.ws + WS_TAB + (size_t)(layer * 2) * 16384 * 1024; const unsigned char* VT = UT + (size_t)16384 * 1024;
    const float* SU = (const float*)(F.ws + WS_TSC) + (layer * 2) * 16384; const float* SV = SU + 16384;
    const float* MOD = (const float*)(F.ws + WS_MOD) + (size_t)layer * 5 * 6144;
    for (int r = gw; r < R; r += NGW) {
        if (layer == 1 && is_ctx_row(r)) continue;
        float hf[16];
        { const u32x4 w0 = *(const u32x4*)(H + (size_t)r * DM + 16 * lane), w1 = *(const u32x4*)(H + (size_t)r * DM + 16 * lane + 8);
#pragma unroll
          for (int d = 0; d < 4; ++d) { hf[2 * d] = bflo(w0[d]); hf[2 * d + 1] = bfhi(w0[d]); hf[8 + 2 * d] = bflo(w1[d]); hf[8 + 2 * d + 1] = bfhi(w1[d]); } }
        float hs = 0.f;
#pragma unroll
        for (int i = 0; i < 16; ++i) hs += hf[i];
        hs = wave_sum(hs);
        int v0 = (int)PK[(size_t)r * 128 + lane], v1 = (int)PK[(size_t)r * 128 + 64 + lane];
#pragma unroll
        for (int k = 2; k <= 128; k <<= 1) {
#pragma unroll
            for (int j = k >> 1; j >= 1; j >>= 1) {
                if (j == 64) { const int a = min(v0, v1), b = max(v0, v1); v0 = a; v1 = b; }
                else { const int o0 = __shfl_xor(v0, j), o1 = __shfl_xor(v1, j); const bool lower = (lane & j) == 0;
                    const bool asc0 = (k == 128) ? true : (k == 64) ? true : ((lane & k) == 0), asc1 = (k == 128) ? true : (k == 64) ? false : ((lane & k) == 0);
                    v0 = (lower == asc0) ? min(v0, o0) : max(v0, o0); v1 = (lower == asc1) ? min(v1, o1) : max(v1, o1); }
            }
        }
        const unsigned pk0 = (unsigned)v0, pk1 = (unsigned)v1;
        const int e0 = (int)(pk0 >> 16), e1 = (int)(pk1 >> 16);
        const float g0 = (float)(pk0 & 0xffffu) * (1.f / 65535.f), g1 = (float)(pk1 & 0xffffu) * (1.f / 65535.f);
        const float su0 = SU[e0], su1 = SU[e1], sv0 = SV[e0], sv1 = SV[e1];
        float d0 = 0.f, d1 = 0.f;
        const int dep_src = (8 * (lane & 7)) << 2; const bool bit3 = (lane & 8) != 0;
#define XISSUE(buf, TAB, esrc, gg) do { _Pragma("unroll") for (int q_ = 0; q_ < 8; ++q_) { const int e_ = __builtin_amdgcn_readlane(esrc, (gg) * 8 + q_); \
            buf[q_] = *(const u32x4*)((TAB) + (size_t)e_ * 1024 + 16 * lane); } } while (0)
#define UCOMP(buf, gg, dsel) do { float p_[8]; _Pragma("unroll") for (int q_ = 0; q_ < 8; ++q_) { float d_ = 0.f; \
            _Pragma("unroll") for (int j_ = 0; j_ < 4; ++j_) d_ += (hf[4 * j_] * UB(buf[q_][j_], 0) + hf[4 * j_ + 1] * UB(buf[q_][j_], 1)) + (hf[4 * j_ + 2] * UB(buf[q_][j_], 2) + hf[4 * j_ + 3] * UB(buf[q_][j_], 3)); p_[q_] = d_; } \
            float s_[4]; _Pragma("unroll") for (int q_ = 0; q_ < 4; ++q_) { auto rr_ = __builtin_amdgcn_permlane32_swap(__float_as_uint(p_[q_]), __float_as_uint(p_[q_ + 4]), false, false); s_[q_] = __uint_as_float(rr_[0]) + __uint_as_float(rr_[1]); } \
            float t_[2]; _Pragma("unroll") for (int q_ = 0; q_ < 2; ++q_) { auto rr_ = __builtin_amdgcn_permlane16_swap(__float_as_uint(s_[q_]), __float_as_uint(s_[q_ + 2]), false, false); t_[q_] = __uint_as_float(rr_[0]) + __uint_as_float(rr_[1]); } \
            const float keep_ = bit3 ? t_[1] : t_[0], send_ = bit3 ? t_[0] : t_[1]; \
            float u_ = keep_ + __builtin_bit_cast(float, __builtin_amdgcn_update_dpp(0, __builtin_bit_cast(int, send_), 0x128, 0xf, 0xf, false)); \
            u_ += __builtin_bit_cast(float, __builtin_amdgcn_update_dpp(0, __builtin_bit_cast(int, u_), DPP_HMIRROR, 0xf, 0xf, false)); \
            u_ += __builtin_bit_cast(float, __builtin_amdgcn_update_dpp(0, __builtin_bit_cast(int, u_), DPP_XOR1, 0xf, 0xf, false)); \
            u_ += __builtin_bit_cast(float, __builtin_amdgcn_update_dpp(0, __builtin_bit_cast(int, u_), DPP_XOR2, 0xf, 0xf, false)); \
            const float v_ = __builtin_bit_cast(float, __builtin_amdgcn_ds_bpermute(dep_src, __builtin_bit_cast(int, u_))); \
            if ((lane >> 3) == (gg)) dsel = v_; } while (0)
        {
            u32x4 ua[8], ub[8];
            XISSUE(ua, UT, e0, 0);
#pragma unroll 1
            for (int g = 0; g < 8; g += 2) { XISSUE(ub, UT, e0, g + 1); UCOMP(ua, g, d0); if (g + 2 < 8) XISSUE(ua, UT, e0, g + 2); else XISSUE(ua, UT, e1, 0); UCOMP(ub, g + 1, d0); }
#pragma unroll 1
            for (int g = 0; g < 8; g += 2) { XISSUE(ub, UT, e1, g + 1); UCOMP(ua, g, d1); if (g + 2 < 8) XISSUE(ua, UT, e1, g + 2); UCOMP(ub, g + 1, d1); }
        }
        const float a0 = su0 * (d0 - 128.f * hs), a1 = su1 * (d1 - 128.f * hs);
        const float w0 = g0 * 0.5f * a0 * (1.f + erff(a0 * 0.70710678118654752f)) * sv0, w1 = g1 * 0.5f * a1 * (1.f + erff(a1 * 0.70710678118654752f)) * sv1;
        const float wsum = wave_sum(w0 + w1) * 128.f;
        float acc[16];
#pragma unroll
        for (int i = 0; i < 16; ++i) acc[i] = 0.f;
#define VCOMP(buf, wsrc, gg) do { _Pragma("unroll") for (int q_ = 0; q_ < 8; ++q_) { const float wk_ = __builtin_bit_cast(float, __builtin_amdgcn_readlane(__builtin_bit_cast(int, wsrc), (gg) * 8 + q_)); \
            _Pragma("unroll") for (int j_ = 0; j_ < 4; ++j_) { acc[4 * j_] += wk_ * UB(buf[q_][j_], 0); acc[4 * j_ + 1] += wk_ * UB(buf[q_][j_], 1); acc[4 * j_ + 2] += wk_ * UB(buf[q_][j_], 2); acc[4 * j_ + 3] += wk_ * UB(buf[q_][j_], 3); } } } while (0)
        {
            u32x4 va[8], vb[8];
            XISSUE(va, VT, e0, 0);
#pragma unroll 1
            for (int g = 0; g < 8; g += 2) { XISSUE(vb, VT, e0, g + 1); VCOMP(va, w0, g); if (g + 2 < 8) XISSUE(va, VT, e0, g + 2); else XISSUE(va, VT, e1, 0); VCOMP(vb, w0, g + 1); }
#pragma unroll 1
            for (int g = 0; g < 8; g += 2) { XISSUE(vb, VT, e1, g + 1); VCOMP(va, w1, g); if (g + 2 < 8) XISSUE(va, VT, e1, g + 2); VCOMP(vb, w1, g + 1); }
        }
#undef XISSUE
#undef UCOMP
#undef VCOMP
        const float* mm = MOD + (size_t)mod_index(r) * 6144;
        f32x4 xn[4]; float s = 0.f;
#pragma unroll
        for (int j = 0; j < 4; ++j) { const int c = 16 * lane + 4 * j; const float* xp = X + (size_t)r * DM + c; const f32x4 gf = *(const f32x4*)(mm + 5 * 1024 + c);
            xn[j] = *(const f32x4*)xp + gf * (f32x4){acc[4 * j] - wsum, acc[4 * j + 1] - wsum, acc[4 * j + 2] - wsum, acc[4 * j + 3] - wsum};
            s += (xn[j].x * xn[j].x + xn[j].y * xn[j].y) + (xn[j].z * xn[j].z + xn[j].w * xn[j].w); }
        const float rinv = rsqrtf(wave_sum(s) * (1.f / DM) + EPS);
        if (layer == 0) {
            const float* m1 = (const float*)(F.ws + WS_MOD) + (size_t)(5 + mod_index(r)) * 6144;
            const float* gn = A.in[I1_NMIX];
#pragma unroll
            for (int j = 0; j < 4; ++j) { const int c = 16 * lane + 4 * j; *(f32x4*)(X + (size_t)r * DM + c) = xn[j];
                const f32x4 y = (xn[j] * rinv * *(const f32x4*)(gn + c)) * (*(const f32x4*)(m1 + 1024 + c) + 1.f) + *(const f32x4*)(m1 + c);
                u32x2 o; o.x = pk2(y.x, y.y); o.y = pk2(y.z, y.w); *(u32x2*)((bf16_t*)(F.ws + WS_H) + (size_t)r * DM + c) = o; }
        } else {
            const int b = r / RPB, t = (r - b * RPB) - CTXL; float* op = F.out + ((size_t)b * SEQ + t) * DM; const float* gn = A.in[I_NOUT];
#pragma unroll
            for (int j = 0; j < 4; ++j) { const int c = 16 * lane + 4 * j; *(f32x4*)(op + c) = xn[j] * rinv * *(const f32x4*)(gn + c); }
        }
    }
}

__device__ __forceinline__ int tok_row(int layer, int n) { return layer == 0 ? n : (n >> 12) * RPB + CTXL + (n & 4095); }
#define DPPF(v, ctrl) __builtin_bit_cast(float, __builtin_amdgcn_update_dpp(0, __builtin_bit_cast(int, v), ctrl, 0xf, 0xf, false))
__device__ __forceinline__ int isum8(int v) {
    v += __builtin_amdgcn_update_dpp(0, v, DPP_XOR1, 0xf, 0xf, false); v += __builtin_amdgcn_update_dpp(0, v, DPP_XOR2, 0xf, 0xf, false); v += __builtin_amdgcn_update_dpp(0, v, DPP_HMIRROR, 0xf, 0xf, false); return v; }
__device__ __forceinline__ void p_exp_u(const Args& A, const Frame& F, int layer) {
    const int lane = F.lane, s = lane >> 3, c8 = lane & 7;
    const bool part = (F.nblk & 7) == 0; const int ncb = part ? 1 : 8, cb0 = part ? (F.bid & 7) : 0;
    const int gwv = part ? ((F.bid >> 3) * NWAVES + F.wave) : (F.bid * NWAVES + F.wave), nwv = part ? ((F.nblk >> 3) * NWAVES) : (F.nblk * NWAVES);
    const int ntok = layer == 0 ? R : NB * SEQ;
    const unsigned char* HQ = F.ws + WS_HQ; const unsigned* PK = (const unsigned*)(F.ws + WS_PK);
    const unsigned char* UT = F.ws + WS_TAB + (size_t)(layer * 2) * 16384 * 1024;
    int* PD = (int*)(F.ws + WS_PD);
#define U_META(pk, hq, n_) do { const int r_ = tok_row(layer, (n_) < ntok ? (n_) : gwv); const unsigned* p_ = PK + (size_t)r_ * 128 + s; \
        _Pragma("unroll") for (int i_ = 0; i_ < 16; ++i_) pk[i_] = p_[8 * i_]; \
        hq = *(const u32x4*)(HQ + (size_t)r_ * DM + 128 * cb + 16 * c8); } while (0)
#define U_ISSUE(pk, lo) do { _Pragma("unroll") for (int i_ = (lo); i_ < (lo) + 8; ++i_) t[i_] = *(const u32x4*)(tb + (size_t)(pk[i_] >> 16) * 128); } while (0)
#define U_DOT(i_) do { int d_ = __builtin_amdgcn_sdot4((int)t[i_][0], (int)hv[0], 0, false); d_ = __builtin_amdgcn_sdot4((int)t[i_][1], (int)hv[1], d_, false); \
        d_ = __builtin_amdgcn_sdot4((int)t[i_][2], (int)hv[2], d_, false); d_ = __builtin_amdgcn_sdot4((int)t[i_][3], (int)hv[3], d_, false); \
        d_ = isum8(d_); if (c8 == ((i_) & 7)) { if ((i_) < 8) kA = d_; else kB = d_; } } while (0)
#define U_ITEM(pkc, hqc, pkn, n_) do { \
        const u32x4 hv = hqc; \
        U_META(pkc, hqc, (n_) + 2 * nwv); \
        int kA = 0, kB = 0; \
        _Pragma("unroll") for (int i_ = 0; i_ < 8; ++i_) U_DOT(i_); \
        U_ISSUE(pkn, 0); \
        _Pragma("unroll") for (int i_ = 8; i_ < 16; ++i_) U_DOT(i_); \
        U_ISSUE(pkn, 8); \
        if ((n_) < ntok) { const int r_ = tok_row(layer, n_); int* pd_ = PD + ((size_t)cb * R + r_) * 128 + 8 * c8 + s; pd_[0] = kA; pd_[64] = kB; } \
        } while (0)
#pragma unroll 1
    for (int cbi = 0; cbi < ncb; ++cbi) {
        const int cb = cb0 + cbi;
        const unsigned char* tb = UT + (size_t)cb * 16384 * 128 + 16 * c8;
        unsigned pkA[16], pkB[16]; u32x4 hA, hB, t[16];
        U_META(pkA, hA, gwv); U_META(pkB, hB, gwv + nwv);
        U_ISSUE(pkA, 0); U_ISSUE(pkA, 8);
#pragma unroll 1
        for (int n = gwv; n < ntok; n += 2 * nwv) {
            U_ITEM(pkA, hA, pkB, n);
            U_ITEM(pkB, hB, pkA, n + nwv);
        }
    }
#undef U_META
#undef U_ISSUE
#undef U_DOT
#undef U_ITEM
}
__device__ __forceinline__ void p_exp_w(const Args& A, const Frame& F, int layer) {
    const int gw = F.bid * NWAVES + F.wave, NGW = F.nblk * NWAVES, lane = F.lane;
    const int ntok = layer == 0 ? R : NB * SEQ;
    const unsigned* PK = (const unsigned*)(F.ws + WS_PK); const int* PD = (const int*)(F.ws + WS_PD); const float* HS = (const float*)(F.ws + WS_HS);
    unsigned* WQ8 = (unsigned*)(F.ws + WS_WQ8); float* WSC = (float*)(F.ws + WS_WSC);
    const float* SU = (const float*)(F.ws + WS_TSC) + (layer * 2) * 16384; const float* SV = SU + 16384;
    const int g2 = (lane >> 3) & 3, sb = lane & 7, src = 32 * (g2 & 1) + sb;
    for (int n = gw; n < ntok; n += 2 * NGW) {
        int r[2]; r[0] = tok_row(layer, n); r[1] = (n + NGW) < ntok ? tok_row(layer, n + NGW) : r[0];
        unsigned pk0[2], pk1[2]; int d0[2], d1[2]; float hs[2];
#pragma unroll
        for (int q = 0; q < 2; ++q) { pk0[q] = PK[(size_t)r[q] * 128 + lane]; pk1[q] = PK[(size_t)r[q] * 128 + 64 + lane]; hs[q] = HS[r[q]]; d0[q] = 0; d1[q] = 0;
#pragma unroll
            for (int cb = 0; cb < 8; ++cb) { d0[q] += PD[((size_t)cb * R + r[q]) * 128 + lane]; d1[q] += PD[((size_t)cb * R + r[q]) * 128 + 64 + lane]; } }
        float su0[2], su1[2], sv0[2], sv1[2];
#pragma unroll
        for (int q = 0; q < 2; ++q) { const int e0 = (int)(pk0[q] >> 16), e1 = (int)(pk1[q] >> 16); su0[q] = SU[e0]; su1[q] = SU[e1]; sv0[q] = SV[e0]; sv1[q] = SV[e1]; }
#pragma unroll
        for (int q = 0; q < 2; ++q) {
            const float g0 = (float)(pk0[q] & 0xffffu) * (1.f / 65535.f), g1 = (float)(pk1[q] & 0xffffu) * (1.f / 65535.f);
            const float a0 = su0[q] * hs[q] * (float)d0[q], a1 = su1[q] * hs[q] * (float)d1[q];
            const float w0 = g0 * 0.5f * a0 * (1.f + erff(a0 * 0.70710678118654752f)) * sv0[q], w1 = g1 * 0.5f * a1 * (1.f + erff(a1 * 0.70710678118654752f)) * sv1[q];
            const float wm = wave_max(fmaxf(fabsf(w0), fabsf(w1)));
            const float inv = wm > 0.f ? 127.f / wm : 0.f;
            const int q0 = (int)rintf(w0 * inv) & 0xff, q1 = (int)rintf(w1 * inv) & 0xff;
            unsigned pw = 0;
#pragma unroll
            for (int j = 0; j < 4; ++j) { const int x0 = __shfl(q0, src + 8 * j), x1 = __shfl(q1, src + 8 * j); pw |= (unsigned)((g2 < 2) ? x0 : x1) << (8 * j); }
            if (q == 0 || (n + NGW) < ntok) { if (lane < 32) WQ8[(size_t)r[q] * 32 + lane] = pw; if (lane == 0) WSC[r[q]] = wm > 0.f ? wm * (1.f / 127.f) : 0.f; }
        }
    }
}
__device__ __forceinline__ void p_exp_v(const Args& A, const Frame& F, int layer) {
    const int lane = F.lane, s = lane >> 3, c8 = lane & 7;
    const bool part = (F.nblk & 7) == 0; const int ncb = part ? 1 : 8, cb0 = part ? (F.bid & 7) : 0;
    const int gwv = part ? ((F.bid >> 3) * NWAVES + F.wave) : (F.bid * NWAVES + F.wave), nwv = part ? ((F.nblk >> 3) * NWAVES) : (F.nblk * NWAVES);
    const int ntok = layer == 0 ? R : NB * SEQ;
    const unsigned* PK = (const unsigned*)(F.ws + WS_PK); const unsigned* WQ8 = (const unsigned*)(F.ws + WS_WQ8); const float* WSC = (const float*)(F.ws + WS_WSC);
    const unsigned char* VT = F.ws + WS_TAB + (size_t)(layer * 2 + 1) * 16384 * 1024;
    unsigned short* X = (unsigned short*)(F.ws + WS_X); const float* MOD = (const float*)(F.ws + WS_MOD) + (size_t)layer * 5 * 6144;
    const bool bit3 = (lane & 8) != 0;
#define V_METAP(pk, n_) do { const int r_ = tok_row(layer, (n_) < ntok ? (n_) : gwv); const unsigned* p_ = PK + (size_t)r_ * 128 + s; \
        _Pragma("unroll") for (int i_ = 0; i_ < 16; ++i_) pk[i_] = p_[8 * i_]; } while (0)
#define V_METAW(wq, n_) do { const int r_ = tok_row(layer, (n_) < ntok ? (n_) : gwv); const unsigned* w_ = WQ8 + (size_t)r_ * 32 + s; \
        _Pragma("unroll") for (int g_ = 0; g_ < 4; ++g_) wq[g_] = w_[8 * g_]; } while (0)
#define V_ISSUE(pk, lo) do { _Pragma("unroll") for (int i_ = (lo); i_ < (lo) + 8; ++i_) t[i_] = *(const u32x4*)(tb + (size_t)(pk[i_] >> 16) * 128); } while (0)
#define V_GRP(wq, g_) do { _Pragma("unroll") for (int j_ = 0; j_ < 4; ++j_) { const unsigned a_ = t[4 * (g_)][j_], b_ = t[4 * (g_) + 1][j_], c_ = t[4 * (g_) + 2][j_], d_ = t[4 * (g_) + 3][j_]; \
        const unsigned ablo = __builtin_amdgcn_perm(b_, a_, 0x05010400u), abhi = __builtin_amdgcn_perm(b_, a_, 0x07030602u), cdlo = __builtin_amdgcn_perm(d_, c_, 0x05010400u), cdhi = __builtin_amdgcn_perm(d_, c_, 0x07030602u); \
        acc[4 * j_]     = __builtin_amdgcn_sdot4((int)__builtin_amdgcn_perm(cdlo, ablo, 0x05040100u), (int)wq[g_], acc[4 * j_], false); \
        acc[4 * j_ + 1] = __builtin_amdgcn_sdot4((int)__builtin_amdgcn_perm(cdlo, ablo, 0x07060302u), (int)wq[g_], acc[4 * j_ + 1], false); \
        acc[4 * j_ + 2] = __builtin_amdgcn_sdot4((int)__builtin_amdgcn_perm(cdhi, abhi, 0x05040100u), (int)wq[g_], acc[4 * j_ + 2], false); \
        acc[4 * j_ + 3] = __builtin_amdgcn_sdot4((int)__builtin_amdgcn_perm(cdhi, abhi, 0x07060302u), (int)wq[g_], acc[4 * j_ + 3], false); } } while (0)
#define V_ITEM(pkc, wqc, pkn, n_) do { \
        int acc[16]; _Pragma("unroll") for (int a_ = 0; a_ < 16; ++a_) acc[a_] = 0; \
        V_METAP(pkc, (n_) + 2 * nwv); \
        V_GRP(wqc, 0); V_GRP(wqc, 1); \
        V_ISSUE(pkn, 0); \
        V_GRP(wqc, 2); V_GRP(wqc, 3); \
        V_ISSUE(pkn, 8); \
        int b8[8], c4[4], o[2]; \
        _Pragma("unroll") for (int a_ = 0; a_ < 8; ++a_) { auto rr = __builtin_amdgcn_permlane32_swap((unsigned)acc[a_], (unsigned)acc[a_ + 8], false, false); b8[a_] = (int)rr[0] + (int)rr[1]; } \
        _Pragma("unroll") for (int a_ = 0; a_ < 4; ++a_) { auto rr = __builtin_amdgcn_permlane16_swap((unsigned)b8[a_], (unsigned)b8[a_ + 4], false, false); c4[a_] = (int)rr[0] + (int)rr[1]; } \
        _Pragma("unroll") for (int a_ = 0; a_ < 2; ++a_) { const int keep = bit3 ? c4[a_ + 2] : c4[a_], send = bit3 ? c4[a_] : c4[a_ + 2]; o[a_] = keep + __builtin_amdgcn_update_dpp(0, send, 0x128, 0xf, 0xf, false); } \
        if ((n_) < ntok) { const int r_ = tok_row(layer, n_); const float ws_ = WSC[r_]; const int col = 128 * cb + 16 * c8 + 2 * s; \
            const f32x2 gf = *(const f32x2*)(MOD + (size_t)mod_index(r_) * 6144 + 5 * 1024 + col); unsigned* xp = (unsigned*)(X + (size_t)r_ * DM + col); \
            const unsigned xw = *xp; *xp = pkh2(h2f_lo(xw) + gf.x * (ws_ * (float)o[0]), h2f_hi(xw) + gf.y * (ws_ * (float)o[1])); } \
        V_METAW(wqc, (n_) + 2 * nwv); } while (0)
#pragma unroll 1
    for (int cbi = 0; cbi < ncb; ++cbi) {
        const int cb = cb0 + cbi;
        const unsigned char* tb = VT + (size_t)cb * 16384 * 128 + 16 * c8;
        unsigned pkA[16], pkB[16], wqA[4], wqB[4]; u32x4 t[16];
        V_METAP(pkA, gwv); V_METAW(wqA, gwv); V_METAP(pkB, gwv + nwv); V_METAW(wqB, gwv + nwv);
        V_ISSUE(pkA, 0); V_ISSUE(pkA, 8);
#pragma unroll 1
        for (int n = gwv; n < ntok; n += 2 * nwv) {
            V_ITEM(pkA, wqA, pkB, n);
            V_ITEM(pkB, wqB, pkA, n + nwv);
        }
    }
#undef V_METAP
#undef V_METAW
#undef V_ISSUE
#undef V_GRP
#undef V_ITEM
}
__device__ __forceinline__ void p_final_norm(const Args& A, const Frame& F) {
    const int gw = F.bid * NWAVES + F.wave, NGW = F.nblk * NWAVES, lane = F.lane;
    const unsigned short* X = (const unsigned short*)(F.ws + WS_X); const float* gn = A.in[I_NOUT];
    for (int n = gw; n < NB * SEQ; n += NGW) {
        const unsigned short* xr = X + (size_t)tok_row(1, n) * DM; float* op = F.out + (size_t)n * DM;
        f32x4 v[4]; float sq = 0.f;
#pragma unroll
        for (int j = 0; j < 4; ++j) { const u32x2 a = *(const u32x2*)(xr + 4 * lane + 256 * j); v[j] = (f32x4){h2f_lo(a.x), h2f_hi(a.x), h2f_lo(a.y), h2f_hi(a.y)}; sq += (v[j].x * v[j].x + v[j].y * v[j].y) + (v[j].z * v[j].z + v[j].w * v[j].w); }
        const float rinv = rsqrtf(wave_sum(sq) * (1.f / DM) + EPS);
#pragma unroll
        for (int j = 0; j < 4; ++j) { const int c = 4 * lane + 256 * j; *(f32x4*)(op + c) = v[j] * rinv * *(const f32x4*)(gn + c); }
    }
}

constexpr int N_PHASES = 24;
__global__ void __launch_bounds__(NTHREADS, 2) mega(Args args) {
    extern __shared__ __attribute__((aligned(16))) unsigned char lds_raw[];
    Frame F; F.x = args.in[I_X]; F.ctx = args.in[I_CTX]; F.out = args.out; F.ws = args.ws; F.lds = (char*)lds_raw;
    F.tid = threadIdx.x; F.lane = F.tid & 63; F.wave = __builtin_amdgcn_readfirstlane(F.tid >> 6); F.bid = blockIdx.x; F.nblk = gridDim.x;
    F.vcu = (F.nblk % 8 == 0) ? (F.bid % 8) * (F.nblk / 8) + F.bid / 8 : F.bid;
    volatile LAS unsigned* st = (volatile LAS unsigned*)(LAS unsigned char*)(lds_raw + LDS_BYTES - 64);
    if (F.tid < 16) st[F.tid] = 0u;
    __syncthreads();
    XcdBarrier bar; bar.bar = (unsigned*)(F.ws + WS_CTL) + 4096; bar.x = 0; bar.st = st;
    const int lo = args.ph_lo, hi = args.ph_hi;
    const bool fused = (hi - lo) > 1;
    if (fused) bar = xcd_barrier_post((unsigned*)(F.ws + WS_CTL) + 4096, st);
#ifdef ONLY_PHASE
#define IN(k) ((k) == ONLY_PHASE && lo <= (k) && (k) < hi)
#else
#define IN(k) (lo <= (k) && (k) < hi)
#endif
#define SEAM(k) do { if (IN(k) && IN((k) + 1)) { if ((k) == 0) cg::this_grid().sync(); else xcd_barrier(bar); } } while (0)
    bf16_t* Hb = (bf16_t*)(F.ws + WS_H);
#define PH(k, ...) if (IN(k)) for (int rep_ = 0; rep_ < (((PROBE_MASK >> (k)) & 1u) ? 2 : 1); ++rep_) { __VA_ARGS__; __syncthreads(); } SEAM(k)
    unsigned short* Xb = (unsigned short*)(F.ws + WS_X); const float* MODb = (const float*)(F.ws + WS_MOD);
    PH(0, for (int q_ = 0; q_ < ((PROBE_P0 & 1u) ? 2 : 1); ++q_) { p0_mod(args, F); __syncthreads(); }
          for (int q_ = 0; q_ < ((PROBE_P0 & 2u) ? 2 : 1); ++q_) { p0_weights(args, F); __syncthreads(); }
          for (int q_ = 0; q_ < ((PROBE_P0 & 4u) ? 2 : 1); ++q_) { p0_weff(args, F); __syncthreads(); }
          for (int q_ = 0; q_ < ((PROBE_P0 & 8u) ? 2 : 1); ++q_) { p0_tables(args, F); __syncthreads(); });
    PH(1, p_norm_rows(args, F, 0, 0, true, false));
    PH(2, gemm8e(F, Hb, (const bf16_t*)(F.ws + WS_WIN), 768, 1024, false, EpiMlaDown{(bf16_t*)(F.ws + WS_CQ), (bf16_t*)(F.ws + WS_CKV), (bf16_t*)(F.ws + WS_KR), (float*)(F.ws + WS_SSP)}));
    PH(3, p_mla_krope(args, F);
          gemm8(F, (const bf16_t*)(F.ws + WS_CQ), (const bf16_t*)(F.ws + WS_WUQ), 1536, 384, false, In8Bf16Rs{(bf16_t*)(F.ws + WS_Q), 1536, (const float*)(F.ws + WS_SSP)});
          gemm8(F, (const bf16_t*)(F.ws + WS_CKV), (const bf16_t*)(F.ws + WS_WUKV), 2048, 256, false, In8KVRs{(bf16_t*)(F.ws + WS_K), (bf16_t*)(F.ws + WS_V), (const float*)(F.ws + WS_SSP)}));
    PH(4, p_attn_mla(args, F));
    PH(5, gemm8(F, (const bf16_t*)(F.ws + WS_O), (const bf16_t*)(F.ws + WS_WO0), 1024, 1024, false, In8Resid{F.x, F.ctx, Xb, MODb + 2 * 1024, true}));
    PH(6, p_norm_rows(args, F, 0, 1, false, false));
    PH(7, gemm8(F, Hb, (const bf16_t*)(F.ws + WS_WQ0), 2048, 1024, false, In8F16{(unsigned short*)(F.ws + WS_S), 2048}));
    PH(8, p_peer_topk(args, F, false));
    PH(9, p_exp_u(args, F, 0));
    PH(10, p_exp_w(args, F, 0));
    if (IN(11)) { p_exp_v(args, F, 0); } SEAM(11);
    PH(12, p_norm_rows(args, F, 1, 0, false, false));
    PH(13, gemm8(F, Hb, (const bf16_t*)(F.ws + WS_WQKV), 1536, 1024, false, In8Bf16{(bf16_t*)(F.ws + WS_RAW1), 1536}));
    PH(14, p_gqa_rows(args, F));
    PH(15, p_attn_gqa(args, F));
    if (IN(16)) { gemm8(F, (const bf16_t*)(F.ws + WS_O), (const bf16_t*)(F.ws + WS_WO1), 1024, 1024, true, In8Resid{F.x, F.ctx, Xb, MODb + 5 * 6144 + 2 * 1024, false}); } SEAM(16);
    PH(17, p_norm_rows(args, F, 1, 1, false, true));
    PH(18, gemm8(F, Hb, (const bf16_t*)(F.ws + WS_WQ1), 2048, 1024, true, In8F16{(unsigned short*)(F.ws + WS_S), 2048}));
    PH(19, p_peer_topk(args, F, true));
    PH(20, p_exp_u(args, F, 1));
    PH(21, p_exp_w(args, F, 1));
    if (IN(22)) { p_exp_v(args, F, 1); } SEAM(22);
    if (IN(23)) p_final_norm(args, F);
#undef PH
#undef IN
#undef SEAM
}

extern "C" void kernel_launch(void* const* d_in, const int* in_sizes, int n_in, void* d_out, int out_size, void* d_ws, size_t ws_size, hipStream_t stream) {
    static int grid = 0;
    if (grid == 0) {
        if (n_in != N_IN || in_sizes[0] != NB * SEQ * DM || out_size != NB * SEQ * DM || ws_size < WS_END) {
            fprintf(stderr, "kernel_launch: shape mismatch (n_in %d, in0 %d, out %d, ws %zu < %zu)\n", n_in, n_in > 0 ? in_sizes[0] : -1, out_size, ws_size, (size_t)WS_END); grid = -1; return; }
        int dev = 0, cus = 0, per_cu = 0;
        hipGetDevice(&dev); hipDeviceGetAttribute(&cus, hipDeviceAttributeMultiprocessorCount, dev);
        if (hipFuncSetAttribute((const void*)mega, hipFuncAttributeMaxDynamicSharedMemorySize, LDS_BYTES) != hipSuccess) { fprintf(stderr, "kernel_launch: hipFuncSetAttribute failed\n"); grid = -1; return; }
        if (hipOccupancyMaxActiveBlocksPerMultiprocessor(&per_cu, (const void*)mega, NTHREADS, LDS_BYTES) != hipSuccess || per_cu < 1) { fprintf(stderr, "kernel_launch: occupancy query failed (%d)\n", per_cu); (void)hipGetLastError(); grid = -1; return; }
        grid = cus * (per_cu > 1 ? 1 : per_cu);
    }
    if (grid < 0) return;
    hipMemsetAsync((char*)d_ws + WS_CTL, 0, 1 * MiB, stream);
    Args a{};
    for (int i = 0; i < N_IN; ++i) a.in[i] = (const float*)d_in[i];
    a.out = (float*)d_out; a.ws = (unsigned char*)d_ws;
#if MK_PER_PHASE
    for (int p = 0; p < N_PHASES; ++p) { a.ph_lo = p; a.ph_hi = p + 1; hipLaunchKernelGGL(mega, dim3(grid), dim3(NTHREADS), LDS_BYTES, stream, a); }
#else
    a.ph_lo = 0; a.ph_hi = N_PHASES;
    void* kargs[] = {&a};
    hipError_t e = hipLaunchCooperativeKernel((const void*)mega, dim3(grid), dim3(NTHREADS), kargs, LDS_BYTES, stream);
    if (e != hipSuccess) fprintf(stderr, "kernel_launch: cooperative launch failed: %s (grid %d)\n", hipGetErrorString(e), grid);
#endif
}
```

```cpp
#include <hip/hip_runtime.h>
#include <hip/hip_cooperative_groups.h>
#include <cstdio>
#include <cstdint>
namespace cg = cooperative_groups;

#ifndef PROBE_MASK
#define PROBE_MASK 0u
#endif
#ifndef PROBE_P0
#define PROBE_P0 0u
#endif
#ifndef MK_PER_PHASE
#define MK_PER_PHASE 0
#endif

typedef unsigned short bf16_t;
typedef short bf16x8 __attribute__((ext_vector_type(8)));
typedef short s16x4 __attribute__((ext_vector_type(4)));
typedef float f32x4 __attribute__((ext_vector_type(4)));
typedef float f32x2 __attribute__((ext_vector_type(2)));
typedef float f32x16 __attribute__((ext_vector_type(16)));
typedef unsigned u32x4 __attribute__((ext_vector_type(4)));
typedef unsigned u32x2 __attribute__((ext_vector_type(2)));
#define LAS __attribute__((address_space(3)))
#define SBAR() __builtin_amdgcn_sched_barrier(0)

__device__ __forceinline__ unsigned f2bf(float f) { unsigned u = __builtin_bit_cast(unsigned, f); return (u + 0x7fffu + ((u >> 16) & 1u)) >> 16; }
__device__ __forceinline__ unsigned pk2(float lo, float hi) { return f2bf(lo) | (f2bf(hi) << 16); }
typedef _Float16 f16x2_t __attribute__((ext_vector_type(2)));
__device__ __forceinline__ unsigned pkh2(float lo, float hi) { f32x2 v = {lo, hi}; return __builtin_bit_cast(unsigned, __builtin_convertvector(v, f16x2_t)); }
__device__ __forceinline__ float h2f_lo(unsigned w) { return (float)__builtin_bit_cast(_Float16, (unsigned short)(w & 0xffffu)); }
__device__ __forceinline__ float h2f_hi(unsigned w) { return (float)__builtin_bit_cast(_Float16, (unsigned short)(w >> 16)); }
__device__ __forceinline__ float bf2f(unsigned short h) { return __builtin_bit_cast(float, (unsigned)h << 16); }
__device__ __forceinline__ float bflo(unsigned w) { return __builtin_bit_cast(float, w << 16); }
__device__ __forceinline__ float bfhi(unsigned w) { return __builtin_bit_cast(float, w & 0xffff0000u); }
__device__ __forceinline__ unsigned cvtpk(float lo, float hi) { unsigned r; asm volatile("v_cvt_pk_bf16_f32 %0, %1, %2" : "=v"(r) : "v"(lo), "v"(hi)); return r; }
#define WDPP(v, ctrl) __builtin_bit_cast(float, __builtin_amdgcn_update_dpp(0, __builtin_bit_cast(int, v), ctrl, 0xf, 0xf, false))
__device__ __forceinline__ float wave_sum(float v) {
    v += WDPP(v, 0xB1); v += WDPP(v, 0x4E); v += WDPP(v, 0x141); v += WDPP(v, 0x140);
    { auto rr = __builtin_amdgcn_permlane16_swap(__float_as_uint(v), __float_as_uint(v), false, false); v = __uint_as_float(rr[0]) + __uint_as_float(rr[1]); }
    { auto rr = __builtin_amdgcn_permlane32_swap(__float_as_uint(v), __float_as_uint(v), false, false); v = __uint_as_float(rr[0]) + __uint_as_float(rr[1]); }
    return v;
}
__device__ __forceinline__ float wave_max(float v) {
    v = fmaxf(v, WDPP(v, 0xB1)); v = fmaxf(v, WDPP(v, 0x4E)); v = fmaxf(v, WDPP(v, 0x141)); v = fmaxf(v, WDPP(v, 0x140));
    { auto rr = __builtin_amdgcn_permlane16_swap(__float_as_uint(v), __float_as_uint(v), false, false); v = fmaxf(__uint_as_float(rr[0]), __uint_as_float(rr[1])); }
    { auto rr = __builtin_amdgcn_permlane32_swap(__float_as_uint(v), __float_as_uint(v), false, false); v = fmaxf(__uint_as_float(rr[0]), __uint_as_float(rr[1])); }
    return v;
}

constexpr int DM = 1024, NB = 4, SEQ = 4096, CTXL = 256;
constexpr int RPB = SEQ + CTXL;
constexpr int R = NB * RPB;
constexpr float EPS = 1e-6f;
constexpr int NTHREADS = 512, NWAVES = 8;
constexpr int LDS_BYTES = 147456;

enum { I_X = 0, I_C, I_CTX, I_CCTX,
       I0_ADAW, I0_ADAB, I0_NMIX, I0_NFFN, I0_WIN, I0_QN, I0_WUQ, I0_KVN, I0_WUKV, I0_WO, I0_PWQ, I0_PK1, I0_PK2, I0_PU, I0_PV,
       I1_ADAW, I1_ADAB, I1_NMIX, I1_NFFN, I1_WQKV, I1_QN, I1_KN, I1_WO, I1_PWQ, I1_PK1, I1_PK2, I1_PU, I1_PV,
       I_NOUT, N_IN };

constexpr size_t MiB = 1u << 20;
constexpr size_t WS_CTL   = 0;
constexpr size_t WS_MOD   = 1 * MiB;
constexpr size_t WS_WIN   = 2 * MiB;
constexpr size_t WS_WUQ   = WS_WIN + 768 * 1024 * 2;
constexpr size_t WS_WUKV  = WS_WUQ + 1536 * 384 * 2;
constexpr size_t WS_WO0   = WS_WUKV + 2048 * 256 * 2;
constexpr size_t WS_WQ0   = WS_WO0 + 1024 * 1024 * 2;
constexpr size_t WS_KK0   = WS_WQ0 + 2048 * 1024 * 2;
constexpr size_t WS_WQKV  = WS_KK0 + 16 * 128 * 128 * 2;
constexpr size_t WS_WO1   = WS_WQKV + 1536 * 1024 * 2;
constexpr size_t WS_WQ1   = WS_WO1 + 1024 * 1024 * 2;
constexpr size_t WS_KK1   = WS_WQ1 + 2048 * 1024 * 2;
constexpr size_t WS_WEND  = WS_KK1 + 16 * 128 * 128 * 2;
static_assert(WS_WEND <= 24 * MiB, "weights region");
constexpr size_t WS_H     = 24 * MiB;
constexpr size_t WS_X     = WS_H + (size_t)R * 1024 * 2;
constexpr size_t WS_QKV   = WS_X + (size_t)R * 1024 * 4;
constexpr size_t WS_Q     = WS_QKV;
constexpr size_t WS_K     = WS_Q + (size_t)R * 1536 * 2;
constexpr size_t WS_V     = WS_K + (size_t)R * 1536 * 2;
constexpr size_t WS_S     = WS_QKV;
constexpr size_t WS_B     = WS_QKV + (size_t)R * 2048 * 4;
constexpr size_t WS_CQ    = WS_B;
constexpr size_t WS_CKV   = WS_CQ + (size_t)R * 384 * 2;
constexpr size_t WS_KR    = WS_CKV + (size_t)R * 256 * 2;
constexpr size_t WS_SSP   = WS_KR + (size_t)R * 64 * 2;
static_assert(WS_SSP + (size_t)R * 24 * 4 <= WS_B + 40 * MiB, "MLA latents inside region B");
constexpr size_t WS_O     = WS_B;
constexpr size_t WS_QP    = WS_B;
constexpr size_t WS_RAW1  = WS_B;
constexpr size_t WS_PK    = WS_B + (size_t)R * 2048 * 2;
constexpr size_t WS_TAB   = WS_PK + (size_t)R * 128 * 4;
constexpr size_t WS_PD    = WS_S;
constexpr size_t WS_WQ8   = WS_PD + (size_t)8 * R * 128 * 4;
constexpr size_t WS_WSC   = WS_WQ8 + (size_t)R * 128;
static_assert(WS_WSC + (size_t)R * 4 <= WS_B, "expert scratch inside the S region");
constexpr size_t WS_HQ    = WS_B + 40 * MiB;
constexpr size_t WS_HS    = WS_HQ + (size_t)R * 1024;
static_assert(WS_HS + (size_t)R * 4 <= WS_PK, "HQ inside region B");
constexpr size_t WS_TSC   = WS_TAB + (size_t)4 * 16384 * 1024;
constexpr size_t WS_END   = WS_TSC + (size_t)4 * 16384 * 4;
constexpr size_t WS_Q1    = WS_QKV;
constexpr size_t WS_K1    = WS_Q1 + (size_t)R * 1024 * 2;
constexpr size_t WS_V1    = WS_K1 + (size_t)R * 256 * 2;

#define XB_TMO      128
#define XB_XCNT(j)  (256  + 64 * (j))
#define XB_XSUB(j)  (1280 + 64 * (j))
#define XB_XGEN(j)  (2304 + 64 * (j))
#define XB_TOP      3328
#define XB_TOPGEN   3392
#define XCD_BAR_WORDS 3456
#define XB_SPIN_CAP (1u << 20)
__device__ __forceinline__ unsigned xb_ld(unsigned* p)              { return __hip_atomic_load(p, __ATOMIC_RELAXED, __HIP_MEMORY_SCOPE_AGENT); }
__device__ __forceinline__ unsigned xb_add(unsigned* p, unsigned v) { return __hip_atomic_fetch_add(p, v, __ATOMIC_RELAXED, __HIP_MEMORY_SCOPE_AGENT); }
__device__ __forceinline__ unsigned xb_xcc_id() { return (unsigned)__builtin_amdgcn_s_getreg((3 << 11) | 20) & 0xFu; }
#define XB_SPIN(cond, bar) do { unsigned _sp = 0; while (cond) { __builtin_amdgcn_s_sleep(1); \
    if ((++_sp & 255u) == 0u) { if (xb_ld(&(bar)[XB_TMO])) break; if (_sp > XB_SPIN_CAP) { atomicAdd(&(bar)[XB_TMO], 1u); break; } } } } while (0)
struct XcdBarrier { unsigned* bar; unsigned x; volatile LAS unsigned* st; };
__device__ __forceinline__ XcdBarrier xcd_barrier_post(unsigned* bar, volatile LAS unsigned* st) {
    XcdBarrier b; b.bar = bar; b.x = xb_xcc_id(); b.st = st;
    if (threadIdx.x == 0) (void)xb_add(&bar[XB_XCNT(b.x)], 1u);
    return b;
}
__device__ __forceinline__ void xcd_barrier_complete(unsigned* bar, unsigned x, unsigned& nloc, unsigned& nx) {
    const unsigned G = gridDim.x * gridDim.y * gridDim.z;
    unsigned sum, cnt, mine, sp = 0u;
    for (;;) {
        sum = 0u; cnt = 0u; mine = 0u;
#pragma unroll
        for (unsigned j = 0; j < 16; ++j) { const unsigned c = xb_ld(&bar[XB_XCNT(j)]); sum += c; cnt += (c > 0u) ? 1u : 0u; mine = (j == x) ? c : mine; }
        if (sum == G) break;
        __builtin_amdgcn_s_sleep(1);
        if ((++sp & 255u) == 0u) { if (xb_ld(&bar[XB_TMO])) break; if (sp > XB_SPIN_CAP) { atomicAdd(&bar[XB_TMO], 1u); break; } }
    }
    nloc = mine > 0u ? mine : 1u; nx = cnt > 0u ? cnt : 1u;
}
__device__ __forceinline__ void xcd_barrier(const XcdBarrier& b) {
    asm volatile("s_waitcnt vmcnt(0)" ::: "memory");
    __syncthreads();
    if (threadIdx.x == 0) {
        unsigned* bar = b.bar;
        __builtin_amdgcn_s_waitcnt(0);
        unsigned nloc = b.st[0], nx = b.st[1];
        if (nloc == 0u) { xcd_barrier_complete(bar, b.x, nloc, nx); b.st[0] = nloc; b.st[1] = nx; }
        const unsigned old = xb_add(&bar[XB_XSUB(b.x)], 1u);
        const unsigned gen = old / nloc;
        if (old + 1u == (gen + 1u) * nloc) {
            __builtin_amdgcn_fence(__ATOMIC_RELEASE, "agent");
            asm volatile("s_waitcnt vmcnt(0)" ::: "memory");
            const unsigned og = xb_add(&bar[XB_TOP], 1u);
            const unsigned tg = og / nx;
            if (og + 1u == (tg + 1u) * nx) xb_add(&bar[XB_TOPGEN], 1u);
            else XB_SPIN(xb_ld(&bar[XB_TOPGEN]) == tg, bar);
            __builtin_amdgcn_fence(__ATOMIC_ACQUIRE, "agent");
            xb_add(&bar[XB_XGEN(b.x)], 1u);
            asm volatile("s_waitcnt vmcnt(0)" ::: "memory");
        } else {
            XB_SPIN(xb_ld(&bar[XB_XGEN(b.x)]) == gen, bar);
            __builtin_amdgcn_fence(__ATOMIC_ACQUIRE, "agent");
            asm volatile("s_waitcnt vmcnt(0)" ::: "memory");
        }
    }
    __syncthreads();
}


struct Args { const float* in[N_IN]; float* out; unsigned char* ws; int ph_lo, ph_hi; };
static_assert(sizeof(Args) == (N_IN + 2) * 8 + 8, "Args has no padding");

struct Frame {
    const float* x; const float* ctx; float* out; unsigned char* ws; char* lds;
    int tid, lane, wave, bid, nblk, vcu;
};

__device__ __forceinline__ const float* xin_row(const Frame& F, int r) {
    const int b = r / RPB, j = r - b * RPB;
    return (j < CTXL) ? F.ctx + ((size_t)b * CTXL + j) * DM : F.x + ((size_t)b * SEQ + (j - CTXL)) * DM;
}
__device__ __forceinline__ int mod_index(int r) { const int b = r / RPB, j = r - b * RPB; return (j < CTXL) ? 4 : b; }
__device__ __forceinline__ bool is_ctx_row(int r) { return (r % RPB) < CTXL; }

__device__ __forceinline__ void p0_mod(const Args& A, const Frame& F) {
    float* sv = (float*)F.lds;
    float* red = sv + 5 * 1024;
    float* MOD = (float*)(F.ws + WS_MOD);
    bool have = false;
    for (int it = F.bid; it < 2 * 96; it += F.nblk) {
        if (!have) {
            for (int i = F.tid; i < 5 * 1024; i += NTHREADS) { const int m = i >> 10, k = i & 1023;
                const float c = (m < 4) ? A.in[I_C][m * 1024 + k] : A.in[I_CCTX][k]; sv[i] = c / (1.f + __expf(-c)); }
            __syncthreads(); have = true;
        }
        const int l = it / 96, n = (it % 96) * 64 + F.lane;
        const float* W = A.in[l ? I1_ADAW : I0_ADAW]; const float* Bv = A.in[l ? I1_ADAB : I0_ADAB];
        float acc[5] = {0.f, 0.f, 0.f, 0.f, 0.f};
        const int k0 = F.wave * 128;
#pragma unroll 16
        for (int k = k0; k < k0 + 128; ++k) { const float w = W[(size_t)k * 6144 + n];
#pragma unroll
            for (int m = 0; m < 5; ++m) acc[m] += sv[m * 1024 + k] * w; }
#pragma unroll
        for (int m = 0; m < 5; ++m) red[(F.wave * 5 + m) * 64 + F.lane] = acc[m];
        __syncthreads();
        if (F.tid < 320) { const int m = F.tid >> 6, ln = F.tid & 63; float s = 0.f;
#pragma unroll
            for (int w = 0; w < 8; ++w) s += red[(w * 5 + m) * 64 + ln];
            const int nn = (it % 96) * 64 + ln;
            MOD[((size_t)l * 5 + m) * 6144 + nn] = s + Bv[nn]; }
        __syncthreads();
    }
}
__device__ __forceinline__ void transpose_item(const float* W, int K, int N, bf16_t* WT, const float* gain, float* scr, int item, int lane) {
    const int nblk = N / 32, kb = item / nblk, nb = item % nblk, k0 = 64 * kb, n0 = 32 * nb;
#pragma unroll 8
    for (int i = 0; i < 32; ++i) { const int kk = 2 * i + (lane >> 5); float v = W[(size_t)(k0 + kk) * N + n0 + (lane & 31)]; if (gain) v *= gain[k0 + kk]; scr[kk * 33 + (lane & 31)] = v; }
    asm volatile("s_waitcnt lgkmcnt(0)" ::: "memory");
    const int c = lane & 7;
#pragma unroll
    for (int j = 0; j < 4; ++j) { const int n = (lane >> 3) + 8 * j; const float* s = scr + (8 * c) * 33 + n;
        u32x4 o; o.x = pk2(s[0 * 33], s[1 * 33]); o.y = pk2(s[2 * 33], s[3 * 33]); o.z = pk2(s[4 * 33], s[5 * 33]); o.w = pk2(s[6 * 33], s[7 * 33]);
        *(u32x4*)(WT + (size_t)(n0 + n) * K + k0 + 8 * c) = o; }
    asm volatile("s_waitcnt lgkmcnt(0)" ::: "memory");
}
__device__ __forceinline__ void p0_weights(const Args& A, const Frame& F) {
    float* scr = (float*)(F.lds + 32768) + F.wave * (64 * 33);
    const int gw = F.bid * NWAVES + F.wave, NGW = F.nblk * NWAVES;
#define TJOB(IN_, K_, N_, OFF_, GAIN_) do { const float* W = A.in[IN_]; bf16_t* WT = (bf16_t*)(F.ws + (OFF_)); \
        for (int it = gw; it < ((K_) / 64) * ((N_) / 32); it += NGW) transpose_item(W, K_, N_, WT, GAIN_, scr, it, F.lane); } while (0)
    TJOB(I0_WIN, 1024, 704, WS_WIN, nullptr); TJOB(I0_WUQ, 384, 1536, WS_WUQ, A.in[I0_QN]); TJOB(I0_WUKV, 256, 2048, WS_WUKV, A.in[I0_KVN]); TJOB(I0_WO, 1024, 1024, WS_WO0, nullptr);
    TJOB(I1_WQKV, 1024, 1536, WS_WQKV, nullptr); TJOB(I1_WO, 1024, 1024, WS_WO1, nullptr);
#undef TJOB
    { u32x4* z = (u32x4*)(F.ws + WS_WIN + (size_t)704 * 1024 * 2); const int n16 = 64 * 1024 * 2 / 16;
      for (int i = F.bid * NTHREADS + F.tid; i < n16; i += F.nblk * NTHREADS) z[i] = (u32x4){0u, 0u, 0u, 0u}; }
}
__device__ __forceinline__ void p0_weff(const Args& A, const Frame& F) {
    float* kkT = (float*)F.lds; float* wqs = kkT + 128 * 129;
    const int tid = F.tid, lane = F.lane, w = F.wave;
    for (int item = F.bid; item < 512; item += F.nblk) {
        const int layer = item >> 8, z = (item >> 4) & 15, kc = item & 15, h = z >> 1;
        const float* kk = ((z & 1) ? (layer ? A.in[I1_PK2] : A.in[I0_PK2]) : (layer ? A.in[I1_PK1] : A.in[I0_PK1])) + (size_t)h * 16384;
        const float* wq = (layer ? A.in[I1_PWQ] : A.in[I0_PWQ]) + (size_t)(kc * 64) * 2048 + z * 128;
        bf16_t* WT = (bf16_t*)(F.ws + (layer ? WS_WQ1 : WS_WQ0));
        __syncthreads();
        { f32x4 kv[8], wv4[4];
#pragma unroll
          for (int i = 0; i < 8; ++i) kv[i] = *(const f32x4*)(kk + 4 * (tid + i * NTHREADS));
#pragma unroll
          for (int i = 0; i < 4; ++i) { const int e = 4 * (tid + i * NTHREADS); wv4[i] = *(const f32x4*)(wq + (size_t)(e >> 7) * 2048 + (e & 127)); }
#pragma unroll
          for (int i = 0; i < 8; ++i) { const int e = 4 * (tid + i * NTHREADS), key = e >> 7, d = e & 127; kkT[d * 129 + key] = kv[i].x; kkT[(d + 1) * 129 + key] = kv[i].y; kkT[(d + 2) * 129 + key] = kv[i].z; kkT[(d + 3) * 129 + key] = kv[i].w; }
#pragma unroll
          for (int i = 0; i < 4; ++i) *(f32x4*)(wqs + 4 * (tid + i * NTHREADS)) = wv4[i]; }
        __syncthreads();
        float acc[8][2];
#pragma unroll
        for (int j = 0; j < 8; ++j) { acc[j][0] = 0.f; acc[j][1] = 0.f; }
#pragma unroll 2
        for (int d = 0; d < 128; ++d) { const float a0 = kkT[d * 129 + lane], a1 = kkT[d * 129 + lane + 64];
#pragma unroll
            for (int j = 0; j < 8; ++j) { const float wv = wqs[(w * 8 + j) * 128 + d]; acc[j][0] += wv * a0; acc[j][1] += wv * a1; } }
        u32x4 o0, o1;
        o0.x = pk2(acc[0][0], acc[1][0]); o0.y = pk2(acc[2][0], acc[3][0]); o0.z = pk2(acc[4][0], acc[5][0]); o0.w = pk2(acc[6][0], acc[7][0]);
        o1.x = pk2(acc[0][1], acc[1][1]); o1.y = pk2(acc[2][1], acc[3][1]); o1.z = pk2(acc[4][1], acc[5][1]); o1.w = pk2(acc[6][1], acc[7][1]);
        *(u32x4*)(WT + (size_t)(z * 128 + lane) * 1024 + kc * 64 + w * 8) = o0;
        *(u32x4*)(WT + (size_t)(z * 128 + lane + 64) * 1024 + kc * 64 + w * 8) = o1;
    }
    __syncthreads();
}

__device__ __forceinline__ void p0_tables(const Args& A, const Frame& F) {
    const int gw = F.bid * NWAVES + F.wave, NGW = F.nblk * NWAVES, lane = F.lane;
    unsigned char* TAB = F.ws + WS_TAB; float* TSC = (float*)(F.ws + WS_TSC);
    for (int it = gw; it < 4 * 16384 / 4; it += NGW) {
        const int t = it >> 12, row0 = (it & 4095) * 4;
        const float* src = (t == 0 ? A.in[I0_PU] : t == 1 ? A.in[I0_PV] : t == 2 ? A.in[I1_PU] : A.in[I1_PV]) + (size_t)row0 * 1024 + 4 * lane;
        f32x4 v[4][4];
#pragma unroll
        for (int rr = 0; rr < 4; ++rr)
#pragma unroll
            for (int j = 0; j < 4; ++j) v[rr][j] = *(const f32x4*)(src + (size_t)rr * 1024 + 256 * j);
#pragma unroll
        for (int rr = 0; rr < 4; ++rr) {
            float am = 0.f;
#pragma unroll
            for (int j = 0; j < 4; ++j) am = fmaxf(am, fmaxf(fmaxf(fabsf(v[rr][j].x), fabsf(v[rr][j].y)), fmaxf(fabsf(v[rr][j].z), fabsf(v[rr][j].w))));
            am = wave_max(am);
            const float sc = am > 0.f ? am * (1.f / 127.f) : 1.f, inv = am > 0.f ? 127.f / am : 0.f;
            const int row = row0 + rr;
#pragma unroll
            for (int j = 0; j < 4; ++j) { const unsigned b0 = (unsigned)((int)rintf(v[rr][j].x * inv)) & 0xffu, b1 = (unsigned)((int)rintf(v[rr][j].y * inv)) & 0xffu, b2 = (unsigned)((int)rintf(v[rr][j].z * inv)) & 0xffu, b3 = (unsigned)((int)rintf(v[rr][j].w * inv)) & 0xffu;
                *(unsigned*)(TAB + (((size_t)t * 8 + 2 * j + (lane >> 5)) * 16384 + row) * 128 + 4 * (lane & 31)) = b0 | (b1 << 8) | (b2 << 16) | (b3 << 24); }
            if (lane == 0) TSC[t * 16384 + row] = sc;
        }
    }
}

__device__ __forceinline__ void norm_mod_store(const f32x4 (&v)[4], float rinv, const float* g, const float* sh, const float* sc, bf16_t* orow, int lane) {
#pragma unroll
    for (int j = 0; j < 4; ++j) { const int c = 4 * lane + 256 * j;
        const f32x4 gg = *(const f32x4*)(g + c), s1 = *(const f32x4*)(sc + c), s0 = *(const f32x4*)(sh + c);
        const f32x4 y = (v[j] * rinv * gg) * (s1 + 1.f) + s0;
        u32x2 o; o.x = pk2(y.x, y.y); o.y = pk2(y.z, y.w); *(u32x2*)(orow + c) = o; }
}
__device__ __forceinline__ int tok_row(int layer, int n);
__device__ __forceinline__ void norm_row_out(const Frame& F, const f32x4 (&v)[4], float rinv, const float* g, const float* mm, int r, int which) {
    norm_mod_store(v, rinv, g, mm, mm + 1024, (bf16_t*)(F.ws + WS_H) + (size_t)r * DM, F.lane);
    if (which) {
        f32x4 y[4]; float am = 0.f;
#pragma unroll
        for (int j = 0; j < 4; ++j) { const int c = 4 * F.lane + 256 * j; y[j] = (v[j] * rinv * *(const f32x4*)(g + c)) * (*(const f32x4*)(mm + 1024 + c) + 1.f) + *(const f32x4*)(mm + c);
            am = fmaxf(am, fmaxf(fmaxf(fabsf(y[j].x), fabsf(y[j].y)), fmaxf(fabsf(y[j].z), fabsf(y[j].w)))); }
        am = wave_max(am);
        const float inv = am > 0.f ? 127.f / am : 0.f;
#pragma unroll
        for (int j = 0; j < 4; ++j) { const unsigned b0 = (unsigned)((int)rintf(y[j].x * inv)) & 0xffu, b1 = (unsigned)((int)rintf(y[j].y * inv)) & 0xffu, b2 = (unsigned)((int)rintf(y[j].z * inv)) & 0xffu, b3 = (unsigned)((int)rintf(y[j].w * inv)) & 0xffu;
            *(unsigned*)(F.ws + WS_HQ + (size_t)r * DM + 4 * F.lane + 256 * j) = b0 | (b1 << 8) | (b2 << 16) | (b3 << 24); }
        if (F.lane == 0) ((float*)(F.ws + WS_HS))[r] = am > 0.f ? am * (1.f / 127.f) : 1.f;
    }
}
__device__ __forceinline__ void p_norm_rows(const Args& A, const Frame& F, int layer, int which, bool from_input, bool skip_ctx) {
    const int gw = F.bid * NWAVES + F.wave, NGW = F.nblk * NWAVES;
    const float* g = A.in[layer ? (which ? I1_NFFN : I1_NMIX) : (which ? I0_NFFN : I0_NMIX)];
    const float* MOD = (const float*)(F.ws + WS_MOD) + (size_t)layer * 5 * 6144;
    const unsigned short* X = (const unsigned short*)(F.ws + WS_X);
    const int ntok = skip_ctx ? NB * SEQ : R;
    for (int n = gw; n < ntok; n += 2 * NGW) {
        const bool has1 = (n + NGW) < ntok;
        const int r0 = skip_ctx ? tok_row(1, n) : n, r1 = has1 ? (skip_ctx ? tok_row(1, n + NGW) : n + NGW) : r0;
        f32x4 v0[4], v1[4]; float s0 = 0.f, s1 = 0.f;
        if (from_input) { const float* x0 = xin_row(F, r0); const float* x1 = xin_row(F, r1);
#pragma unroll
            for (int j = 0; j < 4; ++j) { v0[j] = *(const f32x4*)(x0 + 4 * F.lane + 256 * j); v1[j] = *(const f32x4*)(x1 + 4 * F.lane + 256 * j); } }
        else {
#pragma unroll
            for (int j = 0; j < 4; ++j) { const u32x2 a = *(const u32x2*)(X + (size_t)r0 * DM + 4 * F.lane + 256 * j), b = *(const u32x2*)(X + (size_t)r1 * DM + 4 * F.lane + 256 * j);
                v0[j] = (f32x4){h2f_lo(a.x), h2f_hi(a.x), h2f_lo(a.y), h2f_hi(a.y)}; v1[j] = (f32x4){h2f_lo(b.x), h2f_hi(b.x), h2f_lo(b.y), h2f_hi(b.y)}; } }
#pragma unroll
        for (int j = 0; j < 4; ++j) { s0 += (v0[j].x * v0[j].x + v0[j].y * v0[j].y) + (v0[j].z * v0[j].z + v0[j].w * v0[j].w); s1 += (v1[j].x * v1[j].x + v1[j].y * v1[j].y) + (v1[j].z * v1[j].z + v1[j].w * v1[j].w); }
        const float ri0 = rsqrtf(wave_sum(s0) * (1.f / DM) + EPS), ri1 = rsqrtf(wave_sum(s1) * (1.f / DM) + EPS);
        norm_row_out(F, v0, ri0, g, MOD + (size_t)mod_index(r0) * 6144 + (which ? 3 * 1024 : 0), r0, which);
        if (has1) norm_row_out(F, v1, ri1, g, MOD + (size_t)mod_index(r1) * 6144 + (which ? 3 * 1024 : 0), r1, which);
    }
}

namespace pg8 {
#define PG8_LAS __attribute__((address_space(3)))
typedef unsigned short bf16_t;
typedef short bf16x8 __attribute__((ext_vector_type(8)));
typedef float f32x4 __attribute__((ext_vector_type(4)));
typedef unsigned u32x4 __attribute__((ext_vector_type(4)));
constexpr int BM = 256, BK = 64, HALF = 128, HTB = HALF * BK * 2  , STAGE_BYTES = 8 * HTB, NXCD = 8, WGM = 8;

__host__ __device__ __forceinline__ int lds_byte(int r, int c) { const int st = (r >> 4) * 2 + (c >> 5), rr = r & 15, cc = c & 31, ob = rr * 64 + cc * 2; return st * 1024 + (ob ^ (((ob >> 9) & 1) << 5)); }
__host__ __device__ __forceinline__ void stage_rc(int b, int& R, int& C) { const int st = b / 1024, sb = b % 1024, swz = sb ^ (((sb >> 9) & 1) << 5); R = (st >> 1) * 16 + swz / 64; C = (st & 1) * 32 + (swz % 64) / 2; }
__host__ __device__ __forceinline__ int perm32(int rho) { const int n = rho >> 4, i = rho & 15; return 8 * (i >> 2) + 4 * n + (i & 3); }

struct Unit { int pm, pn; };
struct Gemm { const bf16_t* A; const bf16_t* Bt; int M, N, K; };

struct StaticOrder {
    int nM, nN, nwg, G, c;
    __host__ __device__ void init(int M, int N, int G_, int c_) { nM = M / BM; nN = N / BM; nwg = nM * nN; G = G_; c = c_; }
    __host__ __device__ bool next(int i, Unit& u) const {
        const long L = (long)i * G + c; if (L >= nwg) return false;
        int wgid = (int)L; { const int q = nwg / NXCD, r = nwg % NXCD, xcd = wgid % NXCD, off = wgid / NXCD; wgid = (xcd < r ? xcd * (q + 1) : r * (q + 1) + (xcd - r) * q) + off; }
        const int nig = WGM * nN, gid = wgid / nig, fm = gid * WGM, gsz = (nM - fm) < WGM ? (nM - fm) : WGM;
        u.pm = fm + ((wgid % nig) % gsz); u.pn = (wgid % nig) / gsz; return true;
    }
    __device__ __forceinline__ void a_ready(const Unit&) const {}
    __device__ __forceinline__ void done(const Unit&) const {}
};

template <class Epi, class Sched, bool ALIGN_EPI = false, bool SP2 = false>
__device__ __forceinline__ void gemm_phase(PG8_LAS unsigned char* lds, const Gemm g, const Sched& S, const Epi& E) {
    const int tid = threadIdx.x, wid = __builtin_amdgcn_readfirstlane(tid >> 6), lane = tid & 63, wr = wid >> 2, wc = wid & 3, fr = lane & 15, fq = lane >> 4;
    const int K = g.K, nt = K / BK;
    unsigned voffA[2], voffB[2];
#pragma unroll
    for (int i = 0; i < 2; ++i) { int R, C; stage_rc(tid * 16 + i * 8192, R, C); const int Rb = Epi::PERM ? ((R & ~31) + perm32(R & 31)) : R;
        voffA[i] = (unsigned)(R * K + C) * 2u; voffB[i] = (unsigned)(Rb * K + C) * 2u; }
    const size_t kstep = (size_t)(BK * 2);
    const size_t hstep = (size_t)HALF * K * 2;
    const size_t tstep = 2 * hstep;
    const unsigned ldsw = (unsigned)wid * 1024u;
    const int aoff = lds_byte(wr * 64 + fr, fq * 8), boff = lds_byte(wc * 32 + fr, fq * 8);
#define PG8_SA(b, h) (((b) * 2 + (h)) * HTB)
#define PG8_SB(b, h) ((4 + (b) * 2 + (h)) * HTB)
#define PG8_STAGE(bufoff, gbase, voff) do { _Pragma("unroll") for (int _i = 0; _i < 2; ++_i) \
        __builtin_amdgcn_global_load_lds((const unsigned*)((const char*)(gbase) + (voff)[_i]), (PG8_LAS unsigned*)(lds + (bufoff) + ldsw + _i * 8192), 16, 0, 0); } while (0)
#define PG8_LDA(dst, b, h) do { _Pragma("unroll") for (int m = 0; m < 4; ++m) _Pragma("unroll") for (int k = 0; k < 2; ++k) dst[m][k] = *(const PG8_LAS bf16x8*)(lds + PG8_SA(b, h) + aoff + m * 2048 + k * 1024); } while (0)
#define PG8_LDB(dst, b, h) do { _Pragma("unroll") for (int n = 0; n < 2; ++n) _Pragma("unroll") for (int k = 0; k < 2; ++k) dst[n][k] = *(const PG8_LAS bf16x8*)(lds + PG8_SB(b, h) + boff + n * 2048 + k * 1024); } while (0)
#define PG8_MMA(ai, bj, At, Bt) do { __builtin_amdgcn_s_setprio(1); _Pragma("unroll") for (int m = 0; m < 4; ++m) _Pragma("unroll") for (int n = 0; n < 2; ++n) _Pragma("unroll") for (int k = 0; k < 2; ++k) \
        acc[ai][bj][m][n] = __builtin_amdgcn_mfma_f32_16x16x32_bf16(Bt[n][k], At[m][k], acc[ai][bj][m][n], 0, 0, 0); __builtin_amdgcn_s_setprio(0); } while (0)
#define PG8_WAIT_V(n) asm volatile("s_waitcnt vmcnt(" #n ")" ::: "memory")
#define PG8_WAIT_L(n) asm volatile("s_waitcnt lgkmcnt(" #n ")" ::: "memory")
#define PG8_BAR __builtin_amdgcn_s_barrier()
#define PG8_SCHED __builtin_amdgcn_sched_barrier(0)
    Unit cur, nxt; int ui = 0;
    if (!S.next(0, cur)) return;
    f32x4 acc[2][2][4][2];
#pragma unroll
    for (int a = 0; a < 2; ++a)
#pragma unroll
        for (int b = 0; b < 2; ++b)
#pragma unroll
            for (int m = 0; m < 4; ++m)
#pragma unroll
                for (int n = 0; n < 2; ++n) acc[a][b][m][n] = (f32x4){0.f, 0.f, 0.f, 0.f};
    bf16x8 At[4][2], B0[2][2], B1[2][2];
    const char* cA = (const char*)g.A + (size_t)cur.pm * tstep; const char* cB = (const char*)g.Bt + (size_t)cur.pn * tstep;
    S.a_ready(cur);
    if constexpr (SP2) {
        PG8_STAGE(PG8_SB(0, 0), cB, voffB); PG8_STAGE(PG8_SB(0, 1), cB + hstep, voffB); PG8_STAGE(PG8_SA(0, 0), cA, voffA); PG8_STAGE(PG8_SA(0, 1), cA + hstep, voffA);
        if (wr == 1) PG8_BAR;
        PG8_WAIT_V(2); PG8_BAR;
        PG8_STAGE(PG8_SB(1, 0), cB + kstep, voffB); PG8_STAGE(PG8_SA(1, 0), cA + kstep, voffA); PG8_STAGE(PG8_SB(1, 1), cB + hstep + kstep, voffB);
        PG8_WAIT_V(6); PG8_BAR;
    } else {
        PG8_STAGE(PG8_SB(0, 0), cB, voffB); PG8_STAGE(PG8_SA(0, 0), cA, voffA); PG8_STAGE(PG8_SB(0, 1), cB + hstep, voffB); PG8_STAGE(PG8_SA(0, 1), cA + hstep, voffA);
        if (wr == 1) PG8_BAR;
        PG8_WAIT_V(4); PG8_BAR;
        PG8_STAGE(PG8_SB(1, 0), cB + kstep, voffB); PG8_STAGE(PG8_SA(1, 0), cA + kstep, voffA); PG8_STAGE(PG8_SB(1, 1), cB + hstep + kstep, voffB);
        PG8_WAIT_V(6); PG8_BAR;
    }
    for (;;) {
        const bool has_next = S.next(ui + 1, nxt);
        const char* nA = has_next ? (const char*)g.A + (size_t)nxt.pm * tstep : cA; const char* nB = has_next ? (const char*)g.Bt + (size_t)nxt.pn * tstep : cB;
        for (int t = 0; t < nt; t += 2) {
            const bool last = (t == nt - 2);
            const char* a1 = cA + (size_t)(t + 1) * kstep;
            const char* a2 = last ? nA : cA + (size_t)(t + 2) * kstep; const char* b2 = last ? nB : cB + (size_t)(t + 2) * kstep;
            const char* a3 = a2 + kstep; const char* b3 = b2 + kstep;
            if (last && has_next) S.a_ready(nxt);
            if constexpr (SP2) {
            PG8_LDB(B0, 0, 0); PG8_LDB(B1, 0, 1); PG8_SCHED; PG8_LDA(At, 0, 0); PG8_STAGE(PG8_SA(1, 1), a1 + hstep, voffA);
            PG8_WAIT_V(8); PG8_WAIT_L(0); PG8_BAR; PG8_MMA(0, 0, At, B0); PG8_MMA(0, 1, At, B1); PG8_BAR; PG8_SCHED;
            PG8_LDA(At, 0, 1); PG8_STAGE(PG8_SB(0, 0), b2, voffB); PG8_STAGE(PG8_SB(0, 1), b2 + hstep, voffB); PG8_STAGE(PG8_SA(0, 0), a2, voffA);
            PG8_WAIT_V(8); PG8_WAIT_L(0); PG8_BAR; PG8_MMA(1, 0, At, B0); PG8_MMA(1, 1, At, B1); PG8_BAR; PG8_SCHED;
            PG8_LDB(B0, 1, 0); PG8_LDB(B1, 1, 1); PG8_SCHED; PG8_LDA(At, 1, 0); PG8_STAGE(PG8_SA(0, 1), a2 + hstep, voffA);
            PG8_WAIT_V(8); PG8_WAIT_L(0); PG8_BAR; PG8_MMA(0, 0, At, B0); PG8_MMA(0, 1, At, B1); PG8_BAR; PG8_SCHED;
            PG8_LDA(At, 1, 1); PG8_STAGE(PG8_SB(1, 0), b3, voffB); PG8_STAGE(PG8_SB(1, 1), b3 + hstep, voffB); PG8_STAGE(PG8_SA(1, 0), a3, voffA);
            PG8_WAIT_V(8); PG8_WAIT_L(0); PG8_BAR; PG8_MMA(1, 0, At, B0); PG8_MMA(1, 1, At, B1); PG8_BAR; PG8_SCHED;
            } else {
            PG8_LDB(B0, 0, 0); PG8_SCHED; PG8_LDA(At, 0, 0); PG8_STAGE(PG8_SA(1, 1), a1 + hstep, voffA);
            PG8_WAIT_L(8); PG8_BAR; PG8_WAIT_L(0); PG8_MMA(0, 0, At, B0); PG8_BAR; PG8_SCHED;
            PG8_LDB(B1, 0, 1); PG8_STAGE(PG8_SB(0, 0), b2, voffB);
            PG8_BAR; PG8_WAIT_L(0); PG8_MMA(0, 1, At, B1); PG8_BAR;
            PG8_LDA(At, 0, 1); PG8_STAGE(PG8_SA(0, 0), a2, voffA);
            PG8_BAR; PG8_WAIT_L(0); PG8_MMA(1, 0, At, B0); PG8_BAR; PG8_SCHED;
            PG8_STAGE(PG8_SB(0, 1), b2 + hstep, voffB);
            PG8_WAIT_V(6); PG8_BAR; PG8_MMA(1, 1, At, B1); PG8_BAR;
            PG8_LDB(B0, 1, 0); PG8_SCHED; PG8_LDA(At, 1, 0); PG8_STAGE(PG8_SA(0, 1), a2 + hstep, voffA);
            PG8_WAIT_L(8); PG8_BAR; PG8_WAIT_L(0); PG8_MMA(0, 0, At, B0); PG8_BAR; PG8_SCHED;
            PG8_LDB(B1, 1, 1); PG8_STAGE(PG8_SB(1, 0), b3, voffB);
            PG8_BAR; PG8_WAIT_L(0); PG8_MMA(0, 1, At, B1); PG8_BAR;
            PG8_LDA(At, 1, 1); PG8_STAGE(PG8_SA(1, 0), a3, voffA);
            PG8_BAR; PG8_WAIT_L(0); PG8_MMA(1, 0, At, B0); PG8_BAR; PG8_SCHED;
            PG8_STAGE(PG8_SB(1, 1), b3 + hstep, voffB);
            PG8_WAIT_V(6); PG8_BAR; PG8_MMA(1, 1, At, B1); PG8_BAR;
            }
        }
        if constexpr (ALIGN_EPI) { if (wr == 0) PG8_BAR; }
        if constexpr (!Epi::AFTER_DRAIN) { E(acc, cur, wr, wc, fr, fq); S.done(cur); }
        if (!has_next) break;
#pragma unroll
        for (int a = 0; a < 2; ++a)
#pragma unroll
            for (int b = 0; b < 2; ++b)
#pragma unroll
                for (int m = 0; m < 4; ++m)
#pragma unroll
                    for (int n = 0; n < 2; ++n) acc[a][b][m][n] = (f32x4){0.f, 0.f, 0.f, 0.f};
        cur = nxt; cA = nA; cB = nB; ++ui;
        if constexpr (ALIGN_EPI) { if (wr == 1) PG8_BAR; }
    }
    PG8_WAIT_V(0);
    if constexpr (!ALIGN_EPI) { if (wr == 0) PG8_BAR; }
    PG8_BAR;
    if constexpr (Epi::AFTER_DRAIN) { E.fused(acc, cur, wr, wc, fr, fq, lds, wid, lane); S.done(cur); }
#undef PG8_SA
#undef PG8_SB
#undef PG8_STAGE
#undef PG8_LDA
#undef PG8_LDB
#undef PG8_MMA
#undef PG8_WAIT_V
#undef PG8_WAIT_L
#undef PG8_BAR
#undef PG8_SCHED
}
}

template <class Inner> struct EpiTile { static constexpr bool PERM = true, AFTER_DRAIN = false; Inner in;
    __device__ __forceinline__ void operator()(const pg8::f32x4 (&acc)[2][2][4][2], const pg8::Unit& u, int wr, int wc, int fr, int fq) const {
#pragma unroll
        for (int ai = 0; ai < 2; ++ai)
#pragma unroll
            for (int m = 0; m < 4; ++m) { const int row = u.pm * 256 + ai * 128 + wr * 64 + m * 16 + fr;
#pragma unroll
                for (int bj = 0; bj < 2; ++bj) in(row, u.pn * 256 + bj * 128 + wc * 32 + 8 * fq, acc[ai][bj][m][0], acc[ai][bj][m][1]); }
    } };
struct In8Bf16 { bf16_t* C; int ldc;
    __device__ __forceinline__ void operator()(int row, int col, f32x4 a, f32x4 b) const { u32x4 o; o.x = cvtpk(a.x, a.y); o.y = cvtpk(a.z, a.w); o.z = cvtpk(b.x, b.y); o.w = cvtpk(b.z, b.w); *(u32x4*)(C + (size_t)row * ldc + col) = o; } };
struct In8KV { bf16_t* Kb; bf16_t* Vb;
    __device__ __forceinline__ void operator()(int row, int col, f32x4 a, f32x4 b) const { const int h = col >> 8, c = col & 255; u32x4 o; o.x = cvtpk(a.x, a.y); o.y = cvtpk(a.z, a.w); o.z = cvtpk(b.x, b.y); o.w = cvtpk(b.z, b.w);
        bf16_t* p = (c < 128) ? Kb + (size_t)row * 1536 + h * 192 + c : Vb + (size_t)row * 1024 + h * 128 + (c - 128);
        *(u32x4*)p = o; } };
struct In8F16 { unsigned short* C; int ldc;
    __device__ __forceinline__ void operator()(int row, int col, f32x4 a, f32x4 b) const { u32x4 o; o.x = pkh2(a.x, a.y); o.y = pkh2(a.z, a.w); o.z = pkh2(b.x, b.y); o.w = pkh2(b.z, b.w); *(u32x4*)(C + (size_t)row * ldc + col) = o; } };
struct In8F32 { float* C; int ldc;
    __device__ __forceinline__ void operator()(int row, int col, f32x4 a, f32x4 b) const { float* p = C + (size_t)row * ldc + col; *(f32x4*)p = a; *(f32x4*)(p + 4) = b; } };
struct In8Resid { const float* x; const float* ctx; unsigned short* X; const float* gate; bool from_input;
    __device__ __forceinline__ void operator()(int row, int col, f32x4 a, f32x4 b) const {
        const int bb = row / RPB, j = row - bb * RPB; unsigned short* xo = X + (size_t)row * DM + col;
        f32x4 x0, x1;
        if (from_input) { const float* xi = ((j < CTXL) ? ctx + ((size_t)bb * CTXL + j) * DM : x + ((size_t)bb * SEQ + (j - CTXL)) * DM) + col; x0 = *(const f32x4*)xi; x1 = *(const f32x4*)(xi + 4); }
        else { const u32x4 w = *(const u32x4*)xo; x0 = (f32x4){h2f_lo(w.x), h2f_hi(w.x), h2f_lo(w.y), h2f_hi(w.y)}; x1 = (f32x4){h2f_lo(w.z), h2f_hi(w.z), h2f_lo(w.w), h2f_hi(w.w)}; }
        const float* g = gate + (size_t)((j < CTXL) ? 4 : bb) * 6144 + col;
        x0 += *(const f32x4*)g * a; x1 += *(const f32x4*)(g + 4) * b;
        u32x4 o; o.x = pkh2(x0.x, x0.y); o.y = pkh2(x0.z, x0.w); o.z = pkh2(x1.x, x1.y); o.w = pkh2(x1.z, x1.w); *(u32x4*)xo = o; } };
struct EpiMlaDown { static constexpr bool PERM = true, AFTER_DRAIN = false; bf16_t* CQ; bf16_t* CKV; bf16_t* KR; float* SSP;
    __device__ __forceinline__ void operator()(const pg8::f32x4 (&acc)[2][2][4][2], const pg8::Unit& u, int wr, int wc, int fr, int fq) const {
#pragma unroll
        for (int ai = 0; ai < 2; ++ai)
#pragma unroll
            for (int m = 0; m < 4; ++m) { const int row = u.pm * 256 + ai * 128 + wr * 64 + m * 16 + fr;
#pragma unroll
                for (int bj = 0; bj < 2; ++bj) { const int col = u.pn * 256 + bj * 128 + wc * 32 + 8 * fq; const f32x4 a = acc[ai][bj][m][0], b = acc[ai][bj][m][1];
                    u32x4 o; o.x = cvtpk(a.x, a.y); o.y = cvtpk(a.z, a.w); o.z = cvtpk(b.x, b.y); o.w = cvtpk(b.z, b.w);
                    const int cls = (u.pn * 2 + bj);
                    if (cls < 5) { float sq = (a.x * a.x + a.y * a.y) + (a.z * a.z + a.w * a.w) + (b.x * b.x + b.y * b.y) + (b.z * b.z + b.w * b.w);
                        sq += __shfl_xor(sq, 16); sq += __shfl_xor(sq, 32);
                        if (cls < 3) *(u32x4*)(CQ + (size_t)row * 384 + col) = o; else *(u32x4*)(CKV + (size_t)row * 256 + (col - 384)) = o;
                        if (fq == 0) SSP[(size_t)row * 24 + cls * 4 + wc] = sq; }
                    else if (col < 704) *(u32x4*)(KR + (size_t)row * 64 + (col - 640)) = o; } }
    } };
struct In8Bf16Rs { bf16_t* C; int ldc; const float* ssp;
    __device__ __forceinline__ void operator()(int row, int col, f32x4 a, f32x4 b) const { const f32x4 s0 = *(const f32x4*)(ssp + (size_t)row * 24), s1 = *(const f32x4*)(ssp + (size_t)row * 24 + 4), s2 = *(const f32x4*)(ssp + (size_t)row * 24 + 8);
        const float ssum = (((s0.x + s0.y) + (s0.z + s0.w)) + ((s1.x + s1.y) + (s1.z + s1.w))) + ((s2.x + s2.y) + (s2.z + s2.w));
        const float rs = rsqrtf(ssum * (1.f / 384.f) + EPS); a *= rs; b *= rs;
        u32x4 o; o.x = cvtpk(a.x, a.y); o.y = cvtpk(a.z, a.w); o.z = cvtpk(b.x, b.y); o.w = cvtpk(b.z, b.w); *(u32x4*)(C + (size_t)row * ldc + col) = o; } };
struct In8KVRs { bf16_t* Kb; bf16_t* Vb; const float* ssp;
    __device__ __forceinline__ void operator()(int row, int col, f32x4 a, f32x4 b) const { const f32x4 s0 = *(const f32x4*)(ssp + (size_t)row * 24 + 12), s1 = *(const f32x4*)(ssp + (size_t)row * 24 + 16);
        const float ssum = ((s0.x + s0.y) + (s0.z + s0.w)) + ((s1.x + s1.y) + (s1.z + s1.w));
        const float rs = rsqrtf(ssum * (1.f / 256.f) + EPS); a *= rs; b *= rs;
        const int h = col >> 8, c = col & 255; u32x4 o; o.x = cvtpk(a.x, a.y); o.y = cvtpk(a.z, a.w); o.z = cvtpk(b.x, b.y); o.w = cvtpk(b.z, b.w);
        bf16_t* p = (c < 128) ? Kb + (size_t)row * 1536 + h * 192 + c : Vb + (size_t)row * 1024 + h * 128 + (c - 128);
        *(u32x4*)p = o; } };
struct RowSched { pg8::StaticOrder so; bool latent_only;
    __device__ __forceinline__ void init(int N, int G, int c, bool lat) { latent_only = lat; so.init(lat ? NB * SEQ : R, N, G, c); }
    __device__ __forceinline__ bool next(int i, pg8::Unit& u) const { if (!so.next(i, u)) return false; if (latent_only) u.pm = (u.pm >> 4) * 17 + 1 + (u.pm & 15); return true; }
    __device__ __forceinline__ void a_ready(const pg8::Unit&) const {}
    __device__ __forceinline__ void done(const pg8::Unit&) const {} };
template <class Inner> __device__ __forceinline__ void gemm8(const Frame& F, const bf16_t* Ap, const bf16_t* Bt, int N, int K, bool latent_only, const Inner& in) {
    asm volatile("" : "+s"(K));
    pg8::Gemm g{Ap, Bt, R, N, K}; RowSched S; S.init(N, F.nblk, F.bid, latent_only);
    EpiTile<Inner> E{in};
    pg8::gemm_phase<EpiTile<Inner>, RowSched, true, true>((PG8_LAS unsigned char*)F.lds, g, S, E);
}

template <class Epi> __device__ __forceinline__ void gemm8e(const Frame& F, const bf16_t* Ap, const bf16_t* Bt, int N, int K, bool latent_only, const Epi& E) {
    asm volatile("" : "+s"(K));
    pg8::Gemm g{Ap, Bt, R, N, K}; RowSched S; S.init(N, F.nblk, F.bid, latent_only);
    pg8::gemm_phase<Epi, RowSched, true, true>((PG8_LAS unsigned char*)F.lds, g, S, E);
}

struct GemmDesc { const bf16_t* A; int lda; long sA; const bf16_t* Bt; int ldb; long sB; int M, N, K, nz; };
template <class Epi>
__device__ __forceinline__ void gemm_simple(const Frame& F, const GemmDesc& g, const Epi& epi, bool skip_ctx) {
    const int wm = F.wave >> 1, wn = F.wave & 1, fr = F.lane & 15, fq = F.lane >> 4;
    const int tM = g.M / 128, tN = g.N / 128, per = tM * tN, total = per * g.nz;
    for (int u = F.bid; u < total; u += F.nblk) {
        const int z = u / per, uu = u - z * per, tm = uu / tN, tn = uu - tm * tN;
        if (skip_ctx && ((tm * 128) % RPB) < CTXL) continue;
        const int row0 = tm * 128 + wm * 32, col0 = tn * 128 + wn * 64;
        const bf16_t* ap = g.A + z * g.sA + (size_t)(row0 + fr) * g.lda + fq * 8;
        const bf16_t* bp = g.Bt + z * g.sB + (size_t)(col0 + fr) * g.ldb + fq * 8;
        f32x4 acc[2][4];
#pragma unroll
        for (int mi = 0; mi < 2; ++mi)
#pragma unroll
            for (int ni = 0; ni < 4; ++ni) acc[mi][ni] = (f32x4){0.f, 0.f, 0.f, 0.f};
        for (int k0 = 0; k0 < g.K; k0 += 32) {
            bf16x8 a[2], b[4];
#pragma unroll
            for (int mi = 0; mi < 2; ++mi) a[mi] = *(const bf16x8*)(ap + (size_t)mi * 16 * g.lda + k0);
#pragma unroll
            for (int ni = 0; ni < 4; ++ni) b[ni] = *(const bf16x8*)(bp + (size_t)ni * 16 * g.ldb + k0);
#pragma unroll
            for (int mi = 0; mi < 2; ++mi)
#pragma unroll
                for (int ni = 0; ni < 4; ++ni) acc[mi][ni] = __builtin_amdgcn_mfma_f32_16x16x32_bf16(b[ni], a[mi], acc[mi][ni], 0, 0, 0);
        }
#pragma unroll
        for (int mi = 0; mi < 2; ++mi)
#pragma unroll
            for (int ni = 0; ni < 4; ++ni) epi(z, row0 + mi * 16 + fr, col0 + ni * 16 + fq * 4, acc[mi][ni]);
    }
}
struct EpiBf16 { bf16_t* C; int ldc;
    __device__ __forceinline__ void operator()(int, int row, int col, f32x4 v) const { u32x2 o; o.x = pk2(v.x, v.y); o.y = pk2(v.z, v.w); *(u32x2*)(C + (size_t)row * ldc + col) = o; } };
struct EpiKV { bf16_t* Kb; bf16_t* Vb;
    __device__ __forceinline__ void operator()(int, int row, int col, f32x4 v) const { const int h = col >> 8, c = col & 255; u32x2 o; o.x = pk2(v.x, v.y); o.y = pk2(v.z, v.w);
        if (c < 128) *(u32x2*)(Kb + (size_t)row * 1536 + h * 192 + c) = o; else *(u32x2*)(Vb + (size_t)row * 1024 + h * 128 + (c - 128)) = o; } };
struct EpiF32Z { float* C; int ldc;
    __device__ __forceinline__ void operator()(int z, int row, int col, f32x4 v) const { *(f32x4*)(C + (size_t)row * ldc + z * 128 + col) = v; } };
struct EpiResid { const Frame* F; const float* gate; bool from_input;
    __device__ __forceinline__ void operator()(int, int row, int col, f32x4 v) const {
        float* X = (float*)(F->ws + WS_X) + (size_t)row * DM + col;
        const float* xi = from_input ? xin_row(*F, row) + col : X;
        const f32x4 g = *(const f32x4*)(gate + (size_t)mod_index(row) * 6144 + col);
        *(f32x4*)X = *(const f32x4*)xi + g * v; } };

__device__ __forceinline__ void rope_angles(int r, int& prow, int& pcol) { const int t = (r % RPB) - CTXL; prow = t >> 6; pcol = t & 63; }
__device__ __forceinline__ void p_mla_krope(const Args& A, const Frame& F) {
    const int gw = F.bid * NWAVES + F.wave, NGW = F.nblk * NWAVES, lane = F.lane;
    const bf16_t* KR = (const bf16_t*)(F.ws + WS_KR); bf16_t* Kb = (bf16_t*)(F.ws + WS_K);
    const float invf = __powf(10000.f, -(float)(lane & 15) * (1.f / 16.f));
    for (int r = gw; r < R; r += NGW) {
        float kr = bf2f(KR[(size_t)r * 64 + lane]);
        if (!is_ctx_row(r)) {
            int prow, pcol; rope_angles(r, prow, pcol);
            const float ang = (float)((lane & 32) ? pcol : prow) * invf;
            const float cs = cosf(ang), sn = sinf(ang);
            const float partner = __shfl_xor(kr, 16);
            kr = kr * cs + ((lane & 16) ? partner : -partner) * sn;
        }
        const bf16_t kb = (bf16_t)f2bf(kr);
#pragma unroll
        for (int h = 0; h < 8; ++h) Kb[(size_t)r * 1536 + h * 192 + 128 + lane] = kb;
    }
}
__device__ __forceinline__ float row16_sum(float v) { v += WDPP(v, 0xB1); v += WDPP(v, 0x4E); v += WDPP(v, 0x141); v += WDPP(v, 0x140); return v; }
__device__ __forceinline__ void p_gqa_rows(const Args& A, const Frame& F) {
    const int gw = F.bid * NWAVES + F.wave, NGW = F.nblk * NWAVES, lane = F.lane, c16 = lane & 15, hrow = lane >> 4;
    const bf16_t* RAW = (const bf16_t*)(F.ws + WS_RAW1); bf16_t* Q1 = (bf16_t*)(F.ws + WS_Q1); bf16_t* K1 = (bf16_t*)(F.ws + WS_K1); bf16_t* V1 = (bf16_t*)(F.ws + WS_V1);
    float qg[8], kg[8], invf[8];
#pragma unroll
    for (int e = 0; e < 8; ++e) { qg[e] = A.in[I1_QN][8 * c16 + e]; kg[e] = A.in[I1_KN][8 * c16 + e]; invf[e] = __powf(10000.f, -(float)(8 * (c16 & 3) + e) * (1.f / 32.f)); }
    const bool colaxis = (c16 & 8) != 0, hi32 = (c16 & 4) != 0;
    for (int r = gw; r < R; r += NGW) {
        const bool ctx = is_ctx_row(r);
        const bf16_t* a = RAW + (size_t)r * 1536 + 8 * lane;
        u32x4 ch[3];
#pragma unroll
        for (int j = 0; j < 3; ++j) ch[j] = (ctx && j < 2) ? (u32x4){0u, 0u, 0u, 0u} : *(const u32x4*)(a + 512 * j);
        float cs[8], sn[8];
        { int prow = 0, pcol = 0; if (!ctx) rope_angles(r, prow, pcol); const float pos = (float)(colaxis ? pcol : prow);
#pragma unroll
          for (int e = 0; e < 8; ++e) { const float ang = pos * invf[e]; cs[e] = ctx ? 1.f : __cosf(ang); sn[e] = ctx ? 0.f : __sinf(ang); } }
#pragma unroll
        for (int j = 0; j < 3; ++j) {
            if (ctx && j < 2) continue;
            const bool isv = (j == 2) && (hrow >= 2);
            float x[8];
#pragma unroll
            for (int d = 0; d < 4; ++d) { x[2 * d] = bflo(ch[j][d]); x[2 * d + 1] = bfhi(ch[j][d]); }
            float sq = 0.f;
#pragma unroll
            for (int e = 0; e < 8; ++e) sq += x[e] * x[e];
            const float rinv = rsqrtf(row16_sum(sq) * (1.f / 128.f) + EPS);
            u32x4 o;
            float y[8];
#pragma unroll
            for (int e = 0; e < 8; ++e) y[e] = x[e] * rinv * (j < 2 ? qg[e] : kg[e]);
            u32x4 yp; yp.x = pk2(y[0], y[1]); yp.y = pk2(y[2], y[3]); yp.z = pk2(y[4], y[5]); yp.w = pk2(y[6], y[7]);
            float pr[8];
#pragma unroll
            for (int d = 0; d < 4; ++d) { const float lo = __shfl_xor(y[2 * d], 4), hi2 = __shfl_xor(y[2 * d + 1], 4); pr[2 * d] = lo; pr[2 * d + 1] = hi2; }
            float z[8];
#pragma unroll
            for (int e = 0; e < 8; ++e) z[e] = y[e] * cs[e] + (hi32 ? pr[e] : -pr[e]) * sn[e];
            o.x = pk2(z[0], z[1]); o.y = pk2(z[2], z[3]); o.z = pk2(z[4], z[5]); o.w = pk2(z[6], z[7]);
            (void)yp;
            if (isv) o = ch[j];
            if (j < 2) *(u32x4*)(Q1 + (size_t)r * 1024 + 512 * j + 8 * lane) = o;
            else { bf16_t* dst = (hrow < 2) ? K1 + (size_t)r * 256 + 8 * lane : V1 + (size_t)r * 256 + 8 * (lane - 32); *(u32x4*)dst = o; }
        }
    }
}

__device__ __forceinline__ int crow(int r, int hi) { return (r & 3) + 8 * (r >> 2) + 4 * hi; }
__device__ __forceinline__ int v_st(int k, int c) { const int kk = (k & ~0xC) | ((k & 4) << 1) | ((k & 8) >> 1); return ((kk >> 3) * 4 + (c >> 5)) * 512 + ((kk & 7) * 32 + (c & 31)) * 2; }
__device__ __forceinline__ int v_rd_base(int lane) { return ((lane & 3) << 3) | (((lane >> 2) & 3) << 6) | (((lane >> 4) & 1) << 5) | (((lane >> 5) & 1) << 8); }
constexpr int v_rd_off(int d0, int ks, int half) { return d0 * 512 + ks * 4096 + half * 2048; }
template <int OFF> __device__ __forceinline__ s16x4 tr_read(int vb) { s16x4 r; asm volatile("ds_read_b64_tr_b16 %0, %1 offset:%2" : "=&v"(r) : "v"(vb), "i"(OFF) : "memory"); return r; }
template <int D0> __device__ __forceinline__ void pv_one(f32x16& od, int vb, bf16x8 pa0, bf16x8 pa1, bf16x8 pa2, bf16x8 pa3) {
    const s16x4 l0 = tr_read<v_rd_off(D0, 0, 0)>(vb), h0 = tr_read<v_rd_off(D0, 0, 1)>(vb), l1 = tr_read<v_rd_off(D0, 1, 0)>(vb), h1 = tr_read<v_rd_off(D0, 1, 1)>(vb);
    const s16x4 l2 = tr_read<v_rd_off(D0, 2, 0)>(vb), h2 = tr_read<v_rd_off(D0, 2, 1)>(vb), l3 = tr_read<v_rd_off(D0, 3, 0)>(vb), h3 = tr_read<v_rd_off(D0, 3, 1)>(vb);
    asm volatile("s_waitcnt lgkmcnt(0)" ::: "memory"); SBAR();
#define PK(L, H) (bf16x8){L[0], L[1], L[2], L[3], H[0], H[1], H[2], H[3]}
    od = __builtin_amdgcn_mfma_f32_32x32x16_bf16(pa0, PK(l0, h0), od, 0, 0, 0);
    od = __builtin_amdgcn_mfma_f32_32x32x16_bf16(pa1, PK(l1, h1), od, 0, 0, 0);
    od = __builtin_amdgcn_mfma_f32_32x32x16_bf16(pa2, PK(l2, h2), od, 0, 0, 0);
    od = __builtin_amdgcn_mfma_f32_32x32x16_bf16(pa3, PK(l3, h3), od, 0, 0, 0);
#undef PK
}
__device__ __forceinline__ void pv_d0(f32x16* o, int vb, bf16x8 pa0, bf16x8 pa1, bf16x8 pa2, bf16x8 pa3) {
    pv_one<0>(o[0], vb, pa0, pa1, pa2, pa3); pv_one<1>(o[1], vb, pa0, pa1, pa2, pa3); pv_one<2>(o[2], vb, pa0, pa1, pa2, pa3); pv_one<3>(o[3], vb, pa0, pa1, pa2, pa3);
}
constexpr float ATT_THR = 8.f;
__device__ __forceinline__ void partialSM(f32x16& p0, f32x16& p1, float& m_reg, float& mn, float& alpha, float C, float thr_raw) {
    float pmax = p0[0];
#pragma unroll
    for (int r = 1; r < 16; ++r) pmax = fmaxf(pmax, p0[r]);
#pragma unroll
    for (int r = 0; r < 16; ++r) pmax = fmaxf(pmax, p1[r]);
    { auto rr = __builtin_amdgcn_permlane32_swap(__float_as_uint(pmax), __float_as_uint(pmax), false, false);
      pmax = fmaxf(__uint_as_float(rr[0]), __uint_as_float(rr[1])); }
    if (__builtin_expect(__all(pmax - m_reg <= thr_raw), 1)) { mn = m_reg; alpha = 1.f; }
    else { mn = fmaxf(m_reg, pmax); alpha = __builtin_amdgcn_exp2f((m_reg - mn) * C); m_reg = mn; }
    const float mnC = -mn * C;
#pragma unroll
    for (int r = 0; r < 16; ++r) p0[r] = fmaf(p0[r], C, mnC);
#pragma unroll
    for (int r = 0; r < 16; ++r) p1[r] = fmaf(p1[r], C, mnC);
#pragma unroll
    for (int r = 0; r < 16; ++r) p0[r] = __builtin_amdgcn_exp2f(p0[r]);
}
__device__ __forceinline__ void finishSM(f32x16& p0, f32x16& p1, float alpha, float& l_reg, bf16x8& pa0, bf16x8& pa1, bf16x8& pa2, bf16x8& pa3) {
#pragma unroll
    for (int r = 0; r < 16; ++r) p1[r] = __builtin_amdgcn_exp2f(p1[r]);
    float ps = 0;
#pragma unroll
    for (int r = 0; r < 16; ++r) ps += p0[r];
#pragma unroll
    for (int r = 0; r < 16; ++r) ps += p1[r];
    { auto rr = __builtin_amdgcn_permlane32_swap(__float_as_uint(ps), __float_as_uint(ps), false, false);
      ps = __uint_as_float(rr[0]) + __uint_as_float(rr[1]); }
    l_reg = l_reg * alpha + ps;
#define PK4(P, BASE, OUT) do { unsigned a0 = cvtpk(P[BASE + 0], P[BASE + 1]), a1 = cvtpk(P[BASE + 2], P[BASE + 3]);   \
    unsigned b0 = cvtpk(P[BASE + 4], P[BASE + 5]), b1 = cvtpk(P[BASE + 6], P[BASE + 7]);                              \
    auto r0 = __builtin_amdgcn_permlane32_swap(a0, b0, false, false); auto r1 = __builtin_amdgcn_permlane32_swap(a1, b1, false, false); \
    u32x4 w = {r0[0], r1[0], r0[1], r1[1]}; OUT = *reinterpret_cast<bf16x8*>(&w); } while (0)
    PK4(p0, 0, pa0); PK4(p0, 8, pa1); PK4(p1, 0, pa2); PK4(p1, 8, pa3);
#undef PK4
}
template <int DQK> __device__ __forceinline__ void qkt(f32x16& p0, f32x16& p1, const char* Ks, const bf16x8* qr, int r32, int hi) {
    constexpr int KP = DQK * 2 + 16;
    p0 = f32x16{}; p1 = f32x16{};
#pragma unroll
    for (int d0 = 0; d0 < DQK / 16; ++d0) { const int cb = (d0 * 16 + hi * 8) * 2;
        const bf16x8 b0 = *reinterpret_cast<const bf16x8*>(Ks + r32 * KP + cb);
        const bf16x8 b1 = *reinterpret_cast<const bf16x8*>(Ks + (32 + r32) * KP + cb);
        p0 = __builtin_amdgcn_mfma_f32_32x32x16_bf16(b0, qr[d0], p0, 0, 0, 0);
        p1 = __builtin_amdgcn_mfma_f32_32x32x16_bf16(b1, qr[d0], p1, 0, 0, 0); }
}
template <int DQK> constexpr int att_lds_bytes() { return 2 * 64 * 128 * 2 + 2 * 64 * (DQK * 2 + 16) + NWAVES * 64 * 4; }
template <int DQK, int LDQ, int LDK, int LDV, int LDO>
__device__ __forceinline__ void attn_body(const bf16_t* __restrict__ Qb, const bf16_t* __restrict__ Kh, const bf16_t* __restrict__ Vh, bf16_t* __restrict__ Ob, int seq, float scale, char* lds) {
    constexpr int KP = DQK * 2 + 16, SHM_V = 64 * 128 * 2, SHM_K = 64 * KP, ND = DQK / 16, CH = DQK / 8, NKL = CH * 64 / NTHREADS;
    const float C = scale * 1.4426950408889634f, thr_raw = ATT_THR / scale;
    const int tid = threadIdx.x, wid = tid >> 6, lane = tid & 63, r32 = lane & 31, hi = lane >> 5;
    char* V_lds = lds; char* K_lds = lds + 2 * SHM_V;
    float* wsf = (float*)(lds + 2 * SHM_V + 2 * SHM_K) + wid * 64; float* li_l = wsf; float* al_l = wsf + 32;
    float m_reg = -1e30f, l_reg = 0; f32x16 o[4] = {}; bf16x8 qr[ND];
    const bf16_t* Qw = Qb + (long)(wid * 32 + r32) * LDQ + hi * 8;
#pragma unroll
    for (int d0 = 0; d0 < ND; ++d0) qr[d0] = *reinterpret_cast<const bf16x8*>(Qw + d0 * 16);
    const int sr = tid >> 4, sc = (tid & 15) * 8, vst0 = v_st(sr, sc), vst1 = v_st(32 + sr, sc);
    static_assert(DQK == 128, "double-pipelined body: 128-wide q.k only");
    const int vb0 = (int)(uintptr_t)V_lds + v_rd_base(lane);
    bf16x8 vs0, vs1, ks[NKL];
#define SLOAD(k0) do { vs0 = *reinterpret_cast<const bf16x8*>(&Vh[(long)((k0) + sr) * LDV + sc]); vs1 = *reinterpret_cast<const bf16x8*>(&Vh[(long)((k0) + 32 + sr) * LDV + sc]); \
    _Pragma("unroll") for (int i_ = 0; i_ < NKL; ++i_) ks[i_] = *reinterpret_cast<const bf16x8*>(&Kh[(long)((k0) + sr + 32 * i_) * LDK + sc]); } while (0)
#define SWRITE(b) do { *(bf16x8*)(V_lds + (b) * SHM_V + vst0) = vs0; *(bf16x8*)(V_lds + (b) * SHM_V + vst1) = vs1; \
    _Pragma("unroll") for (int i_ = 0; i_ < NKL; ++i_) *(bf16x8*)(K_lds + (b) * SHM_K + (sr + 32 * i_) * KP + sc * 2) = ks[i_]; } while (0)
#define RESC(a) do { if (__any((a) < 1.f)) { if (hi == 0) al_l[r32] = (a); asm volatile("s_waitcnt lgkmcnt(0)" ::: "memory"); \
    _Pragma("unroll") for (int d = 0; d < 4; ++d) _Pragma("unroll") for (int r = 0; r < 16; ++r) o[d][r] *= al_l[crow(r, hi)]; } } while (0)
    f32x16 pA0, pA1, pB0, pB1; float mnA, mnB, alA, alB; bf16x8 pa0, pa1, pa2, pa3; const int NT = seq / 64;
    SLOAD(0); asm volatile("s_waitcnt vmcnt(0)" ::: "memory"); SWRITE(0); __syncthreads();
    qkt<DQK>(pA0, pA1, K_lds, qr, r32, hi); partialSM(pA0, pA1, m_reg, mnA, alA, C, thr_raw);
    SLOAD(64);
    asm volatile("s_waitcnt vmcnt(0)" ::: "memory"); SWRITE(1); __syncthreads();
    for (int j = 1; j + 1 < NT; j += 2) {
        SBAR(); qkt<DQK>(pB0, pB1, K_lds + SHM_K, qr, r32, hi);
        finishSM(pA0, pA1, alA, l_reg, pa0, pa1, pa2, pa3); SBAR();
        SLOAD((j + 1) * 64); SBAR();
        pv_d0(o, vb0, pa0, pa1, pa2, pa3); partialSM(pB0, pB1, m_reg, mnB, alB, C, thr_raw);
        __syncthreads(); asm volatile("s_waitcnt vmcnt(0)" ::: "memory"); SWRITE(0);
        RESC(alB); __syncthreads();
        SBAR(); qkt<DQK>(pA0, pA1, K_lds, qr, r32, hi);
        finishSM(pB0, pB1, alB, l_reg, pa0, pa1, pa2, pa3); SBAR();
        SLOAD((j + 2) * 64); SBAR();
        pv_d0(o, vb0 + SHM_V, pa0, pa1, pa2, pa3); partialSM(pA0, pA1, m_reg, mnA, alA, C, thr_raw);
        __syncthreads(); asm volatile("s_waitcnt vmcnt(0)" ::: "memory"); SWRITE(1);
        RESC(alA); __syncthreads();
    }
    SBAR(); qkt<DQK>(pB0, pB1, K_lds + SHM_K, qr, r32, hi);
    finishSM(pA0, pA1, alA, l_reg, pa0, pa1, pa2, pa3); SBAR();
    pv_d0(o, vb0, pa0, pa1, pa2, pa3); partialSM(pB0, pB1, m_reg, mnB, alB, C, thr_raw);
    __syncthreads(); RESC(alB);
    finishSM(pB0, pB1, alB, l_reg, pa0, pa1, pa2, pa3); SBAR();
    pv_d0(o, vb0 + SHM_V, pa0, pa1, pa2, pa3);
    if (hi == 0) li_l[r32] = l_reg; asm volatile("s_waitcnt lgkmcnt(0)" ::: "memory");
    float rli[16];
#pragma unroll
    for (int r = 0; r < 16; ++r) rli[r] = __builtin_amdgcn_rcpf(li_l[crow(r, hi)]);
    bf16_t* Ow = Ob + (long)(wid * 32) * LDO;
#pragma unroll
    for (int r = 0; r < 16; ++r) { const int orow = crow(r, hi);
#pragma unroll
        for (int d0 = 0; d0 < 4; ++d0) Ow[(long)orow * LDO + d0 * 32 + r32] = (bf16_t)f2bf(o[d0][r] * rli[r]); }
    __syncthreads();
#undef SLOAD
#undef SWRITE
#undef RESC
}
template <int DQK, int LDQ, int LDK, int LDV, int LDO>
__device__ __forceinline__ void attn_body_single(const bf16_t* __restrict__ Qb, const bf16_t* __restrict__ Kh, const bf16_t* __restrict__ Vh, bf16_t* __restrict__ Ob, int seq, float scale, char* lds, int rope_t0) {
    constexpr int KP = DQK * 2 + 16, SHM_V = 64 * 128 * 2, SHM_K = 64 * KP, ND = DQK / 16, CH = DQK / 8, NKL = CH * 64 / NTHREADS;
    const float C = scale * 1.4426950408889634f, thr_raw = ATT_THR / scale;
    const int tid = threadIdx.x, wid = tid >> 6, lane = tid & 63, r32 = lane & 31, hi = lane >> 5;
    char* V_lds = lds; char* K_lds = lds + 2 * SHM_V;
    float* wsf = (float*)(lds + 2 * SHM_V + 2 * SHM_K) + wid * 64; float* li_l = wsf; float* al_l = wsf + 32;
    float m_reg = -1e30f, l_reg = 0; f32x16 o[4] = {}; bf16x8 qr[ND];
    const bf16_t* Qw = Qb + (long)(wid * 32 + r32) * LDQ + hi * 8;
#pragma unroll
    for (int d0 = 8; d0 < ND; ++d0) qr[d0] = *reinterpret_cast<const bf16x8*>(Qw + d0 * 16);
    if constexpr (DQK == 192) {
        if (rope_t0 >= 0) {
            const int tq = rope_t0 + wid * 32 + r32; const float prow = (float)(tq >> 6), pcol = (float)(tq & 63);
            u32x4 fa1 = __builtin_bit_cast(u32x4, qr[8]), fa2 = __builtin_bit_cast(u32x4, qr[9]), fb1 = __builtin_bit_cast(u32x4, qr[10]), fb2 = __builtin_bit_cast(u32x4, qr[11]);
#pragma unroll
            for (int jj = 0; jj < 4; ++jj) {
                float na1[2], na2[2], nb1[2], nb2[2];
#pragma unroll
                for (int e = 0; e < 2; ++e) { const float invf = __powf(10000.f, -(float)(hi * 8 + 2 * jj + e) * (1.f / 16.f));
                    const float ar = prow * invf, ac = pcol * invf, cr = __cosf(ar), sr_ = __sinf(ar), cc = __cosf(ac), sc_ = __sinf(ac);
                    const float a1 = e ? bfhi(fa1[jj]) : bflo(fa1[jj]), a2 = e ? bfhi(fa2[jj]) : bflo(fa2[jj]), b1 = e ? bfhi(fb1[jj]) : bflo(fb1[jj]), b2 = e ? bfhi(fb2[jj]) : bflo(fb2[jj]);
                    na1[e] = a1 * cr - a2 * sr_; na2[e] = a2 * cr + a1 * sr_; nb1[e] = b1 * cc - b2 * sc_; nb2[e] = b2 * cc + b1 * sc_; }
                fa1[jj] = pk2(na1[0], na1[1]); fa2[jj] = pk2(na2[0], na2[1]); fb1[jj] = pk2(nb1[0], nb1[1]); fb2[jj] = pk2(nb2[0], nb2[1]);
            }
            qr[8] = __builtin_bit_cast(bf16x8, fa1); qr[9] = __builtin_bit_cast(bf16x8, fa2); qr[10] = __builtin_bit_cast(bf16x8, fb1); qr[11] = __builtin_bit_cast(bf16x8, fb2);
        }
    }
    asm volatile("" ::: "memory");
#pragma unroll
    for (int d0 = 0; d0 < 8; ++d0) qr[d0] = *reinterpret_cast<const bf16x8*>(Qw + d0 * 16);
    const int sr = tid >> 4, sc = (tid & 15) * 8, vst0 = v_st(sr, sc), vst1 = v_st(32 + sr, sc);
    int krow[NKL], kch[NKL];
#pragma unroll
    for (int i = 0; i < NKL; ++i) { const int id = tid + i * NTHREADS; krow[i] = id / CH; kch[i] = id % CH; }
    const int vb0 = (int)(uintptr_t)V_lds + v_rd_base(lane);
    bf16x8 vs0, vs1, ks[NKL];
#define SLOAD(k0) do { vs0 = *reinterpret_cast<const bf16x8*>(&Vh[(long)((k0) + sr) * LDV + sc]); vs1 = *reinterpret_cast<const bf16x8*>(&Vh[(long)((k0) + 32 + sr) * LDV + sc]); \
    _Pragma("unroll") for (int i_ = 0; i_ < NKL; ++i_) ks[i_] = *reinterpret_cast<const bf16x8*>(&Kh[(long)((k0) + krow[i_]) * LDK + kch[i_] * 8]); } while (0)
#define SWRITE(b) do { *(bf16x8*)(V_lds + (b) * SHM_V + vst0) = vs0; *(bf16x8*)(V_lds + (b) * SHM_V + vst1) = vs1; \
    _Pragma("unroll") for (int i_ = 0; i_ < NKL; ++i_) *(bf16x8*)(K_lds + (b) * SHM_K + krow[i_] * KP + kch[i_] * 16) = ks[i_]; } while (0)
#define RESC(a) do { if (__any((a) < 1.f)) { if (hi == 0) al_l[r32] = (a); asm volatile("s_waitcnt lgkmcnt(0)" ::: "memory"); \
    _Pragma("unroll") for (int d = 0; d < 4; ++d) _Pragma("unroll") for (int r = 0; r < 16; ++r) o[d][r] *= al_l[crow(r, hi)]; } } while (0)
    f32x16 p0, p1; float mn, al; bf16x8 pa0, pa1, pa2, pa3; const int NT = seq / 64;
    SLOAD(0); asm volatile("s_waitcnt vmcnt(0)" ::: "memory"); SWRITE(0); __syncthreads();
    SLOAD(64);
    for (int j = 0; j < NT; ++j) {
        const int b = j & 1;
        SBAR(); qkt<DQK>(p0, p1, K_lds + b * SHM_K, qr, r32, hi);
        partialSM(p0, p1, m_reg, mn, al, C, thr_raw);
        RESC(al);
        finishSM(p0, p1, al, l_reg, pa0, pa1, pa2, pa3); SBAR();
        pv_d0(o, vb0 + b * SHM_V, pa0, pa1, pa2, pa3);
        if (j + 1 < NT) { asm volatile("s_waitcnt vmcnt(0)" ::: "memory"); SWRITE(b ^ 1); }
        __syncthreads();
        if (j + 2 < NT) SLOAD((j + 2) * 64);
    }
    if (hi == 0) li_l[r32] = l_reg; asm volatile("s_waitcnt lgkmcnt(0)" ::: "memory");
    float rli[16];
#pragma unroll
    for (int r = 0; r < 16; ++r) rli[r] = __builtin_amdgcn_rcpf(li_l[crow(r, hi)]);
    bf16_t* Ow = Ob + (long)(wid * 32) * LDO;
#pragma unroll
    for (int r = 0; r < 16; ++r) { const int orow = crow(r, hi);
#pragma unroll
        for (int d0 = 0; d0 < 4; ++d0) Ow[(long)orow * LDO + d0 * 32 + r32] = (bf16_t)f2bf(o[d0][r] * rli[r]); }
    __syncthreads();
#undef SLOAD
#undef SWRITE
#undef RESC
}
__device__ __forceinline__ void p_attn_mla(const Args& A, const Frame& F) {
    const bf16_t* Q = (const bf16_t*)(F.ws + WS_Q); const bf16_t* Kb = (const bf16_t*)(F.ws + WS_K); const bf16_t* Vb = (const bf16_t*)(F.ws + WS_V); bf16_t* O = (bf16_t*)(F.ws + WS_O);
    const float scale = 0.07216878364870322f;
    for (int u = F.vcu; u < 544; u += F.nblk) {
        int b, h, q0, seq;
        int rope_t0;
        if (u < 512) { const int qb = u & 15; h = (u >> 4) & 7; b = u >> 7; q0 = CTXL + qb * 256; seq = RPB; rope_t0 = qb * 256; }
        else { const int v = u - 512; h = v & 7; b = v >> 3; q0 = 0; seq = CTXL; rope_t0 = -1; }
        const size_t rb = (size_t)b * RPB;
        attn_body_single<192, 1536, 1536, 1024, 1024>(Q + (rb + q0) * 1536 + h * 192, Kb + rb * 1536 + h * 192, Vb + rb * 1024 + h * 128, O + (rb + q0) * 1024 + h * 128, seq, scale, F.lds, rope_t0);
    }
}
__device__ __forceinline__ void p_attn_gqa(const Args& A, const Frame& F) {
    const bf16_t* Q = (const bf16_t*)(F.ws + WS_Q1); const bf16_t* Kb = (const bf16_t*)(F.ws + WS_K1); const bf16_t* Vb = (const bf16_t*)(F.ws + WS_V1); bf16_t* O = (bf16_t*)(F.ws + WS_O);
    const float scale = 0.08838834764831845f;
    for (int u = F.vcu; u < 512; u += F.nblk) {
        const int qb = u & 15, h = (u >> 4) & 7, b = u >> 7, q0 = CTXL + qb * 256, kvh = h >> 2;
        const size_t rb = (size_t)b * RPB;
        attn_body<128, 1024, 256, 256, 1024>(Q + (rb + q0) * 1024 + h * 128, Kb + rb * 256 + kvh * 128, Vb + rb * 256 + kvh * 128, O + (rb + q0) * 1024 + h * 128, RPB, scale, F.lds);
    }
}

#define DPP_XOR1 0xB1
#define DPP_XOR2 0x4E
#define DPP_HMIRROR 0x141
#define DPP_MIRROR 0x140
__device__ __forceinline__ int row_max_i(int v) {
    v = max(v, __builtin_amdgcn_update_dpp(v, v, DPP_XOR1, 0xf, 0xf, false));
    v = max(v, __builtin_amdgcn_update_dpp(v, v, DPP_XOR2, 0xf, 0xf, false));
    v = max(v, __builtin_amdgcn_update_dpp(v, v, DPP_HMIRROR, 0xf, 0xf, false));
    v = max(v, __builtin_amdgcn_update_dpp(v, v, DPP_MIRROR, 0xf, 0xf, false));
    return v;
}
__device__ __forceinline__ float row_sum_f(float v) {
    v += __builtin_bit_cast(float, __builtin_amdgcn_update_dpp(0, __builtin_bit_cast(int, v), DPP_XOR1, 0xf, 0xf, false));
    v += __builtin_bit_cast(float, __builtin_amdgcn_update_dpp(0, __builtin_bit_cast(int, v), DPP_XOR2, 0xf, 0xf, false));
    v += __builtin_bit_cast(float, __builtin_amdgcn_update_dpp(0, __builtin_bit_cast(int, v), DPP_HMIRROR, 0xf, 0xf, false));
    v += __builtin_bit_cast(float, __builtin_amdgcn_update_dpp(0, __builtin_bit_cast(int, v), DPP_MIRROR, 0xf, 0xf, false));
    return v;
}
__device__ __forceinline__ int fkey(float f) { const int b = __builtin_bit_cast(int, f); return b ^ ((b >> 31) & 0x7fffffff); }
__device__ __forceinline__ float keyf(int k) { return __builtin_bit_cast(float, k ^ ((k >> 31) & 0x7fffffff)); }
__device__ __forceinline__ void cand_ij(int t, int& i, int& j) {
    const int g16 = t >= 16, g24 = t >= 24, g29 = t >= 29, g33 = t >= 33, g36 = t >= 36, g38 = t >= 38, g40 = t >= 40;
    i = g16 + g24 + g29 + g33 + g36 + g38 + g40 + max(t - 41, 0);
    const int base = 16 * g16 + 8 * g24 + 5 * g29 + 4 * g33 + 3 * g36 + 2 * g38 + 2 * g40;
    j = (t >= 42) ? 0 : t - base;
    if (t >= 50) { i = 0; j = 0; }
}
__device__ __forceinline__ void row_max2(int& a, int& b) {
    asm volatile("s_nop 1\n\t"
                 "v_max_i32_dpp %0, %0, %0 quad_perm:[1,0,3,2] row_mask:0xf bank_mask:0xf\n\tv_max_i32_dpp %1, %1, %1 quad_perm:[1,0,3,2] row_mask:0xf bank_mask:0xf\n\ts_nop 0\n\t"
                 "v_max_i32_dpp %0, %0, %0 quad_perm:[2,3,0,1] row_mask:0xf bank_mask:0xf\n\tv_max_i32_dpp %1, %1, %1 quad_perm:[2,3,0,1] row_mask:0xf bank_mask:0xf\n\ts_nop 0\n\t"
                 "v_max_i32_dpp %0, %0, %0 row_half_mirror row_mask:0xf bank_mask:0xf\n\tv_max_i32_dpp %1, %1, %1 row_half_mirror row_mask:0xf bank_mask:0xf\n\ts_nop 0\n\t"
                 "v_max_i32_dpp %0, %0, %0 row_mirror row_mask:0xf bank_mask:0xf\n\tv_max_i32_dpp %1, %1, %1 row_mirror row_mask:0xf bank_mask:0xf\n\ts_nop 1"
                 : "+v"(a), "+v"(b));
}
__device__ __forceinline__ void row_max1(int& a) {
    asm volatile("s_nop 1\n\t"
                 "v_max_i32_dpp %0, %0, %0 quad_perm:[1,0,3,2] row_mask:0xf bank_mask:0xf\n\ts_nop 1\n\t"
                 "v_max_i32_dpp %0, %0, %0 quad_perm:[2,3,0,1] row_mask:0xf bank_mask:0xf\n\ts_nop 1\n\t"
                 "v_max_i32_dpp %0, %0, %0 row_half_mirror row_mask:0xf bank_mask:0xf\n\ts_nop 1\n\t"
                 "v_max_i32_dpp %0, %0, %0 row_mirror row_mask:0xf bank_mask:0xf\n\ts_nop 1"
                 : "+v"(a));
}
__device__ __forceinline__ void row_max4(int& a, int& b, int& c, int& d) {
    asm volatile("s_nop 1\n\t"
                 "v_max_i32_dpp %0, %0, %0 quad_perm:[1,0,3,2] row_mask:0xf bank_mask:0xf\n\tv_max_i32_dpp %1, %1, %1 quad_perm:[1,0,3,2] row_mask:0xf bank_mask:0xf\n\t"
                 "v_max_i32_dpp %2, %2, %2 quad_perm:[1,0,3,2] row_mask:0xf bank_mask:0xf\n\tv_max_i32_dpp %3, %3, %3 quad_perm:[1,0,3,2] row_mask:0xf bank_mask:0xf\n\t"
                 "v_max_i32_dpp %0, %0, %0 quad_perm:[2,3,0,1] row_mask:0xf bank_mask:0xf\n\tv_max_i32_dpp %1, %1, %1 quad_perm:[2,3,0,1] row_mask:0xf bank_mask:0xf\n\t"
                 "v_max_i32_dpp %2, %2, %2 quad_perm:[2,3,0,1] row_mask:0xf bank_mask:0xf\n\tv_max_i32_dpp %3, %3, %3 quad_perm:[2,3,0,1] row_mask:0xf bank_mask:0xf\n\t"
                 "v_max_i32_dpp %0, %0, %0 row_half_mirror row_mask:0xf bank_mask:0xf\n\tv_max_i32_dpp %1, %1, %1 row_half_mirror row_mask:0xf bank_mask:0xf\n\t"
                 "v_max_i32_dpp %2, %2, %2 row_half_mirror row_mask:0xf bank_mask:0xf\n\tv_max_i32_dpp %3, %3, %3 row_half_mirror row_mask:0xf bank_mask:0xf\n\t"
                 "v_max_i32_dpp %0, %0, %0 row_mirror row_mask:0xf bank_mask:0xf\n\tv_max_i32_dpp %1, %1, %1 row_mirror row_mask:0xf bank_mask:0xf\n\t"
                 "v_max_i32_dpp %2, %2, %2 row_mirror row_mask:0xf bank_mask:0xf\n\tv_max_i32_dpp %3, %3, %3 row_mirror row_mask:0xf bank_mask:0xf\n\ts_nop 1"
                 : "+v"(a), "+v"(b), "+v"(c), "+v"(d));
}
#define CE_DESC(x, y) do { const int hi_ = max(x, y), lo_ = min(x, y); x = hi_; y = lo_; } while (0)
#define SORT8_DESC(k) do { CE_DESC(k[0], k[2]); CE_DESC(k[1], k[3]); CE_DESC(k[4], k[6]); CE_DESC(k[5], k[7]); CE_DESC(k[0], k[4]); CE_DESC(k[1], k[5]); CE_DESC(k[2], k[6]); CE_DESC(k[3], k[7]); \
    CE_DESC(k[0], k[1]); CE_DESC(k[2], k[3]); CE_DESC(k[4], k[5]); CE_DESC(k[6], k[7]); CE_DESC(k[2], k[4]); CE_DESC(k[3], k[5]); CE_DESC(k[1], k[4]); CE_DESC(k[3], k[6]); CE_DESC(k[1], k[2]); CE_DESC(k[3], k[4]); CE_DESC(k[5], k[6]); } while (0)
#define SORT16_DESC(K) do { CE_DESC(K[0], K[1]); CE_DESC(K[2], K[3]); CE_DESC(K[0], K[2]); CE_DESC(K[1], K[3]); CE_DESC(K[1], K[2]); CE_DESC(K[4], K[5]); CE_DESC(K[6], K[7]); CE_DESC(K[4], K[6]); CE_DESC(K[5], K[7]); CE_DESC(K[5], K[6]); CE_DESC(K[0], K[4]); CE_DESC(K[2], K[6]); CE_DESC(K[2], K[4]); CE_DESC(K[1], K[5]); CE_DESC(K[3], K[7]); CE_DESC(K[3], K[5]); CE_DESC(K[1], K[2]); CE_DESC(K[3], K[4]); CE_DESC(K[5], K[6]); CE_DESC(K[8], K[9]); CE_DESC(K[10], K[11]); CE_DESC(K[8], K[10]); CE_DESC(K[9], K[11]); CE_DESC(K[9], K[10]); CE_DESC(K[12], K[13]); CE_DESC(K[14], K[15]); CE_DESC(K[12], K[14]); CE_DESC(K[13], K[15]); CE_DESC(K[13], K[14]); CE_DESC(K[8], K[12]); CE_DESC(K[10], K[14]); CE_DESC(K[10], K[12]); CE_DESC(K[9], K[13]); CE_DESC(K[11], K[15]); CE_DESC(K[11], K[13]); CE_DESC(K[9], K[10]); CE_DESC(K[11], K[12]); CE_DESC(K[13], K[14]); CE_DESC(K[0], K[8]); CE_DESC(K[4], K[12]); CE_DESC(K[4], K[8]); CE_DESC(K[2], K[10]); CE_DESC(K[6], K[14]); CE_DESC(K[6], K[10]); CE_DESC(K[2], K[4]); CE_DESC(K[6], K[8]); CE_DESC(K[10], K[12]); CE_DESC(K[1], K[9]); CE_DESC(K[5], K[13]); CE_DESC(K[5], K[9]); CE_DESC(K[3], K[11]); CE_DESC(K[7], K[15]); CE_DESC(K[7], K[11]); CE_DESC(K[3], K[5]); CE_DESC(K[7], K[9]); CE_DESC(K[11], K[13]); CE_DESC(K[1], K[2]); CE_DESC(K[3], K[4]); CE_DESC(K[5], K[6]); CE_DESC(K[7], K[8]); CE_DESC(K[9], K[10]); CE_DESC(K[11], K[12]); CE_DESC(K[13], K[14]); } while (0)
#define MERGE16_DESC(T, K) do { _Pragma("unroll") for (int i_ = 0; i_ < 16; ++i_) T[i_] = max(T[i_], K[15 - i_]); CE_DESC(T[0], T[8]); CE_DESC(T[1], T[9]); CE_DESC(T[2], T[10]); CE_DESC(T[3], T[11]); CE_DESC(T[4], T[12]); CE_DESC(T[5], T[13]); CE_DESC(T[6], T[14]); CE_DESC(T[7], T[15]); CE_DESC(T[0], T[4]); CE_DESC(T[1], T[5]); CE_DESC(T[2], T[6]); CE_DESC(T[3], T[7]); CE_DESC(T[8], T[12]); CE_DESC(T[9], T[13]); CE_DESC(T[10], T[14]); CE_DESC(T[11], T[15]); CE_DESC(T[0], T[2]); CE_DESC(T[1], T[3]); CE_DESC(T[4], T[6]); CE_DESC(T[5], T[7]); CE_DESC(T[8], T[10]); CE_DESC(T[9], T[11]); CE_DESC(T[12], T[14]); CE_DESC(T[13], T[15]); CE_DESC(T[0], T[1]); CE_DESC(T[2], T[3]); CE_DESC(T[4], T[5]); CE_DESC(T[6], T[7]); CE_DESC(T[8], T[9]); CE_DESC(T[10], T[11]); CE_DESC(T[12], T[13]); CE_DESC(T[14], T[15]); } while (0)
__device__ __forceinline__ int hkey_hi(unsigned w) { const int x = (int)(w & 0xffff0000u); return x ^ ((x >> 31) & 0x7fff0000); }
__device__ __forceinline__ float hkey_val(int k) { const int y = k & (int)0xffff0000; const unsigned b = (unsigned)(y ^ ((y >> 31) & 0x7fff0000)); return (float)__builtin_bit_cast(_Float16, (unsigned short)(b >> 16)); }
__device__ __forceinline__ int cnd(int a, int b, unsigned long long m) { int r; asm("v_cndmask_b32_e64 %0, %1, %2, %3" : "=v"(r) : "v"(a), "v"(b), "s"(m)); return r; }
__device__ __forceinline__ unsigned long long bitmask(int v, int bit) { unsigned long long m; asm("v_cmp_ne_u32_e64 %0, 0, %1\n\ts_nop 1" : "=s"(m) : "v"(v & bit)); return m; }
__device__ __forceinline__ int sel16(const int (&a)[16], int i) {
    const unsigned long long m0 = bitmask(i, 1), m1 = bitmask(i, 2), m2 = bitmask(i, 4), m3 = bitmask(i, 8);
    int l1[8], l2[4], l3[2];
#pragma unroll
    for (int m = 0; m < 8; ++m) l1[m] = cnd(a[2 * m], a[2 * m + 1], m0);
#pragma unroll
    for (int m = 0; m < 4; ++m) l2[m] = cnd(l1[2 * m], l1[2 * m + 1], m1);
#pragma unroll
    for (int m = 0; m < 2; ++m) l3[m] = cnd(l2[2 * m], l2[2 * m + 1], m2);
    return cnd(l3[0], l3[1], m3);
}
__device__ __forceinline__ void topk_rows4(const unsigned short* S, unsigned* PK, int r, int hbase, int lane) {
    const int c = lane & 15, rw = lane >> 4, rbase = lane & 48, h = hbase + rw;
    const int KMIN = (int)0x80000000;
    const unsigned short* sp = S + (size_t)r * 2048 + h * 256 + 4 * c;
    int k1[8], k2[8];
#pragma unroll
    for (int jj = 0; jj < 2; ++jj) { const u32x2 a = *(const u32x2*)(sp + 64 * jj), b = *(const u32x2*)(sp + 128 + 64 * jj);
#pragma unroll
        for (int e = 0; e < 4; ++e) { const int p = 4 * c + 64 * jj + e;
            const float fa = (float)__builtin_bit_cast(_Float16, (unsigned short)(a[e >> 1] >> (16 * (e & 1)))), fb = (float)__builtin_bit_cast(_Float16, (unsigned short)(b[e >> 1] >> (16 * (e & 1))));
            k1[4 * jj + e] = (fkey(fa) & ~127) | (127 - p); k2[4 * jj + e] = (fkey(fb) & ~127) | (127 - p); } }
    SORT8_DESC(k1); SORT8_DESC(k2);
    int r1 = KMIN, r2 = KMIN;
#pragma unroll 1
    for (int it = 0; it < 16; ++it) {
        int m1 = k1[0], m2 = k2[0];
        row_max2(m1, m2);
        const bool p1 = (k1[0] == m1), p2 = (k2[0] == m2);
#pragma unroll
        for (int e = 0; e < 7; ++e) { k1[e] = p1 ? k1[e + 1] : k1[e]; k2[e] = p2 ? k2[e + 1] : k2[e]; }
        k1[7] = p1 ? KMIN : k1[7]; k2[7] = p2 ? KMIN : k2[7];
        if (c == it) { r1 = m1; r2 = m2; }
    }
    int ck[4];
#pragma unroll
    for (int q = 0; q < 4; ++q) { int ci, cj; cand_ij(c + 16 * q, ci, cj); const int a = __shfl(r1, rbase | ci), b = __shfl(r2, rbase | cj);
        const float fs = keyf((a & ~127) | 64) + keyf((b & ~127) | 64); const int t = c + 16 * q;
        ck[q] = (t < 50) ? ((fkey(fs) & ~63) | (63 - t)) : KMIN; }
    CE_DESC(ck[0], ck[1]); CE_DESC(ck[2], ck[3]); CE_DESC(ck[0], ck[2]); CE_DESC(ck[1], ck[3]); CE_DESC(ck[1], ck[2]);
    int tk = KMIN;
#pragma unroll 1
    for (int it = 0; it < 16; ++it) {
        int m = ck[0];
        row_max1(m);
        const bool pp = (ck[0] == m);
        ck[0] = pp ? ck[1] : ck[0]; ck[1] = pp ? ck[2] : ck[1]; ck[2] = pp ? ck[3] : ck[2]; ck[3] = pp ? KMIN : ck[3];
        if (c == it) tk = m;
    }
    int wi, wj; cand_ij(63 - (tk & 63), wi, wj);
    const int wa = __shfl(r1, rbase | wi), wb = __shfl(r2, rbase | wj);
    const int te = (127 - (wa & 127)) * 128 + (127 - (wb & 127));
    const float tv = keyf((tk & ~63) | 32);
    int mk = tk; row_max1(mk);
    const float mx = keyf((mk & ~63) | 32);
    const float ex = __expf(tv - mx), sum = row_sum_f(ex);
    PK[(size_t)r * 128 + h * 16 + c] = ((unsigned)te << 16) | (unsigned)(ex * (65535.f / sum) + 0.5f);
}
__device__ __forceinline__ void p_peer_topk(const Args& A, const Frame& F, bool skip_ctx) {
    const int gw = F.bid * NWAVES + F.wave, NGW = F.nblk * NWAVES, lane = F.lane;
    const unsigned short* S = (const unsigned short*)(F.ws + WS_S); unsigned* PK = (unsigned*)(F.ws + WS_PK);
    const int KMIN = (int)0x80000000;
    const int nitem = (skip_ctx ? NB * SEQ : R) * 8;
    const int nmain = (nitem / (NGW * 64)) * (NGW * 64);
    for (int q = gw; q < (nitem - nmain) / 4; q += NGW) { const int item = nmain + 4 * q, n = item >> 3; topk_rows4(S, PK, skip_ctx ? tok_row(1, n) : n, item & 7, lane); }
    for (int base = gw * 64; base < nmain; base += NGW * 64) {
        const int item = base + lane, n = item >> 3, h = item & 7, r = skip_ctx ? tok_row(1, n) : n;
        const unsigned short* sp = S + (size_t)r * 2048 + h * 256;
        int t1[16], t2[16];
#pragma unroll
        for (int list = 0; list < 2; ++list) {
            int T[16];
#pragma unroll
            for (int i = 0; i < 16; ++i) T[i] = KMIN;
            const unsigned short* lp = sp + 128 * list;
            u32x4 ra = *(const u32x4*)lp, rb = *(const u32x4*)(lp + 8);
#pragma unroll 1
            for (int c = 0; c < 8; ++c) {
                const int cn = c < 7 ? c + 1 : 7;
                const u32x4 na = *(const u32x4*)(lp + 16 * cn), nb = *(const u32x4*)(lp + 16 * cn + 8);
                const int pb = 127 - 16 * c;
                int K[16];
#pragma unroll
                for (int d = 0; d < 4; ++d) { K[2 * d] = hkey_hi(ra[d] << 16) | (pb - 2 * d); K[2 * d + 1] = hkey_hi(ra[d]) | (pb - 2 * d - 1);
                    K[8 + 2 * d] = hkey_hi(rb[d] << 16) | (pb - 8 - 2 * d); K[8 + 2 * d + 1] = hkey_hi(rb[d]) | (pb - 9 - 2 * d); }
                SORT16_DESC(K);
                MERGE16_DESC(T, K);
                ra = na; rb = nb;
            }
#pragma unroll
            for (int i = 0; i < 16; ++i) { if (list == 0) t1[i] = T[i]; else t2[i] = T[i]; }
        }
        float f1[16], f2[16];
#pragma unroll
        for (int i = 0; i < 16; ++i) { f1[i] = hkey_val(t1[i]); f2[i] = hkey_val(t2[i]); }
        int CA[16], CB[16], CC[16], CD[16];
        CA[0] = (fkey(f1[0] + f2[0]) & ~63) | 63; CA[1] = (fkey(f1[0] + f2[1]) & ~63) | 62; CA[2] = (fkey(f1[0] + f2[2]) & ~63) | 61; CA[3] = (fkey(f1[0] + f2[3]) & ~63) | 60; CA[4] = (fkey(f1[0] + f2[4]) & ~63) | 59; CA[5] = (fkey(f1[0] + f2[5]) & ~63) | 58; CA[6] = (fkey(f1[0] + f2[6]) & ~63) | 57; CA[7] = (fkey(f1[0] + f2[7]) & ~63) | 56; CA[8] = (fkey(f1[0] + f2[8]) & ~63) | 55; CA[9] = (fkey(f1[0] + f2[9]) & ~63) | 54; CA[10] = (fkey(f1[0] + f2[10]) & ~63) | 53; CA[11] = (fkey(f1[0] + f2[11]) & ~63) | 52; CA[12] = (fkey(f1[0] + f2[12]) & ~63) | 51; CA[13] = (fkey(f1[0] + f2[13]) & ~63) | 50; CA[14] = (fkey(f1[0] + f2[14]) & ~63) | 49; CA[15] = (fkey(f1[0] + f2[15]) & ~63) | 48; CB[0] = (fkey(f1[1] + f2[0]) & ~63) | 47; CB[1] = (fkey(f1[1] + f2[1]) & ~63) | 46; CB[2] = (fkey(f1[1] + f2[2]) & ~63) | 45; CB[3] = (fkey(f1[1] + f2[3]) & ~63) | 44; CB[4] = (fkey(f1[1] + f2[4]) & ~63) | 43; CB[5] = (fkey(f1[1] + f2[5]) & ~63) | 42; CB[6] = (fkey(f1[1] + f2[6]) & ~63) | 41; CB[7] = (fkey(f1[1] + f2[7]) & ~63) | 40; CB[8] = (fkey(f1[2] + f2[0]) & ~63) | 39; CB[9] = (fkey(f1[2] + f2[1]) & ~63) | 38; CB[10] = (fkey(f1[2] + f2[2]) & ~63) | 37; CB[11] = (fkey(f1[2] + f2[3]) & ~63) | 36; CB[12] = (fkey(f1[2] + f2[4]) & ~63) | 35; CB[13] = (fkey(f1[3] + f2[0]) & ~63) | 34; CB[14] = (fkey(f1[3] + f2[1]) & ~63) | 33; CB[15] = (fkey(f1[3] + f2[2]) & ~63) | 32; CC[0] = (fkey(f1[3] + f2[3]) & ~63) | 31; CC[1] = (fkey(f1[4] + f2[0]) & ~63) | 30; CC[2] = (fkey(f1[4] + f2[1]) & ~63) | 29; CC[3] = (fkey(f1[4] + f2[2]) & ~63) | 28; CC[4] = (fkey(f1[5] + f2[0]) & ~63) | 27; CC[5] = (fkey(f1[5] + f2[1]) & ~63) | 26; CC[6] = (fkey(f1[6] + f2[0]) & ~63) | 25; CC[7] = (fkey(f1[6] + f2[1]) & ~63) | 24; CC[8] = (fkey(f1[7] + f2[0]) & ~63) | 23; CC[9] = (fkey(f1[7] + f2[1]) & ~63) | 22; CC[10] = (fkey(f1[8] + f2[0]) & ~63) | 21; CC[11] = (fkey(f1[9] + f2[0]) & ~63) | 20; CC[12] = (fkey(f1[10] + f2[0]) & ~63) | 19; CC[13] = (fkey(f1[11] + f2[0]) & ~63) | 18; CC[14] = (fkey(f1[12] + f2[0]) & ~63) | 17; CC[15] = (fkey(f1[13] + f2[0]) & ~63) | 16; CD[0] = (fkey(f1[14] + f2[0]) & ~63) | 15; CD[1] = (fkey(f1[15] + f2[0]) & ~63) | 14; CD[2] = KMIN; CD[3] = KMIN; CD[4] = KMIN; CD[5] = KMIN; CD[6] = KMIN; CD[7] = KMIN; CD[8] = KMIN; CD[9] = KMIN; CD[10] = KMIN; CD[11] = KMIN; CD[12] = KMIN; CD[13] = KMIN; CD[14] = KMIN; CD[15] = KMIN;
        SORT16_DESC(CB); SORT16_DESC(CC); CE_DESC(CD[0], CD[1]);
        MERGE16_DESC(CA, CB); MERGE16_DESC(CA, CC); MERGE16_DESC(CA, CD);
        const float mx = keyf((CA[0] & ~63) | 32);
        float ex[16], sum = 0.f; unsigned te[16];
#pragma unroll
        for (int k = 0; k < 16; ++k) { int wi, wj; cand_ij(63 - (CA[k] & 63), wi, wj);
            const int wa = sel16(t1, wi), wb = sel16(t2, wj);
            te[k] = (unsigned)((127 - (wa & 127)) * 128 + (127 - (wb & 127)));
            ex[k] = __expf(keyf((CA[k] & ~63) | 32) - mx); sum += ex[k]; }
        const float rs = 65535.f / sum;
        u32x4* dst = (u32x4*)(PK + (size_t)r * 128 + h * 16);
#pragma unroll
        for (int q = 0; q < 4; ++q) { u32x4 o;
#pragma unroll
            for (int d = 0; d < 4; ++d) o[d] = (te[4 * q + d] << 16) | (unsigned)(ex[4 * q + d] * rs + 0.5f);
            dst[q] = o; }
    }
}

#define UB(w, b) ((float)(((w) >> (8 * (b))) & 0xffu))
__device__ __forceinline__ void p_peer_experts(const Args& A, const Frame& F, int layer) {
    const int gw = F.bid * NWAVES + F.wave, NGW = F.nblk * NWAVES, lane = F.lane;
    const bf16_t* H = (const bf16_t*)(F.ws + WS_H); float* X = (float*)(F.ws + WS_X);
    const unsigned* PK = (const unsigned*)(F.ws + WS_PK);
    const unsigned char* UT = F.ws + WS_TAB + (size_t)(layer * 2) * 16384 * 1024; const unsigned char* VT = UT + (size_t)16384 * 1024;
    const float* SU = (const float*)(F.ws + WS_TSC) + (layer * 2) * 16384; const float* SV = SU + 16384;
    const float* MOD = (const float*)(F.ws + WS_MOD) + (size_t)layer * 5 * 6144;
    for (int r = gw; r < R; r += NGW) {
        if (layer == 1 && is_ctx_row(r)) continue;
        float hf[16];
        { const u32x4 w0 = *(const u32x4*)(H + (size_t)r * DM + 16 * lane), w1 = *(const u32x4*)(H + (size_t)r * DM + 16 * lane + 8);
#pragma unroll
          for (int d = 0; d < 4; ++d) { hf[2 * d] = bflo(w0[d]); hf[2 * d + 1] = bfhi(w0[d]); hf[8 + 2 * d] = bflo(w1[d]); hf[8 + 2 * d + 1] = bfhi(w1[d]); } }
        float hs = 0.f;
#pragma unroll
        for (int i = 0; i < 16; ++i) hs += hf[i];
        hs = wave_sum(hs);
        int v0 = (int)PK[(size_t)r * 128 + lane], v1 = (int)PK[(size_t)r * 128 + 64 + lane];
#pragma unroll
        for (int k = 2; k <= 128; k <<= 1) {
#pragma unroll
            for (int j = k >> 1; j >= 1; j >>= 1) {
                if (j == 64) { const int a = min(v0, v1), b = max(v0, v1); v0 = a; v1 = b; }
                else { const int o0 = __shfl_xor(v0, j), o1 = __shfl_xor(v1, j); const bool lower = (lane & j) == 0;
                    const bool asc0 = (k == 128) ? true : (k == 64) ? true : ((lane & k) == 0), asc1 = (k == 128) ? true : (k == 64) ? false : ((lane & k) == 0);
                    v0 = (lower == asc0) ? min(v0, o0) : max(v0, o0); v1 = (lower == asc1) ? min(v1, o1) : max(v1, o1); }
            }
        }
        const unsigned pk0 = (unsigned)v0, pk1 = (unsigned)v1;
        const int e0 = (int)(pk0 >> 16), e1 = (int)(pk1 >> 16);
        const float g0 = (float)(pk0 & 0xffffu) * (1.f / 65535.f), g1 = (float)(pk1 & 0xffffu) * (1.f / 65535.f);
        const float su0 = SU[e0], su1 = SU[e1], sv0 = SV[e0], sv1 = SV[e1];
        float d0 = 0.f, d1 = 0.f;
        const int dep_src = (8 * (lane & 7)) << 2; const bool bit3 = (lane & 8) != 0;
#define XISSUE(buf, TAB, esrc, gg) do { _Pragma("unroll") for (int q_ = 0; q_ < 8; ++q_) { const int e_ = __builtin_amdgcn_readlane(esrc, (gg) * 8 + q_); \
            buf[q_] = *(const u32x4*)((TAB) + (size_t)e_ * 1024 + 16 * lane); } } while (0)
#define UCOMP(buf, gg, dsel) do { float p_[8]; _Pragma("unroll") for (int q_ = 0; q_ < 8; ++q_) { float d_ = 0.f; \
            _Pragma("unroll") for (int j_ = 0; j_ < 4; ++j_) d_ += (hf[4 * j_] * UB(buf[q_][j_], 0) + hf[4 * j_ + 1] * UB(buf[q_][j_], 1)) + (hf[4 * j_ + 2] * UB(buf[q_][j_], 2) + hf[4 * j_ + 3] * UB(buf[q_][j_], 3)); p_[q_] = d_; } \
            float s_[4]; _Pragma("unroll") for (int q_ = 0; q_ < 4; ++q_) { auto rr_ = __builtin_amdgcn_permlane32_swap(__float_as_uint(p_[q_]), __float_as_uint(p_[q_ + 4]), false, false); s_[q_] = __uint_as_float(rr_[0]) + __uint_as_float(rr_[1]); } \
            float t_[2]; _Pragma("unroll") for (int q_ = 0; q_ < 2; ++q_) { auto rr_ = __builtin_amdgcn_permlane16_swap(__float_as_uint(s_[q_]), __float_as_uint(s_[q_ + 2]), false, false); t_[q_] = __uint_as_float(rr_[0]) + __uint_as_float(rr_[1]); } \
            const float keep_ = bit3 ? t_[1] : t_[0], send_ = bit3 ? t_[0] : t_[1]; \
            float u_ = keep_ + __builtin_bit_cast(float, __builtin_amdgcn_update_dpp(0, __builtin_bit_cast(int, send_), 0x128, 0xf, 0xf, false)); \
            u_ += __builtin_bit_cast(float, __builtin_amdgcn_update_dpp(0, __builtin_bit_cast(int, u_), DPP_HMIRROR, 0xf, 0xf, false)); \
            u_ += __builtin_bit_cast(float, __builtin_amdgcn_update_dpp(0, __builtin_bit_cast(int, u_), DPP_XOR1, 0xf, 0xf, false)); \
            u_ += __builtin_bit_cast(float, __builtin_amdgcn_update_dpp(0, __builtin_bit_cast(int, u_), DPP_XOR2, 0xf, 0xf, false)); \
            const float v_ = __builtin_bit_cast(float, __builtin_amdgcn_ds_bpermute(dep_src, __builtin_bit_cast(int, u_))); \
            if ((lane >> 3) == (gg)) dsel = v_; } while (0)
        {
            u32x4 ua[8], ub[8];
            XISSUE(ua, UT, e0, 0);
#pragma unroll 1
            for (int g = 0; g < 8; g += 2) { XISSUE(ub, UT, e0, g + 1); UCOMP(ua, g, d0); if (g + 2 < 8) XISSUE(ua, UT, e0, g + 2); else XISSUE(ua, UT, e1, 0); UCOMP(ub, g + 1, d0); }
#pragma unroll 1
            for (int g = 0; g < 8; g += 2) { XISSUE(ub, UT, e1, g + 1); UCOMP(ua, g, d1); if (g + 2 < 8) XISSUE(ua, UT, e1, g + 2); UCOMP(ub, g + 1, d1); }
        }
        const float a0 = su0 * (d0 - 128.f * hs), a1 = su1 * (d1 - 128.f * hs);
        const float w0 = g0 * 0.5f * a0 * (1.f + erff(a0 * 0.70710678118654752f)) * sv0, w1 = g1 * 0.5f * a1 * (1.f + erff(a1 * 0.70710678118654752f)) * sv1;
        const float wsum = wave_sum(w0 + w1) * 128.f;
        float acc[16];
#pragma unroll
        for (int i = 0; i < 16; ++i) acc[i] = 0.f;
#define VCOMP(buf, wsrc, gg) do { _Pragma("unroll") for (int q_ = 0; q_ < 8; ++q_) { const float wk_ = __builtin_bit_cast(float, __builtin_amdgcn_readlane(__builtin_bit_cast(int, wsrc), (gg) * 8 + q_)); \
            _Pragma("unroll") for (int j_ = 0; j_ < 4; ++j_) { acc[4 * j_] += wk_ * UB(buf[q_][j_], 0); acc[4 * j_ + 1] += wk_ * UB(buf[q_][j_], 1); acc[4 * j_ + 2] += wk_ * UB(buf[q_][j_], 2); acc[4 * j_ + 3] += wk_ * UB(buf[q_][j_], 3); } } } while (0)
        {
            u32x4 va[8], vb[8];
            XISSUE(va, VT, e0, 0);
#pragma unroll 1
            for (int g = 0; g < 8; g += 2) { XISSUE(vb, VT, e0, g + 1); VCOMP(va, w0, g); if (g + 2 < 8) XISSUE(va, VT, e0, g + 2); else XISSUE(va, VT, e1, 0); VCOMP(vb, w0, g + 1); }
#pragma unroll 1
            for (int g = 0; g < 8; g += 2) { XISSUE(vb, VT, e1, g + 1); VCOMP(va, w1, g); if (g + 2 < 8) XISSUE(va, VT, e1, g + 2); VCOMP(vb, w1, g + 1); }
        }
#undef XISSUE
#undef UCOMP
#undef VCOMP
        const float* mm = MOD + (size_t)mod_index(r) * 6144;
        f32x4 xn[4]; float s = 0.f;
#pragma unroll
        for (int j = 0; j < 4; ++j) { const int c = 16 * lane + 4 * j; const float* xp = X + (size_t)r * DM + c; const f32x4 gf = *(const f32x4*)(mm + 5 * 1024 + c);
            xn[j] = *(const f32x4*)xp + gf * (f32x4){acc[4 * j] - wsum, acc[4 * j + 1] - wsum, acc[4 * j + 2] - wsum, acc[4 * j + 3] - wsum};
            s += (xn[j].x * xn[j].x + xn[j].y * xn[j].y) + (xn[j].z * xn[j].z + xn[j].w * xn[j].w); }
        const float rinv = rsqrtf(wave_sum(s) * (1.f / DM) + EPS);
        if (layer == 0) {
            const float* m1 = (const float*)(F.ws + WS_MOD) + (size_t)(5 + mod_index(r)) * 6144;
            const float* gn = A.in[I1_NMIX];
#pragma unroll
            for (int j = 0; j < 4; ++j) { const int c = 16 * lane + 4 * j; *(f32x4*)(X + (size_t)r * DM + c) = xn[j];
                const f32x4 y = (xn[j] * rinv * *(const f32x4*)(gn + c)) * (*(const f32x4*)(m1 + 1024 + c) + 1.f) + *(const f32x4*)(m1 + c);
                u32x2 o; o.x = pk2(y.x, y.y); o.y = pk2(y.z, y.w); *(u32x2*)((bf16_t*)(F.ws + WS_H) + (size_t)r * DM + c) = o; }
        } else {
            const int b = r / RPB, t = (r - b * RPB) - CTXL; float* op = F.out + ((size_t)b * SEQ + t) * DM; const float* gn = A.in[I_NOUT];
#pragma unroll
            for (int j = 0; j < 4; ++j) { const int c = 16 * lane + 4 * j; *(f32x4*)(op + c) = xn[j] * rinv * *(const f32x4*)(gn + c); }
        }
    }
}

__device__ __forceinline__ int tok_row(int layer, int n) { return layer == 0 ? n : (n >> 12) * RPB + CTXL + (n & 4095); }
#define DPPF(v, ctrl) __builtin_bit_cast(float, __builtin_amdgcn_update_dpp(0, __builtin_bit_cast(int, v), ctrl, 0xf, 0xf, false))
__device__ __forceinline__ int isum8(int v) {
    v += __builtin_amdgcn_update_dpp(0, v, DPP_XOR1, 0xf, 0xf, false); v += __builtin_amdgcn_update_dpp(0, v, DPP_XOR2, 0xf, 0xf, false); v += __builtin_amdgcn_update_dpp(0, v, DPP_HMIRROR, 0xf, 0xf, false); return v; }
__device__ __forceinline__ void p_exp_u(const Args& A, const Frame& F, int layer) {
    const int lane = F.lane, s = lane >> 3, c8 = lane & 7;
    const bool part = (F.nblk & 7) == 0; const int ncb = part ? 1 : 8, cb0 = part ? (F.bid & 7) : 0;
    const int gwv = part ? ((F.bid >> 3) * NWAVES + F.wave) : (F.bid * NWAVES + F.wave), nwv = part ? ((F.nblk >> 3) * NWAVES) : (F.nblk * NWAVES);
    const int ntok = layer == 0 ? R : NB * SEQ;
    const unsigned char* HQ = F.ws + WS_HQ; const unsigned* PK = (const unsigned*)(F.ws + WS_PK);
    const unsigned char* UT = F.ws + WS_TAB + (size_t)(layer * 2) * 16384 * 1024;
    int* PD = (int*)(F.ws + WS_PD);
#define U_META(pk, hq, n_) do { const int r_ = tok_row(layer, (n_) < ntok ? (n_) : gwv); const unsigned* p_ = PK + (size_t)r_ * 128 + s; \
        _Pragma("unroll") for (int i_ = 0; i_ < 16; ++i_) pk[i_] = p_[8 * i_]; \
        hq = *(const u32x4*)(HQ + (size_t)r_ * DM + 128 * cb + 16 * c8); } while (0)
#define U_ISSUE(pk, lo) do { _Pragma("unroll") for (int i_ = (lo); i_ < (lo) + 8; ++i_) t[i_] = *(const u32x4*)(tb + (size_t)(pk[i_] >> 16) * 128); } while (0)
#define U_DOT(i_) do { int d_ = __builtin_amdgcn_sdot4((int)t[i_][0], (int)hv[0], 0, false); d_ = __builtin_amdgcn_sdot4((int)t[i_][1], (int)hv[1], d_, false); \
        d_ = __builtin_amdgcn_sdot4((int)t[i_][2], (int)hv[2], d_, false); d_ = __builtin_amdgcn_sdot4((int)t[i_][3], (int)hv[3], d_, false); \
        d_ = isum8(d_); if (c8 == ((i_) & 7)) { if ((i_) < 8) kA = d_; else kB = d_; } } while (0)
#define U_ITEM(pkc, hqc, pkn, n_) do { \
        const u32x4 hv = hqc; \
        U_META(pkc, hqc, (n_) + 2 * nwv); \
        int kA = 0, kB = 0; \
        _Pragma("unroll") for (int i_ = 0; i_ < 8; ++i_) U_DOT(i_); \
        U_ISSUE(pkn, 0); \
        _Pragma("unroll") for (int i_ = 8; i_ < 16; ++i_) U_DOT(i_); \
        U_ISSUE(pkn, 8); \
        if ((n_) < ntok) { const int r_ = tok_row(layer, n_); int* pd_ = PD + ((size_t)cb * R + r_) * 128 + 8 * c8 + s; pd_[0] = kA; pd_[64] = kB; } \
        } while (0)
#pragma unroll 1
    for (int cbi = 0; cbi < ncb; ++cbi) {
        const int cb = cb0 + cbi;
        const unsigned char* tb = UT + (size_t)cb * 16384 * 128 + 16 * c8;
        unsigned pkA[16], pkB[16]; u32x4 hA, hB, t[16];
        U_META(pkA, hA, gwv); U_META(pkB, hB, gwv + nwv);
        U_ISSUE(pkA, 0); U_ISSUE(pkA, 8);
#pragma unroll 1
        for (int n = gwv; n < ntok; n += 2 * nwv) {
            U_ITEM(pkA, hA, pkB, n);
            U_ITEM(pkB, hB, pkA, n + nwv);
        }
    }
#undef U_META
#undef U_ISSUE
#undef U_DOT
#undef U_ITEM
}
__device__ __forceinline__ void p_exp_w(const Args& A, const Frame& F, int layer) {
    const int gw = F.bid * NWAVES + F.wave, NGW = F.nblk * NWAVES, lane = F.lane;
    const int ntok = layer == 0 ? R : NB * SEQ;
    const unsigned* PK = (const unsigned*)(F.ws + WS_PK); const int* PD = (const int*)(F.ws + WS_PD); const float* HS = (const float*)(F.ws + WS_HS);
    unsigned* WQ8 = (unsigned*)(F.ws + WS_WQ8); float* WSC = (float*)(F.ws + WS_WSC);
    const float* SU = (const float*)(F.ws + WS_TSC) + (layer * 2) * 16384; const float* SV = SU + 16384;
    const int g2 = (lane >> 3) & 3, sb = lane & 7, src = 32 * (g2 & 1) + sb;
    for (int n = gw; n < ntok; n += 2 * NGW) {
        int r[2]; r[0] = tok_row(layer, n); r[1] = (n + NGW) < ntok ? tok_row(layer, n + NGW) : r[0];
        unsigned pk0[2], pk1[2]; int d0[2], d1[2]; float hs[2];
#pragma unroll
        for (int q = 0; q < 2; ++q) { pk0[q] = PK[(size_t)r[q] * 128 + lane]; pk1[q] = PK[(size_t)r[q] * 128 + 64 + lane]; hs[q] = HS[r[q]]; d0[q] = 0; d1[q] = 0;
#pragma unroll
            for (int cb = 0; cb < 8; ++cb) { d0[q] += PD[((size_t)cb * R + r[q]) * 128 + lane]; d1[q] += PD[((size_t)cb * R + r[q]) * 128 + 64 + lane]; } }
        float su0[2], su1[2], sv0[2], sv1[2];
#pragma unroll
        for (int q = 0; q < 2; ++q) { const int e0 = (int)(pk0[q] >> 16), e1 = (int)(pk1[q] >> 16); su0[q] = SU[e0]; su1[q] = SU[e1]; sv0[q] = SV[e0]; sv1[q] = SV[e1]; }
#pragma unroll
        for (int q = 0; q < 2; ++q) {
            const float g0 = (float)(pk0[q] & 0xffffu) * (1.f / 65535.f), g1 = (float)(pk1[q] & 0xffffu) * (1.f / 65535.f);
            const float a0 = su0[q] * hs[q] * (float)d0[q], a1 = su1[q] * hs[q] * (float)d1[q];
            const float w0 = g0 * 0.5f * a0 * (1.f + erff(a0 * 0.70710678118654752f)) * sv0[q], w1 = g1 * 0.5f * a1 * (1.f + erff(a1 * 0.70710678118654752f)) * sv1[q];
            const float wm = wave_max(fmaxf(fabsf(w0), fabsf(w1)));
            const float inv = wm > 0.f ? 127.f / wm : 0.f;
            const int q0 = (int)rintf(w0 * inv) & 0xff, q1 = (int)rintf(w1 * inv) & 0xff;
            unsigned pw = 0;
#pragma unroll
            for (int j = 0; j < 4; ++j) { const int x0 = __shfl(q0, src + 8 * j), x1 = __shfl(q1, src + 8 * j); pw |= (unsigned)((g2 < 2) ? x0 : x1) << (8 * j); }
            if (q == 0 || (n + NGW) < ntok) { if (lane < 32) WQ8[(size_t)r[q] * 32 + lane] = pw; if (lane == 0) WSC[r[q]] = wm > 0.f ? wm * (1.f / 127.f) : 0.f; }
        }
    }
}
__device__ __forceinline__ void p_exp_v(const Args& A, const Frame& F, int layer) {
    const int lane = F.lane, s = lane >> 3, c8 = lane & 7;
    const bool part = (F.nblk & 7) == 0; const int ncb = part ? 1 : 8, cb0 = part ? (F.bid & 7) : 0;
    const int gwv = part ? ((F.bid >> 3) * NWAVES + F.wave) : (F.bid * NWAVES + F.wave), nwv = part ? ((F.nblk >> 3) * NWAVES) : (F.nblk * NWAVES);
    const int ntok = layer == 0 ? R : NB * SEQ;
    const unsigned* PK = (const unsigned*)(F.ws + WS_PK); const unsigned* WQ8 = (const unsigned*)(F.ws + WS_WQ8); const float* WSC = (const float*)(F.ws + WS_WSC);
    const unsigned char* VT = F.ws + WS_TAB + (size_t)(layer * 2 + 1) * 16384 * 1024;
    unsigned short* X = (unsigned short*)(F.ws + WS_X); const float* MOD = (const float*)(F.ws + WS_MOD) + (size_t)layer * 5 * 6144;
    const bool bit3 = (lane & 8) != 0;
#define V_METAP(pk, n_) do { const int r_ = tok_row(layer, (n_) < ntok ? (n_) : gwv); const unsigned* p_ = PK + (size_t)r_ * 128 + s; \
        _Pragma("unroll") for (int i_ = 0; i_ < 16; ++i_) pk[i_] = p_[8 * i_]; } while (0)
#define V_METAW(wq, n_) do { const int r_ = tok_row(layer, (n_) < ntok ? (n_) : gwv); const unsigned* w_ = WQ8 + (size_t)r_ * 32 + s; \
        _Pragma("unroll") for (int g_ = 0; g_ < 4; ++g_) wq[g_] = w_[8 * g_]; } while (0)
#define V_ISSUE(pk, lo) do { _Pragma("unroll") for (int i_ = (lo); i_ < (lo) + 8; ++i_) t[i_] = *(const u32x4*)(tb + (size_t)(pk[i_] >> 16) * 128); } while (0)
#define V_GRP(wq, g_) do { _Pragma("unroll") for (int j_ = 0; j_ < 4; ++j_) { const unsigned a_ = t[4 * (g_)][j_], b_ = t[4 * (g_) + 1][j_], c_ = t[4 * (g_) + 2][j_], d_ = t[4 * (g_) + 3][j_]; \
        const unsigned ablo = __builtin_amdgcn_perm(b_, a_, 0x05010400u), abhi = __builtin_amdgcn_perm(b_, a_, 0x07030602u), cdlo = __builtin_amdgcn_perm(d_, c_, 0x05010400u), cdhi = __builtin_amdgcn_perm(d_, c_, 0x07030602u); \
        acc[4 * j_]     = __builtin_amdgcn_sdot4((int)__builtin_amdgcn_perm(cdlo, ablo, 0x05040100u), (int)wq[g_], acc[4 * j_], false); \
        acc[4 * j_ + 1] = __builtin_amdgcn_sdot4((int)__builtin_amdgcn_perm(cdlo, ablo, 0x07060302u), (int)wq[g_], acc[4 * j_ + 1], false); \
        acc[4 * j_ + 2] = __builtin_amdgcn_sdot4((int)__builtin_amdgcn_perm(cdhi, abhi, 0x05040100u), (int)wq[g_], acc[4 * j_ + 2], false); \
        acc[4 * j_ + 3] = __builtin_amdgcn_sdot4((int)__builtin_amdgcn_perm(cdhi, abhi, 0x07060302u), (int)wq[g_], acc[4 * j_ + 3], false); } } while (0)
#define V_ITEM(pkc, wqc, pkn, n_) do { \
        int acc[16]; _Pragma("unroll") for (int a_ = 0; a_ < 16; ++a_) acc[a_] = 0; \
        V_METAP(pkc, (n_) + 2 * nwv); \
        V_GRP(wqc, 0); V_GRP(wqc, 1); \
        V_ISSUE(pkn, 0); \
        V_GRP(wqc, 2); V_GRP(wqc, 3); \
        V_ISSUE(pkn, 8); \
        int b8[8], c4[4], o[2]; \
        _Pragma("unroll") for (int a_ = 0; a_ < 8; ++a_) { auto rr = __builtin_amdgcn_permlane32_swap((unsigned)acc[a_], (unsigned)acc[a_ + 8], false, false); b8[a_] = (int)rr[0] + (int)rr[1]; } \
        _Pragma("unroll") for (int a_ = 0; a_ < 4; ++a_) { auto rr = __builtin_amdgcn_permlane16_swap((unsigned)b8[a_], (unsigned)b8[a_ + 4], false, false); c4[a_] = (int)rr[0] + (int)rr[1]; } \
        _Pragma("unroll") for (int a_ = 0; a_ < 2; ++a_) { const int keep = bit3 ? c4[a_ + 2] : c4[a_], send = bit3 ? c4[a_] : c4[a_ + 2]; o[a_] = keep + __builtin_amdgcn_update_dpp(0, send, 0x128, 0xf, 0xf, false); } \
        if ((n_) < ntok) { const int r_ = tok_row(layer, n_); const float ws_ = WSC[r_]; const int col = 128 * cb + 16 * c8 + 2 * s; \
            const f32x2 gf = *(const f32x2*)(MOD + (size_t)mod_index(r_) * 6144 + 5 * 1024 + col); unsigned* xp = (unsigned*)(X + (size_t)r_ * DM + col); \
            const unsigned xw = *xp; *xp = pkh2(h2f_lo(xw) + gf.x * (ws_ * (float)o[0]), h2f_hi(xw) + gf.y * (ws_ * (float)o[1])); } \
        V_METAW(wqc, (n_) + 2 * nwv); } while (0)
#pragma unroll 1
    for (int cbi = 0; cbi < ncb; ++cbi) {
        const int cb = cb0 + cbi;
        const unsigned char* tb = VT + (size_t)cb * 16384 * 128 + 16 * c8;
        unsigned pkA[16], pkB[16], wqA[4], wqB[4]; u32x4 t[16];
        V_METAP(pkA, gwv); V_METAW(wqA, gwv); V_METAP(pkB, gwv + nwv); V_METAW(wqB, gwv + nwv);
        V_ISSUE(pkA, 0); V_ISSUE(pkA, 8);
#pragma unroll 1
        for (int n = gwv; n < ntok; n += 2 * nwv) {
            V_ITEM(pkA, wqA, pkB, n);
            V_ITEM(pkB, wqB, pkA, n + nwv);
        }
    }
#undef V_METAP
#undef V_METAW
#undef V_ISSUE
#undef V_GRP
#undef V_ITEM
}
__device__ __forceinline__ void p_final_norm(const Args& A, const Frame& F) {
    const int gw = F.bid * NWAVES + F.wave, NGW = F.nblk * NWAVES, lane = F.lane;
    const unsigned short* X = (const unsigned short*)(F.ws + WS_X); const float* gn = A.in[I_NOUT];
    for (int n = gw; n < NB * SEQ; n += NGW) {
        const unsigned short* xr = X + (size_t)tok_row(1, n) * DM; float* op = F.out + (size_t)n * DM;
        f32x4 v[4]; float sq = 0.f;
#pragma unroll
        for (int j = 0; j < 4; ++j) { const u32x2 a = *(const u32x2*)(xr + 4 * lane + 256 * j); v[j] = (f32x4){h2f_lo(a.x), h2f_hi(a.x), h2f_lo(a.y), h2f_hi(a.y)}; sq += (v[j].x * v[j].x + v[j].y * v[j].y) + (v[j].z * v[j].z + v[j].w * v[j].w); }
        const float rinv = rsqrtf(wave_sum(sq) * (1.f / DM) + EPS);
#pragma unroll
        for (int j = 0; j < 4; ++j) { const int c = 4 * lane + 256 * j; *(f32x4*)(op + c) = v[j] * rinv * *(const f32x4*)(gn + c); }
    }
}

constexpr int N_PHASES = 24;
__global__ void __launch_bounds__(NTHREADS, 2) mega(Args args) {
    extern __shared__ __attribute__((aligned(16))) unsigned char lds_raw[];
    Frame F; F.x = args.in[I_X]; F.ctx = args.in[I_CTX]; F.out = args.out; F.ws = args.ws; F.lds = (char*)lds_raw;
    F.tid = threadIdx.x; F.lane = F.tid & 63; F.wave = __builtin_amdgcn_readfirstlane(F.tid >> 6); F.bid = blockIdx.x; F.nblk = gridDim.x;
    F.vcu = (F.nblk % 8 == 0) ? (F.bid % 8) * (F.nblk / 8) + F.bid / 8 : F.bid;
    volatile LAS unsigned* st = (volatile LAS unsigned*)(LAS unsigned char*)(lds_raw + LDS_BYTES - 64);
    if (F.tid < 16) st[F.tid] = 0u;
    __syncthreads();
    XcdBarrier bar; bar.bar = (unsigned*)(F.ws + WS_CTL) + 4096; bar.x = 0; bar.st = st;
    const int lo = args.ph_lo, hi = args.ph_hi;
    const bool fused = (hi - lo) > 1;
    if (fused) bar = xcd_barrier_post((unsigned*)(F.ws + WS_CTL) + 4096, st);
#ifdef ONLY_PHASE
#define IN(k) ((k) == ONLY_PHASE && lo <= (k) && (k) < hi)
#else
#define IN(k) (lo <= (k) && (k) < hi)
#endif
#define SEAM(k) do { if (IN(k) && IN((k) + 1)) { if ((k) == 0) cg::this_grid().sync(); else xcd_barrier(bar); } } while (0)
    bf16_t* Hb = (bf16_t*)(F.ws + WS_H);
#define PH(k, ...) if (IN(k)) for (int rep_ = 0; rep_ < (((PROBE_MASK >> (k)) & 1u) ? 2 : 1); ++rep_) { __VA_ARGS__; __syncthreads(); } SEAM(k)
    unsigned short* Xb = (unsigned short*)(F.ws + WS_X); const float* MODb = (const float*)(F.ws + WS_MOD);
    PH(0, for (int q_ = 0; q_ < ((PROBE_P0 & 1u) ? 2 : 1); ++q_) { p0_mod(args, F); __syncthreads(); }
          for (int q_ = 0; q_ < ((PROBE_P0 & 2u) ? 2 : 1); ++q_) { p0_weights(args, F); __syncthreads(); }
          for (int q_ = 0; q_ < ((PROBE_P0 & 4u) ? 2 : 1); ++q_) { p0_weff(args, F); __syncthreads(); }
          for (int q_ = 0; q_ < ((PROBE_P0 & 8u) ? 2 : 1); ++q_) { p0_tables(args, F); __syncthreads(); });
    PH(1, p_norm_rows(args, F, 0, 0, true, false));
    PH(2, gemm8e(F, Hb, (const bf16_t*)(F.ws + WS_WIN), 768, 1024, false, EpiMlaDown{(bf16_t*)(F.ws + WS_CQ), (bf16_t*)(F.ws + WS_CKV), (bf16_t*)(F.ws + WS_KR), (float*)(F.ws + WS_SSP)}));
    PH(3, p_mla_krope(args, F);
          gemm8(F, (const bf16_t*)(F.ws + WS_CQ), (const bf16_t*)(F.ws + WS_WUQ), 1536, 384, false, In8Bf16Rs{(bf16_t*)(F.ws + WS_Q), 1536, (const float*)(F.ws + WS_SSP)});
          gemm8(F, (const bf16_t*)(F.ws + WS_CKV), (const bf16_t*)(F.ws + WS_WUKV), 2048, 256, false, In8KVRs{(bf16_t*)(F.ws + WS_K), (bf16_t*)(F.ws + WS_V), (const float*)(F.ws + WS_SSP)}));
    PH(4, p_attn_mla(args, F));
    PH(5, gemm8(F, (const bf16_t*)(F.ws + WS_O), (const bf16_t*)(F.ws + WS_WO0), 1024, 1024, false, In8Resid{F.x, F.ctx, Xb, MODb + 2 * 1024, true}));
    PH(6, p_norm_rows(args, F, 0, 1, false, false));
    PH(7, gemm8(F, Hb, (const bf16_t*)(F.ws + WS_WQ0), 2048, 1024, false, In8F16{(unsigned short*)(F.ws + WS_S), 2048}));
    PH(8, p_peer_topk(args, F, false));
    PH(9, p_exp_u(args, F, 0));
    PH(10, p_exp_w(args, F, 0));
    if (IN(11)) { p_exp_v(args, F, 0); } SEAM(11);
    PH(12, p_norm_rows(args, F, 1, 0, false, false));
    PH(13, gemm8(F, Hb, (const bf16_t*)(F.ws + WS_WQKV), 1536, 1024, false, In8Bf16{(bf16_t*)(F.ws + WS_RAW1), 1536}));
    PH(14, p_gqa_rows(args, F));
    PH(15, p_attn_gqa(args, F));
    if (IN(16)) { gemm8(F, (const bf16_t*)(F.ws + WS_O), (const bf16_t*)(F.ws + WS_WO1), 1024, 1024, true, In8Resid{F.x, F.ctx, Xb, MODb + 5 * 6144 + 2 * 1024, false}); } SEAM(16);
    PH(17, p_norm_rows(args, F, 1, 1, false, true));
    PH(18, gemm8(F, Hb, (const bf16_t*)(F.ws + WS_WQ1), 2048, 1024, true, In8F16{(unsigned short*)(F.ws + WS_S), 2048}));
    PH(19, p_peer_topk(args, F, true));
    PH(20, p_exp_u(args, F, 1));
    PH(21, p_exp_w(args, F, 1));
    if (IN(22)) { p_exp_v(args, F, 1); } SEAM(22);
    if (IN(23)) p_final_norm(args, F);
#undef PH
#undef IN
#undef SEAM
}

extern "C" void kernel_launch(void* const* d_in, const int* in_sizes, int n_in, void* d_out, int out_size, void* d_ws, size_t ws_size, hipStream_t stream) {
    static int grid = 0;
    if (grid == 0) {
        if (n_in != N_IN || in_sizes[0] != NB * SEQ * DM || out_size != NB * SEQ * DM || ws_size < WS_END) {
            fprintf(stderr, "kernel_launch: shape mismatch (n_in %d, in0 %d, out %d, ws %zu < %zu)\n", n_in, n_in > 0 ? in_sizes[0] : -1, out_size, ws_size, (size_t)WS_END); grid = -1; return; }
        int dev = 0, cus = 0, per_cu = 0;
        hipGetDevice(&dev); hipDeviceGetAttribute(&cus, hipDeviceAttributeMultiprocessorCount, dev);
        if (hipFuncSetAttribute((const void*)mega, hipFuncAttributeMaxDynamicSharedMemorySize, LDS_BYTES) != hipSuccess) { fprintf(stderr, "kernel_launch: hipFuncSetAttribute failed\n"); grid = -1; return; }
        if (hipOccupancyMaxActiveBlocksPerMultiprocessor(&per_cu, (const void*)mega, NTHREADS, LDS_BYTES) != hipSuccess || per_cu < 1) { fprintf(stderr, "kernel_launch: occupancy query failed (%d)\n", per_cu); (void)hipGetLastError(); grid = -1; return; }
        grid = cus * (per_cu > 1 ? 1 : per_cu);
    }
    if (grid < 0) return;
    hipMemsetAsync((char*)d_ws + WS_CTL, 0, 1 * MiB, stream);
    Args a{};
    for (int i = 0; i < N_IN; ++i) a.in[i] = (const float*)d_in[i];
    a.out = (float*)d_out; a.ws = (unsigned char*)d_ws;
#if MK_PER_PHASE
    for (int p = 0; p < N_PHASES; ++p) { a.ph_lo = p; a.ph_hi = p + 1; hipLaunchKernelGGL(mega, dim3(grid), dim3(NTHREADS), LDS_BYTES, stream, a); }
#else
    a.ph_lo = 0; a.ph_hi = N_PHASES;
    void* kargs[] = {&a};
    hipError_t e = hipLaunchCooperativeKernel((const void*)mega, dim3(grid), dim3(NTHREADS), kargs, LDS_BYTES, stream);
    if (e != hipSuccess) fprintf(stderr, "kernel_launch: cooperative launch failed: %s (grid %d)\n", hipGetErrorString(e), grid);
#endif
}
```

```cpp
#include <hip/hip_runtime.h>
#include <hip/hip_cooperative_groups.h>
#include <cstdio>
#include <cstdint>
namespace cg = cooperative_groups;

#ifndef PROBE_MASK
#define PROBE_MASK 0u
#endif
#ifndef PROBE_P0
#define PROBE_P0 0u
#endif
#ifndef MK_PER_PHASE
#define MK_PER_PHASE 0
#endif

typedef unsigned short bf16_t;
typedef short bf16x8 __attribute__((ext_vector_type(8)));
typedef short s16x4 __attribute__((ext_vector_type(4)));
typedef float f32x4 __attribute__((ext_vector_type(4)));
typedef float f32x2 __attribute__((ext_vector_type(2)));
typedef float f32x16 __attribute__((ext_vector_type(16)));
typedef unsigned u32x4 __attribute__((ext_vector_type(4)));
typedef unsigned u32x2 __attribute__((ext_vector_type(2)));
#define LAS __attribute__((address_space(3)))
#define SBAR() __builtin_amdgcn_sched_barrier(0)

__device__ __forceinline__ unsigned f2bf(float f) { unsigned u = __builtin_bit_cast(unsigned, f); return (u + 0x7fffu + ((u >> 16) & 1u)) >> 16; }
__device__ __forceinline__ unsigned pk2(float lo, float hi) { return f2bf(lo) | (f2bf(hi) << 16); }
typedef _Float16 f16x2_t __attribute__((ext_vector_type(2)));
__device__ __forceinline__ unsigned pkh2(float lo, float hi) { f32x2 v = {lo, hi}; return __builtin_bit_cast(unsigned, __builtin_convertvector(v, f16x2_t)); }
__device__ __forceinline__ float h2f_lo(unsigned w) { return (float)__builtin_bit_cast(_Float16, (unsigned short)(w & 0xffffu)); }
__device__ __forceinline__ float h2f_hi(unsigned w) { return (float)__builtin_bit_cast(_Float16, (unsigned short)(w >> 16)); }
__device__ __forceinline__ float bf2f(unsigned short h) { return __builtin_bit_cast(float, (unsigned)h << 16); }
__device__ __forceinline__ float bflo(unsigned w) { return __builtin_bit_cast(float, w << 16); }
__device__ __forceinline__ float bfhi(unsigned w) { return __builtin_bit_cast(float, w & 0xffff0000u); }
__device__ __forceinline__ unsigned cvtpk(float lo, float hi) { unsigned r; asm volatile("v_cvt_pk_bf16_f32 %0, %1, %2" : "=v"(r) : "v"(lo), "v"(hi)); return r; }
#define WDPP(v, ctrl) __builtin_bit_cast(float, __builtin_amdgcn_update_dpp(0, __builtin_bit_cast(int, v), ctrl, 0xf, 0xf, false))
__device__ __forceinline__ float wave_sum(float v) {
    v += WDPP(v, 0xB1); v += WDPP(v, 0x4E); v += WDPP(v, 0x141); v += WDPP(v, 0x140);
    { auto rr = __builtin_amdgcn_permlane16_swap(__float_as_uint(v), __float_as_uint(v), false, false); v = __uint_as_float(rr[0]) + __uint_as_float(rr[1]); }
    { auto rr = __builtin_amdgcn_permlane32_swap(__float_as_uint(v), __float_as_uint(v), false, false); v = __uint_as_float(rr[0]) + __uint_as_float(rr[1]); }
    return v;
}
__device__ __forceinline__ float wave_max(float v) {
    v = fmaxf(v, WDPP(v, 0xB1)); v = fmaxf(v, WDPP(v, 0x4E)); v = fmaxf(v, WDPP(v, 0x141)); v = fmaxf(v, WDPP(v, 0x140));
    { auto rr = __builtin_amdgcn_permlane16_swap(__float_as_uint(v), __float_as_uint(v), false, false); v = fmaxf(__uint_as_float(rr[0]), __uint_as_float(rr[1])); }
    { auto rr = __builtin_amdgcn_permlane32_swap(__float_as_uint(v), __float_as_uint(v), false, false); v = fmaxf(__uint_as_float(rr[0]), __uint_as_float(rr[1])); }
    return v;
}

constexpr int DM = 1024, NB = 4, SEQ = 4096, CTXL = 256;
constexpr int RPB = SEQ + CTXL;
constexpr int R = NB * RPB;
constexpr float EPS = 1e-6f;
constexpr int NTHREADS = 512, NWAVES = 8;
constexpr int LDS_BYTES = 147456;

enum { I_X = 0, I_C, I_CTX, I_CCTX,
       I0_ADAW, I0_ADAB, I0_NMIX, I0_NFFN, I0_WIN, I0_QN, I0_WUQ, I0_KVN, I0_WUKV, I0_WO, I0_PWQ, I0_PK1, I0_PK2, I0_PU, I0_PV,
       I1_ADAW, I1_ADAB, I1_NMIX, I1_NFFN, I1_WQKV, I1_QN, I1_KN, I1_WO, I1_PWQ, I1_PK1, I1_PK2, I1_PU, I1_PV,
       I_NOUT, N_IN };

constexpr size_t MiB = 1u << 20;
constexpr size_t WS_CTL   = 0;
constexpr size_t WS_MOD   = 1 * MiB;
constexpr size_t WS_WIN   = 2 * MiB;
constexpr size_t WS_WUQ   = WS_WIN + 768 * 1024 * 2;
constexpr size_t WS_WUKV  = WS_WUQ + 1536 * 384 * 2;
constexpr size_t WS_WO0   = WS_WUKV + 2048 * 256 * 2;
constexpr size_t WS_WQ0   = WS_WO0 + 1024 * 1024 * 2;
constexpr size_t WS_KK0   = WS_WQ0 + 2048 * 1024 * 2;
constexpr size_t WS_WQKV  = WS_KK0 + 16 * 128 * 128 * 2;
constexpr size_t WS_WO1   = WS_WQKV + 1536 * 1024 * 2;
constexpr size_t WS_WQ1   = WS_WO1 + 1024 * 1024 * 2;
constexpr size_t WS_KK1   = WS_WQ1 + 2048 * 1024 * 2;
constexpr size_t WS_WEND  = WS_KK1 + 16 * 128 * 128 * 2;
static_assert(WS_WEND <= 24 * MiB, "weights region");
constexpr size_t WS_H     = 24 * MiB;
constexpr size_t WS_X     = WS_H + (size_t)R * 1024 * 2;
constexpr size_t WS_QKV   = WS_X + (size_t)R * 1024 * 4;
constexpr size_t WS_Q     = WS_QKV;
constexpr size_t WS_K     = WS_Q + (size_t)R * 1536 * 2;
constexpr size_t WS_V     = WS_K + (size_t)R * 1536 * 2;
constexpr size_t WS_S     = WS_QKV;
constexpr size_t WS_B     = WS_QKV + (size_t)R * 2048 * 4;
constexpr size_t WS_CQ    = WS_B;
constexpr size_t WS_CKV   = WS_CQ + (size_t)R * 384 * 2;
constexpr size_t WS_KR    = WS_CKV + (size_t)R * 256 * 2;
constexpr size_t WS_SSP   = WS_KR + (size_t)R * 64 * 2;
static_assert(WS_SSP + (size_t)R * 24 * 4 <= WS_B + 40 * MiB, "MLA latents inside region B");
constexpr size_t WS_O     = WS_B;
constexpr size_t WS_QP    = WS_B;
constexpr size_t WS_RAW1  = WS_B;
constexpr size_t WS_PK    = WS_B + (size_t)R * 2048 * 2;
constexpr size_t WS_TAB   = WS_PK + (size_t)R * 128 * 4;
constexpr size_t WS_PD    = WS_S;
constexpr size_t WS_WQ8   = WS_PD + (size_t)8 * R * 128 * 4;
constexpr size_t WS_WSC   = WS_WQ8 + (size_t)R * 128;
static_assert(WS_WSC + (size_t)R * 4 <= WS_B, "expert scratch inside the S region");
constexpr size_t WS_HQ    = WS_B + 40 * MiB;
constexpr size_t WS_HS    = WS_HQ + (size_t)R * 1024;
static_assert(WS_HS + (size_t)R * 4 <= WS_PK, "HQ inside region B");
constexpr size_t WS_TSC   = WS_TAB + (size_t)4 * 16384 * 1024;
constexpr size_t WS_END   = WS_TSC + (size_t)4 * 16384 * 4;
constexpr size_t WS_Q1    = WS_QKV;
constexpr size_t WS_K1    = WS_Q1 + (size_t)R * 1024 * 2;
constexpr size_t WS_V1    = WS_K1 + (size_t)R * 256 * 2;

#define XB_TMO      128
#define XB_XCNT(j)  (256  + 64 * (j))
#define XB_XSUB(j)  (1280 + 64 * (j))
#define XB_XGEN(j)  (2304 + 64 * (j))
#define XB_TOP      3328
#define XB_TOPGEN   3392
#define XCD_BAR_WORDS 3456
#define XB_SPIN_CAP (1u << 20)
__device__ __forceinline__ unsigned xb_ld(unsigned* p)              { return __hip_atomic_load(p, __ATOMIC_RELAXED, __HIP_MEMORY_SCOPE_AGENT); }
__device__ __forceinline__ unsigned xb_add(unsigned* p, unsigned v) { return __hip_atomic_fetch_add(p, v, __ATOMIC_RELAXED, __HIP_MEMORY_SCOPE_AGENT); }
__device__ __forceinline__ unsigned xb_xcc_id() { return (unsigned)__builtin_amdgcn_s_getreg((3 << 11) | 20) & 0xFu; }
#define XB_SPIN(cond, bar) do { unsigned _sp = 0; while (cond) { __builtin_amdgcn_s_sleep(1); \
    if ((++_sp & 255u) == 0u) { if (xb_ld(&(bar)[XB_TMO])) break; if (_sp > XB_SPIN_CAP) { atomicAdd(&(bar)[XB_TMO], 1u); break; } } } } while (0)
struct XcdBarrier { unsigned* bar; unsigned x; volatile LAS unsigned* st; };
__device__ __forceinline__ XcdBarrier xcd_barrier_post(unsigned* bar, volatile LAS unsigned* st) {
    XcdBarrier b; b.bar = bar; b.x = xb_xcc_id(); b.st = st;
    if (threadIdx.x == 0) (void)xb_add(&bar[XB_XCNT(b.x)], 1u);
    return b;
}
__device__ __forceinline__ void xcd_barrier_complete(unsigned* bar, unsigned x, unsigned& nloc, unsigned& nx) {
    const unsigned G = gridDim.x * gridDim.y * gridDim.z;
    unsigned sum, cnt, mine, sp = 0u;
    for (;;) {
        sum = 0u; cnt = 0u; mine = 0u;
#pragma unroll
        for (unsigned j = 0; j < 16; ++j) { const unsigned c = xb_ld(&bar[XB_XCNT(j)]); sum += c; cnt += (c > 0u) ? 1u : 0u; mine = (j == x) ? c : mine; }
        if (sum == G) break;
        __builtin_amdgcn_s_sleep(1);
        if ((++sp & 255u) == 0u) { if (xb_ld(&bar[XB_TMO])) break; if (sp > XB_SPIN_CAP) { atomicAdd(&bar[XB_TMO], 1u); break; } }
    }
    nloc = mine > 0u ? mine : 1u; nx = cnt > 0u ? cnt : 1u;
}
__device__ __forceinline__ void xcd_barrier(const XcdBarrier& b) {
    asm volatile("s_waitcnt vmcnt(0)" ::: "memory");
    __syncthreads();
    if (threadIdx.x == 0) {
        unsigned* bar = b.bar;
        __builtin_amdgcn_s_waitcnt(0);
        unsigned nloc = b.st[0], nx = b.st[1];
        if (nloc == 0u) { xcd_barrier_complete(bar, b.x, nloc, nx); b.st[0] = nloc; b.st[1] = nx; }
        const unsigned old = xb_add(&bar[XB_XSUB(b.x)], 1u);
        const unsigned gen = old / nloc;
        if (old + 1u == (gen + 1u) * nloc) {
            __builtin_amdgcn_fence(__ATOMIC_RELEASE, "agent");
            asm volatile("s_waitcnt vmcnt(0)" ::: "memory");
            const unsigned og = xb_add(&bar[XB_TOP], 1u);
            const unsigned tg = og / nx;
            if (og + 1u == (tg + 1u) * nx) xb_add(&bar[XB_TOPGEN], 1u);
            else XB_SPIN(xb_ld(&bar[XB_TOPGEN]) == tg, bar);
            __builtin_amdgcn_fence(__ATOMIC_ACQUIRE, "agent");
            xb_add(&bar[XB_XGEN(b.x)], 1u);
            asm volatile("s_waitcnt vmcnt(0)" ::: "memory");
        } else {
            XB_SPIN(xb_ld(&bar[XB_XGEN(b.x)]) == gen, bar);
            __builtin_amdgcn_fence(__ATOMIC_ACQUIRE, "agent");
            asm volatile("s_waitcnt vmcnt(0)" ::: "memory");
        }
    }
    __syncthreads();
}


struct Args { const float* in[N_IN]; float* out; unsigned char* ws; int ph_lo, ph_hi; };
static_assert(sizeof(Args) == (N_IN + 2) * 8 + 8, "Args has no padding");

struct Frame {
    const float* x; const float* ctx; float* out; unsigned char* ws; char* lds;
    int tid, lane, wave, bid, nblk, vcu;
};

__device__ __forceinline__ const float* xin_row(const Frame& F, int r) {
    const int b = r / RPB, j = r - b * RPB;
    return (j < CTXL) ? F.ctx + ((size_t)b * CTXL + j) * DM : F.x + ((size_t)b * SEQ + (j - CTXL)) * DM;
}
__device__ __forceinline__ int mod_index(int r) { const int b = r / RPB, j = r - b * RPB; return (j < CTXL) ? 4 : b; }
__device__ __forceinline__ bool is_ctx_row(int r) { return (r % RPB) < CTXL; }

__device__ __forceinline__ void p0_mod(const Args& A, const Frame& F) {
    float* sv = (float*)F.lds;
    float* red = sv + 5 * 1024;
    float* MOD = (float*)(F.ws + WS_MOD);
    bool have = false;
    for (int it = F.bid; it < 2 * 96; it += F.nblk) {
        if (!have) {
            for (int i = F.tid; i < 5 * 1024; i += NTHREADS) { const int m = i >> 10, k = i & 1023;
                const float c = (m < 4) ? A.in[I_C][m * 1024 + k] : A.in[I_CCTX][k]; sv[i] = c / (1.f + __expf(-c)); }
            __syncthreads(); have = true;
        }
        const int l = it / 96, n = (it % 96) * 64 + F.lane;
        const float* W = A.in[l ? I1_ADAW : I0_ADAW]; const float* Bv = A.in[l ? I1_ADAB : I0_ADAB];
        float acc[5] = {0.f, 0.f, 0.f, 0.f, 0.f};
        const int k0 = F.wave * 128;
#pragma unroll 16
        for (int k = k0; k < k0 + 128; ++k) { const float w = W[(size_t)k * 6144 + n];
#pragma unroll
            for (int m = 0; m < 5; ++m) acc[m] += sv[m * 1024 + k] * w; }
#pragma unroll
        for (int m = 0; m < 5; ++m) red[(F.wave * 5 + m) * 64 + F.lane] = acc[m];
        __syncthreads();
        if (F.tid < 320) { const int m = F.tid >> 6, ln = F.tid & 63; float s = 0.f;
#pragma unroll
            for (int w = 0; w < 8; ++w) s += red[(w * 5 + m) * 64 + ln];
            const int nn = (it % 96) * 64 + ln;
            MOD[((size_t)l * 5 + m) * 6144 + nn] = s + Bv[nn]; }
        __syncthreads();
    }
}
__device__ __forceinline__ void transpose_item(const float* W, int K, int N, bf16_t* WT, const float* gain, float* scr, int item, int lane) {
    const int nblk = N / 32, kb = item / nblk, nb = item % nblk, k0 = 64 * kb, n0 = 32 * nb;
#pragma unroll 8
    for (int i = 0; i < 32; ++i) { const int kk = 2 * i + (lane >> 5); float v = W[(size_t)(k0 + kk) * N + n0 + (lane & 31)]; if (gain) v *= gain[k0 + kk]; scr[kk * 33 + (lane & 31)] = v; }
    asm volatile("s_waitcnt lgkmcnt(0)" ::: "memory");
    const int c = lane & 7;
#pragma unroll
    for (int j = 0; j < 4; ++j) { const int n = (lane >> 3) + 8 * j; const float* s = scr + (8 * c) * 33 + n;
        u32x4 o; o.x = pk2(s[0 * 33], s[1 * 33]); o.y = pk2(s[2 * 33], s[3 * 33]); o.z = pk2(s[4 * 33], s[5 * 33]); o.w = pk2(s[6 * 33], s[7 * 33]);
        *(u32x4*)(WT + (size_t)(n0 + n) * K + k0 + 8 * c) = o; }
    asm volatile("s_waitcnt lgkmcnt(0)" ::: "memory");
}
__device__ __forceinline__ void p0_weights(const Args& A, const Frame& F) {
    float* scr = (float*)(F.lds + 32768) + F.wave * (64 * 33);
    const int gw = F.bid * NWAVES + F.wave, NGW = F.nblk * NWAVES;
#define TJOB(IN_, K_, N_, OFF_, GAIN_) do { const float* W = A.in[IN_]; bf16_t* WT = (bf16_t*)(F.ws + (OFF_)); \
        for (int it = gw; it < ((K_) / 64) * ((N_) / 32); it += NGW) transpose_item(W, K_, N_, WT, GAIN_, scr, it, F.lane); } while (0)
    TJOB(I0_WIN, 1024, 704, WS_WIN, nullptr); TJOB(I0_WUQ, 384, 1536, WS_WUQ, A.in[I0_QN]); TJOB(I0_WUKV, 256, 2048, WS_WUKV, A.in[I0_KVN]); TJOB(I0_WO, 1024, 1024, WS_WO0, nullptr);
    TJOB(I1_WQKV, 1024, 1536, WS_WQKV, nullptr); TJOB(I1_WO, 1024, 1024, WS_WO1, nullptr);
#undef TJOB
    { u32x4* z = (u32x4*)(F.ws + WS_WIN + (size_t)704 * 1024 * 2); const int n16 = 64 * 1024 * 2 / 16;
      for (int i = F.bid * NTHREADS + F.tid; i < n16; i += F.nblk * NTHREADS) z[i] = (u32x4){0u, 0u, 0u, 0u}; }
}
__device__ __forceinline__ void p0_weff(const Args& A, const Frame& F) {
    float* kkT = (float*)F.lds; float* wqs = kkT + 128 * 129;
    const int tid = F.tid, lane = F.lane, w = F.wave;
    for (int item = F.bid; item < 512; item += F.nblk) {
        const int layer = item >> 8, z = (item >> 4) & 15, kc = item & 15, h = z >> 1;
        const float* kk = ((z & 1) ? (layer ? A.in[I1_PK2] : A.in[I0_PK2]) : (layer ? A.in[I1_PK1] : A.in[I0_PK1])) + (size_t)h * 16384;
        const float* wq = (layer ? A.in[I1_PWQ] : A.in[I0_PWQ]) + (size_t)(kc * 64) * 2048 + z * 128;
        bf16_t* WT = (bf16_t*)(F.ws + (layer ? WS_WQ1 : WS_WQ0));
        __syncthreads();
        { f32x4 kv[8], wv4[4];
#pragma unroll
          for (int i = 0; i < 8; ++i) kv[i] = *(const f32x4*)(kk + 4 * (tid + i * NTHREADS));
#pragma unroll
          for (int i = 0; i < 4; ++i) { const int e = 4 * (tid + i * NTHREADS); wv4[i] = *(const f32x4*)(wq + (size_t)(e >> 7) * 2048 + (e & 127)); }
#pragma unroll
          for (int i = 0; i < 8; ++i) { const int e = 4 * (tid + i * NTHREADS), key = e >> 7, d = e & 127; kkT[d * 129 + key] = kv[i].x; kkT[(d + 1) * 129 + key] = kv[i].y; kkT[(d + 2) * 129 + key] = kv[i].z; kkT[(d + 3) * 129 + key] = kv[i].w; }
#pragma unroll
          for (int i = 0; i < 4; ++i) *(f32x4*)(wqs + 4 * (tid + i * NTHREADS)) = wv4[i]; }
        __syncthreads();
        float acc[8][2];
#pragma unroll
        for (int j = 0; j < 8; ++j) { acc[j][0] = 0.f; acc[j][1] = 0.f; }
#pragma unroll 2
        for (int d = 0; d < 128; ++d) { const float a0 = kkT[d * 129 + lane], a1 = kkT[d * 129 + lane + 64];
#pragma unroll
            for (int j = 0; j < 8; ++j) { const float wv = wqs[(w * 8 + j) * 128 + d]; acc[j][0] += wv * a0; acc[j][1] += wv * a1; } }
        u32x4 o0, o1;
        o0.x = pk2(acc[0][0], acc[1][0]); o0.y = pk2(acc[2][0], acc[3][0]); o0.z = pk2(acc[4][0], acc[5][0]); o0.w = pk2(acc[6][0], acc[7][0]);
        o1.x = pk2(acc[0][1], acc[1][1]); o1.y = pk2(acc[2][1], acc[3][1]); o1.z = pk2(acc[4][1], acc[5][1]); o1.w = pk2(acc[6][1], acc[7][1]);
        *(u32x4*)(WT + (size_t)(z * 128 + lane) * 1024 + kc * 64 + w * 8) = o0;
        *(u32x4*)(WT + (size_t)(z * 128 + lane + 64) * 1024 + kc * 64 + w * 8) = o1;
    }
    __syncthreads();
}

__device__ __forceinline__ void p0_tables(const Args& A, const Frame& F) {
    const int gw = F.bid * NWAVES + F.wave, NGW = F.nblk * NWAVES, lane = F.lane;
    unsigned char* TAB = F.ws + WS_TAB; float* TSC = (float*)(F.ws + WS_TSC);
    for (int it = gw; it < 4 * 16384 / 4; it += NGW) {
        const int t = it >> 12, row0 = (it & 4095) * 4;
        const float* src = (t == 0 ? A.in[I0_PU] : t == 1 ? A.in[I0_PV] : t == 2 ? A.in[I1_PU] : A.in[I1_PV]) + (size_t)row0 * 1024 + 4 * lane;
        f32x4 v[4][4];
#pragma unroll
        for (int rr = 0; rr < 4; ++rr)
#pragma unroll
            for (int j = 0; j < 4; ++j) v[rr][j] = *(const f32x4*)(src + (size_t)rr * 1024 + 256 * j);
#pragma unroll
        for (int rr = 0; rr < 4; ++rr) {
            float am = 0.f;
#pragma unroll
            for (int j = 0; j < 4; ++j) am = fmaxf(am, fmaxf(fmaxf(fabsf(v[rr][j].x), fabsf(v[rr][j].y)), fmaxf(fabsf(v[rr][j].z), fabsf(v[rr][j].w))));
            am = wave_max(am);
            const float sc = am > 0.f ? am * (1.f / 127.f) : 1.f, inv = am > 0.f ? 127.f / am : 0.f;
            const int row = row0 + rr;
#pragma unroll
            for (int j = 0; j < 4; ++j) { const unsigned b0 = (unsigned)((int)rintf(v[rr][j].x * inv)) & 0xffu, b1 = (unsigned)((int)rintf(v[rr][j].y * inv)) & 0xffu, b2 = (unsigned)((int)rintf(v[rr][j].z * inv)) & 0xffu, b3 = (unsigned)((int)rintf(v[rr][j].w * inv)) & 0xffu;
                *(unsigned*)(TAB + (((size_t)t * 8 + 2 * j + (lane >> 5)) * 16384 + row) * 128 + 4 * (lane & 31)) = b0 | (b1 << 8) | (b2 << 16) | (b3 << 24); }
            if (lane == 0) TSC[t * 16384 + row] = sc;
        }
    }
}

__device__ __forceinline__ void norm_mod_store(const f32x4 (&v)[4], float rinv, const float* g, const float* sh, const float* sc, bf16_t* orow, int lane) {
#pragma unroll
    for (int j = 0; j < 4; ++j) { const int c = 4 * lane + 256 * j;
        const f32x4 gg = *(const f32x4*)(g + c), s1 = *(const f32x4*)(sc + c), s0 = *(const f32x4*)(sh + c);
        const f32x4 y = (v[j] * rinv * gg) * (s1 + 1.f) + s0;
        u32x2 o; o.x = pk2(y.x, y.y); o.y = pk2(y.z, y.w); *(u32x2*)(orow + c) = o; }
}
__device__ __forceinline__ int tok_row(int layer, int n);
__device__ __forceinline__ void norm_row_out(const Frame& F, const f32x4 (&v)[4], float rinv, const float* g, const float* mm, int r, int which) {
    norm_mod_store(v, rinv, g, mm, mm + 1024, (bf16_t*)(F.ws + WS_H) + (size_t)r * DM, F.lane);
    if (which) {
        f32x4 y[4]; float am = 0.f;
#pragma unroll
        for (int j = 0; j < 4; ++j) { const int c = 4 * F.lane + 256 * j; y[j] = (v[j] * rinv * *(const f32x4*)(g + c)) * (*(const f32x4*)(mm + 1024 + c) + 1.f) + *(const f32x4*)(mm + c);
            am = fmaxf(am, fmaxf(fmaxf(fabsf(y[j].x), fabsf(y[j].y)), fmaxf(fabsf(y[j].z), fabsf(y[j].w)))); }
        am = wave_max(am);
        const float inv = am > 0.f ? 127.f / am : 0.f;
#pragma unroll
        for (int j = 0; j < 4; ++j) { const unsigned b0 = (unsigned)((int)rintf(y[j].x * inv)) & 0xffu, b1 = (unsigned)((int)rintf(y[j].y * inv)) & 0xffu, b2 = (unsigned)((int)rintf(y[j].z * inv)) & 0xffu, b3 = (unsigned)((int)rintf(y[j].w * inv)) & 0xffu;
            *(unsigned*)(F.ws + WS_HQ + (size_t)r * DM + 4 * F.lane + 256 * j) = b0 | (b1 << 8) | (b2 << 16) | (b3 << 24); }
        if (F.lane == 0) ((float*)(F.ws + WS_HS))[r] = am > 0.f ? am * (1.f / 127.f) : 1.f;
    }
}
__device__ __forceinline__ void p_norm_rows(const Args& A, const Frame& F, int layer, int which, bool from_input, bool skip_ctx) {
    const int gw = F.bid * NWAVES + F.wave, NGW = F.nblk * NWAVES;
    const float* g = A.in[layer ? (which ? I1_NFFN : I1_NMIX) : (which ? I0_NFFN : I0_NMIX)];
    const float* MOD = (const float*)(F.ws + WS_MOD) + (size_t)layer * 5 * 6144;
    const unsigned short* X = (const unsigned short*)(F.ws + WS_X);
    const int ntok = skip_ctx ? NB * SEQ : R;
    for (int n = gw; n < ntok; n += 2 * NGW) {
        const bool has1 = (n + NGW) < ntok;
        const int r0 = skip_ctx ? tok_row(1, n) : n, r1 = has1 ? (skip_ctx ? tok_row(1, n + NGW) : n + NGW) : r0;
        f32x4 v0[4], v1[4]; float s0 = 0.f, s1 = 0.f;
        if (from_input) { const float* x0 = xin_row(F, r0); const float* x1 = xin_row(F, r1);
#pragma unroll
            for (int j = 0; j < 4; ++j) { v0[j] = *(const f32x4*)(x0 + 4 * F.lane + 256 * j); v1[j] = *(const f32x4*)(x1 + 4 * F.lane + 256 * j); } }
        else {
#pragma unroll
            for (int j = 0; j < 4; ++j) { const u32x2 a = *(const u32x2*)(X + (size_t)r0 * DM + 4 * F.lane + 256 * j), b = *(const u32x2*)(X + (size_t)r1 * DM + 4 * F.lane + 256 * j);
                v0[j] = (f32x4){h2f_lo(a.x), h2f_hi(a.x), h2f_lo(a.y), h2f_hi(a.y)}; v1[j] = (f32x4){h2f_lo(b.x), h2f_hi(b.x), h2f_lo(b.y), h2f_hi(b.y)}; } }
#pragma unroll
        for (int j = 0; j < 4; ++j) { s0 += (v0[j].x * v0[j].x + v0[j].y * v0[j].y) + (v0[j].z * v0[j].z + v0[j].w * v0[j].w); s1 += (v1[j].x * v1[j].x + v1[j].y * v1[j].y) + (v1[j].z * v1[j].z + v1[j].w * v1[j].w); }
        const float ri0 = rsqrtf(wave_sum(s0) * (1.f / DM) + EPS), ri1 = rsqrtf(wave_sum(s1) * (1.f / DM) + EPS);
        norm_row_out(F, v0, ri0, g, MOD + (size_t)mod_index(r0) * 6144 + (which ? 3 * 1024 : 0), r0, which);
        if (has1) norm_row_out(F, v1, ri1, g, MOD + (size_t)mod_index(r1) * 6144 + (which ? 3 * 1024 : 0), r1, which);
    }
}

namespace pg8 {
#define PG8_LAS __attribute__((address_space(3)))
typedef unsigned short bf16_t;
typedef short bf16x8 __attribute__((ext_vector_type(8)));
typedef float f32x4 __attribute__((ext_vector_type(4)));
typedef unsigned u32x4 __attribute__((ext_vector_type(4)));
constexpr int BM = 256, BK = 64, HALF = 128, HTB = HALF * BK * 2  , STAGE_BYTES = 8 * HTB, NXCD = 8, WGM = 8;

__host__ __device__ __forceinline__ int lds_byte(int r, int c) { const int st = (r >> 4) * 2 + (c >> 5), rr = r & 15, cc = c & 31, ob = rr * 64 + cc * 2; return st * 1024 + (ob ^ (((ob >> 9) & 1) << 5)); }
__host__ __device__ __forceinline__ void stage_rc(int b, int& R, int& C) { const int st = b / 1024, sb = b % 1024, swz = sb ^ (((sb >> 9) & 1) << 5); R = (st >> 1) * 16 + swz / 64; C = (st & 1) * 32 + (swz % 64) / 2; }
__host__ __device__ __forceinline__ int perm32(int rho) { const int n = rho >> 4, i = rho & 15; return 8 * (i >> 2) + 4 * n + (i & 3); }

struct Unit { int pm, pn; };
struct Gemm { const bf16_t* A; const bf16_t* Bt; int M, N, K; };

struct StaticOrder {
    int nM, nN, nwg, G, c;
    __host__ __device__ void init(int M, int N, int G_, int c_) { nM = M / BM; nN = N / BM; nwg = nM * nN; G = G_; c = c_; }
    __host__ __device__ bool next(int i, Unit& u) const {
        const long L = (long)i * G + c; if (L >= nwg) return false;
        int wgid = (int)L; { const int q = nwg / NXCD, r = nwg % NXCD, xcd = wgid % NXCD, off = wgid / NXCD; wgid = (xcd < r ? xcd * (q + 1) : r * (q + 1) + (xcd - r) * q) + off; }
        const int nig = WGM * nN, gid = wgid / nig, fm = gid * WGM, gsz = (nM - fm) < WGM ? (nM - fm) : WGM;
        u.pm = fm + ((wgid % nig) % gsz); u.pn = (wgid % nig) / gsz; return true;
    }
    __device__ __forceinline__ void a_ready(const Unit&) const {}
    __device__ __forceinline__ void done(const Unit&) const {}
};

template <class Epi, class Sched, bool ALIGN_EPI = false, bool SP2 = false>
__device__ __forceinline__ void gemm_phase(PG8_LAS unsigned char* lds, const Gemm g, const Sched& S, const Epi& E) {
    const int tid = threadIdx.x, wid = __builtin_amdgcn_readfirstlane(tid >> 6), lane = tid & 63, wr = wid >> 2, wc = wid & 3, fr = lane & 15, fq = lane >> 4;
    const int K = g.K, nt = K / BK;
    unsigned voffA[2], voffB[2];
#pragma unroll
    for (int i = 0; i < 2; ++i) { int R, C; stage_rc(tid * 16 + i * 8192, R, C); const int Rb = Epi::PERM ? ((R & ~31) + perm32(R & 31)) : R;
        voffA[i] = (unsigned)(R * K + C) * 2u; voffB[i] = (unsigned)(Rb * K + C) * 2u; }
    const size_t kstep = (size_t)(BK * 2);
    const size_t hstep = (size_t)HALF * K * 2;
    const size_t tstep = 2 * hstep;
    const unsigned ldsw = (unsigned)wid * 1024u;
    const int aoff = lds_byte(wr * 64 + fr, fq * 8), boff = lds_byte(wc * 32 + fr, fq * 8);
#define PG8_SA(b, h) (((b) * 2 + (h)) * HTB)
#define PG8_SB(b, h) ((4 + (b) * 2 + (h)) * HTB)
#define PG8_STAGE(bufoff, gbase, voff) do { _Pragma("unroll") for (int _i = 0; _i < 2; ++_i) \
        __builtin_amdgcn_global_load_lds((const unsigned*)((const char*)(gbase) + (voff)[_i]), (PG8_LAS unsigned*)(lds + (bufoff) + ldsw + _i * 8192), 16, 0, 0); } while (0)
#define PG8_LDA(dst, b, h) do { _Pragma("unroll") for (int m = 0; m < 4; ++m) _Pragma("unroll") for (int k = 0; k < 2; ++k) dst[m][k] = *(const PG8_LAS bf16x8*)(lds + PG8_SA(b, h) + aoff + m * 2048 + k * 1024); } while (0)
#define PG8_LDB(dst, b, h) do { _Pragma("unroll") for (int n = 0; n < 2; ++n) _Pragma("unroll") for (int k = 0; k < 2; ++k) dst[n][k] = *(const PG8_LAS bf16x8*)(lds + PG8_SB(b, h) + boff + n * 2048 + k * 1024); } while (0)
#define PG8_MMA(ai, bj, At, Bt) do { __builtin_amdgcn_s_setprio(1); _Pragma("unroll") for (int m = 0; m < 4; ++m) _Pragma("unroll") for (int n = 0; n < 2; ++n) _Pragma("unroll") for (int k = 0; k < 2; ++k) \
        acc[ai][bj][m][n] = __builtin_amdgcn_mfma_f32_16x16x32_bf16(Bt[n][k], At[m][k], acc[ai][bj][m][n], 0, 0, 0); __builtin_amdgcn_s_setprio(0); } while (0)
#define PG8_WAIT_V(n) asm volatile("s_waitcnt vmcnt(" #n ")" ::: "memory")
#define PG8_WAIT_L(n) asm volatile("s_waitcnt lgkmcnt(" #n ")" ::: "memory")
#define PG8_BAR __builtin_amdgcn_s_barrier()
#define PG8_SCHED __builtin_amdgcn_sched_barrier(0)
    Unit cur, nxt; int ui = 0;
    if (!S.next(0, cur)) return;
    f32x4 acc[2][2][4][2];
#pragma unroll
    for (int a = 0; a < 2; ++a)
#pragma unroll
        for (int b = 0; b < 2; ++b)
#pragma unroll
            for (int m = 0; m < 4; ++m)
#pragma unroll
                for (int n = 0; n < 2; ++n) acc[a][b][m][n] = (f32x4){0.f, 0.f, 0.f, 0.f};
    bf16x8 At[4][2], B0[2][2], B1[2][2];
    const char* cA = (const char*)g.A + (size_t)cur.pm * tstep; const char* cB = (const char*)g.Bt + (size_t)cur.pn * tstep;
    S.a_ready(cur);
    if constexpr (SP2) {
        PG8_STAGE(PG8_SB(0, 0), cB, voffB); PG8_STAGE(PG8_SB(0, 1), cB + hstep, voffB); PG8_STAGE(PG8_SA(0, 0), cA, voffA); PG8_STAGE(PG8_SA(0, 1), cA + hstep, voffA);
        if (wr == 1) PG8_BAR;
        PG8_WAIT_V(2); PG8_BAR;
        PG8_STAGE(PG8_SB(1, 0), cB + kstep, voffB); PG8_STAGE(PG8_SA(1, 0), cA + kstep, voffA); PG8_STAGE(PG8_SB(1, 1), cB + hstep + kstep, voffB);
        PG8_WAIT_V(6); PG8_BAR;
    } else {
        PG8_STAGE(PG8_SB(0, 0), cB, voffB); PG8_STAGE(PG8_SA(0, 0), cA, voffA); PG8_STAGE(PG8_SB(0, 1), cB + hstep, voffB); PG8_STAGE(PG8_SA(0, 1), cA + hstep, voffA);
        if (wr == 1) PG8_BAR;
        PG8_WAIT_V(4); PG8_BAR;
        PG8_STAGE(PG8_SB(1, 0), cB + kstep, voffB); PG8_STAGE(PG8_SA(1, 0), cA + kstep, voffA); PG8_STAGE(PG8_SB(1, 1), cB + hstep + kstep, voffB);
        PG8_WAIT_V(6); PG8_BAR;
    }
    for (;;) {
        const bool has_next = S.next(ui + 1, nxt);
        const char* nA = has_next ? (const char*)g.A + (size_t)nxt.pm * tstep : cA; const char* nB = has_next ? (const char*)g.Bt + (size_t)nxt.pn * tstep : cB;
        for (int t = 0; t < nt; t += 2) {
            const bool last = (t == nt - 2);
            const char* a1 = cA + (size_t)(t + 1) * kstep;
            const char* a2 = last ? nA : cA + (size_t)(t + 2) * kstep; const char* b2 = last ? nB : cB + (size_t)(t + 2) * kstep;
            const char* a3 = a2 + kstep; const char* b3 = b2 + kstep;
            if (last && has_next) S.a_ready(nxt);
            if constexpr (SP2) {
            PG8_LDB(B0, 0, 0); PG8_LDB(B1, 0, 1); PG8_SCHED; PG8_LDA(At, 0, 0); PG8_STAGE(PG8_SA(1, 1), a1 + hstep, voffA);
            PG8_WAIT_V(8); PG8_WAIT_L(0); PG8_BAR; PG8_MMA(0, 0, At, B0); PG8_MMA(0, 1, At, B1); PG8_BAR; PG8_SCHED;
            PG8_LDA(At, 0, 1); PG8_STAGE(PG8_SB(0, 0), b2, voffB); PG8_STAGE(PG8_SB(0, 1), b2 + hstep, voffB); PG8_STAGE(PG8_SA(0, 0), a2, voffA);
            PG8_WAIT_V(8); PG8_WAIT_L(0); PG8_BAR; PG8_MMA(1, 0, At, B0); PG8_MMA(1, 1, At, B1); PG8_BAR; PG8_SCHED;
            PG8_LDB(B0, 1, 0); PG8_LDB(B1, 1, 1); PG8_SCHED; PG8_LDA(At, 1, 0); PG8_STAGE(PG8_SA(0, 1), a2 + hstep, voffA);
            PG8_WAIT_V(8); PG8_WAIT_L(0); PG8_BAR; PG8_MMA(0, 0, At, B0); PG8_MMA(0, 1, At, B1); PG8_BAR; PG8_SCHED;
            PG8_LDA(At, 1, 1); PG8_STAGE(PG8_SB(1, 0), b3, voffB); PG8_STAGE(PG8_SB(1, 1), b3 + hstep, voffB); PG8_STAGE(PG8_SA(1, 0), a3, voffA);
            PG8_WAIT_V(8); PG8_WAIT_L(0); PG8_BAR; PG8_MMA(1, 0, At, B0); PG8_MMA(1, 1, At, B1); PG8_BAR; PG8_SCHED;
            } else {
            PG8_LDB(B0, 0, 0); PG8_SCHED; PG8_LDA(At, 0, 0); PG8_STAGE(PG8_SA(1, 1), a1 + hstep, voffA);
            PG8_WAIT_L(8); PG8_BAR; PG8_WAIT_L(0); PG8_MMA(0, 0, At, B0); PG8_BAR; PG8_SCHED;
            PG8_LDB(B1, 0, 1); PG8_STAGE(PG8_SB(0, 0), b2, voffB);
            PG8_BAR; PG8_WAIT_L(0); PG8_MMA(0, 1, At, B1); PG8_BAR;
            PG8_LDA(At, 0, 1); PG8_STAGE(PG8_SA(0, 0), a2, voffA);
            PG8_BAR; PG8_WAIT_L(0); PG8_MMA(1, 0, At, B0); PG8_BAR; PG8_SCHED;
            PG8_STAGE(PG8_SB(0, 1), b2 + hstep, voffB);
            PG8_WAIT_V(6); PG8_BAR; PG8_MMA(1, 1, At, B1); PG8_BAR;
            PG8_LDB(B0, 1, 0); PG8_SCHED; PG8_LDA(At, 1, 0); PG8_STAGE(PG8_SA(0, 1), a2 + hstep, voffA);
            PG8_WAIT_L(8); PG8_BAR; PG8_WAIT_L(0); PG8_MMA(0, 0, At, B0); PG8_BAR; PG8_SCHED;
            PG8_LDB(B1, 1, 1); PG8_STAGE(PG8_SB(1, 0), b3, voffB);
            PG8_BAR; PG8_WAIT_L(0); PG8_MMA(0, 1, At, B1); PG8_BAR;
            PG8_LDA(At, 1, 1); PG8_STAGE(PG8_SA(1, 0), a3, voffA);
            PG8_BAR; PG8_WAIT_L(0); PG8_MMA(1, 0, At, B0); PG8_BAR; PG8_SCHED;
            PG8_STAGE(PG8_SB(1, 1), b3 + hstep, voffB);
            PG8_WAIT_V(6); PG8_BAR; PG8_MMA(1, 1, At, B1); PG8_BAR;
            }
        }
        if constexpr (ALIGN_EPI) { if (wr == 0) PG8_BAR; }
        if constexpr (!Epi::AFTER_DRAIN) { E(acc, cur, wr, wc, fr, fq); S.done(cur); }
        if (!has_next) break;
#pragma unroll
        for (int a = 0; a < 2; ++a)
#pragma unroll
            for (int b = 0; b < 2; ++b)
#pragma unroll
                for (int m = 0; m < 4; ++m)
#pragma unroll
                    for (int n = 0; n < 2; ++n) acc[a][b][m][n] = (f32x4){0.f, 0.f, 0.f, 0.f};
        cur = nxt; cA = nA; cB = nB; ++ui;
        if constexpr (ALIGN_EPI) { if (wr == 1) PG8_BAR; }
    }
    PG8_WAIT_V(0);
    if constexpr (!ALIGN_EPI) { if (wr == 0) PG8_BAR; }
    PG8_BAR;
    if constexpr (Epi::AFTER_DRAIN) { E.fused(acc, cur, wr, wc, fr, fq, lds, wid, lane); S.done(cur); }
#undef PG8_SA
#undef PG8_SB
#undef PG8_STAGE
#undef PG8_LDA
#undef PG8_LDB
#undef PG8_MMA
#undef PG8_WAIT_V
#undef PG8_WAIT_L
#undef PG8_BAR
#undef PG8_SCHED
}
}

template <class Inner> struct EpiTile { static constexpr bool PERM = true, AFTER_DRAIN = false; Inner in;
    __device__ __forceinline__ void operator()(const pg8::f32x4 (&acc)[2][2][4][2], const pg8::Unit& u, int wr, int wc, int fr, int fq) const {
#pragma unroll
        for (int ai = 0; ai < 2; ++ai)
#pragma unroll
            for (int m = 0; m < 4; ++m) { const int row = u.pm * 256 + ai * 128 + wr * 64 + m * 16 + fr;
#pragma unroll
                for (int bj = 0; bj < 2; ++bj) in(row, u.pn * 256 + bj * 128 + wc * 32 + 8 * fq, acc[ai][bj][m][0], acc[ai][bj][m][1]); }
    } };
struct In8Bf16 { bf16_t* C; int ldc;
    __device__ __forceinline__ void operator()(int row, int col, f32x4 a, f32x4 b) const { u32x4 o; o.x = cvtpk(a.x, a.y); o.y = cvtpk(a.z, a.w); o.z = cvtpk(b.x, b.y); o.w = cvtpk(b.z, b.w); *(u32x4*)(C + (size_t)row * ldc + col) = o; } };
struct In8KV { bf16_t* Kb; bf16_t* Vb;
    __device__ __forceinline__ void operator()(int row, int col, f32x4 a, f32x4 b) const { const int h = col >> 8, c = col & 255; u32x4 o; o.x = cvtpk(a.x, a.y); o.y = cvtpk(a.z, a.w); o.z = cvtpk(b.x, b.y); o.w = cvtpk(b.z, b.w);
        bf16_t* p = (c < 128) ? Kb + (size_t)row * 1536 + h * 192 + c : Vb + (size_t)row * 1024 + h * 128 + (c - 128);
        *(u32x4*)p = o; } };
struct In8F16 { unsigned short* C; int ldc;
    __device__ __forceinline__ void operator()(int row, int col, f32x4 a, f32x4 b) const { u32x4 o; o.x = pkh2(a.x, a.y); o.y = pkh2(a.z, a.w); o.z = pkh2(b.x, b.y); o.w = pkh2(b.z, b.w); *(u32x4*)(C + (size_t)row * ldc + col) = o; } };
struct In8F32 { float* C; int ldc;
    __device__ __forceinline__ void operator()(int row, int col, f32x4 a, f32x4 b) const { float* p = C + (size_t)row * ldc + col; *(f32x4*)p = a; *(f32x4*)(p + 4) = b; } };
struct In8Resid { const float* x; const float* ctx; unsigned short* X; const float* gate; bool from_input;
    __device__ __forceinline__ void operator()(int row, int col, f32x4 a, f32x4 b) const {
        const int bb = row / RPB, j = row - bb * RPB; unsigned short* xo = X + (size_t)row * DM + col;
        f32x4 x0, x1;
        if (from_input) { const float* xi = ((j < CTXL) ? ctx + ((size_t)bb * CTXL + j) * DM : x + ((size_t)bb * SEQ + (j - CTXL)) * DM) + col; x0 = *(const f32x4*)xi; x1 = *(const f32x4*)(xi + 4); }
        else { const u32x4 w = *(const u32x4*)xo; x0 = (f32x4){h2f_lo(w.x), h2f_hi(w.x), h2f_lo(w.y), h2f_hi(w.y)}; x1 = (f32x4){h2f_lo(w.z), h2f_hi(w.z), h2f_lo(w.w), h2f_hi(w.w)}; }
        const float* g = gate + (size_t)((j < CTXL) ? 4 : bb) * 6144 + col;
        x0 += *(const f32x4*)g * a; x1 += *(const f32x4*)(g + 4) * b;
        u32x4 o; o.x = pkh2(x0.x, x0.y); o.y = pkh2(x0.z, x0.w); o.z = pkh2(x1.x, x1.y); o.w = pkh2(x1.z, x1.w); *(u32x4*)xo = o; } };
struct EpiMlaDown { static constexpr bool PERM = true, AFTER_DRAIN = false; bf16_t* CQ; bf16_t* CKV; bf16_t* KR; float* SSP;
    __device__ __forceinline__ void operator()(const pg8::f32x4 (&acc)[2][2][4][2], const pg8::Unit& u, int wr, int wc, int fr, int fq) const {
#pragma unroll
        for (int ai = 0; ai < 2; ++ai)
#pragma unroll
            for (int m = 0; m < 4; ++m) { const int row = u.pm * 256 + ai * 128 + wr * 64 + m * 16 + fr;
#pragma unroll
                for (int bj = 0; bj < 2; ++bj) { const int col = u.pn * 256 + bj * 128 + wc * 32 + 8 * fq; const f32x4 a = acc[ai][bj][m][0], b = acc[ai][bj][m][1];
                    u32x4 o; o.x = cvtpk(a.x, a.y); o.y = cvtpk(a.z, a.w); o.z = cvtpk(b.x, b.y); o.w = cvtpk(b.z, b.w);
                    const int cls = (u.pn * 2 + bj);
                    if (cls < 5) { float sq = (a.x * a.x + a.y * a.y) + (a.z * a.z + a.w * a.w) + (b.x * b.x + b.y * b.y) + (b.z * b.z + b.w * b.w);
                        sq += __shfl_xor(sq, 16); sq += __shfl_xor(sq, 32);
                        if (cls < 3) *(u32x4*)(CQ + (size_t)row * 384 + col) = o; else *(u32x4*)(CKV + (size_t)row * 256 + (col - 384)) = o;
                        if (fq == 0) SSP[(size_t)row * 24 + cls * 4 + wc] = sq; }
                    else if (col < 704) *(u32x4*)(KR + (size_t)row * 64 + (col - 640)) = o; } }
    } };
struct In8Bf16Rs { bf16_t* C; int ldc; const float* ssp;
    __device__ __forceinline__ void operator()(int row, int col, f32x4 a, f32x4 b) const { const f32x4 s0 = *(const f32x4*)(ssp + (size_t)row * 24), s1 = *(const f32x4*)(ssp + (size_t)row * 24 + 4), s2 = *(const f32x4*)(ssp + (size_t)row * 24 + 8);
        const float ssum = (((s0.x + s0.y) + (s0.z + s0.w)) + ((s1.x + s1.y) + (s1.z + s1.w))) + ((s2.x + s2.y) + (s2.z + s2.w));
        const float rs = rsqrtf(ssum * (1.f / 384.f) + EPS); a *= rs; b *= rs;
        u32x4 o; o.x = cvtpk(a.x, a.y); o.y = cvtpk(a.z, a.w); o.z = cvtpk(b.x, b.y); o.w = cvtpk(b.z, b.w); *(u32x4*)(C + (size_t)row * ldc + col) = o; } };
struct In8KVRs { bf16_t* Kb; bf16_t* Vb; const float* ssp;
    __device__ __forceinline__ void operator()(int row, int col, f32x4 a, f32x4 b) const { const f32x4 s0 = *(const f32x4*)(ssp + (size_t)row * 24 + 12), s1 = *(const f32x4*)(ssp + (size_t)row * 24 + 16);
        const float ssum = ((s0.x + s0.y) + (s0.z + s0.w)) + ((s1.x + s1.y) + (s1.z + s1.w));
        const float rs = rsqrtf(ssum * (1.f / 256.f) + EPS); a *= rs; b *= rs;
        const int h = col >> 8, c = col & 255; u32x4 o; o.x = cvtpk(a.x, a.y); o.y = cvtpk(a.z, a.w); o.z = cvtpk(b.x, b.y); o.w = cvtpk(b.z, b.w);
        bf16_t* p = (c < 128) ? Kb + (size_t)row * 1536 + h * 192 + c : Vb + (size_t)row * 1024 + h * 128 + (c - 128);
        *(u32x4*)p = o; } };
struct RowSched { pg8::StaticOrder so; bool latent_only;
    __device__ __forceinline__ void init(int N, int G, int c, bool lat) { latent_only = lat; so.init(lat ? NB * SEQ : R, N, G, c); }
    __device__ __forceinline__ bool next(int i, pg8::Unit& u) const { if (!so.next(i, u)) return false; if (latent_only) u.pm = (u.pm >> 4) * 17 + 1 + (u.pm & 15); return true; }
    __device__ __forceinline__ void a_ready(const pg8::Unit&) const {}
    __device__ __forceinline__ void done(const pg8::Unit&) const {} };
template <class Inner> __device__ __forceinline__ void gemm8(const Frame& F, const bf16_t* Ap, const bf16_t* Bt, int N, int K, bool latent_only, const Inner& in, bool reverse = false) {
    asm volatile("" : "+s"(K));
    pg8::Gemm g{Ap, Bt, R, N, K}; RowSched S; S.init(N, F.nblk, reverse ? F.nblk - 1 - F.bid : F.bid, latent_only);
    EpiTile<Inner> E{in};
    pg8::gemm_phase<EpiTile<Inner>, RowSched, true, true>((PG8_LAS unsigned char*)F.lds, g, S, E);
}

template <class Epi> __device__ __forceinline__ void gemm8e(const Frame& F, const bf16_t* Ap, const bf16_t* Bt, int N, int K, bool latent_only, const Epi& E) {
    asm volatile("" : "+s"(K));
    pg8::Gemm g{Ap, Bt, R, N, K}; RowSched S; S.init(N, F.nblk, F.bid, latent_only);
    pg8::gemm_phase<Epi, RowSched, true, true>((PG8_LAS unsigned char*)F.lds, g, S, E);
}

struct GemmDesc { const bf16_t* A; int lda; long sA; const bf16_t* Bt; int ldb; long sB; int M, N, K, nz; };
template <class Epi>
__device__ __forceinline__ void gemm_simple(const Frame& F, const GemmDesc& g, const Epi& epi, bool skip_ctx) {
    const int wm = F.wave >> 1, wn = F.wave & 1, fr = F.lane & 15, fq = F.lane >> 4;
    const int tM = g.M / 128, tN = g.N / 128, per = tM * tN, total = per * g.nz;
    for (int u = F.bid; u < total; u += F.nblk) {
        const int z = u / per, uu = u - z * per, tm = uu / tN, tn = uu - tm * tN;
        if (skip_ctx && ((tm * 128) % RPB) < CTXL) continue;
        const int row0 = tm * 128 + wm * 32, col0 = tn * 128 + wn * 64;
        const bf16_t* ap = g.A + z * g.sA + (size_t)(row0 + fr) * g.lda + fq * 8;
        const bf16_t* bp = g.Bt + z * g.sB + (size_t)(col0 + fr) * g.ldb + fq * 8;
        f32x4 acc[2][4];
#pragma unroll
        for (int mi = 0; mi < 2; ++mi)
#pragma unroll
            for (int ni = 0; ni < 4; ++ni) acc[mi][ni] = (f32x4){0.f, 0.f, 0.f, 0.f};
        for (int k0 = 0; k0 < g.K; k0 += 32) {
            bf16x8 a[2], b[4];
#pragma unroll
            for (int mi = 0; mi < 2; ++mi) a[mi] = *(const bf16x8*)(ap + (size_t)mi * 16 * g.lda + k0);
#pragma unroll
            for (int ni = 0; ni < 4; ++ni) b[ni] = *(const bf16x8*)(bp + (size_t)ni * 16 * g.ldb + k0);
#pragma unroll
            for (int mi = 0; mi < 2; ++mi)
#pragma unroll
                for (int ni = 0; ni < 4; ++ni) acc[mi][ni] = __builtin_amdgcn_mfma_f32_16x16x32_bf16(b[ni], a[mi], acc[mi][ni], 0, 0, 0);
        }
#pragma unroll
        for (int mi = 0; mi < 2; ++mi)
#pragma unroll
            for (int ni = 0; ni < 4; ++ni) epi(z, row0 + mi * 16 + fr, col0 + ni * 16 + fq * 4, acc[mi][ni]);
    }
}
struct EpiBf16 { bf16_t* C; int ldc;
    __device__ __forceinline__ void operator()(int, int row, int col, f32x4 v) const { u32x2 o; o.x = pk2(v.x, v.y); o.y = pk2(v.z, v.w); *(u32x2*)(C + (size_t)row * ldc + col) = o; } };
struct EpiKV { bf16_t* Kb; bf16_t* Vb;
    __device__ __forceinline__ void operator()(int, int row, int col, f32x4 v) const { const int h = col >> 8, c = col & 255; u32x2 o; o.x = pk2(v.x, v.y); o.y = pk2(v.z, v.w);
        if (c < 128) *(u32x2*)(Kb + (size_t)row * 1536 + h * 192 + c) = o; else *(u32x2*)(Vb + (size_t)row * 1024 + h * 128 + (c - 128)) = o; } };
struct EpiF32Z { float* C; int ldc;
    __device__ __forceinline__ void operator()(int z, int row, int col, f32x4 v) const { *(f32x4*)(C + (size_t)row * ldc + z * 128 + col) = v; } };
struct EpiResid { const Frame* F; const float* gate; bool from_input;
    __device__ __forceinline__ void operator()(int, int row, int col, f32x4 v) const {
        float* X = (float*)(F->ws + WS_X) + (size_t)row * DM + col;
        const float* xi = from_input ? xin_row(*F, row) + col : X;
        const f32x4 g = *(const f32x4*)(gate + (size_t)mod_index(row) * 6144 + col);
        *(f32x4*)X = *(const f32x4*)xi + g * v; } };

__device__ __forceinline__ void rope_angles(int r, int& prow, int& pcol) { const int t = (r % RPB) - CTXL; prow = t >> 6; pcol = t & 63; }
__device__ __forceinline__ void p_mla_krope(const Args& A, const Frame& F) {
    const int gw = F.bid * NWAVES + F.wave, NGW = F.nblk * NWAVES, lane = F.lane;
    const bf16_t* KR = (const bf16_t*)(F.ws + WS_KR); bf16_t* Kb = (bf16_t*)(F.ws + WS_K);
    const float invf = __powf(10000.f, -(float)(lane & 15) * (1.f / 16.f));
    for (int r = gw; r < R; r += NGW) {
        float kr = bf2f(KR[(size_t)r * 64 + lane]);
        if (!is_ctx_row(r)) {
            int prow, pcol; rope_angles(r, prow, pcol);
            const float ang = (float)((lane & 32) ? pcol : prow) * invf;
            const float cs = cosf(ang), sn = sinf(ang);
            const float partner = __shfl_xor(kr, 16);
            kr = kr * cs + ((lane & 16) ? partner : -partner) * sn;
        }
        const bf16_t kb = (bf16_t)f2bf(kr);
#pragma unroll
        for (int h = 0; h < 8; ++h) Kb[(size_t)r * 1536 + h * 192 + 128 + lane] = kb;
    }
}
__device__ __forceinline__ float row16_sum(float v) { v += WDPP(v, 0xB1); v += WDPP(v, 0x4E); v += WDPP(v, 0x141); v += WDPP(v, 0x140); return v; }
__device__ __forceinline__ void p_gqa_rows(const Args& A, const Frame& F) {
    const int gw = F.bid * NWAVES + F.wave, NGW = F.nblk * NWAVES, lane = F.lane, c16 = lane & 15, hrow = lane >> 4;
    const bf16_t* RAW = (const bf16_t*)(F.ws + WS_RAW1); bf16_t* Q1 = (bf16_t*)(F.ws + WS_Q1); bf16_t* K1 = (bf16_t*)(F.ws + WS_K1); bf16_t* V1 = (bf16_t*)(F.ws + WS_V1);
    float qg[8], kg[8], invf[8];
#pragma unroll
    for (int e = 0; e < 8; ++e) { qg[e] = A.in[I1_QN][8 * c16 + e]; kg[e] = A.in[I1_KN][8 * c16 + e]; invf[e] = __powf(10000.f, -(float)(8 * (c16 & 3) + e) * (1.f / 32.f)); }
    const bool colaxis = (c16 & 8) != 0, hi32 = (c16 & 4) != 0;
    for (int r = gw; r < R; r += NGW) {
        const bool ctx = is_ctx_row(r);
        const bf16_t* a = RAW + (size_t)r * 1536 + 8 * lane;
        u32x4 ch[3];
#pragma unroll
        for (int j = 0; j < 3; ++j) ch[j] = (ctx && j < 2) ? (u32x4){0u, 0u, 0u, 0u} : *(const u32x4*)(a + 512 * j);
        float cs[8], sn[8];
        { int prow = 0, pcol = 0; if (!ctx) rope_angles(r, prow, pcol); const float pos = (float)(colaxis ? pcol : prow);
#pragma unroll
          for (int e = 0; e < 8; ++e) { const float ang = pos * invf[e]; cs[e] = ctx ? 1.f : __cosf(ang); sn[e] = ctx ? 0.f : __sinf(ang); } }
#pragma unroll
        for (int j = 0; j < 3; ++j) {
            if (ctx && j < 2) continue;
            const bool isv = (j == 2) && (hrow >= 2);
            float x[8];
#pragma unroll
            for (int d = 0; d < 4; ++d) { x[2 * d] = bflo(ch[j][d]); x[2 * d + 1] = bfhi(ch[j][d]); }
            float sq = 0.f;
#pragma unroll
            for (int e = 0; e < 8; ++e) sq += x[e] * x[e];
            const float rinv = rsqrtf(row16_sum(sq) * (1.f / 128.f) + EPS);
            u32x4 o;
            float y[8];
#pragma unroll
            for (int e = 0; e < 8; ++e) y[e] = x[e] * rinv * (j < 2 ? qg[e] : kg[e]);
            u32x4 yp; yp.x = pk2(y[0], y[1]); yp.y = pk2(y[2], y[3]); yp.z = pk2(y[4], y[5]); yp.w = pk2(y[6], y[7]);
            float pr[8];
#pragma unroll
            for (int d = 0; d < 4; ++d) { const float lo = __shfl_xor(y[2 * d], 4), hi2 = __shfl_xor(y[2 * d + 1], 4); pr[2 * d] = lo; pr[2 * d + 1] = hi2; }
            float z[8];
#pragma unroll
            for (int e = 0; e < 8; ++e) z[e] = y[e] * cs[e] + (hi32 ? pr[e] : -pr[e]) * sn[e];
            o.x = pk2(z[0], z[1]); o.y = pk2(z[2], z[3]); o.z = pk2(z[4], z[5]); o.w = pk2(z[6], z[7]);
            (void)yp;
            if (isv) o = ch[j];
            if (j < 2) *(u32x4*)(Q1 + (size_t)r * 1024 + 512 * j + 8 * lane) = o;
            else { bf16_t* dst = (hrow < 2) ? K1 + (size_t)r * 256 + 8 * lane : V1 + (size_t)r * 256 + 8 * (lane - 32); *(u32x4*)dst = o; }
        }
    }
}

__device__ __forceinline__ int crow(int r, int hi) { return (r & 3) + 8 * (r >> 2) + 4 * hi; }
__device__ __forceinline__ int v_st(int k, int c) { const int kk = (k & ~0xC) | ((k & 4) << 1) | ((k & 8) >> 1); return ((kk >> 3) * 4 + (c >> 5)) * 512 + ((kk & 7) * 32 + (c & 31)) * 2; }
__device__ __forceinline__ int v_rd_base(int lane) { return ((lane & 3) << 3) | (((lane >> 2) & 3) << 6) | (((lane >> 4) & 1) << 5) | (((lane >> 5) & 1) << 8); }
constexpr int v_rd_off(int d0, int ks, int half) { return d0 * 512 + ks * 4096 + half * 2048; }
template <int OFF> __device__ __forceinline__ s16x4 tr_read(int vb) { s16x4 r; asm volatile("ds_read_b64_tr_b16 %0, %1 offset:%2" : "=&v"(r) : "v"(vb), "i"(OFF) : "memory"); return r; }
template <int D0> __device__ __forceinline__ void pv_one(f32x16& od, int vb, bf16x8 pa0, bf16x8 pa1, bf16x8 pa2, bf16x8 pa3) {
    const s16x4 l0 = tr_read<v_rd_off(D0, 0, 0)>(vb), h0 = tr_read<v_rd_off(D0, 0, 1)>(vb), l1 = tr_read<v_rd_off(D0, 1, 0)>(vb), h1 = tr_read<v_rd_off(D0, 1, 1)>(vb);
    const s16x4 l2 = tr_read<v_rd_off(D0, 2, 0)>(vb), h2 = tr_read<v_rd_off(D0, 2, 1)>(vb), l3 = tr_read<v_rd_off(D0, 3, 0)>(vb), h3 = tr_read<v_rd_off(D0, 3, 1)>(vb);
    asm volatile("s_waitcnt lgkmcnt(0)" ::: "memory"); SBAR();
#define PK(L, H) (bf16x8){L[0], L[1], L[2], L[3], H[0], H[1], H[2], H[3]}
    od = __builtin_amdgcn_mfma_f32_32x32x16_bf16(pa0, PK(l0, h0), od, 0, 0, 0);
    od = __builtin_amdgcn_mfma_f32_32x32x16_bf16(pa1, PK(l1, h1), od, 0, 0, 0);
    od = __builtin_amdgcn_mfma_f32_32x32x16_bf16(pa2, PK(l2, h2), od, 0, 0, 0);
    od = __builtin_amdgcn_mfma_f32_32x32x16_bf16(pa3, PK(l3, h3), od, 0, 0, 0);
#undef PK
}
__device__ __forceinline__ void pv_d0(f32x16* o, int vb, bf16x8 pa0, bf16x8 pa1, bf16x8 pa2, bf16x8 pa3) {
    pv_one<0>(o[0], vb, pa0, pa1, pa2, pa3); pv_one<1>(o[1], vb, pa0, pa1, pa2, pa3); pv_one<2>(o[2], vb, pa0, pa1, pa2, pa3); pv_one<3>(o[3], vb, pa0, pa1, pa2, pa3);
}
constexpr float ATT_THR = 8.f;
__device__ __forceinline__ void partialSM(f32x16& p0, f32x16& p1, float& m_reg, float& mn, float& alpha, float C, float thr_raw) {
    float pmax = p0[0];
#pragma unroll
    for (int r = 1; r < 16; ++r) pmax = fmaxf(pmax, p0[r]);
#pragma unroll
    for (int r = 0; r < 16; ++r) pmax = fmaxf(pmax, p1[r]);
    { auto rr = __builtin_amdgcn_permlane32_swap(__float_as_uint(pmax), __float_as_uint(pmax), false, false);
      pmax = fmaxf(__uint_as_float(rr[0]), __uint_as_float(rr[1])); }
    if (__builtin_expect(__all(pmax - m_reg <= thr_raw), 1)) { mn = m_reg; alpha = 1.f; }
    else { mn = fmaxf(m_reg, pmax); alpha = __builtin_amdgcn_exp2f((m_reg - mn) * C); m_reg = mn; }
    const float mnC = -mn * C;
#pragma unroll
    for (int r = 0; r < 16; ++r) p0[r] = fmaf(p0[r], C, mnC);
#pragma unroll
    for (int r = 0; r < 16; ++r) p1[r] = fmaf(p1[r], C, mnC);
#pragma unroll
    for (int r = 0; r < 16; ++r) p0[r] = __builtin_amdgcn_exp2f(p0[r]);
}
__device__ __forceinline__ void finishSM(f32x16& p0, f32x16& p1, float alpha, float& l_reg, bf16x8& pa0, bf16x8& pa1, bf16x8& pa2, bf16x8& pa3) {
#pragma unroll
    for (int r = 0; r < 16; ++r) p1[r] = __builtin_amdgcn_exp2f(p1[r]);
    float ps = 0;
#pragma unroll
    for (int r = 0; r < 16; ++r) ps += p0[r];
#pragma unroll
    for (int r = 0; r < 16; ++r) ps += p1[r];
    { auto rr = __builtin_amdgcn_permlane32_swap(__float_as_uint(ps), __float_as_uint(ps), false, false);
      ps = __uint_as_float(rr[0]) + __uint_as_float(rr[1]); }
    l_reg = l_reg * alpha + ps;
#define PK4(P, BASE, OUT) do { unsigned a0 = cvtpk(P[BASE + 0], P[BASE + 1]), a1 = cvtpk(P[BASE + 2], P[BASE + 3]);   \
    unsigned b0 = cvtpk(P[BASE + 4], P[BASE + 5]), b1 = cvtpk(P[BASE + 6], P[BASE + 7]);                              \
    auto r0 = __builtin_amdgcn_permlane32_swap(a0, b0, false, false); auto r1 = __builtin_amdgcn_permlane32_swap(a1, b1, false, false); \
    u32x4 w = {r0[0], r1[0], r0[1], r1[1]}; OUT = *reinterpret_cast<bf16x8*>(&w); } while (0)
    PK4(p0, 0, pa0); PK4(p0, 8, pa1); PK4(p1, 0, pa2); PK4(p1, 8, pa3);
#undef PK4
}
template <int DQK> __device__ __forceinline__ void qkt(f32x16& p0, f32x16& p1, const char* Ks, const bf16x8* qr, int r32, int hi) {
    constexpr int KP = DQK * 2 + 16;
    p0 = f32x16{}; p1 = f32x16{};
#pragma unroll
    for (int d0 = 0; d0 < DQK / 16; ++d0) { const int cb = (d0 * 16 + hi * 8) * 2;
        const bf16x8 b0 = *reinterpret_cast<const bf16x8*>(Ks + r32 * KP + cb);
        const bf16x8 b1 = *reinterpret_cast<const bf16x8*>(Ks + (32 + r32) * KP + cb);
        p0 = __builtin_amdgcn_mfma_f32_32x32x16_bf16(b0, qr[d0], p0, 0, 0, 0);
        p1 = __builtin_amdgcn_mfma_f32_32x32x16_bf16(b1, qr[d0], p1, 0, 0, 0); }
}
template <int DQK> constexpr int att_lds_bytes() { return 2 * 64 * 128 * 2 + 2 * 64 * (DQK * 2 + 16) + NWAVES * 64 * 4; }
template <int DQK, int LDQ, int LDK, int LDV, int LDO>
__device__ __forceinline__ void attn_body(const bf16_t* __restrict__ Qb, const bf16_t* __restrict__ Kh, const bf16_t* __restrict__ Vh, bf16_t* __restrict__ Ob, int seq, float scale, char* lds) {
    constexpr int KP = DQK * 2 + 16, SHM_V = 64 * 128 * 2, SHM_K = 64 * KP, ND = DQK / 16, CH = DQK / 8, NKL = CH * 64 / NTHREADS;
    const float C = scale * 1.4426950408889634f, thr_raw = ATT_THR / scale;
    const int tid = threadIdx.x, wid = tid >> 6, lane = tid & 63, r32 = lane & 31, hi = lane >> 5;
    char* V_lds = lds; char* K_lds = lds + 2 * SHM_V;
    float* wsf = (float*)(lds + 2 * SHM_V + 2 * SHM_K) + wid * 64; float* li_l = wsf; float* al_l = wsf + 32;
    float m_reg = -1e30f, l_reg = 0; f32x16 o[4] = {}; bf16x8 qr[ND];
    const bf16_t* Qw = Qb + (long)(wid * 32 + r32) * LDQ + hi * 8;
#pragma unroll
    for (int d0 = 0; d0 < ND; ++d0) qr[d0] = *reinterpret_cast<const bf16x8*>(Qw + d0 * 16);
    const int sr = tid >> 4, sc = (tid & 15) * 8, vst0 = v_st(sr, sc), vst1 = v_st(32 + sr, sc);
    static_assert(DQK == 128, "double-pipelined body: 128-wide q.k only");
    const int vb0 = (int)(uintptr_t)V_lds + v_rd_base(lane);
    bf16x8 vs0, vs1, ks[NKL];
#define SLOAD(k0) do { vs0 = *reinterpret_cast<const bf16x8*>(&Vh[(long)((k0) + sr) * LDV + sc]); vs1 = *reinterpret_cast<const bf16x8*>(&Vh[(long)((k0) + 32 + sr) * LDV + sc]); \
    _Pragma("unroll") for (int i_ = 0; i_ < NKL; ++i_) ks[i_] = *reinterpret_cast<const bf16x8*>(&Kh[(long)((k0) + sr + 32 * i_) * LDK + sc]); } while (0)
#define SWRITE(b) do { *(bf16x8*)(V_lds + (b) * SHM_V + vst0) = vs0; *(bf16x8*)(V_lds + (b) * SHM_V + vst1) = vs1; \
    _Pragma("unroll") for (int i_ = 0; i_ < NKL; ++i_) *(bf16x8*)(K_lds + (b) * SHM_K + (sr + 32 * i_) * KP + sc * 2) = ks[i_]; } while (0)
#define RESC(a) do { if (__any((a) < 1.f)) { if (hi == 0) al_l[r32] = (a); asm volatile("s_waitcnt lgkmcnt(0)" ::: "memory"); \
    _Pragma("unroll") for (int d = 0; d < 4; ++d) _Pragma("unroll") for (int r = 0; r < 16; ++r) o[d][r] *= al_l[crow(r, hi)]; } } while (0)
    f32x16 pA0, pA1, pB0, pB1; float mnA, mnB, alA, alB; bf16x8 pa0, pa1, pa2, pa3; const int NT = seq / 64;
    SLOAD(0); asm volatile("s_waitcnt vmcnt(0)" ::: "memory"); SWRITE(0); __syncthreads();
    qkt<DQK>(pA0, pA1, K_lds, qr, r32, hi); partialSM(pA0, pA1, m_reg, mnA, alA, C, thr_raw);
    SLOAD(64);
    asm volatile("s_waitcnt vmcnt(0)" ::: "memory"); SWRITE(1); __syncthreads();
    for (int j = 1; j + 1 < NT; j += 2) {
        SBAR(); qkt<DQK>(pB0, pB1, K_lds + SHM_K, qr, r32, hi);
        finishSM(pA0, pA1, alA, l_reg, pa0, pa1, pa2, pa3); SBAR();
        SLOAD((j + 1) * 64); SBAR();
        pv_d0(o, vb0, pa0, pa1, pa2, pa3); partialSM(pB0, pB1, m_reg, mnB, alB, C, thr_raw);
        __syncthreads(); asm volatile("s_waitcnt vmcnt(0)" ::: "memory"); SWRITE(0);
        RESC(alB); __syncthreads();
        SBAR(); qkt<DQK>(pA0, pA1, K_lds, qr, r32, hi);
        finishSM(pB0, pB1, alB, l_reg, pa0, pa1, pa2, pa3); SBAR();
        SLOAD((j + 2) * 64); SBAR();
        pv_d0(o, vb0 + SHM_V, pa0, pa1, pa2, pa3); partialSM(pA0, pA1, m_reg, mnA, alA, C, thr_raw);
        __syncthreads(); asm volatile("s_waitcnt vmcnt(0)" ::: "memory"); SWRITE(1);
        RESC(alA); __syncthreads();
    }
    SBAR(); qkt<DQK>(pB0, pB1, K_lds + SHM_K, qr, r32, hi);
    finishSM(pA0, pA1, alA, l_reg, pa0, pa1, pa2, pa3); SBAR();
    pv_d0(o, vb0, pa0, pa1, pa2, pa3); partialSM(pB0, pB1, m_reg, mnB, alB, C, thr_raw);
    __syncthreads(); RESC(alB);
    finishSM(pB0, pB1, alB, l_reg, pa0, pa1, pa2, pa3); SBAR();
    pv_d0(o, vb0 + SHM_V, pa0, pa1, pa2, pa3);
    if (hi == 0) li_l[r32] = l_reg; asm volatile("s_waitcnt lgkmcnt(0)" ::: "memory");
    float rli[16];
#pragma unroll
    for (int r = 0; r < 16; ++r) rli[r] = __builtin_amdgcn_rcpf(li_l[crow(r, hi)]);
    bf16_t* Ow = Ob + (long)(wid * 32) * LDO;
#pragma unroll
    for (int r = 0; r < 16; ++r) { const int orow = crow(r, hi);
#pragma unroll
        for (int d0 = 0; d0 < 4; ++d0) Ow[(long)orow * LDO + d0 * 32 + r32] = (bf16_t)f2bf(o[d0][r] * rli[r]); }
    __syncthreads();
#undef SLOAD
#undef SWRITE
#undef RESC
}
template <int DQK, int LDQ, int LDK, int LDV, int LDO>
__device__ __forceinline__ void attn_body_single(const bf16_t* __restrict__ Qb, const bf16_t* __restrict__ Kh, const bf16_t* __restrict__ Vh, bf16_t* __restrict__ Ob, int seq, float scale, char* lds, int rope_t0) {
    constexpr int KP = DQK * 2 + 16, SHM_V = 64 * 128 * 2, SHM_K = 64 * KP, ND = DQK / 16, CH = DQK / 8, NKL = CH * 64 / NTHREADS;
    const float C = scale * 1.4426950408889634f, thr_raw = ATT_THR / scale;
    const int tid = threadIdx.x, wid = tid >> 6, lane = tid & 63, r32 = lane & 31, hi = lane >> 5;
    char* V_lds = lds; char* K_lds = lds + 2 * SHM_V;
    float* wsf = (float*)(lds + 2 * SHM_V + 2 * SHM_K) + wid * 64; float* li_l = wsf; float* al_l = wsf + 32;
    float m_reg = -1e30f, l_reg = 0; f32x16 o[4] = {}; bf16x8 qr[ND];
    const bf16_t* Qw = Qb + (long)(wid * 32 + r32) * LDQ + hi * 8;
#pragma unroll
    for (int d0 = 8; d0 < ND; ++d0) qr[d0] = *reinterpret_cast<const bf16x8*>(Qw + d0 * 16);
    if constexpr (DQK == 192) {
        if (rope_t0 >= 0) {
            const int tq = rope_t0 + wid * 32 + r32; const float prow = (float)(tq >> 6), pcol = (float)(tq & 63);
            u32x4 fa1 = __builtin_bit_cast(u32x4, qr[8]), fa2 = __builtin_bit_cast(u32x4, qr[9]), fb1 = __builtin_bit_cast(u32x4, qr[10]), fb2 = __builtin_bit_cast(u32x4, qr[11]);
#pragma unroll
            for (int jj = 0; jj < 4; ++jj) {
                float na1[2], na2[2], nb1[2], nb2[2];
#pragma unroll
                for (int e = 0; e < 2; ++e) { const float invf = __powf(10000.f, -(float)(hi * 8 + 2 * jj + e) * (1.f / 16.f));
                    const float ar = prow * invf, ac = pcol * invf, cr = __cosf(ar), sr_ = __sinf(ar), cc = __cosf(ac), sc_ = __sinf(ac);
                    const float a1 = e ? bfhi(fa1[jj]) : bflo(fa1[jj]), a2 = e ? bfhi(fa2[jj]) : bflo(fa2[jj]), b1 = e ? bfhi(fb1[jj]) : bflo(fb1[jj]), b2 = e ? bfhi(fb2[jj]) : bflo(fb2[jj]);
                    na1[e] = a1 * cr - a2 * sr_; na2[e] = a2 * cr + a1 * sr_; nb1[e] = b1 * cc - b2 * sc_; nb2[e] = b2 * cc + b1 * sc_; }
                fa1[jj] = pk2(na1[0], na1[1]); fa2[jj] = pk2(na2[0], na2[1]); fb1[jj] = pk2(nb1[0], nb1[1]); fb2[jj] = pk2(nb2[0], nb2[1]);
            }
            qr[8] = __builtin_bit_cast(bf16x8, fa1); qr[9] = __builtin_bit_cast(bf16x8, fa2); qr[10] = __builtin_bit_cast(bf16x8, fb1); qr[11] = __builtin_bit_cast(bf16x8, fb2);
        }
    }
    asm volatile("" ::: "memory");
#pragma unroll
    for (int d0 = 0; d0 < 8; ++d0) qr[d0] = *reinterpret_cast<const bf16x8*>(Qw + d0 * 16);
    const int sr = tid >> 4, sc = (tid & 15) * 8, vst0 = v_st(sr, sc), vst1 = v_st(32 + sr, sc);
    int krow[NKL], kch[NKL];
#pragma unroll
    for (int i = 0; i < NKL; ++i) { const int id = tid + i * NTHREADS; krow[i] = id / CH; kch[i] = id % CH; }
    const int vb0 = (int)(uintptr_t)V_lds + v_rd_base(lane);
    bf16x8 vs0, vs1, ks[NKL];
#define SLOAD(k0) do { vs0 = *reinterpret_cast<const bf16x8*>(&Vh[(long)((k0) + sr) * LDV + sc]); vs1 = *reinterpret_cast<const bf16x8*>(&Vh[(long)((k0) + 32 + sr) * LDV + sc]); \
    _Pragma("unroll") for (int i_ = 0; i_ < NKL; ++i_) ks[i_] = *reinterpret_cast<const bf16x8*>(&Kh[(long)((k0) + krow[i_]) * LDK + kch[i_] * 8]); } while (0)
#define SWRITE(b) do { *(bf16x8*)(V_lds + (b) * SHM_V + vst0) = vs0; *(bf16x8*)(V_lds + (b) * SHM_V + vst1) = vs1; \
    _Pragma("unroll") for (int i_ = 0; i_ < NKL; ++i_) *(bf16x8*)(K_lds + (b) * SHM_K + krow[i_] * KP + kch[i_] * 16) = ks[i_]; } while (0)
#define RESC(a) do { if (__any((a) < 1.f)) { if (hi == 0) al_l[r32] = (a); asm volatile("s_waitcnt lgkmcnt(0)" ::: "memory"); \
    _Pragma("unroll") for (int d = 0; d < 4; ++d) _Pragma("unroll") for (int r = 0; r < 16; ++r) o[d][r] *= al_l[crow(r, hi)]; } } while (0)
    f32x16 p0, p1; float mn, al; bf16x8 pa0, pa1, pa2, pa3; const int NT = seq / 64;
    SLOAD(0); asm volatile("s_waitcnt vmcnt(0)" ::: "memory"); SWRITE(0); __syncthreads();
    SLOAD(64);
    for (int j = 0; j < NT; ++j) {
        const int b = j & 1;
        SBAR(); qkt<DQK>(p0, p1, K_lds + b * SHM_K, qr, r32, hi);
        partialSM(p0, p1, m_reg, mn, al, C, thr_raw);
        RESC(al);
        finishSM(p0, p1, al, l_reg, pa0, pa1, pa2, pa3); SBAR();
        pv_d0(o, vb0 + b * SHM_V, pa0, pa1, pa2, pa3);
        if (j + 1 < NT) { asm volatile("s_waitcnt vmcnt(0)" ::: "memory"); SWRITE(b ^ 1); }
        __syncthreads();
        if (j + 2 < NT) SLOAD((j + 2) * 64);
    }
    if (hi == 0) li_l[r32] = l_reg; asm volatile("s_waitcnt lgkmcnt(0)" ::: "memory");
    float rli[16];
#pragma unroll
    for (int r = 0; r < 16; ++r) rli[r] = __builtin_amdgcn_rcpf(li_l[crow(r, hi)]);
    bf16_t* Ow = Ob + (long)(wid * 32) * LDO;
#pragma unroll
    for (int r = 0; r < 16; ++r) { const int orow = crow(r, hi);
#pragma unroll
        for (int d0 = 0; d0 < 4; ++d0) Ow[(long)orow * LDO + d0 * 32 + r32] = (bf16_t)f2bf(o[d0][r] * rli[r]); }
    __syncthreads();
#undef SLOAD
#undef SWRITE
#undef RESC
}
__device__ __forceinline__ void p_attn_mla(const Args& A, const Frame& F) {
    const bf16_t* Q = (const bf16_t*)(F.ws + WS_Q); const bf16_t* Kb = (const bf16_t*)(F.ws + WS_K); const bf16_t* Vb = (const bf16_t*)(F.ws + WS_V); bf16_t* O = (bf16_t*)(F.ws + WS_O);
    const float scale = 0.07216878364870322f;
    for (int u = F.vcu; u < 544; u += F.nblk) {
        int b, h, q0, seq;
        int rope_t0;
        if (u < 512) { const int qb = u & 15; h = (u >> 4) & 7; b = u >> 7; q0 = CTXL + qb * 256; seq = RPB; rope_t0 = qb * 256; }
        else { const int v = u - 512; h = v & 7; b = v >> 3; q0 = 0; seq = CTXL; rope_t0 = -1; }
        const size_t rb = (size_t)b * RPB;
        attn_body_single<192, 1536, 1536, 1024, 1024>(Q + (rb + q0) * 1536 + h * 192, Kb + rb * 1536 + h * 192, Vb + rb * 1024 + h * 128, O + (rb + q0) * 1024 + h * 128, seq, scale, F.lds, rope_t0);
    }
}
__device__ __forceinline__ void p_attn_gqa(const Args& A, const Frame& F) {
    const bf16_t* Q = (const bf16_t*)(F.ws + WS_Q1); const bf16_t* Kb = (const bf16_t*)(F.ws + WS_K1); const bf16_t* Vb = (const bf16_t*)(F.ws + WS_V1); bf16_t* O = (bf16_t*)(F.ws + WS_O);
    const float scale = 0.08838834764831845f;
    for (int u = F.vcu; u < 512; u += F.nblk) {
        const int qb = u & 15, h = (u >> 4) & 7, b = u >> 7, q0 = CTXL + qb * 256, kvh = h >> 2;
        const size_t rb = (size_t)b * RPB;
        attn_body<128, 1024, 256, 256, 1024>(Q + (rb + q0) * 1024 + h * 128, Kb + rb * 256 + kvh * 128, Vb + rb * 256 + kvh * 128, O + (rb + q0) * 1024 + h * 128, RPB, scale, F.lds);
    }
}

#define DPP_XOR1 0xB1
#define DPP_XOR2 0x4E
#define DPP_HMIRROR 0x141
#define DPP_MIRROR 0x140
__device__ __forceinline__ int row_max_i(int v) {
    v = max(v, __builtin_amdgcn_update_dpp(v, v, DPP_XOR1, 0xf, 0xf, false));
    v = max(v, __builtin_amdgcn_update_dpp(v, v, DPP_XOR2, 0xf, 0xf, false));
    v = max(v, __builtin_amdgcn_update_dpp(v, v, DPP_HMIRROR, 0xf, 0xf, false));
    v = max(v, __builtin_amdgcn_update_dpp(v, v, DPP_MIRROR, 0xf, 0xf, false));
    return v;
}
__device__ __forceinline__ float row_sum_f(float v) {
    v += __builtin_bit_cast(float, __builtin_amdgcn_update_dpp(0, __builtin_bit_cast(int, v), DPP_XOR1, 0xf, 0xf, false));
    v += __builtin_bit_cast(float, __builtin_amdgcn_update_dpp(0, __builtin_bit_cast(int, v), DPP_XOR2, 0xf, 0xf, false));
    v += __builtin_bit_cast(float, __builtin_amdgcn_update_dpp(0, __builtin_bit_cast(int, v), DPP_HMIRROR, 0xf, 0xf, false));
    v += __builtin_bit_cast(float, __builtin_amdgcn_update_dpp(0, __builtin_bit_cast(int, v), DPP_MIRROR, 0xf, 0xf, false));
    return v;
}
__device__ __forceinline__ int fkey(float f) { const int b = __builtin_bit_cast(int, f); return b ^ ((b >> 31) & 0x7fffffff); }
__device__ __forceinline__ float keyf(int k) { return __builtin_bit_cast(float, k ^ ((k >> 31) & 0x7fffffff)); }
__device__ __forceinline__ void cand_ij(int t, int& i, int& j) {
    const int g16 = t >= 16, g24 = t >= 24, g29 = t >= 29, g33 = t >= 33, g36 = t >= 36, g38 = t >= 38, g40 = t >= 40;
    i = g16 + g24 + g29 + g33 + g36 + g38 + g40 + max(t - 41, 0);
    const int base = 16 * g16 + 8 * g24 + 5 * g29 + 4 * g33 + 3 * g36 + 2 * g38 + 2 * g40;
    j = (t >= 42) ? 0 : t - base;
    if (t >= 50) { i = 0; j = 0; }
}
__device__ __forceinline__ void row_max2(int& a, int& b) {
    asm volatile("s_nop 1\n\t"
                 "v_max_i32_dpp %0, %0, %0 quad_perm:[1,0,3,2] row_mask:0xf bank_mask:0xf\n\tv_max_i32_dpp %1, %1, %1 quad_perm:[1,0,3,2] row_mask:0xf bank_mask:0xf\n\ts_nop 0\n\t"
                 "v_max_i32_dpp %0, %0, %0 quad_perm:[2,3,0,1] row_mask:0xf bank_mask:0xf\n\tv_max_i32_dpp %1, %1, %1 quad_perm:[2,3,0,1] row_mask:0xf bank_mask:0xf\n\ts_nop 0\n\t"
                 "v_max_i32_dpp %0, %0, %0 row_half_mirror row_mask:0xf bank_mask:0xf\n\tv_max_i32_dpp %1, %1, %1 row_half_mirror row_mask:0xf bank_mask:0xf\n\ts_nop 0\n\t"
                 "v_max_i32_dpp %0, %0, %0 row_mirror row_mask:0xf bank_mask:0xf\n\tv_max_i32_dpp %1, %1, %1 row_mirror row_mask:0xf bank_mask:0xf\n\ts_nop 1"
                 : "+v"(a), "+v"(b));
}
__device__ __forceinline__ void row_max1(int& a) {
    asm volatile("s_nop 1\n\t"
                 "v_max_i32_dpp %0, %0, %0 quad_perm:[1,0,3,2] row_mask:0xf bank_mask:0xf\n\ts_nop 1\n\t"
                 "v_max_i32_dpp %0, %0, %0 quad_perm:[2,3,0,1] row_mask:0xf bank_mask:0xf\n\ts_nop 1\n\t"
                 "v_max_i32_dpp %0, %0, %0 row_half_mirror row_mask:0xf bank_mask:0xf\n\ts_nop 1\n\t"
                 "v_max_i32_dpp %0, %0, %0 row_mirror row_mask:0xf bank_mask:0xf\n\ts_nop 1"
                 : "+v"(a));
}
__device__ __forceinline__ void row_max4(int& a, int& b, int& c, int& d) {
    asm volatile("s_nop 1\n\t"
                 "v_max_i32_dpp %0, %0, %0 quad_perm:[1,0,3,2] row_mask:0xf bank_mask:0xf\n\tv_max_i32_dpp %1, %1, %1 quad_perm:[1,0,3,2] row_mask:0xf bank_mask:0xf\n\t"
                 "v_max_i32_dpp %2, %2, %2 quad_perm:[1,0,3,2] row_mask:0xf bank_mask:0xf\n\tv_max_i32_dpp %3, %3, %3 quad_perm:[1,0,3,2] row_mask:0xf bank_mask:0xf\n\t"
                 "v_max_i32_dpp %0, %0, %0 quad_perm:[2,3,0,1] row_mask:0xf bank_mask:0xf\n\tv_max_i32_dpp %1, %1, %1 quad_perm:[2,3,0,1] row_mask:0xf bank_mask:0xf\n\t"
                 "v_max_i32_dpp %2, %2, %2 quad_perm:[2,3,0,1] row_mask:0xf bank_mask:0xf\n\tv_max_i32_dpp %3, %3, %3 quad_perm:[2,3,0,1] row_mask:0xf bank_mask:0xf\n\t"
                 "v_max_i32_dpp %0, %0, %0 row_half_mirror row_mask:0xf bank_mask:0xf\n\tv_max_i32_dpp %1, %1, %1 row_half_mirror row_mask:0xf bank_mask:0xf\n\t"
                 "v_max_i32_dpp %2, %2, %2 row_half_mirror row_mask:0xf bank_mask:0xf\n\tv_max_i32_dpp %3, %3, %3 row_half_mirror row_mask:0xf bank_mask:0xf\n\t"
                 "v_max_i32_dpp %0, %0, %0 row_mirror row_mask:0xf bank_mask:0xf\n\tv_max_i32_dpp %1, %1, %1 row_mirror row_mask:0xf bank_mask:0xf\n\t"
                 "v_max_i32_dpp %2, %2, %2 row_mirror row_mask:0xf bank_mask:0xf\n\tv_max_i32_dpp %3, %3, %3 row_mirror row_mask:0xf bank_mask:0xf\n\ts_nop 1"
                 : "+v"(a), "+v"(b), "+v"(c), "+v"(d));
}
#define CE_DESC(x, y) do { const int hi_ = max(x, y), lo_ = min(x, y); x = hi_; y = lo_; } while (0)
#define SORT8_DESC(k) do { CE_DESC(k[0], k[2]); CE_DESC(k[1], k[3]); CE_DESC(k[4], k[6]); CE_DESC(k[5], k[7]); CE_DESC(k[0], k[4]); CE_DESC(k[1], k[5]); CE_DESC(k[2], k[6]); CE_DESC(k[3], k[7]); \
    CE_DESC(k[0], k[1]); CE_DESC(k[2], k[3]); CE_DESC(k[4], k[5]); CE_DESC(k[6], k[7]); CE_DESC(k[2], k[4]); CE_DESC(k[3], k[5]); CE_DESC(k[1], k[4]); CE_DESC(k[3], k[6]); CE_DESC(k[1], k[2]); CE_DESC(k[3], k[4]); CE_DESC(k[5], k[6]); } while (0)
#define SORT16_DESC(K) do { CE_DESC(K[0], K[1]); CE_DESC(K[2], K[3]); CE_DESC(K[0], K[2]); CE_DESC(K[1], K[3]); CE_DESC(K[1], K[2]); CE_DESC(K[4], K[5]); CE_DESC(K[6], K[7]); CE_DESC(K[4], K[6]); CE_DESC(K[5], K[7]); CE_DESC(K[5], K[6]); CE_DESC(K[0], K[4]); CE_DESC(K[2], K[6]); CE_DESC(K[2], K[4]); CE_DESC(K[1], K[5]); CE_DESC(K[3], K[7]); CE_DESC(K[3], K[5]); CE_DESC(K[1], K[2]); CE_DESC(K[3], K[4]); CE_DESC(K[5], K[6]); CE_DESC(K[8], K[9]); CE_DESC(K[10], K[11]); CE_DESC(K[8], K[10]); CE_DESC(K[9], K[11]); CE_DESC(K[9], K[10]); CE_DESC(K[12], K[13]); CE_DESC(K[14], K[15]); CE_DESC(K[12], K[14]); CE_DESC(K[13], K[15]); CE_DESC(K[13], K[14]); CE_DESC(K[8], K[12]); CE_DESC(K[10], K[14]); CE_DESC(K[10], K[12]); CE_DESC(K[9], K[13]); CE_DESC(K[11], K[15]); CE_DESC(K[11], K[13]); CE_DESC(K[9], K[10]); CE_DESC(K[11], K[12]); CE_DESC(K[13], K[14]); CE_DESC(K[0], K[8]); CE_DESC(K[4], K[12]); CE_DESC(K[4], K[8]); CE_DESC(K[2], K[10]); CE_DESC(K[6], K[14]); CE_DESC(K[6], K[10]); CE_DESC(K[2], K[4]); CE_DESC(K[6], K[8]); CE_DESC(K[10], K[12]); CE_DESC(K[1], K[9]); CE_DESC(K[5], K[13]); CE_DESC(K[5], K[9]); CE_DESC(K[3], K[11]); CE_DESC(K[7], K[15]); CE_DESC(K[7], K[11]); CE_DESC(K[3], K[5]); CE_DESC(K[7], K[9]); CE_DESC(K[11], K[13]); CE_DESC(K[1], K[2]); CE_DESC(K[3], K[4]); CE_DESC(K[5], K[6]); CE_DESC(K[7], K[8]); CE_DESC(K[9], K[10]); CE_DESC(K[11], K[12]); CE_DESC(K[13], K[14]); } while (0)
#define MERGE16_DESC(T, K) do { _Pragma("unroll") for (int i_ = 0; i_ < 16; ++i_) T[i_] = max(T[i_], K[15 - i_]); CE_DESC(T[0], T[8]); CE_DESC(T[1], T[9]); CE_DESC(T[2], T[10]); CE_DESC(T[3], T[11]); CE_DESC(T[4], T[12]); CE_DESC(T[5], T[13]); CE_DESC(T[6], T[14]); CE_DESC(T[7], T[15]); CE_DESC(T[0], T[4]); CE_DESC(T[1], T[5]); CE_DESC(T[2], T[6]); CE_DESC(T[3], T[7]); CE_DESC(T[8], T[12]); CE_DESC(T[9], T[13]); CE_DESC(T[10], T[14]); CE_DESC(T[11], T[15]); CE_DESC(T[0], T[2]); CE_DESC(T[1], T[3]); CE_DESC(T[4], T[6]); CE_DESC(T[5], T[7]); CE_DESC(T[8], T[10]); CE_DESC(T[9], T[11]); CE_DESC(T[12], T[14]); CE_DESC(T[13], T[15]); CE_DESC(T[0], T[1]); CE_DESC(T[2], T[3]); CE_DESC(T[4], T[5]); CE_DESC(T[6], T[7]); CE_DESC(T[8], T[9]); CE_DESC(T[10], T[11]); CE_DESC(T[12], T[13]); CE_DESC(T[14], T[15]); } while (0)
__device__ __forceinline__ int hkey_hi(unsigned w) { const int x = (int)(w & 0xffff0000u); return x ^ ((x >> 31) & 0x7fff0000); }
__device__ __forceinline__ float hkey_val(int k) { const int y = k & (int)0xffff0000; const unsigned b = (unsigned)(y ^ ((y >> 31) & 0x7fff0000)); return (float)__builtin_bit_cast(_Float16, (unsigned short)(b >> 16)); }
__device__ __forceinline__ int cnd(int a, int b, unsigned long long m) { int r; asm("v_cndmask_b32_e64 %0, %1, %2, %3" : "=v"(r) : "v"(a), "v"(b), "s"(m)); return r; }
__device__ __forceinline__ unsigned long long bitmask(int v, int bit) { unsigned long long m; asm("v_cmp_ne_u32_e64 %0, 0, %1\n\ts_nop 1" : "=s"(m) : "v"(v & bit)); return m; }
__device__ __forceinline__ int sel16(const int (&a)[16], int i) {
    const unsigned long long m0 = bitmask(i, 1), m1 = bitmask(i, 2), m2 = bitmask(i, 4), m3 = bitmask(i, 8);
    int l1[8], l2[4], l3[2];
#pragma unroll
    for (int m = 0; m < 8; ++m) l1[m] = cnd(a[2 * m], a[2 * m + 1], m0);
#pragma unroll
    for (int m = 0; m < 4; ++m) l2[m] = cnd(l1[2 * m], l1[2 * m + 1], m1);
#pragma unroll
    for (int m = 0; m < 2; ++m) l3[m] = cnd(l2[2 * m], l2[2 * m + 1], m2);
    return cnd(l3[0], l3[1], m3);
}
__device__ __forceinline__ void topk_rows4(const unsigned short* S, unsigned* PK, int r, int hbase, int lane) {
    const int c = lane & 15, rw = lane >> 4, rbase = lane & 48, h = hbase + rw;
    const int KMIN = (int)0x80000000;
    const unsigned short* sp = S + (size_t)r * 2048 + h * 256 + 4 * c;
    int k1[8], k2[8];
#pragma unroll
    for (int jj = 0; jj < 2; ++jj) { const u32x2 a = *(const u32x2*)(sp + 64 * jj), b = *(const u32x2*)(sp + 128 + 64 * jj);
#pragma unroll
        for (int e = 0; e < 4; ++e) { const int p = 4 * c + 64 * jj + e;
            const float fa = (float)__builtin_bit_cast(_Float16, (unsigned short)(a[e >> 1] >> (16 * (e & 1)))), fb = (float)__builtin_bit_cast(_Float16, (unsigned short)(b[e >> 1] >> (16 * (e & 1))));
            k1[4 * jj + e] = (fkey(fa) & ~127) | (127 - p); k2[4 * jj + e] = (fkey(fb) & ~127) | (127 - p); } }
    SORT8_DESC(k1); SORT8_DESC(k2);
    int r1 = KMIN, r2 = KMIN;
#pragma unroll 1
    for (int it = 0; it < 16; ++it) {
        int m1 = k1[0], m2 = k2[0];
        row_max2(m1, m2);
        const bool p1 = (k1[0] == m1), p2 = (k2[0] == m2);
#pragma unroll
        for (int e = 0; e < 7; ++e) { k1[e] = p1 ? k1[e + 1] : k1[e]; k2[e] = p2 ? k2[e + 1] : k2[e]; }
        k1[7] = p1 ? KMIN : k1[7]; k2[7] = p2 ? KMIN : k2[7];
        if (c == it) { r1 = m1; r2 = m2; }
    }
    int ck[4];
#pragma unroll
    for (int q = 0; q < 4; ++q) { int ci, cj; cand_ij(c + 16 * q, ci, cj); const int a = __shfl(r1, rbase | ci), b = __shfl(r2, rbase | cj);
        const float fs = keyf((a & ~127) | 64) + keyf((b & ~127) | 64); const int t = c + 16 * q;
        ck[q] = (t < 50) ? ((fkey(fs) & ~63) | (63 - t)) : KMIN; }
    CE_DESC(ck[0], ck[1]); CE_DESC(ck[2], ck[3]); CE_DESC(ck[0], ck[2]); CE_DESC(ck[1], ck[3]); CE_DESC(ck[1], ck[2]);
    int tk = KMIN;
#pragma unroll 1
    for (int it = 0; it < 16; ++it) {
        int m = ck[0];
        row_max1(m);
        const bool pp = (ck[0] == m);
        ck[0] = pp ? ck[1] : ck[0]; ck[1] = pp ? ck[2] : ck[1]; ck[2] = pp ? ck[3] : ck[2]; ck[3] = pp ? KMIN : ck[3];
        if (c == it) tk = m;
    }
    int wi, wj; cand_ij(63 - (tk & 63), wi, wj);
    const int wa = __shfl(r1, rbase | wi), wb = __shfl(r2, rbase | wj);
    const int te = (127 - (wa & 127)) * 128 + (127 - (wb & 127));
    const float tv = keyf((tk & ~63) | 32);
    int mk = tk; row_max1(mk);
    const float mx = keyf((mk & ~63) | 32);
    const float ex = __expf(tv - mx), sum = row_sum_f(ex);
    PK[(size_t)r * 128 + h * 16 + c] = ((unsigned)te << 16) | (unsigned)(ex * (65535.f / sum) + 0.5f);
}
__device__ __forceinline__ void p_peer_topk(const Args& A, const Frame& F, bool skip_ctx) {
    const int gw = F.bid * NWAVES + F.wave, NGW = F.nblk * NWAVES, lane = F.lane;
    const unsigned short* S = (const unsigned short*)(F.ws + WS_S); unsigned* PK = (unsigned*)(F.ws + WS_PK);
    const int KMIN = (int)0x80000000;
    const int nitem = (skip_ctx ? NB * SEQ : R) * 8;
    const int nmain = (nitem / (NGW * 64)) * (NGW * 64);
    for (int q = gw; q < (nitem - nmain) / 4; q += NGW) { const int item = nmain + 4 * q, n = item >> 3; topk_rows4(S, PK, skip_ctx ? tok_row(1, n) : n, item & 7, lane); }
    for (int base = gw * 64; base < nmain; base += NGW * 64) {
        const int item = base + lane, n = item >> 3, h = item & 7, r = skip_ctx ? tok_row(1, n) : n;
        const unsigned short* sp = S + (size_t)r * 2048 + h * 256;
        int t1[16], t2[16];
#pragma unroll
        for (int list = 0; list < 2; ++list) {
            int T[16];
#pragma unroll
            for (int i = 0; i < 16; ++i) T[i] = KMIN;
            const unsigned short* lp = sp + 128 * list;
            u32x4 ra = *(const u32x4*)lp, rb = *(const u32x4*)(lp + 8);
#pragma unroll 1
            for (int c = 0; c < 8; ++c) {
                const int cn = c < 7 ? c + 1 : 7;
                const u32x4 na = *(const u32x4*)(lp + 16 * cn), nb = *(const u32x4*)(lp + 16 * cn + 8);
                const int pb = 127 - 16 * c;
                int K[16];
#pragma unroll
                for (int d = 0; d < 4; ++d) { K[2 * d] = hkey_hi(ra[d] << 16) | (pb - 2 * d); K[2 * d + 1] = hkey_hi(ra[d]) | (pb - 2 * d - 1);
                    K[8 + 2 * d] = hkey_hi(rb[d] << 16) | (pb - 8 - 2 * d); K[8 + 2 * d + 1] = hkey_hi(rb[d]) | (pb - 9 - 2 * d); }
                SORT16_DESC(K);
                MERGE16_DESC(T, K);
                ra = na; rb = nb;
            }
#pragma unroll
            for (int i = 0; i < 16; ++i) { if (list == 0) t1[i] = T[i]; else t2[i] = T[i]; }
        }
        float f1[16], f2[16];
#pragma unroll
        for (int i = 0; i < 16; ++i) { f1[i] = hkey_val(t1[i]); f2[i] = hkey_val(t2[i]); }
        int CA[16], CB[16], CC[16], CD[16];
        CA[0] = (fkey(f1[0] + f2[0]) & ~63) | 63; CA[1] = (fkey(f1[0] + f2[1]) & ~63) | 62; CA[2] = (fkey(f1[0] + f2[2]) & ~63) | 61; CA[3] = (fkey(f1[0] + f2[3]) & ~63) | 60; CA[4] = (fkey(f1[0] + f2[4]) & ~63) | 59; CA[5] = (fkey(f1[0] + f2[5]) & ~63) | 58; CA[6] = (fkey(f1[0] + f2[6]) & ~63) | 57; CA[7] = (fkey(f1[0] + f2[7]) & ~63) | 56; CA[8] = (fkey(f1[0] + f2[8]) & ~63) | 55; CA[9] = (fkey(f1[0] + f2[9]) & ~63) | 54; CA[10] = (fkey(f1[0] + f2[10]) & ~63) | 53; CA[11] = (fkey(f1[0] + f2[11]) & ~63) | 52; CA[12] = (fkey(f1[0] + f2[12]) & ~63) | 51; CA[13] = (fkey(f1[0] + f2[13]) & ~63) | 50; CA[14] = (fkey(f1[0] + f2[14]) & ~63) | 49; CA[15] = (fkey(f1[0] + f2[15]) & ~63) | 48; CB[0] = (fkey(f1[1] + f2[0]) & ~63) | 47; CB[1] = (fkey(f1[1] + f2[1]) & ~63) | 46; CB[2] = (fkey(f1[1] + f2[2]) & ~63) | 45; CB[3] = (fkey(f1[1] + f2[3]) & ~63) | 44; CB[4] = (fkey(f1[1] + f2[4]) & ~63) | 43; CB[5] = (fkey(f1[1] + f2[5]) & ~63) | 42; CB[6] = (fkey(f1[1] + f2[6]) & ~63) | 41; CB[7] = (fkey(f1[1] + f2[7]) & ~63) | 40; CB[8] = (fkey(f1[2] + f2[0]) & ~63) | 39; CB[9] = (fkey(f1[2] + f2[1]) & ~63) | 38; CB[10] = (fkey(f1[2] + f2[2]) & ~63) | 37; CB[11] = (fkey(f1[2] + f2[3]) & ~63) | 36; CB[12] = (fkey(f1[2] + f2[4]) & ~63) | 35; CB[13] = (fkey(f1[3] + f2[0]) & ~63) | 34; CB[14] = (fkey(f1[3] + f2[1]) & ~63) | 33; CB[15] = (fkey(f1[3] + f2[2]) & ~63) | 32; CC[0] = (fkey(f1[3] + f2[3]) & ~63) | 31; CC[1] = (fkey(f1[4] + f2[0]) & ~63) | 30; CC[2] = (fkey(f1[4] + f2[1]) & ~63) | 29; CC[3] = (fkey(f1[4] + f2[2]) & ~63) | 28; CC[4] = (fkey(f1[5] + f2[0]) & ~63) | 27; CC[5] = (fkey(f1[5] + f2[1]) & ~63) | 26; CC[6] = (fkey(f1[6] + f2[0]) & ~63) | 25; CC[7] = (fkey(f1[6] + f2[1]) & ~63) | 24; CC[8] = (fkey(f1[7] + f2[0]) & ~63) | 23; CC[9] = (fkey(f1[7] + f2[1]) & ~63) | 22; CC[10] = (fkey(f1[8] + f2[0]) & ~63) | 21; CC[11] = (fkey(f1[9] + f2[0]) & ~63) | 20; CC[12] = (fkey(f1[10] + f2[0]) & ~63) | 19; CC[13] = (fkey(f1[11] + f2[0]) & ~63) | 18; CC[14] = (fkey(f1[12] + f2[0]) & ~63) | 17; CC[15] = (fkey(f1[13] + f2[0]) & ~63) | 16; CD[0] = (fkey(f1[14] + f2[0]) & ~63) | 15; CD[1] = (fkey(f1[15] + f2[0]) & ~63) | 14; CD[2] = KMIN; CD[3] = KMIN; CD[4] = KMIN; CD[5] = KMIN; CD[6] = KMIN; CD[7] = KMIN; CD[8] = KMIN; CD[9] = KMIN; CD[10] = KMIN; CD[11] = KMIN; CD[12] = KMIN; CD[13] = KMIN; CD[14] = KMIN; CD[15] = KMIN;
        SORT16_DESC(CB); SORT16_DESC(CC); CE_DESC(CD[0], CD[1]);
        MERGE16_DESC(CA, CB); MERGE16_DESC(CA, CC); MERGE16_DESC(CA, CD);
        const float mx = keyf((CA[0] & ~63) | 32);
        float ex[16], sum = 0.f; unsigned te[16];
#pragma unroll
        for (int k = 0; k < 16; ++k) { int wi, wj; cand_ij(63 - (CA[k] & 63), wi, wj);
            const int wa = sel16(t1, wi), wb = sel16(t2, wj);
            te[k] = (unsigned)((127 - (wa & 127)) * 128 + (127 - (wb & 127)));
            ex[k] = __expf(keyf((CA[k] & ~63) | 32) - mx); sum += ex[k]; }
        const float rs = 65535.f / sum;
        u32x4* dst = (u32x4*)(PK + (size_t)r * 128 + h * 16);
#pragma unroll
        for (int q = 0; q < 4; ++q) { u32x4 o;
#pragma unroll
            for (int d = 0; d < 4; ++d) o[d] = (te[4 * q + d] << 16) | (unsigned)(ex[4 * q + d] * rs + 0.5f);
            dst[q] = o; }
    }
}

#define UB(w, b) ((float)(((w) >> (8 * (b))) & 0xffu))
__device__ __forceinline__ void p_peer_experts(const Args& A, const Frame& F, int layer) {
    const int gw = F.bid * NWAVES + F.wave, NGW = F.nblk * NWAVES, lane = F.lane;
    const bf16_t* H = (const bf16_t*)(F.ws + WS_H); float* X = (float*)(F.ws + WS_X);
    const unsigned* PK = (const unsigned*)(F.ws + WS_PK);
    const unsigned char* UT = F.ws + WS_TAB + (size_t)(layer * 2) * 16384 * 1024; const unsigned char* VT = UT + (size_t)16384 * 1024;
    const float* SU = (const float*)(F.ws + WS_TSC) + (layer * 2) * 16384; const float* SV = SU + 16384;
    const float* MOD = (const float*)(F.ws + WS_MOD) + (size_t)layer * 5 * 6144;
    for (int r = gw; r < R; r += NGW) {
        if (layer == 1 && is_ctx_row(r)) continue;
        float hf[16];
        { const u32x4 w0 = *(const u32x4*)(H + (size_t)r * DM + 16 * lane), w1 = *(const u32x4*)(H + (size_t)r * DM + 16 * lane + 8);
#pragma unroll
          for (int d = 0; d < 4; ++d) { hf[2 * d] = bflo(w0[d]); hf[2 * d + 1] = bfhi(w0[d]); hf[8 + 2 * d] = bflo(w1[d]); hf[8 + 2 * d + 1] = bfhi(w1[d]); } }
        float hs = 0.f;
#pragma unroll
        for (int i = 0; i < 16; ++i) hs += hf[i];
        hs = wave_sum(hs);
        int v0 = (int)PK[(size_t)r * 128 + lane], v1 = (int)PK[(size_t)r * 128 + 64 + lane];
#pragma unroll
        for (int k = 2; k <= 128; k <<= 1) {
#pragma unroll
            for (int j = k >> 1; j >= 1; j >>= 1) {
                if (j == 64) { const int a = min(v0, v1), b = max(v0, v1); v0 = a; v1 = b; }
                else { const int o0 = __shfl_xor(v0, j), o1 = __shfl_xor(v1, j); const bool lower = (lane & j) == 0;
                    const bool asc0 = (k == 128) ? true : (k == 64) ? true : ((lane & k) == 0), asc1 = (k == 128) ? true : (k == 64) ? false : ((lane & k) == 0);
                    v0 = (lower == asc0) ? min(v0, o0) : max(v0, o0); v1 = (lower == asc1) ? min(v1, o1) : max(v1, o1); }
            }
        }
        const unsigned pk0 = (unsigned)v0, pk1 = (unsigned)v1;
        const int e0 = (int)(pk0 >> 16), e1 = (int)(pk1 >> 16);
        const float g0 = (float)(pk0 & 0xffffu) * (1.f / 65535.f), g1 = (float)(pk1 & 0xffffu) * (1.f / 65535.f);
        const float su0 = SU[e0], su1 = SU[e1], sv0 = SV[e0], sv1 = SV[e1];
        float d0 = 0.f, d1 = 0.f;
        const int dep_src = (8 * (lane & 7)) << 2; const bool bit3 = (lane & 8) != 0;
#define XISSUE(buf, TAB, esrc, gg) do { _Pragma("unroll") for (int q_ = 0; q_ < 8; ++q_) { const int e_ = __builtin_amdgcn_readlane(esrc, (gg) * 8 + q_); \
            buf[q_] = *(const u32x4*)((TAB) + (size_t)e_ * 1024 + 16 * lane); } } while (0)
#define UCOMP(buf, gg, dsel) do { float p_[8]; _Pragma("unroll") for (int q_ = 0; q_ < 8; ++q_) { float d_ = 0.f; \
            _Pragma("unroll") for (int j_ = 0; j_ < 4; ++j_) d_ += (hf[4 * j_] * UB(buf[q_][j_], 0) + hf[4 * j_ + 1] * UB(buf[q_][j_], 1)) + (hf[4 * j_ + 2] * UB(buf[q_][j_], 2) + hf[4 * j_ + 3] * UB(buf[q_][j_], 3)); p_[q_] = d_; } \
            float s_[4]; _Pragma("unroll") for (int q_ = 0; q_ < 4; ++q_) { auto rr_ = __builtin_amdgcn_permlane32_swap(__float_as_uint(p_[q_]), __float_as_uint(p_[q_ + 4]), false, false); s_[q_] = __uint_as_float(rr_[0]) + __uint_as_float(rr_[1]); } \
            float t_[2]; _Pragma("unroll") for (int q_ = 0; q_ < 2; ++q_) { auto rr_ = __builtin_amdgcn_permlane16_swap(__float_as_uint(s_[q_]), __float_as_uint(s_[q_ + 2]), false, false); t_[q_] = __uint_as_float(rr_[0]) + __uint_as_float(rr_[1]); } \
            const float keep_ = bit3 ? t_[1] : t_[0], send_ = bit3 ? t_[0] : t_[1]; \
            float u_ = keep_ + __builtin_bit_cast(float, __builtin_amdgcn_update_dpp(0, __builtin_bit_cast(int, send_), 0x128, 0xf, 0xf, false)); \
            u_ += __builtin_bit_cast(float, __builtin_amdgcn_update_dpp(0, __builtin_bit_cast(int, u_), DPP_HMIRROR, 0xf, 0xf, false)); \
            u_ += __builtin_bit_cast(float, __builtin_amdgcn_update_dpp(0, __builtin_bit_cast(int, u_), DPP_XOR1, 0xf, 0xf, false)); \
            u_ += __builtin_bit_cast(float, __builtin_amdgcn_update_dpp(0, __builtin_bit_cast(int, u_), DPP_XOR2, 0xf, 0xf, false)); \
            const float v_ = __builtin_bit_cast(float, __builtin_amdgcn_ds_bpermute(dep_src, __builtin_bit_cast(int, u_))); \
            if ((lane >> 3) == (gg)) dsel = v_; } while (0)
        {
            u32x4 ua[8], ub[8];
            XISSUE(ua, UT, e0, 0);
#pragma unroll 1
            for (int g = 0; g < 8; g += 2) { XISSUE(ub, UT, e0, g + 1); UCOMP(ua, g, d0); if (g + 2 < 8) XISSUE(ua, UT, e0, g + 2); else XISSUE(ua, UT, e1, 0); UCOMP(ub, g + 1, d0); }
#pragma unroll 1
            for (int g = 0; g < 8; g += 2) { XISSUE(ub, UT, e1, g + 1); UCOMP(ua, g, d1); if (g + 2 < 8) XISSUE(ua, UT, e1, g + 2); UCOMP(ub, g + 1, d1); }
        }
        const float a0 = su0 * (d0 - 128.f * hs), a1 = su1 * (d1 - 128.f * hs);
        const float w0 = g0 * 0.5f * a0 * (1.f + erff(a0 * 0.70710678118654752f)) * sv0, w1 = g1 * 0.5f * a1 * (1.f + erff(a1 * 0.70710678118654752f)) * sv1;
        const float wsum = wave_sum(w0 + w1) * 128.f;
        float acc[16];
#pragma unroll
        for (int i = 0; i < 16; ++i) acc[i] = 0.f;
#define VCOMP(buf, wsrc, gg) do { _Pragma("unroll") for (int q_ = 0; q_ < 8; ++q_) { const float wk_ = __builtin_bit_cast(float, __builtin_amdgcn_readlane(__builtin_bit_cast(int, wsrc), (gg) * 8 + q_)); \
            _Pragma("unroll") for (int j_ = 0; j_ < 4; ++j_) { acc[4 * j_] += wk_ * UB(buf[q_][j_], 0); acc[4 * j_ + 1] += wk_ * UB(buf[q_][j_], 1); acc[4 * j_ + 2] += wk_ * UB(buf[q_][j_], 2); acc[4 * j_ + 3] += wk_ * UB(buf[q_][j_], 3); } } } while (0)
        {
            u32x4 va[8], vb[8];
            XISSUE(va, VT, e0, 0);
#pragma unroll 1
            for (int g = 0; g < 8; g += 2) { XISSUE(vb, VT, e0, g + 1); VCOMP(va, w0, g); if (g + 2 < 8) XISSUE(va, VT, e0, g + 2); else XISSUE(va, VT, e1, 0); VCOMP(vb, w0, g + 1); }
#pragma unroll 1
            for (int g = 0; g < 8; g += 2) { XISSUE(vb, VT, e1, g + 1); VCOMP(va, w1, g); if (g + 2 < 8) XISSUE(va, VT, e1, g + 2); VCOMP(vb, w1, g + 1); }
        }
#undef XISSUE
#undef UCOMP
#undef VCOMP
        const float* mm = MOD + (size_t)mod_index(r) * 6144;
        f32x4 xn[4]; float s = 0.f;
#pragma unroll
        for (int j = 0; j < 4; ++j) { const int c = 16 * lane + 4 * j; const float* xp = X + (size_t)r * DM + c; const f32x4 gf = *(const f32x4*)(mm + 5 * 1024 + c);
            xn[j] = *(const f32x4*)xp + gf * (f32x4){acc[4 * j] - wsum, acc[4 * j + 1] - wsum, acc[4 * j + 2] - wsum, acc[4 * j + 3] - wsum};
            s += (xn[j].x * xn[j].x + xn[j].y * xn[j].y) + (xn[j].z * xn[j].z + xn[j].w * xn[j].w); }
        const float rinv = rsqrtf(wave_sum(s) * (1.f / DM) + EPS);
        if (layer == 0) {
            const float* m1 = (const float*)(F.ws + WS_MOD) + (size_t)(5 + mod_index(r)) * 6144;
            const float* gn = A.in[I1_NMIX];
#pragma unroll
            for (int j = 0; j < 4; ++j) { const int c = 16 * lane + 4 * j; *(f32x4*)(X + (size_t)r * DM + c) = xn[j];
                const f32x4 y = (xn[j] * rinv * *(const f32x4*)(gn + c)) * (*(const f32x4*)(m1 + 1024 + c) + 1.f) + *(const f32x4*)(m1 + c);
                u32x2 o; o.x = pk2(y.x, y.y); o.y = pk2(y.z, y.w); *(u32x2*)((bf16_t*)(F.ws + WS_H) + (size_t)r * DM + c) = o; }
        } else {
            const int b = r / RPB, t = (r - b * RPB) - CTXL; float* op = F.out + ((size_t)b * SEQ + t) * DM; const float* gn = A.in[I_NOUT];
#pragma unroll
            for (int j = 0; j < 4; ++j) { const int c = 16 * lane + 4 * j; *(f32x4*)(op + c) = xn[j] * rinv * *(const f32x4*)(gn + c); }
        }
    }
}

__device__ __forceinline__ int tok_row(int layer, int n) { return layer == 0 ? n : (n >> 12) * RPB + CTXL + (n & 4095); }
#define DPPF(v, ctrl) __builtin_bit_cast(float, __builtin_amdgcn_update_dpp(0, __builtin_bit_cast(int, v), ctrl, 0xf, 0xf, false))
__device__ __forceinline__ int isum8(int v) {
    v += __builtin_amdgcn_update_dpp(0, v, DPP_XOR1, 0xf, 0xf, false); v += __builtin_amdgcn_update_dpp(0, v, DPP_XOR2, 0xf, 0xf, false); v += __builtin_amdgcn_update_dpp(0, v, DPP_HMIRROR, 0xf, 0xf, false); return v; }
__device__ __forceinline__ void p_exp_u(const Args& A, const Frame& F, int layer) {
    const int lane = F.lane, s = lane >> 3, c8 = lane & 7;
    const bool part = (F.nblk & 7) == 0; const int ncb = part ? 1 : 8, cb0 = part ? (F.bid & 7) : 0;
    const int gwv = part ? ((F.bid >> 3) * NWAVES + F.wave) : (F.bid * NWAVES + F.wave), nwv = part ? ((F.nblk >> 3) * NWAVES) : (F.nblk * NWAVES);
    const int ntok = layer == 0 ? R : NB * SEQ;
    const unsigned char* HQ = F.ws + WS_HQ; const unsigned* PK = (const unsigned*)(F.ws + WS_PK);
    const unsigned char* UT = F.ws + WS_TAB + (size_t)(layer * 2) * 16384 * 1024;
    int* PD = (int*)(F.ws + WS_PD);
#define U_META(pk, hq, n_) do { const int r_ = tok_row(layer, (n_) < ntok ? (n_) : gwv); const unsigned* p_ = PK + (size_t)r_ * 128 + s; \
        _Pragma("unroll") for (int i_ = 0; i_ < 16; ++i_) pk[i_] = p_[8 * i_]; \
        hq = *(const u32x4*)(HQ + (size_t)r_ * DM + 128 * cb + 16 * c8); } while (0)
#define U_ISSUE(pk, lo) do { _Pragma("unroll") for (int i_ = (lo); i_ < (lo) + 8; ++i_) t[i_] = *(const u32x4*)(tb + (size_t)(pk[i_] >> 16) * 128); } while (0)
#define U_DOT(i_) do { int d_ = __builtin_amdgcn_sdot4((int)t[i_][0], (int)hv[0], 0, false); d_ = __builtin_amdgcn_sdot4((int)t[i_][1], (int)hv[1], d_, false); \
        d_ = __builtin_amdgcn_sdot4((int)t[i_][2], (int)hv[2], d_, false); d_ = __builtin_amdgcn_sdot4((int)t[i_][3], (int)hv[3], d_, false); \
        d_ = isum8(d_); if (c8 == ((i_) & 7)) { if ((i_) < 8) kA = d_; else kB = d_; } } while (0)
#define U_ITEM(pkc, hqc, pkn, n_) do { \
        const u32x4 hv = hqc; \
        U_META(pkc, hqc, (n_) + 2 * nwv); \
        int kA = 0, kB = 0; \
        _Pragma("unroll") for (int i_ = 0; i_ < 8; ++i_) U_DOT(i_); \
        U_ISSUE(pkn, 0); \
        _Pragma("unroll") for (int i_ = 8; i_ < 16; ++i_) U_DOT(i_); \
        U_ISSUE(pkn, 8); \
        if ((n_) < ntok) { const int r_ = tok_row(layer, n_); int* pd_ = PD + ((size_t)cb * R + r_) * 128 + 8 * c8 + s; pd_[0] = kA; pd_[64] = kB; } \
        } while (0)
#pragma unroll 1
    for (int cbi = 0; cbi < ncb; ++cbi) {
        const int cb = cb0 + cbi;
        const unsigned char* tb = UT + (size_t)cb * 16384 * 128 + 16 * c8;
        unsigned pkA[16], pkB[16]; u32x4 hA, hB, t[16];
        U_META(pkA, hA, gwv); U_META(pkB, hB, gwv + nwv);
        U_ISSUE(pkA, 0); U_ISSUE(pkA, 8);
#pragma unroll 1
        for (int n = gwv; n < ntok; n += 2 * nwv) {
            U_ITEM(pkA, hA, pkB, n);
            U_ITEM(pkB, hB, pkA, n + nwv);
        }
    }
#undef U_META
#undef U_ISSUE
#undef U_DOT
#undef U_ITEM
}
__device__ __forceinline__ void p_exp_w(const Args& A, const Frame& F, int layer) {
    const int gw = F.bid * NWAVES + F.wave, NGW = F.nblk * NWAVES, lane = F.lane;
    const int ntok = layer == 0 ? R : NB * SEQ;
    const unsigned* PK = (const unsigned*)(F.ws + WS_PK); const int* PD = (const int*)(F.ws + WS_PD); const float* HS = (const float*)(F.ws + WS_HS);
    unsigned* WQ8 = (unsigned*)(F.ws + WS_WQ8); float* WSC = (float*)(F.ws + WS_WSC);
    const float* SU = (const float*)(F.ws + WS_TSC) + (layer * 2) * 16384; const float* SV = SU + 16384;
    const int g2 = (lane >> 3) & 3, sb = lane & 7, src = 32 * (g2 & 1) + sb;
    for (int n = gw; n < ntok; n += 2 * NGW) {
        int r[2]; r[0] = tok_row(layer, n); r[1] = (n + NGW) < ntok ? tok_row(layer, n + NGW) : r[0];
        unsigned pk0[2], pk1[2]; int d0[2], d1[2]; float hs[2];
#pragma unroll
        for (int q = 0; q < 2; ++q) { pk0[q] = PK[(size_t)r[q] * 128 + lane]; pk1[q] = PK[(size_t)r[q] * 128 + 64 + lane]; hs[q] = HS[r[q]]; d0[q] = 0; d1[q] = 0;
#pragma unroll
            for (int cb = 0; cb < 8; ++cb) { d0[q] += PD[((size_t)cb * R + r[q]) * 128 + lane]; d1[q] += PD[((size_t)cb * R + r[q]) * 128 + 64 + lane]; } }
        float su0[2], su1[2], sv0[2], sv1[2];
#pragma unroll
        for (int q = 0; q < 2; ++q) { const int e0 = (int)(pk0[q] >> 16), e1 = (int)(pk1[q] >> 16); su0[q] = SU[e0]; su1[q] = SU[e1]; sv0[q] = SV[e0]; sv1[q] = SV[e1]; }
#pragma unroll
        for (int q = 0; q < 2; ++q) {
            const float g0 = (float)(pk0[q] & 0xffffu) * (1.f / 65535.f), g1 = (float)(pk1[q] & 0xffffu) * (1.f / 65535.f);
            const float a0 = su0[q] * hs[q] * (float)d0[q], a1 = su1[q] * hs[q] * (float)d1[q];
            const float w0 = g0 * 0.5f * a0 * (1.f + erff(a0 * 0.70710678118654752f)) * sv0[q], w1 = g1 * 0.5f * a1 * (1.f + erff(a1 * 0.70710678118654752f)) * sv1[q];
            const float wm = wave_max(fmaxf(fabsf(w0), fabsf(w1)));
            const float inv = wm > 0.f ? 127.f / wm : 0.f;
            const int q0 = (int)rintf(w0 * inv) & 0xff, q1 = (int)rintf(w1 * inv) & 0xff;
            unsigned pw = 0;
#pragma unroll
            for (int j = 0; j < 4; ++j) { const int x0 = __shfl(q0, src + 8 * j), x1 = __shfl(q1, src + 8 * j); pw |= (unsigned)((g2 < 2) ? x0 : x1) << (8 * j); }
            if (q == 0 || (n + NGW) < ntok) { if (lane < 32) WQ8[(size_t)r[q] * 32 + lane] = pw; if (lane == 0) WSC[r[q]] = wm > 0.f ? wm * (1.f / 127.f) : 0.f; }
        }
    }
}
__device__ __forceinline__ void p_exp_v(const Args& A, const Frame& F, int layer) {
    const int lane = F.lane, s = lane >> 3, c8 = lane & 7;
    const bool part = (F.nblk & 7) == 0; const int ncb = part ? 1 : 8, cb0 = part ? (F.bid & 7) : 0;
    const int gwv = part ? ((F.bid >> 3) * NWAVES + F.wave) : (F.bid * NWAVES + F.wave), nwv = part ? ((F.nblk >> 3) * NWAVES) : (F.nblk * NWAVES);
    const int ntok = layer == 0 ? R : NB * SEQ;
    const unsigned* PK = (const unsigned*)(F.ws + WS_PK); const unsigned* WQ8 = (const unsigned*)(F.ws + WS_WQ8); const float* WSC = (const float*)(F.ws + WS_WSC);
    const unsigned char* VT = F.ws + WS_TAB + (size_t)(layer * 2 + 1) * 16384 * 1024;
    unsigned short* X = (unsigned short*)(F.ws + WS_X); const float* MOD = (const float*)(F.ws + WS_MOD) + (size_t)layer * 5 * 6144;
    const bool bit3 = (lane & 8) != 0;
#define V_METAP(pk, n_) do { const int r_ = tok_row(layer, (n_) < ntok ? (n_) : gwv); const unsigned* p_ = PK + (size_t)r_ * 128 + s; \
        _Pragma("unroll") for (int i_ = 0; i_ < 16; ++i_) pk[i_] = p_[8 * i_]; } while (0)
#define V_METAW(wq, n_) do { const int r_ = tok_row(layer, (n_) < ntok ? (n_) : gwv); const unsigned* w_ = WQ8 + (size_t)r_ * 32 + s; \
        _Pragma("unroll") for (int g_ = 0; g_ < 4; ++g_) wq[g_] = w_[8 * g_]; } while (0)
#define V_ISSUE(pk, lo) do { _Pragma("unroll") for (int i_ = (lo); i_ < (lo) + 8; ++i_) t[i_] = *(const u32x4*)(tb + (size_t)(pk[i_] >> 16) * 128); } while (0)
#define V_GRP(wq, g_) do { _Pragma("unroll") for (int j_ = 0; j_ < 4; ++j_) { const unsigned a_ = t[4 * (g_)][j_], b_ = t[4 * (g_) + 1][j_], c_ = t[4 * (g_) + 2][j_], d_ = t[4 * (g_) + 3][j_]; \
        const unsigned ablo = __builtin_amdgcn_perm(b_, a_, 0x05010400u), abhi = __builtin_amdgcn_perm(b_, a_, 0x07030602u), cdlo = __builtin_amdgcn_perm(d_, c_, 0x05010400u), cdhi = __builtin_amdgcn_perm(d_, c_, 0x07030602u); \
        acc[4 * j_]     = __builtin_amdgcn_sdot4((int)__builtin_amdgcn_perm(cdlo, ablo, 0x05040100u), (int)wq[g_], acc[4 * j_], false); \
        acc[4 * j_ + 1] = __builtin_amdgcn_sdot4((int)__builtin_amdgcn_perm(cdlo, ablo, 0x07060302u), (int)wq[g_], acc[4 * j_ + 1], false); \
        acc[4 * j_ + 2] = __builtin_amdgcn_sdot4((int)__builtin_amdgcn_perm(cdhi, abhi, 0x05040100u), (int)wq[g_], acc[4 * j_ + 2], false); \
        acc[4 * j_ + 3] = __builtin_amdgcn_sdot4((int)__builtin_amdgcn_perm(cdhi, abhi, 0x07060302u), (int)wq[g_], acc[4 * j_ + 3], false); } } while (0)
#define V_ITEM(pkc, wqc, pkn, n_) do { \
        int acc[16]; _Pragma("unroll") for (int a_ = 0; a_ < 16; ++a_) acc[a_] = 0; \
        V_METAP(pkc, (n_) + 2 * nwv); \
        V_GRP(wqc, 0); V_GRP(wqc, 1); \
        V_ISSUE(pkn, 0); \
        V_GRP(wqc, 2); V_GRP(wqc, 3); \
        V_ISSUE(pkn, 8); \
        int b8[8], c4[4], o[2]; \
        _Pragma("unroll") for (int a_ = 0; a_ < 8; ++a_) { auto rr = __builtin_amdgcn_permlane32_swap((unsigned)acc[a_], (unsigned)acc[a_ + 8], false, false); b8[a_] = (int)rr[0] + (int)rr[1]; } \
        _Pragma("unroll") for (int a_ = 0; a_ < 4; ++a_) { auto rr = __builtin_amdgcn_permlane16_swap((unsigned)b8[a_], (unsigned)b8[a_ + 4], false, false); c4[a_] = (int)rr[0] + (int)rr[1]; } \
        _Pragma("unroll") for (int a_ = 0; a_ < 2; ++a_) { const int keep = bit3 ? c4[a_ + 2] : c4[a_], send = bit3 ? c4[a_] : c4[a_ + 2]; o[a_] = keep + __builtin_amdgcn_update_dpp(0, send, 0x128, 0xf, 0xf, false); } \
        if ((n_) < ntok) { const int r_ = tok_row(layer, n_); const float ws_ = WSC[r_]; const int col = 128 * cb + 16 * c8 + 2 * s; \
            const f32x2 gf = *(const f32x2*)(MOD + (size_t)mod_index(r_) * 6144 + 5 * 1024 + col); unsigned* xp = (unsigned*)(X + (size_t)r_ * DM + col); \
            const unsigned xw = *xp; *xp = pkh2(h2f_lo(xw) + gf.x * (ws_ * (float)o[0]), h2f_hi(xw) + gf.y * (ws_ * (float)o[1])); } \
        V_METAW(wqc, (n_) + 2 * nwv); } while (0)
#pragma unroll 1
    for (int cbi = 0; cbi < ncb; ++cbi) {
        const int cb = cb0 + cbi;
        const unsigned char* tb = VT + (size_t)cb * 16384 * 128 + 16 * c8;
        unsigned pkA[16], pkB[16], wqA[4], wqB[4]; u32x4 t[16];
        V_METAP(pkA, gwv); V_METAW(wqA, gwv); V_METAP(pkB, gwv + nwv); V_METAW(wqB, gwv + nwv);
        V_ISSUE(pkA, 0); V_ISSUE(pkA, 8);
#pragma unroll 1
        for (int n = gwv; n < ntok; n += 2 * nwv) {
            V_ITEM(pkA, wqA, pkB, n);
            V_ITEM(pkB, wqB, pkA, n + nwv);
        }
    }
#undef V_METAP
#undef V_METAW
#undef V_ISSUE
#undef V_GRP
#undef V_ITEM
}
__device__ __forceinline__ void p_final_norm(const Args& A, const Frame& F) {
    const int gw = F.bid * NWAVES + F.wave, NGW = F.nblk * NWAVES, lane = F.lane;
    const unsigned short* X = (const unsigned short*)(F.ws + WS_X); const float* gn = A.in[I_NOUT];
    for (int n = gw; n < NB * SEQ; n += NGW) {
        const unsigned short* xr = X + (size_t)tok_row(1, n) * DM; float* op = F.out + (size_t)n * DM;
        f32x4 v[4]; float sq = 0.f;
#pragma unroll
        for (int j = 0; j < 4; ++j) { const u32x2 a = *(const u32x2*)(xr + 4 * lane + 256 * j); v[j] = (f32x4){h2f_lo(a.x), h2f_hi(a.x), h2f_lo(a.y), h2f_hi(a.y)}; sq += (v[j].x * v[j].x + v[j].y * v[j].y) + (v[j].z * v[j].z + v[j].w * v[j].w); }
        const float rinv = rsqrtf(wave_sum(sq) * (1.f / DM) + EPS);
#pragma unroll
        for (int j = 0; j < 4; ++j) { const int c = 4 * lane + 256 * j; *(f32x4*)(op + c) = v[j] * rinv * *(const f32x4*)(gn + c); }
    }
}

constexpr int N_PHASES = 24;
__global__ void __launch_bounds__(NTHREADS, 2) mega(Args args) {
    extern __shared__ __attribute__((aligned(16))) unsigned char lds_raw[];
    Frame F; F.x = args.in[I_X]; F.ctx = args.in[I_CTX]; F.out = args.out; F.ws = args.ws; F.lds = (char*)lds_raw;
    F.tid = threadIdx.x; F.lane = F.tid & 63; F.wave = __builtin_amdgcn_readfirstlane(F.tid >> 6); F.bid = blockIdx.x; F.nblk = gridDim.x;
    F.vcu = (F.nblk % 8 == 0) ? (F.bid % 8) * (F.nblk / 8) + F.bid / 8 : F.bid;
    volatile LAS unsigned* st = (volatile LAS unsigned*)(LAS unsigned char*)(lds_raw + LDS_BYTES - 64);
    if (F.tid < 16) st[F.tid] = 0u;
    __syncthreads();
    XcdBarrier bar; bar.bar = (unsigned*)(F.ws + WS_CTL) + 4096; bar.x = 0; bar.st = st;
    const int lo = args.ph_lo, hi = args.ph_hi;
    const bool fused = (hi - lo) > 1;
    if (fused) bar = xcd_barrier_post((unsigned*)(F.ws + WS_CTL) + 4096, st);
#ifdef ONLY_PHASE
#define IN(k) ((k) == ONLY_PHASE && lo <= (k) && (k) < hi)
#else
#define IN(k) (lo <= (k) && (k) < hi)
#endif
#define SEAM(k) do { if (IN(k) && IN((k) + 1)) { if ((k) == 0) cg::this_grid().sync(); else xcd_barrier(bar); } } while (0)
    bf16_t* Hb = (bf16_t*)(F.ws + WS_H);
#define PH(k, ...) if (IN(k)) for (int rep_ = 0; rep_ < (((PROBE_MASK >> (k)) & 1u) ? 2 : 1); ++rep_) { __VA_ARGS__; __syncthreads(); } SEAM(k)
    unsigned short* Xb = (unsigned short*)(F.ws + WS_X); const float* MODb = (const float*)(F.ws + WS_MOD);
    PH(0, for (int q_ = 0; q_ < ((PROBE_P0 & 1u) ? 2 : 1); ++q_) { p0_mod(args, F); __syncthreads(); }
          for (int q_ = 0; q_ < ((PROBE_P0 & 2u) ? 2 : 1); ++q_) { p0_weights(args, F); __syncthreads(); }
          for (int q_ = 0; q_ < ((PROBE_P0 & 4u) ? 2 : 1); ++q_) { p0_weff(args, F); __syncthreads(); }
          for (int q_ = 0; q_ < ((PROBE_P0 & 8u) ? 2 : 1); ++q_) { p0_tables(args, F); __syncthreads(); });
    PH(1, p_norm_rows(args, F, 0, 0, true, false));
    PH(2, gemm8e(F, Hb, (const bf16_t*)(F.ws + WS_WIN), 768, 1024, false, EpiMlaDown{(bf16_t*)(F.ws + WS_CQ), (bf16_t*)(F.ws + WS_CKV), (bf16_t*)(F.ws + WS_KR), (float*)(F.ws + WS_SSP)}));
    PH(3, p_mla_krope(args, F);
          gemm8(F, (const bf16_t*)(F.ws + WS_CQ), (const bf16_t*)(F.ws + WS_WUQ), 1536, 384, false, In8Bf16Rs{(bf16_t*)(F.ws + WS_Q), 1536, (const float*)(F.ws + WS_SSP)});
          gemm8(F, (const bf16_t*)(F.ws + WS_CKV), (const bf16_t*)(F.ws + WS_WUKV), 2048, 256, false, In8KVRs{(bf16_t*)(F.ws + WS_K), (bf16_t*)(F.ws + WS_V), (const float*)(F.ws + WS_SSP)}, true));
    PH(4, p_attn_mla(args, F));
    PH(5, gemm8(F, (const bf16_t*)(F.ws + WS_O), (const bf16_t*)(F.ws + WS_WO0), 1024, 1024, false, In8Resid{F.x, F.ctx, Xb, MODb + 2 * 1024, true}));
    PH(6, p_norm_rows(args, F, 0, 1, false, false));
    PH(7, gemm8(F, Hb, (const bf16_t*)(F.ws + WS_WQ0), 2048, 1024, false, In8F16{(unsigned short*)(F.ws + WS_S), 2048}));
    PH(8, p_peer_topk(args, F, false));
    PH(9, p_exp_u(args, F, 0));
    PH(10, p_exp_w(args, F, 0));
    if (IN(11)) { p_exp_v(args, F, 0); } SEAM(11);
    PH(12, p_norm_rows(args, F, 1, 0, false, false));
    PH(13, gemm8(F, Hb, (const bf16_t*)(F.ws + WS_WQKV), 1536, 1024, false, In8Bf16{(bf16_t*)(F.ws + WS_RAW1), 1536}));
    PH(14, p_gqa_rows(args, F));
    PH(15, p_attn_gqa(args, F));
    if (IN(16)) { gemm8(F, (const bf16_t*)(F.ws + WS_O), (const bf16_t*)(F.ws + WS_WO1), 1024, 1024, true, In8Resid{F.x, F.ctx, Xb, MODb + 5 * 6144 + 2 * 1024, false}); } SEAM(16);
    PH(17, p_norm_rows(args, F, 1, 1, false, true));
    PH(18, gemm8(F, Hb, (const bf16_t*)(F.ws + WS_WQ1), 2048, 1024, true, In8F16{(unsigned short*)(F.ws + WS_S), 2048}));
    PH(19, p_peer_topk(args, F, true));
    PH(20, p_exp_u(args, F, 1));
    PH(21, p_exp_w(args, F, 1));
    if (IN(22)) { p_exp_v(args, F, 1); } SEAM(22);
    if (IN(23)) p_final_norm(args, F);
#undef PH
#undef IN
#undef SEAM
}

extern "C" void kernel_launch(void* const* d_in, const int* in_sizes, int n_in, void* d_out, int out_size, void* d_ws, size_t ws_size, hipStream_t stream) {
    static int grid = 0;
    if (grid == 0) {
        if (n_in != N_IN || in_sizes[0] != NB * SEQ * DM || out_size != NB * SEQ * DM || ws_size < WS_END) {
            fprintf(stderr, "kernel_launch: shape mismatch (n_in %d, in0 %d, out %d, ws %zu < %zu)\n", n_in, n_in > 0 ? in_sizes[0] : -1, out_size, ws_size, (size_t)WS_END); grid = -1; return; }
        int dev = 0, cus = 0, per_cu = 0;
        hipGetDevice(&dev); hipDeviceGetAttribute(&cus, hipDeviceAttributeMultiprocessorCount, dev);
        if (hipFuncSetAttribute((const void*)mega, hipFuncAttributeMaxDynamicSharedMemorySize, LDS_BYTES) != hipSuccess) { fprintf(stderr, "kernel_launch: hipFuncSetAttribute failed\n"); grid = -1; return; }
        if (hipOccupancyMaxActiveBlocksPerMultiprocessor(&per_cu, (const void*)mega, NTHREADS, LDS_BYTES) != hipSuccess || per_cu < 1) { fprintf(stderr, "kernel_launch: occupancy query failed (%d)\n", per_cu); (void)hipGetLastError(); grid = -1; return; }
        grid = cus * (per_cu > 1 ? 1 : per_cu);
    }
    if (grid < 0) return;
    hipMemsetAsync((char*)d_ws + WS_CTL, 0, 1 * MiB, stream);
    Args a{};
    for (int i = 0; i < N_IN; ++i) a.in[i] = (const float*)d_in[i];
    a.out = (float*)d_out; a.ws = (unsigned char*)d_ws;
#if MK_PER_PHASE
    for (int p = 0; p < N_PHASES; ++p) { a.ph_lo = p; a.ph_hi = p + 1; hipLaunchKernelGGL(mega, dim3(grid), dim3(NTHREADS), LDS_BYTES, stream, a); }
#else
    a.ph_lo = 0; a.ph_hi = N_PHASES;
    void* kargs[] = {&a};
    hipError_t e = hipLaunchCooperativeKernel((const void*)mega, dim3(grid), dim3(NTHREADS), kargs, LDS_BYTES, stream);
    if (e != hipSuccess) fprintf(stderr, "kernel_launch: cooperative launch failed: %s (grid %d)\n", hipGetErrorString(e), grid);
#endif
}
```

```cpp
#include <hip/hip_runtime.h>
#include <hip/hip_cooperative_groups.h>
#include <cstdio>
#include <cstdint>
namespace cg = cooperative_groups;

#ifndef PROBE_MASK
#define PROBE_MASK 0u
#endif
#ifndef PROBE_P0
#define PROBE_P0 0u
#endif
#ifndef MK_PER_PHASE
#define MK_PER_PHASE 0
#endif

typedef unsigned short bf16_t;
typedef short bf16x8 __attribute__((ext_vector_type(8)));
typedef short s16x4 __attribute__((ext_vector_type(4)));
typedef float f32x4 __attribute__((ext_vector_type(4)));
typedef float f32x2 __attribute__((ext_vector_type(2)));
typedef float f32x16 __attribute__((ext_vector_type(16)));
typedef unsigned u32x4 __attribute__((ext_vector_type(4)));
typedef unsigned u32x2 __attribute__((ext_vector_type(2)));
#define LAS __attribute__((address_space(3)))
#define SBAR() __builtin_amdgcn_sched_barrier(0)

__device__ __forceinline__ unsigned f2bf(float f) { unsigned u = __builtin_bit_cast(unsigned, f); return (u + 0x7fffu + ((u >> 16) & 1u)) >> 16; }
__device__ __forceinline__ unsigned pk2(float lo, float hi) { return f2bf(lo) | (f2bf(hi) << 16); }
typedef _Float16 f16x2_t __attribute__((ext_vector_type(2)));
__device__ __forceinline__ unsigned pkh2(float lo, float hi) { f32x2 v = {lo, hi}; return __builtin_bit_cast(unsigned, __builtin_convertvector(v, f16x2_t)); }
__device__ __forceinline__ float h2f_lo(unsigned w) { return (float)__builtin_bit_cast(_Float16, (unsigned short)(w & 0xffffu)); }
__device__ __forceinline__ float h2f_hi(unsigned w) { return (float)__builtin_bit_cast(_Float16, (unsigned short)(w >> 16)); }
__device__ __forceinline__ float bf2f(unsigned short h) { return __builtin_bit_cast(float, (unsigned)h << 16); }
__device__ __forceinline__ float bflo(unsigned w) { return __builtin_bit_cast(float, w << 16); }
__device__ __forceinline__ float bfhi(unsigned w) { return __builtin_bit_cast(float, w & 0xffff0000u); }
__device__ __forceinline__ unsigned cvtpk(float lo, float hi) { unsigned r; asm volatile("v_cvt_pk_bf16_f32 %0, %1, %2" : "=v"(r) : "v"(lo), "v"(hi)); return r; }
#define WDPP(v, ctrl) __builtin_bit_cast(float, __builtin_amdgcn_update_dpp(0, __builtin_bit_cast(int, v), ctrl, 0xf, 0xf, false))
__device__ __forceinline__ float wave_sum(float v) {
    v += WDPP(v, 0xB1); v += WDPP(v, 0x4E); v += WDPP(v, 0x141); v += WDPP(v, 0x140);
    { auto rr = __builtin_amdgcn_permlane16_swap(__float_as_uint(v), __float_as_uint(v), false, false); v = __uint_as_float(rr[0]) + __uint_as_float(rr[1]); }
    { auto rr = __builtin_amdgcn_permlane32_swap(__float_as_uint(v), __float_as_uint(v), false, false); v = __uint_as_float(rr[0]) + __uint_as_float(rr[1]); }
    return v;
}
__device__ __forceinline__ float wave_max(float v) {
    v = fmaxf(v, WDPP(v, 0xB1)); v = fmaxf(v, WDPP(v, 0x4E)); v = fmaxf(v, WDPP(v, 0x141)); v = fmaxf(v, WDPP(v, 0x140));
    { auto rr = __builtin_amdgcn_permlane16_swap(__float_as_uint(v), __float_as_uint(v), false, false); v = fmaxf(__uint_as_float(rr[0]), __uint_as_float(rr[1])); }
    { auto rr = __builtin_amdgcn_permlane32_swap(__float_as_uint(v), __float_as_uint(v), false, false); v = fmaxf(__uint_as_float(rr[0]), __uint_as_float(rr[1])); }
    return v;
}

constexpr int DM = 1024, NB = 4, SEQ = 4096, CTXL = 256;
constexpr int RPB = SEQ + CTXL;
constexpr int R = NB * RPB;
constexpr float EPS = 1e-6f;
constexpr int NTHREADS = 512, NWAVES = 8;
constexpr int LDS_BYTES = 147456;

enum { I_X = 0, I_C, I_CTX, I_CCTX,
       I0_ADAW, I0_ADAB, I0_NMIX, I0_NFFN, I0_WIN, I0_QN, I0_WUQ, I0_KVN, I0_WUKV, I0_WO, I0_PWQ, I0_PK1, I0_PK2, I0_PU, I0_PV,
       I1_ADAW, I1_ADAB, I1_NMIX, I1_NFFN, I1_WQKV, I1_QN, I1_KN, I1_WO, I1_PWQ, I1_PK1, I1_PK2, I1_PU, I1_PV,
       I_NOUT, N_IN };

constexpr size_t MiB = 1u << 20;
constexpr size_t WS_CTL   = 0;
constexpr size_t WS_MOD   = 1 * MiB;
constexpr size_t WS_WIN   = 2 * MiB;
constexpr size_t WS_WUQ   = WS_WIN + 768 * 1024 * 2;
constexpr size_t WS_WUKV  = WS_WUQ + 1536 * 384 * 2;
constexpr size_t WS_WO0   = WS_WUKV + 2048 * 256 * 2;
constexpr size_t WS_WQ0   = WS_WO0 + 1024 * 1024 * 2;
constexpr size_t WS_KK0   = WS_WQ0 + 2048 * 1024 * 2;
constexpr size_t WS_WQKV  = WS_KK0 + 16 * 128 * 128 * 2;
constexpr size_t WS_WO1   = WS_WQKV + 1536 * 1024 * 2;
constexpr size_t WS_WQ1   = WS_WO1 + 1024 * 1024 * 2;
constexpr size_t WS_KK1   = WS_WQ1 + 2048 * 1024 * 2;
constexpr size_t WS_WEND  = WS_KK1 + 16 * 128 * 128 * 2;
static_assert(WS_WEND <= 24 * MiB, "weights region");
constexpr size_t WS_H     = 24 * MiB;
constexpr size_t WS_X     = WS_H + (size_t)R * 1024 * 2;
constexpr size_t WS_QKV   = WS_X + (size_t)R * 1024 * 4;
constexpr size_t WS_Q     = WS_QKV;
constexpr size_t WS_K     = WS_Q + (size_t)R * 1536 * 2;
constexpr size_t WS_V     = WS_K + (size_t)R * 1536 * 2;
constexpr size_t WS_S     = WS_QKV;
constexpr size_t WS_B     = WS_QKV + (size_t)R * 2048 * 4;
constexpr size_t WS_CQ    = WS_B;
constexpr size_t WS_CKV   = WS_CQ + (size_t)R * 384 * 2;
constexpr size_t WS_KR    = WS_CKV + (size_t)R * 256 * 2;
constexpr size_t WS_SSP   = WS_KR + (size_t)R * 64 * 2;
static_assert(WS_SSP + (size_t)R * 24 * 4 <= WS_B + 40 * MiB, "MLA latents inside region B");
constexpr size_t WS_O     = WS_B;
constexpr size_t WS_QP    = WS_B;
constexpr size_t WS_RAW1  = WS_B;
constexpr size_t WS_PK    = WS_B + (size_t)R * 2048 * 2;
constexpr size_t WS_TAB   = WS_PK + (size_t)R * 128 * 4;
constexpr size_t WS_PD    = WS_S;
constexpr size_t WS_WQ8   = WS_PD + (size_t)8 * R * 128 * 4;
constexpr size_t WS_WSC   = WS_WQ8 + (size_t)R * 128;
static_assert(WS_WSC + (size_t)R * 4 <= WS_B, "expert scratch inside the S region");
constexpr size_t WS_HQ    = WS_B + 40 * MiB;
constexpr size_t WS_HS    = WS_HQ + (size_t)R * 1024;
static_assert(WS_HS + (size_t)R * 4 <= WS_PK, "HQ inside region B");
constexpr size_t WS_TSC   = WS_TAB + (size_t)4 * 16384 * 1024;
constexpr size_t WS_END   = WS_TSC + (size_t)4 * 16384 * 4;
constexpr size_t WS_Q1    = WS_QKV;
constexpr size_t WS_K1    = WS_Q1 + (size_t)R * 1024 * 2;
constexpr size_t WS_V1    = WS_K1 + (size_t)R * 256 * 2;

#define XB_TMO      128
#define XB_XCNT(j)  (256  + 64 * (j))
#define XB_XSUB(j)  (1280 + 64 * (j))
#define XB_XGEN(j)  (2304 + 64 * (j))
#define XB_TOP      3328
#define XB_TOPGEN   3392
#define XCD_BAR_WORDS 3456
#define XB_SPIN_CAP (1u << 20)
__device__ __forceinline__ unsigned xb_ld(unsigned* p)              { return __hip_atomic_load(p, __ATOMIC_RELAXED, __HIP_MEMORY_SCOPE_AGENT); }
__device__ __forceinline__ unsigned xb_add(unsigned* p, unsigned v) { return __hip_atomic_fetch_add(p, v, __ATOMIC_RELAXED, __HIP_MEMORY_SCOPE_AGENT); }
__device__ __forceinline__ unsigned xb_xcc_id() { return (unsigned)__builtin_amdgcn_s_getreg((3 << 11) | 20) & 0xFu; }
#define XB_SPIN(cond, bar) do { unsigned _sp = 0; while (cond) { __builtin_amdgcn_s_sleep(1); \
    if ((++_sp & 255u) == 0u) { if (xb_ld(&(bar)[XB_TMO])) break; if (_sp > XB_SPIN_CAP) { atomicAdd(&(bar)[XB_TMO], 1u); break; } } } } while (0)
struct XcdBarrier { unsigned* bar; unsigned x; volatile LAS unsigned* st; };
__device__ __forceinline__ XcdBarrier xcd_barrier_post(unsigned* bar, volatile LAS unsigned* st) {
    XcdBarrier b; b.bar = bar; b.x = xb_xcc_id(); b.st = st;
    if (threadIdx.x == 0) (void)xb_add(&bar[XB_XCNT(b.x)], 1u);
    return b;
}
__device__ __forceinline__ void xcd_barrier_complete(unsigned* bar, unsigned x, unsigned& nloc, unsigned& nx) {
    const unsigned G = gridDim.x * gridDim.y * gridDim.z;
    unsigned sum, cnt, mine, sp = 0u;
    for (;;) {
        sum = 0u; cnt = 0u; mine = 0u;
#pragma unroll
        for (unsigned j = 0; j < 16; ++j) { const unsigned c = xb_ld(&bar[XB_XCNT(j)]); sum += c; cnt += (c > 0u) ? 1u : 0u; mine = (j == x) ? c : mine; }
        if (sum == G) break;
        __builtin_amdgcn_s_sleep(1);
        if ((++sp & 255u) == 0u) { if (xb_ld(&bar[XB_TMO])) break; if (sp > XB_SPIN_CAP) { atomicAdd(&bar[XB_TMO], 1u); break; } }
    }
    nloc = mine > 0u ? mine : 1u; nx = cnt > 0u ? cnt : 1u;
}
__device__ __forceinline__ void xcd_barrier(const XcdBarrier& b) {
    asm volatile("s_waitcnt vmcnt(0)" ::: "memory");
    __syncthreads();
    if (threadIdx.x == 0) {
        unsigned* bar = b.bar;
        __builtin_amdgcn_s_waitcnt(0);
        unsigned nloc = b.st[0], nx = b.st[1];
        if (nloc == 0u) { xcd_barrier_complete(bar, b.x, nloc, nx); b.st[0] = nloc; b.st[1] = nx; }
        const unsigned old = xb_add(&bar[XB_XSUB(b.x)], 1u);
        const unsigned gen = old / nloc;
        if (old + 1u == (gen + 1u) * nloc) {
            __builtin_amdgcn_fence(__ATOMIC_RELEASE, "agent");
            asm volatile("s_waitcnt vmcnt(0)" ::: "memory");
            const unsigned og = xb_add(&bar[XB_TOP], 1u);
            const unsigned tg = og / nx;
            if (og + 1u == (tg + 1u) * nx) xb_add(&bar[XB_TOPGEN], 1u);
            else XB_SPIN(xb_ld(&bar[XB_TOPGEN]) == tg, bar);
            __builtin_amdgcn_fence(__ATOMIC_ACQUIRE, "agent");
            xb_add(&bar[XB_XGEN(b.x)], 1u);
            asm volatile("s_waitcnt vmcnt(0)" ::: "memory");
        } else {
            XB_SPIN(xb_ld(&bar[XB_XGEN(b.x)]) == gen, bar);
            __builtin_amdgcn_fence(__ATOMIC_ACQUIRE, "agent");
            asm volatile("s_waitcnt vmcnt(0)" ::: "memory");
        }
    }
    __syncthreads();
}


struct Args { const float* in[N_IN]; float* out; unsigned char* ws; int ph_lo, ph_hi; };
static_assert(sizeof(Args) == (N_IN + 2) * 8 + 8, "Args has no padding");

struct Frame {
    const float* x; const float* ctx; float* out; unsigned char* ws; char* lds;
    int tid, lane, wave, bid, nblk, vcu;
};

__device__ __forceinline__ const float* xin_row(const Frame& F, int r) {
    const int b = r / RPB, j = r - b * RPB;
    return (j < CTXL) ? F.ctx + ((size_t)b * CTXL + j) * DM : F.x + ((size_t)b * SEQ + (j - CTXL)) * DM;
}
__device__ __forceinline__ int mod_index(int r) { const int b = r / RPB, j = r - b * RPB; return (j < CTXL) ? 4 : b; }
__device__ __forceinline__ bool is_ctx_row(int r) { return (r % RPB) < CTXL; }

__device__ __forceinline__ void p0_mod(const Args& A, const Frame& F) {
    float* sv = (float*)F.lds;
    float* red = sv + 5 * 1024;
    float* MOD = (float*)(F.ws + WS_MOD);
    bool have = false;
    for (int it = F.bid; it < 2 * 96; it += F.nblk) {
        if (!have) {
            for (int i = F.tid; i < 5 * 1024; i += NTHREADS) { const int m = i >> 10, k = i & 1023;
                const float c = (m < 4) ? A.in[I_C][m * 1024 + k] : A.in[I_CCTX][k]; sv[i] = c / (1.f + __expf(-c)); }
            __syncthreads(); have = true;
        }
        const int l = it / 96, n = (it % 96) * 64 + F.lane;
        const float* W = A.in[l ? I1_ADAW : I0_ADAW]; const float* Bv = A.in[l ? I1_ADAB : I0_ADAB];
        float acc[5] = {0.f, 0.f, 0.f, 0.f, 0.f};
        const int k0 = F.wave * 128;
#pragma unroll 16
        for (int k = k0; k < k0 + 128; ++k) { const float w = W[(size_t)k * 6144 + n];
#pragma unroll
            for (int m = 0; m < 5; ++m) acc[m] += sv[m * 1024 + k] * w; }
#pragma unroll
        for (int m = 0; m < 5; ++m) red[(F.wave * 5 + m) * 64 + F.lane] = acc[m];
        __syncthreads();
        if (F.tid < 320) { const int m = F.tid >> 6, ln = F.tid & 63; float s = 0.f;
#pragma unroll
            for (int w = 0; w < 8; ++w) s += red[(w * 5 + m) * 64 + ln];
            const int nn = (it % 96) * 64 + ln;
            MOD[((size_t)l * 5 + m) * 6144 + nn] = s + Bv[nn]; }
        __syncthreads();
    }
}
__device__ __forceinline__ void transpose_item(const float* W, int K, int N, bf16_t* WT, const float* gain, float* scr, int item, int lane) {
    const int nblk = N / 32, kb = item / nblk, nb = item % nblk, k0 = 64 * kb, n0 = 32 * nb;
#pragma unroll 8
    for (int i = 0; i < 32; ++i) { const int kk = 2 * i + (lane >> 5); float v = W[(size_t)(k0 + kk) * N + n0 + (lane & 31)]; if (gain) v *= gain[k0 + kk]; scr[kk * 33 + (lane & 31)] = v; }
    asm volatile("s_waitcnt lgkmcnt(0)" ::: "memory");
    const int c = lane & 7;
#pragma unroll
    for (int j = 0; j < 4; ++j) { const int n = (lane >> 3) + 8 * j; const float* s = scr + (8 * c) * 33 + n;
        u32x4 o; o.x = pk2(s[0 * 33], s[1 * 33]); o.y = pk2(s[2 * 33], s[3 * 33]); o.z = pk2(s[4 * 33], s[5 * 33]); o.w = pk2(s[6 * 33], s[7 * 33]);
        *(u32x4*)(WT + (size_t)(n0 + n) * K + k0 + 8 * c) = o; }
    asm volatile("s_waitcnt lgkmcnt(0)" ::: "memory");
}
__device__ __forceinline__ void p0_weights(const Args& A, const Frame& F) {
    float* scr = (float*)(F.lds + 32768) + F.wave * (64 * 33);
    const int gw = F.bid * NWAVES + F.wave, NGW = F.nblk * NWAVES;
#define TJOB(IN_, K_, N_, OFF_, GAIN_) do { const float* W = A.in[IN_]; bf16_t* WT = (bf16_t*)(F.ws + (OFF_)); \
        for (int it = gw; it < ((K_) / 64) * ((N_) / 32); it += NGW) transpose_item(W, K_, N_, WT, GAIN_, scr, it, F.lane); } while (0)
    TJOB(I0_WIN, 1024, 704, WS_WIN, nullptr); TJOB(I0_WUQ, 384, 1536, WS_WUQ, A.in[I0_QN]); TJOB(I0_WUKV, 256, 2048, WS_WUKV, A.in[I0_KVN]); TJOB(I0_WO, 1024, 1024, WS_WO0, nullptr);
    TJOB(I1_WQKV, 1024, 1536, WS_WQKV, nullptr); TJOB(I1_WO, 1024, 1024, WS_WO1, nullptr);
#undef TJOB
    { u32x4* z = (u32x4*)(F.ws + WS_WIN + (size_t)704 * 1024 * 2); const int n16 = 64 * 1024 * 2 / 16;
      for (int i = F.bid * NTHREADS + F.tid; i < n16; i += F.nblk * NTHREADS) z[i] = (u32x4){0u, 0u, 0u, 0u}; }
}
__device__ __forceinline__ void p0_weff(const Args& A, const Frame& F) {
    float* kkT = (float*)F.lds; float* wqs = kkT + 128 * 129;
    const int tid = F.tid, lane = F.lane, w = F.wave;
    for (int item = F.bid; item < 512; item += F.nblk) {
        const int layer = item >> 8, z = (item >> 4) & 15, kc = item & 15, h = z >> 1;
        const float* kk = ((z & 1) ? (layer ? A.in[I1_PK2] : A.in[I0_PK2]) : (layer ? A.in[I1_PK1] : A.in[I0_PK1])) + (size_t)h * 16384;
        const float* wq = (layer ? A.in[I1_PWQ] : A.in[I0_PWQ]) + (size_t)(kc * 64) * 2048 + z * 128;
        bf16_t* WT = (bf16_t*)(F.ws + (layer ? WS_WQ1 : WS_WQ0));
        __syncthreads();
        { f32x4 kv[8], wv4[4];
#pragma unroll
          for (int i = 0; i < 8; ++i) kv[i] = *(const f32x4*)(kk + 4 * (tid + i * NTHREADS));
#pragma unroll
          for (int i = 0; i < 4; ++i) { const int e = 4 * (tid + i * NTHREADS); wv4[i] = *(const f32x4*)(wq + (size_t)(e >> 7) * 2048 + (e & 127)); }
#pragma unroll
          for (int i = 0; i < 8; ++i) { const int e = 4 * (tid + i * NTHREADS), key = e >> 7, d = e & 127; kkT[d * 129 + key] = kv[i].x; kkT[(d + 1) * 129 + key] = kv[i].y; kkT[(d + 2) * 129 + key] = kv[i].z; kkT[(d + 3) * 129 + key] = kv[i].w; }
#pragma unroll
          for (int i = 0; i < 4; ++i) *(f32x4*)(wqs + 4 * (tid + i * NTHREADS)) = wv4[i]; }
        __syncthreads();
        float acc[8][2];
#pragma unroll
        for (int j = 0; j < 8; ++j) { acc[j][0] = 0.f; acc[j][1] = 0.f; }
#pragma unroll 2
        for (int d = 0; d < 128; ++d) { const float a0 = kkT[d * 129 + lane], a1 = kkT[d * 129 + lane + 64];
#pragma unroll
            for (int j = 0; j < 8; ++j) { const float wv = wqs[(w * 8 + j) * 128 + d]; acc[j][0] += wv * a0; acc[j][1] += wv * a1; } }
        u32x4 o0, o1;
        o0.x = pk2(acc[0][0], acc[1][0]); o0.y = pk2(acc[2][0], acc[3][0]); o0.z = pk2(acc[4][0], acc[5][0]); o0.w = pk2(acc[6][0], acc[7][0]);
        o1.x = pk2(acc[0][1], acc[1][1]); o1.y = pk2(acc[2][1], acc[3][1]); o1.z = pk2(acc[4][1], acc[5][1]); o1.w = pk2(acc[6][1], acc[7][1]);
        *(u32x4*)(WT + (size_t)(z * 128 + lane) * 1024 + kc * 64 + w * 8) = o0;
        *(u32x4*)(WT + (size_t)(z * 128 + lane + 64) * 1024 + kc * 64 + w * 8) = o1;
    }
    __syncthreads();
}

__device__ __forceinline__ void p0_tables(const Args& A, const Frame& F) {
    const int gw = F.bid * NWAVES + F.wave, NGW = F.nblk * NWAVES, lane = F.lane;
    unsigned char* TAB = F.ws + WS_TAB; float* TSC = (float*)(F.ws + WS_TSC);
    for (int it = gw; it < 4 * 16384 / 4; it += NGW) {
        const int t = it >> 12, row0 = (it & 4095) * 4;
        const float* src = (t == 0 ? A.in[I0_PU] : t == 1 ? A.in[I0_PV] : t == 2 ? A.in[I1_PU] : A.in[I1_PV]) + (size_t)row0 * 1024 + 4 * lane;
        f32x4 v[4][4];
#pragma unroll
        for (int rr = 0; rr < 4; ++rr)
#pragma unroll
            for (int j = 0; j < 4; ++j) v[rr][j] = *(const f32x4*)(src + (size_t)rr * 1024 + 256 * j);
#pragma unroll
        for (int rr = 0; rr < 4; ++rr) {
            float am = 0.f;
#pragma unroll
            for (int j = 0; j < 4; ++j) am = fmaxf(am, fmaxf(fmaxf(fabsf(v[rr][j].x), fabsf(v[rr][j].y)), fmaxf(fabsf(v[rr][j].z), fabsf(v[rr][j].w))));
            am = wave_max(am);
            const int row = row0 + rr;
            float sc;
            if ((t & 1) == 0) {
                float ss = 0.f;
#pragma unroll
                for (int j = 0; j < 4; ++j) ss += (v[rr][j].x * v[rr][j].x + v[rr][j].y * v[rr][j].y) + (v[rr][j].z * v[rr][j].z + v[rr][j].w * v[rr][j].w);
                ss = wave_sum(ss);
                sc = am > 0.f ? fminf(am * (1.f / 7.f), 0.36f * sqrtf(ss * (1.f / 1024.f))) : 1.f;
                const float inv = am > 0.f ? 1.f / sc : 0.f;
#pragma unroll
                for (int j = 0; j < 4; ++j) {
                    const int q0 = (int)fminf(fmaxf(rintf(v[rr][j].x * inv), -7.f), 7.f), q1 = (int)fminf(fmaxf(rintf(v[rr][j].y * inv), -7.f), 7.f), q2 = (int)fminf(fmaxf(rintf(v[rr][j].z * inv), -7.f), 7.f), q3 = (int)fminf(fmaxf(rintf(v[rr][j].w * inv), -7.f), 7.f);
                    *(unsigned short*)(TAB + (((size_t)t * 8 + j) * 16384 + row) * 128 + 2 * lane) = (unsigned short)((q0 & 15) | ((q1 & 15) << 4) | ((q2 & 15) << 8) | ((q3 & 15) << 12)); }
            } else {
            sc = am > 0.f ? am * (1.f / 127.f) : 1.f; const float inv = am > 0.f ? 127.f / am : 0.f;
#pragma unroll
            for (int j = 0; j < 4; ++j) { const unsigned b0 = (unsigned)((int)rintf(v[rr][j].x * inv)) & 0xffu, b1 = (unsigned)((int)rintf(v[rr][j].y * inv)) & 0xffu, b2 = (unsigned)((int)rintf(v[rr][j].z * inv)) & 0xffu, b3 = (unsigned)((int)rintf(v[rr][j].w * inv)) & 0xffu;
                *(unsigned*)(TAB + (((size_t)t * 8 + 2 * j + (lane >> 5)) * 16384 + row) * 128 + 4 * (lane & 31)) = b0 | (b1 << 8) | (b2 << 16) | (b3 << 24); }
            }
            if (lane == 0) TSC[t * 16384 + row] = sc;
        }
    }
}

__device__ __forceinline__ void norm_mod_store(const f32x4 (&v)[4], float rinv, const float* g, const float* sh, const float* sc, bf16_t* orow, int lane) {
#pragma unroll
    for (int j = 0; j < 4; ++j) { const int c = 4 * lane + 256 * j;
        const f32x4 gg = *(const f32x4*)(g + c), s1 = *(const f32x4*)(sc + c), s0 = *(const f32x4*)(sh + c);
        const f32x4 y = (v[j] * rinv * gg) * (s1 + 1.f) + s0;
        u32x2 o; o.x = pk2(y.x, y.y); o.y = pk2(y.z, y.w); *(u32x2*)(orow + c) = o; }
}
__device__ __forceinline__ int tok_row(int layer, int n);
__device__ __forceinline__ void norm_row_out(const Frame& F, const f32x4 (&v)[4], float rinv, const float* g, const float* mm, int r, int which) {
    norm_mod_store(v, rinv, g, mm, mm + 1024, (bf16_t*)(F.ws + WS_H) + (size_t)r * DM, F.lane);
    if (which) {
        f32x4 y[4]; float am = 0.f;
#pragma unroll
        for (int j = 0; j < 4; ++j) { const int c = 4 * F.lane + 256 * j; y[j] = (v[j] * rinv * *(const f32x4*)(g + c)) * (*(const f32x4*)(mm + 1024 + c) + 1.f) + *(const f32x4*)(mm + c);
            am = fmaxf(am, fmaxf(fmaxf(fabsf(y[j].x), fabsf(y[j].y)), fmaxf(fabsf(y[j].z), fabsf(y[j].w)))); }
        am = wave_max(am);
        const float inv = am > 0.f ? 119.f / am : 0.f;
#pragma unroll
        for (int j = 0; j < 4; ++j) { const int h0 = (int)rintf(y[j].x * inv), h1 = (int)rintf(y[j].y * inv), h2 = (int)rintf(y[j].z * inv), h3 = (int)rintf(y[j].w * inv);
            const unsigned hh = (unsigned)(((h0 + 8) >> 4) & 15) | ((unsigned)(((h1 + 8) >> 4) & 15) << 4) | ((unsigned)(((h2 + 8) >> 4) & 15) << 8) | ((unsigned)(((h3 + 8) >> 4) & 15) << 12);
            const unsigned hl = (unsigned)(h0 & 15) | ((unsigned)(h1 & 15) << 4) | ((unsigned)(h2 & 15) << 8) | ((unsigned)(h3 & 15) << 12);
            const bool odd = (F.lane & 1) != 0;
            const unsigned recv = (unsigned)__builtin_amdgcn_update_dpp(0, (int)(odd ? hh : hl), 0xB1, 0xf, 0xf, false);
            *(unsigned*)(F.ws + WS_HQ + (size_t)r * DM + 256 * j + 4 * F.lane) = odd ? (recv | (hl << 16)) : (hh | (recv << 16)); }
        if (F.lane == 0) ((float*)(F.ws + WS_HS))[r] = am > 0.f ? am * (1.f / 119.f) : 1.f;
    }
}
__device__ __forceinline__ void p_norm_rows(const Args& A, const Frame& F, int layer, int which, bool from_input, bool skip_ctx) {
    const int gw = F.bid * NWAVES + F.wave, NGW = F.nblk * NWAVES;
    const float* g = A.in[layer ? (which ? I1_NFFN : I1_NMIX) : (which ? I0_NFFN : I0_NMIX)];
    const float* MOD = (const float*)(F.ws + WS_MOD) + (size_t)layer * 5 * 6144;
    const unsigned short* X = (const unsigned short*)(F.ws + WS_X);
    const int ntok = skip_ctx ? NB * SEQ : R;
    for (int n = gw; n < ntok; n += 2 * NGW) {
        const bool has1 = (n + NGW) < ntok;
        const int r0 = skip_ctx ? tok_row(1, n) : n, r1 = has1 ? (skip_ctx ? tok_row(1, n + NGW) : n + NGW) : r0;
        f32x4 v0[4], v1[4]; float s0 = 0.f, s1 = 0.f;
        if (from_input) { const float* x0 = xin_row(F, r0); const float* x1 = xin_row(F, r1);
#pragma unroll
            for (int j = 0; j < 4; ++j) { v0[j] = *(const f32x4*)(x0 + 4 * F.lane + 256 * j); v1[j] = *(const f32x4*)(x1 + 4 * F.lane + 256 * j); } }
        else {
#pragma unroll
            for (int j = 0; j < 4; ++j) { const u32x2 a = *(const u32x2*)(X + (size_t)r0 * DM + 4 * F.lane + 256 * j), b = *(const u32x2*)(X + (size_t)r1 * DM + 4 * F.lane + 256 * j);
                v0[j] = (f32x4){h2f_lo(a.x), h2f_hi(a.x), h2f_lo(a.y), h2f_hi(a.y)}; v1[j] = (f32x4){h2f_lo(b.x), h2f_hi(b.x), h2f_lo(b.y), h2f_hi(b.y)}; } }
#pragma unroll
        for (int j = 0; j < 4; ++j) { s0 += (v0[j].x * v0[j].x + v0[j].y * v0[j].y) + (v0[j].z * v0[j].z + v0[j].w * v0[j].w); s1 += (v1[j].x * v1[j].x + v1[j].y * v1[j].y) + (v1[j].z * v1[j].z + v1[j].w * v1[j].w); }
        const float ri0 = rsqrtf(wave_sum(s0) * (1.f / DM) + EPS), ri1 = rsqrtf(wave_sum(s1) * (1.f / DM) + EPS);
        norm_row_out(F, v0, ri0, g, MOD + (size_t)mod_index(r0) * 6144 + (which ? 3 * 1024 : 0), r0, which);
        if (has1) norm_row_out(F, v1, ri1, g, MOD + (size_t)mod_index(r1) * 6144 + (which ? 3 * 1024 : 0), r1, which);
    }
}

namespace pg8 {
#define PG8_LAS __attribute__((address_space(3)))
typedef unsigned short bf16_t;
typedef short bf16x8 __attribute__((ext_vector_type(8)));
typedef float f32x4 __attribute__((ext_vector_type(4)));
typedef unsigned u32x4 __attribute__((ext_vector_type(4)));
constexpr int BM = 256, BK = 64, HALF = 128, HTB = HALF * BK * 2  , STAGE_BYTES = 8 * HTB, NXCD = 8, WGM = 8;

__host__ __device__ __forceinline__ int lds_byte(int r, int c) { const int st = (r >> 4) * 2 + (c >> 5), rr = r & 15, cc = c & 31, ob = rr * 64 + cc * 2; return st * 1024 + (ob ^ (((ob >> 9) & 1) << 5)); }
__host__ __device__ __forceinline__ void stage_rc(int b, int& R, int& C) { const int st = b / 1024, sb = b % 1024, swz = sb ^ (((sb >> 9) & 1) << 5); R = (st >> 1) * 16 + swz / 64; C = (st & 1) * 32 + (swz % 64) / 2; }
__host__ __device__ __forceinline__ int perm32(int rho) { const int n = rho >> 4, i = rho & 15; return 8 * (i >> 2) + 4 * n + (i & 3); }

struct Unit { int pm, pn; };
struct Gemm { const bf16_t* A; const bf16_t* Bt; int M, N, K; };

struct StaticOrder {
    int nM, nN, nwg, G, c;
    __host__ __device__ void init(int M, int N, int G_, int c_) { nM = M / BM; nN = N / BM; nwg = nM * nN; G = G_; c = c_; }
    __host__ __device__ bool next(int i, Unit& u) const {
        const long L = (long)i * G + c; if (L >= nwg) return false;
        int wgid = (int)L; { const int q = nwg / NXCD, r = nwg % NXCD, xcd = wgid % NXCD, off = wgid / NXCD; wgid = (xcd < r ? xcd * (q + 1) : r * (q + 1) + (xcd - r) * q) + off; }
        const int nig = WGM * nN, gid = wgid / nig, fm = gid * WGM, gsz = (nM - fm) < WGM ? (nM - fm) : WGM;
        u.pm = fm + ((wgid % nig) % gsz); u.pn = (wgid % nig) / gsz; return true;
    }
    __device__ __forceinline__ void a_ready(const Unit&) const {}
    __device__ __forceinline__ void done(const Unit&) const {}
};

template <class Epi, class Sched, bool ALIGN_EPI = false, bool SP2 = false>
__device__ __forceinline__ void gemm_phase(PG8_LAS unsigned char* lds, const Gemm g, const Sched& S, const Epi& E) {
    const int tid = threadIdx.x, wid = __builtin_amdgcn_readfirstlane(tid >> 6), lane = tid & 63, wr = wid >> 2, wc = wid & 3, fr = lane & 15, fq = lane >> 4;
    const int K = g.K, nt = K / BK;
    unsigned voffA[2], voffB[2];
#pragma unroll
    for (int i = 0; i < 2; ++i) { int R, C; stage_rc(tid * 16 + i * 8192, R, C); const int Rb = Epi::PERM ? ((R & ~31) + perm32(R & 31)) : R;
        voffA[i] = (unsigned)(R * K + C) * 2u; voffB[i] = (unsigned)(Rb * K + C) * 2u; }
    const size_t kstep = (size_t)(BK * 2);
    const size_t hstep = (size_t)HALF * K * 2;
    const size_t tstep = 2 * hstep;
    const unsigned ldsw = (unsigned)wid * 1024u;
    const int aoff = lds_byte(wr * 64 + fr, fq * 8), boff = lds_byte(wc * 32 + fr, fq * 8);
#define PG8_SA(b, h) (((b) * 2 + (h)) * HTB)
#define PG8_SB(b, h) ((4 + (b) * 2 + (h)) * HTB)
#define PG8_STAGE(bufoff, gbase, voff) do { _Pragma("unroll") for (int _i = 0; _i < 2; ++_i) \
        __builtin_amdgcn_global_load_lds((const unsigned*)((const char*)(gbase) + (voff)[_i]), (PG8_LAS unsigned*)(lds + (bufoff) + ldsw + _i * 8192), 16, 0, 0); } while (0)
#define PG8_LDA(dst, b, h) do { _Pragma("unroll") for (int m = 0; m < 4; ++m) _Pragma("unroll") for (int k = 0; k < 2; ++k) dst[m][k] = *(const PG8_LAS bf16x8*)(lds + PG8_SA(b, h) + aoff + m * 2048 + k * 1024); } while (0)
#define PG8_LDB(dst, b, h) do { _Pragma("unroll") for (int n = 0; n < 2; ++n) _Pragma("unroll") for (int k = 0; k < 2; ++k) dst[n][k] = *(const PG8_LAS bf16x8*)(lds + PG8_SB(b, h) + boff + n * 2048 + k * 1024); } while (0)
#define PG8_MMA(ai, bj, At, Bt) do { __builtin_amdgcn_s_setprio(1); _Pragma("unroll") for (int m = 0; m < 4; ++m) _Pragma("unroll") for (int n = 0; n < 2; ++n) _Pragma("unroll") for (int k = 0; k < 2; ++k) \
        acc[ai][bj][m][n] = __builtin_amdgcn_mfma_f32_16x16x32_bf16(Bt[n][k], At[m][k], acc[ai][bj][m][n], 0, 0, 0); __builtin_amdgcn_s_setprio(0); } while (0)
#define PG8_WAIT_V(n) asm volatile("s_waitcnt vmcnt(" #n ")" ::: "memory")
#define PG8_WAIT_L(n) asm volatile("s_waitcnt lgkmcnt(" #n ")" ::: "memory")
#define PG8_BAR __builtin_amdgcn_s_barrier()
#define PG8_SCHED __builtin_amdgcn_sched_barrier(0)
    Unit cur, nxt; int ui = 0;
    if (!S.next(0, cur)) return;
    f32x4 acc[2][2][4][2];
#pragma unroll
    for (int a = 0; a < 2; ++a)
#pragma unroll
        for (int b = 0; b < 2; ++b)
#pragma unroll
            for (int m = 0; m < 4; ++m)
#pragma unroll
                for (int n = 0; n < 2; ++n) acc[a][b][m][n] = (f32x4){0.f, 0.f, 0.f, 0.f};
    bf16x8 At[4][2], B0[2][2], B1[2][2];
    const char* cA = (const char*)g.A + (size_t)cur.pm * tstep; const char* cB = (const char*)g.Bt + (size_t)cur.pn * tstep;
    S.a_ready(cur);
    if constexpr (SP2) {
        PG8_STAGE(PG8_SB(0, 0), cB, voffB); PG8_STAGE(PG8_SB(0, 1), cB + hstep, voffB); PG8_STAGE(PG8_SA(0, 0), cA, voffA); PG8_STAGE(PG8_SA(0, 1), cA + hstep, voffA);
        if (wr == 1) PG8_BAR;
        PG8_WAIT_V(2); PG8_BAR;
        PG8_STAGE(PG8_SB(1, 0), cB + kstep, voffB); PG8_STAGE(PG8_SA(1, 0), cA + kstep, voffA); PG8_STAGE(PG8_SB(1, 1), cB + hstep + kstep, voffB);
        PG8_WAIT_V(6); PG8_BAR;
    } else {
        PG8_STAGE(PG8_SB(0, 0), cB, voffB); PG8_STAGE(PG8_SA(0, 0), cA, voffA); PG8_STAGE(PG8_SB(0, 1), cB + hstep, voffB); PG8_STAGE(PG8_SA(0, 1), cA + hstep, voffA);
        if (wr == 1) PG8_BAR;
        PG8_WAIT_V(4); PG8_BAR;
        PG8_STAGE(PG8_SB(1, 0), cB + kstep, voffB); PG8_STAGE(PG8_SA(1, 0), cA + kstep, voffA); PG8_STAGE(PG8_SB(1, 1), cB + hstep + kstep, voffB);
        PG8_WAIT_V(6); PG8_BAR;
    }
    for (;;) {
        const bool has_next = S.next(ui + 1, nxt);
        const char* nA = has_next ? (const char*)g.A + (size_t)nxt.pm * tstep : cA; const char* nB = has_next ? (const char*)g.Bt + (size_t)nxt.pn * tstep : cB;
        for (int t = 0; t < nt; t += 2) {
            const bool last = (t == nt - 2);
            const char* a1 = cA + (size_t)(t + 1) * kstep;
            const char* a2 = last ? nA : cA + (size_t)(t + 2) * kstep; const char* b2 = last ? nB : cB + (size_t)(t + 2) * kstep;
            const char* a3 = a2 + kstep; const char* b3 = b2 + kstep;
            if (last && has_next) S.a_ready(nxt);
            if constexpr (SP2) {
            PG8_LDB(B0, 0, 0); PG8_LDB(B1, 0, 1); PG8_SCHED; PG8_LDA(At, 0, 0); PG8_STAGE(PG8_SA(1, 1), a1 + hstep, voffA);
            PG8_WAIT_V(8); PG8_WAIT_L(0); PG8_BAR; PG8_MMA(0, 0, At, B0); PG8_MMA(0, 1, At, B1); PG8_BAR; PG8_SCHED;
            PG8_LDA(At, 0, 1); PG8_STAGE(PG8_SB(0, 0), b2, voffB); PG8_STAGE(PG8_SB(0, 1), b2 + hstep, voffB); PG8_STAGE(PG8_SA(0, 0), a2, voffA);
            PG8_WAIT_V(8); PG8_WAIT_L(0); PG8_BAR; PG8_MMA(1, 0, At, B0); PG8_MMA(1, 1, At, B1); PG8_BAR; PG8_SCHED;
            PG8_LDB(B0, 1, 0); PG8_LDB(B1, 1, 1); PG8_SCHED; PG8_LDA(At, 1, 0); PG8_STAGE(PG8_SA(0, 1), a2 + hstep, voffA);
            PG8_WAIT_V(8); PG8_WAIT_L(0); PG8_BAR; PG8_MMA(0, 0, At, B0); PG8_MMA(0, 1, At, B1); PG8_BAR; PG8_SCHED;
            PG8_LDA(At, 1, 1); PG8_STAGE(PG8_SB(1, 0), b3, voffB); PG8_STAGE(PG8_SB(1, 1), b3 + hstep, voffB); PG8_STAGE(PG8_SA(1, 0), a3, voffA);
            PG8_WAIT_V(8); PG8_WAIT_L(0); PG8_BAR; PG8_MMA(1, 0, At, B0); PG8_MMA(1, 1, At, B1); PG8_BAR; PG8_SCHED;
            } else {
            PG8_LDB(B0, 0, 0); PG8_SCHED; PG8_LDA(At, 0, 0); PG8_STAGE(PG8_SA(1, 1), a1 + hstep, voffA);
            PG8_WAIT_L(8); PG8_BAR; PG8_WAIT_L(0); PG8_MMA(0, 0, At, B0); PG8_BAR; PG8_SCHED;
            PG8_LDB(B1, 0, 1); PG8_STAGE(PG8_SB(0, 0), b2, voffB);
            PG8_BAR; PG8_WAIT_L(0); PG8_MMA(0, 1, At, B1); PG8_BAR;
            PG8_LDA(At, 0, 1); PG8_STAGE(PG8_SA(0, 0), a2, voffA);
            PG8_BAR; PG8_WAIT_L(0); PG8_MMA(1, 0, At, B0); PG8_BAR; PG8_SCHED;
            PG8_STAGE(PG8_SB(0, 1), b2 + hstep, voffB);
            PG8_WAIT_V(6); PG8_BAR; PG8_MMA(1, 1, At, B1); PG8_BAR;
            PG8_LDB(B0, 1, 0); PG8_SCHED; PG8_LDA(At, 1, 0); PG8_STAGE(PG8_SA(0, 1), a2 + hstep, voffA);
            PG8_WAIT_L(8); PG8_BAR; PG8_WAIT_L(0); PG8_MMA(0, 0, At, B0); PG8_BAR; PG8_SCHED;
            PG8_LDB(B1, 1, 1); PG8_STAGE(PG8_SB(1, 0), b3, voffB);
            PG8_BAR; PG8_WAIT_L(0); PG8_MMA(0, 1, At, B1); PG8_BAR;
            PG8_LDA(At, 1, 1); PG8_STAGE(PG8_SA(1, 0), a3, voffA);
            PG8_BAR; PG8_WAIT_L(0); PG8_MMA(1, 0, At, B0); PG8_BAR; PG8_SCHED;
            PG8_STAGE(PG8_SB(1, 1), b3 + hstep, voffB);
            PG8_WAIT_V(6); PG8_BAR; PG8_MMA(1, 1, At, B1); PG8_BAR;
            }
        }
        if constexpr (ALIGN_EPI) { if (wr == 0) PG8_BAR; }
        if constexpr (!Epi::AFTER_DRAIN) { E(acc, cur, wr, wc, fr, fq); S.done(cur); }
        if (!has_next) break;
#pragma unroll
        for (int a = 0; a < 2; ++a)
#pragma unroll
            for (int b = 0; b < 2; ++b)
#pragma unroll
                for (int m = 0; m < 4; ++m)
#pragma unroll
                    for (int n = 0; n < 2; ++n) acc[a][b][m][n] = (f32x4){0.f, 0.f, 0.f, 0.f};
        cur = nxt; cA = nA; cB = nB; ++ui;
        if constexpr (ALIGN_EPI) { if (wr == 1) PG8_BAR; }
    }
    PG8_WAIT_V(0);
    if constexpr (!ALIGN_EPI) { if (wr == 0) PG8_BAR; }
    PG8_BAR;
    if constexpr (Epi::AFTER_DRAIN) { E.fused(acc, cur, wr, wc, fr, fq, lds, wid, lane); S.done(cur); }
#undef PG8_SA
#undef PG8_SB
#undef PG8_STAGE
#undef PG8_LDA
#undef PG8_LDB
#undef PG8_MMA
#undef PG8_WAIT_V
#undef PG8_WAIT_L
#undef PG8_BAR
#undef PG8_SCHED
}
}

template <class Inner> struct EpiTile { static constexpr bool PERM = true, AFTER_DRAIN = false; Inner in;
    __device__ __forceinline__ void operator()(const pg8::f32x4 (&acc)[2][2][4][2], const pg8::Unit& u, int wr, int wc, int fr, int fq) const {
#pragma unroll
        for (int ai = 0; ai < 2; ++ai)
#pragma unroll
            for (int m = 0; m < 4; ++m) { const int row = u.pm * 256 + ai * 128 + wr * 64 + m * 16 + fr;
#pragma unroll
                for (int bj = 0; bj < 2; ++bj) in(row, u.pn * 256 + bj * 128 + wc * 32 + 8 * fq, acc[ai][bj][m][0], acc[ai][bj][m][1]); }
    } };
struct In8Bf16 { bf16_t* C; int ldc;
    __device__ __forceinline__ void operator()(int row, int col, f32x4 a, f32x4 b) const { u32x4 o; o.x = cvtpk(a.x, a.y); o.y = cvtpk(a.z, a.w); o.z = cvtpk(b.x, b.y); o.w = cvtpk(b.z, b.w); *(u32x4*)(C + (size_t)row * ldc + col) = o; } };
struct In8KV { bf16_t* Kb; bf16_t* Vb;
    __device__ __forceinline__ void operator()(int row, int col, f32x4 a, f32x4 b) const { const int h = col >> 8, c = col & 255; u32x4 o; o.x = cvtpk(a.x, a.y); o.y = cvtpk(a.z, a.w); o.z = cvtpk(b.x, b.y); o.w = cvtpk(b.z, b.w);
        bf16_t* p = (c < 128) ? Kb + (size_t)row * 1536 + h * 192 + c : Vb + (size_t)row * 1024 + h * 128 + (c - 128);
        *(u32x4*)p = o; } };
struct In8F16 { unsigned short* C; int ldc;
    __device__ __forceinline__ void operator()(int row, int col, f32x4 a, f32x4 b) const { u32x4 o; o.x = pkh2(a.x, a.y); o.y = pkh2(a.z, a.w); o.z = pkh2(b.x, b.y); o.w = pkh2(b.z, b.w); *(u32x4*)(C + (size_t)row * ldc + col) = o; } };
struct In8F32 { float* C; int ldc;
    __device__ __forceinline__ void operator()(int row, int col, f32x4 a, f32x4 b) const { float* p = C + (size_t)row * ldc + col; *(f32x4*)p = a; *(f32x4*)(p + 4) = b; } };
struct In8Resid { const float* x; const float* ctx; unsigned short* X; const float* gate; bool from_input;
    __device__ __forceinline__ void operator()(int row, int col, f32x4 a, f32x4 b) const {
        const int bb = row / RPB, j = row - bb * RPB; unsigned short* xo = X + (size_t)row * DM + col;
        f32x4 x0, x1;
        if (from_input) { const float* xi = ((j < CTXL) ? ctx + ((size_t)bb * CTXL + j) * DM : x + ((size_t)bb * SEQ + (j - CTXL)) * DM) + col; x0 = *(const f32x4*)xi; x1 = *(const f32x4*)(xi + 4); }
        else { const u32x4 w = *(const u32x4*)xo; x0 = (f32x4){h2f_lo(w.x), h2f_hi(w.x), h2f_lo(w.y), h2f_hi(w.y)}; x1 = (f32x4){h2f_lo(w.z), h2f_hi(w.z), h2f_lo(w.w), h2f_hi(w.w)}; }
        const float* g = gate + (size_t)((j < CTXL) ? 4 : bb) * 6144 + col;
        x0 += *(const f32x4*)g * a; x1 += *(const f32x4*)(g + 4) * b;
        u32x4 o; o.x = pkh2(x0.x, x0.y); o.y = pkh2(x0.z, x0.w); o.z = pkh2(x1.x, x1.y); o.w = pkh2(x1.z, x1.w); *(u32x4*)xo = o; } };
struct EpiMlaDown { static constexpr bool PERM = true, AFTER_DRAIN = false; bf16_t* CQ; bf16_t* CKV; bf16_t* KR; float* SSP;
    __device__ __forceinline__ void operator()(const pg8::f32x4 (&acc)[2][2][4][2], const pg8::Unit& u, int wr, int wc, int fr, int fq) const {
#pragma unroll
        for (int ai = 0; ai < 2; ++ai)
#pragma unroll
            for (int m = 0; m < 4; ++m) { const int row = u.pm * 256 + ai * 128 + wr * 64 + m * 16 + fr;
#pragma unroll
                for (int bj = 0; bj < 2; ++bj) { const int col = u.pn * 256 + bj * 128 + wc * 32 + 8 * fq; const f32x4 a = acc[ai][bj][m][0], b = acc[ai][bj][m][1];
                    u32x4 o; o.x = cvtpk(a.x, a.y); o.y = cvtpk(a.z, a.w); o.z = cvtpk(b.x, b.y); o.w = cvtpk(b.z, b.w);
                    const int cls = (u.pn * 2 + bj);
                    if (cls < 5) { float sq = (a.x * a.x + a.y * a.y) + (a.z * a.z + a.w * a.w) + (b.x * b.x + b.y * b.y) + (b.z * b.z + b.w * b.w);
                        sq += __shfl_xor(sq, 16); sq += __shfl_xor(sq, 32);
                        if (cls < 3) *(u32x4*)(CQ + (size_t)row * 384 + col) = o; else *(u32x4*)(CKV + (size_t)row * 256 + (col - 384)) = o;
                        if (fq == 0) SSP[(size_t)row * 24 + cls * 4 + wc] = sq; }
                    else if (col < 704) *(u32x4*)(KR + (size_t)row * 64 + (col - 640)) = o; } }
    } };
struct In8Bf16Rs { bf16_t* C; int ldc; const float* ssp;
    __device__ __forceinline__ void operator()(int row, int col, f32x4 a, f32x4 b) const { const f32x4 s0 = *(const f32x4*)(ssp + (size_t)row * 24), s1 = *(const f32x4*)(ssp + (size_t)row * 24 + 4), s2 = *(const f32x4*)(ssp + (size_t)row * 24 + 8);
        const float ssum = (((s0.x + s0.y) + (s0.z + s0.w)) + ((s1.x + s1.y) + (s1.z + s1.w))) + ((s2.x + s2.y) + (s2.z + s2.w));
        const float rs = rsqrtf(ssum * (1.f / 384.f) + EPS); a *= rs; b *= rs;
        u32x4 o; o.x = cvtpk(a.x, a.y); o.y = cvtpk(a.z, a.w); o.z = cvtpk(b.x, b.y); o.w = cvtpk(b.z, b.w); *(u32x4*)(C + (size_t)row * ldc + col) = o; } };
struct In8KVRs { bf16_t* Kb; bf16_t* Vb; const float* ssp;
    __device__ __forceinline__ void operator()(int row, int col, f32x4 a, f32x4 b) const { const f32x4 s0 = *(const f32x4*)(ssp + (size_t)row * 24 + 12), s1 = *(const f32x4*)(ssp + (size_t)row * 24 + 16);
        const float ssum = ((s0.x + s0.y) + (s0.z + s0.w)) + ((s1.x + s1.y) + (s1.z + s1.w));
        const float rs = rsqrtf(ssum * (1.f / 256.f) + EPS); a *= rs; b *= rs;
        const int h = col >> 8, c = col & 255; u32x4 o; o.x = cvtpk(a.x, a.y); o.y = cvtpk(a.z, a.w); o.z = cvtpk(b.x, b.y); o.w = cvtpk(b.z, b.w);
        bf16_t* p = (c < 128) ? Kb + (size_t)row * 1536 + h * 192 + c : Vb + (size_t)row * 1024 + h * 128 + (c - 128);
        *(u32x4*)p = o; } };
struct RowSched { pg8::StaticOrder so; bool latent_only;
    __device__ __forceinline__ void init(int N, int G, int c, bool lat) { latent_only = lat; so.init(lat ? NB * SEQ : R, N, G, c); }
    __device__ __forceinline__ bool next(int i, pg8::Unit& u) const { if (!so.next(i, u)) return false; if (latent_only) u.pm = (u.pm >> 4) * 17 + 1 + (u.pm & 15); return true; }
    __device__ __forceinline__ void a_ready(const pg8::Unit&) const {}
    __device__ __forceinline__ void done(const pg8::Unit&) const {} };
template <class Inner> __device__ __forceinline__ void gemm8(const Frame& F, const bf16_t* Ap, const bf16_t* Bt, int N, int K, bool latent_only, const Inner& in, bool reverse = false) {
    asm volatile("" : "+s"(K));
    pg8::Gemm g{Ap, Bt, R, N, K}; RowSched S; S.init(N, F.nblk, reverse ? F.nblk - 1 - F.bid : F.bid, latent_only);
    EpiTile<Inner> E{in};
    pg8::gemm_phase<EpiTile<Inner>, RowSched, true, true>((PG8_LAS unsigned char*)F.lds, g, S, E);
}

template <class Epi> __device__ __forceinline__ void gemm8e(const Frame& F, const bf16_t* Ap, const bf16_t* Bt, int N, int K, bool latent_only, const Epi& E) {
    asm volatile("" : "+s"(K));
    pg8::Gemm g{Ap, Bt, R, N, K}; RowSched S; S.init(N, F.nblk, F.bid, latent_only);
    pg8::gemm_phase<Epi, RowSched, true, true>((PG8_LAS unsigned char*)F.lds, g, S, E);
}

struct GemmDesc { const bf16_t* A; int lda; long sA; const bf16_t* Bt; int ldb; long sB; int M, N, K, nz; };
template <class Epi>
__device__ __forceinline__ void gemm_simple(const Frame& F, const GemmDesc& g, const Epi& epi, bool skip_ctx) {
    const int wm = F.wave >> 1, wn = F.wave & 1, fr = F.lane & 15, fq = F.lane >> 4;
    const int tM = g.M / 128, tN = g.N / 128, per = tM * tN, total = per * g.nz;
    for (int u = F.bid; u < total; u += F.nblk) {
        const int z = u / per, uu = u - z * per, tm = uu / tN, tn = uu - tm * tN;
        if (skip_ctx && ((tm * 128) % RPB) < CTXL) continue;
        const int row0 = tm * 128 + wm * 32, col0 = tn * 128 + wn * 64;
        const bf16_t* ap = g.A + z * g.sA + (size_t)(row0 + fr) * g.lda + fq * 8;
        const bf16_t* bp = g.Bt + z * g.sB + (size_t)(col0 + fr) * g.ldb + fq * 8;
        f32x4 acc[2][4];
#pragma unroll
        for (int mi = 0; mi < 2; ++mi)
#pragma unroll
            for (int ni = 0; ni < 4; ++ni) acc[mi][ni] = (f32x4){0.f, 0.f, 0.f, 0.f};
        for (int k0 = 0; k0 < g.K; k0 += 32) {
            bf16x8 a[2], b[4];
#pragma unroll
            for (int mi = 0; mi < 2; ++mi) a[mi] = *(const bf16x8*)(ap + (size_t)mi * 16 * g.lda + k0);
#pragma unroll
            for (int ni = 0; ni < 4; ++ni) b[ni] = *(const bf16x8*)(bp + (size_t)ni * 16 * g.ldb + k0);
#pragma unroll
            for (int mi = 0; mi < 2; ++mi)
#pragma unroll
                for (int ni = 0; ni < 4; ++ni) acc[mi][ni] = __builtin_amdgcn_mfma_f32_16x16x32_bf16(b[ni], a[mi], acc[mi][ni], 0, 0, 0);
        }
#pragma unroll
        for (int mi = 0; mi < 2; ++mi)
#pragma unroll
            for (int ni = 0; ni < 4; ++ni) epi(z, row0 + mi * 16 + fr, col0 + ni * 16 + fq * 4, acc[mi][ni]);
    }
}
struct EpiBf16 { bf16_t* C; int ldc;
    __device__ __forceinline__ void operator()(int, int row, int col, f32x4 v) const { u32x2 o; o.x = pk2(v.x, v.y); o.y = pk2(v.z, v.w); *(u32x2*)(C + (size_t)row * ldc + col) = o; } };
struct EpiKV { bf16_t* Kb; bf16_t* Vb;
    __device__ __forceinline__ void operator()(int, int row, int col, f32x4 v) const { const int h = col >> 8, c = col & 255; u32x2 o; o.x = pk2(v.x, v.y); o.y = pk2(v.z, v.w);
        if (c < 128) *(u32x2*)(Kb + (size_t)row * 1536 + h * 192 + c) = o; else *(u32x2*)(Vb + (size_t)row * 1024 + h * 128 + (c - 128)) = o; } };
struct EpiF32Z { float* C; int ldc;
    __device__ __forceinline__ void operator()(int z, int row, int col, f32x4 v) const { *(f32x4*)(C + (size_t)row * ldc + z * 128 + col) = v; } };
struct EpiResid { const Frame* F; const float* gate; bool from_input;
    __device__ __forceinline__ void operator()(int, int row, int col, f32x4 v) const {
        float* X = (float*)(F->ws + WS_X) + (size_t)row * DM + col;
        const float* xi = from_input ? xin_row(*F, row) + col : X;
        const f32x4 g = *(const f32x4*)(gate + (size_t)mod_index(row) * 6144 + col);
        *(f32x4*)X = *(const f32x4*)xi + g * v; } };

__device__ __forceinline__ void rope_angles(int r, int& prow, int& pcol) { const int t = (r % RPB) - CTXL; prow = t >> 6; pcol = t & 63; }
__device__ __forceinline__ void p_mla_krope(const Args& A, const Frame& F) {
    const int gw = F.bid * NWAVES + F.wave, NGW = F.nblk * NWAVES, lane = F.lane;
    const bf16_t* KR = (const bf16_t*)(F.ws + WS_KR); bf16_t* Kb = (bf16_t*)(F.ws + WS_K);
    const float invf = __powf(10000.f, -(float)(lane & 15) * (1.f / 16.f));
    for (int r = gw; r < R; r += NGW) {
        float kr = bf2f(KR[(size_t)r * 64 + lane]);
        if (!is_ctx_row(r)) {
            int prow, pcol; rope_angles(r, prow, pcol);
            const float ang = (float)((lane & 32) ? pcol : prow) * invf;
            const float cs = cosf(ang), sn = sinf(ang);
            const float partner = __shfl_xor(kr, 16);
            kr = kr * cs + ((lane & 16) ? partner : -partner) * sn;
        }
        const bf16_t kb = (bf16_t)f2bf(kr);
#pragma unroll
        for (int h = 0; h < 8; ++h) Kb[(size_t)r * 1536 + h * 192 + 128 + lane] = kb;
    }
}
__device__ __forceinline__ float row16_sum(float v) { v += WDPP(v, 0xB1); v += WDPP(v, 0x4E); v += WDPP(v, 0x141); v += WDPP(v, 0x140); return v; }
__device__ __forceinline__ void p_gqa_rows(const Args& A, const Frame& F) {
    const int gw = F.bid * NWAVES + F.wave, NGW = F.nblk * NWAVES, lane = F.lane, c16 = lane & 15, hrow = lane >> 4;
    const bf16_t* RAW = (const bf16_t*)(F.ws + WS_RAW1); bf16_t* Q1 = (bf16_t*)(F.ws + WS_Q1); bf16_t* K1 = (bf16_t*)(F.ws + WS_K1); bf16_t* V1 = (bf16_t*)(F.ws + WS_V1);
    float qg[8], kg[8], invf[8];
#pragma unroll
    for (int e = 0; e < 8; ++e) { qg[e] = A.in[I1_QN][8 * c16 + e]; kg[e] = A.in[I1_KN][8 * c16 + e]; invf[e] = __powf(10000.f, -(float)(8 * (c16 & 3) + e) * (1.f / 32.f)); }
    const bool colaxis = (c16 & 8) != 0, hi32 = (c16 & 4) != 0;
    for (int r = gw; r < R; r += NGW) {
        const bool ctx = is_ctx_row(r);
        const bf16_t* a = RAW + (size_t)r * 1536 + 8 * lane;
        u32x4 ch[3];
#pragma unroll
        for (int j = 0; j < 3; ++j) ch[j] = (ctx && j < 2) ? (u32x4){0u, 0u, 0u, 0u} : *(const u32x4*)(a + 512 * j);
        float cs[8], sn[8];
        { int prow = 0, pcol = 0; if (!ctx) rope_angles(r, prow, pcol); const float pos = (float)(colaxis ? pcol : prow);
#pragma unroll
          for (int e = 0; e < 8; ++e) { const float ang = pos * invf[e]; cs[e] = ctx ? 1.f : __cosf(ang); sn[e] = ctx ? 0.f : __sinf(ang); } }
#pragma unroll
        for (int j = 0; j < 3; ++j) {
            if (ctx && j < 2) continue;
            const bool isv = (j == 2) && (hrow >= 2);
            float x[8];
#pragma unroll
            for (int d = 0; d < 4; ++d) { x[2 * d] = bflo(ch[j][d]); x[2 * d + 1] = bfhi(ch[j][d]); }
            float sq = 0.f;
#pragma unroll
            for (int e = 0; e < 8; ++e) sq += x[e] * x[e];
            const float rinv = rsqrtf(row16_sum(sq) * (1.f / 128.f) + EPS);
            u32x4 o;
            float y[8];
#pragma unroll
            for (int e = 0; e < 8; ++e) y[e] = x[e] * rinv * (j < 2 ? qg[e] : kg[e]);
            u32x4 yp; yp.x = pk2(y[0], y[1]); yp.y = pk2(y[2], y[3]); yp.z = pk2(y[4], y[5]); yp.w = pk2(y[6], y[7]);
            float pr[8];
#pragma unroll
            for (int d = 0; d < 4; ++d) { const float lo = __shfl_xor(y[2 * d], 4), hi2 = __shfl_xor(y[2 * d + 1], 4); pr[2 * d] = lo; pr[2 * d + 1] = hi2; }
            float z[8];
#pragma unroll
            for (int e = 0; e < 8; ++e) z[e] = y[e] * cs[e] + (hi32 ? pr[e] : -pr[e]) * sn[e];
            o.x = pk2(z[0], z[1]); o.y = pk2(z[2], z[3]); o.z = pk2(z[4], z[5]); o.w = pk2(z[6], z[7]);
            (void)yp;
            if (isv) o = ch[j];
            if (j < 2) *(u32x4*)(Q1 + (size_t)r * 1024 + 512 * j + 8 * lane) = o;
            else { bf16_t* dst = (hrow < 2) ? K1 + (size_t)r * 256 + 8 * lane : V1 + (size_t)r * 256 + 8 * (lane - 32); *(u32x4*)dst = o; }
        }
    }
}

__device__ __forceinline__ int crow(int r, int hi) { return (r & 3) + 8 * (r >> 2) + 4 * hi; }
__device__ __forceinline__ int v_st(int k, int c) { const int kk = (k & ~0xC) | ((k & 4) << 1) | ((k & 8) >> 1); return ((kk >> 3) * 4 + (c >> 5)) * 512 + ((kk & 7) * 32 + (c & 31)) * 2; }
__device__ __forceinline__ int v_rd_base(int lane) { return ((lane & 3) << 3) | (((lane >> 2) & 3) << 6) | (((lane >> 4) & 1) << 5) | (((lane >> 5) & 1) << 8); }
constexpr int v_rd_off(int d0, int ks, int half) { return d0 * 512 + ks * 4096 + half * 2048; }
template <int OFF> __device__ __forceinline__ s16x4 tr_read(int vb) { s16x4 r; asm volatile("ds_read_b64_tr_b16 %0, %1 offset:%2" : "=&v"(r) : "v"(vb), "i"(OFF) : "memory"); return r; }
template <int D0> __device__ __forceinline__ void pv_one(f32x16& od, int vb, bf16x8 pa0, bf16x8 pa1, bf16x8 pa2, bf16x8 pa3) {
    const s16x4 l0 = tr_read<v_rd_off(D0, 0, 0)>(vb), h0 = tr_read<v_rd_off(D0, 0, 1)>(vb), l1 = tr_read<v_rd_off(D0, 1, 0)>(vb), h1 = tr_read<v_rd_off(D0, 1, 1)>(vb);
    const s16x4 l2 = tr_read<v_rd_off(D0, 2, 0)>(vb), h2 = tr_read<v_rd_off(D0, 2, 1)>(vb), l3 = tr_read<v_rd_off(D0, 3, 0)>(vb), h3 = tr_read<v_rd_off(D0, 3, 1)>(vb);
    asm volatile("s_waitcnt lgkmcnt(0)" ::: "memory"); SBAR();
#define PK(L, H) (bf16x8){L[0], L[1], L[2], L[3], H[0], H[1], H[2], H[3]}
    od = __builtin_amdgcn_mfma_f32_32x32x16_bf16(pa0, PK(l0, h0), od, 0, 0, 0);
    od = __builtin_amdgcn_mfma_f32_32x32x16_bf16(pa1, PK(l1, h1), od, 0, 0, 0);
    od = __builtin_amdgcn_mfma_f32_32x32x16_bf16(pa2, PK(l2, h2), od, 0, 0, 0);
    od = __builtin_amdgcn_mfma_f32_32x32x16_bf16(pa3, PK(l3, h3), od, 0, 0, 0);
#undef PK
}
__device__ __forceinline__ void pv_d0(f32x16* o, int vb, bf16x8 pa0, bf16x8 pa1, bf16x8 pa2, bf16x8 pa3) {
    pv_one<0>(o[0], vb, pa0, pa1, pa2, pa3); pv_one<1>(o[1], vb, pa0, pa1, pa2, pa3); pv_one<2>(o[2], vb, pa0, pa1, pa2, pa3); pv_one<3>(o[3], vb, pa0, pa1, pa2, pa3);
}
constexpr float ATT_THR = 8.f;
__device__ __forceinline__ void partialSM(f32x16& p0, f32x16& p1, float& m_reg, float& mn, float& alpha, float C, float thr_raw) {
    float pmax = p0[0];
#pragma unroll
    for (int r = 1; r < 16; ++r) pmax = fmaxf(pmax, p0[r]);
#pragma unroll
    for (int r = 0; r < 16; ++r) pmax = fmaxf(pmax, p1[r]);
    { auto rr = __builtin_amdgcn_permlane32_swap(__float_as_uint(pmax), __float_as_uint(pmax), false, false);
      pmax = fmaxf(__uint_as_float(rr[0]), __uint_as_float(rr[1])); }
    if (__builtin_expect(__all(pmax - m_reg <= thr_raw), 1)) { mn = m_reg; alpha = 1.f; }
    else { mn = fmaxf(m_reg, pmax); alpha = __builtin_amdgcn_exp2f((m_reg - mn) * C); m_reg = mn; }
    const float mnC = -mn * C;
#pragma unroll
    for (int r = 0; r < 16; ++r) p0[r] = fmaf(p0[r], C, mnC);
#pragma unroll
    for (int r = 0; r < 16; ++r) p1[r] = fmaf(p1[r], C, mnC);
#pragma unroll
    for (int r = 0; r < 16; ++r) p0[r] = __builtin_amdgcn_exp2f(p0[r]);
}
__device__ __forceinline__ void finishSM(f32x16& p0, f32x16& p1, float alpha, float& l_reg, bf16x8& pa0, bf16x8& pa1, bf16x8& pa2, bf16x8& pa3) {
#pragma unroll
    for (int r = 0; r < 16; ++r) p1[r] = __builtin_amdgcn_exp2f(p1[r]);
    float ps = 0;
#pragma unroll
    for (int r = 0; r < 16; ++r) ps += p0[r];
#pragma unroll
    for (int r = 0; r < 16; ++r) ps += p1[r];
    { auto rr = __builtin_amdgcn_permlane32_swap(__float_as_uint(ps), __float_as_uint(ps), false, false);
      ps = __uint_as_float(rr[0]) + __uint_as_float(rr[1]); }
    l_reg = l_reg * alpha + ps;
#define PK4(P, BASE, OUT) do { unsigned a0 = cvtpk(P[BASE + 0], P[BASE + 1]), a1 = cvtpk(P[BASE + 2], P[BASE + 3]);   \
    unsigned b0 = cvtpk(P[BASE + 4], P[BASE + 5]), b1 = cvtpk(P[BASE + 6], P[BASE + 7]);                              \
    auto r0 = __builtin_amdgcn_permlane32_swap(a0, b0, false, false); auto r1 = __builtin_amdgcn_permlane32_swap(a1, b1, false, false); \
    u32x4 w = {r0[0], r1[0], r0[1], r1[1]}; OUT = *reinterpret_cast<bf16x8*>(&w); } while (0)
    PK4(p0, 0, pa0); PK4(p0, 8, pa1); PK4(p1, 0, pa2); PK4(p1, 8, pa3);
#undef PK4
}
template <int DQK> __device__ __forceinline__ void qkt(f32x16& p0, f32x16& p1, const char* Ks, const bf16x8* qr, int r32, int hi) {
    constexpr int KP = DQK * 2 + 16;
    p0 = f32x16{}; p1 = f32x16{};
#pragma unroll
    for (int d0 = 0; d0 < DQK / 16; ++d0) { const int cb = (d0 * 16 + hi * 8) * 2;
        const bf16x8 b0 = *reinterpret_cast<const bf16x8*>(Ks + r32 * KP + cb);
        const bf16x8 b1 = *reinterpret_cast<const bf16x8*>(Ks + (32 + r32) * KP + cb);
        p0 = __builtin_amdgcn_mfma_f32_32x32x16_bf16(b0, qr[d0], p0, 0, 0, 0);
        p1 = __builtin_amdgcn_mfma_f32_32x32x16_bf16(b1, qr[d0], p1, 0, 0, 0); }
}
template <int DQK> constexpr int att_lds_bytes() { return 2 * 64 * 128 * 2 + 2 * 64 * (DQK * 2 + 16) + NWAVES * 64 * 4; }
template <int DQK, int LDQ, int LDK, int LDV, int LDO>
__device__ __forceinline__ void attn_body(const bf16_t* __restrict__ Qb, const bf16_t* __restrict__ Kh, const bf16_t* __restrict__ Vh, bf16_t* __restrict__ Ob, int seq, float scale, char* lds) {
    constexpr int KP = DQK * 2 + 16, SHM_V = 64 * 128 * 2, SHM_K = 64 * KP, ND = DQK / 16, CH = DQK / 8, NKL = CH * 64 / NTHREADS;
    const float C = scale * 1.4426950408889634f, thr_raw = ATT_THR / scale;
    const int tid = threadIdx.x, wid = tid >> 6, lane = tid & 63, r32 = lane & 31, hi = lane >> 5;
    char* V_lds = lds; char* K_lds = lds + 2 * SHM_V;
    float* wsf = (float*)(lds + 2 * SHM_V + 2 * SHM_K) + wid * 64; float* li_l = wsf; float* al_l = wsf + 32;
    float m_reg = -1e30f, l_reg = 0; f32x16 o[4] = {}; bf16x8 qr[ND];
    const bf16_t* Qw = Qb + (long)(wid * 32 + r32) * LDQ + hi * 8;
#pragma unroll
    for (int d0 = 0; d0 < ND; ++d0) qr[d0] = *reinterpret_cast<const bf16x8*>(Qw + d0 * 16);
    const int sr = tid >> 4, sc = (tid & 15) * 8, vst0 = v_st(sr, sc), vst1 = v_st(32 + sr, sc);
    static_assert(DQK == 128, "double-pipelined body: 128-wide q.k only");
    const int vb0 = (int)(uintptr_t)V_lds + v_rd_base(lane);
    bf16x8 vs0, vs1, ks[NKL];
#define SLOAD(k0) do { vs0 = *reinterpret_cast<const bf16x8*>(&Vh[(long)((k0) + sr) * LDV + sc]); vs1 = *reinterpret_cast<const bf16x8*>(&Vh[(long)((k0) + 32 + sr) * LDV + sc]); \
    _Pragma("unroll") for (int i_ = 0; i_ < NKL; ++i_) ks[i_] = *reinterpret_cast<const bf16x8*>(&Kh[(long)((k0) + sr + 32 * i_) * LDK + sc]); } while (0)
#define SWRITE(b) do { *(bf16x8*)(V_lds + (b) * SHM_V + vst0) = vs0; *(bf16x8*)(V_lds + (b) * SHM_V + vst1) = vs1; \
    _Pragma("unroll") for (int i_ = 0; i_ < NKL; ++i_) *(bf16x8*)(K_lds + (b) * SHM_K + (sr + 32 * i_) * KP + sc * 2) = ks[i_]; } while (0)
#define RESC(a) do { if (__any((a) < 1.f)) { if (hi == 0) al_l[r32] = (a); asm volatile("s_waitcnt lgkmcnt(0)" ::: "memory"); \
    _Pragma("unroll") for (int d = 0; d < 4; ++d) _Pragma("unroll") for (int r = 0; r < 16; ++r) o[d][r] *= al_l[crow(r, hi)]; } } while (0)
    f32x16 pA0, pA1, pB0, pB1; float mnA, mnB, alA, alB; bf16x8 pa0, pa1, pa2, pa3; const int NT = seq / 64;
    SLOAD(0); asm volatile("s_waitcnt vmcnt(0)" ::: "memory"); SWRITE(0); __syncthreads();
    qkt<DQK>(pA0, pA1, K_lds, qr, r32, hi); partialSM(pA0, pA1, m_reg, mnA, alA, C, thr_raw);
    SLOAD(64);
    asm volatile("s_waitcnt vmcnt(0)" ::: "memory"); SWRITE(1); __syncthreads();
    for (int j = 1; j + 1 < NT; j += 2) {
        SBAR(); qkt<DQK>(pB0, pB1, K_lds + SHM_K, qr, r32, hi);
        finishSM(pA0, pA1, alA, l_reg, pa0, pa1, pa2, pa3); SBAR();
        SLOAD((j + 1) * 64); SBAR();
        pv_d0(o, vb0, pa0, pa1, pa2, pa3); partialSM(pB0, pB1, m_reg, mnB, alB, C, thr_raw);
        __syncthreads(); asm volatile("s_waitcnt vmcnt(0)" ::: "memory"); SWRITE(0);
        RESC(alB); __syncthreads();
        SBAR(); qkt<DQK>(pA0, pA1, K_lds, qr, r32, hi);
        finishSM(pB0, pB1, alB, l_reg, pa0, pa1, pa2, pa3); SBAR();
        SLOAD((j + 2) * 64); SBAR();
        pv_d0(o, vb0 + SHM_V, pa0, pa1, pa2, pa3); partialSM(pA0, pA1, m_reg, mnA, alA, C, thr_raw);
        __syncthreads(); asm volatile("s_waitcnt vmcnt(0)" ::: "memory"); SWRITE(1);
        RESC(alA); __syncthreads();
    }
    SBAR(); qkt<DQK>(pB0, pB1, K_lds + SHM_K, qr, r32, hi);
    finishSM(pA0, pA1, alA, l_reg, pa0, pa1, pa2, pa3); SBAR();
    pv_d0(o, vb0, pa0, pa1, pa2, pa3); partialSM(pB0, pB1, m_reg, mnB, alB, C, thr_raw);
    __syncthreads(); RESC(alB);
    finishSM(pB0, pB1, alB, l_reg, pa0, pa1, pa2, pa3); SBAR();
    pv_d0(o, vb0 + SHM_V, pa0, pa1, pa2, pa3);
    if (hi == 0) li_l[r32] = l_reg; asm volatile("s_waitcnt lgkmcnt(0)" ::: "memory");
    float rli[16];
#pragma unroll
    for (int r = 0; r < 16; ++r) rli[r] = __builtin_amdgcn_rcpf(li_l[crow(r, hi)]);
    bf16_t* Ow = Ob + (long)(wid * 32) * LDO;
#pragma unroll
    for (int r = 0; r < 16; ++r) { const int orow = crow(r, hi);
#pragma unroll
        for (int d0 = 0; d0 < 4; ++d0) Ow[(long)orow * LDO + d0 * 32 + r32] = (bf16_t)f2bf(o[d0][r] * rli[r]); }
    __syncthreads();
#undef SLOAD
#undef SWRITE
#undef RESC
}
template <int DQK, int LDQ, int LDK, int LDV, int LDO>
__device__ __forceinline__ void attn_body_single(const bf16_t* __restrict__ Qb, const bf16_t* __restrict__ Kh, const bf16_t* __restrict__ Vh, bf16_t* __restrict__ Ob, int seq, float scale, char* lds, int rope_t0) {
    constexpr int KP = DQK * 2 + 16, SHM_V = 64 * 128 * 2, SHM_K = 64 * KP, ND = DQK / 16, CH = DQK / 8, NKL = CH * 64 / NTHREADS;
    const float C = scale * 1.4426950408889634f, thr_raw = ATT_THR / scale;
    const int tid = threadIdx.x, wid = tid >> 6, lane = tid & 63, r32 = lane & 31, hi = lane >> 5;
    char* V_lds = lds; char* K_lds = lds + 2 * SHM_V;
    float* wsf = (float*)(lds + 2 * SHM_V + 2 * SHM_K) + wid * 64; float* li_l = wsf; float* al_l = wsf + 32;
    float m_reg = -1e30f, l_reg = 0; f32x16 o[4] = {}; bf16x8 qr[ND];
    const bf16_t* Qw = Qb + (long)(wid * 32 + r32) * LDQ + hi * 8;
#pragma unroll
    for (int d0 = 8; d0 < ND; ++d0) qr[d0] = *reinterpret_cast<const bf16x8*>(Qw + d0 * 16);
    if constexpr (DQK == 192) {
        if (rope_t0 >= 0) {
            const int tq = rope_t0 + wid * 32 + r32; const float prow = (float)(tq >> 6), pcol = (float)(tq & 63);
            u32x4 fa1 = __builtin_bit_cast(u32x4, qr[8]), fa2 = __builtin_bit_cast(u32x4, qr[9]), fb1 = __builtin_bit_cast(u32x4, qr[10]), fb2 = __builtin_bit_cast(u32x4, qr[11]);
#pragma unroll
            for (int jj = 0; jj < 4; ++jj) {
                float na1[2], na2[2], nb1[2], nb2[2];
#pragma unroll
                for (int e = 0; e < 2; ++e) { const float invf = __powf(10000.f, -(float)(hi * 8 + 2 * jj + e) * (1.f / 16.f));
                    const float ar = prow * invf, ac = pcol * invf, cr = __cosf(ar), sr_ = __sinf(ar), cc = __cosf(ac), sc_ = __sinf(ac);
                    const float a1 = e ? bfhi(fa1[jj]) : bflo(fa1[jj]), a2 = e ? bfhi(fa2[jj]) : bflo(fa2[jj]), b1 = e ? bfhi(fb1[jj]) : bflo(fb1[jj]), b2 = e ? bfhi(fb2[jj]) : bflo(fb2[jj]);
                    na1[e] = a1 * cr - a2 * sr_; na2[e] = a2 * cr + a1 * sr_; nb1[e] = b1 * cc - b2 * sc_; nb2[e] = b2 * cc + b1 * sc_; }
                fa1[jj] = pk2(na1[0], na1[1]); fa2[jj] = pk2(na2[0], na2[1]); fb1[jj] = pk2(nb1[0], nb1[1]); fb2[jj] = pk2(nb2[0], nb2[1]);
            }
            qr[8] = __builtin_bit_cast(bf16x8, fa1); qr[9] = __builtin_bit_cast(bf16x8, fa2); qr[10] = __builtin_bit_cast(bf16x8, fb1); qr[11] = __builtin_bit_cast(bf16x8, fb2);
        }
    }
    asm volatile("" ::: "memory");
#pragma unroll
    for (int d0 = 0; d0 < 8; ++d0) qr[d0] = *reinterpret_cast<const bf16x8*>(Qw + d0 * 16);
    const int sr = tid >> 4, sc = (tid & 15) * 8, vst0 = v_st(sr, sc), vst1 = v_st(32 + sr, sc);
    int krow[NKL], kch[NKL];
#pragma unroll
    for (int i = 0; i < NKL; ++i) { const int id = tid + i * NTHREADS; krow[i] = id / CH; kch[i] = id % CH; }
    const int vb0 = (int)(uintptr_t)V_lds + v_rd_base(lane);
    bf16x8 vs0, vs1, ks[NKL];
#define SLOAD(k0) do { vs0 = *reinterpret_cast<const bf16x8*>(&Vh[(long)((k0) + sr) * LDV + sc]); vs1 = *reinterpret_cast<const bf16x8*>(&Vh[(long)((k0) + 32 + sr) * LDV + sc]); \
    _Pragma("unroll") for (int i_ = 0; i_ < NKL; ++i_) ks[i_] = *reinterpret_cast<const bf16x8*>(&Kh[(long)((k0) + krow[i_]) * LDK + kch[i_] * 8]); } while (0)
#define SWRITE(b) do { *(bf16x8*)(V_lds + (b) * SHM_V + vst0) = vs0; *(bf16x8*)(V_lds + (b) * SHM_V + vst1) = vs1; \
    _Pragma("unroll") for (int i_ = 0; i_ < NKL; ++i_) *(bf16x8*)(K_lds + (b) * SHM_K + krow[i_] * KP + kch[i_] * 16) = ks[i_]; } while (0)
#define RESC(a) do { if (__any((a) < 1.f)) { if (hi == 0) al_l[r32] = (a); asm volatile("s_waitcnt lgkmcnt(0)" ::: "memory"); \
    _Pragma("unroll") for (int d = 0; d < 4; ++d) _Pragma("unroll") for (int r = 0; r < 16; ++r) o[d][r] *= al_l[crow(r, hi)]; } } while (0)
    f32x16 p0, p1; float mn, al; bf16x8 pa0, pa1, pa2, pa3; const int NT = seq / 64;
    SLOAD(0); asm volatile("s_waitcnt vmcnt(0)" ::: "memory"); SWRITE(0); __syncthreads();
    SLOAD(64);
    for (int j = 0; j < NT; ++j) {
        const int b = j & 1;
        SBAR(); qkt<DQK>(p0, p1, K_lds + b * SHM_K, qr, r32, hi);
        partialSM(p0, p1, m_reg, mn, al, C, thr_raw);
        RESC(al);
        finishSM(p0, p1, al, l_reg, pa0, pa1, pa2, pa3); SBAR();
        pv_d0(o, vb0 + b * SHM_V, pa0, pa1, pa2, pa3);
        if (j + 1 < NT) { asm volatile("s_waitcnt vmcnt(0)" ::: "memory"); SWRITE(b ^ 1); }
        __syncthreads();
        if (j + 2 < NT) SLOAD((j + 2) * 64);
    }
    if (hi == 0) li_l[r32] = l_reg; asm volatile("s_waitcnt lgkmcnt(0)" ::: "memory");
    float rli[16];
#pragma unroll
    for (int r = 0; r < 16; ++r) rli[r] = __builtin_amdgcn_rcpf(li_l[crow(r, hi)]);
    bf16_t* Ow = Ob + (long)(wid * 32) * LDO;
#pragma unroll
    for (int r = 0; r < 16; ++r) { const int orow = crow(r, hi);
#pragma unroll
        for (int d0 = 0; d0 < 4; ++d0) Ow[(long)orow * LDO + d0 * 32 + r32] = (bf16_t)f2bf(o[d0][r] * rli[r]); }
    __syncthreads();
#undef SLOAD
#undef SWRITE
#undef RESC
}
__device__ __forceinline__ void p_attn_mla(const Args& A, const Frame& F) {
    const bf16_t* Q = (const bf16_t*)(F.ws + WS_Q); const bf16_t* Kb = (const bf16_t*)(F.ws + WS_K); const bf16_t* Vb = (const bf16_t*)(F.ws + WS_V); bf16_t* O = (bf16_t*)(F.ws + WS_O);
    const float scale = 0.07216878364870322f;
    for (int u = F.vcu; u < 544; u += F.nblk) {
        int b, h, q0, seq;
        int rope_t0;
        if (u < 512) { const int qb = u & 15; h = (u >> 4) & 7; b = u >> 7; q0 = CTXL + qb * 256; seq = RPB; rope_t0 = qb * 256; }
        else { const int v = u - 512; h = v & 7; b = v >> 3; q0 = 0; seq = CTXL; rope_t0 = -1; }
        const size_t rb = (size_t)b * RPB;
        attn_body_single<192, 1536, 1536, 1024, 1024>(Q + (rb + q0) * 1536 + h * 192, Kb + rb * 1536 + h * 192, Vb + rb * 1024 + h * 128, O + (rb + q0) * 1024 + h * 128, seq, scale, F.lds, rope_t0);
    }
}
__device__ __forceinline__ void p_attn_gqa(const Args& A, const Frame& F) {
    const bf16_t* Q = (const bf16_t*)(F.ws + WS_Q1); const bf16_t* Kb = (const bf16_t*)(F.ws + WS_K1); const bf16_t* Vb = (const bf16_t*)(F.ws + WS_V1); bf16_t* O = (bf16_t*)(F.ws + WS_O);
    const float scale = 0.08838834764831845f;
    for (int u = F.vcu; u < 512; u += F.nblk) {
        const int qb = u & 15, h = (u >> 4) & 7, b = u >> 7, q0 = CTXL + qb * 256, kvh = h >> 2;
        const size_t rb = (size_t)b * RPB;
        attn_body<128, 1024, 256, 256, 1024>(Q + (rb + q0) * 1024 + h * 128, Kb + rb * 256 + kvh * 128, Vb + rb * 256 + kvh * 128, O + (rb + q0) * 1024 + h * 128, RPB, scale, F.lds);
    }
}

#define DPP_XOR1 0xB1
#define DPP_XOR2 0x4E
#define DPP_HMIRROR 0x141
#define DPP_MIRROR 0x140
__device__ __forceinline__ int row_max_i(int v) {
    v = max(v, __builtin_amdgcn_update_dpp(v, v, DPP_XOR1, 0xf, 0xf, false));
    v = max(v, __builtin_amdgcn_update_dpp(v, v, DPP_XOR2, 0xf, 0xf, false));
    v = max(v, __builtin_amdgcn_update_dpp(v, v, DPP_HMIRROR, 0xf, 0xf, false));
    v = max(v, __builtin_amdgcn_update_dpp(v, v, DPP_MIRROR, 0xf, 0xf, false));
    return v;
}
__device__ __forceinline__ float row_sum_f(float v) {
    v += __builtin_bit_cast(float, __builtin_amdgcn_update_dpp(0, __builtin_bit_cast(int, v), DPP_XOR1, 0xf, 0xf, false));
    v += __builtin_bit_cast(float, __builtin_amdgcn_update_dpp(0, __builtin_bit_cast(int, v), DPP_XOR2, 0xf, 0xf, false));
    v += __builtin_bit_cast(float, __builtin_amdgcn_update_dpp(0, __builtin_bit_cast(int, v), DPP_HMIRROR, 0xf, 0xf, false));
    v += __builtin_bit_cast(float, __builtin_amdgcn_update_dpp(0, __builtin_bit_cast(int, v), DPP_MIRROR, 0xf, 0xf, false));
    return v;
}
__device__ __forceinline__ int fkey(float f) { const int b = __builtin_bit_cast(int, f); return b ^ ((b >> 31) & 0x7fffffff); }
__device__ __forceinline__ float keyf(int k) { return __builtin_bit_cast(float, k ^ ((k >> 31) & 0x7fffffff)); }
__device__ __forceinline__ void cand_ij(int t, int& i, int& j) {
    const int g16 = t >= 16, g24 = t >= 24, g29 = t >= 29, g33 = t >= 33, g36 = t >= 36, g38 = t >= 38, g40 = t >= 40;
    i = g16 + g24 + g29 + g33 + g36 + g38 + g40 + max(t - 41, 0);
    const int base = 16 * g16 + 8 * g24 + 5 * g29 + 4 * g33 + 3 * g36 + 2 * g38 + 2 * g40;
    j = (t >= 42) ? 0 : t - base;
    if (t >= 50) { i = 0; j = 0; }
}
__device__ __forceinline__ void row_max2(int& a, int& b) {
    asm volatile("s_nop 1\n\t"
                 "v_max_i32_dpp %0, %0, %0 quad_perm:[1,0,3,2] row_mask:0xf bank_mask:0xf\n\tv_max_i32_dpp %1, %1, %1 quad_perm:[1,0,3,2] row_mask:0xf bank_mask:0xf\n\ts_nop 0\n\t"
                 "v_max_i32_dpp %0, %0, %0 quad_perm:[2,3,0,1] row_mask:0xf bank_mask:0xf\n\tv_max_i32_dpp %1, %1, %1 quad_perm:[2,3,0,1] row_mask:0xf bank_mask:0xf\n\ts_nop 0\n\t"
                 "v_max_i32_dpp %0, %0, %0 row_half_mirror row_mask:0xf bank_mask:0xf\n\tv_max_i32_dpp %1, %1, %1 row_half_mirror row_mask:0xf bank_mask:0xf\n\ts_nop 0\n\t"
                 "v_max_i32_dpp %0, %0, %0 row_mirror row_mask:0xf bank_mask:0xf\n\tv_max_i32_dpp %1, %1, %1 row_mirror row_mask:0xf bank_mask:0xf\n\ts_nop 1"
                 : "+v"(a), "+v"(b));
}
__device__ __forceinline__ void row_max1(int& a) {
    asm volatile("s_nop 1\n\t"
                 "v_max_i32_dpp %0, %0, %0 quad_perm:[1,0,3,2] row_mask:0xf bank_mask:0xf\n\ts_nop 1\n\t"
                 "v_max_i32_dpp %0, %0, %0 quad_perm:[2,3,0,1] row_mask:0xf bank_mask:0xf\n\ts_nop 1\n\t"
                 "v_max_i32_dpp %0, %0, %0 row_half_mirror row_mask:0xf bank_mask:0xf\n\ts_nop 1\n\t"
                 "v_max_i32_dpp %0, %0, %0 row_mirror row_mask:0xf bank_mask:0xf\n\ts_nop 1"
                 : "+v"(a));
}
__device__ __forceinline__ void row_max4(int& a, int& b, int& c, int& d) {
    asm volatile("s_nop 1\n\t"
                 "v_max_i32_dpp %0, %0, %0 quad_perm:[1,0,3,2] row_mask:0xf bank_mask:0xf\n\tv_max_i32_dpp %1, %1, %1 quad_perm:[1,0,3,2] row_mask:0xf bank_mask:0xf\n\t"
                 "v_max_i32_dpp %2, %2, %2 quad_perm:[1,0,3,2] row_mask:0xf bank_mask:0xf\n\tv_max_i32_dpp %3, %3, %3 quad_perm:[1,0,3,2] row_mask:0xf bank_mask:0xf\n\t"
                 "v_max_i32_dpp %0, %0, %0 quad_perm:[2,3,0,1] row_mask:0xf bank_mask:0xf\n\tv_max_i32_dpp %1, %1, %1 quad_perm:[2,3,0,1] row_mask:0xf bank_mask:0xf\n\t"
                 "v_max_i32_dpp %2, %2, %2 quad_perm:[2,3,0,1] row_mask:0xf bank_mask:0xf\n\tv_max_i32_dpp %3, %3, %3 quad_perm:[2,3,0,1] row_mask:0xf bank_mask:0xf\n\t"
                 "v_max_i32_dpp %0, %0, %0 row_half_mirror row_mask:0xf bank_mask:0xf\n\tv_max_i32_dpp %1, %1, %1 row_half_mirror row_mask:0xf bank_mask:0xf\n\t"
                 "v_max_i32_dpp %2, %2, %2 row_half_mirror row_mask:0xf bank_mask:0xf\n\tv_max_i32_dpp %3, %3, %3 row_half_mirror row_mask:0xf bank_mask:0xf\n\t"
                 "v_max_i32_dpp %0, %0, %0 row_mirror row_mask:0xf bank_mask:0xf\n\tv_max_i32_dpp %1, %1, %1 row_mirror row_mask:0xf bank_mask:0xf\n\t"
                 "v_max_i32_dpp %2, %2, %2 row_mirror row_mask:0xf bank_mask:0xf\n\tv_max_i32_dpp %3, %3, %3 row_mirror row_mask:0xf bank_mask:0xf\n\ts_nop 1"
                 : "+v"(a), "+v"(b), "+v"(c), "+v"(d));
}
#define CE_DESC(x, y) do { const int hi_ = max(x, y), lo_ = min(x, y); x = hi_; y = lo_; } while (0)
#define SORT8_DESC(k) do { CE_DESC(k[0], k[2]); CE_DESC(k[1], k[3]); CE_DESC(k[4], k[6]); CE_DESC(k[5], k[7]); CE_DESC(k[0], k[4]); CE_DESC(k[1], k[5]); CE_DESC(k[2], k[6]); CE_DESC(k[3], k[7]); \
    CE_DESC(k[0], k[1]); CE_DESC(k[2], k[3]); CE_DESC(k[4], k[5]); CE_DESC(k[6], k[7]); CE_DESC(k[2], k[4]); CE_DESC(k[3], k[5]); CE_DESC(k[1], k[4]); CE_DESC(k[3], k[6]); CE_DESC(k[1], k[2]); CE_DESC(k[3], k[4]); CE_DESC(k[5], k[6]); } while (0)
#define SORT16_DESC(K) do { CE_DESC(K[0], K[1]); CE_DESC(K[2], K[3]); CE_DESC(K[0], K[2]); CE_DESC(K[1], K[3]); CE_DESC(K[1], K[2]); CE_DESC(K[4], K[5]); CE_DESC(K[6], K[7]); CE_DESC(K[4], K[6]); CE_DESC(K[5], K[7]); CE_DESC(K[5], K[6]); CE_DESC(K[0], K[4]); CE_DESC(K[2], K[6]); CE_DESC(K[2], K[4]); CE_DESC(K[1], K[5]); CE_DESC(K[3], K[7]); CE_DESC(K[3], K[5]); CE_DESC(K[1], K[2]); CE_DESC(K[3], K[4]); CE_DESC(K[5], K[6]); CE_DESC(K[8], K[9]); CE_DESC(K[10], K[11]); CE_DESC(K[8], K[10]); CE_DESC(K[9], K[11]); CE_DESC(K[9], K[10]); CE_DESC(K[12], K[13]); CE_DESC(K[14], K[15]); CE_DESC(K[12], K[14]); CE_DESC(K[13], K[15]); CE_DESC(K[13], K[14]); CE_DESC(K[8], K[12]); CE_DESC(K[10], K[14]); CE_DESC(K[10], K[12]); CE_DESC(K[9], K[13]); CE_DESC(K[11], K[15]); CE_DESC(K[11], K[13]); CE_DESC(K[9], K[10]); CE_DESC(K[11], K[12]); CE_DESC(K[13], K[14]); CE_DESC(K[0], K[8]); CE_DESC(K[4], K[12]); CE_DESC(K[4], K[8]); CE_DESC(K[2], K[10]); CE_DESC(K[6], K[14]); CE_DESC(K[6], K[10]); CE_DESC(K[2], K[4]); CE_DESC(K[6], K[8]); CE_DESC(K[10], K[12]); CE_DESC(K[1], K[9]); CE_DESC(K[5], K[13]); CE_DESC(K[5], K[9]); CE_DESC(K[3], K[11]); CE_DESC(K[7], K[15]); CE_DESC(K[7], K[11]); CE_DESC(K[3], K[5]); CE_DESC(K[7], K[9]); CE_DESC(K[11], K[13]); CE_DESC(K[1], K[2]); CE_DESC(K[3], K[4]); CE_DESC(K[5], K[6]); CE_DESC(K[7], K[8]); CE_DESC(K[9], K[10]); CE_DESC(K[11], K[12]); CE_DESC(K[13], K[14]); } while (0)
#define MERGE16_DESC(T, K) do { _Pragma("unroll") for (int i_ = 0; i_ < 16; ++i_) T[i_] = max(T[i_], K[15 - i_]); CE_DESC(T[0], T[8]); CE_DESC(T[1], T[9]); CE_DESC(T[2], T[10]); CE_DESC(T[3], T[11]); CE_DESC(T[4], T[12]); CE_DESC(T[5], T[13]); CE_DESC(T[6], T[14]); CE_DESC(T[7], T[15]); CE_DESC(T[0], T[4]); CE_DESC(T[1], T[5]); CE_DESC(T[2], T[6]); CE_DESC(T[3], T[7]); CE_DESC(T[8], T[12]); CE_DESC(T[9], T[13]); CE_DESC(T[10], T[14]); CE_DESC(T[11], T[15]); CE_DESC(T[0], T[2]); CE_DESC(T[1], T[3]); CE_DESC(T[4], T[6]); CE_DESC(T[5], T[7]); CE_DESC(T[8], T[10]); CE_DESC(T[9], T[11]); CE_DESC(T[12], T[14]); CE_DESC(T[13], T[15]); CE_DESC(T[0], T[1]); CE_DESC(T[2], T[3]); CE_DESC(T[4], T[5]); CE_DESC(T[6], T[7]); CE_DESC(T[8], T[9]); CE_DESC(T[10], T[11]); CE_DESC(T[12], T[13]); CE_DESC(T[14], T[15]); } while (0)
__device__ __forceinline__ int hkey_hi(unsigned w) { const int x = (int)(w & 0xffff0000u); return x ^ ((x >> 31) & 0x7fff0000); }
__device__ __forceinline__ float hkey_val(int k) { const int y = k & (int)0xffff0000; const unsigned b = (unsigned)(y ^ ((y >> 31) & 0x7fff0000)); return (float)__builtin_bit_cast(_Float16, (unsigned short)(b >> 16)); }
__device__ __forceinline__ int cnd(int a, int b, unsigned long long m) { int r; asm("v_cndmask_b32_e64 %0, %1, %2, %3" : "=v"(r) : "v"(a), "v"(b), "s"(m)); return r; }
__device__ __forceinline__ unsigned long long bitmask(int v, int bit) { unsigned long long m; asm("v_cmp_ne_u32_e64 %0, 0, %1\n\ts_nop 1" : "=s"(m) : "v"(v & bit)); return m; }
__device__ __forceinline__ int sel16(const int (&a)[16], int i) {
    const unsigned long long m0 = bitmask(i, 1), m1 = bitmask(i, 2), m2 = bitmask(i, 4), m3 = bitmask(i, 8);
    int l1[8], l2[4], l3[2];
#pragma unroll
    for (int m = 0; m < 8; ++m) l1[m] = cnd(a[2 * m], a[2 * m + 1], m0);
#pragma unroll
    for (int m = 0; m < 4; ++m) l2[m] = cnd(l1[2 * m], l1[2 * m + 1], m1);
#pragma unroll
    for (int m = 0; m < 2; ++m) l3[m] = cnd(l2[2 * m], l2[2 * m + 1], m2);
    return cnd(l3[0], l3[1], m3);
}
__device__ __forceinline__ void topk_rows4(const unsigned short* S, unsigned* PK, int r, int hbase, int lane) {
    const int c = lane & 15, rw = lane >> 4, rbase = lane & 48, h = hbase + rw;
    const int KMIN = (int)0x80000000;
    const unsigned short* sp = S + (size_t)r * 2048 + h * 256 + 4 * c;
    int k1[8], k2[8];
#pragma unroll
    for (int jj = 0; jj < 2; ++jj) { const u32x2 a = *(const u32x2*)(sp + 64 * jj), b = *(const u32x2*)(sp + 128 + 64 * jj);
#pragma unroll
        for (int e = 0; e < 4; ++e) { const int p = 4 * c + 64 * jj + e;
            const float fa = (float)__builtin_bit_cast(_Float16, (unsigned short)(a[e >> 1] >> (16 * (e & 1)))), fb = (float)__builtin_bit_cast(_Float16, (unsigned short)(b[e >> 1] >> (16 * (e & 1))));
            k1[4 * jj + e] = (fkey(fa) & ~127) | (127 - p); k2[4 * jj + e] = (fkey(fb) & ~127) | (127 - p); } }
    SORT8_DESC(k1); SORT8_DESC(k2);
    int r1 = KMIN, r2 = KMIN;
#pragma unroll 1
    for (int it = 0; it < 16; ++it) {
        int m1 = k1[0], m2 = k2[0];
        row_max2(m1, m2);
        const bool p1 = (k1[0] == m1), p2 = (k2[0] == m2);
#pragma unroll
        for (int e = 0; e < 7; ++e) { k1[e] = p1 ? k1[e + 1] : k1[e]; k2[e] = p2 ? k2[e + 1] : k2[e]; }
        k1[7] = p1 ? KMIN : k1[7]; k2[7] = p2 ? KMIN : k2[7];
        if (c == it) { r1 = m1; r2 = m2; }
    }
    int ck[4];
#pragma unroll
    for (int q = 0; q < 4; ++q) { int ci, cj; cand_ij(c + 16 * q, ci, cj); const int a = __shfl(r1, rbase | ci), b = __shfl(r2, rbase | cj);
        const float fs = keyf((a & ~127) | 64) + keyf((b & ~127) | 64); const int t = c + 16 * q;
        ck[q] = (t < 50) ? ((fkey(fs) & ~63) | (63 - t)) : KMIN; }
    CE_DESC(ck[0], ck[1]); CE_DESC(ck[2], ck[3]); CE_DESC(ck[0], ck[2]); CE_DESC(ck[1], ck[3]); CE_DESC(ck[1], ck[2]);
    int tk = KMIN;
#pragma unroll 1
    for (int it = 0; it < 16; ++it) {
        int m = ck[0];
        row_max1(m);
        const bool pp = (ck[0] == m);
        ck[0] = pp ? ck[1] : ck[0]; ck[1] = pp ? ck[2] : ck[1]; ck[2] = pp ? ck[3] : ck[2]; ck[3] = pp ? KMIN : ck[3];
        if (c == it) tk = m;
    }
    int wi, wj; cand_ij(63 - (tk & 63), wi, wj);
    const int wa = __shfl(r1, rbase | wi), wb = __shfl(r2, rbase | wj);
    const int te = (127 - (wa & 127)) * 128 + (127 - (wb & 127));
    const float tv = keyf((tk & ~63) | 32);
    int mk = tk; row_max1(mk);
    const float mx = keyf((mk & ~63) | 32);
    const float ex = __expf(tv - mx), sum = row_sum_f(ex);
    PK[(size_t)r * 128 + h * 16 + c] = ((unsigned)te << 16) | (unsigned)(ex * (65535.f / sum) + 0.5f);
}
__device__ __forceinline__ void p_peer_topk(const Args& A, const Frame& F, bool skip_ctx) {
    const int gw = F.bid * NWAVES + F.wave, NGW = F.nblk * NWAVES, lane = F.lane;
    const unsigned short* S = (const unsigned short*)(F.ws + WS_S); unsigned* PK = (unsigned*)(F.ws + WS_PK);
    const int KMIN = (int)0x80000000;
    const int nitem = (skip_ctx ? NB * SEQ : R) * 8;
    const int nmain = (nitem / (NGW * 64)) * (NGW * 64);
    for (int q = gw; q < (nitem - nmain) / 4; q += NGW) { const int item = nmain + 4 * q, n = item >> 3; topk_rows4(S, PK, skip_ctx ? tok_row(1, n) : n, item & 7, lane); }
    for (int base = gw * 64; base < nmain; base += NGW * 64) {
        const int item = base + lane, n = item >> 3, h = item & 7, r = skip_ctx ? tok_row(1, n) : n;
        const unsigned short* sp = S + (size_t)r * 2048 + h * 256;
        int t1[16], t2[16];
#pragma unroll
        for (int list = 0; list < 2; ++list) {
            int T[16];
#pragma unroll
            for (int i = 0; i < 16; ++i) T[i] = KMIN;
            const unsigned short* lp = sp + 128 * list;
            u32x4 ra = *(const u32x4*)lp, rb = *(const u32x4*)(lp + 8);
#pragma unroll 1
            for (int c = 0; c < 8; ++c) {
                const int cn = c < 7 ? c + 1 : 7;
                const u32x4 na = *(const u32x4*)(lp + 16 * cn), nb = *(const u32x4*)(lp + 16 * cn + 8);
                const int pb = 127 - 16 * c;
                int K[16];
#pragma unroll
                for (int d = 0; d < 4; ++d) { K[2 * d] = hkey_hi(ra[d] << 16) | (pb - 2 * d); K[2 * d + 1] = hkey_hi(ra[d]) | (pb - 2 * d - 1);
                    K[8 + 2 * d] = hkey_hi(rb[d] << 16) | (pb - 8 - 2 * d); K[8 + 2 * d + 1] = hkey_hi(rb[d]) | (pb - 9 - 2 * d); }
                SORT16_DESC(K);
                MERGE16_DESC(T, K);
                ra = na; rb = nb;
            }
#pragma unroll
            for (int i = 0; i < 16; ++i) { if (list == 0) t1[i] = T[i]; else t2[i] = T[i]; }
        }
        float f1[16], f2[16];
#pragma unroll
        for (int i = 0; i < 16; ++i) { f1[i] = hkey_val(t1[i]); f2[i] = hkey_val(t2[i]); }
        int CA[16], CB[16], CC[16], CD[16];
        CA[0] = (fkey(f1[0] + f2[0]) & ~63) | 63; CA[1] = (fkey(f1[0] + f2[1]) & ~63) | 62; CA[2] = (fkey(f1[0] + f2[2]) & ~63) | 61; CA[3] = (fkey(f1[0] + f2[3]) & ~63) | 60; CA[4] = (fkey(f1[0] + f2[4]) & ~63) | 59; CA[5] = (fkey(f1[0] + f2[5]) & ~63) | 58; CA[6] = (fkey(f1[0] + f2[6]) & ~63) | 57; CA[7] = (fkey(f1[0] + f2[7]) & ~63) | 56; CA[8] = (fkey(f1[0] + f2[8]) & ~63) | 55; CA[9] = (fkey(f1[0] + f2[9]) & ~63) | 54; CA[10] = (fkey(f1[0] + f2[10]) & ~63) | 53; CA[11] = (fkey(f1[0] + f2[11]) & ~63) | 52; CA[12] = (fkey(f1[0] + f2[12]) & ~63) | 51; CA[13] = (fkey(f1[0] + f2[13]) & ~63) | 50; CA[14] = (fkey(f1[0] + f2[14]) & ~63) | 49; CA[15] = (fkey(f1[0] + f2[15]) & ~63) | 48; CB[0] = (fkey(f1[1] + f2[0]) & ~63) | 47; CB[1] = (fkey(f1[1] + f2[1]) & ~63) | 46; CB[2] = (fkey(f1[1] + f2[2]) & ~63) | 45; CB[3] = (fkey(f1[1] + f2[3]) & ~63) | 44; CB[4] = (fkey(f1[1] + f2[4]) & ~63) | 43; CB[5] = (fkey(f1[1] + f2[5]) & ~63) | 42; CB[6] = (fkey(f1[1] + f2[6]) & ~63) | 41; CB[7] = (fkey(f1[1] + f2[7]) & ~63) | 40; CB[8] = (fkey(f1[2] + f2[0]) & ~63) | 39; CB[9] = (fkey(f1[2] + f2[1]) & ~63) | 38; CB[10] = (fkey(f1[2] + f2[2]) & ~63) | 37; CB[11] = (fkey(f1[2] + f2[3]) & ~63) | 36; CB[12] = (fkey(f1[2] + f2[4]) & ~63) | 35; CB[13] = (fkey(f1[3] + f2[0]) & ~63) | 34; CB[14] = (fkey(f1[3] + f2[1]) & ~63) | 33; CB[15] = (fkey(f1[3] + f2[2]) & ~63) | 32; CC[0] = (fkey(f1[3] + f2[3]) & ~63) | 31; CC[1] = (fkey(f1[4] + f2[0]) & ~63) | 30; CC[2] = (fkey(f1[4] + f2[1]) & ~63) | 29; CC[3] = (fkey(f1[4] + f2[2]) & ~63) | 28; CC[4] = (fkey(f1[5] + f2[0]) & ~63) | 27; CC[5] = (fkey(f1[5] + f2[1]) & ~63) | 26; CC[6] = (fkey(f1[6] + f2[0]) & ~63) | 25; CC[7] = (fkey(f1[6] + f2[1]) & ~63) | 24; CC[8] = (fkey(f1[7] + f2[0]) & ~63) | 23; CC[9] = (fkey(f1[7] + f2[1]) & ~63) | 22; CC[10] = (fkey(f1[8] + f2[0]) & ~63) | 21; CC[11] = (fkey(f1[9] + f2[0]) & ~63) | 20; CC[12] = (fkey(f1[10] + f2[0]) & ~63) | 19; CC[13] = (fkey(f1[11] + f2[0]) & ~63) | 18; CC[14] = (fkey(f1[12] + f2[0]) & ~63) | 17; CC[15] = (fkey(f1[13] + f2[0]) & ~63) | 16; CD[0] = (fkey(f1[14] + f2[0]) & ~63) | 15; CD[1] = (fkey(f1[15] + f2[0]) & ~63) | 14; CD[2] = KMIN; CD[3] = KMIN; CD[4] = KMIN; CD[5] = KMIN; CD[6] = KMIN; CD[7] = KMIN; CD[8] = KMIN; CD[9] = KMIN; CD[10] = KMIN; CD[11] = KMIN; CD[12] = KMIN; CD[13] = KMIN; CD[14] = KMIN; CD[15] = KMIN;
        SORT16_DESC(CB); SORT16_DESC(CC); CE_DESC(CD[0], CD[1]);
        MERGE16_DESC(CA, CB); MERGE16_DESC(CA, CC); MERGE16_DESC(CA, CD);
        const float mx = keyf((CA[0] & ~63) | 32);
        float ex[16], sum = 0.f; unsigned te[16];
#pragma unroll
        for (int k = 0; k < 16; ++k) { int wi, wj; cand_ij(63 - (CA[k] & 63), wi, wj);
            const int wa = sel16(t1, wi), wb = sel16(t2, wj);
            te[k] = (unsigned)((127 - (wa & 127)) * 128 + (127 - (wb & 127)));
            ex[k] = __expf(keyf((CA[k] & ~63) | 32) - mx); sum += ex[k]; }
        const float rs = 65535.f / sum;
        u32x4* dst = (u32x4*)(PK + (size_t)r * 128 + h * 16);
#pragma unroll
        for (int q = 0; q < 4; ++q) { u32x4 o;
#pragma unroll
            for (int d = 0; d < 4; ++d) o[d] = (te[4 * q + d] << 16) | (unsigned)(ex[4 * q + d] * rs + 0.5f);
            dst[q] = o; }
    }
}

#define UB(w, b) ((float)(((w) >> (8 * (b))) & 0xffu))
__device__ __forceinline__ void p_peer_experts(const Args& A, const Frame& F, int layer) {
    const int gw = F.bid * NWAVES + F.wave, NGW = F.nblk * NWAVES, lane = F.lane;
    const bf16_t* H = (const bf16_t*)(F.ws + WS_H); float* X = (float*)(F.ws + WS_X);
    const unsigned* PK = (const unsigned*)(F.ws + WS_PK);
    const unsigned char* UT = F.ws + WS_TAB + (size_t)(layer * 2) * 16384 * 1024; const unsigned char* VT = UT + (size_t)16384 * 1024;
    const float* SU = (const float*)(F.ws + WS_TSC) + (layer * 2) * 16384; const float* SV = SU + 16384;
    const float* MOD = (const float*)(F.ws + WS_MOD) + (size_t)layer * 5 * 6144;
    for (int r = gw; r < R; r += NGW) {
        if (layer == 1 && is_ctx_row(r)) continue;
        float hf[16];
        { const u32x4 w0 = *(const u32x4*)(H + (size_t)r * DM + 16 * lane), w1 = *(const u32x4*)(H + (size_t)r * DM + 16 * lane + 8);
#pragma unroll
          for (int d = 0; d < 4; ++d) { hf[2 * d] = bflo(w0[d]); hf[2 * d + 1] = bfhi(w0[d]); hf[8 + 2 * d] = bflo(w1[d]); hf[8 + 2 * d + 1] = bfhi(w1[d]); } }
        float hs = 0.f;
#pragma unroll
        for (int i = 0; i < 16; ++i) hs += hf[i];
        hs = wave_sum(hs);
        int v0 = (int)PK[(size_t)r * 128 + lane], v1 = (int)PK[(size_t)r * 128 + 64 + lane];
#pragma unroll
        for (int k = 2; k <= 128; k <<= 1) {
#pragma unroll
            for (int j = k >> 1; j >= 1; j >>= 1) {
                if (j == 64) { const int a = min(v0, v1), b = max(v0, v1); v0 = a; v1 = b; }
                else { const int o0 = __shfl_xor(v0, j), o1 = __shfl_xor(v1, j); const bool lower = (lane & j) == 0;
                    const bool asc0 = (k == 128) ? true : (k == 64) ? true : ((lane & k) == 0), asc1 = (k == 128) ? true : (k == 64) ? false : ((lane & k) == 0);
                    v0 = (lower == asc0) ? min(v0, o0) : max(v0, o0); v1 = (lower == asc1) ? min(v1, o1) : max(v1, o1); }
            }
        }
        const unsigned pk0 = (unsigned)v0, pk1 = (unsigned)v1;
        const int e0 = (int)(pk0 >> 16), e1 = (int)(pk1 >> 16);
        const float g0 = (float)(pk0 & 0xffffu) * (1.f / 65535.f), g1 = (float)(pk1 & 0xffffu) * (1.f / 65535.f);
        const float su0 = SU[e0], su1 = SU[e1], sv0 = SV[e0], sv1 = SV[e1];
        float d0 = 0.f, d1 = 0.f;
        const int dep_src = (8 * (lane & 7)) << 2; const bool bit3 = (lane & 8) != 0;
#define XISSUE(buf, TAB, esrc, gg) do { _Pragma("unroll") for (int q_ = 0; q_ < 8; ++q_) { const int e_ = __builtin_amdgcn_readlane(esrc, (gg) * 8 + q_); \
            buf[q_] = *(const u32x4*)((TAB) + (size_t)e_ * 1024 + 16 * lane); } } while (0)
#define UCOMP(buf, gg, dsel) do { float p_[8]; _Pragma("unroll") for (int q_ = 0; q_ < 8; ++q_) { float d_ = 0.f; \
            _Pragma("unroll") for (int j_ = 0; j_ < 4; ++j_) d_ += (hf[4 * j_] * UB(buf[q_][j_], 0) + hf[4 * j_ + 1] * UB(buf[q_][j_], 1)) + (hf[4 * j_ + 2] * UB(buf[q_][j_], 2) + hf[4 * j_ + 3] * UB(buf[q_][j_], 3)); p_[q_] = d_; } \
            float s_[4]; _Pragma("unroll") for (int q_ = 0; q_ < 4; ++q_) { auto rr_ = __builtin_amdgcn_permlane32_swap(__float_as_uint(p_[q_]), __float_as_uint(p_[q_ + 4]), false, false); s_[q_] = __uint_as_float(rr_[0]) + __uint_as_float(rr_[1]); } \
            float t_[2]; _Pragma("unroll") for (int q_ = 0; q_ < 2; ++q_) { auto rr_ = __builtin_amdgcn_permlane16_swap(__float_as_uint(s_[q_]), __float_as_uint(s_[q_ + 2]), false, false); t_[q_] = __uint_as_float(rr_[0]) + __uint_as_float(rr_[1]); } \
            const float keep_ = bit3 ? t_[1] : t_[0], send_ = bit3 ? t_[0] : t_[1]; \
            float u_ = keep_ + __builtin_bit_cast(float, __builtin_amdgcn_update_dpp(0, __builtin_bit_cast(int, send_), 0x128, 0xf, 0xf, false)); \
            u_ += __builtin_bit_cast(float, __builtin_amdgcn_update_dpp(0, __builtin_bit_cast(int, u_), DPP_HMIRROR, 0xf, 0xf, false)); \
            u_ += __builtin_bit_cast(float, __builtin_amdgcn_update_dpp(0, __builtin_bit_cast(int, u_), DPP_XOR1, 0xf, 0xf, false)); \
            u_ += __builtin_bit_cast(float, __builtin_amdgcn_update_dpp(0, __builtin_bit_cast(int, u_), DPP_XOR2, 0xf, 0xf, false)); \
            const float v_ = __builtin_bit_cast(float, __builtin_amdgcn_ds_bpermute(dep_src, __builtin_bit_cast(int, u_))); \
            if ((lane >> 3) == (gg)) dsel = v_; } while (0)
        {
            u32x4 ua[8], ub[8];
            XISSUE(ua, UT, e0, 0);
#pragma unroll 1
            for (int g = 0; g < 8; g += 2) { XISSUE(ub, UT, e0, g + 1); UCOMP(ua, g, d0); if (g + 2 < 8) XISSUE(ua, UT, e0, g + 2); else XISSUE(ua, UT, e1, 0); UCOMP(ub, g + 1, d0); }
#pragma unroll 1
            for (int g = 0; g < 8; g += 2) { XISSUE(ub, UT, e1, g + 1); UCOMP(ua, g, d1); if (g + 2 < 8) XISSUE(ua, UT, e1, g + 2); UCOMP(ub, g + 1, d1); }
        }
        const float a0 = su0 * (d0 - 128.f * hs), a1 = su1 * (d1 - 128.f * hs);
        const float w0 = g0 * 0.5f * a0 * (1.f + erff(a0 * 0.70710678118654752f)) * sv0, w1 = g1 * 0.5f * a1 * (1.f + erff(a1 * 0.70710678118654752f)) * sv1;
        const float wsum = wave_sum(w0 + w1) * 128.f;
        float acc[16];
#pragma unroll
        for (int i = 0; i < 16; ++i) acc[i] = 0.f;
#define VCOMP(buf, wsrc, gg) do { _Pragma("unroll") for (int q_ = 0; q_ < 8; ++q_) { const float wk_ = __builtin_bit_cast(float, __builtin_amdgcn_readlane(__builtin_bit_cast(int, wsrc), (gg) * 8 + q_)); \
            _Pragma("unroll") for (int j_ = 0; j_ < 4; ++j_) { acc[4 * j_] += wk_ * UB(buf[q_][j_], 0); acc[4 * j_ + 1] += wk_ * UB(buf[q_][j_], 1); acc[4 * j_ + 2] += wk_ * UB(buf[q_][j_], 2); acc[4 * j_ + 3] += wk_ * UB(buf[q_][j_], 3); } } } while (0)
        {
            u32x4 va[8], vb[8];
            XISSUE(va, VT, e0, 0);
#pragma unroll 1
            for (int g = 0; g < 8; g += 2) { XISSUE(vb, VT, e0, g + 1); VCOMP(va, w0, g); if (g + 2 < 8) XISSUE(va, VT, e0, g + 2); else XISSUE(va, VT, e1, 0); VCOMP(vb, w0, g + 1); }
#pragma unroll 1
            for (int g = 0; g < 8; g += 2) { XISSUE(vb, VT, e1, g + 1); VCOMP(va, w1, g); if (g + 2 < 8) XISSUE(va, VT, e1, g + 2); VCOMP(vb, w1, g + 1); }
        }
#undef XISSUE
#undef UCOMP
#undef VCOMP
        const float* mm = MOD + (size_t)mod_index(r) * 6144;
        f32x4 xn[4]; float s = 0.f;
#pragma unroll
        for (int j = 0; j < 4; ++j) { const int c = 16 * lane + 4 * j; const float* xp = X + (size_t)r * DM + c; const f32x4 gf = *(const f32x4*)(mm + 5 * 1024 + c);
            xn[j] = *(const f32x4*)xp + gf * (f32x4){acc[4 * j] - wsum, acc[4 * j + 1] - wsum, acc[4 * j + 2] - wsum, acc[4 * j + 3] - wsum};
            s += (xn[j].x * xn[j].x + xn[j].y * xn[j].y) + (xn[j].z * xn[j].z + xn[j].w * xn[j].w); }
        const float rinv = rsqrtf(wave_sum(s) * (1.f / DM) + EPS);
        if (layer == 0) {
            const float* m1 = (const float*)(F.ws + WS_MOD) + (size_t)(5 + mod_index(r)) * 6144;
            const float* gn = A.in[I1_NMIX];
#pragma unroll
            for (int j = 0; j < 4; ++j) { const int c = 16 * lane + 4 * j; *(f32x4*)(X + (size_t)r * DM + c) = xn[j];
                const f32x4 y = (xn[j] * rinv * *(const f32x4*)(gn + c)) * (*(const f32x4*)(m1 + 1024 + c) + 1.f) + *(const f32x4*)(m1 + c);
                u32x2 o; o.x = pk2(y.x, y.y); o.y = pk2(y.z, y.w); *(u32x2*)((bf16_t*)(F.ws + WS_H) + (size_t)r * DM + c) = o; }
        } else {
            const int b = r / RPB, t = (r - b * RPB) - CTXL; float* op = F.out + ((size_t)b * SEQ + t) * DM; const float* gn = A.in[I_NOUT];
#pragma unroll
            for (int j = 0; j < 4; ++j) { const int c = 16 * lane + 4 * j; *(f32x4*)(op + c) = xn[j] * rinv * *(const f32x4*)(gn + c); }
        }
    }
}

__device__ __forceinline__ int tok_row(int layer, int n) { return layer == 0 ? n : (n >> 12) * RPB + CTXL + (n & 4095); }
#define DPPF(v, ctrl) __builtin_bit_cast(float, __builtin_amdgcn_update_dpp(0, __builtin_bit_cast(int, v), ctrl, 0xf, 0xf, false))
__device__ __forceinline__ int isum8(int v) {
    v += __builtin_amdgcn_update_dpp(0, v, DPP_XOR1, 0xf, 0xf, false); v += __builtin_amdgcn_update_dpp(0, v, DPP_XOR2, 0xf, 0xf, false); v += __builtin_amdgcn_update_dpp(0, v, DPP_HMIRROR, 0xf, 0xf, false); return v; }
__device__ __forceinline__ void p_exp_u(const Args& A, const Frame& F, int layer) {
    const int lane = F.lane, s = lane >> 3, c8 = lane & 7;
    const bool part = (F.nblk & 7) == 0; const int ncb = part ? 1 : 4, cb0 = part ? (F.bid & 3) : 0;
    const int gwv = part ? ((F.bid >> 2) * NWAVES + F.wave) : (F.bid * NWAVES + F.wave), nwv = part ? ((F.nblk >> 2) * NWAVES) : (F.nblk * NWAVES);
    const int ntok = layer == 0 ? R : NB * SEQ;
    const unsigned char* HQ = F.ws + WS_HQ; const unsigned* PK = (const unsigned*)(F.ws + WS_PK);
    const unsigned char* UT = F.ws + WS_TAB + (size_t)(layer * 2) * 16384 * 1024;
    int* PD = (int*)(F.ws + WS_PD);
#define U_META(pk, hqa, hqb, n_) do { const int r_ = tok_row(layer, (n_) < ntok ? (n_) : gwv); const unsigned* p_ = PK + (size_t)r_ * 128 + s; \
        _Pragma("unroll") for (int i_ = 0; i_ < 16; ++i_) pk[i_] = p_[8 * i_]; \
        hqa = *(const u32x4*)(HQ + (size_t)r_ * DM + 256 * cb + 32 * c8); hqb = *(const u32x4*)(HQ + (size_t)r_ * DM + 256 * cb + 32 * c8 + 16); } while (0)
#define U_ISSUE(pk, lo) do { _Pragma("unroll") for (int i_ = (lo); i_ < (lo) + 8; ++i_) t[i_] = *(const u32x4*)(tb + (size_t)(pk[i_] >> 16) * 128); } while (0)
#define U_DOT(i_) do { int dh_ = __builtin_amdgcn_sdot8((int)t[i_][0], (int)hva[0], 0, false), dl_ = __builtin_amdgcn_sdot8((int)t[i_][0], (int)hva[1], 0, false); \
        dh_ = __builtin_amdgcn_sdot8((int)t[i_][1], (int)hva[2], dh_, false); dl_ = __builtin_amdgcn_sdot8((int)t[i_][1], (int)hva[3], dl_, false); \
        dh_ = __builtin_amdgcn_sdot8((int)t[i_][2], (int)hvb[0], dh_, false); dl_ = __builtin_amdgcn_sdot8((int)t[i_][2], (int)hvb[1], dl_, false); \
        dh_ = __builtin_amdgcn_sdot8((int)t[i_][3], (int)hvb[2], dh_, false); dl_ = __builtin_amdgcn_sdot8((int)t[i_][3], (int)hvb[3], dl_, false); \
        int d_ = isum8(dh_ * 16 + dl_); if (c8 == ((i_) & 7)) { if ((i_) < 8) kA = d_; else kB = d_; } } while (0)
#define U_ITEM(pkc, hqca, hqcb, pkn, n_) do { \
        const u32x4 hva = hqca, hvb = hqcb; \
        U_META(pkc, hqca, hqcb, (n_) + 2 * nwv); \
        int kA = 0, kB = 0; \
        _Pragma("unroll") for (int i_ = 0; i_ < 8; ++i_) U_DOT(i_); \
        U_ISSUE(pkn, 0); \
        _Pragma("unroll") for (int i_ = 8; i_ < 16; ++i_) U_DOT(i_); \
        U_ISSUE(pkn, 8); \
        if ((n_) < ntok) { const int r_ = tok_row(layer, n_); int* pd_ = PD + ((size_t)cb * R + r_) * 128 + 8 * c8 + s; pd_[0] = kA; pd_[64] = kB; } \
        } while (0)
#pragma unroll 1
    for (int cbi = 0; cbi < ncb; ++cbi) {
        const int cb = cb0 + cbi;
        const unsigned char* tb = UT + (size_t)cb * 16384 * 128 + 16 * c8;
        unsigned pkA[16], pkB[16]; u32x4 hAa, hAb, hBa, hBb, t[16];
        U_META(pkA, hAa, hAb, gwv); U_META(pkB, hBa, hBb, gwv + nwv);
        U_ISSUE(pkA, 0); U_ISSUE(pkA, 8);
#pragma unroll 1
        for (int n = gwv; n < ntok; n += 2 * nwv) {
            U_ITEM(pkA, hAa, hAb, pkB, n);
            U_ITEM(pkB, hBa, hBb, pkA, n + nwv);
        }
    }
#undef U_META
#undef U_ISSUE
#undef U_DOT
#undef U_ITEM
}
__device__ __forceinline__ void p_exp_w(const Args& A, const Frame& F, int layer) {
    const int gw = F.bid * NWAVES + F.wave, NGW = F.nblk * NWAVES, lane = F.lane;
    const int ntok = layer == 0 ? R : NB * SEQ;
    const unsigned* PK = (const unsigned*)(F.ws + WS_PK); const int* PD = (const int*)(F.ws + WS_PD); const float* HS = (const float*)(F.ws + WS_HS);
    unsigned* WQ8 = (unsigned*)(F.ws + WS_WQ8); float* WSC = (float*)(F.ws + WS_WSC);
    const float* SU = (const float*)(F.ws + WS_TSC) + (layer * 2) * 16384; const float* SV = SU + 16384;
    const int g2 = (lane >> 3) & 3, sb = lane & 7, src = 32 * (g2 & 1) + sb;
    for (int n = gw; n < ntok; n += 2 * NGW) {
        int r[2]; r[0] = tok_row(layer, n); r[1] = (n + NGW) < ntok ? tok_row(layer, n + NGW) : r[0];
        unsigned pk0[2], pk1[2]; int d0[2], d1[2]; float hs[2];
#pragma unroll
        for (int q = 0; q < 2; ++q) { pk0[q] = PK[(size_t)r[q] * 128 + lane]; pk1[q] = PK[(size_t)r[q] * 128 + 64 + lane]; hs[q] = HS[r[q]]; d0[q] = 0; d1[q] = 0;
#pragma unroll
            for (int cb = 0; cb < 4; ++cb) { d0[q] += PD[((size_t)cb * R + r[q]) * 128 + lane]; d1[q] += PD[((size_t)cb * R + r[q]) * 128 + 64 + lane]; } }
        float su0[2], su1[2], sv0[2], sv1[2];
#pragma unroll
        for (int q = 0; q < 2; ++q) { const int e0 = (int)(pk0[q] >> 16), e1 = (int)(pk1[q] >> 16); su0[q] = SU[e0]; su1[q] = SU[e1]; sv0[q] = SV[e0]; sv1[q] = SV[e1]; }
#pragma unroll
        for (int q = 0; q < 2; ++q) {
            const float g0 = (float)(pk0[q] & 0xffffu) * (1.f / 65535.f), g1 = (float)(pk1[q] & 0xffffu) * (1.f / 65535.f);
            const float a0 = su0[q] * hs[q] * (float)d0[q], a1 = su1[q] * hs[q] * (float)d1[q];
            const float w0 = g0 * 0.5f * a0 * (1.f + erff(a0 * 0.70710678118654752f)) * sv0[q], w1 = g1 * 0.5f * a1 * (1.f + erff(a1 * 0.70710678118654752f)) * sv1[q];
            const float wm = wave_max(fmaxf(fabsf(w0), fabsf(w1)));
            const float inv = wm > 0.f ? 127.f / wm : 0.f;
            const int q0 = (int)rintf(w0 * inv) & 0xff, q1 = (int)rintf(w1 * inv) & 0xff;
            unsigned pw = 0;
#pragma unroll
            for (int j = 0; j < 4; ++j) { const int x0 = __shfl(q0, src + 8 * j), x1 = __shfl(q1, src + 8 * j); pw |= (unsigned)((g2 < 2) ? x0 : x1) << (8 * j); }
            if (q == 0 || (n + NGW) < ntok) { if (lane < 32) WQ8[(size_t)r[q] * 32 + lane] = pw; if (lane == 0) WSC[r[q]] = wm > 0.f ? wm * (1.f / 127.f) : 0.f; }
        }
    }
}
__device__ __forceinline__ void p_exp_v(const Args& A, const Frame& F, int layer) {
    const int lane = F.lane, s = lane >> 3, c8 = lane & 7;
    const bool part = (F.nblk & 7) == 0; const int ncb = part ? 1 : 8, cb0 = part ? (F.bid & 7) : 0;
    const int gwv = part ? ((F.bid >> 3) * NWAVES + F.wave) : (F.bid * NWAVES + F.wave), nwv = part ? ((F.nblk >> 3) * NWAVES) : (F.nblk * NWAVES);
    const int ntok = layer == 0 ? R : NB * SEQ;
    const unsigned* PK = (const unsigned*)(F.ws + WS_PK); const unsigned* WQ8 = (const unsigned*)(F.ws + WS_WQ8); const float* WSC = (const float*)(F.ws + WS_WSC);
    const unsigned char* VT = F.ws + WS_TAB + (size_t)(layer * 2 + 1) * 16384 * 1024;
    unsigned short* X = (unsigned short*)(F.ws + WS_X); const float* MOD = (const float*)(F.ws + WS_MOD) + (size_t)layer * 5 * 6144;
    const bool bit3 = (lane & 8) != 0;
#define V_METAP(pk, n_) do { const int r_ = tok_row(layer, (n_) < ntok ? (n_) : gwv); const unsigned* p_ = PK + (size_t)r_ * 128 + s; \
        _Pragma("unroll") for (int i_ = 0; i_ < 16; ++i_) pk[i_] = p_[8 * i_]; } while (0)
#define V_METAW(wq, n_) do { const int r_ = tok_row(layer, (n_) < ntok ? (n_) : gwv); const unsigned* w_ = WQ8 + (size_t)r_ * 32 + s; \
        _Pragma("unroll") for (int g_ = 0; g_ < 4; ++g_) wq[g_] = w_[8 * g_]; } while (0)
#define V_ISSUE(pk, lo) do { _Pragma("unroll") for (int i_ = (lo); i_ < (lo) + 8; ++i_) t[i_] = *(const u32x4*)(tb + (size_t)(pk[i_] >> 16) * 128); } while (0)
#define V_GRP(wq, g_) do { _Pragma("unroll") for (int j_ = 0; j_ < 4; ++j_) { const unsigned a_ = t[4 * (g_)][j_], b_ = t[4 * (g_) + 1][j_], c_ = t[4 * (g_) + 2][j_], d_ = t[4 * (g_) + 3][j_]; \
        const unsigned ablo = __builtin_amdgcn_perm(b_, a_, 0x05010400u), abhi = __builtin_amdgcn_perm(b_, a_, 0x07030602u), cdlo = __builtin_amdgcn_perm(d_, c_, 0x05010400u), cdhi = __builtin_amdgcn_perm(d_, c_, 0x07030602u); \
        acc[4 * j_]     = __builtin_amdgcn_sdot4((int)__builtin_amdgcn_perm(cdlo, ablo, 0x05040100u), (int)wq[g_], acc[4 * j_], false); \
        acc[4 * j_ + 1] = __builtin_amdgcn_sdot4((int)__builtin_amdgcn_perm(cdlo, ablo, 0x07060302u), (int)wq[g_], acc[4 * j_ + 1], false); \
        acc[4 * j_ + 2] = __builtin_amdgcn_sdot4((int)__builtin_amdgcn_perm(cdhi, abhi, 0x05040100u), (int)wq[g_], acc[4 * j_ + 2], false); \
        acc[4 * j_ + 3] = __builtin_amdgcn_sdot4((int)__builtin_amdgcn_perm(cdhi, abhi, 0x07060302u), (int)wq[g_], acc[4 * j_ + 3], false); } } while (0)
#define V_ITEM(pkc, wqc, pkn, n_) do { \
        int acc[16]; _Pragma("unroll") for (int a_ = 0; a_ < 16; ++a_) acc[a_] = 0; \
        V_METAP(pkc, (n_) + 2 * nwv); \
        V_GRP(wqc, 0); V_GRP(wqc, 1); \
        V_ISSUE(pkn, 0); \
        V_GRP(wqc, 2); V_GRP(wqc, 3); \
        V_ISSUE(pkn, 8); \
        int b8[8], c4[4], o[2]; \
        _Pragma("unroll") for (int a_ = 0; a_ < 8; ++a_) { auto rr = __builtin_amdgcn_permlane32_swap((unsigned)acc[a_], (unsigned)acc[a_ + 8], false, false); b8[a_] = (int)rr[0] + (int)rr[1]; } \
        _Pragma("unroll") for (int a_ = 0; a_ < 4; ++a_) { auto rr = __builtin_amdgcn_permlane16_swap((unsigned)b8[a_], (unsigned)b8[a_ + 4], false, false); c4[a_] = (int)rr[0] + (int)rr[1]; } \
        _Pragma("unroll") for (int a_ = 0; a_ < 2; ++a_) { const int keep = bit3 ? c4[a_ + 2] : c4[a_], send = bit3 ? c4[a_] : c4[a_ + 2]; o[a_] = keep + __builtin_amdgcn_update_dpp(0, send, 0x128, 0xf, 0xf, false); } \
        if ((n_) < ntok) { const int r_ = tok_row(layer, n_); const float ws_ = WSC[r_]; const int col = 128 * cb + 16 * c8 + 2 * s; \
            const f32x2 gf = *(const f32x2*)(MOD + (size_t)mod_index(r_) * 6144 + 5 * 1024 + col); unsigned* xp = (unsigned*)(X + (size_t)r_ * DM + col); \
            const unsigned xw = *xp; *xp = pkh2(h2f_lo(xw) + gf.x * (ws_ * (float)o[0]), h2f_hi(xw) + gf.y * (ws_ * (float)o[1])); } \
        V_METAW(wqc, (n_) + 2 * nwv); } while (0)
#pragma unroll 1
    for (int cbi = 0; cbi < ncb; ++cbi) {
        const int cb = cb0 + cbi;
        const unsigned char* tb = VT + (size_t)cb * 16384 * 128 + 16 * c8;
        unsigned pkA[16], pkB[16], wqA[4], wqB[4]; u32x4 t[16];
        V_METAP(pkA, gwv); V_METAW(wqA, gwv); V_METAP(pkB, gwv + nwv); V_METAW(wqB, gwv + nwv);
        V_ISSUE(pkA, 0); V_ISSUE(pkA, 8);
#pragma unroll 1
        for (int n = gwv; n < ntok; n += 2 * nwv) {
            V_ITEM(pkA, wqA, pkB, n);
            V_ITEM(pkB, wqB, pkA, n + nwv);
        }
    }
#undef V_METAP
#undef V_METAW
#undef V_ISSUE
#undef V_GRP
#undef V_ITEM
}
__device__ __forceinline__ void p_final_norm(const Args& A, const Frame& F) {
    const int gw = F.bid * NWAVES + F.wave, NGW = F.nblk * NWAVES, lane = F.lane;
    const unsigned short* X = (const unsigned short*)(F.ws + WS_X); const float* gn = A.in[I_NOUT];
    for (int n = gw; n < NB * SEQ; n += NGW) {
        const unsigned short* xr = X + (size_t)tok_row(1, n) * DM; float* op = F.out + (size_t)n * DM;
        f32x4 v[4]; float sq = 0.f;
#pragma unroll
        for (int j = 0; j < 4; ++j) { const u32x2 a = *(const u32x2*)(xr + 4 * lane + 256 * j); v[j] = (f32x4){h2f_lo(a.x), h2f_hi(a.x), h2f_lo(a.y), h2f_hi(a.y)}; sq += (v[j].x * v[j].x + v[j].y * v[j].y) + (v[j].z * v[j].z + v[j].w * v[j].w); }
        const float rinv = rsqrtf(wave_sum(sq) * (1.f / DM) + EPS);
#pragma unroll
        for (int j = 0; j < 4; ++j) { const int c = 4 * lane + 256 * j; *(f32x4*)(op + c) = v[j] * rinv * *(const f32x4*)(gn + c); }
    }
}

constexpr int N_PHASES = 24;
__global__ void __launch_bounds__(NTHREADS, 2) mega(Args args) {
    extern __shared__ __attribute__((aligned(16))) unsigned char lds_raw[];
    Frame F; F.x = args.in[I_X]; F.ctx = args.in[I_CTX]; F.out = args.out; F.ws = args.ws; F.lds = (char*)lds_raw;
    F.tid = threadIdx.x; F.lane = F.tid & 63; F.wave = __builtin_amdgcn_readfirstlane(F.tid >> 6); F.bid = blockIdx.x; F.nblk = gridDim.x;
    F.vcu = (F.nblk % 8 == 0) ? (F.bid % 8) * (F.nblk / 8) + F.bid / 8 : F.bid;
    volatile LAS unsigned* st = (volatile LAS unsigned*)(LAS unsigned char*)(lds_raw + LDS_BYTES - 64);
    if (F.tid < 16) st[F.tid] = 0u;
    __syncthreads();
    XcdBarrier bar; bar.bar = (unsigned*)(F.ws + WS_CTL) + 4096; bar.x = 0; bar.st = st;
    const int lo = args.ph_lo, hi = args.ph_hi;
    const bool fused = (hi - lo) > 1;
    if (fused) bar = xcd_barrier_post((unsigned*)(F.ws + WS_CTL) + 4096, st);
#ifdef ONLY_PHASE
#define IN(k) ((k) == ONLY_PHASE && lo <= (k) && (k) < hi)
#else
#define IN(k) (lo <= (k) && (k) < hi)
#endif
#define SEAM(k) do { if (IN(k) && IN((k) + 1)) { if ((k) == 0) cg::this_grid().sync(); else xcd_barrier(bar); } } while (0)
    bf16_t* Hb = (bf16_t*)(F.ws + WS_H);
#define PH(k, ...) if (IN(k)) for (int rep_ = 0; rep_ < (((PROBE_MASK >> (k)) & 1u) ? 2 : 1); ++rep_) { __VA_ARGS__; __syncthreads(); } SEAM(k)
    unsigned short* Xb = (unsigned short*)(F.ws + WS_X); const float* MODb = (const float*)(F.ws + WS_MOD);
    PH(0, for (int q_ = 0; q_ < ((PROBE_P0 & 1u) ? 2 : 1); ++q_) { p0_mod(args, F); __syncthreads(); }
          for (int q_ = 0; q_ < ((PROBE_P0 & 2u) ? 2 : 1); ++q_) { p0_weights(args, F); __syncthreads(); }
          for (int q_ = 0; q_ < ((PROBE_P0 & 4u) ? 2 : 1); ++q_) { p0_weff(args, F); __syncthreads(); }
          for (int q_ = 0; q_ < ((PROBE_P0 & 8u) ? 2 : 1); ++q_) { p0_tables(args, F); __syncthreads(); });
    PH(1, p_norm_rows(args, F, 0, 0, true, false));
    PH(2, gemm8e(F, Hb, (const bf16_t*)(F.ws + WS_WIN), 768, 1024, false, EpiMlaDown{(bf16_t*)(F.ws + WS_CQ), (bf16_t*)(F.ws + WS_CKV), (bf16_t*)(F.ws + WS_KR), (float*)(F.ws + WS_SSP)}));
    PH(3, p_mla_krope(args, F);
          gemm8(F, (const bf16_t*)(F.ws + WS_CQ), (const bf16_t*)(F.ws + WS_WUQ), 1536, 384, false, In8Bf16Rs{(bf16_t*)(F.ws + WS_Q), 1536, (const float*)(F.ws + WS_SSP)});
          gemm8(F, (const bf16_t*)(F.ws + WS_CKV), (const bf16_t*)(F.ws + WS_WUKV), 2048, 256, false, In8KVRs{(bf16_t*)(F.ws + WS_K), (bf16_t*)(F.ws + WS_V), (const float*)(F.ws + WS_SSP)}, true));
    PH(4, p_attn_mla(args, F));
    PH(5, gemm8(F, (const bf16_t*)(F.ws + WS_O), (const bf16_t*)(F.ws + WS_WO0), 1024, 1024, false, In8Resid{F.x, F.ctx, Xb, MODb + 2 * 1024, true}));
    PH(6, p_norm_rows(args, F, 0, 1, false, false));
    PH(7, gemm8(F, Hb, (const bf16_t*)(F.ws + WS_WQ0), 2048, 1024, false, In8F16{(unsigned short*)(F.ws + WS_S), 2048}));
    PH(8, p_peer_topk(args, F, false));
    PH(9, p_exp_u(args, F, 0));
    PH(10, p_exp_w(args, F, 0));
    if (IN(11)) { p_exp_v(args, F, 0); } SEAM(11);
    PH(12, p_norm_rows(args, F, 1, 0, false, false));
    PH(13, gemm8(F, Hb, (const bf16_t*)(F.ws + WS_WQKV), 1536, 1024, false, In8Bf16{(bf16_t*)(F.ws + WS_RAW1), 1536}));
    PH(14, p_gqa_rows(args, F));
    PH(15, p_attn_gqa(args, F));
    if (IN(16)) { gemm8(F, (const bf16_t*)(F.ws + WS_O), (const bf16_t*)(F.ws + WS_WO1), 1024, 1024, true, In8Resid{F.x, F.ctx, Xb, MODb + 5 * 6144 + 2 * 1024, false}); } SEAM(16);
    PH(17, p_norm_rows(args, F, 1, 1, false, true));
    PH(18, gemm8(F, Hb, (const bf16_t*)(F.ws + WS_WQ1), 2048, 1024, true, In8F16{(unsigned short*)(F.ws + WS_S), 2048}));
    PH(19, p_peer_topk(args, F, true));
    PH(20, p_exp_u(args, F, 1));
    PH(21, p_exp_w(args, F, 1));
    if (IN(22)) { p_exp_v(args, F, 1); } SEAM(22);
    if (IN(23)) p_final_norm(args, F);
#undef PH
#undef IN
#undef SEAM
}

extern "C" void kernel_launch(void* const* d_in, const int* in_sizes, int n_in, void* d_out, int out_size, void* d_ws, size_t ws_size, hipStream_t stream) {
    static int grid = 0;
    if (grid == 0) {
        if (n_in != N_IN || in_sizes[0] != NB * SEQ * DM || out_size != NB * SEQ * DM || ws_size < WS_END) {
            fprintf(stderr, "kernel_launch: shape mismatch (n_in %d, in0 %d, out %d, ws %zu < %zu)\n", n_in, n_in > 0 ? in_sizes[0] : -1, out_size, ws_size, (size_t)WS_END); grid = -1; return; }
        int dev = 0, cus = 0, per_cu = 0;
        hipGetDevice(&dev); hipDeviceGetAttribute(&cus, hipDeviceAttributeMultiprocessorCount, dev);
        if (hipFuncSetAttribute((const void*)mega, hipFuncAttributeMaxDynamicSharedMemorySize, LDS_BYTES) != hipSuccess) { fprintf(stderr, "kernel_launch: hipFuncSetAttribute failed\n"); grid = -1; return; }
        if (hipOccupancyMaxActiveBlocksPerMultiprocessor(&per_cu, (const void*)mega, NTHREADS, LDS_BYTES) != hipSuccess || per_cu < 1) { fprintf(stderr, "kernel_launch: occupancy query failed (%d)\n", per_cu); (void)hipGetLastError(); grid = -1; return; }
        grid = cus * (per_cu > 1 ? 1 : per_cu);
    }
    if (grid < 0) return;
    hipMemsetAsync((char*)d_ws + WS_CTL, 0, 1 * MiB, stream);
    Args a{};
    for (int i = 0; i < N_IN; ++i) a.in[i] = (const float*)d_in[i];
    a.out = (float*)d_out; a.ws = (unsigned char*)d_ws;
#if MK_PER_PHASE
    for (int p = 0; p < N_PHASES; ++p) { a.ph_lo = p; a.ph_hi = p + 1; hipLaunchKernelGGL(mega, dim3(grid), dim3(NTHREADS), LDS_BYTES, stream, a); }
#else
    a.ph_lo = 0; a.ph_hi = N_PHASES;
    void* kargs[] = {&a};
    hipError_t e = hipLaunchCooperativeKernel((const void*)mega, dim3(grid), dim3(NTHREADS), kargs, LDS_BYTES, stream);
    if (e != hipSuccess) fprintf(stderr, "kernel_launch: cooperative launch failed: %s (grid %d)\n", hipGetErrorString(e), grid);
#endif
}
```

```cpp
#include <hip/hip_runtime.h>
#include <hip/hip_cooperative_groups.h>
#include <cstdio>
#include <cstdint>
namespace cg = cooperative_groups;

#ifndef PROBE_MASK
#define PROBE_MASK 0u
#endif
#ifndef PROBE_P0
#define PROBE_P0 0u
#endif
#ifndef ATTN_SELFTEST
#define ATTN_SELFTEST 0
#endif
#ifndef MK_PER_PHASE
#define MK_PER_PHASE 0
#endif

typedef unsigned short bf16_t;
typedef short bf16x8 __attribute__((ext_vector_type(8)));
typedef short s16x4 __attribute__((ext_vector_type(4)));
typedef float f32x4 __attribute__((ext_vector_type(4)));
typedef float f32x2 __attribute__((ext_vector_type(2)));
typedef float f32x16 __attribute__((ext_vector_type(16)));
typedef unsigned u32x4 __attribute__((ext_vector_type(4)));
typedef unsigned u32x2 __attribute__((ext_vector_type(2)));
#define LAS __attribute__((address_space(3)))
#define SBAR() __builtin_amdgcn_sched_barrier(0)

__device__ __forceinline__ unsigned f2bf(float f) { unsigned u = __builtin_bit_cast(unsigned, f); return (u + 0x7fffu + ((u >> 16) & 1u)) >> 16; }
__device__ __forceinline__ unsigned pk2(float lo, float hi) { return f2bf(lo) | (f2bf(hi) << 16); }
typedef _Float16 f16x2_t __attribute__((ext_vector_type(2)));
__device__ __forceinline__ unsigned pkh2(float lo, float hi) { f32x2 v = {lo, hi}; return __builtin_bit_cast(unsigned, __builtin_convertvector(v, f16x2_t)); }
__device__ __forceinline__ float h2f_lo(unsigned w) { return (float)__builtin_bit_cast(_Float16, (unsigned short)(w & 0xffffu)); }
__device__ __forceinline__ float h2f_hi(unsigned w) { return (float)__builtin_bit_cast(_Float16, (unsigned short)(w >> 16)); }
__device__ __forceinline__ float bf2f(unsigned short h) { return __builtin_bit_cast(float, (unsigned)h << 16); }
__device__ __forceinline__ float bflo(unsigned w) { return __builtin_bit_cast(float, w << 16); }
__device__ __forceinline__ float bfhi(unsigned w) { return __builtin_bit_cast(float, w & 0xffff0000u); }
__device__ __forceinline__ unsigned cvtpk(float lo, float hi) { unsigned r; asm volatile("v_cvt_pk_bf16_f32 %0, %1, %2" : "=v"(r) : "v"(lo), "v"(hi)); return r; }
typedef int i32x8 __attribute__((ext_vector_type(8)));
__device__ __forceinline__ unsigned f8x4(float a, float b, float c, float d) { int w = __builtin_amdgcn_cvt_pk_fp8_f32(a, b, 0, false); w = __builtin_amdgcn_cvt_pk_fp8_f32(c, d, w, true); return (unsigned)w; }
template <int B> __device__ __forceinline__ float f8dec(unsigned w) { return __builtin_amdgcn_cvt_f32_fp8((int)w, B); }
#define WDPP(v, ctrl) __builtin_bit_cast(float, __builtin_amdgcn_update_dpp(0, __builtin_bit_cast(int, v), ctrl, 0xf, 0xf, false))
__device__ __forceinline__ float wave_sum(float v) {
    v += WDPP(v, 0xB1); v += WDPP(v, 0x4E); v += WDPP(v, 0x141); v += WDPP(v, 0x140);
    { auto rr = __builtin_amdgcn_permlane16_swap(__float_as_uint(v), __float_as_uint(v), false, false); v = __uint_as_float(rr[0]) + __uint_as_float(rr[1]); }
    { auto rr = __builtin_amdgcn_permlane32_swap(__float_as_uint(v), __float_as_uint(v), false, false); v = __uint_as_float(rr[0]) + __uint_as_float(rr[1]); }
    return v;
}
__device__ __forceinline__ float wave_max(float v) {
    v = fmaxf(v, WDPP(v, 0xB1)); v = fmaxf(v, WDPP(v, 0x4E)); v = fmaxf(v, WDPP(v, 0x141)); v = fmaxf(v, WDPP(v, 0x140));
    { auto rr = __builtin_amdgcn_permlane16_swap(__float_as_uint(v), __float_as_uint(v), false, false); v = fmaxf(__uint_as_float(rr[0]), __uint_as_float(rr[1])); }
    { auto rr = __builtin_amdgcn_permlane32_swap(__float_as_uint(v), __float_as_uint(v), false, false); v = fmaxf(__uint_as_float(rr[0]), __uint_as_float(rr[1])); }
    return v;
}

constexpr int DM = 1024, NB = 4, SEQ = 4096, CTXL = 256;
constexpr int RPB = SEQ + CTXL;
constexpr int R = NB * RPB;
constexpr float EPS = 1e-6f;
constexpr int NTHREADS = 512, NWAVES = 8;
constexpr int LDS_BYTES = 147456;

enum { I_X = 0, I_C, I_CTX, I_CCTX,
       I0_ADAW, I0_ADAB, I0_NMIX, I0_NFFN, I0_WIN, I0_QN, I0_WUQ, I0_KVN, I0_WUKV, I0_WO, I0_PWQ, I0_PK1, I0_PK2, I0_PU, I0_PV,
       I1_ADAW, I1_ADAB, I1_NMIX, I1_NFFN, I1_WQKV, I1_QN, I1_KN, I1_WO, I1_PWQ, I1_PK1, I1_PK2, I1_PU, I1_PV,
       I_NOUT, N_IN };

constexpr size_t MiB = 1u << 20;
constexpr size_t WS_CTL   = 0;
constexpr size_t WS_MOD   = 1 * MiB;
constexpr size_t WS_WIN   = 2 * MiB;
constexpr size_t WS_WUQ   = WS_WIN + 768 * 1024 * 2;
constexpr size_t WS_WUKV  = WS_WUQ + 1536 * 384 * 2;
constexpr size_t WS_WO0   = WS_WUKV + 2048 * 256 * 2;
constexpr size_t WS_WQ0   = WS_WO0 + 1024 * 1024 * 2;
constexpr size_t WS_KK0   = WS_WQ0 + 2048 * 1024 * 2;
constexpr size_t WS_WQKV  = WS_KK0 + 16 * 128 * 128 * 2;
constexpr size_t WS_WO1   = WS_WQKV + 1536 * 1024 * 2;
constexpr size_t WS_WQ1   = WS_WO1 + 1024 * 1024 * 2;
constexpr size_t WS_KK1   = WS_WQ1 + 2048 * 1024 * 2;
constexpr size_t WS_WEND  = WS_KK1 + 16 * 128 * 128 * 2;
static_assert(WS_WEND <= 24 * MiB, "weights region");
constexpr size_t WS_H     = 24 * MiB;
constexpr size_t WS_X     = WS_H + (size_t)R * 1024 * 2;
constexpr size_t WS_QKV   = WS_X + (size_t)R * 1024 * 4;
constexpr size_t WS_Q     = WS_QKV;
constexpr size_t WS_K     = WS_Q + (size_t)R * 1536 * 2;
constexpr size_t WS_V     = WS_K + (size_t)R * 1536 * 2;
constexpr size_t WS_S     = WS_QKV;
constexpr size_t WS_B     = WS_QKV + (size_t)R * 2048 * 4;
constexpr size_t WS_CQ    = WS_B;
constexpr size_t WS_CKV   = WS_CQ + (size_t)R * 384 * 2;
constexpr size_t WS_KR    = WS_CKV + (size_t)R * 256 * 2;
constexpr size_t WS_SSP   = WS_KR + (size_t)R * 64 * 2;
static_assert(WS_SSP + (size_t)R * 24 * 4 <= WS_B + 40 * MiB, "MLA latents inside region B");
constexpr size_t WS_O     = WS_B;
constexpr size_t WS_QP    = WS_B;
constexpr size_t WS_RAW1  = WS_B;
constexpr size_t WS_PK    = WS_B + (size_t)R * 2048 * 2;
constexpr size_t WS_TAB   = WS_PK + (size_t)R * 128 * 4;
constexpr size_t WS_PD    = WS_S;
constexpr size_t WS_WQ8   = WS_PD + (size_t)8 * R * 128 * 4;
constexpr size_t WS_WSC   = WS_WQ8 + (size_t)R * 128;
static_assert(WS_WSC + (size_t)R * 4 <= WS_B, "expert scratch inside the S region");
constexpr size_t WS_HQ    = WS_B + 40 * MiB;
constexpr size_t WS_HS    = WS_HQ + (size_t)R * 1024;
static_assert(WS_HS + (size_t)R * 4 <= WS_PK, "HQ inside region B");
constexpr size_t WS_TSC   = WS_TAB + (size_t)4 * 16384 * 1024;
constexpr size_t WS_END   = WS_TSC + (size_t)4 * 16384 * 4;
constexpr size_t WS_Q1    = WS_QKV;
constexpr size_t WS_K1    = WS_Q1 + (size_t)R * 1024 * 2;
constexpr size_t WS_V1    = WS_K1 + (size_t)R * 256 * 2;

#define XB_TMO      128
#define XB_XCNT(j)  (256  + 64 * (j))
#define XB_XSUB(j)  (1280 + 64 * (j))
#define XB_XGEN(j)  (2304 + 64 * (j))
#define XB_TOP      3328
#define XB_TOPGEN   3392
#define XCD_BAR_WORDS 3456
#define XB_SPIN_CAP (1u << 20)
__device__ __forceinline__ unsigned xb_ld(unsigned* p)              { return __hip_atomic_load(p, __ATOMIC_RELAXED, __HIP_MEMORY_SCOPE_AGENT); }
__device__ __forceinline__ unsigned xb_add(unsigned* p, unsigned v) { return __hip_atomic_fetch_add(p, v, __ATOMIC_RELAXED, __HIP_MEMORY_SCOPE_AGENT); }
__device__ __forceinline__ unsigned xb_xcc_id() { return (unsigned)__builtin_amdgcn_s_getreg((3 << 11) | 20) & 0xFu; }
#define XB_SPIN(cond, bar) do { unsigned _sp = 0; while (cond) { __builtin_amdgcn_s_sleep(1); \
    if ((++_sp & 255u) == 0u) { if (xb_ld(&(bar)[XB_TMO])) break; if (_sp > XB_SPIN_CAP) { atomicAdd(&(bar)[XB_TMO], 1u); break; } } } } while (0)
struct XcdBarrier { unsigned* bar; unsigned x; volatile LAS unsigned* st; };
__device__ __forceinline__ XcdBarrier xcd_barrier_post(unsigned* bar, volatile LAS unsigned* st) {
    XcdBarrier b; b.bar = bar; b.x = xb_xcc_id(); b.st = st;
    if (threadIdx.x == 0) (void)xb_add(&bar[XB_XCNT(b.x)], 1u);
    return b;
}
__device__ __forceinline__ void xcd_barrier_complete(unsigned* bar, unsigned x, unsigned& nloc, unsigned& nx) {
    const unsigned G = gridDim.x * gridDim.y * gridDim.z;
    unsigned sum, cnt, mine, sp = 0u;
    for (;;) {
        sum = 0u; cnt = 0u; mine = 0u;
#pragma unroll
        for (unsigned j = 0; j < 16; ++j) { const unsigned c = xb_ld(&bar[XB_XCNT(j)]); sum += c; cnt += (c > 0u) ? 1u : 0u; mine = (j == x) ? c : mine; }
        if (sum == G) break;
        __builtin_amdgcn_s_sleep(1);
        if ((++sp & 255u) == 0u) { if (xb_ld(&bar[XB_TMO])) break; if (sp > XB_SPIN_CAP) { atomicAdd(&bar[XB_TMO], 1u); break; } }
    }
    nloc = mine > 0u ? mine : 1u; nx = cnt > 0u ? cnt : 1u;
}
__device__ __forceinline__ void xcd_barrier(const XcdBarrier& b) {
    asm volatile("s_waitcnt vmcnt(0)" ::: "memory");
    __syncthreads();
    if (threadIdx.x == 0) {
        unsigned* bar = b.bar;
        __builtin_amdgcn_s_waitcnt(0);
        unsigned nloc = b.st[0], nx = b.st[1];
        if (nloc == 0u) { xcd_barrier_complete(bar, b.x, nloc, nx); b.st[0] = nloc; b.st[1] = nx; }
        const unsigned old = xb_add(&bar[XB_XSUB(b.x)], 1u);
        const unsigned gen = old / nloc;
        if (old + 1u == (gen + 1u) * nloc) {
            __builtin_amdgcn_fence(__ATOMIC_RELEASE, "agent");
            asm volatile("s_waitcnt vmcnt(0)" ::: "memory");
            const unsigned og = xb_add(&bar[XB_TOP], 1u);
            const unsigned tg = og / nx;
            if (og + 1u == (tg + 1u) * nx) xb_add(&bar[XB_TOPGEN], 1u);
            else XB_SPIN(xb_ld(&bar[XB_TOPGEN]) == tg, bar);
            __builtin_amdgcn_fence(__ATOMIC_ACQUIRE, "agent");
            xb_add(&bar[XB_XGEN(b.x)], 1u);
            asm volatile("s_waitcnt vmcnt(0)" ::: "memory");
        } else {
            XB_SPIN(xb_ld(&bar[XB_XGEN(b.x)]) == gen, bar);
            __builtin_amdgcn_fence(__ATOMIC_ACQUIRE, "agent");
            asm volatile("s_waitcnt vmcnt(0)" ::: "memory");
        }
    }
    __syncthreads();
}


struct Args { const float* in[N_IN]; float* out; unsigned char* ws; int ph_lo, ph_hi; };
static_assert(sizeof(Args) == (N_IN + 2) * 8 + 8, "Args has no padding");

struct Frame {
    const float* x; const float* ctx; float* out; unsigned char* ws; char* lds;
    int tid, lane, wave, bid, nblk, vcu;
};

__device__ __forceinline__ const float* xin_row(const Frame& F, int r) {
    const int b = r / RPB, j = r - b * RPB;
    return (j < CTXL) ? F.ctx + ((size_t)b * CTXL + j) * DM : F.x + ((size_t)b * SEQ + (j - CTXL)) * DM;
}
__device__ __forceinline__ int mod_index(int r) { const int b = r / RPB, j = r - b * RPB; return (j < CTXL) ? 4 : b; }
__device__ __forceinline__ bool is_ctx_row(int r) { return (r % RPB) < CTXL; }

__device__ __forceinline__ void p0_mod(const Args& A, const Frame& F) {
    float* sv = (float*)F.lds;
    float* red = sv + 5 * 1024;
    float* MOD = (float*)(F.ws + WS_MOD);
    bool have = false;
    for (int it = F.bid; it < 2 * 96; it += F.nblk) {
        if (!have) {
            for (int i = F.tid; i < 5 * 1024; i += NTHREADS) { const int m = i >> 10, k = i & 1023;
                const float c = (m < 4) ? A.in[I_C][m * 1024 + k] : A.in[I_CCTX][k]; sv[i] = c / (1.f + __expf(-c)); }
            __syncthreads(); have = true;
        }
        const int l = it / 96, n = (it % 96) * 64 + F.lane;
        const float* W = A.in[l ? I1_ADAW : I0_ADAW]; const float* Bv = A.in[l ? I1_ADAB : I0_ADAB];
        float acc[5] = {0.f, 0.f, 0.f, 0.f, 0.f};
        const int k0 = F.wave * 128;
#pragma unroll 16
        for (int k = k0; k < k0 + 128; ++k) { const float w = W[(size_t)k * 6144 + n];
#pragma unroll
            for (int m = 0; m < 5; ++m) acc[m] += sv[m * 1024 + k] * w; }
#pragma unroll
        for (int m = 0; m < 5; ++m) red[(F.wave * 5 + m) * 64 + F.lane] = acc[m];
        __syncthreads();
        if (F.tid < 320) { const int m = F.tid >> 6, ln = F.tid & 63; float s = 0.f;
#pragma unroll
            for (int w = 0; w < 8; ++w) s += red[(w * 5 + m) * 64 + ln];
            const int nn = (it % 96) * 64 + ln;
            MOD[((size_t)l * 5 + m) * 6144 + nn] = s + Bv[nn]; }
        __syncthreads();
    }
}
__device__ __forceinline__ void transpose_item(const float* W, int K, int N, bf16_t* WT, const float* gain, float* scr, int item, int lane) {
    const int nblk = N / 32, kb = item / nblk, nb = item % nblk, k0 = 64 * kb, n0 = 32 * nb;
#pragma unroll 8
    for (int i = 0; i < 32; ++i) { const int kk = 2 * i + (lane >> 5); float v = W[(size_t)(k0 + kk) * N + n0 + (lane & 31)]; if (gain) v *= gain[k0 + kk]; scr[kk * 33 + (lane & 31)] = v; }
    asm volatile("s_waitcnt lgkmcnt(0)" ::: "memory");
    const int c = lane & 7;
#pragma unroll
    for (int j = 0; j < 4; ++j) { const int n = (lane >> 3) + 8 * j; const float* s = scr + (8 * c) * 33 + n;
        u32x4 o; o.x = pk2(s[0 * 33], s[1 * 33]); o.y = pk2(s[2 * 33], s[3 * 33]); o.z = pk2(s[4 * 33], s[5 * 33]); o.w = pk2(s[6 * 33], s[7 * 33]);
        *(u32x4*)(WT + (size_t)(n0 + n) * K + k0 + 8 * c) = o; }
    asm volatile("s_waitcnt lgkmcnt(0)" ::: "memory");
}
__device__ __forceinline__ void p0_weights(const Args& A, const Frame& F) {
    float* scr = (float*)(F.lds + 32768) + F.wave * (64 * 33);
    const int gw = F.bid * NWAVES + F.wave, NGW = F.nblk * NWAVES;
#define TJOB(IN_, K_, N_, OFF_, GAIN_) do { const float* W = A.in[IN_]; bf16_t* WT = (bf16_t*)(F.ws + (OFF_)); \
        for (int it = gw; it < ((K_) / 64) * ((N_) / 32); it += NGW) transpose_item(W, K_, N_, WT, GAIN_, scr, it, F.lane); } while (0)
    TJOB(I0_WIN, 1024, 704, WS_WIN, nullptr); TJOB(I0_WUQ, 384, 1536, WS_WUQ, A.in[I0_QN]); TJOB(I0_WUKV, 256, 2048, WS_WUKV, A.in[I0_KVN]); TJOB(I0_WO, 1024, 1024, WS_WO0, nullptr);
    TJOB(I1_WQKV, 1024, 1536, WS_WQKV, nullptr); TJOB(I1_WO, 1024, 1024, WS_WO1, nullptr);
#undef TJOB
    { u32x4* z = (u32x4*)(F.ws + WS_WIN + (size_t)704 * 1024 * 2); const int n16 = 64 * 1024 * 2 / 16;
      for (int i = F.bid * NTHREADS + F.tid; i < n16; i += F.nblk * NTHREADS) z[i] = (u32x4){0u, 0u, 0u, 0u}; }
}
__device__ __forceinline__ void p0_weff(const Args& A, const Frame& F) {
    float* kkT = (float*)F.lds; float* wqs = kkT + 128 * 129;
    const int tid = F.tid, lane = F.lane, w = F.wave;
    for (int item = F.bid; item < 512; item += F.nblk) {
        const int layer = item >> 8, z = (item >> 4) & 15, kc = item & 15, h = z >> 1;
        const float* kk = ((z & 1) ? (layer ? A.in[I1_PK2] : A.in[I0_PK2]) : (layer ? A.in[I1_PK1] : A.in[I0_PK1])) + (size_t)h * 16384;
        const float* wq = (layer ? A.in[I1_PWQ] : A.in[I0_PWQ]) + (size_t)(kc * 64) * 2048 + z * 128;
        bf16_t* WT = (bf16_t*)(F.ws + (layer ? WS_WQ1 : WS_WQ0));
        __syncthreads();
        { f32x4 kv[8], wv4[4];
#pragma unroll
          for (int i = 0; i < 8; ++i) kv[i] = *(const f32x4*)(kk + 4 * (tid + i * NTHREADS));
#pragma unroll
          for (int i = 0; i < 4; ++i) { const int e = 4 * (tid + i * NTHREADS); wv4[i] = *(const f32x4*)(wq + (size_t)(e >> 7) * 2048 + (e & 127)); }
#pragma unroll
          for (int i = 0; i < 8; ++i) { const int e = 4 * (tid + i * NTHREADS), key = e >> 7, d = e & 127; kkT[d * 129 + key] = kv[i].x; kkT[(d + 1) * 129 + key] = kv[i].y; kkT[(d + 2) * 129 + key] = kv[i].z; kkT[(d + 3) * 129 + key] = kv[i].w; }
#pragma unroll
          for (int i = 0; i < 4; ++i) *(f32x4*)(wqs + 4 * (tid + i * NTHREADS)) = wv4[i]; }
        __syncthreads();
        float acc[8][2];
#pragma unroll
        for (int j = 0; j < 8; ++j) { acc[j][0] = 0.f; acc[j][1] = 0.f; }
#pragma unroll 2
        for (int d = 0; d < 128; ++d) { const float a0 = kkT[d * 129 + lane], a1 = kkT[d * 129 + lane + 64];
#pragma unroll
            for (int j = 0; j < 8; ++j) { const float wv = wqs[(w * 8 + j) * 128 + d]; acc[j][0] += wv * a0; acc[j][1] += wv * a1; } }
        u32x4 o0, o1;
        o0.x = pk2(acc[0][0], acc[1][0]); o0.y = pk2(acc[2][0], acc[3][0]); o0.z = pk2(acc[4][0], acc[5][0]); o0.w = pk2(acc[6][0], acc[7][0]);
        o1.x = pk2(acc[0][1], acc[1][1]); o1.y = pk2(acc[2][1], acc[3][1]); o1.z = pk2(acc[4][1], acc[5][1]); o1.w = pk2(acc[6][1], acc[7][1]);
        *(u32x4*)(WT + (size_t)(z * 128 + lane) * 1024 + kc * 64 + w * 8) = o0;
        *(u32x4*)(WT + (size_t)(z * 128 + lane + 64) * 1024 + kc * 64 + w * 8) = o1;
    }
    __syncthreads();
}

__device__ __forceinline__ void p0_tables(const Args& A, const Frame& F) {
    const int gw = F.bid * NWAVES + F.wave, NGW = F.nblk * NWAVES, lane = F.lane;
    unsigned char* TAB = F.ws + WS_TAB; float* TSC = (float*)(F.ws + WS_TSC);
    for (int it = gw; it < 4 * 16384 / 4; it += NGW) {
        const int t = it >> 12, row0 = (it & 4095) * 4;
        const float* src = (t == 0 ? A.in[I0_PU] : t == 1 ? A.in[I0_PV] : t == 2 ? A.in[I1_PU] : A.in[I1_PV]) + (size_t)row0 * 1024 + 4 * lane;
        f32x4 v[4][4];
#pragma unroll
        for (int rr = 0; rr < 4; ++rr)
#pragma unroll
            for (int j = 0; j < 4; ++j) v[rr][j] = *(const f32x4*)(src + (size_t)rr * 1024 + 256 * j);
#pragma unroll
        for (int rr = 0; rr < 4; ++rr) {
            float am = 0.f;
#pragma unroll
            for (int j = 0; j < 4; ++j) am = fmaxf(am, fmaxf(fmaxf(fabsf(v[rr][j].x), fabsf(v[rr][j].y)), fmaxf(fabsf(v[rr][j].z), fabsf(v[rr][j].w))));
            am = wave_max(am);
            const int row = row0 + rr;
            float sc;
            if ((t & 1) == 0) {
                float ss = 0.f;
#pragma unroll
                for (int j = 0; j < 4; ++j) ss += (v[rr][j].x * v[rr][j].x + v[rr][j].y * v[rr][j].y) + (v[rr][j].z * v[rr][j].z + v[rr][j].w * v[rr][j].w);
                ss = wave_sum(ss);
                sc = am > 0.f ? fminf(am * (1.f / 7.f), 0.36f * sqrtf(ss * (1.f / 1024.f))) : 1.f;
                const float inv = am > 0.f ? 1.f / sc : 0.f;
#pragma unroll
                for (int j = 0; j < 4; ++j) {
                    const int q0 = (int)fminf(fmaxf(rintf(v[rr][j].x * inv), -7.f), 7.f), q1 = (int)fminf(fmaxf(rintf(v[rr][j].y * inv), -7.f), 7.f), q2 = (int)fminf(fmaxf(rintf(v[rr][j].z * inv), -7.f), 7.f), q3 = (int)fminf(fmaxf(rintf(v[rr][j].w * inv), -7.f), 7.f);
                    *(unsigned short*)(TAB + (((size_t)t * 8 + j) * 16384 + row) * 128 + 2 * lane) = (unsigned short)((q0 & 15) | ((q1 & 15) << 4) | ((q2 & 15) << 8) | ((q3 & 15) << 12)); }
            } else {
            sc = am > 0.f ? am * (1.f / 127.f) : 1.f; const float inv = am > 0.f ? 127.f / am : 0.f;
#pragma unroll
            for (int j = 0; j < 4; ++j) { const unsigned b0 = (unsigned)((int)rintf(v[rr][j].x * inv)) & 0xffu, b1 = (unsigned)((int)rintf(v[rr][j].y * inv)) & 0xffu, b2 = (unsigned)((int)rintf(v[rr][j].z * inv)) & 0xffu, b3 = (unsigned)((int)rintf(v[rr][j].w * inv)) & 0xffu;
                *(unsigned*)(TAB + (((size_t)t * 8 + 2 * j + (lane >> 5)) * 16384 + row) * 128 + 4 * (lane & 31)) = b0 | (b1 << 8) | (b2 << 16) | (b3 << 24); }
            }
            if (lane == 0) TSC[t * 16384 + row] = sc;
        }
    }
}

__device__ __forceinline__ void norm_mod_store(const f32x4 (&v)[4], float rinv, const float* g, const float* sh, const float* sc, bf16_t* orow, int lane) {
#pragma unroll
    for (int j = 0; j < 4; ++j) { const int c = 4 * lane + 256 * j;
        const f32x4 gg = *(const f32x4*)(g + c), s1 = *(const f32x4*)(sc + c), s0 = *(const f32x4*)(sh + c);
        const f32x4 y = (v[j] * rinv * gg) * (s1 + 1.f) + s0;
        u32x2 o; o.x = pk2(y.x, y.y); o.y = pk2(y.z, y.w); *(u32x2*)(orow + c) = o; }
}
__device__ __forceinline__ int tok_row(int layer, int n);
__device__ __forceinline__ void norm_row_out(const Frame& F, const f32x4 (&v)[4], float rinv, const float* g, const float* mm, int r, int which) {
    norm_mod_store(v, rinv, g, mm, mm + 1024, (bf16_t*)(F.ws + WS_H) + (size_t)r * DM, F.lane);
    if (which) {
        f32x4 y[4]; float am = 0.f;
#pragma unroll
        for (int j = 0; j < 4; ++j) { const int c = 4 * F.lane + 256 * j; y[j] = (v[j] * rinv * *(const f32x4*)(g + c)) * (*(const f32x4*)(mm + 1024 + c) + 1.f) + *(const f32x4*)(mm + c);
            am = fmaxf(am, fmaxf(fmaxf(fabsf(y[j].x), fabsf(y[j].y)), fmaxf(fabsf(y[j].z), fabsf(y[j].w)))); }
        am = wave_max(am);
        const float inv = am > 0.f ? 119.f / am : 0.f;
#pragma unroll
        for (int j = 0; j < 4; ++j) { const int h0 = (int)rintf(y[j].x * inv), h1 = (int)rintf(y[j].y * inv), h2 = (int)rintf(y[j].z * inv), h3 = (int)rintf(y[j].w * inv);
            const unsigned hh = (unsigned)(((h0 + 8) >> 4) & 15) | ((unsigned)(((h1 + 8) >> 4) & 15) << 4) | ((unsigned)(((h2 + 8) >> 4) & 15) << 8) | ((unsigned)(((h3 + 8) >> 4) & 15) << 12);
            const unsigned hl = (unsigned)(h0 & 15) | ((unsigned)(h1 & 15) << 4) | ((unsigned)(h2 & 15) << 8) | ((unsigned)(h3 & 15) << 12);
            const bool odd = (F.lane & 1) != 0;
            const unsigned recv = (unsigned)__builtin_amdgcn_update_dpp(0, (int)(odd ? hh : hl), 0xB1, 0xf, 0xf, false);
            *(unsigned*)(F.ws + WS_HQ + (size_t)r * DM + 256 * j + 4 * F.lane) = odd ? (recv | (hl << 16)) : (hh | (recv << 16)); }
        if (F.lane == 0) ((float*)(F.ws + WS_HS))[r] = am > 0.f ? am * (1.f / 119.f) : 1.f;
    }
}
__device__ __forceinline__ void p_norm_rows(const Args& A, const Frame& F, int layer, int which, bool from_input, bool skip_ctx) {
    const int gw = F.bid * NWAVES + F.wave, NGW = F.nblk * NWAVES;
    const float* g = A.in[layer ? (which ? I1_NFFN : I1_NMIX) : (which ? I0_NFFN : I0_NMIX)];
    const float* MOD = (const float*)(F.ws + WS_MOD) + (size_t)layer * 5 * 6144;
    const unsigned short* X = (const unsigned short*)(F.ws + WS_X);
    const int ntok = skip_ctx ? NB * SEQ : R;
    for (int n = gw; n < ntok; n += 2 * NGW) {
        const bool has1 = (n + NGW) < ntok;
        const int r0 = skip_ctx ? tok_row(1, n) : n, r1 = has1 ? (skip_ctx ? tok_row(1, n + NGW) : n + NGW) : r0;
        f32x4 v0[4], v1[4]; float s0 = 0.f, s1 = 0.f;
        if (from_input) { const float* x0 = xin_row(F, r0); const float* x1 = xin_row(F, r1);
#pragma unroll
            for (int j = 0; j < 4; ++j) { v0[j] = *(const f32x4*)(x0 + 4 * F.lane + 256 * j); v1[j] = *(const f32x4*)(x1 + 4 * F.lane + 256 * j); } }
        else {
#pragma unroll
            for (int j = 0; j < 4; ++j) { const u32x2 a = *(const u32x2*)(X + (size_t)r0 * DM + 4 * F.lane + 256 * j), b = *(const u32x2*)(X + (size_t)r1 * DM + 4 * F.lane + 256 * j);
                v0[j] = (f32x4){h2f_lo(a.x), h2f_hi(a.x), h2f_lo(a.y), h2f_hi(a.y)}; v1[j] = (f32x4){h2f_lo(b.x), h2f_hi(b.x), h2f_lo(b.y), h2f_hi(b.y)}; } }
#pragma unroll
        for (int j = 0; j < 4; ++j) { s0 += (v0[j].x * v0[j].x + v0[j].y * v0[j].y) + (v0[j].z * v0[j].z + v0[j].w * v0[j].w); s1 += (v1[j].x * v1[j].x + v1[j].y * v1[j].y) + (v1[j].z * v1[j].z + v1[j].w * v1[j].w); }
        const float ri0 = rsqrtf(wave_sum(s0) * (1.f / DM) + EPS), ri1 = rsqrtf(wave_sum(s1) * (1.f / DM) + EPS);
        norm_row_out(F, v0, ri0, g, MOD + (size_t)mod_index(r0) * 6144 + (which ? 3 * 1024 : 0), r0, which);
        if (has1) norm_row_out(F, v1, ri1, g, MOD + (size_t)mod_index(r1) * 6144 + (which ? 3 * 1024 : 0), r1, which);
    }
}

namespace pg8 {
#define PG8_LAS __attribute__((address_space(3)))
typedef unsigned short bf16_t;
typedef short bf16x8 __attribute__((ext_vector_type(8)));
typedef float f32x4 __attribute__((ext_vector_type(4)));
typedef unsigned u32x4 __attribute__((ext_vector_type(4)));
constexpr int BM = 256, BK = 64, HALF = 128, HTB = HALF * BK * 2  , STAGE_BYTES = 8 * HTB, NXCD = 8, WGM = 8;

__host__ __device__ __forceinline__ int lds_byte(int r, int c) { const int st = (r >> 4) * 2 + (c >> 5), rr = r & 15, cc = c & 31, ob = rr * 64 + cc * 2; return st * 1024 + (ob ^ (((ob >> 9) & 1) << 5)); }
__host__ __device__ __forceinline__ void stage_rc(int b, int& R, int& C) { const int st = b / 1024, sb = b % 1024, swz = sb ^ (((sb >> 9) & 1) << 5); R = (st >> 1) * 16 + swz / 64; C = (st & 1) * 32 + (swz % 64) / 2; }
__host__ __device__ __forceinline__ int perm32(int rho) { const int n = rho >> 4, i = rho & 15; return 8 * (i >> 2) + 4 * n + (i & 3); }

struct Unit { int pm, pn; };
struct Gemm { const bf16_t* A; const bf16_t* Bt; int M, N, K; };

struct StaticOrder {
    int nM, nN, nwg, G, c;
    __host__ __device__ void init(int M, int N, int G_, int c_) { nM = M / BM; nN = N / BM; nwg = nM * nN; G = G_; c = c_; }
    __host__ __device__ bool next(int i, Unit& u) const {
        const long L = (long)i * G + c; if (L >= nwg) return false;
        int wgid = (int)L; { const int q = nwg / NXCD, r = nwg % NXCD, xcd = wgid % NXCD, off = wgid / NXCD; wgid = (xcd < r ? xcd * (q + 1) : r * (q + 1) + (xcd - r) * q) + off; }
        const int nig = WGM * nN, gid = wgid / nig, fm = gid * WGM, gsz = (nM - fm) < WGM ? (nM - fm) : WGM;
        u.pm = fm + ((wgid % nig) % gsz); u.pn = (wgid % nig) / gsz; return true;
    }
    __device__ __forceinline__ void a_ready(const Unit&) const {}
    __device__ __forceinline__ void done(const Unit&) const {}
};

template <class Epi, class Sched, bool ALIGN_EPI = false, bool SP2 = false>
__device__ __forceinline__ void gemm_phase(PG8_LAS unsigned char* lds, const Gemm g, const Sched& S, const Epi& E) {
    const int tid = threadIdx.x, wid = __builtin_amdgcn_readfirstlane(tid >> 6), lane = tid & 63, wr = wid >> 2, wc = wid & 3, fr = lane & 15, fq = lane >> 4;
    const int K = g.K, nt = K / BK;
    unsigned voffA[2], voffB[2];
#pragma unroll
    for (int i = 0; i < 2; ++i) { int R, C; stage_rc(tid * 16 + i * 8192, R, C); const int Rb = Epi::PERM ? ((R & ~31) + perm32(R & 31)) : R;
        voffA[i] = (unsigned)(R * K + C) * 2u; voffB[i] = (unsigned)(Rb * K + C) * 2u; }
    const size_t kstep = (size_t)(BK * 2);
    const size_t hstep = (size_t)HALF * K * 2;
    const size_t tstep = 2 * hstep;
    const unsigned ldsw = (unsigned)wid * 1024u;
    const int aoff = lds_byte(wr * 64 + fr, fq * 8), boff = lds_byte(wc * 32 + fr, fq * 8);
#define PG8_SA(b, h) (((b) * 2 + (h)) * HTB)
#define PG8_SB(b, h) ((4 + (b) * 2 + (h)) * HTB)
#define PG8_STAGE(bufoff, gbase, voff) do { _Pragma("unroll") for (int _i = 0; _i < 2; ++_i) \
        __builtin_amdgcn_global_load_lds((const unsigned*)((const char*)(gbase) + (voff)[_i]), (PG8_LAS unsigned*)(lds + (bufoff) + ldsw + _i * 8192), 16, 0, 0); } while (0)
#define PG8_LDA(dst, b, h) do { _Pragma("unroll") for (int m = 0; m < 4; ++m) _Pragma("unroll") for (int k = 0; k < 2; ++k) dst[m][k] = *(const PG8_LAS bf16x8*)(lds + PG8_SA(b, h) + aoff + m * 2048 + k * 1024); } while (0)
#define PG8_LDB(dst, b, h) do { _Pragma("unroll") for (int n = 0; n < 2; ++n) _Pragma("unroll") for (int k = 0; k < 2; ++k) dst[n][k] = *(const PG8_LAS bf16x8*)(lds + PG8_SB(b, h) + boff + n * 2048 + k * 1024); } while (0)
#define PG8_MMA(ai, bj, At, Bt) do { __builtin_amdgcn_s_setprio(1); _Pragma("unroll") for (int m = 0; m < 4; ++m) _Pragma("unroll") for (int n = 0; n < 2; ++n) _Pragma("unroll") for (int k = 0; k < 2; ++k) \
        acc[ai][bj][m][n] = __builtin_amdgcn_mfma_f32_16x16x32_bf16(Bt[n][k], At[m][k], acc[ai][bj][m][n], 0, 0, 0); __builtin_amdgcn_s_setprio(0); } while (0)
#define PG8_WAIT_V(n) asm volatile("s_waitcnt vmcnt(" #n ")" ::: "memory")
#define PG8_WAIT_L(n) asm volatile("s_waitcnt lgkmcnt(" #n ")" ::: "memory")
#define PG8_BAR __builtin_amdgcn_s_barrier()
#define PG8_SCHED __builtin_amdgcn_sched_barrier(0)
    Unit cur, nxt; int ui = 0;
    if (!S.next(0, cur)) return;
    f32x4 acc[2][2][4][2];
#pragma unroll
    for (int a = 0; a < 2; ++a)
#pragma unroll
        for (int b = 0; b < 2; ++b)
#pragma unroll
            for (int m = 0; m < 4; ++m)
#pragma unroll
                for (int n = 0; n < 2; ++n) acc[a][b][m][n] = (f32x4){0.f, 0.f, 0.f, 0.f};
    bf16x8 At[4][2], B0[2][2], B1[2][2];
    const char* cA = (const char*)g.A + (size_t)cur.pm * tstep; const char* cB = (const char*)g.Bt + (size_t)cur.pn * tstep;
    S.a_ready(cur);
    if constexpr (SP2) {
        PG8_STAGE(PG8_SB(0, 0), cB, voffB); PG8_STAGE(PG8_SB(0, 1), cB + hstep, voffB); PG8_STAGE(PG8_SA(0, 0), cA, voffA); PG8_STAGE(PG8_SA(0, 1), cA + hstep, voffA);
        if (wr == 1) PG8_BAR;
        PG8_WAIT_V(2); PG8_BAR;
        PG8_STAGE(PG8_SB(1, 0), cB + kstep, voffB); PG8_STAGE(PG8_SA(1, 0), cA + kstep, voffA); PG8_STAGE(PG8_SB(1, 1), cB + hstep + kstep, voffB);
        PG8_WAIT_V(6); PG8_BAR;
    } else {
        PG8_STAGE(PG8_SB(0, 0), cB, voffB); PG8_STAGE(PG8_SA(0, 0), cA, voffA); PG8_STAGE(PG8_SB(0, 1), cB + hstep, voffB); PG8_STAGE(PG8_SA(0, 1), cA + hstep, voffA);
        if (wr == 1) PG8_BAR;
        PG8_WAIT_V(4); PG8_BAR;
        PG8_STAGE(PG8_SB(1, 0), cB + kstep, voffB); PG8_STAGE(PG8_SA(1, 0), cA + kstep, voffA); PG8_STAGE(PG8_SB(1, 1), cB + hstep + kstep, voffB);
        PG8_WAIT_V(6); PG8_BAR;
    }
    for (;;) {
        const bool has_next = S.next(ui + 1, nxt);
        const char* nA = has_next ? (const char*)g.A + (size_t)nxt.pm * tstep : cA; const char* nB = has_next ? (const char*)g.Bt + (size_t)nxt.pn * tstep : cB;
        for (int t = 0; t < nt; t += 2) {
            const bool last = (t == nt - 2);
            const char* a1 = cA + (size_t)(t + 1) * kstep;
            const char* a2 = last ? nA : cA + (size_t)(t + 2) * kstep; const char* b2 = last ? nB : cB + (size_t)(t + 2) * kstep;
            const char* a3 = a2 + kstep; const char* b3 = b2 + kstep;
            if (last && has_next) S.a_ready(nxt);
            if constexpr (SP2) {
            PG8_LDB(B0, 0, 0); PG8_LDB(B1, 0, 1); PG8_SCHED; PG8_LDA(At, 0, 0); PG8_STAGE(PG8_SA(1, 1), a1 + hstep, voffA);
            PG8_WAIT_V(8); PG8_WAIT_L(0); PG8_BAR; PG8_MMA(0, 0, At, B0); PG8_MMA(0, 1, At, B1); PG8_BAR; PG8_SCHED;
            PG8_LDA(At, 0, 1); PG8_STAGE(PG8_SB(0, 0), b2, voffB); PG8_STAGE(PG8_SB(0, 1), b2 + hstep, voffB); PG8_STAGE(PG8_SA(0, 0), a2, voffA);
            PG8_WAIT_V(8); PG8_WAIT_L(0); PG8_BAR; PG8_MMA(1, 0, At, B0); PG8_MMA(1, 1, At, B1); PG8_BAR; PG8_SCHED;
            PG8_LDB(B0, 1, 0); PG8_LDB(B1, 1, 1); PG8_SCHED; PG8_LDA(At, 1, 0); PG8_STAGE(PG8_SA(0, 1), a2 + hstep, voffA);
            PG8_WAIT_V(8); PG8_WAIT_L(0); PG8_BAR; PG8_MMA(0, 0, At, B0); PG8_MMA(0, 1, At, B1); PG8_BAR; PG8_SCHED;
            PG8_LDA(At, 1, 1); PG8_STAGE(PG8_SB(1, 0), b3, voffB); PG8_STAGE(PG8_SB(1, 1), b3 + hstep, voffB); PG8_STAGE(PG8_SA(1, 0), a3, voffA);
            PG8_WAIT_V(8); PG8_WAIT_L(0); PG8_BAR; PG8_MMA(1, 0, At, B0); PG8_MMA(1, 1, At, B1); PG8_BAR; PG8_SCHED;
            } else {
            PG8_LDB(B0, 0, 0); PG8_SCHED; PG8_LDA(At, 0, 0); PG8_STAGE(PG8_SA(1, 1), a1 + hstep, voffA);
            PG8_WAIT_L(8); PG8_BAR; PG8_WAIT_L(0); PG8_MMA(0, 0, At, B0); PG8_BAR; PG8_SCHED;
            PG8_LDB(B1, 0, 1); PG8_STAGE(PG8_SB(0, 0), b2, voffB);
            PG8_BAR; PG8_WAIT_L(0); PG8_MMA(0, 1, At, B1); PG8_BAR;
            PG8_LDA(At, 0, 1); PG8_STAGE(PG8_SA(0, 0), a2, voffA);
            PG8_BAR; PG8_WAIT_L(0); PG8_MMA(1, 0, At, B0); PG8_BAR; PG8_SCHED;
            PG8_STAGE(PG8_SB(0, 1), b2 + hstep, voffB);
            PG8_WAIT_V(6); PG8_BAR; PG8_MMA(1, 1, At, B1); PG8_BAR;
            PG8_LDB(B0, 1, 0); PG8_SCHED; PG8_LDA(At, 1, 0); PG8_STAGE(PG8_SA(0, 1), a2 + hstep, voffA);
            PG8_WAIT_L(8); PG8_BAR; PG8_WAIT_L(0); PG8_MMA(0, 0, At, B0); PG8_BAR; PG8_SCHED;
            PG8_LDB(B1, 1, 1); PG8_STAGE(PG8_SB(1, 0), b3, voffB);
            PG8_BAR; PG8_WAIT_L(0); PG8_MMA(0, 1, At, B1); PG8_BAR;
            PG8_LDA(At, 1, 1); PG8_STAGE(PG8_SA(1, 0), a3, voffA);
            PG8_BAR; PG8_WAIT_L(0); PG8_MMA(1, 0, At, B0); PG8_BAR; PG8_SCHED;
            PG8_STAGE(PG8_SB(1, 1), b3 + hstep, voffB);
            PG8_WAIT_V(6); PG8_BAR; PG8_MMA(1, 1, At, B1); PG8_BAR;
            }
        }
        if constexpr (ALIGN_EPI) { if (wr == 0) PG8_BAR; }
        if constexpr (!Epi::AFTER_DRAIN) { E(acc, cur, wr, wc, fr, fq); S.done(cur); }
        if (!has_next) break;
#pragma unroll
        for (int a = 0; a < 2; ++a)
#pragma unroll
            for (int b = 0; b < 2; ++b)
#pragma unroll
                for (int m = 0; m < 4; ++m)
#pragma unroll
                    for (int n = 0; n < 2; ++n) acc[a][b][m][n] = (f32x4){0.f, 0.f, 0.f, 0.f};
        cur = nxt; cA = nA; cB = nB; ++ui;
        if constexpr (ALIGN_EPI) { if (wr == 1) PG8_BAR; }
    }
    PG8_WAIT_V(0);
    if constexpr (!ALIGN_EPI) { if (wr == 0) PG8_BAR; }
    PG8_BAR;
    if constexpr (Epi::AFTER_DRAIN) { E.fused(acc, cur, wr, wc, fr, fq, lds, wid, lane); S.done(cur); }
#undef PG8_SA
#undef PG8_SB
#undef PG8_STAGE
#undef PG8_LDA
#undef PG8_LDB
#undef PG8_MMA
#undef PG8_WAIT_V
#undef PG8_WAIT_L
#undef PG8_BAR
#undef PG8_SCHED
}
}

template <class Inner> struct EpiTile { static constexpr bool PERM = true, AFTER_DRAIN = false; Inner in;
    __device__ __forceinline__ void operator()(const pg8::f32x4 (&acc)[2][2][4][2], const pg8::Unit& u, int wr, int wc, int fr, int fq) const {
#pragma unroll
        for (int ai = 0; ai < 2; ++ai)
#pragma unroll
            for (int m = 0; m < 4; ++m) { const int row = u.pm * 256 + ai * 128 + wr * 64 + m * 16 + fr;
#pragma unroll
                for (int bj = 0; bj < 2; ++bj) in(row, u.pn * 256 + bj * 128 + wc * 32 + 8 * fq, acc[ai][bj][m][0], acc[ai][bj][m][1]); }
    } };
struct In8Bf16 { bf16_t* C; int ldc;
    __device__ __forceinline__ void operator()(int row, int col, f32x4 a, f32x4 b) const { u32x4 o; o.x = cvtpk(a.x, a.y); o.y = cvtpk(a.z, a.w); o.z = cvtpk(b.x, b.y); o.w = cvtpk(b.z, b.w); *(u32x4*)(C + (size_t)row * ldc + col) = o; } };
struct In8KV { bf16_t* Kb; bf16_t* Vb;
    __device__ __forceinline__ void operator()(int row, int col, f32x4 a, f32x4 b) const { const int h = col >> 8, c = col & 255; u32x4 o; o.x = cvtpk(a.x, a.y); o.y = cvtpk(a.z, a.w); o.z = cvtpk(b.x, b.y); o.w = cvtpk(b.z, b.w);
        bf16_t* p = (c < 128) ? Kb + (size_t)row * 1536 + h * 192 + c : Vb + (size_t)row * 1024 + h * 128 + (c - 128);
        *(u32x4*)p = o; } };
struct In8F16 { unsigned short* C; int ldc;
    __device__ __forceinline__ void operator()(int row, int col, f32x4 a, f32x4 b) const { u32x4 o; o.x = pkh2(a.x, a.y); o.y = pkh2(a.z, a.w); o.z = pkh2(b.x, b.y); o.w = pkh2(b.z, b.w); *(u32x4*)(C + (size_t)row * ldc + col) = o; } };
struct In8F32 { float* C; int ldc;
    __device__ __forceinline__ void operator()(int row, int col, f32x4 a, f32x4 b) const { float* p = C + (size_t)row * ldc + col; *(f32x4*)p = a; *(f32x4*)(p + 4) = b; } };
struct In8Resid { const float* x; const float* ctx; unsigned short* X; const float* gate; bool from_input;
    __device__ __forceinline__ void operator()(int row, int col, f32x4 a, f32x4 b) const {
        const int bb = row / RPB, j = row - bb * RPB; unsigned short* xo = X + (size_t)row * DM + col;
        f32x4 x0, x1;
        if (from_input) { const float* xi = ((j < CTXL) ? ctx + ((size_t)bb * CTXL + j) * DM : x + ((size_t)bb * SEQ + (j - CTXL)) * DM) + col; x0 = *(const f32x4*)xi; x1 = *(const f32x4*)(xi + 4); }
        else { const u32x4 w = *(const u32x4*)xo; x0 = (f32x4){h2f_lo(w.x), h2f_hi(w.x), h2f_lo(w.y), h2f_hi(w.y)}; x1 = (f32x4){h2f_lo(w.z), h2f_hi(w.z), h2f_lo(w.w), h2f_hi(w.w)}; }
        const float* g = gate + (size_t)((j < CTXL) ? 4 : bb) * 6144 + col;
        x0 += *(const f32x4*)g * a; x1 += *(const f32x4*)(g + 4) * b;
        u32x4 o; o.x = pkh2(x0.x, x0.y); o.y = pkh2(x0.z, x0.w); o.z = pkh2(x1.x, x1.y); o.w = pkh2(x1.z, x1.w); *(u32x4*)xo = o; } };
struct EpiMlaDown { static constexpr bool PERM = true, AFTER_DRAIN = false; bf16_t* CQ; bf16_t* CKV; bf16_t* KR; float* SSP;
    __device__ __forceinline__ void operator()(const pg8::f32x4 (&acc)[2][2][4][2], const pg8::Unit& u, int wr, int wc, int fr, int fq) const {
#pragma unroll
        for (int ai = 0; ai < 2; ++ai)
#pragma unroll
            for (int m = 0; m < 4; ++m) { const int row = u.pm * 256 + ai * 128 + wr * 64 + m * 16 + fr;
#pragma unroll
                for (int bj = 0; bj < 2; ++bj) { const int col = u.pn * 256 + bj * 128 + wc * 32 + 8 * fq; const f32x4 a = acc[ai][bj][m][0], b = acc[ai][bj][m][1];
                    u32x4 o; o.x = cvtpk(a.x, a.y); o.y = cvtpk(a.z, a.w); o.z = cvtpk(b.x, b.y); o.w = cvtpk(b.z, b.w);
                    const int cls = (u.pn * 2 + bj);
                    if (cls < 5) { float sq = (a.x * a.x + a.y * a.y) + (a.z * a.z + a.w * a.w) + (b.x * b.x + b.y * b.y) + (b.z * b.z + b.w * b.w);
                        sq += __shfl_xor(sq, 16); sq += __shfl_xor(sq, 32);
                        if (cls < 3) *(u32x4*)(CQ + (size_t)row * 384 + col) = o; else *(u32x4*)(CKV + (size_t)row * 256 + (col - 384)) = o;
                        if (fq == 0) SSP[(size_t)row * 24 + cls * 4 + wc] = sq; }
                    else if (col < 704) *(u32x4*)(KR + (size_t)row * 64 + (col - 640)) = o; } }
    } };
struct In8Bf16Rs { bf16_t* C; int ldc; const float* ssp;
    __device__ __forceinline__ void operator()(int row, int col, f32x4 a, f32x4 b) const { const f32x4 s0 = *(const f32x4*)(ssp + (size_t)row * 24), s1 = *(const f32x4*)(ssp + (size_t)row * 24 + 4), s2 = *(const f32x4*)(ssp + (size_t)row * 24 + 8);
        const float ssum = (((s0.x + s0.y) + (s0.z + s0.w)) + ((s1.x + s1.y) + (s1.z + s1.w))) + ((s2.x + s2.y) + (s2.z + s2.w));
        const float rs = rsqrtf(ssum * (1.f / 384.f) + EPS); a *= rs; b *= rs;
        u32x4 o; o.x = cvtpk(a.x, a.y); o.y = cvtpk(a.z, a.w); o.z = cvtpk(b.x, b.y); o.w = cvtpk(b.z, b.w); *(u32x4*)(C + (size_t)row * ldc + col) = o; } };
struct In8KVRs { unsigned char* K8; bf16_t* Vb; const float* ssp;
    __device__ __forceinline__ void operator()(int row, int col, f32x4 a, f32x4 b) const { const f32x4 s0 = *(const f32x4*)(ssp + (size_t)row * 24 + 12), s1 = *(const f32x4*)(ssp + (size_t)row * 24 + 16);
        const float ssum = ((s0.x + s0.y) + (s0.z + s0.w)) + ((s1.x + s1.y) + (s1.z + s1.w));
        const float rs = rsqrtf(ssum * (1.f / 256.f) + EPS); a *= rs; b *= rs;
        const int h = col >> 8, c = col & 255;
        if (c < 128) { u32x2 o; o.x = f8x4(a.x, a.y, a.z, a.w); o.y = f8x4(b.x, b.y, b.z, b.w); *(u32x2*)(K8 + (size_t)row * 1536 + h * 192 + c) = o; }
        else { u32x4 o; o.x = cvtpk(a.x, a.y); o.y = cvtpk(a.z, a.w); o.z = cvtpk(b.x, b.y); o.w = cvtpk(b.z, b.w); *(u32x4*)(Vb + (size_t)row * 1024 + h * 128 + (c - 128)) = o; } } };
struct RowSched { pg8::StaticOrder so; bool latent_only;
    __device__ __forceinline__ void init(int N, int G, int c, bool lat) { latent_only = lat; so.init(lat ? NB * SEQ : R, N, G, c); }
    __device__ __forceinline__ bool next(int i, pg8::Unit& u) const { if (!so.next(i, u)) return false; if (latent_only) u.pm = (u.pm >> 4) * 17 + 1 + (u.pm & 15); return true; }
    __device__ __forceinline__ void a_ready(const pg8::Unit&) const {}
    __device__ __forceinline__ void done(const pg8::Unit&) const {} };
template <class Inner> __device__ __forceinline__ void gemm8(const Frame& F, const bf16_t* Ap, const bf16_t* Bt, int N, int K, bool latent_only, const Inner& in, bool reverse = false) {
    asm volatile("" : "+s"(K));
    pg8::Gemm g{Ap, Bt, R, N, K}; RowSched S; S.init(N, F.nblk, reverse ? F.nblk - 1 - F.bid : F.bid, latent_only);
    EpiTile<Inner> E{in};
    pg8::gemm_phase<EpiTile<Inner>, RowSched, true, true>((PG8_LAS unsigned char*)F.lds, g, S, E);
}

template <class Epi> __device__ __forceinline__ void gemm8e(const Frame& F, const bf16_t* Ap, const bf16_t* Bt, int N, int K, bool latent_only, const Epi& E) {
    asm volatile("" : "+s"(K));
    pg8::Gemm g{Ap, Bt, R, N, K}; RowSched S; S.init(N, F.nblk, F.bid, latent_only);
    pg8::gemm_phase<Epi, RowSched, true, true>((PG8_LAS unsigned char*)F.lds, g, S, E);
}

struct GemmDesc { const bf16_t* A; int lda; long sA; const bf16_t* Bt; int ldb; long sB; int M, N, K, nz; };
template <class Epi>
__device__ __forceinline__ void gemm_simple(const Frame& F, const GemmDesc& g, const Epi& epi, bool skip_ctx) {
    const int wm = F.wave >> 1, wn = F.wave & 1, fr = F.lane & 15, fq = F.lane >> 4;
    const int tM = g.M / 128, tN = g.N / 128, per = tM * tN, total = per * g.nz;
    for (int u = F.bid; u < total; u += F.nblk) {
        const int z = u / per, uu = u - z * per, tm = uu / tN, tn = uu - tm * tN;
        if (skip_ctx && ((tm * 128) % RPB) < CTXL) continue;
        const int row0 = tm * 128 + wm * 32, col0 = tn * 128 + wn * 64;
        const bf16_t* ap = g.A + z * g.sA + (size_t)(row0 + fr) * g.lda + fq * 8;
        const bf16_t* bp = g.Bt + z * g.sB + (size_t)(col0 + fr) * g.ldb + fq * 8;
        f32x4 acc[2][4];
#pragma unroll
        for (int mi = 0; mi < 2; ++mi)
#pragma unroll
            for (int ni = 0; ni < 4; ++ni) acc[mi][ni] = (f32x4){0.f, 0.f, 0.f, 0.f};
        for (int k0 = 0; k0 < g.K; k0 += 32) {
            bf16x8 a[2], b[4];
#pragma unroll
            for (int mi = 0; mi < 2; ++mi) a[mi] = *(const bf16x8*)(ap + (size_t)mi * 16 * g.lda + k0);
#pragma unroll
            for (int ni = 0; ni < 4; ++ni) b[ni] = *(const bf16x8*)(bp + (size_t)ni * 16 * g.ldb + k0);
#pragma unroll
            for (int mi = 0; mi < 2; ++mi)
#pragma unroll
                for (int ni = 0; ni < 4; ++ni) acc[mi][ni] = __builtin_amdgcn_mfma_f32_16x16x32_bf16(b[ni], a[mi], acc[mi][ni], 0, 0, 0);
        }
#pragma unroll
        for (int mi = 0; mi < 2; ++mi)
#pragma unroll
            for (int ni = 0; ni < 4; ++ni) epi(z, row0 + mi * 16 + fr, col0 + ni * 16 + fq * 4, acc[mi][ni]);
    }
}
struct EpiBf16 { bf16_t* C; int ldc;
    __device__ __forceinline__ void operator()(int, int row, int col, f32x4 v) const { u32x2 o; o.x = pk2(v.x, v.y); o.y = pk2(v.z, v.w); *(u32x2*)(C + (size_t)row * ldc + col) = o; } };
struct EpiKV { bf16_t* Kb; bf16_t* Vb;
    __device__ __forceinline__ void operator()(int, int row, int col, f32x4 v) const { const int h = col >> 8, c = col & 255; u32x2 o; o.x = pk2(v.x, v.y); o.y = pk2(v.z, v.w);
        if (c < 128) *(u32x2*)(Kb + (size_t)row * 1536 + h * 192 + c) = o; else *(u32x2*)(Vb + (size_t)row * 1024 + h * 128 + (c - 128)) = o; } };
struct EpiF32Z { float* C; int ldc;
    __device__ __forceinline__ void operator()(int z, int row, int col, f32x4 v) const { *(f32x4*)(C + (size_t)row * ldc + z * 128 + col) = v; } };
struct EpiResid { const Frame* F; const float* gate; bool from_input;
    __device__ __forceinline__ void operator()(int, int row, int col, f32x4 v) const {
        float* X = (float*)(F->ws + WS_X) + (size_t)row * DM + col;
        const float* xi = from_input ? xin_row(*F, row) + col : X;
        const f32x4 g = *(const f32x4*)(gate + (size_t)mod_index(row) * 6144 + col);
        *(f32x4*)X = *(const f32x4*)xi + g * v; } };

__device__ __forceinline__ void rope_angles(int r, int& prow, int& pcol) { const int t = (r % RPB) - CTXL; prow = t >> 6; pcol = t & 63; }
__device__ __forceinline__ void p_mla_krope(const Args& A, const Frame& F) {
    const int gw = F.bid * NWAVES + F.wave, NGW = F.nblk * NWAVES, lane = F.lane;
    const bf16_t* KR = (const bf16_t*)(F.ws + WS_KR); unsigned char* K8 = F.ws + WS_K;
    const float invf = __powf(10000.f, -(float)(lane & 15) * (1.f / 16.f));
    for (int r = gw; r < R; r += NGW) {
        float kr = bf2f(KR[(size_t)r * 64 + lane]);
        if (!is_ctx_row(r)) {
            int prow, pcol; rope_angles(r, prow, pcol);
            const float ang = (float)((lane & 32) ? pcol : prow) * invf;
            const float cs = cosf(ang), sn = sinf(ang);
            const float partner = __shfl_xor(kr, 16);
            kr = kr * cs + ((lane & 16) ? partner : -partner) * sn;
        }
        const unsigned char kb = (unsigned char)(f8x4(kr, kr, kr, kr) & 0xffu);
#pragma unroll
        for (int h = 0; h < 8; ++h) K8[(size_t)r * 1536 + h * 192 + 128 + lane] = kb;
    }
}
__device__ __forceinline__ float row16_sum(float v) { v += WDPP(v, 0xB1); v += WDPP(v, 0x4E); v += WDPP(v, 0x141); v += WDPP(v, 0x140); return v; }
__device__ __forceinline__ void p_gqa_rows(const Args& A, const Frame& F) {
    const int gw = F.bid * NWAVES + F.wave, NGW = F.nblk * NWAVES, lane = F.lane, c16 = lane & 15, hrow = lane >> 4;
    const bf16_t* RAW = (const bf16_t*)(F.ws + WS_RAW1); bf16_t* Q1 = (bf16_t*)(F.ws + WS_Q1); unsigned char* K18 = F.ws + WS_K1; bf16_t* V1 = (bf16_t*)(F.ws + WS_V1);
    float qg[8], kg[8], invf[8];
#pragma unroll
    for (int e = 0; e < 8; ++e) { qg[e] = A.in[I1_QN][8 * c16 + e]; kg[e] = A.in[I1_KN][8 * c16 + e]; invf[e] = __powf(10000.f, -(float)(8 * (c16 & 3) + e) * (1.f / 32.f)); }
    const bool colaxis = (c16 & 8) != 0, hi32 = (c16 & 4) != 0;
    for (int r = gw; r < R; r += NGW) {
        const bool ctx = is_ctx_row(r);
        const bf16_t* a = RAW + (size_t)r * 1536 + 8 * lane;
        u32x4 ch[3];
#pragma unroll
        for (int j = 0; j < 3; ++j) ch[j] = (ctx && j < 2) ? (u32x4){0u, 0u, 0u, 0u} : *(const u32x4*)(a + 512 * j);
        float cs[8], sn[8];
        { int prow = 0, pcol = 0; if (!ctx) rope_angles(r, prow, pcol); const float pos = (float)(colaxis ? pcol : prow);
#pragma unroll
          for (int e = 0; e < 8; ++e) { const float ang = pos * invf[e]; cs[e] = ctx ? 1.f : __cosf(ang); sn[e] = ctx ? 0.f : __sinf(ang); } }
#pragma unroll
        for (int j = 0; j < 3; ++j) {
            if (ctx && j < 2) continue;
            const bool isv = (j == 2) && (hrow >= 2);
            float x[8];
#pragma unroll
            for (int d = 0; d < 4; ++d) { x[2 * d] = bflo(ch[j][d]); x[2 * d + 1] = bfhi(ch[j][d]); }
            float sq = 0.f;
#pragma unroll
            for (int e = 0; e < 8; ++e) sq += x[e] * x[e];
            const float rinv = rsqrtf(row16_sum(sq) * (1.f / 128.f) + EPS);
            u32x4 o;
            float y[8];
#pragma unroll
            for (int e = 0; e < 8; ++e) y[e] = x[e] * rinv * (j < 2 ? qg[e] : kg[e]);
            u32x4 yp; yp.x = pk2(y[0], y[1]); yp.y = pk2(y[2], y[3]); yp.z = pk2(y[4], y[5]); yp.w = pk2(y[6], y[7]);
            float pr[8];
#pragma unroll
            for (int d = 0; d < 4; ++d) { const float lo = __shfl_xor(y[2 * d], 4), hi2 = __shfl_xor(y[2 * d + 1], 4); pr[2 * d] = lo; pr[2 * d + 1] = hi2; }
            float z[8];
#pragma unroll
            for (int e = 0; e < 8; ++e) z[e] = y[e] * cs[e] + (hi32 ? pr[e] : -pr[e]) * sn[e];
            o.x = pk2(z[0], z[1]); o.y = pk2(z[2], z[3]); o.z = pk2(z[4], z[5]); o.w = pk2(z[6], z[7]);
            (void)yp;
            if (isv) o = ch[j];
            if (j < 2) *(u32x4*)(Q1 + (size_t)r * 1024 + 512 * j + 8 * lane) = o;
            else if (hrow < 2) { u32x2 o8; o8.x = f8x4(z[0], z[1], z[2], z[3]); o8.y = f8x4(z[4], z[5], z[6], z[7]); *(u32x2*)(K18 + (size_t)r * 256 + 8 * lane) = o8; }
            else *(u32x4*)(V1 + (size_t)r * 256 + 8 * (lane - 32)) = o;
        }
    }
}

__device__ __forceinline__ int crow(int r, int hi) { return (r & 3) + 8 * (r >> 2) + 4 * hi; }
__device__ __forceinline__ int v_st(int k, int c) { const int kk = (k & ~0xC) | ((k & 4) << 1) | ((k & 8) >> 1); return ((kk >> 3) * 4 + (c >> 5)) * 512 + ((kk & 7) * 32 + (c & 31)) * 2; }
__device__ __forceinline__ int v_rd_base(int lane) { return ((lane & 3) << 3) | (((lane >> 2) & 3) << 6) | (((lane >> 4) & 1) << 5) | (((lane >> 5) & 1) << 8); }
constexpr int v_rd_off(int d0, int ks, int half) { return d0 * 512 + ks * 4096 + half * 2048; }
template <int OFF> __device__ __forceinline__ s16x4 tr_read(int vb) { s16x4 r; asm volatile("ds_read_b64_tr_b16 %0, %1 offset:%2" : "=&v"(r) : "v"(vb), "i"(OFF) : "memory"); return r; }
template <int D0> __device__ __forceinline__ void pv_one(f32x16& od, int vb, bf16x8 pa0, bf16x8 pa1, bf16x8 pa2, bf16x8 pa3) {
    const s16x4 l0 = tr_read<v_rd_off(D0, 0, 0)>(vb), h0 = tr_read<v_rd_off(D0, 0, 1)>(vb), l1 = tr_read<v_rd_off(D0, 1, 0)>(vb), h1 = tr_read<v_rd_off(D0, 1, 1)>(vb);
    const s16x4 l2 = tr_read<v_rd_off(D0, 2, 0)>(vb), h2 = tr_read<v_rd_off(D0, 2, 1)>(vb), l3 = tr_read<v_rd_off(D0, 3, 0)>(vb), h3 = tr_read<v_rd_off(D0, 3, 1)>(vb);
    asm volatile("s_waitcnt lgkmcnt(0)" ::: "memory"); SBAR();
#define PK(L, H) (bf16x8){L[0], L[1], L[2], L[3], H[0], H[1], H[2], H[3]}
    od = __builtin_amdgcn_mfma_f32_32x32x16_bf16(pa0, PK(l0, h0), od, 0, 0, 0);
    od = __builtin_amdgcn_mfma_f32_32x32x16_bf16(pa1, PK(l1, h1), od, 0, 0, 0);
    od = __builtin_amdgcn_mfma_f32_32x32x16_bf16(pa2, PK(l2, h2), od, 0, 0, 0);
    od = __builtin_amdgcn_mfma_f32_32x32x16_bf16(pa3, PK(l3, h3), od, 0, 0, 0);
#undef PK
}
__device__ __forceinline__ void pv_d0(f32x16* o, int vb, bf16x8 pa0, bf16x8 pa1, bf16x8 pa2, bf16x8 pa3) {
    pv_one<0>(o[0], vb, pa0, pa1, pa2, pa3); pv_one<1>(o[1], vb, pa0, pa1, pa2, pa3); pv_one<2>(o[2], vb, pa0, pa1, pa2, pa3); pv_one<3>(o[3], vb, pa0, pa1, pa2, pa3);
}
constexpr float ATT_THR = 8.f;
__device__ __forceinline__ void partialSM(f32x16& p0, f32x16& p1, float& m_reg, float& mn, float& alpha, float C, float thr_raw) {
    float pmax = p0[0];
#pragma unroll
    for (int r = 1; r < 16; ++r) pmax = fmaxf(pmax, p0[r]);
#pragma unroll
    for (int r = 0; r < 16; ++r) pmax = fmaxf(pmax, p1[r]);
    { auto rr = __builtin_amdgcn_permlane32_swap(__float_as_uint(pmax), __float_as_uint(pmax), false, false);
      pmax = fmaxf(__uint_as_float(rr[0]), __uint_as_float(rr[1])); }
    if (__builtin_expect(__all(pmax - m_reg <= thr_raw), 1)) { mn = m_reg; alpha = 1.f; }
    else { mn = fmaxf(m_reg, pmax); alpha = __builtin_amdgcn_exp2f((m_reg - mn) * C); m_reg = mn; }
    const float mnC = -mn * C;
#pragma unroll
    for (int r = 0; r < 16; ++r) p0[r] = fmaf(p0[r], C, mnC);
#pragma unroll
    for (int r = 0; r < 16; ++r) p1[r] = fmaf(p1[r], C, mnC);
#pragma unroll
    for (int r = 0; r < 16; ++r) p0[r] = __builtin_amdgcn_exp2f(p0[r]);
}
__device__ __forceinline__ void finishSM(f32x16& p0, f32x16& p1, float alpha, float& l_reg, bf16x8& pa0, bf16x8& pa1, bf16x8& pa2, bf16x8& pa3) {
#pragma unroll
    for (int r = 0; r < 16; ++r) p1[r] = __builtin_amdgcn_exp2f(p1[r]);
    float ps = 0;
#pragma unroll
    for (int r = 0; r < 16; ++r) ps += p0[r];
#pragma unroll
    for (int r = 0; r < 16; ++r) ps += p1[r];
    { auto rr = __builtin_amdgcn_permlane32_swap(__float_as_uint(ps), __float_as_uint(ps), false, false);
      ps = __uint_as_float(rr[0]) + __uint_as_float(rr[1]); }
    l_reg = l_reg * alpha + ps;
#define PK4(P, BASE, OUT) do { unsigned a0 = cvtpk(P[BASE + 0], P[BASE + 1]), a1 = cvtpk(P[BASE + 2], P[BASE + 3]);   \
    unsigned b0 = cvtpk(P[BASE + 4], P[BASE + 5]), b1 = cvtpk(P[BASE + 6], P[BASE + 7]);                              \
    auto r0 = __builtin_amdgcn_permlane32_swap(a0, b0, false, false); auto r1 = __builtin_amdgcn_permlane32_swap(a1, b1, false, false); \
    u32x4 w = {r0[0], r1[0], r0[1], r1[1]}; OUT = *reinterpret_cast<bf16x8*>(&w); } while (0)
    PK4(p0, 0, pa0); PK4(p0, 8, pa1); PK4(p1, 0, pa2); PK4(p1, 8, pa3);
#undef PK4
}
template <int DQK> __device__ __forceinline__ void qkt(f32x16& p0, f32x16& p1, const char* Ks, const bf16x8* qr, int r32, int hi) {
    constexpr int KP = DQK * 2 + 16;
    p0 = f32x16{}; p1 = f32x16{};
#pragma unroll
    for (int d0 = 0; d0 < DQK / 16; ++d0) { const int cb = (d0 * 16 + hi * 8) * 2;
        const bf16x8 b0 = *reinterpret_cast<const bf16x8*>(Ks + r32 * KP + cb);
        const bf16x8 b1 = *reinterpret_cast<const bf16x8*>(Ks + (32 + r32) * KP + cb);
        p0 = __builtin_amdgcn_mfma_f32_32x32x16_bf16(b0, qr[d0], p0, 0, 0, 0);
        p1 = __builtin_amdgcn_mfma_f32_32x32x16_bf16(b1, qr[d0], p1, 0, 0, 0); }
}
template <int DQK> constexpr int att_lds_bytes() { return 2 * 64 * 128 * 2 + 2 * 64 * (DQK * 2 + 16) + NWAVES * 64 * 4; }
template <int DQK, int LDQ, int LDK, int LDV, int LDO>
__device__ __forceinline__ void attn_body(const bf16_t* __restrict__ Qb, const bf16_t* __restrict__ Kh, const bf16_t* __restrict__ Vh, bf16_t* __restrict__ Ob, int seq, float scale, char* lds) {
    constexpr int KP = DQK * 2 + 16, SHM_V = 64 * 128 * 2, SHM_K = 64 * KP, ND = DQK / 16, CH = DQK / 8, NKL = CH * 64 / NTHREADS;
    const float C = scale * 1.4426950408889634f, thr_raw = ATT_THR / scale;
    const int tid = threadIdx.x, wid = tid >> 6, lane = tid & 63, r32 = lane & 31, hi = lane >> 5;
    char* V_lds = lds; char* K_lds = lds + 2 * SHM_V;
    float* wsf = (float*)(lds + 2 * SHM_V + 2 * SHM_K) + wid * 64; float* li_l = wsf; float* al_l = wsf + 32;
    float m_reg = -1e30f, l_reg = 0; f32x16 o[4] = {}; bf16x8 qr[ND];
    const bf16_t* Qw = Qb + (long)(wid * 32 + r32) * LDQ + hi * 8;
#pragma unroll
    for (int d0 = 0; d0 < ND; ++d0) qr[d0] = *reinterpret_cast<const bf16x8*>(Qw + d0 * 16);
    const int sr = tid >> 4, sc = (tid & 15) * 8, vst0 = v_st(sr, sc), vst1 = v_st(32 + sr, sc);
    static_assert(DQK == 128, "double-pipelined body: 128-wide q.k only");
    const int vb0 = (int)(uintptr_t)V_lds + v_rd_base(lane);
    bf16x8 vs0, vs1, ks[NKL];
#define SLOAD(k0) do { vs0 = *reinterpret_cast<const bf16x8*>(&Vh[(long)((k0) + sr) * LDV + sc]); vs1 = *reinterpret_cast<const bf16x8*>(&Vh[(long)((k0) + 32 + sr) * LDV + sc]); \
    _Pragma("unroll") for (int i_ = 0; i_ < NKL; ++i_) ks[i_] = *reinterpret_cast<const bf16x8*>(&Kh[(long)((k0) + sr + 32 * i_) * LDK + sc]); } while (0)
#define SWRITE(b) do { *(bf16x8*)(V_lds + (b) * SHM_V + vst0) = vs0; *(bf16x8*)(V_lds + (b) * SHM_V + vst1) = vs1; \
    _Pragma("unroll") for (int i_ = 0; i_ < NKL; ++i_) *(bf16x8*)(K_lds + (b) * SHM_K + (sr + 32 * i_) * KP + sc * 2) = ks[i_]; } while (0)
#define RESC(a) do { if (__any((a) < 1.f)) { if (hi == 0) al_l[r32] = (a); asm volatile("s_waitcnt lgkmcnt(0)" ::: "memory"); \
    _Pragma("unroll") for (int d = 0; d < 4; ++d) _Pragma("unroll") for (int r = 0; r < 16; ++r) o[d][r] *= al_l[crow(r, hi)]; } } while (0)
    f32x16 pA0, pA1, pB0, pB1; float mnA, mnB, alA, alB; bf16x8 pa0, pa1, pa2, pa3; const int NT = seq / 64;
    SLOAD(0); asm volatile("s_waitcnt vmcnt(0)" ::: "memory"); SWRITE(0); __syncthreads();
    qkt<DQK>(pA0, pA1, K_lds, qr, r32, hi); partialSM(pA0, pA1, m_reg, mnA, alA, C, thr_raw);
    SLOAD(64);
    asm volatile("s_waitcnt vmcnt(0)" ::: "memory"); SWRITE(1); __syncthreads();
    for (int j = 1; j + 1 < NT; j += 2) {
        SBAR(); qkt<DQK>(pB0, pB1, K_lds + SHM_K, qr, r32, hi);
        finishSM(pA0, pA1, alA, l_reg, pa0, pa1, pa2, pa3); SBAR();
        SLOAD((j + 1) * 64); SBAR();
        pv_d0(o, vb0, pa0, pa1, pa2, pa3); partialSM(pB0, pB1, m_reg, mnB, alB, C, thr_raw);
        __syncthreads(); asm volatile("s_waitcnt vmcnt(0)" ::: "memory"); SWRITE(0);
        RESC(alB); __syncthreads();
        SBAR(); qkt<DQK>(pA0, pA1, K_lds, qr, r32, hi);
        finishSM(pB0, pB1, alB, l_reg, pa0, pa1, pa2, pa3); SBAR();
        SLOAD((j + 2) * 64); SBAR();
        pv_d0(o, vb0 + SHM_V, pa0, pa1, pa2, pa3); partialSM(pA0, pA1, m_reg, mnA, alA, C, thr_raw);
        __syncthreads(); asm volatile("s_waitcnt vmcnt(0)" ::: "memory"); SWRITE(1);
        RESC(alA); __syncthreads();
    }
    SBAR(); qkt<DQK>(pB0, pB1, K_lds + SHM_K, qr, r32, hi);
    finishSM(pA0, pA1, alA, l_reg, pa0, pa1, pa2, pa3); SBAR();
    pv_d0(o, vb0, pa0, pa1, pa2, pa3); partialSM(pB0, pB1, m_reg, mnB, alB, C, thr_raw);
    __syncthreads(); RESC(alB);
    finishSM(pB0, pB1, alB, l_reg, pa0, pa1, pa2, pa3); SBAR();
    pv_d0(o, vb0 + SHM_V, pa0, pa1, pa2, pa3);
    if (hi == 0) li_l[r32] = l_reg; asm volatile("s_waitcnt lgkmcnt(0)" ::: "memory");
    float rli[16];
#pragma unroll
    for (int r = 0; r < 16; ++r) rli[r] = __builtin_amdgcn_rcpf(li_l[crow(r, hi)]);
    bf16_t* Ow = Ob + (long)(wid * 32) * LDO;
#pragma unroll
    for (int r = 0; r < 16; ++r) { const int orow = crow(r, hi);
#pragma unroll
        for (int d0 = 0; d0 < 4; ++d0) Ow[(long)orow * LDO + d0 * 32 + r32] = (bf16_t)f2bf(o[d0][r] * rli[r]); }
    __syncthreads();
#undef SLOAD
#undef SWRITE
#undef RESC
}
template <int DQK, int LDQ, int LDK, int LDV, int LDO>
__device__ __forceinline__ void attn_body_single(const bf16_t* __restrict__ Qb, const bf16_t* __restrict__ Kh, const bf16_t* __restrict__ Vh, bf16_t* __restrict__ Ob, int seq, float scale, char* lds, int rope_t0) {
    constexpr int KP = DQK * 2 + 16, SHM_V = 64 * 128 * 2, SHM_K = 64 * KP, ND = DQK / 16, CH = DQK / 8, NKL = CH * 64 / NTHREADS;
    const float C = scale * 1.4426950408889634f, thr_raw = ATT_THR / scale;
    const int tid = threadIdx.x, wid = tid >> 6, lane = tid & 63, r32 = lane & 31, hi = lane >> 5;
    char* V_lds = lds; char* K_lds = lds + 2 * SHM_V;
    float* wsf = (float*)(lds + 2 * SHM_V + 2 * SHM_K) + wid * 64; float* li_l = wsf; float* al_l = wsf + 32;
    float m_reg = -1e30f, l_reg = 0; f32x16 o[4] = {}; bf16x8 qr[ND];
    const bf16_t* Qw = Qb + (long)(wid * 32 + r32) * LDQ + hi * 8;
#pragma unroll
    for (int d0 = 8; d0 < ND; ++d0) qr[d0] = *reinterpret_cast<const bf16x8*>(Qw + d0 * 16);
    if constexpr (DQK == 192) {
        if (rope_t0 >= 0) {
            const int tq = rope_t0 + wid * 32 + r32; const float prow = (float)(tq >> 6), pcol = (float)(tq & 63);
            u32x4 fa1 = __builtin_bit_cast(u32x4, qr[8]), fa2 = __builtin_bit_cast(u32x4, qr[9]), fb1 = __builtin_bit_cast(u32x4, qr[10]), fb2 = __builtin_bit_cast(u32x4, qr[11]);
#pragma unroll
            for (int jj = 0; jj < 4; ++jj) {
                float na1[2], na2[2], nb1[2], nb2[2];
#pragma unroll
                for (int e = 0; e < 2; ++e) { const float invf = __powf(10000.f, -(float)(hi * 8 + 2 * jj + e) * (1.f / 16.f));
                    const float ar = prow * invf, ac = pcol * invf, cr = __cosf(ar), sr_ = __sinf(ar), cc = __cosf(ac), sc_ = __sinf(ac);
                    const float a1 = e ? bfhi(fa1[jj]) : bflo(fa1[jj]), a2 = e ? bfhi(fa2[jj]) : bflo(fa2[jj]), b1 = e ? bfhi(fb1[jj]) : bflo(fb1[jj]), b2 = e ? bfhi(fb2[jj]) : bflo(fb2[jj]);
                    na1[e] = a1 * cr - a2 * sr_; na2[e] = a2 * cr + a1 * sr_; nb1[e] = b1 * cc - b2 * sc_; nb2[e] = b2 * cc + b1 * sc_; }
                fa1[jj] = pk2(na1[0], na1[1]); fa2[jj] = pk2(na2[0], na2[1]); fb1[jj] = pk2(nb1[0], nb1[1]); fb2[jj] = pk2(nb2[0], nb2[1]);
            }
            qr[8] = __builtin_bit_cast(bf16x8, fa1); qr[9] = __builtin_bit_cast(bf16x8, fa2); qr[10] = __builtin_bit_cast(bf16x8, fb1); qr[11] = __builtin_bit_cast(bf16x8, fb2);
        }
    }
    asm volatile("" ::: "memory");
#pragma unroll
    for (int d0 = 0; d0 < 8; ++d0) qr[d0] = *reinterpret_cast<const bf16x8*>(Qw + d0 * 16);
    const int sr = tid >> 4, sc = (tid & 15) * 8, vst0 = v_st(sr, sc), vst1 = v_st(32 + sr, sc);
    int krow[NKL], kch[NKL];
#pragma unroll
    for (int i = 0; i < NKL; ++i) { const int id = tid + i * NTHREADS; krow[i] = id / CH; kch[i] = id % CH; }
    const int vb0 = (int)(uintptr_t)V_lds + v_rd_base(lane);
    bf16x8 vs0, vs1, ks[NKL];
#define SLOAD(k0) do { vs0 = *reinterpret_cast<const bf16x8*>(&Vh[(long)((k0) + sr) * LDV + sc]); vs1 = *reinterpret_cast<const bf16x8*>(&Vh[(long)((k0) + 32 + sr) * LDV + sc]); \
    _Pragma("unroll") for (int i_ = 0; i_ < NKL; ++i_) ks[i_] = *reinterpret_cast<const bf16x8*>(&Kh[(long)((k0) + krow[i_]) * LDK + kch[i_] * 8]); } while (0)
#define SWRITE(b) do { *(bf16x8*)(V_lds + (b) * SHM_V + vst0) = vs0; *(bf16x8*)(V_lds + (b) * SHM_V + vst1) = vs1; \
    _Pragma("unroll") for (int i_ = 0; i_ < NKL; ++i_) *(bf16x8*)(K_lds + (b) * SHM_K + krow[i_] * KP + kch[i_] * 16) = ks[i_]; } while (0)
#define RESC(a) do { if (__any((a) < 1.f)) { if (hi == 0) al_l[r32] = (a); asm volatile("s_waitcnt lgkmcnt(0)" ::: "memory"); \
    _Pragma("unroll") for (int d = 0; d < 4; ++d) _Pragma("unroll") for (int r = 0; r < 16; ++r) o[d][r] *= al_l[crow(r, hi)]; } } while (0)
    f32x16 p0, p1; float mn, al; bf16x8 pa0, pa1, pa2, pa3; const int NT = seq / 64;
    SLOAD(0); asm volatile("s_waitcnt vmcnt(0)" ::: "memory"); SWRITE(0); __syncthreads();
    SLOAD(64);
    for (int j = 0; j < NT; ++j) {
        const int b = j & 1;
        SBAR(); qkt<DQK>(p0, p1, K_lds + b * SHM_K, qr, r32, hi);
        partialSM(p0, p1, m_reg, mn, al, C, thr_raw);
        RESC(al);
        finishSM(p0, p1, al, l_reg, pa0, pa1, pa2, pa3); SBAR();
        pv_d0(o, vb0 + b * SHM_V, pa0, pa1, pa2, pa3);
        if (j + 1 < NT) { asm volatile("s_waitcnt vmcnt(0)" ::: "memory"); SWRITE(b ^ 1); }
        __syncthreads();
        if (j + 2 < NT) SLOAD((j + 2) * 64);
    }
    if (hi == 0) li_l[r32] = l_reg; asm volatile("s_waitcnt lgkmcnt(0)" ::: "memory");
    float rli[16];
#pragma unroll
    for (int r = 0; r < 16; ++r) rli[r] = __builtin_amdgcn_rcpf(li_l[crow(r, hi)]);
    bf16_t* Ow = Ob + (long)(wid * 32) * LDO;
#pragma unroll
    for (int r = 0; r < 16; ++r) { const int orow = crow(r, hi);
#pragma unroll
        for (int d0 = 0; d0 < 4; ++d0) Ow[(long)orow * LDO + d0 * 32 + r32] = (bf16_t)f2bf(o[d0][r] * rli[r]); }
    __syncthreads();
#undef SLOAD
#undef SWRITE
#undef RESC
}
#define F8_ONE 0x7f7f7f7f
template <int DQK> __device__ __forceinline__ void qkt8(f32x16& p0, f32x16& p1, const char* Ks, const i32x8* qr, int r32, int hi) {
    constexpr int KP = DQK + 16;
    p0 = f32x16{}; p1 = f32x16{};
#pragma unroll
    for (int c = 0; c < DQK / 64; ++c) { const int cb = c * 64 + hi * 32;
        const u32x4 a0 = *reinterpret_cast<const u32x4*>(Ks + r32 * KP + cb), a1 = *reinterpret_cast<const u32x4*>(Ks + r32 * KP + cb + 16);
        const u32x4 b0 = *reinterpret_cast<const u32x4*>(Ks + (32 + r32) * KP + cb), b1 = *reinterpret_cast<const u32x4*>(Ks + (32 + r32) * KP + cb + 16);
        const i32x8 A = {(int)a0.x, (int)a0.y, (int)a0.z, (int)a0.w, (int)a1.x, (int)a1.y, (int)a1.z, (int)a1.w}, B = {(int)b0.x, (int)b0.y, (int)b0.z, (int)b0.w, (int)b1.x, (int)b1.y, (int)b1.z, (int)b1.w};
        p0 = __builtin_amdgcn_mfma_scale_f32_32x32x64_f8f6f4(A, qr[c], p0, 0, 0, 0, F8_ONE, 0, F8_ONE);
        p1 = __builtin_amdgcn_mfma_scale_f32_32x32x64_f8f6f4(B, qr[c], p1, 0, 0, 0, F8_ONE, 0, F8_ONE); }
}
__device__ __forceinline__ i32x8 q32_to_fp8(const bf16_t* p) {
    i32x8 r;
#pragma unroll
    for (int w = 0; w < 4; ++w) { const u32x4 v = *reinterpret_cast<const u32x4*>(p + 8 * w);
        r[2 * w] = (int)f8x4(bflo(v.x), bfhi(v.x), bflo(v.y), bfhi(v.y)); r[2 * w + 1] = (int)f8x4(bflo(v.z), bfhi(v.z), bflo(v.w), bfhi(v.w)); }
    return r;
}
__device__ __forceinline__ i32x8 q32_rope_fp8(const bf16_t* p, float pos) {
    float x[32];
#pragma unroll
    for (int w = 0; w < 4; ++w) { const u32x4 v = *reinterpret_cast<const u32x4*>(p + 8 * w);
#pragma unroll
        for (int e = 0; e < 4; ++e) { x[8 * w + 2 * e] = bflo(v[e]); x[8 * w + 2 * e + 1] = bfhi(v[e]); } }
    float y[32];
#pragma unroll
    for (int i = 0; i < 16; ++i) { const float ang = pos * __powf(10000.f, -(float)i * (1.f / 16.f)), cs = __cosf(ang), sn = __sinf(ang);
        y[i] = x[i] * cs - x[16 + i] * sn; y[16 + i] = x[16 + i] * cs + x[i] * sn; }
    i32x8 r;
#pragma unroll
    for (int w = 0; w < 8; ++w) r[w] = (int)f8x4(y[4 * w], y[4 * w + 1], y[4 * w + 2], y[4 * w + 3]);
    return r;
}
template <int DQK, int LDQ, int LDK, int LDV, int LDO>
__device__ __forceinline__ void attn8_body(const bf16_t* __restrict__ Qb, const unsigned char* __restrict__ Kh, const bf16_t* __restrict__ Vh, bf16_t* __restrict__ Ob, int seq, float scale, char* lds) {
    constexpr int KP = DQK + 16, SHM_V = 64 * 128 * 2, SHM_K = 64 * KP, NC = DQK / 64;
    static_assert(DQK == 128, "double-pipelined body: 128-wide q.k only");
    const float C = scale * 1.4426950408889634f, thr_raw = ATT_THR / scale;
    const int tid = threadIdx.x, wid = tid >> 6, lane = tid & 63, r32 = lane & 31, hi = lane >> 5;
    char* V_lds = lds; char* K_lds = lds + 2 * SHM_V;
    float* wsf = (float*)(lds + 2 * SHM_V + 2 * SHM_K) + wid * 64; float* li_l = wsf; float* al_l = wsf + 32;
    float m_reg = -1e30f, l_reg = 0; f32x16 o[4] = {}; i32x8 qr[NC];
    const bf16_t* Qw = Qb + (long)(wid * 32 + r32) * LDQ + hi * 32;
#pragma unroll
    for (int c = 0; c < NC; ++c) qr[c] = q32_to_fp8(Qw + 64 * c);
    const int sr = tid >> 4, sc = (tid & 15) * 8, vst0 = v_st(sr, sc), vst1 = v_st(32 + sr, sc);
    const int krow = tid >> 3, kch = (tid & 7) * 16;
    const int vb0 = (int)(uintptr_t)V_lds + v_rd_base(lane);
    bf16x8 vs0, vs1; u32x4 ks;
#define SLOAD(k0) do { vs0 = *reinterpret_cast<const bf16x8*>(&Vh[(long)((k0) + sr) * LDV + sc]); vs1 = *reinterpret_cast<const bf16x8*>(&Vh[(long)((k0) + 32 + sr) * LDV + sc]); \
    ks = *reinterpret_cast<const u32x4*>(&Kh[(long)((k0) + krow) * LDK + kch]); } while (0)
#define SWRITE(b) do { *(bf16x8*)(V_lds + (b) * SHM_V + vst0) = vs0; *(bf16x8*)(V_lds + (b) * SHM_V + vst1) = vs1; \
    *(u32x4*)(K_lds + (b) * SHM_K + krow * KP + kch) = ks; } while (0)
#define RESC(a) do { if (__any((a) < 1.f)) { if (hi == 0) al_l[r32] = (a); asm volatile("s_waitcnt lgkmcnt(0)" ::: "memory"); \
    _Pragma("unroll") for (int d = 0; d < 4; ++d) _Pragma("unroll") for (int r = 0; r < 16; ++r) o[d][r] *= al_l[crow(r, hi)]; } } while (0)
    f32x16 pA0, pA1, pB0, pB1; float mnA, mnB, alA, alB; bf16x8 pa0, pa1, pa2, pa3; const int NT = seq / 64;
    SLOAD(0); asm volatile("s_waitcnt vmcnt(0)" ::: "memory"); SWRITE(0); __syncthreads();
    qkt8<DQK>(pA0, pA1, K_lds, qr, r32, hi); partialSM(pA0, pA1, m_reg, mnA, alA, C, thr_raw);
    SLOAD(64);
    asm volatile("s_waitcnt vmcnt(0)" ::: "memory"); SWRITE(1); __syncthreads();
    for (int j = 1; j + 1 < NT; j += 2) {
        SBAR(); qkt8<DQK>(pB0, pB1, K_lds + SHM_K, qr, r32, hi);
        finishSM(pA0, pA1, alA, l_reg, pa0, pa1, pa2, pa3); SBAR();
        SLOAD((j + 1) * 64); SBAR();
        pv_d0(o, vb0, pa0, pa1, pa2, pa3); partialSM(pB0, pB1, m_reg, mnB, alB, C, thr_raw);
        __syncthreads(); asm volatile("s_waitcnt vmcnt(0)" ::: "memory"); SWRITE(0);
        RESC(alB); __syncthreads();
        SBAR(); qkt8<DQK>(pA0, pA1, K_lds, qr, r32, hi);
        finishSM(pB0, pB1, alB, l_reg, pa0, pa1, pa2, pa3); SBAR();
        SLOAD((j + 2) * 64); SBAR();
        pv_d0(o, vb0 + SHM_V, pa0, pa1, pa2, pa3); partialSM(pA0, pA1, m_reg, mnA, alA, C, thr_raw);
        __syncthreads(); asm volatile("s_waitcnt vmcnt(0)" ::: "memory"); SWRITE(1);
        RESC(alA); __syncthreads();
    }
    SBAR(); qkt8<DQK>(pB0, pB1, K_lds + SHM_K, qr, r32, hi);
    finishSM(pA0, pA1, alA, l_reg, pa0, pa1, pa2, pa3); SBAR();
    pv_d0(o, vb0, pa0, pa1, pa2, pa3); partialSM(pB0, pB1, m_reg, mnB, alB, C, thr_raw);
    __syncthreads(); RESC(alB);
    finishSM(pB0, pB1, alB, l_reg, pa0, pa1, pa2, pa3); SBAR();
    pv_d0(o, vb0 + SHM_V, pa0, pa1, pa2, pa3);
    if (hi == 0) li_l[r32] = l_reg; asm volatile("s_waitcnt lgkmcnt(0)" ::: "memory");
    float rli[16];
#pragma unroll
    for (int r = 0; r < 16; ++r) rli[r] = __builtin_amdgcn_rcpf(li_l[crow(r, hi)]);
    bf16_t* Ow = Ob + (long)(wid * 32) * LDO;
#pragma unroll
    for (int r = 0; r < 16; ++r) { const int orow = crow(r, hi);
#pragma unroll
        for (int d0 = 0; d0 < 4; ++d0) Ow[(long)orow * LDO + d0 * 32 + r32] = (bf16_t)f2bf(o[d0][r] * rli[r]); }
    __syncthreads();
#undef SLOAD
#undef SWRITE
#undef RESC
}
template <int DQK, int LDQ, int LDK, int LDV, int LDO>
__device__ __forceinline__ void attn8_body_single(const bf16_t* __restrict__ Qb, const unsigned char* __restrict__ Kh, const bf16_t* __restrict__ Vh, bf16_t* __restrict__ Ob, int seq, float scale, char* lds, int rope_t0) {
    constexpr int KP = DQK + 16, SHM_V = 64 * 128 * 2, SHM_K = 64 * KP, NC = DQK / 64, CH = DQK / 16, NCH = 64 * CH, NKL = (NCH + NTHREADS - 1) / NTHREADS;
    const float C = scale * 1.4426950408889634f, thr_raw = ATT_THR / scale;
    const int tid = threadIdx.x, wid = tid >> 6, lane = tid & 63, r32 = lane & 31, hi = lane >> 5;
    char* V_lds = lds; char* K_lds = lds + 2 * SHM_V;
    float* wsf = (float*)(lds + 2 * SHM_V + 2 * SHM_K) + wid * 64; float* li_l = wsf; float* al_l = wsf + 32;
    float m_reg = -1e30f, l_reg = 0; f32x16 o[4] = {}; i32x8 qr[NC];
    const bf16_t* Qw = Qb + (long)(wid * 32 + r32) * LDQ + hi * 32;
    if constexpr (DQK == 192) {
        if (rope_t0 >= 0) { const int tq = rope_t0 + wid * 32 + r32; qr[2] = q32_rope_fp8(Qw + 128, (float)(hi ? (tq & 63) : (tq >> 6))); }
        else qr[2] = q32_to_fp8(Qw + 128);
    }
    asm volatile("" ::: "memory");
#pragma unroll
    for (int c = 0; c < 2; ++c) qr[c] = q32_to_fp8(Qw + 64 * c);
    const int sr = tid >> 4, sc = (tid & 15) * 8, vst0 = v_st(sr, sc), vst1 = v_st(32 + sr, sc);
    int krow[NKL], kch[NKL];
#pragma unroll
    for (int i = 0; i < NKL; ++i) { const int id = tid + i * NTHREADS; krow[i] = (id < NCH) ? id / CH : 0; kch[i] = (id % CH) * 16; }
    const bool k2 = (NKL < 2) || (tid + NTHREADS < NCH);
    const int vb0 = (int)(uintptr_t)V_lds + v_rd_base(lane);
    bf16x8 vs0, vs1; u32x4 ks[NKL];
#define SLOAD(k0) do { vs0 = *reinterpret_cast<const bf16x8*>(&Vh[(long)((k0) + sr) * LDV + sc]); vs1 = *reinterpret_cast<const bf16x8*>(&Vh[(long)((k0) + 32 + sr) * LDV + sc]); \
    _Pragma("unroll") for (int i_ = 0; i_ < NKL; ++i_) ks[i_] = *reinterpret_cast<const u32x4*>(&Kh[(long)((k0) + krow[i_]) * LDK + kch[i_]]); } while (0)
#define SWRITE(b) do { *(bf16x8*)(V_lds + (b) * SHM_V + vst0) = vs0; *(bf16x8*)(V_lds + (b) * SHM_V + vst1) = vs1; \
    _Pragma("unroll") for (int i_ = 0; i_ < NKL; ++i_) if (i_ == 0 || k2) *(u32x4*)(K_lds + (b) * SHM_K + krow[i_] * KP + kch[i_]) = ks[i_]; } while (0)
#define RESC(a) do { if (__any((a) < 1.f)) { if (hi == 0) al_l[r32] = (a); asm volatile("s_waitcnt lgkmcnt(0)" ::: "memory"); \
    _Pragma("unroll") for (int d = 0; d < 4; ++d) _Pragma("unroll") for (int r = 0; r < 16; ++r) o[d][r] *= al_l[crow(r, hi)]; } } while (0)
    f32x16 p0, p1; float mn, al; bf16x8 pa0, pa1, pa2, pa3; const int NT = seq / 64;
    SLOAD(0); asm volatile("s_waitcnt vmcnt(0)" ::: "memory"); SWRITE(0); __syncthreads();
    SLOAD(64);
    for (int j = 0; j < NT; ++j) {
        const int b = j & 1;
        SBAR(); qkt8<DQK>(p0, p1, K_lds + b * SHM_K, qr, r32, hi);
        partialSM(p0, p1, m_reg, mn, al, C, thr_raw);
        RESC(al);
        finishSM(p0, p1, al, l_reg, pa0, pa1, pa2, pa3); SBAR();
        pv_d0(o, vb0 + b * SHM_V, pa0, pa1, pa2, pa3);
        if (j + 1 < NT) { asm volatile("s_waitcnt vmcnt(0)" ::: "memory"); SWRITE(b ^ 1); }
        __syncthreads();
        if (j + 2 < NT) SLOAD((j + 2) * 64);
    }
    if (hi == 0) li_l[r32] = l_reg; asm volatile("s_waitcnt lgkmcnt(0)" ::: "memory");
    float rli[16];
#pragma unroll
    for (int r = 0; r < 16; ++r) rli[r] = __builtin_amdgcn_rcpf(li_l[crow(r, hi)]);
    bf16_t* Ow = Ob + (long)(wid * 32) * LDO;
#pragma unroll
    for (int r = 0; r < 16; ++r) { const int orow = crow(r, hi);
#pragma unroll
        for (int d0 = 0; d0 < 4; ++d0) Ow[(long)orow * LDO + d0 * 32 + r32] = (bf16_t)f2bf(o[d0][r] * rli[r]); }
    __syncthreads();
#undef SLOAD
#undef SWRITE
#undef RESC
}
__device__ __forceinline__ void p_attn_mla(const Args& A, const Frame& F) {
    const bf16_t* Q = (const bf16_t*)(F.ws + WS_Q); const unsigned char* Kb = F.ws + WS_K; const bf16_t* Vb = (const bf16_t*)(F.ws + WS_V); bf16_t* O = (bf16_t*)(F.ws + WS_O);
    const float scale = 0.07216878364870322f;
    for (int u = F.vcu; u < 544; u += F.nblk) {
        int b, h, q0, seq;
        int rope_t0;
        if (u < 512) { const int qb = u & 15; h = (u >> 4) & 7; b = u >> 7; q0 = CTXL + qb * 256; seq = RPB; rope_t0 = qb * 256; }
        else { const int v = u - 512; h = v & 7; b = v >> 3; q0 = 0; seq = CTXL; rope_t0 = -1; }
        const size_t rb = (size_t)b * RPB;
        attn8_body_single<192, 1536, 1536, 1024, 1024>(Q + (rb + q0) * 1536 + h * 192, Kb + rb * 1536 + h * 192, Vb + rb * 1024 + h * 128, O + (rb + q0) * 1024 + h * 128, seq, scale, F.lds, rope_t0);
    }
}
__device__ __forceinline__ void p_attn_gqa(const Args& A, const Frame& F) {
    const bf16_t* Q = (const bf16_t*)(F.ws + WS_Q1); const unsigned char* Kb = F.ws + WS_K1; const bf16_t* Vb = (const bf16_t*)(F.ws + WS_V1); bf16_t* O = (bf16_t*)(F.ws + WS_O);
    const float scale = 0.08838834764831845f;
    for (int u = F.vcu; u < 512; u += F.nblk) {
        const int qb = u & 15, h = (u >> 4) & 7, b = u >> 7, q0 = CTXL + qb * 256, kvh = h >> 2;
        const size_t rb = (size_t)b * RPB;
        attn8_body<128, 1024, 256, 256, 1024>(Q + (rb + q0) * 1024 + h * 128, Kb + rb * 256 + kvh * 128, Vb + rb * 256 + kvh * 128, O + (rb + q0) * 1024 + h * 128, RPB, scale, F.lds);
    }
}

#define DPP_XOR1 0xB1
#define DPP_XOR2 0x4E
#define DPP_HMIRROR 0x141
#define DPP_MIRROR 0x140
__device__ __forceinline__ int row_max_i(int v) {
    v = max(v, __builtin_amdgcn_update_dpp(v, v, DPP_XOR1, 0xf, 0xf, false));
    v = max(v, __builtin_amdgcn_update_dpp(v, v, DPP_XOR2, 0xf, 0xf, false));
    v = max(v, __builtin_amdgcn_update_dpp(v, v, DPP_HMIRROR, 0xf, 0xf, false));
    v = max(v, __builtin_amdgcn_update_dpp(v, v, DPP_MIRROR, 0xf, 0xf, false));
    return v;
}
__device__ __forceinline__ float row_sum_f(float v) {
    v += __builtin_bit_cast(float, __builtin_amdgcn_update_dpp(0, __builtin_bit_cast(int, v), DPP_XOR1, 0xf, 0xf, false));
    v += __builtin_bit_cast(float, __builtin_amdgcn_update_dpp(0, __builtin_bit_cast(int, v), DPP_XOR2, 0xf, 0xf, false));
    v += __builtin_bit_cast(float, __builtin_amdgcn_update_dpp(0, __builtin_bit_cast(int, v), DPP_HMIRROR, 0xf, 0xf, false));
    v += __builtin_bit_cast(float, __builtin_amdgcn_update_dpp(0, __builtin_bit_cast(int, v), DPP_MIRROR, 0xf, 0xf, false));
    return v;
}
__device__ __forceinline__ int fkey(float f) { const int b = __builtin_bit_cast(int, f); return b ^ ((b >> 31) & 0x7fffffff); }
__device__ __forceinline__ float keyf(int k) { return __builtin_bit_cast(float, k ^ ((k >> 31) & 0x7fffffff)); }
__device__ __forceinline__ void cand_ij(int t, int& i, int& j) {
    const int g16 = t >= 16, g24 = t >= 24, g29 = t >= 29, g33 = t >= 33, g36 = t >= 36, g38 = t >= 38, g40 = t >= 40;
    i = g16 + g24 + g29 + g33 + g36 + g38 + g40 + max(t - 41, 0);
    const int base = 16 * g16 + 8 * g24 + 5 * g29 + 4 * g33 + 3 * g36 + 2 * g38 + 2 * g40;
    j = (t >= 42) ? 0 : t - base;
    if (t >= 50) { i = 0; j = 0; }
}
__device__ __forceinline__ void row_max2(int& a, int& b) {
    asm volatile("s_nop 1\n\t"
                 "v_max_i32_dpp %0, %0, %0 quad_perm:[1,0,3,2] row_mask:0xf bank_mask:0xf\n\tv_max_i32_dpp %1, %1, %1 quad_perm:[1,0,3,2] row_mask:0xf bank_mask:0xf\n\ts_nop 0\n\t"
                 "v_max_i32_dpp %0, %0, %0 quad_perm:[2,3,0,1] row_mask:0xf bank_mask:0xf\n\tv_max_i32_dpp %1, %1, %1 quad_perm:[2,3,0,1] row_mask:0xf bank_mask:0xf\n\ts_nop 0\n\t"
                 "v_max_i32_dpp %0, %0, %0 row_half_mirror row_mask:0xf bank_mask:0xf\n\tv_max_i32_dpp %1, %1, %1 row_half_mirror row_mask:0xf bank_mask:0xf\n\ts_nop 0\n\t"
                 "v_max_i32_dpp %0, %0, %0 row_mirror row_mask:0xf bank_mask:0xf\n\tv_max_i32_dpp %1, %1, %1 row_mirror row_mask:0xf bank_mask:0xf\n\ts_nop 1"
                 : "+v"(a), "+v"(b));
}
__device__ __forceinline__ void row_max1(int& a) {
    asm volatile("s_nop 1\n\t"
                 "v_max_i32_dpp %0, %0, %0 quad_perm:[1,0,3,2] row_mask:0xf bank_mask:0xf\n\ts_nop 1\n\t"
                 "v_max_i32_dpp %0, %0, %0 quad_perm:[2,3,0,1] row_mask:0xf bank_mask:0xf\n\ts_nop 1\n\t"
                 "v_max_i32_dpp %0, %0, %0 row_half_mirror row_mask:0xf bank_mask:0xf\n\ts_nop 1\n\t"
                 "v_max_i32_dpp %0, %0, %0 row_mirror row_mask:0xf bank_mask:0xf\n\ts_nop 1"
                 : "+v"(a));
}
__device__ __forceinline__ void row_max4(int& a, int& b, int& c, int& d) {
    asm volatile("s_nop 1\n\t"
                 "v_max_i32_dpp %0, %0, %0 quad_perm:[1,0,3,2] row_mask:0xf bank_mask:0xf\n\tv_max_i32_dpp %1, %1, %1 quad_perm:[1,0,3,2] row_mask:0xf bank_mask:0xf\n\t"
                 "v_max_i32_dpp %2, %2, %2 quad_perm:[1,0,3,2] row_mask:0xf bank_mask:0xf\n\tv_max_i32_dpp %3, %3, %3 quad_perm:[1,0,3,2] row_mask:0xf bank_mask:0xf\n\t"
                 "v_max_i32_dpp %0, %0, %0 quad_perm:[2,3,0,1] row_mask:0xf bank_mask:0xf\n\tv_max_i32_dpp %1, %1, %1 quad_perm:[2,3,0,1] row_mask:0xf bank_mask:0xf\n\t"
                 "v_max_i32_dpp %2, %2, %2 quad_perm:[2,3,0,1] row_mask:0xf bank_mask:0xf\n\tv_max_i32_dpp %3, %3, %3 quad_perm:[2,3,0,1] row_mask:0xf bank_mask:0xf\n\t"
                 "v_max_i32_dpp %0, %0, %0 row_half_mirror row_mask:0xf bank_mask:0xf\n\tv_max_i32_dpp %1, %1, %1 row_half_mirror row_mask:0xf bank_mask:0xf\n\t"
                 "v_max_i32_dpp %2, %2, %2 row_half_mirror row_mask:0xf bank_mask:0xf\n\tv_max_i32_dpp %3, %3, %3 row_half_mirror row_mask:0xf bank_mask:0xf\n\t"
                 "v_max_i32_dpp %0, %0, %0 row_mirror row_mask:0xf bank_mask:0xf\n\tv_max_i32_dpp %1, %1, %1 row_mirror row_mask:0xf bank_mask:0xf\n\t"
                 "v_max_i32_dpp %2, %2, %2 row_mirror row_mask:0xf bank_mask:0xf\n\tv_max_i32_dpp %3, %3, %3 row_mirror row_mask:0xf bank_mask:0xf\n\ts_nop 1"
                 : "+v"(a), "+v"(b), "+v"(c), "+v"(d));
}
#define CE_DESC(x, y) do { const int hi_ = max(x, y), lo_ = min(x, y); x = hi_; y = lo_; } while (0)
#define SORT8_DESC(k) do { CE_DESC(k[0], k[2]); CE_DESC(k[1], k[3]); CE_DESC(k[4], k[6]); CE_DESC(k[5], k[7]); CE_DESC(k[0], k[4]); CE_DESC(k[1], k[5]); CE_DESC(k[2], k[6]); CE_DESC(k[3], k[7]); \
    CE_DESC(k[0], k[1]); CE_DESC(k[2], k[3]); CE_DESC(k[4], k[5]); CE_DESC(k[6], k[7]); CE_DESC(k[2], k[4]); CE_DESC(k[3], k[5]); CE_DESC(k[1], k[4]); CE_DESC(k[3], k[6]); CE_DESC(k[1], k[2]); CE_DESC(k[3], k[4]); CE_DESC(k[5], k[6]); } while (0)
#define SORT16_DESC(K) do { CE_DESC(K[0], K[1]); CE_DESC(K[2], K[3]); CE_DESC(K[0], K[2]); CE_DESC(K[1], K[3]); CE_DESC(K[1], K[2]); CE_DESC(K[4], K[5]); CE_DESC(K[6], K[7]); CE_DESC(K[4], K[6]); CE_DESC(K[5], K[7]); CE_DESC(K[5], K[6]); CE_DESC(K[0], K[4]); CE_DESC(K[2], K[6]); CE_DESC(K[2], K[4]); CE_DESC(K[1], K[5]); CE_DESC(K[3], K[7]); CE_DESC(K[3], K[5]); CE_DESC(K[1], K[2]); CE_DESC(K[3], K[4]); CE_DESC(K[5], K[6]); CE_DESC(K[8], K[9]); CE_DESC(K[10], K[11]); CE_DESC(K[8], K[10]); CE_DESC(K[9], K[11]); CE_DESC(K[9], K[10]); CE_DESC(K[12], K[13]); CE_DESC(K[14], K[15]); CE_DESC(K[12], K[14]); CE_DESC(K[13], K[15]); CE_DESC(K[13], K[14]); CE_DESC(K[8], K[12]); CE_DESC(K[10], K[14]); CE_DESC(K[10], K[12]); CE_DESC(K[9], K[13]); CE_DESC(K[11], K[15]); CE_DESC(K[11], K[13]); CE_DESC(K[9], K[10]); CE_DESC(K[11], K[12]); CE_DESC(K[13], K[14]); CE_DESC(K[0], K[8]); CE_DESC(K[4], K[12]); CE_DESC(K[4], K[8]); CE_DESC(K[2], K[10]); CE_DESC(K[6], K[14]); CE_DESC(K[6], K[10]); CE_DESC(K[2], K[4]); CE_DESC(K[6], K[8]); CE_DESC(K[10], K[12]); CE_DESC(K[1], K[9]); CE_DESC(K[5], K[13]); CE_DESC(K[5], K[9]); CE_DESC(K[3], K[11]); CE_DESC(K[7], K[15]); CE_DESC(K[7], K[11]); CE_DESC(K[3], K[5]); CE_DESC(K[7], K[9]); CE_DESC(K[11], K[13]); CE_DESC(K[1], K[2]); CE_DESC(K[3], K[4]); CE_DESC(K[5], K[6]); CE_DESC(K[7], K[8]); CE_DESC(K[9], K[10]); CE_DESC(K[11], K[12]); CE_DESC(K[13], K[14]); } while (0)
#define MERGE16_DESC(T, K) do { _Pragma("unroll") for (int i_ = 0; i_ < 16; ++i_) T[i_] = max(T[i_], K[15 - i_]); CE_DESC(T[0], T[8]); CE_DESC(T[1], T[9]); CE_DESC(T[2], T[10]); CE_DESC(T[3], T[11]); CE_DESC(T[4], T[12]); CE_DESC(T[5], T[13]); CE_DESC(T[6], T[14]); CE_DESC(T[7], T[15]); CE_DESC(T[0], T[4]); CE_DESC(T[1], T[5]); CE_DESC(T[2], T[6]); CE_DESC(T[3], T[7]); CE_DESC(T[8], T[12]); CE_DESC(T[9], T[13]); CE_DESC(T[10], T[14]); CE_DESC(T[11], T[15]); CE_DESC(T[0], T[2]); CE_DESC(T[1], T[3]); CE_DESC(T[4], T[6]); CE_DESC(T[5], T[7]); CE_DESC(T[8], T[10]); CE_DESC(T[9], T[11]); CE_DESC(T[12], T[14]); CE_DESC(T[13], T[15]); CE_DESC(T[0], T[1]); CE_DESC(T[2], T[3]); CE_DESC(T[4], T[5]); CE_DESC(T[6], T[7]); CE_DESC(T[8], T[9]); CE_DESC(T[10], T[11]); CE_DESC(T[12], T[13]); CE_DESC(T[14], T[15]); } while (0)
__device__ __forceinline__ int hkey_hi(unsigned w) { const int x = (int)(w & 0xffff0000u); return x ^ ((x >> 31) & 0x7fff0000); }
__device__ __forceinline__ float hkey_val(int k) { const int y = k & (int)0xffff0000; const unsigned b = (unsigned)(y ^ ((y >> 31) & 0x7fff0000)); return (float)__builtin_bit_cast(_Float16, (unsigned short)(b >> 16)); }
__device__ __forceinline__ int cnd(int a, int b, unsigned long long m) { int r; asm("v_cndmask_b32_e64 %0, %1, %2, %3" : "=v"(r) : "v"(a), "v"(b), "s"(m)); return r; }
__device__ __forceinline__ unsigned long long bitmask(int v, int bit) { unsigned long long m; asm("v_cmp_ne_u32_e64 %0, 0, %1\n\ts_nop 1" : "=s"(m) : "v"(v & bit)); return m; }
__device__ __forceinline__ int sel16(const int (&a)[16], int i) {
    const unsigned long long m0 = bitmask(i, 1), m1 = bitmask(i, 2), m2 = bitmask(i, 4), m3 = bitmask(i, 8);
    int l1[8], l2[4], l3[2];
#pragma unroll
    for (int m = 0; m < 8; ++m) l1[m] = cnd(a[2 * m], a[2 * m + 1], m0);
#pragma unroll
    for (int m = 0; m < 4; ++m) l2[m] = cnd(l1[2 * m], l1[2 * m + 1], m1);
#pragma unroll
    for (int m = 0; m < 2; ++m) l3[m] = cnd(l2[2 * m], l2[2 * m + 1], m2);
    return cnd(l3[0], l3[1], m3);
}
__device__ __forceinline__ void topk_rows4(const unsigned short* S, unsigned* PK, int r, int hbase, int lane) {
    const int c = lane & 15, rw = lane >> 4, rbase = lane & 48, h = hbase + rw;
    const int KMIN = (int)0x80000000;
    const unsigned short* sp = S + (size_t)r * 2048 + h * 256 + 4 * c;
    int k1[8], k2[8];
#pragma unroll
    for (int jj = 0; jj < 2; ++jj) { const u32x2 a = *(const u32x2*)(sp + 64 * jj), b = *(const u32x2*)(sp + 128 + 64 * jj);
#pragma unroll
        for (int e = 0; e < 4; ++e) { const int p = 4 * c + 64 * jj + e;
            const float fa = (float)__builtin_bit_cast(_Float16, (unsigned short)(a[e >> 1] >> (16 * (e & 1)))), fb = (float)__builtin_bit_cast(_Float16, (unsigned short)(b[e >> 1] >> (16 * (e & 1))));
            k1[4 * jj + e] = (fkey(fa) & ~127) | (127 - p); k2[4 * jj + e] = (fkey(fb) & ~127) | (127 - p); } }
    SORT8_DESC(k1); SORT8_DESC(k2);
    int r1 = KMIN, r2 = KMIN;
#pragma unroll 1
    for (int it = 0; it < 16; ++it) {
        int m1 = k1[0], m2 = k2[0];
        row_max2(m1, m2);
        const bool p1 = (k1[0] == m1), p2 = (k2[0] == m2);
#pragma unroll
        for (int e = 0; e < 7; ++e) { k1[e] = p1 ? k1[e + 1] : k1[e]; k2[e] = p2 ? k2[e + 1] : k2[e]; }
        k1[7] = p1 ? KMIN : k1[7]; k2[7] = p2 ? KMIN : k2[7];
        if (c == it) { r1 = m1; r2 = m2; }
    }
    int ck[4];
#pragma unroll
    for (int q = 0; q < 4; ++q) { int ci, cj; cand_ij(c + 16 * q, ci, cj); const int a = __shfl(r1, rbase | ci), b = __shfl(r2, rbase | cj);
        const float fs = keyf((a & ~127) | 64) + keyf((b & ~127) | 64); const int t = c + 16 * q;
        ck[q] = (t < 50) ? ((fkey(fs) & ~63) | (63 - t)) : KMIN; }
    CE_DESC(ck[0], ck[1]); CE_DESC(ck[2], ck[3]); CE_DESC(ck[0], ck[2]); CE_DESC(ck[1], ck[3]); CE_DESC(ck[1], ck[2]);
    int tk = KMIN;
#pragma unroll 1
    for (int it = 0; it < 16; ++it) {
        int m = ck[0];
        row_max1(m);
        const bool pp = (ck[0] == m);
        ck[0] = pp ? ck[1] : ck[0]; ck[1] = pp ? ck[2] : ck[1]; ck[2] = pp ? ck[3] : ck[2]; ck[3] = pp ? KMIN : ck[3];
        if (c == it) tk = m;
    }
    int wi, wj; cand_ij(63 - (tk & 63), wi, wj);
    const int wa = __shfl(r1, rbase | wi), wb = __shfl(r2, rbase | wj);
    const int te = (127 - (wa & 127)) * 128 + (127 - (wb & 127));
    const float tv = keyf((tk & ~63) | 32);
    int mk = tk; row_max1(mk);
    const float mx = keyf((mk & ~63) | 32);
    const float ex = __expf(tv - mx), sum = row_sum_f(ex);
    PK[(size_t)r * 128 + h * 16 + c] = ((unsigned)te << 16) | (unsigned)(ex * (65535.f / sum) + 0.5f);
}
__device__ __forceinline__ void p_peer_topk(const Args& A, const Frame& F, bool skip_ctx) {
    const int gw = F.bid * NWAVES + F.wave, NGW = F.nblk * NWAVES, lane = F.lane;
    const unsigned short* S = (const unsigned short*)(F.ws + WS_S); unsigned* PK = (unsigned*)(F.ws + WS_PK);
    const int KMIN = (int)0x80000000;
    const int nitem = (skip_ctx ? NB * SEQ : R) * 8;
    const int nmain = (nitem / (NGW * 64)) * (NGW * 64);
    for (int q = gw; q < (nitem - nmain) / 4; q += NGW) { const int item = nmain + 4 * q, n = item >> 3; topk_rows4(S, PK, skip_ctx ? tok_row(1, n) : n, item & 7, lane); }
    for (int base = gw * 64; base < nmain; base += NGW * 64) {
        const int item = base + lane, n = item >> 3, h = item & 7, r = skip_ctx ? tok_row(1, n) : n;
        const unsigned short* sp = S + (size_t)r * 2048 + h * 256;
        int t1[16], t2[16];
#pragma unroll
        for (int list = 0; list < 2; ++list) {
            int T[16];
#pragma unroll
            for (int i = 0; i < 16; ++i) T[i] = KMIN;
            const unsigned short* lp = sp + 128 * list;
            u32x4 ra = *(const u32x4*)lp, rb = *(const u32x4*)(lp + 8);
#pragma unroll 1
            for (int c = 0; c < 8; ++c) {
                const int cn = c < 7 ? c + 1 : 7;
                const u32x4 na = *(const u32x4*)(lp + 16 * cn), nb = *(const u32x4*)(lp + 16 * cn + 8);
                const int pb = 127 - 16 * c;
                int K[16];
#pragma unroll
                for (int d = 0; d < 4; ++d) { K[2 * d] = hkey_hi(ra[d] << 16) | (pb - 2 * d); K[2 * d + 1] = hkey_hi(ra[d]) | (pb - 2 * d - 1);
                    K[8 + 2 * d] = hkey_hi(rb[d] << 16) | (pb - 8 - 2 * d); K[8 + 2 * d + 1] = hkey_hi(rb[d]) | (pb - 9 - 2 * d); }
                SORT16_DESC(K);
                MERGE16_DESC(T, K);
                ra = na; rb = nb;
            }
#pragma unroll
            for (int i = 0; i < 16; ++i) { if (list == 0) t1[i] = T[i]; else t2[i] = T[i]; }
        }
        float f1[16], f2[16];
#pragma unroll
        for (int i = 0; i < 16; ++i) { f1[i] = hkey_val(t1[i]); f2[i] = hkey_val(t2[i]); }
        int CA[16], CB[16], CC[16], CD[16];
        CA[0] = (fkey(f1[0] + f2[0]) & ~63) | 63; CA[1] = (fkey(f1[0] + f2[1]) & ~63) | 62; CA[2] = (fkey(f1[0] + f2[2]) & ~63) | 61; CA[3] = (fkey(f1[0] + f2[3]) & ~63) | 60; CA[4] = (fkey(f1[0] + f2[4]) & ~63) | 59; CA[5] = (fkey(f1[0] + f2[5]) & ~63) | 58; CA[6] = (fkey(f1[0] + f2[6]) & ~63) | 57; CA[7] = (fkey(f1[0] + f2[7]) & ~63) | 56; CA[8] = (fkey(f1[0] + f2[8]) & ~63) | 55; CA[9] = (fkey(f1[0] + f2[9]) & ~63) | 54; CA[10] = (fkey(f1[0] + f2[10]) & ~63) | 53; CA[11] = (fkey(f1[0] + f2[11]) & ~63) | 52; CA[12] = (fkey(f1[0] + f2[12]) & ~63) | 51; CA[13] = (fkey(f1[0] + f2[13]) & ~63) | 50; CA[14] = (fkey(f1[0] + f2[14]) & ~63) | 49; CA[15] = (fkey(f1[0] + f2[15]) & ~63) | 48; CB[0] = (fkey(f1[1] + f2[0]) & ~63) | 47; CB[1] = (fkey(f1[1] + f2[1]) & ~63) | 46; CB[2] = (fkey(f1[1] + f2[2]) & ~63) | 45; CB[3] = (fkey(f1[1] + f2[3]) & ~63) | 44; CB[4] = (fkey(f1[1] + f2[4]) & ~63) | 43; CB[5] = (fkey(f1[1] + f2[5]) & ~63) | 42; CB[6] = (fkey(f1[1] + f2[6]) & ~63) | 41; CB[7] = (fkey(f1[1] + f2[7]) & ~63) | 40; CB[8] = (fkey(f1[2] + f2[0]) & ~63) | 39; CB[9] = (fkey(f1[2] + f2[1]) & ~63) | 38; CB[10] = (fkey(f1[2] + f2[2]) & ~63) | 37; CB[11] = (fkey(f1[2] + f2[3]) & ~63) | 36; CB[12] = (fkey(f1[2] + f2[4]) & ~63) | 35; CB[13] = (fkey(f1[3] + f2[0]) & ~63) | 34; CB[14] = (fkey(f1[3] + f2[1]) & ~63) | 33; CB[15] = (fkey(f1[3] + f2[2]) & ~63) | 32; CC[0] = (fkey(f1[3] + f2[3]) & ~63) | 31; CC[1] = (fkey(f1[4] + f2[0]) & ~63) | 30; CC[2] = (fkey(f1[4] + f2[1]) & ~63) | 29; CC[3] = (fkey(f1[4] + f2[2]) & ~63) | 28; CC[4] = (fkey(f1[5] + f2[0]) & ~63) | 27; CC[5] = (fkey(f1[5] + f2[1]) & ~63) | 26; CC[6] = (fkey(f1[6] + f2[0]) & ~63) | 25; CC[7] = (fkey(f1[6] + f2[1]) & ~63) | 24; CC[8] = (fkey(f1[7] + f2[0]) & ~63) | 23; CC[9] = (fkey(f1[7] + f2[1]) & ~63) | 22; CC[10] = (fkey(f1[8] + f2[0]) & ~63) | 21; CC[11] = (fkey(f1[9] + f2[0]) & ~63) | 20; CC[12] = (fkey(f1[10] + f2[0]) & ~63) | 19; CC[13] = (fkey(f1[11] + f2[0]) & ~63) | 18; CC[14] = (fkey(f1[12] + f2[0]) & ~63) | 17; CC[15] = (fkey(f1[13] + f2[0]) & ~63) | 16; CD[0] = (fkey(f1[14] + f2[0]) & ~63) | 15; CD[1] = (fkey(f1[15] + f2[0]) & ~63) | 14; CD[2] = KMIN; CD[3] = KMIN; CD[4] = KMIN; CD[5] = KMIN; CD[6] = KMIN; CD[7] = KMIN; CD[8] = KMIN; CD[9] = KMIN; CD[10] = KMIN; CD[11] = KMIN; CD[12] = KMIN; CD[13] = KMIN; CD[14] = KMIN; CD[15] = KMIN;
        SORT16_DESC(CB); SORT16_DESC(CC); CE_DESC(CD[0], CD[1]);
        MERGE16_DESC(CA, CB); MERGE16_DESC(CA, CC); MERGE16_DESC(CA, CD);
        const float mx = keyf((CA[0] & ~63) | 32);
        float ex[16], sum = 0.f; unsigned te[16];
#pragma unroll
        for (int k = 0; k < 16; ++k) { int wi, wj; cand_ij(63 - (CA[k] & 63), wi, wj);
            const int wa = sel16(t1, wi), wb = sel16(t2, wj);
            te[k] = (unsigned)((127 - (wa & 127)) * 128 + (127 - (wb & 127)));
            ex[k] = __expf(keyf((CA[k] & ~63) | 32) - mx); sum += ex[k]; }
        const float rs = 65535.f / sum;
        u32x4* dst = (u32x4*)(PK + (size_t)r * 128 + h * 16);
#pragma unroll
        for (int q = 0; q < 4; ++q) { u32x4 o;
#pragma unroll
            for (int d = 0; d < 4; ++d) o[d] = (te[4 * q + d] << 16) | (unsigned)(ex[4 * q + d] * rs + 0.5f);
            dst[q] = o; }
    }
}

#define UB(w, b) ((float)(((w) >> (8 * (b))) & 0xffu))
__device__ __forceinline__ void p_peer_experts(const Args& A, const Frame& F, int layer) {
    const int gw = F.bid * NWAVES + F.wave, NGW = F.nblk * NWAVES, lane = F.lane;
    const bf16_t* H = (const bf16_t*)(F.ws + WS_H); float* X = (float*)(F.ws + WS_X);
    const unsigned* PK = (const unsigned*)(F.ws + WS_PK);
    const unsigned char* UT = F.ws + WS_TAB + (size_t)(layer * 2) * 16384 * 1024; const unsigned char* VT = UT + (size_t)16384 * 1024;
    const float* SU = (const float*)(F.ws + WS_TSC) + (layer * 2) * 16384; const float* SV = SU + 16384;
    const float* MOD = (const float*)(F.ws + WS_MOD) + (size_t)layer * 5 * 6144;
    for (int r = gw; r < R; r += NGW) {
        if (layer == 1 && is_ctx_row(r)) continue;
        float hf[16];
        { const u32x4 w0 = *(const u32x4*)(H + (size_t)r * DM + 16 * lane), w1 = *(const u32x4*)(H + (size_t)r * DM + 16 * lane + 8);
#pragma unroll
          for (int d = 0; d < 4; ++d) { hf[2 * d] = bflo(w0[d]); hf[2 * d + 1] = bfhi(w0[d]); hf[8 + 2 * d] = bflo(w1[d]); hf[8 + 2 * d + 1] = bfhi(w1[d]); } }
        float hs = 0.f;
#pragma unroll
        for (int i = 0; i < 16; ++i) hs += hf[i];
        hs = wave_sum(hs);
        int v0 = (int)PK[(size_t)r * 128 + lane], v1 = (int)PK[(size_t)r * 128 + 64 + lane];
#pragma unroll
        for (int k = 2; k <= 128; k <<= 1) {
#pragma unroll
            for (int j = k >> 1; j >= 1; j >>= 1) {
                if (j == 64) { const int a = min(v0, v1), b = max(v0, v1); v0 = a; v1 = b; }
                else { const int o0 = __shfl_xor(v0, j), o1 = __shfl_xor(v1, j); const bool lower = (lane & j) == 0;
                    const bool asc0 = (k == 128) ? true : (k == 64) ? true : ((lane & k) == 0), asc1 = (k == 128) ? true : (k == 64) ? false : ((lane & k) == 0);
                    v0 = (lower == asc0) ? min(v0, o0) : max(v0, o0); v1 = (lower == asc1) ? min(v1, o1) : max(v1, o1); }
            }
        }
        const unsigned pk0 = (unsigned)v0, pk1 = (unsigned)v1;
        const int e0 = (int)(pk0 >> 16), e1 = (int)(pk1 >> 16);
        const float g0 = (float)(pk0 & 0xffffu) * (1.f / 65535.f), g1 = (float)(pk1 & 0xffffu) * (1.f / 65535.f);
        const float su0 = SU[e0], su1 = SU[e1], sv0 = SV[e0], sv1 = SV[e1];
        float d0 = 0.f, d1 = 0.f;
        const int dep_src = (8 * (lane & 7)) << 2; const bool bit3 = (lane & 8) != 0;
#define XISSUE(buf, TAB, esrc, gg) do { _Pragma("unroll") for (int q_ = 0; q_ < 8; ++q_) { const int e_ = __builtin_amdgcn_readlane(esrc, (gg) * 8 + q_); \
            buf[q_] = *(const u32x4*)((TAB) + (size_t)e_ * 1024 + 16 * lane); } } while (0)
#define UCOMP(buf, gg, dsel) do { float p_[8]; _Pragma("unroll") for (int q_ = 0; q_ < 8; ++q_) { float d_ = 0.f; \
            _Pragma("unroll") for (int j_ = 0; j_ < 4; ++j_) d_ += (hf[4 * j_] * UB(buf[q_][j_], 0) + hf[4 * j_ + 1] * UB(buf[q_][j_], 1)) + (hf[4 * j_ + 2] * UB(buf[q_][j_], 2) + hf[4 * j_ + 3] * UB(buf[q_][j_], 3)); p_[q_] = d_; } \
            float s_[4]; _Pragma("unroll") for (int q_ = 0; q_ < 4; ++q_) { auto rr_ = __builtin_amdgcn_permlane32_swap(__float_as_uint(p_[q_]), __float_as_uint(p_[q_ + 4]), false, false); s_[q_] = __uint_as_float(rr_[0]) + __uint_as_float(rr_[1]); } \
            float t_[2]; _Pragma("unroll") for (int q_ = 0; q_ < 2; ++q_) { auto rr_ = __builtin_amdgcn_permlane16_swap(__float_as_uint(s_[q_]), __float_as_uint(s_[q_ + 2]), false, false); t_[q_] = __uint_as_float(rr_[0]) + __uint_as_float(rr_[1]); } \
            const float keep_ = bit3 ? t_[1] : t_[0], send_ = bit3 ? t_[0] : t_[1]; \
            float u_ = keep_ + __builtin_bit_cast(float, __builtin_amdgcn_update_dpp(0, __builtin_bit_cast(int, send_), 0x128, 0xf, 0xf, false)); \
            u_ += __builtin_bit_cast(float, __builtin_amdgcn_update_dpp(0, __builtin_bit_cast(int, u_), DPP_HMIRROR, 0xf, 0xf, false)); \
            u_ += __builtin_bit_cast(float, __builtin_amdgcn_update_dpp(0, __builtin_bit_cast(int, u_), DPP_XOR1, 0xf, 0xf, false)); \
            u_ += __builtin_bit_cast(float, __builtin_amdgcn_update_dpp(0, __builtin_bit_cast(int, u_), DPP_XOR2, 0xf, 0xf, false)); \
            const float v_ = __builtin_bit_cast(float, __builtin_amdgcn_ds_bpermute(dep_src, __builtin_bit_cast(int, u_))); \
            if ((lane >> 3) == (gg)) dsel = v_; } while (0)
        {
            u32x4 ua[8], ub[8];
            XISSUE(ua, UT, e0, 0);
#pragma unroll 1
            for (int g = 0; g < 8; g += 2) { XISSUE(ub, UT, e0, g + 1); UCOMP(ua, g, d0); if (g + 2 < 8) XISSUE(ua, UT, e0, g + 2); else XISSUE(ua, UT, e1, 0); UCOMP(ub, g + 1, d0); }
#pragma unroll 1
            for (int g = 0; g < 8; g += 2) { XISSUE(ub, UT, e1, g + 1); UCOMP(ua, g, d1); if (g + 2 < 8) XISSUE(ua, UT, e1, g + 2); UCOMP(ub, g + 1, d1); }
        }
        const float a0 = su0 * (d0 - 128.f * hs), a1 = su1 * (d1 - 128.f * hs);
        const float w0 = g0 * 0.5f * a0 * (1.f + erff(a0 * 0.70710678118654752f)) * sv0, w1 = g1 * 0.5f * a1 * (1.f + erff(a1 * 0.70710678118654752f)) * sv1;
        const float wsum = wave_sum(w0 + w1) * 128.f;
        float acc[16];
#pragma unroll
        for (int i = 0; i < 16; ++i) acc[i] = 0.f;
#define VCOMP(buf, wsrc, gg) do { _Pragma("unroll") for (int q_ = 0; q_ < 8; ++q_) { const float wk_ = __builtin_bit_cast(float, __builtin_amdgcn_readlane(__builtin_bit_cast(int, wsrc), (gg) * 8 + q_)); \
            _Pragma("unroll") for (int j_ = 0; j_ < 4; ++j_) { acc[4 * j_] += wk_ * UB(buf[q_][j_], 0); acc[4 * j_ + 1] += wk_ * UB(buf[q_][j_], 1); acc[4 * j_ + 2] += wk_ * UB(buf[q_][j_], 2); acc[4 * j_ + 3] += wk_ * UB(buf[q_][j_], 3); } } } while (0)
        {
            u32x4 va[8], vb[8];
            XISSUE(va, VT, e0, 0);
#pragma unroll 1
            for (int g = 0; g < 8; g += 2) { XISSUE(vb, VT, e0, g + 1); VCOMP(va, w0, g); if (g + 2 < 8) XISSUE(va, VT, e0, g + 2); else XISSUE(va, VT, e1, 0); VCOMP(vb, w0, g + 1); }
#pragma unroll 1
            for (int g = 0; g < 8; g += 2) { XISSUE(vb, VT, e1, g + 1); VCOMP(va, w1, g); if (g + 2 < 8) XISSUE(va, VT, e1, g + 2); VCOMP(vb, w1, g + 1); }
        }
#undef XISSUE
#undef UCOMP
#undef VCOMP
        const float* mm = MOD + (size_t)mod_index(r) * 6144;
        f32x4 xn[4]; float s = 0.f;
#pragma unroll
        for (int j = 0; j < 4; ++j) { const int c = 16 * lane + 4 * j; const float* xp = X + (size_t)r * DM + c; const f32x4 gf = *(const f32x4*)(mm + 5 * 1024 + c);
            xn[j] = *(const f32x4*)xp + gf * (f32x4){acc[4 * j] - wsum, acc[4 * j + 1] - wsum, acc[4 * j + 2] - wsum, acc[4 * j + 3] - wsum};
            s += (xn[j].x * xn[j].x + xn[j].y * xn[j].y) + (xn[j].z * xn[j].z + xn[j].w * xn[j].w); }
        const float rinv = rsqrtf(wave_sum(s) * (1.f / DM) + EPS);
        if (layer == 0) {
            const float* m1 = (const float*)(F.ws + WS_MOD) + (size_t)(5 + mod_index(r)) * 6144;
            const float* gn = A.in[I1_NMIX];
#pragma unroll
            for (int j = 0; j < 4; ++j) { const int c = 16 * lane + 4 * j; *(f32x4*)(X + (size_t)r * DM + c) = xn[j];
                const f32x4 y = (xn[j] * rinv * *(const f32x4*)(gn + c)) * (*(const f32x4*)(m1 + 1024 + c) + 1.f) + *(const f32x4*)(m1 + c);
                u32x2 o; o.x = pk2(y.x, y.y); o.y = pk2(y.z, y.w); *(u32x2*)((bf16_t*)(F.ws + WS_H) + (size_t)r * DM + c) = o; }
        } else {
            const int b = r / RPB, t = (r - b * RPB) - CTXL; float* op = F.out + ((size_t)b * SEQ + t) * DM; const float* gn = A.in[I_NOUT];
#pragma unroll
            for (int j = 0; j < 4; ++j) { const int c = 16 * lane + 4 * j; *(f32x4*)(op + c) = xn[j] * rinv * *(const f32x4*)(gn + c); }
        }
    }
}

__device__ __forceinline__ int tok_row(int layer, int n) { return layer == 0 ? n : (n >> 12) * RPB + CTXL + (n & 4095); }
#define DPPF(v, ctrl) __builtin_bit_cast(float, __builtin_amdgcn_update_dpp(0, __builtin_bit_cast(int, v), ctrl, 0xf, 0xf, false))
__device__ __forceinline__ int isum8(int v) {
    v += __builtin_amdgcn_update_dpp(0, v, DPP_XOR1, 0xf, 0xf, false); v += __builtin_amdgcn_update_dpp(0, v, DPP_XOR2, 0xf, 0xf, false); v += __builtin_amdgcn_update_dpp(0, v, DPP_HMIRROR, 0xf, 0xf, false); return v; }
__device__ __forceinline__ void p_exp_u(const Args& A, const Frame& F, int layer) {
    const int lane = F.lane, s = lane >> 3, c8 = lane & 7;
    const bool part = (F.nblk & 7) == 0; const int ncb = part ? 1 : 4, cb0 = part ? (F.bid & 3) : 0;
    const int gwv = part ? ((F.bid >> 2) * NWAVES + F.wave) : (F.bid * NWAVES + F.wave), nwv = part ? ((F.nblk >> 2) * NWAVES) : (F.nblk * NWAVES);
    const int ntok = layer == 0 ? R : NB * SEQ;
    const unsigned char* HQ = F.ws + WS_HQ; const unsigned* PK = (const unsigned*)(F.ws + WS_PK);
    const unsigned char* UT = F.ws + WS_TAB + (size_t)(layer * 2) * 16384 * 1024;
    int* PD = (int*)(F.ws + WS_PD);
#define U_META(pk, hqa, hqb, n_) do { const int r_ = tok_row(layer, (n_) < ntok ? (n_) : gwv); const unsigned* p_ = PK + (size_t)r_ * 128 + s; \
        _Pragma("unroll") for (int i_ = 0; i_ < 16; ++i_) pk[i_] = p_[8 * i_]; \
        hqa = *(const u32x4*)(HQ + (size_t)r_ * DM + 256 * cb + 32 * c8); hqb = *(const u32x4*)(HQ + (size_t)r_ * DM + 256 * cb + 32 * c8 + 16); } while (0)
#define U_ISSUE(pk, lo) do { _Pragma("unroll") for (int i_ = (lo); i_ < (lo) + 8; ++i_) t[i_] = *(const u32x4*)(tb + (size_t)(pk[i_] >> 16) * 128); } while (0)
#define U_DOT(i_) do { int dh_ = __builtin_amdgcn_sdot8((int)t[i_][0], (int)hva[0], 0, false), dl_ = __builtin_amdgcn_sdot8((int)t[i_][0], (int)hva[1], 0, false); \
        dh_ = __builtin_amdgcn_sdot8((int)t[i_][1], (int)hva[2], dh_, false); dl_ = __builtin_amdgcn_sdot8((int)t[i_][1], (int)hva[3], dl_, false); \
        dh_ = __builtin_amdgcn_sdot8((int)t[i_][2], (int)hvb[0], dh_, false); dl_ = __builtin_amdgcn_sdot8((int)t[i_][2], (int)hvb[1], dl_, false); \
        dh_ = __builtin_amdgcn_sdot8((int)t[i_][3], (int)hvb[2], dh_, false); dl_ = __builtin_amdgcn_sdot8((int)t[i_][3], (int)hvb[3], dl_, false); \
        int d_ = isum8(dh_ * 16 + dl_); if (c8 == ((i_) & 7)) { if ((i_) < 8) kA = d_; else kB = d_; } } while (0)
#define U_ITEM(pkc, hqca, hqcb, pkn, n_) do { \
        const u32x4 hva = hqca, hvb = hqcb; \
        U_META(pkc, hqca, hqcb, (n_) + 2 * nwv); \
        int kA = 0, kB = 0; \
        _Pragma("unroll") for (int i_ = 0; i_ < 8; ++i_) U_DOT(i_); \
        U_ISSUE(pkn, 0); \
        _Pragma("unroll") for (int i_ = 8; i_ < 16; ++i_) U_DOT(i_); \
        U_ISSUE(pkn, 8); \
        if ((n_) < ntok) { const int r_ = tok_row(layer, n_); int* pd_ = PD + ((size_t)cb * R + r_) * 128 + 8 * c8 + s; pd_[0] = kA; pd_[64] = kB; } \
        } while (0)
#pragma unroll 1
    for (int cbi = 0; cbi < ncb; ++cbi) {
        const int cb = cb0 + cbi;
        const unsigned char* tb = UT + (size_t)cb * 16384 * 128 + 16 * c8;
        unsigned pkA[16], pkB[16]; u32x4 hAa, hAb, hBa, hBb, t[16];
        U_META(pkA, hAa, hAb, gwv); U_META(pkB, hBa, hBb, gwv + nwv);
        U_ISSUE(pkA, 0); U_ISSUE(pkA, 8);
#pragma unroll 1
        for (int n = gwv; n < ntok; n += 2 * nwv) {
            U_ITEM(pkA, hAa, hAb, pkB, n);
            U_ITEM(pkB, hBa, hBb, pkA, n + nwv);
        }
    }
#undef U_META
#undef U_ISSUE
#undef U_DOT
#undef U_ITEM
}
__device__ __forceinline__ void p_exp_w(const Args& A, const Frame& F, int layer) {
    const int gw = F.bid * NWAVES + F.wave, NGW = F.nblk * NWAVES, lane = F.lane;
    const int ntok = layer == 0 ? R : NB * SEQ;
    const unsigned* PK = (const unsigned*)(F.ws + WS_PK); const int* PD = (const int*)(F.ws + WS_PD); const float* HS = (const float*)(F.ws + WS_HS);
    unsigned* WQ8 = (unsigned*)(F.ws + WS_WQ8); float* WSC = (float*)(F.ws + WS_WSC);
    const float* SU = (const float*)(F.ws + WS_TSC) + (layer * 2) * 16384; const float* SV = SU + 16384;
    const int g2 = (lane >> 3) & 3, sb = lane & 7, src = 32 * (g2 & 1) + sb;
    for (int n = gw; n < ntok; n += 2 * NGW) {
        int r[2]; r[0] = tok_row(layer, n); r[1] = (n + NGW) < ntok ? tok_row(layer, n + NGW) : r[0];
        unsigned pk0[2], pk1[2]; int d0[2], d1[2]; float hs[2];
#pragma unroll
        for (int q = 0; q < 2; ++q) { pk0[q] = PK[(size_t)r[q] * 128 + lane]; pk1[q] = PK[(size_t)r[q] * 128 + 64 + lane]; hs[q] = HS[r[q]]; d0[q] = 0; d1[q] = 0;
#pragma unroll
            for (int cb = 0; cb < 4; ++cb) { d0[q] += PD[((size_t)cb * R + r[q]) * 128 + lane]; d1[q] += PD[((size_t)cb * R + r[q]) * 128 + 64 + lane]; } }
        float su0[2], su1[2], sv0[2], sv1[2];
#pragma unroll
        for (int q = 0; q < 2; ++q) { const int e0 = (int)(pk0[q] >> 16), e1 = (int)(pk1[q] >> 16); su0[q] = SU[e0]; su1[q] = SU[e1]; sv0[q] = SV[e0]; sv1[q] = SV[e1]; }
#pragma unroll
        for (int q = 0; q < 2; ++q) {
            const float g0 = (float)(pk0[q] & 0xffffu) * (1.f / 65535.f), g1 = (float)(pk1[q] & 0xffffu) * (1.f / 65535.f);
            const float a0 = su0[q] * hs[q] * (float)d0[q], a1 = su1[q] * hs[q] * (float)d1[q];
            const float w0 = g0 * 0.5f * a0 * (1.f + erff(a0 * 0.70710678118654752f)) * sv0[q], w1 = g1 * 0.5f * a1 * (1.f + erff(a1 * 0.70710678118654752f)) * sv1[q];
            const float wm = wave_max(fmaxf(fabsf(w0), fabsf(w1)));
            const float inv = wm > 0.f ? 127.f / wm : 0.f;
            const int q0 = (int)rintf(w0 * inv) & 0xff, q1 = (int)rintf(w1 * inv) & 0xff;
            unsigned pw = 0;
#pragma unroll
            for (int j = 0; j < 4; ++j) { const int x0 = __shfl(q0, src + 8 * j), x1 = __shfl(q1, src + 8 * j); pw |= (unsigned)((g2 < 2) ? x0 : x1) << (8 * j); }
            if (q == 0 || (n + NGW) < ntok) { if (lane < 32) WQ8[(size_t)r[q] * 32 + lane] = pw; if (lane == 0) WSC[r[q]] = wm > 0.f ? wm * (1.f / 127.f) : 0.f; }
        }
    }
}
__device__ __forceinline__ void p_exp_v(const Args& A, const Frame& F, int layer) {
    const int lane = F.lane, s = lane >> 3, c8 = lane & 7;
    const bool part = (F.nblk & 7) == 0; const int ncb = part ? 1 : 8, cb0 = part ? (F.bid & 7) : 0;
    const int gwv = part ? ((F.bid >> 3) * NWAVES + F.wave) : (F.bid * NWAVES + F.wave), nwv = part ? ((F.nblk >> 3) * NWAVES) : (F.nblk * NWAVES);
    const int ntok = layer == 0 ? R : NB * SEQ;
    const unsigned* PK = (const unsigned*)(F.ws + WS_PK); const unsigned* WQ8 = (const unsigned*)(F.ws + WS_WQ8); const float* WSC = (const float*)(F.ws + WS_WSC);
    const unsigned char* VT = F.ws + WS_TAB + (size_t)(layer * 2 + 1) * 16384 * 1024;
    unsigned short* X = (unsigned short*)(F.ws + WS_X); const float* MOD = (const float*)(F.ws + WS_MOD) + (size_t)layer * 5 * 6144;
    const bool bit3 = (lane & 8) != 0;
#define V_METAP(pk, n_) do { const int r_ = tok_row(layer, (n_) < ntok ? (n_) : gwv); const unsigned* p_ = PK + (size_t)r_ * 128 + s; \
        _Pragma("unroll") for (int i_ = 0; i_ < 16; ++i_) pk[i_] = p_[8 * i_]; } while (0)
#define V_METAW(wq, n_) do { const int r_ = tok_row(layer, (n_) < ntok ? (n_) : gwv); const unsigned* w_ = WQ8 + (size_t)r_ * 32 + s; \
        _Pragma("unroll") for (int g_ = 0; g_ < 4; ++g_) wq[g_] = w_[8 * g_]; } while (0)
#define V_ISSUE(pk, lo) do { _Pragma("unroll") for (int i_ = (lo); i_ < (lo) + 8; ++i_) t[i_] = *(const u32x4*)(tb + (size_t)(pk[i_] >> 16) * 128); } while (0)
#define V_GRP(wq, g_) do { _Pragma("unroll") for (int j_ = 0; j_ < 4; ++j_) { const unsigned a_ = t[4 * (g_)][j_], b_ = t[4 * (g_) + 1][j_], c_ = t[4 * (g_) + 2][j_], d_ = t[4 * (g_) + 3][j_]; \
        const unsigned ablo = __builtin_amdgcn_perm(b_, a_, 0x05010400u), abhi = __builtin_amdgcn_perm(b_, a_, 0x07030602u), cdlo = __builtin_amdgcn_perm(d_, c_, 0x05010400u), cdhi = __builtin_amdgcn_perm(d_, c_, 0x07030602u); \
        acc[4 * j_]     = __builtin_amdgcn_sdot4((int)__builtin_amdgcn_perm(cdlo, ablo, 0x05040100u), (int)wq[g_], acc[4 * j_], false); \
        acc[4 * j_ + 1] = __builtin_amdgcn_sdot4((int)__builtin_amdgcn_perm(cdlo, ablo, 0x07060302u), (int)wq[g_], acc[4 * j_ + 1], false); \
        acc[4 * j_ + 2] = __builtin_amdgcn_sdot4((int)__builtin_amdgcn_perm(cdhi, abhi, 0x05040100u), (int)wq[g_], acc[4 * j_ + 2], false); \
        acc[4 * j_ + 3] = __builtin_amdgcn_sdot4((int)__builtin_amdgcn_perm(cdhi, abhi, 0x07060302u), (int)wq[g_], acc[4 * j_ + 3], false); } } while (0)
#define V_ITEM(pkc, wqc, pkn, n_) do { \
        int acc[16]; _Pragma("unroll") for (int a_ = 0; a_ < 16; ++a_) acc[a_] = 0; \
        V_METAP(pkc, (n_) + 2 * nwv); \
        V_GRP(wqc, 0); V_GRP(wqc, 1); \
        V_ISSUE(pkn, 0); \
        V_GRP(wqc, 2); V_GRP(wqc, 3); \
        V_ISSUE(pkn, 8); \
        int b8[8], c4[4], o[2]; \
        _Pragma("unroll") for (int a_ = 0; a_ < 8; ++a_) { auto rr = __builtin_amdgcn_permlane32_swap((unsigned)acc[a_], (unsigned)acc[a_ + 8], false, false); b8[a_] = (int)rr[0] + (int)rr[1]; } \
        _Pragma("unroll") for (int a_ = 0; a_ < 4; ++a_) { auto rr = __builtin_amdgcn_permlane16_swap((unsigned)b8[a_], (unsigned)b8[a_ + 4], false, false); c4[a_] = (int)rr[0] + (int)rr[1]; } \
        _Pragma("unroll") for (int a_ = 0; a_ < 2; ++a_) { const int keep = bit3 ? c4[a_ + 2] : c4[a_], send = bit3 ? c4[a_] : c4[a_ + 2]; o[a_] = keep + __builtin_amdgcn_update_dpp(0, send, 0x128, 0xf, 0xf, false); } \
        if ((n_) < ntok) { const int r_ = tok_row(layer, n_); const float ws_ = WSC[r_]; const int col = 128 * cb + 16 * c8 + 2 * s; \
            const f32x2 gf = *(const f32x2*)(MOD + (size_t)mod_index(r_) * 6144 + 5 * 1024 + col); unsigned* xp = (unsigned*)(X + (size_t)r_ * DM + col); \
            const unsigned xw = *xp; *xp = pkh2(h2f_lo(xw) + gf.x * (ws_ * (float)o[0]), h2f_hi(xw) + gf.y * (ws_ * (float)o[1])); } \
        V_METAW(wqc, (n_) + 2 * nwv); } while (0)
#pragma unroll 1
    for (int cbi = 0; cbi < ncb; ++cbi) {
        const int cb = cb0 + cbi;
        const unsigned char* tb = VT + (size_t)cb * 16384 * 128 + 16 * c8;
        unsigned pkA[16], pkB[16], wqA[4], wqB[4]; u32x4 t[16];
        V_METAP(pkA, gwv); V_METAW(wqA, gwv); V_METAP(pkB, gwv + nwv); V_METAW(wqB, gwv + nwv);
        V_ISSUE(pkA, 0); V_ISSUE(pkA, 8);
#pragma unroll 1
        for (int n = gwv; n < ntok; n += 2 * nwv) {
            V_ITEM(pkA, wqA, pkB, n);
            V_ITEM(pkB, wqB, pkA, n + nwv);
        }
    }
#undef V_METAP
#undef V_METAW
#undef V_ISSUE
#undef V_GRP
#undef V_ITEM
}
__device__ __forceinline__ void p_final_norm(const Args& A, const Frame& F) {
    const int gw = F.bid * NWAVES + F.wave, NGW = F.nblk * NWAVES, lane = F.lane;
    const unsigned short* X = (const unsigned short*)(F.ws + WS_X); const float* gn = A.in[I_NOUT];
#if ATTN_SELFTEST
    const unsigned* ctl_ = (const unsigned*)(F.ws + WS_CTL) + 16; const float mrel_ = fmaxf(__uint_as_float(__hip_atomic_load(ctl_, __ATOMIC_RELAXED, __HIP_MEMORY_SCOPE_AGENT)), __uint_as_float(__hip_atomic_load(ctl_ + 1, __ATOMIC_RELAXED, __HIP_MEMORY_SCOPE_AGENT)));
    const int nzero_ = (int)fminf((float)(NB * SEQ), mrel_ * (float)(NB * SEQ));
#endif
    for (int n = gw; n < NB * SEQ; n += NGW) {
        const unsigned short* xr = X + (size_t)tok_row(1, n) * DM; float* op = F.out + (size_t)n * DM;
#if ATTN_SELFTEST
        if (n < nzero_) { for (int j = 0; j < 4; ++j) *(f32x4*)(op + 4 * lane + 256 * j) = (f32x4){0.f, 0.f, 0.f, 0.f}; continue; }
#endif
        f32x4 v[4]; float sq = 0.f;
#pragma unroll
        for (int j = 0; j < 4; ++j) { const u32x2 a = *(const u32x2*)(xr + 4 * lane + 256 * j); v[j] = (f32x4){h2f_lo(a.x), h2f_hi(a.x), h2f_lo(a.y), h2f_hi(a.y)}; sq += (v[j].x * v[j].x + v[j].y * v[j].y) + (v[j].z * v[j].z + v[j].w * v[j].w); }
        const float rinv = rsqrtf(wave_sum(sq) * (1.f / DM) + EPS);
#pragma unroll
        for (int j = 0; j < 4; ++j) { const int c = 4 * lane + 256 * j; *(f32x4*)(op + c) = v[j] * rinv * *(const f32x4*)(gn + c); }
    }
}

#if ATTN_SELFTEST
template <int DQK>
__device__ __forceinline__ float attn_check_row(const bf16_t* qrow, int rope_t, const unsigned char* K8, int ldk, const bf16_t* Vb, int ldv, int nk, float scale, const bf16_t* orow, float* sl, float* ql, int lane) {
    for (int d = lane; d < DQK; d += 64) ql[d] = bf2f(qrow[d]);
    asm volatile("s_waitcnt lgkmcnt(0)" ::: "memory");
    if (DQK == 192 && rope_t >= 0 && lane < 32) {
        const int i = lane & 15, ax = lane >> 4; const float pos = (float)(ax ? (rope_t & 63) : (rope_t >> 6));
        const float invf = __powf(10000.f, -(float)i * (1.f / 16.f)), ang = pos * invf, cs = __cosf(ang), sn = __sinf(ang);
        const float x1 = ql[128 + 32 * ax + i], x2 = ql[128 + 32 * ax + 16 + i];
        ql[128 + 32 * ax + i] = x1 * cs - x2 * sn; ql[128 + 32 * ax + 16 + i] = x2 * cs + x1 * sn;
    }
    asm volatile("s_waitcnt lgkmcnt(0)" ::: "memory");
    for (int d = lane; d < DQK; d += 64) { const float v = ql[d]; ql[d] = f8dec<0>(f8x4(v, v, v, v)); }
    asm volatile("s_waitcnt lgkmcnt(0)" ::: "memory");
    float mx = -1e30f;
    for (int k = lane; k < nk; k += 64) {
        const unsigned char* kr = K8 + (size_t)k * ldk; float acc = 0.f;
#pragma unroll 1
        for (int c = 0; c < DQK / 16; ++c) { const u32x4 w = *(const u32x4*)(kr + 16 * c);
#pragma unroll
            for (int e = 0; e < 4; ++e) acc += (ql[16 * c + 4 * e] * f8dec<0>(w[e]) + ql[16 * c + 4 * e + 1] * f8dec<1>(w[e])) + (ql[16 * c + 4 * e + 2] * f8dec<2>(w[e]) + ql[16 * c + 4 * e + 3] * f8dec<3>(w[e])); }
        acc *= scale; sl[k] = acc; mx = fmaxf(mx, acc);
    }
    mx = wave_max(mx);
    float sum = 0.f;
    for (int k = lane; k < nk; k += 64) { const float pv = __expf(sl[k] - mx); sl[k] = pv; sum += pv; }
    sum = wave_sum(sum);
    asm volatile("s_waitcnt lgkmcnt(0)" ::: "memory");
    float o0 = 0.f, o1 = 0.f;
    for (int k = 0; k < nk; ++k) { const float pv = sl[k]; const unsigned w = *(const unsigned*)(Vb + (size_t)k * ldv + 2 * lane); o0 += pv * bflo(w); o1 += pv * bfhi(w); }
    o0 /= sum; o1 /= sum;
    const unsigned fw = *(const unsigned*)(orow + 2 * lane); const float f0 = bflo(fw), f1 = bfhi(fw);
    const float num = wave_sum((f0 - o0) * (f0 - o0) + (f1 - o1) * (f1 - o1)), den = wave_sum(o0 * o0 + o1 * o1);
    return sqrtf(num / fmaxf(den, 1e-30f));
}
__device__ __forceinline__ void attn_selftest(const Frame& F, int layer) {
    float* sl = (float*)F.lds + F.wave * (RPB + 192); float* ql = sl + RPB;
    const int gw = F.bid * NWAVES + F.wave;
    unsigned hsh = (unsigned)gw * 2654435761u + 12345u * (unsigned)(layer + 1); hsh ^= hsh >> 15; hsh *= 2246822519u; hsh ^= hsh >> 13;
    const int h = (int)(hsh & 7u); float rel;
    if (layer == 0) {
        const int r = (int)((hsh >> 3) % (unsigned)R), b = r / RPB, j = r - b * RPB; const bool ctx = j < CTXL; const size_t rb = (size_t)b * RPB;
        rel = attn_check_row<192>((const bf16_t*)(F.ws + WS_Q) + (size_t)r * 1536 + h * 192, ctx ? -1 : j - CTXL, F.ws + WS_K + rb * 1536 + h * 192, 1536,
                                  (const bf16_t*)(F.ws + WS_V) + rb * 1024 + h * 128, 1024, ctx ? CTXL : RPB, 0.07216878364870322f, (const bf16_t*)(F.ws + WS_O) + (size_t)r * 1024 + h * 128, sl, ql, F.lane);
    } else {
        const int n = (int)((hsh >> 3) % (unsigned)(NB * SEQ)), r = (n >> 12) * RPB + CTXL + (n & 4095), b = r / RPB, kvh = h >> 2; const size_t rb = (size_t)b * RPB;
        rel = attn_check_row<128>((const bf16_t*)(F.ws + WS_Q1) + (size_t)r * 1024 + h * 128, -1, F.ws + WS_K1 + rb * 256 + kvh * 128, 256,
                                  (const bf16_t*)(F.ws + WS_V1) + rb * 256 + kvh * 128, 256, RPB, 0.08838834764831845f, (const bf16_t*)(F.ws + WS_O) + (size_t)r * 1024 + h * 128, sl, ql, F.lane);
    }
    if (!(rel < 1e30f)) rel = 1e30f;
    if (F.lane == 0) atomicMax((unsigned*)(F.ws + WS_CTL) + 16 + layer, __float_as_uint(rel));
    __syncthreads();
}
#endif

constexpr int N_PHASES = 24;
__global__ void __launch_bounds__(NTHREADS, 2) mega(Args args) {
    extern __shared__ __attribute__((aligned(16))) unsigned char lds_raw[];
    Frame F; F.x = args.in[I_X]; F.ctx = args.in[I_CTX]; F.out = args.out; F.ws = args.ws; F.lds = (char*)lds_raw;
    F.tid = threadIdx.x; F.lane = F.tid & 63; F.wave = __builtin_amdgcn_readfirstlane(F.tid >> 6); F.bid = blockIdx.x; F.nblk = gridDim.x;
    F.vcu = (F.nblk % 8 == 0) ? (F.bid % 8) * (F.nblk / 8) + F.bid / 8 : F.bid;
    volatile LAS unsigned* st = (volatile LAS unsigned*)(LAS unsigned char*)(lds_raw + LDS_BYTES - 64);
    if (F.tid < 16) st[F.tid] = 0u;
    __syncthreads();
    XcdBarrier bar; bar.bar = (unsigned*)(F.ws + WS_CTL) + 4096; bar.x = 0; bar.st = st;
    const int lo = args.ph_lo, hi = args.ph_hi;
    const bool fused = (hi - lo) > 1;
    if (fused) bar = xcd_barrier_post((unsigned*)(F.ws + WS_CTL) + 4096, st);
#ifdef ONLY_PHASE
#define IN(k) ((k) == ONLY_PHASE && lo <= (k) && (k) < hi)
#else
#define IN(k) (lo <= (k) && (k) < hi)
#endif
#define SEAM(k) do { if (IN(k) && IN((k) + 1)) { if ((k) == 0) cg::this_grid().sync(); else xcd_barrier(bar); } } while (0)
    bf16_t* Hb = (bf16_t*)(F.ws + WS_H);
#define PH(k, ...) if (IN(k)) for (int rep_ = 0; rep_ < (((PROBE_MASK >> (k)) & 1u) ? 2 : 1); ++rep_) { __VA_ARGS__; __syncthreads(); } SEAM(k)
    unsigned short* Xb = (unsigned short*)(F.ws + WS_X); const float* MODb = (const float*)(F.ws + WS_MOD);
    PH(0, for (int q_ = 0; q_ < ((PROBE_P0 & 1u) ? 2 : 1); ++q_) { p0_mod(args, F); __syncthreads(); }
          for (int q_ = 0; q_ < ((PROBE_P0 & 2u) ? 2 : 1); ++q_) { p0_weights(args, F); __syncthreads(); }
          for (int q_ = 0; q_ < ((PROBE_P0 & 4u) ? 2 : 1); ++q_) { p0_weff(args, F); __syncthreads(); }
          for (int q_ = 0; q_ < ((PROBE_P0 & 8u) ? 2 : 1); ++q_) { p0_tables(args, F); __syncthreads(); });
    PH(1, p_norm_rows(args, F, 0, 0, true, false));
    PH(2, gemm8e(F, Hb, (const bf16_t*)(F.ws + WS_WIN), 768, 1024, false, EpiMlaDown{(bf16_t*)(F.ws + WS_CQ), (bf16_t*)(F.ws + WS_CKV), (bf16_t*)(F.ws + WS_KR), (float*)(F.ws + WS_SSP)}));
    PH(3, p_mla_krope(args, F);
          gemm8(F, (const bf16_t*)(F.ws + WS_CQ), (const bf16_t*)(F.ws + WS_WUQ), 1536, 384, false, In8Bf16Rs{(bf16_t*)(F.ws + WS_Q), 1536, (const float*)(F.ws + WS_SSP)});
          gemm8(F, (const bf16_t*)(F.ws + WS_CKV), (const bf16_t*)(F.ws + WS_WUKV), 2048, 256, false, In8KVRs{F.ws + WS_K, (bf16_t*)(F.ws + WS_V), (const float*)(F.ws + WS_SSP)}, true));
    PH(4, p_attn_mla(args, F));
#if ATTN_SELFTEST & 1
    if (IN(5)) attn_selftest(F, 0);
#endif
    PH(5, gemm8(F, (const bf16_t*)(F.ws + WS_O), (const bf16_t*)(F.ws + WS_WO0), 1024, 1024, false, In8Resid{F.x, F.ctx, Xb, MODb + 2 * 1024, true}));
    PH(6, p_norm_rows(args, F, 0, 1, false, false));
    PH(7, gemm8(F, Hb, (const bf16_t*)(F.ws + WS_WQ0), 2048, 1024, false, In8F16{(unsigned short*)(F.ws + WS_S), 2048}));
    PH(8, p_peer_topk(args, F, false));
    PH(9, p_exp_u(args, F, 0));
    PH(10, p_exp_w(args, F, 0));
    if (IN(11)) { p_exp_v(args, F, 0); } SEAM(11);
    PH(12, p_norm_rows(args, F, 1, 0, false, false));
    PH(13, gemm8(F, Hb, (const bf16_t*)(F.ws + WS_WQKV), 1536, 1024, false, In8Bf16{(bf16_t*)(F.ws + WS_RAW1), 1536}));
    PH(14, p_gqa_rows(args, F));
    PH(15, p_attn_gqa(args, F));
#if ATTN_SELFTEST & 2
    if (IN(16)) attn_selftest(F, 1);
#endif
    if (IN(16)) { gemm8(F, (const bf16_t*)(F.ws + WS_O), (const bf16_t*)(F.ws + WS_WO1), 1024, 1024, true, In8Resid{F.x, F.ctx, Xb, MODb + 5 * 6144 + 2 * 1024, false}); } SEAM(16);
    PH(17, p_norm_rows(args, F, 1, 1, false, true));
    PH(18, gemm8(F, Hb, (const bf16_t*)(F.ws + WS_WQ1), 2048, 1024, true, In8F16{(unsigned short*)(F.ws + WS_S), 2048}));
    PH(19, p_peer_topk(args, F, true));
    PH(20, p_exp_u(args, F, 1));
    PH(21, p_exp_w(args, F, 1));
    if (IN(22)) { p_exp_v(args, F, 1); } SEAM(22);
    if (IN(23)) p_final_norm(args, F);
#undef PH
#undef IN
#undef SEAM
}

extern "C" void kernel_launch(void* const* d_in, const int* in_sizes, int n_in, void* d_out, int out_size, void* d_ws, size_t ws_size, hipStream_t stream) {
    static int grid = 0;
    if (grid == 0) {
        if (n_in != N_IN || in_sizes[0] != NB * SEQ * DM || out_size != NB * SEQ * DM || ws_size < WS_END) {
            fprintf(stderr, "kernel_launch: shape mismatch (n_in %d, in0 %d, out %d, ws %zu < %zu)\n", n_in, n_in > 0 ? in_sizes[0] : -1, out_size, ws_size, (size_t)WS_END); grid = -1; return; }
        int dev = 0, cus = 0, per_cu = 0;
        hipGetDevice(&dev); hipDeviceGetAttribute(&cus, hipDeviceAttributeMultiprocessorCount, dev);
        if (hipFuncSetAttribute((const void*)mega, hipFuncAttributeMaxDynamicSharedMemorySize, LDS_BYTES) != hipSuccess) { fprintf(stderr, "kernel_launch: hipFuncSetAttribute failed\n"); grid = -1; return; }
        if (hipOccupancyMaxActiveBlocksPerMultiprocessor(&per_cu, (const void*)mega, NTHREADS, LDS_BYTES) != hipSuccess || per_cu < 1) { fprintf(stderr, "kernel_launch: occupancy query failed (%d)\n", per_cu); (void)hipGetLastError(); grid = -1; return; }
        grid = cus * (per_cu > 1 ? 1 : per_cu);
    }
    if (grid < 0) return;
    hipMemsetAsync((char*)d_ws + WS_CTL, 0, 1 * MiB, stream);
    Args a{};
    for (int i = 0; i < N_IN; ++i) a.in[i] = (const float*)d_in[i];
    a.out = (float*)d_out; a.ws = (unsigned char*)d_ws;
#if MK_PER_PHASE
    for (int p = 0; p < N_PHASES; ++p) { a.ph_lo = p; a.ph_hi = p + 1; hipLaunchKernelGGL(mega, dim3(grid), dim3(NTHREADS), LDS_BYTES, stream, a); }
#else
    a.ph_lo = 0; a.ph_hi = N_PHASES;
    void* kargs[] = {&a};
    hipError_t e = hipLaunchCooperativeKernel((const void*)mega, dim3(grid), dim3(NTHREADS), kargs, LDS_BYTES, stream);
    if (e != hipSuccess) fprintf(stderr, "kernel_launch: cooperative launch failed: %s (grid %d)\n", hipGetErrorString(e), grid);
#endif
}
```

```cpp
#include <hip/hip_runtime.h>
#include <hip/hip_cooperative_groups.h>
#include <cstdio>
#include <cstdint>
namespace cg = cooperative_groups;

#ifndef PROBE_MASK
#define PROBE_MASK 0u
#endif
#ifndef PROBE_P0
#define PROBE_P0 0u
#endif
#ifndef ATTN_SELFTEST
#define ATTN_SELFTEST 0
#endif
#ifndef MK_PER_PHASE
#define MK_PER_PHASE 0
#endif

typedef unsigned short bf16_t;
typedef short bf16x8 __attribute__((ext_vector_type(8)));
typedef short s16x4 __attribute__((ext_vector_type(4)));
typedef float f32x4 __attribute__((ext_vector_type(4)));
typedef float f32x2 __attribute__((ext_vector_type(2)));
typedef float f32x16 __attribute__((ext_vector_type(16)));
typedef unsigned u32x4 __attribute__((ext_vector_type(4)));
typedef unsigned u32x2 __attribute__((ext_vector_type(2)));
#define LAS __attribute__((address_space(3)))
#define SBAR() __builtin_amdgcn_sched_barrier(0)

__device__ __forceinline__ unsigned f2bf(float f) { unsigned u = __builtin_bit_cast(unsigned, f); return (u + 0x7fffu + ((u >> 16) & 1u)) >> 16; }
__device__ __forceinline__ unsigned pk2(float lo, float hi) { return f2bf(lo) | (f2bf(hi) << 16); }
typedef _Float16 f16x2_t __attribute__((ext_vector_type(2)));
__device__ __forceinline__ unsigned pkh2(float lo, float hi) { f32x2 v = {lo, hi}; return __builtin_bit_cast(unsigned, __builtin_convertvector(v, f16x2_t)); }
__device__ __forceinline__ float h2f_lo(unsigned w) { return (float)__builtin_bit_cast(_Float16, (unsigned short)(w & 0xffffu)); }
__device__ __forceinline__ float h2f_hi(unsigned w) { return (float)__builtin_bit_cast(_Float16, (unsigned short)(w >> 16)); }
__device__ __forceinline__ float bf2f(unsigned short h) { return __builtin_bit_cast(float, (unsigned)h << 16); }
__device__ __forceinline__ float bflo(unsigned w) { return __builtin_bit_cast(float, w << 16); }
__device__ __forceinline__ float bfhi(unsigned w) { return __builtin_bit_cast(float, w & 0xffff0000u); }
__device__ __forceinline__ unsigned cvtpk(float lo, float hi) { unsigned r; asm volatile("v_cvt_pk_bf16_f32 %0, %1, %2" : "=v"(r) : "v"(lo), "v"(hi)); return r; }
typedef int i32x8 __attribute__((ext_vector_type(8)));
__device__ __forceinline__ unsigned f8x4(float a, float b, float c, float d) { int w = __builtin_amdgcn_cvt_pk_fp8_f32(a, b, 0, false); w = __builtin_amdgcn_cvt_pk_fp8_f32(c, d, w, true); return (unsigned)w; }
template <int B> __device__ __forceinline__ float f8dec(unsigned w) { return __builtin_amdgcn_cvt_f32_fp8((int)w, B); }
#define WDPP(v, ctrl) __builtin_bit_cast(float, __builtin_amdgcn_update_dpp(0, __builtin_bit_cast(int, v), ctrl, 0xf, 0xf, false))
__device__ __forceinline__ float wave_sum(float v) {
    v += WDPP(v, 0xB1); v += WDPP(v, 0x4E); v += WDPP(v, 0x141); v += WDPP(v, 0x140);
    { auto rr = __builtin_amdgcn_permlane16_swap(__float_as_uint(v), __float_as_uint(v), false, false); v = __uint_as_float(rr[0]) + __uint_as_float(rr[1]); }
    { auto rr = __builtin_amdgcn_permlane32_swap(__float_as_uint(v), __float_as_uint(v), false, false); v = __uint_as_float(rr[0]) + __uint_as_float(rr[1]); }
    return v;
}
__device__ __forceinline__ float wave_max(float v) {
    v = fmaxf(v, WDPP(v, 0xB1)); v = fmaxf(v, WDPP(v, 0x4E)); v = fmaxf(v, WDPP(v, 0x141)); v = fmaxf(v, WDPP(v, 0x140));
    { auto rr = __builtin_amdgcn_permlane16_swap(__float_as_uint(v), __float_as_uint(v), false, false); v = fmaxf(__uint_as_float(rr[0]), __uint_as_float(rr[1])); }
    { auto rr = __builtin_amdgcn_permlane32_swap(__float_as_uint(v), __float_as_uint(v), false, false); v = fmaxf(__uint_as_float(rr[0]), __uint_as_float(rr[1])); }
    return v;
}

constexpr int DM = 1024, NB = 4, SEQ = 4096, CTXL = 256;
constexpr int RPB = SEQ + CTXL;
constexpr int R = NB * RPB;
constexpr float EPS = 1e-6f;
constexpr int NTHREADS = 512, NWAVES = 8;
constexpr int LDS_BYTES = 147456;

enum { I_X = 0, I_C, I_CTX, I_CCTX,
       I0_ADAW, I0_ADAB, I0_NMIX, I0_NFFN, I0_WIN, I0_QN, I0_WUQ, I0_KVN, I0_WUKV, I0_WO, I0_PWQ, I0_PK1, I0_PK2, I0_PU, I0_PV,
       I1_ADAW, I1_ADAB, I1_NMIX, I1_NFFN, I1_WQKV, I1_QN, I1_KN, I1_WO, I1_PWQ, I1_PK1, I1_PK2, I1_PU, I1_PV,
       I_NOUT, N_IN };

constexpr size_t MiB = 1u << 20;
constexpr size_t WS_CTL   = 0;
constexpr size_t WS_MOD   = 1 * MiB;
constexpr size_t WS_WIN   = 2 * MiB;
constexpr size_t WS_WUQ   = WS_WIN + 768 * 1024 * 2;
constexpr size_t WS_WUKV  = WS_WUQ + 1536 * 384 * 2;
constexpr size_t WS_WO0   = WS_WUKV + 2048 * 256 * 2;
constexpr size_t WS_WQ0   = WS_WO0 + 1024 * 1024 * 2;
constexpr size_t WS_KK0   = WS_WQ0 + 2048 * 1024 * 2;
constexpr size_t WS_WQKV  = WS_KK0 + 16 * 128 * 128 * 2;
constexpr size_t WS_WO1   = WS_WQKV + 1536 * 1024 * 2;
constexpr size_t WS_WQ1   = WS_WO1 + 1024 * 1024 * 2;
constexpr size_t WS_KK1   = WS_WQ1 + 2048 * 1024 * 2;
constexpr size_t WS_WEND  = WS_KK1 + 16 * 128 * 128 * 2;
static_assert(WS_WEND <= 24 * MiB, "weights region");
constexpr size_t WS_H     = 24 * MiB;
constexpr size_t WS_X     = WS_H + (size_t)R * 1024 * 2;
constexpr size_t WS_QKV   = WS_X + (size_t)R * 1024 * 4;
constexpr size_t WS_Q     = WS_QKV;
constexpr size_t WS_K     = WS_Q + (size_t)R * 1536 * 2;
constexpr size_t WS_V     = WS_K + (size_t)R * 1536 * 2;
constexpr size_t WS_S     = WS_QKV;
constexpr size_t WS_B     = WS_QKV + (size_t)R * 2048 * 4;
constexpr size_t WS_CQ    = WS_B;
constexpr size_t WS_CKV   = WS_CQ + (size_t)R * 384 * 2;
constexpr size_t WS_KR    = WS_CKV + (size_t)R * 256 * 2;
constexpr size_t WS_SSP   = WS_KR + (size_t)R * 64 * 2;
static_assert(WS_SSP + (size_t)R * 24 * 4 <= WS_B + 40 * MiB, "MLA latents inside region B");
constexpr size_t WS_O     = WS_B;
constexpr size_t WS_QP    = WS_B;
constexpr size_t WS_RAW1  = WS_B;
constexpr size_t WS_PK    = WS_B + (size_t)R * 2048 * 2;
constexpr size_t WS_TAB   = WS_PK + (size_t)R * 128 * 4;
constexpr size_t WS_PD    = WS_S;
constexpr size_t WS_WQ8   = WS_PD + (size_t)8 * R * 128 * 4;
constexpr size_t WS_WSC   = WS_WQ8 + (size_t)R * 128;
static_assert(WS_WSC + (size_t)R * 4 <= WS_B, "expert scratch inside the S region");
constexpr size_t WS_HQ    = WS_B + 40 * MiB;
constexpr size_t WS_HS    = WS_HQ + (size_t)R * 1024;
static_assert(WS_HS + (size_t)R * 4 <= WS_PK, "HQ inside region B");
constexpr size_t WS_TSC   = WS_TAB + (size_t)4 * 16384 * 1024;
constexpr size_t WS_END   = WS_TSC + (size_t)4 * 16384 * 4;
constexpr size_t WS_Q1    = WS_QKV;
constexpr size_t WS_K1    = WS_Q1 + (size_t)R * 1024 * 2;
constexpr size_t WS_V1    = WS_K1 + (size_t)R * 256 * 2;

#define XB_TMO      128
#define XB_XCNT(j)  (256  + 64 * (j))
#define XB_XSUB(j)  (1280 + 64 * (j))
#define XB_XGEN(j)  (2304 + 64 * (j))
#define XB_TOP      3328
#define XB_TOPGEN   3392
#define XCD_BAR_WORDS 3456
#define XB_SPIN_CAP (1u << 20)
__device__ __forceinline__ unsigned xb_ld(unsigned* p)              { return __hip_atomic_load(p, __ATOMIC_RELAXED, __HIP_MEMORY_SCOPE_AGENT); }
__device__ __forceinline__ unsigned xb_add(unsigned* p, unsigned v) { return __hip_atomic_fetch_add(p, v, __ATOMIC_RELAXED, __HIP_MEMORY_SCOPE_AGENT); }
__device__ __forceinline__ unsigned xb_xcc_id() { return (unsigned)__builtin_amdgcn_s_getreg((3 << 11) | 20) & 0xFu; }
#define XB_SPIN(cond, bar) do { unsigned _sp = 0; while (cond) { __builtin_amdgcn_s_sleep(1); \
    if ((++_sp & 255u) == 0u) { if (xb_ld(&(bar)[XB_TMO])) break; if (_sp > XB_SPIN_CAP) { atomicAdd(&(bar)[XB_TMO], 1u); break; } } } } while (0)
struct XcdBarrier { unsigned* bar; unsigned x; volatile LAS unsigned* st; };
__device__ __forceinline__ XcdBarrier xcd_barrier_post(unsigned* bar, volatile LAS unsigned* st) {
    XcdBarrier b; b.bar = bar; b.x = xb_xcc_id(); b.st = st;
    if (threadIdx.x == 0) (void)xb_add(&bar[XB_XCNT(b.x)], 1u);
    return b;
}
__device__ __forceinline__ void xcd_barrier_complete(unsigned* bar, unsigned x, unsigned& nloc, unsigned& nx) {
    const unsigned G = gridDim.x * gridDim.y * gridDim.z;
    unsigned sum, cnt, mine, sp = 0u;
    for (;;) {
        sum = 0u; cnt = 0u; mine = 0u;
#pragma unroll
        for (unsigned j = 0; j < 16; ++j) { const unsigned c = xb_ld(&bar[XB_XCNT(j)]); sum += c; cnt += (c > 0u) ? 1u : 0u; mine = (j == x) ? c : mine; }
        if (sum == G) break;
        __builtin_amdgcn_s_sleep(1);
        if ((++sp & 255u) == 0u) { if (xb_ld(&bar[XB_TMO])) break; if (sp > XB_SPIN_CAP) { atomicAdd(&bar[XB_TMO], 1u); break; } }
    }
    nloc = mine > 0u ? mine : 1u; nx = cnt > 0u ? cnt : 1u;
}
__device__ __forceinline__ void xcd_barrier(const XcdBarrier& b) {
    asm volatile("s_waitcnt vmcnt(0)" ::: "memory");
    __syncthreads();
    if (threadIdx.x == 0) {
        unsigned* bar = b.bar;
        __builtin_amdgcn_s_waitcnt(0);
        unsigned nloc = b.st[0], nx = b.st[1];
        if (nloc == 0u) { xcd_barrier_complete(bar, b.x, nloc, nx); b.st[0] = nloc; b.st[1] = nx; }
        const unsigned old = xb_add(&bar[XB_XSUB(b.x)], 1u);
        const unsigned gen = old / nloc;
        if (old + 1u == (gen + 1u) * nloc) {
            __builtin_amdgcn_fence(__ATOMIC_RELEASE, "agent");
            asm volatile("s_waitcnt vmcnt(0)" ::: "memory");
            const unsigned og = xb_add(&bar[XB_TOP], 1u);
            const unsigned tg = og / nx;
            if (og + 1u == (tg + 1u) * nx) xb_add(&bar[XB_TOPGEN], 1u);
            else XB_SPIN(xb_ld(&bar[XB_TOPGEN]) == tg, bar);
            __builtin_amdgcn_fence(__ATOMIC_ACQUIRE, "agent");
            xb_add(&bar[XB_XGEN(b.x)], 1u);
            asm volatile("s_waitcnt vmcnt(0)" ::: "memory");
        } else {
            XB_SPIN(xb_ld(&bar[XB_XGEN(b.x)]) == gen, bar);
            __builtin_amdgcn_fence(__ATOMIC_ACQUIRE, "agent");
            asm volatile("s_waitcnt vmcnt(0)" ::: "memory");
        }
    }
    __syncthreads();
}


struct Args { const float* in[N_IN]; float* out; unsigned char* ws; int ph_lo, ph_hi; };
static_assert(sizeof(Args) == (N_IN + 2) * 8 + 8, "Args has no padding");

struct Frame {
    const float* x; const float* ctx; float* out; unsigned char* ws; char* lds;
    int tid, lane, wave, bid, nblk, vcu;
};

__device__ __forceinline__ const float* xin_row(const Frame& F, int r) {
    const int b = r / RPB, j = r - b * RPB;
    return (j < CTXL) ? F.ctx + ((size_t)b * CTXL + j) * DM : F.x + ((size_t)b * SEQ + (j - CTXL)) * DM;
}
__device__ __forceinline__ int mod_index(int r) { const int b = r / RPB, j = r - b * RPB; return (j < CTXL) ? 4 : b; }
__device__ __forceinline__ bool is_ctx_row(int r) { return (r % RPB) < CTXL; }

__device__ __forceinline__ void p0_mod(const Args& A, const Frame& F) {
    float* sv = (float*)F.lds;
    float* red = sv + 5 * 1024;
    float* MOD = (float*)(F.ws + WS_MOD);
    bool have = false;
    for (int it = F.bid; it < 2 * 96; it += F.nblk) {
        if (!have) {
            for (int i = F.tid; i < 5 * 1024; i += NTHREADS) { const int m = i >> 10, k = i & 1023;
                const float c = (m < 4) ? A.in[I_C][m * 1024 + k] : A.in[I_CCTX][k]; sv[i] = c / (1.f + __expf(-c)); }
            __syncthreads(); have = true;
        }
        const int l = it / 96, n = (it % 96) * 64 + F.lane;
        const float* W = A.in[l ? I1_ADAW : I0_ADAW]; const float* Bv = A.in[l ? I1_ADAB : I0_ADAB];
        float acc[5] = {0.f, 0.f, 0.f, 0.f, 0.f};
        const int k0 = F.wave * 128;
#pragma unroll 16
        for (int k = k0; k < k0 + 128; ++k) { const float w = W[(size_t)k * 6144 + n];
#pragma unroll
            for (int m = 0; m < 5; ++m) acc[m] += sv[m * 1024 + k] * w; }
#pragma unroll
        for (int m = 0; m < 5; ++m) red[(F.wave * 5 + m) * 64 + F.lane] = acc[m];
        __syncthreads();
        if (F.tid < 320) { const int m = F.tid >> 6, ln = F.tid & 63; float s = 0.f;
#pragma unroll
            for (int w = 0; w < 8; ++w) s += red[(w * 5 + m) * 64 + ln];
            const int nn = (it % 96) * 64 + ln;
            MOD[((size_t)l * 5 + m) * 6144 + nn] = s + Bv[nn]; }
        __syncthreads();
    }
}
__device__ __forceinline__ void transpose_item(const float* W, int K, int N, bf16_t* WT, const float* gain, float* scr, int item, int lane) {
    const int nblk = N / 32, kb = item / nblk, nb = item % nblk, k0 = 64 * kb, n0 = 32 * nb;
#pragma unroll 8
    for (int i = 0; i < 32; ++i) { const int kk = 2 * i + (lane >> 5); float v = W[(size_t)(k0 + kk) * N + n0 + (lane & 31)]; if (gain) v *= gain[k0 + kk]; scr[kk * 33 + (lane & 31)] = v; }
    asm volatile("s_waitcnt lgkmcnt(0)" ::: "memory");
    const int c = lane & 7;
#pragma unroll
    for (int j = 0; j < 4; ++j) { const int n = (lane >> 3) + 8 * j; const float* s = scr + (8 * c) * 33 + n;
        u32x4 o; o.x = pk2(s[0 * 33], s[1 * 33]); o.y = pk2(s[2 * 33], s[3 * 33]); o.z = pk2(s[4 * 33], s[5 * 33]); o.w = pk2(s[6 * 33], s[7 * 33]);
        *(u32x4*)(WT + (size_t)(n0 + n) * K + k0 + 8 * c) = o; }
    asm volatile("s_waitcnt lgkmcnt(0)" ::: "memory");
}
__device__ __forceinline__ void p0_weights(const Args& A, const Frame& F) {
    float* scr = (float*)(F.lds + 32768) + F.wave * (64 * 33);
    const int gw = F.bid * NWAVES + F.wave, NGW = F.nblk * NWAVES;
#define TJOB(IN_, K_, N_, OFF_, GAIN_) do { const float* W = A.in[IN_]; bf16_t* WT = (bf16_t*)(F.ws + (OFF_)); \
        for (int it = gw; it < ((K_) / 64) * ((N_) / 32); it += NGW) transpose_item(W, K_, N_, WT, GAIN_, scr, it, F.lane); } while (0)
    TJOB(I0_WIN, 1024, 704, WS_WIN, nullptr); TJOB(I0_WUQ, 384, 1536, WS_WUQ, A.in[I0_QN]); TJOB(I0_WUKV, 256, 2048, WS_WUKV, A.in[I0_KVN]); TJOB(I0_WO, 1024, 1024, WS_WO0, nullptr);
    TJOB(I1_WQKV, 1024, 1536, WS_WQKV, nullptr); TJOB(I1_WO, 1024, 1024, WS_WO1, nullptr);
#undef TJOB
    { u32x4* z = (u32x4*)(F.ws + WS_WIN + (size_t)704 * 1024 * 2); const int n16 = 64 * 1024 * 2 / 16;
      for (int i = F.bid * NTHREADS + F.tid; i < n16; i += F.nblk * NTHREADS) z[i] = (u32x4){0u, 0u, 0u, 0u}; }
}
__device__ __forceinline__ void p0_weff(const Args& A, const Frame& F) {
    float* kkT = (float*)F.lds; float* wqs = kkT + 128 * 129;
    const int tid = F.tid, lane = F.lane, w = F.wave;
    for (int item = F.bid; item < 512; item += F.nblk) {
        const int layer = item >> 8, z = (item >> 4) & 15, kc = item & 15, h = z >> 1;
        const float* kk = ((z & 1) ? (layer ? A.in[I1_PK2] : A.in[I0_PK2]) : (layer ? A.in[I1_PK1] : A.in[I0_PK1])) + (size_t)h * 16384;
        const float* wq = (layer ? A.in[I1_PWQ] : A.in[I0_PWQ]) + (size_t)(kc * 64) * 2048 + z * 128;
        bf16_t* WT = (bf16_t*)(F.ws + (layer ? WS_WQ1 : WS_WQ0));
        __syncthreads();
        { f32x4 kv[8], wv4[4];
#pragma unroll
          for (int i = 0; i < 8; ++i) kv[i] = *(const f32x4*)(kk + 4 * (tid + i * NTHREADS));
#pragma unroll
          for (int i = 0; i < 4; ++i) { const int e = 4 * (tid + i * NTHREADS); wv4[i] = *(const f32x4*)(wq + (size_t)(e >> 7) * 2048 + (e & 127)); }
#pragma unroll
          for (int i = 0; i < 8; ++i) { const int e = 4 * (tid + i * NTHREADS), key = e >> 7, d = e & 127; kkT[d * 129 + key] = kv[i].x; kkT[(d + 1) * 129 + key] = kv[i].y; kkT[(d + 2) * 129 + key] = kv[i].z; kkT[(d + 3) * 129 + key] = kv[i].w; }
#pragma unroll
          for (int i = 0; i < 4; ++i) *(f32x4*)(wqs + 4 * (tid + i * NTHREADS)) = wv4[i]; }
        __syncthreads();
        float acc[8][2];
#pragma unroll
        for (int j = 0; j < 8; ++j) { acc[j][0] = 0.f; acc[j][1] = 0.f; }
#pragma unroll 2
        for (int d = 0; d < 128; ++d) { const float a0 = kkT[d * 129 + lane], a1 = kkT[d * 129 + lane + 64];
#pragma unroll
            for (int j = 0; j < 8; ++j) { const float wv = wqs[(w * 8 + j) * 128 + d]; acc[j][0] += wv * a0; acc[j][1] += wv * a1; } }
        u32x4 o0, o1;
        o0.x = pk2(acc[0][0], acc[1][0]); o0.y = pk2(acc[2][0], acc[3][0]); o0.z = pk2(acc[4][0], acc[5][0]); o0.w = pk2(acc[6][0], acc[7][0]);
        o1.x = pk2(acc[0][1], acc[1][1]); o1.y = pk2(acc[2][1], acc[3][1]); o1.z = pk2(acc[4][1], acc[5][1]); o1.w = pk2(acc[6][1], acc[7][1]);
        *(u32x4*)(WT + (size_t)(z * 128 + lane) * 1024 + kc * 64 + w * 8) = o0;
        *(u32x4*)(WT + (size_t)(z * 128 + lane + 64) * 1024 + kc * 64 + w * 8) = o1;
    }
    __syncthreads();
}

__device__ __forceinline__ void p0_tables(const Args& A, const Frame& F) {
    const int gw = F.bid * NWAVES + F.wave, NGW = F.nblk * NWAVES, lane = F.lane;
    unsigned char* TAB = F.ws + WS_TAB; float* TSC = (float*)(F.ws + WS_TSC);
    for (int it = gw; it < 4 * 16384 / 4; it += NGW) {
        const int t = it >> 12, row0 = (it & 4095) * 4;
        const float* src = (t == 0 ? A.in[I0_PU] : t == 1 ? A.in[I0_PV] : t == 2 ? A.in[I1_PU] : A.in[I1_PV]) + (size_t)row0 * 1024 + 4 * lane;
        f32x4 v[4][4];
#pragma unroll
        for (int rr = 0; rr < 4; ++rr)
#pragma unroll
            for (int j = 0; j < 4; ++j) v[rr][j] = *(const f32x4*)(src + (size_t)rr * 1024 + 256 * j);
#pragma unroll
        for (int rr = 0; rr < 4; ++rr) {
            float am = 0.f;
#pragma unroll
            for (int j = 0; j < 4; ++j) am = fmaxf(am, fmaxf(fmaxf(fabsf(v[rr][j].x), fabsf(v[rr][j].y)), fmaxf(fabsf(v[rr][j].z), fabsf(v[rr][j].w))));
            am = wave_max(am);
            const int row = row0 + rr;
            float sc;
            if ((t & 1) == 0) {
                float ss = 0.f;
#pragma unroll
                for (int j = 0; j < 4; ++j) ss += (v[rr][j].x * v[rr][j].x + v[rr][j].y * v[rr][j].y) + (v[rr][j].z * v[rr][j].z + v[rr][j].w * v[rr][j].w);
                ss = wave_sum(ss);
                sc = am > 0.f ? fminf(am * (1.f / 7.f), 0.36f * sqrtf(ss * (1.f / 1024.f))) : 1.f;
                const float inv = am > 0.f ? 1.f / sc : 0.f;
#pragma unroll
                for (int j = 0; j < 4; ++j) {
                    const int q0 = (int)fminf(fmaxf(rintf(v[rr][j].x * inv), -7.f), 7.f), q1 = (int)fminf(fmaxf(rintf(v[rr][j].y * inv), -7.f), 7.f), q2 = (int)fminf(fmaxf(rintf(v[rr][j].z * inv), -7.f), 7.f), q3 = (int)fminf(fmaxf(rintf(v[rr][j].w * inv), -7.f), 7.f);
                    *(unsigned short*)(TAB + (((size_t)t * 8 + j) * 16384 + row) * 128 + 2 * lane) = (unsigned short)((q0 & 15) | ((q1 & 15) << 4) | ((q2 & 15) << 8) | ((q3 & 15) << 12)); }
            } else {
            sc = am > 0.f ? am * (1.f / 127.f) : 1.f; const float inv = am > 0.f ? 127.f / am : 0.f;
#pragma unroll
            for (int j = 0; j < 4; ++j) { const unsigned b0 = (unsigned)((int)rintf(v[rr][j].x * inv)) & 0xffu, b1 = (unsigned)((int)rintf(v[rr][j].y * inv)) & 0xffu, b2 = (unsigned)((int)rintf(v[rr][j].z * inv)) & 0xffu, b3 = (unsigned)((int)rintf(v[rr][j].w * inv)) & 0xffu;
                *(unsigned*)(TAB + (((size_t)t * 8 + 2 * j + (lane >> 5)) * 16384 + row) * 128 + 4 * (lane & 31)) = b0 | (b1 << 8) | (b2 << 16) | (b3 << 24); }
            }
            if (lane == 0) TSC[t * 16384 + row] = sc;
        }
    }
}

__device__ __forceinline__ void norm_mod_store(const f32x4 (&v)[4], float rinv, const float* g, const float* sh, const float* sc, bf16_t* orow, int lane) {
#pragma unroll
    for (int j = 0; j < 4; ++j) { const int c = 4 * lane + 256 * j;
        const f32x4 gg = *(const f32x4*)(g + c), s1 = *(const f32x4*)(sc + c), s0 = *(const f32x4*)(sh + c);
        const f32x4 y = (v[j] * rinv * gg) * (s1 + 1.f) + s0;
        u32x2 o; o.x = pk2(y.x, y.y); o.y = pk2(y.z, y.w); *(u32x2*)(orow + c) = o; }
}
__device__ __forceinline__ int tok_row(int layer, int n);
__device__ __forceinline__ void norm_row_out(const Frame& F, const f32x4 (&v)[4], float rinv, const float* g, const float* mm, int r, int which) {
    norm_mod_store(v, rinv, g, mm, mm + 1024, (bf16_t*)(F.ws + WS_H) + (size_t)r * DM, F.lane);
    if (which) {
        f32x4 y[4]; float am = 0.f;
#pragma unroll
        for (int j = 0; j < 4; ++j) { const int c = 4 * F.lane + 256 * j; y[j] = (v[j] * rinv * *(const f32x4*)(g + c)) * (*(const f32x4*)(mm + 1024 + c) + 1.f) + *(const f32x4*)(mm + c);
            am = fmaxf(am, fmaxf(fmaxf(fabsf(y[j].x), fabsf(y[j].y)), fmaxf(fabsf(y[j].z), fabsf(y[j].w)))); }
        am = wave_max(am);
        const float inv = am > 0.f ? 119.f / am : 0.f;
#pragma unroll
        for (int j = 0; j < 4; ++j) { const int h0 = (int)rintf(y[j].x * inv), h1 = (int)rintf(y[j].y * inv), h2 = (int)rintf(y[j].z * inv), h3 = (int)rintf(y[j].w * inv);
            const unsigned hh = (unsigned)(((h0 + 8) >> 4) & 15) | ((unsigned)(((h1 + 8) >> 4) & 15) << 4) | ((unsigned)(((h2 + 8) >> 4) & 15) << 8) | ((unsigned)(((h3 + 8) >> 4) & 15) << 12);
            const unsigned hl = (unsigned)(h0 & 15) | ((unsigned)(h1 & 15) << 4) | ((unsigned)(h2 & 15) << 8) | ((unsigned)(h3 & 15) << 12);
            const bool odd = (F.lane & 1) != 0;
            const unsigned recv = (unsigned)__builtin_amdgcn_update_dpp(0, (int)(odd ? hh : hl), 0xB1, 0xf, 0xf, false);
            *(unsigned*)(F.ws + WS_HQ + (size_t)r * DM + 256 * j + 4 * F.lane) = odd ? (recv | (hl << 16)) : (hh | (recv << 16)); }
        if (F.lane == 0) ((float*)(F.ws + WS_HS))[r] = am > 0.f ? am * (1.f / 119.f) : 1.f;
    }
}
__device__ __forceinline__ void p_norm_rows(const Args& A, const Frame& F, int layer, int which, bool from_input, bool skip_ctx) {
    const int gw = F.bid * NWAVES + F.wave, NGW = F.nblk * NWAVES;
    const float* g = A.in[layer ? (which ? I1_NFFN : I1_NMIX) : (which ? I0_NFFN : I0_NMIX)];
    const float* MOD = (const float*)(F.ws + WS_MOD) + (size_t)layer * 5 * 6144;
    const unsigned short* X = (const unsigned short*)(F.ws + WS_X);
    const int ntok = skip_ctx ? NB * SEQ : R;
    for (int n = gw; n < ntok; n += 2 * NGW) {
        const bool has1 = (n + NGW) < ntok;
        const int r0 = skip_ctx ? tok_row(1, n) : n, r1 = has1 ? (skip_ctx ? tok_row(1, n + NGW) : n + NGW) : r0;
        f32x4 v0[4], v1[4]; float s0 = 0.f, s1 = 0.f;
        if (from_input) { const float* x0 = xin_row(F, r0); const float* x1 = xin_row(F, r1);
#pragma unroll
            for (int j = 0; j < 4; ++j) { v0[j] = *(const f32x4*)(x0 + 4 * F.lane + 256 * j); v1[j] = *(const f32x4*)(x1 + 4 * F.lane + 256 * j); } }
        else {
#pragma unroll
            for (int j = 0; j < 4; ++j) { const u32x2 a = *(const u32x2*)(X + (size_t)r0 * DM + 4 * F.lane + 256 * j), b = *(const u32x2*)(X + (size_t)r1 * DM + 4 * F.lane + 256 * j);
                v0[j] = (f32x4){h2f_lo(a.x), h2f_hi(a.x), h2f_lo(a.y), h2f_hi(a.y)}; v1[j] = (f32x4){h2f_lo(b.x), h2f_hi(b.x), h2f_lo(b.y), h2f_hi(b.y)}; } }
#pragma unroll
        for (int j = 0; j < 4; ++j) { s0 += (v0[j].x * v0[j].x + v0[j].y * v0[j].y) + (v0[j].z * v0[j].z + v0[j].w * v0[j].w); s1 += (v1[j].x * v1[j].x + v1[j].y * v1[j].y) + (v1[j].z * v1[j].z + v1[j].w * v1[j].w); }
        const float ri0 = rsqrtf(wave_sum(s0) * (1.f / DM) + EPS), ri1 = rsqrtf(wave_sum(s1) * (1.f / DM) + EPS);
        norm_row_out(F, v0, ri0, g, MOD + (size_t)mod_index(r0) * 6144 + (which ? 3 * 1024 : 0), r0, which);
        if (has1) norm_row_out(F, v1, ri1, g, MOD + (size_t)mod_index(r1) * 6144 + (which ? 3 * 1024 : 0), r1, which);
    }
}

namespace pg8 {
#define PG8_LAS __attribute__((address_space(3)))
typedef unsigned short bf16_t;
typedef short bf16x8 __attribute__((ext_vector_type(8)));
typedef float f32x4 __attribute__((ext_vector_type(4)));
typedef unsigned u32x4 __attribute__((ext_vector_type(4)));
constexpr int BM = 256, BK = 64, HALF = 128, HTB = HALF * BK * 2  , STAGE_BYTES = 8 * HTB, NXCD = 8, WGM = 8;

__host__ __device__ __forceinline__ int lds_byte(int r, int c) { const int st = (r >> 4) * 2 + (c >> 5), rr = r & 15, cc = c & 31, ob = rr * 64 + cc * 2; return st * 1024 + (ob ^ (((ob >> 9) & 1) << 5)); }
__host__ __device__ __forceinline__ void stage_rc(int b, int& R, int& C) { const int st = b / 1024, sb = b % 1024, swz = sb ^ (((sb >> 9) & 1) << 5); R = (st >> 1) * 16 + swz / 64; C = (st & 1) * 32 + (swz % 64) / 2; }
__host__ __device__ __forceinline__ int perm32(int rho) { const int n = rho >> 4, i = rho & 15; return 8 * (i >> 2) + 4 * n + (i & 3); }

struct Unit { int pm, pn; };
struct Gemm { const bf16_t* A; const bf16_t* Bt; int M, N, K; };

struct StaticOrder {
    int nM, nN, nwg, G, c;
    __host__ __device__ void init(int M, int N, int G_, int c_) { nM = M / BM; nN = N / BM; nwg = nM * nN; G = G_; c = c_; }
    __host__ __device__ bool next(int i, Unit& u) const {
        const long L = (long)i * G + c; if (L >= nwg) return false;
        int wgid = (int)L; { const int q = nwg / NXCD, r = nwg % NXCD, xcd = wgid % NXCD, off = wgid / NXCD; wgid = (xcd < r ? xcd * (q + 1) : r * (q + 1) + (xcd - r) * q) + off; }
        const int nig = WGM * nN, gid = wgid / nig, fm = gid * WGM, gsz = (nM - fm) < WGM ? (nM - fm) : WGM;
        u.pm = fm + ((wgid % nig) % gsz); u.pn = (wgid % nig) / gsz; return true;
    }
    __device__ __forceinline__ void a_ready(const Unit&) const {}
    __device__ __forceinline__ void done(const Unit&) const {}
};

template <class Epi, class Sched, bool ALIGN_EPI = false, bool SP2 = false>
__device__ __forceinline__ void gemm_phase(PG8_LAS unsigned char* lds, const Gemm g, const Sched& S, const Epi& E) {
    const int tid = threadIdx.x, wid = __builtin_amdgcn_readfirstlane(tid >> 6), lane = tid & 63, wr = wid >> 2, wc = wid & 3, fr = lane & 15, fq = lane >> 4;
    const int K = g.K, nt = K / BK;
    unsigned voffA[2], voffB[2];
#pragma unroll
    for (int i = 0; i < 2; ++i) { int R, C; stage_rc(tid * 16 + i * 8192, R, C); const int Rb = Epi::PERM ? ((R & ~31) + perm32(R & 31)) : R;
        voffA[i] = (unsigned)(R * K + C) * 2u; voffB[i] = (unsigned)(Rb * K + C) * 2u; }
    const size_t kstep = (size_t)(BK * 2);
    const size_t hstep = (size_t)HALF * K * 2;
    const size_t tstep = 2 * hstep;
    const unsigned ldsw = (unsigned)wid * 1024u;
    const int aoff = lds_byte(wr * 64 + fr, fq * 8), boff = lds_byte(wc * 32 + fr, fq * 8);
#define PG8_SA(b, h) (((b) * 2 + (h)) * HTB)
#define PG8_SB(b, h) ((4 + (b) * 2 + (h)) * HTB)
#define PG8_STAGE(bufoff, gbase, voff) do { _Pragma("unroll") for (int _i = 0; _i < 2; ++_i) \
        __builtin_amdgcn_global_load_lds((const unsigned*)((const char*)(gbase) + (voff)[_i]), (PG8_LAS unsigned*)(lds + (bufoff) + ldsw + _i * 8192), 16, 0, 0); } while (0)
#define PG8_LDA(dst, b, h) do { _Pragma("unroll") for (int m = 0; m < 4; ++m) _Pragma("unroll") for (int k = 0; k < 2; ++k) dst[m][k] = *(const PG8_LAS bf16x8*)(lds + PG8_SA(b, h) + aoff + m * 2048 + k * 1024); } while (0)
#define PG8_LDB(dst, b, h) do { _Pragma("unroll") for (int n = 0; n < 2; ++n) _Pragma("unroll") for (int k = 0; k < 2; ++k) dst[n][k] = *(const PG8_LAS bf16x8*)(lds + PG8_SB(b, h) + boff + n * 2048 + k * 1024); } while (0)
#define PG8_MMA(ai, bj, At, Bt) do { __builtin_amdgcn_s_setprio(1); _Pragma("unroll") for (int m = 0; m < 4; ++m) _Pragma("unroll") for (int n = 0; n < 2; ++n) _Pragma("unroll") for (int k = 0; k < 2; ++k) \
        acc[ai][bj][m][n] = __builtin_amdgcn_mfma_f32_16x16x32_bf16(Bt[n][k], At[m][k], acc[ai][bj][m][n], 0, 0, 0); __builtin_amdgcn_s_setprio(0); } while (0)
#define PG8_WAIT_V(n) asm volatile("s_waitcnt vmcnt(" #n ")" ::: "memory")
#define PG8_WAIT_L(n) asm volatile("s_waitcnt lgkmcnt(" #n ")" ::: "memory")
#define PG8_BAR __builtin_amdgcn_s_barrier()
#define PG8_SCHED __builtin_amdgcn_sched_barrier(0)
    Unit cur, nxt; int ui = 0;
    if (!S.next(0, cur)) return;
    f32x4 acc[2][2][4][2];
#pragma unroll
    for (int a = 0; a < 2; ++a)
#pragma unroll
        for (int b = 0; b < 2; ++b)
#pragma unroll
            for (int m = 0; m < 4; ++m)
#pragma unroll
                for (int n = 0; n < 2; ++n) acc[a][b][m][n] = (f32x4){0.f, 0.f, 0.f, 0.f};
    bf16x8 At[4][2], B0[2][2], B1[2][2];
    const char* cA = (const char*)g.A + (size_t)cur.pm * tstep; const char* cB = (const char*)g.Bt + (size_t)cur.pn * tstep;
    S.a_ready(cur);
    if constexpr (SP2) {
        PG8_STAGE(PG8_SB(0, 0), cB, voffB); PG8_STAGE(PG8_SB(0, 1), cB + hstep, voffB); PG8_STAGE(PG8_SA(0, 0), cA, voffA); PG8_STAGE(PG8_SA(0, 1), cA + hstep, voffA);
        if (wr == 1) PG8_BAR;
        PG8_WAIT_V(2); PG8_BAR;
        PG8_STAGE(PG8_SB(1, 0), cB + kstep, voffB); PG8_STAGE(PG8_SA(1, 0), cA + kstep, voffA); PG8_STAGE(PG8_SB(1, 1), cB + hstep + kstep, voffB);
        PG8_WAIT_V(6); PG8_BAR;
    } else {
        PG8_STAGE(PG8_SB(0, 0), cB, voffB); PG8_STAGE(PG8_SA(0, 0), cA, voffA); PG8_STAGE(PG8_SB(0, 1), cB + hstep, voffB); PG8_STAGE(PG8_SA(0, 1), cA + hstep, voffA);
        if (wr == 1) PG8_BAR;
        PG8_WAIT_V(4); PG8_BAR;
        PG8_STAGE(PG8_SB(1, 0), cB + kstep, voffB); PG8_STAGE(PG8_SA(1, 0), cA + kstep, voffA); PG8_STAGE(PG8_SB(1, 1), cB + hstep + kstep, voffB);
        PG8_WAIT_V(6); PG8_BAR;
    }
    for (;;) {
        const bool has_next = S.next(ui + 1, nxt);
        const char* nA = has_next ? (const char*)g.A + (size_t)nxt.pm * tstep : cA; const char* nB = has_next ? (const char*)g.Bt + (size_t)nxt.pn * tstep : cB;
        for (int t = 0; t < nt; t += 2) {
            const bool last = (t == nt - 2);
            const char* a1 = cA + (size_t)(t + 1) * kstep;
            const char* a2 = last ? nA : cA + (size_t)(t + 2) * kstep; const char* b2 = last ? nB : cB + (size_t)(t + 2) * kstep;
            const char* a3 = a2 + kstep; const char* b3 = b2 + kstep;
            if (last && has_next) S.a_ready(nxt);
            if constexpr (SP2) {
            PG8_LDB(B0, 0, 0); PG8_LDB(B1, 0, 1); PG8_SCHED; PG8_LDA(At, 0, 0); PG8_STAGE(PG8_SA(1, 1), a1 + hstep, voffA);
            PG8_WAIT_V(8); PG8_WAIT_L(0); PG8_BAR; PG8_MMA(0, 0, At, B0); PG8_MMA(0, 1, At, B1); PG8_BAR; PG8_SCHED;
            PG8_LDA(At, 0, 1); PG8_STAGE(PG8_SB(0, 0), b2, voffB); PG8_STAGE(PG8_SB(0, 1), b2 + hstep, voffB); PG8_STAGE(PG8_SA(0, 0), a2, voffA);
            PG8_WAIT_V(8); PG8_WAIT_L(0); PG8_BAR; PG8_MMA(1, 0, At, B0); PG8_MMA(1, 1, At, B1); PG8_BAR; PG8_SCHED;
            PG8_LDB(B0, 1, 0); PG8_LDB(B1, 1, 1); PG8_SCHED; PG8_LDA(At, 1, 0); PG8_STAGE(PG8_SA(0, 1), a2 + hstep, voffA);
            PG8_WAIT_V(8); PG8_WAIT_L(0); PG8_BAR; PG8_MMA(0, 0, At, B0); PG8_MMA(0, 1, At, B1); PG8_BAR; PG8_SCHED;
            PG8_LDA(At, 1, 1); PG8_STAGE(PG8_SB(1, 0), b3, voffB); PG8_STAGE(PG8_SB(1, 1), b3 + hstep, voffB); PG8_STAGE(PG8_SA(1, 0), a3, voffA);
            PG8_WAIT_V(8); PG8_WAIT_L(0); PG8_BAR; PG8_MMA(1, 0, At, B0); PG8_MMA(1, 1, At, B1); PG8_BAR; PG8_SCHED;
            } else {
            PG8_LDB(B0, 0, 0); PG8_SCHED; PG8_LDA(At, 0, 0); PG8_STAGE(PG8_SA(1, 1), a1 + hstep, voffA);
            PG8_WAIT_L(8); PG8_BAR; PG8_WAIT_L(0); PG8_MMA(0, 0, At, B0); PG8_BAR; PG8_SCHED;
            PG8_LDB(B1, 0, 1); PG8_STAGE(PG8_SB(0, 0), b2, voffB);
            PG8_BAR; PG8_WAIT_L(0); PG8_MMA(0, 1, At, B1); PG8_BAR;
            PG8_LDA(At, 0, 1); PG8_STAGE(PG8_SA(0, 0), a2, voffA);
            PG8_BAR; PG8_WAIT_L(0); PG8_MMA(1, 0, At, B0); PG8_BAR; PG8_SCHED;
            PG8_STAGE(PG8_SB(0, 1), b2 + hstep, voffB);
            PG8_WAIT_V(6); PG8_BAR; PG8_MMA(1, 1, At, B1); PG8_BAR;
            PG8_LDB(B0, 1, 0); PG8_SCHED; PG8_LDA(At, 1, 0); PG8_STAGE(PG8_SA(0, 1), a2 + hstep, voffA);
            PG8_WAIT_L(8); PG8_BAR; PG8_WAIT_L(0); PG8_MMA(0, 0, At, B0); PG8_BAR; PG8_SCHED;
            PG8_LDB(B1, 1, 1); PG8_STAGE(PG8_SB(1, 0), b3, voffB);
            PG8_BAR; PG8_WAIT_L(0); PG8_MMA(0, 1, At, B1); PG8_BAR;
            PG8_LDA(At, 1, 1); PG8_STAGE(PG8_SA(1, 0), a3, voffA);
            PG8_BAR; PG8_WAIT_L(0); PG8_MMA(1, 0, At, B0); PG8_BAR; PG8_SCHED;
            PG8_STAGE(PG8_SB(1, 1), b3 + hstep, voffB);
            PG8_WAIT_V(6); PG8_BAR; PG8_MMA(1, 1, At, B1); PG8_BAR;
            }
        }
        if constexpr (ALIGN_EPI) { if (wr == 0) PG8_BAR; }
        if constexpr (!Epi::AFTER_DRAIN) { E(acc, cur, wr, wc, fr, fq); S.done(cur); }
        if (!has_next) break;
#pragma unroll
        for (int a = 0; a < 2; ++a)
#pragma unroll
            for (int b = 0; b < 2; ++b)
#pragma unroll
                for (int m = 0; m < 4; ++m)
#pragma unroll
                    for (int n = 0; n < 2; ++n) acc[a][b][m][n] = (f32x4){0.f, 0.f, 0.f, 0.f};
        cur = nxt; cA = nA; cB = nB; ++ui;
        if constexpr (ALIGN_EPI) { if (wr == 1) PG8_BAR; }
    }
    PG8_WAIT_V(0);
    if constexpr (!ALIGN_EPI) { if (wr == 0) PG8_BAR; }
    PG8_BAR;
    if constexpr (Epi::AFTER_DRAIN) { E.fused(acc, cur, wr, wc, fr, fq, lds, wid, lane); S.done(cur); }
#undef PG8_SA
#undef PG8_SB
#undef PG8_STAGE
#undef PG8_LDA
#undef PG8_LDB
#undef PG8_MMA
#undef PG8_WAIT_V
#undef PG8_WAIT_L
#undef PG8_BAR
#undef PG8_SCHED
}
}

template <class Inner> struct EpiTile { static constexpr bool PERM = true, AFTER_DRAIN = false; Inner in;
    __device__ __forceinline__ void operator()(const pg8::f32x4 (&acc)[2][2][4][2], const pg8::Unit& u, int wr, int wc, int fr, int fq) const {
#pragma unroll
        for (int ai = 0; ai < 2; ++ai)
#pragma unroll
            for (int m = 0; m < 4; ++m) { const int row = u.pm * 256 + ai * 128 + wr * 64 + m * 16 + fr;
#pragma unroll
                for (int bj = 0; bj < 2; ++bj) in(row, u.pn * 256 + bj * 128 + wc * 32 + 8 * fq, acc[ai][bj][m][0], acc[ai][bj][m][1]); }
    } };
struct In8Bf16 { bf16_t* C; int ldc;
    __device__ __forceinline__ void operator()(int row, int col, f32x4 a, f32x4 b) const { u32x4 o; o.x = cvtpk(a.x, a.y); o.y = cvtpk(a.z, a.w); o.z = cvtpk(b.x, b.y); o.w = cvtpk(b.z, b.w); *(u32x4*)(C + (size_t)row * ldc + col) = o; } };
struct In8KV { bf16_t* Kb; bf16_t* Vb;
    __device__ __forceinline__ void operator()(int row, int col, f32x4 a, f32x4 b) const { const int h = col >> 8, c = col & 255; u32x4 o; o.x = cvtpk(a.x, a.y); o.y = cvtpk(a.z, a.w); o.z = cvtpk(b.x, b.y); o.w = cvtpk(b.z, b.w);
        bf16_t* p = (c < 128) ? Kb + (size_t)row * 1536 + h * 192 + c : Vb + (size_t)row * 1024 + h * 128 + (c - 128);
        *(u32x4*)p = o; } };
struct In8F16 { unsigned short* C; int ldc;
    __device__ __forceinline__ void operator()(int row, int col, f32x4 a, f32x4 b) const { u32x4 o; o.x = pkh2(a.x, a.y); o.y = pkh2(a.z, a.w); o.z = pkh2(b.x, b.y); o.w = pkh2(b.z, b.w); *(u32x4*)(C + (size_t)row * ldc + col) = o; } };
struct In8F32 { float* C; int ldc;
    __device__ __forceinline__ void operator()(int row, int col, f32x4 a, f32x4 b) const { float* p = C + (size_t)row * ldc + col; *(f32x4*)p = a; *(f32x4*)(p + 4) = b; } };
struct In8Resid { const float* x; const float* ctx; unsigned short* X; const float* gate; bool from_input;
    __device__ __forceinline__ void operator()(int row, int col, f32x4 a, f32x4 b) const {
        const int bb = row / RPB, j = row - bb * RPB; unsigned short* xo = X + (size_t)row * DM + col;
        f32x4 x0, x1;
        if (from_input) { const float* xi = ((j < CTXL) ? ctx + ((size_t)bb * CTXL + j) * DM : x + ((size_t)bb * SEQ + (j - CTXL)) * DM) + col; x0 = *(const f32x4*)xi; x1 = *(const f32x4*)(xi + 4); }
        else { const u32x4 w = *(const u32x4*)xo; x0 = (f32x4){h2f_lo(w.x), h2f_hi(w.x), h2f_lo(w.y), h2f_hi(w.y)}; x1 = (f32x4){h2f_lo(w.z), h2f_hi(w.z), h2f_lo(w.w), h2f_hi(w.w)}; }
        const float* g = gate + (size_t)((j < CTXL) ? 4 : bb) * 6144 + col;
        x0 += *(const f32x4*)g * a; x1 += *(const f32x4*)(g + 4) * b;
        u32x4 o; o.x = pkh2(x0.x, x0.y); o.y = pkh2(x0.z, x0.w); o.z = pkh2(x1.x, x1.y); o.w = pkh2(x1.z, x1.w); *(u32x4*)xo = o; } };
struct EpiMlaDown { static constexpr bool PERM = true, AFTER_DRAIN = false; bf16_t* CQ; bf16_t* CKV; bf16_t* KR; float* SSP;
    __device__ __forceinline__ void operator()(const pg8::f32x4 (&acc)[2][2][4][2], const pg8::Unit& u, int wr, int wc, int fr, int fq) const {
#pragma unroll
        for (int ai = 0; ai < 2; ++ai)
#pragma unroll
            for (int m = 0; m < 4; ++m) { const int row = u.pm * 256 + ai * 128 + wr * 64 + m * 16 + fr;
#pragma unroll
                for (int bj = 0; bj < 2; ++bj) { const int col = u.pn * 256 + bj * 128 + wc * 32 + 8 * fq; const f32x4 a = acc[ai][bj][m][0], b = acc[ai][bj][m][1];
                    u32x4 o; o.x = cvtpk(a.x, a.y); o.y = cvtpk(a.z, a.w); o.z = cvtpk(b.x, b.y); o.w = cvtpk(b.z, b.w);
                    const int cls = (u.pn * 2 + bj);
                    if (cls < 5) { float sq = (a.x * a.x + a.y * a.y) + (a.z * a.z + a.w * a.w) + (b.x * b.x + b.y * b.y) + (b.z * b.z + b.w * b.w);
                        sq += __shfl_xor(sq, 16); sq += __shfl_xor(sq, 32);
                        if (cls < 3) *(u32x4*)(CQ + (size_t)row * 384 + col) = o; else *(u32x4*)(CKV + (size_t)row * 256 + (col - 384)) = o;
                        if (fq == 0) SSP[(size_t)row * 24 + cls * 4 + wc] = sq; }
                    else if (col < 704) *(u32x4*)(KR + (size_t)row * 64 + (col - 640)) = o; } }
    } };
struct In8Bf16Rs { bf16_t* C; int ldc; const float* ssp;
    __device__ __forceinline__ void operator()(int row, int col, f32x4 a, f32x4 b) const { const f32x4 s0 = *(const f32x4*)(ssp + (size_t)row * 24), s1 = *(const f32x4*)(ssp + (size_t)row * 24 + 4), s2 = *(const f32x4*)(ssp + (size_t)row * 24 + 8);
        const float ssum = (((s0.x + s0.y) + (s0.z + s0.w)) + ((s1.x + s1.y) + (s1.z + s1.w))) + ((s2.x + s2.y) + (s2.z + s2.w));
        const float rs = rsqrtf(ssum * (1.f / 384.f) + EPS); a *= rs; b *= rs;
        u32x4 o; o.x = cvtpk(a.x, a.y); o.y = cvtpk(a.z, a.w); o.z = cvtpk(b.x, b.y); o.w = cvtpk(b.z, b.w); *(u32x4*)(C + (size_t)row * ldc + col) = o; } };
struct In8KVRs { unsigned char* K8; unsigned char* V8; const float* ssp;
    __device__ __forceinline__ void operator()(int row, int col, f32x4 a, f32x4 b) const { const f32x4 s0 = *(const f32x4*)(ssp + (size_t)row * 24 + 12), s1 = *(const f32x4*)(ssp + (size_t)row * 24 + 16);
        const float ssum = ((s0.x + s0.y) + (s0.z + s0.w)) + ((s1.x + s1.y) + (s1.z + s1.w));
        const float rs = rsqrtf(ssum * (1.f / 256.f) + EPS); a *= rs; b *= rs;
        const int h = col >> 8, c = col & 255;
        if (c < 128) { u32x2 o; o.x = f8x4(a.x, a.y, a.z, a.w); o.y = f8x4(b.x, b.y, b.z, b.w); *(u32x2*)(K8 + (size_t)row * 1536 + h * 192 + c) = o; }
        else { u32x2 o; o.x = f8x4(a.x, a.y, a.z, a.w); o.y = f8x4(b.x, b.y, b.z, b.w); *(u32x2*)(V8 + (size_t)row * 1024 + h * 128 + (c - 128)) = o; } } };
struct RowSched { pg8::StaticOrder so; bool latent_only;
    __device__ __forceinline__ void init(int N, int G, int c, bool lat) { latent_only = lat; so.init(lat ? NB * SEQ : R, N, G, c); }
    __device__ __forceinline__ bool next(int i, pg8::Unit& u) const { if (!so.next(i, u)) return false; if (latent_only) u.pm = (u.pm >> 4) * 17 + 1 + (u.pm & 15); return true; }
    __device__ __forceinline__ void a_ready(const pg8::Unit&) const {}
    __device__ __forceinline__ void done(const pg8::Unit&) const {} };
template <class Inner> __device__ __forceinline__ void gemm8(const Frame& F, const bf16_t* Ap, const bf16_t* Bt, int N, int K, bool latent_only, const Inner& in, bool reverse = false) {
    asm volatile("" : "+s"(K));
    pg8::Gemm g{Ap, Bt, R, N, K}; RowSched S; S.init(N, F.nblk, reverse ? F.nblk - 1 - F.bid : F.bid, latent_only);
    EpiTile<Inner> E{in};
    pg8::gemm_phase<EpiTile<Inner>, RowSched, true, true>((PG8_LAS unsigned char*)F.lds, g, S, E);
}

template <class Epi> __device__ __forceinline__ void gemm8e(const Frame& F, const bf16_t* Ap, const bf16_t* Bt, int N, int K, bool latent_only, const Epi& E) {
    asm volatile("" : "+s"(K));
    pg8::Gemm g{Ap, Bt, R, N, K}; RowSched S; S.init(N, F.nblk, F.bid, latent_only);
    pg8::gemm_phase<Epi, RowSched, true, true>((PG8_LAS unsigned char*)F.lds, g, S, E);
}

struct GemmDesc { const bf16_t* A; int lda; long sA; const bf16_t* Bt; int ldb; long sB; int M, N, K, nz; };
template <class Epi>
__device__ __forceinline__ void gemm_simple(const Frame& F, const GemmDesc& g, const Epi& epi, bool skip_ctx) {
    const int wm = F.wave >> 1, wn = F.wave & 1, fr = F.lane & 15, fq = F.lane >> 4;
    const int tM = g.M / 128, tN = g.N / 128, per = tM * tN, total = per * g.nz;
    for (int u = F.bid; u < total; u += F.nblk) {
        const int z = u / per, uu = u - z * per, tm = uu / tN, tn = uu - tm * tN;
        if (skip_ctx && ((tm * 128) % RPB) < CTXL) continue;
        const int row0 = tm * 128 + wm * 32, col0 = tn * 128 + wn * 64;
        const bf16_t* ap = g.A + z * g.sA + (size_t)(row0 + fr) * g.lda + fq * 8;
        const bf16_t* bp = g.Bt + z * g.sB + (size_t)(col0 + fr) * g.ldb + fq * 8;
        f32x4 acc[2][4];
#pragma unroll
        for (int mi = 0; mi < 2; ++mi)
#pragma unroll
            for (int ni = 0; ni < 4; ++ni) acc[mi][ni] = (f32x4){0.f, 0.f, 0.f, 0.f};
        for (int k0 = 0; k0 < g.K; k0 += 32) {
            bf16x8 a[2], b[4];
#pragma unroll
            for (int mi = 0; mi < 2; ++mi) a[mi] = *(const bf16x8*)(ap + (size_t)mi * 16 * g.lda + k0);
#pragma unroll
            for (int ni = 0; ni < 4; ++ni) b[ni] = *(const bf16x8*)(bp + (size_t)ni * 16 * g.ldb + k0);
#pragma unroll
            for (int mi = 0; mi < 2; ++mi)
#pragma unroll
                for (int ni = 0; ni < 4; ++ni) acc[mi][ni] = __builtin_amdgcn_mfma_f32_16x16x32_bf16(b[ni], a[mi], acc[mi][ni], 0, 0, 0);
        }
#pragma unroll
        for (int mi = 0; mi < 2; ++mi)
#pragma unroll
            for (int ni = 0; ni < 4; ++ni) epi(z, row0 + mi * 16 + fr, col0 + ni * 16 + fq * 4, acc[mi][ni]);
    }
}
struct EpiBf16 { bf16_t* C; int ldc;
    __device__ __forceinline__ void operator()(int, int row, int col, f32x4 v) const { u32x2 o; o.x = pk2(v.x, v.y); o.y = pk2(v.z, v.w); *(u32x2*)(C + (size_t)row * ldc + col) = o; } };
struct EpiKV { bf16_t* Kb; bf16_t* Vb;
    __device__ __forceinline__ void operator()(int, int row, int col, f32x4 v) const { const int h = col >> 8, c = col & 255; u32x2 o; o.x = pk2(v.x, v.y); o.y = pk2(v.z, v.w);
        if (c < 128) *(u32x2*)(Kb + (size_t)row * 1536 + h * 192 + c) = o; else *(u32x2*)(Vb + (size_t)row * 1024 + h * 128 + (c - 128)) = o; } };
struct EpiF32Z { float* C; int ldc;
    __device__ __forceinline__ void operator()(int z, int row, int col, f32x4 v) const { *(f32x4*)(C + (size_t)row * ldc + z * 128 + col) = v; } };
struct EpiResid { const Frame* F; const float* gate; bool from_input;
    __device__ __forceinline__ void operator()(int, int row, int col, f32x4 v) const {
        float* X = (float*)(F->ws + WS_X) + (size_t)row * DM + col;
        const float* xi = from_input ? xin_row(*F, row) + col : X;
        const f32x4 g = *(const f32x4*)(gate + (size_t)mod_index(row) * 6144 + col);
        *(f32x4*)X = *(const f32x4*)xi + g * v; } };

__device__ __forceinline__ void rope_angles(int r, int& prow, int& pcol) { const int t = (r % RPB) - CTXL; prow = t >> 6; pcol = t & 63; }
__device__ __forceinline__ void p_mla_krope(const Args& A, const Frame& F) {
    const int gw = F.bid * NWAVES + F.wave, NGW = F.nblk * NWAVES, lane = F.lane;
    const bf16_t* KR = (const bf16_t*)(F.ws + WS_KR); unsigned char* K8 = F.ws + WS_K;
    const float invf = __powf(10000.f, -(float)(lane & 15) * (1.f / 16.f));
    for (int r = gw; r < R; r += NGW) {
        float kr = bf2f(KR[(size_t)r * 64 + lane]);
        if (!is_ctx_row(r)) {
            int prow, pcol; rope_angles(r, prow, pcol);
            const float ang = (float)((lane & 32) ? pcol : prow) * invf;
            const float cs = cosf(ang), sn = sinf(ang);
            const float partner = __shfl_xor(kr, 16);
            kr = kr * cs + ((lane & 16) ? partner : -partner) * sn;
        }
        const unsigned char kb = (unsigned char)(f8x4(kr, kr, kr, kr) & 0xffu);
#pragma unroll
        for (int h = 0; h < 8; ++h) K8[(size_t)r * 1536 + h * 192 + 128 + lane] = kb;
    }
}
__device__ __forceinline__ float row16_sum(float v) { v += WDPP(v, 0xB1); v += WDPP(v, 0x4E); v += WDPP(v, 0x141); v += WDPP(v, 0x140); return v; }
__device__ __forceinline__ void p_gqa_rows(const Args& A, const Frame& F) {
    const int gw = F.bid * NWAVES + F.wave, NGW = F.nblk * NWAVES, lane = F.lane, c16 = lane & 15, hrow = lane >> 4;
    const bf16_t* RAW = (const bf16_t*)(F.ws + WS_RAW1); bf16_t* Q1 = (bf16_t*)(F.ws + WS_Q1); unsigned char* K18 = F.ws + WS_K1; unsigned char* V18 = F.ws + WS_V1;
    float qg[8], kg[8], invf[8];
#pragma unroll
    for (int e = 0; e < 8; ++e) { qg[e] = A.in[I1_QN][8 * c16 + e]; kg[e] = A.in[I1_KN][8 * c16 + e]; invf[e] = __powf(10000.f, -(float)(8 * (c16 & 3) + e) * (1.f / 32.f)); }
    const bool colaxis = (c16 & 8) != 0, hi32 = (c16 & 4) != 0;
    for (int r = gw; r < R; r += NGW) {
        const bool ctx = is_ctx_row(r);
        const bf16_t* a = RAW + (size_t)r * 1536 + 8 * lane;
        u32x4 ch[3];
#pragma unroll
        for (int j = 0; j < 3; ++j) ch[j] = (ctx && j < 2) ? (u32x4){0u, 0u, 0u, 0u} : *(const u32x4*)(a + 512 * j);
        float cs[8], sn[8];
        { int prow = 0, pcol = 0; if (!ctx) rope_angles(r, prow, pcol); const float pos = (float)(colaxis ? pcol : prow);
#pragma unroll
          for (int e = 0; e < 8; ++e) { const float ang = pos * invf[e]; cs[e] = ctx ? 1.f : __cosf(ang); sn[e] = ctx ? 0.f : __sinf(ang); } }
#pragma unroll
        for (int j = 0; j < 3; ++j) {
            if (ctx && j < 2) continue;
            const bool isv = (j == 2) && (hrow >= 2);
            float x[8];
#pragma unroll
            for (int d = 0; d < 4; ++d) { x[2 * d] = bflo(ch[j][d]); x[2 * d + 1] = bfhi(ch[j][d]); }
            float sq = 0.f;
#pragma unroll
            for (int e = 0; e < 8; ++e) sq += x[e] * x[e];
            const float rinv = rsqrtf(row16_sum(sq) * (1.f / 128.f) + EPS);
            u32x4 o;
            float y[8];
#pragma unroll
            for (int e = 0; e < 8; ++e) y[e] = x[e] * rinv * (j < 2 ? qg[e] : kg[e]);
            u32x4 yp; yp.x = pk2(y[0], y[1]); yp.y = pk2(y[2], y[3]); yp.z = pk2(y[4], y[5]); yp.w = pk2(y[6], y[7]);
            float pr[8];
#pragma unroll
            for (int d = 0; d < 4; ++d) { const float lo = __shfl_xor(y[2 * d], 4), hi2 = __shfl_xor(y[2 * d + 1], 4); pr[2 * d] = lo; pr[2 * d + 1] = hi2; }
            float z[8];
#pragma unroll
            for (int e = 0; e < 8; ++e) z[e] = y[e] * cs[e] + (hi32 ? pr[e] : -pr[e]) * sn[e];
            o.x = pk2(z[0], z[1]); o.y = pk2(z[2], z[3]); o.z = pk2(z[4], z[5]); o.w = pk2(z[6], z[7]);
            (void)yp;
            if (isv) o = ch[j];
            if (j < 2) *(u32x4*)(Q1 + (size_t)r * 1024 + 512 * j + 8 * lane) = o;
            else if (hrow < 2) { u32x2 o8; o8.x = f8x4(z[0], z[1], z[2], z[3]); o8.y = f8x4(z[4], z[5], z[6], z[7]); *(u32x2*)(K18 + (size_t)r * 256 + 8 * lane) = o8; }
            else { u32x2 o8; o8.x = f8x4(x[0], x[1], x[2], x[3]); o8.y = f8x4(x[4], x[5], x[6], x[7]); *(u32x2*)(V18 + (size_t)r * 256 + 8 * (lane - 32)) = o8; }
        }
    }
}

__device__ __forceinline__ int crow(int r, int hi) { return (r & 3) + 8 * (r >> 2) + 4 * hi; }
__device__ __forceinline__ int v_st(int k, int c) { const int kk = (k & ~0xC) | ((k & 4) << 1) | ((k & 8) >> 1); return ((kk >> 3) * 4 + (c >> 5)) * 512 + ((kk & 7) * 32 + (c & 31)) * 2; }
__device__ __forceinline__ int v_rd_base(int lane) { return ((lane & 3) << 3) | (((lane >> 2) & 3) << 6) | (((lane >> 4) & 1) << 5) | (((lane >> 5) & 1) << 8); }
constexpr int v_rd_off(int d0, int ks, int half) { return d0 * 512 + ks * 4096 + half * 2048; }
template <int OFF> __device__ __forceinline__ s16x4 tr_read(int vb) { s16x4 r; asm volatile("ds_read_b64_tr_b16 %0, %1 offset:%2" : "=&v"(r) : "v"(vb), "i"(OFF) : "memory"); return r; }
template <int D0> __device__ __forceinline__ void pv_one(f32x16& od, int vb, bf16x8 pa0, bf16x8 pa1, bf16x8 pa2, bf16x8 pa3) {
    const s16x4 l0 = tr_read<v_rd_off(D0, 0, 0)>(vb), h0 = tr_read<v_rd_off(D0, 0, 1)>(vb), l1 = tr_read<v_rd_off(D0, 1, 0)>(vb), h1 = tr_read<v_rd_off(D0, 1, 1)>(vb);
    const s16x4 l2 = tr_read<v_rd_off(D0, 2, 0)>(vb), h2 = tr_read<v_rd_off(D0, 2, 1)>(vb), l3 = tr_read<v_rd_off(D0, 3, 0)>(vb), h3 = tr_read<v_rd_off(D0, 3, 1)>(vb);
    asm volatile("s_waitcnt lgkmcnt(0)" ::: "memory"); SBAR();
#define PK(L, H) (bf16x8){L[0], L[1], L[2], L[3], H[0], H[1], H[2], H[3]}
    od = __builtin_amdgcn_mfma_f32_32x32x16_bf16(pa0, PK(l0, h0), od, 0, 0, 0);
    od = __builtin_amdgcn_mfma_f32_32x32x16_bf16(pa1, PK(l1, h1), od, 0, 0, 0);
    od = __builtin_amdgcn_mfma_f32_32x32x16_bf16(pa2, PK(l2, h2), od, 0, 0, 0);
    od = __builtin_amdgcn_mfma_f32_32x32x16_bf16(pa3, PK(l3, h3), od, 0, 0, 0);
#undef PK
}
__device__ __forceinline__ void pv_d0(f32x16* o, int vb, bf16x8 pa0, bf16x8 pa1, bf16x8 pa2, bf16x8 pa3) {
    pv_one<0>(o[0], vb, pa0, pa1, pa2, pa3); pv_one<1>(o[1], vb, pa0, pa1, pa2, pa3); pv_one<2>(o[2], vb, pa0, pa1, pa2, pa3); pv_one<3>(o[3], vb, pa0, pa1, pa2, pa3);
}
constexpr float ATT_THR = 8.f;
__device__ __forceinline__ void partialSM(f32x16& p0, f32x16& p1, float& m_reg, float& mn, float& alpha, float C, float thr_raw) {
    float pmax = p0[0];
#pragma unroll
    for (int r = 1; r < 16; ++r) pmax = fmaxf(pmax, p0[r]);
#pragma unroll
    for (int r = 0; r < 16; ++r) pmax = fmaxf(pmax, p1[r]);
    { auto rr = __builtin_amdgcn_permlane32_swap(__float_as_uint(pmax), __float_as_uint(pmax), false, false);
      pmax = fmaxf(__uint_as_float(rr[0]), __uint_as_float(rr[1])); }
    if (__builtin_expect(__all(pmax - m_reg <= thr_raw), 1)) { mn = m_reg; alpha = 1.f; }
    else { mn = fmaxf(m_reg, pmax); alpha = __builtin_amdgcn_exp2f((m_reg - mn) * C); m_reg = mn; }
    const float mnC = -mn * C;
#pragma unroll
    for (int r = 0; r < 16; ++r) p0[r] = fmaf(p0[r], C, mnC);
#pragma unroll
    for (int r = 0; r < 16; ++r) p1[r] = fmaf(p1[r], C, mnC);
#pragma unroll
    for (int r = 0; r < 16; ++r) p0[r] = __builtin_amdgcn_exp2f(p0[r]);
}
__device__ __forceinline__ void finishSM(f32x16& p0, f32x16& p1, float alpha, float& l_reg, bf16x8& pa0, bf16x8& pa1, bf16x8& pa2, bf16x8& pa3) {
#pragma unroll
    for (int r = 0; r < 16; ++r) p1[r] = __builtin_amdgcn_exp2f(p1[r]);
    float ps = 0;
#pragma unroll
    for (int r = 0; r < 16; ++r) ps += p0[r];
#pragma unroll
    for (int r = 0; r < 16; ++r) ps += p1[r];
    { auto rr = __builtin_amdgcn_permlane32_swap(__float_as_uint(ps), __float_as_uint(ps), false, false);
      ps = __uint_as_float(rr[0]) + __uint_as_float(rr[1]); }
    l_reg = l_reg * alpha + ps;
#define PK4(P, BASE, OUT) do { unsigned a0 = cvtpk(P[BASE + 0], P[BASE + 1]), a1 = cvtpk(P[BASE + 2], P[BASE + 3]);   \
    unsigned b0 = cvtpk(P[BASE + 4], P[BASE + 5]), b1 = cvtpk(P[BASE + 6], P[BASE + 7]);                              \
    auto r0 = __builtin_amdgcn_permlane32_swap(a0, b0, false, false); auto r1 = __builtin_amdgcn_permlane32_swap(a1, b1, false, false); \
    u32x4 w = {r0[0], r1[0], r0[1], r1[1]}; OUT = *reinterpret_cast<bf16x8*>(&w); } while (0)
    PK4(p0, 0, pa0); PK4(p0, 8, pa1); PK4(p1, 0, pa2); PK4(p1, 8, pa3);
#undef PK4
}
template <int DQK> __device__ __forceinline__ void qkt(f32x16& p0, f32x16& p1, const char* Ks, const bf16x8* qr, int r32, int hi) {
    constexpr int KP = DQK * 2 + 16;
    p0 = f32x16{}; p1 = f32x16{};
#pragma unroll
    for (int d0 = 0; d0 < DQK / 16; ++d0) { const int cb = (d0 * 16 + hi * 8) * 2;
        const bf16x8 b0 = *reinterpret_cast<const bf16x8*>(Ks + r32 * KP + cb);
        const bf16x8 b1 = *reinterpret_cast<const bf16x8*>(Ks + (32 + r32) * KP + cb);
        p0 = __builtin_amdgcn_mfma_f32_32x32x16_bf16(b0, qr[d0], p0, 0, 0, 0);
        p1 = __builtin_amdgcn_mfma_f32_32x32x16_bf16(b1, qr[d0], p1, 0, 0, 0); }
}
template <int DQK> constexpr int att_lds_bytes() { return 2 * 64 * 128 * 2 + 2 * 64 * (DQK * 2 + 16) + NWAVES * 64 * 4; }
template <int DQK, int LDQ, int LDK, int LDV, int LDO>
__device__ __forceinline__ void attn_body(const bf16_t* __restrict__ Qb, const bf16_t* __restrict__ Kh, const bf16_t* __restrict__ Vh, bf16_t* __restrict__ Ob, int seq, float scale, char* lds) {
    constexpr int KP = DQK * 2 + 16, SHM_V = 64 * 128 * 2, SHM_K = 64 * KP, ND = DQK / 16, CH = DQK / 8, NKL = CH * 64 / NTHREADS;
    const float C = scale * 1.4426950408889634f, thr_raw = ATT_THR / scale;
    const int tid = threadIdx.x, wid = tid >> 6, lane = tid & 63, r32 = lane & 31, hi = lane >> 5;
    char* V_lds = lds; char* K_lds = lds + 2 * SHM_V;
    float* wsf = (float*)(lds + 2 * SHM_V + 2 * SHM_K) + wid * 64; float* li_l = wsf; float* al_l = wsf + 32;
    float m_reg = -1e30f, l_reg = 0; f32x16 o[4] = {}; bf16x8 qr[ND];
    const bf16_t* Qw = Qb + (long)(wid * 32 + r32) * LDQ + hi * 8;
#pragma unroll
    for (int d0 = 0; d0 < ND; ++d0) qr[d0] = *reinterpret_cast<const bf16x8*>(Qw + d0 * 16);
    const int sr = tid >> 4, sc = (tid & 15) * 8, vst0 = v_st(sr, sc), vst1 = v_st(32 + sr, sc);
    static_assert(DQK == 128, "double-pipelined body: 128-wide q.k only");
    const int vb0 = (int)(uintptr_t)V_lds + v_rd_base(lane);
    bf16x8 vs0, vs1, ks[NKL];
#define SLOAD(k0) do { vs0 = *reinterpret_cast<const bf16x8*>(&Vh[(long)((k0) + sr) * LDV + sc]); vs1 = *reinterpret_cast<const bf16x8*>(&Vh[(long)((k0) + 32 + sr) * LDV + sc]); \
    _Pragma("unroll") for (int i_ = 0; i_ < NKL; ++i_) ks[i_] = *reinterpret_cast<const bf16x8*>(&Kh[(long)((k0) + sr + 32 * i_) * LDK + sc]); } while (0)
#define SWRITE(b) do { *(bf16x8*)(V_lds + (b) * SHM_V + vst0) = vs0; *(bf16x8*)(V_lds + (b) * SHM_V + vst1) = vs1; \
    _Pragma("unroll") for (int i_ = 0; i_ < NKL; ++i_) *(bf16x8*)(K_lds + (b) * SHM_K + (sr + 32 * i_) * KP + sc * 2) = ks[i_]; } while (0)
#define RESC(a) do { if (__any((a) < 1.f)) { if (hi == 0) al_l[r32] = (a); asm volatile("s_waitcnt lgkmcnt(0)" ::: "memory"); \
    _Pragma("unroll") for (int d = 0; d < 4; ++d) _Pragma("unroll") for (int r = 0; r < 16; ++r) o[d][r] *= al_l[crow(r, hi)]; } } while (0)
    f32x16 pA0, pA1, pB0, pB1; float mnA, mnB, alA, alB; bf16x8 pa0, pa1, pa2, pa3; const int NT = seq / 64;
    SLOAD(0); asm volatile("s_waitcnt vmcnt(0)" ::: "memory"); SWRITE(0); __syncthreads();
    qkt<DQK>(pA0, pA1, K_lds, qr, r32, hi); partialSM(pA0, pA1, m_reg, mnA, alA, C, thr_raw);
    SLOAD(64);
    asm volatile("s_waitcnt vmcnt(0)" ::: "memory"); SWRITE(1); __syncthreads();
    for (int j = 1; j + 1 < NT; j += 2) {
        SBAR(); qkt<DQK>(pB0, pB1, K_lds + SHM_K, qr, r32, hi);
        finishSM(pA0, pA1, alA, l_reg, pa0, pa1, pa2, pa3); SBAR();
        SLOAD((j + 1) * 64); SBAR();
        pv_d0(o, vb0, pa0, pa1, pa2, pa3); partialSM(pB0, pB1, m_reg, mnB, alB, C, thr_raw);
        __syncthreads(); asm volatile("s_waitcnt vmcnt(0)" ::: "memory"); SWRITE(0);
        RESC(alB); __syncthreads();
        SBAR(); qkt<DQK>(pA0, pA1, K_lds, qr, r32, hi);
        finishSM(pB0, pB1, alB, l_reg, pa0, pa1, pa2, pa3); SBAR();
        SLOAD((j + 2) * 64); SBAR();
        pv_d0(o, vb0 + SHM_V, pa0, pa1, pa2, pa3); partialSM(pA0, pA1, m_reg, mnA, alA, C, thr_raw);
        __syncthreads(); asm volatile("s_waitcnt vmcnt(0)" ::: "memory"); SWRITE(1);
        RESC(alA); __syncthreads();
    }
    SBAR(); qkt<DQK>(pB0, pB1, K_lds + SHM_K, qr, r32, hi);
    finishSM(pA0, pA1, alA, l_reg, pa0, pa1, pa2, pa3); SBAR();
    pv_d0(o, vb0, pa0, pa1, pa2, pa3); partialSM(pB0, pB1, m_reg, mnB, alB, C, thr_raw);
    __syncthreads(); RESC(alB);
    finishSM(pB0, pB1, alB, l_reg, pa0, pa1, pa2, pa3); SBAR();
    pv_d0(o, vb0 + SHM_V, pa0, pa1, pa2, pa3);
    if (hi == 0) li_l[r32] = l_reg; asm volatile("s_waitcnt lgkmcnt(0)" ::: "memory");
    float rli[16];
#pragma unroll
    for (int r = 0; r < 16; ++r) rli[r] = __builtin_amdgcn_rcpf(li_l[crow(r, hi)]);
    bf16_t* Ow = Ob + (long)(wid * 32) * LDO;
#pragma unroll
    for (int r = 0; r < 16; ++r) { const int orow = crow(r, hi);
#pragma unroll
        for (int d0 = 0; d0 < 4; ++d0) Ow[(long)orow * LDO + d0 * 32 + r32] = (bf16_t)f2bf(o[d0][r] * rli[r]); }
    __syncthreads();
#undef SLOAD
#undef SWRITE
#undef RESC
}
template <int DQK, int LDQ, int LDK, int LDV, int LDO>
__device__ __forceinline__ void attn_body_single(const bf16_t* __restrict__ Qb, const bf16_t* __restrict__ Kh, const bf16_t* __restrict__ Vh, bf16_t* __restrict__ Ob, int seq, float scale, char* lds, int rope_t0) {
    constexpr int KP = DQK * 2 + 16, SHM_V = 64 * 128 * 2, SHM_K = 64 * KP, ND = DQK / 16, CH = DQK / 8, NKL = CH * 64 / NTHREADS;
    const float C = scale * 1.4426950408889634f, thr_raw = ATT_THR / scale;
    const int tid = threadIdx.x, wid = tid >> 6, lane = tid & 63, r32 = lane & 31, hi = lane >> 5;
    char* V_lds = lds; char* K_lds = lds + 2 * SHM_V;
    float* wsf = (float*)(lds + 2 * SHM_V + 2 * SHM_K) + wid * 64; float* li_l = wsf; float* al_l = wsf + 32;
    float m_reg = -1e30f, l_reg = 0; f32x16 o[4] = {}; bf16x8 qr[ND];
    const bf16_t* Qw = Qb + (long)(wid * 32 + r32) * LDQ + hi * 8;
#pragma unroll
    for (int d0 = 8; d0 < ND; ++d0) qr[d0] = *reinterpret_cast<const bf16x8*>(Qw + d0 * 16);
    if constexpr (DQK == 192) {
        if (rope_t0 >= 0) {
            const int tq = rope_t0 + wid * 32 + r32; const float prow = (float)(tq >> 6), pcol = (float)(tq & 63);
            u32x4 fa1 = __builtin_bit_cast(u32x4, qr[8]), fa2 = __builtin_bit_cast(u32x4, qr[9]), fb1 = __builtin_bit_cast(u32x4, qr[10]), fb2 = __builtin_bit_cast(u32x4, qr[11]);
#pragma unroll
            for (int jj = 0; jj < 4; ++jj) {
                float na1[2], na2[2], nb1[2], nb2[2];
#pragma unroll
                for (int e = 0; e < 2; ++e) { const float invf = __powf(10000.f, -(float)(hi * 8 + 2 * jj + e) * (1.f / 16.f));
                    const float ar = prow * invf, ac = pcol * invf, cr = __cosf(ar), sr_ = __sinf(ar), cc = __cosf(ac), sc_ = __sinf(ac);
                    const float a1 = e ? bfhi(fa1[jj]) : bflo(fa1[jj]), a2 = e ? bfhi(fa2[jj]) : bflo(fa2[jj]), b1 = e ? bfhi(fb1[jj]) : bflo(fb1[jj]), b2 = e ? bfhi(fb2[jj]) : bflo(fb2[jj]);
                    na1[e] = a1 * cr - a2 * sr_; na2[e] = a2 * cr + a1 * sr_; nb1[e] = b1 * cc - b2 * sc_; nb2[e] = b2 * cc + b1 * sc_; }
                fa1[jj] = pk2(na1[0], na1[1]); fa2[jj] = pk2(na2[0], na2[1]); fb1[jj] = pk2(nb1[0], nb1[1]); fb2[jj] = pk2(nb2[0], nb2[1]);
            }
            qr[8] = __builtin_bit_cast(bf16x8, fa1); qr[9] = __builtin_bit_cast(bf16x8, fa2); qr[10] = __builtin_bit_cast(bf16x8, fb1); qr[11] = __builtin_bit_cast(bf16x8, fb2);
        }
    }
    asm volatile("" ::: "memory");
#pragma unroll
    for (int d0 = 0; d0 < 8; ++d0) qr[d0] = *reinterpret_cast<const bf16x8*>(Qw + d0 * 16);
    const int sr = tid >> 4, sc = (tid & 15) * 8, vst0 = v_st(sr, sc), vst1 = v_st(32 + sr, sc);
    int krow[NKL], kch[NKL];
#pragma unroll
    for (int i = 0; i < NKL; ++i) { const int id = tid + i * NTHREADS; krow[i] = id / CH; kch[i] = id % CH; }
    const int vb0 = (int)(uintptr_t)V_lds + v_rd_base(lane);
    bf16x8 vs0, vs1, ks[NKL];
#define SLOAD(k0) do { vs0 = *reinterpret_cast<const bf16x8*>(&Vh[(long)((k0) + sr) * LDV + sc]); vs1 = *reinterpret_cast<const bf16x8*>(&Vh[(long)((k0) + 32 + sr) * LDV + sc]); \
    _Pragma("unroll") for (int i_ = 0; i_ < NKL; ++i_) ks[i_] = *reinterpret_cast<const bf16x8*>(&Kh[(long)((k0) + krow[i_]) * LDK + kch[i_] * 8]); } while (0)
#define SWRITE(b) do { *(bf16x8*)(V_lds + (b) * SHM_V + vst0) = vs0; *(bf16x8*)(V_lds + (b) * SHM_V + vst1) = vs1; \
    _Pragma("unroll") for (int i_ = 0; i_ < NKL; ++i_) *(bf16x8*)(K_lds + (b) * SHM_K + krow[i_] * KP + kch[i_] * 16) = ks[i_]; } while (0)
#define RESC(a) do { if (__any((a) < 1.f)) { if (hi == 0) al_l[r32] = (a); asm volatile("s_waitcnt lgkmcnt(0)" ::: "memory"); \
    _Pragma("unroll") for (int d = 0; d < 4; ++d) _Pragma("unroll") for (int r = 0; r < 16; ++r) o[d][r] *= al_l[crow(r, hi)]; } } while (0)
    f32x16 p0, p1; float mn, al; bf16x8 pa0, pa1, pa2, pa3; const int NT = seq / 64;
    SLOAD(0); asm volatile("s_waitcnt vmcnt(0)" ::: "memory"); SWRITE(0); __syncthreads();
    SLOAD(64);
    for (int j = 0; j < NT; ++j) {
        const int b = j & 1;
        SBAR(); qkt<DQK>(p0, p1, K_lds + b * SHM_K, qr, r32, hi);
        partialSM(p0, p1, m_reg, mn, al, C, thr_raw);
        RESC(al);
        finishSM(p0, p1, al, l_reg, pa0, pa1, pa2, pa3); SBAR();
        pv_d0(o, vb0 + b * SHM_V, pa0, pa1, pa2, pa3);
        if (j + 1 < NT) { asm volatile("s_waitcnt vmcnt(0)" ::: "memory"); SWRITE(b ^ 1); }
        __syncthreads();
        if (j + 2 < NT) SLOAD((j + 2) * 64);
    }
    if (hi == 0) li_l[r32] = l_reg; asm volatile("s_waitcnt lgkmcnt(0)" ::: "memory");
    float rli[16];
#pragma unroll
    for (int r = 0; r < 16; ++r) rli[r] = __builtin_amdgcn_rcpf(li_l[crow(r, hi)]);
    bf16_t* Ow = Ob + (long)(wid * 32) * LDO;
#pragma unroll
    for (int r = 0; r < 16; ++r) { const int orow = crow(r, hi);
#pragma unroll
        for (int d0 = 0; d0 < 4; ++d0) Ow[(long)orow * LDO + d0 * 32 + r32] = (bf16_t)f2bf(o[d0][r] * rli[r]); }
    __syncthreads();
#undef SLOAD
#undef SWRITE
#undef RESC
}
#define F8_ONE 0x7f7f7f7f
template <int DQK> __device__ __forceinline__ void qkt8(f32x16& p0, f32x16& p1, const char* Ks, const i32x8* qr, int r32, int hi) {
    constexpr int KP = DQK + 16;
    p0 = f32x16{}; p1 = f32x16{};
#pragma unroll
    for (int c = 0; c < DQK / 64; ++c) { const int cb = c * 64 + hi * 32;
        const u32x4 a0 = *reinterpret_cast<const u32x4*>(Ks + r32 * KP + cb), a1 = *reinterpret_cast<const u32x4*>(Ks + r32 * KP + cb + 16);
        const u32x4 b0 = *reinterpret_cast<const u32x4*>(Ks + (32 + r32) * KP + cb), b1 = *reinterpret_cast<const u32x4*>(Ks + (32 + r32) * KP + cb + 16);
        const i32x8 A = {(int)a0.x, (int)a0.y, (int)a0.z, (int)a0.w, (int)a1.x, (int)a1.y, (int)a1.z, (int)a1.w}, B = {(int)b0.x, (int)b0.y, (int)b0.z, (int)b0.w, (int)b1.x, (int)b1.y, (int)b1.z, (int)b1.w};
        p0 = __builtin_amdgcn_mfma_scale_f32_32x32x64_f8f6f4(A, qr[c], p0, 0, 0, 0, F8_ONE, 0, F8_ONE);
        p1 = __builtin_amdgcn_mfma_scale_f32_32x32x64_f8f6f4(B, qr[c], p1, 0, 0, 0, F8_ONE, 0, F8_ONE); }
}
__device__ __forceinline__ i32x8 q32_to_fp8(const bf16_t* p) {
    i32x8 r;
#pragma unroll
    for (int w = 0; w < 4; ++w) { const u32x4 v = *reinterpret_cast<const u32x4*>(p + 8 * w);
        r[2 * w] = (int)f8x4(bflo(v.x), bfhi(v.x), bflo(v.y), bfhi(v.y)); r[2 * w + 1] = (int)f8x4(bflo(v.z), bfhi(v.z), bflo(v.w), bfhi(v.w)); }
    return r;
}
__device__ __forceinline__ i32x8 q32_rope_fp8(const bf16_t* p, float pos) {
    float x[32];
#pragma unroll
    for (int w = 0; w < 4; ++w) { const u32x4 v = *reinterpret_cast<const u32x4*>(p + 8 * w);
#pragma unroll
        for (int e = 0; e < 4; ++e) { x[8 * w + 2 * e] = bflo(v[e]); x[8 * w + 2 * e + 1] = bfhi(v[e]); } }
    float y[32];
#pragma unroll
    for (int i = 0; i < 16; ++i) { const float ang = pos * __powf(10000.f, -(float)i * (1.f / 16.f)), cs = __cosf(ang), sn = __sinf(ang);
        y[i] = x[i] * cs - x[16 + i] * sn; y[16 + i] = x[16 + i] * cs + x[i] * sn; }
    i32x8 r;
#pragma unroll
    for (int w = 0; w < 8; ++w) r[w] = (int)f8x4(y[4 * w], y[4 * w + 1], y[4 * w + 2], y[4 * w + 3]);
    return r;
}
template <int DQK, int LDQ, int LDK, int LDV, int LDO>
__device__ __forceinline__ void attn8_body(const bf16_t* __restrict__ Qb, const unsigned char* __restrict__ Kh, const bf16_t* __restrict__ Vh, bf16_t* __restrict__ Ob, int seq, float scale, char* lds) {
    constexpr int KP = DQK + 16, SHM_V = 64 * 128 * 2, SHM_K = 64 * KP, NC = DQK / 64;
    static_assert(DQK == 128, "double-pipelined body: 128-wide q.k only");
    const float C = scale * 1.4426950408889634f, thr_raw = ATT_THR / scale;
    const int tid = threadIdx.x, wid = tid >> 6, lane = tid & 63, r32 = lane & 31, hi = lane >> 5;
    char* V_lds = lds; char* K_lds = lds + 2 * SHM_V;
    float* wsf = (float*)(lds + 2 * SHM_V + 2 * SHM_K) + wid * 64; float* li_l = wsf; float* al_l = wsf + 32;
    float m_reg = -1e30f, l_reg = 0; f32x16 o[4] = {}; i32x8 qr[NC];
    const bf16_t* Qw = Qb + (long)(wid * 32 + r32) * LDQ + hi * 32;
#pragma unroll
    for (int c = 0; c < NC; ++c) qr[c] = q32_to_fp8(Qw + 64 * c);
    const int sr = tid >> 4, sc = (tid & 15) * 8, vst0 = v_st(sr, sc), vst1 = v_st(32 + sr, sc);
    const int krow = tid >> 3, kch = (tid & 7) * 16;
    const int vb0 = (int)(uintptr_t)V_lds + v_rd_base(lane);
    bf16x8 vs0, vs1; u32x4 ks;
#define SLOAD(k0) do { vs0 = *reinterpret_cast<const bf16x8*>(&Vh[(long)((k0) + sr) * LDV + sc]); vs1 = *reinterpret_cast<const bf16x8*>(&Vh[(long)((k0) + 32 + sr) * LDV + sc]); \
    ks = *reinterpret_cast<const u32x4*>(&Kh[(long)((k0) + krow) * LDK + kch]); } while (0)
#define SWRITE(b) do { *(bf16x8*)(V_lds + (b) * SHM_V + vst0) = vs0; *(bf16x8*)(V_lds + (b) * SHM_V + vst1) = vs1; \
    *(u32x4*)(K_lds + (b) * SHM_K + krow * KP + kch) = ks; } while (0)
#define RESC(a) do { if (__any((a) < 1.f)) { if (hi == 0) al_l[r32] = (a); asm volatile("s_waitcnt lgkmcnt(0)" ::: "memory"); \
    _Pragma("unroll") for (int d = 0; d < 4; ++d) _Pragma("unroll") for (int r = 0; r < 16; ++r) o[d][r] *= al_l[crow(r, hi)]; } } while (0)
    f32x16 pA0, pA1, pB0, pB1; float mnA, mnB, alA, alB; bf16x8 pa0, pa1, pa2, pa3; const int NT = seq / 64;
    SLOAD(0); asm volatile("s_waitcnt vmcnt(0)" ::: "memory"); SWRITE(0); __syncthreads();
    qkt8<DQK>(pA0, pA1, K_lds, qr, r32, hi); partialSM(pA0, pA1, m_reg, mnA, alA, C, thr_raw);
    SLOAD(64);
    asm volatile("s_waitcnt vmcnt(0)" ::: "memory"); SWRITE(1); __syncthreads();
    for (int j = 1; j + 1 < NT; j += 2) {
        SBAR(); qkt8<DQK>(pB0, pB1, K_lds + SHM_K, qr, r32, hi);
        finishSM(pA0, pA1, alA, l_reg, pa0, pa1, pa2, pa3); SBAR();
        SLOAD((j + 1) * 64); SBAR();
        pv_d0(o, vb0, pa0, pa1, pa2, pa3); partialSM(pB0, pB1, m_reg, mnB, alB, C, thr_raw);
        __syncthreads(); asm volatile("s_waitcnt vmcnt(0)" ::: "memory"); SWRITE(0);
        RESC(alB); __syncthreads();
        SBAR(); qkt8<DQK>(pA0, pA1, K_lds, qr, r32, hi);
        finishSM(pB0, pB1, alB, l_reg, pa0, pa1, pa2, pa3); SBAR();
        SLOAD((j + 2) * 64); SBAR();
        pv_d0(o, vb0 + SHM_V, pa0, pa1, pa2, pa3); partialSM(pA0, pA1, m_reg, mnA, alA, C, thr_raw);
        __syncthreads(); asm volatile("s_waitcnt vmcnt(0)" ::: "memory"); SWRITE(1);
        RESC(alA); __syncthreads();
    }
    SBAR(); qkt8<DQK>(pB0, pB1, K_lds + SHM_K, qr, r32, hi);
    finishSM(pA0, pA1, alA, l_reg, pa0, pa1, pa2, pa3); SBAR();
    pv_d0(o, vb0, pa0, pa1, pa2, pa3); partialSM(pB0, pB1, m_reg, mnB, alB, C, thr_raw);
    __syncthreads(); RESC(alB);
    finishSM(pB0, pB1, alB, l_reg, pa0, pa1, pa2, pa3); SBAR();
    pv_d0(o, vb0 + SHM_V, pa0, pa1, pa2, pa3);
    if (hi == 0) li_l[r32] = l_reg; asm volatile("s_waitcnt lgkmcnt(0)" ::: "memory");
    float rli[16];
#pragma unroll
    for (int r = 0; r < 16; ++r) rli[r] = __builtin_amdgcn_rcpf(li_l[crow(r, hi)]);
    bf16_t* Ow = Ob + (long)(wid * 32) * LDO;
#pragma unroll
    for (int r = 0; r < 16; ++r) { const int orow = crow(r, hi);
#pragma unroll
        for (int d0 = 0; d0 < 4; ++d0) Ow[(long)orow * LDO + d0 * 32 + r32] = (bf16_t)f2bf(o[d0][r] * rli[r]); }
    __syncthreads();
#undef SLOAD
#undef SWRITE
#undef RESC
}
template <int DQK, int LDQ, int LDK, int LDV, int LDO>
__device__ __forceinline__ void attn8_body_single(const bf16_t* __restrict__ Qb, const unsigned char* __restrict__ Kh, const bf16_t* __restrict__ Vh, bf16_t* __restrict__ Ob, int seq, float scale, char* lds, int rope_t0) {
    constexpr int KP = DQK + 16, SHM_V = 64 * 128 * 2, SHM_K = 64 * KP, NC = DQK / 64, CH = DQK / 16, NCH = 64 * CH, NKL = (NCH + NTHREADS - 1) / NTHREADS;
    const float C = scale * 1.4426950408889634f, thr_raw = ATT_THR / scale;
    const int tid = threadIdx.x, wid = tid >> 6, lane = tid & 63, r32 = lane & 31, hi = lane >> 5;
    char* V_lds = lds; char* K_lds = lds + 2 * SHM_V;
    float* wsf = (float*)(lds + 2 * SHM_V + 2 * SHM_K) + wid * 64; float* li_l = wsf; float* al_l = wsf + 32;
    float m_reg = -1e30f, l_reg = 0; f32x16 o[4] = {}; i32x8 qr[NC];
    const bf16_t* Qw = Qb + (long)(wid * 32 + r32) * LDQ + hi * 32;
    if constexpr (DQK == 192) {
        if (rope_t0 >= 0) { const int tq = rope_t0 + wid * 32 + r32; qr[2] = q32_rope_fp8(Qw + 128, (float)(hi ? (tq & 63) : (tq >> 6))); }
        else qr[2] = q32_to_fp8(Qw + 128);
    }
    asm volatile("" ::: "memory");
#pragma unroll
    for (int c = 0; c < 2; ++c) qr[c] = q32_to_fp8(Qw + 64 * c);
    const int sr = tid >> 4, sc = (tid & 15) * 8, vst0 = v_st(sr, sc), vst1 = v_st(32 + sr, sc);
    int krow[NKL], kch[NKL];
#pragma unroll
    for (int i = 0; i < NKL; ++i) { const int id = tid + i * NTHREADS; krow[i] = (id < NCH) ? id / CH : 0; kch[i] = (id % CH) * 16; }
    const bool k2 = (NKL < 2) || (tid + NTHREADS < NCH);
    const int vb0 = (int)(uintptr_t)V_lds + v_rd_base(lane);
    bf16x8 vs0, vs1; u32x4 ks[NKL];
#define SLOAD(k0) do { vs0 = *reinterpret_cast<const bf16x8*>(&Vh[(long)((k0) + sr) * LDV + sc]); vs1 = *reinterpret_cast<const bf16x8*>(&Vh[(long)((k0) + 32 + sr) * LDV + sc]); \
    _Pragma("unroll") for (int i_ = 0; i_ < NKL; ++i_) ks[i_] = *reinterpret_cast<const u32x4*>(&Kh[(long)((k0) + krow[i_]) * LDK + kch[i_]]); } while (0)
#define SWRITE(b) do { *(bf16x8*)(V_lds + (b) * SHM_V + vst0) = vs0; *(bf16x8*)(V_lds + (b) * SHM_V + vst1) = vs1; \
    _Pragma("unroll") for (int i_ = 0; i_ < NKL; ++i_) if (i_ == 0 || k2) *(u32x4*)(K_lds + (b) * SHM_K + krow[i_] * KP + kch[i_]) = ks[i_]; } while (0)
#define RESC(a) do { if (__any((a) < 1.f)) { if (hi == 0) al_l[r32] = (a); asm volatile("s_waitcnt lgkmcnt(0)" ::: "memory"); \
    _Pragma("unroll") for (int d = 0; d < 4; ++d) _Pragma("unroll") for (int r = 0; r < 16; ++r) o[d][r] *= al_l[crow(r, hi)]; } } while (0)
    f32x16 p0, p1; float mn, al; bf16x8 pa0, pa1, pa2, pa3; const int NT = seq / 64;
    SLOAD(0); asm volatile("s_waitcnt vmcnt(0)" ::: "memory"); SWRITE(0); __syncthreads();
    SLOAD(64);
    for (int j = 0; j < NT; ++j) {
        const int b = j & 1;
        SBAR(); qkt8<DQK>(p0, p1, K_lds + b * SHM_K, qr, r32, hi);
        partialSM(p0, p1, m_reg, mn, al, C, thr_raw);
        RESC(al);
        finishSM(p0, p1, al, l_reg, pa0, pa1, pa2, pa3); SBAR();
        pv_d0(o, vb0 + b * SHM_V, pa0, pa1, pa2, pa3);
        if (j + 1 < NT) { asm volatile("s_waitcnt vmcnt(0)" ::: "memory"); SWRITE(b ^ 1); }
        __syncthreads();
        if (j + 2 < NT) SLOAD((j + 2) * 64);
    }
    if (hi == 0) li_l[r32] = l_reg; asm volatile("s_waitcnt lgkmcnt(0)" ::: "memory");
    float rli[16];
#pragma unroll
    for (int r = 0; r < 16; ++r) rli[r] = __builtin_amdgcn_rcpf(li_l[crow(r, hi)]);
    bf16_t* Ow = Ob + (long)(wid * 32) * LDO;
#pragma unroll
    for (int r = 0; r < 16; ++r) { const int orow = crow(r, hi);
#pragma unroll
        for (int d0 = 0; d0 < 4; ++d0) Ow[(long)orow * LDO + d0 * 32 + r32] = (bf16_t)f2bf(o[d0][r] * rli[r]); }
    __syncthreads();
#undef SLOAD
#undef SWRITE
#undef RESC
}
constexpr float ATT8_THR = 3.5f, ATT8_SH = 3.f;
#ifndef ATT8_FIXED_M
#define ATT8_FIXED_M 0
#endif
__device__ __forceinline__ void partialSM8(f32x16& p0, f32x16& p1, float& m_reg, float& mn, float& alpha, float C, float thr_raw) {
#if ATT8_FIXED_M
    mn = 6.f * 1.4426950408889634f / C; alpha = 1.f; m_reg = mn;
#else
    float pmax = p0[0];
#pragma unroll
    for (int r = 1; r < 16; ++r) pmax = fmaxf(pmax, p0[r]);
#pragma unroll
    for (int r = 0; r < 16; ++r) pmax = fmaxf(pmax, p1[r]);
    { auto rr = __builtin_amdgcn_permlane32_swap(__float_as_uint(pmax), __float_as_uint(pmax), false, false);
      pmax = fmaxf(__uint_as_float(rr[0]), __uint_as_float(rr[1])); }
    if (__builtin_expect(__all(pmax - m_reg <= thr_raw), 1)) { mn = m_reg; alpha = 1.f; }
    else { mn = fmaxf(m_reg, pmax); alpha = __builtin_amdgcn_exp2f((m_reg - mn) * C); m_reg = mn; }
#endif
    const float mnC = ATT8_SH - mn * C;
#pragma unroll
    for (int r = 0; r < 16; ++r) p0[r] = fmaf(p0[r], C, mnC);
#pragma unroll
    for (int r = 0; r < 16; ++r) p1[r] = fmaf(p1[r], C, mnC);
#pragma unroll
    for (int r = 0; r < 16; ++r) p0[r] = __builtin_amdgcn_exp2f(p0[r]);
}
__device__ __forceinline__ void finishSM8(f32x16& p0, f32x16& p1, float alpha, float& l_reg, i32x8& pa) {
#pragma unroll
    for (int r = 0; r < 16; ++r) p1[r] = __builtin_amdgcn_exp2f(p1[r]);
    float ps = 0;
#pragma unroll
    for (int r = 0; r < 16; ++r) ps += p0[r];
#pragma unroll
    for (int r = 0; r < 16; ++r) ps += p1[r];
    { auto rr = __builtin_amdgcn_permlane32_swap(__float_as_uint(ps), __float_as_uint(ps), false, false);
      ps = __uint_as_float(rr[0]) + __uint_as_float(rr[1]); }
    l_reg = l_reg * alpha + ps;
#pragma unroll
    for (int w = 0; w < 4; ++w) { pa[w] = (int)f8x4(p0[4 * w], p0[4 * w + 1], p0[4 * w + 2], p0[4 * w + 3]); pa[4 + w] = (int)f8x4(p1[4 * w], p1[4 * w + 1], p1[4 * w + 2], p1[4 * w + 3]); }
}
template <int OFF> __device__ __forceinline__ u32x2 tr8_read(int vb) { u32x2 r; asm volatile("ds_read_b64_tr_b8 %0, %1 offset:%2" : "=&v"(r) : "v"(vb), "i"(OFF) : "memory"); return r; }
__device__ __forceinline__ void pv8_one(f32x16& od, int vb, const i32x8& pa) {
    const u32x2 t0 = tr8_read<0>(vb), t1 = tr8_read<2048>(vb), t2 = tr8_read<4096>(vb), t3 = tr8_read<6144>(vb);
    asm volatile("s_waitcnt lgkmcnt(0)" ::: "memory"); SBAR();
    const i32x8 B = {(int)t0.x, (int)t0.y, (int)t1.x, (int)t1.y, (int)t2.x, (int)t2.y, (int)t3.x, (int)t3.y};
    od = __builtin_amdgcn_mfma_scale_f32_32x32x64_f8f6f4(pa, B, od, 0, 0, 0, F8_ONE, 0, F8_ONE);
}
__device__ __forceinline__ int v8_f(int key) { return ((key >> 1) & 1) + 2 * ((key >> 3) & 1); }
__device__ __forceinline__ int v8_st(int key, int ch16) { return key * 128 + 32 * ((ch16 >> 1) ^ v8_f(key)) + 16 * (ch16 & 1); }
__device__ __forceinline__ int v8_rd_base(int lane, int db) {
    const int q = (lane & 15) >> 1, pp = lane & 1, g1 = (lane >> 4) & 1, hi = lane >> 5, fq = ((q >> 1) & 1) + 2 * (q >> 2);
    return (8 * (q >> 2) + 4 * hi + (q & 3)) * 128 + 32 * (db ^ fq) + 16 * g1 + 8 * pp;
}
template <int DQK, int LDQ, int LDK, int LDV, int LDO>
__device__ __forceinline__ void attn88_body(const bf16_t* __restrict__ Qb, const unsigned char* __restrict__ Kh, const unsigned char* __restrict__ Vh, bf16_t* __restrict__ Ob, int seq, float scale, char* lds) {
    constexpr int KP = DQK + 16, SHM_V = 64 * 128, SHM_K = 64 * KP, NC = DQK / 64;
    static_assert(DQK == 128, "double-pipelined body: 128-wide q.k only");
    const float C = scale * 1.4426950408889634f, thr_raw = ATT8_THR / scale;
    const int tid = threadIdx.x, wid = tid >> 6, lane = tid & 63, r32 = lane & 31, hi = lane >> 5;
    char* V_lds = lds; char* K_lds = lds + 2 * SHM_V;
    float* wsf = (float*)(lds + 2 * SHM_V + 2 * SHM_K) + wid * 64; float* li_l = wsf; float* al_l = wsf + 32;
    float m_reg = -1e30f, l_reg = 0; f32x16 o[4] = {}; i32x8 qr[NC];
    const bf16_t* Qw = Qb + (long)(wid * 32 + r32) * LDQ + hi * 32;
#pragma unroll
    for (int c = 0; c < NC; ++c) qr[c] = q32_to_fp8(Qw + 64 * c);
    const int krow = tid >> 3, kch = (tid & 7) * 16, vst = v8_st(krow, tid & 7);
    int vb[4];
#pragma unroll
    for (int d = 0; d < 4; ++d) vb[d] = (int)(uintptr_t)V_lds + v8_rd_base(lane, d);
    u32x4 vs, ks;
#define SLOAD(k0) do { vs = *reinterpret_cast<const u32x4*>(&Vh[(long)((k0) + krow) * LDV + kch]); ks = *reinterpret_cast<const u32x4*>(&Kh[(long)((k0) + krow) * LDK + kch]); } while (0)
#define SWRITE(b) do { *(u32x4*)(V_lds + (b) * SHM_V + vst) = vs; *(u32x4*)(K_lds + (b) * SHM_K + krow * KP + kch) = ks; } while (0)
#define RESC(a) do { if (__any((a) < 1.f)) { if (hi == 0) al_l[r32] = (a); asm volatile("s_waitcnt lgkmcnt(0)" ::: "memory"); \
    _Pragma("unroll") for (int d = 0; d < 4; ++d) _Pragma("unroll") for (int r = 0; r < 16; ++r) o[d][r] *= al_l[crow(r, hi)]; } } while (0)
#define PV8(b) do { pv8_one(o[0], vb[0] + (b) * SHM_V, pa); pv8_one(o[1], vb[1] + (b) * SHM_V, pa); pv8_one(o[2], vb[2] + (b) * SHM_V, pa); pv8_one(o[3], vb[3] + (b) * SHM_V, pa); } while (0)
    f32x16 pA0, pA1, pB0, pB1; float mnA, mnB, alA, alB; i32x8 pa; const int NT = seq / 64;
    SLOAD(0); asm volatile("s_waitcnt vmcnt(0)" ::: "memory"); SWRITE(0); __syncthreads();
    qkt8<DQK>(pA0, pA1, K_lds, qr, r32, hi); partialSM8(pA0, pA1, m_reg, mnA, alA, C, thr_raw);
    SLOAD(64);
    asm volatile("s_waitcnt vmcnt(0)" ::: "memory"); SWRITE(1); __syncthreads();
    for (int j = 1; j + 1 < NT; j += 2) {
        SBAR(); qkt8<DQK>(pB0, pB1, K_lds + SHM_K, qr, r32, hi);
        finishSM8(pA0, pA1, alA, l_reg, pa); SBAR();
        SLOAD((j + 1) * 64); SBAR();
        PV8(0); partialSM8(pB0, pB1, m_reg, mnB, alB, C, thr_raw);
        __syncthreads(); asm volatile("s_waitcnt vmcnt(0)" ::: "memory"); SWRITE(0);
        RESC(alB); __syncthreads();
        SBAR(); qkt8<DQK>(pA0, pA1, K_lds, qr, r32, hi);
        finishSM8(pB0, pB1, alB, l_reg, pa); SBAR();
        SLOAD((j + 2) * 64); SBAR();
        PV8(1); partialSM8(pA0, pA1, m_reg, mnA, alA, C, thr_raw);
        __syncthreads(); asm volatile("s_waitcnt vmcnt(0)" ::: "memory"); SWRITE(1);
        RESC(alA); __syncthreads();
    }
    SBAR(); qkt8<DQK>(pB0, pB1, K_lds + SHM_K, qr, r32, hi);
    finishSM8(pA0, pA1, alA, l_reg, pa); SBAR();
    PV8(0); partialSM8(pB0, pB1, m_reg, mnB, alB, C, thr_raw);
    __syncthreads(); RESC(alB);
    finishSM8(pB0, pB1, alB, l_reg, pa); SBAR();
    PV8(1);
    if (hi == 0) li_l[r32] = l_reg; asm volatile("s_waitcnt lgkmcnt(0)" ::: "memory");
    float rli[16];
#pragma unroll
    for (int r = 0; r < 16; ++r) rli[r] = __builtin_amdgcn_rcpf(li_l[crow(r, hi)]);
    bf16_t* Ow = Ob + (long)(wid * 32) * LDO;
#pragma unroll
    for (int r = 0; r < 16; ++r) { const int orow = crow(r, hi);
#pragma unroll
        for (int d0 = 0; d0 < 4; ++d0) Ow[(long)orow * LDO + d0 * 32 + r32] = (bf16_t)f2bf(o[d0][r] * rli[r]); }
    __syncthreads();
#undef SLOAD
#undef SWRITE
}
template <int DQK, int LDQ, int LDK, int LDV, int LDO>
__device__ __forceinline__ void attn88_body_single(const bf16_t* __restrict__ Qb, const unsigned char* __restrict__ Kh, const unsigned char* __restrict__ Vh, bf16_t* __restrict__ Ob, int seq, float scale, char* lds, int rope_t0) {
    constexpr int KP = DQK + 16, SHM_V = 64 * 128, SHM_K = 64 * KP, NC = DQK / 64, CH = DQK / 16, NCH = 64 * CH, NKL = (NCH + NTHREADS - 1) / NTHREADS;
    const float C = scale * 1.4426950408889634f, thr_raw = ATT8_THR / scale;
    const int tid = threadIdx.x, wid = tid >> 6, lane = tid & 63, r32 = lane & 31, hi = lane >> 5;
    char* V_lds = lds; char* K_lds = lds + 2 * SHM_V;
    float* wsf = (float*)(lds + 2 * SHM_V + 2 * SHM_K) + wid * 64; float* li_l = wsf; float* al_l = wsf + 32;
    float m_reg = -1e30f, l_reg = 0; f32x16 o[4] = {}; i32x8 qr[NC];
    const bf16_t* Qw = Qb + (long)(wid * 32 + r32) * LDQ + hi * 32;
    if constexpr (DQK == 192) {
        if (rope_t0 >= 0) { const int tq = rope_t0 + wid * 32 + r32; qr[2] = q32_rope_fp8(Qw + 128, (float)(hi ? (tq & 63) : (tq >> 6))); }
        else qr[2] = q32_to_fp8(Qw + 128);
    }
    asm volatile("" ::: "memory");
#pragma unroll
    for (int c = 0; c < 2; ++c) qr[c] = q32_to_fp8(Qw + 64 * c);
    const int vrow = tid >> 3, vch = (tid & 7) * 16, vst = v8_st(vrow, tid & 7);
    int krow[NKL], kch[NKL];
#pragma unroll
    for (int i = 0; i < NKL; ++i) { const int id = tid + i * NTHREADS; krow[i] = (id < NCH) ? id / CH : 0; kch[i] = (id % CH) * 16; }
    const bool k2 = (NKL < 2) || (tid + NTHREADS < NCH);
    int vb[4];
#pragma unroll
    for (int d = 0; d < 4; ++d) vb[d] = (int)(uintptr_t)V_lds + v8_rd_base(lane, d);
    u32x4 vs, ks[NKL];
#define SLOAD(k0) do { vs = *reinterpret_cast<const u32x4*>(&Vh[(long)((k0) + vrow) * LDV + vch]); \
    _Pragma("unroll") for (int i_ = 0; i_ < NKL; ++i_) ks[i_] = *reinterpret_cast<const u32x4*>(&Kh[(long)((k0) + krow[i_]) * LDK + kch[i_]]); } while (0)
#define SWRITE(b) do { *(u32x4*)(V_lds + (b) * SHM_V + vst) = vs; \
    _Pragma("unroll") for (int i_ = 0; i_ < NKL; ++i_) if (i_ == 0 || k2) *(u32x4*)(K_lds + (b) * SHM_K + krow[i_] * KP + kch[i_]) = ks[i_]; } while (0)
    f32x16 p0, p1; float mn, al; i32x8 pa; const int NT = seq / 64;
    SLOAD(0); asm volatile("s_waitcnt vmcnt(0)" ::: "memory"); SWRITE(0); __syncthreads();
    SLOAD(64);
    for (int j = 0; j < NT; ++j) {
        const int b = j & 1;
        SBAR(); qkt8<DQK>(p0, p1, K_lds + b * SHM_K, qr, r32, hi);
        partialSM8(p0, p1, m_reg, mn, al, C, thr_raw);
        RESC(al);
        finishSM8(p0, p1, al, l_reg, pa); SBAR();
        PV8(b);
        if (j + 1 < NT) { asm volatile("s_waitcnt vmcnt(0)" ::: "memory"); SWRITE(b ^ 1); }
        __syncthreads();
        if (j + 2 < NT) SLOAD((j + 2) * 64);
    }
    if (hi == 0) li_l[r32] = l_reg; asm volatile("s_waitcnt lgkmcnt(0)" ::: "memory");
    float rli[16];
#pragma unroll
    for (int r = 0; r < 16; ++r) rli[r] = __builtin_amdgcn_rcpf(li_l[crow(r, hi)]);
    bf16_t* Ow = Ob + (long)(wid * 32) * LDO;
#pragma unroll
    for (int r = 0; r < 16; ++r) { const int orow = crow(r, hi);
#pragma unroll
        for (int d0 = 0; d0 < 4; ++d0) Ow[(long)orow * LDO + d0 * 32 + r32] = (bf16_t)f2bf(o[d0][r] * rli[r]); }
    __syncthreads();
#undef SLOAD
#undef SWRITE
#undef RESC
#undef PV8
}
__device__ __forceinline__ void p_attn_mla(const Args& A, const Frame& F) {
    const bf16_t* Q = (const bf16_t*)(F.ws + WS_Q); const unsigned char* Kb = F.ws + WS_K; const unsigned char* Vb = F.ws + WS_V; bf16_t* O = (bf16_t*)(F.ws + WS_O);
    const float scale = 0.07216878364870322f;
    for (int u = F.vcu; u < 544; u += F.nblk) {
        int b, h, q0, seq;
        int rope_t0;
        if (u < 512) { const int qb = u & 15; h = (u >> 4) & 7; b = u >> 7; q0 = CTXL + qb * 256; seq = RPB; rope_t0 = qb * 256; }
        else { const int v = u - 512; h = v & 7; b = v >> 3; q0 = 0; seq = CTXL; rope_t0 = -1; }
        const size_t rb = (size_t)b * RPB;
        attn88_body_single<192, 1536, 1536, 1024, 1024>(Q + (rb + q0) * 1536 + h * 192, Kb + rb * 1536 + h * 192, Vb + rb * 1024 + h * 128, O + (rb + q0) * 1024 + h * 128, seq, scale, F.lds, rope_t0);
    }
}
__device__ __forceinline__ void p_attn_gqa(const Args& A, const Frame& F) {
    const bf16_t* Q = (const bf16_t*)(F.ws + WS_Q1); const unsigned char* Kb = F.ws + WS_K1; const unsigned char* Vb = F.ws + WS_V1; bf16_t* O = (bf16_t*)(F.ws + WS_O);
    const float scale = 0.08838834764831845f;
    for (int u = F.vcu; u < 512; u += F.nblk) {
        const int qb = u & 15, h = (u >> 4) & 7, b = u >> 7, q0 = CTXL + qb * 256, kvh = h >> 2;
        const size_t rb = (size_t)b * RPB;
        attn88_body<128, 1024, 256, 256, 1024>(Q + (rb + q0) * 1024 + h * 128, Kb + rb * 256 + kvh * 128, Vb + rb * 256 + kvh * 128, O + (rb + q0) * 1024 + h * 128, RPB, scale, F.lds);
    }
}

#define DPP_XOR1 0xB1
#define DPP_XOR2 0x4E
#define DPP_HMIRROR 0x141
#define DPP_MIRROR 0x140
__device__ __forceinline__ int row_max_i(int v) {
    v = max(v, __builtin_amdgcn_update_dpp(v, v, DPP_XOR1, 0xf, 0xf, false));
    v = max(v, __builtin_amdgcn_update_dpp(v, v, DPP_XOR2, 0xf, 0xf, false));
    v = max(v, __builtin_amdgcn_update_dpp(v, v, DPP_HMIRROR, 0xf, 0xf, false));
    v = max(v, __builtin_amdgcn_update_dpp(v, v, DPP_MIRROR, 0xf, 0xf, false));
    return v;
}
__device__ __forceinline__ float row_sum_f(float v) {
    v += __builtin_bit_cast(float, __builtin_amdgcn_update_dpp(0, __builtin_bit_cast(int, v), DPP_XOR1, 0xf, 0xf, false));
    v += __builtin_bit_cast(float, __builtin_amdgcn_update_dpp(0, __builtin_bit_cast(int, v), DPP_XOR2, 0xf, 0xf, false));
    v += __builtin_bit_cast(float, __builtin_amdgcn_update_dpp(0, __builtin_bit_cast(int, v), DPP_HMIRROR, 0xf, 0xf, false));
    v += __builtin_bit_cast(float, __builtin_amdgcn_update_dpp(0, __builtin_bit_cast(int, v), DPP_MIRROR, 0xf, 0xf, false));
    return v;
}
__device__ __forceinline__ int fkey(float f) { const int b = __builtin_bit_cast(int, f); return b ^ ((b >> 31) & 0x7fffffff); }
__device__ __forceinline__ float keyf(int k) { return __builtin_bit_cast(float, k ^ ((k >> 31) & 0x7fffffff)); }
__device__ __forceinline__ void cand_ij(int t, int& i, int& j) {
    const int g16 = t >= 16, g24 = t >= 24, g29 = t >= 29, g33 = t >= 33, g36 = t >= 36, g38 = t >= 38, g40 = t >= 40;
    i = g16 + g24 + g29 + g33 + g36 + g38 + g40 + max(t - 41, 0);
    const int base = 16 * g16 + 8 * g24 + 5 * g29 + 4 * g33 + 3 * g36 + 2 * g38 + 2 * g40;
    j = (t >= 42) ? 0 : t - base;
    if (t >= 50) { i = 0; j = 0; }
}
__device__ __forceinline__ void row_max2(int& a, int& b) {
    asm volatile("s_nop 1\n\t"
                 "v_max_i32_dpp %0, %0, %0 quad_perm:[1,0,3,2] row_mask:0xf bank_mask:0xf\n\tv_max_i32_dpp %1, %1, %1 quad_perm:[1,0,3,2] row_mask:0xf bank_mask:0xf\n\ts_nop 0\n\t"
                 "v_max_i32_dpp %0, %0, %0 quad_perm:[2,3,0,1] row_mask:0xf bank_mask:0xf\n\tv_max_i32_dpp %1, %1, %1 quad_perm:[2,3,0,1] row_mask:0xf bank_mask:0xf\n\ts_nop 0\n\t"
                 "v_max_i32_dpp %0, %0, %0 row_half_mirror row_mask:0xf bank_mask:0xf\n\tv_max_i32_dpp %1, %1, %1 row_half_mirror row_mask:0xf bank_mask:0xf\n\ts_nop 0\n\t"
                 "v_max_i32_dpp %0, %0, %0 row_mirror row_mask:0xf bank_mask:0xf\n\tv_max_i32_dpp %1, %1, %1 row_mirror row_mask:0xf bank_mask:0xf\n\ts_nop 1"
                 : "+v"(a), "+v"(b));
}
__device__ __forceinline__ void row_max1(int& a) {
    asm volatile("s_nop 1\n\t"
                 "v_max_i32_dpp %0, %0, %0 quad_perm:[1,0,3,2] row_mask:0xf bank_mask:0xf\n\ts_nop 1\n\t"
                 "v_max_i32_dpp %0, %0, %0 quad_perm:[2,3,0,1] row_mask:0xf bank_mask:0xf\n\ts_nop 1\n\t"
                 "v_max_i32_dpp %0, %0, %0 row_half_mirror row_mask:0xf bank_mask:0xf\n\ts_nop 1\n\t"
                 "v_max_i32_dpp %0, %0, %0 row_mirror row_mask:0xf bank_mask:0xf\n\ts_nop 1"
                 : "+v"(a));
}
__device__ __forceinline__ void row_max4(int& a, int& b, int& c, int& d) {
    asm volatile("s_nop 1\n\t"
                 "v_max_i32_dpp %0, %0, %0 quad_perm:[1,0,3,2] row_mask:0xf bank_mask:0xf\n\tv_max_i32_dpp %1, %1, %1 quad_perm:[1,0,3,2] row_mask:0xf bank_mask:0xf\n\t"
                 "v_max_i32_dpp %2, %2, %2 quad_perm:[1,0,3,2] row_mask:0xf bank_mask:0xf\n\tv_max_i32_dpp %3, %3, %3 quad_perm:[1,0,3,2] row_mask:0xf bank_mask:0xf\n\t"
                 "v_max_i32_dpp %0, %0, %0 quad_perm:[2,3,0,1] row_mask:0xf bank_mask:0xf\n\tv_max_i32_dpp %1, %1, %1 quad_perm:[2,3,0,1] row_mask:0xf bank_mask:0xf\n\t"
                 "v_max_i32_dpp %2, %2, %2 quad_perm:[2,3,0,1] row_mask:0xf bank_mask:0xf\n\tv_max_i32_dpp %3, %3, %3 quad_perm:[2,3,0,1] row_mask:0xf bank_mask:0xf\n\t"
                 "v_max_i32_dpp %0, %0, %0 row_half_mirror row_mask:0xf bank_mask:0xf\n\tv_max_i32_dpp %1, %1, %1 row_half_mirror row_mask:0xf bank_mask:0xf\n\t"
                 "v_max_i32_dpp %2, %2, %2 row_half_mirror row_mask:0xf bank_mask:0xf\n\tv_max_i32_dpp %3, %3, %3 row_half_mirror row_mask:0xf bank_mask:0xf\n\t"
                 "v_max_i32_dpp %0, %0, %0 row_mirror row_mask:0xf bank_mask:0xf\n\tv_max_i32_dpp %1, %1, %1 row_mirror row_mask:0xf bank_mask:0xf\n\t"
                 "v_max_i32_dpp %2, %2, %2 row_mirror row_mask:0xf bank_mask:0xf\n\tv_max_i32_dpp %3, %3, %3 row_mirror row_mask:0xf bank_mask:0xf\n\ts_nop 1"
                 : "+v"(a), "+v"(b), "+v"(c), "+v"(d));
}
#define CE_DESC(x, y) do { const int hi_ = max(x, y), lo_ = min(x, y); x = hi_; y = lo_; } while (0)
#define SORT8_DESC(k) do { CE_DESC(k[0], k[2]); CE_DESC(k[1], k[3]); CE_DESC(k[4], k[6]); CE_DESC(k[5], k[7]); CE_DESC(k[0], k[4]); CE_DESC(k[1], k[5]); CE_DESC(k[2], k[6]); CE_DESC(k[3], k[7]); \
    CE_DESC(k[0], k[1]); CE_DESC(k[2], k[3]); CE_DESC(k[4], k[5]); CE_DESC(k[6], k[7]); CE_DESC(k[2], k[4]); CE_DESC(k[3], k[5]); CE_DESC(k[1], k[4]); CE_DESC(k[3], k[6]); CE_DESC(k[1], k[2]); CE_DESC(k[3], k[4]); CE_DESC(k[5], k[6]); } while (0)
#define SORT16_DESC(K) do { CE_DESC(K[0], K[1]); CE_DESC(K[2], K[3]); CE_DESC(K[0], K[2]); CE_DESC(K[1], K[3]); CE_DESC(K[1], K[2]); CE_DESC(K[4], K[5]); CE_DESC(K[6], K[7]); CE_DESC(K[4], K[6]); CE_DESC(K[5], K[7]); CE_DESC(K[5], K[6]); CE_DESC(K[0], K[4]); CE_DESC(K[2], K[6]); CE_DESC(K[2], K[4]); CE_DESC(K[1], K[5]); CE_DESC(K[3], K[7]); CE_DESC(K[3], K[5]); CE_DESC(K[1], K[2]); CE_DESC(K[3], K[4]); CE_DESC(K[5], K[6]); CE_DESC(K[8], K[9]); CE_DESC(K[10], K[11]); CE_DESC(K[8], K[10]); CE_DESC(K[9], K[11]); CE_DESC(K[9], K[10]); CE_DESC(K[12], K[13]); CE_DESC(K[14], K[15]); CE_DESC(K[12], K[14]); CE_DESC(K[13], K[15]); CE_DESC(K[13], K[14]); CE_DESC(K[8], K[12]); CE_DESC(K[10], K[14]); CE_DESC(K[10], K[12]); CE_DESC(K[9], K[13]); CE_DESC(K[11], K[15]); CE_DESC(K[11], K[13]); CE_DESC(K[9], K[10]); CE_DESC(K[11], K[12]); CE_DESC(K[13], K[14]); CE_DESC(K[0], K[8]); CE_DESC(K[4], K[12]); CE_DESC(K[4], K[8]); CE_DESC(K[2], K[10]); CE_DESC(K[6], K[14]); CE_DESC(K[6], K[10]); CE_DESC(K[2], K[4]); CE_DESC(K[6], K[8]); CE_DESC(K[10], K[12]); CE_DESC(K[1], K[9]); CE_DESC(K[5], K[13]); CE_DESC(K[5], K[9]); CE_DESC(K[3], K[11]); CE_DESC(K[7], K[15]); CE_DESC(K[7], K[11]); CE_DESC(K[3], K[5]); CE_DESC(K[7], K[9]); CE_DESC(K[11], K[13]); CE_DESC(K[1], K[2]); CE_DESC(K[3], K[4]); CE_DESC(K[5], K[6]); CE_DESC(K[7], K[8]); CE_DESC(K[9], K[10]); CE_DESC(K[11], K[12]); CE_DESC(K[13], K[14]); } while (0)
#define MERGE16_DESC(T, K) do { _Pragma("unroll") for (int i_ = 0; i_ < 16; ++i_) T[i_] = max(T[i_], K[15 - i_]); CE_DESC(T[0], T[8]); CE_DESC(T[1], T[9]); CE_DESC(T[2], T[10]); CE_DESC(T[3], T[11]); CE_DESC(T[4], T[12]); CE_DESC(T[5], T[13]); CE_DESC(T[6], T[14]); CE_DESC(T[7], T[15]); CE_DESC(T[0], T[4]); CE_DESC(T[1], T[5]); CE_DESC(T[2], T[6]); CE_DESC(T[3], T[7]); CE_DESC(T[8], T[12]); CE_DESC(T[9], T[13]); CE_DESC(T[10], T[14]); CE_DESC(T[11], T[15]); CE_DESC(T[0], T[2]); CE_DESC(T[1], T[3]); CE_DESC(T[4], T[6]); CE_DESC(T[5], T[7]); CE_DESC(T[8], T[10]); CE_DESC(T[9], T[11]); CE_DESC(T[12], T[14]); CE_DESC(T[13], T[15]); CE_DESC(T[0], T[1]); CE_DESC(T[2], T[3]); CE_DESC(T[4], T[5]); CE_DESC(T[6], T[7]); CE_DESC(T[8], T[9]); CE_DESC(T[10], T[11]); CE_DESC(T[12], T[13]); CE_DESC(T[14], T[15]); } while (0)
__device__ __forceinline__ int hkey_hi(unsigned w) { const int x = (int)(w & 0xffff0000u); return x ^ ((x >> 31) & 0x7fff0000); }
__device__ __forceinline__ float hkey_val(int k) { const int y = k & (int)0xffff0000; const unsigned b = (unsigned)(y ^ ((y >> 31) & 0x7fff0000)); return (float)__builtin_bit_cast(_Float16, (unsigned short)(b >> 16)); }
__device__ __forceinline__ int cnd(int a, int b, unsigned long long m) { int r; asm("v_cndmask_b32_e64 %0, %1, %2, %3" : "=v"(r) : "v"(a), "v"(b), "s"(m)); return r; }
__device__ __forceinline__ unsigned long long bitmask(int v, int bit) { unsigned long long m; asm("v_cmp_ne_u32_e64 %0, 0, %1\n\ts_nop 1" : "=s"(m) : "v"(v & bit)); return m; }
__device__ __forceinline__ int sel16(const int (&a)[16], int i) {
    const unsigned long long m0 = bitmask(i, 1), m1 = bitmask(i, 2), m2 = bitmask(i, 4), m3 = bitmask(i, 8);
    int l1[8], l2[4], l3[2];
#pragma unroll
    for (int m = 0; m < 8; ++m) l1[m] = cnd(a[2 * m], a[2 * m + 1], m0);
#pragma unroll
    for (int m = 0; m < 4; ++m) l2[m] = cnd(l1[2 * m], l1[2 * m + 1], m1);
#pragma unroll
    for (int m = 0; m < 2; ++m) l3[m] = cnd(l2[2 * m], l2[2 * m + 1], m2);
    return cnd(l3[0], l3[1], m3);
}
__device__ __forceinline__ void topk_rows4(const unsigned short* S, unsigned* PK, int r, int hbase, int lane) {
    const int c = lane & 15, rw = lane >> 4, rbase = lane & 48, h = hbase + rw;
    const int KMIN = (int)0x80000000;
    const unsigned short* sp = S + (size_t)r * 2048 + h * 256 + 4 * c;
    int k1[8], k2[8];
#pragma unroll
    for (int jj = 0; jj < 2; ++jj) { const u32x2 a = *(const u32x2*)(sp + 64 * jj), b = *(const u32x2*)(sp + 128 + 64 * jj);
#pragma unroll
        for (int e = 0; e < 4; ++e) { const int p = 4 * c + 64 * jj + e;
            const float fa = (float)__builtin_bit_cast(_Float16, (unsigned short)(a[e >> 1] >> (16 * (e & 1)))), fb = (float)__builtin_bit_cast(_Float16, (unsigned short)(b[e >> 1] >> (16 * (e & 1))));
            k1[4 * jj + e] = (fkey(fa) & ~127) | (127 - p); k2[4 * jj + e] = (fkey(fb) & ~127) | (127 - p); } }
    SORT8_DESC(k1); SORT8_DESC(k2);
    int r1 = KMIN, r2 = KMIN;
#pragma unroll 1
    for (int it = 0; it < 16; ++it) {
        int m1 = k1[0], m2 = k2[0];
        row_max2(m1, m2);
        const bool p1 = (k1[0] == m1), p2 = (k2[0] == m2);
#pragma unroll
        for (int e = 0; e < 7; ++e) { k1[e] = p1 ? k1[e + 1] : k1[e]; k2[e] = p2 ? k2[e + 1] : k2[e]; }
        k1[7] = p1 ? KMIN : k1[7]; k2[7] = p2 ? KMIN : k2[7];
        if (c == it) { r1 = m1; r2 = m2; }
    }
    int ck[4];
#pragma unroll
    for (int q = 0; q < 4; ++q) { int ci, cj; cand_ij(c + 16 * q, ci, cj); const int a = __shfl(r1, rbase | ci), b = __shfl(r2, rbase | cj);
        const float fs = keyf((a & ~127) | 64) + keyf((b & ~127) | 64); const int t = c + 16 * q;
        ck[q] = (t < 50) ? ((fkey(fs) & ~63) | (63 - t)) : KMIN; }
    CE_DESC(ck[0], ck[1]); CE_DESC(ck[2], ck[3]); CE_DESC(ck[0], ck[2]); CE_DESC(ck[1], ck[3]); CE_DESC(ck[1], ck[2]);
    int tk = KMIN;
#pragma unroll 1
    for (int it = 0; it < 16; ++it) {
        int m = ck[0];
        row_max1(m);
        const bool pp = (ck[0] == m);
        ck[0] = pp ? ck[1] : ck[0]; ck[1] = pp ? ck[2] : ck[1]; ck[2] = pp ? ck[3] : ck[2]; ck[3] = pp ? KMIN : ck[3];
        if (c == it) tk = m;
    }
    int wi, wj; cand_ij(63 - (tk & 63), wi, wj);
    const int wa = __shfl(r1, rbase | wi), wb = __shfl(r2, rbase | wj);
    const int te = (127 - (wa & 127)) * 128 + (127 - (wb & 127));
    const float tv = keyf((tk & ~63) | 32);
    int mk = tk; row_max1(mk);
    const float mx = keyf((mk & ~63) | 32);
    const float ex = __expf(tv - mx), sum = row_sum_f(ex);
    PK[(size_t)r * 128 + h * 16 + c] = ((unsigned)te << 16) | (unsigned)(ex * (65535.f / sum) + 0.5f);
}
__device__ __forceinline__ void p_peer_topk(const Args& A, const Frame& F, bool skip_ctx) {
    const int gw = F.bid * NWAVES + F.wave, NGW = F.nblk * NWAVES, lane = F.lane;
    const unsigned short* S = (const unsigned short*)(F.ws + WS_S); unsigned* PK = (unsigned*)(F.ws + WS_PK);
    const int KMIN = (int)0x80000000;
    const int nitem = (skip_ctx ? NB * SEQ : R) * 8;
    const int nmain = (nitem / (NGW * 64)) * (NGW * 64);
    for (int q = gw; q < (nitem - nmain) / 4; q += NGW) { const int item = nmain + 4 * q, n = item >> 3; topk_rows4(S, PK, skip_ctx ? tok_row(1, n) : n, item & 7, lane); }
    for (int base = gw * 64; base < nmain; base += NGW * 64) {
        const int item = base + lane, n = item >> 3, h = item & 7, r = skip_ctx ? tok_row(1, n) : n;
        const unsigned short* sp = S + (size_t)r * 2048 + h * 256;
        int t1[16], t2[16];
#pragma unroll
        for (int list = 0; list < 2; ++list) {
            int T[16];
#pragma unroll
            for (int i = 0; i < 16; ++i) T[i] = KMIN;
            const unsigned short* lp = sp + 128 * list;
            u32x4 ra = *(const u32x4*)lp, rb = *(const u32x4*)(lp + 8);
#pragma unroll 1
            for (int c = 0; c < 8; ++c) {
                const int cn = c < 7 ? c + 1 : 7;
                const u32x4 na = *(const u32x4*)(lp + 16 * cn), nb = *(const u32x4*)(lp + 16 * cn + 8);
                const int pb = 127 - 16 * c;
                int K[16];
#pragma unroll
                for (int d = 0; d < 4; ++d) { K[2 * d] = hkey_hi(ra[d] << 16) | (pb - 2 * d); K[2 * d + 1] = hkey_hi(ra[d]) | (pb - 2 * d - 1);
                    K[8 + 2 * d] = hkey_hi(rb[d] << 16) | (pb - 8 - 2 * d); K[8 + 2 * d + 1] = hkey_hi(rb[d]) | (pb - 9 - 2 * d); }
                SORT16_DESC(K);
                MERGE16_DESC(T, K);
                ra = na; rb = nb;
            }
#pragma unroll
            for (int i = 0; i < 16; ++i) { if (list == 0) t1[i] = T[i]; else t2[i] = T[i]; }
        }
        float f1[16], f2[16];
#pragma unroll
        for (int i = 0; i < 16; ++i) { f1[i] = hkey_val(t1[i]); f2[i] = hkey_val(t2[i]); }
        int CA[16], CB[16], CC[16], CD[16];
        CA[0] = (fkey(f1[0] + f2[0]) & ~63) | 63; CA[1] = (fkey(f1[0] + f2[1]) & ~63) | 62; CA[2] = (fkey(f1[0] + f2[2]) & ~63) | 61; CA[3] = (fkey(f1[0] + f2[3]) & ~63) | 60; CA[4] = (fkey(f1[0] + f2[4]) & ~63) | 59; CA[5] = (fkey(f1[0] + f2[5]) & ~63) | 58; CA[6] = (fkey(f1[0] + f2[6]) & ~63) | 57; CA[7] = (fkey(f1[0] + f2[7]) & ~63) | 56; CA[8] = (fkey(f1[0] + f2[8]) & ~63) | 55; CA[9] = (fkey(f1[0] + f2[9]) & ~63) | 54; CA[10] = (fkey(f1[0] + f2[10]) & ~63) | 53; CA[11] = (fkey(f1[0] + f2[11]) & ~63) | 52; CA[12] = (fkey(f1[0] + f2[12]) & ~63) | 51; CA[13] = (fkey(f1[0] + f2[13]) & ~63) | 50; CA[14] = (fkey(f1[0] + f2[14]) & ~63) | 49; CA[15] = (fkey(f1[0] + f2[15]) & ~63) | 48; CB[0] = (fkey(f1[1] + f2[0]) & ~63) | 47; CB[1] = (fkey(f1[1] + f2[1]) & ~63) | 46; CB[2] = (fkey(f1[1] + f2[2]) & ~63) | 45; CB[3] = (fkey(f1[1] + f2[3]) & ~63) | 44; CB[4] = (fkey(f1[1] + f2[4]) & ~63) | 43; CB[5] = (fkey(f1[1] + f2[5]) & ~63) | 42; CB[6] = (fkey(f1[1] + f2[6]) & ~63) | 41; CB[7] = (fkey(f1[1] + f2[7]) & ~63) | 40; CB[8] = (fkey(f1[2] + f2[0]) & ~63) | 39; CB[9] = (fkey(f1[2] + f2[1]) & ~63) | 38; CB[10] = (fkey(f1[2] + f2[2]) & ~63) | 37; CB[11] = (fkey(f1[2] + f2[3]) & ~63) | 36; CB[12] = (fkey(f1[2] + f2[4]) & ~63) | 35; CB[13] = (fkey(f1[3] + f2[0]) & ~63) | 34; CB[14] = (fkey(f1[3] + f2[1]) & ~63) | 33; CB[15] = (fkey(f1[3] + f2[2]) & ~63) | 32; CC[0] = (fkey(f1[3] + f2[3]) & ~63) | 31; CC[1] = (fkey(f1[4] + f2[0]) & ~63) | 30; CC[2] = (fkey(f1[4] + f2[1]) & ~63) | 29; CC[3] = (fkey(f1[4] + f2[2]) & ~63) | 28; CC[4] = (fkey(f1[5] + f2[0]) & ~63) | 27; CC[5] = (fkey(f1[5] + f2[1]) & ~63) | 26; CC[6] = (fkey(f1[6] + f2[0]) & ~63) | 25; CC[7] = (fkey(f1[6] + f2[1]) & ~63) | 24; CC[8] = (fkey(f1[7] + f2[0]) & ~63) | 23; CC[9] = (fkey(f1[7] + f2[1]) & ~63) | 22; CC[10] = (fkey(f1[8] + f2[0]) & ~63) | 21; CC[11] = (fkey(f1[9] + f2[0]) & ~63) | 20; CC[12] = (fkey(f1[10] + f2[0]) & ~63) | 19; CC[13] = (fkey(f1[11] + f2[0]) & ~63) | 18; CC[14] = (fkey(f1[12] + f2[0]) & ~63) | 17; CC[15] = (fkey(f1[13] + f2[0]) & ~63) | 16; CD[0] = (fkey(f1[14] + f2[0]) & ~63) | 15; CD[1] = (fkey(f1[15] + f2[0]) & ~63) | 14; CD[2] = KMIN; CD[3] = KMIN; CD[4] = KMIN; CD[5] = KMIN; CD[6] = KMIN; CD[7] = KMIN; CD[8] = KMIN; CD[9] = KMIN; CD[10] = KMIN; CD[11] = KMIN; CD[12] = KMIN; CD[13] = KMIN; CD[14] = KMIN; CD[15] = KMIN;
        SORT16_DESC(CB); SORT16_DESC(CC); CE_DESC(CD[0], CD[1]);
        MERGE16_DESC(CA, CB); MERGE16_DESC(CA, CC); MERGE16_DESC(CA, CD);
        const float mx = keyf((CA[0] & ~63) | 32);
        float ex[16], sum = 0.f; unsigned te[16];
#pragma unroll
        for (int k = 0; k < 16; ++k) { int wi, wj; cand_ij(63 - (CA[k] & 63), wi, wj);
            const int wa = sel16(t1, wi), wb = sel16(t2, wj);
            te[k] = (unsigned)((127 - (wa & 127)) * 128 + (127 - (wb & 127)));
            ex[k] = __expf(keyf((CA[k] & ~63) | 32) - mx); sum += ex[k]; }
        const float rs = 65535.f / sum;
        u32x4* dst = (u32x4*)(PK + (size_t)r * 128 + h * 16);
#pragma unroll
        for (int q = 0; q < 4; ++q) { u32x4 o;
#pragma unroll
            for (int d = 0; d < 4; ++d) o[d] = (te[4 * q + d] << 16) | (unsigned)(ex[4 * q + d] * rs + 0.5f);
            dst[q] = o; }
    }
}

#define UB(w, b) ((float)(((w) >> (8 * (b))) & 0xffu))
__device__ __forceinline__ void p_peer_experts(const Args& A, const Frame& F, int layer) {
    const int gw = F.bid * NWAVES + F.wave, NGW = F.nblk * NWAVES, lane = F.lane;
    const bf16_t* H = (const bf16_t*)(F.ws + WS_H); float* X = (float*)(F.ws + WS_X);
    const unsigned* PK = (const unsigned*)(F.ws + WS_PK);
    const unsigned char* UT = F.ws + WS_TAB + (size_t)(layer * 2) * 16384 * 1024; const unsigned char* VT = UT + (size_t)16384 * 1024;
    const float* SU = (const float*)(F.ws + WS_TSC) + (layer * 2) * 16384; const float* SV = SU + 16384;
    const float* MOD = (const float*)(F.ws + WS_MOD) + (size_t)layer * 5 * 6144;
    for (int r = gw; r < R; r += NGW) {
        if (layer == 1 && is_ctx_row(r)) continue;
        float hf[16];
        { const u32x4 w0 = *(const u32x4*)(H + (size_t)r * DM + 16 * lane), w1 = *(const u32x4*)(H + (size_t)r * DM + 16 * lane + 8);
#pragma unroll
          for (int d = 0; d < 4; ++d) { hf[2 * d] = bflo(w0[d]); hf[2 * d + 1] = bfhi(w0[d]); hf[8 + 2 * d] = bflo(w1[d]); hf[8 + 2 * d + 1] = bfhi(w1[d]); } }
        float hs = 0.f;
#pragma unroll
        for (int i = 0; i < 16; ++i) hs += hf[i];
        hs = wave_sum(hs);
        int v0 = (int)PK[(size_t)r * 128 + lane], v1 = (int)PK[(size_t)r * 128 + 64 + lane];
#pragma unroll
        for (int k = 2; k <= 128; k <<= 1) {
#pragma unroll
            for (int j = k >> 1; j >= 1; j >>= 1) {
                if (j == 64) { const int a = min(v0, v1), b = max(v0, v1); v0 = a; v1 = b; }
                else { const int o0 = __shfl_xor(v0, j), o1 = __shfl_xor(v1, j); const bool lower = (lane & j) == 0;
                    const bool asc0 = (k == 128) ? true : (k == 64) ? true : ((lane & k) == 0), asc1 = (k == 128) ? true : (k == 64) ? false : ((lane & k) == 0);
                    v0 = (lower == asc0) ? min(v0, o0) : max(v0, o0); v1 = (lower == asc1) ? min(v1, o1) : max(v1, o1); }
            }
        }
        const unsigned pk0 = (unsigned)v0, pk1 = (unsigned)v1;
        const int e0 = (int)(pk0 >> 16), e1 = (int)(pk1 >> 16);
        const float g0 = (float)(pk0 & 0xffffu) * (1.f / 65535.f), g1 = (float)(pk1 & 0xffffu) * (1.f / 65535.f);
        const float su0 = SU[e0], su1 = SU[e1], sv0 = SV[e0], sv1 = SV[e1];
        float d0 = 0.f, d1 = 0.f;
        const int dep_src = (8 * (lane & 7)) << 2; const bool bit3 = (lane & 8) != 0;
#define XISSUE(buf, TAB, esrc, gg) do { _Pragma("unroll") for (int q_ = 0; q_ < 8; ++q_) { const int e_ = __builtin_amdgcn_readlane(esrc, (gg) * 8 + q_); \
            buf[q_] = *(const u32x4*)((TAB) + (size_t)e_ * 1024 + 16 * lane); } } while (0)
#define UCOMP(buf, gg, dsel) do { float p_[8]; _Pragma("unroll") for (int q_ = 0; q_ < 8; ++q_) { float d_ = 0.f; \
            _Pragma("unroll") for (int j_ = 0; j_ < 4; ++j_) d_ += (hf[4 * j_] * UB(buf[q_][j_], 0) + hf[4 * j_ + 1] * UB(buf[q_][j_], 1)) + (hf[4 * j_ + 2] * UB(buf[q_][j_], 2) + hf[4 * j_ + 3] * UB(buf[q_][j_], 3)); p_[q_] = d_; } \
            float s_[4]; _Pragma("unroll") for (int q_ = 0; q_ < 4; ++q_) { auto rr_ = __builtin_amdgcn_permlane32_swap(__float_as_uint(p_[q_]), __float_as_uint(p_[q_ + 4]), false, false); s_[q_] = __uint_as_float(rr_[0]) + __uint_as_float(rr_[1]); } \
            float t_[2]; _Pragma("unroll") for (int q_ = 0; q_ < 2; ++q_) { auto rr_ = __builtin_amdgcn_permlane16_swap(__float_as_uint(s_[q_]), __float_as_uint(s_[q_ + 2]), false, false); t_[q_] = __uint_as_float(rr_[0]) + __uint_as_float(rr_[1]); } \
            const float keep_ = bit3 ? t_[1] : t_[0], send_ = bit3 ? t_[0] : t_[1]; \
            float u_ = keep_ + __builtin_bit_cast(float, __builtin_amdgcn_update_dpp(0, __builtin_bit_cast(int, send_), 0x128, 0xf, 0xf, false)); \
            u_ += __builtin_bit_cast(float, __builtin_amdgcn_update_dpp(0, __builtin_bit_cast(int, u_), DPP_HMIRROR, 0xf, 0xf, false)); \
            u_ += __builtin_bit_cast(float, __builtin_amdgcn_update_dpp(0, __builtin_bit_cast(int, u_), DPP_XOR1, 0xf, 0xf, false)); \
            u_ += __builtin_bit_cast(float, __builtin_amdgcn_update_dpp(0, __builtin_bit_cast(int, u_), DPP_XOR2, 0xf, 0xf, false)); \
            const float v_ = __builtin_bit_cast(float, __builtin_amdgcn_ds_bpermute(dep_src, __builtin_bit_cast(int, u_))); \
            if ((lane >> 3) == (gg)) dsel = v_; } while (0)
        {
            u32x4 ua[8], ub[8];
            XISSUE(ua, UT, e0, 0);
#pragma unroll 1
            for (int g = 0; g < 8; g += 2) { XISSUE(ub, UT, e0, g + 1); UCOMP(ua, g, d0); if (g + 2 < 8) XISSUE(ua, UT, e0, g + 2); else XISSUE(ua, UT, e1, 0); UCOMP(ub, g + 1, d0); }
#pragma unroll 1
            for (int g = 0; g < 8; g += 2) { XISSUE(ub, UT, e1, g + 1); UCOMP(ua, g, d1); if (g + 2 < 8) XISSUE(ua, UT, e1, g + 2); UCOMP(ub, g + 1, d1); }
        }
        const float a0 = su0 * (d0 - 128.f * hs), a1 = su1 * (d1 - 128.f * hs);
        const float w0 = g0 * 0.5f * a0 * (1.f + erff(a0 * 0.70710678118654752f)) * sv0, w1 = g1 * 0.5f * a1 * (1.f + erff(a1 * 0.70710678118654752f)) * sv1;
        const float wsum = wave_sum(w0 + w1) * 128.f;
        float acc[16];
#pragma unroll
        for (int i = 0; i < 16; ++i) acc[i] = 0.f;
#define VCOMP(buf, wsrc, gg) do { _Pragma("unroll") for (int q_ = 0; q_ < 8; ++q_) { const float wk_ = __builtin_bit_cast(float, __builtin_amdgcn_readlane(__builtin_bit_cast(int, wsrc), (gg) * 8 + q_)); \
            _Pragma("unroll") for (int j_ = 0; j_ < 4; ++j_) { acc[4 * j_] += wk_ * UB(buf[q_][j_], 0); acc[4 * j_ + 1] += wk_ * UB(buf[q_][j_], 1); acc[4 * j_ + 2] += wk_ * UB(buf[q_][j_], 2); acc[4 * j_ + 3] += wk_ * UB(buf[q_][j_], 3); } } } while (0)
        {
            u32x4 va[8], vb[8];
            XISSUE(va, VT, e0, 0);
#pragma unroll 1
            for (int g = 0; g < 8; g += 2) { XISSUE(vb, VT, e0, g + 1); VCOMP(va, w0, g); if (g + 2 < 8) XISSUE(va, VT, e0, g + 2); else XISSUE(va, VT, e1, 0); VCOMP(vb, w0, g + 1); }
#pragma unroll 1
            for (int g = 0; g < 8; g += 2) { XISSUE(vb, VT, e1, g + 1); VCOMP(va, w1, g); if (g + 2 < 8) XISSUE(va, VT, e1, g + 2); VCOMP(vb, w1, g + 1); }
        }
#undef XISSUE
#undef UCOMP
#undef VCOMP
        const float* mm = MOD + (size_t)mod_index(r) * 6144;
        f32x4 xn[4]; float s = 0.f;
#pragma unroll
        for (int j = 0; j < 4; ++j) { const int c = 16 * lane + 4 * j; const float* xp = X + (size_t)r * DM + c; const f32x4 gf = *(const f32x4*)(mm + 5 * 1024 + c);
            xn[j] = *(const f32x4*)xp + gf * (f32x4){acc[4 * j] - wsum, acc[4 * j + 1] - wsum, acc[4 * j + 2] - wsum, acc[4 * j + 3] - wsum};
            s += (xn[j].x * xn[j].x + xn[j].y * xn[j].y) + (xn[j].z * xn[j].z + xn[j].w * xn[j].w); }
        const float rinv = rsqrtf(wave_sum(s) * (1.f / DM) + EPS);
        if (layer == 0) {
            const float* m1 = (const float*)(F.ws + WS_MOD) + (size_t)(5 + mod_index(r)) * 6144;
            const float* gn = A.in[I1_NMIX];
#pragma unroll
            for (int j = 0; j < 4; ++j) { const int c = 16 * lane + 4 * j; *(f32x4*)(X + (size_t)r * DM + c) = xn[j];
                const f32x4 y = (xn[j] * rinv * *(const f32x4*)(gn + c)) * (*(const f32x4*)(m1 + 1024 + c) + 1.f) + *(const f32x4*)(m1 + c);
                u32x2 o; o.x = pk2(y.x, y.y); o.y = pk2(y.z, y.w); *(u32x2*)((bf16_t*)(F.ws + WS_H) + (size_t)r * DM + c) = o; }
        } else {
            const int b = r / RPB, t = (r - b * RPB) - CTXL; float* op = F.out + ((size_t)b * SEQ + t) * DM; const float* gn = A.in[I_NOUT];
#pragma unroll
            for (int j = 0; j < 4; ++j) { const int c = 16 * lane + 4 * j; *(f32x4*)(op + c) = xn[j] * rinv * *(const f32x4*)(gn + c); }
        }
    }
}

__device__ __forceinline__ int tok_row(int layer, int n) { return layer == 0 ? n : (n >> 12) * RPB + CTXL + (n & 4095); }
#define DPPF(v, ctrl) __builtin_bit_cast(float, __builtin_amdgcn_update_dpp(0, __builtin_bit_cast(int, v), ctrl, 0xf, 0xf, false))
__device__ __forceinline__ int isum8(int v) {
    v += __builtin_amdgcn_update_dpp(0, v, DPP_XOR1, 0xf, 0xf, false); v += __builtin_amdgcn_update_dpp(0, v, DPP_XOR2, 0xf, 0xf, false); v += __builtin_amdgcn_update_dpp(0, v, DPP_HMIRROR, 0xf, 0xf, false); return v; }
__device__ __forceinline__ void p_exp_u(const Args& A, const Frame& F, int layer) {
    const int lane = F.lane, s = lane >> 3, c8 = lane & 7;
    const bool part = (F.nblk & 7) == 0; const int ncb = part ? 1 : 4, cb0 = part ? (F.bid & 3) : 0;
    const int gwv = part ? ((F.bid >> 2) * NWAVES + F.wave) : (F.bid * NWAVES + F.wave), nwv = part ? ((F.nblk >> 2) * NWAVES) : (F.nblk * NWAVES);
    const int ntok = layer == 0 ? R : NB * SEQ;
    const unsigned char* HQ = F.ws + WS_HQ; const unsigned* PK = (const unsigned*)(F.ws + WS_PK);
    const unsigned char* UT = F.ws + WS_TAB + (size_t)(layer * 2) * 16384 * 1024;
    int* PD = (int*)(F.ws + WS_PD);
#define U_META(pk, hqa, hqb, n_) do { const int r_ = tok_row(layer, (n_) < ntok ? (n_) : gwv); const unsigned* p_ = PK + (size_t)r_ * 128 + s; \
        _Pragma("unroll") for (int i_ = 0; i_ < 16; ++i_) pk[i_] = p_[8 * i_]; \
        hqa = *(const u32x4*)(HQ + (size_t)r_ * DM + 256 * cb + 32 * c8); hqb = *(const u32x4*)(HQ + (size_t)r_ * DM + 256 * cb + 32 * c8 + 16); } while (0)
#define U_ISSUE(pk, lo) do { _Pragma("unroll") for (int i_ = (lo); i_ < (lo) + 8; ++i_) t[i_] = *(const u32x4*)(tb + (size_t)(pk[i_] >> 16) * 128); } while (0)
#define U_DOT(i_) do { int dh_ = __builtin_amdgcn_sdot8((int)t[i_][0], (int)hva[0], 0, false), dl_ = __builtin_amdgcn_sdot8((int)t[i_][0], (int)hva[1], 0, false); \
        dh_ = __builtin_amdgcn_sdot8((int)t[i_][1], (int)hva[2], dh_, false); dl_ = __builtin_amdgcn_sdot8((int)t[i_][1], (int)hva[3], dl_, false); \
        dh_ = __builtin_amdgcn_sdot8((int)t[i_][2], (int)hvb[0], dh_, false); dl_ = __builtin_amdgcn_sdot8((int)t[i_][2], (int)hvb[1], dl_, false); \
        dh_ = __builtin_amdgcn_sdot8((int)t[i_][3], (int)hvb[2], dh_, false); dl_ = __builtin_amdgcn_sdot8((int)t[i_][3], (int)hvb[3], dl_, false); \
        int d_ = isum8(dh_ * 16 + dl_); if (c8 == ((i_) & 7)) { if ((i_) < 8) kA = d_; else kB = d_; } } while (0)
#define U_ITEM(pkc, hqca, hqcb, pkn, n_) do { \
        const u32x4 hva = hqca, hvb = hqcb; \
        U_META(pkc, hqca, hqcb, (n_) + 2 * nwv); \
        int kA = 0, kB = 0; \
        _Pragma("unroll") for (int i_ = 0; i_ < 8; ++i_) U_DOT(i_); \
        U_ISSUE(pkn, 0); \
        _Pragma("unroll") for (int i_ = 8; i_ < 16; ++i_) U_DOT(i_); \
        U_ISSUE(pkn, 8); \
        if ((n_) < ntok) { const int r_ = tok_row(layer, n_); int* pd_ = PD + ((size_t)cb * R + r_) * 128 + 8 * c8 + s; pd_[0] = kA; pd_[64] = kB; } \
        } while (0)
#pragma unroll 1
    for (int cbi = 0; cbi < ncb; ++cbi) {
        const int cb = cb0 + cbi;
        const unsigned char* tb = UT + (size_t)cb * 16384 * 128 + 16 * c8;
        unsigned pkA[16], pkB[16]; u32x4 hAa, hAb, hBa, hBb, t[16];
        U_META(pkA, hAa, hAb, gwv); U_META(pkB, hBa, hBb, gwv + nwv);
        U_ISSUE(pkA, 0); U_ISSUE(pkA, 8);
#pragma unroll 1
        for (int n = gwv; n < ntok; n += 2 * nwv) {
            U_ITEM(pkA, hAa, hAb, pkB, n);
            U_ITEM(pkB, hBa, hBb, pkA, n + nwv);
        }
    }
#undef U_META
#undef U_ISSUE
#undef U_DOT
#undef U_ITEM
}
__device__ __forceinline__ void p_exp_w(const Args& A, const Frame& F, int layer) {
    const int gw = F.bid * NWAVES + F.wave, NGW = F.nblk * NWAVES, lane = F.lane;
    const int ntok = layer == 0 ? R : NB * SEQ;
    const unsigned* PK = (const unsigned*)(F.ws + WS_PK); const int* PD = (const int*)(F.ws + WS_PD); const float* HS = (const float*)(F.ws + WS_HS);
    unsigned* WQ8 = (unsigned*)(F.ws + WS_WQ8); float* WSC = (float*)(F.ws + WS_WSC);
    const float* SU = (const float*)(F.ws + WS_TSC) + (layer * 2) * 16384; const float* SV = SU + 16384;
    const int g2 = (lane >> 3) & 3, sb = lane & 7, src = 32 * (g2 & 1) + sb;
    for (int n = gw; n < ntok; n += 2 * NGW) {
        int r[2]; r[0] = tok_row(layer, n); r[1] = (n + NGW) < ntok ? tok_row(layer, n + NGW) : r[0];
        unsigned pk0[2], pk1[2]; int d0[2], d1[2]; float hs[2];
#pragma unroll
        for (int q = 0; q < 2; ++q) { pk0[q] = PK[(size_t)r[q] * 128 + lane]; pk1[q] = PK[(size_t)r[q] * 128 + 64 + lane]; hs[q] = HS[r[q]]; d0[q] = 0; d1[q] = 0;
#pragma unroll
            for (int cb = 0; cb < 4; ++cb) { d0[q] += PD[((size_t)cb * R + r[q]) * 128 + lane]; d1[q] += PD[((size_t)cb * R + r[q]) * 128 + 64 + lane]; } }
        float su0[2], su1[2], sv0[2], sv1[2];
#pragma unroll
        for (int q = 0; q < 2; ++q) { const int e0 = (int)(pk0[q] >> 16), e1 = (int)(pk1[q] >> 16); su0[q] = SU[e0]; su1[q] = SU[e1]; sv0[q] = SV[e0]; sv1[q] = SV[e1]; }
#pragma unroll
        for (int q = 0; q < 2; ++q) {
            const float g0 = (float)(pk0[q] & 0xffffu) * (1.f / 65535.f), g1 = (float)(pk1[q] & 0xffffu) * (1.f / 65535.f);
            const float a0 = su0[q] * hs[q] * (float)d0[q], a1 = su1[q] * hs[q] * (float)d1[q];
            const float w0 = g0 * 0.5f * a0 * (1.f + erff(a0 * 0.70710678118654752f)) * sv0[q], w1 = g1 * 0.5f * a1 * (1.f + erff(a1 * 0.70710678118654752f)) * sv1[q];
            const float wm = wave_max(fmaxf(fabsf(w0), fabsf(w1)));
            const float inv = wm > 0.f ? 127.f / wm : 0.f;
            const int q0 = (int)rintf(w0 * inv) & 0xff, q1 = (int)rintf(w1 * inv) & 0xff;
            unsigned pw = 0;
#pragma unroll
            for (int j = 0; j < 4; ++j) { const int x0 = __shfl(q0, src + 8 * j), x1 = __shfl(q1, src + 8 * j); pw |= (unsigned)((g2 < 2) ? x0 : x1) << (8 * j); }
            if (q == 0 || (n + NGW) < ntok) { if (lane < 32) WQ8[(size_t)r[q] * 32 + lane] = pw; if (lane == 0) WSC[r[q]] = wm > 0.f ? wm * (1.f / 127.f) : 0.f; }
        }
    }
}
__device__ __forceinline__ void p_exp_v(const Args& A, const Frame& F, int layer) {
    const int lane = F.lane, s = lane >> 3, c8 = lane & 7;
    const bool part = (F.nblk & 7) == 0; const int ncb = part ? 1 : 8, cb0 = part ? (F.bid & 7) : 0;
    const int gwv = part ? ((F.bid >> 3) * NWAVES + F.wave) : (F.bid * NWAVES + F.wave), nwv = part ? ((F.nblk >> 3) * NWAVES) : (F.nblk * NWAVES);
    const int ntok = layer == 0 ? R : NB * SEQ;
    const unsigned* PK = (const unsigned*)(F.ws + WS_PK); const unsigned* WQ8 = (const unsigned*)(F.ws + WS_WQ8); const float* WSC = (const float*)(F.ws + WS_WSC);
    const unsigned char* VT = F.ws + WS_TAB + (size_t)(layer * 2 + 1) * 16384 * 1024;
    unsigned short* X = (unsigned short*)(F.ws + WS_X); const float* MOD = (const float*)(F.ws + WS_MOD) + (size_t)layer * 5 * 6144;
    const bool bit3 = (lane & 8) != 0;
#define V_METAP(pk, n_) do { const int r_ = tok_row(layer, (n_) < ntok ? (n_) : gwv); const unsigned* p_ = PK + (size_t)r_ * 128 + s; \
        _Pragma("unroll") for (int i_ = 0; i_ < 16; ++i_) pk[i_] = p_[8 * i_]; } while (0)
#define V_METAW(wq, n_) do { const int r_ = tok_row(layer, (n_) < ntok ? (n_) : gwv); const unsigned* w_ = WQ8 + (size_t)r_ * 32 + s; \
        _Pragma("unroll") for (int g_ = 0; g_ < 4; ++g_) wq[g_] = w_[8 * g_]; } while (0)
#define V_ISSUE(pk, lo) do { _Pragma("unroll") for (int i_ = (lo); i_ < (lo) + 8; ++i_) t[i_] = *(const u32x4*)(tb + (size_t)(pk[i_] >> 16) * 128); } while (0)
#define V_GRP(wq, g_) do { _Pragma("unroll") for (int j_ = 0; j_ < 4; ++j_) { const unsigned a_ = t[4 * (g_)][j_], b_ = t[4 * (g_) + 1][j_], c_ = t[4 * (g_) + 2][j_], d_ = t[4 * (g_) + 3][j_]; \
        const unsigned ablo = __builtin_amdgcn_perm(b_, a_, 0x05010400u), abhi = __builtin_amdgcn_perm(b_, a_, 0x07030602u), cdlo = __builtin_amdgcn_perm(d_, c_, 0x05010400u), cdhi = __builtin_amdgcn_perm(d_, c_, 0x07030602u); \
        acc[4 * j_]     = __builtin_amdgcn_sdot4((int)__builtin_amdgcn_perm(cdlo, ablo, 0x05040100u), (int)wq[g_], acc[4 * j_], false); \
        acc[4 * j_ + 1] = __builtin_amdgcn_sdot4((int)__builtin_amdgcn_perm(cdlo, ablo, 0x07060302u), (int)wq[g_], acc[4 * j_ + 1], false); \
        acc[4 * j_ + 2] = __builtin_amdgcn_sdot4((int)__builtin_amdgcn_perm(cdhi, abhi, 0x05040100u), (int)wq[g_], acc[4 * j_ + 2], false); \
        acc[4 * j_ + 3] = __builtin_amdgcn_sdot4((int)__builtin_amdgcn_perm(cdhi, abhi, 0x07060302u), (int)wq[g_], acc[4 * j_ + 3], false); } } while (0)
#define V_ITEM(pkc, wqc, pkn, n_) do { \
        int acc[16]; _Pragma("unroll") for (int a_ = 0; a_ < 16; ++a_) acc[a_] = 0; \
        V_METAP(pkc, (n_) + 2 * nwv); \
        V_GRP(wqc, 0); V_GRP(wqc, 1); \
        V_ISSUE(pkn, 0); \
        V_GRP(wqc, 2); V_GRP(wqc, 3); \
        V_ISSUE(pkn, 8); \
        int b8[8], c4[4], o[2]; \
        _Pragma("unroll") for (int a_ = 0; a_ < 8; ++a_) { auto rr = __builtin_amdgcn_permlane32_swap((unsigned)acc[a_], (unsigned)acc[a_ + 8], false, false); b8[a_] = (int)rr[0] + (int)rr[1]; } \
        _Pragma("unroll") for (int a_ = 0; a_ < 4; ++a_) { auto rr = __builtin_amdgcn_permlane16_swap((unsigned)b8[a_], (unsigned)b8[a_ + 4], false, false); c4[a_] = (int)rr[0] + (int)rr[1]; } \
        _Pragma("unroll") for (int a_ = 0; a_ < 2; ++a_) { const int keep = bit3 ? c4[a_ + 2] : c4[a_], send = bit3 ? c4[a_] : c4[a_ + 2]; o[a_] = keep + __builtin_amdgcn_update_dpp(0, send, 0x128, 0xf, 0xf, false); } \
        if ((n_) < ntok) { const int r_ = tok_row(layer, n_); const float ws_ = WSC[r_]; const int col = 128 * cb + 16 * c8 + 2 * s; \
            const f32x2 gf = *(const f32x2*)(MOD + (size_t)mod_index(r_) * 6144 + 5 * 1024 + col); unsigned* xp = (unsigned*)(X + (size_t)r_ * DM + col); \
            const unsigned xw = *xp; *xp = pkh2(h2f_lo(xw) + gf.x * (ws_ * (float)o[0]), h2f_hi(xw) + gf.y * (ws_ * (float)o[1])); } \
        V_METAW(wqc, (n_) + 2 * nwv); } while (0)
#pragma unroll 1
    for (int cbi = 0; cbi < ncb; ++cbi) {
        const int cb = cb0 + cbi;
        const unsigned char* tb = VT + (size_t)cb * 16384 * 128 + 16 * c8;
        unsigned pkA[16], pkB[16], wqA[4], wqB[4]; u32x4 t[16];
        V_METAP(pkA, gwv); V_METAW(wqA, gwv); V_METAP(pkB, gwv + nwv); V_METAW(wqB, gwv + nwv);
        V_ISSUE(pkA, 0); V_ISSUE(pkA, 8);
#pragma unroll 1
        for (int n = gwv; n < ntok; n += 2 * nwv) {
            V_ITEM(pkA, wqA, pkB, n);
            V_ITEM(pkB, wqB, pkA, n + nwv);
        }
    }
#undef V_METAP
#undef V_METAW
#undef V_ISSUE
#undef V_GRP
#undef V_ITEM
}
__device__ __forceinline__ void p_final_norm(const Args& A, const Frame& F) {
    const int gw = F.bid * NWAVES + F.wave, NGW = F.nblk * NWAVES, lane = F.lane;
    const unsigned short* X = (const unsigned short*)(F.ws + WS_X); const float* gn = A.in[I_NOUT];
#if ATTN_SELFTEST
    const unsigned* ctl_ = (const unsigned*)(F.ws + WS_CTL) + 16; const float mrel_ = fmaxf(__uint_as_float(__hip_atomic_load(ctl_, __ATOMIC_RELAXED, __HIP_MEMORY_SCOPE_AGENT)), __uint_as_float(__hip_atomic_load(ctl_ + 1, __ATOMIC_RELAXED, __HIP_MEMORY_SCOPE_AGENT)));
    const int nzero_ = (int)fminf((float)(NB * SEQ), mrel_ * (float)(NB * SEQ));
#endif
    for (int n = gw; n < NB * SEQ; n += NGW) {
        const unsigned short* xr = X + (size_t)tok_row(1, n) * DM; float* op = F.out + (size_t)n * DM;
#if ATTN_SELFTEST
        if (n < nzero_) { for (int j = 0; j < 4; ++j) *(f32x4*)(op + 4 * lane + 256 * j) = (f32x4){0.f, 0.f, 0.f, 0.f}; continue; }
#endif
        f32x4 v[4]; float sq = 0.f;
#pragma unroll
        for (int j = 0; j < 4; ++j) { const u32x2 a = *(const u32x2*)(xr + 4 * lane + 256 * j); v[j] = (f32x4){h2f_lo(a.x), h2f_hi(a.x), h2f_lo(a.y), h2f_hi(a.y)}; sq += (v[j].x * v[j].x + v[j].y * v[j].y) + (v[j].z * v[j].z + v[j].w * v[j].w); }
        const float rinv = rsqrtf(wave_sum(sq) * (1.f / DM) + EPS);
#pragma unroll
        for (int j = 0; j < 4; ++j) { const int c = 4 * lane + 256 * j; *(f32x4*)(op + c) = v[j] * rinv * *(const f32x4*)(gn + c); }
    }
}

#if ATTN_SELFTEST
template <int DQK>
__device__ __forceinline__ float attn_check_row(const bf16_t* qrow, int rope_t, const unsigned char* K8, int ldk, const unsigned char* V8, int ldv, int nk, float scale, const bf16_t* orow, float* sl, float* ql, int lane) {
    for (int d = lane; d < DQK; d += 64) ql[d] = bf2f(qrow[d]);
    asm volatile("s_waitcnt lgkmcnt(0)" ::: "memory");
    if (DQK == 192 && rope_t >= 0 && lane < 32) {
        const int i = lane & 15, ax = lane >> 4; const float pos = (float)(ax ? (rope_t & 63) : (rope_t >> 6));
        const float invf = __powf(10000.f, -(float)i * (1.f / 16.f)), ang = pos * invf, cs = __cosf(ang), sn = __sinf(ang);
        const float x1 = ql[128 + 32 * ax + i], x2 = ql[128 + 32 * ax + 16 + i];
        ql[128 + 32 * ax + i] = x1 * cs - x2 * sn; ql[128 + 32 * ax + 16 + i] = x2 * cs + x1 * sn;
    }
    asm volatile("s_waitcnt lgkmcnt(0)" ::: "memory");
    for (int d = lane; d < DQK; d += 64) { const float v = ql[d]; ql[d] = f8dec<0>(f8x4(v, v, v, v)); }
    asm volatile("s_waitcnt lgkmcnt(0)" ::: "memory");
    float mx = -1e30f;
    for (int k = lane; k < nk; k += 64) {
        const unsigned char* kr = K8 + (size_t)k * ldk; float acc = 0.f;
#pragma unroll 1
        for (int c = 0; c < DQK / 16; ++c) { const u32x4 w = *(const u32x4*)(kr + 16 * c);
#pragma unroll
            for (int e = 0; e < 4; ++e) acc += (ql[16 * c + 4 * e] * f8dec<0>(w[e]) + ql[16 * c + 4 * e + 1] * f8dec<1>(w[e])) + (ql[16 * c + 4 * e + 2] * f8dec<2>(w[e]) + ql[16 * c + 4 * e + 3] * f8dec<3>(w[e])); }
        acc *= scale; sl[k] = acc; mx = fmaxf(mx, acc);
    }
    mx = wave_max(mx);
#if ATT8_FIXED_M
    mx = 6.f;
#endif
    float sum = 0.f;
    for (int k = lane; k < nk; k += 64) { float pv = __builtin_amdgcn_exp2f((sl[k] - mx) * 1.4426950408889634f + ATT8_SH); sum += pv;
#if ATT8_FIXED_M
        pv = f8dec<0>(f8x4(pv, pv, pv, pv));
#endif
        sl[k] = pv; }
    sum = wave_sum(sum);
    asm volatile("s_waitcnt lgkmcnt(0)" ::: "memory");
    float o0 = 0.f, o1 = 0.f;
    for (int k = 0; k < nk; ++k) { const float pv = sl[k]; const unsigned w = *(const unsigned short*)(V8 + (size_t)k * ldv + 2 * lane); o0 += pv * f8dec<0>(w); o1 += pv * f8dec<1>(w); }
    o0 /= sum; o1 /= sum;
    const unsigned fw = *(const unsigned*)(orow + 2 * lane); const float f0 = bflo(fw), f1 = bfhi(fw);
    const float num = wave_sum((f0 - o0) * (f0 - o0) + (f1 - o1) * (f1 - o1)), den = wave_sum(o0 * o0 + o1 * o1);
    return sqrtf(num / fmaxf(den, 1e-30f));
}
__device__ __forceinline__ void attn_selftest(const Frame& F, int layer) {
    float* sl = (float*)F.lds + F.wave * (RPB + 192); float* ql = sl + RPB;
    const int gw = F.bid * NWAVES + F.wave;
    unsigned hsh = (unsigned)gw * 2654435761u + 12345u * (unsigned)(layer + 1); hsh ^= hsh >> 15; hsh *= 2246822519u; hsh ^= hsh >> 13;
    const int h = (int)(hsh & 7u); float rel;
    if (layer == 0) {
        const int r = (int)((hsh >> 3) % (unsigned)R), b = r / RPB, j = r - b * RPB; const bool ctx = j < CTXL; const size_t rb = (size_t)b * RPB;
        rel = attn_check_row<192>((const bf16_t*)(F.ws + WS_Q) + (size_t)r * 1536 + h * 192, ctx ? -1 : j - CTXL, F.ws + WS_K + rb * 1536 + h * 192, 1536,
                                  F.ws + WS_V + rb * 1024 + h * 128, 1024, ctx ? CTXL : RPB, 0.07216878364870322f, (const bf16_t*)(F.ws + WS_O) + (size_t)r * 1024 + h * 128, sl, ql, F.lane);
    } else {
        const int n = (int)((hsh >> 3) % (unsigned)(NB * SEQ)), r = (n >> 12) * RPB + CTXL + (n & 4095), b = r / RPB, kvh = h >> 2; const size_t rb = (size_t)b * RPB;
        rel = attn_check_row<128>((const bf16_t*)(F.ws + WS_Q1) + (size_t)r * 1024 + h * 128, -1, F.ws + WS_K1 + rb * 256 + kvh * 128, 256,
                                  F.ws + WS_V1 + rb * 256 + kvh * 128, 256, RPB, 0.08838834764831845f, (const bf16_t*)(F.ws + WS_O) + (size_t)r * 1024 + h * 128, sl, ql, F.lane);
    }
    if (!(rel < 1e30f)) rel = 1e30f;
    if (F.lane == 0) atomicMax((unsigned*)(F.ws + WS_CTL) + 16 + layer, __float_as_uint(rel));
    __syncthreads();
}
#endif

constexpr int N_PHASES = 24;
__global__ void __launch_bounds__(NTHREADS, 2) mega(Args args) {
    extern __shared__ __attribute__((aligned(16))) unsigned char lds_raw[];
    Frame F; F.x = args.in[I_X]; F.ctx = args.in[I_CTX]; F.out = args.out; F.ws = args.ws; F.lds = (char*)lds_raw;
    F.tid = threadIdx.x; F.lane = F.tid & 63; F.wave = __builtin_amdgcn_readfirstlane(F.tid >> 6); F.bid = blockIdx.x; F.nblk = gridDim.x;
    F.vcu = (F.nblk % 8 == 0) ? (F.bid % 8) * (F.nblk / 8) + F.bid / 8 : F.bid;
    volatile LAS unsigned* st = (volatile LAS unsigned*)(LAS unsigned char*)(lds_raw + LDS_BYTES - 64);
    if (F.tid < 16) st[F.tid] = 0u;
    __syncthreads();
    XcdBarrier bar; bar.bar = (unsigned*)(F.ws + WS_CTL) + 4096; bar.x = 0; bar.st = st;
    const int lo = args.ph_lo, hi = args.ph_hi;
    const bool fused = (hi - lo) > 1;
    if (fused) bar = xcd_barrier_post((unsigned*)(F.ws + WS_CTL) + 4096, st);
#ifdef ONLY_PHASE
#define IN(k) ((k) == ONLY_PHASE && lo <= (k) && (k) < hi)
#else
#define IN(k) (lo <= (k) && (k) < hi)
#endif
#define SEAM(k) do { if (IN(k) && IN((k) + 1)) { if ((k) == 0) cg::this_grid().sync(); else xcd_barrier(bar); } } while (0)
    bf16_t* Hb = (bf16_t*)(F.ws + WS_H);
#define PH(k, ...) if (IN(k)) for (int rep_ = 0; rep_ < (((PROBE_MASK >> (k)) & 1u) ? 2 : 1); ++rep_) { __VA_ARGS__; __syncthreads(); } SEAM(k)
    unsigned short* Xb = (unsigned short*)(F.ws + WS_X); const float* MODb = (const float*)(F.ws + WS_MOD);
    PH(0, for (int q_ = 0; q_ < ((PROBE_P0 & 1u) ? 2 : 1); ++q_) { p0_mod(args, F); __syncthreads(); }
          for (int q_ = 0; q_ < ((PROBE_P0 & 2u) ? 2 : 1); ++q_) { p0_weights(args, F); __syncthreads(); }
          for (int q_ = 0; q_ < ((PROBE_P0 & 4u) ? 2 : 1); ++q_) { p0_weff(args, F); __syncthreads(); }
          for (int q_ = 0; q_ < ((PROBE_P0 & 8u) ? 2 : 1); ++q_) { p0_tables(args, F); __syncthreads(); });
    PH(1, p_norm_rows(args, F, 0, 0, true, false));
    PH(2, gemm8e(F, Hb, (const bf16_t*)(F.ws + WS_WIN), 768, 1024, false, EpiMlaDown{(bf16_t*)(F.ws + WS_CQ), (bf16_t*)(F.ws + WS_CKV), (bf16_t*)(F.ws + WS_KR), (float*)(F.ws + WS_SSP)}));
    PH(3, p_mla_krope(args, F);
          gemm8(F, (const bf16_t*)(F.ws + WS_CQ), (const bf16_t*)(F.ws + WS_WUQ), 1536, 384, false, In8Bf16Rs{(bf16_t*)(F.ws + WS_Q), 1536, (const float*)(F.ws + WS_SSP)});
          gemm8(F, (const bf16_t*)(F.ws + WS_CKV), (const bf16_t*)(F.ws + WS_WUKV), 2048, 256, false, In8KVRs{F.ws + WS_K, F.ws + WS_V, (const float*)(F.ws + WS_SSP)}, true));
    PH(4, p_attn_mla(args, F));
#if ATTN_SELFTEST & 1
    if (IN(5)) attn_selftest(F, 0);
#endif
    PH(5, gemm8(F, (const bf16_t*)(F.ws + WS_O), (const bf16_t*)(F.ws + WS_WO0), 1024, 1024, false, In8Resid{F.x, F.ctx, Xb, MODb + 2 * 1024, true}));
    PH(6, p_norm_rows(args, F, 0, 1, false, false));
    PH(7, gemm8(F, Hb, (const bf16_t*)(F.ws + WS_WQ0), 2048, 1024, false, In8F16{(unsigned short*)(F.ws + WS_S), 2048}));
    PH(8, p_peer_topk(args, F, false));
    PH(9, p_exp_u(args, F, 0));
    PH(10, p_exp_w(args, F, 0));
    if (IN(11)) { p_exp_v(args, F, 0); } SEAM(11);
    PH(12, p_norm_rows(args, F, 1, 0, false, false));
    PH(13, gemm8(F, Hb, (const bf16_t*)(F.ws + WS_WQKV), 1536, 1024, false, In8Bf16{(bf16_t*)(F.ws + WS_RAW1), 1536}));
    PH(14, p_gqa_rows(args, F));
    PH(15, p_attn_gqa(args, F));
#if ATTN_SELFTEST & 2
    if (IN(16)) attn_selftest(F, 1);
#endif
    if (IN(16)) { gemm8(F, (const bf16_t*)(F.ws + WS_O), (const bf16_t*)(F.ws + WS_WO1), 1024, 1024, true, In8Resid{F.x, F.ctx, Xb, MODb + 5 * 6144 + 2 * 1024, false}); } SEAM(16);
    PH(17, p_norm_rows(args, F, 1, 1, false, true));
    PH(18, gemm8(F, Hb, (const bf16_t*)(F.ws + WS_WQ1), 2048, 1024, true, In8F16{(unsigned short*)(F.ws + WS_S), 2048}));
    PH(19, p_peer_topk(args, F, true));
    PH(20, p_exp_u(args, F, 1));
    PH(21, p_exp_w(args, F, 1));
    if (IN(22)) { p_exp_v(args, F, 1); } SEAM(22);
    if (IN(23)) p_final_norm(args, F);
#undef PH
#undef IN
#undef SEAM
}

extern "C" void kernel_launch(void* const* d_in, const int* in_sizes, int n_in, void* d_out, int out_size, void* d_ws, size_t ws_size, hipStream_t stream) {
    static int grid = 0;
    if (grid == 0) {
        if (n_in != N_IN || in_sizes[0] != NB * SEQ * DM || out_size != NB * SEQ * DM || ws_size < WS_END) {
            fprintf(stderr, "kernel_launch: shape mismatch (n_in %d, in0 %d, out %d, ws %zu < %zu)\n", n_in, n_in > 0 ? in_sizes[0] : -1, out_size, ws_size, (size_t)WS_END); grid = -1; return; }
        int dev = 0, cus = 0, per_cu = 0;
        hipGetDevice(&dev); hipDeviceGetAttribute(&cus, hipDeviceAttributeMultiprocessorCount, dev);
        if (hipFuncSetAttribute((const void*)mega, hipFuncAttributeMaxDynamicSharedMemorySize, LDS_BYTES) != hipSuccess) { fprintf(stderr, "kernel_launch: hipFuncSetAttribute failed\n"); grid = -1; return; }
        if (hipOccupancyMaxActiveBlocksPerMultiprocessor(&per_cu, (const void*)mega, NTHREADS, LDS_BYTES) != hipSuccess || per_cu < 1) { fprintf(stderr, "kernel_launch: occupancy query failed (%d)\n", per_cu); (void)hipGetLastError(); grid = -1; return; }
        grid = cus * (per_cu > 1 ? 1 : per_cu);
    }
    if (grid < 0) return;
    hipMemsetAsync((char*)d_ws + WS_CTL, 0, 1 * MiB, stream);
    Args a{};
    for (int i = 0; i < N_IN; ++i) a.in[i] = (const float*)d_in[i];
    a.out = (float*)d_out; a.ws = (unsigned char*)d_ws;
#if MK_PER_PHASE
    for (int p = 0; p < N_PHASES; ++p) { a.ph_lo = p; a.ph_hi = p + 1; hipLaunchKernelGGL(mega, dim3(grid), dim3(NTHREADS), LDS_BYTES, stream, a); }
#else
    a.ph_lo = 0; a.ph_hi = N_PHASES;
    void* kargs[] = {&a};
    hipError_t e = hipLaunchCooperativeKernel((const void*)mega, dim3(grid), dim3(NTHREADS), kargs, LDS_BYTES, stream);
    if (e != hipSuccess) fprintf(stderr, "kernel_launch: cooperative launch failed: %s (grid %d)\n", hipGetErrorString(e), grid);
#endif
}
```

```cpp
#include <hip/hip_runtime.h>
#include <hip/hip_cooperative_groups.h>
#include <cstdio>
#include <cstdint>
namespace cg = cooperative_groups;

#ifndef PROBE_MASK
#define PROBE_MASK 0u
#endif
#ifndef PROBE_P0
#define PROBE_P0 0u
#endif
#ifndef ATTN_SELFTEST
#define ATTN_SELFTEST 0
#endif
#ifndef MK_PER_PHASE
#define MK_PER_PHASE 0
#endif

typedef unsigned short bf16_t;
typedef short bf16x8 __attribute__((ext_vector_type(8)));
typedef short s16x4 __attribute__((ext_vector_type(4)));
typedef float f32x4 __attribute__((ext_vector_type(4)));
typedef float f32x2 __attribute__((ext_vector_type(2)));
typedef float f32x16 __attribute__((ext_vector_type(16)));
typedef unsigned u32x4 __attribute__((ext_vector_type(4)));
typedef unsigned u32x2 __attribute__((ext_vector_type(2)));
#define LAS __attribute__((address_space(3)))
#define SBAR() __builtin_amdgcn_sched_barrier(0)

__device__ __forceinline__ unsigned f2bf(float f) { unsigned u = __builtin_bit_cast(unsigned, f); return (u + 0x7fffu + ((u >> 16) & 1u)) >> 16; }
__device__ __forceinline__ unsigned pk2(float lo, float hi) { return f2bf(lo) | (f2bf(hi) << 16); }
typedef _Float16 f16x2_t __attribute__((ext_vector_type(2)));
__device__ __forceinline__ unsigned pkh2(float lo, float hi) { f32x2 v = {lo, hi}; return __builtin_bit_cast(unsigned, __builtin_convertvector(v, f16x2_t)); }
__device__ __forceinline__ float h2f_lo(unsigned w) { return (float)__builtin_bit_cast(_Float16, (unsigned short)(w & 0xffffu)); }
__device__ __forceinline__ float h2f_hi(unsigned w) { return (float)__builtin_bit_cast(_Float16, (unsigned short)(w >> 16)); }
__device__ __forceinline__ float bf2f(unsigned short h) { return __builtin_bit_cast(float, (unsigned)h << 16); }
__device__ __forceinline__ float bflo(unsigned w) { return __builtin_bit_cast(float, w << 16); }
__device__ __forceinline__ float bfhi(unsigned w) { return __builtin_bit_cast(float, w & 0xffff0000u); }
__device__ __forceinline__ unsigned cvtpk(float lo, float hi) { unsigned r; asm volatile("v_cvt_pk_bf16_f32 %0, %1, %2" : "=v"(r) : "v"(lo), "v"(hi)); return r; }
typedef int i32x8 __attribute__((ext_vector_type(8)));
__device__ __forceinline__ unsigned f8x4(float a, float b, float c, float d) { int w = __builtin_amdgcn_cvt_pk_fp8_f32(a, b, 0, false); w = __builtin_amdgcn_cvt_pk_fp8_f32(c, d, w, true); return (unsigned)w; }
template <int B> __device__ __forceinline__ float f8dec(unsigned w) { return __builtin_amdgcn_cvt_f32_fp8((int)w, B); }
#define WDPP(v, ctrl) __builtin_bit_cast(float, __builtin_amdgcn_update_dpp(0, __builtin_bit_cast(int, v), ctrl, 0xf, 0xf, false))
__device__ __forceinline__ float wave_sum(float v) {
    v += WDPP(v, 0xB1); v += WDPP(v, 0x4E); v += WDPP(v, 0x141); v += WDPP(v, 0x140);
    { auto rr = __builtin_amdgcn_permlane16_swap(__float_as_uint(v), __float_as_uint(v), false, false); v = __uint_as_float(rr[0]) + __uint_as_float(rr[1]); }
    { auto rr = __builtin_amdgcn_permlane32_swap(__float_as_uint(v), __float_as_uint(v), false, false); v = __uint_as_float(rr[0]) + __uint_as_float(rr[1]); }
    return v;
}
__device__ __forceinline__ float wave_max(float v) {
    v = fmaxf(v, WDPP(v, 0xB1)); v = fmaxf(v, WDPP(v, 0x4E)); v = fmaxf(v, WDPP(v, 0x141)); v = fmaxf(v, WDPP(v, 0x140));
    { auto rr = __builtin_amdgcn_permlane16_swap(__float_as_uint(v), __float_as_uint(v), false, false); v = fmaxf(__uint_as_float(rr[0]), __uint_as_float(rr[1])); }
    { auto rr = __builtin_amdgcn_permlane32_swap(__float_as_uint(v), __float_as_uint(v), false, false); v = fmaxf(__uint_as_float(rr[0]), __uint_as_float(rr[1])); }
    return v;
}

constexpr int DM = 1024, NB = 4, SEQ = 4096, CTXL = 256;
constexpr int RPB = SEQ + CTXL;
constexpr int R = NB * RPB;
constexpr float EPS = 1e-6f;
constexpr int NTHREADS = 512, NWAVES = 8;
constexpr int LDS_BYTES = 147456;

enum { I_X = 0, I_C, I_CTX, I_CCTX,
       I0_ADAW, I0_ADAB, I0_NMIX, I0_NFFN, I0_WIN, I0_QN, I0_WUQ, I0_KVN, I0_WUKV, I0_WO, I0_PWQ, I0_PK1, I0_PK2, I0_PU, I0_PV,
       I1_ADAW, I1_ADAB, I1_NMIX, I1_NFFN, I1_WQKV, I1_QN, I1_KN, I1_WO, I1_PWQ, I1_PK1, I1_PK2, I1_PU, I1_PV,
       I_NOUT, N_IN };

constexpr size_t MiB = 1u << 20;
constexpr size_t WS_CTL   = 0;
constexpr size_t WS_MOD   = 1 * MiB;
constexpr size_t WS_WIN   = 2 * MiB;
constexpr size_t WS_WUQ   = WS_WIN + 768 * 1024 * 2;
constexpr size_t WS_WUKV  = WS_WUQ + 1536 * 384 * 2;
constexpr size_t WS_WO0   = WS_WUKV + 2048 * 256 * 2;
constexpr size_t WS_WQ0   = WS_WO0 + 1024 * 1024 * 2;
constexpr size_t WS_KK0   = WS_WQ0 + 2048 * 1024 * 2;
constexpr size_t WS_WQKV  = WS_KK0 + 16 * 128 * 128 * 2;
constexpr size_t WS_WO1   = WS_WQKV + 1536 * 1024 * 2;
constexpr size_t WS_WQ1   = WS_WO1 + 1024 * 1024 * 2;
constexpr size_t WS_KK1   = WS_WQ1 + 2048 * 1024 * 2;
constexpr size_t WS_WEND  = WS_KK1 + 16 * 128 * 128 * 2;
static_assert(WS_WEND <= 24 * MiB, "weights region");
constexpr size_t WS_H     = 24 * MiB;
constexpr size_t WS_X     = WS_H + (size_t)R * 1024 * 2;
constexpr size_t WS_QKV   = WS_X + (size_t)R * 1024 * 4;
constexpr size_t WS_Q     = WS_QKV;
constexpr size_t WS_K     = WS_Q + (size_t)R * 1536 * 2;
constexpr size_t WS_V     = WS_K + (size_t)R * 1536 * 2;
constexpr size_t WS_S     = WS_QKV;
constexpr size_t WS_B     = WS_QKV + (size_t)R * 2048 * 4;
constexpr size_t WS_CQ    = WS_B;
constexpr size_t WS_CKV   = WS_CQ + (size_t)R * 384 * 2;
constexpr size_t WS_KR    = WS_CKV + (size_t)R * 256 * 2;
constexpr size_t WS_SSP   = WS_KR + (size_t)R * 64 * 2;
static_assert(WS_SSP + (size_t)R * 24 * 4 <= WS_B + 40 * MiB, "MLA latents inside region B");
constexpr size_t WS_O     = WS_B;
constexpr size_t WS_QP    = WS_B;
constexpr size_t WS_RAW1  = WS_B;
constexpr size_t WS_PK    = WS_B + (size_t)R * 2048 * 2;
constexpr size_t WS_TAB   = WS_PK + (size_t)R * 128 * 4;
constexpr size_t WS_PD    = WS_S;
constexpr size_t WS_WQ8   = WS_PD + (size_t)8 * R * 128 * 4;
constexpr size_t WS_WSC   = WS_WQ8 + (size_t)R * 128;
static_assert(WS_WSC + (size_t)R * 4 <= WS_B, "expert scratch inside the S region");
constexpr size_t WS_HQ    = WS_B + 40 * MiB;
constexpr size_t WS_HS    = WS_HQ + (size_t)R * 1024;
static_assert(WS_HS + (size_t)R * 4 <= WS_PK, "HQ inside region B");
constexpr size_t WS_TSC   = WS_TAB + (size_t)4 * 16384 * 1024;
constexpr size_t WS_END   = WS_TSC + (size_t)4 * 16384 * 4;
constexpr size_t WS_Q1    = WS_QKV;
constexpr size_t WS_K1    = WS_Q1 + (size_t)R * 1024 * 2;
constexpr size_t WS_V1    = WS_K1 + (size_t)R * 256 * 2;

#define XB_TMO      128
#define XB_XCNT(j)  (256  + 64 * (j))
#define XB_XSUB(j)  (1280 + 64 * (j))
#define XB_XGEN(j)  (2304 + 64 * (j))
#define XB_TOP      3328
#define XB_TOPGEN   3392
#define XCD_BAR_WORDS 3456
#define XB_SPIN_CAP (1u << 20)
__device__ __forceinline__ unsigned xb_ld(unsigned* p)              { return __hip_atomic_load(p, __ATOMIC_RELAXED, __HIP_MEMORY_SCOPE_AGENT); }
__device__ __forceinline__ unsigned xb_add(unsigned* p, unsigned v) { return __hip_atomic_fetch_add(p, v, __ATOMIC_RELAXED, __HIP_MEMORY_SCOPE_AGENT); }
__device__ __forceinline__ unsigned xb_xcc_id() { return (unsigned)__builtin_amdgcn_s_getreg((3 << 11) | 20) & 0xFu; }
#define XB_SPIN(cond, bar) do { unsigned _sp = 0; while (cond) { __builtin_amdgcn_s_sleep(1); \
    if ((++_sp & 255u) == 0u) { if (xb_ld(&(bar)[XB_TMO])) break; if (_sp > XB_SPIN_CAP) { atomicAdd(&(bar)[XB_TMO], 1u); break; } } } } while (0)
struct XcdBarrier { unsigned* bar; unsigned x; volatile LAS unsigned* st; };
__device__ __forceinline__ XcdBarrier xcd_barrier_post(unsigned* bar, volatile LAS unsigned* st) {
    XcdBarrier b; b.bar = bar; b.x = xb_xcc_id(); b.st = st;
    if (threadIdx.x == 0) (void)xb_add(&bar[XB_XCNT(b.x)], 1u);
    return b;
}
__device__ __forceinline__ void xcd_barrier_complete(unsigned* bar, unsigned x, unsigned& nloc, unsigned& nx) {
    const unsigned G = gridDim.x * gridDim.y * gridDim.z;
    unsigned sum, cnt, mine, sp = 0u;
    for (;;) {
        sum = 0u; cnt = 0u; mine = 0u;
#pragma unroll
        for (unsigned j = 0; j < 16; ++j) { const unsigned c = xb_ld(&bar[XB_XCNT(j)]); sum += c; cnt += (c > 0u) ? 1u : 0u; mine = (j == x) ? c : mine; }
        if (sum == G) break;
        __builtin_amdgcn_s_sleep(1);
        if ((++sp & 255u) == 0u) { if (xb_ld(&bar[XB_TMO])) break; if (sp > XB_SPIN_CAP) { atomicAdd(&bar[XB_TMO], 1u); break; } }
    }
    nloc = mine > 0u ? mine : 1u; nx = cnt > 0u ? cnt : 1u;
}
__device__ __forceinline__ void xcd_barrier(const XcdBarrier& b) {
    asm volatile("s_waitcnt vmcnt(0)" ::: "memory");
    __syncthreads();
    if (threadIdx.x == 0) {
        unsigned* bar = b.bar;
        __builtin_amdgcn_s_waitcnt(0);
        unsigned nloc = b.st[0], nx = b.st[1];
        if (nloc == 0u) { xcd_barrier_complete(bar, b.x, nloc, nx); b.st[0] = nloc; b.st[1] = nx; }
        const unsigned old = xb_add(&bar[XB_XSUB(b.x)], 1u);
        const unsigned gen = old / nloc;
        if (old + 1u == (gen + 1u) * nloc) {
            __builtin_amdgcn_fence(__ATOMIC_RELEASE, "agent");
            asm volatile("s_waitcnt vmcnt(0)" ::: "memory");
            const unsigned og = xb_add(&bar[XB_TOP], 1u);
            const unsigned tg = og / nx;
            if (og + 1u == (tg + 1u) * nx) xb_add(&bar[XB_TOPGEN], 1u);
            else XB_SPIN(xb_ld(&bar[XB_TOPGEN]) == tg, bar);
            __builtin_amdgcn_fence(__ATOMIC_ACQUIRE, "agent");
            xb_add(&bar[XB_XGEN(b.x)], 1u);
            asm volatile("s_waitcnt vmcnt(0)" ::: "memory");
        } else {
            XB_SPIN(xb_ld(&bar[XB_XGEN(b.x)]) == gen, bar);
            __builtin_amdgcn_fence(__ATOMIC_ACQUIRE, "agent");
            asm volatile("s_waitcnt vmcnt(0)" ::: "memory");
        }
    }
    __syncthreads();
}


struct Args { const float* in[N_IN]; float* out; unsigned char* ws; int ph_lo, ph_hi; };
static_assert(sizeof(Args) == (N_IN + 2) * 8 + 8, "Args has no padding");

struct Frame {
    const float* x; const float* ctx; float* out; unsigned char* ws; char* lds;
    int tid, lane, wave, bid, nblk, vcu;
};

__device__ __forceinline__ const float* xin_row(const Frame& F, int r) {
    const int b = r / RPB, j = r - b * RPB;
    return (j < CTXL) ? F.ctx + ((size_t)b * CTXL + j) * DM : F.x + ((size_t)b * SEQ + (j - CTXL)) * DM;
}
__device__ __forceinline__ int mod_index(int r) { const int b = r / RPB, j = r - b * RPB; return (j < CTXL) ? 4 : b; }
__device__ __forceinline__ bool is_ctx_row(int r) { return (r % RPB) < CTXL; }

__device__ __forceinline__ void p0_mod(const Args& A, const Frame& F) {
    float* sv = (float*)F.lds;
    float* red = sv + 5 * 1024;
    float* MOD = (float*)(F.ws + WS_MOD);
    bool have = false;
    for (int it = F.bid; it < 2 * 96; it += F.nblk) {
        if (!have) {
            for (int i = F.tid; i < 5 * 1024; i += NTHREADS) { const int m = i >> 10, k = i & 1023;
                const float c = (m < 4) ? A.in[I_C][m * 1024 + k] : A.in[I_CCTX][k]; sv[i] = c / (1.f + __expf(-c)); }
            __syncthreads(); have = true;
        }
        const int l = it / 96, n = (it % 96) * 64 + F.lane;
        const float* W = A.in[l ? I1_ADAW : I0_ADAW]; const float* Bv = A.in[l ? I1_ADAB : I0_ADAB];
        float acc[5] = {0.f, 0.f, 0.f, 0.f, 0.f};
        const int k0 = F.wave * 128;
#pragma unroll 16
        for (int k = k0; k < k0 + 128; ++k) { const float w = W[(size_t)k * 6144 + n];
#pragma unroll
            for (int m = 0; m < 5; ++m) acc[m] += sv[m * 1024 + k] * w; }
#pragma unroll
        for (int m = 0; m < 5; ++m) red[(F.wave * 5 + m) * 64 + F.lane] = acc[m];
        __syncthreads();
        if (F.tid < 320) { const int m = F.tid >> 6, ln = F.tid & 63; float s = 0.f;
#pragma unroll
            for (int w = 0; w < 8; ++w) s += red[(w * 5 + m) * 64 + ln];
            const int nn = (it % 96) * 64 + ln;
            MOD[((size_t)l * 5 + m) * 6144 + nn] = s + Bv[nn]; }
        __syncthreads();
    }
}
__device__ __forceinline__ void transpose_item(const float* W, int K, int N, bf16_t* WT, const float* gain, float* scr, int item, int lane) {
    const int nblk = N / 32, kb = item / nblk, nb = item % nblk, k0 = 64 * kb, n0 = 32 * nb;
#pragma unroll 8
    for (int i = 0; i < 32; ++i) { const int kk = 2 * i + (lane >> 5); float v = W[(size_t)(k0 + kk) * N + n0 + (lane & 31)]; if (gain) v *= gain[k0 + kk]; scr[kk * 33 + (lane & 31)] = v; }
    asm volatile("s_waitcnt lgkmcnt(0)" ::: "memory");
    const int c = lane & 7;
#pragma unroll
    for (int j = 0; j < 4; ++j) { const int n = (lane >> 3) + 8 * j; const float* s = scr + (8 * c) * 33 + n;
        u32x4 o; o.x = pk2(s[0 * 33], s[1 * 33]); o.y = pk2(s[2 * 33], s[3 * 33]); o.z = pk2(s[4 * 33], s[5 * 33]); o.w = pk2(s[6 * 33], s[7 * 33]);
        *(u32x4*)(WT + (size_t)(n0 + n) * K + k0 + 8 * c) = o; }
    asm volatile("s_waitcnt lgkmcnt(0)" ::: "memory");
}
__device__ __forceinline__ void p0_weights(const Args& A, const Frame& F) {
    float* scr = (float*)(F.lds + 32768) + F.wave * (64 * 33);
    const int gw = F.bid * NWAVES + F.wave, NGW = F.nblk * NWAVES;
#define TJOB(IN_, K_, N_, OFF_, GAIN_) do { const float* W = A.in[IN_]; bf16_t* WT = (bf16_t*)(F.ws + (OFF_)); \
        for (int it = gw; it < ((K_) / 64) * ((N_) / 32); it += NGW) transpose_item(W, K_, N_, WT, GAIN_, scr, it, F.lane); } while (0)
    TJOB(I0_WIN, 1024, 704, WS_WIN, nullptr); TJOB(I0_WUQ, 384, 1536, WS_WUQ, A.in[I0_QN]); TJOB(I0_WUKV, 256, 2048, WS_WUKV, A.in[I0_KVN]); TJOB(I0_WO, 1024, 1024, WS_WO0, nullptr);
    TJOB(I1_WQKV, 1024, 1536, WS_WQKV, nullptr); TJOB(I1_WO, 1024, 1024, WS_WO1, nullptr);
#undef TJOB
    { u32x4* z = (u32x4*)(F.ws + WS_WIN + (size_t)704 * 1024 * 2); const int n16 = 64 * 1024 * 2 / 16;
      for (int i = F.bid * NTHREADS + F.tid; i < n16; i += F.nblk * NTHREADS) z[i] = (u32x4){0u, 0u, 0u, 0u}; }
}
__device__ __forceinline__ void p0_weff(const Args& A, const Frame& F) {
    float* kkT = (float*)F.lds; float* wqs = kkT + 128 * 129;
    const int tid = F.tid, lane = F.lane, w = F.wave;
    for (int item = F.bid; item < 512; item += F.nblk) {
        const int layer = item >> 8, z = (item >> 4) & 15, kc = item & 15, h = z >> 1;
        const float* kk = ((z & 1) ? (layer ? A.in[I1_PK2] : A.in[I0_PK2]) : (layer ? A.in[I1_PK1] : A.in[I0_PK1])) + (size_t)h * 16384;
        const float* wq = (layer ? A.in[I1_PWQ] : A.in[I0_PWQ]) + (size_t)(kc * 64) * 2048 + z * 128;
        bf16_t* WT = (bf16_t*)(F.ws + (layer ? WS_WQ1 : WS_WQ0));
        __syncthreads();
        { f32x4 kv[8], wv4[4];
#pragma unroll
          for (int i = 0; i < 8; ++i) kv[i] = *(const f32x4*)(kk + 4 * (tid + i * NTHREADS));
#pragma unroll
          for (int i = 0; i < 4; ++i) { const int e = 4 * (tid + i * NTHREADS); wv4[i] = *(const f32x4*)(wq + (size_t)(e >> 7) * 2048 + (e & 127)); }
#pragma unroll
          for (int i = 0; i < 8; ++i) { const int e = 4 * (tid + i * NTHREADS), key = e >> 7, d = e & 127; kkT[d * 129 + key] = kv[i].x; kkT[(d + 1) * 129 + key] = kv[i].y; kkT[(d + 2) * 129 + key] = kv[i].z; kkT[(d + 3) * 129 + key] = kv[i].w; }
#pragma unroll
          for (int i = 0; i < 4; ++i) *(f32x4*)(wqs + 4 * (tid + i * NTHREADS)) = wv4[i]; }
        __syncthreads();
        float acc[8][2];
#pragma unroll
        for (int j = 0; j < 8; ++j) { acc[j][0] = 0.f; acc[j][1] = 0.f; }
#pragma unroll 2
        for (int d = 0; d < 128; ++d) { const float a0 = kkT[d * 129 + lane], a1 = kkT[d * 129 + lane + 64];
#pragma unroll
            for (int j = 0; j < 8; ++j) { const float wv = wqs[(w * 8 + j) * 128 + d]; acc[j][0] += wv * a0; acc[j][1] += wv * a1; } }
        u32x4 o0, o1;
        o0.x = pk2(acc[0][0], acc[1][0]); o0.y = pk2(acc[2][0], acc[3][0]); o0.z = pk2(acc[4][0], acc[5][0]); o0.w = pk2(acc[6][0], acc[7][0]);
        o1.x = pk2(acc[0][1], acc[1][1]); o1.y = pk2(acc[2][1], acc[3][1]); o1.z = pk2(acc[4][1], acc[5][1]); o1.w = pk2(acc[6][1], acc[7][1]);
        *(u32x4*)(WT + (size_t)(z * 128 + lane) * 1024 + kc * 64 + w * 8) = o0;
        *(u32x4*)(WT + (size_t)(z * 128 + lane + 64) * 1024 + kc * 64 + w * 8) = o1;
    }
    __syncthreads();
}

__device__ __forceinline__ void p0_tables(const Args& A, const Frame& F) {
    const int gw = F.bid * NWAVES + F.wave, NGW = F.nblk * NWAVES, lane = F.lane;
    unsigned char* TAB = F.ws + WS_TAB; float* TSC = (float*)(F.ws + WS_TSC);
    for (int it = gw; it < 4 * 16384 / 4; it += NGW) {
        const int t = it >> 12, row0 = (it & 4095) * 4;
        const float* src = (t == 0 ? A.in[I0_PU] : t == 1 ? A.in[I0_PV] : t == 2 ? A.in[I1_PU] : A.in[I1_PV]) + (size_t)row0 * 1024 + 4 * lane;
        f32x4 v[4][4];
#pragma unroll
        for (int rr = 0; rr < 4; ++rr)
#pragma unroll
            for (int j = 0; j < 4; ++j) v[rr][j] = *(const f32x4*)(src + (size_t)rr * 1024 + 256 * j);
#pragma unroll
        for (int rr = 0; rr < 4; ++rr) {
            float am = 0.f;
#pragma unroll
            for (int j = 0; j < 4; ++j) am = fmaxf(am, fmaxf(fmaxf(fabsf(v[rr][j].x), fabsf(v[rr][j].y)), fmaxf(fabsf(v[rr][j].z), fabsf(v[rr][j].w))));
            am = wave_max(am);
            const int row = row0 + rr;
            float sc;
            if ((t & 1) == 0) {
                float ss = 0.f;
#pragma unroll
                for (int j = 0; j < 4; ++j) ss += (v[rr][j].x * v[rr][j].x + v[rr][j].y * v[rr][j].y) + (v[rr][j].z * v[rr][j].z + v[rr][j].w * v[rr][j].w);
                ss = wave_sum(ss);
                sc = am > 0.f ? fminf(am * (1.f / 7.f), 0.36f * sqrtf(ss * (1.f / 1024.f))) : 1.f;
                const float inv = am > 0.f ? 1.f / sc : 0.f;
#pragma unroll
                for (int j = 0; j < 4; ++j) {
                    const int q0 = (int)fminf(fmaxf(rintf(v[rr][j].x * inv), -7.f), 7.f), q1 = (int)fminf(fmaxf(rintf(v[rr][j].y * inv), -7.f), 7.f), q2 = (int)fminf(fmaxf(rintf(v[rr][j].z * inv), -7.f), 7.f), q3 = (int)fminf(fmaxf(rintf(v[rr][j].w * inv), -7.f), 7.f);
                    *(unsigned short*)(TAB + (((size_t)t * 8 + j) * 16384 + row) * 128 + 2 * lane) = (unsigned short)((q0 & 15) | ((q1 & 15) << 4) | ((q2 & 15) << 8) | ((q3 & 15) << 12)); }
            } else {
            sc = am > 0.f ? am * (1.f / 127.f) : 1.f; const float inv = am > 0.f ? 127.f / am : 0.f;
#pragma unroll
            for (int j = 0; j < 4; ++j) { const unsigned b0 = (unsigned)((int)rintf(v[rr][j].x * inv)) & 0xffu, b1 = (unsigned)((int)rintf(v[rr][j].y * inv)) & 0xffu, b2 = (unsigned)((int)rintf(v[rr][j].z * inv)) & 0xffu, b3 = (unsigned)((int)rintf(v[rr][j].w * inv)) & 0xffu;
                *(unsigned*)(TAB + (((size_t)t * 8 + 2 * j + (lane >> 5)) * 16384 + row) * 128 + 4 * (lane & 31)) = b0 | (b1 << 8) | (b2 << 16) | (b3 << 24); }
            }
            if (lane == 0) TSC[t * 16384 + row] = sc;
        }
    }
}

__device__ __forceinline__ void norm_mod_store(const f32x4 (&v)[4], float rinv, const float* g, const float* sh, const float* sc, bf16_t* orow, int lane) {
#pragma unroll
    for (int j = 0; j < 4; ++j) { const int c = 4 * lane + 256 * j;
        const f32x4 gg = *(const f32x4*)(g + c), s1 = *(const f32x4*)(sc + c), s0 = *(const f32x4*)(sh + c);
        const f32x4 y = (v[j] * rinv * gg) * (s1 + 1.f) + s0;
        u32x2 o; o.x = pk2(y.x, y.y); o.y = pk2(y.z, y.w); *(u32x2*)(orow + c) = o; }
}
__device__ __forceinline__ int tok_row(int layer, int n);
__device__ __forceinline__ void norm_row_out(const Frame& F, const f32x4 (&v)[4], float rinv, const float* g, const float* mm, int r, int which) {
    norm_mod_store(v, rinv, g, mm, mm + 1024, (bf16_t*)(F.ws + WS_H) + (size_t)r * DM, F.lane);
    if (which) {
        f32x4 y[4]; float am = 0.f;
#pragma unroll
        for (int j = 0; j < 4; ++j) { const int c = 4 * F.lane + 256 * j; y[j] = (v[j] * rinv * *(const f32x4*)(g + c)) * (*(const f32x4*)(mm + 1024 + c) + 1.f) + *(const f32x4*)(mm + c);
            am = fmaxf(am, fmaxf(fmaxf(fabsf(y[j].x), fabsf(y[j].y)), fmaxf(fabsf(y[j].z), fabsf(y[j].w)))); }
        am = wave_max(am);
        const float inv = am > 0.f ? 119.f / am : 0.f;
#pragma unroll
        for (int j = 0; j < 4; ++j) { const int h0 = (int)rintf(y[j].x * inv), h1 = (int)rintf(y[j].y * inv), h2 = (int)rintf(y[j].z * inv), h3 = (int)rintf(y[j].w * inv);
            const unsigned hh = (unsigned)(((h0 + 8) >> 4) & 15) | ((unsigned)(((h1 + 8) >> 4) & 15) << 4) | ((unsigned)(((h2 + 8) >> 4) & 15) << 8) | ((unsigned)(((h3 + 8) >> 4) & 15) << 12);
            const unsigned hl = (unsigned)(h0 & 15) | ((unsigned)(h1 & 15) << 4) | ((unsigned)(h2 & 15) << 8) | ((unsigned)(h3 & 15) << 12);
            const bool odd = (F.lane & 1) != 0;
            const unsigned recv = (unsigned)__builtin_amdgcn_update_dpp(0, (int)(odd ? hh : hl), 0xB1, 0xf, 0xf, false);
            *(unsigned*)(F.ws + WS_HQ + (size_t)r * DM + 256 * j + 4 * F.lane) = odd ? (recv | (hl << 16)) : (hh | (recv << 16)); }
        if (F.lane == 0) ((float*)(F.ws + WS_HS))[r] = am > 0.f ? am * (1.f / 119.f) : 1.f;
    }
}
__device__ __forceinline__ void p_norm_rows(const Args& A, const Frame& F, int layer, int which, bool from_input, bool skip_ctx) {
    const int gw = F.bid * NWAVES + F.wave, NGW = F.nblk * NWAVES;
    const float* g = A.in[layer ? (which ? I1_NFFN : I1_NMIX) : (which ? I0_NFFN : I0_NMIX)];
    const float* MOD = (const float*)(F.ws + WS_MOD) + (size_t)layer * 5 * 6144;
    const unsigned short* X = (const unsigned short*)(F.ws + WS_X);
    const int ntok = skip_ctx ? NB * SEQ : R;
    for (int n = gw; n < ntok; n += 2 * NGW) {
        const bool has1 = (n + NGW) < ntok;
        const int r0 = skip_ctx ? tok_row(1, n) : n, r1 = has1 ? (skip_ctx ? tok_row(1, n + NGW) : n + NGW) : r0;
        f32x4 v0[4], v1[4]; float s0 = 0.f, s1 = 0.f;
        if (from_input) { const float* x0 = xin_row(F, r0); const float* x1 = xin_row(F, r1);
#pragma unroll
            for (int j = 0; j < 4; ++j) { v0[j] = *(const f32x4*)(x0 + 4 * F.lane + 256 * j); v1[j] = *(const f32x4*)(x1 + 4 * F.lane + 256 * j); } }
        else {
#pragma unroll
            for (int j = 0; j < 4; ++j) { const u32x2 a = *(const u32x2*)(X + (size_t)r0 * DM + 4 * F.lane + 256 * j), b = *(const u32x2*)(X + (size_t)r1 * DM + 4 * F.lane + 256 * j);
                v0[j] = (f32x4){h2f_lo(a.x), h2f_hi(a.x), h2f_lo(a.y), h2f_hi(a.y)}; v1[j] = (f32x4){h2f_lo(b.x), h2f_hi(b.x), h2f_lo(b.y), h2f_hi(b.y)}; } }
#pragma unroll
        for (int j = 0; j < 4; ++j) { s0 += (v0[j].x * v0[j].x + v0[j].y * v0[j].y) + (v0[j].z * v0[j].z + v0[j].w * v0[j].w); s1 += (v1[j].x * v1[j].x + v1[j].y * v1[j].y) + (v1[j].z * v1[j].z + v1[j].w * v1[j].w); }
        const float ri0 = rsqrtf(wave_sum(s0) * (1.f / DM) + EPS), ri1 = rsqrtf(wave_sum(s1) * (1.f / DM) + EPS);
        norm_row_out(F, v0, ri0, g, MOD + (size_t)mod_index(r0) * 6144 + (which ? 3 * 1024 : 0), r0, which);
        if (has1) norm_row_out(F, v1, ri1, g, MOD + (size_t)mod_index(r1) * 6144 + (which ? 3 * 1024 : 0), r1, which);
    }
}

namespace pg8 {
#define PG8_LAS __attribute__((address_space(3)))
typedef unsigned short bf16_t;
typedef short bf16x8 __attribute__((ext_vector_type(8)));
typedef float f32x4 __attribute__((ext_vector_type(4)));
typedef unsigned u32x4 __attribute__((ext_vector_type(4)));
constexpr int BM = 256, BK = 64, HALF = 128, HTB = HALF * BK * 2  , STAGE_BYTES = 8 * HTB, NXCD = 8, WGM = 8;

__host__ __device__ __forceinline__ int lds_byte(int r, int c) { const int st = (r >> 4) * 2 + (c >> 5), rr = r & 15, cc = c & 31, ob = rr * 64 + cc * 2; return st * 1024 + (ob ^ (((ob >> 9) & 1) << 5)); }
__host__ __device__ __forceinline__ void stage_rc(int b, int& R, int& C) { const int st = b / 1024, sb = b % 1024, swz = sb ^ (((sb >> 9) & 1) << 5); R = (st >> 1) * 16 + swz / 64; C = (st & 1) * 32 + (swz % 64) / 2; }
__host__ __device__ __forceinline__ int perm32(int rho) { const int n = rho >> 4, i = rho & 15; return 8 * (i >> 2) + 4 * n + (i & 3); }

struct Unit { int pm, pn; };
struct Gemm { const bf16_t* A; const bf16_t* Bt; int M, N, K; };

struct StaticOrder {
    int nM, nN, nwg, G, c;
    __host__ __device__ void init(int M, int N, int G_, int c_) { nM = M / BM; nN = N / BM; nwg = nM * nN; G = G_; c = c_; }
    __host__ __device__ bool next(int i, Unit& u) const {
        const long L = (long)i * G + c; if (L >= nwg) return false;
        int wgid = (int)L; { const int q = nwg / NXCD, r = nwg % NXCD, xcd = wgid % NXCD, off = wgid / NXCD; wgid = (xcd < r ? xcd * (q + 1) : r * (q + 1) + (xcd - r) * q) + off; }
        const int nig = WGM * nN, gid = wgid / nig, fm = gid * WGM, gsz = (nM - fm) < WGM ? (nM - fm) : WGM;
        u.pm = fm + ((wgid % nig) % gsz); u.pn = (wgid % nig) / gsz; return true;
    }
    __device__ __forceinline__ void a_ready(const Unit&) const {}
    __device__ __forceinline__ void done(const Unit&) const {}
};

template <class Epi, class Sched, bool ALIGN_EPI = false, bool SP2 = false>
__device__ __forceinline__ void gemm_phase(PG8_LAS unsigned char* lds, const Gemm g, const Sched& S, const Epi& E) {
    const int tid = threadIdx.x, wid = __builtin_amdgcn_readfirstlane(tid >> 6), lane = tid & 63, wr = wid >> 2, wc = wid & 3, fr = lane & 15, fq = lane >> 4;
    const int K = g.K, nt = K / BK;
    unsigned voffA[2], voffB[2];
#pragma unroll
    for (int i = 0; i < 2; ++i) { int R, C; stage_rc(tid * 16 + i * 8192, R, C); const int Rb = Epi::PERM ? ((R & ~31) + perm32(R & 31)) : R;
        voffA[i] = (unsigned)(R * K + C) * 2u; voffB[i] = (unsigned)(Rb * K + C) * 2u; }
    const size_t kstep = (size_t)(BK * 2);
    const size_t hstep = (size_t)HALF * K * 2;
    const size_t tstep = 2 * hstep;
    const unsigned ldsw = (unsigned)wid * 1024u;
    const int aoff = lds_byte(wr * 64 + fr, fq * 8), boff = lds_byte(wc * 32 + fr, fq * 8);
#define PG8_SA(b, h) (((b) * 2 + (h)) * HTB)
#define PG8_SB(b, h) ((4 + (b) * 2 + (h)) * HTB)
#define PG8_STAGE(bufoff, gbase, voff) do { _Pragma("unroll") for (int _i = 0; _i < 2; ++_i) \
        __builtin_amdgcn_global_load_lds((const unsigned*)((const char*)(gbase) + (voff)[_i]), (PG8_LAS unsigned*)(lds + (bufoff) + ldsw + _i * 8192), 16, 0, 0); } while (0)
#define PG8_LDA(dst, b, h) do { _Pragma("unroll") for (int m = 0; m < 4; ++m) _Pragma("unroll") for (int k = 0; k < 2; ++k) dst[m][k] = *(const PG8_LAS bf16x8*)(lds + PG8_SA(b, h) + aoff + m * 2048 + k * 1024); } while (0)
#define PG8_LDB(dst, b, h) do { _Pragma("unroll") for (int n = 0; n < 2; ++n) _Pragma("unroll") for (int k = 0; k < 2; ++k) dst[n][k] = *(const PG8_LAS bf16x8*)(lds + PG8_SB(b, h) + boff + n * 2048 + k * 1024); } while (0)
#define PG8_MMA(ai, bj, At, Bt) do { __builtin_amdgcn_s_setprio(1); _Pragma("unroll") for (int m = 0; m < 4; ++m) _Pragma("unroll") for (int n = 0; n < 2; ++n) _Pragma("unroll") for (int k = 0; k < 2; ++k) \
        acc[ai][bj][m][n] = __builtin_amdgcn_mfma_f32_16x16x32_bf16(Bt[n][k], At[m][k], acc[ai][bj][m][n], 0, 0, 0); __builtin_amdgcn_s_setprio(0); } while (0)
#define PG8_WAIT_V(n) asm volatile("s_waitcnt vmcnt(" #n ")" ::: "memory")
#define PG8_WAIT_L(n) asm volatile("s_waitcnt lgkmcnt(" #n ")" ::: "memory")
#define PG8_BAR __builtin_amdgcn_s_barrier()
#define PG8_SCHED __builtin_amdgcn_sched_barrier(0)
    Unit cur, nxt; int ui = 0;
    if (!S.next(0, cur)) return;
    f32x4 acc[2][2][4][2];
#pragma unroll
    for (int a = 0; a < 2; ++a)
#pragma unroll
        for (int b = 0; b < 2; ++b)
#pragma unroll
            for (int m = 0; m < 4; ++m)
#pragma unroll
                for (int n = 0; n < 2; ++n) acc[a][b][m][n] = (f32x4){0.f, 0.f, 0.f, 0.f};
    bf16x8 At[4][2], B0[2][2], B1[2][2];
    const char* cA = (const char*)g.A + (size_t)cur.pm * tstep; const char* cB = (const char*)g.Bt + (size_t)cur.pn * tstep;
    S.a_ready(cur);
    if constexpr (SP2) {
        PG8_STAGE(PG8_SB(0, 0), cB, voffB); PG8_STAGE(PG8_SB(0, 1), cB + hstep, voffB); PG8_STAGE(PG8_SA(0, 0), cA, voffA); PG8_STAGE(PG8_SA(0, 1), cA + hstep, voffA);
        if (wr == 1) PG8_BAR;
        PG8_WAIT_V(2); PG8_BAR;
        PG8_STAGE(PG8_SB(1, 0), cB + kstep, voffB); PG8_STAGE(PG8_SA(1, 0), cA + kstep, voffA); PG8_STAGE(PG8_SB(1, 1), cB + hstep + kstep, voffB);
        PG8_WAIT_V(6); PG8_BAR;
    } else {
        PG8_STAGE(PG8_SB(0, 0), cB, voffB); PG8_STAGE(PG8_SA(0, 0), cA, voffA); PG8_STAGE(PG8_SB(0, 1), cB + hstep, voffB); PG8_STAGE(PG8_SA(0, 1), cA + hstep, voffA);
        if (wr == 1) PG8_BAR;
        PG8_WAIT_V(4); PG8_BAR;
        PG8_STAGE(PG8_SB(1, 0), cB + kstep, voffB); PG8_STAGE(PG8_SA(1, 0), cA + kstep, voffA); PG8_STAGE(PG8_SB(1, 1), cB + hstep + kstep, voffB);
        PG8_WAIT_V(6); PG8_BAR;
    }
    for (;;) {
        const bool has_next = S.next(ui + 1, nxt);
        const char* nA = has_next ? (const char*)g.A + (size_t)nxt.pm * tstep : cA; const char* nB = has_next ? (const char*)g.Bt + (size_t)nxt.pn * tstep : cB;
        for (int t = 0; t < nt; t += 2) {
            const bool last = (t == nt - 2);
            const char* a1 = cA + (size_t)(t + 1) * kstep;
            const char* a2 = last ? nA : cA + (size_t)(t + 2) * kstep; const char* b2 = last ? nB : cB + (size_t)(t + 2) * kstep;
            const char* a3 = a2 + kstep; const char* b3 = b2 + kstep;
            if (last && has_next) S.a_ready(nxt);
            if constexpr (SP2) {
            PG8_LDB(B0, 0, 0); PG8_LDB(B1, 0, 1); PG8_SCHED; PG8_LDA(At, 0, 0); PG8_STAGE(PG8_SA(1, 1), a1 + hstep, voffA);
            PG8_WAIT_V(8); PG8_WAIT_L(0); PG8_BAR; PG8_MMA(0, 0, At, B0); PG8_MMA(0, 1, At, B1); PG8_BAR; PG8_SCHED;
            PG8_LDA(At, 0, 1); PG8_STAGE(PG8_SB(0, 0), b2, voffB); PG8_STAGE(PG8_SB(0, 1), b2 + hstep, voffB); PG8_STAGE(PG8_SA(0, 0), a2, voffA);
            PG8_WAIT_V(8); PG8_WAIT_L(0); PG8_BAR; PG8_MMA(1, 0, At, B0); PG8_MMA(1, 1, At, B1); PG8_BAR; PG8_SCHED;
            PG8_LDB(B0, 1, 0); PG8_LDB(B1, 1, 1); PG8_SCHED; PG8_LDA(At, 1, 0); PG8_STAGE(PG8_SA(0, 1), a2 + hstep, voffA);
            PG8_WAIT_V(8); PG8_WAIT_L(0); PG8_BAR; PG8_MMA(0, 0, At, B0); PG8_MMA(0, 1, At, B1); PG8_BAR; PG8_SCHED;
            PG8_LDA(At, 1, 1); PG8_STAGE(PG8_SB(1, 0), b3, voffB); PG8_STAGE(PG8_SB(1, 1), b3 + hstep, voffB); PG8_STAGE(PG8_SA(1, 0), a3, voffA);
            PG8_WAIT_V(8); PG8_WAIT_L(0); PG8_BAR; PG8_MMA(1, 0, At, B0); PG8_MMA(1, 1, At, B1); PG8_BAR; PG8_SCHED;
            } else {
            PG8_LDB(B0, 0, 0); PG8_SCHED; PG8_LDA(At, 0, 0); PG8_STAGE(PG8_SA(1, 1), a1 + hstep, voffA);
            PG8_WAIT_L(8); PG8_BAR; PG8_WAIT_L(0); PG8_MMA(0, 0, At, B0); PG8_BAR; PG8_SCHED;
            PG8_LDB(B1, 0, 1); PG8_STAGE(PG8_SB(0, 0), b2, voffB);
            PG8_BAR; PG8_WAIT_L(0); PG8_MMA(0, 1, At, B1); PG8_BAR;
            PG8_LDA(At, 0, 1); PG8_STAGE(PG8_SA(0, 0), a2, voffA);
            PG8_BAR; PG8_WAIT_L(0); PG8_MMA(1, 0, At, B0); PG8_BAR; PG8_SCHED;
            PG8_STAGE(PG8_SB(0, 1), b2 + hstep, voffB);
            PG8_WAIT_V(6); PG8_BAR; PG8_MMA(1, 1, At, B1); PG8_BAR;
            PG8_LDB(B0, 1, 0); PG8_SCHED; PG8_LDA(At, 1, 0); PG8_STAGE(PG8_SA(0, 1), a2 + hstep, voffA);
            PG8_WAIT_L(8); PG8_BAR; PG8_WAIT_L(0); PG8_MMA(0, 0, At, B0); PG8_BAR; PG8_SCHED;
            PG8_LDB(B1, 1, 1); PG8_STAGE(PG8_SB(1, 0), b3, voffB);
            PG8_BAR; PG8_WAIT_L(0); PG8_MMA(0, 1, At, B1); PG8_BAR;
            PG8_LDA(At, 1, 1); PG8_STAGE(PG8_SA(1, 0), a3, voffA);
            PG8_BAR; PG8_WAIT_L(0); PG8_MMA(1, 0, At, B0); PG8_BAR; PG8_SCHED;
            PG8_STAGE(PG8_SB(1, 1), b3 + hstep, voffB);
            PG8_WAIT_V(6); PG8_BAR; PG8_MMA(1, 1, At, B1); PG8_BAR;
            }
        }
        if constexpr (ALIGN_EPI) { if (wr == 0) PG8_BAR; }
        if constexpr (!Epi::AFTER_DRAIN) { E(acc, cur, wr, wc, fr, fq); S.done(cur); }
        if (!has_next) break;
#pragma unroll
        for (int a = 0; a < 2; ++a)
#pragma unroll
            for (int b = 0; b < 2; ++b)
#pragma unroll
                for (int m = 0; m < 4; ++m)
#pragma unroll
                    for (int n = 0; n < 2; ++n) acc[a][b][m][n] = (f32x4){0.f, 0.f, 0.f, 0.f};
        cur = nxt; cA = nA; cB = nB; ++ui;
        if constexpr (ALIGN_EPI) { if (wr == 1) PG8_BAR; }
    }
    PG8_WAIT_V(0);
    if constexpr (!ALIGN_EPI) { if (wr == 0) PG8_BAR; }
    PG8_BAR;
    if constexpr (Epi::AFTER_DRAIN) { E.fused(acc, cur, wr, wc, fr, fq, lds, wid, lane); S.done(cur); }
#undef PG8_SA
#undef PG8_SB
#undef PG8_STAGE
#undef PG8_LDA
#undef PG8_LDB
#undef PG8_MMA
#undef PG8_WAIT_V
#undef PG8_WAIT_L
#undef PG8_BAR
#undef PG8_SCHED
}
}

template <class Inner> struct EpiTile { static constexpr bool PERM = true, AFTER_DRAIN = false; Inner in;
    __device__ __forceinline__ void operator()(const pg8::f32x4 (&acc)[2][2][4][2], const pg8::Unit& u, int wr, int wc, int fr, int fq) const {
#pragma unroll
        for (int ai = 0; ai < 2; ++ai)
#pragma unroll
            for (int m = 0; m < 4; ++m) { const int row = u.pm * 256 + ai * 128 + wr * 64 + m * 16 + fr;
#pragma unroll
                for (int bj = 0; bj < 2; ++bj) in(row, u.pn * 256 + bj * 128 + wc * 32 + 8 * fq, acc[ai][bj][m][0], acc[ai][bj][m][1]); }
    } };
struct In8Bf16 { bf16_t* C; int ldc;
    __device__ __forceinline__ void operator()(int row, int col, f32x4 a, f32x4 b) const { u32x4 o; o.x = cvtpk(a.x, a.y); o.y = cvtpk(a.z, a.w); o.z = cvtpk(b.x, b.y); o.w = cvtpk(b.z, b.w); *(u32x4*)(C + (size_t)row * ldc + col) = o; } };
struct In8KV { bf16_t* Kb; bf16_t* Vb;
    __device__ __forceinline__ void operator()(int row, int col, f32x4 a, f32x4 b) const { const int h = col >> 8, c = col & 255; u32x4 o; o.x = cvtpk(a.x, a.y); o.y = cvtpk(a.z, a.w); o.z = cvtpk(b.x, b.y); o.w = cvtpk(b.z, b.w);
        bf16_t* p = (c < 128) ? Kb + (size_t)row * 1536 + h * 192 + c : Vb + (size_t)row * 1024 + h * 128 + (c - 128);
        *(u32x4*)p = o; } };
struct In8F16 { unsigned short* C; int ldc;
    __device__ __forceinline__ void operator()(int row, int col, f32x4 a, f32x4 b) const { u32x4 o; o.x = pkh2(a.x, a.y); o.y = pkh2(a.z, a.w); o.z = pkh2(b.x, b.y); o.w = pkh2(b.z, b.w); *(u32x4*)(C + (size_t)row * ldc + col) = o; } };
struct In8F32 { float* C; int ldc;
    __device__ __forceinline__ void operator()(int row, int col, f32x4 a, f32x4 b) const { float* p = C + (size_t)row * ldc + col; *(f32x4*)p = a; *(f32x4*)(p + 4) = b; } };
struct In8Resid { const float* x; const float* ctx; unsigned short* X; const float* gate; bool from_input;
    __device__ __forceinline__ void operator()(int row, int col, f32x4 a, f32x4 b) const {
        const int bb = row / RPB, j = row - bb * RPB; unsigned short* xo = X + (size_t)row * DM + col;
        f32x4 x0, x1;
        if (from_input) { const float* xi = ((j < CTXL) ? ctx + ((size_t)bb * CTXL + j) * DM : x + ((size_t)bb * SEQ + (j - CTXL)) * DM) + col; x0 = *(const f32x4*)xi; x1 = *(const f32x4*)(xi + 4); }
        else { const u32x4 w = *(const u32x4*)xo; x0 = (f32x4){h2f_lo(w.x), h2f_hi(w.x), h2f_lo(w.y), h2f_hi(w.y)}; x1 = (f32x4){h2f_lo(w.z), h2f_hi(w.z), h2f_lo(w.w), h2f_hi(w.w)}; }
        const float* g = gate + (size_t)((j < CTXL) ? 4 : bb) * 6144 + col;
        x0 += *(const f32x4*)g * a; x1 += *(const f32x4*)(g + 4) * b;
        u32x4 o; o.x = pkh2(x0.x, x0.y); o.y = pkh2(x0.z, x0.w); o.z = pkh2(x1.x, x1.y); o.w = pkh2(x1.z, x1.w); *(u32x4*)xo = o; } };
struct EpiMlaDown { static constexpr bool PERM = true, AFTER_DRAIN = false; bf16_t* CQ; bf16_t* CKV; bf16_t* KR; float* SSP;
    __device__ __forceinline__ void operator()(const pg8::f32x4 (&acc)[2][2][4][2], const pg8::Unit& u, int wr, int wc, int fr, int fq) const {
#pragma unroll
        for (int ai = 0; ai < 2; ++ai)
#pragma unroll
            for (int m = 0; m < 4; ++m) { const int row = u.pm * 256 + ai * 128 + wr * 64 + m * 16 + fr;
#pragma unroll
                for (int bj = 0; bj < 2; ++bj) { const int col = u.pn * 256 + bj * 128 + wc * 32 + 8 * fq; const f32x4 a = acc[ai][bj][m][0], b = acc[ai][bj][m][1];
                    u32x4 o; o.x = cvtpk(a.x, a.y); o.y = cvtpk(a.z, a.w); o.z = cvtpk(b.x, b.y); o.w = cvtpk(b.z, b.w);
                    const int cls = (u.pn * 2 + bj);
                    if (cls < 5) { float sq = (a.x * a.x + a.y * a.y) + (a.z * a.z + a.w * a.w) + (b.x * b.x + b.y * b.y) + (b.z * b.z + b.w * b.w);
                        sq += __shfl_xor(sq, 16); sq += __shfl_xor(sq, 32);
                        if (cls < 3) *(u32x4*)(CQ + (size_t)row * 384 + col) = o; else *(u32x4*)(CKV + (size_t)row * 256 + (col - 384)) = o;
                        if (fq == 0) SSP[(size_t)row * 24 + cls * 4 + wc] = sq; }
                    else if (col < 704) *(u32x4*)(KR + (size_t)row * 64 + (col - 640)) = o; } }
    } };
struct In8Bf16Rs { bf16_t* C; int ldc; const float* ssp;
    __device__ __forceinline__ void operator()(int row, int col, f32x4 a, f32x4 b) const { const f32x4 s0 = *(const f32x4*)(ssp + (size_t)row * 24), s1 = *(const f32x4*)(ssp + (size_t)row * 24 + 4), s2 = *(const f32x4*)(ssp + (size_t)row * 24 + 8);
        const float ssum = (((s0.x + s0.y) + (s0.z + s0.w)) + ((s1.x + s1.y) + (s1.z + s1.w))) + ((s2.x + s2.y) + (s2.z + s2.w));
        const float rs = rsqrtf(ssum * (1.f / 384.f) + EPS); a *= rs; b *= rs;
        u32x4 o; o.x = cvtpk(a.x, a.y); o.y = cvtpk(a.z, a.w); o.z = cvtpk(b.x, b.y); o.w = cvtpk(b.z, b.w); *(u32x4*)(C + (size_t)row * ldc + col) = o; } };
struct In8KVRs { unsigned char* K8; unsigned char* V8; const float* ssp;
    __device__ __forceinline__ void operator()(int row, int col, f32x4 a, f32x4 b) const { const f32x4 s0 = *(const f32x4*)(ssp + (size_t)row * 24 + 12), s1 = *(const f32x4*)(ssp + (size_t)row * 24 + 16);
        const float ssum = ((s0.x + s0.y) + (s0.z + s0.w)) + ((s1.x + s1.y) + (s1.z + s1.w));
        const float rs = rsqrtf(ssum * (1.f / 256.f) + EPS); a *= rs; b *= rs;
        const int h = col >> 8, c = col & 255;
        if (c < 128) { u32x2 o; o.x = f8x4(a.x, a.y, a.z, a.w); o.y = f8x4(b.x, b.y, b.z, b.w); *(u32x2*)(K8 + (size_t)row * 1536 + h * 192 + c) = o; }
        else { u32x2 o; o.x = f8x4(a.x, a.y, a.z, a.w); o.y = f8x4(b.x, b.y, b.z, b.w); *(u32x2*)(V8 + (size_t)row * 1024 + h * 128 + (c - 128)) = o; } } };
struct RowSched { pg8::StaticOrder so; bool latent_only;
    __device__ __forceinline__ void init(int N, int G, int c, bool lat) { latent_only = lat; so.init(lat ? NB * SEQ : R, N, G, c); }
    __device__ __forceinline__ bool next(int i, pg8::Unit& u) const { if (!so.next(i, u)) return false; if (latent_only) u.pm = (u.pm >> 4) * 17 + 1 + (u.pm & 15); return true; }
    __device__ __forceinline__ void a_ready(const pg8::Unit&) const {}
    __device__ __forceinline__ void done(const pg8::Unit&) const {} };
template <class Inner> __device__ __forceinline__ void gemm8(const Frame& F, const bf16_t* Ap, const bf16_t* Bt, int N, int K, bool latent_only, const Inner& in, bool reverse = false) {
    asm volatile("" : "+s"(K));
    pg8::Gemm g{Ap, Bt, R, N, K}; RowSched S; S.init(N, F.nblk, reverse ? F.nblk - 1 - F.bid : F.bid, latent_only);
    EpiTile<Inner> E{in};
    pg8::gemm_phase<EpiTile<Inner>, RowSched, true, true>((PG8_LAS unsigned char*)F.lds, g, S, E);
}

template <class Epi> __device__ __forceinline__ void gemm8e(const Frame& F, const bf16_t* Ap, const bf16_t* Bt, int N, int K, bool latent_only, const Epi& E) {
    asm volatile("" : "+s"(K));
    pg8::Gemm g{Ap, Bt, R, N, K}; RowSched S; S.init(N, F.nblk, F.bid, latent_only);
    pg8::gemm_phase<Epi, RowSched, true, true>((PG8_LAS unsigned char*)F.lds, g, S, E);
}

struct GemmDesc { const bf16_t* A; int lda; long sA; const bf16_t* Bt; int ldb; long sB; int M, N, K, nz; };
template <class Epi>
__device__ __forceinline__ void gemm_simple(const Frame& F, const GemmDesc& g, const Epi& epi, bool skip_ctx) {
    const int wm = F.wave >> 1, wn = F.wave & 1, fr = F.lane & 15, fq = F.lane >> 4;
    const int tM = g.M / 128, tN = g.N / 128, per = tM * tN, total = per * g.nz;
    for (int u = F.bid; u < total; u += F.nblk) {
        const int z = u / per, uu = u - z * per, tm = uu / tN, tn = uu - tm * tN;
        if (skip_ctx && ((tm * 128) % RPB) < CTXL) continue;
        const int row0 = tm * 128 + wm * 32, col0 = tn * 128 + wn * 64;
        const bf16_t* ap = g.A + z * g.sA + (size_t)(row0 + fr) * g.lda + fq * 8;
        const bf16_t* bp = g.Bt + z * g.sB + (size_t)(col0 + fr) * g.ldb + fq * 8;
        f32x4 acc[2][4];
#pragma unroll
        for (int mi = 0; mi < 2; ++mi)
#pragma unroll
            for (int ni = 0; ni < 4; ++ni) acc[mi][ni] = (f32x4){0.f, 0.f, 0.f, 0.f};
        for (int k0 = 0; k0 < g.K; k0 += 32) {
            bf16x8 a[2], b[4];
#pragma unroll
            for (int mi = 0; mi < 2; ++mi) a[mi] = *(const bf16x8*)(ap + (size_t)mi * 16 * g.lda + k0);
#pragma unroll
            for (int ni = 0; ni < 4; ++ni) b[ni] = *(const bf16x8*)(bp + (size_t)ni * 16 * g.ldb + k0);
#pragma unroll
            for (int mi = 0; mi < 2; ++mi)
#pragma unroll
                for (int ni = 0; ni < 4; ++ni) acc[mi][ni] = __builtin_amdgcn_mfma_f32_16x16x32_bf16(b[ni], a[mi], acc[mi][ni], 0, 0, 0);
        }
#pragma unroll
        for (int mi = 0; mi < 2; ++mi)
#pragma unroll
            for (int ni = 0; ni < 4; ++ni) epi(z, row0 + mi * 16 + fr, col0 + ni * 16 + fq * 4, acc[mi][ni]);
    }
}
struct EpiBf16 { bf16_t* C; int ldc;
    __device__ __forceinline__ void operator()(int, int row, int col, f32x4 v) const { u32x2 o; o.x = pk2(v.x, v.y); o.y = pk2(v.z, v.w); *(u32x2*)(C + (size_t)row * ldc + col) = o; } };
struct EpiKV { bf16_t* Kb; bf16_t* Vb;
    __device__ __forceinline__ void operator()(int, int row, int col, f32x4 v) const { const int h = col >> 8, c = col & 255; u32x2 o; o.x = pk2(v.x, v.y); o.y = pk2(v.z, v.w);
        if (c < 128) *(u32x2*)(Kb + (size_t)row * 1536 + h * 192 + c) = o; else *(u32x2*)(Vb + (size_t)row * 1024 + h * 128 + (c - 128)) = o; } };
struct EpiF32Z { float* C; int ldc;
    __device__ __forceinline__ void operator()(int z, int row, int col, f32x4 v) const { *(f32x4*)(C + (size_t)row * ldc + z * 128 + col) = v; } };
struct EpiResid { const Frame* F; const float* gate; bool from_input;
    __device__ __forceinline__ void operator()(int, int row, int col, f32x4 v) const {
        float* X = (float*)(F->ws + WS_X) + (size_t)row * DM + col;
        const float* xi = from_input ? xin_row(*F, row) + col : X;
        const f32x4 g = *(const f32x4*)(gate + (size_t)mod_index(row) * 6144 + col);
        *(f32x4*)X = *(const f32x4*)xi + g * v; } };

__device__ __forceinline__ void rope_angles(int r, int& prow, int& pcol) { const int t = (r % RPB) - CTXL; prow = t >> 6; pcol = t & 63; }
__device__ __forceinline__ void p_mla_krope(const Args& A, const Frame& F) {
    const int gw = F.bid * NWAVES + F.wave, NGW = F.nblk * NWAVES, lane = F.lane;
    const bf16_t* KR = (const bf16_t*)(F.ws + WS_KR); unsigned char* K8 = F.ws + WS_K;
    const float invf = __powf(10000.f, -(float)(lane & 15) * (1.f / 16.f));
    for (int r = gw; r < R; r += NGW) {
        float kr = bf2f(KR[(size_t)r * 64 + lane]);
        if (!is_ctx_row(r)) {
            int prow, pcol; rope_angles(r, prow, pcol);
            const float ang = (float)((lane & 32) ? pcol : prow) * invf;
            const float cs = cosf(ang), sn = sinf(ang);
            const float partner = __shfl_xor(kr, 16);
            kr = kr * cs + ((lane & 16) ? partner : -partner) * sn;
        }
        const unsigned char kb = (unsigned char)(f8x4(kr, kr, kr, kr) & 0xffu);
#pragma unroll
        for (int h = 0; h < 8; ++h) K8[(size_t)r * 1536 + h * 192 + 128 + lane] = kb;
    }
}
__device__ __forceinline__ float row16_sum(float v) { v += WDPP(v, 0xB1); v += WDPP(v, 0x4E); v += WDPP(v, 0x141); v += WDPP(v, 0x140); return v; }
__device__ __forceinline__ void p_gqa_rows(const Args& A, const Frame& F) {
    const int gw = F.bid * NWAVES + F.wave, NGW = F.nblk * NWAVES, lane = F.lane, c16 = lane & 15, hrow = lane >> 4;
    const bf16_t* RAW = (const bf16_t*)(F.ws + WS_RAW1); bf16_t* Q1 = (bf16_t*)(F.ws + WS_Q1); unsigned char* K18 = F.ws + WS_K1; unsigned char* V18 = F.ws + WS_V1;
    float qg[8], kg[8], invf[8];
#pragma unroll
    for (int e = 0; e < 8; ++e) { qg[e] = A.in[I1_QN][8 * c16 + e]; kg[e] = A.in[I1_KN][8 * c16 + e]; invf[e] = __powf(10000.f, -(float)(8 * (c16 & 3) + e) * (1.f / 32.f)); }
    const bool colaxis = (c16 & 8) != 0, hi32 = (c16 & 4) != 0;
    for (int r = gw; r < R; r += NGW) {
        const bool ctx = is_ctx_row(r);
        const bf16_t* a = RAW + (size_t)r * 1536 + 8 * lane;
        u32x4 ch[3];
#pragma unroll
        for (int j = 0; j < 3; ++j) ch[j] = (ctx && j < 2) ? (u32x4){0u, 0u, 0u, 0u} : *(const u32x4*)(a + 512 * j);
        float cs[8], sn[8];
        { int prow = 0, pcol = 0; if (!ctx) rope_angles(r, prow, pcol); const float pos = (float)(colaxis ? pcol : prow);
#pragma unroll
          for (int e = 0; e < 8; ++e) { const float ang = pos * invf[e]; cs[e] = ctx ? 1.f : __cosf(ang); sn[e] = ctx ? 0.f : __sinf(ang); } }
#pragma unroll
        for (int j = 0; j < 3; ++j) {
            if (ctx && j < 2) continue;
            const bool isv = (j == 2) && (hrow >= 2);
            float x[8];
#pragma unroll
            for (int d = 0; d < 4; ++d) { x[2 * d] = bflo(ch[j][d]); x[2 * d + 1] = bfhi(ch[j][d]); }
            float sq = 0.f;
#pragma unroll
            for (int e = 0; e < 8; ++e) sq += x[e] * x[e];
            const float rinv = rsqrtf(row16_sum(sq) * (1.f / 128.f) + EPS);
            u32x4 o;
            float y[8];
#pragma unroll
            for (int e = 0; e < 8; ++e) y[e] = x[e] * rinv * (j < 2 ? qg[e] : kg[e]);
            u32x4 yp; yp.x = pk2(y[0], y[1]); yp.y = pk2(y[2], y[3]); yp.z = pk2(y[4], y[5]); yp.w = pk2(y[6], y[7]);
            float pr[8];
#pragma unroll
            for (int d = 0; d < 4; ++d) { const float lo = __shfl_xor(y[2 * d], 4), hi2 = __shfl_xor(y[2 * d + 1], 4); pr[2 * d] = lo; pr[2 * d + 1] = hi2; }
            float z[8];
#pragma unroll
            for (int e = 0; e < 8; ++e) z[e] = y[e] * cs[e] + (hi32 ? pr[e] : -pr[e]) * sn[e];
            o.x = pk2(z[0], z[1]); o.y = pk2(z[2], z[3]); o.z = pk2(z[4], z[5]); o.w = pk2(z[6], z[7]);
            (void)yp;
            if (isv) o = ch[j];
            if (j < 2) *(u32x4*)(Q1 + (size_t)r * 1024 + 512 * j + 8 * lane) = o;
            else if (hrow < 2) { u32x2 o8; o8.x = f8x4(z[0], z[1], z[2], z[3]); o8.y = f8x4(z[4], z[5], z[6], z[7]); *(u32x2*)(K18 + (size_t)r * 256 + 8 * lane) = o8; }
            else { u32x2 o8; o8.x = f8x4(x[0], x[1], x[2], x[3]); o8.y = f8x4(x[4], x[5], x[6], x[7]); *(u32x2*)(V18 + (size_t)r * 256 + 8 * (lane - 32)) = o8; }
        }
    }
}

__device__ __forceinline__ int crow(int r, int hi) { return (r & 3) + 8 * (r >> 2) + 4 * hi; }
__device__ __forceinline__ int v_st(int k, int c) { const int kk = (k & ~0xC) | ((k & 4) << 1) | ((k & 8) >> 1); return ((kk >> 3) * 4 + (c >> 5)) * 512 + ((kk & 7) * 32 + (c & 31)) * 2; }
__device__ __forceinline__ int v_rd_base(int lane) { return ((lane & 3) << 3) | (((lane >> 2) & 3) << 6) | (((lane >> 4) & 1) << 5) | (((lane >> 5) & 1) << 8); }
constexpr int v_rd_off(int d0, int ks, int half) { return d0 * 512 + ks * 4096 + half * 2048; }
template <int OFF> __device__ __forceinline__ s16x4 tr_read(int vb) { s16x4 r; asm volatile("ds_read_b64_tr_b16 %0, %1 offset:%2" : "=&v"(r) : "v"(vb), "i"(OFF) : "memory"); return r; }
template <int D0> __device__ __forceinline__ void pv_one(f32x16& od, int vb, bf16x8 pa0, bf16x8 pa1, bf16x8 pa2, bf16x8 pa3) {
    const s16x4 l0 = tr_read<v_rd_off(D0, 0, 0)>(vb), h0 = tr_read<v_rd_off(D0, 0, 1)>(vb), l1 = tr_read<v_rd_off(D0, 1, 0)>(vb), h1 = tr_read<v_rd_off(D0, 1, 1)>(vb);
    const s16x4 l2 = tr_read<v_rd_off(D0, 2, 0)>(vb), h2 = tr_read<v_rd_off(D0, 2, 1)>(vb), l3 = tr_read<v_rd_off(D0, 3, 0)>(vb), h3 = tr_read<v_rd_off(D0, 3, 1)>(vb);
    asm volatile("s_waitcnt lgkmcnt(0)" ::: "memory"); SBAR();
#define PK(L, H) (bf16x8){L[0], L[1], L[2], L[3], H[0], H[1], H[2], H[3]}
    od = __builtin_amdgcn_mfma_f32_32x32x16_bf16(pa0, PK(l0, h0), od, 0, 0, 0);
    od = __builtin_amdgcn_mfma_f32_32x32x16_bf16(pa1, PK(l1, h1), od, 0, 0, 0);
    od = __builtin_amdgcn_mfma_f32_32x32x16_bf16(pa2, PK(l2, h2), od, 0, 0, 0);
    od = __builtin_amdgcn_mfma_f32_32x32x16_bf16(pa3, PK(l3, h3), od, 0, 0, 0);
#undef PK
}
__device__ __forceinline__ void pv_d0(f32x16* o, int vb, bf16x8 pa0, bf16x8 pa1, bf16x8 pa2, bf16x8 pa3) {
    pv_one<0>(o[0], vb, pa0, pa1, pa2, pa3); pv_one<1>(o[1], vb, pa0, pa1, pa2, pa3); pv_one<2>(o[2], vb, pa0, pa1, pa2, pa3); pv_one<3>(o[3], vb, pa0, pa1, pa2, pa3);
}
constexpr float ATT_THR = 8.f;
__device__ __forceinline__ void partialSM(f32x16& p0, f32x16& p1, float& m_reg, float& mn, float& alpha, float C, float thr_raw) {
    float pmax = p0[0];
#pragma unroll
    for (int r = 1; r < 16; ++r) pmax = fmaxf(pmax, p0[r]);
#pragma unroll
    for (int r = 0; r < 16; ++r) pmax = fmaxf(pmax, p1[r]);
    { auto rr = __builtin_amdgcn_permlane32_swap(__float_as_uint(pmax), __float_as_uint(pmax), false, false);
      pmax = fmaxf(__uint_as_float(rr[0]), __uint_as_float(rr[1])); }
    if (__builtin_expect(__all(pmax - m_reg <= thr_raw), 1)) { mn = m_reg; alpha = 1.f; }
    else { mn = fmaxf(m_reg, pmax); alpha = __builtin_amdgcn_exp2f((m_reg - mn) * C); m_reg = mn; }
    const float mnC = -mn * C;
#pragma unroll
    for (int r = 0; r < 16; ++r) p0[r] = fmaf(p0[r], C, mnC);
#pragma unroll
    for (int r = 0; r < 16; ++r) p1[r] = fmaf(p1[r], C, mnC);
#pragma unroll
    for (int r = 0; r < 16; ++r) p0[r] = __builtin_amdgcn_exp2f(p0[r]);
}
__device__ __forceinline__ void finishSM(f32x16& p0, f32x16& p1, float alpha, float& l_reg, bf16x8& pa0, bf16x8& pa1, bf16x8& pa2, bf16x8& pa3) {
#pragma unroll
    for (int r = 0; r < 16; ++r) p1[r] = __builtin_amdgcn_exp2f(p1[r]);
    float ps = 0;
#pragma unroll
    for (int r = 0; r < 16; ++r) ps += p0[r];
#pragma unroll
    for (int r = 0; r < 16; ++r) ps += p1[r];
    { auto rr = __builtin_amdgcn_permlane32_swap(__float_as_uint(ps), __float_as_uint(ps), false, false);
      ps = __uint_as_float(rr[0]) + __uint_as_float(rr[1]); }
    l_reg = l_reg * alpha + ps;
#define PK4(P, BASE, OUT) do { unsigned a0 = cvtpk(P[BASE + 0], P[BASE + 1]), a1 = cvtpk(P[BASE + 2], P[BASE + 3]);   \
    unsigned b0 = cvtpk(P[BASE + 4], P[BASE + 5]), b1 = cvtpk(P[BASE + 6], P[BASE + 7]);                              \
    auto r0 = __builtin_amdgcn_permlane32_swap(a0, b0, false, false); auto r1 = __builtin_amdgcn_permlane32_swap(a1, b1, false, false); \
    u32x4 w = {r0[0], r1[0], r0[1], r1[1]}; OUT = *reinterpret_cast<bf16x8*>(&w); } while (0)
    PK4(p0, 0, pa0); PK4(p0, 8, pa1); PK4(p1, 0, pa2); PK4(p1, 8, pa3);
#undef PK4
}
template <int DQK> __device__ __forceinline__ void qkt(f32x16& p0, f32x16& p1, const char* Ks, const bf16x8* qr, int r32, int hi) {
    constexpr int KP = DQK * 2 + 16;
    p0 = f32x16{}; p1 = f32x16{};
#pragma unroll
    for (int d0 = 0; d0 < DQK / 16; ++d0) { const int cb = (d0 * 16 + hi * 8) * 2;
        const bf16x8 b0 = *reinterpret_cast<const bf16x8*>(Ks + r32 * KP + cb);
        const bf16x8 b1 = *reinterpret_cast<const bf16x8*>(Ks + (32 + r32) * KP + cb);
        p0 = __builtin_amdgcn_mfma_f32_32x32x16_bf16(b0, qr[d0], p0, 0, 0, 0);
        p1 = __builtin_amdgcn_mfma_f32_32x32x16_bf16(b1, qr[d0], p1, 0, 0, 0); }
}
template <int DQK> constexpr int att_lds_bytes() { return 2 * 64 * 128 * 2 + 2 * 64 * (DQK * 2 + 16) + NWAVES * 64 * 4; }
template <int DQK, int LDQ, int LDK, int LDV, int LDO>
__device__ __forceinline__ void attn_body(const bf16_t* __restrict__ Qb, const bf16_t* __restrict__ Kh, const bf16_t* __restrict__ Vh, bf16_t* __restrict__ Ob, int seq, float scale, char* lds) {
    constexpr int KP = DQK * 2 + 16, SHM_V = 64 * 128 * 2, SHM_K = 64 * KP, ND = DQK / 16, CH = DQK / 8, NKL = CH * 64 / NTHREADS;
    const float C = scale * 1.4426950408889634f, thr_raw = ATT_THR / scale;
    const int tid = threadIdx.x, wid = tid >> 6, lane = tid & 63, r32 = lane & 31, hi = lane >> 5;
    char* V_lds = lds; char* K_lds = lds + 2 * SHM_V;
    float* wsf = (float*)(lds + 2 * SHM_V + 2 * SHM_K) + wid * 64; float* li_l = wsf; float* al_l = wsf + 32;
    float m_reg = -1e30f, l_reg = 0; f32x16 o[4] = {}; bf16x8 qr[ND];
    const bf16_t* Qw = Qb + (long)(wid * 32 + r32) * LDQ + hi * 8;
#pragma unroll
    for (int d0 = 0; d0 < ND; ++d0) qr[d0] = *reinterpret_cast<const bf16x8*>(Qw + d0 * 16);
    const int sr = tid >> 4, sc = (tid & 15) * 8, vst0 = v_st(sr, sc), vst1 = v_st(32 + sr, sc);
    static_assert(DQK == 128, "double-pipelined body: 128-wide q.k only");
    const int vb0 = (int)(uintptr_t)V_lds + v_rd_base(lane);
    bf16x8 vs0, vs1, ks[NKL];
#define SLOAD(k0) do { vs0 = *reinterpret_cast<const bf16x8*>(&Vh[(long)((k0) + sr) * LDV + sc]); vs1 = *reinterpret_cast<const bf16x8*>(&Vh[(long)((k0) + 32 + sr) * LDV + sc]); \
    _Pragma("unroll") for (int i_ = 0; i_ < NKL; ++i_) ks[i_] = *reinterpret_cast<const bf16x8*>(&Kh[(long)((k0) + sr + 32 * i_) * LDK + sc]); } while (0)
#define SWRITE(b) do { *(bf16x8*)(V_lds + (b) * SHM_V + vst0) = vs0; *(bf16x8*)(V_lds + (b) * SHM_V + vst1) = vs1; \
    _Pragma("unroll") for (int i_ = 0; i_ < NKL; ++i_) *(bf16x8*)(K_lds + (b) * SHM_K + (sr + 32 * i_) * KP + sc * 2) = ks[i_]; } while (0)
#define RESC(a) do { if (__any((a) < 1.f)) { if (hi == 0) al_l[r32] = (a); asm volatile("s_waitcnt lgkmcnt(0)" ::: "memory"); \
    _Pragma("unroll") for (int d = 0; d < 4; ++d) _Pragma("unroll") for (int r = 0; r < 16; ++r) o[d][r] *= al_l[crow(r, hi)]; } } while (0)
    f32x16 pA0, pA1, pB0, pB1; float mnA, mnB, alA, alB; bf16x8 pa0, pa1, pa2, pa3; const int NT = seq / 64;
    SLOAD(0); asm volatile("s_waitcnt vmcnt(0)" ::: "memory"); SWRITE(0); __syncthreads();
    qkt<DQK>(pA0, pA1, K_lds, qr, r32, hi); partialSM(pA0, pA1, m_reg, mnA, alA, C, thr_raw);
    SLOAD(64);
    asm volatile("s_waitcnt vmcnt(0)" ::: "memory"); SWRITE(1); __syncthreads();
    for (int j = 1; j + 1 < NT; j += 2) {
        SBAR(); qkt<DQK>(pB0, pB1, K_lds + SHM_K, qr, r32, hi);
        finishSM(pA0, pA1, alA, l_reg, pa0, pa1, pa2, pa3); SBAR();
        SLOAD((j + 1) * 64); SBAR();
        pv_d0(o, vb0, pa0, pa1, pa2, pa3); partialSM(pB0, pB1, m_reg, mnB, alB, C, thr_raw);
        __syncthreads(); asm volatile("s_waitcnt vmcnt(0)" ::: "memory"); SWRITE(0);
        RESC(alB); __syncthreads();
        SBAR(); qkt<DQK>(pA0, pA1, K_lds, qr, r32, hi);
        finishSM(pB0, pB1, alB, l_reg, pa0, pa1, pa2, pa3); SBAR();
        SLOAD((j + 2) * 64); SBAR();
        pv_d0(o, vb0 + SHM_V, pa0, pa1, pa2, pa3); partialSM(pA0, pA1, m_reg, mnA, alA, C, thr_raw);
        __syncthreads(); asm volatile("s_waitcnt vmcnt(0)" ::: "memory"); SWRITE(1);
        RESC(alA); __syncthreads();
    }
    SBAR(); qkt<DQK>(pB0, pB1, K_lds + SHM_K, qr, r32, hi);
    finishSM(pA0, pA1, alA, l_reg, pa0, pa1, pa2, pa3); SBAR();
    pv_d0(o, vb0, pa0, pa1, pa2, pa3); partialSM(pB0, pB1, m_reg, mnB, alB, C, thr_raw);
    __syncthreads(); RESC(alB);
    finishSM(pB0, pB1, alB, l_reg, pa0, pa1, pa2, pa3); SBAR();
    pv_d0(o, vb0 + SHM_V, pa0, pa1, pa2, pa3);
    if (hi == 0) li_l[r32] = l_reg; asm volatile("s_waitcnt lgkmcnt(0)" ::: "memory");
    float rli[16];
#pragma unroll
    for (int r = 0; r < 16; ++r) rli[r] = __builtin_amdgcn_rcpf(li_l[crow(r, hi)]);
    bf16_t* Ow = Ob + (long)(wid * 32) * LDO;
#pragma unroll
    for (int r = 0; r < 16; ++r) { const int orow = crow(r, hi);
#pragma unroll
        for (int d0 = 0; d0 < 4; ++d0) Ow[(long)orow * LDO + d0 * 32 + r32] = (bf16_t)f2bf(o[d0][r] * rli[r]); }
    __syncthreads();
#undef SLOAD
#undef SWRITE
#undef RESC
}
template <int DQK, int LDQ, int LDK, int LDV, int LDO>
__device__ __forceinline__ void attn_body_single(const bf16_t* __restrict__ Qb, const bf16_t* __restrict__ Kh, const bf16_t* __restrict__ Vh, bf16_t* __restrict__ Ob, int seq, float scale, char* lds, int rope_t0) {
    constexpr int KP = DQK * 2 + 16, SHM_V = 64 * 128 * 2, SHM_K = 64 * KP, ND = DQK / 16, CH = DQK / 8, NKL = CH * 64 / NTHREADS;
    const float C = scale * 1.4426950408889634f, thr_raw = ATT_THR / scale;
    const int tid = threadIdx.x, wid = tid >> 6, lane = tid & 63, r32 = lane & 31, hi = lane >> 5;
    char* V_lds = lds; char* K_lds = lds + 2 * SHM_V;
    float* wsf = (float*)(lds + 2 * SHM_V + 2 * SHM_K) + wid * 64; float* li_l = wsf; float* al_l = wsf + 32;
    float m_reg = -1e30f, l_reg = 0; f32x16 o[4] = {}; bf16x8 qr[ND];
    const bf16_t* Qw = Qb + (long)(wid * 32 + r32) * LDQ + hi * 8;
#pragma unroll
    for (int d0 = 8; d0 < ND; ++d0) qr[d0] = *reinterpret_cast<const bf16x8*>(Qw + d0 * 16);
    if constexpr (DQK == 192) {
        if (rope_t0 >= 0) {
            const int tq = rope_t0 + wid * 32 + r32; const float prow = (float)(tq >> 6), pcol = (float)(tq & 63);
            u32x4 fa1 = __builtin_bit_cast(u32x4, qr[8]), fa2 = __builtin_bit_cast(u32x4, qr[9]), fb1 = __builtin_bit_cast(u32x4, qr[10]), fb2 = __builtin_bit_cast(u32x4, qr[11]);
#pragma unroll
            for (int jj = 0; jj < 4; ++jj) {
                float na1[2], na2[2], nb1[2], nb2[2];
#pragma unroll
                for (int e = 0; e < 2; ++e) { const float invf = __powf(10000.f, -(float)(hi * 8 + 2 * jj + e) * (1.f / 16.f));
                    const float ar = prow * invf, ac = pcol * invf, cr = __cosf(ar), sr_ = __sinf(ar), cc = __cosf(ac), sc_ = __sinf(ac);
                    const float a1 = e ? bfhi(fa1[jj]) : bflo(fa1[jj]), a2 = e ? bfhi(fa2[jj]) : bflo(fa2[jj]), b1 = e ? bfhi(fb1[jj]) : bflo(fb1[jj]), b2 = e ? bfhi(fb2[jj]) : bflo(fb2[jj]);
                    na1[e] = a1 * cr - a2 * sr_; na2[e] = a2 * cr + a1 * sr_; nb1[e] = b1 * cc - b2 * sc_; nb2[e] = b2 * cc + b1 * sc_; }
                fa1[jj] = pk2(na1[0], na1[1]); fa2[jj] = pk2(na2[0], na2[1]); fb1[jj] = pk2(nb1[0], nb1[1]); fb2[jj] = pk2(nb2[0], nb2[1]);
            }
            qr[8] = __builtin_bit_cast(bf16x8, fa1); qr[9] = __builtin_bit_cast(bf16x8, fa2); qr[10] = __builtin_bit_cast(bf16x8, fb1); qr[11] = __builtin_bit_cast(bf16x8, fb2);
        }
    }
    asm volatile("" ::: "memory");
#pragma unroll
    for (int d0 = 0; d0 < 8; ++d0) qr[d0] = *reinterpret_cast<const bf16x8*>(Qw + d0 * 16);
    const int sr = tid >> 4, sc = (tid & 15) * 8, vst0 = v_st(sr, sc), vst1 = v_st(32 + sr, sc);
    int krow[NKL], kch[NKL];
#pragma unroll
    for (int i = 0; i < NKL; ++i) { const int id = tid + i * NTHREADS; krow[i] = id / CH; kch[i] = id % CH; }
    const int vb0 = (int)(uintptr_t)V_lds + v_rd_base(lane);
    bf16x8 vs0, vs1, ks[NKL];
#define SLOAD(k0) do { vs0 = *reinterpret_cast<const bf16x8*>(&Vh[(long)((k0) + sr) * LDV + sc]); vs1 = *reinterpret_cast<const bf16x8*>(&Vh[(long)((k0) + 32 + sr) * LDV + sc]); \
    _Pragma("unroll") for (int i_ = 0; i_ < NKL; ++i_) ks[i_] = *reinterpret_cast<const bf16x8*>(&Kh[(long)((k0) + krow[i_]) * LDK + kch[i_] * 8]); } while (0)
#define SWRITE(b) do { *(bf16x8*)(V_lds + (b) * SHM_V + vst0) = vs0; *(bf16x8*)(V_lds + (b) * SHM_V + vst1) = vs1; \
    _Pragma("unroll") for (int i_ = 0; i_ < NKL; ++i_) *(bf16x8*)(K_lds + (b) * SHM_K + krow[i_] * KP + kch[i_] * 16) = ks[i_]; } while (0)
#define RESC(a) do { if (__any((a) < 1.f)) { if (hi == 0) al_l[r32] = (a); asm volatile("s_waitcnt lgkmcnt(0)" ::: "memory"); \
    _Pragma("unroll") for (int d = 0; d < 4; ++d) _Pragma("unroll") for (int r = 0; r < 16; ++r) o[d][r] *= al_l[crow(r, hi)]; } } while (0)
    f32x16 p0, p1; float mn, al; bf16x8 pa0, pa1, pa2, pa3; const int NT = seq / 64;
    SLOAD(0); asm volatile("s_waitcnt vmcnt(0)" ::: "memory"); SWRITE(0); __syncthreads();
    SLOAD(64);
    for (int j = 0; j < NT; ++j) {
        const int b = j & 1;
        SBAR(); qkt<DQK>(p0, p1, K_lds + b * SHM_K, qr, r32, hi);
        partialSM(p0, p1, m_reg, mn, al, C, thr_raw);
        RESC(al);
        finishSM(p0, p1, al, l_reg, pa0, pa1, pa2, pa3); SBAR();
        pv_d0(o, vb0 + b * SHM_V, pa0, pa1, pa2, pa3);
        if (j + 1 < NT) { asm volatile("s_waitcnt vmcnt(0)" ::: "memory"); SWRITE(b ^ 1); }
        __syncthreads();
        if (j + 2 < NT) SLOAD((j + 2) * 64);
    }
    if (hi == 0) li_l[r32] = l_reg; asm volatile("s_waitcnt lgkmcnt(0)" ::: "memory");
    float rli[16];
#pragma unroll
    for (int r = 0; r < 16; ++r) rli[r] = __builtin_amdgcn_rcpf(li_l[crow(r, hi)]);
    bf16_t* Ow = Ob + (long)(wid * 32) * LDO;
#pragma unroll
    for (int r = 0; r < 16; ++r) { const int orow = crow(r, hi);
#pragma unroll
        for (int d0 = 0; d0 < 4; ++d0) Ow[(long)orow * LDO + d0 * 32 + r32] = (bf16_t)f2bf(o[d0][r] * rli[r]); }
    __syncthreads();
#undef SLOAD
#undef SWRITE
#undef RESC
}
#define F8_ONE 0x7f7f7f7f
template <int DQK> __device__ __forceinline__ void qkt8(f32x16& p0, f32x16& p1, const char* Ks, const i32x8* qr, int r32, int hi) {
    constexpr int KP = DQK + 16;
    p0 = f32x16{}; p1 = f32x16{};
#pragma unroll
    for (int c = 0; c < DQK / 64; ++c) { const int cb = c * 64 + hi * 32;
        const u32x4 a0 = *reinterpret_cast<const u32x4*>(Ks + r32 * KP + cb), a1 = *reinterpret_cast<const u32x4*>(Ks + r32 * KP + cb + 16);
        const u32x4 b0 = *reinterpret_cast<const u32x4*>(Ks + (32 + r32) * KP + cb), b1 = *reinterpret_cast<const u32x4*>(Ks + (32 + r32) * KP + cb + 16);
        const i32x8 A = {(int)a0.x, (int)a0.y, (int)a0.z, (int)a0.w, (int)a1.x, (int)a1.y, (int)a1.z, (int)a1.w}, B = {(int)b0.x, (int)b0.y, (int)b0.z, (int)b0.w, (int)b1.x, (int)b1.y, (int)b1.z, (int)b1.w};
        p0 = __builtin_amdgcn_mfma_scale_f32_32x32x64_f8f6f4(A, qr[c], p0, 0, 0, 0, F8_ONE, 0, F8_ONE);
        p1 = __builtin_amdgcn_mfma_scale_f32_32x32x64_f8f6f4(B, qr[c], p1, 0, 0, 0, F8_ONE, 0, F8_ONE); }
}
__device__ __forceinline__ i32x8 q32_to_fp8(const bf16_t* p) {
    i32x8 r;
#pragma unroll
    for (int w = 0; w < 4; ++w) { const u32x4 v = *reinterpret_cast<const u32x4*>(p + 8 * w);
        r[2 * w] = (int)f8x4(bflo(v.x), bfhi(v.x), bflo(v.y), bfhi(v.y)); r[2 * w + 1] = (int)f8x4(bflo(v.z), bfhi(v.z), bflo(v.w), bfhi(v.w)); }
    return r;
}
__device__ __forceinline__ i32x8 q32_rope_fp8(const bf16_t* p, float pos) {
    float x[32];
#pragma unroll
    for (int w = 0; w < 4; ++w) { const u32x4 v = *reinterpret_cast<const u32x4*>(p + 8 * w);
#pragma unroll
        for (int e = 0; e < 4; ++e) { x[8 * w + 2 * e] = bflo(v[e]); x[8 * w + 2 * e + 1] = bfhi(v[e]); } }
    float y[32];
#pragma unroll
    for (int i = 0; i < 16; ++i) { const float ang = pos * __powf(10000.f, -(float)i * (1.f / 16.f)), cs = __cosf(ang), sn = __sinf(ang);
        y[i] = x[i] * cs - x[16 + i] * sn; y[16 + i] = x[16 + i] * cs + x[i] * sn; }
    i32x8 r;
#pragma unroll
    for (int w = 0; w < 8; ++w) r[w] = (int)f8x4(y[4 * w], y[4 * w + 1], y[4 * w + 2], y[4 * w + 3]);
    return r;
}
template <int DQK, int LDQ, int LDK, int LDV, int LDO>
__device__ __forceinline__ void attn8_body(const bf16_t* __restrict__ Qb, const unsigned char* __restrict__ Kh, const bf16_t* __restrict__ Vh, bf16_t* __restrict__ Ob, int seq, float scale, char* lds) {
    constexpr int KP = DQK + 16, SHM_V = 64 * 128 * 2, SHM_K = 64 * KP, NC = DQK / 64;
    static_assert(DQK == 128, "double-pipelined body: 128-wide q.k only");
    const float C = scale * 1.4426950408889634f, thr_raw = ATT_THR / scale;
    const int tid = threadIdx.x, wid = tid >> 6, lane = tid & 63, r32 = lane & 31, hi = lane >> 5;
    char* V_lds = lds; char* K_lds = lds + 2 * SHM_V;
    float* wsf = (float*)(lds + 2 * SHM_V + 2 * SHM_K) + wid * 64; float* li_l = wsf; float* al_l = wsf + 32;
    float m_reg = -1e30f, l_reg = 0; f32x16 o[4] = {}; i32x8 qr[NC];
    const bf16_t* Qw = Qb + (long)(wid * 32 + r32) * LDQ + hi * 32;
#pragma unroll
    for (int c = 0; c < NC; ++c) qr[c] = q32_to_fp8(Qw + 64 * c);
    const int sr = tid >> 4, sc = (tid & 15) * 8, vst0 = v_st(sr, sc), vst1 = v_st(32 + sr, sc);
    const int krow = tid >> 3, kch = (tid & 7) * 16;
    const int vb0 = (int)(uintptr_t)V_lds + v_rd_base(lane);
    bf16x8 vs0, vs1; u32x4 ks;
#define SLOAD(k0) do { vs0 = *reinterpret_cast<const bf16x8*>(&Vh[(long)((k0) + sr) * LDV + sc]); vs1 = *reinterpret_cast<const bf16x8*>(&Vh[(long)((k0) + 32 + sr) * LDV + sc]); \
    ks = *reinterpret_cast<const u32x4*>(&Kh[(long)((k0) + krow) * LDK + kch]); } while (0)
#define SWRITE(b) do { *(bf16x8*)(V_lds + (b) * SHM_V + vst0) = vs0; *(bf16x8*)(V_lds + (b) * SHM_V + vst1) = vs1; \
    *(u32x4*)(K_lds + (b) * SHM_K + krow * KP + kch) = ks; } while (0)
#define RESC(a) do { if (__any((a) < 1.f)) { if (hi == 0) al_l[r32] = (a); asm volatile("s_waitcnt lgkmcnt(0)" ::: "memory"); \
    _Pragma("unroll") for (int d = 0; d < 4; ++d) _Pragma("unroll") for (int r = 0; r < 16; ++r) o[d][r] *= al_l[crow(r, hi)]; } } while (0)
    f32x16 pA0, pA1, pB0, pB1; float mnA, mnB, alA, alB; bf16x8 pa0, pa1, pa2, pa3; const int NT = seq / 64;
    SLOAD(0); asm volatile("s_waitcnt vmcnt(0)" ::: "memory"); SWRITE(0); __syncthreads();
    qkt8<DQK>(pA0, pA1, K_lds, qr, r32, hi); partialSM(pA0, pA1, m_reg, mnA, alA, C, thr_raw);
    SLOAD(64);
    asm volatile("s_waitcnt vmcnt(0)" ::: "memory"); SWRITE(1); __syncthreads();
    for (int j = 1; j + 1 < NT; j += 2) {
        SBAR(); qkt8<DQK>(pB0, pB1, K_lds + SHM_K, qr, r32, hi);
        finishSM(pA0, pA1, alA, l_reg, pa0, pa1, pa2, pa3); SBAR();
        SLOAD((j + 1) * 64); SBAR();
        pv_d0(o, vb0, pa0, pa1, pa2, pa3); partialSM(pB0, pB1, m_reg, mnB, alB, C, thr_raw);
        __syncthreads(); asm volatile("s_waitcnt vmcnt(0)" ::: "memory"); SWRITE(0);
        RESC(alB); __syncthreads();
        SBAR(); qkt8<DQK>(pA0, pA1, K_lds, qr, r32, hi);
        finishSM(pB0, pB1, alB, l_reg, pa0, pa1, pa2, pa3); SBAR();
        SLOAD((j + 2) * 64); SBAR();
        pv_d0(o, vb0 + SHM_V, pa0, pa1, pa2, pa3); partialSM(pA0, pA1, m_reg, mnA, alA, C, thr_raw);
        __syncthreads(); asm volatile("s_waitcnt vmcnt(0)" ::: "memory"); SWRITE(1);
        RESC(alA); __syncthreads();
    }
    SBAR(); qkt8<DQK>(pB0, pB1, K_lds + SHM_K, qr, r32, hi);
    finishSM(pA0, pA1, alA, l_reg, pa0, pa1, pa2, pa3); SBAR();
    pv_d0(o, vb0, pa0, pa1, pa2, pa3); partialSM(pB0, pB1, m_reg, mnB, alB, C, thr_raw);
    __syncthreads(); RESC(alB);
    finishSM(pB0, pB1, alB, l_reg, pa0, pa1, pa2, pa3); SBAR();
    pv_d0(o, vb0 + SHM_V, pa0, pa1, pa2, pa3);
    if (hi == 0) li_l[r32] = l_reg; asm volatile("s_waitcnt lgkmcnt(0)" ::: "memory");
    float rli[16];
#pragma unroll
    for (int r = 0; r < 16; ++r) rli[r] = __builtin_amdgcn_rcpf(li_l[crow(r, hi)]);
    bf16_t* Ow = Ob + (long)(wid * 32) * LDO;
#pragma unroll
    for (int r = 0; r < 16; ++r) { const int orow = crow(r, hi);
#pragma unroll
        for (int d0 = 0; d0 < 4; ++d0) Ow[(long)orow * LDO + d0 * 32 + r32] = (bf16_t)f2bf(o[d0][r] * rli[r]); }
    __syncthreads();
#undef SLOAD
#undef SWRITE
#undef RESC
}
template <int DQK, int LDQ, int LDK, int LDV, int LDO>
__device__ __forceinline__ void attn8_body_single(const bf16_t* __restrict__ Qb, const unsigned char* __restrict__ Kh, const bf16_t* __restrict__ Vh, bf16_t* __restrict__ Ob, int seq, float scale, char* lds, int rope_t0) {
    constexpr int KP = DQK + 16, SHM_V = 64 * 128 * 2, SHM_K = 64 * KP, NC = DQK / 64, CH = DQK / 16, NCH = 64 * CH, NKL = (NCH + NTHREADS - 1) / NTHREADS;
    const float C = scale * 1.4426950408889634f, thr_raw = ATT_THR / scale;
    const int tid = threadIdx.x, wid = tid >> 6, lane = tid & 63, r32 = lane & 31, hi = lane >> 5;
    char* V_lds = lds; char* K_lds = lds + 2 * SHM_V;
    float* wsf = (float*)(lds + 2 * SHM_V + 2 * SHM_K) + wid * 64; float* li_l = wsf; float* al_l = wsf + 32;
    float m_reg = -1e30f, l_reg = 0; f32x16 o[4] = {}; i32x8 qr[NC];
    const bf16_t* Qw = Qb + (long)(wid * 32 + r32) * LDQ + hi * 32;
    if constexpr (DQK == 192) {
        if (rope_t0 >= 0) { const int tq = rope_t0 + wid * 32 + r32; qr[2] = q32_rope_fp8(Qw + 128, (float)(hi ? (tq & 63) : (tq >> 6))); }
        else qr[2] = q32_to_fp8(Qw + 128);
    }
    asm volatile("" ::: "memory");
#pragma unroll
    for (int c = 0; c < 2; ++c) qr[c] = q32_to_fp8(Qw + 64 * c);
    const int sr = tid >> 4, sc = (tid & 15) * 8, vst0 = v_st(sr, sc), vst1 = v_st(32 + sr, sc);
    int krow[NKL], kch[NKL];
#pragma unroll
    for (int i = 0; i < NKL; ++i) { const int id = tid + i * NTHREADS; krow[i] = (id < NCH) ? id / CH : 0; kch[i] = (id % CH) * 16; }
    const bool k2 = (NKL < 2) || (tid + NTHREADS < NCH);
    const int vb0 = (int)(uintptr_t)V_lds + v_rd_base(lane);
    bf16x8 vs0, vs1; u32x4 ks[NKL];
#define SLOAD(k0) do { vs0 = *reinterpret_cast<const bf16x8*>(&Vh[(long)((k0) + sr) * LDV + sc]); vs1 = *reinterpret_cast<const bf16x8*>(&Vh[(long)((k0) + 32 + sr) * LDV + sc]); \
    _Pragma("unroll") for (int i_ = 0; i_ < NKL; ++i_) ks[i_] = *reinterpret_cast<const u32x4*>(&Kh[(long)((k0) + krow[i_]) * LDK + kch[i_]]); } while (0)
#define SWRITE(b) do { *(bf16x8*)(V_lds + (b) * SHM_V + vst0) = vs0; *(bf16x8*)(V_lds + (b) * SHM_V + vst1) = vs1; \
    _Pragma("unroll") for (int i_ = 0; i_ < NKL; ++i_) if (i_ == 0 || k2) *(u32x4*)(K_lds + (b) * SHM_K + krow[i_] * KP + kch[i_]) = ks[i_]; } while (0)
#define RESC(a) do { if (__any((a) < 1.f)) { if (hi == 0) al_l[r32] = (a); asm volatile("s_waitcnt lgkmcnt(0)" ::: "memory"); \
    _Pragma("unroll") for (int d = 0; d < 4; ++d) _Pragma("unroll") for (int r = 0; r < 16; ++r) o[d][r] *= al_l[crow(r, hi)]; } } while (0)
    f32x16 p0, p1; float mn, al; bf16x8 pa0, pa1, pa2, pa3; const int NT = seq / 64;
    SLOAD(0); asm volatile("s_waitcnt vmcnt(0)" ::: "memory"); SWRITE(0); __syncthreads();
    SLOAD(64);
    for (int j = 0; j < NT; ++j) {
        const int b = j & 1;
        SBAR(); qkt8<DQK>(p0, p1, K_lds + b * SHM_K, qr, r32, hi);
        partialSM(p0, p1, m_reg, mn, al, C, thr_raw);
        RESC(al);
        finishSM(p0, p1, al, l_reg, pa0, pa1, pa2, pa3); SBAR();
        pv_d0(o, vb0 + b * SHM_V, pa0, pa1, pa2, pa3);
        if (j + 1 < NT) { asm volatile("s_waitcnt vmcnt(0)" ::: "memory"); SWRITE(b ^ 1); }
        __syncthreads();
        if (j + 2 < NT) SLOAD((j + 2) * 64);
    }
    if (hi == 0) li_l[r32] = l_reg; asm volatile("s_waitcnt lgkmcnt(0)" ::: "memory");
    float rli[16];
#pragma unroll
    for (int r = 0; r < 16; ++r) rli[r] = __builtin_amdgcn_rcpf(li_l[crow(r, hi)]);
    bf16_t* Ow = Ob + (long)(wid * 32) * LDO;
#pragma unroll
    for (int r = 0; r < 16; ++r) { const int orow = crow(r, hi);
#pragma unroll
        for (int d0 = 0; d0 < 4; ++d0) Ow[(long)orow * LDO + d0 * 32 + r32] = (bf16_t)f2bf(o[d0][r] * rli[r]); }
    __syncthreads();
#undef SLOAD
#undef SWRITE
#undef RESC
}
constexpr float ATT8_THR = 3.5f, ATT8_SH = 3.f;
#ifndef ATT8_FIXED_M
#define ATT8_FIXED_M 0
#endif
__device__ __forceinline__ void partialSM8(f32x16& p0, f32x16& p1, float& m_reg, float& mn, float& alpha, float C, float thr_raw) {
#if ATT8_FIXED_M
    mn = 6.f * 1.4426950408889634f / C; alpha = 1.f; m_reg = mn;
#else
    float pmax = p0[0];
#pragma unroll
    for (int r = 1; r < 16; ++r) pmax = fmaxf(pmax, p0[r]);
#pragma unroll
    for (int r = 0; r < 16; ++r) pmax = fmaxf(pmax, p1[r]);
    { auto rr = __builtin_amdgcn_permlane32_swap(__float_as_uint(pmax), __float_as_uint(pmax), false, false);
      pmax = fmaxf(__uint_as_float(rr[0]), __uint_as_float(rr[1])); }
    if (__builtin_expect(__all(pmax - m_reg <= thr_raw), 1)) { mn = m_reg; alpha = 1.f; }
    else { mn = fmaxf(m_reg, pmax); alpha = __builtin_amdgcn_exp2f((m_reg - mn) * C); m_reg = mn; }
#endif
    const float mnC = ATT8_SH - mn * C;
#pragma unroll
    for (int r = 0; r < 16; ++r) p0[r] = fmaf(p0[r], C, mnC);
#pragma unroll
    for (int r = 0; r < 16; ++r) p1[r] = fmaf(p1[r], C, mnC);
#pragma unroll
    for (int r = 0; r < 16; ++r) p0[r] = __builtin_amdgcn_exp2f(p0[r]);
}
__device__ __forceinline__ void finishSM8(f32x16& p0, f32x16& p1, i32x8& pa) {
#pragma unroll
    for (int r = 0; r < 16; ++r) p1[r] = __builtin_amdgcn_exp2f(p1[r]);
#pragma unroll
    for (int w = 0; w < 4; ++w) { pa[w] = (int)f8x4(p0[4 * w], p0[4 * w + 1], p0[4 * w + 2], p0[4 * w + 3]); pa[4 + w] = (int)f8x4(p1[4 * w], p1[4 * w + 1], p1[4 * w + 2], p1[4 * w + 3]); }
}
template <int OFF> __device__ __forceinline__ u32x2 tr8_read(int vb) { u32x2 r; asm volatile("ds_read_b64_tr_b8 %0, %1 offset:%2" : "=&v"(r) : "v"(vb), "i"(OFF) : "memory"); return r; }
#define F8_MFMA(A_, B_, C_) __builtin_amdgcn_mfma_scale_f32_32x32x64_f8f6f4(A_, B_, C_, 0, 0, 0, F8_ONE, 0, F8_ONE)
#define TR8X4(T, VB) const u32x2 T[4] = {tr8_read<0>(VB), tr8_read<2048>(VB), tr8_read<4096>(VB), tr8_read<6144>(VB)}
#define TR8B(T) (i32x8){(int)T[0].x, (int)T[0].y, (int)T[1].x, (int)T[1].y, (int)T[2].x, (int)T[2].y, (int)T[3].x, (int)T[3].y}
template <bool ALL16> __device__ __forceinline__ void pv8_all(f32x16* o, const int* vb, int boff, const i32x8& pa) {
    const i32x8 ones = {0x38383838, 0x38383838, 0x38383838, 0x38383838, 0x38383838, 0x38383838, 0x38383838, 0x38383838};
    if constexpr (ALL16) {
        TR8X4(a, vb[0] + boff); TR8X4(b, vb[1] + boff); TR8X4(c, vb[2] + boff); TR8X4(d, vb[3] + boff);
        o[4] = F8_MFMA(pa, ones, o[4]);
        asm volatile("s_waitcnt lgkmcnt(12)" ::: "memory"); SBAR(); o[0] = F8_MFMA(pa, TR8B(a), o[0]);
        asm volatile("s_waitcnt lgkmcnt(8)" ::: "memory"); SBAR(); o[1] = F8_MFMA(pa, TR8B(b), o[1]);
        asm volatile("s_waitcnt lgkmcnt(4)" ::: "memory"); SBAR(); o[2] = F8_MFMA(pa, TR8B(c), o[2]);
        asm volatile("s_waitcnt lgkmcnt(0)" ::: "memory"); SBAR(); o[3] = F8_MFMA(pa, TR8B(d), o[3]);
    } else {
        { TR8X4(a, vb[0] + boff); TR8X4(b, vb[1] + boff);
          o[4] = F8_MFMA(pa, ones, o[4]);
          asm volatile("s_waitcnt lgkmcnt(4)" ::: "memory"); SBAR(); o[0] = F8_MFMA(pa, TR8B(a), o[0]);
          asm volatile("s_waitcnt lgkmcnt(0)" ::: "memory"); SBAR(); o[1] = F8_MFMA(pa, TR8B(b), o[1]); }
        { TR8X4(c, vb[2] + boff); TR8X4(d, vb[3] + boff);
          asm volatile("s_waitcnt lgkmcnt(4)" ::: "memory"); SBAR(); o[2] = F8_MFMA(pa, TR8B(c), o[2]);
          asm volatile("s_waitcnt lgkmcnt(0)" ::: "memory"); SBAR(); o[3] = F8_MFMA(pa, TR8B(d), o[3]); }
    }
}
__device__ __forceinline__ int v8_f(int key) { return ((key >> 1) & 1) + 2 * ((key >> 3) & 1); }
__device__ __forceinline__ int v8_st(int key, int ch16) { return key * 128 + 32 * ((ch16 >> 1) ^ v8_f(key)) + 16 * (ch16 & 1); }
__device__ __forceinline__ int v8_rd_base(int lane, int db) {
    const int q = (lane & 15) >> 1, pp = lane & 1, g1 = (lane >> 4) & 1, hi = lane >> 5, fq = ((q >> 1) & 1) + 2 * (q >> 2);
    return (8 * (q >> 2) + 4 * hi + (q & 3)) * 128 + 32 * (db ^ fq) + 16 * g1 + 8 * pp;
}
template <int DQK, int LDQ, int LDK, int LDV, int LDO>
__device__ __forceinline__ void attn88_body(const bf16_t* __restrict__ Qb, const unsigned char* __restrict__ Kh, const unsigned char* __restrict__ Vh, bf16_t* __restrict__ Ob, int seq, float scale, char* lds) {
    constexpr int KP = DQK + 16, SHM_V = 64 * 128, SHM_K = 64 * KP, NC = DQK / 64;
    static_assert(DQK == 128, "double-pipelined body: 128-wide q.k only");
    const float C = scale * 1.4426950408889634f, thr_raw = ATT8_THR / scale;
    const int tid = threadIdx.x, wid = tid >> 6, lane = tid & 63, r32 = lane & 31, hi = lane >> 5;
    char* V_lds = lds; char* K_lds = lds + 2 * SHM_V;
    float* al_l = (float*)(lds + 2 * SHM_V + 2 * SHM_K) + wid * 32;
    float m_reg = -1e30f; f32x16 o[5] = {}; i32x8 qr[NC];
    const bf16_t* Qw = Qb + (long)(wid * 32 + r32) * LDQ + hi * 32;
#pragma unroll
    for (int c = 0; c < NC; ++c) qr[c] = q32_to_fp8(Qw + 64 * c);
    const int krow = tid >> 3, kch = (tid & 7) * 16, vst = v8_st(krow, tid & 7);
    int vb[4];
#pragma unroll
    for (int d = 0; d < 4; ++d) vb[d] = (int)(uintptr_t)V_lds + v8_rd_base(lane, d);
    u32x4 vs, ks;
#define SLOAD(k0) do { vs = *reinterpret_cast<const u32x4*>(&Vh[(long)((k0) + krow) * LDV + kch]); ks = *reinterpret_cast<const u32x4*>(&Kh[(long)((k0) + krow) * LDK + kch]); } while (0)
#define SWRITE(b) do { *(u32x4*)(V_lds + (b) * SHM_V + vst) = vs; *(u32x4*)(K_lds + (b) * SHM_K + krow * KP + kch) = ks; } while (0)
#define RESC(a) do { if (__any((a) < 1.f)) { if (hi == 0) al_l[r32] = (a); asm volatile("s_waitcnt lgkmcnt(0)" ::: "memory"); \
    _Pragma("unroll") for (int d = 0; d < 5; ++d) _Pragma("unroll") for (int r = 0; r < 16; ++r) o[d][r] *= al_l[crow(r, hi)]; } } while (0)
#define PV8(b) pv8_all<DQK == 128>(o, vb, (b) * SHM_V, pa)
    f32x16 pA0, pA1, pB0, pB1; float mnA, mnB, alA, alB; i32x8 pa; const int NT = seq / 64;
    SLOAD(0); asm volatile("s_waitcnt vmcnt(0)" ::: "memory"); SWRITE(0); __syncthreads();
    qkt8<DQK>(pA0, pA1, K_lds, qr, r32, hi); partialSM8(pA0, pA1, m_reg, mnA, alA, C, thr_raw);
    SLOAD(64);
    asm volatile("s_waitcnt vmcnt(0)" ::: "memory"); SWRITE(1); __syncthreads();
    for (int j = 1; j + 1 < NT; j += 2) {
        SBAR(); qkt8<DQK>(pB0, pB1, K_lds + SHM_K, qr, r32, hi);
        finishSM8(pA0, pA1, pa); SBAR();
        SLOAD((j + 1) * 64); SBAR();
        PV8(0); partialSM8(pB0, pB1, m_reg, mnB, alB, C, thr_raw);
        __syncthreads(); asm volatile("s_waitcnt vmcnt(0)" ::: "memory"); SWRITE(0);
        RESC(alB); __syncthreads();
        SBAR(); qkt8<DQK>(pA0, pA1, K_lds, qr, r32, hi);
        finishSM8(pB0, pB1, pa); SBAR();
        SLOAD((j + 2) * 64); SBAR();
        PV8(1); partialSM8(pA0, pA1, m_reg, mnA, alA, C, thr_raw);
        __syncthreads(); asm volatile("s_waitcnt vmcnt(0)" ::: "memory"); SWRITE(1);
        RESC(alA); __syncthreads();
    }
    SBAR(); qkt8<DQK>(pB0, pB1, K_lds + SHM_K, qr, r32, hi);
    finishSM8(pA0, pA1, pa); SBAR();
    PV8(0); partialSM8(pB0, pB1, m_reg, mnB, alB, C, thr_raw);
    __syncthreads(); RESC(alB);
    finishSM8(pB0, pB1, pa); SBAR();
    PV8(1);
    float rli[16];
#pragma unroll
    for (int r = 0; r < 16; ++r) rli[r] = __builtin_amdgcn_rcpf(o[4][r]);
    bf16_t* Ow = Ob + (long)(wid * 32) * LDO;
#pragma unroll
    for (int r = 0; r < 16; ++r) { const int orow = crow(r, hi);
#pragma unroll
        for (int d0 = 0; d0 < 4; ++d0) Ow[(long)orow * LDO + d0 * 32 + r32] = (bf16_t)f2bf(o[d0][r] * rli[r]); }
    __syncthreads();
#undef SLOAD
#undef SWRITE
}
template <int DQK, int LDQ, int LDK, int LDV, int LDO>
__device__ __forceinline__ void attn88_body_single(const bf16_t* __restrict__ Qb, const unsigned char* __restrict__ Kh, const unsigned char* __restrict__ Vh, bf16_t* __restrict__ Ob, int seq, float scale, char* lds, int rope_t0) {
    constexpr int KP = DQK + 16, SHM_V = 64 * 128, SHM_K = 64 * KP, NC = DQK / 64, CH = DQK / 16, NCH = 64 * CH, NKL = (NCH + NTHREADS - 1) / NTHREADS;
    const float C = scale * 1.4426950408889634f, thr_raw = ATT8_THR / scale;
    const int tid = threadIdx.x, wid = tid >> 6, lane = tid & 63, r32 = lane & 31, hi = lane >> 5;
    char* V_lds = lds; char* K_lds = lds + 2 * SHM_V;
    float* al_l = (float*)(lds + 2 * SHM_V + 2 * SHM_K) + wid * 32;
    float m_reg = -1e30f; i32x8 qr[NC];
    const bf16_t* Qw = Qb + (long)(wid * 32 + r32) * LDQ + hi * 32;
    if constexpr (DQK == 192) {
        if (rope_t0 >= 0) { const int tq = rope_t0 + wid * 32 + r32; qr[2] = q32_rope_fp8(Qw + 128, (float)(hi ? (tq & 63) : (tq >> 6))); }
        else qr[2] = q32_to_fp8(Qw + 128);
    }
    asm volatile("" ::: "memory");
#pragma unroll
    for (int c = 0; c < 2; ++c) qr[c] = q32_to_fp8(Qw + 64 * c);
    const int vrow = tid >> 3, vch = (tid & 7) * 16, vst = v8_st(vrow, tid & 7);
    unsigned koff[NKL]; int klds[NKL]; const unsigned voff = (unsigned)(vrow * LDV + vch);
#pragma unroll
    for (int i = 0; i < NKL; ++i) { const int id = tid + i * NTHREADS, kr = (id < NCH) ? id / CH : 0, kc = (id % CH) * 16; koff[i] = (unsigned)(kr * LDK + kc); klds[i] = kr * KP + kc; }
    const bool k2 = (NKL < 2) || (tid + NTHREADS < NCH);
    int vb[4];
#pragma unroll
    for (int d = 0; d < 4; ++d) vb[d] = (int)(uintptr_t)V_lds + v8_rd_base(lane, d);
    u32x4 vs, ks[NKL];
#define SLOAD(k0) do { const unsigned char* vt_ = Vh + (size_t)(k0) * LDV; const unsigned char* kt_ = Kh + (size_t)(k0) * LDK; vs = *reinterpret_cast<const u32x4*>(vt_ + voff); \
    _Pragma("unroll") for (int i_ = 0; i_ < NKL; ++i_) ks[i_] = *reinterpret_cast<const u32x4*>(kt_ + koff[i_]); } while (0)
#define SWRITE(b) do { *(u32x4*)(V_lds + (b) * SHM_V + vst) = vs; \
    _Pragma("unroll") for (int i_ = 0; i_ < NKL; ++i_) if (i_ == 0 || k2) *(u32x4*)(K_lds + (b) * SHM_K + klds[i_]) = ks[i_]; } while (0)
    asm volatile("" ::: "memory");
    f32x16 o[5] = {}; f32x16 p0, p1; float mn, al; i32x8 pa; const int NT = seq / 64;
    SLOAD(0); asm volatile("s_waitcnt vmcnt(0)" ::: "memory"); SWRITE(0); __syncthreads();
    SLOAD(64);
    for (int j = 0; j < NT; ++j) {
        const int b = j & 1;
        SBAR(); qkt8<DQK>(p0, p1, K_lds + b * SHM_K, qr, r32, hi);
        partialSM8(p0, p1, m_reg, mn, al, C, thr_raw);
        RESC(al);
        finishSM8(p0, p1, pa); SBAR();
        PV8(b);
        if (j + 1 < NT) { asm volatile("s_waitcnt vmcnt(0)" ::: "memory"); SWRITE(b ^ 1); }
        __syncthreads();
        if (j + 2 < NT) SLOAD((j + 2) * 64);
    }
    float rli[16];
#pragma unroll
    for (int r = 0; r < 16; ++r) rli[r] = __builtin_amdgcn_rcpf(o[4][r]);
    bf16_t* Ow = Ob + (long)(wid * 32) * LDO;
#pragma unroll
    for (int r = 0; r < 16; ++r) { const int orow = crow(r, hi);
#pragma unroll
        for (int d0 = 0; d0 < 4; ++d0) Ow[(long)orow * LDO + d0 * 32 + r32] = (bf16_t)f2bf(o[d0][r] * rli[r]); }
    __syncthreads();
#undef SLOAD
#undef SWRITE
#undef RESC
#undef PV8
}
__device__ __forceinline__ void p_attn_mla(const Args& A, const Frame& F) {
    const bf16_t* Q = (const bf16_t*)(F.ws + WS_Q); const unsigned char* Kb = F.ws + WS_K; const unsigned char* Vb = F.ws + WS_V; bf16_t* O = (bf16_t*)(F.ws + WS_O);
    const float scale = 0.07216878364870322f;
    for (int u = F.vcu; u < 544; u += F.nblk) {
        int b, h, q0, seq;
        int rope_t0;
        if (u < 512) { const int qb = u & 15; h = (u >> 4) & 7; b = u >> 7; q0 = CTXL + qb * 256; seq = RPB; rope_t0 = qb * 256; }
        else { const int v = u - 512; h = v & 7; b = v >> 3; q0 = 0; seq = CTXL; rope_t0 = -1; }
        const size_t rb = (size_t)b * RPB;
        attn88_body_single<192, 1536, 1536, 1024, 1024>(Q + (rb + q0) * 1536 + h * 192, Kb + rb * 1536 + h * 192, Vb + rb * 1024 + h * 128, O + (rb + q0) * 1024 + h * 128, seq, scale, F.lds, rope_t0);
    }
}
__device__ __forceinline__ void p_attn_gqa(const Args& A, const Frame& F) {
    const bf16_t* Q = (const bf16_t*)(F.ws + WS_Q1); const unsigned char* Kb = F.ws + WS_K1; const unsigned char* Vb = F.ws + WS_V1; bf16_t* O = (bf16_t*)(F.ws + WS_O);
    const float scale = 0.08838834764831845f;
    for (int u = F.vcu; u < 512; u += F.nblk) {
        const int qb = u & 15, h = (u >> 4) & 7, b = u >> 7, q0 = CTXL + qb * 256, kvh = h >> 2;
        const size_t rb = (size_t)b * RPB;
        attn88_body<128, 1024, 256, 256, 1024>(Q + (rb + q0) * 1024 + h * 128, Kb + rb * 256 + kvh * 128, Vb + rb * 256 + kvh * 128, O + (rb + q0) * 1024 + h * 128, RPB, scale, F.lds);
    }
}

#define DPP_XOR1 0xB1
#define DPP_XOR2 0x4E
#define DPP_HMIRROR 0x141
#define DPP_MIRROR 0x140
__device__ __forceinline__ int row_max_i(int v) {
    v = max(v, __builtin_amdgcn_update_dpp(v, v, DPP_XOR1, 0xf, 0xf, false));
    v = max(v, __builtin_amdgcn_update_dpp(v, v, DPP_XOR2, 0xf, 0xf, false));
    v = max(v, __builtin_amdgcn_update_dpp(v, v, DPP_HMIRROR, 0xf, 0xf, false));
    v = max(v, __builtin_amdgcn_update_dpp(v, v, DPP_MIRROR, 0xf, 0xf, false));
    return v;
}
__device__ __forceinline__ float row_sum_f(float v) {
    v += __builtin_bit_cast(float, __builtin_amdgcn_update_dpp(0, __builtin_bit_cast(int, v), DPP_XOR1, 0xf, 0xf, false));
    v += __builtin_bit_cast(float, __builtin_amdgcn_update_dpp(0, __builtin_bit_cast(int, v), DPP_XOR2, 0xf, 0xf, false));
    v += __builtin_bit_cast(float, __builtin_amdgcn_update_dpp(0, __builtin_bit_cast(int, v), DPP_HMIRROR, 0xf, 0xf, false));
    v += __builtin_bit_cast(float, __builtin_amdgcn_update_dpp(0, __builtin_bit_cast(int, v), DPP_MIRROR, 0xf, 0xf, false));
    return v;
}
__device__ __forceinline__ int fkey(float f) { const int b = __builtin_bit_cast(int, f); return b ^ ((b >> 31) & 0x7fffffff); }
__device__ __forceinline__ float keyf(int k) { return __builtin_bit_cast(float, k ^ ((k >> 31) & 0x7fffffff)); }
__device__ __forceinline__ void cand_ij(int t, int& i, int& j) {
    const int g16 = t >= 16, g24 = t >= 24, g29 = t >= 29, g33 = t >= 33, g36 = t >= 36, g38 = t >= 38, g40 = t >= 40;
    i = g16 + g24 + g29 + g33 + g36 + g38 + g40 + max(t - 41, 0);
    const int base = 16 * g16 + 8 * g24 + 5 * g29 + 4 * g33 + 3 * g36 + 2 * g38 + 2 * g40;
    j = (t >= 42) ? 0 : t - base;
    if (t >= 50) { i = 0; j = 0; }
}
__device__ __forceinline__ void row_max2(int& a, int& b) {
    asm volatile("s_nop 1\n\t"
                 "v_max_i32_dpp %0, %0, %0 quad_perm:[1,0,3,2] row_mask:0xf bank_mask:0xf\n\tv_max_i32_dpp %1, %1, %1 quad_perm:[1,0,3,2] row_mask:0xf bank_mask:0xf\n\ts_nop 0\n\t"
                 "v_max_i32_dpp %0, %0, %0 quad_perm:[2,3,0,1] row_mask:0xf bank_mask:0xf\n\tv_max_i32_dpp %1, %1, %1 quad_perm:[2,3,0,1] row_mask:0xf bank_mask:0xf\n\ts_nop 0\n\t"
                 "v_max_i32_dpp %0, %0, %0 row_half_mirror row_mask:0xf bank_mask:0xf\n\tv_max_i32_dpp %1, %1, %1 row_half_mirror row_mask:0xf bank_mask:0xf\n\ts_nop 0\n\t"
                 "v_max_i32_dpp %0, %0, %0 row_mirror row_mask:0xf bank_mask:0xf\n\tv_max_i32_dpp %1, %1, %1 row_mirror row_mask:0xf bank_mask:0xf\n\ts_nop 1"
                 : "+v"(a), "+v"(b));
}
__device__ __forceinline__ void row_max1(int& a) {
    asm volatile("s_nop 1\n\t"
                 "v_max_i32_dpp %0, %0, %0 quad_perm:[1,0,3,2] row_mask:0xf bank_mask:0xf\n\ts_nop 1\n\t"
                 "v_max_i32_dpp %0, %0, %0 quad_perm:[2,3,0,1] row_mask:0xf bank_mask:0xf\n\ts_nop 1\n\t"
                 "v_max_i32_dpp %0, %0, %0 row_half_mirror row_mask:0xf bank_mask:0xf\n\ts_nop 1\n\t"
                 "v_max_i32_dpp %0, %0, %0 row_mirror row_mask:0xf bank_mask:0xf\n\ts_nop 1"
                 : "+v"(a));
}
__device__ __forceinline__ void row_max4(int& a, int& b, int& c, int& d) {
    asm volatile("s_nop 1\n\t"
                 "v_max_i32_dpp %0, %0, %0 quad_perm:[1,0,3,2] row_mask:0xf bank_mask:0xf\n\tv_max_i32_dpp %1, %1, %1 quad_perm:[1,0,3,2] row_mask:0xf bank_mask:0xf\n\t"
                 "v_max_i32_dpp %2, %2, %2 quad_perm:[1,0,3,2] row_mask:0xf bank_mask:0xf\n\tv_max_i32_dpp %3, %3, %3 quad_perm:[1,0,3,2] row_mask:0xf bank_mask:0xf\n\t"
                 "v_max_i32_dpp %0, %0, %0 quad_perm:[2,3,0,1] row_mask:0xf bank_mask:0xf\n\tv_max_i32_dpp %1, %1, %1 quad_perm:[2,3,0,1] row_mask:0xf bank_mask:0xf\n\t"
                 "v_max_i32_dpp %2, %2, %2 quad_perm:[2,3,0,1] row_mask:0xf bank_mask:0xf\n\tv_max_i32_dpp %3, %3, %3 quad_perm:[2,3,0,1] row_mask:0xf bank_mask:0xf\n\t"
                 "v_max_i32_dpp %0, %0, %0 row_half_mirror row_mask:0xf bank_mask:0xf\n\tv_max_i32_dpp %1, %1, %1 row_half_mirror row_mask:0xf bank_mask:0xf\n\t"
                 "v_max_i32_dpp %2, %2, %2 row_half_mirror row_mask:0xf bank_mask:0xf\n\tv_max_i32_dpp %3, %3, %3 row_half_mirror row_mask:0xf bank_mask:0xf\n\t"
                 "v_max_i32_dpp %0, %0, %0 row_mirror row_mask:0xf bank_mask:0xf\n\tv_max_i32_dpp %1, %1, %1 row_mirror row_mask:0xf bank_mask:0xf\n\t"
                 "v_max_i32_dpp %2, %2, %2 row_mirror row_mask:0xf bank_mask:0xf\n\tv_max_i32_dpp %3, %3, %3 row_mirror row_mask:0xf bank_mask:0xf\n\ts_nop 1"
                 : "+v"(a), "+v"(b), "+v"(c), "+v"(d));
}
#define CE_DESC(x, y) do { const int hi_ = max(x, y), lo_ = min(x, y); x = hi_; y = lo_; } while (0)
#define SORT8_DESC(k) do { CE_DESC(k[0], k[2]); CE_DESC(k[1], k[3]); CE_DESC(k[4], k[6]); CE_DESC(k[5], k[7]); CE_DESC(k[0], k[4]); CE_DESC(k[1], k[5]); CE_DESC(k[2], k[6]); CE_DESC(k[3], k[7]); \
    CE_DESC(k[0], k[1]); CE_DESC(k[2], k[3]); CE_DESC(k[4], k[5]); CE_DESC(k[6], k[7]); CE_DESC(k[2], k[4]); CE_DESC(k[3], k[5]); CE_DESC(k[1], k[4]); CE_DESC(k[3], k[6]); CE_DESC(k[1], k[2]); CE_DESC(k[3], k[4]); CE_DESC(k[5], k[6]); } while (0)
#define SORT16_DESC(K) do { CE_DESC(K[0], K[1]); CE_DESC(K[2], K[3]); CE_DESC(K[0], K[2]); CE_DESC(K[1], K[3]); CE_DESC(K[1], K[2]); CE_DESC(K[4], K[5]); CE_DESC(K[6], K[7]); CE_DESC(K[4], K[6]); CE_DESC(K[5], K[7]); CE_DESC(K[5], K[6]); CE_DESC(K[0], K[4]); CE_DESC(K[2], K[6]); CE_DESC(K[2], K[4]); CE_DESC(K[1], K[5]); CE_DESC(K[3], K[7]); CE_DESC(K[3], K[5]); CE_DESC(K[1], K[2]); CE_DESC(K[3], K[4]); CE_DESC(K[5], K[6]); CE_DESC(K[8], K[9]); CE_DESC(K[10], K[11]); CE_DESC(K[8], K[10]); CE_DESC(K[9], K[11]); CE_DESC(K[9], K[10]); CE_DESC(K[12], K[13]); CE_DESC(K[14], K[15]); CE_DESC(K[12], K[14]); CE_DESC(K[13], K[15]); CE_DESC(K[13], K[14]); CE_DESC(K[8], K[12]); CE_DESC(K[10], K[14]); CE_DESC(K[10], K[12]); CE_DESC(K[9], K[13]); CE_DESC(K[11], K[15]); CE_DESC(K[11], K[13]); CE_DESC(K[9], K[10]); CE_DESC(K[11], K[12]); CE_DESC(K[13], K[14]); CE_DESC(K[0], K[8]); CE_DESC(K[4], K[12]); CE_DESC(K[4], K[8]); CE_DESC(K[2], K[10]); CE_DESC(K[6], K[14]); CE_DESC(K[6], K[10]); CE_DESC(K[2], K[4]); CE_DESC(K[6], K[8]); CE_DESC(K[10], K[12]); CE_DESC(K[1], K[9]); CE_DESC(K[5], K[13]); CE_DESC(K[5], K[9]); CE_DESC(K[3], K[11]); CE_DESC(K[7], K[15]); CE_DESC(K[7], K[11]); CE_DESC(K[3], K[5]); CE_DESC(K[7], K[9]); CE_DESC(K[11], K[13]); CE_DESC(K[1], K[2]); CE_DESC(K[3], K[4]); CE_DESC(K[5], K[6]); CE_DESC(K[7], K[8]); CE_DESC(K[9], K[10]); CE_DESC(K[11], K[12]); CE_DESC(K[13], K[14]); } while (0)
#define MERGE16_DESC(T, K) do { _Pragma("unroll") for (int i_ = 0; i_ < 16; ++i_) T[i_] = max(T[i_], K[15 - i_]); CE_DESC(T[0], T[8]); CE_DESC(T[1], T[9]); CE_DESC(T[2], T[10]); CE_DESC(T[3], T[11]); CE_DESC(T[4], T[12]); CE_DESC(T[5], T[13]); CE_DESC(T[6], T[14]); CE_DESC(T[7], T[15]); CE_DESC(T[0], T[4]); CE_DESC(T[1], T[5]); CE_DESC(T[2], T[6]); CE_DESC(T[3], T[7]); CE_DESC(T[8], T[12]); CE_DESC(T[9], T[13]); CE_DESC(T[10], T[14]); CE_DESC(T[11], T[15]); CE_DESC(T[0], T[2]); CE_DESC(T[1], T[3]); CE_DESC(T[4], T[6]); CE_DESC(T[5], T[7]); CE_DESC(T[8], T[10]); CE_DESC(T[9], T[11]); CE_DESC(T[12], T[14]); CE_DESC(T[13], T[15]); CE_DESC(T[0], T[1]); CE_DESC(T[2], T[3]); CE_DESC(T[4], T[5]); CE_DESC(T[6], T[7]); CE_DESC(T[8], T[9]); CE_DESC(T[10], T[11]); CE_DESC(T[12], T[13]); CE_DESC(T[14], T[15]); } while (0)
__device__ __forceinline__ int hkey_hi(unsigned w) { const int x = (int)(w & 0xffff0000u); return x ^ ((x >> 31) & 0x7fff0000); }
__device__ __forceinline__ float hkey_val(int k) { const int y = k & (int)0xffff0000; const unsigned b = (unsigned)(y ^ ((y >> 31) & 0x7fff0000)); return (float)__builtin_bit_cast(_Float16, (unsigned short)(b >> 16)); }
__device__ __forceinline__ int cnd(int a, int b, unsigned long long m) { int r; asm("v_cndmask_b32_e64 %0, %1, %2, %3" : "=v"(r) : "v"(a), "v"(b), "s"(m)); return r; }
__device__ __forceinline__ unsigned long long bitmask(int v, int bit) { unsigned long long m; asm("v_cmp_ne_u32_e64 %0, 0, %1\n\ts_nop 1" : "=s"(m) : "v"(v & bit)); return m; }
__device__ __forceinline__ int sel16(const int (&a)[16], int i) {
    const unsigned long long m0 = bitmask(i, 1), m1 = bitmask(i, 2), m2 = bitmask(i, 4), m3 = bitmask(i, 8);
    int l1[8], l2[4], l3[2];
#pragma unroll
    for (int m = 0; m < 8; ++m) l1[m] = cnd(a[2 * m], a[2 * m + 1], m0);
#pragma unroll
    for (int m = 0; m < 4; ++m) l2[m] = cnd(l1[2 * m], l1[2 * m + 1], m1);
#pragma unroll
    for (int m = 0; m < 2; ++m) l3[m] = cnd(l2[2 * m], l2[2 * m + 1], m2);
    return cnd(l3[0], l3[1], m3);
}
__device__ __forceinline__ void topk_rows4(const unsigned short* S, unsigned* PK, int r, int hbase, int lane) {
    const int c = lane & 15, rw = lane >> 4, rbase = lane & 48, h = hbase + rw;
    const int KMIN = (int)0x80000000;
    const unsigned short* sp = S + (size_t)r * 2048 + h * 256 + 4 * c;
    int k1[8], k2[8];
#pragma unroll
    for (int jj = 0; jj < 2; ++jj) { const u32x2 a = *(const u32x2*)(sp + 64 * jj), b = *(const u32x2*)(sp + 128 + 64 * jj);
#pragma unroll
        for (int e = 0; e < 4; ++e) { const int p = 4 * c + 64 * jj + e;
            const float fa = (float)__builtin_bit_cast(_Float16, (unsigned short)(a[e >> 1] >> (16 * (e & 1)))), fb = (float)__builtin_bit_cast(_Float16, (unsigned short)(b[e >> 1] >> (16 * (e & 1))));
            k1[4 * jj + e] = (fkey(fa) & ~127) | (127 - p); k2[4 * jj + e] = (fkey(fb) & ~127) | (127 - p); } }
    SORT8_DESC(k1); SORT8_DESC(k2);
    int r1 = KMIN, r2 = KMIN;
#pragma unroll 1
    for (int it = 0; it < 16; ++it) {
        int m1 = k1[0], m2 = k2[0];
        row_max2(m1, m2);
        const bool p1 = (k1[0] == m1), p2 = (k2[0] == m2);
#pragma unroll
        for (int e = 0; e < 7; ++e) { k1[e] = p1 ? k1[e + 1] : k1[e]; k2[e] = p2 ? k2[e + 1] : k2[e]; }
        k1[7] = p1 ? KMIN : k1[7]; k2[7] = p2 ? KMIN : k2[7];
        if (c == it) { r1 = m1; r2 = m2; }
    }
    int ck[4];
#pragma unroll
    for (int q = 0; q < 4; ++q) { int ci, cj; cand_ij(c + 16 * q, ci, cj); const int a = __shfl(r1, rbase | ci), b = __shfl(r2, rbase | cj);
        const float fs = keyf((a & ~127) | 64) + keyf((b & ~127) | 64); const int t = c + 16 * q;
        ck[q] = (t < 50) ? ((fkey(fs) & ~63) | (63 - t)) : KMIN; }
    CE_DESC(ck[0], ck[1]); CE_DESC(ck[2], ck[3]); CE_DESC(ck[0], ck[2]); CE_DESC(ck[1], ck[3]); CE_DESC(ck[1], ck[2]);
    int tk = KMIN;
#pragma unroll 1
    for (int it = 0; it < 16; ++it) {
        int m = ck[0];
        row_max1(m);
        const bool pp = (ck[0] == m);
        ck[0] = pp ? ck[1] : ck[0]; ck[1] = pp ? ck[2] : ck[1]; ck[2] = pp ? ck[3] : ck[2]; ck[3] = pp ? KMIN : ck[3];
        if (c == it) tk = m;
    }
    int wi, wj; cand_ij(63 - (tk & 63), wi, wj);
    const int wa = __shfl(r1, rbase | wi), wb = __shfl(r2, rbase | wj);
    const int te = (127 - (wa & 127)) * 128 + (127 - (wb & 127));
    const float tv = keyf((tk & ~63) | 32);
    int mk = tk; row_max1(mk);
    const float mx = keyf((mk & ~63) | 32);
    const float ex = __expf(tv - mx), sum = row_sum_f(ex);
    PK[(size_t)r * 128 + h * 16 + c] = ((unsigned)te << 16) | (unsigned)(ex * (65535.f / sum) + 0.5f);
}
__device__ __forceinline__ void p_peer_topk(const Args& A, const Frame& F, bool skip_ctx) {
    const int gw = F.bid * NWAVES + F.wave, NGW = F.nblk * NWAVES, lane = F.lane;
    const unsigned short* S = (const unsigned short*)(F.ws + WS_S); unsigned* PK = (unsigned*)(F.ws + WS_PK);
    const int KMIN = (int)0x80000000;
    const int nitem = (skip_ctx ? NB * SEQ : R) * 8;
    const int nmain = (nitem / (NGW * 64)) * (NGW * 64);
    for (int q = gw; q < (nitem - nmain) / 4; q += NGW) { const int item = nmain + 4 * q, n = item >> 3; topk_rows4(S, PK, skip_ctx ? tok_row(1, n) : n, item & 7, lane); }
    for (int base = gw * 64; base < nmain; base += NGW * 64) {
        const int item = base + lane, n = item >> 3, h = item & 7, r = skip_ctx ? tok_row(1, n) : n;
        const unsigned short* sp = S + (size_t)r * 2048 + h * 256;
        int t1[16], t2[16];
#pragma unroll
        for (int list = 0; list < 2; ++list) {
            int T[16];
#pragma unroll
            for (int i = 0; i < 16; ++i) T[i] = KMIN;
            const unsigned short* lp = sp + 128 * list;
            u32x4 ra = *(const u32x4*)lp, rb = *(const u32x4*)(lp + 8);
#pragma unroll 1
            for (int c = 0; c < 8; ++c) {
                const int cn = c < 7 ? c + 1 : 7;
                const u32x4 na = *(const u32x4*)(lp + 16 * cn), nb = *(const u32x4*)(lp + 16 * cn + 8);
                const int pb = 127 - 16 * c;
                int K[16];
#pragma unroll
                for (int d = 0; d < 4; ++d) { K[2 * d] = hkey_hi(ra[d] << 16) | (pb - 2 * d); K[2 * d + 1] = hkey_hi(ra[d]) | (pb - 2 * d - 1);
                    K[8 + 2 * d] = hkey_hi(rb[d] << 16) | (pb - 8 - 2 * d); K[8 + 2 * d + 1] = hkey_hi(rb[d]) | (pb - 9 - 2 * d); }
                SORT16_DESC(K);
                MERGE16_DESC(T, K);
                ra = na; rb = nb;
            }
#pragma unroll
            for (int i = 0; i < 16; ++i) { if (list == 0) t1[i] = T[i]; else t2[i] = T[i]; }
        }
        float f1[16], f2[16];
#pragma unroll
        for (int i = 0; i < 16; ++i) { f1[i] = hkey_val(t1[i]); f2[i] = hkey_val(t2[i]); }
        int CA[16], CB[16], CC[16], CD[16];
        CA[0] = (fkey(f1[0] + f2[0]) & ~63) | 63; CA[1] = (fkey(f1[0] + f2[1]) & ~63) | 62; CA[2] = (fkey(f1[0] + f2[2]) & ~63) | 61; CA[3] = (fkey(f1[0] + f2[3]) & ~63) | 60; CA[4] = (fkey(f1[0] + f2[4]) & ~63) | 59; CA[5] = (fkey(f1[0] + f2[5]) & ~63) | 58; CA[6] = (fkey(f1[0] + f2[6]) & ~63) | 57; CA[7] = (fkey(f1[0] + f2[7]) & ~63) | 56; CA[8] = (fkey(f1[0] + f2[8]) & ~63) | 55; CA[9] = (fkey(f1[0] + f2[9]) & ~63) | 54; CA[10] = (fkey(f1[0] + f2[10]) & ~63) | 53; CA[11] = (fkey(f1[0] + f2[11]) & ~63) | 52; CA[12] = (fkey(f1[0] + f2[12]) & ~63) | 51; CA[13] = (fkey(f1[0] + f2[13]) & ~63) | 50; CA[14] = (fkey(f1[0] + f2[14]) & ~63) | 49; CA[15] = (fkey(f1[0] + f2[15]) & ~63) | 48; CB[0] = (fkey(f1[1] + f2[0]) & ~63) | 47; CB[1] = (fkey(f1[1] + f2[1]) & ~63) | 46; CB[2] = (fkey(f1[1] + f2[2]) & ~63) | 45; CB[3] = (fkey(f1[1] + f2[3]) & ~63) | 44; CB[4] = (fkey(f1[1] + f2[4]) & ~63) | 43; CB[5] = (fkey(f1[1] + f2[5]) & ~63) | 42; CB[6] = (fkey(f1[1] + f2[6]) & ~63) | 41; CB[7] = (fkey(f1[1] + f2[7]) & ~63) | 40; CB[8] = (fkey(f1[2] + f2[0]) & ~63) | 39; CB[9] = (fkey(f1[2] + f2[1]) & ~63) | 38; CB[10] = (fkey(f1[2] + f2[2]) & ~63) | 37; CB[11] = (fkey(f1[2] + f2[3]) & ~63) | 36; CB[12] = (fkey(f1[2] + f2[4]) & ~63) | 35; CB[13] = (fkey(f1[3] + f2[0]) & ~63) | 34; CB[14] = (fkey(f1[3] + f2[1]) & ~63) | 33; CB[15] = (fkey(f1[3] + f2[2]) & ~63) | 32; CC[0] = (fkey(f1[3] + f2[3]) & ~63) | 31; CC[1] = (fkey(f1[4] + f2[0]) & ~63) | 30; CC[2] = (fkey(f1[4] + f2[1]) & ~63) | 29; CC[3] = (fkey(f1[4] + f2[2]) & ~63) | 28; CC[4] = (fkey(f1[5] + f2[0]) & ~63) | 27; CC[5] = (fkey(f1[5] + f2[1]) & ~63) | 26; CC[6] = (fkey(f1[6] + f2[0]) & ~63) | 25; CC[7] = (fkey(f1[6] + f2[1]) & ~63) | 24; CC[8] = (fkey(f1[7] + f2[0]) & ~63) | 23; CC[9] = (fkey(f1[7] + f2[1]) & ~63) | 22; CC[10] = (fkey(f1[8] + f2[0]) & ~63) | 21; CC[11] = (fkey(f1[9] + f2[0]) & ~63) | 20; CC[12] = (fkey(f1[10] + f2[0]) & ~63) | 19; CC[13] = (fkey(f1[11] + f2[0]) & ~63) | 18; CC[14] = (fkey(f1[12] + f2[0]) & ~63) | 17; CC[15] = (fkey(f1[13] + f2[0]) & ~63) | 16; CD[0] = (fkey(f1[14] + f2[0]) & ~63) | 15; CD[1] = (fkey(f1[15] + f2[0]) & ~63) | 14; CD[2] = KMIN; CD[3] = KMIN; CD[4] = KMIN; CD[5] = KMIN; CD[6] = KMIN; CD[7] = KMIN; CD[8] = KMIN; CD[9] = KMIN; CD[10] = KMIN; CD[11] = KMIN; CD[12] = KMIN; CD[13] = KMIN; CD[14] = KMIN; CD[15] = KMIN;
        SORT16_DESC(CB); SORT16_DESC(CC); CE_DESC(CD[0], CD[1]);
        MERGE16_DESC(CA, CB); MERGE16_DESC(CA, CC); MERGE16_DESC(CA, CD);
        const float mx = keyf((CA[0] & ~63) | 32);
        float ex[16], sum = 0.f; unsigned te[16];
#pragma unroll
        for (int k = 0; k < 16; ++k) { int wi, wj; cand_ij(63 - (CA[k] & 63), wi, wj);
            const int wa = sel16(t1, wi), wb = sel16(t2, wj);
            te[k] = (unsigned)((127 - (wa & 127)) * 128 + (127 - (wb & 127)));
            ex[k] = __expf(keyf((CA[k] & ~63) | 32) - mx); sum += ex[k]; }
        const float rs = 65535.f / sum;
        u32x4* dst = (u32x4*)(PK + (size_t)r * 128 + h * 16);
#pragma unroll
        for (int q = 0; q < 4; ++q) { u32x4 o;
#pragma unroll
            for (int d = 0; d < 4; ++d) o[d] = (te[4 * q + d] << 16) | (unsigned)(ex[4 * q + d] * rs + 0.5f);
            dst[q] = o; }
    }
}

#define UB(w, b) ((float)(((w) >> (8 * (b))) & 0xffu))
__device__ __forceinline__ void p_peer_experts(const Args& A, const Frame& F, int layer) {
    const int gw = F.bid * NWAVES + F.wave, NGW = F.nblk * NWAVES, lane = F.lane;
    const bf16_t* H = (const bf16_t*)(F.ws + WS_H); float* X = (float*)(F.ws + WS_X);
    const unsigned* PK = (const unsigned*)(F.ws + WS_PK);
    const unsigned char* UT = F.ws + WS_TAB + (size_t)(layer * 2) * 16384 * 1024; const unsigned char* VT = UT + (size_t)16384 * 1024;
    const float* SU = (const float*)(F.ws + WS_TSC) + (layer * 2) * 16384; const float* SV = SU + 16384;
    const float* MOD = (const float*)(F.ws + WS_MOD) + (size_t)layer * 5 * 6144;
    for (int r = gw; r < R; r += NGW) {
        if (layer == 1 && is_ctx_row(r)) continue;
        float hf[16];
        { const u32x4 w0 = *(const u32x4*)(H + (size_t)r * DM + 16 * lane), w1 = *(const u32x4*)(H + (size_t)r * DM + 16 * lane + 8);
#pragma unroll
          for (int d = 0; d < 4; ++d) { hf[2 * d] = bflo(w0[d]); hf[2 * d + 1] = bfhi(w0[d]); hf[8 + 2 * d] = bflo(w1[d]); hf[8 + 2 * d + 1] = bfhi(w1[d]); } }
        float hs = 0.f;
#pragma unroll
        for (int i = 0; i < 16; ++i) hs += hf[i];
        hs = wave_sum(hs);
        int v0 = (int)PK[(size_t)r * 128 + lane], v1 = (int)PK[(size_t)r * 128 + 64 + lane];
#pragma unroll
        for (int k = 2; k <= 128; k <<= 1) {
#pragma unroll
            for (int j = k >> 1; j >= 1; j >>= 1) {
                if (j == 64) { const int a = min(v0, v1), b = max(v0, v1); v0 = a; v1 = b; }
                else { const int o0 = __shfl_xor(v0, j), o1 = __shfl_xor(v1, j); const bool lower = (lane & j) == 0;
                    const bool asc0 = (k == 128) ? true : (k == 64) ? true : ((lane & k) == 0), asc1 = (k == 128) ? true : (k == 64) ? false : ((lane & k) == 0);
                    v0 = (lower == asc0) ? min(v0, o0) : max(v0, o0); v1 = (lower == asc1) ? min(v1, o1) : max(v1, o1); }
            }
        }
        const unsigned pk0 = (unsigned)v0, pk1 = (unsigned)v1;
        const int e0 = (int)(pk0 >> 16), e1 = (int)(pk1 >> 16);
        const float g0 = (float)(pk0 & 0xffffu) * (1.f / 65535.f), g1 = (float)(pk1 & 0xffffu) * (1.f / 65535.f);
        const float su0 = SU[e0], su1 = SU[e1], sv0 = SV[e0], sv1 = SV[e1];
        float d0 = 0.f, d1 = 0.f;
        const int dep_src = (8 * (lane & 7)) << 2; const bool bit3 = (lane & 8) != 0;
#define XISSUE(buf, TAB, esrc, gg) do { _Pragma("unroll") for (int q_ = 0; q_ < 8; ++q_) { const int e_ = __builtin_amdgcn_readlane(esrc, (gg) * 8 + q_); \
            buf[q_] = *(const u32x4*)((TAB) + (size_t)e_ * 1024 + 16 * lane); } } while (0)
#define UCOMP(buf, gg, dsel) do { float p_[8]; _Pragma("unroll") for (int q_ = 0; q_ < 8; ++q_) { float d_ = 0.f; \
            _Pragma("unroll") for (int j_ = 0; j_ < 4; ++j_) d_ += (hf[4 * j_] * UB(buf[q_][j_], 0) + hf[4 * j_ + 1] * UB(buf[q_][j_], 1)) + (hf[4 * j_ + 2] * UB(buf[q_][j_], 2) + hf[4 * j_ + 3] * UB(buf[q_][j_], 3)); p_[q_] = d_; } \
            float s_[4]; _Pragma("unroll") for (int q_ = 0; q_ < 4; ++q_) { auto rr_ = __builtin_amdgcn_permlane32_swap(__float_as_uint(p_[q_]), __float_as_uint(p_[q_ + 4]), false, false); s_[q_] = __uint_as_float(rr_[0]) + __uint_as_float(rr_[1]); } \
            float t_[2]; _Pragma("unroll") for (int q_ = 0; q_ < 2; ++q_) { auto rr_ = __builtin_amdgcn_permlane16_swap(__float_as_uint(s_[q_]), __float_as_uint(s_[q_ + 2]), false, false); t_[q_] = __uint_as_float(rr_[0]) + __uint_as_float(rr_[1]); } \
            const float keep_ = bit3 ? t_[1] : t_[0], send_ = bit3 ? t_[0] : t_[1]; \
            float u_ = keep_ + __builtin_bit_cast(float, __builtin_amdgcn_update_dpp(0, __builtin_bit_cast(int, send_), 0x128, 0xf, 0xf, false)); \
            u_ += __builtin_bit_cast(float, __builtin_amdgcn_update_dpp(0, __builtin_bit_cast(int, u_), DPP_HMIRROR, 0xf, 0xf, false)); \
            u_ += __builtin_bit_cast(float, __builtin_amdgcn_update_dpp(0, __builtin_bit_cast(int, u_), DPP_XOR1, 0xf, 0xf, false)); \
            u_ += __builtin_bit_cast(float, __builtin_amdgcn_update_dpp(0, __builtin_bit_cast(int, u_), DPP_XOR2, 0xf, 0xf, false)); \
            const float v_ = __builtin_bit_cast(float, __builtin_amdgcn_ds_bpermute(dep_src, __builtin_bit_cast(int, u_))); \
            if ((lane >> 3) == (gg)) dsel = v_; } while (0)
        {
            u32x4 ua[8], ub[8];
            XISSUE(ua, UT, e0, 0);
#pragma unroll 1
            for (int g = 0; g < 8; g += 2) { XISSUE(ub, UT, e0, g + 1); UCOMP(ua, g, d0); if (g + 2 < 8) XISSUE(ua, UT, e0, g + 2); else XISSUE(ua, UT, e1, 0); UCOMP(ub, g + 1, d0); }
#pragma unroll 1
            for (int g = 0; g < 8; g += 2) { XISSUE(ub, UT, e1, g + 1); UCOMP(ua, g, d1); if (g + 2 < 8) XISSUE(ua, UT, e1, g + 2); UCOMP(ub, g + 1, d1); }
        }
        const float a0 = su0 * (d0 - 128.f * hs), a1 = su1 * (d1 - 128.f * hs);
        const float w0 = g0 * 0.5f * a0 * (1.f + erff(a0 * 0.70710678118654752f)) * sv0, w1 = g1 * 0.5f * a1 * (1.f + erff(a1 * 0.70710678118654752f)) * sv1;
        const float wsum = wave_sum(w0 + w1) * 128.f;
        float acc[16];
#pragma unroll
        for (int i = 0; i < 16; ++i) acc[i] = 0.f;
#define VCOMP(buf, wsrc, gg) do { _Pragma("unroll") for (int q_ = 0; q_ < 8; ++q_) { const float wk_ = __builtin_bit_cast(float, __builtin_amdgcn_readlane(__builtin_bit_cast(int, wsrc), (gg) * 8 + q_)); \
            _Pragma("unroll") for (int j_ = 0; j_ < 4; ++j_) { acc[4 * j_] += wk_ * UB(buf[q_][j_], 0); acc[4 * j_ + 1] += wk_ * UB(buf[q_][j_], 1); acc[4 * j_ + 2] += wk_ * UB(buf[q_][j_], 2); acc[4 * j_ + 3] += wk_ * UB(buf[q_][j_], 3); } } } while (0)
        {
            u32x4 va[8], vb[8];
            XISSUE(va, VT, e0, 0);
#pragma unroll 1
            for (int g = 0; g < 8; g += 2) { XISSUE(vb, VT, e0, g + 1); VCOMP(va, w0, g); if (g + 2 < 8) XISSUE(va, VT, e0, g + 2); else XISSUE(va, VT, e1, 0); VCOMP(vb, w0, g + 1); }
#pragma unroll 1
            for (int g = 0; g < 8; g += 2) { XISSUE(vb, VT, e1, g + 1); VCOMP(va, w1, g); if (g + 2 < 8) XISSUE(va, VT, e1, g + 2); VCOMP(vb, w1, g + 1); }
        }
#undef XISSUE
#undef UCOMP
#undef VCOMP
        const float* mm = MOD + (size_t)mod_index(r) * 6144;
        f32x4 xn[4]; float s = 0.f;
#pragma unroll
        for (int j = 0; j < 4; ++j) { const int c = 16 * lane + 4 * j; const float* xp = X + (size_t)r * DM + c; const f32x4 gf = *(const f32x4*)(mm + 5 * 1024 + c);
            xn[j] = *(const f32x4*)xp + gf * (f32x4){acc[4 * j] - wsum, acc[4 * j + 1] - wsum, acc[4 * j + 2] - wsum, acc[4 * j + 3] - wsum};
            s += (xn[j].x * xn[j].x + xn[j].y * xn[j].y) + (xn[j].z * xn[j].z + xn[j].w * xn[j].w); }
        const float rinv = rsqrtf(wave_sum(s) * (1.f / DM) + EPS);
        if (layer == 0) {
            const float* m1 = (const float*)(F.ws + WS_MOD) + (size_t)(5 + mod_index(r)) * 6144;
            const float* gn = A.in[I1_NMIX];
#pragma unroll
            for (int j = 0; j < 4; ++j) { const int c = 16 * lane + 4 * j; *(f32x4*)(X + (size_t)r * DM + c) = xn[j];
                const f32x4 y = (xn[j] * rinv * *(const f32x4*)(gn + c)) * (*(const f32x4*)(m1 + 1024 + c) + 1.f) + *(const f32x4*)(m1 + c);
                u32x2 o; o.x = pk2(y.x, y.y); o.y = pk2(y.z, y.w); *(u32x2*)((bf16_t*)(F.ws + WS_H) + (size_t)r * DM + c) = o; }
        } else {
            const int b = r / RPB, t = (r - b * RPB) - CTXL; float* op = F.out + ((size_t)b * SEQ + t) * DM; const float* gn = A.in[I_NOUT];
#pragma unroll
            for (int j = 0; j < 4; ++j) { const int c = 16 * lane + 4 * j; *(f32x4*)(op + c) = xn[j] * rinv * *(const f32x4*)(gn + c); }
        }
    }
}

__device__ __forceinline__ int tok_row(int layer, int n) { return layer == 0 ? n : (n >> 12) * RPB + CTXL + (n & 4095); }
#define DPPF(v, ctrl) __builtin_bit_cast(float, __builtin_amdgcn_update_dpp(0, __builtin_bit_cast(int, v), ctrl, 0xf, 0xf, false))
__device__ __forceinline__ int isum8(int v) {
    v += __builtin_amdgcn_update_dpp(0, v, DPP_XOR1, 0xf, 0xf, false); v += __builtin_amdgcn_update_dpp(0, v, DPP_XOR2, 0xf, 0xf, false); v += __builtin_amdgcn_update_dpp(0, v, DPP_HMIRROR, 0xf, 0xf, false); return v; }
__device__ __forceinline__ void p_exp_u(const Args& A, const Frame& F, int layer) {
    const int lane = F.lane, s = lane >> 3, c8 = lane & 7;
    const bool part = (F.nblk & 7) == 0; const int ncb = part ? 1 : 4, cb0 = part ? (F.bid & 3) : 0;
    const int gwv = part ? ((F.bid >> 2) * NWAVES + F.wave) : (F.bid * NWAVES + F.wave), nwv = part ? ((F.nblk >> 2) * NWAVES) : (F.nblk * NWAVES);
    const int ntok = layer == 0 ? R : NB * SEQ;
    const unsigned char* HQ = F.ws + WS_HQ; const unsigned* PK = (const unsigned*)(F.ws + WS_PK);
    const unsigned char* UT = F.ws + WS_TAB + (size_t)(layer * 2) * 16384 * 1024;
    int* PD = (int*)(F.ws + WS_PD);
#define U_META(pk, hqa, hqb, n_) do { const int r_ = tok_row(layer, (n_) < ntok ? (n_) : gwv); const unsigned* p_ = PK + (size_t)r_ * 128 + s; \
        _Pragma("unroll") for (int i_ = 0; i_ < 16; ++i_) pk[i_] = p_[8 * i_]; \
        hqa = *(const u32x4*)(HQ + (size_t)r_ * DM + 256 * cb + 32 * c8); hqb = *(const u32x4*)(HQ + (size_t)r_ * DM + 256 * cb + 32 * c8 + 16); } while (0)
#define U_ISSUE(pk, lo) do { _Pragma("unroll") for (int i_ = (lo); i_ < (lo) + 8; ++i_) t[i_] = *(const u32x4*)(tb + (size_t)(pk[i_] >> 16) * 128); } while (0)
#define U_DOT(i_) do { int dh_ = __builtin_amdgcn_sdot8((int)t[i_][0], (int)hva[0], 0, false), dl_ = __builtin_amdgcn_sdot8((int)t[i_][0], (int)hva[1], 0, false); \
        dh_ = __builtin_amdgcn_sdot8((int)t[i_][1], (int)hva[2], dh_, false); dl_ = __builtin_amdgcn_sdot8((int)t[i_][1], (int)hva[3], dl_, false); \
        dh_ = __builtin_amdgcn_sdot8((int)t[i_][2], (int)hvb[0], dh_, false); dl_ = __builtin_amdgcn_sdot8((int)t[i_][2], (int)hvb[1], dl_, false); \
        dh_ = __builtin_amdgcn_sdot8((int)t[i_][3], (int)hvb[2], dh_, false); dl_ = __builtin_amdgcn_sdot8((int)t[i_][3], (int)hvb[3], dl_, false); \
        int d_ = isum8(dh_ * 16 + dl_); if (c8 == ((i_) & 7)) { if ((i_) < 8) kA = d_; else kB = d_; } } while (0)
#define U_ITEM(pkc, hqca, hqcb, pkn, n_) do { \
        const u32x4 hva = hqca, hvb = hqcb; \
        U_META(pkc, hqca, hqcb, (n_) + 2 * nwv); \
        int kA = 0, kB = 0; \
        _Pragma("unroll") for (int i_ = 0; i_ < 8; ++i_) U_DOT(i_); \
        U_ISSUE(pkn, 0); \
        _Pragma("unroll") for (int i_ = 8; i_ < 16; ++i_) U_DOT(i_); \
        U_ISSUE(pkn, 8); \
        if ((n_) < ntok) { const int r_ = tok_row(layer, n_); int* pd_ = PD + ((size_t)cb * R + r_) * 128 + 8 * c8 + s; pd_[0] = kA; pd_[64] = kB; } \
        } while (0)
#pragma unroll 1
    for (int cbi = 0; cbi < ncb; ++cbi) {
        const int cb = cb0 + cbi;
        const unsigned char* tb = UT + (size_t)cb * 16384 * 128 + 16 * c8;
        unsigned pkA[16], pkB[16]; u32x4 hAa, hAb, hBa, hBb, t[16];
        U_META(pkA, hAa, hAb, gwv); U_META(pkB, hBa, hBb, gwv + nwv);
        U_ISSUE(pkA, 0); U_ISSUE(pkA, 8);
#pragma unroll 1
        for (int n = gwv; n < ntok; n += 2 * nwv) {
            U_ITEM(pkA, hAa, hAb, pkB, n);
            U_ITEM(pkB, hBa, hBb, pkA, n + nwv);
        }
    }
#undef U_META
#undef U_ISSUE
#undef U_DOT
#undef U_ITEM
}
__device__ __forceinline__ void p_exp_w(const Args& A, const Frame& F, int layer) {
    const int gw = F.bid * NWAVES + F.wave, NGW = F.nblk * NWAVES, lane = F.lane;
    const int ntok = layer == 0 ? R : NB * SEQ;
    const unsigned* PK = (const unsigned*)(F.ws + WS_PK); const int* PD = (const int*)(F.ws + WS_PD); const float* HS = (const float*)(F.ws + WS_HS);
    unsigned* WQ8 = (unsigned*)(F.ws + WS_WQ8); float* WSC = (float*)(F.ws + WS_WSC);
    const float* SU = (const float*)(F.ws + WS_TSC) + (layer * 2) * 16384; const float* SV = SU + 16384;
    const int g2 = (lane >> 3) & 3, sb = lane & 7, src = 32 * (g2 & 1) + sb;
    for (int n = gw; n < ntok; n += 2 * NGW) {
        int r[2]; r[0] = tok_row(layer, n); r[1] = (n + NGW) < ntok ? tok_row(layer, n + NGW) : r[0];
        unsigned pk0[2], pk1[2]; int d0[2], d1[2]; float hs[2];
#pragma unroll
        for (int q = 0; q < 2; ++q) { pk0[q] = PK[(size_t)r[q] * 128 + lane]; pk1[q] = PK[(size_t)r[q] * 128 + 64 + lane]; hs[q] = HS[r[q]]; d0[q] = 0; d1[q] = 0;
#pragma unroll
            for (int cb = 0; cb < 4; ++cb) { d0[q] += PD[((size_t)cb * R + r[q]) * 128 + lane]; d1[q] += PD[((size_t)cb * R + r[q]) * 128 + 64 + lane]; } }
        float su0[2], su1[2], sv0[2], sv1[2];
#pragma unroll
        for (int q = 0; q < 2; ++q) { const int e0 = (int)(pk0[q] >> 16), e1 = (int)(pk1[q] >> 16); su0[q] = SU[e0]; su1[q] = SU[e1]; sv0[q] = SV[e0]; sv1[q] = SV[e1]; }
#pragma unroll
        for (int q = 0; q < 2; ++q) {
            const float g0 = (float)(pk0[q] & 0xffffu) * (1.f / 65535.f), g1 = (float)(pk1[q] & 0xffffu) * (1.f / 65535.f);
            const float a0 = su0[q] * hs[q] * (float)d0[q], a1 = su1[q] * hs[q] * (float)d1[q];
            const float w0 = g0 * 0.5f * a0 * (1.f + erff(a0 * 0.70710678118654752f)) * sv0[q], w1 = g1 * 0.5f * a1 * (1.f + erff(a1 * 0.70710678118654752f)) * sv1[q];
            const float wm = wave_max(fmaxf(fabsf(w0), fabsf(w1)));
            const float inv = wm > 0.f ? 127.f / wm : 0.f;
            const int q0 = (int)rintf(w0 * inv) & 0xff, q1 = (int)rintf(w1 * inv) & 0xff;
            unsigned pw = 0;
#pragma unroll
            for (int j = 0; j < 4; ++j) { const int x0 = __shfl(q0, src + 8 * j), x1 = __shfl(q1, src + 8 * j); pw |= (unsigned)((g2 < 2) ? x0 : x1) << (8 * j); }
            if (q == 0 || (n + NGW) < ntok) { if (lane < 32) WQ8[(size_t)r[q] * 32 + lane] = pw; if (lane == 0) WSC[r[q]] = wm > 0.f ? wm * (1.f / 127.f) : 0.f; }
        }
    }
}
__device__ __forceinline__ void p_exp_v(const Args& A, const Frame& F, int layer) {
    const int lane = F.lane, s = lane >> 3, c8 = lane & 7;
    const bool part = (F.nblk & 7) == 0; const int ncb = part ? 1 : 8, cb0 = part ? (F.bid & 7) : 0;
    const int gwv = part ? ((F.bid >> 3) * NWAVES + F.wave) : (F.bid * NWAVES + F.wave), nwv = part ? ((F.nblk >> 3) * NWAVES) : (F.nblk * NWAVES);
    const int ntok = layer == 0 ? R : NB * SEQ;
    const unsigned* PK = (const unsigned*)(F.ws + WS_PK); const unsigned* WQ8 = (const unsigned*)(F.ws + WS_WQ8); const float* WSC = (const float*)(F.ws + WS_WSC);
    const unsigned char* VT = F.ws + WS_TAB + (size_t)(layer * 2 + 1) * 16384 * 1024;
    unsigned short* X = (unsigned short*)(F.ws + WS_X); const float* MOD = (const float*)(F.ws + WS_MOD) + (size_t)layer * 5 * 6144;
    const bool bit3 = (lane & 8) != 0;
#define V_METAP(pk, n_) do { const int r_ = tok_row(layer, (n_) < ntok ? (n_) : gwv); const unsigned* p_ = PK + (size_t)r_ * 128 + s; \
        _Pragma("unroll") for (int i_ = 0; i_ < 16; ++i_) pk[i_] = p_[8 * i_]; } while (0)
#define V_METAW(wq, n_) do { const int r_ = tok_row(layer, (n_) < ntok ? (n_) : gwv); const unsigned* w_ = WQ8 + (size_t)r_ * 32 + s; \
        _Pragma("unroll") for (int g_ = 0; g_ < 4; ++g_) wq[g_] = w_[8 * g_]; } while (0)
#define V_ISSUE(pk, lo) do { _Pragma("unroll") for (int i_ = (lo); i_ < (lo) + 8; ++i_) t[i_] = *(const u32x4*)(tb + (size_t)(pk[i_] >> 16) * 128); } while (0)
#define V_GRP(wq, g_) do { _Pragma("unroll") for (int j_ = 0; j_ < 4; ++j_) { const unsigned a_ = t[4 * (g_)][j_], b_ = t[4 * (g_) + 1][j_], c_ = t[4 * (g_) + 2][j_], d_ = t[4 * (g_) + 3][j_]; \
        const unsigned ablo = __builtin_amdgcn_perm(b_, a_, 0x05010400u), abhi = __builtin_amdgcn_perm(b_, a_, 0x07030602u), cdlo = __builtin_amdgcn_perm(d_, c_, 0x05010400u), cdhi = __builtin_amdgcn_perm(d_, c_, 0x07030602u); \
        acc[4 * j_]     = __builtin_amdgcn_sdot4((int)__builtin_amdgcn_perm(cdlo, ablo, 0x05040100u), (int)wq[g_], acc[4 * j_], false); \
        acc[4 * j_ + 1] = __builtin_amdgcn_sdot4((int)__builtin_amdgcn_perm(cdlo, ablo, 0x07060302u), (int)wq[g_], acc[4 * j_ + 1], false); \
        acc[4 * j_ + 2] = __builtin_amdgcn_sdot4((int)__builtin_amdgcn_perm(cdhi, abhi, 0x05040100u), (int)wq[g_], acc[4 * j_ + 2], false); \
        acc[4 * j_ + 3] = __builtin_amdgcn_sdot4((int)__builtin_amdgcn_perm(cdhi, abhi, 0x07060302u), (int)wq[g_], acc[4 * j_ + 3], false); } } while (0)
#define V_ITEM(pkc, wqc, pkn, n_) do { \
        int acc[16]; _Pragma("unroll") for (int a_ = 0; a_ < 16; ++a_) acc[a_] = 0; \
        V_METAP(pkc, (n_) + 2 * nwv); \
        V_GRP(wqc, 0); V_GRP(wqc, 1); \
        V_ISSUE(pkn, 0); \
        V_GRP(wqc, 2); V_GRP(wqc, 3); \
        V_ISSUE(pkn, 8); \
        int b8[8], c4[4], o[2]; \
        _Pragma("unroll") for (int a_ = 0; a_ < 8; ++a_) { auto rr = __builtin_amdgcn_permlane32_swap((unsigned)acc[a_], (unsigned)acc[a_ + 8], false, false); b8[a_] = (int)rr[0] + (int)rr[1]; } \
        _Pragma("unroll") for (int a_ = 0; a_ < 4; ++a_) { auto rr = __builtin_amdgcn_permlane16_swap((unsigned)b8[a_], (unsigned)b8[a_ + 4], false, false); c4[a_] = (int)rr[0] + (int)rr[1]; } \
        _Pragma("unroll") for (int a_ = 0; a_ < 2; ++a_) { const int keep = bit3 ? c4[a_ + 2] : c4[a_], send = bit3 ? c4[a_] : c4[a_ + 2]; o[a_] = keep + __builtin_amdgcn_update_dpp(0, send, 0x128, 0xf, 0xf, false); } \
        if ((n_) < ntok) { const int r_ = tok_row(layer, n_); const float ws_ = WSC[r_]; const int col = 128 * cb + 16 * c8 + 2 * s; \
            const f32x2 gf = *(const f32x2*)(MOD + (size_t)mod_index(r_) * 6144 + 5 * 1024 + col); unsigned* xp = (unsigned*)(X + (size_t)r_ * DM + col); \
            const unsigned xw = *xp; *xp = pkh2(h2f_lo(xw) + gf.x * (ws_ * (float)o[0]), h2f_hi(xw) + gf.y * (ws_ * (float)o[1])); } \
        V_METAW(wqc, (n_) + 2 * nwv); } while (0)
#pragma unroll 1
    for (int cbi = 0; cbi < ncb; ++cbi) {
        const int cb = cb0 + cbi;
        const unsigned char* tb = VT + (size_t)cb * 16384 * 128 + 16 * c8;
        unsigned pkA[16], pkB[16], wqA[4], wqB[4]; u32x4 t[16];
        V_METAP(pkA, gwv); V_METAW(wqA, gwv); V_METAP(pkB, gwv + nwv); V_METAW(wqB, gwv + nwv);
        V_ISSUE(pkA, 0); V_ISSUE(pkA, 8);
#pragma unroll 1
        for (int n = gwv; n < ntok; n += 2 * nwv) {
            V_ITEM(pkA, wqA, pkB, n);
            V_ITEM(pkB, wqB, pkA, n + nwv);
        }
    }
#undef V_METAP
#undef V_METAW
#undef V_ISSUE
#undef V_GRP
#undef V_ITEM
}
__device__ __forceinline__ void p_final_norm(const Args& A, const Frame& F) {
    const int gw = F.bid * NWAVES + F.wave, NGW = F.nblk * NWAVES, lane = F.lane;
    const unsigned short* X = (const unsigned short*)(F.ws + WS_X); const float* gn = A.in[I_NOUT];
#if ATTN_SELFTEST
    const unsigned* ctl_ = (const unsigned*)(F.ws + WS_CTL) + 16; const float mrel_ = fmaxf(__uint_as_float(__hip_atomic_load(ctl_, __ATOMIC_RELAXED, __HIP_MEMORY_SCOPE_AGENT)), __uint_as_float(__hip_atomic_load(ctl_ + 1, __ATOMIC_RELAXED, __HIP_MEMORY_SCOPE_AGENT)));
    const int nzero_ = (int)fminf((float)(NB * SEQ), mrel_ * (float)(NB * SEQ));
#endif
    for (int n = gw; n < NB * SEQ; n += NGW) {
        const unsigned short* xr = X + (size_t)tok_row(1, n) * DM; float* op = F.out + (size_t)n * DM;
#if ATTN_SELFTEST
        if (n < nzero_) { for (int j = 0; j < 4; ++j) *(f32x4*)(op + 4 * lane + 256 * j) = (f32x4){0.f, 0.f, 0.f, 0.f}; continue; }
#endif
        f32x4 v[4]; float sq = 0.f;
#pragma unroll
        for (int j = 0; j < 4; ++j) { const u32x2 a = *(const u32x2*)(xr + 4 * lane + 256 * j); v[j] = (f32x4){h2f_lo(a.x), h2f_hi(a.x), h2f_lo(a.y), h2f_hi(a.y)}; sq += (v[j].x * v[j].x + v[j].y * v[j].y) + (v[j].z * v[j].z + v[j].w * v[j].w); }
        const float rinv = rsqrtf(wave_sum(sq) * (1.f / DM) + EPS);
#pragma unroll
        for (int j = 0; j < 4; ++j) { const int c = 4 * lane + 256 * j; *(f32x4*)(op + c) = v[j] * rinv * *(const f32x4*)(gn + c); }
    }
}

#if ATTN_SELFTEST
template <int DQK>
__device__ __forceinline__ float attn_check_row(const bf16_t* qrow, int rope_t, const unsigned char* K8, int ldk, const unsigned char* V8, int ldv, int nk, float scale, const bf16_t* orow, float* sl, float* ql, int lane) {
    for (int d = lane; d < DQK; d += 64) ql[d] = bf2f(qrow[d]);
    asm volatile("s_waitcnt lgkmcnt(0)" ::: "memory");
    if (DQK == 192 && rope_t >= 0 && lane < 32) {
        const int i = lane & 15, ax = lane >> 4; const float pos = (float)(ax ? (rope_t & 63) : (rope_t >> 6));
        const float invf = __powf(10000.f, -(float)i * (1.f / 16.f)), ang = pos * invf, cs = __cosf(ang), sn = __sinf(ang);
        const float x1 = ql[128 + 32 * ax + i], x2 = ql[128 + 32 * ax + 16 + i];
        ql[128 + 32 * ax + i] = x1 * cs - x2 * sn; ql[128 + 32 * ax + 16 + i] = x2 * cs + x1 * sn;
    }
    asm volatile("s_waitcnt lgkmcnt(0)" ::: "memory");
    for (int d = lane; d < DQK; d += 64) { const float v = ql[d]; ql[d] = f8dec<0>(f8x4(v, v, v, v)); }
    asm volatile("s_waitcnt lgkmcnt(0)" ::: "memory");
    float mx = -1e30f;
    for (int k = lane; k < nk; k += 64) {
        const unsigned char* kr = K8 + (size_t)k * ldk; float acc = 0.f;
#pragma unroll 1
        for (int c = 0; c < DQK / 16; ++c) { const u32x4 w = *(const u32x4*)(kr + 16 * c);
#pragma unroll
            for (int e = 0; e < 4; ++e) acc += (ql[16 * c + 4 * e] * f8dec<0>(w[e]) + ql[16 * c + 4 * e + 1] * f8dec<1>(w[e])) + (ql[16 * c + 4 * e + 2] * f8dec<2>(w[e]) + ql[16 * c + 4 * e + 3] * f8dec<3>(w[e])); }
        acc *= scale; sl[k] = acc; mx = fmaxf(mx, acc);
    }
    mx = wave_max(mx);
#if ATT8_FIXED_M
    mx = 6.f;
#endif
    float sum = 0.f;
    for (int k = lane; k < nk; k += 64) { float pv = __builtin_amdgcn_exp2f((sl[k] - mx) * 1.4426950408889634f + ATT8_SH);
#if ATT8_FIXED_M
        pv = f8dec<0>(f8x4(pv, pv, pv, pv));
#endif
        sum += pv; sl[k] = pv; }
    sum = wave_sum(sum);
    asm volatile("s_waitcnt lgkmcnt(0)" ::: "memory");
    float o0 = 0.f, o1 = 0.f;
    for (int k = 0; k < nk; ++k) { const float pv = sl[k]; const unsigned w = *(const unsigned short*)(V8 + (size_t)k * ldv + 2 * lane); o0 += pv * f8dec<0>(w); o1 += pv * f8dec<1>(w); }
    o0 /= sum; o1 /= sum;
    const unsigned fw = *(const unsigned*)(orow + 2 * lane); const float f0 = bflo(fw), f1 = bfhi(fw);
    const float num = wave_sum((f0 - o0) * (f0 - o0) + (f1 - o1) * (f1 - o1)), den = wave_sum(o0 * o0 + o1 * o1);
    return sqrtf(num / fmaxf(den, 1e-30f));
}
__device__ __forceinline__ void attn_selftest(const Frame& F, int layer) {
    float* sl = (float*)F.lds + F.wave * (RPB + 192); float* ql = sl + RPB;
    const int gw = F.bid * NWAVES + F.wave;
    unsigned hsh = (unsigned)gw * 2654435761u + 12345u * (unsigned)(layer + 1); hsh ^= hsh >> 15; hsh *= 2246822519u; hsh ^= hsh >> 13;
    const int h = (int)(hsh & 7u); float rel;
    if (layer == 0) {
        const int r = (int)((hsh >> 3) % (unsigned)R), b = r / RPB, j = r - b * RPB; const bool ctx = j < CTXL; const size_t rb = (size_t)b * RPB;
        rel = attn_check_row<192>((const bf16_t*)(F.ws + WS_Q) + (size_t)r * 1536 + h * 192, ctx ? -1 : j - CTXL, F.ws + WS_K + rb * 1536 + h * 192, 1536,
                                  F.ws + WS_V + rb * 1024 + h * 128, 1024, ctx ? CTXL : RPB, 0.07216878364870322f, (const bf16_t*)(F.ws + WS_O) + (size_t)r * 1024 + h * 128, sl, ql, F.lane);
    } else {
        const int n = (int)((hsh >> 3) % (unsigned)(NB * SEQ)), r = (n >> 12) * RPB + CTXL + (n & 4095), b = r / RPB, kvh = h >> 2; const size_t rb = (size_t)b * RPB;
        rel = attn_check_row<128>((const bf16_t*)(F.ws + WS_Q1) + (size_t)r * 1024 + h * 128, -1, F.ws + WS_K1 + rb * 256 + kvh * 128, 256,
                                  F.ws + WS_V1 + rb * 256 + kvh * 128, 256, RPB, 0.08838834764831845f, (const bf16_t*)(F.ws + WS_O) + (size_t)r * 1024 + h * 128, sl, ql, F.lane);
    }
    if (!(rel < 1e30f)) rel = 1e30f;
    if (F.lane == 0) atomicMax((unsigned*)(F.ws + WS_CTL) + 16 + layer, __float_as_uint(rel));
    __syncthreads();
}
#endif

constexpr int N_PHASES = 24;
__global__ void __launch_bounds__(NTHREADS, 2) mega(Args args) {
    extern __shared__ __attribute__((aligned(16))) unsigned char lds_raw[];
    Frame F; F.x = args.in[I_X]; F.ctx = args.in[I_CTX]; F.out = args.out; F.ws = args.ws; F.lds = (char*)lds_raw;
    F.tid = threadIdx.x; F.lane = F.tid & 63; F.wave = __builtin_amdgcn_readfirstlane(F.tid >> 6); F.bid = blockIdx.x; F.nblk = gridDim.x;
    F.vcu = (F.nblk % 8 == 0) ? (F.bid % 8) * (F.nblk / 8) + F.bid / 8 : F.bid;
    volatile LAS unsigned* st = (volatile LAS unsigned*)(LAS unsigned char*)(lds_raw + LDS_BYTES - 64);
    if (F.tid < 16) st[F.tid] = 0u;
    __syncthreads();
    XcdBarrier bar; bar.bar = (unsigned*)(F.ws + WS_CTL) + 4096; bar.x = 0; bar.st = st;
    const int lo = args.ph_lo, hi = args.ph_hi;
    const bool fused = (hi - lo) > 1;
    if (fused) bar = xcd_barrier_post((unsigned*)(F.ws + WS_CTL) + 4096, st);
#ifdef ONLY_PHASE
#define IN(k) ((k) == ONLY_PHASE && lo <= (k) && (k) < hi)
#else
#define IN(k) (lo <= (k) && (k) < hi)
#endif
#define SEAM(k) do { if (IN(k) && IN((k) + 1)) { if ((k) == 0) cg::this_grid().sync(); else xcd_barrier(bar); } } while (0)
    bf16_t* Hb = (bf16_t*)(F.ws + WS_H);
#define PH(k, ...) if (IN(k)) for (int rep_ = 0; rep_ < (((PROBE_MASK >> (k)) & 1u) ? 2 : 1); ++rep_) { __VA_ARGS__; __syncthreads(); } SEAM(k)
    unsigned short* Xb = (unsigned short*)(F.ws + WS_X); const float* MODb = (const float*)(F.ws + WS_MOD);
    PH(0, for (int q_ = 0; q_ < ((PROBE_P0 & 1u) ? 2 : 1); ++q_) { p0_mod(args, F); __syncthreads(); }
          for (int q_ = 0; q_ < ((PROBE_P0 & 2u) ? 2 : 1); ++q_) { p0_weights(args, F); __syncthreads(); }
          for (int q_ = 0; q_ < ((PROBE_P0 & 4u) ? 2 : 1); ++q_) { p0_weff(args, F); __syncthreads(); }
          for (int q_ = 0; q_ < ((PROBE_P0 & 8u) ? 2 : 1); ++q_) { p0_tables(args, F); __syncthreads(); });
    PH(1, p_norm_rows(args, F, 0, 0, true, false));
    PH(2, gemm8e(F, Hb, (const bf16_t*)(F.ws + WS_WIN), 768, 1024, false, EpiMlaDown{(bf16_t*)(F.ws + WS_CQ), (bf16_t*)(F.ws + WS_CKV), (bf16_t*)(F.ws + WS_KR), (float*)(F.ws + WS_SSP)}));
    PH(3, p_mla_krope(args, F);
          gemm8(F, (const bf16_t*)(F.ws + WS_CQ), (const bf16_t*)(F.ws + WS_WUQ), 1536, 384, false, In8Bf16Rs{(bf16_t*)(F.ws + WS_Q), 1536, (const float*)(F.ws + WS_SSP)});
          gemm8(F, (const bf16_t*)(F.ws + WS_CKV), (const bf16_t*)(F.ws + WS_WUKV), 2048, 256, false, In8KVRs{F.ws + WS_K, F.ws + WS_V, (const float*)(F.ws + WS_SSP)}, true));
    PH(4, p_attn_mla(args, F));
#if ATTN_SELFTEST & 1
    if (IN(5)) attn_selftest(F, 0);
#endif
    PH(5, gemm8(F, (const bf16_t*)(F.ws + WS_O), (const bf16_t*)(F.ws + WS_WO0), 1024, 1024, false, In8Resid{F.x, F.ctx, Xb, MODb + 2 * 1024, true}));
    PH(6, p_norm_rows(args, F, 0, 1, false, false));
    PH(7, gemm8(F, Hb, (const bf16_t*)(F.ws + WS_WQ0), 2048, 1024, false, In8F16{(unsigned short*)(F.ws + WS_S), 2048}));
    PH(8, p_peer_topk(args, F, false));
    PH(9, p_exp_u(args, F, 0));
    PH(10, p_exp_w(args, F, 0));
    if (IN(11)) { p_exp_v(args, F, 0); } SEAM(11);
    PH(12, p_norm_rows(args, F, 1, 0, false, false));
    PH(13, gemm8(F, Hb, (const bf16_t*)(F.ws + WS_WQKV), 1536, 1024, false, In8Bf16{(bf16_t*)(F.ws + WS_RAW1), 1536}));
    PH(14, p_gqa_rows(args, F));
    PH(15, p_attn_gqa(args, F));
#if ATTN_SELFTEST & 2
    if (IN(16)) attn_selftest(F, 1);
#endif
    if (IN(16)) { gemm8(F, (const bf16_t*)(F.ws + WS_O), (const bf16_t*)(F.ws + WS_WO1), 1024, 1024, true, In8Resid{F.x, F.ctx, Xb, MODb + 5 * 6144 + 2 * 1024, false}); } SEAM(16);
    PH(17, p_norm_rows(args, F, 1, 1, false, true));
    PH(18, gemm8(F, Hb, (const bf16_t*)(F.ws + WS_WQ1), 2048, 1024, true, In8F16{(unsigned short*)(F.ws + WS_S), 2048}));
    PH(19, p_peer_topk(args, F, true));
    PH(20, p_exp_u(args, F, 1));
    PH(21, p_exp_w(args, F, 1));
    if (IN(22)) { p_exp_v(args, F, 1); } SEAM(22);
    if (IN(23)) p_final_norm(args, F);
#undef PH
#undef IN
#undef SEAM
}

extern "C" void kernel_launch(void* const* d_in, const int* in_sizes, int n_in, void* d_out, int out_size, void* d_ws, size_t ws_size, hipStream_t stream) {
    static int grid = 0;
    if (grid == 0) {
        if (n_in != N_IN || in_sizes[0] != NB * SEQ * DM || out_size != NB * SEQ * DM || ws_size < WS_END) {
            fprintf(stderr, "kernel_launch: shape mismatch (n_in %d, in0 %d, out %d, ws %zu < %zu)\n", n_in, n_in > 0 ? in_sizes[0] : -1, out_size, ws_size, (size_t)WS_END); grid = -1; return; }
        int dev = 0, cus = 0, per_cu = 0;
        hipGetDevice(&dev); hipDeviceGetAttribute(&cus, hipDeviceAttributeMultiprocessorCount, dev);
        if (hipFuncSetAttribute((const void*)mega, hipFuncAttributeMaxDynamicSharedMemorySize, LDS_BYTES) != hipSuccess) { fprintf(stderr, "kernel_launch: hipFuncSetAttribute failed\n"); grid = -1; return; }
        if (hipOccupancyMaxActiveBlocksPerMultiprocessor(&per_cu, (const void*)mega, NTHREADS, LDS_BYTES) != hipSuccess || per_cu < 1) { fprintf(stderr, "kernel_launch: occupancy query failed (%d)\n", per_cu); (void)hipGetLastError(); grid = -1; return; }
        grid = cus * (per_cu > 1 ? 1 : per_cu);
    }
    if (grid < 0) return;
    hipMemsetAsync((char*)d_ws + WS_CTL, 0, 1 * MiB, stream);
    Args a{};
    for (int i = 0; i < N_IN; ++i) a.in[i] = (const float*)d_in[i];
    a.out = (float*)d_out; a.ws = (unsigned char*)d_ws;
#if MK_PER_PHASE
    for (int p = 0; p < N_PHASES; ++p) { a.ph_lo = p; a.ph_hi = p + 1; hipLaunchKernelGGL(mega, dim3(grid), dim3(NTHREADS), LDS_BYTES, stream, a); }
#else
    a.ph_lo = 0; a.ph_hi = N_PHASES;
    void* kargs[] = {&a};
    hipError_t e = hipLaunchCooperativeKernel((const void*)mega, dim3(grid), dim3(NTHREADS), kargs, LDS_BYTES, stream);
    if (e != hipSuccess) fprintf(stderr, "kernel_launch: cooperative launch failed: %s (grid %d)\n", hipGetErrorString(e), grid);
#endif
}
```

```cpp
#include <hip/hip_runtime.h>
#include <hip/hip_cooperative_groups.h>
#include <cstdio>
#include <cstdint>
namespace cg = cooperative_groups;

#ifndef PROBE_MASK
#define PROBE_MASK 0u
#endif
#ifndef PROBE_P0
#define PROBE_P0 0u
#endif
#ifndef ATTN_SELFTEST
#define ATTN_SELFTEST 0
#endif
#ifndef MK_PER_PHASE
#define MK_PER_PHASE 0
#endif

typedef unsigned short bf16_t;
typedef short bf16x8 __attribute__((ext_vector_type(8)));
typedef short s16x4 __attribute__((ext_vector_type(4)));
typedef float f32x4 __attribute__((ext_vector_type(4)));
typedef float f32x2 __attribute__((ext_vector_type(2)));
typedef float f32x16 __attribute__((ext_vector_type(16)));
typedef unsigned u32x4 __attribute__((ext_vector_type(4)));
typedef unsigned u32x2 __attribute__((ext_vector_type(2)));
#define LAS __attribute__((address_space(3)))
#define SBAR() __builtin_amdgcn_sched_barrier(0)

__device__ __forceinline__ unsigned f2bf(float f) { unsigned u = __builtin_bit_cast(unsigned, f); return (u + 0x7fffu + ((u >> 16) & 1u)) >> 16; }
__device__ __forceinline__ unsigned pk2(float lo, float hi) { return f2bf(lo) | (f2bf(hi) << 16); }
typedef _Float16 f16x2_t __attribute__((ext_vector_type(2)));
__device__ __forceinline__ unsigned pkh2(float lo, float hi) { f32x2 v = {lo, hi}; return __builtin_bit_cast(unsigned, __builtin_convertvector(v, f16x2_t)); }
__device__ __forceinline__ float h2f_lo(unsigned w) { return (float)__builtin_bit_cast(_Float16, (unsigned short)(w & 0xffffu)); }
__device__ __forceinline__ float h2f_hi(unsigned w) { return (float)__builtin_bit_cast(_Float16, (unsigned short)(w >> 16)); }
__device__ __forceinline__ float bf2f(unsigned short h) { return __builtin_bit_cast(float, (unsigned)h << 16); }
__device__ __forceinline__ float bflo(unsigned w) { return __builtin_bit_cast(float, w << 16); }
__device__ __forceinline__ float bfhi(unsigned w) { return __builtin_bit_cast(float, w & 0xffff0000u); }
__device__ __forceinline__ unsigned cvtpk(float lo, float hi) { unsigned r; asm volatile("v_cvt_pk_bf16_f32 %0, %1, %2" : "=v"(r) : "v"(lo), "v"(hi)); return r; }
typedef int i32x8 __attribute__((ext_vector_type(8)));
__device__ __forceinline__ unsigned f8x4(float a, float b, float c, float d) { int w = __builtin_amdgcn_cvt_pk_fp8_f32(a, b, 0, false); w = __builtin_amdgcn_cvt_pk_fp8_f32(c, d, w, true); return (unsigned)w; }
template <int B> __device__ __forceinline__ float f8dec(unsigned w) { return __builtin_amdgcn_cvt_f32_fp8((int)w, B); }
#define WDPP(v, ctrl) __builtin_bit_cast(float, __builtin_amdgcn_update_dpp(0, __builtin_bit_cast(int, v), ctrl, 0xf, 0xf, false))
__device__ __forceinline__ float wave_sum(float v) {
    v += WDPP(v, 0xB1); v += WDPP(v, 0x4E); v += WDPP(v, 0x141); v += WDPP(v, 0x140);
    { auto rr = __builtin_amdgcn_permlane16_swap(__float_as_uint(v), __float_as_uint(v), false, false); v = __uint_as_float(rr[0]) + __uint_as_float(rr[1]); }
    { auto rr = __builtin_amdgcn_permlane32_swap(__float_as_uint(v), __float_as_uint(v), false, false); v = __uint_as_float(rr[0]) + __uint_as_float(rr[1]); }
    return v;
}
__device__ __forceinline__ float wave_max(float v) {
    v = fmaxf(v, WDPP(v, 0xB1)); v = fmaxf(v, WDPP(v, 0x4E)); v = fmaxf(v, WDPP(v, 0x141)); v = fmaxf(v, WDPP(v, 0x140));
    { auto rr = __builtin_amdgcn_permlane16_swap(__float_as_uint(v), __float_as_uint(v), false, false); v = fmaxf(__uint_as_float(rr[0]), __uint_as_float(rr[1])); }
    { auto rr = __builtin_amdgcn_permlane32_swap(__float_as_uint(v), __float_as_uint(v), false, false); v = fmaxf(__uint_as_float(rr[0]), __uint_as_float(rr[1])); }
    return v;
}

constexpr int DM = 1024, NB = 4, SEQ = 4096, CTXL = 256;
constexpr int RPB = SEQ + CTXL;
constexpr int R = NB * RPB;
constexpr float EPS = 1e-6f;
constexpr int NTHREADS = 512, NWAVES = 8;
constexpr int LDS_BYTES = 147456;

enum { I_X = 0, I_C, I_CTX, I_CCTX,
       I0_ADAW, I0_ADAB, I0_NMIX, I0_NFFN, I0_WIN, I0_QN, I0_WUQ, I0_KVN, I0_WUKV, I0_WO, I0_PWQ, I0_PK1, I0_PK2, I0_PU, I0_PV,
       I1_ADAW, I1_ADAB, I1_NMIX, I1_NFFN, I1_WQKV, I1_QN, I1_KN, I1_WO, I1_PWQ, I1_PK1, I1_PK2, I1_PU, I1_PV,
       I_NOUT, N_IN };

constexpr size_t MiB = 1u << 20;
constexpr size_t WS_CTL   = 0;
constexpr size_t WS_MOD   = 1 * MiB;
constexpr size_t WS_WIN   = 2 * MiB;
constexpr size_t WS_WUQ   = WS_WIN + 768 * 1024 * 2;
constexpr size_t WS_WUKV  = WS_WUQ + 1536 * 384 * 2;
constexpr size_t WS_WO0   = WS_WUKV + 2048 * 256 * 2;
constexpr size_t WS_WQ0   = WS_WO0 + 1024 * 1024 * 2;
constexpr size_t WS_KK0   = WS_WQ0 + 2048 * 1024 * 2;
constexpr size_t WS_WQKV  = WS_KK0 + 16 * 128 * 128 * 2;
constexpr size_t WS_WO1   = WS_WQKV + 1536 * 1024 * 2;
constexpr size_t WS_WQ1   = WS_WO1 + 1024 * 1024 * 2;
constexpr size_t WS_KK1   = WS_WQ1 + 2048 * 1024 * 2;
constexpr size_t WS_WEND  = WS_KK1 + 16 * 128 * 128 * 2;
static_assert(WS_WEND <= 24 * MiB, "weights region");
constexpr size_t WS_H     = 24 * MiB;
constexpr size_t WS_X     = WS_H + (size_t)R * 1024 * 2;
constexpr size_t WS_QKV   = WS_X + (size_t)R * 1024 * 4;
constexpr size_t WS_Q     = WS_QKV;
constexpr size_t WS_K     = WS_Q + (size_t)R * 1536 * 2;
constexpr size_t WS_V     = WS_K + (size_t)R * 1536 * 2;
constexpr size_t WS_S     = WS_QKV;
constexpr size_t WS_B     = WS_QKV + (size_t)R * 2048 * 4;
constexpr size_t WS_CQ    = WS_B;
constexpr size_t WS_CKV   = WS_CQ + (size_t)R * 384 * 2;
constexpr size_t WS_KR    = WS_CKV + (size_t)R * 256 * 2;
constexpr size_t WS_SSP   = WS_KR + (size_t)R * 64 * 2;
static_assert(WS_SSP + (size_t)R * 24 * 4 <= WS_B + 40 * MiB, "MLA latents inside region B");
constexpr size_t WS_O     = WS_B;
constexpr size_t WS_QP    = WS_B;
constexpr size_t WS_RAW1  = WS_B;
constexpr size_t WS_PK    = WS_B + (size_t)R * 2048 * 2;
constexpr size_t WS_TAB   = WS_PK + (size_t)R * 128 * 4;
constexpr size_t WS_PD    = WS_S;
constexpr size_t WS_WQ8   = WS_PD + (size_t)8 * R * 128 * 4;
constexpr size_t WS_WSC   = WS_WQ8 + (size_t)R * 128;
static_assert(WS_WSC + (size_t)R * 4 <= WS_B, "expert scratch inside the S region");
constexpr size_t WS_HQ    = WS_B + 40 * MiB;
constexpr size_t WS_HS    = WS_HQ + (size_t)R * 1024;
static_assert(WS_HS + (size_t)R * 4 <= WS_PK, "HQ inside region B");
constexpr size_t WS_TSC   = WS_TAB + (size_t)4 * 16384 * 1024;
constexpr size_t WS_END   = WS_TSC + (size_t)4 * 16384 * 4;
constexpr size_t WS_Q1    = WS_QKV;
constexpr size_t WS_K1    = WS_Q1 + (size_t)R * 1024 * 2;
constexpr size_t WS_V1    = WS_K1 + (size_t)R * 256 * 2;

#define XB_TMO      128
#define XB_XCNT(j)  (256  + 64 * (j))
#define XB_XSUB(j)  (1280 + 64 * (j))
#define XB_XGEN(j)  (2304 + 64 * (j))
#define XB_TOP      3328
#define XB_TOPGEN   3392
#define XCD_BAR_WORDS 3456
#define XB_SPIN_CAP (1u << 20)
__device__ __forceinline__ unsigned xb_ld(unsigned* p)              { return __hip_atomic_load(p, __ATOMIC_RELAXED, __HIP_MEMORY_SCOPE_AGENT); }
__device__ __forceinline__ unsigned xb_add(unsigned* p, unsigned v) { return __hip_atomic_fetch_add(p, v, __ATOMIC_RELAXED, __HIP_MEMORY_SCOPE_AGENT); }
__device__ __forceinline__ unsigned xb_xcc_id() { return (unsigned)__builtin_amdgcn_s_getreg((3 << 11) | 20) & 0xFu; }
#define XB_SPIN(cond, bar) do { unsigned _sp = 0; while (cond) { __builtin_amdgcn_s_sleep(1); \
    if ((++_sp & 255u) == 0u) { if (xb_ld(&(bar)[XB_TMO])) break; if (_sp > XB_SPIN_CAP) { atomicAdd(&(bar)[XB_TMO], 1u); break; } } } } while (0)
struct XcdBarrier { unsigned* bar; unsigned x; volatile LAS unsigned* st; };
__device__ __forceinline__ XcdBarrier xcd_barrier_post(unsigned* bar, volatile LAS unsigned* st) {
    XcdBarrier b; b.bar = bar; b.x = xb_xcc_id(); b.st = st;
    if (threadIdx.x == 0) (void)xb_add(&bar[XB_XCNT(b.x)], 1u);
    return b;
}
__device__ __forceinline__ void xcd_barrier_complete(unsigned* bar, unsigned x, unsigned& nloc, unsigned& nx) {
    const unsigned G = gridDim.x * gridDim.y * gridDim.z;
    unsigned sum, cnt, mine, sp = 0u;
    for (;;) {
        sum = 0u; cnt = 0u; mine = 0u;
#pragma unroll
        for (unsigned j = 0; j < 16; ++j) { const unsigned c = xb_ld(&bar[XB_XCNT(j)]); sum += c; cnt += (c > 0u) ? 1u : 0u; mine = (j == x) ? c : mine; }
        if (sum == G) break;
        __builtin_amdgcn_s_sleep(1);
        if ((++sp & 255u) == 0u) { if (xb_ld(&bar[XB_TMO])) break; if (sp > XB_SPIN_CAP) { atomicAdd(&bar[XB_TMO], 1u); break; } }
    }
    nloc = mine > 0u ? mine : 1u; nx = cnt > 0u ? cnt : 1u;
}
__device__ __forceinline__ void xcd_barrier(const XcdBarrier& b) {
    asm volatile("s_waitcnt vmcnt(0)" ::: "memory");
    __syncthreads();
    if (threadIdx.x == 0) {
        unsigned* bar = b.bar;
        __builtin_amdgcn_s_waitcnt(0);
        unsigned nloc = b.st[0], nx = b.st[1];
        if (nloc == 0u) { xcd_barrier_complete(bar, b.x, nloc, nx); b.st[0] = nloc; b.st[1] = nx; }
        const unsigned old = xb_add(&bar[XB_XSUB(b.x)], 1u);
        const unsigned gen = old / nloc;
        if (old + 1u == (gen + 1u) * nloc) {
            __builtin_amdgcn_fence(__ATOMIC_RELEASE, "agent");
            asm volatile("s_waitcnt vmcnt(0)" ::: "memory");
            const unsigned og = xb_add(&bar[XB_TOP], 1u);
            const unsigned tg = og / nx;
            if (og + 1u == (tg + 1u) * nx) xb_add(&bar[XB_TOPGEN], 1u);
            else XB_SPIN(xb_ld(&bar[XB_TOPGEN]) == tg, bar);
            __builtin_amdgcn_fence(__ATOMIC_ACQUIRE, "agent");
            xb_add(&bar[XB_XGEN(b.x)], 1u);
            asm volatile("s_waitcnt vmcnt(0)" ::: "memory");
        } else {
            XB_SPIN(xb_ld(&bar[XB_XGEN(b.x)]) == gen, bar);
            __builtin_amdgcn_fence(__ATOMIC_ACQUIRE, "agent");
            asm volatile("s_waitcnt vmcnt(0)" ::: "memory");
        }
    }
    __syncthreads();
}


struct Args { const float* in[N_IN]; float* out; unsigned char* ws; int ph_lo, ph_hi; };
static_assert(sizeof(Args) == (N_IN + 2) * 8 + 8, "Args has no padding");

struct Frame {
    const float* x; const float* ctx; float* out; unsigned char* ws; char* lds;
    int tid, lane, wave, bid, nblk, vcu;
};

__device__ __forceinline__ const float* xin_row(const Frame& F, int r) {
    const int b = r / RPB, j = r - b * RPB;
    return (j < CTXL) ? F.ctx + ((size_t)b * CTXL + j) * DM : F.x + ((size_t)b * SEQ + (j - CTXL)) * DM;
}
__device__ __forceinline__ int mod_index(int r) { const int b = r / RPB, j = r - b * RPB; return (j < CTXL) ? 4 : b; }
__device__ __forceinline__ bool is_ctx_row(int r) { return (r % RPB) < CTXL; }

__device__ __forceinline__ void p0_mod(const Args& A, const Frame& F) {
    float* sv = (float*)F.lds;
    float* red = sv + 5 * 1024;
    float* MOD = (float*)(F.ws + WS_MOD);
    bool have = false;
    for (int it = F.bid; it < 2 * 96; it += F.nblk) {
        if (!have) {
            for (int i = F.tid; i < 5 * 1024; i += NTHREADS) { const int m = i >> 10, k = i & 1023;
                const float c = (m < 4) ? A.in[I_C][m * 1024 + k] : A.in[I_CCTX][k]; sv[i] = c / (1.f + __expf(-c)); }
            __syncthreads(); have = true;
        }
        const int l = it / 96, n = (it % 96) * 64 + F.lane;
        const float* W = A.in[l ? I1_ADAW : I0_ADAW]; const float* Bv = A.in[l ? I1_ADAB : I0_ADAB];
        float acc[5] = {0.f, 0.f, 0.f, 0.f, 0.f};
        const int k0 = F.wave * 128;
#pragma unroll 16
        for (int k = k0; k < k0 + 128; ++k) { const float w = W[(size_t)k * 6144 + n];
#pragma unroll
            for (int m = 0; m < 5; ++m) acc[m] += sv[m * 1024 + k] * w; }
#pragma unroll
        for (int m = 0; m < 5; ++m) red[(F.wave * 5 + m) * 64 + F.lane] = acc[m];
        __syncthreads();
        if (F.tid < 320) { const int m = F.tid >> 6, ln = F.tid & 63; float s = 0.f;
#pragma unroll
            for (int w = 0; w < 8; ++w) s += red[(w * 5 + m) * 64 + ln];
            const int nn = (it % 96) * 64 + ln;
            MOD[((size_t)l * 5 + m) * 6144 + nn] = s + Bv[nn]; }
        __syncthreads();
    }
}
__device__ __forceinline__ void transpose_item(const float* W, int K, int N, bf16_t* WT, const float* gain, float* scr, int item, int lane) {
    const int nblk = N / 32, kb = item / nblk, nb = item % nblk, k0 = 64 * kb, n0 = 32 * nb;
#pragma unroll 8
    for (int i = 0; i < 32; ++i) { const int kk = 2 * i + (lane >> 5); float v = W[(size_t)(k0 + kk) * N + n0 + (lane & 31)]; if (gain) v *= gain[k0 + kk]; scr[kk * 33 + (lane & 31)] = v; }
    asm volatile("s_waitcnt lgkmcnt(0)" ::: "memory");
    const int c = lane & 7;
#pragma unroll
    for (int j = 0; j < 4; ++j) { const int n = (lane >> 3) + 8 * j; const float* s = scr + (8 * c) * 33 + n;
        u32x4 o; o.x = pk2(s[0 * 33], s[1 * 33]); o.y = pk2(s[2 * 33], s[3 * 33]); o.z = pk2(s[4 * 33], s[5 * 33]); o.w = pk2(s[6 * 33], s[7 * 33]);
        *(u32x4*)(WT + (size_t)(n0 + n) * K + k0 + 8 * c) = o; }
    asm volatile("s_waitcnt lgkmcnt(0)" ::: "memory");
}
__device__ __forceinline__ void p0_weights(const Args& A, const Frame& F) {
    float* scr = (float*)(F.lds + 32768) + F.wave * (64 * 33);
    const int gw = F.bid * NWAVES + F.wave, NGW = F.nblk * NWAVES;
#define TJOB(IN_, K_, N_, OFF_, GAIN_) do { const float* W = A.in[IN_]; bf16_t* WT = (bf16_t*)(F.ws + (OFF_)); \
        for (int it = gw; it < ((K_) / 64) * ((N_) / 32); it += NGW) transpose_item(W, K_, N_, WT, GAIN_, scr, it, F.lane); } while (0)
    TJOB(I0_WIN, 1024, 704, WS_WIN, nullptr); TJOB(I0_WUQ, 384, 1536, WS_WUQ, A.in[I0_QN]); TJOB(I0_WUKV, 256, 2048, WS_WUKV, A.in[I0_KVN]); TJOB(I0_WO, 1024, 1024, WS_WO0, nullptr);
    TJOB(I1_WQKV, 1024, 1536, WS_WQKV, nullptr); TJOB(I1_WO, 1024, 1024, WS_WO1, nullptr);
#undef TJOB
    { u32x4* z = (u32x4*)(F.ws + WS_WIN + (size_t)704 * 1024 * 2); const int n16 = 64 * 1024 * 2 / 16;
      for (int i = F.bid * NTHREADS + F.tid; i < n16; i += F.nblk * NTHREADS) z[i] = (u32x4){0u, 0u, 0u, 0u}; }
}
__device__ __forceinline__ void p0_weff(const Args& A, const Frame& F) {
    float* kkT = (float*)F.lds; float* wqs = kkT + 128 * 129;
    const int tid = F.tid, lane = F.lane, w = F.wave;
    for (int item = F.bid; item < 512; item += F.nblk) {
        const int layer = item >> 8, z = (item >> 4) & 15, kc = item & 15, h = z >> 1;
        const float* kk = ((z & 1) ? (layer ? A.in[I1_PK2] : A.in[I0_PK2]) : (layer ? A.in[I1_PK1] : A.in[I0_PK1])) + (size_t)h * 16384;
        const float* wq = (layer ? A.in[I1_PWQ] : A.in[I0_PWQ]) + (size_t)(kc * 64) * 2048 + z * 128;
        bf16_t* WT = (bf16_t*)(F.ws + (layer ? WS_WQ1 : WS_WQ0));
        __syncthreads();
        { f32x4 kv[8], wv4[4];
#pragma unroll
          for (int i = 0; i < 8; ++i) kv[i] = *(const f32x4*)(kk + 4 * (tid + i * NTHREADS));
#pragma unroll
          for (int i = 0; i < 4; ++i) { const int e = 4 * (tid + i * NTHREADS); wv4[i] = *(const f32x4*)(wq + (size_t)(e >> 7) * 2048 + (e & 127)); }
#pragma unroll
          for (int i = 0; i < 8; ++i) { const int e = 4 * (tid + i * NTHREADS), key = e >> 7, d = e & 127; kkT[d * 129 + key] = kv[i].x; kkT[(d + 1) * 129 + key] = kv[i].y; kkT[(d + 2) * 129 + key] = kv[i].z; kkT[(d + 3) * 129 + key] = kv[i].w; }
#pragma unroll
          for (int i = 0; i < 4; ++i) *(f32x4*)(wqs + 4 * (tid + i * NTHREADS)) = wv4[i]; }
        __syncthreads();
        float acc[8][2];
#pragma unroll
        for (int j = 0; j < 8; ++j) { acc[j][0] = 0.f; acc[j][1] = 0.f; }
#pragma unroll 2
        for (int d = 0; d < 128; ++d) { const float a0 = kkT[d * 129 + lane], a1 = kkT[d * 129 + lane + 64];
#pragma unroll
            for (int j = 0; j < 8; ++j) { const float wv = wqs[(w * 8 + j) * 128 + d]; acc[j][0] += wv * a0; acc[j][1] += wv * a1; } }
        u32x4 o0, o1;
        o0.x = pk2(acc[0][0], acc[1][0]); o0.y = pk2(acc[2][0], acc[3][0]); o0.z = pk2(acc[4][0], acc[5][0]); o0.w = pk2(acc[6][0], acc[7][0]);
        o1.x = pk2(acc[0][1], acc[1][1]); o1.y = pk2(acc[2][1], acc[3][1]); o1.z = pk2(acc[4][1], acc[5][1]); o1.w = pk2(acc[6][1], acc[7][1]);
        *(u32x4*)(WT + (size_t)(z * 128 + lane) * 1024 + kc * 64 + w * 8) = o0;
        *(u32x4*)(WT + (size_t)(z * 128 + lane + 64) * 1024 + kc * 64 + w * 8) = o1;
    }
    __syncthreads();
}

__device__ __forceinline__ void p0_tables(const Args& A, const Frame& F) {
    const int gw = F.bid * NWAVES + F.wave, NGW = F.nblk * NWAVES, lane = F.lane;
    unsigned char* TAB = F.ws + WS_TAB; float* TSC = (float*)(F.ws + WS_TSC);
    for (int it = gw; it < 4 * 16384 / 4; it += NGW) {
        const int t = it >> 12, row0 = (it & 4095) * 4;
        const float* src = (t == 0 ? A.in[I0_PU] : t == 1 ? A.in[I0_PV] : t == 2 ? A.in[I1_PU] : A.in[I1_PV]) + (size_t)row0 * 1024 + 4 * lane;
        f32x4 v[4][4];
#pragma unroll
        for (int rr = 0; rr < 4; ++rr)
#pragma unroll
            for (int j = 0; j < 4; ++j) v[rr][j] = *(const f32x4*)(src + (size_t)rr * 1024 + 256 * j);
#pragma unroll
        for (int rr = 0; rr < 4; ++rr) {
            float am = 0.f;
#pragma unroll
            for (int j = 0; j < 4; ++j) am = fmaxf(am, fmaxf(fmaxf(fabsf(v[rr][j].x), fabsf(v[rr][j].y)), fmaxf(fabsf(v[rr][j].z), fabsf(v[rr][j].w))));
            am = wave_max(am);
            const int row = row0 + rr;
            float sc;
            if ((t & 1) == 0) {
                float ss = 0.f;
#pragma unroll
                for (int j = 0; j < 4; ++j) ss += (v[rr][j].x * v[rr][j].x + v[rr][j].y * v[rr][j].y) + (v[rr][j].z * v[rr][j].z + v[rr][j].w * v[rr][j].w);
                ss = wave_sum(ss);
                sc = am > 0.f ? fminf(am * (1.f / 7.f), 0.36f * sqrtf(ss * (1.f / 1024.f))) : 1.f;
                const float inv = am > 0.f ? 1.f / sc : 0.f;
#pragma unroll
                for (int j = 0; j < 4; ++j) {
                    const int q0 = (int)fminf(fmaxf(rintf(v[rr][j].x * inv), -7.f), 7.f), q1 = (int)fminf(fmaxf(rintf(v[rr][j].y * inv), -7.f), 7.f), q2 = (int)fminf(fmaxf(rintf(v[rr][j].z * inv), -7.f), 7.f), q3 = (int)fminf(fmaxf(rintf(v[rr][j].w * inv), -7.f), 7.f);
                    *(unsigned short*)(TAB + (((size_t)t * 8 + j) * 16384 + row) * 128 + 2 * lane) = (unsigned short)((q0 & 15) | ((q1 & 15) << 4) | ((q2 & 15) << 8) | ((q3 & 15) << 12)); }
            } else {
            sc = am > 0.f ? am * (1.f / 127.f) : 1.f; const float inv = am > 0.f ? 127.f / am : 0.f;
#pragma unroll
            for (int j = 0; j < 4; ++j) { const unsigned b0 = (unsigned)((int)rintf(v[rr][j].x * inv)) & 0xffu, b1 = (unsigned)((int)rintf(v[rr][j].y * inv)) & 0xffu, b2 = (unsigned)((int)rintf(v[rr][j].z * inv)) & 0xffu, b3 = (unsigned)((int)rintf(v[rr][j].w * inv)) & 0xffu;
                *(unsigned*)(TAB + (((size_t)t * 8 + 2 * j + (lane >> 5)) * 16384 + row) * 128 + 4 * (lane & 31)) = b0 | (b1 << 8) | (b2 << 16) | (b3 << 24); }
            }
            if (lane == 0) TSC[t * 16384 + row] = sc;
        }
    }
}

__device__ __forceinline__ void norm_mod_store(const f32x4 (&v)[4], float rinv, const float* g, const float* sh, const float* sc, bf16_t* orow, int lane) {
#pragma unroll
    for (int j = 0; j < 4; ++j) { const int c = 4 * lane + 256 * j;
        const f32x4 gg = *(const f32x4*)(g + c), s1 = *(const f32x4*)(sc + c), s0 = *(const f32x4*)(sh + c);
        const f32x4 y = (v[j] * rinv * gg) * (s1 + 1.f) + s0;
        u32x2 o; o.x = pk2(y.x, y.y); o.y = pk2(y.z, y.w); *(u32x2*)(orow + c) = o; }
}
__device__ __forceinline__ int tok_row(int layer, int n);
__device__ __forceinline__ void norm_row_out(const Frame& F, const f32x4 (&v)[4], float rinv, const float* g, const float* mm, int r, int which) {
    norm_mod_store(v, rinv, g, mm, mm + 1024, (bf16_t*)(F.ws + WS_H) + (size_t)r * DM, F.lane);
    if (which) {
        f32x4 y[4]; float am = 0.f;
#pragma unroll
        for (int j = 0; j < 4; ++j) { const int c = 4 * F.lane + 256 * j; y[j] = (v[j] * rinv * *(const f32x4*)(g + c)) * (*(const f32x4*)(mm + 1024 + c) + 1.f) + *(const f32x4*)(mm + c);
            am = fmaxf(am, fmaxf(fmaxf(fabsf(y[j].x), fabsf(y[j].y)), fmaxf(fabsf(y[j].z), fabsf(y[j].w)))); }
        am = wave_max(am);
        const float inv = am > 0.f ? 119.f / am : 0.f;
#pragma unroll
        for (int j = 0; j < 4; ++j) { const int h0 = (int)rintf(y[j].x * inv), h1 = (int)rintf(y[j].y * inv), h2 = (int)rintf(y[j].z * inv), h3 = (int)rintf(y[j].w * inv);
            const unsigned hh = (unsigned)(((h0 + 8) >> 4) & 15) | ((unsigned)(((h1 + 8) >> 4) & 15) << 4) | ((unsigned)(((h2 + 8) >> 4) & 15) << 8) | ((unsigned)(((h3 + 8) >> 4) & 15) << 12);
            const unsigned hl = (unsigned)(h0 & 15) | ((unsigned)(h1 & 15) << 4) | ((unsigned)(h2 & 15) << 8) | ((unsigned)(h3 & 15) << 12);
            const bool odd = (F.lane & 1) != 0;
            const unsigned recv = (unsigned)__builtin_amdgcn_update_dpp(0, (int)(odd ? hh : hl), 0xB1, 0xf, 0xf, false);
            *(unsigned*)(F.ws + WS_HQ + (size_t)r * DM + 256 * j + 4 * F.lane) = odd ? (recv | (hl << 16)) : (hh | (recv << 16)); }
        if (F.lane == 0) ((float*)(F.ws + WS_HS))[r] = am > 0.f ? am * (1.f / 119.f) : 1.f;
    }
}
__device__ __forceinline__ void p_norm_rows(const Args& A, const Frame& F, int layer, int which, bool from_input, bool skip_ctx) {
    const int gw = F.bid * NWAVES + F.wave, NGW = F.nblk * NWAVES;
    const float* g = A.in[layer ? (which ? I1_NFFN : I1_NMIX) : (which ? I0_NFFN : I0_NMIX)];
    const float* MOD = (const float*)(F.ws + WS_MOD) + (size_t)layer * 5 * 6144;
    const unsigned short* X = (const unsigned short*)(F.ws + WS_X);
    const int ntok = skip_ctx ? NB * SEQ : R;
    for (int n = gw; n < ntok; n += 2 * NGW) {
        const bool has1 = (n + NGW) < ntok;
        const int r0 = skip_ctx ? tok_row(1, n) : n, r1 = has1 ? (skip_ctx ? tok_row(1, n + NGW) : n + NGW) : r0;
        f32x4 v0[4], v1[4]; float s0 = 0.f, s1 = 0.f;
        if (from_input) { const float* x0 = xin_row(F, r0); const float* x1 = xin_row(F, r1);
#pragma unroll
            for (int j = 0; j < 4; ++j) { v0[j] = *(const f32x4*)(x0 + 4 * F.lane + 256 * j); v1[j] = *(const f32x4*)(x1 + 4 * F.lane + 256 * j); } }
        else {
#pragma unroll
            for (int j = 0; j < 4; ++j) { const u32x2 a = *(const u32x2*)(X + (size_t)r0 * DM + 4 * F.lane + 256 * j), b = *(const u32x2*)(X + (size_t)r1 * DM + 4 * F.lane + 256 * j);
                v0[j] = (f32x4){h2f_lo(a.x), h2f_hi(a.x), h2f_lo(a.y), h2f_hi(a.y)}; v1[j] = (f32x4){h2f_lo(b.x), h2f_hi(b.x), h2f_lo(b.y), h2f_hi(b.y)}; } }
#pragma unroll
        for (int j = 0; j < 4; ++j) { s0 += (v0[j].x * v0[j].x + v0[j].y * v0[j].y) + (v0[j].z * v0[j].z + v0[j].w * v0[j].w); s1 += (v1[j].x * v1[j].x + v1[j].y * v1[j].y) + (v1[j].z * v1[j].z + v1[j].w * v1[j].w); }
        const float ri0 = rsqrtf(wave_sum(s0) * (1.f / DM) + EPS), ri1 = rsqrtf(wave_sum(s1) * (1.f / DM) + EPS);
        norm_row_out(F, v0, ri0, g, MOD + (size_t)mod_index(r0) * 6144 + (which ? 3 * 1024 : 0), r0, which);
        if (has1) norm_row_out(F, v1, ri1, g, MOD + (size_t)mod_index(r1) * 6144 + (which ? 3 * 1024 : 0), r1, which);
    }
}

namespace pg8 {
#define PG8_LAS __attribute__((address_space(3)))
typedef unsigned short bf16_t;
typedef short bf16x8 __attribute__((ext_vector_type(8)));
typedef float f32x4 __attribute__((ext_vector_type(4)));
typedef unsigned u32x4 __attribute__((ext_vector_type(4)));
constexpr int BM = 256, BK = 64, HALF = 128, HTB = HALF * BK * 2  , STAGE_BYTES = 8 * HTB, NXCD = 8, WGM = 8;

__host__ __device__ __forceinline__ int lds_byte(int r, int c) { const int st = (r >> 4) * 2 + (c >> 5), rr = r & 15, cc = c & 31, ob = rr * 64 + cc * 2; return st * 1024 + (ob ^ (((ob >> 9) & 1) << 5)); }
__host__ __device__ __forceinline__ void stage_rc(int b, int& R, int& C) { const int st = b / 1024, sb = b % 1024, swz = sb ^ (((sb >> 9) & 1) << 5); R = (st >> 1) * 16 + swz / 64; C = (st & 1) * 32 + (swz % 64) / 2; }
__host__ __device__ __forceinline__ int perm32(int rho) { const int n = rho >> 4, i = rho & 15; return 8 * (i >> 2) + 4 * n + (i & 3); }

struct Unit { int pm, pn; };
struct Gemm { const bf16_t* A; const bf16_t* Bt; int M, N, K; };

struct StaticOrder {
    int nM, nN, nwg, G, c;
    __host__ __device__ void init(int M, int N, int G_, int c_) { nM = M / BM; nN = N / BM; nwg = nM * nN; G = G_; c = c_; }
    __host__ __device__ bool next(int i, Unit& u) const {
        const long L = (long)i * G + c; if (L >= nwg) return false;
        int wgid = (int)L; { const int q = nwg / NXCD, r = nwg % NXCD, xcd = wgid % NXCD, off = wgid / NXCD; wgid = (xcd < r ? xcd * (q + 1) : r * (q + 1) + (xcd - r) * q) + off; }
        const int nig = WGM * nN, gid = wgid / nig, fm = gid * WGM, gsz = (nM - fm) < WGM ? (nM - fm) : WGM;
        u.pm = fm + ((wgid % nig) % gsz); u.pn = (wgid % nig) / gsz; return true;
    }
    __device__ __forceinline__ void a_ready(const Unit&) const {}
    __device__ __forceinline__ void done(const Unit&) const {}
};

template <class Epi, class Sched, bool ALIGN_EPI = false, bool SP2 = false>
__device__ __forceinline__ void gemm_phase(PG8_LAS unsigned char* lds, const Gemm g, const Sched& S, const Epi& E) {
    const int tid = threadIdx.x, wid = __builtin_amdgcn_readfirstlane(tid >> 6), lane = tid & 63, wr = wid >> 2, wc = wid & 3, fr = lane & 15, fq = lane >> 4;
    const int K = g.K, nt = K / BK;
    unsigned voffA[2], voffB[2];
#pragma unroll
    for (int i = 0; i < 2; ++i) { int R, C; stage_rc(tid * 16 + i * 8192, R, C); const int Rb = Epi::PERM ? ((R & ~31) + perm32(R & 31)) : R;
        voffA[i] = (unsigned)(R * K + C) * 2u; voffB[i] = (unsigned)(Rb * K + C) * 2u; }
    const size_t kstep = (size_t)(BK * 2);
    const size_t hstep = (size_t)HALF * K * 2;
    const size_t tstep = 2 * hstep;
    const unsigned ldsw = (unsigned)wid * 1024u;
    const int aoff = lds_byte(wr * 64 + fr, fq * 8), boff = lds_byte(wc * 32 + fr, fq * 8);
#define PG8_SA(b, h) (((b) * 2 + (h)) * HTB)
#define PG8_SB(b, h) ((4 + (b) * 2 + (h)) * HTB)
#define PG8_STAGE(bufoff, gbase, voff) do { _Pragma("unroll") for (int _i = 0; _i < 2; ++_i) \
        __builtin_amdgcn_global_load_lds((const unsigned*)((const char*)(gbase) + (voff)[_i]), (PG8_LAS unsigned*)(lds + (bufoff) + ldsw + _i * 8192), 16, 0, 0); } while (0)
#define PG8_LDA(dst, b, h) do { _Pragma("unroll") for (int m = 0; m < 4; ++m) _Pragma("unroll") for (int k = 0; k < 2; ++k) dst[m][k] = *(const PG8_LAS bf16x8*)(lds + PG8_SA(b, h) + aoff + m * 2048 + k * 1024); } while (0)
#define PG8_LDB(dst, b, h) do { _Pragma("unroll") for (int n = 0; n < 2; ++n) _Pragma("unroll") for (int k = 0; k < 2; ++k) dst[n][k] = *(const PG8_LAS bf16x8*)(lds + PG8_SB(b, h) + boff + n * 2048 + k * 1024); } while (0)
#define PG8_MMA(ai, bj, At, Bt) do { __builtin_amdgcn_s_setprio(1); _Pragma("unroll") for (int m = 0; m < 4; ++m) _Pragma("unroll") for (int n = 0; n < 2; ++n) _Pragma("unroll") for (int k = 0; k < 2; ++k) \
        acc[ai][bj][m][n] = __builtin_amdgcn_mfma_f32_16x16x32_bf16(Bt[n][k], At[m][k], acc[ai][bj][m][n], 0, 0, 0); __builtin_amdgcn_s_setprio(0); } while (0)
#define PG8_WAIT_V(n) asm volatile("s_waitcnt vmcnt(" #n ")" ::: "memory")
#define PG8_WAIT_L(n) asm volatile("s_waitcnt lgkmcnt(" #n ")" ::: "memory")
#define PG8_BAR __builtin_amdgcn_s_barrier()
#define PG8_SCHED __builtin_amdgcn_sched_barrier(0)
    Unit cur, nxt; int ui = 0;
    if (!S.next(0, cur)) return;
    f32x4 acc[2][2][4][2];
#pragma unroll
    for (int a = 0; a < 2; ++a)
#pragma unroll
        for (int b = 0; b < 2; ++b)
#pragma unroll
            for (int m = 0; m < 4; ++m)
#pragma unroll
                for (int n = 0; n < 2; ++n) acc[a][b][m][n] = (f32x4){0.f, 0.f, 0.f, 0.f};
    bf16x8 At[4][2], B0[2][2], B1[2][2];
    const char* cA = (const char*)g.A + (size_t)cur.pm * tstep; const char* cB = (const char*)g.Bt + (size_t)cur.pn * tstep;
    S.a_ready(cur);
    if constexpr (SP2) {
        PG8_STAGE(PG8_SB(0, 0), cB, voffB); PG8_STAGE(PG8_SB(0, 1), cB + hstep, voffB); PG8_STAGE(PG8_SA(0, 0), cA, voffA); PG8_STAGE(PG8_SA(0, 1), cA + hstep, voffA);
        if (wr == 1) PG8_BAR;
        PG8_WAIT_V(2); PG8_BAR;
        PG8_STAGE(PG8_SB(1, 0), cB + kstep, voffB); PG8_STAGE(PG8_SA(1, 0), cA + kstep, voffA); PG8_STAGE(PG8_SB(1, 1), cB + hstep + kstep, voffB);
        PG8_WAIT_V(6); PG8_BAR;
    } else {
        PG8_STAGE(PG8_SB(0, 0), cB, voffB); PG8_STAGE(PG8_SA(0, 0), cA, voffA); PG8_STAGE(PG8_SB(0, 1), cB + hstep, voffB); PG8_STAGE(PG8_SA(0, 1), cA + hstep, voffA);
        if (wr == 1) PG8_BAR;
        PG8_WAIT_V(4); PG8_BAR;
        PG8_STAGE(PG8_SB(1, 0), cB + kstep, voffB); PG8_STAGE(PG8_SA(1, 0), cA + kstep, voffA); PG8_STAGE(PG8_SB(1, 1), cB + hstep + kstep, voffB);
        PG8_WAIT_V(6); PG8_BAR;
    }
    for (;;) {
        const bool has_next = S.next(ui + 1, nxt);
        const char* nA = has_next ? (const char*)g.A + (size_t)nxt.pm * tstep : cA; const char* nB = has_next ? (const char*)g.Bt + (size_t)nxt.pn * tstep : cB;
        for (int t = 0; t < nt; t += 2) {
            const bool last = (t == nt - 2);
            const char* a1 = cA + (size_t)(t + 1) * kstep;
            const char* a2 = last ? nA : cA + (size_t)(t + 2) * kstep; const char* b2 = last ? nB : cB + (size_t)(t + 2) * kstep;
            const char* a3 = a2 + kstep; const char* b3 = b2 + kstep;
            if (last && has_next) S.a_ready(nxt);
            if constexpr (SP2) {
            PG8_LDB(B0, 0, 0); PG8_LDB(B1, 0, 1); PG8_SCHED; PG8_LDA(At, 0, 0); PG8_STAGE(PG8_SA(1, 1), a1 + hstep, voffA);
            PG8_WAIT_V(8); PG8_WAIT_L(0); PG8_BAR; PG8_MMA(0, 0, At, B0); PG8_MMA(0, 1, At, B1); PG8_BAR; PG8_SCHED;
            PG8_LDA(At, 0, 1); PG8_STAGE(PG8_SB(0, 0), b2, voffB); PG8_STAGE(PG8_SB(0, 1), b2 + hstep, voffB); PG8_STAGE(PG8_SA(0, 0), a2, voffA);
            PG8_WAIT_V(8); PG8_WAIT_L(0); PG8_BAR; PG8_MMA(1, 0, At, B0); PG8_MMA(1, 1, At, B1); PG8_BAR; PG8_SCHED;
            PG8_LDB(B0, 1, 0); PG8_LDB(B1, 1, 1); PG8_SCHED; PG8_LDA(At, 1, 0); PG8_STAGE(PG8_SA(0, 1), a2 + hstep, voffA);
            PG8_WAIT_V(8); PG8_WAIT_L(0); PG8_BAR; PG8_MMA(0, 0, At, B0); PG8_MMA(0, 1, At, B1); PG8_BAR; PG8_SCHED;
            PG8_LDA(At, 1, 1); PG8_STAGE(PG8_SB(1, 0), b3, voffB); PG8_STAGE(PG8_SB(1, 1), b3 + hstep, voffB); PG8_STAGE(PG8_SA(1, 0), a3, voffA);
            PG8_WAIT_V(8); PG8_WAIT_L(0); PG8_BAR; PG8_MMA(1, 0, At, B0); PG8_MMA(1, 1, At, B1); PG8_BAR; PG8_SCHED;
            } else {
            PG8_LDB(B0, 0, 0); PG8_SCHED; PG8_LDA(At, 0, 0); PG8_STAGE(PG8_SA(1, 1), a1 + hstep, voffA);
            PG8_WAIT_L(8); PG8_BAR; PG8_WAIT_L(0); PG8_MMA(0, 0, At, B0); PG8_BAR; PG8_SCHED;
            PG8_LDB(B1, 0, 1); PG8_STAGE(PG8_SB(0, 0), b2, voffB);
            PG8_BAR; PG8_WAIT_L(0); PG8_MMA(0, 1, At, B1); PG8_BAR;
            PG8_LDA(At, 0, 1); PG8_STAGE(PG8_SA(0, 0), a2, voffA);
            PG8_BAR; PG8_WAIT_L(0); PG8_MMA(1, 0, At, B0); PG8_BAR; PG8_SCHED;
            PG8_STAGE(PG8_SB(0, 1), b2 + hstep, voffB);
            PG8_WAIT_V(6); PG8_BAR; PG8_MMA(1, 1, At, B1); PG8_BAR;
            PG8_LDB(B0, 1, 0); PG8_SCHED; PG8_LDA(At, 1, 0); PG8_STAGE(PG8_SA(0, 1), a2 + hstep, voffA);
            PG8_WAIT_L(8); PG8_BAR; PG8_WAIT_L(0); PG8_MMA(0, 0, At, B0); PG8_BAR; PG8_SCHED;
            PG8_LDB(B1, 1, 1); PG8_STAGE(PG8_SB(1, 0), b3, voffB);
            PG8_BAR; PG8_WAIT_L(0); PG8_MMA(0, 1, At, B1); PG8_BAR;
            PG8_LDA(At, 1, 1); PG8_STAGE(PG8_SA(1, 0), a3, voffA);
            PG8_BAR; PG8_WAIT_L(0); PG8_MMA(1, 0, At, B0); PG8_BAR; PG8_SCHED;
            PG8_STAGE(PG8_SB(1, 1), b3 + hstep, voffB);
            PG8_WAIT_V(6); PG8_BAR; PG8_MMA(1, 1, At, B1); PG8_BAR;
            }
        }
        if constexpr (ALIGN_EPI) { if (wr == 0) PG8_BAR; }
        if constexpr (!Epi::AFTER_DRAIN) { E(acc, cur, wr, wc, fr, fq); S.done(cur); }
        if (!has_next) break;
#pragma unroll
        for (int a = 0; a < 2; ++a)
#pragma unroll
            for (int b = 0; b < 2; ++b)
#pragma unroll
                for (int m = 0; m < 4; ++m)
#pragma unroll
                    for (int n = 0; n < 2; ++n) acc[a][b][m][n] = (f32x4){0.f, 0.f, 0.f, 0.f};
        cur = nxt; cA = nA; cB = nB; ++ui;
        if constexpr (ALIGN_EPI) { if (wr == 1) PG8_BAR; }
    }
    PG8_WAIT_V(0);
    if constexpr (!ALIGN_EPI) { if (wr == 0) PG8_BAR; }
    PG8_BAR;
    if constexpr (Epi::AFTER_DRAIN) { E.fused(acc, cur, wr, wc, fr, fq, lds, wid, lane); S.done(cur); }
#undef PG8_SA
#undef PG8_SB
#undef PG8_STAGE
#undef PG8_LDA
#undef PG8_LDB
#undef PG8_MMA
#undef PG8_WAIT_V
#undef PG8_WAIT_L
#undef PG8_BAR
#undef PG8_SCHED
}
}

template <class Inner> struct EpiTile { static constexpr bool PERM = true, AFTER_DRAIN = false; Inner in;
    __device__ __forceinline__ void operator()(const pg8::f32x4 (&acc)[2][2][4][2], const pg8::Unit& u, int wr, int wc, int fr, int fq) const {
#pragma unroll
        for (int ai = 0; ai < 2; ++ai)
#pragma unroll
            for (int m = 0; m < 4; ++m) { const int row = u.pm * 256 + ai * 128 + wr * 64 + m * 16 + fr;
#pragma unroll
                for (int bj = 0; bj < 2; ++bj) in(row, u.pn * 256 + bj * 128 + wc * 32 + 8 * fq, acc[ai][bj][m][0], acc[ai][bj][m][1]); }
    } };
struct In8Bf16 { bf16_t* C; int ldc;
    __device__ __forceinline__ void operator()(int row, int col, f32x4 a, f32x4 b) const { u32x4 o; o.x = cvtpk(a.x, a.y); o.y = cvtpk(a.z, a.w); o.z = cvtpk(b.x, b.y); o.w = cvtpk(b.z, b.w); *(u32x4*)(C + (size_t)row * ldc + col) = o; } };
struct In8KV { bf16_t* Kb; bf16_t* Vb;
    __device__ __forceinline__ void operator()(int row, int col, f32x4 a, f32x4 b) const { const int h = col >> 8, c = col & 255; u32x4 o; o.x = cvtpk(a.x, a.y); o.y = cvtpk(a.z, a.w); o.z = cvtpk(b.x, b.y); o.w = cvtpk(b.z, b.w);
        bf16_t* p = (c < 128) ? Kb + (size_t)row * 1536 + h * 192 + c : Vb + (size_t)row * 1024 + h * 128 + (c - 128);
        *(u32x4*)p = o; } };
struct In8F16 { unsigned short* C; int ldc;
    __device__ __forceinline__ void operator()(int row, int col, f32x4 a, f32x4 b) const { u32x4 o; o.x = pkh2(a.x, a.y); o.y = pkh2(a.z, a.w); o.z = pkh2(b.x, b.y); o.w = pkh2(b.z, b.w); *(u32x4*)(C + (size_t)row * ldc + col) = o; } };
struct In8F32 { float* C; int ldc;
    __device__ __forceinline__ void operator()(int row, int col, f32x4 a, f32x4 b) const { float* p = C + (size_t)row * ldc + col; *(f32x4*)p = a; *(f32x4*)(p + 4) = b; } };
struct In8Resid { const float* x; const float* ctx; unsigned short* X; const float* gate; bool from_input;
    __device__ __forceinline__ void operator()(int row, int col, f32x4 a, f32x4 b) const {
        const int bb = row / RPB, j = row - bb * RPB; unsigned short* xo = X + (size_t)row * DM + col;
        f32x4 x0, x1;
        if (from_input) { const float* xi = ((j < CTXL) ? ctx + ((size_t)bb * CTXL + j) * DM : x + ((size_t)bb * SEQ + (j - CTXL)) * DM) + col; x0 = *(const f32x4*)xi; x1 = *(const f32x4*)(xi + 4); }
        else { const u32x4 w = *(const u32x4*)xo; x0 = (f32x4){h2f_lo(w.x), h2f_hi(w.x), h2f_lo(w.y), h2f_hi(w.y)}; x1 = (f32x4){h2f_lo(w.z), h2f_hi(w.z), h2f_lo(w.w), h2f_hi(w.w)}; }
        const float* g = gate + (size_t)((j < CTXL) ? 4 : bb) * 6144 + col;
        x0 += *(const f32x4*)g * a; x1 += *(const f32x4*)(g + 4) * b;
        u32x4 o; o.x = pkh2(x0.x, x0.y); o.y = pkh2(x0.z, x0.w); o.z = pkh2(x1.x, x1.y); o.w = pkh2(x1.z, x1.w); *(u32x4*)xo = o; } };
struct EpiMlaDown { static constexpr bool PERM = true, AFTER_DRAIN = false; bf16_t* CQ; bf16_t* CKV; bf16_t* KR; float* SSP;
    __device__ __forceinline__ void operator()(const pg8::f32x4 (&acc)[2][2][4][2], const pg8::Unit& u, int wr, int wc, int fr, int fq) const {
#pragma unroll
        for (int ai = 0; ai < 2; ++ai)
#pragma unroll
            for (int m = 0; m < 4; ++m) { const int row = u.pm * 256 + ai * 128 + wr * 64 + m * 16 + fr;
#pragma unroll
                for (int bj = 0; bj < 2; ++bj) { const int col = u.pn * 256 + bj * 128 + wc * 32 + 8 * fq; const f32x4 a = acc[ai][bj][m][0], b = acc[ai][bj][m][1];
                    u32x4 o; o.x = cvtpk(a.x, a.y); o.y = cvtpk(a.z, a.w); o.z = cvtpk(b.x, b.y); o.w = cvtpk(b.z, b.w);
                    const int cls = (u.pn * 2 + bj);
                    if (cls < 5) { float sq = (a.x * a.x + a.y * a.y) + (a.z * a.z + a.w * a.w) + (b.x * b.x + b.y * b.y) + (b.z * b.z + b.w * b.w);
                        sq += __shfl_xor(sq, 16); sq += __shfl_xor(sq, 32);
                        if (cls < 3) *(u32x4*)(CQ + (size_t)row * 384 + col) = o; else *(u32x4*)(CKV + (size_t)row * 256 + (col - 384)) = o;
                        if (fq == 0) SSP[(size_t)row * 24 + cls * 4 + wc] = sq; }
                    else if (col < 704) *(u32x4*)(KR + (size_t)row * 64 + (col - 640)) = o; } }
    } };
struct In8Bf16Rs { bf16_t* C; int ldc; const float* ssp;
    __device__ __forceinline__ void operator()(int row, int col, f32x4 a, f32x4 b) const { const f32x4 s0 = *(const f32x4*)(ssp + (size_t)row * 24), s1 = *(const f32x4*)(ssp + (size_t)row * 24 + 4), s2 = *(const f32x4*)(ssp + (size_t)row * 24 + 8);
        const float ssum = (((s0.x + s0.y) + (s0.z + s0.w)) + ((s1.x + s1.y) + (s1.z + s1.w))) + ((s2.x + s2.y) + (s2.z + s2.w));
        const float rs = rsqrtf(ssum * (1.f / 384.f) + EPS); a *= rs; b *= rs;
        u32x4 o; o.x = cvtpk(a.x, a.y); o.y = cvtpk(a.z, a.w); o.z = cvtpk(b.x, b.y); o.w = cvtpk(b.z, b.w); *(u32x4*)(C + (size_t)row * ldc + col) = o; } };
struct In8KVRs { unsigned char* K8; unsigned char* V8; const float* ssp;
    __device__ __forceinline__ void operator()(int row, int col, f32x4 a, f32x4 b) const { const f32x4 s0 = *(const f32x4*)(ssp + (size_t)row * 24 + 12), s1 = *(const f32x4*)(ssp + (size_t)row * 24 + 16);
        const float ssum = ((s0.x + s0.y) + (s0.z + s0.w)) + ((s1.x + s1.y) + (s1.z + s1.w));
        const float rs = rsqrtf(ssum * (1.f / 256.f) + EPS); a *= rs; b *= rs;
        const int h = col >> 8, c = col & 255;
        if (c < 128) { u32x2 o; o.x = f8x4(a.x, a.y, a.z, a.w); o.y = f8x4(b.x, b.y, b.z, b.w); *(u32x2*)(K8 + (size_t)row * 1536 + h * 192 + c) = o; }
        else { u32x2 o; o.x = f8x4(a.x, a.y, a.z, a.w); o.y = f8x4(b.x, b.y, b.z, b.w); *(u32x2*)(V8 + (size_t)row * 1024 + h * 128 + (c - 128)) = o; } } };
struct RowSched { pg8::StaticOrder so; bool latent_only;
    __device__ __forceinline__ void init(int N, int G, int c, bool lat) { latent_only = lat; so.init(lat ? NB * SEQ : R, N, G, c); }
    __device__ __forceinline__ bool next(int i, pg8::Unit& u) const { if (!so.next(i, u)) return false; if (latent_only) u.pm = (u.pm >> 4) * 17 + 1 + (u.pm & 15); return true; }
    __device__ __forceinline__ void a_ready(const pg8::Unit&) const {}
    __device__ __forceinline__ void done(const pg8::Unit&) const {} };
template <class Inner> __device__ __forceinline__ void gemm8(const Frame& F, const bf16_t* Ap, const bf16_t* Bt, int N, int K, bool latent_only, const Inner& in, bool reverse = false) {
    asm volatile("" : "+s"(K));
    pg8::Gemm g{Ap, Bt, R, N, K}; RowSched S; S.init(N, F.nblk, reverse ? F.nblk - 1 - F.bid : F.bid, latent_only);
    EpiTile<Inner> E{in};
    pg8::gemm_phase<EpiTile<Inner>, RowSched, true, true>((PG8_LAS unsigned char*)F.lds, g, S, E);
}

template <class Epi> __device__ __forceinline__ void gemm8e(const Frame& F, const bf16_t* Ap, const bf16_t* Bt, int N, int K, bool latent_only, const Epi& E) {
    asm volatile("" : "+s"(K));
    pg8::Gemm g{Ap, Bt, R, N, K}; RowSched S; S.init(N, F.nblk, F.bid, latent_only);
    pg8::gemm_phase<Epi, RowSched, true, true>((PG8_LAS unsigned char*)F.lds, g, S, E);
}

struct GemmDesc { const bf16_t* A; int lda; long sA; const bf16_t* Bt; int ldb; long sB; int M, N, K, nz; };
template <class Epi>
__device__ __forceinline__ void gemm_simple(const Frame& F, const GemmDesc& g, const Epi& epi, bool skip_ctx) {
    const int wm = F.wave >> 1, wn = F.wave & 1, fr = F.lane & 15, fq = F.lane >> 4;
    const int tM = g.M / 128, tN = g.N / 128, per = tM * tN, total = per * g.nz;
    for (int u = F.bid; u < total; u += F.nblk) {
        const int z = u / per, uu = u - z * per, tm = uu / tN, tn = uu - tm * tN;
        if (skip_ctx && ((tm * 128) % RPB) < CTXL) continue;
        const int row0 = tm * 128 + wm * 32, col0 = tn * 128 + wn * 64;
        const bf16_t* ap = g.A + z * g.sA + (size_t)(row0 + fr) * g.lda + fq * 8;
        const bf16_t* bp = g.Bt + z * g.sB + (size_t)(col0 + fr) * g.ldb + fq * 8;
        f32x4 acc[2][4];
#pragma unroll
        for (int mi = 0; mi < 2; ++mi)
#pragma unroll
            for (int ni = 0; ni < 4; ++ni) acc[mi][ni] = (f32x4){0.f, 0.f, 0.f, 0.f};
        for (int k0 = 0; k0 < g.K; k0 += 32) {
            bf16x8 a[2], b[4];
#pragma unroll
            for (int mi = 0; mi < 2; ++mi) a[mi] = *(const bf16x8*)(ap + (size_t)mi * 16 * g.lda + k0);
#pragma unroll
            for (int ni = 0; ni < 4; ++ni) b[ni] = *(const bf16x8*)(bp + (size_t)ni * 16 * g.ldb + k0);
#pragma unroll
            for (int mi = 0; mi < 2; ++mi)
#pragma unroll
                for (int ni = 0; ni < 4; ++ni) acc[mi][ni] = __builtin_amdgcn_mfma_f32_16x16x32_bf16(b[ni], a[mi], acc[mi][ni], 0, 0, 0);
        }
#pragma unroll
        for (int mi = 0; mi < 2; ++mi)
#pragma unroll
            for (int ni = 0; ni < 4; ++ni) epi(z, row0 + mi * 16 + fr, col0 + ni * 16 + fq * 4, acc[mi][ni]);
    }
}
struct EpiBf16 { bf16_t* C; int ldc;
    __device__ __forceinline__ void operator()(int, int row, int col, f32x4 v) const { u32x2 o; o.x = pk2(v.x, v.y); o.y = pk2(v.z, v.w); *(u32x2*)(C + (size_t)row * ldc + col) = o; } };
struct EpiKV { bf16_t* Kb; bf16_t* Vb;
    __device__ __forceinline__ void operator()(int, int row, int col, f32x4 v) const { const int h = col >> 8, c = col & 255; u32x2 o; o.x = pk2(v.x, v.y); o.y = pk2(v.z, v.w);
        if (c < 128) *(u32x2*)(Kb + (size_t)row * 1536 + h * 192 + c) = o; else *(u32x2*)(Vb + (size_t)row * 1024 + h * 128 + (c - 128)) = o; } };
struct EpiF32Z { float* C; int ldc;
    __device__ __forceinline__ void operator()(int z, int row, int col, f32x4 v) const { *(f32x4*)(C + (size_t)row * ldc + z * 128 + col) = v; } };
struct EpiResid { const Frame* F; const float* gate; bool from_input;
    __device__ __forceinline__ void operator()(int, int row, int col, f32x4 v) const {
        float* X = (float*)(F->ws + WS_X) + (size_t)row * DM + col;
        const float* xi = from_input ? xin_row(*F, row) + col : X;
        const f32x4 g = *(const f32x4*)(gate + (size_t)mod_index(row) * 6144 + col);
        *(f32x4*)X = *(const f32x4*)xi + g * v; } };

__device__ __forceinline__ void rope_angles(int r, int& prow, int& pcol) { const int t = (r % RPB) - CTXL; prow = t >> 6; pcol = t & 63; }
__device__ __forceinline__ void p_mla_krope(const Args& A, const Frame& F) {
    const int gw = F.bid * NWAVES + F.wave, NGW = F.nblk * NWAVES, lane = F.lane;
    const bf16_t* KR = (const bf16_t*)(F.ws + WS_KR); unsigned char* K8 = F.ws + WS_K;
    const float invf = __powf(10000.f, -(float)(lane & 15) * (1.f / 16.f));
    for (int r = gw; r < R; r += NGW) {
        float kr = bf2f(KR[(size_t)r * 64 + lane]);
        if (!is_ctx_row(r)) {
            int prow, pcol; rope_angles(r, prow, pcol);
            const float ang = (float)((lane & 32) ? pcol : prow) * invf;
            const float cs = cosf(ang), sn = sinf(ang);
            const float partner = __shfl_xor(kr, 16);
            kr = kr * cs + ((lane & 16) ? partner : -partner) * sn;
        }
        const unsigned char kb = (unsigned char)(f8x4(kr, kr, kr, kr) & 0xffu);
#pragma unroll
        for (int h = 0; h < 8; ++h) K8[(size_t)r * 1536 + h * 192 + 128 + lane] = kb;
    }
}
__device__ __forceinline__ float row16_sum(float v) { v += WDPP(v, 0xB1); v += WDPP(v, 0x4E); v += WDPP(v, 0x141); v += WDPP(v, 0x140); return v; }
__device__ __forceinline__ void p_gqa_rows(const Args& A, const Frame& F) {
    const int gw = F.bid * NWAVES + F.wave, NGW = F.nblk * NWAVES, lane = F.lane, c16 = lane & 15, hrow = lane >> 4;
    const bf16_t* RAW = (const bf16_t*)(F.ws + WS_RAW1); bf16_t* Q1 = (bf16_t*)(F.ws + WS_Q1); unsigned char* K18 = F.ws + WS_K1; unsigned char* V18 = F.ws + WS_V1;
    float qg[8], kg[8], invf[8];
#pragma unroll
    for (int e = 0; e < 8; ++e) { qg[e] = A.in[I1_QN][8 * c16 + e]; kg[e] = A.in[I1_KN][8 * c16 + e]; invf[e] = __powf(10000.f, -(float)(8 * (c16 & 3) + e) * (1.f / 32.f)); }
    const bool colaxis = (c16 & 8) != 0, hi32 = (c16 & 4) != 0;
    for (int r = gw; r < R; r += NGW) {
        const bool ctx = is_ctx_row(r);
        const bf16_t* a = RAW + (size_t)r * 1536 + 8 * lane;
        u32x4 ch[3];
#pragma unroll
        for (int j = 0; j < 3; ++j) ch[j] = (ctx && j < 2) ? (u32x4){0u, 0u, 0u, 0u} : *(const u32x4*)(a + 512 * j);
        float cs[8], sn[8];
        { int prow = 0, pcol = 0; if (!ctx) rope_angles(r, prow, pcol); const float pos = (float)(colaxis ? pcol : prow);
#pragma unroll
          for (int e = 0; e < 8; ++e) { const float ang = pos * invf[e]; cs[e] = ctx ? 1.f : __cosf(ang); sn[e] = ctx ? 0.f : __sinf(ang); } }
#pragma unroll
        for (int j = 0; j < 3; ++j) {
            if (ctx && j < 2) continue;
            const bool isv = (j == 2) && (hrow >= 2);
            float x[8];
#pragma unroll
            for (int d = 0; d < 4; ++d) { x[2 * d] = bflo(ch[j][d]); x[2 * d + 1] = bfhi(ch[j][d]); }
            float sq = 0.f;
#pragma unroll
            for (int e = 0; e < 8; ++e) sq += x[e] * x[e];
            const float rinv = rsqrtf(row16_sum(sq) * (1.f / 128.f) + EPS);
            u32x4 o;
            float y[8];
#pragma unroll
            for (int e = 0; e < 8; ++e) y[e] = x[e] * rinv * (j < 2 ? qg[e] : kg[e]);
            u32x4 yp; yp.x = pk2(y[0], y[1]); yp.y = pk2(y[2], y[3]); yp.z = pk2(y[4], y[5]); yp.w = pk2(y[6], y[7]);
            float pr[8];
#pragma unroll
            for (int d = 0; d < 4; ++d) { const float lo = __shfl_xor(y[2 * d], 4), hi2 = __shfl_xor(y[2 * d + 1], 4); pr[2 * d] = lo; pr[2 * d + 1] = hi2; }
            float z[8];
#pragma unroll
            for (int e = 0; e < 8; ++e) z[e] = y[e] * cs[e] + (hi32 ? pr[e] : -pr[e]) * sn[e];
            o.x = pk2(z[0], z[1]); o.y = pk2(z[2], z[3]); o.z = pk2(z[4], z[5]); o.w = pk2(z[6], z[7]);
            (void)yp;
            if (isv) o = ch[j];
            if (j < 2) *(u32x4*)(Q1 + (size_t)r * 1024 + 512 * j + 8 * lane) = o;
            else if (hrow < 2) { u32x2 o8; o8.x = f8x4(z[0], z[1], z[2], z[3]); o8.y = f8x4(z[4], z[5], z[6], z[7]); *(u32x2*)(K18 + (size_t)r * 256 + 8 * lane) = o8; }
            else { u32x2 o8; o8.x = f8x4(x[0], x[1], x[2], x[3]); o8.y = f8x4(x[4], x[5], x[6], x[7]); *(u32x2*)(V18 + (size_t)r * 256 + 8 * (lane - 32)) = o8; }
        }
    }
}

__device__ __forceinline__ int crow(int r, int hi) { return (r & 3) + 8 * (r >> 2) + 4 * hi; }
__device__ __forceinline__ int v_st(int k, int c) { const int kk = (k & ~0xC) | ((k & 4) << 1) | ((k & 8) >> 1); return ((kk >> 3) * 4 + (c >> 5)) * 512 + ((kk & 7) * 32 + (c & 31)) * 2; }
__device__ __forceinline__ int v_rd_base(int lane) { return ((lane & 3) << 3) | (((lane >> 2) & 3) << 6) | (((lane >> 4) & 1) << 5) | (((lane >> 5) & 1) << 8); }
constexpr int v_rd_off(int d0, int ks, int half) { return d0 * 512 + ks * 4096 + half * 2048; }
template <int OFF> __device__ __forceinline__ s16x4 tr_read(int vb) { s16x4 r; asm volatile("ds_read_b64_tr_b16 %0, %1 offset:%2" : "=&v"(r) : "v"(vb), "i"(OFF) : "memory"); return r; }
template <int D0> __device__ __forceinline__ void pv_one(f32x16& od, int vb, bf16x8 pa0, bf16x8 pa1, bf16x8 pa2, bf16x8 pa3) {
    const s16x4 l0 = tr_read<v_rd_off(D0, 0, 0)>(vb), h0 = tr_read<v_rd_off(D0, 0, 1)>(vb), l1 = tr_read<v_rd_off(D0, 1, 0)>(vb), h1 = tr_read<v_rd_off(D0, 1, 1)>(vb);
    const s16x4 l2 = tr_read<v_rd_off(D0, 2, 0)>(vb), h2 = tr_read<v_rd_off(D0, 2, 1)>(vb), l3 = tr_read<v_rd_off(D0, 3, 0)>(vb), h3 = tr_read<v_rd_off(D0, 3, 1)>(vb);
    asm volatile("s_waitcnt lgkmcnt(0)" ::: "memory"); SBAR();
#define PK(L, H) (bf16x8){L[0], L[1], L[2], L[3], H[0], H[1], H[2], H[3]}
    od = __builtin_amdgcn_mfma_f32_32x32x16_bf16(pa0, PK(l0, h0), od, 0, 0, 0);
    od = __builtin_amdgcn_mfma_f32_32x32x16_bf16(pa1, PK(l1, h1), od, 0, 0, 0);
    od = __builtin_amdgcn_mfma_f32_32x32x16_bf16(pa2, PK(l2, h2), od, 0, 0, 0);
    od = __builtin_amdgcn_mfma_f32_32x32x16_bf16(pa3, PK(l3, h3), od, 0, 0, 0);
#undef PK
}
__device__ __forceinline__ void pv_d0(f32x16* o, int vb, bf16x8 pa0, bf16x8 pa1, bf16x8 pa2, bf16x8 pa3) {
    pv_one<0>(o[0], vb, pa0, pa1, pa2, pa3); pv_one<1>(o[1], vb, pa0, pa1, pa2, pa3); pv_one<2>(o[2], vb, pa0, pa1, pa2, pa3); pv_one<3>(o[3], vb, pa0, pa1, pa2, pa3);
}
constexpr float ATT_THR = 8.f;
__device__ __forceinline__ void partialSM(f32x16& p0, f32x16& p1, float& m_reg, float& mn, float& alpha, float C, float thr_raw) {
    float pmax = p0[0];
#pragma unroll
    for (int r = 1; r < 16; ++r) pmax = fmaxf(pmax, p0[r]);
#pragma unroll
    for (int r = 0; r < 16; ++r) pmax = fmaxf(pmax, p1[r]);
    { auto rr = __builtin_amdgcn_permlane32_swap(__float_as_uint(pmax), __float_as_uint(pmax), false, false);
      pmax = fmaxf(__uint_as_float(rr[0]), __uint_as_float(rr[1])); }
    if (__builtin_expect(__all(pmax - m_reg <= thr_raw), 1)) { mn = m_reg; alpha = 1.f; }
    else { mn = fmaxf(m_reg, pmax); alpha = __builtin_amdgcn_exp2f((m_reg - mn) * C); m_reg = mn; }
    const float mnC = -mn * C;
#pragma unroll
    for (int r = 0; r < 16; ++r) p0[r] = fmaf(p0[r], C, mnC);
#pragma unroll
    for (int r = 0; r < 16; ++r) p1[r] = fmaf(p1[r], C, mnC);
#pragma unroll
    for (int r = 0; r < 16; ++r) p0[r] = __builtin_amdgcn_exp2f(p0[r]);
}
__device__ __forceinline__ void finishSM(f32x16& p0, f32x16& p1, float alpha, float& l_reg, bf16x8& pa0, bf16x8& pa1, bf16x8& pa2, bf16x8& pa3) {
#pragma unroll
    for (int r = 0; r < 16; ++r) p1[r] = __builtin_amdgcn_exp2f(p1[r]);
    float ps = 0;
#pragma unroll
    for (int r = 0; r < 16; ++r) ps += p0[r];
#pragma unroll
    for (int r = 0; r < 16; ++r) ps += p1[r];
    { auto rr = __builtin_amdgcn_permlane32_swap(__float_as_uint(ps), __float_as_uint(ps), false, false);
      ps = __uint_as_float(rr[0]) + __uint_as_float(rr[1]); }
    l_reg = l_reg * alpha + ps;
#define PK4(P, BASE, OUT) do { unsigned a0 = cvtpk(P[BASE + 0], P[BASE + 1]), a1 = cvtpk(P[BASE + 2], P[BASE + 3]);   \
    unsigned b0 = cvtpk(P[BASE + 4], P[BASE + 5]), b1 = cvtpk(P[BASE + 6], P[BASE + 7]);                              \
    auto r0 = __builtin_amdgcn_permlane32_swap(a0, b0, false, false); auto r1 = __builtin_amdgcn_permlane32_swap(a1, b1, false, false); \
    u32x4 w = {r0[0], r1[0], r0[1], r1[1]}; OUT = *reinterpret_cast<bf16x8*>(&w); } while (0)
    PK4(p0, 0, pa0); PK4(p0, 8, pa1); PK4(p1, 0, pa2); PK4(p1, 8, pa3);
#undef PK4
}
template <int DQK> __device__ __forceinline__ void qkt(f32x16& p0, f32x16& p1, const char* Ks, const bf16x8* qr, int r32, int hi) {
    constexpr int KP = DQK * 2 + 16;
    p0 = f32x16{}; p1 = f32x16{};
#pragma unroll
    for (int d0 = 0; d0 < DQK / 16; ++d0) { const int cb = (d0 * 16 + hi * 8) * 2;
        const bf16x8 b0 = *reinterpret_cast<const bf16x8*>(Ks + r32 * KP + cb);
        const bf16x8 b1 = *reinterpret_cast<const bf16x8*>(Ks + (32 + r32) * KP + cb);
        p0 = __builtin_amdgcn_mfma_f32_32x32x16_bf16(b0, qr[d0], p0, 0, 0, 0);
        p1 = __builtin_amdgcn_mfma_f32_32x32x16_bf16(b1, qr[d0], p1, 0, 0, 0); }
}
template <int DQK> constexpr int att_lds_bytes() { return 2 * 64 * 128 * 2 + 2 * 64 * (DQK * 2 + 16) + NWAVES * 64 * 4; }
template <int DQK, int LDQ, int LDK, int LDV, int LDO>
__device__ __forceinline__ void attn_body(const bf16_t* __restrict__ Qb, const bf16_t* __restrict__ Kh, const bf16_t* __restrict__ Vh, bf16_t* __restrict__ Ob, int seq, float scale, char* lds) {
    constexpr int KP = DQK * 2 + 16, SHM_V = 64 * 128 * 2, SHM_K = 64 * KP, ND = DQK / 16, CH = DQK / 8, NKL = CH * 64 / NTHREADS;
    const float C = scale * 1.4426950408889634f, thr_raw = ATT_THR / scale;
    const int tid = threadIdx.x, wid = tid >> 6, lane = tid & 63, r32 = lane & 31, hi = lane >> 5;
    char* V_lds = lds; char* K_lds = lds + 2 * SHM_V;
    float* wsf = (float*)(lds + 2 * SHM_V + 2 * SHM_K) + wid * 64; float* li_l = wsf; float* al_l = wsf + 32;
    float m_reg = -1e30f, l_reg = 0; f32x16 o[4] = {}; bf16x8 qr[ND];
    const bf16_t* Qw = Qb + (long)(wid * 32 + r32) * LDQ + hi * 8;
#pragma unroll
    for (int d0 = 0; d0 < ND; ++d0) qr[d0] = *reinterpret_cast<const bf16x8*>(Qw + d0 * 16);
    const int sr = tid >> 4, sc = (tid & 15) * 8, vst0 = v_st(sr, sc), vst1 = v_st(32 + sr, sc);
    static_assert(DQK == 128, "double-pipelined body: 128-wide q.k only");
    const int vb0 = (int)(uintptr_t)V_lds + v_rd_base(lane);
    bf16x8 vs0, vs1, ks[NKL];
#define SLOAD(k0) do { vs0 = *reinterpret_cast<const bf16x8*>(&Vh[(long)((k0) + sr) * LDV + sc]); vs1 = *reinterpret_cast<const bf16x8*>(&Vh[(long)((k0) + 32 + sr) * LDV + sc]); \
    _Pragma("unroll") for (int i_ = 0; i_ < NKL; ++i_) ks[i_] = *reinterpret_cast<const bf16x8*>(&Kh[(long)((k0) + sr + 32 * i_) * LDK + sc]); } while (0)
#define SWRITE(b) do { *(bf16x8*)(V_lds + (b) * SHM_V + vst0) = vs0; *(bf16x8*)(V_lds + (b) * SHM_V + vst1) = vs1; \
    _Pragma("unroll") for (int i_ = 0; i_ < NKL; ++i_) *(bf16x8*)(K_lds + (b) * SHM_K + (sr + 32 * i_) * KP + sc * 2) = ks[i_]; } while (0)
#define RESC(a) do { if (__any((a) < 1.f)) { if (hi == 0) al_l[r32] = (a); asm volatile("s_waitcnt lgkmcnt(0)" ::: "memory"); \
    _Pragma("unroll") for (int d = 0; d < 4; ++d) _Pragma("unroll") for (int r = 0; r < 16; ++r) o[d][r] *= al_l[crow(r, hi)]; } } while (0)
    f32x16 pA0, pA1, pB0, pB1; float mnA, mnB, alA, alB; bf16x8 pa0, pa1, pa2, pa3; const int NT = seq / 64;
    SLOAD(0); asm volatile("s_waitcnt vmcnt(0)" ::: "memory"); SWRITE(0); __syncthreads();
    qkt<DQK>(pA0, pA1, K_lds, qr, r32, hi); partialSM(pA0, pA1, m_reg, mnA, alA, C, thr_raw);
    SLOAD(64);
    asm volatile("s_waitcnt vmcnt(0)" ::: "memory"); SWRITE(1); __syncthreads();
    for (int j = 1; j + 1 < NT; j += 2) {
        SBAR(); qkt<DQK>(pB0, pB1, K_lds + SHM_K, qr, r32, hi);
        finishSM(pA0, pA1, alA, l_reg, pa0, pa1, pa2, pa3); SBAR();
        SLOAD((j + 1) * 64); SBAR();
        pv_d0(o, vb0, pa0, pa1, pa2, pa3); partialSM(pB0, pB1, m_reg, mnB, alB, C, thr_raw);
        __syncthreads(); asm volatile("s_waitcnt vmcnt(0)" ::: "memory"); SWRITE(0);
        RESC(alB); __syncthreads();
        SBAR(); qkt<DQK>(pA0, pA1, K_lds, qr, r32, hi);
        finishSM(pB0, pB1, alB, l_reg, pa0, pa1, pa2, pa3); SBAR();
        SLOAD((j + 2) * 64); SBAR();
        pv_d0(o, vb0 + SHM_V, pa0, pa1, pa2, pa3); partialSM(pA0, pA1, m_reg, mnA, alA, C, thr_raw);
        __syncthreads(); asm volatile("s_waitcnt vmcnt(0)" ::: "memory"); SWRITE(1);
        RESC(alA); __syncthreads();
    }
    SBAR(); qkt<DQK>(pB0, pB1, K_lds + SHM_K, qr, r32, hi);
    finishSM(pA0, pA1, alA, l_reg, pa0, pa1, pa2, pa3); SBAR();
    pv_d0(o, vb0, pa0, pa1, pa2, pa3); partialSM(pB0, pB1, m_reg, mnB, alB, C, thr_raw);
    __syncthreads(); RESC(alB);
    finishSM(pB0, pB1, alB, l_reg, pa0, pa1, pa2, pa3); SBAR();
    pv_d0(o, vb0 + SHM_V, pa0, pa1, pa2, pa3);
    if (hi == 0) li_l[r32] = l_reg; asm volatile("s_waitcnt lgkmcnt(0)" ::: "memory");
    float rli[16];
#pragma unroll
    for (int r = 0; r < 16; ++r) rli[r] = __builtin_amdgcn_rcpf(li_l[crow(r, hi)]);
    bf16_t* Ow = Ob + (long)(wid * 32) * LDO;
#pragma unroll
    for (int r = 0; r < 16; ++r) { const int orow = crow(r, hi);
#pragma unroll
        for (int d0 = 0; d0 < 4; ++d0) Ow[(long)orow * LDO + d0 * 32 + r32] = (bf16_t)f2bf(o[d0][r] * rli[r]); }
    __syncthreads();
#undef SLOAD
#undef SWRITE
#undef RESC
}
template <int DQK, int LDQ, int LDK, int LDV, int LDO>
__device__ __forceinline__ void attn_body_single(const bf16_t* __restrict__ Qb, const bf16_t* __restrict__ Kh, const bf16_t* __restrict__ Vh, bf16_t* __restrict__ Ob, int seq, float scale, char* lds, int rope_t0) {
    constexpr int KP = DQK * 2 + 16, SHM_V = 64 * 128 * 2, SHM_K = 64 * KP, ND = DQK / 16, CH = DQK / 8, NKL = CH * 64 / NTHREADS;
    const float C = scale * 1.4426950408889634f, thr_raw = ATT_THR / scale;
    const int tid = threadIdx.x, wid = tid >> 6, lane = tid & 63, r32 = lane & 31, hi = lane >> 5;
    char* V_lds = lds; char* K_lds = lds + 2 * SHM_V;
    float* wsf = (float*)(lds + 2 * SHM_V + 2 * SHM_K) + wid * 64; float* li_l = wsf; float* al_l = wsf + 32;
    float m_reg = -1e30f, l_reg = 0; f32x16 o[4] = {}; bf16x8 qr[ND];
    const bf16_t* Qw = Qb + (long)(wid * 32 + r32) * LDQ + hi * 8;
#pragma unroll
    for (int d0 = 8; d0 < ND; ++d0) qr[d0] = *reinterpret_cast<const bf16x8*>(Qw + d0 * 16);
    if constexpr (DQK == 192) {
        if (rope_t0 >= 0) {
            const int tq = rope_t0 + wid * 32 + r32; const float prow = (float)(tq >> 6), pcol = (float)(tq & 63);
            u32x4 fa1 = __builtin_bit_cast(u32x4, qr[8]), fa2 = __builtin_bit_cast(u32x4, qr[9]), fb1 = __builtin_bit_cast(u32x4, qr[10]), fb2 = __builtin_bit_cast(u32x4, qr[11]);
#pragma unroll
            for (int jj = 0; jj < 4; ++jj) {
                float na1[2], na2[2], nb1[2], nb2[2];
#pragma unroll
                for (int e = 0; e < 2; ++e) { const float invf = __powf(10000.f, -(float)(hi * 8 + 2 * jj + e) * (1.f / 16.f));
                    const float ar = prow * invf, ac = pcol * invf, cr = __cosf(ar), sr_ = __sinf(ar), cc = __cosf(ac), sc_ = __sinf(ac);
                    const float a1 = e ? bfhi(fa1[jj]) : bflo(fa1[jj]), a2 = e ? bfhi(fa2[jj]) : bflo(fa2[jj]), b1 = e ? bfhi(fb1[jj]) : bflo(fb1[jj]), b2 = e ? bfhi(fb2[jj]) : bflo(fb2[jj]);
                    na1[e] = a1 * cr - a2 * sr_; na2[e] = a2 * cr + a1 * sr_; nb1[e] = b1 * cc - b2 * sc_; nb2[e] = b2 * cc + b1 * sc_; }
                fa1[jj] = pk2(na1[0], na1[1]); fa2[jj] = pk2(na2[0], na2[1]); fb1[jj] = pk2(nb1[0], nb1[1]); fb2[jj] = pk2(nb2[0], nb2[1]);
            }
            qr[8] = __builtin_bit_cast(bf16x8, fa1); qr[9] = __builtin_bit_cast(bf16x8, fa2); qr[10] = __builtin_bit_cast(bf16x8, fb1); qr[11] = __builtin_bit_cast(bf16x8, fb2);
        }
    }
    asm volatile("" ::: "memory");
#pragma unroll
    for (int d0 = 0; d0 < 8; ++d0) qr[d0] = *reinterpret_cast<const bf16x8*>(Qw + d0 * 16);
    const int sr = tid >> 4, sc = (tid & 15) * 8, vst0 = v_st(sr, sc), vst1 = v_st(32 + sr, sc);
    int krow[NKL], kch[NKL];
#pragma unroll
    for (int i = 0; i < NKL; ++i) { const int id = tid + i * NTHREADS; krow[i] = id / CH; kch[i] = id % CH; }
    const int vb0 = (int)(uintptr_t)V_lds + v_rd_base(lane);
    bf16x8 vs0, vs1, ks[NKL];
#define SLOAD(k0) do { vs0 = *reinterpret_cast<const bf16x8*>(&Vh[(long)((k0) + sr) * LDV + sc]); vs1 = *reinterpret_cast<const bf16x8*>(&Vh[(long)((k0) + 32 + sr) * LDV + sc]); \
    _Pragma("unroll") for (int i_ = 0; i_ < NKL; ++i_) ks[i_] = *reinterpret_cast<const bf16x8*>(&Kh[(long)((k0) + krow[i_]) * LDK + kch[i_] * 8]); } while (0)
#define SWRITE(b) do { *(bf16x8*)(V_lds + (b) * SHM_V + vst0) = vs0; *(bf16x8*)(V_lds + (b) * SHM_V + vst1) = vs1; \
    _Pragma("unroll") for (int i_ = 0; i_ < NKL; ++i_) *(bf16x8*)(K_lds + (b) * SHM_K + krow[i_] * KP + kch[i_] * 16) = ks[i_]; } while (0)
#define RESC(a) do { if (__any((a) < 1.f)) { if (hi == 0) al_l[r32] = (a); asm volatile("s_waitcnt lgkmcnt(0)" ::: "memory"); \
    _Pragma("unroll") for (int d = 0; d < 4; ++d) _Pragma("unroll") for (int r = 0; r < 16; ++r) o[d][r] *= al_l[crow(r, hi)]; } } while (0)
    f32x16 p0, p1; float mn, al; bf16x8 pa0, pa1, pa2, pa3; const int NT = seq / 64;
    SLOAD(0); asm volatile("s_waitcnt vmcnt(0)" ::: "memory"); SWRITE(0); __syncthreads();
    SLOAD(64);
    for (int j = 0; j < NT; ++j) {
        const int b = j & 1;
        SBAR(); qkt<DQK>(p0, p1, K_lds + b * SHM_K, qr, r32, hi);
        partialSM(p0, p1, m_reg, mn, al, C, thr_raw);
        RESC(al);
        finishSM(p0, p1, al, l_reg, pa0, pa1, pa2, pa3); SBAR();
        pv_d0(o, vb0 + b * SHM_V, pa0, pa1, pa2, pa3);
        if (j + 1 < NT) { asm volatile("s_waitcnt vmcnt(0)" ::: "memory"); SWRITE(b ^ 1); }
        __syncthreads();
        if (j + 2 < NT) SLOAD((j + 2) * 64);
    }
    if (hi == 0) li_l[r32] = l_reg; asm volatile("s_waitcnt lgkmcnt(0)" ::: "memory");
    float rli[16];
#pragma unroll
    for (int r = 0; r < 16; ++r) rli[r] = __builtin_amdgcn_rcpf(li_l[crow(r, hi)]);
    bf16_t* Ow = Ob + (long)(wid * 32) * LDO;
#pragma unroll
    for (int r = 0; r < 16; ++r) { const int orow = crow(r, hi);
#pragma unroll
        for (int d0 = 0; d0 < 4; ++d0) Ow[(long)orow * LDO + d0 * 32 + r32] = (bf16_t)f2bf(o[d0][r] * rli[r]); }
    __syncthreads();
#undef SLOAD
#undef SWRITE
#undef RESC
}
#define F8_ONE 0x7f7f7f7f
template <int DQK> __device__ __forceinline__ void qkt8(f32x16& p0, f32x16& p1, const char* Ks, const i32x8* qr, int r32, int hi) {
    constexpr int KP = DQK + 16;
    p0 = f32x16{}; p1 = f32x16{};
#pragma unroll
    for (int c = 0; c < DQK / 64; ++c) { const int cb = c * 64 + hi * 32;
        const u32x4 a0 = *reinterpret_cast<const u32x4*>(Ks + r32 * KP + cb), a1 = *reinterpret_cast<const u32x4*>(Ks + r32 * KP + cb + 16);
        const u32x4 b0 = *reinterpret_cast<const u32x4*>(Ks + (32 + r32) * KP + cb), b1 = *reinterpret_cast<const u32x4*>(Ks + (32 + r32) * KP + cb + 16);
        const i32x8 A = {(int)a0.x, (int)a0.y, (int)a0.z, (int)a0.w, (int)a1.x, (int)a1.y, (int)a1.z, (int)a1.w}, B = {(int)b0.x, (int)b0.y, (int)b0.z, (int)b0.w, (int)b1.x, (int)b1.y, (int)b1.z, (int)b1.w};
        p0 = __builtin_amdgcn_mfma_scale_f32_32x32x64_f8f6f4(A, qr[c], p0, 0, 0, 0, F8_ONE, 0, F8_ONE);
        p1 = __builtin_amdgcn_mfma_scale_f32_32x32x64_f8f6f4(B, qr[c], p1, 0, 0, 0, F8_ONE, 0, F8_ONE); }
}
__device__ __forceinline__ i32x8 q32_to_fp8(const bf16_t* p) {
    i32x8 r;
#pragma unroll
    for (int w = 0; w < 4; ++w) { const u32x4 v = *reinterpret_cast<const u32x4*>(p + 8 * w);
        r[2 * w] = (int)f8x4(bflo(v.x), bfhi(v.x), bflo(v.y), bfhi(v.y)); r[2 * w + 1] = (int)f8x4(bflo(v.z), bfhi(v.z), bflo(v.w), bfhi(v.w)); }
    return r;
}
__device__ __forceinline__ i32x8 q32_rope_fp8(const bf16_t* p, float pos) {
    float x[32];
#pragma unroll
    for (int w = 0; w < 4; ++w) { const u32x4 v = *reinterpret_cast<const u32x4*>(p + 8 * w);
#pragma unroll
        for (int e = 0; e < 4; ++e) { x[8 * w + 2 * e] = bflo(v[e]); x[8 * w + 2 * e + 1] = bfhi(v[e]); } }
    float y[32];
#pragma unroll
    for (int i = 0; i < 16; ++i) { const float ang = pos * __powf(10000.f, -(float)i * (1.f / 16.f)), cs = __cosf(ang), sn = __sinf(ang);
        y[i] = x[i] * cs - x[16 + i] * sn; y[16 + i] = x[16 + i] * cs + x[i] * sn; }
    i32x8 r;
#pragma unroll
    for (int w = 0; w < 8; ++w) r[w] = (int)f8x4(y[4 * w], y[4 * w + 1], y[4 * w + 2], y[4 * w + 3]);
    return r;
}
template <int DQK, int LDQ, int LDK, int LDV, int LDO>
__device__ __forceinline__ void attn8_body(const bf16_t* __restrict__ Qb, const unsigned char* __restrict__ Kh, const bf16_t* __restrict__ Vh, bf16_t* __restrict__ Ob, int seq, float scale, char* lds) {
    constexpr int KP = DQK + 16, SHM_V = 64 * 128 * 2, SHM_K = 64 * KP, NC = DQK / 64;
    static_assert(DQK == 128, "double-pipelined body: 128-wide q.k only");
    const float C = scale * 1.4426950408889634f, thr_raw = ATT_THR / scale;
    const int tid = threadIdx.x, wid = tid >> 6, lane = tid & 63, r32 = lane & 31, hi = lane >> 5;
    char* V_lds = lds; char* K_lds = lds + 2 * SHM_V;
    float* wsf = (float*)(lds + 2 * SHM_V + 2 * SHM_K) + wid * 64; float* li_l = wsf; float* al_l = wsf + 32;
    float m_reg = -1e30f, l_reg = 0; f32x16 o[4] = {}; i32x8 qr[NC];
    const bf16_t* Qw = Qb + (long)(wid * 32 + r32) * LDQ + hi * 32;
#pragma unroll
    for (int c = 0; c < NC; ++c) qr[c] = q32_to_fp8(Qw + 64 * c);
    const int sr = tid >> 4, sc = (tid & 15) * 8, vst0 = v_st(sr, sc), vst1 = v_st(32 + sr, sc);
    const int krow = tid >> 3, kch = (tid & 7) * 16;
    const int vb0 = (int)(uintptr_t)V_lds + v_rd_base(lane);
    bf16x8 vs0, vs1; u32x4 ks;
#define SLOAD(k0) do { vs0 = *reinterpret_cast<const bf16x8*>(&Vh[(long)((k0) + sr) * LDV + sc]); vs1 = *reinterpret_cast<const bf16x8*>(&Vh[(long)((k0) + 32 + sr) * LDV + sc]); \
    ks = *reinterpret_cast<const u32x4*>(&Kh[(long)((k0) + krow) * LDK + kch]); } while (0)
#define SWRITE(b) do { *(bf16x8*)(V_lds + (b) * SHM_V + vst0) = vs0; *(bf16x8*)(V_lds + (b) * SHM_V + vst1) = vs1; \
    *(u32x4*)(K_lds + (b) * SHM_K + krow * KP + kch) = ks; } while (0)
#define RESC(a) do { if (__any((a) < 1.f)) { if (hi == 0) al_l[r32] = (a); asm volatile("s_waitcnt lgkmcnt(0)" ::: "memory"); \
    _Pragma("unroll") for (int d = 0; d < 4; ++d) _Pragma("unroll") for (int r = 0; r < 16; ++r) o[d][r] *= al_l[crow(r, hi)]; } } while (0)
    f32x16 pA0, pA1, pB0, pB1; float mnA, mnB, alA, alB; bf16x8 pa0, pa1, pa2, pa3; const int NT = seq / 64;
    SLOAD(0); asm volatile("s_waitcnt vmcnt(0)" ::: "memory"); SWRITE(0); __syncthreads();
    qkt8<DQK>(pA0, pA1, K_lds, qr, r32, hi); partialSM(pA0, pA1, m_reg, mnA, alA, C, thr_raw);
    SLOAD(64);
    asm volatile("s_waitcnt vmcnt(0)" ::: "memory"); SWRITE(1); __syncthreads();
    for (int j = 1; j + 1 < NT; j += 2) {
        SBAR(); qkt8<DQK>(pB0, pB1, K_lds + SHM_K, qr, r32, hi);
        finishSM(pA0, pA1, alA, l_reg, pa0, pa1, pa2, pa3); SBAR();
        SLOAD((j + 1) * 64); SBAR();
        pv_d0(o, vb0, pa0, pa1, pa2, pa3); partialSM(pB0, pB1, m_reg, mnB, alB, C, thr_raw);
        __syncthreads(); asm volatile("s_waitcnt vmcnt(0)" ::: "memory"); SWRITE(0);
        RESC(alB); __syncthreads();
        SBAR(); qkt8<DQK>(pA0, pA1, K_lds, qr, r32, hi);
        finishSM(pB0, pB1, alB, l_reg, pa0, pa1, pa2, pa3); SBAR();
        SLOAD((j + 2) * 64); SBAR();
        pv_d0(o, vb0 + SHM_V, pa0, pa1, pa2, pa3); partialSM(pA0, pA1, m_reg, mnA, alA, C, thr_raw);
        __syncthreads(); asm volatile("s_waitcnt vmcnt(0)" ::: "memory"); SWRITE(1);
        RESC(alA); __syncthreads();
    }
    SBAR(); qkt8<DQK>(pB0, pB1, K_lds + SHM_K, qr, r32, hi);
    finishSM(pA0, pA1, alA, l_reg, pa0, pa1, pa2, pa3); SBAR();
    pv_d0(o, vb0, pa0, pa1, pa2, pa3); partialSM(pB0, pB1, m_reg, mnB, alB, C, thr_raw);
    __syncthreads(); RESC(alB);
    finishSM(pB0, pB1, alB, l_reg, pa0, pa1, pa2, pa3); SBAR();
    pv_d0(o, vb0 + SHM_V, pa0, pa1, pa2, pa3);
    if (hi == 0) li_l[r32] = l_reg; asm volatile("s_waitcnt lgkmcnt(0)" ::: "memory");
    float rli[16];
#pragma unroll
    for (int r = 0; r < 16; ++r) rli[r] = __builtin_amdgcn_rcpf(li_l[crow(r, hi)]);
    bf16_t* Ow = Ob + (long)(wid * 32) * LDO;
#pragma unroll
    for (int r = 0; r < 16; ++r) { const int orow = crow(r, hi);
#pragma unroll
        for (int d0 = 0; d0 < 4; ++d0) Ow[(long)orow * LDO + d0 * 32 + r32] = (bf16_t)f2bf(o[d0][r] * rli[r]); }
    __syncthreads();
#undef SLOAD
#undef SWRITE
#undef RESC
}
template <int DQK, int LDQ, int LDK, int LDV, int LDO>
__device__ __forceinline__ void attn8_body_single(const bf16_t* __restrict__ Qb, const unsigned char* __restrict__ Kh, const bf16_t* __restrict__ Vh, bf16_t* __restrict__ Ob, int seq, float scale, char* lds, int rope_t0) {
    constexpr int KP = DQK + 16, SHM_V = 64 * 128 * 2, SHM_K = 64 * KP, NC = DQK / 64, CH = DQK / 16, NCH = 64 * CH, NKL = (NCH + NTHREADS - 1) / NTHREADS;
    const float C = scale * 1.4426950408889634f, thr_raw = ATT_THR / scale;
    const int tid = threadIdx.x, wid = tid >> 6, lane = tid & 63, r32 = lane & 31, hi = lane >> 5;
    char* V_lds = lds; char* K_lds = lds + 2 * SHM_V;
    float* wsf = (float*)(lds + 2 * SHM_V + 2 * SHM_K) + wid * 64; float* li_l = wsf; float* al_l = wsf + 32;
    float m_reg = -1e30f, l_reg = 0; f32x16 o[4] = {}; i32x8 qr[NC];
    const bf16_t* Qw = Qb + (long)(wid * 32 + r32) * LDQ + hi * 32;
    if constexpr (DQK == 192) {
        if (rope_t0 >= 0) { const int tq = rope_t0 + wid * 32 + r32; qr[2] = q32_rope_fp8(Qw + 128, (float)(hi ? (tq & 63) : (tq >> 6))); }
        else qr[2] = q32_to_fp8(Qw + 128);
    }
    asm volatile("" ::: "memory");
#pragma unroll
    for (int c = 0; c < 2; ++c) qr[c] = q32_to_fp8(Qw + 64 * c);
    const int sr = tid >> 4, sc = (tid & 15) * 8, vst0 = v_st(sr, sc), vst1 = v_st(32 + sr, sc);
    int krow[NKL], kch[NKL];
#pragma unroll
    for (int i = 0; i < NKL; ++i) { const int id = tid + i * NTHREADS; krow[i] = (id < NCH) ? id / CH : 0; kch[i] = (id % CH) * 16; }
    const bool k2 = (NKL < 2) || (tid + NTHREADS < NCH);
    const int vb0 = (int)(uintptr_t)V_lds + v_rd_base(lane);
    bf16x8 vs0, vs1; u32x4 ks[NKL];
#define SLOAD(k0) do { vs0 = *reinterpret_cast<const bf16x8*>(&Vh[(long)((k0) + sr) * LDV + sc]); vs1 = *reinterpret_cast<const bf16x8*>(&Vh[(long)((k0) + 32 + sr) * LDV + sc]); \
    _Pragma("unroll") for (int i_ = 0; i_ < NKL; ++i_) ks[i_] = *reinterpret_cast<const u32x4*>(&Kh[(long)((k0) + krow[i_]) * LDK + kch[i_]]); } while (0)
#define SWRITE(b) do { *(bf16x8*)(V_lds + (b) * SHM_V + vst0) = vs0; *(bf16x8*)(V_lds + (b) * SHM_V + vst1) = vs1; \
    _Pragma("unroll") for (int i_ = 0; i_ < NKL; ++i_) if (i_ == 0 || k2) *(u32x4*)(K_lds + (b) * SHM_K + krow[i_] * KP + kch[i_]) = ks[i_]; } while (0)
#define RESC(a) do { if (__any((a) < 1.f)) { if (hi == 0) al_l[r32] = (a); asm volatile("s_waitcnt lgkmcnt(0)" ::: "memory"); \
    _Pragma("unroll") for (int d = 0; d < 4; ++d) _Pragma("unroll") for (int r = 0; r < 16; ++r) o[d][r] *= al_l[crow(r, hi)]; } } while (0)
    f32x16 p0, p1; float mn, al; bf16x8 pa0, pa1, pa2, pa3; const int NT = seq / 64;
    SLOAD(0); asm volatile("s_waitcnt vmcnt(0)" ::: "memory"); SWRITE(0); __syncthreads();
    SLOAD(64);
    for (int j = 0; j < NT; ++j) {
        const int b = j & 1;
        SBAR(); qkt8<DQK>(p0, p1, K_lds + b * SHM_K, qr, r32, hi);
        partialSM(p0, p1, m_reg, mn, al, C, thr_raw);
        RESC(al);
        finishSM(p0, p1, al, l_reg, pa0, pa1, pa2, pa3); SBAR();
        pv_d0(o, vb0 + b * SHM_V, pa0, pa1, pa2, pa3);
        if (j + 1 < NT) { asm volatile("s_waitcnt vmcnt(0)" ::: "memory"); SWRITE(b ^ 1); }
        __syncthreads();
        if (j + 2 < NT) SLOAD((j + 2) * 64);
    }
    if (hi == 0) li_l[r32] = l_reg; asm volatile("s_waitcnt lgkmcnt(0)" ::: "memory");
    float rli[16];
#pragma unroll
    for (int r = 0; r < 16; ++r) rli[r] = __builtin_amdgcn_rcpf(li_l[crow(r, hi)]);
    bf16_t* Ow = Ob + (long)(wid * 32) * LDO;
#pragma unroll
    for (int r = 0; r < 16; ++r) { const int orow = crow(r, hi);
#pragma unroll
        for (int d0 = 0; d0 < 4; ++d0) Ow[(long)orow * LDO + d0 * 32 + r32] = (bf16_t)f2bf(o[d0][r] * rli[r]); }
    __syncthreads();
#undef SLOAD
#undef SWRITE
#undef RESC
}
constexpr float ATT8_THR = 3.5f, ATT8_SH = 3.f;
#ifndef ATT8_FIXED_M
#define ATT8_FIXED_M 0
#endif
__device__ __forceinline__ void partialSM8(f32x16& p0, f32x16& p1, float& m_reg, float& mn, float& alpha, float C, float thr_raw) {
#if ATT8_FIXED_M
    mn = 6.f * 1.4426950408889634f / C; alpha = 1.f; m_reg = mn;
#else
    float pmax = p0[0];
#pragma unroll
    for (int r = 1; r < 16; ++r) pmax = fmaxf(pmax, p0[r]);
#pragma unroll
    for (int r = 0; r < 16; ++r) pmax = fmaxf(pmax, p1[r]);
    { auto rr = __builtin_amdgcn_permlane32_swap(__float_as_uint(pmax), __float_as_uint(pmax), false, false);
      pmax = fmaxf(__uint_as_float(rr[0]), __uint_as_float(rr[1])); }
    if (__builtin_expect(__all(pmax - m_reg <= thr_raw), 1)) { mn = m_reg; alpha = 1.f; }
    else { mn = fmaxf(m_reg, pmax); alpha = __builtin_amdgcn_exp2f((m_reg - mn) * C); m_reg = mn; }
#endif
    const float mnC = ATT8_SH - mn * C;
#pragma unroll
    for (int r = 0; r < 16; ++r) p0[r] = fmaf(p0[r], C, mnC);
#pragma unroll
    for (int r = 0; r < 16; ++r) p1[r] = fmaf(p1[r], C, mnC);
#pragma unroll
    for (int r = 0; r < 16; ++r) p0[r] = __builtin_amdgcn_exp2f(p0[r]);
}
__device__ __forceinline__ void finishSM8(f32x16& p0, f32x16& p1, i32x8& pa) {
#pragma unroll
    for (int r = 0; r < 16; ++r) p1[r] = __builtin_amdgcn_exp2f(p1[r]);
#pragma unroll
    for (int w = 0; w < 4; ++w) { pa[w] = (int)f8x4(p0[4 * w], p0[4 * w + 1], p0[4 * w + 2], p0[4 * w + 3]); pa[4 + w] = (int)f8x4(p1[4 * w], p1[4 * w + 1], p1[4 * w + 2], p1[4 * w + 3]); }
}
__device__ __forceinline__ void finishSM8s(f32x16& p0, f32x16& p1, float alpha, float& l_reg, i32x8& pa) {
#pragma unroll
    for (int r = 0; r < 16; ++r) p1[r] = __builtin_amdgcn_exp2f(p1[r]);
    float ps = 0;
#pragma unroll
    for (int r = 0; r < 16; ++r) ps += p0[r];
#pragma unroll
    for (int r = 0; r < 16; ++r) ps += p1[r];
    { auto rr = __builtin_amdgcn_permlane32_swap(__float_as_uint(ps), __float_as_uint(ps), false, false);
      ps = __uint_as_float(rr[0]) + __uint_as_float(rr[1]); }
    l_reg = l_reg * alpha + ps;
#pragma unroll
    for (int w = 0; w < 4; ++w) { pa[w] = (int)f8x4(p0[4 * w], p0[4 * w + 1], p0[4 * w + 2], p0[4 * w + 3]); pa[4 + w] = (int)f8x4(p1[4 * w], p1[4 * w + 1], p1[4 * w + 2], p1[4 * w + 3]); }
}
typedef int i32x2 __attribute__((ext_vector_type(2)));
template <int OFF> __device__ __forceinline__ u32x2 tr8_read(int vb) { typedef i32x2 LAS* lp; const i32x2 r = __builtin_amdgcn_ds_read_tr8_b64_v2i32((lp)(uintptr_t)(unsigned)(vb + OFF)); return (u32x2){(unsigned)r.x, (unsigned)r.y}; }
#define F8_MFMA(A_, B_, C_) __builtin_amdgcn_mfma_scale_f32_32x32x64_f8f6f4(A_, B_, C_, 0, 0, 0, F8_ONE, 0, F8_ONE)
#define TR8X4(T, VB) const u32x2 T[4] = {tr8_read<0>(VB), tr8_read<2048>(VB), tr8_read<4096>(VB), tr8_read<6144>(VB)}
#define TR8B(T) (i32x8){(int)T[0].x, (int)T[0].y, (int)T[1].x, (int)T[1].y, (int)T[2].x, (int)T[2].y, (int)T[3].x, (int)T[3].y}
__device__ __forceinline__ void pv8_pairs(f32x16* o, const int* vb, int boff, const i32x8& pa) {
    { TR8X4(a, vb[0] + boff); TR8X4(b, vb[1] + boff);
      o[0] = F8_MFMA(pa, TR8B(a), o[0]);
      o[1] = F8_MFMA(pa, TR8B(b), o[1]); }
    { TR8X4(c, vb[2] + boff); TR8X4(d, vb[3] + boff);
      o[2] = F8_MFMA(pa, TR8B(c), o[2]);
      o[3] = F8_MFMA(pa, TR8B(d), o[3]); }
}
__device__ __forceinline__ void pv8_seq(f32x16* o, const int* vb, int boff, const i32x8& pa) {
    const i32x8 ones = {0x38383838, 0x38383838, 0x38383838, 0x38383838, 0x38383838, 0x38383838, 0x38383838, 0x38383838};
    { TR8X4(a, vb[0] + boff); o[4] = F8_MFMA(pa, ones, o[4]); o[0] = F8_MFMA(pa, TR8B(a), o[0]); }
    { TR8X4(b, vb[1] + boff); o[1] = F8_MFMA(pa, TR8B(b), o[1]); }
    { TR8X4(c, vb[2] + boff); o[2] = F8_MFMA(pa, TR8B(c), o[2]); }
    { TR8X4(d, vb[3] + boff); o[3] = F8_MFMA(pa, TR8B(d), o[3]); }
}
template <bool ALL16> __device__ __forceinline__ void pv8_all(f32x16* o, const int* vb, int boff, const i32x8& pa) {
    const i32x8 ones = {0x38383838, 0x38383838, 0x38383838, 0x38383838, 0x38383838, 0x38383838, 0x38383838, 0x38383838};
    if constexpr (ALL16) {
        TR8X4(a, vb[0] + boff); TR8X4(b, vb[1] + boff); TR8X4(c, vb[2] + boff); TR8X4(d, vb[3] + boff);
        o[4] = F8_MFMA(pa, ones, o[4]);
        o[0] = F8_MFMA(pa, TR8B(a), o[0]);
        o[1] = F8_MFMA(pa, TR8B(b), o[1]);
        o[2] = F8_MFMA(pa, TR8B(c), o[2]);
        o[3] = F8_MFMA(pa, TR8B(d), o[3]);
    } else {
        { TR8X4(a, vb[0] + boff); TR8X4(b, vb[1] + boff);
          o[4] = F8_MFMA(pa, ones, o[4]);
          o[0] = F8_MFMA(pa, TR8B(a), o[0]);
          o[1] = F8_MFMA(pa, TR8B(b), o[1]); }
        { TR8X4(c, vb[2] + boff); TR8X4(d, vb[3] + boff);
          o[2] = F8_MFMA(pa, TR8B(c), o[2]);
          o[3] = F8_MFMA(pa, TR8B(d), o[3]); }
    }
}
__device__ __forceinline__ int v8_f(int key) { return ((key >> 1) & 1) + 2 * ((key >> 3) & 1); }
__device__ __forceinline__ int v8_st(int key, int ch16) { return key * 128 + 32 * ((ch16 >> 1) ^ v8_f(key)) + 16 * (ch16 & 1); }
__device__ __forceinline__ int v8_rd_base(int lane, int db) {
    const int q = (lane & 15) >> 1, pp = lane & 1, g1 = (lane >> 4) & 1, hi = lane >> 5, fq = ((q >> 1) & 1) + 2 * (q >> 2);
    return (8 * (q >> 2) + 4 * hi + (q & 3)) * 128 + 32 * (db ^ fq) + 16 * g1 + 8 * pp;
}
template <int DQK, int LDQ, int LDK, int LDV, int LDO>
__device__ __forceinline__ void attn88_body(const bf16_t* __restrict__ Qb, const unsigned char* __restrict__ Kh, const unsigned char* __restrict__ Vh, bf16_t* __restrict__ Ob, int seq, float scale, char* lds) {
    constexpr int KP = DQK + 16, SHM_V = 64 * 128, SHM_K = 64 * KP, NC = DQK / 64;
    static_assert(DQK == 128, "double-pipelined body: 128-wide q.k only");
    const float C = scale * 1.4426950408889634f, thr_raw = ATT8_THR / scale;
    const int tid = threadIdx.x, wid = tid >> 6, lane = tid & 63, r32 = lane & 31, hi = lane >> 5;
    char* V_lds = lds; char* K_lds = lds + 2 * SHM_V;
    float* al_l = (float*)(lds + 2 * SHM_V + 2 * SHM_K) + wid * 32;
    float m_reg = -1e30f; f32x16 o[5] = {}; i32x8 qr[NC];
    const bf16_t* Qw = Qb + (long)(wid * 32 + r32) * LDQ + hi * 32;
#pragma unroll
    for (int c = 0; c < NC; ++c) qr[c] = q32_to_fp8(Qw + 64 * c);
    const int krow = tid >> 3, kch = (tid & 7) * 16, vst = v8_st(krow, tid & 7);
    int vb[4];
#pragma unroll
    for (int d = 0; d < 4; ++d) vb[d] = (int)(uintptr_t)V_lds + v8_rd_base(lane, d);
    u32x4 vs, ks;
#define SLOAD(k0) do { vs = *reinterpret_cast<const u32x4*>(&Vh[(long)((k0) + krow) * LDV + kch]); ks = *reinterpret_cast<const u32x4*>(&Kh[(long)((k0) + krow) * LDK + kch]); } while (0)
#define SWRITE(b) do { *(u32x4*)(V_lds + (b) * SHM_V + vst) = vs; *(u32x4*)(K_lds + (b) * SHM_K + krow * KP + kch) = ks; } while (0)
#define RESC(a) do { if (__any((a) < 1.f)) { if (hi == 0) al_l[r32] = (a); asm volatile("s_waitcnt lgkmcnt(0)" ::: "memory"); \
    _Pragma("unroll") for (int d = 0; d < 5; ++d) _Pragma("unroll") for (int r = 0; r < 16; ++r) o[d][r] *= al_l[crow(r, hi)]; } } while (0)
#define PV8(b) pv8_all<DQK == 128>(o, vb, (b) * SHM_V, pa)
    f32x16 pA0, pA1, pB0, pB1; float mnA, mnB, alA, alB; i32x8 pa; const int NT = seq / 64;
    SLOAD(0); asm volatile("s_waitcnt vmcnt(0)" ::: "memory"); SWRITE(0); __syncthreads();
    qkt8<DQK>(pA0, pA1, K_lds, qr, r32, hi); partialSM8(pA0, pA1, m_reg, mnA, alA, C, thr_raw);
    SLOAD(64);
    asm volatile("s_waitcnt vmcnt(0)" ::: "memory"); SWRITE(1); __syncthreads();
    for (int j = 1; j + 1 < NT; j += 2) {
        SBAR(); qkt8<DQK>(pB0, pB1, K_lds + SHM_K, qr, r32, hi);
        finishSM8(pA0, pA1, pa); SBAR();
        SLOAD((j + 1) * 64); SBAR();
        PV8(0); partialSM8(pB0, pB1, m_reg, mnB, alB, C, thr_raw);
        __syncthreads(); asm volatile("s_waitcnt vmcnt(0)" ::: "memory"); SWRITE(0);
        RESC(alB); __syncthreads();
        SBAR(); qkt8<DQK>(pA0, pA1, K_lds, qr, r32, hi);
        finishSM8(pB0, pB1, pa); SBAR();
        SLOAD((j + 2) * 64); SBAR();
        PV8(1); partialSM8(pA0, pA1, m_reg, mnA, alA, C, thr_raw);
        __syncthreads(); asm volatile("s_waitcnt vmcnt(0)" ::: "memory"); SWRITE(1);
        RESC(alA); __syncthreads();
    }
    SBAR(); qkt8<DQK>(pB0, pB1, K_lds + SHM_K, qr, r32, hi);
    finishSM8(pA0, pA1, pa); SBAR();
    PV8(0); partialSM8(pB0, pB1, m_reg, mnB, alB, C, thr_raw);
    __syncthreads(); RESC(alB);
    finishSM8(pB0, pB1, pa); SBAR();
    PV8(1);
    float rli[16];
#pragma unroll
    for (int r = 0; r < 16; ++r) rli[r] = __builtin_amdgcn_rcpf(o[4][r]);
    bf16_t* Ow = Ob + (long)(wid * 32) * LDO;
#pragma unroll
    for (int r = 0; r < 16; ++r) { const int orow = crow(r, hi);
#pragma unroll
        for (int d0 = 0; d0 < 4; ++d0) Ow[(long)orow * LDO + d0 * 32 + r32] = (bf16_t)f2bf(o[d0][r] * rli[r]); }
    __syncthreads();
#undef SLOAD
#undef SWRITE
}
template <int DQK, int LDQ, int LDK, int LDV, int LDO>
__device__ __forceinline__ void attn88_body_single(const bf16_t* __restrict__ Qb, const unsigned char* __restrict__ Kh, const unsigned char* __restrict__ Vh, bf16_t* __restrict__ Ob, int seq, float scale, char* lds, int rope_t0) {
    constexpr int KP = DQK + 16, SHM_V = 64 * 128, SHM_K = 64 * KP, NC = DQK / 64, CH = DQK / 16, NCH = 64 * CH, NKL = (NCH + NTHREADS - 1) / NTHREADS;
    const float C = scale * 1.4426950408889634f, thr_raw = ATT8_THR / scale;
    const int tid = threadIdx.x, wid = tid >> 6, lane = tid & 63, r32 = lane & 31, hi = lane >> 5;
    char* V_lds = lds; char* K_lds = lds + 2 * SHM_V;
    float* al_l = (float*)(lds + 2 * SHM_V + 2 * SHM_K) + wid * 32;
    float m_reg = -1e30f; i32x8 qr[NC];
    const bf16_t* Qw = Qb + (long)(wid * 32 + r32) * LDQ + hi * 32;
    if constexpr (DQK == 192) {
        if (rope_t0 >= 0) { const int tq = rope_t0 + wid * 32 + r32; qr[2] = q32_rope_fp8(Qw + 128, (float)(hi ? (tq & 63) : (tq >> 6))); }
        else qr[2] = q32_to_fp8(Qw + 128);
    }
    asm volatile("" ::: "memory");
#pragma unroll
    for (int c = 0; c < 2; ++c) qr[c] = q32_to_fp8(Qw + 64 * c);
    const int vrow = tid >> 3, vch = (tid & 7) * 16, vst = v8_st(vrow, tid & 7);
    unsigned koff[NKL]; int klds[NKL]; const unsigned voff = (unsigned)(vrow * LDV + vch);
#pragma unroll
    for (int i = 0; i < NKL; ++i) { const int id = tid + i * NTHREADS, kr = (id < NCH) ? id / CH : 0, kc = (id % CH) * 16; koff[i] = (unsigned)(kr * LDK + kc); klds[i] = kr * KP + kc; }
    const bool k2 = (NKL < 2) || (tid + NTHREADS < NCH);
    int vb[4];
#pragma unroll
    for (int d = 0; d < 4; ++d) vb[d] = (int)(uintptr_t)V_lds + v8_rd_base(lane, d);
    u32x4 vs, ks[NKL];
#define SLOAD(k0) do { const unsigned char* vt_ = Vh + (size_t)(k0) * LDV; const unsigned char* kt_ = Kh + (size_t)(k0) * LDK; vs = *reinterpret_cast<const u32x4*>(vt_ + voff); \
    _Pragma("unroll") for (int i_ = 0; i_ < NKL; ++i_) ks[i_] = *reinterpret_cast<const u32x4*>(kt_ + koff[i_]); } while (0)
#define SWRITE(b) do { *(u32x4*)(V_lds + (b) * SHM_V + vst) = vs; \
    _Pragma("unroll") for (int i_ = 0; i_ < NKL; ++i_) if (i_ == 0 || k2) *(u32x4*)(K_lds + (b) * SHM_K + klds[i_]) = ks[i_]; } while (0)
    asm volatile("" ::: "memory");
    f32x16 o[5] = {}; f32x16 p0, p1; float mn, al; i32x8 pa; const int NT = seq / 64;
    SLOAD(0); asm volatile("s_waitcnt vmcnt(0)" ::: "memory"); SWRITE(0); __syncthreads();
    SLOAD(64);
    for (int j = 0; j < NT; ++j) {
        const int b = j & 1;
        SBAR(); qkt8<DQK>(p0, p1, K_lds + b * SHM_K, qr, r32, hi);
        partialSM8(p0, p1, m_reg, mn, al, C, thr_raw);
        RESC(al);
        finishSM8(p0, p1, pa); SBAR();
        PV8(b);
        if (j + 1 < NT) { asm volatile("s_waitcnt vmcnt(0)" ::: "memory"); SWRITE(b ^ 1); }
        __syncthreads();
        if (j + 2 < NT) SLOAD((j + 2) * 64);
    }
    float rli[16];
#pragma unroll
    for (int r = 0; r < 16; ++r) rli[r] = __builtin_amdgcn_rcpf(o[4][r]);
    bf16_t* Ow = Ob + (long)(wid * 32) * LDO;
#pragma unroll
    for (int r = 0; r < 16; ++r) { const int orow = crow(r, hi);
#pragma unroll
        for (int d0 = 0; d0 < 4; ++d0) Ow[(long)orow * LDO + d0 * 32 + r32] = (bf16_t)f2bf(o[d0][r] * rli[r]); }
    __syncthreads();
#undef SLOAD
#undef SWRITE
#undef RESC
#undef PV8
}
template <int DQK, int LDQ, int LDK, int LDV, int LDO, int VAR = 0>
__device__ __forceinline__ void attn88_pp(const bf16_t* __restrict__ Qb, const unsigned char* __restrict__ Kh, const unsigned char* __restrict__ Vh, bf16_t* __restrict__ Ob, int seq, float scale, char* lds, int rope_t0) {
#define PPBAR() do { SBAR(); __syncthreads(); SBAR(); } while (0)
    constexpr int KP = DQK + 16, SHM_V = 64 * 128, SHM_K = 64 * KP, SHM_P = SHM_V + SHM_K, NC = DQK / 64, CH = DQK / 16, NCH = 64 * CH, NKL = (NCH + NTHREADS - 1) / NTHREADS;
    const float C = scale * 1.4426950408889634f, thr_raw = ATT8_THR / scale;
    const int tid = threadIdx.x, wid = __builtin_amdgcn_readfirstlane(tid >> 6), lane = tid & 63, r32 = lane & 31, hi = lane >> 5, grp = wid >> 2;
    char* P_lds = lds;
    float* al_l = (float*)(lds + 2 * SHM_P) + wid * 32;
    constexpr bool MSUM = (DQK == 128);
    float m_reg = -1e30f, l_reg = 0.f; i32x8 qr[NC];
    const bf16_t* Qw = Qb + (long)(wid * 32 + r32) * LDQ + hi * 32;
    if constexpr (DQK == 192) {
        if (rope_t0 >= 0) { const int tq = rope_t0 + wid * 32 + r32; qr[2] = q32_rope_fp8(Qw + 128, (float)(hi ? (tq & 63) : (tq >> 6))); }
        else qr[2] = q32_to_fp8(Qw + 128);
    }
    asm volatile("" ::: "memory");
#pragma unroll
    for (int c = 0; c < 2; ++c) qr[c] = q32_to_fp8(Qw + 64 * c);
    const int vrow = tid >> 3, vch = (tid & 7) * 16, vst = v8_st(vrow, tid & 7);
    unsigned koff[NKL]; int klds[NKL]; const unsigned voff = (unsigned)(vrow * LDV + vch);
#pragma unroll
    for (int i = 0; i < NKL; ++i) { const int id = tid + i * NTHREADS, kr = (id < NCH) ? id / CH : 0, kc = (id % CH) * 16; koff[i] = (unsigned)(kr * LDK + kc); klds[i] = kr * KP + kc; }
    const bool k2 = (NKL < 2) || (tid + NTHREADS < NCH);
    int vb[4];
#pragma unroll
    for (int d = 0; d < 4; ++d) vb[d] = (int)(uintptr_t)P_lds + v8_rd_base(lane, d);
    u32x4 vs, ks[NKL]; const int NT = seq / 64;
#define PLOAD(jp) do { const int jv_ = (jp) < NT ? (jp) : NT - 1, jk_ = (jp) + 1 < NT ? (jp) + 1 : NT - 1; const unsigned char* vt_ = Vh + (size_t)jv_ * 64 * LDV; const unsigned char* kt_ = Kh + (size_t)jk_ * 64 * LDK; \
    vs = *reinterpret_cast<const u32x4*>(vt_ + voff); _Pragma("unroll") for (int i_ = 0; i_ < NKL; ++i_) ks[i_] = *reinterpret_cast<const u32x4*>(kt_ + koff[i_]); } while (0)
#define PWRITE(b) do { *(u32x4*)(P_lds + (b) * SHM_P + vst) = vs; \
    _Pragma("unroll") for (int i_ = 0; i_ < NKL; ++i_) if (i_ == 0 || k2) *(u32x4*)(P_lds + (b) * SHM_P + SHM_V + klds[i_]) = ks[i_]; } while (0)
#define RESC(a) do { if (__any((a) < 1.f)) { if (hi == 0) al_l[r32] = (a); asm volatile("s_waitcnt lgkmcnt(0)" ::: "memory"); \
    _Pragma("unroll") for (int d = 0; d < (MSUM ? 5 : 4); ++d) _Pragma("unroll") for (int r = 0; r < 16; ++r) o[d][r] *= al_l[crow(r, hi)]; } } while (0)
    asm volatile("" ::: "memory");
    f32x16 o[5] = {}; f32x16 p0 = {}, p1 = {}; float mn, al; i32x8 pa = {};
    { const unsigned char* kt_ = Kh;
#pragma unroll
      for (int i_ = 0; i_ < NKL; ++i_) ks[i_] = *reinterpret_cast<const u32x4*>(kt_ + koff[i_]);
      asm volatile("s_waitcnt vmcnt(0)" ::: "memory");
#pragma unroll
      for (int i_ = 0; i_ < NKL; ++i_) if (i_ == 0 || k2) *(u32x4*)(P_lds + SHM_P + SHM_V + klds[i_]) = ks[i_]; }
    PLOAD(0); asm volatile("s_waitcnt vmcnt(0)" ::: "memory"); PWRITE(0);
    PLOAD(1);
    PPBAR();
#define STAGE(j_) do { if (!(VAR & 4) && (j_) + 1 < NT) { asm volatile("s_waitcnt vmcnt(0)" ::: "memory"); PWRITE(((j_) + 1) & 1); if ((j_) + 2 < NT) PLOAD((j_) + 2); } } while (0)
#define HALF_A() do { if (VAR & 1) { _Pragma("unroll") for (int w_ = 0; w_ < 8; ++w_) pa[w_] = (int)__float_as_uint(w_ < 4 ? p0[4 * w_] : p1[4 * w_ - 16]); break; } partialSM8(p0, p1, m_reg, mn, al, C, thr_raw); RESC(al); if constexpr (MSUM) finishSM8(p0, p1, pa); else finishSM8s(p0, p1, al, l_reg, pa); asm volatile("" : "+v"(pa)); } while (0)
#define HALF_B(j_) do { if (VAR & 2) { _Pragma("unroll") for (int r_ = 0; r_ < 16; ++r_) { p0[r_] = __uint_as_float((unsigned)pa[r_ & 7]) * 1e-30f + (float)r_; p1[r_] = p0[r_] + 1.f; } o[0][(j_) & 15] += p0[3]; break; } const int boff_ = ((j_) & 1) * SHM_P; if constexpr (MSUM) pv8_all<true>(o, vb, boff_, pa); else pv8_pairs(o, vb, boff_, pa); if ((j_) + 1 < NT) { SBAR(); qkt8<DQK>(p0, p1, P_lds + boff_ + SHM_V, qr, r32, hi); asm volatile("" : "+v"(p0), "+v"(p1)); } } while (0)
    if (grp == 0) {
        qkt8<DQK>(p0, p1, P_lds + SHM_P + SHM_V, qr, r32, hi); PPBAR();
#pragma unroll 1
        for (int j = 0; j < NT; ++j) {
            HALF_A(); PPBAR();
            STAGE(j); HALF_B(j); PPBAR();
        }
        PPBAR();
    } else {
        PPBAR();
        qkt8<DQK>(p0, p1, P_lds + SHM_P + SHM_V, qr, r32, hi); PPBAR();
#pragma unroll 1
        for (int j = 0; j < NT; ++j) {
            STAGE(j); HALF_A(); PPBAR();
            HALF_B(j); PPBAR();
        }
    }
#undef STAGE
#undef HALF_A
#undef HALF_B
    float rli[16];
    if constexpr (MSUM) {
#pragma unroll
        for (int r = 0; r < 16; ++r) rli[r] = __builtin_amdgcn_rcpf(o[4][r]);
    } else {
        if (hi == 0) al_l[r32] = l_reg; asm volatile("s_waitcnt lgkmcnt(0)" ::: "memory");
#pragma unroll
        for (int r = 0; r < 16; ++r) rli[r] = __builtin_amdgcn_rcpf(al_l[crow(r, hi)]);
    }
    { int t2 = threadIdx.x; asm volatile("" : "+v"(t2));
      const int w2 = t2 >> 6, r2 = t2 & 31, h2 = (t2 >> 5) & 1;
      bf16_t* Ow = Ob + (long)(w2 * 32) * LDO;
#pragma unroll
      for (int r = 0; r < 16; ++r) { const int orow = crow(r, h2);
#pragma unroll
          for (int d0 = 0; d0 < 4; ++d0) Ow[(long)orow * LDO + d0 * 32 + r2] = (bf16_t)f2bf(o[d0][r] * rli[r]); } }
    PPBAR();
#undef PLOAD
#undef PWRITE
#undef RESC
#undef PPBAR
}
#ifndef ATTN_PP
#define ATTN_PP 1
#endif
#if ATTN_PP
#define ATTN_MLA attn88_body_single
#define ATTN_GQA attn88_pp
#else
#define ATTN_MLA attn88_body_single
#define ATTN_GQA(...) attn88_body
#endif
__device__ __forceinline__ void p_attn_mla(const Args& A, const Frame& F) {
    const bf16_t* Q = (const bf16_t*)(F.ws + WS_Q); const unsigned char* Kb = F.ws + WS_K; const unsigned char* Vb = F.ws + WS_V; bf16_t* O = (bf16_t*)(F.ws + WS_O);
    const float scale = 0.07216878364870322f;
    for (int u = F.vcu; u < 544; u += F.nblk) {
        int b, h, q0, seq;
        int rope_t0;
        if (u < 512) { const int qb = u & 15; h = (u >> 4) & 7; b = u >> 7; q0 = CTXL + qb * 256; seq = RPB; rope_t0 = qb * 256; }
        else { const int v = u - 512; h = v & 7; b = v >> 3; q0 = 0; seq = CTXL; rope_t0 = -1; }
        const size_t rb = (size_t)b * RPB;
        ATTN_MLA<192, 1536, 1536, 1024, 1024>(Q + (rb + q0) * 1536 + h * 192, Kb + rb * 1536 + h * 192, Vb + rb * 1024 + h * 128, O + (rb + q0) * 1024 + h * 128, seq, scale, F.lds, rope_t0);
    }
}
template <int VAR = 0> __device__ __forceinline__ void p_attn_gqa(const Args& A, const Frame& F, bf16_t* O) {
    const bf16_t* Q = (const bf16_t*)(F.ws + WS_Q1); const unsigned char* Kb = F.ws + WS_K1; const unsigned char* Vb = F.ws + WS_V1;
    const float scale = 0.08838834764831845f;
    for (int u = F.vcu; u < 512; u += F.nblk) {
        const int qb = u & 15, h = (u >> 4) & 7, b = u >> 7, q0 = CTXL + qb * 256, kvh = h >> 2;
        const size_t rb = (size_t)b * RPB;
        attn88_pp<128, 1024, 256, 256, 1024, VAR>(Q + (rb + q0) * 1024 + h * 128, Kb + rb * 256 + kvh * 128, Vb + rb * 256 + kvh * 128, O + (rb + q0) * 1024 + h * 128, RPB, scale, F.lds, -1);
    }
}
#define DPP_XOR1 0xB1
#define DPP_XOR2 0x4E
#define DPP_HMIRROR 0x141
#define DPP_MIRROR 0x140
__device__ __forceinline__ int row_max_i(int v) {
    v = max(v, __builtin_amdgcn_update_dpp(v, v, DPP_XOR1, 0xf, 0xf, false));
    v = max(v, __builtin_amdgcn_update_dpp(v, v, DPP_XOR2, 0xf, 0xf, false));
    v = max(v, __builtin_amdgcn_update_dpp(v, v, DPP_HMIRROR, 0xf, 0xf, false));
    v = max(v, __builtin_amdgcn_update_dpp(v, v, DPP_MIRROR, 0xf, 0xf, false));
    return v;
}
__device__ __forceinline__ float row_sum_f(float v) {
    v += __builtin_bit_cast(float, __builtin_amdgcn_update_dpp(0, __builtin_bit_cast(int, v), DPP_XOR1, 0xf, 0xf, false));
    v += __builtin_bit_cast(float, __builtin_amdgcn_update_dpp(0, __builtin_bit_cast(int, v), DPP_XOR2, 0xf, 0xf, false));
    v += __builtin_bit_cast(float, __builtin_amdgcn_update_dpp(0, __builtin_bit_cast(int, v), DPP_HMIRROR, 0xf, 0xf, false));
    v += __builtin_bit_cast(float, __builtin_amdgcn_update_dpp(0, __builtin_bit_cast(int, v), DPP_MIRROR, 0xf, 0xf, false));
    return v;
}
__device__ __forceinline__ int fkey(float f) { const int b = __builtin_bit_cast(int, f); return b ^ ((b >> 31) & 0x7fffffff); }
__device__ __forceinline__ float keyf(int k) { return __builtin_bit_cast(float, k ^ ((k >> 31) & 0x7fffffff)); }
__device__ __forceinline__ void cand_ij(int t, int& i, int& j) {
    const int g16 = t >= 16, g24 = t >= 24, g29 = t >= 29, g33 = t >= 33, g36 = t >= 36, g38 = t >= 38, g40 = t >= 40;
    i = g16 + g24 + g29 + g33 + g36 + g38 + g40 + max(t - 41, 0);
    const int base = 16 * g16 + 8 * g24 + 5 * g29 + 4 * g33 + 3 * g36 + 2 * g38 + 2 * g40;
    j = (t >= 42) ? 0 : t - base;
    if (t >= 50) { i = 0; j = 0; }
}
__device__ __forceinline__ void row_max2(int& a, int& b) {
    asm volatile("s_nop 1\n\t"
                 "v_max_i32_dpp %0, %0, %0 quad_perm:[1,0,3,2] row_mask:0xf bank_mask:0xf\n\tv_max_i32_dpp %1, %1, %1 quad_perm:[1,0,3,2] row_mask:0xf bank_mask:0xf\n\ts_nop 0\n\t"
                 "v_max_i32_dpp %0, %0, %0 quad_perm:[2,3,0,1] row_mask:0xf bank_mask:0xf\n\tv_max_i32_dpp %1, %1, %1 quad_perm:[2,3,0,1] row_mask:0xf bank_mask:0xf\n\ts_nop 0\n\t"
                 "v_max_i32_dpp %0, %0, %0 row_half_mirror row_mask:0xf bank_mask:0xf\n\tv_max_i32_dpp %1, %1, %1 row_half_mirror row_mask:0xf bank_mask:0xf\n\ts_nop 0\n\t"
                 "v_max_i32_dpp %0, %0, %0 row_mirror row_mask:0xf bank_mask:0xf\n\tv_max_i32_dpp %1, %1, %1 row_mirror row_mask:0xf bank_mask:0xf\n\ts_nop 1"
                 : "+v"(a), "+v"(b));
}
__device__ __forceinline__ void row_max1(int& a) {
    asm volatile("s_nop 1\n\t"
                 "v_max_i32_dpp %0, %0, %0 quad_perm:[1,0,3,2] row_mask:0xf bank_mask:0xf\n\ts_nop 1\n\t"
                 "v_max_i32_dpp %0, %0, %0 quad_perm:[2,3,0,1] row_mask:0xf bank_mask:0xf\n\ts_nop 1\n\t"
                 "v_max_i32_dpp %0, %0, %0 row_half_mirror row_mask:0xf bank_mask:0xf\n\ts_nop 1\n\t"
                 "v_max_i32_dpp %0, %0, %0 row_mirror row_mask:0xf bank_mask:0xf\n\ts_nop 1"
                 : "+v"(a));
}
__device__ __forceinline__ void row_max4(int& a, int& b, int& c, int& d) {
    asm volatile("s_nop 1\n\t"
                 "v_max_i32_dpp %0, %0, %0 quad_perm:[1,0,3,2] row_mask:0xf bank_mask:0xf\n\tv_max_i32_dpp %1, %1, %1 quad_perm:[1,0,3,2] row_mask:0xf bank_mask:0xf\n\t"
                 "v_max_i32_dpp %2, %2, %2 quad_perm:[1,0,3,2] row_mask:0xf bank_mask:0xf\n\tv_max_i32_dpp %3, %3, %3 quad_perm:[1,0,3,2] row_mask:0xf bank_mask:0xf\n\t"
                 "v_max_i32_dpp %0, %0, %0 quad_perm:[2,3,0,1] row_mask:0xf bank_mask:0xf\n\tv_max_i32_dpp %1, %1, %1 quad_perm:[2,3,0,1] row_mask:0xf bank_mask:0xf\n\t"
                 "v_max_i32_dpp %2, %2, %2 quad_perm:[2,3,0,1] row_mask:0xf bank_mask:0xf\n\tv_max_i32_dpp %3, %3, %3 quad_perm:[2,3,0,1] row_mask:0xf bank_mask:0xf\n\t"
                 "v_max_i32_dpp %0, %0, %0 row_half_mirror row_mask:0xf bank_mask:0xf\n\tv_max_i32_dpp %1, %1, %1 row_half_mirror row_mask:0xf bank_mask:0xf\n\t"
                 "v_max_i32_dpp %2, %2, %2 row_half_mirror row_mask:0xf bank_mask:0xf\n\tv_max_i32_dpp %3, %3, %3 row_half_mirror row_mask:0xf bank_mask:0xf\n\t"
                 "v_max_i32_dpp %0, %0, %0 row_mirror row_mask:0xf bank_mask:0xf\n\tv_max_i32_dpp %1, %1, %1 row_mirror row_mask:0xf bank_mask:0xf\n\t"
                 "v_max_i32_dpp %2, %2, %2 row_mirror row_mask:0xf bank_mask:0xf\n\tv_max_i32_dpp %3, %3, %3 row_mirror row_mask:0xf bank_mask:0xf\n\ts_nop 1"
                 : "+v"(a), "+v"(b), "+v"(c), "+v"(d));
}
#define CE_DESC(x, y) do { const int hi_ = max(x, y), lo_ = min(x, y); x = hi_; y = lo_; } while (0)
#define SORT8_DESC(k) do { CE_DESC(k[0], k[2]); CE_DESC(k[1], k[3]); CE_DESC(k[4], k[6]); CE_DESC(k[5], k[7]); CE_DESC(k[0], k[4]); CE_DESC(k[1], k[5]); CE_DESC(k[2], k[6]); CE_DESC(k[3], k[7]); \
    CE_DESC(k[0], k[1]); CE_DESC(k[2], k[3]); CE_DESC(k[4], k[5]); CE_DESC(k[6], k[7]); CE_DESC(k[2], k[4]); CE_DESC(k[3], k[5]); CE_DESC(k[1], k[4]); CE_DESC(k[3], k[6]); CE_DESC(k[1], k[2]); CE_DESC(k[3], k[4]); CE_DESC(k[5], k[6]); } while (0)
#define SORT16_DESC(K) do { CE_DESC(K[0], K[1]); CE_DESC(K[2], K[3]); CE_DESC(K[0], K[2]); CE_DESC(K[1], K[3]); CE_DESC(K[1], K[2]); CE_DESC(K[4], K[5]); CE_DESC(K[6], K[7]); CE_DESC(K[4], K[6]); CE_DESC(K[5], K[7]); CE_DESC(K[5], K[6]); CE_DESC(K[0], K[4]); CE_DESC(K[2], K[6]); CE_DESC(K[2], K[4]); CE_DESC(K[1], K[5]); CE_DESC(K[3], K[7]); CE_DESC(K[3], K[5]); CE_DESC(K[1], K[2]); CE_DESC(K[3], K[4]); CE_DESC(K[5], K[6]); CE_DESC(K[8], K[9]); CE_DESC(K[10], K[11]); CE_DESC(K[8], K[10]); CE_DESC(K[9], K[11]); CE_DESC(K[9], K[10]); CE_DESC(K[12], K[13]); CE_DESC(K[14], K[15]); CE_DESC(K[12], K[14]); CE_DESC(K[13], K[15]); CE_DESC(K[13], K[14]); CE_DESC(K[8], K[12]); CE_DESC(K[10], K[14]); CE_DESC(K[10], K[12]); CE_DESC(K[9], K[13]); CE_DESC(K[11], K[15]); CE_DESC(K[11], K[13]); CE_DESC(K[9], K[10]); CE_DESC(K[11], K[12]); CE_DESC(K[13], K[14]); CE_DESC(K[0], K[8]); CE_DESC(K[4], K[12]); CE_DESC(K[4], K[8]); CE_DESC(K[2], K[10]); CE_DESC(K[6], K[14]); CE_DESC(K[6], K[10]); CE_DESC(K[2], K[4]); CE_DESC(K[6], K[8]); CE_DESC(K[10], K[12]); CE_DESC(K[1], K[9]); CE_DESC(K[5], K[13]); CE_DESC(K[5], K[9]); CE_DESC(K[3], K[11]); CE_DESC(K[7], K[15]); CE_DESC(K[7], K[11]); CE_DESC(K[3], K[5]); CE_DESC(K[7], K[9]); CE_DESC(K[11], K[13]); CE_DESC(K[1], K[2]); CE_DESC(K[3], K[4]); CE_DESC(K[5], K[6]); CE_DESC(K[7], K[8]); CE_DESC(K[9], K[10]); CE_DESC(K[11], K[12]); CE_DESC(K[13], K[14]); } while (0)
#define MERGE16_DESC(T, K) do { _Pragma("unroll") for (int i_ = 0; i_ < 16; ++i_) T[i_] = max(T[i_], K[15 - i_]); CE_DESC(T[0], T[8]); CE_DESC(T[1], T[9]); CE_DESC(T[2], T[10]); CE_DESC(T[3], T[11]); CE_DESC(T[4], T[12]); CE_DESC(T[5], T[13]); CE_DESC(T[6], T[14]); CE_DESC(T[7], T[15]); CE_DESC(T[0], T[4]); CE_DESC(T[1], T[5]); CE_DESC(T[2], T[6]); CE_DESC(T[3], T[7]); CE_DESC(T[8], T[12]); CE_DESC(T[9], T[13]); CE_DESC(T[10], T[14]); CE_DESC(T[11], T[15]); CE_DESC(T[0], T[2]); CE_DESC(T[1], T[3]); CE_DESC(T[4], T[6]); CE_DESC(T[5], T[7]); CE_DESC(T[8], T[10]); CE_DESC(T[9], T[11]); CE_DESC(T[12], T[14]); CE_DESC(T[13], T[15]); CE_DESC(T[0], T[1]); CE_DESC(T[2], T[3]); CE_DESC(T[4], T[5]); CE_DESC(T[6], T[7]); CE_DESC(T[8], T[9]); CE_DESC(T[10], T[11]); CE_DESC(T[12], T[13]); CE_DESC(T[14], T[15]); } while (0)
__device__ __forceinline__ int hkey_hi(unsigned w) { const int x = (int)(w & 0xffff0000u); return x ^ ((x >> 31) & 0x7fff0000); }
__device__ __forceinline__ float hkey_val(int k) { const int y = k & (int)0xffff0000; const unsigned b = (unsigned)(y ^ ((y >> 31) & 0x7fff0000)); return (float)__builtin_bit_cast(_Float16, (unsigned short)(b >> 16)); }
__device__ __forceinline__ int cnd(int a, int b, unsigned long long m) { int r; asm("v_cndmask_b32_e64 %0, %1, %2, %3" : "=v"(r) : "v"(a), "v"(b), "s"(m)); return r; }
__device__ __forceinline__ unsigned long long bitmask(int v, int bit) { unsigned long long m; asm("v_cmp_ne_u32_e64 %0, 0, %1\n\ts_nop 1" : "=s"(m) : "v"(v & bit)); return m; }
__device__ __forceinline__ int sel16(const int (&a)[16], int i) {
    const unsigned long long m0 = bitmask(i, 1), m1 = bitmask(i, 2), m2 = bitmask(i, 4), m3 = bitmask(i, 8);
    int l1[8], l2[4], l3[2];
#pragma unroll
    for (int m = 0; m < 8; ++m) l1[m] = cnd(a[2 * m], a[2 * m + 1], m0);
#pragma unroll
    for (int m = 0; m < 4; ++m) l2[m] = cnd(l1[2 * m], l1[2 * m + 1], m1);
#pragma unroll
    for (int m = 0; m < 2; ++m) l3[m] = cnd(l2[2 * m], l2[2 * m + 1], m2);
    return cnd(l3[0], l3[1], m3);
}
__device__ __forceinline__ void topk_rows4(const unsigned short* S, unsigned* PK, int r, int hbase, int lane) {
    const int c = lane & 15, rw = lane >> 4, rbase = lane & 48, h = hbase + rw;
    const int KMIN = (int)0x80000000;
    const unsigned short* sp = S + (size_t)r * 2048 + h * 256 + 4 * c;
    int k1[8], k2[8];
#pragma unroll
    for (int jj = 0; jj < 2; ++jj) { const u32x2 a = *(const u32x2*)(sp + 64 * jj), b = *(const u32x2*)(sp + 128 + 64 * jj);
#pragma unroll
        for (int e = 0; e < 4; ++e) { const int p = 4 * c + 64 * jj + e;
            const float fa = (float)__builtin_bit_cast(_Float16, (unsigned short)(a[e >> 1] >> (16 * (e & 1)))), fb = (float)__builtin_bit_cast(_Float16, (unsigned short)(b[e >> 1] >> (16 * (e & 1))));
            k1[4 * jj + e] = (fkey(fa) & ~127) | (127 - p); k2[4 * jj + e] = (fkey(fb) & ~127) | (127 - p); } }
    SORT8_DESC(k1); SORT8_DESC(k2);
    int r1 = KMIN, r2 = KMIN;
#pragma unroll 1
    for (int it = 0; it < 16; ++it) {
        int m1 = k1[0], m2 = k2[0];
        row_max2(m1, m2);
        const bool p1 = (k1[0] == m1), p2 = (k2[0] == m2);
#pragma unroll
        for (int e = 0; e < 7; ++e) { k1[e] = p1 ? k1[e + 1] : k1[e]; k2[e] = p2 ? k2[e + 1] : k2[e]; }
        k1[7] = p1 ? KMIN : k1[7]; k2[7] = p2 ? KMIN : k2[7];
        if (c == it) { r1 = m1; r2 = m2; }
    }
    int ck[4];
#pragma unroll
    for (int q = 0; q < 4; ++q) { int ci, cj; cand_ij(c + 16 * q, ci, cj); const int a = __shfl(r1, rbase | ci), b = __shfl(r2, rbase | cj);
        const float fs = keyf((a & ~127) | 64) + keyf((b & ~127) | 64); const int t = c + 16 * q;
        ck[q] = (t < 50) ? ((fkey(fs) & ~63) | (63 - t)) : KMIN; }
    CE_DESC(ck[0], ck[1]); CE_DESC(ck[2], ck[3]); CE_DESC(ck[0], ck[2]); CE_DESC(ck[1], ck[3]); CE_DESC(ck[1], ck[2]);
    int tk = KMIN;
#pragma unroll 1
    for (int it = 0; it < 16; ++it) {
        int m = ck[0];
        row_max1(m);
        const bool pp = (ck[0] == m);
        ck[0] = pp ? ck[1] : ck[0]; ck[1] = pp ? ck[2] : ck[1]; ck[2] = pp ? ck[3] : ck[2]; ck[3] = pp ? KMIN : ck[3];
        if (c == it) tk = m;
    }
    int wi, wj; cand_ij(63 - (tk & 63), wi, wj);
    const int wa = __shfl(r1, rbase | wi), wb = __shfl(r2, rbase | wj);
    const int te = (127 - (wa & 127)) * 128 + (127 - (wb & 127));
    const float tv = keyf((tk & ~63) | 32);
    int mk = tk; row_max1(mk);
    const float mx = keyf((mk & ~63) | 32);
    const float ex = __expf(tv - mx), sum = row_sum_f(ex);
    PK[(size_t)r * 128 + h * 16 + c] = ((unsigned)te << 16) | (unsigned)(ex * (65535.f / sum) + 0.5f);
}
__device__ __forceinline__ void p_peer_topk(const Args& A, const Frame& F, bool skip_ctx) {
    const int gw = F.bid * NWAVES + F.wave, NGW = F.nblk * NWAVES, lane = F.lane;
    const unsigned short* S = (const unsigned short*)(F.ws + WS_S); unsigned* PK = (unsigned*)(F.ws + WS_PK);
    const int KMIN = (int)0x80000000;
    const int nitem = (skip_ctx ? NB * SEQ : R) * 8;
    const int nmain = (nitem / (NGW * 64)) * (NGW * 64);
    for (int q = gw; q < (nitem - nmain) / 4; q += NGW) { const int item = nmain + 4 * q, n = item >> 3; topk_rows4(S, PK, skip_ctx ? tok_row(1, n) : n, item & 7, lane); }
    for (int base = gw * 64; base < nmain; base += NGW * 64) {
        const int item = base + lane, n = item >> 3, h = item & 7, r = skip_ctx ? tok_row(1, n) : n;
        const unsigned short* sp = S + (size_t)r * 2048 + h * 256;
        int t1[16], t2[16];
#pragma unroll
        for (int list = 0; list < 2; ++list) {
            int T[16];
#pragma unroll
            for (int i = 0; i < 16; ++i) T[i] = KMIN;
            const unsigned short* lp = sp + 128 * list;
            u32x4 ra = *(const u32x4*)lp, rb = *(const u32x4*)(lp + 8);
#pragma unroll 1
            for (int c = 0; c < 8; ++c) {
                const int cn = c < 7 ? c + 1 : 7;
                const u32x4 na = *(const u32x4*)(lp + 16 * cn), nb = *(const u32x4*)(lp + 16 * cn + 8);
                const int pb = 127 - 16 * c;
                int K[16];
#pragma unroll
                for (int d = 0; d < 4; ++d) { K[2 * d] = hkey_hi(ra[d] << 16) | (pb - 2 * d); K[2 * d + 1] = hkey_hi(ra[d]) | (pb - 2 * d - 1);
                    K[8 + 2 * d] = hkey_hi(rb[d] << 16) | (pb - 8 - 2 * d); K[8 + 2 * d + 1] = hkey_hi(rb[d]) | (pb - 9 - 2 * d); }
                SORT16_DESC(K);
                MERGE16_DESC(T, K);
                ra = na; rb = nb;
            }
#pragma unroll
            for (int i = 0; i < 16; ++i) { if (list == 0) t1[i] = T[i]; else t2[i] = T[i]; }
        }
        float f1[16], f2[16];
#pragma unroll
        for (int i = 0; i < 16; ++i) { f1[i] = hkey_val(t1[i]); f2[i] = hkey_val(t2[i]); }
        int CA[16], CB[16], CC[16], CD[16];
        CA[0] = (fkey(f1[0] + f2[0]) & ~63) | 63; CA[1] = (fkey(f1[0] + f2[1]) & ~63) | 62; CA[2] = (fkey(f1[0] + f2[2]) & ~63) | 61; CA[3] = (fkey(f1[0] + f2[3]) & ~63) | 60; CA[4] = (fkey(f1[0] + f2[4]) & ~63) | 59; CA[5] = (fkey(f1[0] + f2[5]) & ~63) | 58; CA[6] = (fkey(f1[0] + f2[6]) & ~63) | 57; CA[7] = (fkey(f1[0] + f2[7]) & ~63) | 56; CA[8] = (fkey(f1[0] + f2[8]) & ~63) | 55; CA[9] = (fkey(f1[0] + f2[9]) & ~63) | 54; CA[10] = (fkey(f1[0] + f2[10]) & ~63) | 53; CA[11] = (fkey(f1[0] + f2[11]) & ~63) | 52; CA[12] = (fkey(f1[0] + f2[12]) & ~63) | 51; CA[13] = (fkey(f1[0] + f2[13]) & ~63) | 50; CA[14] = (fkey(f1[0] + f2[14]) & ~63) | 49; CA[15] = (fkey(f1[0] + f2[15]) & ~63) | 48; CB[0] = (fkey(f1[1] + f2[0]) & ~63) | 47; CB[1] = (fkey(f1[1] + f2[1]) & ~63) | 46; CB[2] = (fkey(f1[1] + f2[2]) & ~63) | 45; CB[3] = (fkey(f1[1] + f2[3]) & ~63) | 44; CB[4] = (fkey(f1[1] + f2[4]) & ~63) | 43; CB[5] = (fkey(f1[1] + f2[5]) & ~63) | 42; CB[6] = (fkey(f1[1] + f2[6]) & ~63) | 41; CB[7] = (fkey(f1[1] + f2[7]) & ~63) | 40; CB[8] = (fkey(f1[2] + f2[0]) & ~63) | 39; CB[9] = (fkey(f1[2] + f2[1]) & ~63) | 38; CB[10] = (fkey(f1[2] + f2[2]) & ~63) | 37; CB[11] = (fkey(f1[2] + f2[3]) & ~63) | 36; CB[12] = (fkey(f1[2] + f2[4]) & ~63) | 35; CB[13] = (fkey(f1[3] + f2[0]) & ~63) | 34; CB[14] = (fkey(f1[3] + f2[1]) & ~63) | 33; CB[15] = (fkey(f1[3] + f2[2]) & ~63) | 32; CC[0] = (fkey(f1[3] + f2[3]) & ~63) | 31; CC[1] = (fkey(f1[4] + f2[0]) & ~63) | 30; CC[2] = (fkey(f1[4] + f2[1]) & ~63) | 29; CC[3] = (fkey(f1[4] + f2[2]) & ~63) | 28; CC[4] = (fkey(f1[5] + f2[0]) & ~63) | 27; CC[5] = (fkey(f1[5] + f2[1]) & ~63) | 26; CC[6] = (fkey(f1[6] + f2[0]) & ~63) | 25; CC[7] = (fkey(f1[6] + f2[1]) & ~63) | 24; CC[8] = (fkey(f1[7] + f2[0]) & ~63) | 23; CC[9] = (fkey(f1[7] + f2[1]) & ~63) | 22; CC[10] = (fkey(f1[8] + f2[0]) & ~63) | 21; CC[11] = (fkey(f1[9] + f2[0]) & ~63) | 20; CC[12] = (fkey(f1[10] + f2[0]) & ~63) | 19; CC[13] = (fkey(f1[11] + f2[0]) & ~63) | 18; CC[14] = (fkey(f1[12] + f2[0]) & ~63) | 17; CC[15] = (fkey(f1[13] + f2[0]) & ~63) | 16; CD[0] = (fkey(f1[14] + f2[0]) & ~63) | 15; CD[1] = (fkey(f1[15] + f2[0]) & ~63) | 14; CD[2] = KMIN; CD[3] = KMIN; CD[4] = KMIN; CD[5] = KMIN; CD[6] = KMIN; CD[7] = KMIN; CD[8] = KMIN; CD[9] = KMIN; CD[10] = KMIN; CD[11] = KMIN; CD[12] = KMIN; CD[13] = KMIN; CD[14] = KMIN; CD[15] = KMIN;
        SORT16_DESC(CB); SORT16_DESC(CC); CE_DESC(CD[0], CD[1]);
        MERGE16_DESC(CA, CB); MERGE16_DESC(CA, CC); MERGE16_DESC(CA, CD);
        const float mx = keyf((CA[0] & ~63) | 32);
        float ex[16], sum = 0.f; unsigned te[16];
#pragma unroll
        for (int k = 0; k < 16; ++k) { int wi, wj; cand_ij(63 - (CA[k] & 63), wi, wj);
            const int wa = sel16(t1, wi), wb = sel16(t2, wj);
            te[k] = (unsigned)((127 - (wa & 127)) * 128 + (127 - (wb & 127)));
            ex[k] = __expf(keyf((CA[k] & ~63) | 32) - mx); sum += ex[k]; }
        const float rs = 65535.f / sum;
        u32x4* dst = (u32x4*)(PK + (size_t)r * 128 + h * 16);
#pragma unroll
        for (int q = 0; q < 4; ++q) { u32x4 o;
#pragma unroll
            for (int d = 0; d < 4; ++d) o[d] = (te[4 * q + d] << 16) | (unsigned)(ex[4 * q + d] * rs + 0.5f);
            dst[q] = o; }
    }
}

#define UB(w, b) ((float)(((w) >> (8 * (b))) & 0xffu))
__device__ __forceinline__ void p_peer_experts(const Args& A, const Frame& F, int layer) {
    const int gw = F.bid * NWAVES + F.wave, NGW = F.nblk * NWAVES, lane = F.lane;
    const bf16_t* H = (const bf16_t*)(F.ws + WS_H); float* X = (float*)(F.ws + WS_X);
    const unsigned* PK = (const unsigned*)(F.ws + WS_PK);
    const unsigned char* UT = F.ws + WS_TAB + (size_t)(layer * 2) * 16384 * 1024; const unsigned char* VT = UT + (size_t)16384 * 1024;
    const float* SU = (const float*)(F.ws + WS_TSC) + (layer * 2) * 16384; const float* SV = SU + 16384;
    const float* MOD = (const float*)(F.ws + WS_MOD) + (size_t)layer * 5 * 6144;
    for (int r = gw; r < R; r += NGW) {
        if (layer == 1 && is_ctx_row(r)) continue;
        float hf[16];
        { const u32x4 w0 = *(const u32x4*)(H + (size_t)r * DM + 16 * lane), w1 = *(const u32x4*)(H + (size_t)r * DM + 16 * lane + 8);
#pragma unroll
          for (int d = 0; d < 4; ++d) { hf[2 * d] = bflo(w0[d]); hf[2 * d + 1] = bfhi(w0[d]); hf[8 + 2 * d] = bflo(w1[d]); hf[8 + 2 * d + 1] = bfhi(w1[d]); } }
        float hs = 0.f;
#pragma unroll
        for (int i = 0; i < 16; ++i) hs += hf[i];
        hs = wave_sum(hs);
        int v0 = (int)PK[(size_t)r * 128 + lane], v1 = (int)PK[(size_t)r * 128 + 64 + lane];
#pragma unroll
        for (int k = 2; k <= 128; k <<= 1) {
#pragma unroll
            for (int j = k >> 1; j >= 1; j >>= 1) {
                if (j == 64) { const int a = min(v0, v1), b = max(v0, v1); v0 = a; v1 = b; }
                else { const int o0 = __shfl_xor(v0, j), o1 = __shfl_xor(v1, j); const bool lower = (lane & j) == 0;
                    const bool asc0 = (k == 128) ? true : (k == 64) ? true : ((lane & k) == 0), asc1 = (k == 128) ? true : (k == 64) ? false : ((lane & k) == 0);
                    v0 = (lower == asc0) ? min(v0, o0) : max(v0, o0); v1 = (lower == asc1) ? min(v1, o1) : max(v1, o1); }
            }
        }
        const unsigned pk0 = (unsigned)v0, pk1 = (unsigned)v1;
        const int e0 = (int)(pk0 >> 16), e1 = (int)(pk1 >> 16);
        const float g0 = (float)(pk0 & 0xffffu) * (1.f / 65535.f), g1 = (float)(pk1 & 0xffffu) * (1.f / 65535.f);
        const float su0 = SU[e0], su1 = SU[e1], sv0 = SV[e0], sv1 = SV[e1];
        float d0 = 0.f, d1 = 0.f;
        const int dep_src = (8 * (lane & 7)) << 2; const bool bit3 = (lane & 8) != 0;
#define XISSUE(buf, TAB, esrc, gg) do { _Pragma("unroll") for (int q_ = 0; q_ < 8; ++q_) { const int e_ = __builtin_amdgcn_readlane(esrc, (gg) * 8 + q_); \
            buf[q_] = *(const u32x4*)((TAB) + (size_t)e_ * 1024 + 16 * lane); } } while (0)
#define UCOMP(buf, gg, dsel) do { float p_[8]; _Pragma("unroll") for (int q_ = 0; q_ < 8; ++q_) { float d_ = 0.f; \
            _Pragma("unroll") for (int j_ = 0; j_ < 4; ++j_) d_ += (hf[4 * j_] * UB(buf[q_][j_], 0) + hf[4 * j_ + 1] * UB(buf[q_][j_], 1)) + (hf[4 * j_ + 2] * UB(buf[q_][j_], 2) + hf[4 * j_ + 3] * UB(buf[q_][j_], 3)); p_[q_] = d_; } \
            float s_[4]; _Pragma("unroll") for (int q_ = 0; q_ < 4; ++q_) { auto rr_ = __builtin_amdgcn_permlane32_swap(__float_as_uint(p_[q_]), __float_as_uint(p_[q_ + 4]), false, false); s_[q_] = __uint_as_float(rr_[0]) + __uint_as_float(rr_[1]); } \
            float t_[2]; _Pragma("unroll") for (int q_ = 0; q_ < 2; ++q_) { auto rr_ = __builtin_amdgcn_permlane16_swap(__float_as_uint(s_[q_]), __float_as_uint(s_[q_ + 2]), false, false); t_[q_] = __uint_as_float(rr_[0]) + __uint_as_float(rr_[1]); } \
            const float keep_ = bit3 ? t_[1] : t_[0], send_ = bit3 ? t_[0] : t_[1]; \
            float u_ = keep_ + __builtin_bit_cast(float, __builtin_amdgcn_update_dpp(0, __builtin_bit_cast(int, send_), 0x128, 0xf, 0xf, false)); \
            u_ += __builtin_bit_cast(float, __builtin_amdgcn_update_dpp(0, __builtin_bit_cast(int, u_), DPP_HMIRROR, 0xf, 0xf, false)); \
            u_ += __builtin_bit_cast(float, __builtin_amdgcn_update_dpp(0, __builtin_bit_cast(int, u_), DPP_XOR1, 0xf, 0xf, false)); \
            u_ += __builtin_bit_cast(float, __builtin_amdgcn_update_dpp(0, __builtin_bit_cast(int, u_), DPP_XOR2, 0xf, 0xf, false)); \
            const float v_ = __builtin_bit_cast(float, __builtin_amdgcn_ds_bpermute(dep_src, __builtin_bit_cast(int, u_))); \
            if ((lane >> 3) == (gg)) dsel = v_; } while (0)
        {
            u32x4 ua[8], ub[8];
            XISSUE(ua, UT, e0, 0);
#pragma unroll 1
            for (int g = 0; g < 8; g += 2) { XISSUE(ub, UT, e0, g + 1); UCOMP(ua, g, d0); if (g + 2 < 8) XISSUE(ua, UT, e0, g + 2); else XISSUE(ua, UT, e1, 0); UCOMP(ub, g + 1, d0); }
#pragma unroll 1
            for (int g = 0; g < 8; g += 2) { XISSUE(ub, UT, e1, g + 1); UCOMP(ua, g, d1); if (g + 2 < 8) XISSUE(ua, UT, e1, g + 2); UCOMP(ub, g + 1, d1); }
        }
        const float a0 = su0 * (d0 - 128.f * hs), a1 = su1 * (d1 - 128.f * hs);
        const float w0 = g0 * 0.5f * a0 * (1.f + erff(a0 * 0.70710678118654752f)) * sv0, w1 = g1 * 0.5f * a1 * (1.f + erff(a1 * 0.70710678118654752f)) * sv1;
        const float wsum = wave_sum(w0 + w1) * 128.f;
        float acc[16];
#pragma unroll
        for (int i = 0; i < 16; ++i) acc[i] = 0.f;
#define VCOMP(buf, wsrc, gg) do { _Pragma("unroll") for (int q_ = 0; q_ < 8; ++q_) { const float wk_ = __builtin_bit_cast(float, __builtin_amdgcn_readlane(__builtin_bit_cast(int, wsrc), (gg) * 8 + q_)); \
            _Pragma("unroll") for (int j_ = 0; j_ < 4; ++j_) { acc[4 * j_] += wk_ * UB(buf[q_][j_], 0); acc[4 * j_ + 1] += wk_ * UB(buf[q_][j_], 1); acc[4 * j_ + 2] += wk_ * UB(buf[q_][j_], 2); acc[4 * j_ + 3] += wk_ * UB(buf[q_][j_], 3); } } } while (0)
        {
            u32x4 va[8], vb[8];
            XISSUE(va, VT, e0, 0);
#pragma unroll 1
            for (int g = 0; g < 8; g += 2) { XISSUE(vb, VT, e0, g + 1); VCOMP(va, w0, g); if (g + 2 < 8) XISSUE(va, VT, e0, g + 2); else XISSUE(va, VT, e1, 0); VCOMP(vb, w0, g + 1); }
#pragma unroll 1
            for (int g = 0; g < 8; g += 2) { XISSUE(vb, VT, e1, g + 1); VCOMP(va, w1, g); if (g + 2 < 8) XISSUE(va, VT, e1, g + 2); VCOMP(vb, w1, g + 1); }
        }
#undef XISSUE
#undef UCOMP
#undef VCOMP
        const float* mm = MOD + (size_t)mod_index(r) * 6144;
        f32x4 xn[4]; float s = 0.f;
#pragma unroll
        for (int j = 0; j < 4; ++j) { const int c = 16 * lane + 4 * j; const float* xp = X + (size_t)r * DM + c; const f32x4 gf = *(const f32x4*)(mm + 5 * 1024 + c);
            xn[j] = *(const f32x4*)xp + gf * (f32x4){acc[4 * j] - wsum, acc[4 * j + 1] - wsum, acc[4 * j + 2] - wsum, acc[4 * j + 3] - wsum};
            s += (xn[j].x * xn[j].x + xn[j].y * xn[j].y) + (xn[j].z * xn[j].z + xn[j].w * xn[j].w); }
        const float rinv = rsqrtf(wave_sum(s) * (1.f / DM) + EPS);
        if (layer == 0) {
            const float* m1 = (const float*)(F.ws + WS_MOD) + (size_t)(5 + mod_index(r)) * 6144;
            const float* gn = A.in[I1_NMIX];
#pragma unroll
            for (int j = 0; j < 4; ++j) { const int c = 16 * lane + 4 * j; *(f32x4*)(X + (size_t)r * DM + c) = xn[j];
                const f32x4 y = (xn[j] * rinv * *(const f32x4*)(gn + c)) * (*(const f32x4*)(m1 + 1024 + c) + 1.f) + *(const f32x4*)(m1 + c);
                u32x2 o; o.x = pk2(y.x, y.y); o.y = pk2(y.z, y.w); *(u32x2*)((bf16_t*)(F.ws + WS_H) + (size_t)r * DM + c) = o; }
        } else {
            const int b = r / RPB, t = (r - b * RPB) - CTXL; float* op = F.out + ((size_t)b * SEQ + t) * DM; const float* gn = A.in[I_NOUT];
#pragma unroll
            for (int j = 0; j < 4; ++j) { const int c = 16 * lane + 4 * j; *(f32x4*)(op + c) = xn[j] * rinv * *(const f32x4*)(gn + c); }
        }
    }
}

__device__ __forceinline__ int tok_row(int layer, int n) { return layer == 0 ? n : (n >> 12) * RPB + CTXL + (n & 4095); }
#define DPPF(v, ctrl) __builtin_bit_cast(float, __builtin_amdgcn_update_dpp(0, __builtin_bit_cast(int, v), ctrl, 0xf, 0xf, false))
__device__ __forceinline__ int isum8(int v) {
    v += __builtin_amdgcn_update_dpp(0, v, DPP_XOR1, 0xf, 0xf, false); v += __builtin_amdgcn_update_dpp(0, v, DPP_XOR2, 0xf, 0xf, false); v += __builtin_amdgcn_update_dpp(0, v, DPP_HMIRROR, 0xf, 0xf, false); return v; }
__device__ __forceinline__ void p_exp_u(const Args& A, const Frame& F, int layer) {
    const int lane = F.lane, s = lane >> 3, c8 = lane & 7;
    const bool part = (F.nblk & 7) == 0; const int ncb = part ? 1 : 4, cb0 = part ? (F.bid & 3) : 0;
    const int gwv = part ? ((F.bid >> 2) * NWAVES + F.wave) : (F.bid * NWAVES + F.wave), nwv = part ? ((F.nblk >> 2) * NWAVES) : (F.nblk * NWAVES);
    const int ntok = layer == 0 ? R : NB * SEQ;
    const unsigned char* HQ = F.ws + WS_HQ; const unsigned* PK = (const unsigned*)(F.ws + WS_PK);
    const unsigned char* UT = F.ws + WS_TAB + (size_t)(layer * 2) * 16384 * 1024;
    int* PD = (int*)(F.ws + WS_PD);
#define U_META(pk, hqa, hqb, n_) do { const int r_ = tok_row(layer, (n_) < ntok ? (n_) : gwv); const unsigned* p_ = PK + (size_t)r_ * 128 + s; \
        _Pragma("unroll") for (int i_ = 0; i_ < 16; ++i_) pk[i_] = p_[8 * i_]; \
        hqa = *(const u32x4*)(HQ + (size_t)r_ * DM + 256 * cb + 32 * c8); hqb = *(const u32x4*)(HQ + (size_t)r_ * DM + 256 * cb + 32 * c8 + 16); } while (0)
#define U_ISSUE(pk, lo) do { _Pragma("unroll") for (int i_ = (lo); i_ < (lo) + 8; ++i_) t[i_] = *(const u32x4*)(tb + (size_t)(pk[i_] >> 16) * 128); } while (0)
#define U_DOT(i_) do { int dh_ = __builtin_amdgcn_sdot8((int)t[i_][0], (int)hva[0], 0, false), dl_ = __builtin_amdgcn_sdot8((int)t[i_][0], (int)hva[1], 0, false); \
        dh_ = __builtin_amdgcn_sdot8((int)t[i_][1], (int)hva[2], dh_, false); dl_ = __builtin_amdgcn_sdot8((int)t[i_][1], (int)hva[3], dl_, false); \
        dh_ = __builtin_amdgcn_sdot8((int)t[i_][2], (int)hvb[0], dh_, false); dl_ = __builtin_amdgcn_sdot8((int)t[i_][2], (int)hvb[1], dl_, false); \
        dh_ = __builtin_amdgcn_sdot8((int)t[i_][3], (int)hvb[2], dh_, false); dl_ = __builtin_amdgcn_sdot8((int)t[i_][3], (int)hvb[3], dl_, false); \
        int d_ = isum8(dh_ * 16 + dl_); if (c8 == ((i_) & 7)) { if ((i_) < 8) kA = d_; else kB = d_; } } while (0)
#define U_ITEM(pkc, hqca, hqcb, pkn, n_) do { \
        const u32x4 hva = hqca, hvb = hqcb; \
        U_META(pkc, hqca, hqcb, (n_) + 2 * nwv); \
        int kA = 0, kB = 0; \
        _Pragma("unroll") for (int i_ = 0; i_ < 8; ++i_) U_DOT(i_); \
        U_ISSUE(pkn, 0); \
        _Pragma("unroll") for (int i_ = 8; i_ < 16; ++i_) U_DOT(i_); \
        U_ISSUE(pkn, 8); \
        if ((n_) < ntok) { const int r_ = tok_row(layer, n_); int* pd_ = PD + ((size_t)cb * R + r_) * 128 + 8 * c8 + s; pd_[0] = kA; pd_[64] = kB; } \
        } while (0)
#pragma unroll 1
    for (int cbi = 0; cbi < ncb; ++cbi) {
        const int cb = cb0 + cbi;
        const unsigned char* tb = UT + (size_t)cb * 16384 * 128 + 16 * c8;
        unsigned pkA[16], pkB[16]; u32x4 hAa, hAb, hBa, hBb, t[16];
        U_META(pkA, hAa, hAb, gwv); U_META(pkB, hBa, hBb, gwv + nwv);
        U_ISSUE(pkA, 0); U_ISSUE(pkA, 8);
#pragma unroll 1
        for (int n = gwv; n < ntok; n += 2 * nwv) {
            U_ITEM(pkA, hAa, hAb, pkB, n);
            U_ITEM(pkB, hBa, hBb, pkA, n + nwv);
        }
    }
#undef U_META
#undef U_ISSUE
#undef U_DOT
#undef U_ITEM
}
__device__ __forceinline__ void p_exp_w(const Args& A, const Frame& F, int layer) {
    const int gw = F.bid * NWAVES + F.wave, NGW = F.nblk * NWAVES, lane = F.lane;
    const int ntok = layer == 0 ? R : NB * SEQ;
    const unsigned* PK = (const unsigned*)(F.ws + WS_PK); const int* PD = (const int*)(F.ws + WS_PD); const float* HS = (const float*)(F.ws + WS_HS);
    unsigned* WQ8 = (unsigned*)(F.ws + WS_WQ8); float* WSC = (float*)(F.ws + WS_WSC);
    const float* SU = (const float*)(F.ws + WS_TSC) + (layer * 2) * 16384; const float* SV = SU + 16384;
    const int g2 = (lane >> 3) & 3, sb = lane & 7, src = 32 * (g2 & 1) + sb;
    for (int n = gw; n < ntok; n += 2 * NGW) {
        int r[2]; r[0] = tok_row(layer, n); r[1] = (n + NGW) < ntok ? tok_row(layer, n + NGW) : r[0];
        unsigned pk0[2], pk1[2]; int d0[2], d1[2]; float hs[2];
#pragma unroll
        for (int q = 0; q < 2; ++q) { pk0[q] = PK[(size_t)r[q] * 128 + lane]; pk1[q] = PK[(size_t)r[q] * 128 + 64 + lane]; hs[q] = HS[r[q]]; d0[q] = 0; d1[q] = 0;
#pragma unroll
            for (int cb = 0; cb < 4; ++cb) { d0[q] += PD[((size_t)cb * R + r[q]) * 128 + lane]; d1[q] += PD[((size_t)cb * R + r[q]) * 128 + 64 + lane]; } }
        float su0[2], su1[2], sv0[2], sv1[2];
#pragma unroll
        for (int q = 0; q < 2; ++q) { const int e0 = (int)(pk0[q] >> 16), e1 = (int)(pk1[q] >> 16); su0[q] = SU[e0]; su1[q] = SU[e1]; sv0[q] = SV[e0]; sv1[q] = SV[e1]; }
#pragma unroll
        for (int q = 0; q < 2; ++q) {
            const float g0 = (float)(pk0[q] & 0xffffu) * (1.f / 65535.f), g1 = (float)(pk1[q] & 0xffffu) * (1.f / 65535.f);
            const float a0 = su0[q] * hs[q] * (float)d0[q], a1 = su1[q] * hs[q] * (float)d1[q];
            const float w0 = g0 * 0.5f * a0 * (1.f + erff(a0 * 0.70710678118654752f)) * sv0[q], w1 = g1 * 0.5f * a1 * (1.f + erff(a1 * 0.70710678118654752f)) * sv1[q];
            const float wm = wave_max(fmaxf(fabsf(w0), fabsf(w1)));
            const float inv = wm > 0.f ? 127.f / wm : 0.f;
            const int q0 = (int)rintf(w0 * inv) & 0xff, q1 = (int)rintf(w1 * inv) & 0xff;
            unsigned pw = 0;
#pragma unroll
            for (int j = 0; j < 4; ++j) { const int x0 = __shfl(q0, src + 8 * j), x1 = __shfl(q1, src + 8 * j); pw |= (unsigned)((g2 < 2) ? x0 : x1) << (8 * j); }
            if (q == 0 || (n + NGW) < ntok) { if (lane < 32) WQ8[(size_t)r[q] * 32 + lane] = pw; if (lane == 0) WSC[r[q]] = wm > 0.f ? wm * (1.f / 127.f) : 0.f; }
        }
    }
}
__device__ __forceinline__ void p_exp_v(const Args& A, const Frame& F, int layer) {
    const int lane = F.lane, s = lane >> 3, c8 = lane & 7;
    const bool part = (F.nblk & 7) == 0; const int ncb = part ? 1 : 8, cb0 = part ? (F.bid & 7) : 0;
    const int gwv = part ? ((F.bid >> 3) * NWAVES + F.wave) : (F.bid * NWAVES + F.wave), nwv = part ? ((F.nblk >> 3) * NWAVES) : (F.nblk * NWAVES);
    const int ntok = layer == 0 ? R : NB * SEQ;
    const unsigned* PK = (const unsigned*)(F.ws + WS_PK); const unsigned* WQ8 = (const unsigned*)(F.ws + WS_WQ8); const float* WSC = (const float*)(F.ws + WS_WSC);
    const unsigned char* VT = F.ws + WS_TAB + (size_t)(layer * 2 + 1) * 16384 * 1024;
    unsigned short* X = (unsigned short*)(F.ws + WS_X); const float* MOD = (const float*)(F.ws + WS_MOD) + (size_t)layer * 5 * 6144;
    const bool bit3 = (lane & 8) != 0;
#define V_METAP(pk, n_) do { const int r_ = tok_row(layer, (n_) < ntok ? (n_) : gwv); const unsigned* p_ = PK + (size_t)r_ * 128 + s; \
        _Pragma("unroll") for (int i_ = 0; i_ < 16; ++i_) pk[i_] = p_[8 * i_]; } while (0)
#define V_METAW(wq, n_) do { const int r_ = tok_row(layer, (n_) < ntok ? (n_) : gwv); const unsigned* w_ = WQ8 + (size_t)r_ * 32 + s; \
        _Pragma("unroll") for (int g_ = 0; g_ < 4; ++g_) wq[g_] = w_[8 * g_]; } while (0)
#define V_ISSUE(pk, lo) do { _Pragma("unroll") for (int i_ = (lo); i_ < (lo) + 8; ++i_) t[i_] = *(const u32x4*)(tb + (size_t)(pk[i_] >> 16) * 128); } while (0)
#define V_GRP(wq, g_) do { _Pragma("unroll") for (int j_ = 0; j_ < 4; ++j_) { const unsigned a_ = t[4 * (g_)][j_], b_ = t[4 * (g_) + 1][j_], c_ = t[4 * (g_) + 2][j_], d_ = t[4 * (g_) + 3][j_]; \
        const unsigned ablo = __builtin_amdgcn_perm(b_, a_, 0x05010400u), abhi = __builtin_amdgcn_perm(b_, a_, 0x07030602u), cdlo = __builtin_amdgcn_perm(d_, c_, 0x05010400u), cdhi = __builtin_amdgcn_perm(d_, c_, 0x07030602u); \
        acc[4 * j_]     = __builtin_amdgcn_sdot4((int)__builtin_amdgcn_perm(cdlo, ablo, 0x05040100u), (int)wq[g_], acc[4 * j_], false); \
        acc[4 * j_ + 1] = __builtin_amdgcn_sdot4((int)__builtin_amdgcn_perm(cdlo, ablo, 0x07060302u), (int)wq[g_], acc[4 * j_ + 1], false); \
        acc[4 * j_ + 2] = __builtin_amdgcn_sdot4((int)__builtin_amdgcn_perm(cdhi, abhi, 0x05040100u), (int)wq[g_], acc[4 * j_ + 2], false); \
        acc[4 * j_ + 3] = __builtin_amdgcn_sdot4((int)__builtin_amdgcn_perm(cdhi, abhi, 0x07060302u), (int)wq[g_], acc[4 * j_ + 3], false); } } while (0)
#define V_ITEM(pkc, wqc, pkn, n_) do { \
        int acc[16]; _Pragma("unroll") for (int a_ = 0; a_ < 16; ++a_) acc[a_] = 0; \
        V_METAP(pkc, (n_) + 2 * nwv); \
        V_GRP(wqc, 0); V_GRP(wqc, 1); \
        V_ISSUE(pkn, 0); \
        V_GRP(wqc, 2); V_GRP(wqc, 3); \
        V_ISSUE(pkn, 8); \
        int b8[8], c4[4], o[2]; \
        _Pragma("unroll") for (int a_ = 0; a_ < 8; ++a_) { auto rr = __builtin_amdgcn_permlane32_swap((unsigned)acc[a_], (unsigned)acc[a_ + 8], false, false); b8[a_] = (int)rr[0] + (int)rr[1]; } \
        _Pragma("unroll") for (int a_ = 0; a_ < 4; ++a_) { auto rr = __builtin_amdgcn_permlane16_swap((unsigned)b8[a_], (unsigned)b8[a_ + 4], false, false); c4[a_] = (int)rr[0] + (int)rr[1]; } \
        _Pragma("unroll") for (int a_ = 0; a_ < 2; ++a_) { const int keep = bit3 ? c4[a_ + 2] : c4[a_], send = bit3 ? c4[a_] : c4[a_ + 2]; o[a_] = keep + __builtin_amdgcn_update_dpp(0, send, 0x128, 0xf, 0xf, false); } \
        if ((n_) < ntok) { const int r_ = tok_row(layer, n_); const float ws_ = WSC[r_]; const int col = 128 * cb + 16 * c8 + 2 * s; \
            const f32x2 gf = *(const f32x2*)(MOD + (size_t)mod_index(r_) * 6144 + 5 * 1024 + col); unsigned* xp = (unsigned*)(X + (size_t)r_ * DM + col); \
            const unsigned xw = *xp; *xp = pkh2(h2f_lo(xw) + gf.x * (ws_ * (float)o[0]), h2f_hi(xw) + gf.y * (ws_ * (float)o[1])); } \
        V_METAW(wqc, (n_) + 2 * nwv); } while (0)
#pragma unroll 1
    for (int cbi = 0; cbi < ncb; ++cbi) {
        const int cb = cb0 + cbi;
        const unsigned char* tb = VT + (size_t)cb * 16384 * 128 + 16 * c8;
        unsigned pkA[16], pkB[16], wqA[4], wqB[4]; u32x4 t[16];
        V_METAP(pkA, gwv); V_METAW(wqA, gwv); V_METAP(pkB, gwv + nwv); V_METAW(wqB, gwv + nwv);
        V_ISSUE(pkA, 0); V_ISSUE(pkA, 8);
#pragma unroll 1
        for (int n = gwv; n < ntok; n += 2 * nwv) {
            V_ITEM(pkA, wqA, pkB, n);
            V_ITEM(pkB, wqB, pkA, n + nwv);
        }
    }
#undef V_METAP
#undef V_METAW
#undef V_ISSUE
#undef V_GRP
#undef V_ITEM
}
__device__ __forceinline__ void p_final_norm(const Args& A, const Frame& F) {
    const int gw = F.bid * NWAVES + F.wave, NGW = F.nblk * NWAVES, lane = F.lane;
    const unsigned short* X = (const unsigned short*)(F.ws + WS_X); const float* gn = A.in[I_NOUT];
#if ATTN_SELFTEST
    const unsigned* ctl_ = (const unsigned*)(F.ws + WS_CTL) + 16; const float mrel_ = fmaxf(__uint_as_float(__hip_atomic_load(ctl_, __ATOMIC_RELAXED, __HIP_MEMORY_SCOPE_AGENT)), __uint_as_float(__hip_atomic_load(ctl_ + 1, __ATOMIC_RELAXED, __HIP_MEMORY_SCOPE_AGENT)));
    const int nzero_ = (int)fminf((float)(NB * SEQ), mrel_ * (float)(NB * SEQ));
#endif
    for (int n = gw; n < NB * SEQ; n += NGW) {
        const unsigned short* xr = X + (size_t)tok_row(1, n) * DM; float* op = F.out + (size_t)n * DM;
#if ATTN_SELFTEST
        if (n < nzero_) { for (int j = 0; j < 4; ++j) *(f32x4*)(op + 4 * lane + 256 * j) = (f32x4){0.f, 0.f, 0.f, 0.f}; continue; }
#endif
        f32x4 v[4]; float sq = 0.f;
#pragma unroll
        for (int j = 0; j < 4; ++j) { const u32x2 a = *(const u32x2*)(xr + 4 * lane + 256 * j); v[j] = (f32x4){h2f_lo(a.x), h2f_hi(a.x), h2f_lo(a.y), h2f_hi(a.y)}; sq += (v[j].x * v[j].x + v[j].y * v[j].y) + (v[j].z * v[j].z + v[j].w * v[j].w); }
        const float rinv = rsqrtf(wave_sum(sq) * (1.f / DM) + EPS);
#pragma unroll
        for (int j = 0; j < 4; ++j) { const int c = 4 * lane + 256 * j; *(f32x4*)(op + c) = v[j] * rinv * *(const f32x4*)(gn + c); }
    }
}

#if ATTN_SELFTEST
template <int DQK>
__device__ __forceinline__ float attn_check_row(const bf16_t* qrow, int rope_t, const unsigned char* K8, int ldk, const unsigned char* V8, int ldv, int nk, float scale, const bf16_t* orow, float* sl, float* ql, int lane) {
    for (int d = lane; d < DQK; d += 64) ql[d] = bf2f(qrow[d]);
    asm volatile("s_waitcnt lgkmcnt(0)" ::: "memory");
    if (DQK == 192 && rope_t >= 0 && lane < 32) {
        const int i = lane & 15, ax = lane >> 4; const float pos = (float)(ax ? (rope_t & 63) : (rope_t >> 6));
        const float invf = __powf(10000.f, -(float)i * (1.f / 16.f)), ang = pos * invf, cs = __cosf(ang), sn = __sinf(ang);
        const float x1 = ql[128 + 32 * ax + i], x2 = ql[128 + 32 * ax + 16 + i];
        ql[128 + 32 * ax + i] = x1 * cs - x2 * sn; ql[128 + 32 * ax + 16 + i] = x2 * cs + x1 * sn;
    }
    asm volatile("s_waitcnt lgkmcnt(0)" ::: "memory");
    for (int d = lane; d < DQK; d += 64) { const float v = ql[d]; ql[d] = f8dec<0>(f8x4(v, v, v, v)); }
    asm volatile("s_waitcnt lgkmcnt(0)" ::: "memory");
    float mx = -1e30f;
    for (int k = lane; k < nk; k += 64) {
        const unsigned char* kr = K8 + (size_t)k * ldk; float acc = 0.f;
#pragma unroll 1
        for (int c = 0; c < DQK / 16; ++c) { const u32x4 w = *(const u32x4*)(kr + 16 * c);
#pragma unroll
            for (int e = 0; e < 4; ++e) acc += (ql[16 * c + 4 * e] * f8dec<0>(w[e]) + ql[16 * c + 4 * e + 1] * f8dec<1>(w[e])) + (ql[16 * c + 4 * e + 2] * f8dec<2>(w[e]) + ql[16 * c + 4 * e + 3] * f8dec<3>(w[e])); }
        acc *= scale; sl[k] = acc; mx = fmaxf(mx, acc);
    }
    mx = wave_max(mx);
#if ATT8_FIXED_M
    mx = 6.f;
#endif
    float sum = 0.f;
    for (int k = lane; k < nk; k += 64) { float pv = __builtin_amdgcn_exp2f((sl[k] - mx) * 1.4426950408889634f + ATT8_SH);
#if ATT8_FIXED_M
        pv = f8dec<0>(f8x4(pv, pv, pv, pv));
        sum += pv;
#else
        sum += pv;
#endif
        sl[k] = pv; }
    sum = wave_sum(sum);
    asm volatile("s_waitcnt lgkmcnt(0)" ::: "memory");
    float o0 = 0.f, o1 = 0.f;
    for (int k = 0; k < nk; ++k) { const float pv = sl[k]; const unsigned w = *(const unsigned short*)(V8 + (size_t)k * ldv + 2 * lane); o0 += pv * f8dec<0>(w); o1 += pv * f8dec<1>(w); }
    o0 /= sum; o1 /= sum;
    const unsigned fw = *(const unsigned*)(orow + 2 * lane); const float f0 = bflo(fw), f1 = bfhi(fw);
    const float num = wave_sum((f0 - o0) * (f0 - o0) + (f1 - o1) * (f1 - o1)), den = wave_sum(o0 * o0 + o1 * o1);
    return sqrtf(num / fmaxf(den, 1e-30f));
}
__device__ __forceinline__ void attn_selftest(const Frame& F, int layer) {
    float* sl = (float*)F.lds + F.wave * (RPB + 192); float* ql = sl + RPB;
    const int gw = F.bid * NWAVES + F.wave;
    unsigned hsh = (unsigned)gw * 2654435761u + 12345u * (unsigned)(layer + 1); hsh ^= hsh >> 15; hsh *= 2246822519u; hsh ^= hsh >> 13;
    const int h = (int)(hsh & 7u); float rel;
    if (layer == 0) {
        const int r = (int)((hsh >> 3) % (unsigned)R), b = r / RPB, j = r - b * RPB; const bool ctx = j < CTXL; const size_t rb = (size_t)b * RPB;
        rel = attn_check_row<192>((const bf16_t*)(F.ws + WS_Q) + (size_t)r * 1536 + h * 192, ctx ? -1 : j - CTXL, F.ws + WS_K + rb * 1536 + h * 192, 1536,
                                  F.ws + WS_V + rb * 1024 + h * 128, 1024, ctx ? CTXL : RPB, 0.07216878364870322f, (const bf16_t*)(F.ws + WS_O) + (size_t)r * 1024 + h * 128, sl, ql, F.lane);
    } else {
        const int n = (int)((hsh >> 3) % (unsigned)(NB * SEQ)), r = (n >> 12) * RPB + CTXL + (n & 4095), b = r / RPB, kvh = h >> 2; const size_t rb = (size_t)b * RPB;
        rel = attn_check_row<128>((const bf16_t*)(F.ws + WS_Q1) + (size_t)r * 1024 + h * 128, -1, F.ws + WS_K1 + rb * 256 + kvh * 128, 256,
                                  F.ws + WS_V1 + rb * 256 + kvh * 128, 256, RPB, 0.08838834764831845f, (const bf16_t*)(F.ws + WS_O) + (size_t)r * 1024 + h * 128, sl, ql, F.lane);
    }
    if (!(rel < 1e30f)) rel = 1e30f;
    if (F.lane == 0) atomicMax((unsigned*)(F.ws + WS_CTL) + 16 + layer, __float_as_uint(rel));
    __syncthreads();
}
#endif

constexpr int N_PHASES = 24;
__global__ void __launch_bounds__(NTHREADS, 2) mega(Args args) {
    extern __shared__ __attribute__((aligned(16))) unsigned char lds_raw[];
    Frame F; F.x = args.in[I_X]; F.ctx = args.in[I_CTX]; F.out = args.out; F.ws = args.ws; F.lds = (char*)lds_raw;
    F.tid = threadIdx.x; F.lane = F.tid & 63; F.wave = __builtin_amdgcn_readfirstlane(F.tid >> 6); F.bid = blockIdx.x; F.nblk = gridDim.x;
    F.vcu = (F.nblk % 8 == 0) ? (F.bid % 8) * (F.nblk / 8) + F.bid / 8 : F.bid;
    volatile LAS unsigned* st = (volatile LAS unsigned*)(LAS unsigned char*)(lds_raw + LDS_BYTES - 64);
    if (F.tid < 16) st[F.tid] = 0u;
    __syncthreads();
    XcdBarrier bar; bar.bar = (unsigned*)(F.ws + WS_CTL) + 4096; bar.x = 0; bar.st = st;
    const int lo = args.ph_lo, hi = args.ph_hi;
    const bool fused = (hi - lo) > 1;
    if (fused) bar = xcd_barrier_post((unsigned*)(F.ws + WS_CTL) + 4096, st);
#ifdef ONLY_PHASE
#define IN(k) ((k) == ONLY_PHASE && lo <= (k) && (k) < hi)
#else
#define IN(k) (lo <= (k) && (k) < hi)
#endif
#define SEAM(k) do { if (IN(k) && IN((k) + 1)) { if ((k) == 0) cg::this_grid().sync(); else xcd_barrier(bar); } } while (0)
    bf16_t* Hb = (bf16_t*)(F.ws + WS_H);
#define PH(k, ...) if (IN(k)) for (int rep_ = 0; rep_ < (((PROBE_MASK >> (k)) & 1u) ? 2 : 1); ++rep_) { __VA_ARGS__; __syncthreads(); } SEAM(k)
    unsigned short* Xb = (unsigned short*)(F.ws + WS_X); const float* MODb = (const float*)(F.ws + WS_MOD);
    PH(0, for (int q_ = 0; q_ < ((PROBE_P0 & 1u) ? 2 : 1); ++q_) { p0_mod(args, F); __syncthreads(); }
          for (int q_ = 0; q_ < ((PROBE_P0 & 2u) ? 2 : 1); ++q_) { p0_weights(args, F); __syncthreads(); }
          for (int q_ = 0; q_ < ((PROBE_P0 & 4u) ? 2 : 1); ++q_) { p0_weff(args, F); __syncthreads(); }
          for (int q_ = 0; q_ < ((PROBE_P0 & 8u) ? 2 : 1); ++q_) { p0_tables(args, F); __syncthreads(); });
    PH(1, p_norm_rows(args, F, 0, 0, true, false));
    PH(2, gemm8e(F, Hb, (const bf16_t*)(F.ws + WS_WIN), 768, 1024, false, EpiMlaDown{(bf16_t*)(F.ws + WS_CQ), (bf16_t*)(F.ws + WS_CKV), (bf16_t*)(F.ws + WS_KR), (float*)(F.ws + WS_SSP)}));
    PH(3, p_mla_krope(args, F);
          gemm8(F, (const bf16_t*)(F.ws + WS_CQ), (const bf16_t*)(F.ws + WS_WUQ), 1536, 384, false, In8Bf16Rs{(bf16_t*)(F.ws + WS_Q), 1536, (const float*)(F.ws + WS_SSP)});
          gemm8(F, (const bf16_t*)(F.ws + WS_CKV), (const bf16_t*)(F.ws + WS_WUKV), 2048, 256, false, In8KVRs{F.ws + WS_K, F.ws + WS_V, (const float*)(F.ws + WS_SSP)}, true));
    PH(4, p_attn_mla(args, F));
#if ATTN_SELFTEST & 1
    if (IN(5)) attn_selftest(F, 0);
#endif
    PH(5, gemm8(F, (const bf16_t*)(F.ws + WS_O), (const bf16_t*)(F.ws + WS_WO0), 1024, 1024, false, In8Resid{F.x, F.ctx, Xb, MODb + 2 * 1024, true}));
    PH(6, p_norm_rows(args, F, 0, 1, false, false));
    PH(7, gemm8(F, Hb, (const bf16_t*)(F.ws + WS_WQ0), 2048, 1024, false, In8F16{(unsigned short*)(F.ws + WS_S), 2048}));
    PH(8, p_peer_topk(args, F, false));
    PH(9, p_exp_u(args, F, 0));
    PH(10, p_exp_w(args, F, 0));
    if (IN(11)) { p_exp_v(args, F, 0); } SEAM(11);
    PH(12, p_norm_rows(args, F, 1, 0, false, false));
    PH(13, gemm8(F, Hb, (const bf16_t*)(F.ws + WS_WQKV), 1536, 1024, false, In8Bf16{(bf16_t*)(F.ws + WS_RAW1), 1536}));
    PH(14, p_gqa_rows(args, F));
    PH(15, p_attn_gqa<0>(args, F, (bf16_t*)(F.ws + WS_O)));
#ifdef ATTN_PROBE_VAR
    if (IN(15)) { p_attn_gqa<ATTN_PROBE_VAR>(args, F, (bf16_t*)(F.ws + WS_S)); __syncthreads(); }
#endif
#if ATTN_SELFTEST & 2
    if (IN(16)) attn_selftest(F, 1);
#endif
    if (IN(16)) { gemm8(F, (const bf16_t*)(F.ws + WS_O), (const bf16_t*)(F.ws + WS_WO1), 1024, 1024, true, In8Resid{F.x, F.ctx, Xb, MODb + 5 * 6144 + 2 * 1024, false}); } SEAM(16);
    PH(17, p_norm_rows(args, F, 1, 1, false, true));
    PH(18, gemm8(F, Hb, (const bf16_t*)(F.ws + WS_WQ1), 2048, 1024, true, In8F16{(unsigned short*)(F.ws + WS_S), 2048}));
    PH(19, p_peer_topk(args, F, true));
    PH(20, p_exp_u(args, F, 1));
    PH(21, p_exp_w(args, F, 1));
    if (IN(22)) { p_exp_v(args, F, 1); } SEAM(22);
    if (IN(23)) p_final_norm(args, F);
#undef PH
#undef IN
#undef SEAM
}

extern "C" void kernel_launch(void* const* d_in, const int* in_sizes, int n_in, void* d_out, int out_size, void* d_ws, size_t ws_size, hipStream_t stream) {
    static int grid = 0;
    if (grid == 0) {
        if (n_in != N_IN || in_sizes[0] != NB * SEQ * DM || out_size != NB * SEQ * DM || ws_size < WS_END) {
            fprintf(stderr, "kernel_launch: shape mismatch (n_in %d, in0 %d, out %d, ws %zu < %zu)\n", n_in, n_in > 0 ? in_sizes[0] : -1, out_size, ws_size, (size_t)WS_END); grid = -1; return; }
        int dev = 0, cus = 0, per_cu = 0;
        hipGetDevice(&dev); hipDeviceGetAttribute(&cus, hipDeviceAttributeMultiprocessorCount, dev);
        if (hipFuncSetAttribute((const void*)mega, hipFuncAttributeMaxDynamicSharedMemorySize, LDS_BYTES) != hipSuccess) { fprintf(stderr, "kernel_launch: hipFuncSetAttribute failed\n"); grid = -1; return; }
        if (hipOccupancyMaxActiveBlocksPerMultiprocessor(&per_cu, (const void*)mega, NTHREADS, LDS_BYTES) != hipSuccess || per_cu < 1) { fprintf(stderr, "kernel_launch: occupancy query failed (%d)\n", per_cu); (void)hipGetLastError(); grid = -1; return; }
        grid = cus * (per_cu > 1 ? 1 : per_cu);
    }
    if (grid < 0) return;
    hipMemsetAsync((char*)d_ws + WS_CTL, 0, 1 * MiB, stream);
    Args a{};
    for (int i = 0; i < N_IN; ++i) a.in[i] = (const float*)d_in[i];
    a.out = (float*)d_out; a.ws = (unsigned char*)d_ws;
#if MK_PER_PHASE
    for (int p = 0; p < N_PHASES; ++p) { a.ph_lo = p; a.ph_hi = p + 1; hipLaunchKernelGGL(mega, dim3(grid), dim3(NTHREADS), LDS_BYTES, stream, a); }
#else
    a.ph_lo = 0; a.ph_hi = N_PHASES;
    void* kargs[] = {&a};
    hipError_t e = hipLaunchCooperativeKernel((const void*)mega, dim3(grid), dim3(NTHREADS), kargs, LDS_BYTES, stream);
    if (e != hipSuccess) fprintf(stderr, "kernel_launch: cooperative launch failed: %s (grid %d)\n", hipGetErrorString(e), grid);
#endif
}
```

```cpp
#include <hip/hip_runtime.h>
#include <hip/hip_cooperative_groups.h>
#include <cstdio>
#include <cstdint>
namespace cg = cooperative_groups;

#ifndef PROBE_MASK
#define PROBE_MASK 0u
#endif
#ifndef PROBE_P0
#define PROBE_P0 0u
#endif
#ifndef ATTN_SELFTEST
#define ATTN_SELFTEST 0
#endif
#ifndef MK_PER_PHASE
#define MK_PER_PHASE 0
#endif

typedef unsigned short bf16_t;
typedef short bf16x8 __attribute__((ext_vector_type(8)));
typedef short s16x4 __attribute__((ext_vector_type(4)));
typedef float f32x4 __attribute__((ext_vector_type(4)));
typedef float f32x2 __attribute__((ext_vector_type(2)));
typedef float f32x16 __attribute__((ext_vector_type(16)));
typedef unsigned u32x4 __attribute__((ext_vector_type(4)));
typedef unsigned u32x2 __attribute__((ext_vector_type(2)));
#define LAS __attribute__((address_space(3)))
#define SBAR() __builtin_amdgcn_sched_barrier(0)

__device__ __forceinline__ unsigned f2bf(float f) { unsigned u = __builtin_bit_cast(unsigned, f); return (u + 0x7fffu + ((u >> 16) & 1u)) >> 16; }
__device__ __forceinline__ unsigned pk2(float lo, float hi) { return f2bf(lo) | (f2bf(hi) << 16); }
typedef _Float16 f16x2_t __attribute__((ext_vector_type(2)));
__device__ __forceinline__ unsigned pkh2(float lo, float hi) { f32x2 v = {lo, hi}; return __builtin_bit_cast(unsigned, __builtin_convertvector(v, f16x2_t)); }
__device__ __forceinline__ float h2f_lo(unsigned w) { return (float)__builtin_bit_cast(_Float16, (unsigned short)(w & 0xffffu)); }
__device__ __forceinline__ float h2f_hi(unsigned w) { return (float)__builtin_bit_cast(_Float16, (unsigned short)(w >> 16)); }
__device__ __forceinline__ float bf2f(unsigned short h) { return __builtin_bit_cast(float, (unsigned)h << 16); }
__device__ __forceinline__ float bflo(unsigned w) { return __builtin_bit_cast(float, w << 16); }
__device__ __forceinline__ float bfhi(unsigned w) { return __builtin_bit_cast(float, w & 0xffff0000u); }
__device__ __forceinline__ unsigned cvtpk(float lo, float hi) { unsigned r; asm volatile("v_cvt_pk_bf16_f32 %0, %1, %2" : "=v"(r) : "v"(lo), "v"(hi)); return r; }
typedef int i32x8 __attribute__((ext_vector_type(8)));
__device__ __forceinline__ unsigned f8x4(float a, float b, float c, float d) { int w = __builtin_amdgcn_cvt_pk_fp8_f32(a, b, 0, false); w = __builtin_amdgcn_cvt_pk_fp8_f32(c, d, w, true); return (unsigned)w; }
template <int B> __device__ __forceinline__ float f8dec(unsigned w) { return __builtin_amdgcn_cvt_f32_fp8((int)w, B); }
#define WDPP(v, ctrl) __builtin_bit_cast(float, __builtin_amdgcn_update_dpp(0, __builtin_bit_cast(int, v), ctrl, 0xf, 0xf, false))
__device__ __forceinline__ float wave_sum(float v) {
    v += WDPP(v, 0xB1); v += WDPP(v, 0x4E); v += WDPP(v, 0x141); v += WDPP(v, 0x140);
    { auto rr = __builtin_amdgcn_permlane16_swap(__float_as_uint(v), __float_as_uint(v), false, false); v = __uint_as_float(rr[0]) + __uint_as_float(rr[1]); }
    { auto rr = __builtin_amdgcn_permlane32_swap(__float_as_uint(v), __float_as_uint(v), false, false); v = __uint_as_float(rr[0]) + __uint_as_float(rr[1]); }
    return v;
}
__device__ __forceinline__ float wave_max(float v) {
    v = fmaxf(v, WDPP(v, 0xB1)); v = fmaxf(v, WDPP(v, 0x4E)); v = fmaxf(v, WDPP(v, 0x141)); v = fmaxf(v, WDPP(v, 0x140));
    { auto rr = __builtin_amdgcn_permlane16_swap(__float_as_uint(v), __float_as_uint(v), false, false); v = fmaxf(__uint_as_float(rr[0]), __uint_as_float(rr[1])); }
    { auto rr = __builtin_amdgcn_permlane32_swap(__float_as_uint(v), __float_as_uint(v), false, false); v = fmaxf(__uint_as_float(rr[0]), __uint_as_float(rr[1])); }
    return v;
}

constexpr int DM = 1024, NB = 4, SEQ = 4096, CTXL = 256;
constexpr int RPB = SEQ + CTXL;
constexpr int R = NB * RPB;
constexpr float EPS = 1e-6f;
constexpr int NTHREADS = 512, NWAVES = 8;
constexpr int LDS_BYTES = 147456;

enum { I_X = 0, I_C, I_CTX, I_CCTX,
       I0_ADAW, I0_ADAB, I0_NMIX, I0_NFFN, I0_WIN, I0_QN, I0_WUQ, I0_KVN, I0_WUKV, I0_WO, I0_PWQ, I0_PK1, I0_PK2, I0_PU, I0_PV,
       I1_ADAW, I1_ADAB, I1_NMIX, I1_NFFN, I1_WQKV, I1_QN, I1_KN, I1_WO, I1_PWQ, I1_PK1, I1_PK2, I1_PU, I1_PV,
       I_NOUT, N_IN };

constexpr size_t MiB = 1u << 20;
constexpr size_t WS_CTL   = 0;
constexpr size_t WS_MOD   = 1 * MiB;
constexpr size_t WS_WIN   = 2 * MiB;
constexpr size_t WS_WUQ   = WS_WIN + 768 * 1024 * 2;
constexpr size_t WS_WUKV  = WS_WUQ + 1536 * 384 * 2;
constexpr size_t WS_WO0   = WS_WUKV + 2048 * 256 * 2;
constexpr size_t WS_WQ0   = WS_WO0 + 1024 * 1024 * 2;
constexpr size_t WS_KK0   = WS_WQ0 + 2048 * 1024 * 2;
constexpr size_t WS_WQKV  = WS_KK0 + 16 * 128 * 128 * 2;
constexpr size_t WS_WO1   = WS_WQKV + 1536 * 1024 * 2;
constexpr size_t WS_WQ1   = WS_WO1 + 1024 * 1024 * 2;
constexpr size_t WS_KK1   = WS_WQ1 + 2048 * 1024 * 2;
constexpr size_t WS_WEND  = WS_KK1 + 16 * 128 * 128 * 2;
static_assert(WS_WEND <= 24 * MiB, "weights region");
constexpr size_t WS_H     = 24 * MiB;
constexpr size_t WS_X     = WS_H + (size_t)R * 1024 * 2;
constexpr size_t WS_QKV   = WS_X + (size_t)R * 1024 * 4;
constexpr size_t WS_Q     = WS_QKV;
constexpr size_t WS_K     = WS_Q + (size_t)R * 1536 * 2;
constexpr size_t WS_V     = WS_K + (size_t)R * 1536 * 2;
constexpr size_t WS_S     = WS_QKV;
constexpr size_t WS_B     = WS_QKV + (size_t)R * 2048 * 4;
constexpr size_t WS_CQ    = WS_B;
constexpr size_t WS_CKV   = WS_CQ + (size_t)R * 384 * 2;
constexpr size_t WS_KR    = WS_CKV + (size_t)R * 256 * 2;
constexpr size_t WS_SSP   = WS_KR + (size_t)R * 64 * 2;
static_assert(WS_SSP + (size_t)R * 24 * 4 <= WS_B + 40 * MiB, "MLA latents inside region B");
constexpr size_t WS_O     = WS_B;
constexpr size_t WS_QP    = WS_B;
constexpr size_t WS_RAW1  = WS_B;
constexpr size_t WS_PK    = WS_B + (size_t)R * 2048 * 2;
constexpr size_t WS_TAB   = WS_PK + (size_t)R * 128 * 4;
constexpr size_t WS_PD    = WS_S;
constexpr size_t WS_WQ8   = WS_PD + (size_t)8 * R * 128 * 4;
constexpr size_t WS_WSC   = WS_WQ8 + (size_t)R * 128;
static_assert(WS_WSC + (size_t)R * 4 <= WS_B, "expert scratch inside the S region");
constexpr size_t WS_HQ    = WS_B + 40 * MiB;
constexpr size_t WS_HS    = WS_HQ + (size_t)R * 1024;
static_assert(WS_HS + (size_t)R * 4 <= WS_PK, "HQ inside region B");
constexpr size_t WS_TSC   = WS_TAB + (size_t)4 * 16384 * 1024;
constexpr size_t WS_END   = WS_TSC + (size_t)4 * 16384 * 4;
constexpr size_t WS_Q1    = WS_QKV;
constexpr size_t WS_K1    = WS_Q1 + (size_t)R * 1024 * 2;
constexpr size_t WS_V1    = WS_K1 + (size_t)R * 256 * 2;

#define XB_TMO      128
#define XB_XCNT(j)  (256  + 64 * (j))
#define XB_XSUB(j)  (1280 + 64 * (j))
#define XB_XGEN(j)  (2304 + 64 * (j))
#define XB_TOP      3328
#define XB_TOPGEN   3392
#define XCD_BAR_WORDS 3456
#define XB_SPIN_CAP (1u << 20)
__device__ __forceinline__ unsigned xb_ld(unsigned* p)              { return __hip_atomic_load(p, __ATOMIC_RELAXED, __HIP_MEMORY_SCOPE_AGENT); }
__device__ __forceinline__ unsigned xb_add(unsigned* p, unsigned v) { return __hip_atomic_fetch_add(p, v, __ATOMIC_RELAXED, __HIP_MEMORY_SCOPE_AGENT); }
__device__ __forceinline__ unsigned xb_xcc_id() { return (unsigned)__builtin_amdgcn_s_getreg((3 << 11) | 20) & 0xFu; }
#define XB_SPIN(cond, bar) do { unsigned _sp = 0; while (cond) { __builtin_amdgcn_s_sleep(1); \
    if ((++_sp & 255u) == 0u) { if (xb_ld(&(bar)[XB_TMO])) break; if (_sp > XB_SPIN_CAP) { atomicAdd(&(bar)[XB_TMO], 1u); break; } } } } while (0)
struct XcdBarrier { unsigned* bar; unsigned x; volatile LAS unsigned* st; };
__device__ __forceinline__ XcdBarrier xcd_barrier_post(unsigned* bar, volatile LAS unsigned* st) {
    XcdBarrier b; b.bar = bar; b.x = xb_xcc_id(); b.st = st;
    if (threadIdx.x == 0) (void)xb_add(&bar[XB_XCNT(b.x)], 1u);
    return b;
}
__device__ __forceinline__ void xcd_barrier_complete(unsigned* bar, unsigned x, unsigned& nloc, unsigned& nx) {
    const unsigned G = gridDim.x * gridDim.y * gridDim.z;
    unsigned sum, cnt, mine, sp = 0u;
    for (;;) {
        sum = 0u; cnt = 0u; mine = 0u;
#pragma unroll
        for (unsigned j = 0; j < 16; ++j) { const unsigned c = xb_ld(&bar[XB_XCNT(j)]); sum += c; cnt += (c > 0u) ? 1u : 0u; mine = (j == x) ? c : mine; }
        if (sum == G) break;
        __builtin_amdgcn_s_sleep(1);
        if ((++sp & 255u) == 0u) { if (xb_ld(&bar[XB_TMO])) break; if (sp > XB_SPIN_CAP) { atomicAdd(&bar[XB_TMO], 1u); break; } }
    }
    nloc = mine > 0u ? mine : 1u; nx = cnt > 0u ? cnt : 1u;
}
__device__ __forceinline__ void xcd_barrier(const XcdBarrier& b) {
    asm volatile("s_waitcnt vmcnt(0)" ::: "memory");
    __syncthreads();
    if (threadIdx.x == 0) {
        unsigned* bar = b.bar;
        __builtin_amdgcn_s_waitcnt(0);
        unsigned nloc = b.st[0], nx = b.st[1];
        if (nloc == 0u) { xcd_barrier_complete(bar, b.x, nloc, nx); b.st[0] = nloc; b.st[1] = nx; }
        const unsigned old = xb_add(&bar[XB_XSUB(b.x)], 1u);
        const unsigned gen = old / nloc;
        if (old + 1u == (gen + 1u) * nloc) {
            __builtin_amdgcn_fence(__ATOMIC_RELEASE, "agent");
            asm volatile("s_waitcnt vmcnt(0)" ::: "memory");
            const unsigned og = xb_add(&bar[XB_TOP], 1u);
            const unsigned tg = og / nx;
            if (og + 1u == (tg + 1u) * nx) xb_add(&bar[XB_TOPGEN], 1u);
            else XB_SPIN(xb_ld(&bar[XB_TOPGEN]) == tg, bar);
            __builtin_amdgcn_fence(__ATOMIC_ACQUIRE, "agent");
            xb_add(&bar[XB_XGEN(b.x)], 1u);
            asm volatile("s_waitcnt vmcnt(0)" ::: "memory");
        } else {
            XB_SPIN(xb_ld(&bar[XB_XGEN(b.x)]) == gen, bar);
            __builtin_amdgcn_fence(__ATOMIC_ACQUIRE, "agent");
            asm volatile("s_waitcnt vmcnt(0)" ::: "memory");
        }
    }
    __syncthreads();
}


struct Args { const float* in[N_IN]; float* out; unsigned char* ws; int ph_lo, ph_hi; };
static_assert(sizeof(Args) == (N_IN + 2) * 8 + 8, "Args has no padding");

struct Frame {
    const float* x; const float* ctx; float* out; unsigned char* ws; char* lds;
    int tid, lane, wave, bid, nblk, vcu;
};

__device__ __forceinline__ const float* xin_row(const Frame& F, int r) {
    const int b = r / RPB, j = r - b * RPB;
    return (j < CTXL) ? F.ctx + ((size_t)b * CTXL + j) * DM : F.x + ((size_t)b * SEQ + (j - CTXL)) * DM;
}
__device__ __forceinline__ int mod_index(int r) { const int b = r / RPB, j = r - b * RPB; return (j < CTXL) ? 4 : b; }
__device__ __forceinline__ bool is_ctx_row(int r) { return (r % RPB) < CTXL; }

__device__ __forceinline__ void p0_mod(const Args& A, const Frame& F) {
    float* sv = (float*)F.lds;
    float* red = sv + 5 * 1024;
    float* MOD = (float*)(F.ws + WS_MOD);
    bool have = false;
    for (int it = F.bid; it < 2 * 96; it += F.nblk) {
        if (!have) {
            for (int i = F.tid; i < 5 * 1024; i += NTHREADS) { const int m = i >> 10, k = i & 1023;
                const float c = (m < 4) ? A.in[I_C][m * 1024 + k] : A.in[I_CCTX][k]; sv[i] = c / (1.f + __expf(-c)); }
            __syncthreads(); have = true;
        }
        const int l = it / 96, n = (it % 96) * 64 + F.lane;
        const float* W = A.in[l ? I1_ADAW : I0_ADAW]; const float* Bv = A.in[l ? I1_ADAB : I0_ADAB];
        float acc[5] = {0.f, 0.f, 0.f, 0.f, 0.f};
        const int k0 = F.wave * 128;
#pragma unroll 16
        for (int k = k0; k < k0 + 128; ++k) { const float w = W[(size_t)k * 6144 + n];
#pragma unroll
            for (int m = 0; m < 5; ++m) acc[m] += sv[m * 1024 + k] * w; }
#pragma unroll
        for (int m = 0; m < 5; ++m) red[(F.wave * 5 + m) * 64 + F.lane] = acc[m];
        __syncthreads();
        if (F.tid < 320) { const int m = F.tid >> 6, ln = F.tid & 63; float s = 0.f;
#pragma unroll
            for (int w = 0; w < 8; ++w) s += red[(w * 5 + m) * 64 + ln];
            const int nn = (it % 96) * 64 + ln;
            MOD[((size_t)l * 5 + m) * 6144 + nn] = s + Bv[nn]; }
        __syncthreads();
    }
}
__device__ __forceinline__ void transpose_item(const float* W, int K, int N, bf16_t* WT, const float* gain, float* scr, int item, int lane) {
    const int nblk = N / 32, kb = item / nblk, nb = item % nblk, k0 = 64 * kb, n0 = 32 * nb;
#pragma unroll 8
    for (int i = 0; i < 32; ++i) { const int kk = 2 * i + (lane >> 5); float v = W[(size_t)(k0 + kk) * N + n0 + (lane & 31)]; if (gain) v *= gain[k0 + kk]; scr[kk * 33 + (lane & 31)] = v; }
    asm volatile("s_waitcnt lgkmcnt(0)" ::: "memory");
    const int c = lane & 7;
#pragma unroll
    for (int j = 0; j < 4; ++j) { const int n = (lane >> 3) + 8 * j; const float* s = scr + (8 * c) * 33 + n;
        u32x4 o; o.x = pk2(s[0 * 33], s[1 * 33]); o.y = pk2(s[2 * 33], s[3 * 33]); o.z = pk2(s[4 * 33], s[5 * 33]); o.w = pk2(s[6 * 33], s[7 * 33]);
        *(u32x4*)(WT + (size_t)(n0 + n) * K + k0 + 8 * c) = o; }
    asm volatile("s_waitcnt lgkmcnt(0)" ::: "memory");
}
__device__ __forceinline__ void p0_weights(const Args& A, const Frame& F) {
    float* scr = (float*)(F.lds + 32768) + F.wave * (64 * 33);
    const int gw = F.bid * NWAVES + F.wave, NGW = F.nblk * NWAVES;
#define TJOB(IN_, K_, N_, OFF_, GAIN_) do { const float* W = A.in[IN_]; bf16_t* WT = (bf16_t*)(F.ws + (OFF_)); \
        for (int it = gw; it < ((K_) / 64) * ((N_) / 32); it += NGW) transpose_item(W, K_, N_, WT, GAIN_, scr, it, F.lane); } while (0)
    TJOB(I0_WIN, 1024, 704, WS_WIN, nullptr); TJOB(I0_WUQ, 384, 1536, WS_WUQ, A.in[I0_QN]); TJOB(I0_WUKV, 256, 2048, WS_WUKV, A.in[I0_KVN]); TJOB(I0_WO, 1024, 1024, WS_WO0, nullptr);
    TJOB(I1_WQKV, 1024, 1536, WS_WQKV, nullptr); TJOB(I1_WO, 1024, 1024, WS_WO1, nullptr);
#undef TJOB
    { u32x4* z = (u32x4*)(F.ws + WS_WIN + (size_t)704 * 1024 * 2); const int n16 = 64 * 1024 * 2 / 16;
      for (int i = F.bid * NTHREADS + F.tid; i < n16; i += F.nblk * NTHREADS) z[i] = (u32x4){0u, 0u, 0u, 0u}; }
}
__device__ __forceinline__ void p0_weff(const Args& A, const Frame& F) {
    float* kkT = (float*)F.lds; float* wqs = kkT + 128 * 129;
    const int tid = F.tid, lane = F.lane, w = F.wave;
    for (int item = F.bid; item < 512; item += F.nblk) {
        const int layer = item >> 8, z = (item >> 4) & 15, kc = item & 15, h = z >> 1;
        const float* kk = ((z & 1) ? (layer ? A.in[I1_PK2] : A.in[I0_PK2]) : (layer ? A.in[I1_PK1] : A.in[I0_PK1])) + (size_t)h * 16384;
        const float* wq = (layer ? A.in[I1_PWQ] : A.in[I0_PWQ]) + (size_t)(kc * 64) * 2048 + z * 128;
        bf16_t* WT = (bf16_t*)(F.ws + (layer ? WS_WQ1 : WS_WQ0));
        __syncthreads();
        { f32x4 kv[8], wv4[4];
#pragma unroll
          for (int i = 0; i < 8; ++i) kv[i] = *(const f32x4*)(kk + 4 * (tid + i * NTHREADS));
#pragma unroll
          for (int i = 0; i < 4; ++i) { const int e = 4 * (tid + i * NTHREADS); wv4[i] = *(const f32x4*)(wq + (size_t)(e >> 7) * 2048 + (e & 127)); }
#pragma unroll
          for (int i = 0; i < 8; ++i) { const int e = 4 * (tid + i * NTHREADS), key = e >> 7, d = e & 127; kkT[d * 129 + key] = kv[i].x; kkT[(d + 1) * 129 + key] = kv[i].y; kkT[(d + 2) * 129 + key] = kv[i].z; kkT[(d + 3) * 129 + key] = kv[i].w; }
#pragma unroll
          for (int i = 0; i < 4; ++i) *(f32x4*)(wqs + 4 * (tid + i * NTHREADS)) = wv4[i]; }
        __syncthreads();
        float acc[8][2];
#pragma unroll
        for (int j = 0; j < 8; ++j) { acc[j][0] = 0.f; acc[j][1] = 0.f; }
#pragma unroll 2
        for (int d = 0; d < 128; ++d) { const float a0 = kkT[d * 129 + lane], a1 = kkT[d * 129 + lane + 64];
#pragma unroll
            for (int j = 0; j < 8; ++j) { const float wv = wqs[(w * 8 + j) * 128 + d]; acc[j][0] += wv * a0; acc[j][1] += wv * a1; } }
        u32x4 o0, o1;
        o0.x = pk2(acc[0][0], acc[1][0]); o0.y = pk2(acc[2][0], acc[3][0]); o0.z = pk2(acc[4][0], acc[5][0]); o0.w = pk2(acc[6][0], acc[7][0]);
        o1.x = pk2(acc[0][1], acc[1][1]); o1.y = pk2(acc[2][1], acc[3][1]); o1.z = pk2(acc[4][1], acc[5][1]); o1.w = pk2(acc[6][1], acc[7][1]);
        *(u32x4*)(WT + (size_t)(z * 128 + lane) * 1024 + kc * 64 + w * 8) = o0;
        *(u32x4*)(WT + (size_t)(z * 128 + lane + 64) * 1024 + kc * 64 + w * 8) = o1;
    }
    __syncthreads();
}

__device__ __forceinline__ void p0_tables(const Args& A, const Frame& F) {
    const int gw = F.bid * NWAVES + F.wave, NGW = F.nblk * NWAVES, lane = F.lane;
    unsigned char* TAB = F.ws + WS_TAB; float* TSC = (float*)(F.ws + WS_TSC);
    for (int it = gw; it < 4 * 16384 / 4; it += NGW) {
        const int t = it >> 12, row0 = (it & 4095) * 4;
        const float* src = (t == 0 ? A.in[I0_PU] : t == 1 ? A.in[I0_PV] : t == 2 ? A.in[I1_PU] : A.in[I1_PV]) + (size_t)row0 * 1024 + 4 * lane;
        f32x4 v[4][4];
#pragma unroll
        for (int rr = 0; rr < 4; ++rr)
#pragma unroll
            for (int j = 0; j < 4; ++j) v[rr][j] = *(const f32x4*)(src + (size_t)rr * 1024 + 256 * j);
#pragma unroll
        for (int rr = 0; rr < 4; ++rr) {
            float am = 0.f;
#pragma unroll
            for (int j = 0; j < 4; ++j) am = fmaxf(am, fmaxf(fmaxf(fabsf(v[rr][j].x), fabsf(v[rr][j].y)), fmaxf(fabsf(v[rr][j].z), fabsf(v[rr][j].w))));
            am = wave_max(am);
            const int row = row0 + rr;
            float sc;
            if ((t & 1) == 0) {
                float ss = 0.f;
#pragma unroll
                for (int j = 0; j < 4; ++j) ss += (v[rr][j].x * v[rr][j].x + v[rr][j].y * v[rr][j].y) + (v[rr][j].z * v[rr][j].z + v[rr][j].w * v[rr][j].w);
                ss = wave_sum(ss);
                sc = am > 0.f ? fminf(am * (1.f / 7.f), 0.36f * sqrtf(ss * (1.f / 1024.f))) : 1.f;
                const float inv = am > 0.f ? 1.f / sc : 0.f;
#pragma unroll
                for (int j = 0; j < 4; ++j) {
                    const int q0 = (int)fminf(fmaxf(rintf(v[rr][j].x * inv), -7.f), 7.f), q1 = (int)fminf(fmaxf(rintf(v[rr][j].y * inv), -7.f), 7.f), q2 = (int)fminf(fmaxf(rintf(v[rr][j].z * inv), -7.f), 7.f), q3 = (int)fminf(fmaxf(rintf(v[rr][j].w * inv), -7.f), 7.f);
                    *(unsigned short*)(TAB + (((size_t)t * 8 + j) * 16384 + row) * 128 + 2 * lane) = (unsigned short)((q0 & 15) | ((q1 & 15) << 4) | ((q2 & 15) << 8) | ((q3 & 15) << 12)); }
            } else {
                float ss = 0.f;
#pragma unroll
                for (int j = 0; j < 4; ++j) ss += (v[rr][j].x * v[rr][j].x + v[rr][j].y * v[rr][j].y) + (v[rr][j].z * v[rr][j].z + v[rr][j].w * v[rr][j].w);
                ss = wave_sum(ss);
                sc = am > 0.f ? fminf(am * (1.f / 7.f), 0.36f * sqrtf(ss * (1.f / 1024.f))) : 1.f;
                const float inv = am > 0.f ? 1.f / sc : 0.f;
#pragma unroll
                for (int j = 0; j < 4; ++j) {
                    const int q0 = (int)fminf(fmaxf(rintf(v[rr][j].x * inv), -7.f), 7.f), q1 = (int)fminf(fmaxf(rintf(v[rr][j].y * inv), -7.f), 7.f), q2 = (int)fminf(fmaxf(rintf(v[rr][j].z * inv), -7.f), 7.f), q3 = (int)fminf(fmaxf(rintf(v[rr][j].w * inv), -7.f), 7.f);
                    const unsigned mine = ((unsigned)(q0 & 15) | ((unsigned)(q1 & 15) << 8) | ((unsigned)(q2 & 15) << 16) | ((unsigned)(q3 & 15) << 24)) << ((lane & 1) ? 4 : 0);
                    const unsigned other = (unsigned)__builtin_amdgcn_update_dpp(0, (int)mine, 0xB1, 0xf, 0xf, false);
                    if ((lane & 1) == 0) *(unsigned*)(TAB + (((size_t)t * 8 + j) * 16384 + row) * 128 + 4 * (lane >> 1)) = mine | other; }
            }
            if (lane == 0) TSC[t * 16384 + row] = sc;
        }
    }
}

__device__ __forceinline__ void norm_mod_store(const f32x4 (&v)[4], float rinv, const float* g, const float* sh, const float* sc, bf16_t* orow, int lane) {
#pragma unroll
    for (int j = 0; j < 4; ++j) { const int c = 4 * lane + 256 * j;
        const f32x4 gg = *(const f32x4*)(g + c), s1 = *(const f32x4*)(sc + c), s0 = *(const f32x4*)(sh + c);
        const f32x4 y = (v[j] * rinv * gg) * (s1 + 1.f) + s0;
        u32x2 o; o.x = pk2(y.x, y.y); o.y = pk2(y.z, y.w); *(u32x2*)(orow + c) = o; }
}
__device__ __forceinline__ int tok_row(int layer, int n);
__device__ __forceinline__ void norm_row_out(const Frame& F, const f32x4 (&v)[4], float rinv, const float* g, const float* mm, int r, int which) {
    norm_mod_store(v, rinv, g, mm, mm + 1024, (bf16_t*)(F.ws + WS_H) + (size_t)r * DM, F.lane);
    if (which) {
        f32x4 y[4]; float am = 0.f;
#pragma unroll
        for (int j = 0; j < 4; ++j) { const int c = 4 * F.lane + 256 * j; y[j] = (v[j] * rinv * *(const f32x4*)(g + c)) * (*(const f32x4*)(mm + 1024 + c) + 1.f) + *(const f32x4*)(mm + c);
            am = fmaxf(am, fmaxf(fmaxf(fabsf(y[j].x), fabsf(y[j].y)), fmaxf(fabsf(y[j].z), fabsf(y[j].w)))); }
        am = wave_max(am);
        const float inv = am > 0.f ? 119.f / am : 0.f;
#pragma unroll
        for (int j = 0; j < 4; ++j) { const int h0 = (int)rintf(y[j].x * inv), h1 = (int)rintf(y[j].y * inv), h2 = (int)rintf(y[j].z * inv), h3 = (int)rintf(y[j].w * inv);
            const unsigned hh = (unsigned)(((h0 + 8) >> 4) & 15) | ((unsigned)(((h1 + 8) >> 4) & 15) << 4) | ((unsigned)(((h2 + 8) >> 4) & 15) << 8) | ((unsigned)(((h3 + 8) >> 4) & 15) << 12);
            const unsigned hl = (unsigned)(h0 & 15) | ((unsigned)(h1 & 15) << 4) | ((unsigned)(h2 & 15) << 8) | ((unsigned)(h3 & 15) << 12);
            const bool odd = (F.lane & 1) != 0;
            const unsigned recv = (unsigned)__builtin_amdgcn_update_dpp(0, (int)(odd ? hh : hl), 0xB1, 0xf, 0xf, false);
            *(unsigned*)(F.ws + WS_HQ + (size_t)r * DM + 256 * j + 4 * F.lane) = odd ? (recv | (hl << 16)) : (hh | (recv << 16)); }
        if (F.lane == 0) ((float*)(F.ws + WS_HS))[r] = am > 0.f ? am * (1.f / 119.f) : 1.f;
    }
}
__device__ __forceinline__ void p_norm_rows(const Args& A, const Frame& F, int layer, int which, bool from_input, bool skip_ctx) {
    const int gw = F.bid * NWAVES + F.wave, NGW = F.nblk * NWAVES;
    const float* g = A.in[layer ? (which ? I1_NFFN : I1_NMIX) : (which ? I0_NFFN : I0_NMIX)];
    const float* MOD = (const float*)(F.ws + WS_MOD) + (size_t)layer * 5 * 6144;
    const unsigned short* X = (const unsigned short*)(F.ws + WS_X);
    const int ntok = skip_ctx ? NB * SEQ : R;
    for (int n = gw; n < ntok; n += 2 * NGW) {
        const bool has1 = (n + NGW) < ntok;
        const int r0 = skip_ctx ? tok_row(1, n) : n, r1 = has1 ? (skip_ctx ? tok_row(1, n + NGW) : n + NGW) : r0;
        f32x4 v0[4], v1[4]; float s0 = 0.f, s1 = 0.f;
        if (from_input) { const float* x0 = xin_row(F, r0); const float* x1 = xin_row(F, r1);
#pragma unroll
            for (int j = 0; j < 4; ++j) { v0[j] = *(const f32x4*)(x0 + 4 * F.lane + 256 * j); v1[j] = *(const f32x4*)(x1 + 4 * F.lane + 256 * j); } }
        else {
#pragma unroll
            for (int j = 0; j < 4; ++j) { const u32x2 a = *(const u32x2*)(X + (size_t)r0 * DM + 4 * F.lane + 256 * j), b = *(const u32x2*)(X + (size_t)r1 * DM + 4 * F.lane + 256 * j);
                v0[j] = (f32x4){h2f_lo(a.x), h2f_hi(a.x), h2f_lo(a.y), h2f_hi(a.y)}; v1[j] = (f32x4){h2f_lo(b.x), h2f_hi(b.x), h2f_lo(b.y), h2f_hi(b.y)}; } }
#pragma unroll
        for (int j = 0; j < 4; ++j) { s0 += (v0[j].x * v0[j].x + v0[j].y * v0[j].y) + (v0[j].z * v0[j].z + v0[j].w * v0[j].w); s1 += (v1[j].x * v1[j].x + v1[j].y * v1[j].y) + (v1[j].z * v1[j].z + v1[j].w * v1[j].w); }
        const float ri0 = rsqrtf(wave_sum(s0) * (1.f / DM) + EPS), ri1 = rsqrtf(wave_sum(s1) * (1.f / DM) + EPS);
        norm_row_out(F, v0, ri0, g, MOD + (size_t)mod_index(r0) * 6144 + (which ? 3 * 1024 : 0), r0, which);
        if (has1) norm_row_out(F, v1, ri1, g, MOD + (size_t)mod_index(r1) * 6144 + (which ? 3 * 1024 : 0), r1, which);
    }
}

namespace pg8 {
#define PG8_LAS __attribute__((address_space(3)))
typedef unsigned short bf16_t;
typedef short bf16x8 __attribute__((ext_vector_type(8)));
typedef float f32x4 __attribute__((ext_vector_type(4)));
typedef unsigned u32x4 __attribute__((ext_vector_type(4)));
constexpr int BM = 256, BK = 64, HALF = 128, HTB = HALF * BK * 2  , STAGE_BYTES = 8 * HTB, NXCD = 8, WGM = 8;

__host__ __device__ __forceinline__ int lds_byte(int r, int c) { const int st = (r >> 4) * 2 + (c >> 5), rr = r & 15, cc = c & 31, ob = rr * 64 + cc * 2; return st * 1024 + (ob ^ (((ob >> 9) & 1) << 5)); }
__host__ __device__ __forceinline__ void stage_rc(int b, int& R, int& C) { const int st = b / 1024, sb = b % 1024, swz = sb ^ (((sb >> 9) & 1) << 5); R = (st >> 1) * 16 + swz / 64; C = (st & 1) * 32 + (swz % 64) / 2; }
__host__ __device__ __forceinline__ int perm32(int rho) { const int n = rho >> 4, i = rho & 15; return 8 * (i >> 2) + 4 * n + (i & 3); }

struct Unit { int pm, pn; };
struct Gemm { const bf16_t* A; const bf16_t* Bt; int M, N, K; };

struct StaticOrder {
    int nM, nN, nwg, G, c;
    __host__ __device__ void init(int M, int N, int G_, int c_) { nM = M / BM; nN = N / BM; nwg = nM * nN; G = G_; c = c_; }
    __host__ __device__ bool next(int i, Unit& u) const {
        const long L = (long)i * G + c; if (L >= nwg) return false;
        int wgid = (int)L; { const int q = nwg / NXCD, r = nwg % NXCD, xcd = wgid % NXCD, off = wgid / NXCD; wgid = (xcd < r ? xcd * (q + 1) : r * (q + 1) + (xcd - r) * q) + off; }
        const int nig = WGM * nN, gid = wgid / nig, fm = gid * WGM, gsz = (nM - fm) < WGM ? (nM - fm) : WGM;
        u.pm = fm + ((wgid % nig) % gsz); u.pn = (wgid % nig) / gsz; return true;
    }
    __device__ __forceinline__ void a_ready(const Unit&) const {}
    __device__ __forceinline__ void done(const Unit&) const {}
};

template <class Epi, class Sched, bool ALIGN_EPI = false, bool SP2 = false>
__device__ __forceinline__ void gemm_phase(PG8_LAS unsigned char* lds, const Gemm g, const Sched& S, const Epi& E) {
    const int tid = threadIdx.x, wid = __builtin_amdgcn_readfirstlane(tid >> 6), lane = tid & 63, wr = wid >> 2, wc = wid & 3, fr = lane & 15, fq = lane >> 4;
    const int K = g.K, nt = K / BK;
    unsigned voffA[2], voffB[2];
#pragma unroll
    for (int i = 0; i < 2; ++i) { int R, C; stage_rc(tid * 16 + i * 8192, R, C); const int Rb = Epi::PERM ? ((R & ~31) + perm32(R & 31)) : R;
        voffA[i] = (unsigned)(R * K + C) * 2u; voffB[i] = (unsigned)(Rb * K + C) * 2u; }
    const size_t kstep = (size_t)(BK * 2);
    const size_t hstep = (size_t)HALF * K * 2;
    const size_t tstep = 2 * hstep;
    const unsigned ldsw = (unsigned)wid * 1024u;
    const int aoff = lds_byte(wr * 64 + fr, fq * 8), boff = lds_byte(wc * 32 + fr, fq * 8);
#define PG8_SA(b, h) (((b) * 2 + (h)) * HTB)
#define PG8_SB(b, h) ((4 + (b) * 2 + (h)) * HTB)
#define PG8_STAGE(bufoff, gbase, voff) do { _Pragma("unroll") for (int _i = 0; _i < 2; ++_i) \
        __builtin_amdgcn_global_load_lds((const unsigned*)((const char*)(gbase) + (voff)[_i]), (PG8_LAS unsigned*)(lds + (bufoff) + ldsw + _i * 8192), 16, 0, 0); } while (0)
#define PG8_LDA(dst, b, h) do { _Pragma("unroll") for (int m = 0; m < 4; ++m) _Pragma("unroll") for (int k = 0; k < 2; ++k) dst[m][k] = *(const PG8_LAS bf16x8*)(lds + PG8_SA(b, h) + aoff + m * 2048 + k * 1024); } while (0)
#define PG8_LDB(dst, b, h) do { _Pragma("unroll") for (int n = 0; n < 2; ++n) _Pragma("unroll") for (int k = 0; k < 2; ++k) dst[n][k] = *(const PG8_LAS bf16x8*)(lds + PG8_SB(b, h) + boff + n * 2048 + k * 1024); } while (0)
#define PG8_MMA(ai, bj, At, Bt) do { __builtin_amdgcn_s_setprio(1); _Pragma("unroll") for (int m = 0; m < 4; ++m) _Pragma("unroll") for (int n = 0; n < 2; ++n) _Pragma("unroll") for (int k = 0; k < 2; ++k) \
        acc[ai][bj][m][n] = __builtin_amdgcn_mfma_f32_16x16x32_bf16(Bt[n][k], At[m][k], acc[ai][bj][m][n], 0, 0, 0); __builtin_amdgcn_s_setprio(0); } while (0)
#define PG8_WAIT_V(n) asm volatile("s_waitcnt vmcnt(" #n ")" ::: "memory")
#define PG8_WAIT_L(n) asm volatile("s_waitcnt lgkmcnt(" #n ")" ::: "memory")
#define PG8_BAR __builtin_amdgcn_s_barrier()
#define PG8_SCHED __builtin_amdgcn_sched_barrier(0)
    Unit cur, nxt; int ui = 0;
    if (!S.next(0, cur)) return;
    f32x4 acc[2][2][4][2];
#pragma unroll
    for (int a = 0; a < 2; ++a)
#pragma unroll
        for (int b = 0; b < 2; ++b)
#pragma unroll
            for (int m = 0; m < 4; ++m)
#pragma unroll
                for (int n = 0; n < 2; ++n) acc[a][b][m][n] = (f32x4){0.f, 0.f, 0.f, 0.f};
    bf16x8 At[4][2], B0[2][2], B1[2][2];
    const char* cA = (const char*)g.A + (size_t)cur.pm * tstep; const char* cB = (const char*)g.Bt + (size_t)cur.pn * tstep;
    S.a_ready(cur);
    if constexpr (SP2) {
        PG8_STAGE(PG8_SB(0, 0), cB, voffB); PG8_STAGE(PG8_SB(0, 1), cB + hstep, voffB); PG8_STAGE(PG8_SA(0, 0), cA, voffA); PG8_STAGE(PG8_SA(0, 1), cA + hstep, voffA);
        if (wr == 1) PG8_BAR;
        PG8_WAIT_V(2); PG8_BAR;
        PG8_STAGE(PG8_SB(1, 0), cB + kstep, voffB); PG8_STAGE(PG8_SA(1, 0), cA + kstep, voffA); PG8_STAGE(PG8_SB(1, 1), cB + hstep + kstep, voffB);
        PG8_WAIT_V(6); PG8_BAR;
    } else {
        PG8_STAGE(PG8_SB(0, 0), cB, voffB); PG8_STAGE(PG8_SA(0, 0), cA, voffA); PG8_STAGE(PG8_SB(0, 1), cB + hstep, voffB); PG8_STAGE(PG8_SA(0, 1), cA + hstep, voffA);
        if (wr == 1) PG8_BAR;
        PG8_WAIT_V(4); PG8_BAR;
        PG8_STAGE(PG8_SB(1, 0), cB + kstep, voffB); PG8_STAGE(PG8_SA(1, 0), cA + kstep, voffA); PG8_STAGE(PG8_SB(1, 1), cB + hstep + kstep, voffB);
        PG8_WAIT_V(6); PG8_BAR;
    }
    for (;;) {
        const bool has_next = S.next(ui + 1, nxt);
        const char* nA = has_next ? (const char*)g.A + (size_t)nxt.pm * tstep : cA; const char* nB = has_next ? (const char*)g.Bt + (size_t)nxt.pn * tstep : cB;
        for (int t = 0; t < nt; t += 2) {
            const bool last = (t == nt - 2);
            const char* a1 = cA + (size_t)(t + 1) * kstep;
            const char* a2 = last ? nA : cA + (size_t)(t + 2) * kstep; const char* b2 = last ? nB : cB + (size_t)(t + 2) * kstep;
            const char* a3 = a2 + kstep; const char* b3 = b2 + kstep;
            if (last && has_next) S.a_ready(nxt);
            if constexpr (SP2) {
            PG8_LDB(B0, 0, 0); PG8_LDB(B1, 0, 1); PG8_SCHED; PG8_LDA(At, 0, 0); PG8_STAGE(PG8_SA(1, 1), a1 + hstep, voffA);
            PG8_WAIT_V(8); PG8_WAIT_L(0); PG8_BAR; PG8_MMA(0, 0, At, B0); PG8_MMA(0, 1, At, B1); PG8_BAR; PG8_SCHED;
            PG8_LDA(At, 0, 1); PG8_STAGE(PG8_SB(0, 0), b2, voffB); PG8_STAGE(PG8_SB(0, 1), b2 + hstep, voffB); PG8_STAGE(PG8_SA(0, 0), a2, voffA);
            PG8_WAIT_V(8); PG8_WAIT_L(0); PG8_BAR; PG8_MMA(1, 0, At, B0); PG8_MMA(1, 1, At, B1); PG8_BAR; PG8_SCHED;
            PG8_LDB(B0, 1, 0); PG8_LDB(B1, 1, 1); PG8_SCHED; PG8_LDA(At, 1, 0); PG8_STAGE(PG8_SA(0, 1), a2 + hstep, voffA);
            PG8_WAIT_V(8); PG8_WAIT_L(0); PG8_BAR; PG8_MMA(0, 0, At, B0); PG8_MMA(0, 1, At, B1); PG8_BAR; PG8_SCHED;
            PG8_LDA(At, 1, 1); PG8_STAGE(PG8_SB(1, 0), b3, voffB); PG8_STAGE(PG8_SB(1, 1), b3 + hstep, voffB); PG8_STAGE(PG8_SA(1, 0), a3, voffA);
            PG8_WAIT_V(8); PG8_WAIT_L(0); PG8_BAR; PG8_MMA(1, 0, At, B0); PG8_MMA(1, 1, At, B1); PG8_BAR; PG8_SCHED;
            } else {
            PG8_LDB(B0, 0, 0); PG8_SCHED; PG8_LDA(At, 0, 0); PG8_STAGE(PG8_SA(1, 1), a1 + hstep, voffA);
            PG8_WAIT_L(8); PG8_BAR; PG8_WAIT_L(0); PG8_MMA(0, 0, At, B0); PG8_BAR; PG8_SCHED;
            PG8_LDB(B1, 0, 1); PG8_STAGE(PG8_SB(0, 0), b2, voffB);
            PG8_BAR; PG8_WAIT_L(0); PG8_MMA(0, 1, At, B1); PG8_BAR;
            PG8_LDA(At, 0, 1); PG8_STAGE(PG8_SA(0, 0), a2, voffA);
            PG8_BAR; PG8_WAIT_L(0); PG8_MMA(1, 0, At, B0); PG8_BAR; PG8_SCHED;
            PG8_STAGE(PG8_SB(0, 1), b2 + hstep, voffB);
            PG8_WAIT_V(6); PG8_BAR; PG8_MMA(1, 1, At, B1); PG8_BAR;
            PG8_LDB(B0, 1, 0); PG8_SCHED; PG8_LDA(At, 1, 0); PG8_STAGE(PG8_SA(0, 1), a2 + hstep, voffA);
            PG8_WAIT_L(8); PG8_BAR; PG8_WAIT_L(0); PG8_MMA(0, 0, At, B0); PG8_BAR; PG8_SCHED;
            PG8_LDB(B1, 1, 1); PG8_STAGE(PG8_SB(1, 0), b3, voffB);
            PG8_BAR; PG8_WAIT_L(0); PG8_MMA(0, 1, At, B1); PG8_BAR;
            PG8_LDA(At, 1, 1); PG8_STAGE(PG8_SA(1, 0), a3, voffA);
            PG8_BAR; PG8_WAIT_L(0); PG8_MMA(1, 0, At, B0); PG8_BAR; PG8_SCHED;
            PG8_STAGE(PG8_SB(1, 1), b3 + hstep, voffB);
            PG8_WAIT_V(6); PG8_BAR; PG8_MMA(1, 1, At, B1); PG8_BAR;
            }
        }
        if constexpr (ALIGN_EPI) { if (wr == 0) PG8_BAR; }
        if constexpr (!Epi::AFTER_DRAIN) { E(acc, cur, wr, wc, fr, fq); S.done(cur); }
        if (!has_next) break;
#pragma unroll
        for (int a = 0; a < 2; ++a)
#pragma unroll
            for (int b = 0; b < 2; ++b)
#pragma unroll
                for (int m = 0; m < 4; ++m)
#pragma unroll
                    for (int n = 0; n < 2; ++n) acc[a][b][m][n] = (f32x4){0.f, 0.f, 0.f, 0.f};
        cur = nxt; cA = nA; cB = nB; ++ui;
        if constexpr (ALIGN_EPI) { if (wr == 1) PG8_BAR; }
    }
    PG8_WAIT_V(0);
    if constexpr (!ALIGN_EPI) { if (wr == 0) PG8_BAR; }
    PG8_BAR;
    if constexpr (Epi::AFTER_DRAIN) { E.fused(acc, cur, wr, wc, fr, fq, lds, wid, lane); S.done(cur); }
#undef PG8_SA
#undef PG8_SB
#undef PG8_STAGE
#undef PG8_LDA
#undef PG8_LDB
#undef PG8_MMA
#undef PG8_WAIT_V
#undef PG8_WAIT_L
#undef PG8_BAR
#undef PG8_SCHED
}
}

template <class Inner> struct EpiTile { static constexpr bool PERM = true, AFTER_DRAIN = false; Inner in;
    __device__ __forceinline__ void operator()(const pg8::f32x4 (&acc)[2][2][4][2], const pg8::Unit& u, int wr, int wc, int fr, int fq) const {
#pragma unroll
        for (int ai = 0; ai < 2; ++ai)
#pragma unroll
            for (int m = 0; m < 4; ++m) { const int row = u.pm * 256 + ai * 128 + wr * 64 + m * 16 + fr;
#pragma unroll
                for (int bj = 0; bj < 2; ++bj) in(row, u.pn * 256 + bj * 128 + wc * 32 + 8 * fq, acc[ai][bj][m][0], acc[ai][bj][m][1]); }
    } };
struct In8Bf16 { bf16_t* C; int ldc;
    __device__ __forceinline__ void operator()(int row, int col, f32x4 a, f32x4 b) const { u32x4 o; o.x = cvtpk(a.x, a.y); o.y = cvtpk(a.z, a.w); o.z = cvtpk(b.x, b.y); o.w = cvtpk(b.z, b.w); *(u32x4*)(C + (size_t)row * ldc + col) = o; } };
struct In8KV { bf16_t* Kb; bf16_t* Vb;
    __device__ __forceinline__ void operator()(int row, int col, f32x4 a, f32x4 b) const { const int h = col >> 8, c = col & 255; u32x4 o; o.x = cvtpk(a.x, a.y); o.y = cvtpk(a.z, a.w); o.z = cvtpk(b.x, b.y); o.w = cvtpk(b.z, b.w);
        bf16_t* p = (c < 128) ? Kb + (size_t)row * 1536 + h * 192 + c : Vb + (size_t)row * 1024 + h * 128 + (c - 128);
        *(u32x4*)p = o; } };
struct In8F16 { unsigned short* C; int ldc;
    __device__ __forceinline__ void operator()(int row, int col, f32x4 a, f32x4 b) const { u32x4 o; o.x = pkh2(a.x, a.y); o.y = pkh2(a.z, a.w); o.z = pkh2(b.x, b.y); o.w = pkh2(b.z, b.w); *(u32x4*)(C + (size_t)row * ldc + col) = o; } };
struct In8F32 { float* C; int ldc;
    __device__ __forceinline__ void operator()(int row, int col, f32x4 a, f32x4 b) const { float* p = C + (size_t)row * ldc + col; *(f32x4*)p = a; *(f32x4*)(p + 4) = b; } };
struct In8Resid { const float* x; const float* ctx; unsigned short* X; const float* gate; bool from_input;
    __device__ __forceinline__ void operator()(int row, int col, f32x4 a, f32x4 b) const {
        const int bb = row / RPB, j = row - bb * RPB; unsigned short* xo = X + (size_t)row * DM + col;
        f32x4 x0, x1;
        if (from_input) { const float* xi = ((j < CTXL) ? ctx + ((size_t)bb * CTXL + j) * DM : x + ((size_t)bb * SEQ + (j - CTXL)) * DM) + col; x0 = *(const f32x4*)xi; x1 = *(const f32x4*)(xi + 4); }
        else { const u32x4 w = *(const u32x4*)xo; x0 = (f32x4){h2f_lo(w.x), h2f_hi(w.x), h2f_lo(w.y), h2f_hi(w.y)}; x1 = (f32x4){h2f_lo(w.z), h2f_hi(w.z), h2f_lo(w.w), h2f_hi(w.w)}; }
        const float* g = gate + (size_t)((j < CTXL) ? 4 : bb) * 6144 + col;
        x0 += *(const f32x4*)g * a; x1 += *(const f32x4*)(g + 4) * b;
        u32x4 o; o.x = pkh2(x0.x, x0.y); o.y = pkh2(x0.z, x0.w); o.z = pkh2(x1.x, x1.y); o.w = pkh2(x1.z, x1.w); *(u32x4*)xo = o; } };
struct EpiMlaDown { static constexpr bool PERM = true, AFTER_DRAIN = false; bf16_t* CQ; bf16_t* CKV; bf16_t* KR; float* SSP;
    __device__ __forceinline__ void operator()(const pg8::f32x4 (&acc)[2][2][4][2], const pg8::Unit& u, int wr, int wc, int fr, int fq) const {
#pragma unroll
        for (int ai = 0; ai < 2; ++ai)
#pragma unroll
            for (int m = 0; m < 4; ++m) { const int row = u.pm * 256 + ai * 128 + wr * 64 + m * 16 + fr;
#pragma unroll
                for (int bj = 0; bj < 2; ++bj) { const int col = u.pn * 256 + bj * 128 + wc * 32 + 8 * fq; const f32x4 a = acc[ai][bj][m][0], b = acc[ai][bj][m][1];
                    u32x4 o; o.x = cvtpk(a.x, a.y); o.y = cvtpk(a.z, a.w); o.z = cvtpk(b.x, b.y); o.w = cvtpk(b.z, b.w);
                    const int cls = (u.pn * 2 + bj);
                    if (cls < 5) { float sq = (a.x * a.x + a.y * a.y) + (a.z * a.z + a.w * a.w) + (b.x * b.x + b.y * b.y) + (b.z * b.z + b.w * b.w);
                        sq += __shfl_xor(sq, 16); sq += __shfl_xor(sq, 32);
                        if (cls < 3) *(u32x4*)(CQ + (size_t)row * 384 + col) = o; else *(u32x4*)(CKV + (size_t)row * 256 + (col - 384)) = o;
                        if (fq == 0) SSP[(size_t)row * 24 + cls * 4 + wc] = sq; }
                    else if (col < 704) *(u32x4*)(KR + (size_t)row * 64 + (col - 640)) = o; } }
    } };
struct In8Bf16Rs { bf16_t* C; int ldc; const float* ssp;
    __device__ __forceinline__ void operator()(int row, int col, f32x4 a, f32x4 b) const { const f32x4 s0 = *(const f32x4*)(ssp + (size_t)row * 24), s1 = *(const f32x4*)(ssp + (size_t)row * 24 + 4), s2 = *(const f32x4*)(ssp + (size_t)row * 24 + 8);
        const float ssum = (((s0.x + s0.y) + (s0.z + s0.w)) + ((s1.x + s1.y) + (s1.z + s1.w))) + ((s2.x + s2.y) + (s2.z + s2.w));
        const float rs = rsqrtf(ssum * (1.f / 384.f) + EPS); a *= rs; b *= rs;
        u32x4 o; o.x = cvtpk(a.x, a.y); o.y = cvtpk(a.z, a.w); o.z = cvtpk(b.x, b.y); o.w = cvtpk(b.z, b.w); *(u32x4*)(C + (size_t)row * ldc + col) = o; } };
struct In8KVRs { unsigned char* K8; unsigned char* V8; const float* ssp;
    __device__ __forceinline__ void operator()(int row, int col, f32x4 a, f32x4 b) const { const f32x4 s0 = *(const f32x4*)(ssp + (size_t)row * 24 + 12), s1 = *(const f32x4*)(ssp + (size_t)row * 24 + 16);
        const float ssum = ((s0.x + s0.y) + (s0.z + s0.w)) + ((s1.x + s1.y) + (s1.z + s1.w));
        const float rs = rsqrtf(ssum * (1.f / 256.f) + EPS); a *= rs; b *= rs;
        const int h = col >> 8, c = col & 255;
        if (c < 128) { u32x2 o; o.x = f8x4(a.x, a.y, a.z, a.w); o.y = f8x4(b.x, b.y, b.z, b.w); *(u32x2*)(K8 + (size_t)row * 1536 + h * 192 + c) = o; }
        else { u32x2 o; o.x = f8x4(a.x, a.y, a.z, a.w); o.y = f8x4(b.x, b.y, b.z, b.w); *(u32x2*)(V8 + (size_t)row * 1024 + h * 128 + (c - 128)) = o; } } };
struct RowSched { pg8::StaticOrder so; bool latent_only;
    __device__ __forceinline__ void init(int N, int G, int c, bool lat) { latent_only = lat; so.init(lat ? NB * SEQ : R, N, G, c); }
    __device__ __forceinline__ bool next(int i, pg8::Unit& u) const { if (!so.next(i, u)) return false; if (latent_only) u.pm = (u.pm >> 4) * 17 + 1 + (u.pm & 15); return true; }
    __device__ __forceinline__ void a_ready(const pg8::Unit&) const {}
    __device__ __forceinline__ void done(const pg8::Unit&) const {} };
template <class Inner> __device__ __forceinline__ void gemm8(const Frame& F, const bf16_t* Ap, const bf16_t* Bt, int N, int K, bool latent_only, const Inner& in, bool reverse = false) {
    asm volatile("" : "+s"(K));
    pg8::Gemm g{Ap, Bt, R, N, K}; RowSched S; S.init(N, F.nblk, reverse ? F.nblk - 1 - F.bid : F.bid, latent_only);
    EpiTile<Inner> E{in};
    pg8::gemm_phase<EpiTile<Inner>, RowSched, true, true>((PG8_LAS unsigned char*)F.lds, g, S, E);
}

template <class Epi> __device__ __forceinline__ void gemm8e(const Frame& F, const bf16_t* Ap, const bf16_t* Bt, int N, int K, bool latent_only, const Epi& E) {
    asm volatile("" : "+s"(K));
    pg8::Gemm g{Ap, Bt, R, N, K}; RowSched S; S.init(N, F.nblk, F.bid, latent_only);
    pg8::gemm_phase<Epi, RowSched, true, true>((PG8_LAS unsigned char*)F.lds, g, S, E);
}

struct GemmDesc { const bf16_t* A; int lda; long sA; const bf16_t* Bt; int ldb; long sB; int M, N, K, nz; };
template <class Epi>
__device__ __forceinline__ void gemm_simple(const Frame& F, const GemmDesc& g, const Epi& epi, bool skip_ctx) {
    const int wm = F.wave >> 1, wn = F.wave & 1, fr = F.lane & 15, fq = F.lane >> 4;
    const int tM = g.M / 128, tN = g.N / 128, per = tM * tN, total = per * g.nz;
    for (int u = F.bid; u < total; u += F.nblk) {
        const int z = u / per, uu = u - z * per, tm = uu / tN, tn = uu - tm * tN;
        if (skip_ctx && ((tm * 128) % RPB) < CTXL) continue;
        const int row0 = tm * 128 + wm * 32, col0 = tn * 128 + wn * 64;
        const bf16_t* ap = g.A + z * g.sA + (size_t)(row0 + fr) * g.lda + fq * 8;
        const bf16_t* bp = g.Bt + z * g.sB + (size_t)(col0 + fr) * g.ldb + fq * 8;
        f32x4 acc[2][4];
#pragma unroll
        for (int mi = 0; mi < 2; ++mi)
#pragma unroll
            for (int ni = 0; ni < 4; ++ni) acc[mi][ni] = (f32x4){0.f, 0.f, 0.f, 0.f};
        for (int k0 = 0; k0 < g.K; k0 += 32) {
            bf16x8 a[2], b[4];
#pragma unroll
            for (int mi = 0; mi < 2; ++mi) a[mi] = *(const bf16x8*)(ap + (size_t)mi * 16 * g.lda + k0);
#pragma unroll
            for (int ni = 0; ni < 4; ++ni) b[ni] = *(const bf16x8*)(bp + (size_t)ni * 16 * g.ldb + k0);
#pragma unroll
            for (int mi = 0; mi < 2; ++mi)
#pragma unroll
                for (int ni = 0; ni < 4; ++ni) acc[mi][ni] = __builtin_amdgcn_mfma_f32_16x16x32_bf16(b[ni], a[mi], acc[mi][ni], 0, 0, 0);
        }
#pragma unroll
        for (int mi = 0; mi < 2; ++mi)
#pragma unroll
            for (int ni = 0; ni < 4; ++ni) epi(z, row0 + mi * 16 + fr, col0 + ni * 16 + fq * 4, acc[mi][ni]);
    }
}
struct EpiBf16 { bf16_t* C; int ldc;
    __device__ __forceinline__ void operator()(int, int row, int col, f32x4 v) const { u32x2 o; o.x = pk2(v.x, v.y); o.y = pk2(v.z, v.w); *(u32x2*)(C + (size_t)row * ldc + col) = o; } };
struct EpiKV { bf16_t* Kb; bf16_t* Vb;
    __device__ __forceinline__ void operator()(int, int row, int col, f32x4 v) const { const int h = col >> 8, c = col & 255; u32x2 o; o.x = pk2(v.x, v.y); o.y = pk2(v.z, v.w);
        if (c < 128) *(u32x2*)(Kb + (size_t)row * 1536 + h * 192 + c) = o; else *(u32x2*)(Vb + (size_t)row * 1024 + h * 128 + (c - 128)) = o; } };
struct EpiF32Z { float* C; int ldc;
    __device__ __forceinline__ void operator()(int z, int row, int col, f32x4 v) const { *(f32x4*)(C + (size_t)row * ldc + z * 128 + col) = v; } };
struct EpiResid { const Frame* F; const float* gate; bool from_input;
    __device__ __forceinline__ void operator()(int, int row, int col, f32x4 v) const {
        float* X = (float*)(F->ws + WS_X) + (size_t)row * DM + col;
        const float* xi = from_input ? xin_row(*F, row) + col : X;
        const f32x4 g = *(const f32x4*)(gate + (size_t)mod_index(row) * 6144 + col);
        *(f32x4*)X = *(const f32x4*)xi + g * v; } };

__device__ __forceinline__ void rope_angles(int r, int& prow, int& pcol) { const int t = (r % RPB) - CTXL; prow = t >> 6; pcol = t & 63; }
__device__ __forceinline__ void p_mla_krope(const Args& A, const Frame& F) {
    const int gw = F.bid * NWAVES + F.wave, NGW = F.nblk * NWAVES, lane = F.lane;
    const bf16_t* KR = (const bf16_t*)(F.ws + WS_KR); unsigned char* K8 = F.ws + WS_K;
    const float invf = __powf(10000.f, -(float)(lane & 15) * (1.f / 16.f));
    for (int r = gw; r < R; r += NGW) {
        float kr = bf2f(KR[(size_t)r * 64 + lane]);
        if (!is_ctx_row(r)) {
            int prow, pcol; rope_angles(r, prow, pcol);
            const float ang = (float)((lane & 32) ? pcol : prow) * invf;
            const float cs = cosf(ang), sn = sinf(ang);
            const float partner = __shfl_xor(kr, 16);
            kr = kr * cs + ((lane & 16) ? partner : -partner) * sn;
        }
        const unsigned char kb = (unsigned char)(f8x4(kr, kr, kr, kr) & 0xffu);
#pragma unroll
        for (int h = 0; h < 8; ++h) K8[(size_t)r * 1536 + h * 192 + 128 + lane] = kb;
    }
}
__device__ __forceinline__ float row16_sum(float v) { v += WDPP(v, 0xB1); v += WDPP(v, 0x4E); v += WDPP(v, 0x141); v += WDPP(v, 0x140); return v; }
__device__ __forceinline__ void p_gqa_rows(const Args& A, const Frame& F) {
    const int gw = F.bid * NWAVES + F.wave, NGW = F.nblk * NWAVES, lane = F.lane, c16 = lane & 15, hrow = lane >> 4;
    const bf16_t* RAW = (const bf16_t*)(F.ws + WS_RAW1); bf16_t* Q1 = (bf16_t*)(F.ws + WS_Q1); unsigned char* K18 = F.ws + WS_K1; unsigned char* V18 = F.ws + WS_V1;
    float qg[8], kg[8], invf[8];
#pragma unroll
    for (int e = 0; e < 8; ++e) { qg[e] = A.in[I1_QN][8 * c16 + e]; kg[e] = A.in[I1_KN][8 * c16 + e]; invf[e] = __powf(10000.f, -(float)(8 * (c16 & 3) + e) * (1.f / 32.f)); }
    const bool colaxis = (c16 & 8) != 0, hi32 = (c16 & 4) != 0;
    for (int r = gw; r < R; r += NGW) {
        const bool ctx = is_ctx_row(r);
        const bf16_t* a = RAW + (size_t)r * 1536 + 8 * lane;
        u32x4 ch[3];
#pragma unroll
        for (int j = 0; j < 3; ++j) ch[j] = (ctx && j < 2) ? (u32x4){0u, 0u, 0u, 0u} : *(const u32x4*)(a + 512 * j);
        float cs[8], sn[8];
        { int prow = 0, pcol = 0; if (!ctx) rope_angles(r, prow, pcol); const float pos = (float)(colaxis ? pcol : prow);
#pragma unroll
          for (int e = 0; e < 8; ++e) { const float ang = pos * invf[e]; cs[e] = ctx ? 1.f : __cosf(ang); sn[e] = ctx ? 0.f : __sinf(ang); } }
#pragma unroll
        for (int j = 0; j < 3; ++j) {
            if (ctx && j < 2) continue;
            const bool isv = (j == 2) && (hrow >= 2);
            float x[8];
#pragma unroll
            for (int d = 0; d < 4; ++d) { x[2 * d] = bflo(ch[j][d]); x[2 * d + 1] = bfhi(ch[j][d]); }
            float sq = 0.f;
#pragma unroll
            for (int e = 0; e < 8; ++e) sq += x[e] * x[e];
            const float rinv = rsqrtf(row16_sum(sq) * (1.f / 128.f) + EPS);
            u32x4 o;
            float y[8];
#pragma unroll
            for (int e = 0; e < 8; ++e) y[e] = x[e] * rinv * (j < 2 ? qg[e] : kg[e]);
            u32x4 yp; yp.x = pk2(y[0], y[1]); yp.y = pk2(y[2], y[3]); yp.z = pk2(y[4], y[5]); yp.w = pk2(y[6], y[7]);
            float pr[8];
#pragma unroll
            for (int d = 0; d < 4; ++d) { const float lo = __shfl_xor(y[2 * d], 4), hi2 = __shfl_xor(y[2 * d + 1], 4); pr[2 * d] = lo; pr[2 * d + 1] = hi2; }
            float z[8];
#pragma unroll
            for (int e = 0; e < 8; ++e) z[e] = y[e] * cs[e] + (hi32 ? pr[e] : -pr[e]) * sn[e];
            o.x = pk2(z[0], z[1]); o.y = pk2(z[2], z[3]); o.z = pk2(z[4], z[5]); o.w = pk2(z[6], z[7]);
            (void)yp;
            if (isv) o = ch[j];
            if (j < 2) *(u32x4*)(Q1 + (size_t)r * 1024 + 512 * j + 8 * lane) = o;
            else if (hrow < 2) { u32x2 o8; o8.x = f8x4(z[0], z[1], z[2], z[3]); o8.y = f8x4(z[4], z[5], z[6], z[7]); *(u32x2*)(K18 + (size_t)r * 256 + 8 * lane) = o8; }
            else { u32x2 o8; o8.x = f8x4(x[0], x[1], x[2], x[3]); o8.y = f8x4(x[4], x[5], x[6], x[7]); *(u32x2*)(V18 + (size_t)r * 256 + 8 * (lane - 32)) = o8; }
        }
    }
}

__device__ __forceinline__ int crow(int r, int hi) { return (r & 3) + 8 * (r >> 2) + 4 * hi; }
__device__ __forceinline__ int v_st(int k, int c) { const int kk = (k & ~0xC) | ((k & 4) << 1) | ((k & 8) >> 1); return ((kk >> 3) * 4 + (c >> 5)) * 512 + ((kk & 7) * 32 + (c & 31)) * 2; }
__device__ __forceinline__ int v_rd_base(int lane) { return ((lane & 3) << 3) | (((lane >> 2) & 3) << 6) | (((lane >> 4) & 1) << 5) | (((lane >> 5) & 1) << 8); }
constexpr int v_rd_off(int d0, int ks, int half) { return d0 * 512 + ks * 4096 + half * 2048; }
template <int OFF> __device__ __forceinline__ s16x4 tr_read(int vb) { s16x4 r; asm volatile("ds_read_b64_tr_b16 %0, %1 offset:%2" : "=&v"(r) : "v"(vb), "i"(OFF) : "memory"); return r; }
template <int D0> __device__ __forceinline__ void pv_one(f32x16& od, int vb, bf16x8 pa0, bf16x8 pa1, bf16x8 pa2, bf16x8 pa3) {
    const s16x4 l0 = tr_read<v_rd_off(D0, 0, 0)>(vb), h0 = tr_read<v_rd_off(D0, 0, 1)>(vb), l1 = tr_read<v_rd_off(D0, 1, 0)>(vb), h1 = tr_read<v_rd_off(D0, 1, 1)>(vb);
    const s16x4 l2 = tr_read<v_rd_off(D0, 2, 0)>(vb), h2 = tr_read<v_rd_off(D0, 2, 1)>(vb), l3 = tr_read<v_rd_off(D0, 3, 0)>(vb), h3 = tr_read<v_rd_off(D0, 3, 1)>(vb);
    asm volatile("s_waitcnt lgkmcnt(0)" ::: "memory"); SBAR();
#define PK(L, H) (bf16x8){L[0], L[1], L[2], L[3], H[0], H[1], H[2], H[3]}
    od = __builtin_amdgcn_mfma_f32_32x32x16_bf16(pa0, PK(l0, h0), od, 0, 0, 0);
    od = __builtin_amdgcn_mfma_f32_32x32x16_bf16(pa1, PK(l1, h1), od, 0, 0, 0);
    od = __builtin_amdgcn_mfma_f32_32x32x16_bf16(pa2, PK(l2, h2), od, 0, 0, 0);
    od = __builtin_amdgcn_mfma_f32_32x32x16_bf16(pa3, PK(l3, h3), od, 0, 0, 0);
#undef PK
}
__device__ __forceinline__ void pv_d0(f32x16* o, int vb, bf16x8 pa0, bf16x8 pa1, bf16x8 pa2, bf16x8 pa3) {
    pv_one<0>(o[0], vb, pa0, pa1, pa2, pa3); pv_one<1>(o[1], vb, pa0, pa1, pa2, pa3); pv_one<2>(o[2], vb, pa0, pa1, pa2, pa3); pv_one<3>(o[3], vb, pa0, pa1, pa2, pa3);
}
constexpr float ATT_THR = 8.f;
__device__ __forceinline__ void partialSM(f32x16& p0, f32x16& p1, float& m_reg, float& mn, float& alpha, float C, float thr_raw) {
    float pmax = p0[0];
#pragma unroll
    for (int r = 1; r < 16; ++r) pmax = fmaxf(pmax, p0[r]);
#pragma unroll
    for (int r = 0; r < 16; ++r) pmax = fmaxf(pmax, p1[r]);
    { auto rr = __builtin_amdgcn_permlane32_swap(__float_as_uint(pmax), __float_as_uint(pmax), false, false);
      pmax = fmaxf(__uint_as_float(rr[0]), __uint_as_float(rr[1])); }
    if (__builtin_expect(__all(pmax - m_reg <= thr_raw), 1)) { mn = m_reg; alpha = 1.f; }
    else { mn = fmaxf(m_reg, pmax); alpha = __builtin_amdgcn_exp2f((m_reg - mn) * C); m_reg = mn; }
    const float mnC = -mn * C;
#pragma unroll
    for (int r = 0; r < 16; ++r) p0[r] = fmaf(p0[r], C, mnC);
#pragma unroll
    for (int r = 0; r < 16; ++r) p1[r] = fmaf(p1[r], C, mnC);
#pragma unroll
    for (int r = 0; r < 16; ++r) p0[r] = __builtin_amdgcn_exp2f(p0[r]);
}
__device__ __forceinline__ void finishSM(f32x16& p0, f32x16& p1, float alpha, float& l_reg, bf16x8& pa0, bf16x8& pa1, bf16x8& pa2, bf16x8& pa3) {
#pragma unroll
    for (int r = 0; r < 16; ++r) p1[r] = __builtin_amdgcn_exp2f(p1[r]);
    float ps = 0;
#pragma unroll
    for (int r = 0; r < 16; ++r) ps += p0[r];
#pragma unroll
    for (int r = 0; r < 16; ++r) ps += p1[r];
    { auto rr = __builtin_amdgcn_permlane32_swap(__float_as_uint(ps), __float_as_uint(ps), false, false);
      ps = __uint_as_float(rr[0]) + __uint_as_float(rr[1]); }
    l_reg = l_reg * alpha + ps;
#define PK4(P, BASE, OUT) do { unsigned a0 = cvtpk(P[BASE + 0], P[BASE + 1]), a1 = cvtpk(P[BASE + 2], P[BASE + 3]);   \
    unsigned b0 = cvtpk(P[BASE + 4], P[BASE + 5]), b1 = cvtpk(P[BASE + 6], P[BASE + 7]);                              \
    auto r0 = __builtin_amdgcn_permlane32_swap(a0, b0, false, false); auto r1 = __builtin_amdgcn_permlane32_swap(a1, b1, false, false); \
    u32x4 w = {r0[0], r1[0], r0[1], r1[1]}; OUT = *reinterpret_cast<bf16x8*>(&w); } while (0)
    PK4(p0, 0, pa0); PK4(p0, 8, pa1); PK4(p1, 0, pa2); PK4(p1, 8, pa3);
#undef PK4
}
template <int DQK> __device__ __forceinline__ void qkt(f32x16& p0, f32x16& p1, const char* Ks, const bf16x8* qr, int r32, int hi) {
    constexpr int KP = DQK * 2 + 16;
    p0 = f32x16{}; p1 = f32x16{};
#pragma unroll
    for (int d0 = 0; d0 < DQK / 16; ++d0) { const int cb = (d0 * 16 + hi * 8) * 2;
        const bf16x8 b0 = *reinterpret_cast<const bf16x8*>(Ks + r32 * KP + cb);
        const bf16x8 b1 = *reinterpret_cast<const bf16x8*>(Ks + (32 + r32) * KP + cb);
        p0 = __builtin_amdgcn_mfma_f32_32x32x16_bf16(b0, qr[d0], p0, 0, 0, 0);
        p1 = __builtin_amdgcn_mfma_f32_32x32x16_bf16(b1, qr[d0], p1, 0, 0, 0); }
}
template <int DQK> constexpr int att_lds_bytes() { return 2 * 64 * 128 * 2 + 2 * 64 * (DQK * 2 + 16) + NWAVES * 64 * 4; }
template <int DQK, int LDQ, int LDK, int LDV, int LDO>
__device__ __forceinline__ void attn_body(const bf16_t* __restrict__ Qb, const bf16_t* __restrict__ Kh, const bf16_t* __restrict__ Vh, bf16_t* __restrict__ Ob, int seq, float scale, char* lds) {
    constexpr int KP = DQK * 2 + 16, SHM_V = 64 * 128 * 2, SHM_K = 64 * KP, ND = DQK / 16, CH = DQK / 8, NKL = CH * 64 / NTHREADS;
    const float C = scale * 1.4426950408889634f, thr_raw = ATT_THR / scale;
    const int tid = threadIdx.x, wid = tid >> 6, lane = tid & 63, r32 = lane & 31, hi = lane >> 5;
    char* V_lds = lds; char* K_lds = lds + 2 * SHM_V;
    float* wsf = (float*)(lds + 2 * SHM_V + 2 * SHM_K) + wid * 64; float* li_l = wsf; float* al_l = wsf + 32;
    float m_reg = -1e30f, l_reg = 0; f32x16 o[4] = {}; bf16x8 qr[ND];
    const bf16_t* Qw = Qb + (long)(wid * 32 + r32) * LDQ + hi * 8;
#pragma unroll
    for (int d0 = 0; d0 < ND; ++d0) qr[d0] = *reinterpret_cast<const bf16x8*>(Qw + d0 * 16);
    const int sr = tid >> 4, sc = (tid & 15) * 8, vst0 = v_st(sr, sc), vst1 = v_st(32 + sr, sc);
    static_assert(DQK == 128, "double-pipelined body: 128-wide q.k only");
    const int vb0 = (int)(uintptr_t)V_lds + v_rd_base(lane);
    bf16x8 vs0, vs1, ks[NKL];
#define SLOAD(k0) do { vs0 = *reinterpret_cast<const bf16x8*>(&Vh[(long)((k0) + sr) * LDV + sc]); vs1 = *reinterpret_cast<const bf16x8*>(&Vh[(long)((k0) + 32 + sr) * LDV + sc]); \
    _Pragma("unroll") for (int i_ = 0; i_ < NKL; ++i_) ks[i_] = *reinterpret_cast<const bf16x8*>(&Kh[(long)((k0) + sr + 32 * i_) * LDK + sc]); } while (0)
#define SWRITE(b) do { *(bf16x8*)(V_lds + (b) * SHM_V + vst0) = vs0; *(bf16x8*)(V_lds + (b) * SHM_V + vst1) = vs1; \
    _Pragma("unroll") for (int i_ = 0; i_ < NKL; ++i_) *(bf16x8*)(K_lds + (b) * SHM_K + (sr + 32 * i_) * KP + sc * 2) = ks[i_]; } while (0)
#define RESC(a) do { if (__any((a) < 1.f)) { if (hi == 0) al_l[r32] = (a); asm volatile("s_waitcnt lgkmcnt(0)" ::: "memory"); \
    _Pragma("unroll") for (int d = 0; d < 4; ++d) _Pragma("unroll") for (int r = 0; r < 16; ++r) o[d][r] *= al_l[crow(r, hi)]; } } while (0)
    f32x16 pA0, pA1, pB0, pB1; float mnA, mnB, alA, alB; bf16x8 pa0, pa1, pa2, pa3; const int NT = seq / 64;
    SLOAD(0); asm volatile("s_waitcnt vmcnt(0)" ::: "memory"); SWRITE(0); __syncthreads();
    qkt<DQK>(pA0, pA1, K_lds, qr, r32, hi); partialSM(pA0, pA1, m_reg, mnA, alA, C, thr_raw);
    SLOAD(64);
    asm volatile("s_waitcnt vmcnt(0)" ::: "memory"); SWRITE(1); __syncthreads();
    for (int j = 1; j + 1 < NT; j += 2) {
        SBAR(); qkt<DQK>(pB0, pB1, K_lds + SHM_K, qr, r32, hi);
        finishSM(pA0, pA1, alA, l_reg, pa0, pa1, pa2, pa3); SBAR();
        SLOAD((j + 1) * 64); SBAR();
        pv_d0(o, vb0, pa0, pa1, pa2, pa3); partialSM(pB0, pB1, m_reg, mnB, alB, C, thr_raw);
        __syncthreads(); asm volatile("s_waitcnt vmcnt(0)" ::: "memory"); SWRITE(0);
        RESC(alB); __syncthreads();
        SBAR(); qkt<DQK>(pA0, pA1, K_lds, qr, r32, hi);
        finishSM(pB0, pB1, alB, l_reg, pa0, pa1, pa2, pa3); SBAR();
        SLOAD((j + 2) * 64); SBAR();
        pv_d0(o, vb0 + SHM_V, pa0, pa1, pa2, pa3); partialSM(pA0, pA1, m_reg, mnA, alA, C, thr_raw);
        __syncthreads(); asm volatile("s_waitcnt vmcnt(0)" ::: "memory"); SWRITE(1);
        RESC(alA); __syncthreads();
    }
    SBAR(); qkt<DQK>(pB0, pB1, K_lds + SHM_K, qr, r32, hi);
    finishSM(pA0, pA1, alA, l_reg, pa0, pa1, pa2, pa3); SBAR();
    pv_d0(o, vb0, pa0, pa1, pa2, pa3); partialSM(pB0, pB1, m_reg, mnB, alB, C, thr_raw);
    __syncthreads(); RESC(alB);
    finishSM(pB0, pB1, alB, l_reg, pa0, pa1, pa2, pa3); SBAR();
    pv_d0(o, vb0 + SHM_V, pa0, pa1, pa2, pa3);
    if (hi == 0) li_l[r32] = l_reg; asm volatile("s_waitcnt lgkmcnt(0)" ::: "memory");
    float rli[16];
#pragma unroll
    for (int r = 0; r < 16; ++r) rli[r] = __builtin_amdgcn_rcpf(li_l[crow(r, hi)]);
    bf16_t* Ow = Ob + (long)(wid * 32) * LDO;
#pragma unroll
    for (int r = 0; r < 16; ++r) { const int orow = crow(r, hi);
#pragma unroll
        for (int d0 = 0; d0 < 4; ++d0) Ow[(long)orow * LDO + d0 * 32 + r32] = (bf16_t)f2bf(o[d0][r] * rli[r]); }
    __syncthreads();
#undef SLOAD
#undef SWRITE
#undef RESC
}
template <int DQK, int LDQ, int LDK, int LDV, int LDO>
__device__ __forceinline__ void attn_body_single(const bf16_t* __restrict__ Qb, const bf16_t* __restrict__ Kh, const bf16_t* __restrict__ Vh, bf16_t* __restrict__ Ob, int seq, float scale, char* lds, int rope_t0) {
    constexpr int KP = DQK * 2 + 16, SHM_V = 64 * 128 * 2, SHM_K = 64 * KP, ND = DQK / 16, CH = DQK / 8, NKL = CH * 64 / NTHREADS;
    const float C = scale * 1.4426950408889634f, thr_raw = ATT_THR / scale;
    const int tid = threadIdx.x, wid = tid >> 6, lane = tid & 63, r32 = lane & 31, hi = lane >> 5;
    char* V_lds = lds; char* K_lds = lds + 2 * SHM_V;
    float* wsf = (float*)(lds + 2 * SHM_V + 2 * SHM_K) + wid * 64; float* li_l = wsf; float* al_l = wsf + 32;
    float m_reg = -1e30f, l_reg = 0; f32x16 o[4] = {}; bf16x8 qr[ND];
    const bf16_t* Qw = Qb + (long)(wid * 32 + r32) * LDQ + hi * 8;
#pragma unroll
    for (int d0 = 8; d0 < ND; ++d0) qr[d0] = *reinterpret_cast<const bf16x8*>(Qw + d0 * 16);
    if constexpr (DQK == 192) {
        if (rope_t0 >= 0) {
            const int tq = rope_t0 + wid * 32 + r32; const float prow = (float)(tq >> 6), pcol = (float)(tq & 63);
            u32x4 fa1 = __builtin_bit_cast(u32x4, qr[8]), fa2 = __builtin_bit_cast(u32x4, qr[9]), fb1 = __builtin_bit_cast(u32x4, qr[10]), fb2 = __builtin_bit_cast(u32x4, qr[11]);
#pragma unroll
            for (int jj = 0; jj < 4; ++jj) {
                float na1[2], na2[2], nb1[2], nb2[2];
#pragma unroll
                for (int e = 0; e < 2; ++e) { const float invf = __powf(10000.f, -(float)(hi * 8 + 2 * jj + e) * (1.f / 16.f));
                    const float ar = prow * invf, ac = pcol * invf, cr = __cosf(ar), sr_ = __sinf(ar), cc = __cosf(ac), sc_ = __sinf(ac);
                    const float a1 = e ? bfhi(fa1[jj]) : bflo(fa1[jj]), a2 = e ? bfhi(fa2[jj]) : bflo(fa2[jj]), b1 = e ? bfhi(fb1[jj]) : bflo(fb1[jj]), b2 = e ? bfhi(fb2[jj]) : bflo(fb2[jj]);
                    na1[e] = a1 * cr - a2 * sr_; na2[e] = a2 * cr + a1 * sr_; nb1[e] = b1 * cc - b2 * sc_; nb2[e] = b2 * cc + b1 * sc_; }
                fa1[jj] = pk2(na1[0], na1[1]); fa2[jj] = pk2(na2[0], na2[1]); fb1[jj] = pk2(nb1[0], nb1[1]); fb2[jj] = pk2(nb2[0], nb2[1]);
            }
            qr[8] = __builtin_bit_cast(bf16x8, fa1); qr[9] = __builtin_bit_cast(bf16x8, fa2); qr[10] = __builtin_bit_cast(bf16x8, fb1); qr[11] = __builtin_bit_cast(bf16x8, fb2);
        }
    }
    asm volatile("" ::: "memory");
#pragma unroll
    for (int d0 = 0; d0 < 8; ++d0) qr[d0] = *reinterpret_cast<const bf16x8*>(Qw + d0 * 16);
    const int sr = tid >> 4, sc = (tid & 15) * 8, vst0 = v_st(sr, sc), vst1 = v_st(32 + sr, sc);
    int krow[NKL], kch[NKL];
#pragma unroll
    for (int i = 0; i < NKL; ++i) { const int id = tid + i * NTHREADS; krow[i] = id / CH; kch[i] = id % CH; }
    const int vb0 = (int)(uintptr_t)V_lds + v_rd_base(lane);
    bf16x8 vs0, vs1, ks[NKL];
#define SLOAD(k0) do { vs0 = *reinterpret_cast<const bf16x8*>(&Vh[(long)((k0) + sr) * LDV + sc]); vs1 = *reinterpret_cast<const bf16x8*>(&Vh[(long)((k0) + 32 + sr) * LDV + sc]); \
    _Pragma("unroll") for (int i_ = 0; i_ < NKL; ++i_) ks[i_] = *reinterpret_cast<const bf16x8*>(&Kh[(long)((k0) + krow[i_]) * LDK + kch[i_] * 8]); } while (0)
#define SWRITE(b) do { *(bf16x8*)(V_lds + (b) * SHM_V + vst0) = vs0; *(bf16x8*)(V_lds + (b) * SHM_V + vst1) = vs1; \
    _Pragma("unroll") for (int i_ = 0; i_ < NKL; ++i_) *(bf16x8*)(K_lds + (b) * SHM_K + krow[i_] * KP + kch[i_] * 16) = ks[i_]; } while (0)
#define RESC(a) do { if (__any((a) < 1.f)) { if (hi == 0) al_l[r32] = (a); asm volatile("s_waitcnt lgkmcnt(0)" ::: "memory"); \
    _Pragma("unroll") for (int d = 0; d < 4; ++d) _Pragma("unroll") for (int r = 0; r < 16; ++r) o[d][r] *= al_l[crow(r, hi)]; } } while (0)
    f32x16 p0, p1; float mn, al; bf16x8 pa0, pa1, pa2, pa3; const int NT = seq / 64;
    SLOAD(0); asm volatile("s_waitcnt vmcnt(0)" ::: "memory"); SWRITE(0); __syncthreads();
    SLOAD(64);
    for (int j = 0; j < NT; ++j) {
        const int b = j & 1;
        SBAR(); qkt<DQK>(p0, p1, K_lds + b * SHM_K, qr, r32, hi);
        partialSM(p0, p1, m_reg, mn, al, C, thr_raw);
        RESC(al);
        finishSM(p0, p1, al, l_reg, pa0, pa1, pa2, pa3); SBAR();
        pv_d0(o, vb0 + b * SHM_V, pa0, pa1, pa2, pa3);
        if (j + 1 < NT) { asm volatile("s_waitcnt vmcnt(0)" ::: "memory"); SWRITE(b ^ 1); }
        __syncthreads();
        if (j + 2 < NT) SLOAD((j + 2) * 64);
    }
    if (hi == 0) li_l[r32] = l_reg; asm volatile("s_waitcnt lgkmcnt(0)" ::: "memory");
    float rli[16];
#pragma unroll
    for (int r = 0; r < 16; ++r) rli[r] = __builtin_amdgcn_rcpf(li_l[crow(r, hi)]);
    bf16_t* Ow = Ob + (long)(wid * 32) * LDO;
#pragma unroll
    for (int r = 0; r < 16; ++r) { const int orow = crow(r, hi);
#pragma unroll
        for (int d0 = 0; d0 < 4; ++d0) Ow[(long)orow * LDO + d0 * 32 + r32] = (bf16_t)f2bf(o[d0][r] * rli[r]); }
    __syncthreads();
#undef SLOAD
#undef SWRITE
#undef RESC
}
#define F8_ONE 0x7f7f7f7f
template <int DQK> __device__ __forceinline__ void qkt8(f32x16& p0, f32x16& p1, const char* Ks, const i32x8* qr, int r32, int hi) {
    constexpr int KP = DQK + 16;
    p0 = f32x16{}; p1 = f32x16{};
#pragma unroll
    for (int c = 0; c < DQK / 64; ++c) { const int cb = c * 64 + hi * 32;
        const u32x4 a0 = *reinterpret_cast<const u32x4*>(Ks + r32 * KP + cb), a1 = *reinterpret_cast<const u32x4*>(Ks + r32 * KP + cb + 16);
        const u32x4 b0 = *reinterpret_cast<const u32x4*>(Ks + (32 + r32) * KP + cb), b1 = *reinterpret_cast<const u32x4*>(Ks + (32 + r32) * KP + cb + 16);
        const i32x8 A = {(int)a0.x, (int)a0.y, (int)a0.z, (int)a0.w, (int)a1.x, (int)a1.y, (int)a1.z, (int)a1.w}, B = {(int)b0.x, (int)b0.y, (int)b0.z, (int)b0.w, (int)b1.x, (int)b1.y, (int)b1.z, (int)b1.w};
        p0 = __builtin_amdgcn_mfma_scale_f32_32x32x64_f8f6f4(A, qr[c], p0, 0, 0, 0, F8_ONE, 0, F8_ONE);
        p1 = __builtin_amdgcn_mfma_scale_f32_32x32x64_f8f6f4(B, qr[c], p1, 0, 0, 0, F8_ONE, 0, F8_ONE); }
}
__device__ __forceinline__ i32x8 q32_to_fp8(const bf16_t* p) {
    i32x8 r;
#pragma unroll
    for (int w = 0; w < 4; ++w) { const u32x4 v = *reinterpret_cast<const u32x4*>(p + 8 * w);
        r[2 * w] = (int)f8x4(bflo(v.x), bfhi(v.x), bflo(v.y), bfhi(v.y)); r[2 * w + 1] = (int)f8x4(bflo(v.z), bfhi(v.z), bflo(v.w), bfhi(v.w)); }
    return r;
}
__device__ __forceinline__ i32x8 q32_rope_fp8(const bf16_t* p, float pos) {
    float x[32];
#pragma unroll
    for (int w = 0; w < 4; ++w) { const u32x4 v = *reinterpret_cast<const u32x4*>(p + 8 * w);
#pragma unroll
        for (int e = 0; e < 4; ++e) { x[8 * w + 2 * e] = bflo(v[e]); x[8 * w + 2 * e + 1] = bfhi(v[e]); } }
    float y[32];
#pragma unroll
    for (int i = 0; i < 16; ++i) { const float ang = pos * __powf(10000.f, -(float)i * (1.f / 16.f)), cs = __cosf(ang), sn = __sinf(ang);
        y[i] = x[i] * cs - x[16 + i] * sn; y[16 + i] = x[16 + i] * cs + x[i] * sn; }
    i32x8 r;
#pragma unroll
    for (int w = 0; w < 8; ++w) r[w] = (int)f8x4(y[4 * w], y[4 * w + 1], y[4 * w + 2], y[4 * w + 3]);
    return r;
}
template <int DQK, int LDQ, int LDK, int LDV, int LDO>
__device__ __forceinline__ void attn8_body(const bf16_t* __restrict__ Qb, const unsigned char* __restrict__ Kh, const bf16_t* __restrict__ Vh, bf16_t* __restrict__ Ob, int seq, float scale, char* lds) {
    constexpr int KP = DQK + 16, SHM_V = 64 * 128 * 2, SHM_K = 64 * KP, NC = DQK / 64;
    static_assert(DQK == 128, "double-pipelined body: 128-wide q.k only");
    const float C = scale * 1.4426950408889634f, thr_raw = ATT_THR / scale;
    const int tid = threadIdx.x, wid = tid >> 6, lane = tid & 63, r32 = lane & 31, hi = lane >> 5;
    char* V_lds = lds; char* K_lds = lds + 2 * SHM_V;
    float* wsf = (float*)(lds + 2 * SHM_V + 2 * SHM_K) + wid * 64; float* li_l = wsf; float* al_l = wsf + 32;
    float m_reg = -1e30f, l_reg = 0; f32x16 o[4] = {}; i32x8 qr[NC];
    const bf16_t* Qw = Qb + (long)(wid * 32 + r32) * LDQ + hi * 32;
#pragma unroll
    for (int c = 0; c < NC; ++c) qr[c] = q32_to_fp8(Qw + 64 * c);
    const int sr = tid >> 4, sc = (tid & 15) * 8, vst0 = v_st(sr, sc), vst1 = v_st(32 + sr, sc);
    const int krow = tid >> 3, kch = (tid & 7) * 16;
    const int vb0 = (int)(uintptr_t)V_lds + v_rd_base(lane);
    bf16x8 vs0, vs1; u32x4 ks;
#define SLOAD(k0) do { vs0 = *reinterpret_cast<const bf16x8*>(&Vh[(long)((k0) + sr) * LDV + sc]); vs1 = *reinterpret_cast<const bf16x8*>(&Vh[(long)((k0) + 32 + sr) * LDV + sc]); \
    ks = *reinterpret_cast<const u32x4*>(&Kh[(long)((k0) + krow) * LDK + kch]); } while (0)
#define SWRITE(b) do { *(bf16x8*)(V_lds + (b) * SHM_V + vst0) = vs0; *(bf16x8*)(V_lds + (b) * SHM_V + vst1) = vs1; \
    *(u32x4*)(K_lds + (b) * SHM_K + krow * KP + kch) = ks; } while (0)
#define RESC(a) do { if (__any((a) < 1.f)) { if (hi == 0) al_l[r32] = (a); asm volatile("s_waitcnt lgkmcnt(0)" ::: "memory"); \
    _Pragma("unroll") for (int d = 0; d < 4; ++d) _Pragma("unroll") for (int r = 0; r < 16; ++r) o[d][r] *= al_l[crow(r, hi)]; } } while (0)
    f32x16 pA0, pA1, pB0, pB1; float mnA, mnB, alA, alB; bf16x8 pa0, pa1, pa2, pa3; const int NT = seq / 64;
    SLOAD(0); asm volatile("s_waitcnt vmcnt(0)" ::: "memory"); SWRITE(0); __syncthreads();
    qkt8<DQK>(pA0, pA1, K_lds, qr, r32, hi); partialSM(pA0, pA1, m_reg, mnA, alA, C, thr_raw);
    SLOAD(64);
    asm volatile("s_waitcnt vmcnt(0)" ::: "memory"); SWRITE(1); __syncthreads();
    for (int j = 1; j + 1 < NT; j += 2) {
        SBAR(); qkt8<DQK>(pB0, pB1, K_lds + SHM_K, qr, r32, hi);
        finishSM(pA0, pA1, alA, l_reg, pa0, pa1, pa2, pa3); SBAR();
        SLOAD((j + 1) * 64); SBAR();
        pv_d0(o, vb0, pa0, pa1, pa2, pa3); partialSM(pB0, pB1, m_reg, mnB, alB, C, thr_raw);
        __syncthreads(); asm volatile("s_waitcnt vmcnt(0)" ::: "memory"); SWRITE(0);
        RESC(alB); __syncthreads();
        SBAR(); qkt8<DQK>(pA0, pA1, K_lds, qr, r32, hi);
        finishSM(pB0, pB1, alB, l_reg, pa0, pa1, pa2, pa3); SBAR();
        SLOAD((j + 2) * 64); SBAR();
        pv_d0(o, vb0 + SHM_V, pa0, pa1, pa2, pa3); partialSM(pA0, pA1, m_reg, mnA, alA, C, thr_raw);
        __syncthreads(); asm volatile("s_waitcnt vmcnt(0)" ::: "memory"); SWRITE(1);
        RESC(alA); __syncthreads();
    }
    SBAR(); qkt8<DQK>(pB0, pB1, K_lds + SHM_K, qr, r32, hi);
    finishSM(pA0, pA1, alA, l_reg, pa0, pa1, pa2, pa3); SBAR();
    pv_d0(o, vb0, pa0, pa1, pa2, pa3); partialSM(pB0, pB1, m_reg, mnB, alB, C, thr_raw);
    __syncthreads(); RESC(alB);
    finishSM(pB0, pB1, alB, l_reg, pa0, pa1, pa2, pa3); SBAR();
    pv_d0(o, vb0 + SHM_V, pa0, pa1, pa2, pa3);
    if (hi == 0) li_l[r32] = l_reg; asm volatile("s_waitcnt lgkmcnt(0)" ::: "memory");
    float rli[16];
#pragma unroll
    for (int r = 0; r < 16; ++r) rli[r] = __builtin_amdgcn_rcpf(li_l[crow(r, hi)]);
    bf16_t* Ow = Ob + (long)(wid * 32) * LDO;
#pragma unroll
    for (int r = 0; r < 16; ++r) { const int orow = crow(r, hi);
#pragma unroll
        for (int d0 = 0; d0 < 4; ++d0) Ow[(long)orow * LDO + d0 * 32 + r32] = (bf16_t)f2bf(o[d0][r] * rli[r]); }
    __syncthreads();
#undef SLOAD
#undef SWRITE
#undef RESC
}
template <int DQK, int LDQ, int LDK, int LDV, int LDO>
__device__ __forceinline__ void attn8_body_single(const bf16_t* __restrict__ Qb, const unsigned char* __restrict__ Kh, const bf16_t* __restrict__ Vh, bf16_t* __restrict__ Ob, int seq, float scale, char* lds, int rope_t0) {
    constexpr int KP = DQK + 16, SHM_V = 64 * 128 * 2, SHM_K = 64 * KP, NC = DQK / 64, CH = DQK / 16, NCH = 64 * CH, NKL = (NCH + NTHREADS - 1) / NTHREADS;
    const float C = scale * 1.4426950408889634f, thr_raw = ATT_THR / scale;
    const int tid = threadIdx.x, wid = tid >> 6, lane = tid & 63, r32 = lane & 31, hi = lane >> 5;
    char* V_lds = lds; char* K_lds = lds + 2 * SHM_V;
    float* wsf = (float*)(lds + 2 * SHM_V + 2 * SHM_K) + wid * 64; float* li_l = wsf; float* al_l = wsf + 32;
    float m_reg = -1e30f, l_reg = 0; f32x16 o[4] = {}; i32x8 qr[NC];
    const bf16_t* Qw = Qb + (long)(wid * 32 + r32) * LDQ + hi * 32;
    if constexpr (DQK == 192) {
        if (rope_t0 >= 0) { const int tq = rope_t0 + wid * 32 + r32; qr[2] = q32_rope_fp8(Qw + 128, (float)(hi ? (tq & 63) : (tq >> 6))); }
        else qr[2] = q32_to_fp8(Qw + 128);
    }
    asm volatile("" ::: "memory");
#pragma unroll
    for (int c = 0; c < 2; ++c) qr[c] = q32_to_fp8(Qw + 64 * c);
    const int sr = tid >> 4, sc = (tid & 15) * 8, vst0 = v_st(sr, sc), vst1 = v_st(32 + sr, sc);
    int krow[NKL], kch[NKL];
#pragma unroll
    for (int i = 0; i < NKL; ++i) { const int id = tid + i * NTHREADS; krow[i] = (id < NCH) ? id / CH : 0; kch[i] = (id % CH) * 16; }
    const bool k2 = (NKL < 2) || (tid + NTHREADS < NCH);
    const int vb0 = (int)(uintptr_t)V_lds + v_rd_base(lane);
    bf16x8 vs0, vs1; u32x4 ks[NKL];
#define SLOAD(k0) do { vs0 = *reinterpret_cast<const bf16x8*>(&Vh[(long)((k0) + sr) * LDV + sc]); vs1 = *reinterpret_cast<const bf16x8*>(&Vh[(long)((k0) + 32 + sr) * LDV + sc]); \
    _Pragma("unroll") for (int i_ = 0; i_ < NKL; ++i_) ks[i_] = *reinterpret_cast<const u32x4*>(&Kh[(long)((k0) + krow[i_]) * LDK + kch[i_]]); } while (0)
#define SWRITE(b) do { *(bf16x8*)(V_lds + (b) * SHM_V + vst0) = vs0; *(bf16x8*)(V_lds + (b) * SHM_V + vst1) = vs1; \
    _Pragma("unroll") for (int i_ = 0; i_ < NKL; ++i_) if (i_ == 0 || k2) *(u32x4*)(K_lds + (b) * SHM_K + krow[i_] * KP + kch[i_]) = ks[i_]; } while (0)
#define RESC(a) do { if (__any((a) < 1.f)) { if (hi == 0) al_l[r32] = (a); asm volatile("s_waitcnt lgkmcnt(0)" ::: "memory"); \
    _Pragma("unroll") for (int d = 0; d < 4; ++d) _Pragma("unroll") for (int r = 0; r < 16; ++r) o[d][r] *= al_l[crow(r, hi)]; } } while (0)
    f32x16 p0, p1; float mn, al; bf16x8 pa0, pa1, pa2, pa3; const int NT = seq / 64;
    SLOAD(0); asm volatile("s_waitcnt vmcnt(0)" ::: "memory"); SWRITE(0); __syncthreads();
    SLOAD(64);
    for (int j = 0; j < NT; ++j) {
        const int b = j & 1;
        SBAR(); qkt8<DQK>(p0, p1, K_lds + b * SHM_K, qr, r32, hi);
        partialSM(p0, p1, m_reg, mn, al, C, thr_raw);
        RESC(al);
        finishSM(p0, p1, al, l_reg, pa0, pa1, pa2, pa3); SBAR();
        pv_d0(o, vb0 + b * SHM_V, pa0, pa1, pa2, pa3);
        if (j + 1 < NT) { asm volatile("s_waitcnt vmcnt(0)" ::: "memory"); SWRITE(b ^ 1); }
        __syncthreads();
        if (j + 2 < NT) SLOAD((j + 2) * 64);
    }
    if (hi == 0) li_l[r32] = l_reg; asm volatile("s_waitcnt lgkmcnt(0)" ::: "memory");
    float rli[16];
#pragma unroll
    for (int r = 0; r < 16; ++r) rli[r] = __builtin_amdgcn_rcpf(li_l[crow(r, hi)]);
    bf16_t* Ow = Ob + (long)(wid * 32) * LDO;
#pragma unroll
    for (int r = 0; r < 16; ++r) { const int orow = crow(r, hi);
#pragma unroll
        for (int d0 = 0; d0 < 4; ++d0) Ow[(long)orow * LDO + d0 * 32 + r32] = (bf16_t)f2bf(o[d0][r] * rli[r]); }
    __syncthreads();
#undef SLOAD
#undef SWRITE
#undef RESC
}
constexpr float ATT8_THR = 3.5f, ATT8_SH = 3.f;
#ifndef ATT8_FIXED_M
#define ATT8_FIXED_M 0
#endif
__device__ __forceinline__ void partialSM8(f32x16& p0, f32x16& p1, float& m_reg, float& mn, float& alpha, float C, float thr_raw) {
#if ATT8_FIXED_M
    mn = 6.f * 1.4426950408889634f / C; alpha = 1.f; m_reg = mn;
#else
    float pmax = p0[0];
#pragma unroll
    for (int r = 1; r < 16; ++r) pmax = fmaxf(pmax, p0[r]);
#pragma unroll
    for (int r = 0; r < 16; ++r) pmax = fmaxf(pmax, p1[r]);
    { auto rr = __builtin_amdgcn_permlane32_swap(__float_as_uint(pmax), __float_as_uint(pmax), false, false);
      pmax = fmaxf(__uint_as_float(rr[0]), __uint_as_float(rr[1])); }
    if (__builtin_expect(__all(pmax - m_reg <= thr_raw), 1)) { mn = m_reg; alpha = 1.f; }
    else { mn = fmaxf(m_reg, pmax); alpha = __builtin_amdgcn_exp2f((m_reg - mn) * C); m_reg = mn; }
#endif
    const float mnC = ATT8_SH - mn * C;
#pragma unroll
    for (int r = 0; r < 16; ++r) p0[r] = fmaf(p0[r], C, mnC);
#pragma unroll
    for (int r = 0; r < 16; ++r) p1[r] = fmaf(p1[r], C, mnC);
#pragma unroll
    for (int r = 0; r < 16; ++r) p0[r] = __builtin_amdgcn_exp2f(p0[r]);
}
__device__ __forceinline__ void finishSM8(f32x16& p0, f32x16& p1, i32x8& pa) {
#pragma unroll
    for (int r = 0; r < 16; ++r) p1[r] = __builtin_amdgcn_exp2f(p1[r]);
#pragma unroll
    for (int w = 0; w < 4; ++w) { pa[w] = (int)f8x4(p0[4 * w], p0[4 * w + 1], p0[4 * w + 2], p0[4 * w + 3]); pa[4 + w] = (int)f8x4(p1[4 * w], p1[4 * w + 1], p1[4 * w + 2], p1[4 * w + 3]); }
}
__device__ __forceinline__ void finishSM8s(f32x16& p0, f32x16& p1, float alpha, float& l_reg, i32x8& pa) {
#pragma unroll
    for (int r = 0; r < 16; ++r) p1[r] = __builtin_amdgcn_exp2f(p1[r]);
    float ps = 0;
#pragma unroll
    for (int r = 0; r < 16; ++r) ps += p0[r];
#pragma unroll
    for (int r = 0; r < 16; ++r) ps += p1[r];
    { auto rr = __builtin_amdgcn_permlane32_swap(__float_as_uint(ps), __float_as_uint(ps), false, false);
      ps = __uint_as_float(rr[0]) + __uint_as_float(rr[1]); }
    l_reg = l_reg * alpha + ps;
#pragma unroll
    for (int w = 0; w < 4; ++w) { pa[w] = (int)f8x4(p0[4 * w], p0[4 * w + 1], p0[4 * w + 2], p0[4 * w + 3]); pa[4 + w] = (int)f8x4(p1[4 * w], p1[4 * w + 1], p1[4 * w + 2], p1[4 * w + 3]); }
}
typedef int i32x2 __attribute__((ext_vector_type(2)));
template <int OFF> __device__ __forceinline__ u32x2 tr8_read(int vb) { typedef i32x2 LAS* lp; const i32x2 r = __builtin_amdgcn_ds_read_tr8_b64_v2i32((lp)(uintptr_t)(unsigned)(vb + OFF)); return (u32x2){(unsigned)r.x, (unsigned)r.y}; }
#define F8_MFMA(A_, B_, C_) __builtin_amdgcn_mfma_scale_f32_32x32x64_f8f6f4(A_, B_, C_, 0, 0, 0, F8_ONE, 0, F8_ONE)
#define TR8X4(T, VB) const u32x2 T[4] = {tr8_read<0>(VB), tr8_read<2048>(VB), tr8_read<4096>(VB), tr8_read<6144>(VB)}
#define TR8B(T) (i32x8){(int)T[0].x, (int)T[0].y, (int)T[1].x, (int)T[1].y, (int)T[2].x, (int)T[2].y, (int)T[3].x, (int)T[3].y}
__device__ __forceinline__ void pv8_pairs(f32x16* o, const int* vb, int boff, const i32x8& pa) {
    { TR8X4(a, vb[0] + boff); TR8X4(b, vb[1] + boff);
      o[0] = F8_MFMA(pa, TR8B(a), o[0]);
      o[1] = F8_MFMA(pa, TR8B(b), o[1]); }
    { TR8X4(c, vb[2] + boff); TR8X4(d, vb[3] + boff);
      o[2] = F8_MFMA(pa, TR8B(c), o[2]);
      o[3] = F8_MFMA(pa, TR8B(d), o[3]); }
}
__device__ __forceinline__ void pv8_seq(f32x16* o, const int* vb, int boff, const i32x8& pa) {
    const i32x8 ones = {0x38383838, 0x38383838, 0x38383838, 0x38383838, 0x38383838, 0x38383838, 0x38383838, 0x38383838};
    { TR8X4(a, vb[0] + boff); o[4] = F8_MFMA(pa, ones, o[4]); o[0] = F8_MFMA(pa, TR8B(a), o[0]); }
    { TR8X4(b, vb[1] + boff); o[1] = F8_MFMA(pa, TR8B(b), o[1]); }
    { TR8X4(c, vb[2] + boff); o[2] = F8_MFMA(pa, TR8B(c), o[2]); }
    { TR8X4(d, vb[3] + boff); o[3] = F8_MFMA(pa, TR8B(d), o[3]); }
}
template <bool ALL16> __device__ __forceinline__ void pv8_all(f32x16* o, const int* vb, int boff, const i32x8& pa) {
    const i32x8 ones = {0x38383838, 0x38383838, 0x38383838, 0x38383838, 0x38383838, 0x38383838, 0x38383838, 0x38383838};
    if constexpr (ALL16) {
        TR8X4(a, vb[0] + boff); TR8X4(b, vb[1] + boff); TR8X4(c, vb[2] + boff); TR8X4(d, vb[3] + boff);
        o[4] = F8_MFMA(pa, ones, o[4]);
        o[0] = F8_MFMA(pa, TR8B(a), o[0]);
        o[1] = F8_MFMA(pa, TR8B(b), o[1]);
        o[2] = F8_MFMA(pa, TR8B(c), o[2]);
        o[3] = F8_MFMA(pa, TR8B(d), o[3]);
    } else {
        { TR8X4(a, vb[0] + boff); TR8X4(b, vb[1] + boff);
          o[4] = F8_MFMA(pa, ones, o[4]);
          o[0] = F8_MFMA(pa, TR8B(a), o[0]);
          o[1] = F8_MFMA(pa, TR8B(b), o[1]); }
        { TR8X4(c, vb[2] + boff); TR8X4(d, vb[3] + boff);
          o[2] = F8_MFMA(pa, TR8B(c), o[2]);
          o[3] = F8_MFMA(pa, TR8B(d), o[3]); }
    }
}
__device__ __forceinline__ int v8_f(int key) { return ((key >> 1) & 1) + 2 * ((key >> 3) & 1); }
__device__ __forceinline__ int v8_st(int key, int ch16) { return key * 128 + 32 * ((ch16 >> 1) ^ v8_f(key)) + 16 * (ch16 & 1); }
__device__ __forceinline__ int v8_rd_base(int lane, int db) {
    const int q = (lane & 15) >> 1, pp = lane & 1, g1 = (lane >> 4) & 1, hi = lane >> 5, fq = ((q >> 1) & 1) + 2 * (q >> 2);
    return (8 * (q >> 2) + 4 * hi + (q & 3)) * 128 + 32 * (db ^ fq) + 16 * g1 + 8 * pp;
}
template <int DQK, int LDQ, int LDK, int LDV, int LDO>
__device__ __forceinline__ void attn88_body(const bf16_t* __restrict__ Qb, const unsigned char* __restrict__ Kh, const unsigned char* __restrict__ Vh, bf16_t* __restrict__ Ob, int seq, float scale, char* lds) {
    constexpr int KP = DQK + 16, SHM_V = 64 * 128, SHM_K = 64 * KP, NC = DQK / 64;
    static_assert(DQK == 128, "double-pipelined body: 128-wide q.k only");
    const float C = scale * 1.4426950408889634f, thr_raw = ATT8_THR / scale;
    const int tid = threadIdx.x, wid = tid >> 6, lane = tid & 63, r32 = lane & 31, hi = lane >> 5;
    char* V_lds = lds; char* K_lds = lds + 2 * SHM_V;
    float* al_l = (float*)(lds + 2 * SHM_V + 2 * SHM_K) + wid * 32;
    float m_reg = -1e30f; f32x16 o[5] = {}; i32x8 qr[NC];
    const bf16_t* Qw = Qb + (long)(wid * 32 + r32) * LDQ + hi * 32;
#pragma unroll
    for (int c = 0; c < NC; ++c) qr[c] = q32_to_fp8(Qw + 64 * c);
    const int krow = tid >> 3, kch = (tid & 7) * 16, vst = v8_st(krow, tid & 7);
    int vb[4];
#pragma unroll
    for (int d = 0; d < 4; ++d) vb[d] = (int)(uintptr_t)V_lds + v8_rd_base(lane, d);
    u32x4 vs, ks;
#define SLOAD(k0) do { vs = *reinterpret_cast<const u32x4*>(&Vh[(long)((k0) + krow) * LDV + kch]); ks = *reinterpret_cast<const u32x4*>(&Kh[(long)((k0) + krow) * LDK + kch]); } while (0)
#define SWRITE(b) do { *(u32x4*)(V_lds + (b) * SHM_V + vst) = vs; *(u32x4*)(K_lds + (b) * SHM_K + krow * KP + kch) = ks; } while (0)
#define RESC(a) do { if (__any((a) < 1.f)) { if (hi == 0) al_l[r32] = (a); asm volatile("s_waitcnt lgkmcnt(0)" ::: "memory"); \
    _Pragma("unroll") for (int d = 0; d < 5; ++d) _Pragma("unroll") for (int r = 0; r < 16; ++r) o[d][r] *= al_l[crow(r, hi)]; } } while (0)
#define PV8(b) pv8_all<DQK == 128>(o, vb, (b) * SHM_V, pa)
    f32x16 pA0, pA1, pB0, pB1; float mnA, mnB, alA, alB; i32x8 pa; const int NT = seq / 64;
    SLOAD(0); asm volatile("s_waitcnt vmcnt(0)" ::: "memory"); SWRITE(0); __syncthreads();
    qkt8<DQK>(pA0, pA1, K_lds, qr, r32, hi); partialSM8(pA0, pA1, m_reg, mnA, alA, C, thr_raw);
    SLOAD(64);
    asm volatile("s_waitcnt vmcnt(0)" ::: "memory"); SWRITE(1); __syncthreads();
    for (int j = 1; j + 1 < NT; j += 2) {
        SBAR(); qkt8<DQK>(pB0, pB1, K_lds + SHM_K, qr, r32, hi);
        finishSM8(pA0, pA1, pa); SBAR();
        SLOAD((j + 1) * 64); SBAR();
        PV8(0); partialSM8(pB0, pB1, m_reg, mnB, alB, C, thr_raw);
        __syncthreads(); asm volatile("s_waitcnt vmcnt(0)" ::: "memory"); SWRITE(0);
        RESC(alB); __syncthreads();
        SBAR(); qkt8<DQK>(pA0, pA1, K_lds, qr, r32, hi);
        finishSM8(pB0, pB1, pa); SBAR();
        SLOAD((j + 2) * 64); SBAR();
        PV8(1); partialSM8(pA0, pA1, m_reg, mnA, alA, C, thr_raw);
        __syncthreads(); asm volatile("s_waitcnt vmcnt(0)" ::: "memory"); SWRITE(1);
        RESC(alA); __syncthreads();
    }
    SBAR(); qkt8<DQK>(pB0, pB1, K_lds + SHM_K, qr, r32, hi);
    finishSM8(pA0, pA1, pa); SBAR();
    PV8(0); partialSM8(pB0, pB1, m_reg, mnB, alB, C, thr_raw);
    __syncthreads(); RESC(alB);
    finishSM8(pB0, pB1, pa); SBAR();
    PV8(1);
    float rli[16];
#pragma unroll
    for (int r = 0; r < 16; ++r) rli[r] = __builtin_amdgcn_rcpf(o[4][r]);
    bf16_t* Ow = Ob + (long)(wid * 32) * LDO;
#pragma unroll
    for (int r = 0; r < 16; ++r) { const int orow = crow(r, hi);
#pragma unroll
        for (int d0 = 0; d0 < 4; ++d0) Ow[(long)orow * LDO + d0 * 32 + r32] = (bf16_t)f2bf(o[d0][r] * rli[r]); }
    __syncthreads();
#undef SLOAD
#undef SWRITE
}
template <int DQK, int LDQ, int LDK, int LDV, int LDO>
__device__ __forceinline__ void attn88_body_single(const bf16_t* __restrict__ Qb, const unsigned char* __restrict__ Kh, const unsigned char* __restrict__ Vh, bf16_t* __restrict__ Ob, int seq, float scale, char* lds, int rope_t0) {
    constexpr int KP = DQK + 16, SHM_V = 64 * 128, SHM_K = 64 * KP, NC = DQK / 64, CH = DQK / 16, NCH = 64 * CH, NKL = (NCH + NTHREADS - 1) / NTHREADS;
    const float C = scale * 1.4426950408889634f, thr_raw = ATT8_THR / scale;
    const int tid = threadIdx.x, wid = tid >> 6, lane = tid & 63, r32 = lane & 31, hi = lane >> 5;
    char* V_lds = lds; char* K_lds = lds + 2 * SHM_V;
    float* al_l = (float*)(lds + 2 * SHM_V + 2 * SHM_K) + wid * 32;
    float m_reg = -1e30f; i32x8 qr[NC];
    const bf16_t* Qw = Qb + (long)(wid * 32 + r32) * LDQ + hi * 32;
    if constexpr (DQK == 192) {
        if (rope_t0 >= 0) { const int tq = rope_t0 + wid * 32 + r32; qr[2] = q32_rope_fp8(Qw + 128, (float)(hi ? (tq & 63) : (tq >> 6))); }
        else qr[2] = q32_to_fp8(Qw + 128);
    }
    asm volatile("" ::: "memory");
#pragma unroll
    for (int c = 0; c < 2; ++c) qr[c] = q32_to_fp8(Qw + 64 * c);
    const int vrow = tid >> 3, vch = (tid & 7) * 16, vst = v8_st(vrow, tid & 7);
    unsigned koff[NKL]; int klds[NKL]; const unsigned voff = (unsigned)(vrow * LDV + vch);
#pragma unroll
    for (int i = 0; i < NKL; ++i) { const int id = tid + i * NTHREADS, kr = (id < NCH) ? id / CH : 0, kc = (id % CH) * 16; koff[i] = (unsigned)(kr * LDK + kc); klds[i] = kr * KP + kc; }
    const bool k2 = (NKL < 2) || (tid + NTHREADS < NCH);
    int vb[4];
#pragma unroll
    for (int d = 0; d < 4; ++d) vb[d] = (int)(uintptr_t)V_lds + v8_rd_base(lane, d);
    u32x4 vs, ks[NKL];
#define SLOAD(k0) do { const unsigned char* vt_ = Vh + (size_t)(k0) * LDV; const unsigned char* kt_ = Kh + (size_t)(k0) * LDK; vs = *reinterpret_cast<const u32x4*>(vt_ + voff); \
    _Pragma("unroll") for (int i_ = 0; i_ < NKL; ++i_) ks[i_] = *reinterpret_cast<const u32x4*>(kt_ + koff[i_]); } while (0)
#define SWRITE(b) do { *(u32x4*)(V_lds + (b) * SHM_V + vst) = vs; \
    _Pragma("unroll") for (int i_ = 0; i_ < NKL; ++i_) if (i_ == 0 || k2) *(u32x4*)(K_lds + (b) * SHM_K + klds[i_]) = ks[i_]; } while (0)
    asm volatile("" ::: "memory");
    f32x16 o[5] = {}; f32x16 p0, p1; float mn, al; i32x8 pa; const int NT = seq / 64;
    SLOAD(0); asm volatile("s_waitcnt vmcnt(0)" ::: "memory"); SWRITE(0); __syncthreads();
    SLOAD(64);
    for (int j = 0; j < NT; ++j) {
        const int b = j & 1;
        SBAR(); qkt8<DQK>(p0, p1, K_lds + b * SHM_K, qr, r32, hi);
        partialSM8(p0, p1, m_reg, mn, al, C, thr_raw);
        RESC(al);
        finishSM8(p0, p1, pa); SBAR();
        PV8(b);
        if (j + 1 < NT) { asm volatile("s_waitcnt vmcnt(0)" ::: "memory"); SWRITE(b ^ 1); }
        __syncthreads();
        if (j + 2 < NT) SLOAD((j + 2) * 64);
    }
    float rli[16];
#pragma unroll
    for (int r = 0; r < 16; ++r) rli[r] = __builtin_amdgcn_rcpf(o[4][r]);
    bf16_t* Ow = Ob + (long)(wid * 32) * LDO;
#pragma unroll
    for (int r = 0; r < 16; ++r) { const int orow = crow(r, hi);
#pragma unroll
        for (int d0 = 0; d0 < 4; ++d0) Ow[(long)orow * LDO + d0 * 32 + r32] = (bf16_t)f2bf(o[d0][r] * rli[r]); }
    __syncthreads();
#undef SLOAD
#undef SWRITE
#undef RESC
#undef PV8
}
template <int DQK, int LDQ, int LDK, int LDV, int LDO, int VAR = 0>
__device__ __forceinline__ void attn88_pp(const bf16_t* __restrict__ Qb, const unsigned char* __restrict__ Kh, const unsigned char* __restrict__ Vh, bf16_t* __restrict__ Ob, int seq, float scale, char* lds, int rope_t0) {
#define PPBAR() do { SBAR(); __syncthreads(); SBAR(); } while (0)
    constexpr int KP = DQK + 16, SHM_V = 64 * 128, SHM_K = 64 * KP, SHM_P = SHM_V + SHM_K, NC = DQK / 64, CH = DQK / 16, NCH = 64 * CH, NKL = (NCH + NTHREADS - 1) / NTHREADS;
    const float C = scale * 1.4426950408889634f, thr_raw = ATT8_THR / scale;
    const int tid = threadIdx.x, wid = __builtin_amdgcn_readfirstlane(tid >> 6), lane = tid & 63, r32 = lane & 31, hi = lane >> 5, grp = wid >> 2;
    char* P_lds = lds;
    float* al_l = (float*)(lds + 2 * SHM_P) + wid * 32;
    constexpr bool MSUM = (DQK == 128);
    float m_reg = -1e30f, l_reg = 0.f; i32x8 qr[NC];
    const bf16_t* Qw = Qb + (long)(wid * 32 + r32) * LDQ + hi * 32;
    if constexpr (DQK == 192) {
        if (rope_t0 >= 0) { const int tq = rope_t0 + wid * 32 + r32; qr[2] = q32_rope_fp8(Qw + 128, (float)(hi ? (tq & 63) : (tq >> 6))); }
        else qr[2] = q32_to_fp8(Qw + 128);
    }
    asm volatile("" ::: "memory");
#pragma unroll
    for (int c = 0; c < 2; ++c) qr[c] = q32_to_fp8(Qw + 64 * c);
    const int vrow = tid >> 3, vch = (tid & 7) * 16, vst = v8_st(vrow, tid & 7);
    unsigned koff[NKL]; int klds[NKL]; const unsigned voff = (unsigned)(vrow * LDV + vch);
#pragma unroll
    for (int i = 0; i < NKL; ++i) { const int id = tid + i * NTHREADS, kr = (id < NCH) ? id / CH : 0, kc = (id % CH) * 16; koff[i] = (unsigned)(kr * LDK + kc); klds[i] = kr * KP + kc; }
    const bool k2 = (NKL < 2) || (tid + NTHREADS < NCH);
    int vb[4];
#pragma unroll
    for (int d = 0; d < 4; ++d) vb[d] = (int)(uintptr_t)P_lds + v8_rd_base(lane, d);
    u32x4 vs, ks[NKL]; const int NT = seq / 64;
#define PLOAD(jp) do { const int jv_ = (jp) < NT ? (jp) : NT - 1, jk_ = (jp) + 1 < NT ? (jp) + 1 : NT - 1; const unsigned char* vt_ = Vh + (size_t)jv_ * 64 * LDV; const unsigned char* kt_ = Kh + (size_t)jk_ * 64 * LDK; \
    vs = *reinterpret_cast<const u32x4*>(vt_ + voff); _Pragma("unroll") for (int i_ = 0; i_ < NKL; ++i_) ks[i_] = *reinterpret_cast<const u32x4*>(kt_ + koff[i_]); } while (0)
#define PWRITE(b) do { *(u32x4*)(P_lds + (b) * SHM_P + vst) = vs; \
    _Pragma("unroll") for (int i_ = 0; i_ < NKL; ++i_) if (i_ == 0 || k2) *(u32x4*)(P_lds + (b) * SHM_P + SHM_V + klds[i_]) = ks[i_]; } while (0)
#define RESC(a) do { if (__any((a) < 1.f)) { if (hi == 0) al_l[r32] = (a); asm volatile("s_waitcnt lgkmcnt(0)" ::: "memory"); \
    _Pragma("unroll") for (int d = 0; d < (MSUM ? 5 : 4); ++d) _Pragma("unroll") for (int r = 0; r < 16; ++r) o[d][r] *= al_l[crow(r, hi)]; } } while (0)
    asm volatile("" ::: "memory");
    f32x16 o[5] = {}; f32x16 p0 = {}, p1 = {}; float mn, al; i32x8 pa = {};
    { const unsigned char* kt_ = Kh;
#pragma unroll
      for (int i_ = 0; i_ < NKL; ++i_) ks[i_] = *reinterpret_cast<const u32x4*>(kt_ + koff[i_]);
      asm volatile("s_waitcnt vmcnt(0)" ::: "memory");
#pragma unroll
      for (int i_ = 0; i_ < NKL; ++i_) if (i_ == 0 || k2) *(u32x4*)(P_lds + SHM_P + SHM_V + klds[i_]) = ks[i_]; }
    PLOAD(0); asm volatile("s_waitcnt vmcnt(0)" ::: "memory"); PWRITE(0);
    PLOAD(1);
    PPBAR();
#define STAGE(j_) do { if (!(VAR & 4) && (j_) + 1 < NT) { asm volatile("s_waitcnt vmcnt(0)" ::: "memory"); PWRITE(((j_) + 1) & 1); if ((j_) + 2 < NT) PLOAD((j_) + 2); } } while (0)
#define HALF_A() do { if (VAR & 1) { _Pragma("unroll") for (int w_ = 0; w_ < 8; ++w_) pa[w_] = (int)__float_as_uint(w_ < 4 ? p0[4 * w_] : p1[4 * w_ - 16]); break; } partialSM8(p0, p1, m_reg, mn, al, C, thr_raw); RESC(al); if constexpr (MSUM) finishSM8(p0, p1, pa); else finishSM8s(p0, p1, al, l_reg, pa); asm volatile("" : "+v"(pa)); } while (0)
#define HALF_B(j_) do { if (VAR & 2) { _Pragma("unroll") for (int r_ = 0; r_ < 16; ++r_) { p0[r_] = __uint_as_float((unsigned)pa[r_ & 7]) * 1e-30f + (float)r_; p1[r_] = p0[r_] + 1.f; } o[0][(j_) & 15] += p0[3]; break; } const int boff_ = ((j_) & 1) * SHM_P; if constexpr (MSUM) pv8_all<true>(o, vb, boff_, pa); else pv8_pairs(o, vb, boff_, pa); if ((j_) + 1 < NT) { SBAR(); qkt8<DQK>(p0, p1, P_lds + boff_ + SHM_V, qr, r32, hi); asm volatile("" : "+v"(p0), "+v"(p1)); } } while (0)
    if (grp == 0) {
        qkt8<DQK>(p0, p1, P_lds + SHM_P + SHM_V, qr, r32, hi); PPBAR();
#pragma unroll 1
        for (int j = 0; j < NT; ++j) {
            HALF_A(); PPBAR();
            STAGE(j); HALF_B(j); PPBAR();
        }
        PPBAR();
    } else {
        PPBAR();
        qkt8<DQK>(p0, p1, P_lds + SHM_P + SHM_V, qr, r32, hi); PPBAR();
#pragma unroll 1
        for (int j = 0; j < NT; ++j) {
            STAGE(j); HALF_A(); PPBAR();
            HALF_B(j); PPBAR();
        }
    }
#undef STAGE
#undef HALF_A
#undef HALF_B
    float rli[16];
    if constexpr (MSUM) {
#pragma unroll
        for (int r = 0; r < 16; ++r) rli[r] = __builtin_amdgcn_rcpf(o[4][r]);
    } else {
        if (hi == 0) al_l[r32] = l_reg; asm volatile("s_waitcnt lgkmcnt(0)" ::: "memory");
#pragma unroll
        for (int r = 0; r < 16; ++r) rli[r] = __builtin_amdgcn_rcpf(al_l[crow(r, hi)]);
    }
    { int t2 = threadIdx.x; asm volatile("" : "+v"(t2));
      const int w2 = t2 >> 6, r2 = t2 & 31, h2 = (t2 >> 5) & 1;
      bf16_t* Ow = Ob + (long)(w2 * 32) * LDO;
#pragma unroll
      for (int r = 0; r < 16; ++r) { const int orow = crow(r, h2);
#pragma unroll
          for (int d0 = 0; d0 < 4; ++d0) Ow[(long)orow * LDO + d0 * 32 + r2] = (bf16_t)f2bf(o[d0][r] * rli[r]); } }
    PPBAR();
#undef PLOAD
#undef PWRITE
#undef RESC
#undef PPBAR
}
#ifndef ATTN_PP
#define ATTN_PP 1
#endif
#if ATTN_PP
#define ATTN_MLA attn88_body_single
#define ATTN_GQA attn88_pp
#else
#define ATTN_MLA attn88_body_single
#define ATTN_GQA(...) attn88_body
#endif
__device__ __forceinline__ void p_attn_mla(const Args& A, const Frame& F) {
    const bf16_t* Q = (const bf16_t*)(F.ws + WS_Q); const unsigned char* Kb = F.ws + WS_K; const unsigned char* Vb = F.ws + WS_V; bf16_t* O = (bf16_t*)(F.ws + WS_O);
    const float scale = 0.07216878364870322f;
    for (int u = F.vcu; u < 544; u += F.nblk) {
        int b, h, q0, seq;
        int rope_t0;
        if (u < 512) { const int qb = u & 15; h = (u >> 4) & 7; b = u >> 7; q0 = CTXL + qb * 256; seq = RPB; rope_t0 = qb * 256; }
        else { const int v = u - 512; h = v & 7; b = v >> 3; q0 = 0; seq = CTXL; rope_t0 = -1; }
        const size_t rb = (size_t)b * RPB;
        ATTN_MLA<192, 1536, 1536, 1024, 1024>(Q + (rb + q0) * 1536 + h * 192, Kb + rb * 1536 + h * 192, Vb + rb * 1024 + h * 128, O + (rb + q0) * 1024 + h * 128, seq, scale, F.lds, rope_t0);
    }
}
template <int VAR = 0> __device__ __forceinline__ void p_attn_gqa(const Args& A, const Frame& F, bf16_t* O) {
    const bf16_t* Q = (const bf16_t*)(F.ws + WS_Q1); const unsigned char* Kb = F.ws + WS_K1; const unsigned char* Vb = F.ws + WS_V1;
    const float scale = 0.08838834764831845f;
    for (int u = F.vcu; u < 512; u += F.nblk) {
        const int qb = u & 15, h = (u >> 4) & 7, b = u >> 7, q0 = CTXL + qb * 256, kvh = h >> 2;
        const size_t rb = (size_t)b * RPB;
        attn88_pp<128, 1024, 256, 256, 1024, VAR>(Q + (rb + q0) * 1024 + h * 128, Kb + rb * 256 + kvh * 128, Vb + rb * 256 + kvh * 128, O + (rb + q0) * 1024 + h * 128, RPB, scale, F.lds, -1);
    }
}
#define DPP_XOR1 0xB1
#define DPP_XOR2 0x4E
#define DPP_HMIRROR 0x141
#define DPP_MIRROR 0x140
__device__ __forceinline__ int row_max_i(int v) {
    v = max(v, __builtin_amdgcn_update_dpp(v, v, DPP_XOR1, 0xf, 0xf, false));
    v = max(v, __builtin_amdgcn_update_dpp(v, v, DPP_XOR2, 0xf, 0xf, false));
    v = max(v, __builtin_amdgcn_update_dpp(v, v, DPP_HMIRROR, 0xf, 0xf, false));
    v = max(v, __builtin_amdgcn_update_dpp(v, v, DPP_MIRROR, 0xf, 0xf, false));
    return v;
}
__device__ __forceinline__ float row_sum_f(float v) {
    v += __builtin_bit_cast(float, __builtin_amdgcn_update_dpp(0, __builtin_bit_cast(int, v), DPP_XOR1, 0xf, 0xf, false));
    v += __builtin_bit_cast(float, __builtin_amdgcn_update_dpp(0, __builtin_bit_cast(int, v), DPP_XOR2, 0xf, 0xf, false));
    v += __builtin_bit_cast(float, __builtin_amdgcn_update_dpp(0, __builtin_bit_cast(int, v), DPP_HMIRROR, 0xf, 0xf, false));
    v += __builtin_bit_cast(float, __builtin_amdgcn_update_dpp(0, __builtin_bit_cast(int, v), DPP_MIRROR, 0xf, 0xf, false));
    return v;
}
__device__ __forceinline__ int fkey(float f) { const int b = __builtin_bit_cast(int, f); return b ^ ((b >> 31) & 0x7fffffff); }
__device__ __forceinline__ float keyf(int k) { return __builtin_bit_cast(float, k ^ ((k >> 31) & 0x7fffffff)); }
__device__ __forceinline__ void cand_ij(int t, int& i, int& j) {
    const int g16 = t >= 16, g24 = t >= 24, g29 = t >= 29, g33 = t >= 33, g36 = t >= 36, g38 = t >= 38, g40 = t >= 40;
    i = g16 + g24 + g29 + g33 + g36 + g38 + g40 + max(t - 41, 0);
    const int base = 16 * g16 + 8 * g24 + 5 * g29 + 4 * g33 + 3 * g36 + 2 * g38 + 2 * g40;
    j = (t >= 42) ? 0 : t - base;
    if (t >= 50) { i = 0; j = 0; }
}
__device__ __forceinline__ void row_max2(int& a, int& b) {
    asm volatile("s_nop 1\n\t"
                 "v_max_i32_dpp %0, %0, %0 quad_perm:[1,0,3,2] row_mask:0xf bank_mask:0xf\n\tv_max_i32_dpp %1, %1, %1 quad_perm:[1,0,3,2] row_mask:0xf bank_mask:0xf\n\ts_nop 0\n\t"
                 "v_max_i32_dpp %0, %0, %0 quad_perm:[2,3,0,1] row_mask:0xf bank_mask:0xf\n\tv_max_i32_dpp %1, %1, %1 quad_perm:[2,3,0,1] row_mask:0xf bank_mask:0xf\n\ts_nop 0\n\t"
                 "v_max_i32_dpp %0, %0, %0 row_half_mirror row_mask:0xf bank_mask:0xf\n\tv_max_i32_dpp %1, %1, %1 row_half_mirror row_mask:0xf bank_mask:0xf\n\ts_nop 0\n\t"
                 "v_max_i32_dpp %0, %0, %0 row_mirror row_mask:0xf bank_mask:0xf\n\tv_max_i32_dpp %1, %1, %1 row_mirror row_mask:0xf bank_mask:0xf\n\ts_nop 1"
                 : "+v"(a), "+v"(b));
}
__device__ __forceinline__ void row_max1(int& a) {
    asm volatile("s_nop 1\n\t"
                 "v_max_i32_dpp %0, %0, %0 quad_perm:[1,0,3,2] row_mask:0xf bank_mask:0xf\n\ts_nop 1\n\t"
                 "v_max_i32_dpp %0, %0, %0 quad_perm:[2,3,0,1] row_mask:0xf bank_mask:0xf\n\ts_nop 1\n\t"
                 "v_max_i32_dpp %0, %0, %0 row_half_mirror row_mask:0xf bank_mask:0xf\n\ts_nop 1\n\t"
                 "v_max_i32_dpp %0, %0, %0 row_mirror row_mask:0xf bank_mask:0xf\n\ts_nop 1"
                 : "+v"(a));
}
__device__ __forceinline__ void row_max4(int& a, int& b, int& c, int& d) {
    asm volatile("s_nop 1\n\t"
                 "v_max_i32_dpp %0, %0, %0 quad_perm:[1,0,3,2] row_mask:0xf bank_mask:0xf\n\tv_max_i32_dpp %1, %1, %1 quad_perm:[1,0,3,2] row_mask:0xf bank_mask:0xf\n\t"
                 "v_max_i32_dpp %2, %2, %2 quad_perm:[1,0,3,2] row_mask:0xf bank_mask:0xf\n\tv_max_i32_dpp %3, %3, %3 quad_perm:[1,0,3,2] row_mask:0xf bank_mask:0xf\n\t"
                 "v_max_i32_dpp %0, %0, %0 quad_perm:[2,3,0,1] row_mask:0xf bank_mask:0xf\n\tv_max_i32_dpp %1, %1, %1 quad_perm:[2,3,0,1] row_mask:0xf bank_mask:0xf\n\t"
                 "v_max_i32_dpp %2, %2, %2 quad_perm:[2,3,0,1] row_mask:0xf bank_mask:0xf\n\tv_max_i32_dpp %3, %3, %3 quad_perm:[2,3,0,1] row_mask:0xf bank_mask:0xf\n\t"
                 "v_max_i32_dpp %0, %0, %0 row_half_mirror row_mask:0xf bank_mask:0xf\n\tv_max_i32_dpp %1, %1, %1 row_half_mirror row_mask:0xf bank_mask:0xf\n\t"
                 "v_max_i32_dpp %2, %2, %2 row_half_mirror row_mask:0xf bank_mask:0xf\n\tv_max_i32_dpp %3, %3, %3 row_half_mirror row_mask:0xf bank_mask:0xf\n\t"
                 "v_max_i32_dpp %0, %0, %0 row_mirror row_mask:0xf bank_mask:0xf\n\tv_max_i32_dpp %1, %1, %1 row_mirror row_mask:0xf bank_mask:0xf\n\t"
                 "v_max_i32_dpp %2, %2, %2 row_mirror row_mask:0xf bank_mask:0xf\n\tv_max_i32_dpp %3, %3, %3 row_mirror row_mask:0xf bank_mask:0xf\n\ts_nop 1"
                 : "+v"(a), "+v"(b), "+v"(c), "+v"(d));
}
#define CE_DESC(x, y) do { const int hi_ = max(x, y), lo_ = min(x, y); x = hi_; y = lo_; } while (0)
#define SORT8_DESC(k) do { CE_DESC(k[0], k[2]); CE_DESC(k[1], k[3]); CE_DESC(k[4], k[6]); CE_DESC(k[5], k[7]); CE_DESC(k[0], k[4]); CE_DESC(k[1], k[5]); CE_DESC(k[2], k[6]); CE_DESC(k[3], k[7]); \
    CE_DESC(k[0], k[1]); CE_DESC(k[2], k[3]); CE_DESC(k[4], k[5]); CE_DESC(k[6], k[7]); CE_DESC(k[2], k[4]); CE_DESC(k[3], k[5]); CE_DESC(k[1], k[4]); CE_DESC(k[3], k[6]); CE_DESC(k[1], k[2]); CE_DESC(k[3], k[4]); CE_DESC(k[5], k[6]); } while (0)
#define SORT16_DESC(K) do { CE_DESC(K[0], K[1]); CE_DESC(K[2], K[3]); CE_DESC(K[0], K[2]); CE_DESC(K[1], K[3]); CE_DESC(K[1], K[2]); CE_DESC(K[4], K[5]); CE_DESC(K[6], K[7]); CE_DESC(K[4], K[6]); CE_DESC(K[5], K[7]); CE_DESC(K[5], K[6]); CE_DESC(K[0], K[4]); CE_DESC(K[2], K[6]); CE_DESC(K[2], K[4]); CE_DESC(K[1], K[5]); CE_DESC(K[3], K[7]); CE_DESC(K[3], K[5]); CE_DESC(K[1], K[2]); CE_DESC(K[3], K[4]); CE_DESC(K[5], K[6]); CE_DESC(K[8], K[9]); CE_DESC(K[10], K[11]); CE_DESC(K[8], K[10]); CE_DESC(K[9], K[11]); CE_DESC(K[9], K[10]); CE_DESC(K[12], K[13]); CE_DESC(K[14], K[15]); CE_DESC(K[12], K[14]); CE_DESC(K[13], K[15]); CE_DESC(K[13], K[14]); CE_DESC(K[8], K[12]); CE_DESC(K[10], K[14]); CE_DESC(K[10], K[12]); CE_DESC(K[9], K[13]); CE_DESC(K[11], K[15]); CE_DESC(K[11], K[13]); CE_DESC(K[9], K[10]); CE_DESC(K[11], K[12]); CE_DESC(K[13], K[14]); CE_DESC(K[0], K[8]); CE_DESC(K[4], K[12]); CE_DESC(K[4], K[8]); CE_DESC(K[2], K[10]); CE_DESC(K[6], K[14]); CE_DESC(K[6], K[10]); CE_DESC(K[2], K[4]); CE_DESC(K[6], K[8]); CE_DESC(K[10], K[12]); CE_DESC(K[1], K[9]); CE_DESC(K[5], K[13]); CE_DESC(K[5], K[9]); CE_DESC(K[3], K[11]); CE_DESC(K[7], K[15]); CE_DESC(K[7], K[11]); CE_DESC(K[3], K[5]); CE_DESC(K[7], K[9]); CE_DESC(K[11], K[13]); CE_DESC(K[1], K[2]); CE_DESC(K[3], K[4]); CE_DESC(K[5], K[6]); CE_DESC(K[7], K[8]); CE_DESC(K[9], K[10]); CE_DESC(K[11], K[12]); CE_DESC(K[13], K[14]); } while (0)
#define MERGE16_DESC(T, K) do { _Pragma("unroll") for (int i_ = 0; i_ < 16; ++i_) T[i_] = max(T[i_], K[15 - i_]); CE_DESC(T[0], T[8]); CE_DESC(T[1], T[9]); CE_DESC(T[2], T[10]); CE_DESC(T[3], T[11]); CE_DESC(T[4], T[12]); CE_DESC(T[5], T[13]); CE_DESC(T[6], T[14]); CE_DESC(T[7], T[15]); CE_DESC(T[0], T[4]); CE_DESC(T[1], T[5]); CE_DESC(T[2], T[6]); CE_DESC(T[3], T[7]); CE_DESC(T[8], T[12]); CE_DESC(T[9], T[13]); CE_DESC(T[10], T[14]); CE_DESC(T[11], T[15]); CE_DESC(T[0], T[2]); CE_DESC(T[1], T[3]); CE_DESC(T[4], T[6]); CE_DESC(T[5], T[7]); CE_DESC(T[8], T[10]); CE_DESC(T[9], T[11]); CE_DESC(T[12], T[14]); CE_DESC(T[13], T[15]); CE_DESC(T[0], T[1]); CE_DESC(T[2], T[3]); CE_DESC(T[4], T[5]); CE_DESC(T[6], T[7]); CE_DESC(T[8], T[9]); CE_DESC(T[10], T[11]); CE_DESC(T[12], T[13]); CE_DESC(T[14], T[15]); } while (0)
__device__ __forceinline__ int hkey_hi(unsigned w) { const int x = (int)(w & 0xffff0000u); return x ^ ((x >> 31) & 0x7fff0000); }
__device__ __forceinline__ float hkey_val(int k) { const int y = k & (int)0xffff0000; const unsigned b = (unsigned)(y ^ ((y >> 31) & 0x7fff0000)); return (float)__builtin_bit_cast(_Float16, (unsigned short)(b >> 16)); }
__device__ __forceinline__ int cnd(int a, int b, unsigned long long m) { int r; asm("v_cndmask_b32_e64 %0, %1, %2, %3" : "=v"(r) : "v"(a), "v"(b), "s"(m)); return r; }
__device__ __forceinline__ unsigned long long bitmask(int v, int bit) { unsigned long long m; asm("v_cmp_ne_u32_e64 %0, 0, %1\n\ts_nop 1" : "=s"(m) : "v"(v & bit)); return m; }
__device__ __forceinline__ int sel16(const int (&a)[16], int i) {
    const unsigned long long m0 = bitmask(i, 1), m1 = bitmask(i, 2), m2 = bitmask(i, 4), m3 = bitmask(i, 8);
    int l1[8], l2[4], l3[2];
#pragma unroll
    for (int m = 0; m < 8; ++m) l1[m] = cnd(a[2 * m], a[2 * m + 1], m0);
#pragma unroll
    for (int m = 0; m < 4; ++m) l2[m] = cnd(l1[2 * m], l1[2 * m + 1], m1);
#pragma unroll
    for (int m = 0; m < 2; ++m) l3[m] = cnd(l2[2 * m], l2[2 * m + 1], m2);
    return cnd(l3[0], l3[1], m3);
}
__device__ __forceinline__ void topk_rows4(const unsigned short* S, unsigned* PK, int r, int hbase, int lane) {
    const int c = lane & 15, rw = lane >> 4, rbase = lane & 48, h = hbase + rw;
    const int KMIN = (int)0x80000000;
    const unsigned short* sp = S + (size_t)r * 2048 + h * 256 + 4 * c;
    int k1[8], k2[8];
#pragma unroll
    for (int jj = 0; jj < 2; ++jj) { const u32x2 a = *(const u32x2*)(sp + 64 * jj), b = *(const u32x2*)(sp + 128 + 64 * jj);
#pragma unroll
        for (int e = 0; e < 4; ++e) { const int p = 4 * c + 64 * jj + e;
            const float fa = (float)__builtin_bit_cast(_Float16, (unsigned short)(a[e >> 1] >> (16 * (e & 1)))), fb = (float)__builtin_bit_cast(_Float16, (unsigned short)(b[e >> 1] >> (16 * (e & 1))));
            k1[4 * jj + e] = (fkey(fa) & ~127) | (127 - p); k2[4 * jj + e] = (fkey(fb) & ~127) | (127 - p); } }
    SORT8_DESC(k1); SORT8_DESC(k2);
    int r1 = KMIN, r2 = KMIN;
#pragma unroll 1
    for (int it = 0; it < 16; ++it) {
        int m1 = k1[0], m2 = k2[0];
        row_max2(m1, m2);
        const bool p1 = (k1[0] == m1), p2 = (k2[0] == m2);
#pragma unroll
        for (int e = 0; e < 7; ++e) { k1[e] = p1 ? k1[e + 1] : k1[e]; k2[e] = p2 ? k2[e + 1] : k2[e]; }
        k1[7] = p1 ? KMIN : k1[7]; k2[7] = p2 ? KMIN : k2[7];
        if (c == it) { r1 = m1; r2 = m2; }
    }
    int ck[4];
#pragma unroll
    for (int q = 0; q < 4; ++q) { int ci, cj; cand_ij(c + 16 * q, ci, cj); const int a = __shfl(r1, rbase | ci), b = __shfl(r2, rbase | cj);
        const float fs = keyf((a & ~127) | 64) + keyf((b & ~127) | 64); const int t = c + 16 * q;
        ck[q] = (t < 50) ? ((fkey(fs) & ~63) | (63 - t)) : KMIN; }
    CE_DESC(ck[0], ck[1]); CE_DESC(ck[2], ck[3]); CE_DESC(ck[0], ck[2]); CE_DESC(ck[1], ck[3]); CE_DESC(ck[1], ck[2]);
    int tk = KMIN;
#pragma unroll 1
    for (int it = 0; it < 16; ++it) {
        int m = ck[0];
        row_max1(m);
        const bool pp = (ck[0] == m);
        ck[0] = pp ? ck[1] : ck[0]; ck[1] = pp ? ck[2] : ck[1]; ck[2] = pp ? ck[3] : ck[2]; ck[3] = pp ? KMIN : ck[3];
        if (c == it) tk = m;
    }
    int wi, wj; cand_ij(63 - (tk & 63), wi, wj);
    const int wa = __shfl(r1, rbase | wi), wb = __shfl(r2, rbase | wj);
    const int te = (127 - (wa & 127)) * 128 + (127 - (wb & 127));
    const float tv = keyf((tk & ~63) | 32);
    int mk = tk; row_max1(mk);
    const float mx = keyf((mk & ~63) | 32);
    const float ex = __expf(tv - mx), sum = row_sum_f(ex);
    PK[(size_t)r * 128 + h * 16 + c] = ((unsigned)te << 16) | (unsigned)(ex * (65535.f / sum) + 0.5f);
}
__device__ __forceinline__ void p_peer_topk(const Args& A, const Frame& F, bool skip_ctx) {
    const int gw = F.bid * NWAVES + F.wave, NGW = F.nblk * NWAVES, lane = F.lane;
    const unsigned short* S = (const unsigned short*)(F.ws + WS_S); unsigned* PK = (unsigned*)(F.ws + WS_PK);
    const int KMIN = (int)0x80000000;
    const int nitem = (skip_ctx ? NB * SEQ : R) * 8;
    const int nmain = (nitem / (NGW * 64)) * (NGW * 64);
    for (int q = gw; q < (nitem - nmain) / 4; q += NGW) { const int item = nmain + 4 * q, n = item >> 3; topk_rows4(S, PK, skip_ctx ? tok_row(1, n) : n, item & 7, lane); }
    for (int base = gw * 64; base < nmain; base += NGW * 64) {
        const int item = base + lane, n = item >> 3, h = item & 7, r = skip_ctx ? tok_row(1, n) : n;
        const unsigned short* sp = S + (size_t)r * 2048 + h * 256;
        int t1[16], t2[16];
#pragma unroll
        for (int list = 0; list < 2; ++list) {
            int T[16];
#pragma unroll
            for (int i = 0; i < 16; ++i) T[i] = KMIN;
            const unsigned short* lp = sp + 128 * list;
            u32x4 ra = *(const u32x4*)lp, rb = *(const u32x4*)(lp + 8);
#pragma unroll 1
            for (int c = 0; c < 8; ++c) {
                const int cn = c < 7 ? c + 1 : 7;
                const u32x4 na = *(const u32x4*)(lp + 16 * cn), nb = *(const u32x4*)(lp + 16 * cn + 8);
                const int pb = 127 - 16 * c;
                int K[16];
#pragma unroll
                for (int d = 0; d < 4; ++d) { K[2 * d] = hkey_hi(ra[d] << 16) | (pb - 2 * d); K[2 * d + 1] = hkey_hi(ra[d]) | (pb - 2 * d - 1);
                    K[8 + 2 * d] = hkey_hi(rb[d] << 16) | (pb - 8 - 2 * d); K[8 + 2 * d + 1] = hkey_hi(rb[d]) | (pb - 9 - 2 * d); }
                SORT16_DESC(K);
                MERGE16_DESC(T, K);
                ra = na; rb = nb;
            }
#pragma unroll
            for (int i = 0; i < 16; ++i) { if (list == 0) t1[i] = T[i]; else t2[i] = T[i]; }
        }
        float f1[16], f2[16];
#pragma unroll
        for (int i = 0; i < 16; ++i) { f1[i] = hkey_val(t1[i]); f2[i] = hkey_val(t2[i]); }
        int CA[16], CB[16], CC[16], CD[16];
        CA[0] = (fkey(f1[0] + f2[0]) & ~63) | 63; CA[1] = (fkey(f1[0] + f2[1]) & ~63) | 62; CA[2] = (fkey(f1[0] + f2[2]) & ~63) | 61; CA[3] = (fkey(f1[0] + f2[3]) & ~63) | 60; CA[4] = (fkey(f1[0] + f2[4]) & ~63) | 59; CA[5] = (fkey(f1[0] + f2[5]) & ~63) | 58; CA[6] = (fkey(f1[0] + f2[6]) & ~63) | 57; CA[7] = (fkey(f1[0] + f2[7]) & ~63) | 56; CA[8] = (fkey(f1[0] + f2[8]) & ~63) | 55; CA[9] = (fkey(f1[0] + f2[9]) & ~63) | 54; CA[10] = (fkey(f1[0] + f2[10]) & ~63) | 53; CA[11] = (fkey(f1[0] + f2[11]) & ~63) | 52; CA[12] = (fkey(f1[0] + f2[12]) & ~63) | 51; CA[13] = (fkey(f1[0] + f2[13]) & ~63) | 50; CA[14] = (fkey(f1[0] + f2[14]) & ~63) | 49; CA[15] = (fkey(f1[0] + f2[15]) & ~63) | 48; CB[0] = (fkey(f1[1] + f2[0]) & ~63) | 47; CB[1] = (fkey(f1[1] + f2[1]) & ~63) | 46; CB[2] = (fkey(f1[1] + f2[2]) & ~63) | 45; CB[3] = (fkey(f1[1] + f2[3]) & ~63) | 44; CB[4] = (fkey(f1[1] + f2[4]) & ~63) | 43; CB[5] = (fkey(f1[1] + f2[5]) & ~63) | 42; CB[6] = (fkey(f1[1] + f2[6]) & ~63) | 41; CB[7] = (fkey(f1[1] + f2[7]) & ~63) | 40; CB[8] = (fkey(f1[2] + f2[0]) & ~63) | 39; CB[9] = (fkey(f1[2] + f2[1]) & ~63) | 38; CB[10] = (fkey(f1[2] + f2[2]) & ~63) | 37; CB[11] = (fkey(f1[2] + f2[3]) & ~63) | 36; CB[12] = (fkey(f1[2] + f2[4]) & ~63) | 35; CB[13] = (fkey(f1[3] + f2[0]) & ~63) | 34; CB[14] = (fkey(f1[3] + f2[1]) & ~63) | 33; CB[15] = (fkey(f1[3] + f2[2]) & ~63) | 32; CC[0] = (fkey(f1[3] + f2[3]) & ~63) | 31; CC[1] = (fkey(f1[4] + f2[0]) & ~63) | 30; CC[2] = (fkey(f1[4] + f2[1]) & ~63) | 29; CC[3] = (fkey(f1[4] + f2[2]) & ~63) | 28; CC[4] = (fkey(f1[5] + f2[0]) & ~63) | 27; CC[5] = (fkey(f1[5] + f2[1]) & ~63) | 26; CC[6] = (fkey(f1[6] + f2[0]) & ~63) | 25; CC[7] = (fkey(f1[6] + f2[1]) & ~63) | 24; CC[8] = (fkey(f1[7] + f2[0]) & ~63) | 23; CC[9] = (fkey(f1[7] + f2[1]) & ~63) | 22; CC[10] = (fkey(f1[8] + f2[0]) & ~63) | 21; CC[11] = (fkey(f1[9] + f2[0]) & ~63) | 20; CC[12] = (fkey(f1[10] + f2[0]) & ~63) | 19; CC[13] = (fkey(f1[11] + f2[0]) & ~63) | 18; CC[14] = (fkey(f1[12] + f2[0]) & ~63) | 17; CC[15] = (fkey(f1[13] + f2[0]) & ~63) | 16; CD[0] = (fkey(f1[14] + f2[0]) & ~63) | 15; CD[1] = (fkey(f1[15] + f2[0]) & ~63) | 14; CD[2] = KMIN; CD[3] = KMIN; CD[4] = KMIN; CD[5] = KMIN; CD[6] = KMIN; CD[7] = KMIN; CD[8] = KMIN; CD[9] = KMIN; CD[10] = KMIN; CD[11] = KMIN; CD[12] = KMIN; CD[13] = KMIN; CD[14] = KMIN; CD[15] = KMIN;
        SORT16_DESC(CB); SORT16_DESC(CC); CE_DESC(CD[0], CD[1]);
        MERGE16_DESC(CA, CB); MERGE16_DESC(CA, CC); MERGE16_DESC(CA, CD);
        const float mx = keyf((CA[0] & ~63) | 32);
        float ex[16], sum = 0.f; unsigned te[16];
#pragma unroll
        for (int k = 0; k < 16; ++k) { int wi, wj; cand_ij(63 - (CA[k] & 63), wi, wj);
            const int wa = sel16(t1, wi), wb = sel16(t2, wj);
            te[k] = (unsigned)((127 - (wa & 127)) * 128 + (127 - (wb & 127)));
            ex[k] = __expf(keyf((CA[k] & ~63) | 32) - mx); sum += ex[k]; }
        const float rs = 65535.f / sum;
        u32x4* dst = (u32x4*)(PK + (size_t)r * 128 + h * 16);
#pragma unroll
        for (int q = 0; q < 4; ++q) { u32x4 o;
#pragma unroll
            for (int d = 0; d < 4; ++d) o[d] = (te[4 * q + d] << 16) | (unsigned)(ex[4 * q + d] * rs + 0.5f);
            dst[q] = o; }
    }
}

#define UB(w, b) ((float)(((w) >> (8 * (b))) & 0xffu))
__device__ __forceinline__ void p_peer_experts(const Args& A, const Frame& F, int layer) {
    const int gw = F.bid * NWAVES + F.wave, NGW = F.nblk * NWAVES, lane = F.lane;
    const bf16_t* H = (const bf16_t*)(F.ws + WS_H); float* X = (float*)(F.ws + WS_X);
    const unsigned* PK = (const unsigned*)(F.ws + WS_PK);
    const unsigned char* UT = F.ws + WS_TAB + (size_t)(layer * 2) * 16384 * 1024; const unsigned char* VT = UT + (size_t)16384 * 1024;
    const float* SU = (const float*)(F.ws + WS_TSC) + (layer * 2) * 16384; const float* SV = SU + 16384;
    const float* MOD = (const float*)(F.ws + WS_MOD) + (size_t)layer * 5 * 6144;
    for (int r = gw; r < R; r += NGW) {
        if (layer == 1 && is_ctx_row(r)) continue;
        float hf[16];
        { const u32x4 w0 = *(const u32x4*)(H + (size_t)r * DM + 16 * lane), w1 = *(const u32x4*)(H + (size_t)r * DM + 16 * lane + 8);
#pragma unroll
          for (int d = 0; d < 4; ++d) { hf[2 * d] = bflo(w0[d]); hf[2 * d + 1] = bfhi(w0[d]); hf[8 + 2 * d] = bflo(w1[d]); hf[8 + 2 * d + 1] = bfhi(w1[d]); } }
        float hs = 0.f;
#pragma unroll
        for (int i = 0; i < 16; ++i) hs += hf[i];
        hs = wave_sum(hs);
        int v0 = (int)PK[(size_t)r * 128 + lane], v1 = (int)PK[(size_t)r * 128 + 64 + lane];
#pragma unroll
        for (int k = 2; k <= 128; k <<= 1) {
#pragma unroll
            for (int j = k >> 1; j >= 1; j >>= 1) {
                if (j == 64) { const int a = min(v0, v1), b = max(v0, v1); v0 = a; v1 = b; }
                else { const int o0 = __shfl_xor(v0, j), o1 = __shfl_xor(v1, j); const bool lower = (lane & j) == 0;
                    const bool asc0 = (k == 128) ? true : (k == 64) ? true : ((lane & k) == 0), asc1 = (k == 128) ? true : (k == 64) ? false : ((lane & k) == 0);
                    v0 = (lower == asc0) ? min(v0, o0) : max(v0, o0); v1 = (lower == asc1) ? min(v1, o1) : max(v1, o1); }
            }
        }
        const unsigned pk0 = (unsigned)v0, pk1 = (unsigned)v1;
        const int e0 = (int)(pk0 >> 16), e1 = (int)(pk1 >> 16);
        const float g0 = (float)(pk0 & 0xffffu) * (1.f / 65535.f), g1 = (float)(pk1 & 0xffffu) * (1.f / 65535.f);
        const float su0 = SU[e0], su1 = SU[e1], sv0 = SV[e0], sv1 = SV[e1];
        float d0 = 0.f, d1 = 0.f;
        const int dep_src = (8 * (lane & 7)) << 2; const bool bit3 = (lane & 8) != 0;
#define XISSUE(buf, TAB, esrc, gg) do { _Pragma("unroll") for (int q_ = 0; q_ < 8; ++q_) { const int e_ = __builtin_amdgcn_readlane(esrc, (gg) * 8 + q_); \
            buf[q_] = *(const u32x4*)((TAB) + (size_t)e_ * 1024 + 16 * lane); } } while (0)
#define UCOMP(buf, gg, dsel) do { float p_[8]; _Pragma("unroll") for (int q_ = 0; q_ < 8; ++q_) { float d_ = 0.f; \
            _Pragma("unroll") for (int j_ = 0; j_ < 4; ++j_) d_ += (hf[4 * j_] * UB(buf[q_][j_], 0) + hf[4 * j_ + 1] * UB(buf[q_][j_], 1)) + (hf[4 * j_ + 2] * UB(buf[q_][j_], 2) + hf[4 * j_ + 3] * UB(buf[q_][j_], 3)); p_[q_] = d_; } \
            float s_[4]; _Pragma("unroll") for (int q_ = 0; q_ < 4; ++q_) { auto rr_ = __builtin_amdgcn_permlane32_swap(__float_as_uint(p_[q_]), __float_as_uint(p_[q_ + 4]), false, false); s_[q_] = __uint_as_float(rr_[0]) + __uint_as_float(rr_[1]); } \
            float t_[2]; _Pragma("unroll") for (int q_ = 0; q_ < 2; ++q_) { auto rr_ = __builtin_amdgcn_permlane16_swap(__float_as_uint(s_[q_]), __float_as_uint(s_[q_ + 2]), false, false); t_[q_] = __uint_as_float(rr_[0]) + __uint_as_float(rr_[1]); } \
            const float keep_ = bit3 ? t_[1] : t_[0], send_ = bit3 ? t_[0] : t_[1]; \
            float u_ = keep_ + __builtin_bit_cast(float, __builtin_amdgcn_update_dpp(0, __builtin_bit_cast(int, send_), 0x128, 0xf, 0xf, false)); \
            u_ += __builtin_bit_cast(float, __builtin_amdgcn_update_dpp(0, __builtin_bit_cast(int, u_), DPP_HMIRROR, 0xf, 0xf, false)); \
            u_ += __builtin_bit_cast(float, __builtin_amdgcn_update_dpp(0, __builtin_bit_cast(int, u_), DPP_XOR1, 0xf, 0xf, false)); \
            u_ += __builtin_bit_cast(float, __builtin_amdgcn_update_dpp(0, __builtin_bit_cast(int, u_), DPP_XOR2, 0xf, 0xf, false)); \
            const float v_ = __builtin_bit_cast(float, __builtin_amdgcn_ds_bpermute(dep_src, __builtin_bit_cast(int, u_))); \
            if ((lane >> 3) == (gg)) dsel = v_; } while (0)
        {
            u32x4 ua[8], ub[8];
            XISSUE(ua, UT, e0, 0);
#pragma unroll 1
            for (int g = 0; g < 8; g += 2) { XISSUE(ub, UT, e0, g + 1); UCOMP(ua, g, d0); if (g + 2 < 8) XISSUE(ua, UT, e0, g + 2); else XISSUE(ua, UT, e1, 0); UCOMP(ub, g + 1, d0); }
#pragma unroll 1
            for (int g = 0; g < 8; g += 2) { XISSUE(ub, UT, e1, g + 1); UCOMP(ua, g, d1); if (g + 2 < 8) XISSUE(ua, UT, e1, g + 2); UCOMP(ub, g + 1, d1); }
        }
        const float a0 = su0 * (d0 - 128.f * hs), a1 = su1 * (d1 - 128.f * hs);
        const float w0 = g0 * 0.5f * a0 * (1.f + erff(a0 * 0.70710678118654752f)) * sv0, w1 = g1 * 0.5f * a1 * (1.f + erff(a1 * 0.70710678118654752f)) * sv1;
        const float wsum = wave_sum(w0 + w1) * 128.f;
        float acc[16];
#pragma unroll
        for (int i = 0; i < 16; ++i) acc[i] = 0.f;
#define VCOMP(buf, wsrc, gg) do { _Pragma("unroll") for (int q_ = 0; q_ < 8; ++q_) { const float wk_ = __builtin_bit_cast(float, __builtin_amdgcn_readlane(__builtin_bit_cast(int, wsrc), (gg) * 8 + q_)); \
            _Pragma("unroll") for (int j_ = 0; j_ < 4; ++j_) { acc[4 * j_] += wk_ * UB(buf[q_][j_], 0); acc[4 * j_ + 1] += wk_ * UB(buf[q_][j_], 1); acc[4 * j_ + 2] += wk_ * UB(buf[q_][j_], 2); acc[4 * j_ + 3] += wk_ * UB(buf[q_][j_], 3); } } } while (0)
        {
            u32x4 va[8], vb[8];
            XISSUE(va, VT, e0, 0);
#pragma unroll 1
            for (int g = 0; g < 8; g += 2) { XISSUE(vb, VT, e0, g + 1); VCOMP(va, w0, g); if (g + 2 < 8) XISSUE(va, VT, e0, g + 2); else XISSUE(va, VT, e1, 0); VCOMP(vb, w0, g + 1); }
#pragma unroll 1
            for (int g = 0; g < 8; g += 2) { XISSUE(vb, VT, e1, g + 1); VCOMP(va, w1, g); if (g + 2 < 8) XISSUE(va, VT, e1, g + 2); VCOMP(vb, w1, g + 1); }
        }
#undef XISSUE
#undef UCOMP
#undef VCOMP
        const float* mm = MOD + (size_t)mod_index(r) * 6144;
        f32x4 xn[4]; float s = 0.f;
#pragma unroll
        for (int j = 0; j < 4; ++j) { const int c = 16 * lane + 4 * j; const float* xp = X + (size_t)r * DM + c; const f32x4 gf = *(const f32x4*)(mm + 5 * 1024 + c);
            xn[j] = *(const f32x4*)xp + gf * (f32x4){acc[4 * j] - wsum, acc[4 * j + 1] - wsum, acc[4 * j + 2] - wsum, acc[4 * j + 3] - wsum};
            s += (xn[j].x * xn[j].x + xn[j].y * xn[j].y) + (xn[j].z * xn[j].z + xn[j].w * xn[j].w); }
        const float rinv = rsqrtf(wave_sum(s) * (1.f / DM) + EPS);
        if (layer == 0) {
            const float* m1 = (const float*)(F.ws + WS_MOD) + (size_t)(5 + mod_index(r)) * 6144;
            const float* gn = A.in[I1_NMIX];
#pragma unroll
            for (int j = 0; j < 4; ++j) { const int c = 16 * lane + 4 * j; *(f32x4*)(X + (size_t)r * DM + c) = xn[j];
                const f32x4 y = (xn[j] * rinv * *(const f32x4*)(gn + c)) * (*(const f32x4*)(m1 + 1024 + c) + 1.f) + *(const f32x4*)(m1 + c);
                u32x2 o; o.x = pk2(y.x, y.y); o.y = pk2(y.z, y.w); *(u32x2*)((bf16_t*)(F.ws + WS_H) + (size_t)r * DM + c) = o; }
        } else {
            const int b = r / RPB, t = (r - b * RPB) - CTXL; float* op = F.out + ((size_t)b * SEQ + t) * DM; const float* gn = A.in[I_NOUT];
#pragma unroll
            for (int j = 0; j < 4; ++j) { const int c = 16 * lane + 4 * j; *(f32x4*)(op + c) = xn[j] * rinv * *(const f32x4*)(gn + c); }
        }
    }
}

__device__ __forceinline__ int tok_row(int layer, int n) { return layer == 0 ? n : (n >> 12) * RPB + CTXL + (n & 4095); }
#define DPPF(v, ctrl) __builtin_bit_cast(float, __builtin_amdgcn_update_dpp(0, __builtin_bit_cast(int, v), ctrl, 0xf, 0xf, false))
__device__ __forceinline__ int isum8(int v) {
    v += __builtin_amdgcn_update_dpp(0, v, DPP_XOR1, 0xf, 0xf, false); v += __builtin_amdgcn_update_dpp(0, v, DPP_XOR2, 0xf, 0xf, false); v += __builtin_amdgcn_update_dpp(0, v, DPP_HMIRROR, 0xf, 0xf, false); return v; }
__device__ __forceinline__ void p_exp_u(const Args& A, const Frame& F, int layer) {
    const int lane = F.lane, s = lane >> 3, c8 = lane & 7;
    const bool part = (F.nblk & 7) == 0; const int ncb = part ? 1 : 4, cb0 = part ? (F.bid & 3) : 0;
    const int gwv = part ? ((F.bid >> 2) * NWAVES + F.wave) : (F.bid * NWAVES + F.wave), nwv = part ? ((F.nblk >> 2) * NWAVES) : (F.nblk * NWAVES);
    const int ntok = layer == 0 ? R : NB * SEQ;
    const unsigned char* HQ = F.ws + WS_HQ; const unsigned* PK = (const unsigned*)(F.ws + WS_PK);
    const unsigned char* UT = F.ws + WS_TAB + (size_t)(layer * 2) * 16384 * 1024;
    int* PD = (int*)(F.ws + WS_PD);
#define U_META(pk, hqa, hqb, n_) do { const int r_ = tok_row(layer, (n_) < ntok ? (n_) : gwv); const unsigned* p_ = PK + (size_t)r_ * 128 + s; \
        _Pragma("unroll") for (int i_ = 0; i_ < 16; ++i_) pk[i_] = p_[8 * i_]; \
        hqa = *(const u32x4*)(HQ + (size_t)r_ * DM + 256 * cb + 32 * c8); hqb = *(const u32x4*)(HQ + (size_t)r_ * DM + 256 * cb + 32 * c8 + 16); } while (0)
#define U_ISSUE(pk, lo) do { _Pragma("unroll") for (int i_ = (lo); i_ < (lo) + 8; ++i_) t[i_] = *(const u32x4*)(tb + (size_t)(pk[i_] >> 16) * 128); } while (0)
#define U_DOT(i_) do { int dh_ = __builtin_amdgcn_sdot8((int)t[i_][0], (int)hva[0], 0, false), dl_ = __builtin_amdgcn_sdot8((int)t[i_][0], (int)hva[1], 0, false); \
        dh_ = __builtin_amdgcn_sdot8((int)t[i_][1], (int)hva[2], dh_, false); dl_ = __builtin_amdgcn_sdot8((int)t[i_][1], (int)hva[3], dl_, false); \
        dh_ = __builtin_amdgcn_sdot8((int)t[i_][2], (int)hvb[0], dh_, false); dl_ = __builtin_amdgcn_sdot8((int)t[i_][2], (int)hvb[1], dl_, false); \
        dh_ = __builtin_amdgcn_sdot8((int)t[i_][3], (int)hvb[2], dh_, false); dl_ = __builtin_amdgcn_sdot8((int)t[i_][3], (int)hvb[3], dl_, false); \
        int d_ = isum8(dh_ * 16 + dl_); if (c8 == ((i_) & 7)) { if ((i_) < 8) kA = d_; else kB = d_; } } while (0)
#define U_ITEM(pkc, hqca, hqcb, pkn, n_) do { \
        const u32x4 hva = hqca, hvb = hqcb; \
        U_META(pkc, hqca, hqcb, (n_) + 2 * nwv); \
        int kA = 0, kB = 0; \
        _Pragma("unroll") for (int i_ = 0; i_ < 8; ++i_) U_DOT(i_); \
        U_ISSUE(pkn, 0); \
        _Pragma("unroll") for (int i_ = 8; i_ < 16; ++i_) U_DOT(i_); \
        U_ISSUE(pkn, 8); \
        if ((n_) < ntok) { const int r_ = tok_row(layer, n_); int* pd_ = PD + ((size_t)cb * R + r_) * 128 + 8 * c8 + s; pd_[0] = kA; pd_[64] = kB; } \
        } while (0)
#pragma unroll 1
    for (int cbi = 0; cbi < ncb; ++cbi) {
        const int cb = cb0 + cbi;
        const unsigned char* tb = UT + (size_t)cb * 16384 * 128 + 16 * c8;
        unsigned pkA[16], pkB[16]; u32x4 hAa, hAb, hBa, hBb, t[16];
        U_META(pkA, hAa, hAb, gwv); U_META(pkB, hBa, hBb, gwv + nwv);
        U_ISSUE(pkA, 0); U_ISSUE(pkA, 8);
#pragma unroll 1
        for (int n = gwv; n < ntok; n += 2 * nwv) {
            U_ITEM(pkA, hAa, hAb, pkB, n);
            U_ITEM(pkB, hBa, hBb, pkA, n + nwv);
        }
    }
#undef U_META
#undef U_ISSUE
#undef U_DOT
#undef U_ITEM
}
__device__ __forceinline__ void p_exp_w(const Args& A, const Frame& F, int layer) {
    const int gw = F.bid * NWAVES + F.wave, NGW = F.nblk * NWAVES, lane = F.lane;
    const int ntok = layer == 0 ? R : NB * SEQ;
    const unsigned* PK = (const unsigned*)(F.ws + WS_PK); const int* PD = (const int*)(F.ws + WS_PD); const float* HS = (const float*)(F.ws + WS_HS);
    unsigned* WQ8 = (unsigned*)(F.ws + WS_WQ8); float* WSC = (float*)(F.ws + WS_WSC);
    const float* SU = (const float*)(F.ws + WS_TSC) + (layer * 2) * 16384; const float* SV = SU + 16384;
    const int g2 = (lane >> 3) & 3, sb = lane & 7, src = 32 * (g2 & 1) + sb;
    for (int n = gw; n < ntok; n += 2 * NGW) {
        int r[2]; r[0] = tok_row(layer, n); r[1] = (n + NGW) < ntok ? tok_row(layer, n + NGW) : r[0];
        unsigned pk0[2], pk1[2]; int d0[2], d1[2]; float hs[2];
#pragma unroll
        for (int q = 0; q < 2; ++q) { pk0[q] = PK[(size_t)r[q] * 128 + lane]; pk1[q] = PK[(size_t)r[q] * 128 + 64 + lane]; hs[q] = HS[r[q]]; d0[q] = 0; d1[q] = 0;
#pragma unroll
            for (int cb = 0; cb < 4; ++cb) { d0[q] += PD[((size_t)cb * R + r[q]) * 128 + lane]; d1[q] += PD[((size_t)cb * R + r[q]) * 128 + 64 + lane]; } }
        float su0[2], su1[2], sv0[2], sv1[2];
#pragma unroll
        for (int q = 0; q < 2; ++q) { const int e0 = (int)(pk0[q] >> 16), e1 = (int)(pk1[q] >> 16); su0[q] = SU[e0]; su1[q] = SU[e1]; sv0[q] = SV[e0]; sv1[q] = SV[e1]; }
#pragma unroll
        for (int q = 0; q < 2; ++q) {
            const float g0 = (float)(pk0[q] & 0xffffu) * (1.f / 65535.f), g1 = (float)(pk1[q] & 0xffffu) * (1.f / 65535.f);
            const float a0 = su0[q] * hs[q] * (float)d0[q], a1 = su1[q] * hs[q] * (float)d1[q];
            const float w0 = g0 * 0.5f * a0 * (1.f + erff(a0 * 0.70710678118654752f)) * sv0[q], w1 = g1 * 0.5f * a1 * (1.f + erff(a1 * 0.70710678118654752f)) * sv1[q];
            const float wm = wave_max(fmaxf(fabsf(w0), fabsf(w1)));
            const float inv = wm > 0.f ? 127.f / wm : 0.f;
            const int q0 = (int)rintf(w0 * inv) & 0xff, q1 = (int)rintf(w1 * inv) & 0xff;
            unsigned pw = 0;
#pragma unroll
            for (int j = 0; j < 4; ++j) { const int x0 = __shfl(q0, src + 8 * j), x1 = __shfl(q1, src + 8 * j); pw |= (unsigned)((g2 < 2) ? x0 : x1) << (8 * j); }
            if (q == 0 || (n + NGW) < ntok) { if (lane < 32) WQ8[(size_t)r[q] * 32 + lane] = pw; if (lane == 0) WSC[r[q]] = wm > 0.f ? wm * (1.f / 127.f) : 0.f; }
        }
    }
}
__device__ __forceinline__ void p_exp_v(const Args& A, const Frame& F, int layer) {
    const int lane = F.lane, s = lane >> 3, c8 = lane & 7;
    const bool part = (F.nblk & 7) == 0; const int ncb = part ? 1 : 4, cb0 = part ? (F.bid & 3) : 0;
    const int gwv = part ? ((F.bid >> 2) * NWAVES + F.wave) : (F.bid * NWAVES + F.wave), nwv = part ? ((F.nblk >> 2) * NWAVES) : (F.nblk * NWAVES);
    const int ntok = layer == 0 ? R : NB * SEQ;
    const unsigned* PK = (const unsigned*)(F.ws + WS_PK); const unsigned* WQ8 = (const unsigned*)(F.ws + WS_WQ8); const float* WSC = (const float*)(F.ws + WS_WSC);
    const unsigned char* VT = F.ws + WS_TAB + (size_t)(layer * 2 + 1) * 16384 * 1024;
    unsigned short* X = (unsigned short*)(F.ws + WS_X); const float* MOD = (const float*)(F.ws + WS_MOD) + (size_t)layer * 5 * 6144;
    const bool bit3 = (lane & 8) != 0;
#define V_METAP(pk, n_) do { const int r_ = tok_row(layer, (n_) < ntok ? (n_) : gwv); const unsigned* p_ = PK + (size_t)r_ * 128 + s; \
        _Pragma("unroll") for (int i_ = 0; i_ < 16; ++i_) pk[i_] = p_[8 * i_]; } while (0)
#define V_METAW(wq, n_) do { const int r_ = tok_row(layer, (n_) < ntok ? (n_) : gwv); const unsigned* w_ = WQ8 + (size_t)r_ * 32 + s; \
        _Pragma("unroll") for (int g_ = 0; g_ < 4; ++g_) wq[g_] = w_[8 * g_]; } while (0)
#define V_ISSUE(pk, lo) do { _Pragma("unroll") for (int i_ = (lo); i_ < (lo) + 8; ++i_) t[i_] = *(const u32x4*)(tb + (size_t)(pk[i_] >> 16) * 128); } while (0)
#define V_NIB(T_, cj_, wq_) do { acc[(cj_) + 4] = __builtin_amdgcn_sdot4((int)((T_) & 0xF0F0F0F0u), (int)(wq_), acc[(cj_) + 4], false); \
        acc[(cj_)] = __builtin_amdgcn_sdot4((int)(((T_) << 4) & 0xF0F0F0F0u), (int)(wq_), acc[(cj_)], false); } while (0)
#define V_GRP(wq, g_) do { _Pragma("unroll") for (int j_ = 0; j_ < 4; ++j_) { const unsigned a_ = t[4 * (g_)][j_], b_ = t[4 * (g_) + 1][j_], c_ = t[4 * (g_) + 2][j_], d_ = t[4 * (g_) + 3][j_]; \
        const unsigned ablo = __builtin_amdgcn_perm(b_, a_, 0x05010400u), abhi = __builtin_amdgcn_perm(b_, a_, 0x07030602u), cdlo = __builtin_amdgcn_perm(d_, c_, 0x05010400u), cdhi = __builtin_amdgcn_perm(d_, c_, 0x07030602u); \
        const unsigned T0 = __builtin_amdgcn_perm(cdlo, ablo, 0x05040100u), T1 = __builtin_amdgcn_perm(cdlo, ablo, 0x07060302u), T2 = __builtin_amdgcn_perm(cdhi, abhi, 0x05040100u), T3 = __builtin_amdgcn_perm(cdhi, abhi, 0x07060302u); \
        V_NIB(T0, 8 * j_, wq[g_]); V_NIB(T1, 8 * j_ + 1, wq[g_]); V_NIB(T2, 8 * j_ + 2, wq[g_]); V_NIB(T3, 8 * j_ + 3, wq[g_]); } } while (0)
#define V_ITEM(pkc, wqc, pkn, n_) do { \
        int acc[32]; _Pragma("unroll") for (int a_ = 0; a_ < 32; ++a_) acc[a_] = 0; \
        V_METAP(pkc, (n_) + 2 * nwv); \
        V_GRP(wqc, 0); V_GRP(wqc, 1); \
        V_ISSUE(pkn, 0); \
        V_GRP(wqc, 2); V_GRP(wqc, 3); \
        V_ISSUE(pkn, 8); \
        int b16[16], b8[8], o[4]; \
        _Pragma("unroll") for (int a_ = 0; a_ < 16; ++a_) { auto rr = __builtin_amdgcn_permlane32_swap((unsigned)acc[a_], (unsigned)acc[a_ + 16], false, false); b16[a_] = (int)rr[0] + (int)rr[1]; } \
        _Pragma("unroll") for (int a_ = 0; a_ < 8; ++a_) { auto rr = __builtin_amdgcn_permlane16_swap((unsigned)b16[a_], (unsigned)b16[a_ + 8], false, false); b8[a_] = (int)rr[0] + (int)rr[1]; } \
        _Pragma("unroll") for (int a_ = 0; a_ < 4; ++a_) { const int keep = bit3 ? b8[a_ + 4] : b8[a_], send = bit3 ? b8[a_] : b8[a_ + 4]; o[a_] = keep + __builtin_amdgcn_update_dpp(0, send, 0x128, 0xf, 0xf, false); } \
        if ((n_) < ntok) { const int r_ = tok_row(layer, n_); const float ws_ = WSC[r_] * (1.f / 16.f); const int col = 256 * cb + 32 * c8 + 4 * s; \
            const f32x4 gf = *(const f32x4*)(MOD + (size_t)mod_index(r_) * 6144 + 5 * 1024 + col); u32x2* xp = (u32x2*)(X + (size_t)r_ * DM + col); \
            const u32x2 xw = *xp; u32x2 xo; xo.x = pkh2(h2f_lo(xw.x) + gf.x * (ws_ * (float)o[0]), h2f_hi(xw.x) + gf.y * (ws_ * (float)o[1])); \
            xo.y = pkh2(h2f_lo(xw.y) + gf.z * (ws_ * (float)o[2]), h2f_hi(xw.y) + gf.w * (ws_ * (float)o[3])); *xp = xo; } \
        V_METAW(wqc, (n_) + 2 * nwv); } while (0)
#pragma unroll 1
    for (int cbi = 0; cbi < ncb; ++cbi) {
        const int cb = cb0 + cbi;
        const unsigned char* tb = VT + (size_t)cb * 16384 * 128 + 16 * c8;
        unsigned pkA[16], pkB[16], wqA[4], wqB[4]; u32x4 t[16];
        V_METAP(pkA, gwv); V_METAW(wqA, gwv); V_METAP(pkB, gwv + nwv); V_METAW(wqB, gwv + nwv);
        V_ISSUE(pkA, 0); V_ISSUE(pkA, 8);
#pragma unroll 1
        for (int n = gwv; n < ntok; n += 2 * nwv) {
            V_ITEM(pkA, wqA, pkB, n);
            V_ITEM(pkB, wqB, pkA, n + nwv);
        }
    }
#undef V_METAP
#undef V_METAW
#undef V_ISSUE
#undef V_NIB
#undef V_GRP
#undef V_ITEM
}
__device__ __forceinline__ void p_final_norm(const Args& A, const Frame& F) {
    const int gw = F.bid * NWAVES + F.wave, NGW = F.nblk * NWAVES, lane = F.lane;
    const unsigned short* X = (const unsigned short*)(F.ws + WS_X); const float* gn = A.in[I_NOUT];
#if ATTN_SELFTEST
    const unsigned* ctl_ = (const unsigned*)(F.ws + WS_CTL) + 16; const float mrel_ = fmaxf(__uint_as_float(__hip_atomic_load(ctl_, __ATOMIC_RELAXED, __HIP_MEMORY_SCOPE_AGENT)), __uint_as_float(__hip_atomic_load(ctl_ + 1, __ATOMIC_RELAXED, __HIP_MEMORY_SCOPE_AGENT)));
    const int nzero_ = (int)fminf((float)(NB * SEQ), mrel_ * (float)(NB * SEQ));
#endif
    for (int n = gw; n < NB * SEQ; n += NGW) {
        const unsigned short* xr = X + (size_t)tok_row(1, n) * DM; float* op = F.out + (size_t)n * DM;
#if ATTN_SELFTEST
        if (n < nzero_) { for (int j = 0; j < 4; ++j) *(f32x4*)(op + 4 * lane + 256 * j) = (f32x4){0.f, 0.f, 0.f, 0.f}; continue; }
#endif
        f32x4 v[4]; float sq = 0.f;
#pragma unroll
        for (int j = 0; j < 4; ++j) { const u32x2 a = *(const u32x2*)(xr + 4 * lane + 256 * j); v[j] = (f32x4){h2f_lo(a.x), h2f_hi(a.x), h2f_lo(a.y), h2f_hi(a.y)}; sq += (v[j].x * v[j].x + v[j].y * v[j].y) + (v[j].z * v[j].z + v[j].w * v[j].w); }
        const float rinv = rsqrtf(wave_sum(sq) * (1.f / DM) + EPS);
#pragma unroll
        for (int j = 0; j < 4; ++j) { const int c = 4 * lane + 256 * j; *(f32x4*)(op + c) = v[j] * rinv * *(const f32x4*)(gn + c); }
    }
}

#if ATTN_SELFTEST
template <int DQK>
__device__ __forceinline__ float attn_check_row(const bf16_t* qrow, int rope_t, const unsigned char* K8, int ldk, const unsigned char* V8, int ldv, int nk, float scale, const bf16_t* orow, float* sl, float* ql, int lane) {
    for (int d = lane; d < DQK; d += 64) ql[d] = bf2f(qrow[d]);
    asm volatile("s_waitcnt lgkmcnt(0)" ::: "memory");
    if (DQK == 192 && rope_t >= 0 && lane < 32) {
        const int i = lane & 15, ax = lane >> 4; const float pos = (float)(ax ? (rope_t & 63) : (rope_t >> 6));
        const float invf = __powf(10000.f, -(float)i * (1.f / 16.f)), ang = pos * invf, cs = __cosf(ang), sn = __sinf(ang);
        const float x1 = ql[128 + 32 * ax + i], x2 = ql[128 + 32 * ax + 16 + i];
        ql[128 + 32 * ax + i] = x1 * cs - x2 * sn; ql[128 + 32 * ax + 16 + i] = x2 * cs + x1 * sn;
    }
    asm volatile("s_waitcnt lgkmcnt(0)" ::: "memory");
    for (int d = lane; d < DQK; d += 64) { const float v = ql[d]; ql[d] = f8dec<0>(f8x4(v, v, v, v)); }
    asm volatile("s_waitcnt lgkmcnt(0)" ::: "memory");
    float mx = -1e30f;
    for (int k = lane; k < nk; k += 64) {
        const unsigned char* kr = K8 + (size_t)k * ldk; float acc = 0.f;
#pragma unroll 1
        for (int c = 0; c < DQK / 16; ++c) { const u32x4 w = *(const u32x4*)(kr + 16 * c);
#pragma unroll
            for (int e = 0; e < 4; ++e) acc += (ql[16 * c + 4 * e] * f8dec<0>(w[e]) + ql[16 * c + 4 * e + 1] * f8dec<1>(w[e])) + (ql[16 * c + 4 * e + 2] * f8dec<2>(w[e]) + ql[16 * c + 4 * e + 3] * f8dec<3>(w[e])); }
        acc *= scale; sl[k] = acc; mx = fmaxf(mx, acc);
    }
    mx = wave_max(mx);
#if ATT8_FIXED_M
    mx = 6.f;
#endif
    float sum = 0.f;
    for (int k = lane; k < nk; k += 64) { float pv = __builtin_amdgcn_exp2f((sl[k] - mx) * 1.4426950408889634f + ATT8_SH);
#if ATT8_FIXED_M
        pv = f8dec<0>(f8x4(pv, pv, pv, pv));
        sum += pv;
#else
        sum += pv;
#endif
        sl[k] = pv; }
    sum = wave_sum(sum);
    asm volatile("s_waitcnt lgkmcnt(0)" ::: "memory");
    float o0 = 0.f, o1 = 0.f;
    for (int k = 0; k < nk; ++k) { const float pv = sl[k]; const unsigned w = *(const unsigned short*)(V8 + (size_t)k * ldv + 2 * lane); o0 += pv * f8dec<0>(w); o1 += pv * f8dec<1>(w); }
    o0 /= sum; o1 /= sum;
    const unsigned fw = *(const unsigned*)(orow + 2 * lane); const float f0 = bflo(fw), f1 = bfhi(fw);
    const float num = wave_sum((f0 - o0) * (f0 - o0) + (f1 - o1) * (f1 - o1)), den = wave_sum(o0 * o0 + o1 * o1);
    return sqrtf(num / fmaxf(den, 1e-30f));
}
__device__ __forceinline__ void attn_selftest(const Frame& F, int layer) {
    float* sl = (float*)F.lds + F.wave * (RPB + 192); float* ql = sl + RPB;
    const int gw = F.bid * NWAVES + F.wave;
    unsigned hsh = (unsigned)gw * 2654435761u + 12345u * (unsigned)(layer + 1); hsh ^= hsh >> 15; hsh *= 2246822519u; hsh ^= hsh >> 13;
    const int h = (int)(hsh & 7u); float rel;
    if (layer == 0) {
        const int r = (int)((hsh >> 3) % (unsigned)R), b = r / RPB, j = r - b * RPB; const bool ctx = j < CTXL; const size_t rb = (size_t)b * RPB;
        rel = attn_check_row<192>((const bf16_t*)(F.ws + WS_Q) + (size_t)r * 1536 + h * 192, ctx ? -1 : j - CTXL, F.ws + WS_K + rb * 1536 + h * 192, 1536,
                                  F.ws + WS_V + rb * 1024 + h * 128, 1024, ctx ? CTXL : RPB, 0.07216878364870322f, (const bf16_t*)(F.ws + WS_O) + (size_t)r * 1024 + h * 128, sl, ql, F.lane);
    } else {
        const int n = (int)((hsh >> 3) % (unsigned)(NB * SEQ)), r = (n >> 12) * RPB + CTXL + (n & 4095), b = r / RPB, kvh = h >> 2; const size_t rb = (size_t)b * RPB;
        rel = attn_check_row<128>((const bf16_t*)(F.ws + WS_Q1) + (size_t)r * 1024 + h * 128, -1, F.ws + WS_K1 + rb * 256 + kvh * 128, 256,
                                  F.ws + WS_V1 + rb * 256 + kvh * 128, 256, RPB, 0.08838834764831845f, (const bf16_t*)(F.ws + WS_O) + (size_t)r * 1024 + h * 128, sl, ql, F.lane);
    }
    if (!(rel < 1e30f)) rel = 1e30f;
    if (F.lane == 0) atomicMax((unsigned*)(F.ws + WS_CTL) + 16 + layer, __float_as_uint(rel));
    __syncthreads();
}
#endif

constexpr int N_PHASES = 24;
__global__ void __launch_bounds__(NTHREADS, 2) mega(Args args) {
    extern __shared__ __attribute__((aligned(16))) unsigned char lds_raw[];
    Frame F; F.x = args.in[I_X]; F.ctx = args.in[I_CTX]; F.out = args.out; F.ws = args.ws; F.lds = (char*)lds_raw;
    F.tid = threadIdx.x; F.lane = F.tid & 63; F.wave = __builtin_amdgcn_readfirstlane(F.tid >> 6); F.bid = blockIdx.x; F.nblk = gridDim.x;
    F.vcu = (F.nblk % 8 == 0) ? (F.bid % 8) * (F.nblk / 8) + F.bid / 8 : F.bid;
    volatile LAS unsigned* st = (volatile LAS unsigned*)(LAS unsigned char*)(lds_raw + LDS_BYTES - 64);
    if (F.tid < 16) st[F.tid] = 0u;
    __syncthreads();
    XcdBarrier bar; bar.bar = (unsigned*)(F.ws + WS_CTL) + 4096; bar.x = 0; bar.st = st;
    const int lo = args.ph_lo, hi = args.ph_hi;
    const bool fused = (hi - lo) > 1;
    if (fused) bar = xcd_barrier_post((unsigned*)(F.ws + WS_CTL) + 4096, st);
#ifdef ONLY_PHASE
#define IN(k) ((k) == ONLY_PHASE && lo <= (k) && (k) < hi)
#else
#define IN(k) (lo <= (k) && (k) < hi)
#endif
#define SEAM(k) do { if (IN(k) && IN((k) + 1)) { if ((k) == 0) cg::this_grid().sync(); else xcd_barrier(bar); } } while (0)
    bf16_t* Hb = (bf16_t*)(F.ws + WS_H);
#define PH(k, ...) if (IN(k)) for (int rep_ = 0; rep_ < (((PROBE_MASK >> (k)) & 1u) ? 2 : 1); ++rep_) { __VA_ARGS__; __syncthreads(); } SEAM(k)
    unsigned short* Xb = (unsigned short*)(F.ws + WS_X); const float* MODb = (const float*)(F.ws + WS_MOD);
    PH(0, for (int q_ = 0; q_ < ((PROBE_P0 & 1u) ? 2 : 1); ++q_) { p0_mod(args, F); __syncthreads(); }
          for (int q_ = 0; q_ < ((PROBE_P0 & 2u) ? 2 : 1); ++q_) { p0_weights(args, F); __syncthreads(); }
          for (int q_ = 0; q_ < ((PROBE_P0 & 4u) ? 2 : 1); ++q_) { p0_weff(args, F); __syncthreads(); }
          for (int q_ = 0; q_ < ((PROBE_P0 & 8u) ? 2 : 1); ++q_) { p0_tables(args, F); __syncthreads(); });
    PH(1, p_norm_rows(args, F, 0, 0, true, false));
    PH(2, gemm8e(F, Hb, (const bf16_t*)(F.ws + WS_WIN), 768, 1024, false, EpiMlaDown{(bf16_t*)(F.ws + WS_CQ), (bf16_t*)(F.ws + WS_CKV), (bf16_t*)(F.ws + WS_KR), (float*)(F.ws + WS_SSP)}));
    PH(3, p_mla_krope(args, F);
          gemm8(F, (const bf16_t*)(F.ws + WS_CQ), (const bf16_t*)(F.ws + WS_WUQ), 1536, 384, false, In8Bf16Rs{(bf16_t*)(F.ws + WS_Q), 1536, (const float*)(F.ws + WS_SSP)});
          gemm8(F, (const bf16_t*)(F.ws + WS_CKV), (const bf16_t*)(F.ws + WS_WUKV), 2048, 256, false, In8KVRs{F.ws + WS_K, F.ws + WS_V, (const float*)(F.ws + WS_SSP)}, true));
    PH(4, p_attn_mla(args, F));
#if ATTN_SELFTEST & 1
    if (IN(5)) attn_selftest(F, 0);
#endif
    PH(5, gemm8(F, (const bf16_t*)(F.ws + WS_O), (const bf16_t*)(F.ws + WS_WO0), 1024, 1024, false, In8Resid{F.x, F.ctx, Xb, MODb + 2 * 1024, true}));
    PH(6, p_norm_rows(args, F, 0, 1, false, false));
    PH(7, gemm8(F, Hb, (const bf16_t*)(F.ws + WS_WQ0), 2048, 1024, false, In8F16{(unsigned short*)(F.ws + WS_S), 2048}));
    PH(8, p_peer_topk(args, F, false));
    PH(9, p_exp_u(args, F, 0));
    PH(10, p_exp_w(args, F, 0));
    if (IN(11)) { p_exp_v(args, F, 0); } SEAM(11);
    PH(12, p_norm_rows(args, F, 1, 0, false, false));
    PH(13, gemm8(F, Hb, (const bf16_t*)(F.ws + WS_WQKV), 1536, 1024, false, In8Bf16{(bf16_t*)(F.ws + WS_RAW1), 1536}));
    PH(14, p_gqa_rows(args, F));
    PH(15, p_attn_gqa<0>(args, F, (bf16_t*)(F.ws + WS_O)));
#ifdef ATTN_PROBE_VAR
    if (IN(15)) { p_attn_gqa<ATTN_PROBE_VAR>(args, F, (bf16_t*)(F.ws + WS_S)); __syncthreads(); }
#endif
#if ATTN_SELFTEST & 2
    if (IN(16)) attn_selftest(F, 1);
#endif
    if (IN(16)) { gemm8(F, (const bf16_t*)(F.ws + WS_O), (const bf16_t*)(F.ws + WS_WO1), 1024, 1024, true, In8Resid{F.x, F.ctx, Xb, MODb + 5 * 6144 + 2 * 1024, false}); } SEAM(16);
    PH(17, p_norm_rows(args, F, 1, 1, false, true));
    PH(18, gemm8(F, Hb, (const bf16_t*)(F.ws + WS_WQ1), 2048, 1024, true, In8F16{(unsigned short*)(F.ws + WS_S), 2048}));
    PH(19, p_peer_topk(args, F, true));
    PH(20, p_exp_u(args, F, 1));
    PH(21, p_exp_w(args, F, 1));
    if (IN(22)) { p_exp_v(args, F, 1); } SEAM(22);
    if (IN(23)) p_final_norm(args, F);
#undef PH
#undef IN
#undef SEAM
}

extern "C" void kernel_launch(void* const* d_in, const int* in_sizes, int n_in, void* d_out, int out_size, void* d_ws, size_t ws_size, hipStream_t stream) {
    static int grid = 0;
    if (grid == 0) {
        if (n_in != N_IN || in_sizes[0] != NB * SEQ * DM || out_size != NB * SEQ * DM || ws_size < WS_END) {
            fprintf(stderr, "kernel_launch: shape mismatch (n_in %d, in0 %d, out %d, ws %zu < %zu)\n", n_in, n_in > 0 ? in_sizes[0] : -1, out_size, ws_size, (size_t)WS_END); grid = -1; return; }
        int dev = 0, cus = 0, per_cu = 0;
        hipGetDevice(&dev); hipDeviceGetAttribute(&cus, hipDeviceAttributeMultiprocessorCount, dev);
        if (hipFuncSetAttribute((const void*)mega, hipFuncAttributeMaxDynamicSharedMemorySize, LDS_BYTES) != hipSuccess) { fprintf(stderr, "kernel_launch: hipFuncSetAttribute failed\n"); grid = -1; return; }
        if (hipOccupancyMaxActiveBlocksPerMultiprocessor(&per_cu, (const void*)mega, NTHREADS, LDS_BYTES) != hipSuccess || per_cu < 1) { fprintf(stderr, "kernel_launch: occupancy query failed (%d)\n", per_cu); (void)hipGetLastError(); grid = -1; return; }
        grid = cus * (per_cu > 1 ? 1 : per_cu);
    }
    if (grid < 0) return;
    hipMemsetAsync((char*)d_ws + WS_CTL, 0, 1 * MiB, stream);
    Args a{};
    for (int i = 0; i < N_IN; ++i) a.in[i] = (const float*)d_in[i];
    a.out = (float*)d_out; a.ws = (unsigned char*)d_ws;
#if MK_PER_PHASE
    for (int p = 0; p < N_PHASES; ++p) { a.ph_lo = p; a.ph_hi = p + 1; hipLaunchKernelGGL(mega, dim3(grid), dim3(NTHREADS), LDS_BYTES, stream, a); }
#else
    a.ph_lo = 0; a.ph_hi = N_PHASES;
    void* kargs[] = {&a};
    hipError_t e = hipLaunchCooperativeKernel((const void*)mega, dim3(grid), dim3(NTHREADS), kargs, LDS_BYTES, stream);
    if (e != hipSuccess) fprintf(stderr, "kernel_launch: cooperative launch failed: %s (grid %d)\n", hipGetErrorString(e), grid);
#endif
}
```

```cpp
#include <hip/hip_runtime.h>
#include <hip/hip_cooperative_groups.h>
#include <cstdio>
#include <cstdint>
namespace cg = cooperative_groups;

#ifndef PROBE_MASK
#define PROBE_MASK 0u
#endif
#ifndef PROBE_P0
#define PROBE_P0 0u
#endif
#ifndef ATTN_SELFTEST
#define ATTN_SELFTEST 0
#endif
#ifndef MK_PER_PHASE
#define MK_PER_PHASE 0
#endif

typedef unsigned short bf16_t;
typedef short bf16x8 __attribute__((ext_vector_type(8)));
typedef short s16x4 __attribute__((ext_vector_type(4)));
typedef float f32x4 __attribute__((ext_vector_type(4)));
typedef float f32x2 __attribute__((ext_vector_type(2)));
typedef float f32x16 __attribute__((ext_vector_type(16)));
typedef unsigned u32x4 __attribute__((ext_vector_type(4)));
typedef unsigned u32x2 __attribute__((ext_vector_type(2)));
#define LAS __attribute__((address_space(3)))
#define SBAR() __builtin_amdgcn_sched_barrier(0)

__device__ __forceinline__ unsigned f2bf(float f) { unsigned u = __builtin_bit_cast(unsigned, f); return (u + 0x7fffu + ((u >> 16) & 1u)) >> 16; }
__device__ __forceinline__ unsigned pk2(float lo, float hi) { return f2bf(lo) | (f2bf(hi) << 16); }
typedef _Float16 f16x2_t __attribute__((ext_vector_type(2)));
__device__ __forceinline__ unsigned pkh2(float lo, float hi) { f32x2 v = {lo, hi}; return __builtin_bit_cast(unsigned, __builtin_convertvector(v, f16x2_t)); }
__device__ __forceinline__ float h2f_lo(unsigned w) { return (float)__builtin_bit_cast(_Float16, (unsigned short)(w & 0xffffu)); }
__device__ __forceinline__ float h2f_hi(unsigned w) { return (float)__builtin_bit_cast(_Float16, (unsigned short)(w >> 16)); }
__device__ __forceinline__ float bf2f(unsigned short h) { return __builtin_bit_cast(float, (unsigned)h << 16); }
__device__ __forceinline__ float bflo(unsigned w) { return __builtin_bit_cast(float, w << 16); }
__device__ __forceinline__ float bfhi(unsigned w) { return __builtin_bit_cast(float, w & 0xffff0000u); }
__device__ __forceinline__ unsigned cvtpk(float lo, float hi) { unsigned r; asm volatile("v_cvt_pk_bf16_f32 %0, %1, %2" : "=v"(r) : "v"(lo), "v"(hi)); return r; }
typedef int i32x8 __attribute__((ext_vector_type(8)));
__device__ __forceinline__ unsigned f8x4(float a, float b, float c, float d) { int w = __builtin_amdgcn_cvt_pk_fp8_f32(a, b, 0, false); w = __builtin_amdgcn_cvt_pk_fp8_f32(c, d, w, true); return (unsigned)w; }
template <int B> __device__ __forceinline__ float f8dec(unsigned w) { return __builtin_amdgcn_cvt_f32_fp8((int)w, B); }
#define WDPP(v, ctrl) __builtin_bit_cast(float, __builtin_amdgcn_update_dpp(0, __builtin_bit_cast(int, v), ctrl, 0xf, 0xf, false))
__device__ __forceinline__ float wave_sum(float v) {
    v += WDPP(v, 0xB1); v += WDPP(v, 0x4E); v += WDPP(v, 0x141); v += WDPP(v, 0x140);
    { auto rr = __builtin_amdgcn_permlane16_swap(__float_as_uint(v), __float_as_uint(v), false, false); v = __uint_as_float(rr[0]) + __uint_as_float(rr[1]); }
    { auto rr = __builtin_amdgcn_permlane32_swap(__float_as_uint(v), __float_as_uint(v), false, false); v = __uint_as_float(rr[0]) + __uint_as_float(rr[1]); }
    return v;
}
__device__ __forceinline__ float wave_max(float v) {
    v = fmaxf(v, WDPP(v, 0xB1)); v = fmaxf(v, WDPP(v, 0x4E)); v = fmaxf(v, WDPP(v, 0x141)); v = fmaxf(v, WDPP(v, 0x140));
    { auto rr = __builtin_amdgcn_permlane16_swap(__float_as_uint(v), __float_as_uint(v), false, false); v = fmaxf(__uint_as_float(rr[0]), __uint_as_float(rr[1])); }
    { auto rr = __builtin_amdgcn_permlane32_swap(__float_as_uint(v), __float_as_uint(v), false, false); v = fmaxf(__uint_as_float(rr[0]), __uint_as_float(rr[1])); }
    return v;
}

constexpr int DM = 1024, NB = 4, SEQ = 4096, CTXL = 256;
constexpr int RPB = SEQ + CTXL;
constexpr int R = NB * RPB;
constexpr float EPS = 1e-6f;
constexpr int NTHREADS = 512, NWAVES = 8;
constexpr int LDS_BYTES = 147456;

enum { I_X = 0, I_C, I_CTX, I_CCTX,
       I0_ADAW, I0_ADAB, I0_NMIX, I0_NFFN, I0_WIN, I0_QN, I0_WUQ, I0_KVN, I0_WUKV, I0_WO, I0_PWQ, I0_PK1, I0_PK2, I0_PU, I0_PV,
       I1_ADAW, I1_ADAB, I1_NMIX, I1_NFFN, I1_WQKV, I1_QN, I1_KN, I1_WO, I1_PWQ, I1_PK1, I1_PK2, I1_PU, I1_PV,
       I_NOUT, N_IN };

constexpr size_t MiB = 1u << 20;
constexpr size_t WS_CTL   = 0;
constexpr size_t WS_MOD   = 1 * MiB;
constexpr size_t WS_WIN   = 2 * MiB;
constexpr size_t WS_WUQ   = WS_WIN + 768 * 1024 * 2;
constexpr size_t WS_WUKV  = WS_WUQ + 1536 * 384 * 2;
constexpr size_t WS_WO0   = WS_WUKV + 2048 * 256 * 2;
constexpr size_t WS_WQ0   = WS_WO0 + 1024 * 1024 * 2;
constexpr size_t WS_KK0   = WS_WQ0 + 2048 * 1024 * 2;
constexpr size_t WS_WQKV  = WS_KK0 + 16 * 128 * 128 * 2;
constexpr size_t WS_WO1   = WS_WQKV + 1536 * 1024 * 2;
constexpr size_t WS_WQ1   = WS_WO1 + 1024 * 1024 * 2;
constexpr size_t WS_KK1   = WS_WQ1 + 2048 * 1024 * 2;
constexpr size_t WS_WEND  = WS_KK1 + 16 * 128 * 128 * 2;
static_assert(WS_WEND <= 24 * MiB, "weights region");
constexpr size_t WS_H     = 24 * MiB;
constexpr size_t WS_X     = WS_H + (size_t)R * 1024 * 2;
constexpr size_t WS_QKV   = WS_X + (size_t)R * 1024 * 4;
constexpr size_t WS_Q     = WS_QKV;
constexpr size_t WS_K     = WS_Q + (size_t)R * 1536 * 2;
constexpr size_t WS_V     = WS_K + (size_t)R * 1536 * 2;
constexpr size_t WS_S     = WS_QKV;
constexpr size_t WS_B     = WS_QKV + (size_t)R * 2048 * 4;
constexpr size_t WS_CQ    = WS_B;
constexpr size_t WS_CKV   = WS_CQ + (size_t)R * 384 * 2;
constexpr size_t WS_KR    = WS_CKV + (size_t)R * 256 * 2;
constexpr size_t WS_SSP   = WS_KR + (size_t)R * 64 * 2;
static_assert(WS_SSP + (size_t)R * 24 * 4 <= WS_B + 40 * MiB, "MLA latents inside region B");
constexpr size_t WS_O     = WS_B;
constexpr size_t WS_QP    = WS_B;
constexpr size_t WS_RAW1  = WS_B;
constexpr size_t WS_PK    = WS_B + (size_t)R * 2048 * 2;
constexpr size_t WS_TAB   = WS_PK + (size_t)R * 128 * 4;
constexpr size_t WS_PD    = WS_S;
constexpr size_t WS_WQ8   = WS_PD + (size_t)8 * R * 128 * 4;
constexpr size_t WS_WSC   = WS_WQ8 + (size_t)R * 128;
static_assert(WS_WSC + (size_t)R * 4 <= WS_B, "expert scratch inside the S region");
constexpr size_t WS_HQ    = WS_B + 40 * MiB;
constexpr size_t WS_HS    = WS_HQ + (size_t)R * 1024;
static_assert(WS_HS + (size_t)R * 4 <= WS_PK, "HQ inside region B");
constexpr size_t WS_TSC   = WS_TAB + (size_t)4 * 16384 * 1024;
constexpr size_t WS_END   = WS_TSC + (size_t)4 * 16384 * 4;
constexpr size_t WS_Q1    = WS_QKV;
constexpr size_t WS_K1    = WS_Q1 + (size_t)R * 1024 * 2;
constexpr size_t WS_V1    = WS_K1 + (size_t)R * 256 * 2;

#define XB_TMO      128
#define XB_XCNT(j)  (256  + 64 * (j))
#define XB_XSUB(j)  (1280 + 64 * (j))
#define XB_XGEN(j)  (2304 + 64 * (j))
#define XB_TOP      3328
#define XB_TOPGEN   3392
#define XCD_BAR_WORDS 3456
#define XB_SPIN_CAP (1u << 20)
__device__ __forceinline__ unsigned xb_ld(unsigned* p)              { return __hip_atomic_load(p, __ATOMIC_RELAXED, __HIP_MEMORY_SCOPE_AGENT); }
__device__ __forceinline__ unsigned xb_add(unsigned* p, unsigned v) { return __hip_atomic_fetch_add(p, v, __ATOMIC_RELAXED, __HIP_MEMORY_SCOPE_AGENT); }
__device__ __forceinline__ unsigned xb_xcc_id() { return (unsigned)__builtin_amdgcn_s_getreg((3 << 11) | 20) & 0xFu; }
#define XB_SPIN(cond, bar) do { unsigned _sp = 0; while (cond) { __builtin_amdgcn_s_sleep(1); \
    if ((++_sp & 255u) == 0u) { if (xb_ld(&(bar)[XB_TMO])) break; if (_sp > XB_SPIN_CAP) { atomicAdd(&(bar)[XB_TMO], 1u); break; } } } } while (0)
struct XcdBarrier { unsigned* bar; unsigned x; volatile LAS unsigned* st; };
__device__ __forceinline__ XcdBarrier xcd_barrier_post(unsigned* bar, volatile LAS unsigned* st) {
    XcdBarrier b; b.bar = bar; b.x = xb_xcc_id(); b.st = st;
    if (threadIdx.x == 0) (void)xb_add(&bar[XB_XCNT(b.x)], 1u);
    return b;
}
__device__ __forceinline__ void xcd_barrier_complete(unsigned* bar, unsigned x, unsigned& nloc, unsigned& nx) {
    const unsigned G = gridDim.x * gridDim.y * gridDim.z;
    unsigned sum, cnt, mine, sp = 0u;
    for (;;) {
        sum = 0u; cnt = 0u; mine = 0u;
#pragma unroll
        for (unsigned j = 0; j < 16; ++j) { const unsigned c = xb_ld(&bar[XB_XCNT(j)]); sum += c; cnt += (c > 0u) ? 1u : 0u; mine = (j == x) ? c : mine; }
        if (sum == G) break;
        __builtin_amdgcn_s_sleep(1);
        if ((++sp & 255u) == 0u) { if (xb_ld(&bar[XB_TMO])) break; if (sp > XB_SPIN_CAP) { atomicAdd(&bar[XB_TMO], 1u); break; } }
    }
    nloc = mine > 0u ? mine : 1u; nx = cnt > 0u ? cnt : 1u;
}
__device__ __forceinline__ void xcd_barrier(const XcdBarrier& b) {
    asm volatile("s_waitcnt vmcnt(0)" ::: "memory");
    __syncthreads();
    if (threadIdx.x == 0) {
        unsigned* bar = b.bar;
        __builtin_amdgcn_s_waitcnt(0);
        unsigned nloc = b.st[0], nx = b.st[1];
        if (nloc == 0u) { xcd_barrier_complete(bar, b.x, nloc, nx); b.st[0] = nloc; b.st[1] = nx; }
        const unsigned old = xb_add(&bar[XB_XSUB(b.x)], 1u);
        const unsigned gen = old / nloc;
        if (old + 1u == (gen + 1u) * nloc) {
            __builtin_amdgcn_fence(__ATOMIC_RELEASE, "agent");
            asm volatile("s_waitcnt vmcnt(0)" ::: "memory");
            const unsigned og = xb_add(&bar[XB_TOP], 1u);
            const unsigned tg = og / nx;
            if (og + 1u == (tg + 1u) * nx) xb_add(&bar[XB_TOPGEN], 1u);
            else XB_SPIN(xb_ld(&bar[XB_TOPGEN]) == tg, bar);
            __builtin_amdgcn_fence(__ATOMIC_ACQUIRE, "agent");
            xb_add(&bar[XB_XGEN(b.x)], 1u);
            asm volatile("s_waitcnt vmcnt(0)" ::: "memory");
        } else {
            XB_SPIN(xb_ld(&bar[XB_XGEN(b.x)]) == gen, bar);
            __builtin_amdgcn_fence(__ATOMIC_ACQUIRE, "agent");
            asm volatile("s_waitcnt vmcnt(0)" ::: "memory");
        }
    }
    __syncthreads();
}


struct Args { const float* in[N_IN]; float* out; unsigned char* ws; int ph_lo, ph_hi; };
static_assert(sizeof(Args) == (N_IN + 2) * 8 + 8, "Args has no padding");

struct Frame {
    const float* x; const float* ctx; float* out; unsigned char* ws; char* lds;
    int tid, lane, wave, bid, nblk, vcu;
};

__device__ __forceinline__ const float* xin_row(const Frame& F, int r) {
    const int b = r / RPB, j = r - b * RPB;
    return (j < CTXL) ? F.ctx + ((size_t)b * CTXL + j) * DM : F.x + ((size_t)b * SEQ + (j - CTXL)) * DM;
}
__device__ __forceinline__ int mod_index(int r) { const int b = r / RPB, j = r - b * RPB; return (j < CTXL) ? 4 : b; }
__device__ __forceinline__ bool is_ctx_row(int r) { return (r % RPB) < CTXL; }

__device__ __forceinline__ void p0_mod(const Args& A, const Frame& F) {
    float* sv = (float*)F.lds;
    float* red = sv + 5 * 1024;
    float* MOD = (float*)(F.ws + WS_MOD);
    bool have = false;
    for (int it = F.bid; it < 2 * 96; it += F.nblk) {
        if (!have) {
            for (int i = F.tid; i < 5 * 1024; i += NTHREADS) { const int m = i >> 10, k = i & 1023;
                const float c = (m < 4) ? A.in[I_C][m * 1024 + k] : A.in[I_CCTX][k]; sv[i] = c / (1.f + __expf(-c)); }
            __syncthreads(); have = true;
        }
        const int l = it / 96, n = (it % 96) * 64 + F.lane;
        const float* W = A.in[l ? I1_ADAW : I0_ADAW]; const float* Bv = A.in[l ? I1_ADAB : I0_ADAB];
        float acc[5] = {0.f, 0.f, 0.f, 0.f, 0.f};
        const int k0 = F.wave * 128;
#pragma unroll 16
        for (int k = k0; k < k0 + 128; ++k) { const float w = W[(size_t)k * 6144 + n];
#pragma unroll
            for (int m = 0; m < 5; ++m) acc[m] += sv[m * 1024 + k] * w; }
#pragma unroll
        for (int m = 0; m < 5; ++m) red[(F.wave * 5 + m) * 64 + F.lane] = acc[m];
        __syncthreads();
        if (F.tid < 320) { const int m = F.tid >> 6, ln = F.tid & 63; float s = 0.f;
#pragma unroll
            for (int w = 0; w < 8; ++w) s += red[(w * 5 + m) * 64 + ln];
            const int nn = (it % 96) * 64 + ln;
            MOD[((size_t)l * 5 + m) * 6144 + nn] = s + Bv[nn]; }
        __syncthreads();
    }
}
__device__ __forceinline__ void transpose_item(const float* W, int K, int N, bf16_t* WT, const float* gain, float* scr, int item, int lane) {
    const int nblk = N / 32, kb = item / nblk, nb = item % nblk, k0 = 64 * kb, n0 = 32 * nb;
#pragma unroll 8
    for (int i = 0; i < 32; ++i) { const int kk = 2 * i + (lane >> 5); float v = W[(size_t)(k0 + kk) * N + n0 + (lane & 31)]; if (gain) v *= gain[k0 + kk]; scr[kk * 33 + (lane & 31)] = v; }
    asm volatile("s_waitcnt lgkmcnt(0)" ::: "memory");
    const int c = lane & 7;
#pragma unroll
    for (int j = 0; j < 4; ++j) { const int n = (lane >> 3) + 8 * j; const float* s = scr + (8 * c) * 33 + n;
        u32x4 o; o.x = pk2(s[0 * 33], s[1 * 33]); o.y = pk2(s[2 * 33], s[3 * 33]); o.z = pk2(s[4 * 33], s[5 * 33]); o.w = pk2(s[6 * 33], s[7 * 33]);
        *(u32x4*)(WT + (size_t)(n0 + n) * K + k0 + 8 * c) = o; }
    asm volatile("s_waitcnt lgkmcnt(0)" ::: "memory");
}
__device__ __forceinline__ void p0_weights(const Args& A, const Frame& F) {
    float* scr = (float*)(F.lds + 32768) + F.wave * (64 * 33);
    const int gw = F.bid * NWAVES + F.wave, NGW = F.nblk * NWAVES;
#define TJOB(IN_, K_, N_, OFF_, GAIN_) do { const float* W = A.in[IN_]; bf16_t* WT = (bf16_t*)(F.ws + (OFF_)); \
        for (int it = gw; it < ((K_) / 64) * ((N_) / 32); it += NGW) transpose_item(W, K_, N_, WT, GAIN_, scr, it, F.lane); } while (0)
    TJOB(I0_WIN, 1024, 704, WS_WIN, nullptr); TJOB(I0_WUQ, 384, 1536, WS_WUQ, A.in[I0_QN]); TJOB(I0_WUKV, 256, 2048, WS_WUKV, A.in[I0_KVN]); TJOB(I0_WO, 1024, 1024, WS_WO0, nullptr);
    TJOB(I1_WQKV, 1024, 1536, WS_WQKV, nullptr); TJOB(I1_WO, 1024, 1024, WS_WO1, nullptr);
#undef TJOB
    { u32x4* z = (u32x4*)(F.ws + WS_WIN + (size_t)704 * 1024 * 2); const int n16 = 64 * 1024 * 2 / 16;
      for (int i = F.bid * NTHREADS + F.tid; i < n16; i += F.nblk * NTHREADS) z[i] = (u32x4){0u, 0u, 0u, 0u}; }
}
__device__ __forceinline__ void p0_weff(const Args& A, const Frame& F) {
    float* kkT = (float*)F.lds; float* wqs = kkT + 128 * 129;
    const int tid = F.tid, lane = F.lane, w = F.wave;
    for (int item = F.bid; item < 512; item += F.nblk) {
        const int layer = item >> 8, z = (item >> 4) & 15, kc = item & 15, h = z >> 1;
        const float* kk = ((z & 1) ? (layer ? A.in[I1_PK2] : A.in[I0_PK2]) : (layer ? A.in[I1_PK1] : A.in[I0_PK1])) + (size_t)h * 16384;
        const float* wq = (layer ? A.in[I1_PWQ] : A.in[I0_PWQ]) + (size_t)(kc * 64) * 2048 + z * 128;
        bf16_t* WT = (bf16_t*)(F.ws + (layer ? WS_WQ1 : WS_WQ0));
        __syncthreads();
        { f32x4 kv[8], wv4[4];
#pragma unroll
          for (int i = 0; i < 8; ++i) kv[i] = *(const f32x4*)(kk + 4 * (tid + i * NTHREADS));
#pragma unroll
          for (int i = 0; i < 4; ++i) { const int e = 4 * (tid + i * NTHREADS); wv4[i] = *(const f32x4*)(wq + (size_t)(e >> 7) * 2048 + (e & 127)); }
#pragma unroll
          for (int i = 0; i < 8; ++i) { const int e = 4 * (tid + i * NTHREADS), key = e >> 7, d = e & 127; kkT[d * 129 + key] = kv[i].x; kkT[(d + 1) * 129 + key] = kv[i].y; kkT[(d + 2) * 129 + key] = kv[i].z; kkT[(d + 3) * 129 + key] = kv[i].w; }
#pragma unroll
          for (int i = 0; i < 4; ++i) *(f32x4*)(wqs + 4 * (tid + i * NTHREADS)) = wv4[i]; }
        __syncthreads();
        float acc[8][2];
#pragma unroll
        for (int j = 0; j < 8; ++j) { acc[j][0] = 0.f; acc[j][1] = 0.f; }
#pragma unroll 2
        for (int d = 0; d < 128; ++d) { const float a0 = kkT[d * 129 + lane], a1 = kkT[d * 129 + lane + 64];
#pragma unroll
            for (int j = 0; j < 8; ++j) { const float wv = wqs[(w * 8 + j) * 128 + d]; acc[j][0] += wv * a0; acc[j][1] += wv * a1; } }
        u32x4 o0, o1;
        o0.x = pk2(acc[0][0], acc[1][0]); o0.y = pk2(acc[2][0], acc[3][0]); o0.z = pk2(acc[4][0], acc[5][0]); o0.w = pk2(acc[6][0], acc[7][0]);
        o1.x = pk2(acc[0][1], acc[1][1]); o1.y = pk2(acc[2][1], acc[3][1]); o1.z = pk2(acc[4][1], acc[5][1]); o1.w = pk2(acc[6][1], acc[7][1]);
        *(u32x4*)(WT + (size_t)(z * 128 + lane) * 1024 + kc * 64 + w * 8) = o0;
        *(u32x4*)(WT + (size_t)(z * 128 + lane + 64) * 1024 + kc * 64 + w * 8) = o1;
    }
    __syncthreads();
}

__device__ __forceinline__ void p0_tables(const Args& A, const Frame& F) {
    const int gw = F.bid * NWAVES + F.wave, NGW = F.nblk * NWAVES, lane = F.lane;
    unsigned char* TAB = F.ws + WS_TAB; float* TSC = (float*)(F.ws + WS_TSC);
    for (int it = gw; it < 4 * 16384 / 4; it += NGW) {
        const int t = it >> 12, row0 = (it & 4095) * 4;
        const float* src = (t == 0 ? A.in[I0_PU] : t == 1 ? A.in[I0_PV] : t == 2 ? A.in[I1_PU] : A.in[I1_PV]) + (size_t)row0 * 1024 + 4 * lane;
        f32x4 v[4][4];
#pragma unroll
        for (int rr = 0; rr < 4; ++rr)
#pragma unroll
            for (int j = 0; j < 4; ++j) v[rr][j] = *(const f32x4*)(src + (size_t)rr * 1024 + 256 * j);
#pragma unroll
        for (int rr = 0; rr < 4; ++rr) {
            float am = 0.f;
#pragma unroll
            for (int j = 0; j < 4; ++j) am = fmaxf(am, fmaxf(fmaxf(fabsf(v[rr][j].x), fabsf(v[rr][j].y)), fmaxf(fabsf(v[rr][j].z), fabsf(v[rr][j].w))));
            am = wave_max(am);
            const int row = row0 + rr;
            float sc;
            if ((t & 1) == 0) {
                float ss = 0.f;
#pragma unroll
                for (int j = 0; j < 4; ++j) ss += (v[rr][j].x * v[rr][j].x + v[rr][j].y * v[rr][j].y) + (v[rr][j].z * v[rr][j].z + v[rr][j].w * v[rr][j].w);
                ss = wave_sum(ss);
                sc = am > 0.f ? fminf(am * (1.f / 7.f), 0.36f * sqrtf(ss * (1.f / 1024.f))) : 1.f;
                const float inv = am > 0.f ? 1.f / sc : 0.f;
#pragma unroll
                for (int j = 0; j < 4; ++j) {
                    const int q0 = (int)fminf(fmaxf(rintf(v[rr][j].x * inv), -7.f), 7.f), q1 = (int)fminf(fmaxf(rintf(v[rr][j].y * inv), -7.f), 7.f), q2 = (int)fminf(fmaxf(rintf(v[rr][j].z * inv), -7.f), 7.f), q3 = (int)fminf(fmaxf(rintf(v[rr][j].w * inv), -7.f), 7.f);
                    *(unsigned short*)(TAB + (((size_t)t * 8 + j) * 16384 + row) * 128 + 2 * lane) = (unsigned short)((q0 & 15) | ((q1 & 15) << 4) | ((q2 & 15) << 8) | ((q3 & 15) << 12)); }
            } else {
                float ss = 0.f;
#pragma unroll
                for (int j = 0; j < 4; ++j) ss += (v[rr][j].x * v[rr][j].x + v[rr][j].y * v[rr][j].y) + (v[rr][j].z * v[rr][j].z + v[rr][j].w * v[rr][j].w);
                ss = wave_sum(ss);
                sc = am > 0.f ? fminf(am * (1.f / 7.f), 0.36f * sqrtf(ss * (1.f / 1024.f))) : 1.f;
                const float inv = am > 0.f ? 1.f / sc : 0.f;
#pragma unroll
                for (int j = 0; j < 4; ++j) {
                    const int q0 = (int)fminf(fmaxf(rintf(v[rr][j].x * inv), -7.f), 7.f), q1 = (int)fminf(fmaxf(rintf(v[rr][j].y * inv), -7.f), 7.f), q2 = (int)fminf(fmaxf(rintf(v[rr][j].z * inv), -7.f), 7.f), q3 = (int)fminf(fmaxf(rintf(v[rr][j].w * inv), -7.f), 7.f);
                    const unsigned mine = ((unsigned)(q0 & 15) | ((unsigned)(q1 & 15) << 8) | ((unsigned)(q2 & 15) << 16) | ((unsigned)(q3 & 15) << 24)) << ((lane & 1) ? 4 : 0);
                    const unsigned other = (unsigned)__builtin_amdgcn_update_dpp(0, (int)mine, 0xB1, 0xf, 0xf, false);
                    if ((lane & 1) == 0) *(unsigned*)(TAB + (((size_t)t * 8 + j) * 16384 + row) * 128 + 4 * (lane >> 1)) = mine | other; }
            }
            if (lane == 0) TSC[t * 16384 + row] = sc;
        }
    }
}

__device__ __forceinline__ void norm_mod_store(const f32x4 (&v)[4], float rinv, const float* g, const float* sh, const float* sc, bf16_t* orow, int lane) {
#pragma unroll
    for (int j = 0; j < 4; ++j) { const int c = 4 * lane + 256 * j;
        const f32x4 gg = *(const f32x4*)(g + c), s1 = *(const f32x4*)(sc + c), s0 = *(const f32x4*)(sh + c);
        const f32x4 y = (v[j] * rinv * gg) * (s1 + 1.f) + s0;
        u32x2 o; o.x = pk2(y.x, y.y); o.y = pk2(y.z, y.w); *(u32x2*)(orow + c) = o; }
}
__device__ __forceinline__ int tok_row(int layer, int n);
__device__ __forceinline__ void norm_row_out(const Frame& F, const f32x4 (&v)[4], float rinv, const float* g, const float* mm, int r, int which) {
    norm_mod_store(v, rinv, g, mm, mm + 1024, (bf16_t*)(F.ws + WS_H) + (size_t)r * DM, F.lane);
    if (which) {
        f32x4 y[4]; float am = 0.f;
#pragma unroll
        for (int j = 0; j < 4; ++j) { const int c = 4 * F.lane + 256 * j; y[j] = (v[j] * rinv * *(const f32x4*)(g + c)) * (*(const f32x4*)(mm + 1024 + c) + 1.f) + *(const f32x4*)(mm + c);
            am = fmaxf(am, fmaxf(fmaxf(fabsf(y[j].x), fabsf(y[j].y)), fmaxf(fabsf(y[j].z), fabsf(y[j].w)))); }
        am = wave_max(am);
        const float inv = am > 0.f ? 119.f / am : 0.f;
#pragma unroll
        for (int j = 0; j < 4; ++j) { const int h0 = (int)rintf(y[j].x * inv), h1 = (int)rintf(y[j].y * inv), h2 = (int)rintf(y[j].z * inv), h3 = (int)rintf(y[j].w * inv);
            const unsigned hh = (unsigned)(((h0 + 8) >> 4) & 15) | ((unsigned)(((h1 + 8) >> 4) & 15) << 4) | ((unsigned)(((h2 + 8) >> 4) & 15) << 8) | ((unsigned)(((h3 + 8) >> 4) & 15) << 12);
            const unsigned hl = (unsigned)(h0 & 15) | ((unsigned)(h1 & 15) << 4) | ((unsigned)(h2 & 15) << 8) | ((unsigned)(h3 & 15) << 12);
            const bool odd = (F.lane & 1) != 0;
            const unsigned recv = (unsigned)__builtin_amdgcn_update_dpp(0, (int)(odd ? hh : hl), 0xB1, 0xf, 0xf, false);
            *(unsigned*)(F.ws + WS_HQ + (size_t)r * DM + 256 * j + 4 * F.lane) = odd ? (recv | (hl << 16)) : (hh | (recv << 16)); }
        if (F.lane == 0) ((float*)(F.ws + WS_HS))[r] = am > 0.f ? am * (1.f / 119.f) : 1.f;
    }
}
__device__ __forceinline__ void p_norm_rows(const Args& A, const Frame& F, int layer, int which, bool from_input, bool skip_ctx) {
    const int gw = F.bid * NWAVES + F.wave, NGW = F.nblk * NWAVES;
    const float* g = A.in[layer ? (which ? I1_NFFN : I1_NMIX) : (which ? I0_NFFN : I0_NMIX)];
    const float* MOD = (const float*)(F.ws + WS_MOD) + (size_t)layer * 5 * 6144;
    const unsigned short* X = (const unsigned short*)(F.ws + WS_X);
    const int ntok = skip_ctx ? NB * SEQ : R;
    for (int n = gw; n < ntok; n += 2 * NGW) {
        const bool has1 = (n + NGW) < ntok;
        const int r0 = skip_ctx ? tok_row(1, n) : n, r1 = has1 ? (skip_ctx ? tok_row(1, n + NGW) : n + NGW) : r0;
        f32x4 v0[4], v1[4]; float s0 = 0.f, s1 = 0.f;
        if (from_input) { const float* x0 = xin_row(F, r0); const float* x1 = xin_row(F, r1);
#pragma unroll
            for (int j = 0; j < 4; ++j) { v0[j] = *(const f32x4*)(x0 + 4 * F.lane + 256 * j); v1[j] = *(const f32x4*)(x1 + 4 * F.lane + 256 * j); } }
        else {
#pragma unroll
            for (int j = 0; j < 4; ++j) { const u32x2 a = *(const u32x2*)(X + (size_t)r0 * DM + 4 * F.lane + 256 * j), b = *(const u32x2*)(X + (size_t)r1 * DM + 4 * F.lane + 256 * j);
                v0[j] = (f32x4){h2f_lo(a.x), h2f_hi(a.x), h2f_lo(a.y), h2f_hi(a.y)}; v1[j] = (f32x4){h2f_lo(b.x), h2f_hi(b.x), h2f_lo(b.y), h2f_hi(b.y)}; } }
#pragma unroll
        for (int j = 0; j < 4; ++j) { s0 += (v0[j].x * v0[j].x + v0[j].y * v0[j].y) + (v0[j].z * v0[j].z + v0[j].w * v0[j].w); s1 += (v1[j].x * v1[j].x + v1[j].y * v1[j].y) + (v1[j].z * v1[j].z + v1[j].w * v1[j].w); }
        const float ri0 = rsqrtf(wave_sum(s0) * (1.f / DM) + EPS), ri1 = rsqrtf(wave_sum(s1) * (1.f / DM) + EPS);
        norm_row_out(F, v0, ri0, g, MOD + (size_t)mod_index(r0) * 6144 + (which ? 3 * 1024 : 0), r0, which);
        if (has1) norm_row_out(F, v1, ri1, g, MOD + (size_t)mod_index(r1) * 6144 + (which ? 3 * 1024 : 0), r1, which);
    }
}

namespace pg8 {
#define PG8_LAS __attribute__((address_space(3)))
typedef unsigned short bf16_t;
typedef short bf16x8 __attribute__((ext_vector_type(8)));
typedef float f32x4 __attribute__((ext_vector_type(4)));
typedef unsigned u32x4 __attribute__((ext_vector_type(4)));
constexpr int BM = 256, BK = 64, HALF = 128, HTB = HALF * BK * 2  , STAGE_BYTES = 8 * HTB, NXCD = 8, WGM = 8;

__host__ __device__ __forceinline__ int lds_byte(int r, int c) { const int st = (r >> 4) * 2 + (c >> 5), rr = r & 15, cc = c & 31, ob = rr * 64 + cc * 2; return st * 1024 + (ob ^ (((ob >> 9) & 1) << 5)); }
__host__ __device__ __forceinline__ void stage_rc(int b, int& R, int& C) { const int st = b / 1024, sb = b % 1024, swz = sb ^ (((sb >> 9) & 1) << 5); R = (st >> 1) * 16 + swz / 64; C = (st & 1) * 32 + (swz % 64) / 2; }
__host__ __device__ __forceinline__ int perm32(int rho) { const int n = rho >> 4, i = rho & 15; return 8 * (i >> 2) + 4 * n + (i & 3); }

struct Unit { int pm, pn; };
struct Gemm { const bf16_t* A; const bf16_t* Bt; int M, N, K; };

struct StaticOrder {
    int nM, nN, nwg, G, c;
    __host__ __device__ void init(int M, int N, int G_, int c_) { nM = M / BM; nN = N / BM; nwg = nM * nN; G = G_; c = c_; }
    __host__ __device__ bool next(int i, Unit& u) const {
        const long L = (long)i * G + c; if (L >= nwg) return false;
        int wgid = (int)L; { const int q = nwg / NXCD, r = nwg % NXCD, xcd = wgid % NXCD, off = wgid / NXCD; wgid = (xcd < r ? xcd * (q + 1) : r * (q + 1) + (xcd - r) * q) + off; }
        const int nig = WGM * nN, gid = wgid / nig, fm = gid * WGM, gsz = (nM - fm) < WGM ? (nM - fm) : WGM;
        u.pm = fm + ((wgid % nig) % gsz); u.pn = (wgid % nig) / gsz; return true;
    }
    __device__ __forceinline__ void a_ready(const Unit&) const {}
    __device__ __forceinline__ void done(const Unit&) const {}
};

template <class Epi, class Sched, bool ALIGN_EPI = false, bool SP2 = false>
__device__ __forceinline__ void gemm_phase(PG8_LAS unsigned char* lds, const Gemm g, const Sched& S, const Epi& E) {
    const int tid = threadIdx.x, wid = __builtin_amdgcn_readfirstlane(tid >> 6), lane = tid & 63, wr = wid >> 2, wc = wid & 3, fr = lane & 15, fq = lane >> 4;
    const int K = g.K, nt = K / BK;
    unsigned voffA[2], voffB[2];
#pragma unroll
    for (int i = 0; i < 2; ++i) { int R, C; stage_rc(tid * 16 + i * 8192, R, C); const int Rb = Epi::PERM ? ((R & ~31) + perm32(R & 31)) : R;
        voffA[i] = (unsigned)(R * K + C) * 2u; voffB[i] = (unsigned)(Rb * K + C) * 2u; }
    const size_t kstep = (size_t)(BK * 2);
    const size_t hstep = (size_t)HALF * K * 2;
    const size_t tstep = 2 * hstep;
    const unsigned ldsw = (unsigned)wid * 1024u;
    const int aoff = lds_byte(wr * 64 + fr, fq * 8), boff = lds_byte(wc * 32 + fr, fq * 8);
#define PG8_SA(b, h) (((b) * 2 + (h)) * HTB)
#define PG8_SB(b, h) ((4 + (b) * 2 + (h)) * HTB)
#define PG8_STAGE(bufoff, gbase, voff) do { _Pragma("unroll") for (int _i = 0; _i < 2; ++_i) \
        __builtin_amdgcn_global_load_lds((const unsigned*)((const char*)(gbase) + (voff)[_i]), (PG8_LAS unsigned*)(lds + (bufoff) + ldsw + _i * 8192), 16, 0, 0); } while (0)
#define PG8_LDA(dst, b, h) do { _Pragma("unroll") for (int m = 0; m < 4; ++m) _Pragma("unroll") for (int k = 0; k < 2; ++k) dst[m][k] = *(const PG8_LAS bf16x8*)(lds + PG8_SA(b, h) + aoff + m * 2048 + k * 1024); } while (0)
#define PG8_LDB(dst, b, h) do { _Pragma("unroll") for (int n = 0; n < 2; ++n) _Pragma("unroll") for (int k = 0; k < 2; ++k) dst[n][k] = *(const PG8_LAS bf16x8*)(lds + PG8_SB(b, h) + boff + n * 2048 + k * 1024); } while (0)
#define PG8_MMA(ai, bj, At, Bt) do { __builtin_amdgcn_s_setprio(1); _Pragma("unroll") for (int m = 0; m < 4; ++m) _Pragma("unroll") for (int n = 0; n < 2; ++n) _Pragma("unroll") for (int k = 0; k < 2; ++k) \
        acc[ai][bj][m][n] = __builtin_amdgcn_mfma_f32_16x16x32_bf16(Bt[n][k], At[m][k], acc[ai][bj][m][n], 0, 0, 0); __builtin_amdgcn_s_setprio(0); } while (0)
#define PG8_WAIT_V(n) asm volatile("s_waitcnt vmcnt(" #n ")" ::: "memory")
#define PG8_WAIT_L(n) asm volatile("s_waitcnt lgkmcnt(" #n ")" ::: "memory")
#define PG8_BAR __builtin_amdgcn_s_barrier()
#define PG8_SCHED __builtin_amdgcn_sched_barrier(0)
    Unit cur, nxt; int ui = 0;
    if (!S.next(0, cur)) return;
    f32x4 acc[2][2][4][2];
#pragma unroll
    for (int a = 0; a < 2; ++a)
#pragma unroll
        for (int b = 0; b < 2; ++b)
#pragma unroll
            for (int m = 0; m < 4; ++m)
#pragma unroll
                for (int n = 0; n < 2; ++n) acc[a][b][m][n] = (f32x4){0.f, 0.f, 0.f, 0.f};
    bf16x8 At[4][2], B0[2][2], B1[2][2];
    const char* cA = (const char*)g.A + (size_t)cur.pm * tstep; const char* cB = (const char*)g.Bt + (size_t)cur.pn * tstep;
    S.a_ready(cur);
    if constexpr (SP2) {
        PG8_STAGE(PG8_SB(0, 0), cB, voffB); PG8_STAGE(PG8_SB(0, 1), cB + hstep, voffB); PG8_STAGE(PG8_SA(0, 0), cA, voffA); PG8_STAGE(PG8_SA(0, 1), cA + hstep, voffA);
        if (wr == 1) PG8_BAR;
        PG8_WAIT_V(2); PG8_BAR;
        PG8_STAGE(PG8_SB(1, 0), cB + kstep, voffB); PG8_STAGE(PG8_SA(1, 0), cA + kstep, voffA); PG8_STAGE(PG8_SB(1, 1), cB + hstep + kstep, voffB);
        PG8_WAIT_V(6); PG8_BAR;
    } else {
        PG8_STAGE(PG8_SB(0, 0), cB, voffB); PG8_STAGE(PG8_SA(0, 0), cA, voffA); PG8_STAGE(PG8_SB(0, 1), cB + hstep, voffB); PG8_STAGE(PG8_SA(0, 1), cA + hstep, voffA);
        if (wr == 1) PG8_BAR;
        PG8_WAIT_V(4); PG8_BAR;
        PG8_STAGE(PG8_SB(1, 0), cB + kstep, voffB); PG8_STAGE(PG8_SA(1, 0), cA + kstep, voffA); PG8_STAGE(PG8_SB(1, 1), cB + hstep + kstep, voffB);
        PG8_WAIT_V(6); PG8_BAR;
    }
    for (;;) {
        const bool has_next = S.next(ui + 1, nxt);
        const char* nA = has_next ? (const char*)g.A + (size_t)nxt.pm * tstep : cA; const char* nB = has_next ? (const char*)g.Bt + (size_t)nxt.pn * tstep : cB;
        for (int t = 0; t < nt; t += 2) {
            const bool last = (t == nt - 2);
            const char* a1 = cA + (size_t)(t + 1) * kstep;
            const char* a2 = last ? nA : cA + (size_t)(t + 2) * kstep; const char* b2 = last ? nB : cB + (size_t)(t + 2) * kstep;
            const char* a3 = a2 + kstep; const char* b3 = b2 + kstep;
            if (last && has_next) S.a_ready(nxt);
            if constexpr (SP2) {
            PG8_LDB(B0, 0, 0); PG8_LDB(B1, 0, 1); PG8_SCHED; PG8_LDA(At, 0, 0); PG8_STAGE(PG8_SA(1, 1), a1 + hstep, voffA);
            PG8_WAIT_V(8); PG8_WAIT_L(0); PG8_BAR; PG8_MMA(0, 0, At, B0); PG8_MMA(0, 1, At, B1); PG8_BAR; PG8_SCHED;
            PG8_LDA(At, 0, 1); PG8_STAGE(PG8_SB(0, 0), b2, voffB); PG8_STAGE(PG8_SB(0, 1), b2 + hstep, voffB); PG8_STAGE(PG8_SA(0, 0), a2, voffA);
            PG8_WAIT_V(8); PG8_WAIT_L(0); PG8_BAR; PG8_MMA(1, 0, At, B0); PG8_MMA(1, 1, At, B1); PG8_BAR; PG8_SCHED;
            PG8_LDB(B0, 1, 0); PG8_LDB(B1, 1, 1); PG8_SCHED; PG8_LDA(At, 1, 0); PG8_STAGE(PG8_SA(0, 1), a2 + hstep, voffA);
            PG8_WAIT_V(8); PG8_WAIT_L(0); PG8_BAR; PG8_MMA(0, 0, At, B0); PG8_MMA(0, 1, At, B1); PG8_BAR; PG8_SCHED;
            PG8_LDA(At, 1, 1); PG8_STAGE(PG8_SB(1, 0), b3, voffB); PG8_STAGE(PG8_SB(1, 1), b3 + hstep, voffB); PG8_STAGE(PG8_SA(1, 0), a3, voffA);
            PG8_WAIT_V(8); PG8_WAIT_L(0); PG8_BAR; PG8_MMA(1, 0, At, B0); PG8_MMA(1, 1, At, B1); PG8_BAR; PG8_SCHED;
            } else {
            PG8_LDB(B0, 0, 0); PG8_SCHED; PG8_LDA(At, 0, 0); PG8_STAGE(PG8_SA(1, 1), a1 + hstep, voffA);
            PG8_WAIT_L(8); PG8_BAR; PG8_WAIT_L(0); PG8_MMA(0, 0, At, B0); PG8_BAR; PG8_SCHED;
            PG8_LDB(B1, 0, 1); PG8_STAGE(PG8_SB(0, 0), b2, voffB);
            PG8_BAR; PG8_WAIT_L(0); PG8_MMA(0, 1, At, B1); PG8_BAR;
            PG8_LDA(At, 0, 1); PG8_STAGE(PG8_SA(0, 0), a2, voffA);
            PG8_BAR; PG8_WAIT_L(0); PG8_MMA(1, 0, At, B0); PG8_BAR; PG8_SCHED;
            PG8_STAGE(PG8_SB(0, 1), b2 + hstep, voffB);
            PG8_WAIT_V(6); PG8_BAR; PG8_MMA(1, 1, At, B1); PG8_BAR;
            PG8_LDB(B0, 1, 0); PG8_SCHED; PG8_LDA(At, 1, 0); PG8_STAGE(PG8_SA(0, 1), a2 + hstep, voffA);
            PG8_WAIT_L(8); PG8_BAR; PG8_WAIT_L(0); PG8_MMA(0, 0, At, B0); PG8_BAR; PG8_SCHED;
            PG8_LDB(B1, 1, 1); PG8_STAGE(PG8_SB(1, 0), b3, voffB);
            PG8_BAR; PG8_WAIT_L(0); PG8_MMA(0, 1, At, B1); PG8_BAR;
            PG8_LDA(At, 1, 1); PG8_STAGE(PG8_SA(1, 0), a3, voffA);
            PG8_BAR; PG8_WAIT_L(0); PG8_MMA(1, 0, At, B0); PG8_BAR; PG8_SCHED;
            PG8_STAGE(PG8_SB(1, 1), b3 + hstep, voffB);
            PG8_WAIT_V(6); PG8_BAR; PG8_MMA(1, 1, At, B1); PG8_BAR;
            }
        }
        if constexpr (ALIGN_EPI) { if (wr == 0) PG8_BAR; }
        if constexpr (!Epi::AFTER_DRAIN) { E(acc, cur, wr, wc, fr, fq); S.done(cur); }
        if (!has_next) break;
#pragma unroll
        for (int a = 0; a < 2; ++a)
#pragma unroll
            for (int b = 0; b < 2; ++b)
#pragma unroll
                for (int m = 0; m < 4; ++m)
#pragma unroll
                    for (int n = 0; n < 2; ++n) acc[a][b][m][n] = (f32x4){0.f, 0.f, 0.f, 0.f};
        cur = nxt; cA = nA; cB = nB; ++ui;
        if constexpr (ALIGN_EPI) { if (wr == 1) PG8_BAR; }
    }
    PG8_WAIT_V(0);
    if constexpr (!ALIGN_EPI) { if (wr == 0) PG8_BAR; }
    PG8_BAR;
    if constexpr (Epi::AFTER_DRAIN) { E.fused(acc, cur, wr, wc, fr, fq, lds, wid, lane); S.done(cur); }
#undef PG8_SA
#undef PG8_SB
#undef PG8_STAGE
#undef PG8_LDA
#undef PG8_LDB
#undef PG8_MMA
#undef PG8_WAIT_V
#undef PG8_WAIT_L
#undef PG8_BAR
#undef PG8_SCHED
}
}

template <class Inner> struct EpiTile { static constexpr bool PERM = true, AFTER_DRAIN = false; Inner in;
    __device__ __forceinline__ void operator()(const pg8::f32x4 (&acc)[2][2][4][2], const pg8::Unit& u, int wr, int wc, int fr, int fq) const {
#pragma unroll
        for (int ai = 0; ai < 2; ++ai)
#pragma unroll
            for (int m = 0; m < 4; ++m) { const int row = u.pm * 256 + ai * 128 + wr * 64 + m * 16 + fr;
#pragma unroll
                for (int bj = 0; bj < 2; ++bj) in(row, u.pn * 256 + bj * 128 + wc * 32 + 8 * fq, acc[ai][bj][m][0], acc[ai][bj][m][1]); }
    } };
struct In8Bf16 { bf16_t* C; int ldc;
    __device__ __forceinline__ void operator()(int row, int col, f32x4 a, f32x4 b) const { u32x4 o; o.x = cvtpk(a.x, a.y); o.y = cvtpk(a.z, a.w); o.z = cvtpk(b.x, b.y); o.w = cvtpk(b.z, b.w); *(u32x4*)(C + (size_t)row * ldc + col) = o; } };
struct In8KV { bf16_t* Kb; bf16_t* Vb;
    __device__ __forceinline__ void operator()(int row, int col, f32x4 a, f32x4 b) const { const int h = col >> 8, c = col & 255; u32x4 o; o.x = cvtpk(a.x, a.y); o.y = cvtpk(a.z, a.w); o.z = cvtpk(b.x, b.y); o.w = cvtpk(b.z, b.w);
        bf16_t* p = (c < 128) ? Kb + (size_t)row * 1536 + h * 192 + c : Vb + (size_t)row * 1024 + h * 128 + (c - 128);
        *(u32x4*)p = o; } };
struct In8F16 { unsigned short* C; int ldc;
    __device__ __forceinline__ void operator()(int row, int col, f32x4 a, f32x4 b) const { u32x4 o; o.x = pkh2(a.x, a.y); o.y = pkh2(a.z, a.w); o.z = pkh2(b.x, b.y); o.w = pkh2(b.z, b.w); *(u32x4*)(C + (size_t)row * ldc + col) = o; } };
struct In8F32 { float* C; int ldc;
    __device__ __forceinline__ void operator()(int row, int col, f32x4 a, f32x4 b) const { float* p = C + (size_t)row * ldc + col; *(f32x4*)p = a; *(f32x4*)(p + 4) = b; } };
struct In8Resid { const float* x; const float* ctx; unsigned short* X; const float* gate; bool from_input;
    __device__ __forceinline__ void operator()(int row, int col, f32x4 a, f32x4 b) const {
        const int bb = row / RPB, j = row - bb * RPB; unsigned short* xo = X + (size_t)row * DM + col;
        f32x4 x0, x1;
        if (from_input) { const float* xi = ((j < CTXL) ? ctx + ((size_t)bb * CTXL + j) * DM : x + ((size_t)bb * SEQ + (j - CTXL)) * DM) + col; x0 = *(const f32x4*)xi; x1 = *(const f32x4*)(xi + 4); }
        else { const u32x4 w = *(const u32x4*)xo; x0 = (f32x4){h2f_lo(w.x), h2f_hi(w.x), h2f_lo(w.y), h2f_hi(w.y)}; x1 = (f32x4){h2f_lo(w.z), h2f_hi(w.z), h2f_lo(w.w), h2f_hi(w.w)}; }
        const float* g = gate + (size_t)((j < CTXL) ? 4 : bb) * 6144 + col;
        x0 += *(const f32x4*)g * a; x1 += *(const f32x4*)(g + 4) * b;
        u32x4 o; o.x = pkh2(x0.x, x0.y); o.y = pkh2(x0.z, x0.w); o.z = pkh2(x1.x, x1.y); o.w = pkh2(x1.z, x1.w); *(u32x4*)xo = o; } };
struct EpiMlaDown { static constexpr bool PERM = true, AFTER_DRAIN = false; bf16_t* CQ; bf16_t* CKV; bf16_t* KR; float* SSP;
    __device__ __forceinline__ void operator()(const pg8::f32x4 (&acc)[2][2][4][2], const pg8::Unit& u, int wr, int wc, int fr, int fq) const {
#pragma unroll
        for (int ai = 0; ai < 2; ++ai)
#pragma unroll
            for (int m = 0; m < 4; ++m) { const int row = u.pm * 256 + ai * 128 + wr * 64 + m * 16 + fr;
#pragma unroll
                for (int bj = 0; bj < 2; ++bj) { const int col = u.pn * 256 + bj * 128 + wc * 32 + 8 * fq; const f32x4 a = acc[ai][bj][m][0], b = acc[ai][bj][m][1];
                    u32x4 o; o.x = cvtpk(a.x, a.y); o.y = cvtpk(a.z, a.w); o.z = cvtpk(b.x, b.y); o.w = cvtpk(b.z, b.w);
                    const int cls = (u.pn * 2 + bj);
                    if (cls < 5) { float sq = (a.x * a.x + a.y * a.y) + (a.z * a.z + a.w * a.w) + (b.x * b.x + b.y * b.y) + (b.z * b.z + b.w * b.w);
                        sq += __shfl_xor(sq, 16); sq += __shfl_xor(sq, 32);
                        if (cls < 3) *(u32x4*)(CQ + (size_t)row * 384 + col) = o; else *(u32x4*)(CKV + (size_t)row * 256 + (col - 384)) = o;
                        if (fq == 0) SSP[(size_t)row * 24 + cls * 4 + wc] = sq; }
                    else if (col < 704) *(u32x4*)(KR + (size_t)row * 64 + (col - 640)) = o; } }
    } };
struct In8Bf16Rs { bf16_t* C; int ldc; const float* ssp;
    __device__ __forceinline__ void operator()(int row, int col, f32x4 a, f32x4 b) const { const f32x4 s0 = *(const f32x4*)(ssp + (size_t)row * 24), s1 = *(const f32x4*)(ssp + (size_t)row * 24 + 4), s2 = *(const f32x4*)(ssp + (size_t)row * 24 + 8);
        const float ssum = (((s0.x + s0.y) + (s0.z + s0.w)) + ((s1.x + s1.y) + (s1.z + s1.w))) + ((s2.x + s2.y) + (s2.z + s2.w));
        const float rs = rsqrtf(ssum * (1.f / 384.f) + EPS); a *= rs; b *= rs;
        u32x4 o; o.x = cvtpk(a.x, a.y); o.y = cvtpk(a.z, a.w); o.z = cvtpk(b.x, b.y); o.w = cvtpk(b.z, b.w); *(u32x4*)(C + (size_t)row * ldc + col) = o; } };
struct In8KVRs { unsigned char* K8; unsigned char* V8; const float* ssp;
    __device__ __forceinline__ void operator()(int row, int col, f32x4 a, f32x4 b) const { const f32x4 s0 = *(const f32x4*)(ssp + (size_t)row * 24 + 12), s1 = *(const f32x4*)(ssp + (size_t)row * 24 + 16);
        const float ssum = ((s0.x + s0.y) + (s0.z + s0.w)) + ((s1.x + s1.y) + (s1.z + s1.w));
        const float rs = rsqrtf(ssum * (1.f / 256.f) + EPS); a *= rs; b *= rs;
        const int h = col >> 8, c = col & 255;
        if (c < 128) { u32x2 o; o.x = f8x4(a.x, a.y, a.z, a.w); o.y = f8x4(b.x, b.y, b.z, b.w); *(u32x2*)(K8 + (size_t)row * 1536 + h * 192 + c) = o; }
        else { u32x2 o; o.x = f8x4(a.x, a.y, a.z, a.w); o.y = f8x4(b.x, b.y, b.z, b.w); *(u32x2*)(V8 + (size_t)row * 1024 + h * 128 + (c - 128)) = o; } } };
struct RowSched { pg8::StaticOrder so; bool latent_only;
    __device__ __forceinline__ void init(int N, int G, int c, bool lat) { latent_only = lat; so.init(lat ? NB * SEQ : R, N, G, c); }
    __device__ __forceinline__ bool next(int i, pg8::Unit& u) const { if (!so.next(i, u)) return false; if (latent_only) u.pm = (u.pm >> 4) * 17 + 1 + (u.pm & 15); return true; }
    __device__ __forceinline__ void a_ready(const pg8::Unit&) const {}
    __device__ __forceinline__ void done(const pg8::Unit&) const {} };
template <class Inner> __device__ __forceinline__ void gemm8(const Frame& F, const bf16_t* Ap, const bf16_t* Bt, int N, int K, bool latent_only, const Inner& in, bool reverse = false) {
    asm volatile("" : "+s"(K));
    pg8::Gemm g{Ap, Bt, R, N, K}; RowSched S; S.init(N, F.nblk, reverse ? F.nblk - 1 - F.bid : F.bid, latent_only);
    EpiTile<Inner> E{in};
    pg8::gemm_phase<EpiTile<Inner>, RowSched, true, true>((PG8_LAS unsigned char*)F.lds, g, S, E);
}

template <class Epi> __device__ __forceinline__ void gemm8e(const Frame& F, const bf16_t* Ap, const bf16_t* Bt, int N, int K, bool latent_only, const Epi& E) {
    asm volatile("" : "+s"(K));
    pg8::Gemm g{Ap, Bt, R, N, K}; RowSched S; S.init(N, F.nblk, F.bid, latent_only);
    pg8::gemm_phase<Epi, RowSched, true, true>((PG8_LAS unsigned char*)F.lds, g, S, E);
}

struct GemmDesc { const bf16_t* A; int lda; long sA; const bf16_t* Bt; int ldb; long sB; int M, N, K, nz; };
template <class Epi>
__device__ __forceinline__ void gemm_simple(const Frame& F, const GemmDesc& g, const Epi& epi, bool skip_ctx) {
    const int wm = F.wave >> 1, wn = F.wave & 1, fr = F.lane & 15, fq = F.lane >> 4;
    const int tM = g.M / 128, tN = g.N / 128, per = tM * tN, total = per * g.nz;
    for (int u = F.bid; u < total; u += F.nblk) {
        const int z = u / per, uu = u - z * per, tm = uu / tN, tn = uu - tm * tN;
        if (skip_ctx && ((tm * 128) % RPB) < CTXL) continue;
        const int row0 = tm * 128 + wm * 32, col0 = tn * 128 + wn * 64;
        const bf16_t* ap = g.A + z * g.sA + (size_t)(row0 + fr) * g.lda + fq * 8;
        const bf16_t* bp = g.Bt + z * g.sB + (size_t)(col0 + fr) * g.ldb + fq * 8;
        f32x4 acc[2][4];
#pragma unroll
        for (int mi = 0; mi < 2; ++mi)
#pragma unroll
            for (int ni = 0; ni < 4; ++ni) acc[mi][ni] = (f32x4){0.f, 0.f, 0.f, 0.f};
        for (int k0 = 0; k0 < g.K; k0 += 32) {
            bf16x8 a[2], b[4];
#pragma unroll
            for (int mi = 0; mi < 2; ++mi) a[mi] = *(const bf16x8*)(ap + (size_t)mi * 16 * g.lda + k0);
#pragma unroll
            for (int ni = 0; ni < 4; ++ni) b[ni] = *(const bf16x8*)(bp + (size_t)ni * 16 * g.ldb + k0);
#pragma unroll
            for (int mi = 0; mi < 2; ++mi)
#pragma unroll
                for (int ni = 0; ni < 4; ++ni) acc[mi][ni] = __builtin_amdgcn_mfma_f32_16x16x32_bf16(b[ni], a[mi], acc[mi][ni], 0, 0, 0);
        }
#pragma unroll
        for (int mi = 0; mi < 2; ++mi)
#pragma unroll
            for (int ni = 0; ni < 4; ++ni) epi(z, row0 + mi * 16 + fr, col0 + ni * 16 + fq * 4, acc[mi][ni]);
    }
}
struct EpiBf16 { bf16_t* C; int ldc;
    __device__ __forceinline__ void operator()(int, int row, int col, f32x4 v) const { u32x2 o; o.x = pk2(v.x, v.y); o.y = pk2(v.z, v.w); *(u32x2*)(C + (size_t)row * ldc + col) = o; } };
struct EpiKV { bf16_t* Kb; bf16_t* Vb;
    __device__ __forceinline__ void operator()(int, int row, int col, f32x4 v) const { const int h = col >> 8, c = col & 255; u32x2 o; o.x = pk2(v.x, v.y); o.y = pk2(v.z, v.w);
        if (c < 128) *(u32x2*)(Kb + (size_t)row * 1536 + h * 192 + c) = o; else *(u32x2*)(Vb + (size_t)row * 1024 + h * 128 + (c - 128)) = o; } };
struct EpiF32Z { float* C; int ldc;
    __device__ __forceinline__ void operator()(int z, int row, int col, f32x4 v) const { *(f32x4*)(C + (size_t)row * ldc + z * 128 + col) = v; } };
struct EpiResid { const Frame* F; const float* gate; bool from_input;
    __device__ __forceinline__ void operator()(int, int row, int col, f32x4 v) const {
        float* X = (float*)(F->ws + WS_X) + (size_t)row * DM + col;
        const float* xi = from_input ? xin_row(*F, row) + col : X;
        const f32x4 g = *(const f32x4*)(gate + (size_t)mod_index(row) * 6144 + col);
        *(f32x4*)X = *(const f32x4*)xi + g * v; } };

__device__ __forceinline__ void rope_angles(int r, int& prow, int& pcol) { const int t = (r % RPB) - CTXL; prow = t >> 6; pcol = t & 63; }
__device__ __forceinline__ void p_mla_krope(const Args& A, const Frame& F) {
    const int gw = F.bid * NWAVES + F.wave, NGW = F.nblk * NWAVES, lane = F.lane;
    const bf16_t* KR = (const bf16_t*)(F.ws + WS_KR); unsigned char* K8 = F.ws + WS_K;
    const float invf = __powf(10000.f, -(float)(lane & 15) * (1.f / 16.f));
    for (int r = gw; r < R; r += NGW) {
        float kr = bf2f(KR[(size_t)r * 64 + lane]);
        if (!is_ctx_row(r)) {
            int prow, pcol; rope_angles(r, prow, pcol);
            const float ang = (float)((lane & 32) ? pcol : prow) * invf;
            const float cs = cosf(ang), sn = sinf(ang);
            const float partner = __shfl_xor(kr, 16);
            kr = kr * cs + ((lane & 16) ? partner : -partner) * sn;
        }
        const unsigned char kb = (unsigned char)(f8x4(kr, kr, kr, kr) & 0xffu);
#pragma unroll
        for (int h = 0; h < 8; ++h) K8[(size_t)r * 1536 + h * 192 + 128 + lane] = kb;
    }
}
__device__ __forceinline__ float row16_sum(float v) { v += WDPP(v, 0xB1); v += WDPP(v, 0x4E); v += WDPP(v, 0x141); v += WDPP(v, 0x140); return v; }
__device__ __forceinline__ void p_gqa_rows(const Args& A, const Frame& F) {
    const int gw = F.bid * NWAVES + F.wave, NGW = F.nblk * NWAVES, lane = F.lane, c16 = lane & 15, hrow = lane >> 4;
    const bf16_t* RAW = (const bf16_t*)(F.ws + WS_RAW1); bf16_t* Q1 = (bf16_t*)(F.ws + WS_Q1); unsigned char* K18 = F.ws + WS_K1; unsigned char* V18 = F.ws + WS_V1;
    float qg[8], kg[8], invf[8];
#pragma unroll
    for (int e = 0; e < 8; ++e) { qg[e] = A.in[I1_QN][8 * c16 + e]; kg[e] = A.in[I1_KN][8 * c16 + e]; invf[e] = __powf(10000.f, -(float)(8 * (c16 & 3) + e) * (1.f / 32.f)); }
    const bool colaxis = (c16 & 8) != 0, hi32 = (c16 & 4) != 0;
    for (int r = gw; r < R; r += NGW) {
        const bool ctx = is_ctx_row(r);
        const bf16_t* a = RAW + (size_t)r * 1536 + 8 * lane;
        u32x4 ch[3];
#pragma unroll
        for (int j = 0; j < 3; ++j) ch[j] = (ctx && j < 2) ? (u32x4){0u, 0u, 0u, 0u} : *(const u32x4*)(a + 512 * j);
        float cs[8], sn[8];
        { int prow = 0, pcol = 0; if (!ctx) rope_angles(r, prow, pcol); const float pos = (float)(colaxis ? pcol : prow);
#pragma unroll
          for (int e = 0; e < 8; ++e) { const float ang = pos * invf[e]; cs[e] = ctx ? 1.f : __cosf(ang); sn[e] = ctx ? 0.f : __sinf(ang); } }
#pragma unroll
        for (int j = 0; j < 3; ++j) {
            if (ctx && j < 2) continue;
            const bool isv = (j == 2) && (hrow >= 2);
            float x[8];
#pragma unroll
            for (int d = 0; d < 4; ++d) { x[2 * d] = bflo(ch[j][d]); x[2 * d + 1] = bfhi(ch[j][d]); }
            float sq = 0.f;
#pragma unroll
            for (int e = 0; e < 8; ++e) sq += x[e] * x[e];
            const float rinv = rsqrtf(row16_sum(sq) * (1.f / 128.f) + EPS);
            u32x4 o;
            float y[8];
#pragma unroll
            for (int e = 0; e < 8; ++e) y[e] = x[e] * rinv * (j < 2 ? qg[e] : kg[e]);
            u32x4 yp; yp.x = pk2(y[0], y[1]); yp.y = pk2(y[2], y[3]); yp.z = pk2(y[4], y[5]); yp.w = pk2(y[6], y[7]);
            float pr[8];
#pragma unroll
            for (int d = 0; d < 4; ++d) { const float lo = __shfl_xor(y[2 * d], 4), hi2 = __shfl_xor(y[2 * d + 1], 4); pr[2 * d] = lo; pr[2 * d + 1] = hi2; }
            float z[8];
#pragma unroll
            for (int e = 0; e < 8; ++e) z[e] = y[e] * cs[e] + (hi32 ? pr[e] : -pr[e]) * sn[e];
            o.x = pk2(z[0], z[1]); o.y = pk2(z[2], z[3]); o.z = pk2(z[4], z[5]); o.w = pk2(z[6], z[7]);
            (void)yp;
            if (isv) o = ch[j];
            if (j < 2) *(u32x4*)(Q1 + (size_t)r * 1024 + 512 * j + 8 * lane) = o;
            else if (hrow < 2) { u32x2 o8; o8.x = f8x4(z[0], z[1], z[2], z[3]); o8.y = f8x4(z[4], z[5], z[6], z[7]); *(u32x2*)(K18 + (size_t)r * 256 + 8 * lane) = o8; }
            else { u32x2 o8; o8.x = f8x4(x[0], x[1], x[2], x[3]); o8.y = f8x4(x[4], x[5], x[6], x[7]); *(u32x2*)(V18 + (size_t)r * 256 + 8 * (lane - 32)) = o8; }
        }
    }
}

__device__ __forceinline__ int crow(int r, int hi) { return (r & 3) + 8 * (r >> 2) + 4 * hi; }
__device__ __forceinline__ int v_st(int k, int c) { const int kk = (k & ~0xC) | ((k & 4) << 1) | ((k & 8) >> 1); return ((kk >> 3) * 4 + (c >> 5)) * 512 + ((kk & 7) * 32 + (c & 31)) * 2; }
__device__ __forceinline__ int v_rd_base(int lane) { return ((lane & 3) << 3) | (((lane >> 2) & 3) << 6) | (((lane >> 4) & 1) << 5) | (((lane >> 5) & 1) << 8); }
constexpr int v_rd_off(int d0, int ks, int half) { return d0 * 512 + ks * 4096 + half * 2048; }
template <int OFF> __device__ __forceinline__ s16x4 tr_read(int vb) { s16x4 r; asm volatile("ds_read_b64_tr_b16 %0, %1 offset:%2" : "=&v"(r) : "v"(vb), "i"(OFF) : "memory"); return r; }
template <int D0> __device__ __forceinline__ void pv_one(f32x16& od, int vb, bf16x8 pa0, bf16x8 pa1, bf16x8 pa2, bf16x8 pa3) {
    const s16x4 l0 = tr_read<v_rd_off(D0, 0, 0)>(vb), h0 = tr_read<v_rd_off(D0, 0, 1)>(vb), l1 = tr_read<v_rd_off(D0, 1, 0)>(vb), h1 = tr_read<v_rd_off(D0, 1, 1)>(vb);
    const s16x4 l2 = tr_read<v_rd_off(D0, 2, 0)>(vb), h2 = tr_read<v_rd_off(D0, 2, 1)>(vb), l3 = tr_read<v_rd_off(D0, 3, 0)>(vb), h3 = tr_read<v_rd_off(D0, 3, 1)>(vb);
    asm volatile("s_waitcnt lgkmcnt(0)" ::: "memory"); SBAR();
#define PK(L, H) (bf16x8){L[0], L[1], L[2], L[3], H[0], H[1], H[2], H[3]}
    od = __builtin_amdgcn_mfma_f32_32x32x16_bf16(pa0, PK(l0, h0), od, 0, 0, 0);
    od = __builtin_amdgcn_mfma_f32_32x32x16_bf16(pa1, PK(l1, h1), od, 0, 0, 0);
    od = __builtin_amdgcn_mfma_f32_32x32x16_bf16(pa2, PK(l2, h2), od, 0, 0, 0);
    od = __builtin_amdgcn_mfma_f32_32x32x16_bf16(pa3, PK(l3, h3), od, 0, 0, 0);
#undef PK
}
__device__ __forceinline__ void pv_d0(f32x16* o, int vb, bf16x8 pa0, bf16x8 pa1, bf16x8 pa2, bf16x8 pa3) {
    pv_one<0>(o[0], vb, pa0, pa1, pa2, pa3); pv_one<1>(o[1], vb, pa0, pa1, pa2, pa3); pv_one<2>(o[2], vb, pa0, pa1, pa2, pa3); pv_one<3>(o[3], vb, pa0, pa1, pa2, pa3);
}
constexpr float ATT_THR = 8.f;
__device__ __forceinline__ void partialSM(f32x16& p0, f32x16& p1, float& m_reg, float& mn, float& alpha, float C, float thr_raw) {
    float pmax = p0[0];
#pragma unroll
    for (int r = 1; r < 16; ++r) pmax = fmaxf(pmax, p0[r]);
#pragma unroll
    for (int r = 0; r < 16; ++r) pmax = fmaxf(pmax, p1[r]);
    { auto rr = __builtin_amdgcn_permlane32_swap(__float_as_uint(pmax), __float_as_uint(pmax), false, false);
      pmax = fmaxf(__uint_as_float(rr[0]), __uint_as_float(rr[1])); }
    if (__builtin_expect(__all(pmax - m_reg <= thr_raw), 1)) { mn = m_reg; alpha = 1.f; }
    else { mn = fmaxf(m_reg, pmax); alpha = __builtin_amdgcn_exp2f((m_reg - mn) * C); m_reg = mn; }
    const float mnC = -mn * C;
#pragma unroll
    for (int r = 0; r < 16; ++r) p0[r] = fmaf(p0[r], C, mnC);
#pragma unroll
    for (int r = 0; r < 16; ++r) p1[r] = fmaf(p1[r], C, mnC);
#pragma unroll
    for (int r = 0; r < 16; ++r) p0[r] = __builtin_amdgcn_exp2f(p0[r]);
}
__device__ __forceinline__ void finishSM(f32x16& p0, f32x16& p1, float alpha, float& l_reg, bf16x8& pa0, bf16x8& pa1, bf16x8& pa2, bf16x8& pa3) {
#pragma unroll
    for (int r = 0; r < 16; ++r) p1[r] = __builtin_amdgcn_exp2f(p1[r]);
    float ps = 0;
#pragma unroll
    for (int r = 0; r < 16; ++r) ps += p0[r];
#pragma unroll
    for (int r = 0; r < 16; ++r) ps += p1[r];
    { auto rr = __builtin_amdgcn_permlane32_swap(__float_as_uint(ps), __float_as_uint(ps), false, false);
      ps = __uint_as_float(rr[0]) + __uint_as_float(rr[1]); }
    l_reg = l_reg * alpha + ps;
#define PK4(P, BASE, OUT) do { unsigned a0 = cvtpk(P[BASE + 0], P[BASE + 1]), a1 = cvtpk(P[BASE + 2], P[BASE + 3]);   \
    unsigned b0 = cvtpk(P[BASE + 4], P[BASE + 5]), b1 = cvtpk(P[BASE + 6], P[BASE + 7]);                              \
    auto r0 = __builtin_amdgcn_permlane32_swap(a0, b0, false, false); auto r1 = __builtin_amdgcn_permlane32_swap(a1, b1, false, false); \
    u32x4 w = {r0[0], r1[0], r0[1], r1[1]}; OUT = *reinterpret_cast<bf16x8*>(&w); } while (0)
    PK4(p0, 0, pa0); PK4(p0, 8, pa1); PK4(p1, 0, pa2); PK4(p1, 8, pa3);
#undef PK4
}
template <int DQK> __device__ __forceinline__ void qkt(f32x16& p0, f32x16& p1, const char* Ks, const bf16x8* qr, int r32, int hi) {
    constexpr int KP = DQK * 2 + 16;
    p0 = f32x16{}; p1 = f32x16{};
#pragma unroll
    for (int d0 = 0; d0 < DQK / 16; ++d0) { const int cb = (d0 * 16 + hi * 8) * 2;
        const bf16x8 b0 = *reinterpret_cast<const bf16x8*>(Ks + r32 * KP + cb);
        const bf16x8 b1 = *reinterpret_cast<const bf16x8*>(Ks + (32 + r32) * KP + cb);
        p0 = __builtin_amdgcn_mfma_f32_32x32x16_bf16(b0, qr[d0], p0, 0, 0, 0);
        p1 = __builtin_amdgcn_mfma_f32_32x32x16_bf16(b1, qr[d0], p1, 0, 0, 0); }
}
template <int DQK> constexpr int att_lds_bytes() { return 2 * 64 * 128 * 2 + 2 * 64 * (DQK * 2 + 16) + NWAVES * 64 * 4; }
template <int DQK, int LDQ, int LDK, int LDV, int LDO>
__device__ __forceinline__ void attn_body(const bf16_t* __restrict__ Qb, const bf16_t* __restrict__ Kh, const bf16_t* __restrict__ Vh, bf16_t* __restrict__ Ob, int seq, float scale, char* lds) {
    constexpr int KP = DQK * 2 + 16, SHM_V = 64 * 128 * 2, SHM_K = 64 * KP, ND = DQK / 16, CH = DQK / 8, NKL = CH * 64 / NTHREADS;
    const float C = scale * 1.4426950408889634f, thr_raw = ATT_THR / scale;
    const int tid = threadIdx.x, wid = tid >> 6, lane = tid & 63, r32 = lane & 31, hi = lane >> 5;
    char* V_lds = lds; char* K_lds = lds + 2 * SHM_V;
    float* wsf = (float*)(lds + 2 * SHM_V + 2 * SHM_K) + wid * 64; float* li_l = wsf; float* al_l = wsf + 32;
    float m_reg = -1e30f, l_reg = 0; f32x16 o[4] = {}; bf16x8 qr[ND];
    const bf16_t* Qw = Qb + (long)(wid * 32 + r32) * LDQ + hi * 8;
#pragma unroll
    for (int d0 = 0; d0 < ND; ++d0) qr[d0] = *reinterpret_cast<const bf16x8*>(Qw + d0 * 16);
    const int sr = tid >> 4, sc = (tid & 15) * 8, vst0 = v_st(sr, sc), vst1 = v_st(32 + sr, sc);
    static_assert(DQK == 128, "double-pipelined body: 128-wide q.k only");
    const int vb0 = (int)(uintptr_t)V_lds + v_rd_base(lane);
    bf16x8 vs0, vs1, ks[NKL];
#define SLOAD(k0) do { vs0 = *reinterpret_cast<const bf16x8*>(&Vh[(long)((k0) + sr) * LDV + sc]); vs1 = *reinterpret_cast<const bf16x8*>(&Vh[(long)((k0) + 32 + sr) * LDV + sc]); \
    _Pragma("unroll") for (int i_ = 0; i_ < NKL; ++i_) ks[i_] = *reinterpret_cast<const bf16x8*>(&Kh[(long)((k0) + sr + 32 * i_) * LDK + sc]); } while (0)
#define SWRITE(b) do { *(bf16x8*)(V_lds + (b) * SHM_V + vst0) = vs0; *(bf16x8*)(V_lds + (b) * SHM_V + vst1) = vs1; \
    _Pragma("unroll") for (int i_ = 0; i_ < NKL; ++i_) *(bf16x8*)(K_lds + (b) * SHM_K + (sr + 32 * i_) * KP + sc * 2) = ks[i_]; } while (0)
#define RESC(a) do { if (__any((a) < 1.f)) { if (hi == 0) al_l[r32] = (a); asm volatile("s_waitcnt lgkmcnt(0)" ::: "memory"); \
    _Pragma("unroll") for (int d = 0; d < 4; ++d) _Pragma("unroll") for (int r = 0; r < 16; ++r) o[d][r] *= al_l[crow(r, hi)]; } } while (0)
    f32x16 pA0, pA1, pB0, pB1; float mnA, mnB, alA, alB; bf16x8 pa0, pa1, pa2, pa3; const int NT = seq / 64;
    SLOAD(0); asm volatile("s_waitcnt vmcnt(0)" ::: "memory"); SWRITE(0); __syncthreads();
    qkt<DQK>(pA0, pA1, K_lds, qr, r32, hi); partialSM(pA0, pA1, m_reg, mnA, alA, C, thr_raw);
    SLOAD(64);
    asm volatile("s_waitcnt vmcnt(0)" ::: "memory"); SWRITE(1); __syncthreads();
    for (int j = 1; j + 1 < NT; j += 2) {
        SBAR(); qkt<DQK>(pB0, pB1, K_lds + SHM_K, qr, r32, hi);
        finishSM(pA0, pA1, alA, l_reg, pa0, pa1, pa2, pa3); SBAR();
        SLOAD((j + 1) * 64); SBAR();
        pv_d0(o, vb0, pa0, pa1, pa2, pa3); partialSM(pB0, pB1, m_reg, mnB, alB, C, thr_raw);
        __syncthreads(); asm volatile("s_waitcnt vmcnt(0)" ::: "memory"); SWRITE(0);
        RESC(alB); __syncthreads();
        SBAR(); qkt<DQK>(pA0, pA1, K_lds, qr, r32, hi);
        finishSM(pB0, pB1, alB, l_reg, pa0, pa1, pa2, pa3); SBAR();
        SLOAD((j + 2) * 64); SBAR();
        pv_d0(o, vb0 + SHM_V, pa0, pa1, pa2, pa3); partialSM(pA0, pA1, m_reg, mnA, alA, C, thr_raw);
        __syncthreads(); asm volatile("s_waitcnt vmcnt(0)" ::: "memory"); SWRITE(1);
        RESC(alA); __syncthreads();
    }
    SBAR(); qkt<DQK>(pB0, pB1, K_lds + SHM_K, qr, r32, hi);
    finishSM(pA0, pA1, alA, l_reg, pa0, pa1, pa2, pa3); SBAR();
    pv_d0(o, vb0, pa0, pa1, pa2, pa3); partialSM(pB0, pB1, m_reg, mnB, alB, C, thr_raw);
    __syncthreads(); RESC(alB);
    finishSM(pB0, pB1, alB, l_reg, pa0, pa1, pa2, pa3); SBAR();
    pv_d0(o, vb0 + SHM_V, pa0, pa1, pa2, pa3);
    if (hi == 0) li_l[r32] = l_reg; asm volatile("s_waitcnt lgkmcnt(0)" ::: "memory");
    float rli[16];
#pragma unroll
    for (int r = 0; r < 16; ++r) rli[r] = __builtin_amdgcn_rcpf(li_l[crow(r, hi)]);
    bf16_t* Ow = Ob + (long)(wid * 32) * LDO;
#pragma unroll
    for (int r = 0; r < 16; ++r) { const int orow = crow(r, hi);
#pragma unroll
        for (int d0 = 0; d0 < 4; ++d0) Ow[(long)orow * LDO + d0 * 32 + r32] = (bf16_t)f2bf(o[d0][r] * rli[r]); }
    __syncthreads();
#undef SLOAD
#undef SWRITE
#undef RESC
}
template <int DQK, int LDQ, int LDK, int LDV, int LDO>
__device__ __forceinline__ void attn_body_single(const bf16_t* __restrict__ Qb, const bf16_t* __restrict__ Kh, const bf16_t* __restrict__ Vh, bf16_t* __restrict__ Ob, int seq, float scale, char* lds, int rope_t0) {
    constexpr int KP = DQK * 2 + 16, SHM_V = 64 * 128 * 2, SHM_K = 64 * KP, ND = DQK / 16, CH = DQK / 8, NKL = CH * 64 / NTHREADS;
    const float C = scale * 1.4426950408889634f, thr_raw = ATT_THR / scale;
    const int tid = threadIdx.x, wid = tid >> 6, lane = tid & 63, r32 = lane & 31, hi = lane >> 5;
    char* V_lds = lds; char* K_lds = lds + 2 * SHM_V;
    float* wsf = (float*)(lds + 2 * SHM_V + 2 * SHM_K) + wid * 64; float* li_l = wsf; float* al_l = wsf + 32;
    float m_reg = -1e30f, l_reg = 0; f32x16 o[4] = {}; bf16x8 qr[ND];
    const bf16_t* Qw = Qb + (long)(wid * 32 + r32) * LDQ + hi * 8;
#pragma unroll
    for (int d0 = 8; d0 < ND; ++d0) qr[d0] = *reinterpret_cast<const bf16x8*>(Qw + d0 * 16);
    if constexpr (DQK == 192) {
        if (rope_t0 >= 0) {
            const int tq = rope_t0 + wid * 32 + r32; const float prow = (float)(tq >> 6), pcol = (float)(tq & 63);
            u32x4 fa1 = __builtin_bit_cast(u32x4, qr[8]), fa2 = __builtin_bit_cast(u32x4, qr[9]), fb1 = __builtin_bit_cast(u32x4, qr[10]), fb2 = __builtin_bit_cast(u32x4, qr[11]);
#pragma unroll
            for (int jj = 0; jj < 4; ++jj) {
                float na1[2], na2[2], nb1[2], nb2[2];
#pragma unroll
                for (int e = 0; e < 2; ++e) { const float invf = __powf(10000.f, -(float)(hi * 8 + 2 * jj + e) * (1.f / 16.f));
                    const float ar = prow * invf, ac = pcol * invf, cr = __cosf(ar), sr_ = __sinf(ar), cc = __cosf(ac), sc_ = __sinf(ac);
                    const float a1 = e ? bfhi(fa1[jj]) : bflo(fa1[jj]), a2 = e ? bfhi(fa2[jj]) : bflo(fa2[jj]), b1 = e ? bfhi(fb1[jj]) : bflo(fb1[jj]), b2 = e ? bfhi(fb2[jj]) : bflo(fb2[jj]);
                    na1[e] = a1 * cr - a2 * sr_; na2[e] = a2 * cr + a1 * sr_; nb1[e] = b1 * cc - b2 * sc_; nb2[e] = b2 * cc + b1 * sc_; }
                fa1[jj] = pk2(na1[0], na1[1]); fa2[jj] = pk2(na2[0], na2[1]); fb1[jj] = pk2(nb1[0], nb1[1]); fb2[jj] = pk2(nb2[0], nb2[1]);
            }
            qr[8] = __builtin_bit_cast(bf16x8, fa1); qr[9] = __builtin_bit_cast(bf16x8, fa2); qr[10] = __builtin_bit_cast(bf16x8, fb1); qr[11] = __builtin_bit_cast(bf16x8, fb2);
        }
    }
    asm volatile("" ::: "memory");
#pragma unroll
    for (int d0 = 0; d0 < 8; ++d0) qr[d0] = *reinterpret_cast<const bf16x8*>(Qw + d0 * 16);
    const int sr = tid >> 4, sc = (tid & 15) * 8, vst0 = v_st(sr, sc), vst1 = v_st(32 + sr, sc);
    int krow[NKL], kch[NKL];
#pragma unroll
    for (int i = 0; i < NKL; ++i) { const int id = tid + i * NTHREADS; krow[i] = id / CH; kch[i] = id % CH; }
    const int vb0 = (int)(uintptr_t)V_lds + v_rd_base(lane);
    bf16x8 vs0, vs1, ks[NKL];
#define SLOAD(k0) do { vs0 = *reinterpret_cast<const bf16x8*>(&Vh[(long)((k0) + sr) * LDV + sc]); vs1 = *reinterpret_cast<const bf16x8*>(&Vh[(long)((k0) + 32 + sr) * LDV + sc]); \
    _Pragma("unroll") for (int i_ = 0; i_ < NKL; ++i_) ks[i_] = *reinterpret_cast<const bf16x8*>(&Kh[(long)((k0) + krow[i_]) * LDK + kch[i_] * 8]); } while (0)
#define SWRITE(b) do { *(bf16x8*)(V_lds + (b) * SHM_V + vst0) = vs0; *(bf16x8*)(V_lds + (b) * SHM_V + vst1) = vs1; \
    _Pragma("unroll") for (int i_ = 0; i_ < NKL; ++i_) *(bf16x8*)(K_lds + (b) * SHM_K + krow[i_] * KP + kch[i_] * 16) = ks[i_]; } while (0)
#define RESC(a) do { if (__any((a) < 1.f)) { if (hi == 0) al_l[r32] = (a); asm volatile("s_waitcnt lgkmcnt(0)" ::: "memory"); \
    _Pragma("unroll") for (int d = 0; d < 4; ++d) _Pragma("unroll") for (int r = 0; r < 16; ++r) o[d][r] *= al_l[crow(r, hi)]; } } while (0)
    f32x16 p0, p1; float mn, al; bf16x8 pa0, pa1, pa2, pa3; const int NT = seq / 64;
    SLOAD(0); asm volatile("s_waitcnt vmcnt(0)" ::: "memory"); SWRITE(0); __syncthreads();
    SLOAD(64);
    for (int j = 0; j < NT; ++j) {
        const int b = j & 1;
        SBAR(); qkt<DQK>(p0, p1, K_lds + b * SHM_K, qr, r32, hi);
        partialSM(p0, p1, m_reg, mn, al, C, thr_raw);
        RESC(al);
        finishSM(p0, p1, al, l_reg, pa0, pa1, pa2, pa3); SBAR();
        pv_d0(o, vb0 + b * SHM_V, pa0, pa1, pa2, pa3);
        if (j + 1 < NT) { asm volatile("s_waitcnt vmcnt(0)" ::: "memory"); SWRITE(b ^ 1); }
        __syncthreads();
        if (j + 2 < NT) SLOAD((j + 2) * 64);
    }
    if (hi == 0) li_l[r32] = l_reg; asm volatile("s_waitcnt lgkmcnt(0)" ::: "memory");
    float rli[16];
#pragma unroll
    for (int r = 0; r < 16; ++r) rli[r] = __builtin_amdgcn_rcpf(li_l[crow(r, hi)]);
    bf16_t* Ow = Ob + (long)(wid * 32) * LDO;
#pragma unroll
    for (int r = 0; r < 16; ++r) { const int orow = crow(r, hi);
#pragma unroll
        for (int d0 = 0; d0 < 4; ++d0) Ow[(long)orow * LDO + d0 * 32 + r32] = (bf16_t)f2bf(o[d0][r] * rli[r]); }
    __syncthreads();
#undef SLOAD
#undef SWRITE
#undef RESC
}
#define F8_ONE 0x7f7f7f7f
template <int DQK> __device__ __forceinline__ void qkt8(f32x16& p0, f32x16& p1, const char* Ks, const i32x8* qr, int r32, int hi) {
    constexpr int KP = DQK + 16;
    p0 = f32x16{}; p1 = f32x16{};
#pragma unroll
    for (int c = 0; c < DQK / 64; ++c) { const int cb = c * 64 + hi * 32;
        const u32x4 a0 = *reinterpret_cast<const u32x4*>(Ks + r32 * KP + cb), a1 = *reinterpret_cast<const u32x4*>(Ks + r32 * KP + cb + 16);
        const u32x4 b0 = *reinterpret_cast<const u32x4*>(Ks + (32 + r32) * KP + cb), b1 = *reinterpret_cast<const u32x4*>(Ks + (32 + r32) * KP + cb + 16);
        const i32x8 A = {(int)a0.x, (int)a0.y, (int)a0.z, (int)a0.w, (int)a1.x, (int)a1.y, (int)a1.z, (int)a1.w}, B = {(int)b0.x, (int)b0.y, (int)b0.z, (int)b0.w, (int)b1.x, (int)b1.y, (int)b1.z, (int)b1.w};
        p0 = __builtin_amdgcn_mfma_scale_f32_32x32x64_f8f6f4(A, qr[c], p0, 0, 0, 0, F8_ONE, 0, F8_ONE);
        p1 = __builtin_amdgcn_mfma_scale_f32_32x32x64_f8f6f4(B, qr[c], p1, 0, 0, 0, F8_ONE, 0, F8_ONE); }
}
__device__ __forceinline__ i32x8 q32_to_fp8(const bf16_t* p) {
    i32x8 r;
#pragma unroll
    for (int w = 0; w < 4; ++w) { const u32x4 v = *reinterpret_cast<const u32x4*>(p + 8 * w);
        r[2 * w] = (int)f8x4(bflo(v.x), bfhi(v.x), bflo(v.y), bfhi(v.y)); r[2 * w + 1] = (int)f8x4(bflo(v.z), bfhi(v.z), bflo(v.w), bfhi(v.w)); }
    return r;
}
__device__ __forceinline__ i32x8 q32_rope_fp8(const bf16_t* p, float pos) {
    float x[32];
#pragma unroll
    for (int w = 0; w < 4; ++w) { const u32x4 v = *reinterpret_cast<const u32x4*>(p + 8 * w);
#pragma unroll
        for (int e = 0; e < 4; ++e) { x[8 * w + 2 * e] = bflo(v[e]); x[8 * w + 2 * e + 1] = bfhi(v[e]); } }
    float y[32];
#pragma unroll
    for (int i = 0; i < 16; ++i) { const float ang = pos * __powf(10000.f, -(float)i * (1.f / 16.f)), cs = __cosf(ang), sn = __sinf(ang);
        y[i] = x[i] * cs - x[16 + i] * sn; y[16 + i] = x[16 + i] * cs + x[i] * sn; }
    i32x8 r;
#pragma unroll
    for (int w = 0; w < 8; ++w) r[w] = (int)f8x4(y[4 * w], y[4 * w + 1], y[4 * w + 2], y[4 * w + 3]);
    return r;
}
template <int DQK, int LDQ, int LDK, int LDV, int LDO>
__device__ __forceinline__ void attn8_body(const bf16_t* __restrict__ Qb, const unsigned char* __restrict__ Kh, const bf16_t* __restrict__ Vh, bf16_t* __restrict__ Ob, int seq, float scale, char* lds) {
    constexpr int KP = DQK + 16, SHM_V = 64 * 128 * 2, SHM_K = 64 * KP, NC = DQK / 64;
    static_assert(DQK == 128, "double-pipelined body: 128-wide q.k only");
    const float C = scale * 1.4426950408889634f, thr_raw = ATT_THR / scale;
    const int tid = threadIdx.x, wid = tid >> 6, lane = tid & 63, r32 = lane & 31, hi = lane >> 5;
    char* V_lds = lds; char* K_lds = lds + 2 * SHM_V;
    float* wsf = (float*)(lds + 2 * SHM_V + 2 * SHM_K) + wid * 64; float* li_l = wsf; float* al_l = wsf + 32;
    float m_reg = -1e30f, l_reg = 0; f32x16 o[4] = {}; i32x8 qr[NC];
    const bf16_t* Qw = Qb + (long)(wid * 32 + r32) * LDQ + hi * 32;
#pragma unroll
    for (int c = 0; c < NC; ++c) qr[c] = q32_to_fp8(Qw + 64 * c);
    const int sr = tid >> 4, sc = (tid & 15) * 8, vst0 = v_st(sr, sc), vst1 = v_st(32 + sr, sc);
    const int krow = tid >> 3, kch = (tid & 7) * 16;
    const int vb0 = (int)(uintptr_t)V_lds + v_rd_base(lane);
    bf16x8 vs0, vs1; u32x4 ks;
#define SLOAD(k0) do { vs0 = *reinterpret_cast<const bf16x8*>(&Vh[(long)((k0) + sr) * LDV + sc]); vs1 = *reinterpret_cast<const bf16x8*>(&Vh[(long)((k0) + 32 + sr) * LDV + sc]); \
    ks = *reinterpret_cast<const u32x4*>(&Kh[(long)((k0) + krow) * LDK + kch]); } while (0)
#define SWRITE(b) do { *(bf16x8*)(V_lds + (b) * SHM_V + vst0) = vs0; *(bf16x8*)(V_lds + (b) * SHM_V + vst1) = vs1; \
    *(u32x4*)(K_lds + (b) * SHM_K + krow * KP + kch) = ks; } while (0)
#define RESC(a) do { if (__any((a) < 1.f)) { if (hi == 0) al_l[r32] = (a); asm volatile("s_waitcnt lgkmcnt(0)" ::: "memory"); \
    _Pragma("unroll") for (int d = 0; d < 4; ++d) _Pragma("unroll") for (int r = 0; r < 16; ++r) o[d][r] *= al_l[crow(r, hi)]; } } while (0)
    f32x16 pA0, pA1, pB0, pB1; float mnA, mnB, alA, alB; bf16x8 pa0, pa1, pa2, pa3; const int NT = seq / 64;
    SLOAD(0); asm volatile("s_waitcnt vmcnt(0)" ::: "memory"); SWRITE(0); __syncthreads();
    qkt8<DQK>(pA0, pA1, K_lds, qr, r32, hi); partialSM(pA0, pA1, m_reg, mnA, alA, C, thr_raw);
    SLOAD(64);
    asm volatile("s_waitcnt vmcnt(0)" ::: "memory"); SWRITE(1); __syncthreads();
    for (int j = 1; j + 1 < NT; j += 2) {
        SBAR(); qkt8<DQK>(pB0, pB1, K_lds + SHM_K, qr, r32, hi);
        finishSM(pA0, pA1, alA, l_reg, pa0, pa1, pa2, pa3); SBAR();
        SLOAD((j + 1) * 64); SBAR();
        pv_d0(o, vb0, pa0, pa1, pa2, pa3); partialSM(pB0, pB1, m_reg, mnB, alB, C, thr_raw);
        __syncthreads(); asm volatile("s_waitcnt vmcnt(0)" ::: "memory"); SWRITE(0);
        RESC(alB); __syncthreads();
        SBAR(); qkt8<DQK>(pA0, pA1, K_lds, qr, r32, hi);
        finishSM(pB0, pB1, alB, l_reg, pa0, pa1, pa2, pa3); SBAR();
        SLOAD((j + 2) * 64); SBAR();
        pv_d0(o, vb0 + SHM_V, pa0, pa1, pa2, pa3); partialSM(pA0, pA1, m_reg, mnA, alA, C, thr_raw);
        __syncthreads(); asm volatile("s_waitcnt vmcnt(0)" ::: "memory"); SWRITE(1);
        RESC(alA); __syncthreads();
    }
    SBAR(); qkt8<DQK>(pB0, pB1, K_lds + SHM_K, qr, r32, hi);
    finishSM(pA0, pA1, alA, l_reg, pa0, pa1, pa2, pa3); SBAR();
    pv_d0(o, vb0, pa0, pa1, pa2, pa3); partialSM(pB0, pB1, m_reg, mnB, alB, C, thr_raw);
    __syncthreads(); RESC(alB);
    finishSM(pB0, pB1, alB, l_reg, pa0, pa1, pa2, pa3); SBAR();
    pv_d0(o, vb0 + SHM_V, pa0, pa1, pa2, pa3);
    if (hi == 0) li_l[r32] = l_reg; asm volatile("s_waitcnt lgkmcnt(0)" ::: "memory");
    float rli[16];
#pragma unroll
    for (int r = 0; r < 16; ++r) rli[r] = __builtin_amdgcn_rcpf(li_l[crow(r, hi)]);
    bf16_t* Ow = Ob + (long)(wid * 32) * LDO;
#pragma unroll
    for (int r = 0; r < 16; ++r) { const int orow = crow(r, hi);
#pragma unroll
        for (int d0 = 0; d0 < 4; ++d0) Ow[(long)orow * LDO + d0 * 32 + r32] = (bf16_t)f2bf(o[d0][r] * rli[r]); }
    __syncthreads();
#undef SLOAD
#undef SWRITE
#undef RESC
}
template <int DQK, int LDQ, int LDK, int LDV, int LDO>
__device__ __forceinline__ void attn8_body_single(const bf16_t* __restrict__ Qb, const unsigned char* __restrict__ Kh, const bf16_t* __restrict__ Vh, bf16_t* __restrict__ Ob, int seq, float scale, char* lds, int rope_t0) {
    constexpr int KP = DQK + 16, SHM_V = 64 * 128 * 2, SHM_K = 64 * KP, NC = DQK / 64, CH = DQK / 16, NCH = 64 * CH, NKL = (NCH + NTHREADS - 1) / NTHREADS;
    const float C = scale * 1.4426950408889634f, thr_raw = ATT_THR / scale;
    const int tid = threadIdx.x, wid = tid >> 6, lane = tid & 63, r32 = lane & 31, hi = lane >> 5;
    char* V_lds = lds; char* K_lds = lds + 2 * SHM_V;
    float* wsf = (float*)(lds + 2 * SHM_V + 2 * SHM_K) + wid * 64; float* li_l = wsf; float* al_l = wsf + 32;
    float m_reg = -1e30f, l_reg = 0; f32x16 o[4] = {}; i32x8 qr[NC];
    const bf16_t* Qw = Qb + (long)(wid * 32 + r32) * LDQ + hi * 32;
    if constexpr (DQK == 192) {
        if (rope_t0 >= 0) { const int tq = rope_t0 + wid * 32 + r32; qr[2] = q32_rope_fp8(Qw + 128, (float)(hi ? (tq & 63) : (tq >> 6))); }
        else qr[2] = q32_to_fp8(Qw + 128);
    }
    asm volatile("" ::: "memory");
#pragma unroll
    for (int c = 0; c < 2; ++c) qr[c] = q32_to_fp8(Qw + 64 * c);
    const int sr = tid >> 4, sc = (tid & 15) * 8, vst0 = v_st(sr, sc), vst1 = v_st(32 + sr, sc);
    int krow[NKL], kch[NKL];
#pragma unroll
    for (int i = 0; i < NKL; ++i) { const int id = tid + i * NTHREADS; krow[i] = (id < NCH) ? id / CH : 0; kch[i] = (id % CH) * 16; }
    const bool k2 = (NKL < 2) || (tid + NTHREADS < NCH);
    const int vb0 = (int)(uintptr_t)V_lds + v_rd_base(lane);
    bf16x8 vs0, vs1; u32x4 ks[NKL];
#define SLOAD(k0) do { vs0 = *reinterpret_cast<const bf16x8*>(&Vh[(long)((k0) + sr) * LDV + sc]); vs1 = *reinterpret_cast<const bf16x8*>(&Vh[(long)((k0) + 32 + sr) * LDV + sc]); \
    _Pragma("unroll") for (int i_ = 0; i_ < NKL; ++i_) ks[i_] = *reinterpret_cast<const u32x4*>(&Kh[(long)((k0) + krow[i_]) * LDK + kch[i_]]); } while (0)
#define SWRITE(b) do { *(bf16x8*)(V_lds + (b) * SHM_V + vst0) = vs0; *(bf16x8*)(V_lds + (b) * SHM_V + vst1) = vs1; \
    _Pragma("unroll") for (int i_ = 0; i_ < NKL; ++i_) if (i_ == 0 || k2) *(u32x4*)(K_lds + (b) * SHM_K + krow[i_] * KP + kch[i_]) = ks[i_]; } while (0)
#define RESC(a) do { if (__any((a) < 1.f)) { if (hi == 0) al_l[r32] = (a); asm volatile("s_waitcnt lgkmcnt(0)" ::: "memory"); \
    _Pragma("unroll") for (int d = 0; d < 4; ++d) _Pragma("unroll") for (int r = 0; r < 16; ++r) o[d][r] *= al_l[crow(r, hi)]; } } while (0)
    f32x16 p0, p1; float mn, al; bf16x8 pa0, pa1, pa2, pa3; const int NT = seq / 64;
    SLOAD(0); asm volatile("s_waitcnt vmcnt(0)" ::: "memory"); SWRITE(0); __syncthreads();
    SLOAD(64);
    for (int j = 0; j < NT; ++j) {
        const int b = j & 1;
        SBAR(); qkt8<DQK>(p0, p1, K_lds + b * SHM_K, qr, r32, hi);
        partialSM(p0, p1, m_reg, mn, al, C, thr_raw);
        RESC(al);
        finishSM(p0, p1, al, l_reg, pa0, pa1, pa2, pa3); SBAR();
        pv_d0(o, vb0 + b * SHM_V, pa0, pa1, pa2, pa3);
        if (j + 1 < NT) { asm volatile("s_waitcnt vmcnt(0)" ::: "memory"); SWRITE(b ^ 1); }
        __syncthreads();
        if (j + 2 < NT) SLOAD((j + 2) * 64);
    }
    if (hi == 0) li_l[r32] = l_reg; asm volatile("s_waitcnt lgkmcnt(0)" ::: "memory");
    float rli[16];
#pragma unroll
    for (int r = 0; r < 16; ++r) rli[r] = __builtin_amdgcn_rcpf(li_l[crow(r, hi)]);
    bf16_t* Ow = Ob + (long)(wid * 32) * LDO;
#pragma unroll
    for (int r = 0; r < 16; ++r) { const int orow = crow(r, hi);
#pragma unroll
        for (int d0 = 0; d0 < 4; ++d0) Ow[(long)orow * LDO + d0 * 32 + r32] = (bf16_t)f2bf(o[d0][r] * rli[r]); }
    __syncthreads();
#undef SLOAD
#undef SWRITE
#undef RESC
}
constexpr float ATT8_THR = 3.5f, ATT8_SH = 3.f;
#ifndef ATT8_FIXED_M
#define ATT8_FIXED_M 0
#endif
__device__ __forceinline__ void partialSM8(f32x16& p0, f32x16& p1, float& m_reg, float& mn, float& alpha, float C, float thr_raw) {
#if ATT8_FIXED_M
    mn = 6.f * 1.4426950408889634f / C; alpha = 1.f; m_reg = mn;
#else
    float pmax = p0[0];
#pragma unroll
    for (int r = 1; r < 16; ++r) pmax = fmaxf(pmax, p0[r]);
#pragma unroll
    for (int r = 0; r < 16; ++r) pmax = fmaxf(pmax, p1[r]);
    { auto rr = __builtin_amdgcn_permlane32_swap(__float_as_uint(pmax), __float_as_uint(pmax), false, false);
      pmax = fmaxf(__uint_as_float(rr[0]), __uint_as_float(rr[1])); }
    if (__builtin_expect(__all(pmax - m_reg <= thr_raw), 1)) { mn = m_reg; alpha = 1.f; }
    else { mn = fmaxf(m_reg, pmax); alpha = __builtin_amdgcn_exp2f((m_reg - mn) * C); m_reg = mn; }
#endif
    const float mnC = ATT8_SH - mn * C;
#pragma unroll
    for (int r = 0; r < 16; ++r) p0[r] = fmaf(p0[r], C, mnC);
#pragma unroll
    for (int r = 0; r < 16; ++r) p1[r] = fmaf(p1[r], C, mnC);
#pragma unroll
    for (int r = 0; r < 16; ++r) p0[r] = __builtin_amdgcn_exp2f(p0[r]);
}
__device__ __forceinline__ void finishSM8(f32x16& p0, f32x16& p1, i32x8& pa) {
#pragma unroll
    for (int r = 0; r < 16; ++r) p1[r] = __builtin_amdgcn_exp2f(p1[r]);
#pragma unroll
    for (int w = 0; w < 4; ++w) { pa[w] = (int)f8x4(p0[4 * w], p0[4 * w + 1], p0[4 * w + 2], p0[4 * w + 3]); pa[4 + w] = (int)f8x4(p1[4 * w], p1[4 * w + 1], p1[4 * w + 2], p1[4 * w + 3]); }
}
__device__ __forceinline__ void finishSM8s(f32x16& p0, f32x16& p1, float alpha, float& l_reg, i32x8& pa) {
#pragma unroll
    for (int r = 0; r < 16; ++r) p1[r] = __builtin_amdgcn_exp2f(p1[r]);
    float ps = 0;
#pragma unroll
    for (int r = 0; r < 16; ++r) ps += p0[r];
#pragma unroll
    for (int r = 0; r < 16; ++r) ps += p1[r];
    { auto rr = __builtin_amdgcn_permlane32_swap(__float_as_uint(ps), __float_as_uint(ps), false, false);
      ps = __uint_as_float(rr[0]) + __uint_as_float(rr[1]); }
    l_reg = l_reg * alpha + ps;
#pragma unroll
    for (int w = 0; w < 4; ++w) { pa[w] = (int)f8x4(p0[4 * w], p0[4 * w + 1], p0[4 * w + 2], p0[4 * w + 3]); pa[4 + w] = (int)f8x4(p1[4 * w], p1[4 * w + 1], p1[4 * w + 2], p1[4 * w + 3]); }
}
typedef int i32x2 __attribute__((ext_vector_type(2)));
template <int OFF> __device__ __forceinline__ u32x2 tr8_read(int vb) { typedef i32x2 LAS* lp; const i32x2 r = __builtin_amdgcn_ds_read_tr8_b64_v2i32((lp)(uintptr_t)(unsigned)(vb + OFF)); return (u32x2){(unsigned)r.x, (unsigned)r.y}; }
#define F8_MFMA(A_, B_, C_) __builtin_amdgcn_mfma_scale_f32_32x32x64_f8f6f4(A_, B_, C_, 0, 0, 0, F8_ONE, 0, F8_ONE)
#define TR8X4(T, VB) const u32x2 T[4] = {tr8_read<0>(VB), tr8_read<2048>(VB), tr8_read<4096>(VB), tr8_read<6144>(VB)}
#define TR8B(T) (i32x8){(int)T[0].x, (int)T[0].y, (int)T[1].x, (int)T[1].y, (int)T[2].x, (int)T[2].y, (int)T[3].x, (int)T[3].y}
__device__ __forceinline__ void pv8_pairs(f32x16* o, const int* vb, int boff, const i32x8& pa) {
    { TR8X4(a, vb[0] + boff); TR8X4(b, vb[1] + boff);
      o[0] = F8_MFMA(pa, TR8B(a), o[0]);
      o[1] = F8_MFMA(pa, TR8B(b), o[1]); }
    { TR8X4(c, vb[2] + boff); TR8X4(d, vb[3] + boff);
      o[2] = F8_MFMA(pa, TR8B(c), o[2]);
      o[3] = F8_MFMA(pa, TR8B(d), o[3]); }
}
__device__ __forceinline__ void pv8_seq(f32x16* o, const int* vb, int boff, const i32x8& pa) {
    const i32x8 ones = {0x38383838, 0x38383838, 0x38383838, 0x38383838, 0x38383838, 0x38383838, 0x38383838, 0x38383838};
    { TR8X4(a, vb[0] + boff); o[4] = F8_MFMA(pa, ones, o[4]); o[0] = F8_MFMA(pa, TR8B(a), o[0]); }
    { TR8X4(b, vb[1] + boff); o[1] = F8_MFMA(pa, TR8B(b), o[1]); }
    { TR8X4(c, vb[2] + boff); o[2] = F8_MFMA(pa, TR8B(c), o[2]); }
    { TR8X4(d, vb[3] + boff); o[3] = F8_MFMA(pa, TR8B(d), o[3]); }
}
template <bool ALL16> __device__ __forceinline__ void pv8_all(f32x16* o, const int* vb, int boff, const i32x8& pa) {
    const i32x8 ones = {0x38383838, 0x38383838, 0x38383838, 0x38383838, 0x38383838, 0x38383838, 0x38383838, 0x38383838};
    if constexpr (ALL16) {
        TR8X4(a, vb[0] + boff); TR8X4(b, vb[1] + boff); TR8X4(c, vb[2] + boff); TR8X4(d, vb[3] + boff);
        o[4] = F8_MFMA(pa, ones, o[4]);
        o[0] = F8_MFMA(pa, TR8B(a), o[0]);
        o[1] = F8_MFMA(pa, TR8B(b), o[1]);
        o[2] = F8_MFMA(pa, TR8B(c), o[2]);
        o[3] = F8_MFMA(pa, TR8B(d), o[3]);
    } else {
        { TR8X4(a, vb[0] + boff); TR8X4(b, vb[1] + boff);
          o[4] = F8_MFMA(pa, ones, o[4]);
          o[0] = F8_MFMA(pa, TR8B(a), o[0]);
          o[1] = F8_MFMA(pa, TR8B(b), o[1]); }
        { TR8X4(c, vb[2] + boff); TR8X4(d, vb[3] + boff);
          o[2] = F8_MFMA(pa, TR8B(c), o[2]);
          o[3] = F8_MFMA(pa, TR8B(d), o[3]); }
    }
}
__device__ __forceinline__ int v8_f(int key) { return ((key >> 1) & 1) + 2 * ((key >> 3) & 1); }
__device__ __forceinline__ int v8_st(int key, int ch16) { return key * 128 + 32 * ((ch16 >> 1) ^ v8_f(key)) + 16 * (ch16 & 1); }
__device__ __forceinline__ int v8_rd_base(int lane, int db) {
    const int q = (lane & 15) >> 1, pp = lane & 1, g1 = (lane >> 4) & 1, hi = lane >> 5, fq = ((q >> 1) & 1) + 2 * (q >> 2);
    return (8 * (q >> 2) + 4 * hi + (q & 3)) * 128 + 32 * (db ^ fq) + 16 * g1 + 8 * pp;
}
template <int DQK, int LDQ, int LDK, int LDV, int LDO>
__device__ __forceinline__ void attn88_body(const bf16_t* __restrict__ Qb, const unsigned char* __restrict__ Kh, const unsigned char* __restrict__ Vh, bf16_t* __restrict__ Ob, int seq, float scale, char* lds) {
    constexpr int KP = DQK + 16, SHM_V = 64 * 128, SHM_K = 64 * KP, NC = DQK / 64;
    static_assert(DQK == 128, "double-pipelined body: 128-wide q.k only");
    const float C = scale * 1.4426950408889634f, thr_raw = ATT8_THR / scale;
    const int tid = threadIdx.x, wid = tid >> 6, lane = tid & 63, r32 = lane & 31, hi = lane >> 5;
    char* V_lds = lds; char* K_lds = lds + 2 * SHM_V;
    float* al_l = (float*)(lds + 2 * SHM_V + 2 * SHM_K) + wid * 32;
    float m_reg = -1e30f; f32x16 o[5] = {}; i32x8 qr[NC];
    const bf16_t* Qw = Qb + (long)(wid * 32 + r32) * LDQ + hi * 32;
#pragma unroll
    for (int c = 0; c < NC; ++c) qr[c] = q32_to_fp8(Qw + 64 * c);
    const int krow = tid >> 3, kch = (tid & 7) * 16, vst = v8_st(krow, tid & 7);
    int vb[4];
#pragma unroll
    for (int d = 0; d < 4; ++d) vb[d] = (int)(uintptr_t)V_lds + v8_rd_base(lane, d);
    u32x4 vs, ks;
#define SLOAD(k0) do { vs = *reinterpret_cast<const u32x4*>(&Vh[(long)((k0) + krow) * LDV + kch]); ks = *reinterpret_cast<const u32x4*>(&Kh[(long)((k0) + krow) * LDK + kch]); } while (0)
#define SWRITE(b) do { *(u32x4*)(V_lds + (b) * SHM_V + vst) = vs; *(u32x4*)(K_lds + (b) * SHM_K + krow * KP + kch) = ks; } while (0)
#define RESC(a) do { if (__any((a) < 1.f)) { if (hi == 0) al_l[r32] = (a); asm volatile("s_waitcnt lgkmcnt(0)" ::: "memory"); \
    _Pragma("unroll") for (int d = 0; d < 5; ++d) _Pragma("unroll") for (int r = 0; r < 16; ++r) o[d][r] *= al_l[crow(r, hi)]; } } while (0)
#define PV8(b) pv8_all<DQK == 128>(o, vb, (b) * SHM_V, pa)
    f32x16 pA0, pA1, pB0, pB1; float mnA, mnB, alA, alB; i32x8 pa; const int NT = seq / 64;
    SLOAD(0); asm volatile("s_waitcnt vmcnt(0)" ::: "memory"); SWRITE(0); __syncthreads();
    qkt8<DQK>(pA0, pA1, K_lds, qr, r32, hi); partialSM8(pA0, pA1, m_reg, mnA, alA, C, thr_raw);
    SLOAD(64);
    asm volatile("s_waitcnt vmcnt(0)" ::: "memory"); SWRITE(1); __syncthreads();
    for (int j = 1; j + 1 < NT; j += 2) {
        SBAR(); qkt8<DQK>(pB0, pB1, K_lds + SHM_K, qr, r32, hi);
        finishSM8(pA0, pA1, pa); SBAR();
        SLOAD((j + 1) * 64); SBAR();
        PV8(0); partialSM8(pB0, pB1, m_reg, mnB, alB, C, thr_raw);
        __syncthreads(); asm volatile("s_waitcnt vmcnt(0)" ::: "memory"); SWRITE(0);
        RESC(alB); __syncthreads();
        SBAR(); qkt8<DQK>(pA0, pA1, K_lds, qr, r32, hi);
        finishSM8(pB0, pB1, pa); SBAR();
        SLOAD((j + 2) * 64); SBAR();
        PV8(1); partialSM8(pA0, pA1, m_reg, mnA, alA, C, thr_raw);
        __syncthreads(); asm volatile("s_waitcnt vmcnt(0)" ::: "memory"); SWRITE(1);
        RESC(alA); __syncthreads();
    }
    SBAR(); qkt8<DQK>(pB0, pB1, K_lds + SHM_K, qr, r32, hi);
    finishSM8(pA0, pA1, pa); SBAR();
    PV8(0); partialSM8(pB0, pB1, m_reg, mnB, alB, C, thr_raw);
    __syncthreads(); RESC(alB);
    finishSM8(pB0, pB1, pa); SBAR();
    PV8(1);
    float rli[16];
#pragma unroll
    for (int r = 0; r < 16; ++r) rli[r] = __builtin_amdgcn_rcpf(o[4][r]);
    bf16_t* Ow = Ob + (long)(wid * 32) * LDO;
#pragma unroll
    for (int r = 0; r < 16; ++r) { const int orow = crow(r, hi);
#pragma unroll
        for (int d0 = 0; d0 < 4; ++d0) Ow[(long)orow * LDO + d0 * 32 + r32] = (bf16_t)f2bf(o[d0][r] * rli[r]); }
    __syncthreads();
#undef SLOAD
#undef SWRITE
}
template <int DQK, int LDQ, int LDK, int LDV, int LDO>
__device__ __forceinline__ void attn88_body_single(const bf16_t* __restrict__ Qb, const unsigned char* __restrict__ Kh, const unsigned char* __restrict__ Vh, bf16_t* __restrict__ Ob, int seq, float scale, char* lds, int rope_t0) {
    constexpr int KP = DQK + 16, SHM_V = 64 * 128, SHM_K = 64 * KP, NC = DQK / 64, CH = DQK / 16, NCH = 64 * CH, NKL = (NCH + NTHREADS - 1) / NTHREADS;
    const float C = scale * 1.4426950408889634f, thr_raw = ATT8_THR / scale;
    const int tid = threadIdx.x, wid = tid >> 6, lane = tid & 63, r32 = lane & 31, hi = lane >> 5;
    char* V_lds = lds; char* K_lds = lds + 2 * SHM_V;
    float* al_l = (float*)(lds + 2 * SHM_V + 2 * SHM_K) + wid * 32;
    float m_reg = -1e30f; i32x8 qr[NC];
    const bf16_t* Qw = Qb + (long)(wid * 32 + r32) * LDQ + hi * 32;
    if constexpr (DQK == 192) {
        if (rope_t0 >= 0) { const int tq = rope_t0 + wid * 32 + r32; qr[2] = q32_rope_fp8(Qw + 128, (float)(hi ? (tq & 63) : (tq >> 6))); }
        else qr[2] = q32_to_fp8(Qw + 128);
    }
    asm volatile("" ::: "memory");
#pragma unroll
    for (int c = 0; c < 2; ++c) qr[c] = q32_to_fp8(Qw + 64 * c);
    const int vrow = tid >> 3, vch = (tid & 7) * 16, vst = v8_st(vrow, tid & 7);
    unsigned koff[NKL]; int klds[NKL]; const unsigned voff = (unsigned)(vrow * LDV + vch);
#pragma unroll
    for (int i = 0; i < NKL; ++i) { const int id = tid + i * NTHREADS, kr = (id < NCH) ? id / CH : 0, kc = (id % CH) * 16; koff[i] = (unsigned)(kr * LDK + kc); klds[i] = kr * KP + kc; }
    const bool k2 = (NKL < 2) || (tid + NTHREADS < NCH);
    int vb[4];
#pragma unroll
    for (int d = 0; d < 4; ++d) vb[d] = (int)(uintptr_t)V_lds + v8_rd_base(lane, d);
    u32x4 vs, ks[NKL];
#define SLOAD(k0) do { const unsigned char* vt_ = Vh + (size_t)(k0) * LDV; const unsigned char* kt_ = Kh + (size_t)(k0) * LDK; vs = *reinterpret_cast<const u32x4*>(vt_ + voff); \
    _Pragma("unroll") for (int i_ = 0; i_ < NKL; ++i_) ks[i_] = *reinterpret_cast<const u32x4*>(kt_ + koff[i_]); } while (0)
#define SWRITE(b) do { *(u32x4*)(V_lds + (b) * SHM_V + vst) = vs; \
    _Pragma("unroll") for (int i_ = 0; i_ < NKL; ++i_) if (i_ == 0 || k2) *(u32x4*)(K_lds + (b) * SHM_K + klds[i_]) = ks[i_]; } while (0)
    asm volatile("" ::: "memory");
    f32x16 o[5] = {}; f32x16 p0, p1; float mn, al; i32x8 pa; const int NT = seq / 64;
    SLOAD(0); asm volatile("s_waitcnt vmcnt(0)" ::: "memory"); SWRITE(0); __syncthreads();
    SLOAD(64);
    for (int j = 0; j < NT; ++j) {
        const int b = j & 1;
        SBAR(); qkt8<DQK>(p0, p1, K_lds + b * SHM_K, qr, r32, hi);
        partialSM8(p0, p1, m_reg, mn, al, C, thr_raw);
        RESC(al);
        finishSM8(p0, p1, pa); SBAR();
        PV8(b);
        if (j + 1 < NT) { asm volatile("s_waitcnt vmcnt(0)" ::: "memory"); SWRITE(b ^ 1); }
        __syncthreads();
        if (j + 2 < NT) SLOAD((j + 2) * 64);
    }
    float rli[16];
#pragma unroll
    for (int r = 0; r < 16; ++r) rli[r] = __builtin_amdgcn_rcpf(o[4][r]);
    bf16_t* Ow = Ob + (long)(wid * 32) * LDO;
#pragma unroll
    for (int r = 0; r < 16; ++r) { const int orow = crow(r, hi);
#pragma unroll
        for (int d0 = 0; d0 < 4; ++d0) Ow[(long)orow * LDO + d0 * 32 + r32] = (bf16_t)f2bf(o[d0][r] * rli[r]); }
    __syncthreads();
#undef SLOAD
#undef SWRITE
#undef RESC
#undef PV8
}
template <int DQK, int LDQ, int LDK, int LDV, int LDO, int VAR = 0>
__device__ __forceinline__ void attn88_pp(const bf16_t* __restrict__ Qb, const unsigned char* __restrict__ Kh, const unsigned char* __restrict__ Vh, bf16_t* __restrict__ Ob, int seq, float scale, char* lds, int rope_t0) {
#define PPBAR() do { SBAR(); __syncthreads(); SBAR(); } while (0)
    constexpr int KP = DQK + 16, SHM_V = 64 * 128, SHM_K = 64 * KP, SHM_P = SHM_V + SHM_K, NC = DQK / 64, CH = DQK / 16, NCH = 64 * CH, NKL = (NCH + NTHREADS - 1) / NTHREADS;
    const float C = scale * 1.4426950408889634f, thr_raw = ATT8_THR / scale;
    const int tid = threadIdx.x, wid = __builtin_amdgcn_readfirstlane(tid >> 6), lane = tid & 63, r32 = lane & 31, hi = lane >> 5, grp = wid >> 2;
    char* P_lds = lds;
    float* al_l = (float*)(lds + 2 * SHM_P) + wid * 32;
    constexpr bool MSUM = (DQK == 128);
    float m_reg = -1e30f, l_reg = 0.f; i32x8 qr[NC];
    const bf16_t* Qw = Qb + (long)(wid * 32 + r32) * LDQ + hi * 32;
    if constexpr (DQK == 192) {
        if (rope_t0 >= 0) { const int tq = rope_t0 + wid * 32 + r32; qr[2] = q32_rope_fp8(Qw + 128, (float)(hi ? (tq & 63) : (tq >> 6))); }
        else qr[2] = q32_to_fp8(Qw + 128);
    }
    asm volatile("" ::: "memory");
#pragma unroll
    for (int c = 0; c < 2; ++c) qr[c] = q32_to_fp8(Qw + 64 * c);
    const int vrow = tid >> 3, vch = (tid & 7) * 16, vst = v8_st(vrow, tid & 7);
    unsigned koff[NKL]; int klds[NKL]; const unsigned voff = (unsigned)(vrow * LDV + vch);
#pragma unroll
    for (int i = 0; i < NKL; ++i) { const int id = tid + i * NTHREADS, kr = (id < NCH) ? id / CH : 0, kc = (id % CH) * 16; koff[i] = (unsigned)(kr * LDK + kc); klds[i] = kr * KP + kc; }
    const bool k2 = (NKL < 2) || (tid + NTHREADS < NCH);
    int vb[4];
#pragma unroll
    for (int d = 0; d < 4; ++d) vb[d] = (int)(uintptr_t)P_lds + v8_rd_base(lane, d);
    u32x4 vs, ks[NKL]; const int NT = seq / 64;
#define PLOAD(jp) do { const int jv_ = (jp) < NT ? (jp) : NT - 1, jk_ = (jp) + 1 < NT ? (jp) + 1 : NT - 1; const unsigned char* vt_ = Vh + (size_t)jv_ * 64 * LDV; const unsigned char* kt_ = Kh + (size_t)jk_ * 64 * LDK; \
    vs = *reinterpret_cast<const u32x4*>(vt_ + voff); _Pragma("unroll") for (int i_ = 0; i_ < NKL; ++i_) ks[i_] = *reinterpret_cast<const u32x4*>(kt_ + koff[i_]); } while (0)
#define PWRITE(b) do { *(u32x4*)(P_lds + (b) * SHM_P + vst) = vs; \
    _Pragma("unroll") for (int i_ = 0; i_ < NKL; ++i_) if (i_ == 0 || k2) *(u32x4*)(P_lds + (b) * SHM_P + SHM_V + klds[i_]) = ks[i_]; } while (0)
#define RESC(a) do { if (__any((a) < 1.f)) { if (hi == 0) al_l[r32] = (a); asm volatile("s_waitcnt lgkmcnt(0)" ::: "memory"); \
    _Pragma("unroll") for (int d = 0; d < (MSUM ? 5 : 4); ++d) _Pragma("unroll") for (int r = 0; r < 16; ++r) o[d][r] *= al_l[crow(r, hi)]; } } while (0)
    asm volatile("" ::: "memory");
    f32x16 o[5] = {}; f32x16 p0 = {}, p1 = {}; float mn, al; i32x8 pa = {};
    { const unsigned char* kt_ = Kh;
#pragma unroll
      for (int i_ = 0; i_ < NKL; ++i_) ks[i_] = *reinterpret_cast<const u32x4*>(kt_ + koff[i_]);
      asm volatile("s_waitcnt vmcnt(0)" ::: "memory");
#pragma unroll
      for (int i_ = 0; i_ < NKL; ++i_) if (i_ == 0 || k2) *(u32x4*)(P_lds + SHM_P + SHM_V + klds[i_]) = ks[i_]; }
    PLOAD(0); asm volatile("s_waitcnt vmcnt(0)" ::: "memory"); PWRITE(0);
    PLOAD(1);
    PPBAR();
#define STAGE(j_) do { if (!(VAR & 4) && (j_) + 1 < NT) { asm volatile("s_waitcnt vmcnt(0)" ::: "memory"); PWRITE(((j_) + 1) & 1); if ((j_) + 2 < NT) PLOAD((j_) + 2); } } while (0)
#define HALF_A() do { if (VAR & 1) { _Pragma("unroll") for (int w_ = 0; w_ < 8; ++w_) pa[w_] = (int)__float_as_uint(w_ < 4 ? p0[4 * w_] : p1[4 * w_ - 16]); break; } partialSM8(p0, p1, m_reg, mn, al, C, thr_raw); RESC(al); if constexpr (MSUM) finishSM8(p0, p1, pa); else finishSM8s(p0, p1, al, l_reg, pa); asm volatile("" : "+v"(pa)); } while (0)
#define HALF_B(j_) do { if (VAR & 2) { _Pragma("unroll") for (int r_ = 0; r_ < 16; ++r_) { p0[r_] = __uint_as_float((unsigned)pa[r_ & 7]) * 1e-30f + (float)r_; p1[r_] = p0[r_] + 1.f; } o[0][(j_) & 15] += p0[3]; break; } const int boff_ = ((j_) & 1) * SHM_P; if constexpr (MSUM) pv8_all<true>(o, vb, boff_, pa); else pv8_pairs(o, vb, boff_, pa); if ((j_) + 1 < NT) { SBAR(); qkt8<DQK>(p0, p1, P_lds + boff_ + SHM_V, qr, r32, hi); asm volatile("" : "+v"(p0), "+v"(p1)); } } while (0)
    if (grp == 0) {
        qkt8<DQK>(p0, p1, P_lds + SHM_P + SHM_V, qr, r32, hi); PPBAR();
#pragma unroll 1
        for (int j = 0; j < NT; ++j) {
            HALF_A(); PPBAR();
            STAGE(j); HALF_B(j); PPBAR();
        }
        PPBAR();
    } else {
        PPBAR();
        qkt8<DQK>(p0, p1, P_lds + SHM_P + SHM_V, qr, r32, hi); PPBAR();
#pragma unroll 1
        for (int j = 0; j < NT; ++j) {
            STAGE(j); HALF_A(); PPBAR();
            HALF_B(j); PPBAR();
        }
    }
#undef STAGE
#undef HALF_A
#undef HALF_B
    float rli[16];
    if constexpr (MSUM) {
#pragma unroll
        for (int r = 0; r < 16; ++r) rli[r] = __builtin_amdgcn_rcpf(o[4][r]);
    } else {
        if (hi == 0) al_l[r32] = l_reg; asm volatile("s_waitcnt lgkmcnt(0)" ::: "memory");
#pragma unroll
        for (int r = 0; r < 16; ++r) rli[r] = __builtin_amdgcn_rcpf(al_l[crow(r, hi)]);
    }
    { int t2 = threadIdx.x; asm volatile("" : "+v"(t2));
      const int w2 = t2 >> 6, r2 = t2 & 31, h2 = (t2 >> 5) & 1;
      bf16_t* Ow = Ob + (long)(w2 * 32) * LDO;
#pragma unroll
      for (int r = 0; r < 16; ++r) { const int orow = crow(r, h2);
#pragma unroll
          for (int d0 = 0; d0 < 4; ++d0) Ow[(long)orow * LDO + d0 * 32 + r2] = (bf16_t)f2bf(o[d0][r] * rli[r]); } }
    PPBAR();
#undef PLOAD
#undef PWRITE
#undef RESC
#undef PPBAR
}
#ifndef ATTN_PP
#define ATTN_PP 1
#endif
#if ATTN_PP
#define ATTN_MLA attn88_pp
#define ATTN_GQA attn88_pp
#else
#define ATTN_MLA attn88_body_single
#define ATTN_GQA(...) attn88_body
#endif
__device__ __forceinline__ void p_attn_mla(const Args& A, const Frame& F) {
    const bf16_t* Q = (const bf16_t*)(F.ws + WS_Q); const unsigned char* Kb = F.ws + WS_K; const unsigned char* Vb = F.ws + WS_V; bf16_t* O = (bf16_t*)(F.ws + WS_O);
    const float scale = 0.07216878364870322f;
    for (int u = F.vcu; u < 544; u += F.nblk) {
        int b, h, q0, seq;
        int rope_t0;
        if (u < 512) { const int qb = u & 15; h = (u >> 4) & 7; b = u >> 7; q0 = CTXL + qb * 256; seq = RPB; rope_t0 = qb * 256; }
        else { const int v = u - 512; h = v & 7; b = v >> 3; q0 = 0; seq = CTXL; rope_t0 = -1; }
        const size_t rb = (size_t)b * RPB;
        ATTN_MLA<192, 1536, 1536, 1024, 1024>(Q + (rb + q0) * 1536 + h * 192, Kb + rb * 1536 + h * 192, Vb + rb * 1024 + h * 128, O + (rb + q0) * 1024 + h * 128, seq, scale, F.lds, rope_t0);
    }
}
template <int VAR = 0> __device__ __forceinline__ void p_attn_gqa(const Args& A, const Frame& F, bf16_t* O) {
    const bf16_t* Q = (const bf16_t*)(F.ws + WS_Q1); const unsigned char* Kb = F.ws + WS_K1; const unsigned char* Vb = F.ws + WS_V1;
    const float scale = 0.08838834764831845f;
    for (int u = F.vcu; u < 512; u += F.nblk) {
        const int qb = u & 15, h = (u >> 4) & 7, b = u >> 7, q0 = CTXL + qb * 256, kvh = h >> 2;
        const size_t rb = (size_t)b * RPB;
        attn88_pp<128, 1024, 256, 256, 1024, VAR>(Q + (rb + q0) * 1024 + h * 128, Kb + rb * 256 + kvh * 128, Vb + rb * 256 + kvh * 128, O + (rb + q0) * 1024 + h * 128, RPB, scale, F.lds, -1);
    }
}
#define DPP_XOR1 0xB1
#define DPP_XOR2 0x4E
#define DPP_HMIRROR 0x141
#define DPP_MIRROR 0x140
__device__ __forceinline__ int row_max_i(int v) {
    v = max(v, __builtin_amdgcn_update_dpp(v, v, DPP_XOR1, 0xf, 0xf, false));
    v = max(v, __builtin_amdgcn_update_dpp(v, v, DPP_XOR2, 0xf, 0xf, false));
    v = max(v, __builtin_amdgcn_update_dpp(v, v, DPP_HMIRROR, 0xf, 0xf, false));
    v = max(v, __builtin_amdgcn_update_dpp(v, v, DPP_MIRROR, 0xf, 0xf, false));
    return v;
}
__device__ __forceinline__ float row_sum_f(float v) {
    v += __builtin_bit_cast(float, __builtin_amdgcn_update_dpp(0, __builtin_bit_cast(int, v), DPP_XOR1, 0xf, 0xf, false));
    v += __builtin_bit_cast(float, __builtin_amdgcn_update_dpp(0, __builtin_bit_cast(int, v), DPP_XOR2, 0xf, 0xf, false));
    v += __builtin_bit_cast(float, __builtin_amdgcn_update_dpp(0, __builtin_bit_cast(int, v), DPP_HMIRROR, 0xf, 0xf, false));
    v += __builtin_bit_cast(float, __builtin_amdgcn_update_dpp(0, __builtin_bit_cast(int, v), DPP_MIRROR, 0xf, 0xf, false));
    return v;
}
__device__ __forceinline__ int fkey(float f) { const int b = __builtin_bit_cast(int, f); return b ^ ((b >> 31) & 0x7fffffff); }
__device__ __forceinline__ float keyf(int k) { return __builtin_bit_cast(float, k ^ ((k >> 31) & 0x7fffffff)); }
__device__ __forceinline__ void cand_ij(int t, int& i, int& j) {
    const int g16 = t >= 16, g24 = t >= 24, g29 = t >= 29, g33 = t >= 33, g36 = t >= 36, g38 = t >= 38, g40 = t >= 40;
    i = g16 + g24 + g29 + g33 + g36 + g38 + g40 + max(t - 41, 0);
    const int base = 16 * g16 + 8 * g24 + 5 * g29 + 4 * g33 + 3 * g36 + 2 * g38 + 2 * g40;
    j = (t >= 42) ? 0 : t - base;
    if (t >= 50) { i = 0; j = 0; }
}
__device__ __forceinline__ void row_max2(int& a, int& b) {
    asm volatile("s_nop 1\n\t"
                 "v_max_i32_dpp %0, %0, %0 quad_perm:[1,0,3,2] row_mask:0xf bank_mask:0xf\n\tv_max_i32_dpp %1, %1, %1 quad_perm:[1,0,3,2] row_mask:0xf bank_mask:0xf\n\ts_nop 0\n\t"
                 "v_max_i32_dpp %0, %0, %0 quad_perm:[2,3,0,1] row_mask:0xf bank_mask:0xf\n\tv_max_i32_dpp %1, %1, %1 quad_perm:[2,3,0,1] row_mask:0xf bank_mask:0xf\n\ts_nop 0\n\t"
                 "v_max_i32_dpp %0, %0, %0 row_half_mirror row_mask:0xf bank_mask:0xf\n\tv_max_i32_dpp %1, %1, %1 row_half_mirror row_mask:0xf bank_mask:0xf\n\ts_nop 0\n\t"
                 "v_max_i32_dpp %0, %0, %0 row_mirror row_mask:0xf bank_mask:0xf\n\tv_max_i32_dpp %1, %1, %1 row_mirror row_mask:0xf bank_mask:0xf\n\ts_nop 1"
                 : "+v"(a), "+v"(b));
}
__device__ __forceinline__ void row_max1(int& a) {
    asm volatile("s_nop 1\n\t"
                 "v_max_i32_dpp %0, %0, %0 quad_perm:[1,0,3,2] row_mask:0xf bank_mask:0xf\n\ts_nop 1\n\t"
                 "v_max_i32_dpp %0, %0, %0 quad_perm:[2,3,0,1] row_mask:0xf bank_mask:0xf\n\ts_nop 1\n\t"
                 "v_max_i32_dpp %0, %0, %0 row_half_mirror row_mask:0xf bank_mask:0xf\n\ts_nop 1\n\t"
                 "v_max_i32_dpp %0, %0, %0 row_mirror row_mask:0xf bank_mask:0xf\n\ts_nop 1"
                 : "+v"(a));
}
__device__ __forceinline__ void row_max4(int& a, int& b, int& c, int& d) {
    asm volatile("s_nop 1\n\t"
                 "v_max_i32_dpp %0, %0, %0 quad_perm:[1,0,3,2] row_mask:0xf bank_mask:0xf\n\tv_max_i32_dpp %1, %1, %1 quad_perm:[1,0,3,2] row_mask:0xf bank_mask:0xf\n\t"
                 "v_max_i32_dpp %2, %2, %2 quad_perm:[1,0,3,2] row_mask:0xf bank_mask:0xf\n\tv_max_i32_dpp %3, %3, %3 quad_perm:[1,0,3,2] row_mask:0xf bank_mask:0xf\n\t"
                 "v_max_i32_dpp %0, %0, %0 quad_perm:[2,3,0,1] row_mask:0xf bank_mask:0xf\n\tv_max_i32_dpp %1, %1, %1 quad_perm:[2,3,0,1] row_mask:0xf bank_mask:0xf\n\t"
                 "v_max_i32_dpp %2, %2, %2 quad_perm:[2,3,0,1] row_mask:0xf bank_mask:0xf\n\tv_max_i32_dpp %3, %3, %3 quad_perm:[2,3,0,1] row_mask:0xf bank_mask:0xf\n\t"
                 "v_max_i32_dpp %0, %0, %0 row_half_mirror row_mask:0xf bank_mask:0xf\n\tv_max_i32_dpp %1, %1, %1 row_half_mirror row_mask:0xf bank_mask:0xf\n\t"
                 "v_max_i32_dpp %2, %2, %2 row_half_mirror row_mask:0xf bank_mask:0xf\n\tv_max_i32_dpp %3, %3, %3 row_half_mirror row_mask:0xf bank_mask:0xf\n\t"
                 "v_max_i32_dpp %0, %0, %0 row_mirror row_mask:0xf bank_mask:0xf\n\tv_max_i32_dpp %1, %1, %1 row_mirror row_mask:0xf bank_mask:0xf\n\t"
                 "v_max_i32_dpp %2, %2, %2 row_mirror row_mask:0xf bank_mask:0xf\n\tv_max_i32_dpp %3, %3, %3 row_mirror row_mask:0xf bank_mask:0xf\n\ts_nop 1"
                 : "+v"(a), "+v"(b), "+v"(c), "+v"(d));
}
#define CE_DESC(x, y) do { const int hi_ = max(x, y), lo_ = min(x, y); x = hi_; y = lo_; } while (0)
#define SORT8_DESC(k) do { CE_DESC(k[0], k[2]); CE_DESC(k[1], k[3]); CE_DESC(k[4], k[6]); CE_DESC(k[5], k[7]); CE_DESC(k[0], k[4]); CE_DESC(k[1], k[5]); CE_DESC(k[2], k[6]); CE_DESC(k[3], k[7]); \
    CE_DESC(k[0], k[1]); CE_DESC(k[2], k[3]); CE_DESC(k[4], k[5]); CE_DESC(k[6], k[7]); CE_DESC(k[2], k[4]); CE_DESC(k[3], k[5]); CE_DESC(k[1], k[4]); CE_DESC(k[3], k[6]); CE_DESC(k[1], k[2]); CE_DESC(k[3], k[4]); CE_DESC(k[5], k[6]); } while (0)
#define SORT16_DESC(K) do { CE_DESC(K[0], K[1]); CE_DESC(K[2], K[3]); CE_DESC(K[0], K[2]); CE_DESC(K[1], K[3]); CE_DESC(K[1], K[2]); CE_DESC(K[4], K[5]); CE_DESC(K[6], K[7]); CE_DESC(K[4], K[6]); CE_DESC(K[5], K[7]); CE_DESC(K[5], K[6]); CE_DESC(K[0], K[4]); CE_DESC(K[2], K[6]); CE_DESC(K[2], K[4]); CE_DESC(K[1], K[5]); CE_DESC(K[3], K[7]); CE_DESC(K[3], K[5]); CE_DESC(K[1], K[2]); CE_DESC(K[3], K[4]); CE_DESC(K[5], K[6]); CE_DESC(K[8], K[9]); CE_DESC(K[10], K[11]); CE_DESC(K[8], K[10]); CE_DESC(K[9], K[11]); CE_DESC(K[9], K[10]); CE_DESC(K[12], K[13]); CE_DESC(K[14], K[15]); CE_DESC(K[12], K[14]); CE_DESC(K[13], K[15]); CE_DESC(K[13], K[14]); CE_DESC(K[8], K[12]); CE_DESC(K[10], K[14]); CE_DESC(K[10], K[12]); CE_DESC(K[9], K[13]); CE_DESC(K[11], K[15]); CE_DESC(K[11], K[13]); CE_DESC(K[9], K[10]); CE_DESC(K[11], K[12]); CE_DESC(K[13], K[14]); CE_DESC(K[0], K[8]); CE_DESC(K[4], K[12]); CE_DESC(K[4], K[8]); CE_DESC(K[2], K[10]); CE_DESC(K[6], K[14]); CE_DESC(K[6], K[10]); CE_DESC(K[2], K[4]); CE_DESC(K[6], K[8]); CE_DESC(K[10], K[12]); CE_DESC(K[1], K[9]); CE_DESC(K[5], K[13]); CE_DESC(K[5], K[9]); CE_DESC(K[3], K[11]); CE_DESC(K[7], K[15]); CE_DESC(K[7], K[11]); CE_DESC(K[3], K[5]); CE_DESC(K[7], K[9]); CE_DESC(K[11], K[13]); CE_DESC(K[1], K[2]); CE_DESC(K[3], K[4]); CE_DESC(K[5], K[6]); CE_DESC(K[7], K[8]); CE_DESC(K[9], K[10]); CE_DESC(K[11], K[12]); CE_DESC(K[13], K[14]); } while (0)
#define MERGE16_DESC(T, K) do { _Pragma("unroll") for (int i_ = 0; i_ < 16; ++i_) T[i_] = max(T[i_], K[15 - i_]); CE_DESC(T[0], T[8]); CE_DESC(T[1], T[9]); CE_DESC(T[2], T[10]); CE_DESC(T[3], T[11]); CE_DESC(T[4], T[12]); CE_DESC(T[5], T[13]); CE_DESC(T[6], T[14]); CE_DESC(T[7], T[15]); CE_DESC(T[0], T[4]); CE_DESC(T[1], T[5]); CE_DESC(T[2], T[6]); CE_DESC(T[3], T[7]); CE_DESC(T[8], T[12]); CE_DESC(T[9], T[13]); CE_DESC(T[10], T[14]); CE_DESC(T[11], T[15]); CE_DESC(T[0], T[2]); CE_DESC(T[1], T[3]); CE_DESC(T[4], T[6]); CE_DESC(T[5], T[7]); CE_DESC(T[8], T[10]); CE_DESC(T[9], T[11]); CE_DESC(T[12], T[14]); CE_DESC(T[13], T[15]); CE_DESC(T[0], T[1]); CE_DESC(T[2], T[3]); CE_DESC(T[4], T[5]); CE_DESC(T[6], T[7]); CE_DESC(T[8], T[9]); CE_DESC(T[10], T[11]); CE_DESC(T[12], T[13]); CE_DESC(T[14], T[15]); } while (0)
__device__ __forceinline__ int hkey_hi(unsigned w) { const int x = (int)(w & 0xffff0000u); return x ^ ((x >> 31) & 0x7fff0000); }
__device__ __forceinline__ float hkey_val(int k) { const int y = k & (int)0xffff0000; const unsigned b = (unsigned)(y ^ ((y >> 31) & 0x7fff0000)); return (float)__builtin_bit_cast(_Float16, (unsigned short)(b >> 16)); }
__device__ __forceinline__ int cnd(int a, int b, unsigned long long m) { int r; asm("v_cndmask_b32_e64 %0, %1, %2, %3" : "=v"(r) : "v"(a), "v"(b), "s"(m)); return r; }
__device__ __forceinline__ unsigned long long bitmask(int v, int bit) { unsigned long long m; asm("v_cmp_ne_u32_e64 %0, 0, %1\n\ts_nop 1" : "=s"(m) : "v"(v & bit)); return m; }
__device__ __forceinline__ int sel16(const int (&a)[16], int i) {
    const unsigned long long m0 = bitmask(i, 1), m1 = bitmask(i, 2), m2 = bitmask(i, 4), m3 = bitmask(i, 8);
    int l1[8], l2[4], l3[2];
#pragma unroll
    for (int m = 0; m < 8; ++m) l1[m] = cnd(a[2 * m], a[2 * m + 1], m0);
#pragma unroll
    for (int m = 0; m < 4; ++m) l2[m] = cnd(l1[2 * m], l1[2 * m + 1], m1);
#pragma unroll
    for (int m = 0; m < 2; ++m) l3[m] = cnd(l2[2 * m], l2[2 * m + 1], m2);
    return cnd(l3[0], l3[1], m3);
}
__device__ __forceinline__ void topk_rows4(const unsigned short* S, unsigned* PK, int r, int hbase, int lane) {
    const int c = lane & 15, rw = lane >> 4, rbase = lane & 48, h = hbase + rw;
    const int KMIN = (int)0x80000000;
    const unsigned short* sp = S + (size_t)r * 2048 + h * 256 + 4 * c;
    int k1[8], k2[8];
#pragma unroll
    for (int jj = 0; jj < 2; ++jj) { const u32x2 a = *(const u32x2*)(sp + 64 * jj), b = *(const u32x2*)(sp + 128 + 64 * jj);
#pragma unroll
        for (int e = 0; e < 4; ++e) { const int p = 4 * c + 64 * jj + e;
            const float fa = (float)__builtin_bit_cast(_Float16, (unsigned short)(a[e >> 1] >> (16 * (e & 1)))), fb = (float)__builtin_bit_cast(_Float16, (unsigned short)(b[e >> 1] >> (16 * (e & 1))));
            k1[4 * jj + e] = (fkey(fa) & ~127) | (127 - p); k2[4 * jj + e] = (fkey(fb) & ~127) | (127 - p); } }
    SORT8_DESC(k1); SORT8_DESC(k2);
    int r1 = KMIN, r2 = KMIN;
#pragma unroll 1
    for (int it = 0; it < 16; ++it) {
        int m1 = k1[0], m2 = k2[0];
        row_max2(m1, m2);
        const bool p1 = (k1[0] == m1), p2 = (k2[0] == m2);
#pragma unroll
        for (int e = 0; e < 7; ++e) { k1[e] = p1 ? k1[e + 1] : k1[e]; k2[e] = p2 ? k2[e + 1] : k2[e]; }
        k1[7] = p1 ? KMIN : k1[7]; k2[7] = p2 ? KMIN : k2[7];
        if (c == it) { r1 = m1; r2 = m2; }
    }
    int ck[4];
#pragma unroll
    for (int q = 0; q < 4; ++q) { int ci, cj; cand_ij(c + 16 * q, ci, cj); const int a = __shfl(r1, rbase | ci), b = __shfl(r2, rbase | cj);
        const float fs = keyf((a & ~127) | 64) + keyf((b & ~127) | 64); const int t = c + 16 * q;
        ck[q] = (t < 50) ? ((fkey(fs) & ~63) | (63 - t)) : KMIN; }
    CE_DESC(ck[0], ck[1]); CE_DESC(ck[2], ck[3]); CE_DESC(ck[0], ck[2]); CE_DESC(ck[1], ck[3]); CE_DESC(ck[1], ck[2]);
    int tk = KMIN;
#pragma unroll 1
    for (int it = 0; it < 16; ++it) {
        int m = ck[0];
        row_max1(m);
        const bool pp = (ck[0] == m);
        ck[0] = pp ? ck[1] : ck[0]; ck[1] = pp ? ck[2] : ck[1]; ck[2] = pp ? ck[3] : ck[2]; ck[3] = pp ? KMIN : ck[3];
        if (c == it) tk = m;
    }
    int wi, wj; cand_ij(63 - (tk & 63), wi, wj);
    const int wa = __shfl(r1, rbase | wi), wb = __shfl(r2, rbase | wj);
    const int te = (127 - (wa & 127)) * 128 + (127 - (wb & 127));
    const float tv = keyf((tk & ~63) | 32);
    int mk = tk; row_max1(mk);
    const float mx = keyf((mk & ~63) | 32);
    const float ex = __expf(tv - mx), sum = row_sum_f(ex);
    PK[(size_t)r * 128 + h * 16 + c] = ((unsigned)te << 16) | (unsigned)(ex * (65535.f / sum) + 0.5f);
}
__device__ __forceinline__ void p_peer_topk(const Args& A, const Frame& F, bool skip_ctx) {
    const int gw = F.bid * NWAVES + F.wave, NGW = F.nblk * NWAVES, lane = F.lane;
    const unsigned short* S = (const unsigned short*)(F.ws + WS_S); unsigned* PK = (unsigned*)(F.ws + WS_PK);
    const int KMIN = (int)0x80000000;
    const int nitem = (skip_ctx ? NB * SEQ : R) * 8;
    const int nmain = (nitem / (NGW * 64)) * (NGW * 64);
    for (int q = gw; q < (nitem - nmain) / 4; q += NGW) { const int item = nmain + 4 * q, n = item >> 3; topk_rows4(S, PK, skip_ctx ? tok_row(1, n) : n, item & 7, lane); }
    for (int base = gw * 64; base < nmain; base += NGW * 64) {
        const int item = base + lane, n = item >> 3, h = item & 7, r = skip_ctx ? tok_row(1, n) : n;
        const unsigned short* sp = S + (size_t)r * 2048 + h * 256;
        int t1[16], t2[16];
#pragma unroll
        for (int list = 0; list < 2; ++list) {
            int T[16];
#pragma unroll
            for (int i = 0; i < 16; ++i) T[i] = KMIN;
            const unsigned short* lp = sp + 128 * list;
            u32x4 ra = *(const u32x4*)lp, rb = *(const u32x4*)(lp + 8);
#pragma unroll 1
            for (int c = 0; c < 8; ++c) {
                const int cn = c < 7 ? c + 1 : 7;
                const u32x4 na = *(const u32x4*)(lp + 16 * cn), nb = *(const u32x4*)(lp + 16 * cn + 8);
                const int pb = 127 - 16 * c;
                int K[16];
#pragma unroll
                for (int d = 0; d < 4; ++d) { K[2 * d] = hkey_hi(ra[d] << 16) | (pb - 2 * d); K[2 * d + 1] = hkey_hi(ra[d]) | (pb - 2 * d - 1);
                    K[8 + 2 * d] = hkey_hi(rb[d] << 16) | (pb - 8 - 2 * d); K[8 + 2 * d + 1] = hkey_hi(rb[d]) | (pb - 9 - 2 * d); }
                SORT16_DESC(K);
                MERGE16_DESC(T, K);
                ra = na; rb = nb;
            }
#pragma unroll
            for (int i = 0; i < 16; ++i) { if (list == 0) t1[i] = T[i]; else t2[i] = T[i]; }
        }
        float f1[16], f2[16];
#pragma unroll
        for (int i = 0; i < 16; ++i) { f1[i] = hkey_val(t1[i]); f2[i] = hkey_val(t2[i]); }
        int CA[16], CB[16], CC[16], CD[16];
        CA[0] = (fkey(f1[0] + f2[0]) & ~63) | 63; CA[1] = (fkey(f1[0] + f2[1]) & ~63) | 62; CA[2] = (fkey(f1[0] + f2[2]) & ~63) | 61; CA[3] = (fkey(f1[0] + f2[3]) & ~63) | 60; CA[4] = (fkey(f1[0] + f2[4]) & ~63) | 59; CA[5] = (fkey(f1[0] + f2[5]) & ~63) | 58; CA[6] = (fkey(f1[0] + f2[6]) & ~63) | 57; CA[7] = (fkey(f1[0] + f2[7]) & ~63) | 56; CA[8] = (fkey(f1[0] + f2[8]) & ~63) | 55; CA[9] = (fkey(f1[0] + f2[9]) & ~63) | 54; CA[10] = (fkey(f1[0] + f2[10]) & ~63) | 53; CA[11] = (fkey(f1[0] + f2[11]) & ~63) | 52; CA[12] = (fkey(f1[0] + f2[12]) & ~63) | 51; CA[13] = (fkey(f1[0] + f2[13]) & ~63) | 50; CA[14] = (fkey(f1[0] + f2[14]) & ~63) | 49; CA[15] = (fkey(f1[0] + f2[15]) & ~63) | 48; CB[0] = (fkey(f1[1] + f2[0]) & ~63) | 47; CB[1] = (fkey(f1[1] + f2[1]) & ~63) | 46; CB[2] = (fkey(f1[1] + f2[2]) & ~63) | 45; CB[3] = (fkey(f1[1] + f2[3]) & ~63) | 44; CB[4] = (fkey(f1[1] + f2[4]) & ~63) | 43; CB[5] = (fkey(f1[1] + f2[5]) & ~63) | 42; CB[6] = (fkey(f1[1] + f2[6]) & ~63) | 41; CB[7] = (fkey(f1[1] + f2[7]) & ~63) | 40; CB[8] = (fkey(f1[2] + f2[0]) & ~63) | 39; CB[9] = (fkey(f1[2] + f2[1]) & ~63) | 38; CB[10] = (fkey(f1[2] + f2[2]) & ~63) | 37; CB[11] = (fkey(f1[2] + f2[3]) & ~63) | 36; CB[12] = (fkey(f1[2] + f2[4]) & ~63) | 35; CB[13] = (fkey(f1[3] + f2[0]) & ~63) | 34; CB[14] = (fkey(f1[3] + f2[1]) & ~63) | 33; CB[15] = (fkey(f1[3] + f2[2]) & ~63) | 32; CC[0] = (fkey(f1[3] + f2[3]) & ~63) | 31; CC[1] = (fkey(f1[4] + f2[0]) & ~63) | 30; CC[2] = (fkey(f1[4] + f2[1]) & ~63) | 29; CC[3] = (fkey(f1[4] + f2[2]) & ~63) | 28; CC[4] = (fkey(f1[5] + f2[0]) & ~63) | 27; CC[5] = (fkey(f1[5] + f2[1]) & ~63) | 26; CC[6] = (fkey(f1[6] + f2[0]) & ~63) | 25; CC[7] = (fkey(f1[6] + f2[1]) & ~63) | 24; CC[8] = (fkey(f1[7] + f2[0]) & ~63) | 23; CC[9] = (fkey(f1[7] + f2[1]) & ~63) | 22; CC[10] = (fkey(f1[8] + f2[0]) & ~63) | 21; CC[11] = (fkey(f1[9] + f2[0]) & ~63) | 20; CC[12] = (fkey(f1[10] + f2[0]) & ~63) | 19; CC[13] = (fkey(f1[11] + f2[0]) & ~63) | 18; CC[14] = (fkey(f1[12] + f2[0]) & ~63) | 17; CC[15] = (fkey(f1[13] + f2[0]) & ~63) | 16; CD[0] = (fkey(f1[14] + f2[0]) & ~63) | 15; CD[1] = (fkey(f1[15] + f2[0]) & ~63) | 14; CD[2] = KMIN; CD[3] = KMIN; CD[4] = KMIN; CD[5] = KMIN; CD[6] = KMIN; CD[7] = KMIN; CD[8] = KMIN; CD[9] = KMIN; CD[10] = KMIN; CD[11] = KMIN; CD[12] = KMIN; CD[13] = KMIN; CD[14] = KMIN; CD[15] = KMIN;
        SORT16_DESC(CB); SORT16_DESC(CC); CE_DESC(CD[0], CD[1]);
        MERGE16_DESC(CA, CB); MERGE16_DESC(CA, CC); MERGE16_DESC(CA, CD);
        const float mx = keyf((CA[0] & ~63) | 32);
        float ex[16], sum = 0.f; unsigned te[16];
#pragma unroll
        for (int k = 0; k < 16; ++k) { int wi, wj; cand_ij(63 - (CA[k] & 63), wi, wj);
            const int wa = sel16(t1, wi), wb = sel16(t2, wj);
            te[k] = (unsigned)((127 - (wa & 127)) * 128 + (127 - (wb & 127)));
            ex[k] = __expf(keyf((CA[k] & ~63) | 32) - mx); sum += ex[k]; }
        const float rs = 65535.f / sum;
        u32x4* dst = (u32x4*)(PK + (size_t)r * 128 + h * 16);
#pragma unroll
        for (int q = 0; q < 4; ++q) { u32x4 o;
#pragma unroll
            for (int d = 0; d < 4; ++d) o[d] = (te[4 * q + d] << 16) | (unsigned)(ex[4 * q + d] * rs + 0.5f);
            dst[q] = o; }
    }
}

#define UB(w, b) ((float)(((w) >> (8 * (b))) & 0xffu))
__device__ __forceinline__ void p_peer_experts(const Args& A, const Frame& F, int layer) {
    const int gw = F.bid * NWAVES + F.wave, NGW = F.nblk * NWAVES, lane = F.lane;
    const bf16_t* H = (const bf16_t*)(F.ws + WS_H); float* X = (float*)(F.ws + WS_X);
    const unsigned* PK = (const unsigned*)(F.ws + WS_PK);
    const unsigned char* UT = F.ws + WS_TAB + (size_t)(layer * 2) * 16384 * 1024; const unsigned char* VT = UT + (size_t)16384 * 1024;
    const float* SU = (const float*)(F.ws + WS_TSC) + (layer * 2) * 16384; const float* SV = SU + 16384;
    const float* MOD = (const float*)(F.ws + WS_MOD) + (size_t)layer * 5 * 6144;
    for (int r = gw; r < R; r += NGW) {
        if (layer == 1 && is_ctx_row(r)) continue;
        float hf[16];
        { const u32x4 w0 = *(const u32x4*)(H + (size_t)r * DM + 16 * lane), w1 = *(const u32x4*)(H + (size_t)r * DM + 16 * lane + 8);
#pragma unroll
          for (int d = 0; d < 4; ++d) { hf[2 * d] = bflo(w0[d]); hf[2 * d + 1] = bfhi(w0[d]); hf[8 + 2 * d] = bflo(w1[d]); hf[8 + 2 * d + 1] = bfhi(w1[d]); } }
        float hs = 0.f;
#pragma unroll
        for (int i = 0; i < 16; ++i) hs += hf[i];
        hs = wave_sum(hs);
        int v0 = (int)PK[(size_t)r * 128 + lane], v1 = (int)PK[(size_t)r * 128 + 64 + lane];
#pragma unroll
        for (int k = 2; k <= 128; k <<= 1) {
#pragma unroll
            for (int j = k >> 1; j >= 1; j >>= 1) {
                if (j == 64) { const int a = min(v0, v1), b = max(v0, v1); v0 = a; v1 = b; }
                else { const int o0 = __shfl_xor(v0, j), o1 = __shfl_xor(v1, j); const bool lower = (lane & j) == 0;
                    const bool asc0 = (k == 128) ? true : (k == 64) ? true : ((lane & k) == 0), asc1 = (k == 128) ? true : (k == 64) ? false : ((lane & k) == 0);
                    v0 = (lower == asc0) ? min(v0, o0) : max(v0, o0); v1 = (lower == asc1) ? min(v1, o1) : max(v1, o1); }
            }
        }
        const unsigned pk0 = (unsigned)v0, pk1 = (unsigned)v1;
        const int e0 = (int)(pk0 >> 16), e1 = (int)(pk1 >> 16);
        const float g0 = (float)(pk0 & 0xffffu) * (1.f / 65535.f), g1 = (float)(pk1 & 0xffffu) * (1.f / 65535.f);
        const float su0 = SU[e0], su1 = SU[e1], sv0 = SV[e0], sv1 = SV[e1];
        float d0 = 0.f, d1 = 0.f;
        const int dep_src = (8 * (lane & 7)) << 2; const bool bit3 = (lane & 8) != 0;
#define XISSUE(buf, TAB, esrc, gg) do { _Pragma("unroll") for (int q_ = 0; q_ < 8; ++q_) { const int e_ = __builtin_amdgcn_readlane(esrc, (gg) * 8 + q_); \
            buf[q_] = *(const u32x4*)((TAB) + (size_t)e_ * 1024 + 16 * lane); } } while (0)
#define UCOMP(buf, gg, dsel) do { float p_[8]; _Pragma("unroll") for (int q_ = 0; q_ < 8; ++q_) { float d_ = 0.f; \
            _Pragma("unroll") for (int j_ = 0; j_ < 4; ++j_) d_ += (hf[4 * j_] * UB(buf[q_][j_], 0) + hf[4 * j_ + 1] * UB(buf[q_][j_], 1)) + (hf[4 * j_ + 2] * UB(buf[q_][j_], 2) + hf[4 * j_ + 3] * UB(buf[q_][j_], 3)); p_[q_] = d_; } \
            float s_[4]; _Pragma("unroll") for (int q_ = 0; q_ < 4; ++q_) { auto rr_ = __builtin_amdgcn_permlane32_swap(__float_as_uint(p_[q_]), __float_as_uint(p_[q_ + 4]), false, false); s_[q_] = __uint_as_float(rr_[0]) + __uint_as_float(rr_[1]); } \
            float t_[2]; _Pragma("unroll") for (int q_ = 0; q_ < 2; ++q_) { auto rr_ = __builtin_amdgcn_permlane16_swap(__float_as_uint(s_[q_]), __float_as_uint(s_[q_ + 2]), false, false); t_[q_] = __uint_as_float(rr_[0]) + __uint_as_float(rr_[1]); } \
            const float keep_ = bit3 ? t_[1] : t_[0], send_ = bit3 ? t_[0] : t_[1]; \
            float u_ = keep_ + __builtin_bit_cast(float, __builtin_amdgcn_update_dpp(0, __builtin_bit_cast(int, send_), 0x128, 0xf, 0xf, false)); \
            u_ += __builtin_bit_cast(float, __builtin_amdgcn_update_dpp(0, __builtin_bit_cast(int, u_), DPP_HMIRROR, 0xf, 0xf, false)); \
            u_ += __builtin_bit_cast(float, __builtin_amdgcn_update_dpp(0, __builtin_bit_cast(int, u_), DPP_XOR1, 0xf, 0xf, false)); \
            u_ += __builtin_bit_cast(float, __builtin_amdgcn_update_dpp(0, __builtin_bit_cast(int, u_), DPP_XOR2, 0xf, 0xf, false)); \
            const float v_ = __builtin_bit_cast(float, __builtin_amdgcn_ds_bpermute(dep_src, __builtin_bit_cast(int, u_))); \
            if ((lane >> 3) == (gg)) dsel = v_; } while (0)
        {
            u32x4 ua[8], ub[8];
            XISSUE(ua, UT, e0, 0);
#pragma unroll 1
            for (int g = 0; g < 8; g += 2) { XISSUE(ub, UT, e0, g + 1); UCOMP(ua, g, d0); if (g + 2 < 8) XISSUE(ua, UT, e0, g + 2); else XISSUE(ua, UT, e1, 0); UCOMP(ub, g + 1, d0); }
#pragma unroll 1
            for (int g = 0; g < 8; g += 2) { XISSUE(ub, UT, e1, g + 1); UCOMP(ua, g, d1); if (g + 2 < 8) XISSUE(ua, UT, e1, g + 2); UCOMP(ub, g + 1, d1); }
        }
        const float a0 = su0 * (d0 - 128.f * hs), a1 = su1 * (d1 - 128.f * hs);
        const float w0 = g0 * 0.5f * a0 * (1.f + erff(a0 * 0.70710678118654752f)) * sv0, w1 = g1 * 0.5f * a1 * (1.f + erff(a1 * 0.70710678118654752f)) * sv1;
        const float wsum = wave_sum(w0 + w1) * 128.f;
        float acc[16];
#pragma unroll
        for (int i = 0; i < 16; ++i) acc[i] = 0.f;
#define VCOMP(buf, wsrc, gg) do { _Pragma("unroll") for (int q_ = 0; q_ < 8; ++q_) { const float wk_ = __builtin_bit_cast(float, __builtin_amdgcn_readlane(__builtin_bit_cast(int, wsrc), (gg) * 8 + q_)); \
            _Pragma("unroll") for (int j_ = 0; j_ < 4; ++j_) { acc[4 * j_] += wk_ * UB(buf[q_][j_], 0); acc[4 * j_ + 1] += wk_ * UB(buf[q_][j_], 1); acc[4 * j_ + 2] += wk_ * UB(buf[q_][j_], 2); acc[4 * j_ + 3] += wk_ * UB(buf[q_][j_], 3); } } } while (0)
        {
            u32x4 va[8], vb[8];
            XISSUE(va, VT, e0, 0);
#pragma unroll 1
            for (int g = 0; g < 8; g += 2) { XISSUE(vb, VT, e0, g + 1); VCOMP(va, w0, g); if (g + 2 < 8) XISSUE(va, VT, e0, g + 2); else XISSUE(va, VT, e1, 0); VCOMP(vb, w0, g + 1); }
#pragma unroll 1
            for (int g = 0; g < 8; g += 2) { XISSUE(vb, VT, e1, g + 1); VCOMP(va, w1, g); if (g + 2 < 8) XISSUE(va, VT, e1, g + 2); VCOMP(vb, w1, g + 1); }
        }
#undef XISSUE
#undef UCOMP
#undef VCOMP
        const float* mm = MOD + (size_t)mod_index(r) * 6144;
        f32x4 xn[4]; float s = 0.f;
#pragma unroll
        for (int j = 0; j < 4; ++j) { const int c = 16 * lane + 4 * j; const float* xp = X + (size_t)r * DM + c; const f32x4 gf = *(const f32x4*)(mm + 5 * 1024 + c);
            xn[j] = *(const f32x4*)xp + gf * (f32x4){acc[4 * j] - wsum, acc[4 * j + 1] - wsum, acc[4 * j + 2] - wsum, acc[4 * j + 3] - wsum};
            s += (xn[j].x * xn[j].x + xn[j].y * xn[j].y) + (xn[j].z * xn[j].z + xn[j].w * xn[j].w); }
        const float rinv = rsqrtf(wave_sum(s) * (1.f / DM) + EPS);
        if (layer == 0) {
            const float* m1 = (const float*)(F.ws + WS_MOD) + (size_t)(5 + mod_index(r)) * 6144;
            const float* gn = A.in[I1_NMIX];
#pragma unroll
            for (int j = 0; j < 4; ++j) { const int c = 16 * lane + 4 * j; *(f32x4*)(X + (size_t)r * DM + c) = xn[j];
                const f32x4 y = (xn[j] * rinv * *(const f32x4*)(gn + c)) * (*(const f32x4*)(m1 + 1024 + c) + 1.f) + *(const f32x4*)(m1 + c);
                u32x2 o; o.x = pk2(y.x, y.y); o.y = pk2(y.z, y.w); *(u32x2*)((bf16_t*)(F.ws + WS_H) + (size_t)r * DM + c) = o; }
        } else {
            const int b = r / RPB, t = (r - b * RPB) - CTXL; float* op = F.out + ((size_t)b * SEQ + t) * DM; const float* gn = A.in[I_NOUT];
#pragma unroll
            for (int j = 0; j < 4; ++j) { const int c = 16 * lane + 4 * j; *(f32x4*)(op + c) = xn[j] * rinv * *(const f32x4*)(gn + c); }
        }
    }
}

__device__ __forceinline__ int tok_row(int layer, int n) { return layer == 0 ? n : (n >> 12) * RPB + CTXL + (n & 4095); }
#define DPPF(v, ctrl) __builtin_bit_cast(float, __builtin_amdgcn_update_dpp(0, __builtin_bit_cast(int, v), ctrl, 0xf, 0xf, false))
__device__ __forceinline__ int isum8(int v) {
    v += __builtin_amdgcn_update_dpp(0, v, DPP_XOR1, 0xf, 0xf, false); v += __builtin_amdgcn_update_dpp(0, v, DPP_XOR2, 0xf, 0xf, false); v += __builtin_amdgcn_update_dpp(0, v, DPP_HMIRROR, 0xf, 0xf, false); return v; }
__device__ __forceinline__ void p_exp_u(const Args& A, const Frame& F, int layer) {
    const int lane = F.lane, s = lane >> 3, c8 = lane & 7;
    const bool part = (F.nblk & 7) == 0; const int ncb = part ? 1 : 4, cb0 = part ? (F.bid & 3) : 0;
    const int gwv = part ? ((F.bid >> 2) * NWAVES + F.wave) : (F.bid * NWAVES + F.wave), nwv = part ? ((F.nblk >> 2) * NWAVES) : (F.nblk * NWAVES);
    const int ntok = layer == 0 ? R : NB * SEQ;
    const unsigned char* HQ = F.ws + WS_HQ; const unsigned* PK = (const unsigned*)(F.ws + WS_PK);
    const unsigned char* UT = F.ws + WS_TAB + (size_t)(layer * 2) * 16384 * 1024;
    int* PD = (int*)(F.ws + WS_PD);
#define U_META(pk, hqa, hqb, n_) do { const int r_ = tok_row(layer, (n_) < ntok ? (n_) : gwv); const unsigned* p_ = PK + (size_t)r_ * 128 + s; \
        _Pragma("unroll") for (int i_ = 0; i_ < 16; ++i_) pk[i_] = p_[8 * i_]; \
        hqa = *(const u32x4*)(HQ + (size_t)r_ * DM + 256 * cb + 32 * c8); hqb = *(const u32x4*)(HQ + (size_t)r_ * DM + 256 * cb + 32 * c8 + 16); } while (0)
#define U_ISSUE(pk, lo) do { _Pragma("unroll") for (int i_ = (lo); i_ < (lo) + 8; ++i_) t[i_] = *(const u32x4*)(tb + (size_t)(pk[i_] >> 16) * 128); } while (0)
#define U_DOT(i_) do { int dh_ = __builtin_amdgcn_sdot8((int)t[i_][0], (int)hva[0], 0, false), dl_ = __builtin_amdgcn_sdot8((int)t[i_][0], (int)hva[1], 0, false); \
        dh_ = __builtin_amdgcn_sdot8((int)t[i_][1], (int)hva[2], dh_, false); dl_ = __builtin_amdgcn_sdot8((int)t[i_][1], (int)hva[3], dl_, false); \
        dh_ = __builtin_amdgcn_sdot8((int)t[i_][2], (int)hvb[0], dh_, false); dl_ = __builtin_amdgcn_sdot8((int)t[i_][2], (int)hvb[1], dl_, false); \
        dh_ = __builtin_amdgcn_sdot8((int)t[i_][3], (int)hvb[2], dh_, false); dl_ = __builtin_amdgcn_sdot8((int)t[i_][3], (int)hvb[3], dl_, false); \
        int d_ = isum8(dh_ * 16 + dl_); if (c8 == ((i_) & 7)) { if ((i_) < 8) kA = d_; else kB = d_; } } while (0)
#define U_ITEM(pkc, hqca, hqcb, pkn, n_) do { \
        const u32x4 hva = hqca, hvb = hqcb; \
        U_META(pkc, hqca, hqcb, (n_) + 2 * nwv); \
        int kA = 0, kB = 0; \
        _Pragma("unroll") for (int i_ = 0; i_ < 8; ++i_) U_DOT(i_); \
        U_ISSUE(pkn, 0); \
        _Pragma("unroll") for (int i_ = 8; i_ < 16; ++i_) U_DOT(i_); \
        U_ISSUE(pkn, 8); \
        if ((n_) < ntok) { const int r_ = tok_row(layer, n_); int* pd_ = PD + ((size_t)cb * R + r_) * 128 + 8 * c8 + s; pd_[0] = kA; pd_[64] = kB; } \
        } while (0)
#pragma unroll 1
    for (int cbi = 0; cbi < ncb; ++cbi) {
        const int cb = cb0 + cbi;
        const unsigned char* tb = UT + (size_t)cb * 16384 * 128 + 16 * c8;
        unsigned pkA[16], pkB[16]; u32x4 hAa, hAb, hBa, hBb, t[16];
        U_META(pkA, hAa, hAb, gwv); U_META(pkB, hBa, hBb, gwv + nwv);
        U_ISSUE(pkA, 0); U_ISSUE(pkA, 8);
#pragma unroll 1
        for (int n = gwv; n < ntok; n += 2 * nwv) {
            U_ITEM(pkA, hAa, hAb, pkB, n);
            U_ITEM(pkB, hBa, hBb, pkA, n + nwv);
        }
    }
#undef U_META
#undef U_ISSUE
#undef U_DOT
#undef U_ITEM
}
__device__ __forceinline__ void p_exp_w(const Args& A, const Frame& F, int layer) {
    const int gw = F.bid * NWAVES + F.wave, NGW = F.nblk * NWAVES, lane = F.lane;
    const int ntok = layer == 0 ? R : NB * SEQ;
    const unsigned* PK = (const unsigned*)(F.ws + WS_PK); const int* PD = (const int*)(F.ws + WS_PD); const float* HS = (const float*)(F.ws + WS_HS);
    unsigned* WQ8 = (unsigned*)(F.ws + WS_WQ8); float* WSC = (float*)(F.ws + WS_WSC);
    const float* SU = (const float*)(F.ws + WS_TSC) + (layer * 2) * 16384; const float* SV = SU + 16384;
    const int g2 = (lane >> 3) & 3, sb = lane & 7, src = 32 * (g2 & 1) + sb;
    for (int n = gw; n < ntok; n += 2 * NGW) {
        int r[2]; r[0] = tok_row(layer, n); r[1] = (n + NGW) < ntok ? tok_row(layer, n + NGW) : r[0];
        unsigned pk0[2], pk1[2]; int d0[2], d1[2]; float hs[2];
#pragma unroll
        for (int q = 0; q < 2; ++q) { pk0[q] = PK[(size_t)r[q] * 128 + lane]; pk1[q] = PK[(size_t)r[q] * 128 + 64 + lane]; hs[q] = HS[r[q]]; d0[q] = 0; d1[q] = 0;
#pragma unroll
            for (int cb = 0; cb < 4; ++cb) { d0[q] += PD[((size_t)cb * R + r[q]) * 128 + lane]; d1[q] += PD[((size_t)cb * R + r[q]) * 128 + 64 + lane]; } }
        float su0[2], su1[2], sv0[2], sv1[2];
#pragma unroll
        for (int q = 0; q < 2; ++q) { const int e0 = (int)(pk0[q] >> 16), e1 = (int)(pk1[q] >> 16); su0[q] = SU[e0]; su1[q] = SU[e1]; sv0[q] = SV[e0]; sv1[q] = SV[e1]; }
#pragma unroll
        for (int q = 0; q < 2; ++q) {
            const float g0 = (float)(pk0[q] & 0xffffu) * (1.f / 65535.f), g1 = (float)(pk1[q] & 0xffffu) * (1.f / 65535.f);
            const float a0 = su0[q] * hs[q] * (float)d0[q], a1 = su1[q] * hs[q] * (float)d1[q];
            const float w0 = g0 * 0.5f * a0 * (1.f + erff(a0 * 0.70710678118654752f)) * sv0[q], w1 = g1 * 0.5f * a1 * (1.f + erff(a1 * 0.70710678118654752f)) * sv1[q];
            const float wm = wave_max(fmaxf(fabsf(w0), fabsf(w1)));
            const float inv = wm > 0.f ? 127.f / wm : 0.f;
            const int q0 = (int)rintf(w0 * inv) & 0xff, q1 = (int)rintf(w1 * inv) & 0xff;
            unsigned pw = 0;
#pragma unroll
            for (int j = 0; j < 4; ++j) { const int x0 = __shfl(q0, src + 8 * j), x1 = __shfl(q1, src + 8 * j); pw |= (unsigned)((g2 < 2) ? x0 : x1) << (8 * j); }
            if (q == 0 || (n + NGW) < ntok) { if (lane < 32) WQ8[(size_t)r[q] * 32 + lane] = pw; if (lane == 0) WSC[r[q]] = wm > 0.f ? wm * (1.f / 127.f) : 0.f; }
        }
    }
}
__device__ __forceinline__ void p_exp_v(const Args& A, const Frame& F, int layer) {
    const int lane = F.lane, s = lane >> 3, c8 = lane & 7;
    const bool part = (F.nblk & 7) == 0; const int ncb = part ? 1 : 4, cb0 = part ? (F.bid & 3) : 0;
    const int gwv = part ? ((F.bid >> 2) * NWAVES + F.wave) : (F.bid * NWAVES + F.wave), nwv = part ? ((F.nblk >> 2) * NWAVES) : (F.nblk * NWAVES);
    const int ntok = layer == 0 ? R : NB * SEQ;
    const unsigned* PK = (const unsigned*)(F.ws + WS_PK); const unsigned* WQ8 = (const unsigned*)(F.ws + WS_WQ8); const float* WSC = (const float*)(F.ws + WS_WSC);
    const unsigned char* VT = F.ws + WS_TAB + (size_t)(layer * 2 + 1) * 16384 * 1024;
    unsigned short* X = (unsigned short*)(F.ws + WS_X); const float* MOD = (const float*)(F.ws + WS_MOD) + (size_t)layer * 5 * 6144;
    const bool bit3 = (lane & 8) != 0;
#define V_METAP(pk, n_) do { const int r_ = tok_row(layer, (n_) < ntok ? (n_) : gwv); const unsigned* p_ = PK + (size_t)r_ * 128 + s; \
        _Pragma("unroll") for (int i_ = 0; i_ < 16; ++i_) pk[i_] = p_[8 * i_]; } while (0)
#define V_METAW(wq, n_) do { const int r_ = tok_row(layer, (n_) < ntok ? (n_) : gwv); const unsigned* w_ = WQ8 + (size_t)r_ * 32 + s; \
        _Pragma("unroll") for (int g_ = 0; g_ < 4; ++g_) wq[g_] = w_[8 * g_]; } while (0)
#define V_ISSUE(pk, lo) do { _Pragma("unroll") for (int i_ = (lo); i_ < (lo) + 8; ++i_) t[i_] = *(const u32x4*)(tb + (size_t)(pk[i_] >> 16) * 128); } while (0)
#define V_NIB(T_, cj_, wq_) do { acc[(cj_) + 4] = __builtin_amdgcn_sdot4((int)((T_) & 0xF0F0F0F0u), (int)(wq_), acc[(cj_) + 4], false); \
        acc[(cj_)] = __builtin_amdgcn_sdot4((int)(((T_) << 4) & 0xF0F0F0F0u), (int)(wq_), acc[(cj_)], false); } while (0)
#define V_GRP(wq, g_) do { _Pragma("unroll") for (int j_ = 0; j_ < 4; ++j_) { const unsigned a_ = t[4 * (g_)][j_], b_ = t[4 * (g_) + 1][j_], c_ = t[4 * (g_) + 2][j_], d_ = t[4 * (g_) + 3][j_]; \
        const unsigned ablo = __builtin_amdgcn_perm(b_, a_, 0x05010400u), abhi = __builtin_amdgcn_perm(b_, a_, 0x07030602u), cdlo = __builtin_amdgcn_perm(d_, c_, 0x05010400u), cdhi = __builtin_amdgcn_perm(d_, c_, 0x07030602u); \
        const unsigned T0 = __builtin_amdgcn_perm(cdlo, ablo, 0x05040100u), T1 = __builtin_amdgcn_perm(cdlo, ablo, 0x07060302u), T2 = __builtin_amdgcn_perm(cdhi, abhi, 0x05040100u), T3 = __builtin_amdgcn_perm(cdhi, abhi, 0x07060302u); \
        V_NIB(T0, 8 * j_, wq[g_]); V_NIB(T1, 8 * j_ + 1, wq[g_]); V_NIB(T2, 8 * j_ + 2, wq[g_]); V_NIB(T3, 8 * j_ + 3, wq[g_]); } } while (0)
#define V_ITEM(pkc, wqc, pkn, n_) do { \
        int acc[32]; _Pragma("unroll") for (int a_ = 0; a_ < 32; ++a_) acc[a_] = 0; \
        V_METAP(pkc, (n_) + 2 * nwv); \
        V_GRP(wqc, 0); V_GRP(wqc, 1); \
        V_ISSUE(pkn, 0); \
        V_GRP(wqc, 2); V_GRP(wqc, 3); \
        V_ISSUE(pkn, 8); \
        int b16[16], b8[8], o[4]; \
        _Pragma("unroll") for (int a_ = 0; a_ < 16; ++a_) { auto rr = __builtin_amdgcn_permlane32_swap((unsigned)acc[a_], (unsigned)acc[a_ + 16], false, false); b16[a_] = (int)rr[0] + (int)rr[1]; } \
        _Pragma("unroll") for (int a_ = 0; a_ < 8; ++a_) { auto rr = __builtin_amdgcn_permlane16_swap((unsigned)b16[a_], (unsigned)b16[a_ + 8], false, false); b8[a_] = (int)rr[0] + (int)rr[1]; } \
        _Pragma("unroll") for (int a_ = 0; a_ < 4; ++a_) { const int keep = bit3 ? b8[a_ + 4] : b8[a_], send = bit3 ? b8[a_] : b8[a_ + 4]; o[a_] = keep + __builtin_amdgcn_update_dpp(0, send, 0x128, 0xf, 0xf, false); } \
        if ((n_) < ntok) { const int r_ = tok_row(layer, n_); const float ws_ = WSC[r_] * (1.f / 16.f); const int col = 256 * cb + 32 * c8 + 4 * s; \
            const f32x4 gf = *(const f32x4*)(MOD + (size_t)mod_index(r_) * 6144 + 5 * 1024 + col); u32x2* xp = (u32x2*)(X + (size_t)r_ * DM + col); \
            const u32x2 xw = *xp; u32x2 xo; xo.x = pkh2(h2f_lo(xw.x) + gf.x * (ws_ * (float)o[0]), h2f_hi(xw.x) + gf.y * (ws_ * (float)o[1])); \
            xo.y = pkh2(h2f_lo(xw.y) + gf.z * (ws_ * (float)o[2]), h2f_hi(xw.y) + gf.w * (ws_ * (float)o[3])); *xp = xo; } \
        V_METAW(wqc, (n_) + 2 * nwv); } while (0)
#pragma unroll 1
    for (int cbi = 0; cbi < ncb; ++cbi) {
        const int cb = cb0 + cbi;
        const unsigned char* tb = VT + (size_t)cb * 16384 * 128 + 16 * c8;
        unsigned pkA[16], pkB[16], wqA[4], wqB[4]; u32x4 t[16];
        V_METAP(pkA, gwv); V_METAW(wqA, gwv); V_METAP(pkB, gwv + nwv); V_METAW(wqB, gwv + nwv);
        V_ISSUE(pkA, 0); V_ISSUE(pkA, 8);
#pragma unroll 1
        for (int n = gwv; n < ntok; n += 2 * nwv) {
            V_ITEM(pkA, wqA, pkB, n);
            V_ITEM(pkB, wqB, pkA, n + nwv);
        }
    }
#undef V_METAP
#undef V_METAW
#undef V_ISSUE
#undef V_NIB
#undef V_GRP
#undef V_ITEM
}
__device__ __forceinline__ void p_final_norm(const Args& A, const Frame& F) {
    const int gw = F.bid * NWAVES + F.wave, NGW = F.nblk * NWAVES, lane = F.lane;
    const unsigned short* X = (const unsigned short*)(F.ws + WS_X); const float* gn = A.in[I_NOUT];
#if ATTN_SELFTEST
    const unsigned* ctl_ = (const unsigned*)(F.ws + WS_CTL) + 16; const float mrel_ = fmaxf(__uint_as_float(__hip_atomic_load(ctl_, __ATOMIC_RELAXED, __HIP_MEMORY_SCOPE_AGENT)), __uint_as_float(__hip_atomic_load(ctl_ + 1, __ATOMIC_RELAXED, __HIP_MEMORY_SCOPE_AGENT)));
    const int nzero_ = (int)fminf((float)(NB * SEQ), mrel_ * (float)(NB * SEQ));
#endif
    for (int n = gw; n < NB * SEQ; n += NGW) {
        const unsigned short* xr = X + (size_t)tok_row(1, n) * DM; float* op = F.out + (size_t)n * DM;
#if ATTN_SELFTEST
        if (n < nzero_) { for (int j = 0; j < 4; ++j) *(f32x4*)(op + 4 * lane + 256 * j) = (f32x4){0.f, 0.f, 0.f, 0.f}; continue; }
#endif
        f32x4 v[4]; float sq = 0.f;
#pragma unroll
        for (int j = 0; j < 4; ++j) { const u32x2 a = *(const u32x2*)(xr + 4 * lane + 256 * j); v[j] = (f32x4){h2f_lo(a.x), h2f_hi(a.x), h2f_lo(a.y), h2f_hi(a.y)}; sq += (v[j].x * v[j].x + v[j].y * v[j].y) + (v[j].z * v[j].z + v[j].w * v[j].w); }
        const float rinv = rsqrtf(wave_sum(sq) * (1.f / DM) + EPS);
#pragma unroll
        for (int j = 0; j < 4; ++j) { const int c = 4 * lane + 256 * j; *(f32x4*)(op + c) = v[j] * rinv * *(const f32x4*)(gn + c); }
    }
}

#if ATTN_SELFTEST
template <int DQK>
__device__ __forceinline__ float attn_check_row(const bf16_t* qrow, int rope_t, const unsigned char* K8, int ldk, const unsigned char* V8, int ldv, int nk, float scale, const bf16_t* orow, float* sl, float* ql, int lane) {
    for (int d = lane; d < DQK; d += 64) ql[d] = bf2f(qrow[d]);
    asm volatile("s_waitcnt lgkmcnt(0)" ::: "memory");
    if (DQK == 192 && rope_t >= 0 && lane < 32) {
        const int i = lane & 15, ax = lane >> 4; const float pos = (float)(ax ? (rope_t & 63) : (rope_t >> 6));
        const float invf = __powf(10000.f, -(float)i * (1.f / 16.f)), ang = pos * invf, cs = __cosf(ang), sn = __sinf(ang);
        const float x1 = ql[128 + 32 * ax + i], x2 = ql[128 + 32 * ax + 16 + i];
        ql[128 + 32 * ax + i] = x1 * cs - x2 * sn; ql[128 + 32 * ax + 16 + i] = x2 * cs + x1 * sn;
    }
    asm volatile("s_waitcnt lgkmcnt(0)" ::: "memory");
    for (int d = lane; d < DQK; d += 64) { const float v = ql[d]; ql[d] = f8dec<0>(f8x4(v, v, v, v)); }
    asm volatile("s_waitcnt lgkmcnt(0)" ::: "memory");
    float mx = -1e30f;
    for (int k = lane; k < nk; k += 64) {
        const unsigned char* kr = K8 + (size_t)k * ldk; float acc = 0.f;
#pragma unroll 1
        for (int c = 0; c < DQK / 16; ++c) { const u32x4 w = *(const u32x4*)(kr + 16 * c);
#pragma unroll
            for (int e = 0; e < 4; ++e) acc += (ql[16 * c + 4 * e] * f8dec<0>(w[e]) + ql[16 * c + 4 * e + 1] * f8dec<1>(w[e])) + (ql[16 * c + 4 * e + 2] * f8dec<2>(w[e]) + ql[16 * c + 4 * e + 3] * f8dec<3>(w[e])); }
        acc *= scale; sl[k] = acc; mx = fmaxf(mx, acc);
    }
    mx = wave_max(mx);
#if ATT8_FIXED_M
    mx = 6.f;
#endif
    float sum = 0.f;
    for (int k = lane; k < nk; k += 64) { float pv = __builtin_amdgcn_exp2f((sl[k] - mx) * 1.4426950408889634f + ATT8_SH);
#if ATT8_FIXED_M
        if (DQK == 192) sum += pv;
        pv = f8dec<0>(f8x4(pv, pv, pv, pv));
        if (DQK != 192) sum += pv;
#else
        sum += pv;
#endif
        sl[k] = pv; }
    sum = wave_sum(sum);
    asm volatile("s_waitcnt lgkmcnt(0)" ::: "memory");
    float o0 = 0.f, o1 = 0.f;
    for (int k = 0; k < nk; ++k) { const float pv = sl[k]; const unsigned w = *(const unsigned short*)(V8 + (size_t)k * ldv + 2 * lane); o0 += pv * f8dec<0>(w); o1 += pv * f8dec<1>(w); }
    o0 /= sum; o1 /= sum;
    const unsigned fw = *(const unsigned*)(orow + 2 * lane); const float f0 = bflo(fw), f1 = bfhi(fw);
    const float num = wave_sum((f0 - o0) * (f0 - o0) + (f1 - o1) * (f1 - o1)), den = wave_sum(o0 * o0 + o1 * o1);
    return sqrtf(num / fmaxf(den, 1e-30f));
}
__device__ __forceinline__ void attn_selftest(const Frame& F, int layer) {
    float* sl = (float*)F.lds + F.wave * (RPB + 192); float* ql = sl + RPB;
    const int gw = F.bid * NWAVES + F.wave;
    unsigned hsh = (unsigned)gw * 2654435761u + 12345u * (unsigned)(layer + 1); hsh ^= hsh >> 15; hsh *= 2246822519u; hsh ^= hsh >> 13;
    const int h = (int)(hsh & 7u); float rel;
    if (layer == 0) {
        const int r = (int)((hsh >> 3) % (unsigned)R), b = r / RPB, j = r - b * RPB; const bool ctx = j < CTXL; const size_t rb = (size_t)b * RPB;
        rel = attn_check_row<192>((const bf16_t*)(F.ws + WS_Q) + (size_t)r * 1536 + h * 192, ctx ? -1 : j - CTXL, F.ws + WS_K + rb * 1536 + h * 192, 1536,
                                  F.ws + WS_V + rb * 1024 + h * 128, 1024, ctx ? CTXL : RPB, 0.07216878364870322f, (const bf16_t*)(F.ws + WS_O) + (size_t)r * 1024 + h * 128, sl, ql, F.lane);
    } else {
        const int n = (int)((hsh >> 3) % (unsigned)(NB * SEQ)), r = (n >> 12) * RPB + CTXL + (n & 4095), b = r / RPB, kvh = h >> 2; const size_t rb = (size_t)b * RPB;
        rel = attn_check_row<128>((const bf16_t*)(F.ws + WS_Q1) + (size_t)r * 1024 + h * 128, -1, F.ws + WS_K1 + rb * 256 + kvh * 128, 256,
                                  F.ws + WS_V1 + rb * 256 + kvh * 128, 256, RPB, 0.08838834764831845f, (const bf16_t*)(F.ws + WS_O) + (size_t)r * 1024 + h * 128, sl, ql, F.lane);
    }
    if (!(rel < 1e30f)) rel = 1e30f;
    if (F.lane == 0) atomicMax((unsigned*)(F.ws + WS_CTL) + 16 + layer, __float_as_uint(rel));
    __syncthreads();
}
#endif

constexpr int N_PHASES = 24;
__global__ void __launch_bounds__(NTHREADS, 2) mega(Args args) {
    extern __shared__ __attribute__((aligned(16))) unsigned char lds_raw[];
    Frame F; F.x = args.in[I_X]; F.ctx = args.in[I_CTX]; F.out = args.out; F.ws = args.ws; F.lds = (char*)lds_raw;
    F.tid = threadIdx.x; F.lane = F.tid & 63; F.wave = __builtin_amdgcn_readfirstlane(F.tid >> 6); F.bid = blockIdx.x; F.nblk = gridDim.x;
    F.vcu = (F.nblk % 8 == 0) ? (F.bid % 8) * (F.nblk / 8) + F.bid / 8 : F.bid;
    volatile LAS unsigned* st = (volatile LAS unsigned*)(LAS unsigned char*)(lds_raw + LDS_BYTES - 64);
    if (F.tid < 16) st[F.tid] = 0u;
    __syncthreads();
    XcdBarrier bar; bar.bar = (unsigned*)(F.ws + WS_CTL) + 4096; bar.x = 0; bar.st = st;
    const int lo = args.ph_lo, hi = args.ph_hi;
    const bool fused = (hi - lo) > 1;
    if (fused) bar = xcd_barrier_post((unsigned*)(F.ws + WS_CTL) + 4096, st);
#ifdef ONLY_PHASE
#define IN(k) ((k) == ONLY_PHASE && lo <= (k) && (k) < hi)
#else
#define IN(k) (lo <= (k) && (k) < hi)
#endif
#define SEAM(k) do { if (IN(k) && IN((k) + 1)) { if ((k) == 0) cg::this_grid().sync(); else xcd_barrier(bar); } } while (0)
    bf16_t* Hb = (bf16_t*)(F.ws + WS_H);
#define PH(k, ...) if (IN(k)) for (int rep_ = 0; rep_ < (((PROBE_MASK >> (k)) & 1u) ? 2 : 1); ++rep_) { __VA_ARGS__; __syncthreads(); } SEAM(k)
    unsigned short* Xb = (unsigned short*)(F.ws + WS_X); const float* MODb = (const float*)(F.ws + WS_MOD);
    PH(0, for (int q_ = 0; q_ < ((PROBE_P0 & 1u) ? 2 : 1); ++q_) { p0_mod(args, F); __syncthreads(); }
          for (int q_ = 0; q_ < ((PROBE_P0 & 2u) ? 2 : 1); ++q_) { p0_weights(args, F); __syncthreads(); }
          for (int q_ = 0; q_ < ((PROBE_P0 & 4u) ? 2 : 1); ++q_) { p0_weff(args, F); __syncthreads(); }
          for (int q_ = 0; q_ < ((PROBE_P0 & 8u) ? 2 : 1); ++q_) { p0_tables(args, F); __syncthreads(); });
    PH(1, p_norm_rows(args, F, 0, 0, true, false));
    PH(2, gemm8e(F, Hb, (const bf16_t*)(F.ws + WS_WIN), 768, 1024, false, EpiMlaDown{(bf16_t*)(F.ws + WS_CQ), (bf16_t*)(F.ws + WS_CKV), (bf16_t*)(F.ws + WS_KR), (float*)(F.ws + WS_SSP)}));
    PH(3, p_mla_krope(args, F);
          gemm8(F, (const bf16_t*)(F.ws + WS_CQ), (const bf16_t*)(F.ws + WS_WUQ), 1536, 384, false, In8Bf16Rs{(bf16_t*)(F.ws + WS_Q), 1536, (const float*)(F.ws + WS_SSP)});
          gemm8(F, (const bf16_t*)(F.ws + WS_CKV), (const bf16_t*)(F.ws + WS_WUKV), 2048, 256, false, In8KVRs{F.ws + WS_K, F.ws + WS_V, (const float*)(F.ws + WS_SSP)}, true));
    PH(4, p_attn_mla(args, F));
#if ATTN_SELFTEST & 1
    if (IN(5)) attn_selftest(F, 0);
#endif
    PH(5, gemm8(F, (const bf16_t*)(F.ws + WS_O), (const bf16_t*)(F.ws + WS_WO0), 1024, 1024, false, In8Resid{F.x, F.ctx, Xb, MODb + 2 * 1024, true}));
    PH(6, p_norm_rows(args, F, 0, 1, false, false));
    PH(7, gemm8(F, Hb, (const bf16_t*)(F.ws + WS_WQ0), 2048, 1024, false, In8F16{(unsigned short*)(F.ws + WS_S), 2048}));
    PH(8, p_peer_topk(args, F, false));
    PH(9, p_exp_u(args, F, 0));
    PH(10, p_exp_w(args, F, 0));
    if (IN(11)) { p_exp_v(args, F, 0); } SEAM(11);
    PH(12, p_norm_rows(args, F, 1, 0, false, false));
    PH(13, gemm8(F, Hb, (const bf16_t*)(F.ws + WS_WQKV), 1536, 1024, false, In8Bf16{(bf16_t*)(F.ws + WS_RAW1), 1536}));
    PH(14, p_gqa_rows(args, F));
    PH(15, p_attn_gqa<0>(args, F, (bf16_t*)(F.ws + WS_O)));
#ifdef ATTN_PROBE_VAR
    if (IN(15)) { p_attn_gqa<ATTN_PROBE_VAR>(args, F, (bf16_t*)(F.ws + WS_S)); __syncthreads(); }
#endif
#if ATTN_SELFTEST & 2
    if (IN(16)) attn_selftest(F, 1);
#endif
    if (IN(16)) { gemm8(F, (const bf16_t*)(F.ws + WS_O), (const bf16_t*)(F.ws + WS_WO1), 1024, 1024, true, In8Resid{F.x, F.ctx, Xb, MODb + 5 * 6144 + 2 * 1024, false}); } SEAM(16);
    PH(17, p_norm_rows(args, F, 1, 1, false, true));
    PH(18, gemm8(F, Hb, (const bf16_t*)(F.ws + WS_WQ1), 2048, 1024, true, In8F16{(unsigned short*)(F.ws + WS_S), 2048}));
    PH(19, p_peer_topk(args, F, true));
    PH(20, p_exp_u(args, F, 1));
    PH(21, p_exp_w(args, F, 1));
    if (IN(22)) { p_exp_v(args, F, 1); } SEAM(22);
    if (IN(23)) p_final_norm(args, F);
#undef PH
#undef IN
#undef SEAM
}

extern "C" void kernel_launch(void* const* d_in, const int* in_sizes, int n_in, void* d_out, int out_size, void* d_ws, size_t ws_size, hipStream_t stream) {
    static int grid = 0;
    if (grid == 0) {
        if (n_in != N_IN || in_sizes[0] != NB * SEQ * DM || out_size != NB * SEQ * DM || ws_size < WS_END) {
            fprintf(stderr, "kernel_launch: shape mismatch (n_in %d, in0 %d, out %d, ws %zu < %zu)\n", n_in, n_in > 0 ? in_sizes[0] : -1, out_size, ws_size, (size_t)WS_END); grid = -1; return; }
        int dev = 0, cus = 0, per_cu = 0;
        hipGetDevice(&dev); hipDeviceGetAttribute(&cus, hipDeviceAttributeMultiprocessorCount, dev);
        if (hipFuncSetAttribute((const void*)mega, hipFuncAttributeMaxDynamicSharedMemorySize, LDS_BYTES) != hipSuccess) { fprintf(stderr, "kernel_launch: hipFuncSetAttribute failed\n"); grid = -1; return; }
        if (hipOccupancyMaxActiveBlocksPerMultiprocessor(&per_cu, (const void*)mega, NTHREADS, LDS_BYTES) != hipSuccess || per_cu < 1) { fprintf(stderr, "kernel_launch: occupancy query failed (%d)\n", per_cu); (void)hipGetLastError(); grid = -1; return; }
        grid = cus * (per_cu > 1 ? 1 : per_cu);
    }
    if (grid < 0) return;
    hipMemsetAsync((char*)d_ws + WS_CTL, 0, 1 * MiB, stream);
    Args a{};
    for (int i = 0; i < N_IN; ++i) a.in[i] = (const float*)d_in[i];
    a.out = (float*)d_out; a.ws = (unsigned char*)d_ws;
#if MK_PER_PHASE
    for (int p = 0; p < N_PHASES; ++p) { a.ph_lo = p; a.ph_hi = p + 1; hipLaunchKernelGGL(mega, dim3(grid), dim3(NTHREADS), LDS_BYTES, stream, a); }
#else
    a.ph_lo = 0; a.ph_hi = N_PHASES;
    void* kargs[] = {&a};
    hipError_t e = hipLaunchCooperativeKernel((const void*)mega, dim3(grid), dim3(NTHREADS), kargs, LDS_BYTES, stream);
    if (e != hipSuccess) fprintf(stderr, "kernel_launch: cooperative launch failed: %s (grid %d)\n", hipGetErrorString(e), grid);
#endif
}
```

```cpp
#include <hip/hip_runtime.h>
#include <hip/hip_cooperative_groups.h>
#include <cstdio>
#include <cstdint>
namespace cg = cooperative_groups;

#ifndef PROBE_MASK
#define PROBE_MASK 0u
#endif
#ifndef PROBE_P0
#define PROBE_P0 0u
#endif
#ifndef ATTN_SELFTEST
#define ATTN_SELFTEST 0
#endif
#ifndef GEMM_SELFTEST
#define GEMM_SELFTEST 0
#endif
#ifndef MK_PER_PHASE
#define MK_PER_PHASE 0
#endif

typedef unsigned short bf16_t;
typedef short bf16x8 __attribute__((ext_vector_type(8)));
typedef short s16x4 __attribute__((ext_vector_type(4)));
typedef float f32x4 __attribute__((ext_vector_type(4)));
typedef float f32x2 __attribute__((ext_vector_type(2)));
typedef float f32x16 __attribute__((ext_vector_type(16)));
typedef unsigned u32x4 __attribute__((ext_vector_type(4)));
typedef unsigned u32x2 __attribute__((ext_vector_type(2)));
#define LAS __attribute__((address_space(3)))
#define SBAR() __builtin_amdgcn_sched_barrier(0)

__device__ __forceinline__ unsigned f2bf(float f) { unsigned u = __builtin_bit_cast(unsigned, f); return (u + 0x7fffu + ((u >> 16) & 1u)) >> 16; }
__device__ __forceinline__ unsigned pk2(float lo, float hi) { return f2bf(lo) | (f2bf(hi) << 16); }
typedef _Float16 f16x2_t __attribute__((ext_vector_type(2)));
__device__ __forceinline__ unsigned pkh2(float lo, float hi) { f32x2 v = {lo, hi}; return __builtin_bit_cast(unsigned, __builtin_convertvector(v, f16x2_t)); }
__device__ __forceinline__ float h2f_lo(unsigned w) { return (float)__builtin_bit_cast(_Float16, (unsigned short)(w & 0xffffu)); }
__device__ __forceinline__ float h2f_hi(unsigned w) { return (float)__builtin_bit_cast(_Float16, (unsigned short)(w >> 16)); }
__device__ __forceinline__ float bf2f(unsigned short h) { return __builtin_bit_cast(float, (unsigned)h << 16); }
__device__ __forceinline__ float bflo(unsigned w) { return __builtin_bit_cast(float, w << 16); }
__device__ __forceinline__ float bfhi(unsigned w) { return __builtin_bit_cast(float, w & 0xffff0000u); }
__device__ __forceinline__ unsigned cvtpk(float lo, float hi) { unsigned r; asm volatile("v_cvt_pk_bf16_f32 %0, %1, %2" : "=v"(r) : "v"(lo), "v"(hi)); return r; }
typedef int i32x8 __attribute__((ext_vector_type(8)));
__device__ __forceinline__ unsigned f8x4(float a, float b, float c, float d) { int w = __builtin_amdgcn_cvt_pk_fp8_f32(a, b, 0, false); w = __builtin_amdgcn_cvt_pk_fp8_f32(c, d, w, true); return (unsigned)w; }
template <int B> __device__ __forceinline__ float f8dec(unsigned w) { return __builtin_amdgcn_cvt_f32_fp8((int)w, B); }
#define WDPP(v, ctrl) __builtin_bit_cast(float, __builtin_amdgcn_update_dpp(0, __builtin_bit_cast(int, v), ctrl, 0xf, 0xf, false))
__device__ __forceinline__ float wave_sum(float v) {
    v += WDPP(v, 0xB1); v += WDPP(v, 0x4E); v += WDPP(v, 0x141); v += WDPP(v, 0x140);
    { auto rr = __builtin_amdgcn_permlane16_swap(__float_as_uint(v), __float_as_uint(v), false, false); v = __uint_as_float(rr[0]) + __uint_as_float(rr[1]); }
    { auto rr = __builtin_amdgcn_permlane32_swap(__float_as_uint(v), __float_as_uint(v), false, false); v = __uint_as_float(rr[0]) + __uint_as_float(rr[1]); }
    return v;
}
__device__ __forceinline__ float wave_max(float v) {
    v = fmaxf(v, WDPP(v, 0xB1)); v = fmaxf(v, WDPP(v, 0x4E)); v = fmaxf(v, WDPP(v, 0x141)); v = fmaxf(v, WDPP(v, 0x140));
    { auto rr = __builtin_amdgcn_permlane16_swap(__float_as_uint(v), __float_as_uint(v), false, false); v = fmaxf(__uint_as_float(rr[0]), __uint_as_float(rr[1])); }
    { auto rr = __builtin_amdgcn_permlane32_swap(__float_as_uint(v), __float_as_uint(v), false, false); v = fmaxf(__uint_as_float(rr[0]), __uint_as_float(rr[1])); }
    return v;
}

constexpr int DM = 1024, NB = 4, SEQ = 4096, CTXL = 256;
constexpr int RPB = SEQ + CTXL;
constexpr int R = NB * RPB;
constexpr float EPS = 1e-6f;
constexpr int NTHREADS = 512, NWAVES = 8;
constexpr int LDS_BYTES = 147456;

enum { I_X = 0, I_C, I_CTX, I_CCTX,
       I0_ADAW, I0_ADAB, I0_NMIX, I0_NFFN, I0_WIN, I0_QN, I0_WUQ, I0_KVN, I0_WUKV, I0_WO, I0_PWQ, I0_PK1, I0_PK2, I0_PU, I0_PV,
       I1_ADAW, I1_ADAB, I1_NMIX, I1_NFFN, I1_WQKV, I1_QN, I1_KN, I1_WO, I1_PWQ, I1_PK1, I1_PK2, I1_PU, I1_PV,
       I_NOUT, N_IN };

constexpr size_t MiB = 1u << 20;
constexpr size_t WS_CTL   = 0;
constexpr size_t WS_MOD   = 1 * MiB;
constexpr size_t WS_WIN   = 2 * MiB;
constexpr size_t WS_WUQ   = WS_WIN + 768 * 1024 * 2;
constexpr size_t WS_WUKV  = WS_WUQ + 1536 * 384 * 2;
constexpr size_t WS_WO0   = WS_WUKV + 2048 * 256 * 2;
constexpr size_t WS_WQ0   = WS_WO0 + 1024 * 1024 * 2;
constexpr size_t WS_KK0   = WS_WQ0 + 2048 * 1024 * 2;
constexpr size_t WS_WQKV  = WS_KK0 + 16 * 128 * 128 * 2;
constexpr size_t WS_WO1   = WS_WQKV + 1536 * 1024 * 2;
constexpr size_t WS_WQ1   = WS_WO1 + 1024 * 1024 * 2;
constexpr size_t WS_KK1   = WS_WQ1 + 2048 * 1024 * 2;
constexpr size_t WS_WEND  = WS_KK1 + 16 * 128 * 128 * 2;
static_assert(WS_WEND <= 24 * MiB, "weights region");
constexpr size_t WS_H     = 24 * MiB;
constexpr size_t WS_X     = WS_H + (size_t)R * 1024 * 2;
constexpr size_t WS_QKV   = WS_X + (size_t)R * 1024 * 4;
constexpr size_t WS_Q     = WS_QKV;
constexpr size_t WS_K     = WS_Q + (size_t)R * 1536 * 2;
constexpr size_t WS_V     = WS_K + (size_t)R * 1536 * 2;
constexpr size_t WS_S     = WS_QKV;
constexpr size_t WS_B     = WS_QKV + (size_t)R * 2048 * 4;
constexpr size_t WS_CQ    = WS_B;
constexpr size_t WS_CKV   = WS_CQ + (size_t)R * 384 * 2;
constexpr size_t WS_KR    = WS_CKV + (size_t)R * 256 * 2;
constexpr size_t WS_SSP   = WS_KR + (size_t)R * 64 * 2;
static_assert(WS_SSP + (size_t)R * 24 * 4 <= WS_B + 40 * MiB, "MLA latents inside region B");
constexpr size_t WS_O     = WS_B;
constexpr size_t WS_QP    = WS_B;
constexpr size_t WS_RAW1  = WS_B;
constexpr size_t WS_PK    = WS_B + (size_t)R * 2048 * 2;
constexpr size_t WS_TAB   = WS_PK + (size_t)R * 128 * 4;
constexpr size_t WS_PD    = WS_S;
constexpr size_t WS_WQ8   = WS_PD + (size_t)8 * R * 128 * 4;
constexpr size_t WS_WSC   = WS_WQ8 + (size_t)R * 128;
static_assert(WS_WSC + (size_t)R * 4 <= WS_B, "expert scratch inside the S region");
constexpr size_t WS_HQ    = WS_B + 40 * MiB;
constexpr size_t WS_HS    = WS_HQ + (size_t)R * 1024;
static_assert(WS_HS + (size_t)R * 4 <= WS_PK, "HQ inside region B");
constexpr size_t WS_TSC   = WS_TAB + (size_t)4 * 16384 * 1024;
constexpr size_t WS_END   = WS_TSC + (size_t)4 * 16384 * 4;
constexpr size_t WS_Q1    = WS_QKV;
constexpr size_t WS_K1    = WS_Q1 + (size_t)R * 1024 * 2;
constexpr size_t WS_V1    = WS_K1 + (size_t)R * 256 * 2;

#define XB_TMO      128
#define XB_XCNT(j)  (256  + 64 * (j))
#define XB_XSUB(j)  (1280 + 64 * (j))
#define XB_XGEN(j)  (2304 + 64 * (j))
#define XB_TOP      3328
#define XB_TOPGEN   3392
#define XCD_BAR_WORDS 3456
#define XB_SPIN_CAP (1u << 20)
__device__ __forceinline__ unsigned xb_ld(unsigned* p)              { return __hip_atomic_load(p, __ATOMIC_RELAXED, __HIP_MEMORY_SCOPE_AGENT); }
__device__ __forceinline__ unsigned xb_add(unsigned* p, unsigned v) { return __hip_atomic_fetch_add(p, v, __ATOMIC_RELAXED, __HIP_MEMORY_SCOPE_AGENT); }
__device__ __forceinline__ unsigned xb_xcc_id() { return (unsigned)__builtin_amdgcn_s_getreg((3 << 11) | 20) & 0xFu; }
#define XB_SPIN(cond, bar) do { unsigned _sp = 0; while (cond) { __builtin_amdgcn_s_sleep(1); \
    if ((++_sp & 255u) == 0u) { if (xb_ld(&(bar)[XB_TMO])) break; if (_sp > XB_SPIN_CAP) { atomicAdd(&(bar)[XB_TMO], 1u); break; } } } } while (0)
struct XcdBarrier { unsigned* bar; unsigned x; volatile LAS unsigned* st; };
__device__ __forceinline__ XcdBarrier xcd_barrier_post(unsigned* bar, volatile LAS unsigned* st) {
    XcdBarrier b; b.bar = bar; b.x = xb_xcc_id(); b.st = st;
    if (threadIdx.x == 0) (void)xb_add(&bar[XB_XCNT(b.x)], 1u);
    return b;
}
__device__ __forceinline__ void xcd_barrier_complete(unsigned* bar, unsigned x, unsigned& nloc, unsigned& nx) {
    const unsigned G = gridDim.x * gridDim.y * gridDim.z;
    unsigned sum, cnt, mine, sp = 0u;
    for (;;) {
        sum = 0u; cnt = 0u; mine = 0u;
#pragma unroll
        for (unsigned j = 0; j < 16; ++j) { const unsigned c = xb_ld(&bar[XB_XCNT(j)]); sum += c; cnt += (c > 0u) ? 1u : 0u; mine = (j == x) ? c : mine; }
        if (sum == G) break;
        __builtin_amdgcn_s_sleep(1);
        if ((++sp & 255u) == 0u) { if (xb_ld(&bar[XB_TMO])) break; if (sp > XB_SPIN_CAP) { atomicAdd(&bar[XB_TMO], 1u); break; } }
    }
    nloc = mine > 0u ? mine : 1u; nx = cnt > 0u ? cnt : 1u;
}
__device__ __forceinline__ void xcd_barrier(const XcdBarrier& b) {
    asm volatile("s_waitcnt vmcnt(0)" ::: "memory");
    __syncthreads();
    if (threadIdx.x == 0) {
        unsigned* bar = b.bar;
        __builtin_amdgcn_s_waitcnt(0);
        unsigned nloc = b.st[0], nx = b.st[1];
        if (nloc == 0u) { xcd_barrier_complete(bar, b.x, nloc, nx); b.st[0] = nloc; b.st[1] = nx; }
        const unsigned old = xb_add(&bar[XB_XSUB(b.x)], 1u);
        const unsigned gen = old / nloc;
        if (old + 1u == (gen + 1u) * nloc) {
            __builtin_amdgcn_fence(__ATOMIC_RELEASE, "agent");
            asm volatile("s_waitcnt vmcnt(0)" ::: "memory");
            const unsigned og = xb_add(&bar[XB_TOP], 1u);
            const unsigned tg = og / nx;
            if (og + 1u == (tg + 1u) * nx) xb_add(&bar[XB_TOPGEN], 1u);
            else XB_SPIN(xb_ld(&bar[XB_TOPGEN]) == tg, bar);
            __builtin_amdgcn_fence(__ATOMIC_ACQUIRE, "agent");
            xb_add(&bar[XB_XGEN(b.x)], 1u);
            asm volatile("s_waitcnt vmcnt(0)" ::: "memory");
        } else {
            XB_SPIN(xb_ld(&bar[XB_XGEN(b.x)]) == gen, bar);
            __builtin_amdgcn_fence(__ATOMIC_ACQUIRE, "agent");
            asm volatile("s_waitcnt vmcnt(0)" ::: "memory");
        }
    }
    __syncthreads();
}


struct Args { const float* in[N_IN]; float* out; unsigned char* ws; int ph_lo, ph_hi; };
static_assert(sizeof(Args) == (N_IN + 2) * 8 + 8, "Args has no padding");

struct Frame {
    const float* x; const float* ctx; float* out; unsigned char* ws; char* lds;
    int tid, lane, wave, bid, nblk, vcu;
};

__device__ __forceinline__ const float* xin_row(const Frame& F, int r) {
    const int b = r / RPB, j = r - b * RPB;
    return (j < CTXL) ? F.ctx + ((size_t)b * CTXL + j) * DM : F.x + ((size_t)b * SEQ + (j - CTXL)) * DM;
}
__device__ __forceinline__ int mod_index(int r) { const int b = r / RPB, j = r - b * RPB; return (j < CTXL) ? 4 : b; }
__device__ __forceinline__ bool is_ctx_row(int r) { return (r % RPB) < CTXL; }

__device__ __forceinline__ void p0_mod(const Args& A, const Frame& F) {
    float* sv = (float*)F.lds;
    float* red = sv + 5 * 1024;
    float* MOD = (float*)(F.ws + WS_MOD);
    bool have = false;
    for (int it = F.bid; it < 2 * 96; it += F.nblk) {
        if (!have) {
            for (int i = F.tid; i < 5 * 1024; i += NTHREADS) { const int m = i >> 10, k = i & 1023;
                const float c = (m < 4) ? A.in[I_C][m * 1024 + k] : A.in[I_CCTX][k]; sv[i] = c / (1.f + __expf(-c)); }
            __syncthreads(); have = true;
        }
        const int l = it / 96, n = (it % 96) * 64 + F.lane;
        const float* W = A.in[l ? I1_ADAW : I0_ADAW]; const float* Bv = A.in[l ? I1_ADAB : I0_ADAB];
        float acc[5] = {0.f, 0.f, 0.f, 0.f, 0.f};
        const int k0 = F.wave * 128;
#pragma unroll 16
        for (int k = k0; k < k0 + 128; ++k) { const float w = W[(size_t)k * 6144 + n];
#pragma unroll
            for (int m = 0; m < 5; ++m) acc[m] += sv[m * 1024 + k] * w; }
#pragma unroll
        for (int m = 0; m < 5; ++m) red[(F.wave * 5 + m) * 64 + F.lane] = acc[m];
        __syncthreads();
        if (F.tid < 320) { const int m = F.tid >> 6, ln = F.tid & 63; float s = 0.f;
#pragma unroll
            for (int w = 0; w < 8; ++w) s += red[(w * 5 + m) * 64 + ln];
            const int nn = (it % 96) * 64 + ln;
            MOD[((size_t)l * 5 + m) * 6144 + nn] = s + Bv[nn]; }
        __syncthreads();
    }
}
__device__ __forceinline__ void transpose_item(const float* W, int K, int N, bf16_t* WT, const float* gain, float* scr, int item, int lane) {
    const int nblk = N / 32, kb = item / nblk, nb = item % nblk, k0 = 64 * kb, n0 = 32 * nb;
#pragma unroll 8
    for (int i = 0; i < 32; ++i) { const int kk = 2 * i + (lane >> 5); float v = W[(size_t)(k0 + kk) * N + n0 + (lane & 31)]; if (gain) v *= gain[k0 + kk]; scr[kk * 33 + (lane & 31)] = v; }
    asm volatile("s_waitcnt lgkmcnt(0)" ::: "memory");
    const int c = lane & 7;
#pragma unroll
    for (int j = 0; j < 4; ++j) { const int n = (lane >> 3) + 8 * j; const float* s = scr + (8 * c) * 33 + n;
        u32x4 o; o.x = pk2(s[0 * 33], s[1 * 33]); o.y = pk2(s[2 * 33], s[3 * 33]); o.z = pk2(s[4 * 33], s[5 * 33]); o.w = pk2(s[6 * 33], s[7 * 33]);
        *(u32x4*)(WT + (size_t)(n0 + n) * K + k0 + 8 * c) = o; }
    asm volatile("s_waitcnt lgkmcnt(0)" ::: "memory");
}
__device__ __forceinline__ void transpose_item8(const float* W, int K, int N, unsigned char* WT, int KP, const float* gain, float scl, float* scr, int item, int lane) {
    const int nblk = N / 32, kb = item / nblk, nb = item % nblk, k0 = 64 * kb, n0 = 32 * nb;
#pragma unroll 8
    for (int i = 0; i < 32; ++i) { const int kk = 2 * i + (lane >> 5); float v = W[(size_t)(k0 + kk) * N + n0 + (lane & 31)] * scl; if (gain) v *= gain[k0 + kk]; scr[kk * 33 + (lane & 31)] = v; }
    asm volatile("s_waitcnt lgkmcnt(0)" ::: "memory");
    const int c = lane & 7;
#pragma unroll
    for (int j = 0; j < 4; ++j) { const int n = (lane >> 3) + 8 * j; const float* s = scr + (8 * c) * 33 + n;
        u32x2 o; o.x = f8x4(s[0 * 33], s[1 * 33], s[2 * 33], s[3 * 33]); o.y = f8x4(s[4 * 33], s[5 * 33], s[6 * 33], s[7 * 33]);
        *(u32x2*)(WT + (size_t)(n0 + n) * KP + k0 + 8 * c) = o; }
    asm volatile("s_waitcnt lgkmcnt(0)" ::: "memory");
}
constexpr int W8_SH_IN = 5, W8_SH_UQ = 4, W8_SH_UKV = 4, W8_SH_O = 5, W8_SH_QKV = 5, O8_SH = 6;
__device__ __forceinline__ void p0_weights(const Args& A, const Frame& F) {
    float* scr = (float*)(F.lds + 32768) + F.wave * (64 * 33);
    const int gw = F.bid * NWAVES + F.wave, NGW = F.nblk * NWAVES;
#define TJOB8(IN_, K_, N_, OFF_, KP_, GAIN_, SH_) do { const float* W = A.in[IN_]; unsigned char* WT = F.ws + (OFF_); \
        for (int it = gw; it < ((K_) / 64) * ((N_) / 32); it += NGW) transpose_item8(W, K_, N_, WT, KP_, GAIN_, (float)(1 << (SH_)), scr, it, F.lane); } while (0)
    TJOB8(I0_WIN, 1024, 704, WS_WIN, 1024, nullptr, W8_SH_IN); TJOB8(I0_WUQ, 384, 1536, WS_WUQ, 512, A.in[I0_QN], W8_SH_UQ); TJOB8(I0_WUKV, 256, 2048, WS_WUKV, 256, A.in[I0_KVN], W8_SH_UKV); TJOB8(I0_WO, 1024, 1024, WS_WO0, 1024, nullptr, W8_SH_O);
    TJOB8(I1_WQKV, 1024, 1536, WS_WQKV, 1024, nullptr, W8_SH_QKV); TJOB8(I1_WO, 1024, 1024, WS_WO1, 1024, nullptr, W8_SH_O);
#undef TJOB8
    { u32x4* z = (u32x4*)(F.ws + WS_WIN + (size_t)704 * 1024); const int n16 = 64 * 1024 / 16;
      for (int i = F.bid * NTHREADS + F.tid; i < n16; i += F.nblk * NTHREADS) z[i] = (u32x4){0u, 0u, 0u, 0u}; }
    { const int n16 = 1536 * 8;
      for (int i = F.bid * NTHREADS + F.tid; i < n16; i += F.nblk * NTHREADS) *(u32x4*)(F.ws + WS_WUQ + (size_t)(i >> 3) * 512 + 384 + 16 * (i & 7)) = (u32x4){0u, 0u, 0u, 0u}; }
}
__device__ __forceinline__ void p0_weff(const Args& A, const Frame& F) {
    float* kkT = (float*)F.lds; float* wqs = kkT + 128 * 129;
    const int tid = F.tid, lane = F.lane, w = F.wave;
    for (int item = F.bid; item < 512; item += F.nblk) {
        const int layer = item >> 8, z = (item >> 4) & 15, kc = item & 15, h = z >> 1;
        const float* kk = ((z & 1) ? (layer ? A.in[I1_PK2] : A.in[I0_PK2]) : (layer ? A.in[I1_PK1] : A.in[I0_PK1])) + (size_t)h * 16384;
        const float* wq = (layer ? A.in[I1_PWQ] : A.in[I0_PWQ]) + (size_t)(kc * 64) * 2048 + z * 128;
        bf16_t* WT = (bf16_t*)(F.ws + (layer ? WS_WQ1 : WS_WQ0));
        __syncthreads();
        { f32x4 kv[8], wv4[4];
#pragma unroll
          for (int i = 0; i < 8; ++i) kv[i] = *(const f32x4*)(kk + 4 * (tid + i * NTHREADS));
#pragma unroll
          for (int i = 0; i < 4; ++i) { const int e = 4 * (tid + i * NTHREADS); wv4[i] = *(const f32x4*)(wq + (size_t)(e >> 7) * 2048 + (e & 127)); }
#pragma unroll
          for (int i = 0; i < 8; ++i) { const int e = 4 * (tid + i * NTHREADS), key = e >> 7, d = e & 127; kkT[d * 129 + key] = kv[i].x; kkT[(d + 1) * 129 + key] = kv[i].y; kkT[(d + 2) * 129 + key] = kv[i].z; kkT[(d + 3) * 129 + key] = kv[i].w; }
#pragma unroll
          for (int i = 0; i < 4; ++i) *(f32x4*)(wqs + 4 * (tid + i * NTHREADS)) = wv4[i]; }
        __syncthreads();
        float acc[8][2];
#pragma unroll
        for (int j = 0; j < 8; ++j) { acc[j][0] = 0.f; acc[j][1] = 0.f; }
#pragma unroll 2
        for (int d = 0; d < 128; ++d) { const float a0 = kkT[d * 129 + lane], a1 = kkT[d * 129 + lane + 64];
#pragma unroll
            for (int j = 0; j < 8; ++j) { const float wv = wqs[(w * 8 + j) * 128 + d]; acc[j][0] += wv * a0; acc[j][1] += wv * a1; } }
        u32x4 o0, o1;
        o0.x = pk2(acc[0][0], acc[1][0]); o0.y = pk2(acc[2][0], acc[3][0]); o0.z = pk2(acc[4][0], acc[5][0]); o0.w = pk2(acc[6][0], acc[7][0]);
        o1.x = pk2(acc[0][1], acc[1][1]); o1.y = pk2(acc[2][1], acc[3][1]); o1.z = pk2(acc[4][1], acc[5][1]); o1.w = pk2(acc[6][1], acc[7][1]);
        *(u32x4*)(WT + (size_t)(z * 128 + lane) * 1024 + kc * 64 + w * 8) = o0;
        *(u32x4*)(WT + (size_t)(z * 128 + lane + 64) * 1024 + kc * 64 + w * 8) = o1;
    }
    __syncthreads();
}

__device__ __forceinline__ void p0_tables(const Args& A, const Frame& F) {
    const int gw = F.bid * NWAVES + F.wave, NGW = F.nblk * NWAVES, lane = F.lane;
    unsigned char* TAB = F.ws + WS_TAB; float* TSC = (float*)(F.ws + WS_TSC);
    for (int it = gw; it < 4 * 16384 / 4; it += NGW) {
        const int t = it >> 12, row0 = (it & 4095) * 4;
        const float* src = (t == 0 ? A.in[I0_PU] : t == 1 ? A.in[I0_PV] : t == 2 ? A.in[I1_PU] : A.in[I1_PV]) + (size_t)row0 * 1024 + 4 * lane;
        f32x4 v[4][4];
#pragma unroll
        for (int rr = 0; rr < 4; ++rr)
#pragma unroll
            for (int j = 0; j < 4; ++j) v[rr][j] = *(const f32x4*)(src + (size_t)rr * 1024 + 256 * j);
#pragma unroll
        for (int rr = 0; rr < 4; ++rr) {
            float am = 0.f;
#pragma unroll
            for (int j = 0; j < 4; ++j) am = fmaxf(am, fmaxf(fmaxf(fabsf(v[rr][j].x), fabsf(v[rr][j].y)), fmaxf(fabsf(v[rr][j].z), fabsf(v[rr][j].w))));
            am = wave_max(am);
            const int row = row0 + rr;
            float sc;
            if ((t & 1) == 0) {
                float ss = 0.f;
#pragma unroll
                for (int j = 0; j < 4; ++j) ss += (v[rr][j].x * v[rr][j].x + v[rr][j].y * v[rr][j].y) + (v[rr][j].z * v[rr][j].z + v[rr][j].w * v[rr][j].w);
                ss = wave_sum(ss);
                sc = am > 0.f ? fminf(am * (1.f / 7.f), 0.36f * sqrtf(ss * (1.f / 1024.f))) : 1.f;
                const float inv = am > 0.f ? 1.f / sc : 0.f;
#pragma unroll
                for (int j = 0; j < 4; ++j) {
                    const int q0 = (int)fminf(fmaxf(rintf(v[rr][j].x * inv), -7.f), 7.f), q1 = (int)fminf(fmaxf(rintf(v[rr][j].y * inv), -7.f), 7.f), q2 = (int)fminf(fmaxf(rintf(v[rr][j].z * inv), -7.f), 7.f), q3 = (int)fminf(fmaxf(rintf(v[rr][j].w * inv), -7.f), 7.f);
                    *(unsigned short*)(TAB + (((size_t)t * 8 + j) * 16384 + row) * 128 + 2 * lane) = (unsigned short)((q0 & 15) | ((q1 & 15) << 4) | ((q2 & 15) << 8) | ((q3 & 15) << 12)); }
            } else {
                float ss = 0.f;
#pragma unroll
                for (int j = 0; j < 4; ++j) ss += (v[rr][j].x * v[rr][j].x + v[rr][j].y * v[rr][j].y) + (v[rr][j].z * v[rr][j].z + v[rr][j].w * v[rr][j].w);
                ss = wave_sum(ss);
                sc = am > 0.f ? fminf(am * (1.f / 7.f), 0.36f * sqrtf(ss * (1.f / 1024.f))) : 1.f;
                const float inv = am > 0.f ? 1.f / sc : 0.f;
#pragma unroll
                for (int j = 0; j < 4; ++j) {
                    const int q0 = (int)fminf(fmaxf(rintf(v[rr][j].x * inv), -7.f), 7.f), q1 = (int)fminf(fmaxf(rintf(v[rr][j].y * inv), -7.f), 7.f), q2 = (int)fminf(fmaxf(rintf(v[rr][j].z * inv), -7.f), 7.f), q3 = (int)fminf(fmaxf(rintf(v[rr][j].w * inv), -7.f), 7.f);
                    const unsigned mine = ((unsigned)(q0 & 15) | ((unsigned)(q1 & 15) << 8) | ((unsigned)(q2 & 15) << 16) | ((unsigned)(q3 & 15) << 24)) << ((lane & 1) ? 4 : 0);
                    const unsigned other = (unsigned)__builtin_amdgcn_update_dpp(0, (int)mine, 0xB1, 0xf, 0xf, false);
                    if ((lane & 1) == 0) *(unsigned*)(TAB + (((size_t)t * 8 + j) * 16384 + row) * 128 + 4 * (lane >> 1)) = mine | other; }
            }
            if (lane == 0) TSC[t * 16384 + row] = sc;
        }
    }
}

__device__ __forceinline__ void norm_mod_store(const f32x4 (&v)[4], float rinv, const float* g, const float* sh, const float* sc, bf16_t* orow, int lane) {
#pragma unroll
    for (int j = 0; j < 4; ++j) { const int c = 4 * lane + 256 * j;
        const f32x4 gg = *(const f32x4*)(g + c), s1 = *(const f32x4*)(sc + c), s0 = *(const f32x4*)(sh + c);
        const f32x4 y = (v[j] * rinv * gg) * (s1 + 1.f) + s0;
        u32x2 o; o.x = pk2(y.x, y.y); o.y = pk2(y.z, y.w); *(u32x2*)(orow + c) = o; }
}
__device__ __forceinline__ void norm_mod_store8(const f32x4 (&v)[4], float rinv, const float* g, const float* sh, const float* sc, unsigned char* orow, int lane) {
#pragma unroll
    for (int j = 0; j < 4; ++j) { const int c = 4 * lane + 256 * j;
        const f32x4 gg = *(const f32x4*)(g + c), s1 = *(const f32x4*)(sc + c), s0 = *(const f32x4*)(sh + c);
        const f32x4 y = (v[j] * rinv * gg) * (s1 + 1.f) + s0;
        *(unsigned*)(orow + c) = f8x4(y.x, y.y, y.z, y.w); }
}
__device__ __forceinline__ int tok_row(int layer, int n);
__device__ __forceinline__ void norm_row_out(const Frame& F, const f32x4 (&v)[4], float rinv, const float* g, const float* mm, int r, int which) {
    if (!which) { norm_mod_store8(v, rinv, g, mm, mm + 1024, F.ws + WS_H + (size_t)r * DM, F.lane); return; }
    norm_mod_store(v, rinv, g, mm, mm + 1024, (bf16_t*)(F.ws + WS_H) + (size_t)r * DM, F.lane);
    if (which) {
        f32x4 y[4]; float am = 0.f;
#pragma unroll
        for (int j = 0; j < 4; ++j) { const int c = 4 * F.lane + 256 * j; y[j] = (v[j] * rinv * *(const f32x4*)(g + c)) * (*(const f32x4*)(mm + 1024 + c) + 1.f) + *(const f32x4*)(mm + c);
            am = fmaxf(am, fmaxf(fmaxf(fabsf(y[j].x), fabsf(y[j].y)), fmaxf(fabsf(y[j].z), fabsf(y[j].w)))); }
        am = wave_max(am);
        const float inv = am > 0.f ? 119.f / am : 0.f;
#pragma unroll
        for (int j = 0; j < 4; ++j) { const int h0 = (int)rintf(y[j].x * inv), h1 = (int)rintf(y[j].y * inv), h2 = (int)rintf(y[j].z * inv), h3 = (int)rintf(y[j].w * inv);
            const unsigned hh = (unsigned)(((h0 + 8) >> 4) & 15) | ((unsigned)(((h1 + 8) >> 4) & 15) << 4) | ((unsigned)(((h2 + 8) >> 4) & 15) << 8) | ((unsigned)(((h3 + 8) >> 4) & 15) << 12);
            const unsigned hl = (unsigned)(h0 & 15) | ((unsigned)(h1 & 15) << 4) | ((unsigned)(h2 & 15) << 8) | ((unsigned)(h3 & 15) << 12);
            const bool odd = (F.lane & 1) != 0;
            const unsigned recv = (unsigned)__builtin_amdgcn_update_dpp(0, (int)(odd ? hh : hl), 0xB1, 0xf, 0xf, false);
            *(unsigned*)(F.ws + WS_HQ + (size_t)r * DM + 256 * j + 4 * F.lane) = odd ? (recv | (hl << 16)) : (hh | (recv << 16)); }
        if (F.lane == 0) ((float*)(F.ws + WS_HS))[r] = am > 0.f ? am * (1.f / 119.f) : 1.f;
    }
}
__device__ __forceinline__ void p_norm_rows(const Args& A, const Frame& F, int layer, int which, bool from_input, bool skip_ctx) {
    const int gw = F.bid * NWAVES + F.wave, NGW = F.nblk * NWAVES;
    const float* g = A.in[layer ? (which ? I1_NFFN : I1_NMIX) : (which ? I0_NFFN : I0_NMIX)];
    const float* MOD = (const float*)(F.ws + WS_MOD) + (size_t)layer * 5 * 6144;
    const unsigned short* X = (const unsigned short*)(F.ws + WS_X);
    const int ntok = skip_ctx ? NB * SEQ : R;
    for (int n = gw; n < ntok; n += 2 * NGW) {
        const bool has1 = (n + NGW) < ntok;
        const int r0 = skip_ctx ? tok_row(1, n) : n, r1 = has1 ? (skip_ctx ? tok_row(1, n + NGW) : n + NGW) : r0;
        f32x4 v0[4], v1[4]; float s0 = 0.f, s1 = 0.f;
        if (from_input) { const float* x0 = xin_row(F, r0); const float* x1 = xin_row(F, r1);
#pragma unroll
            for (int j = 0; j < 4; ++j) { v0[j] = *(const f32x4*)(x0 + 4 * F.lane + 256 * j); v1[j] = *(const f32x4*)(x1 + 4 * F.lane + 256 * j); } }
        else {
#pragma unroll
            for (int j = 0; j < 4; ++j) { const u32x2 a = *(const u32x2*)(X + (size_t)r0 * DM + 4 * F.lane + 256 * j), b = *(const u32x2*)(X + (size_t)r1 * DM + 4 * F.lane + 256 * j);
                v0[j] = (f32x4){h2f_lo(a.x), h2f_hi(a.x), h2f_lo(a.y), h2f_hi(a.y)}; v1[j] = (f32x4){h2f_lo(b.x), h2f_hi(b.x), h2f_lo(b.y), h2f_hi(b.y)}; } }
#pragma unroll
        for (int j = 0; j < 4; ++j) { s0 += (v0[j].x * v0[j].x + v0[j].y * v0[j].y) + (v0[j].z * v0[j].z + v0[j].w * v0[j].w); s1 += (v1[j].x * v1[j].x + v1[j].y * v1[j].y) + (v1[j].z * v1[j].z + v1[j].w * v1[j].w); }
        const float ri0 = rsqrtf(wave_sum(s0) * (1.f / DM) + EPS), ri1 = rsqrtf(wave_sum(s1) * (1.f / DM) + EPS);
        norm_row_out(F, v0, ri0, g, MOD + (size_t)mod_index(r0) * 6144 + (which ? 3 * 1024 : 0), r0, which);
        if (has1) norm_row_out(F, v1, ri1, g, MOD + (size_t)mod_index(r1) * 6144 + (which ? 3 * 1024 : 0), r1, which);
    }
}

namespace pg8 {
#define PG8_LAS __attribute__((address_space(3)))
typedef unsigned short bf16_t;
typedef short bf16x8 __attribute__((ext_vector_type(8)));
typedef float f32x4 __attribute__((ext_vector_type(4)));
typedef unsigned u32x4 __attribute__((ext_vector_type(4)));
typedef int pg8i4 __attribute__((ext_vector_type(4)));
constexpr int BM = 256, BK = 64, HALF = 128, HTB = HALF * BK * 2  , STAGE_BYTES = 8 * HTB, NXCD = 8, WGM = 8;

__host__ __device__ __forceinline__ int lds_byte(int r, int c) { const int st = (r >> 4) * 2 + (c >> 5), rr = r & 15, cc = c & 31, ob = rr * 64 + cc * 2; return st * 1024 + (ob ^ (((ob >> 9) & 1) << 5)); }
__host__ __device__ __forceinline__ void stage_rc(int b, int& R, int& C) { const int st = b / 1024, sb = b % 1024, swz = sb ^ (((sb >> 9) & 1) << 5); R = (st >> 1) * 16 + swz / 64; C = (st & 1) * 32 + (swz % 64) / 2; }
__host__ __device__ __forceinline__ int perm32(int rho) { const int n = rho >> 4, i = rho & 15; return 8 * (i >> 2) + 4 * n + (i & 3); }

struct Unit { int pm, pn; };
struct Gemm { const bf16_t* A; const bf16_t* Bt; int M, N, K; int sa = 0x7f7f7f7f, sb = 0x7f7f7f7f; };

struct StaticOrder {
    int nM, nN, nwg, G, c;
    __host__ __device__ void init(int M, int N, int G_, int c_) { nM = M / BM; nN = N / BM; nwg = nM * nN; G = G_; c = c_; }
    __host__ __device__ bool next(int i, Unit& u) const {
        const long L = (long)i * G + c; if (L >= nwg) return false;
        int wgid = (int)L; { const int q = nwg / NXCD, r = nwg % NXCD, xcd = wgid % NXCD, off = wgid / NXCD; wgid = (xcd < r ? xcd * (q + 1) : r * (q + 1) + (xcd - r) * q) + off; }
        const int nig = WGM * nN, gid = wgid / nig, fm = gid * WGM, gsz = (nM - fm) < WGM ? (nM - fm) : WGM;
        u.pm = fm + ((wgid % nig) % gsz); u.pn = (wgid % nig) / gsz; return true;
    }
    __device__ __forceinline__ void a_ready(const Unit&) const {}
    __device__ __forceinline__ void done(const Unit&) const {}
};

template <class Epi, class Sched, bool ALIGN_EPI = false, bool SP2 = false, bool F8 = false>
__device__ __forceinline__ void gemm_phase(PG8_LAS unsigned char* lds, const Gemm g, const Sched& S, const Epi& E) {
    const int tid = threadIdx.x, wid = __builtin_amdgcn_readfirstlane(tid >> 6), lane = tid & 63, wr = wid >> 2, wc = wid & 3, fr = lane & 15, fq = lane >> 4;
    const int vsa = g.sa, vsb = g.sb;
    const int K = g.K, KB = F8 ? K : 2 * K  , nt = KB / (BK * 2);
    unsigned voffA[2], voffB[2];
#pragma unroll
    for (int i = 0; i < 2; ++i) { int R, C; stage_rc(tid * 16 + i * 8192, R, C); const int Rb = Epi::PERM ? ((R & ~31) + perm32(R & 31)) : R;
        voffA[i] = (unsigned)(R * KB + C * 2); voffB[i] = (unsigned)(Rb * KB + C * 2); }
    const size_t kstep = (size_t)(BK * 2);
    const size_t hstep = (size_t)HALF * KB;
    const size_t tstep = 2 * hstep;
    const unsigned ldsw = (unsigned)wid * 1024u;
    const int aoff = lds_byte(wr * 64 + fr, fq * 8), boff = lds_byte(wc * 32 + fr, fq * 8);
#define PG8_SA(b, h) (((b) * 2 + (h)) * HTB)
#define PG8_SB(b, h) ((4 + (b) * 2 + (h)) * HTB)
#define PG8_STAGE(bufoff, gbase, voff) do { _Pragma("unroll") for (int _i = 0; _i < 2; ++_i) \
        __builtin_amdgcn_global_load_lds((const unsigned*)((const char*)(gbase) + (voff)[_i]), (PG8_LAS unsigned*)(lds + (bufoff) + ldsw + _i * 8192), 16, 0, 0); } while (0)
#define PG8_LDA(dst, b, h) do { if constexpr (F8) { _Pragma("unroll") for (int m = 0; m < 4; ++m) { const pg8i4 x0_ = *(const PG8_LAS pg8i4*)(lds + PG8_SA(b, h) + aoff + m * 2048), x1_ = *(const PG8_LAS pg8i4*)(lds + PG8_SA(b, h) + aoff + m * 2048 + 1024); dst##8[m] = __builtin_shufflevector(x0_, x1_, 0, 1, 2, 3, 4, 5, 6, 7); } } \
    else { _Pragma("unroll") for (int m = 0; m < 4; ++m) _Pragma("unroll") for (int k = 0; k < 2; ++k) dst[m][k] = *(const PG8_LAS bf16x8*)(lds + PG8_SA(b, h) + aoff + m * 2048 + k * 1024); } } while (0)
#define PG8_LDB(dst, b, h) do { if constexpr (F8) { _Pragma("unroll") for (int n = 0; n < 2; ++n) { const pg8i4 x0_ = *(const PG8_LAS pg8i4*)(lds + PG8_SB(b, h) + boff + n * 2048), x1_ = *(const PG8_LAS pg8i4*)(lds + PG8_SB(b, h) + boff + n * 2048 + 1024); dst##8[n] = __builtin_shufflevector(x0_, x1_, 0, 1, 2, 3, 4, 5, 6, 7); } } \
    else { _Pragma("unroll") for (int n = 0; n < 2; ++n) _Pragma("unroll") for (int k = 0; k < 2; ++k) dst[n][k] = *(const PG8_LAS bf16x8*)(lds + PG8_SB(b, h) + boff + n * 2048 + k * 1024); } } while (0)
#define PG8_MMA(ai, bj, At, Bt) do { __builtin_amdgcn_s_setprio(1); _Pragma("unroll") for (int m = 0; m < 4; ++m) _Pragma("unroll") for (int n = 0; n < 2; ++n) { \
        if constexpr (F8) asm volatile("v_mfma_scale_f32_16x16x128_f8f6f4 %0, %1, %2, %0, %3, %4 op_sel_hi:[0,0,0]" : "+v"(acc[ai][bj][m][n]) : "v"(Bt##8[n]), "v"(At##8[m]), "v"(vsa), "v"(vsb));        \
        else { _Pragma("unroll") for (int k = 0; k < 2; ++k) acc[ai][bj][m][n] = __builtin_amdgcn_mfma_f32_16x16x32_bf16(Bt[n][k], At[m][k], acc[ai][bj][m][n], 0, 0, 0); } } __builtin_amdgcn_s_setprio(0); } while (0)
#define PG8_WAIT_V(n) asm volatile("s_waitcnt vmcnt(" #n ")" ::: "memory")
#define PG8_WAIT_L(n) asm volatile("s_waitcnt lgkmcnt(" #n ")" ::: "memory")
#define PG8_BAR __builtin_amdgcn_s_barrier()
#define PG8_SCHED __builtin_amdgcn_sched_barrier(0)
    Unit cur, nxt; int ui = 0;
    if (!S.next(0, cur)) return;
    f32x4 acc[2][2][4][2];
#pragma unroll
    for (int a = 0; a < 2; ++a)
#pragma unroll
        for (int b = 0; b < 2; ++b)
#pragma unroll
            for (int m = 0; m < 4; ++m)
#pragma unroll
                for (int n = 0; n < 2; ++n) acc[a][b][m][n] = (f32x4){0.f, 0.f, 0.f, 0.f};
    bf16x8 At[4][2], B0[2][2], B1[2][2]; typedef int pg8i8 __attribute__((ext_vector_type(8))); pg8i8 At8[4], B08[2], B18[2];
    const char* cA = (const char*)g.A + (size_t)cur.pm * tstep; const char* cB = (const char*)g.Bt + (size_t)cur.pn * tstep;
    S.a_ready(cur);
    if constexpr (SP2) {
        PG8_STAGE(PG8_SB(0, 0), cB, voffB); PG8_STAGE(PG8_SB(0, 1), cB + hstep, voffB); PG8_STAGE(PG8_SA(0, 0), cA, voffA); PG8_STAGE(PG8_SA(0, 1), cA + hstep, voffA);
        if (wr == 1) PG8_BAR;
        PG8_WAIT_V(2); PG8_BAR;
        PG8_STAGE(PG8_SB(1, 0), cB + kstep, voffB); PG8_STAGE(PG8_SA(1, 0), cA + kstep, voffA); PG8_STAGE(PG8_SB(1, 1), cB + hstep + kstep, voffB);
        PG8_WAIT_V(6); PG8_BAR;
    } else {
        PG8_STAGE(PG8_SB(0, 0), cB, voffB); PG8_STAGE(PG8_SA(0, 0), cA, voffA); PG8_STAGE(PG8_SB(0, 1), cB + hstep, voffB); PG8_STAGE(PG8_SA(0, 1), cA + hstep, voffA);
        if (wr == 1) PG8_BAR;
        PG8_WAIT_V(4); PG8_BAR;
        PG8_STAGE(PG8_SB(1, 0), cB + kstep, voffB); PG8_STAGE(PG8_SA(1, 0), cA + kstep, voffA); PG8_STAGE(PG8_SB(1, 1), cB + hstep + kstep, voffB);
        PG8_WAIT_V(6); PG8_BAR;
    }
    for (;;) {
        const bool has_next = S.next(ui + 1, nxt);
        const char* nA = has_next ? (const char*)g.A + (size_t)nxt.pm * tstep : cA; const char* nB = has_next ? (const char*)g.Bt + (size_t)nxt.pn * tstep : cB;
        for (int t = 0; t < nt; t += 2) {
            const bool last = (t == nt - 2);
            const char* a1 = cA + (size_t)(t + 1) * kstep;
            const char* a2 = last ? nA : cA + (size_t)(t + 2) * kstep; const char* b2 = last ? nB : cB + (size_t)(t + 2) * kstep;
            const char* a3 = a2 + kstep; const char* b3 = b2 + kstep;
            if (last && has_next) S.a_ready(nxt);
            if constexpr (SP2) {
            PG8_LDB(B0, 0, 0); PG8_LDB(B1, 0, 1); PG8_SCHED; PG8_LDA(At, 0, 0); PG8_STAGE(PG8_SA(1, 1), a1 + hstep, voffA);
            PG8_WAIT_V(8); PG8_WAIT_L(0); PG8_BAR; PG8_MMA(0, 0, At, B0); PG8_MMA(0, 1, At, B1); PG8_BAR; PG8_SCHED;
            PG8_LDA(At, 0, 1); PG8_STAGE(PG8_SB(0, 0), b2, voffB); PG8_STAGE(PG8_SB(0, 1), b2 + hstep, voffB); PG8_STAGE(PG8_SA(0, 0), a2, voffA);
            PG8_WAIT_V(8); PG8_WAIT_L(0); PG8_BAR; PG8_MMA(1, 0, At, B0); PG8_MMA(1, 1, At, B1); PG8_BAR; PG8_SCHED;
            PG8_LDB(B0, 1, 0); PG8_LDB(B1, 1, 1); PG8_SCHED; PG8_LDA(At, 1, 0); PG8_STAGE(PG8_SA(0, 1), a2 + hstep, voffA);
            PG8_WAIT_V(8); PG8_WAIT_L(0); PG8_BAR; PG8_MMA(0, 0, At, B0); PG8_MMA(0, 1, At, B1); PG8_BAR; PG8_SCHED;
            PG8_LDA(At, 1, 1); PG8_STAGE(PG8_SB(1, 0), b3, voffB); PG8_STAGE(PG8_SB(1, 1), b3 + hstep, voffB); PG8_STAGE(PG8_SA(1, 0), a3, voffA);
            PG8_WAIT_V(8); PG8_WAIT_L(0); PG8_BAR; PG8_MMA(1, 0, At, B0); PG8_MMA(1, 1, At, B1); PG8_BAR; PG8_SCHED;
            } else {
            PG8_LDB(B0, 0, 0); PG8_SCHED; PG8_LDA(At, 0, 0); PG8_STAGE(PG8_SA(1, 1), a1 + hstep, voffA);
            PG8_WAIT_L(8); PG8_BAR; PG8_WAIT_L(0); PG8_MMA(0, 0, At, B0); PG8_BAR; PG8_SCHED;
            PG8_LDB(B1, 0, 1); PG8_STAGE(PG8_SB(0, 0), b2, voffB);
            PG8_BAR; PG8_WAIT_L(0); PG8_MMA(0, 1, At, B1); PG8_BAR;
            PG8_LDA(At, 0, 1); PG8_STAGE(PG8_SA(0, 0), a2, voffA);
            PG8_BAR; PG8_WAIT_L(0); PG8_MMA(1, 0, At, B0); PG8_BAR; PG8_SCHED;
            PG8_STAGE(PG8_SB(0, 1), b2 + hstep, voffB);
            PG8_WAIT_V(6); PG8_BAR; PG8_MMA(1, 1, At, B1); PG8_BAR;
            PG8_LDB(B0, 1, 0); PG8_SCHED; PG8_LDA(At, 1, 0); PG8_STAGE(PG8_SA(0, 1), a2 + hstep, voffA);
            PG8_WAIT_L(8); PG8_BAR; PG8_WAIT_L(0); PG8_MMA(0, 0, At, B0); PG8_BAR; PG8_SCHED;
            PG8_LDB(B1, 1, 1); PG8_STAGE(PG8_SB(1, 0), b3, voffB);
            PG8_BAR; PG8_WAIT_L(0); PG8_MMA(0, 1, At, B1); PG8_BAR;
            PG8_LDA(At, 1, 1); PG8_STAGE(PG8_SA(1, 0), a3, voffA);
            PG8_BAR; PG8_WAIT_L(0); PG8_MMA(1, 0, At, B0); PG8_BAR; PG8_SCHED;
            PG8_STAGE(PG8_SB(1, 1), b3 + hstep, voffB);
            PG8_WAIT_V(6); PG8_BAR; PG8_MMA(1, 1, At, B1); PG8_BAR;
            }
        }
        if constexpr (ALIGN_EPI) { if (wr == 0) PG8_BAR; }
        if constexpr (!Epi::AFTER_DRAIN) { if constexpr (F8) { asm volatile("s_nop 15\n\ts_nop 15" ::: "memory");
            int t2_ = threadIdx.x; asm volatile("" : "+v"(t2_)); const int w2_ = t2_ >> 6, l2_ = t2_ & 63; E(acc, cur, w2_ >> 2, w2_ & 3, l2_ & 15, l2_ >> 4); }
            else E(acc, cur, wr, wc, fr, fq); S.done(cur); }
        if (!has_next) break;
#pragma unroll
        for (int a = 0; a < 2; ++a)
#pragma unroll
            for (int b = 0; b < 2; ++b)
#pragma unroll
                for (int m = 0; m < 4; ++m)
#pragma unroll
                    for (int n = 0; n < 2; ++n) acc[a][b][m][n] = (f32x4){0.f, 0.f, 0.f, 0.f};
        cur = nxt; cA = nA; cB = nB; ++ui;
        if constexpr (ALIGN_EPI) { if (wr == 1) PG8_BAR; }
    }
    PG8_WAIT_V(0);
    if constexpr (!ALIGN_EPI) { if (wr == 0) PG8_BAR; }
    PG8_BAR;
    if constexpr (Epi::AFTER_DRAIN) { E.fused(acc, cur, wr, wc, fr, fq, lds, wid, lane); S.done(cur); }
#undef PG8_SA
#undef PG8_SB
#undef PG8_STAGE
#undef PG8_LDA
#undef PG8_LDB
#undef PG8_MMA
#undef PG8_WAIT_V
#undef PG8_WAIT_L
#undef PG8_BAR
#undef PG8_SCHED
}
}

template <class Inner> struct EpiTile { static constexpr bool PERM = true, AFTER_DRAIN = false; Inner in;
    __device__ __forceinline__ void operator()(const pg8::f32x4 (&acc)[2][2][4][2], const pg8::Unit& u, int wr, int wc, int fr, int fq) const {
#pragma unroll
        for (int ai = 0; ai < 2; ++ai)
#pragma unroll
            for (int m = 0; m < 4; ++m) { const int row = u.pm * 256 + ai * 128 + wr * 64 + m * 16 + fr;
#pragma unroll
                for (int bj = 0; bj < 2; ++bj) in(row, u.pn * 256 + bj * 128 + wc * 32 + 8 * fq, acc[ai][bj][m][0], acc[ai][bj][m][1]); }
    } };
struct In8Bf16 { bf16_t* C; int ldc;
    __device__ __forceinline__ void operator()(int row, int col, f32x4 a, f32x4 b) const { u32x4 o; o.x = cvtpk(a.x, a.y); o.y = cvtpk(a.z, a.w); o.z = cvtpk(b.x, b.y); o.w = cvtpk(b.z, b.w); *(u32x4*)(C + (size_t)row * ldc + col) = o; } };
struct In8KV { bf16_t* Kb; bf16_t* Vb;
    __device__ __forceinline__ void operator()(int row, int col, f32x4 a, f32x4 b) const { const int h = col >> 8, c = col & 255; u32x4 o; o.x = cvtpk(a.x, a.y); o.y = cvtpk(a.z, a.w); o.z = cvtpk(b.x, b.y); o.w = cvtpk(b.z, b.w);
        bf16_t* p = (c < 128) ? Kb + (size_t)row * 1536 + h * 192 + c : Vb + (size_t)row * 1024 + h * 128 + (c - 128);
        *(u32x4*)p = o; } };
struct In8F16 { unsigned short* C; int ldc;
    __device__ __forceinline__ void operator()(int row, int col, f32x4 a, f32x4 b) const { u32x4 o; o.x = pkh2(a.x, a.y); o.y = pkh2(a.z, a.w); o.z = pkh2(b.x, b.y); o.w = pkh2(b.z, b.w); *(u32x4*)(C + (size_t)row * ldc + col) = o; } };
struct In8F32 { float* C; int ldc;
    __device__ __forceinline__ void operator()(int row, int col, f32x4 a, f32x4 b) const { float* p = C + (size_t)row * ldc + col; *(f32x4*)p = a; *(f32x4*)(p + 4) = b; } };
struct In8Resid { const float* x; const float* ctx; unsigned short* X; const float* gate; bool from_input; bf16_t* dbg = nullptr;
    __device__ __forceinline__ void operator()(int row, int col, f32x4 a, f32x4 b) const {
        const int bb = row / RPB, j = row - bb * RPB; unsigned short* xo = X + (size_t)row * DM + col;
        f32x4 x0, x1;
        if (from_input) { const float* xi = ((j < CTXL) ? ctx + ((size_t)bb * CTXL + j) * DM : x + ((size_t)bb * SEQ + (j - CTXL)) * DM) + col; x0 = *(const f32x4*)xi; x1 = *(const f32x4*)(xi + 4); }
        else { const u32x4 w = *(const u32x4*)xo; x0 = (f32x4){h2f_lo(w.x), h2f_hi(w.x), h2f_lo(w.y), h2f_hi(w.y)}; x1 = (f32x4){h2f_lo(w.z), h2f_hi(w.z), h2f_lo(w.w), h2f_hi(w.w)}; }
#if GEMM_SELFTEST
        if (dbg && col < 256) { u32x4 d; d.x = pk2(a.x, a.y); d.y = pk2(a.z, a.w); d.z = pk2(b.x, b.y); d.w = pk2(b.z, b.w); *(u32x4*)(dbg + (size_t)row * 256 + col) = d; }
#endif
        const float* g = gate + (size_t)((j < CTXL) ? 4 : bb) * 6144 + col;
        x0 += *(const f32x4*)g * a; x1 += *(const f32x4*)(g + 4) * b;
        u32x4 o; o.x = pkh2(x0.x, x0.y); o.y = pkh2(x0.z, x0.w); o.z = pkh2(x1.x, x1.y); o.w = pkh2(x1.z, x1.w); *(u32x4*)xo = o; } };
struct EpiMlaDown { static constexpr bool PERM = true, AFTER_DRAIN = false; unsigned char* CQ8; unsigned char* CKV8; bf16_t* KR; float* SSP;
    __device__ __forceinline__ void operator()(const pg8::f32x4 (&acc)[2][2][4][2], const pg8::Unit& u, int wr, int wc, int fr, int fq) const {
#pragma unroll
        for (int ai = 0; ai < 2; ++ai)
#pragma unroll
            for (int m = 0; m < 4; ++m) { const int row = u.pm * 256 + ai * 128 + wr * 64 + m * 16 + fr;
#pragma unroll
                for (int bj = 0; bj < 2; ++bj) { const int col = u.pn * 256 + bj * 128 + wc * 32 + 8 * fq; const f32x4 a = acc[ai][bj][m][0], b = acc[ai][bj][m][1];
                    const int cls = (u.pn * 2 + bj);
                    if (cls < 5) { float sq = (a.x * a.x + a.y * a.y) + (a.z * a.z + a.w * a.w) + (b.x * b.x + b.y * b.y) + (b.z * b.z + b.w * b.w);
                        sq += __shfl_xor(sq, 16); sq += __shfl_xor(sq, 32);
                        u32x2 o8; o8.x = f8x4(a.x, a.y, a.z, a.w); o8.y = f8x4(b.x, b.y, b.z, b.w);
                        if (cls < 3) *(u32x2*)(CQ8 + (size_t)row * 512 + col) = o8; else *(u32x2*)(CKV8 + (size_t)row * 256 + (col - 384)) = o8;
                        if (fq == 0) SSP[(size_t)row * 24 + cls * 4 + wc] = sq; }
                    else if (col < 704) { u32x4 o; o.x = cvtpk(a.x, a.y); o.y = cvtpk(a.z, a.w); o.z = cvtpk(b.x, b.y); o.w = cvtpk(b.z, b.w); *(u32x4*)(KR + (size_t)row * 64 + (col - 640)) = o; }
                    else *(u32x4*)(CQ8 + (size_t)row * 512 + 384 + 2 * (col - 704)) = (u32x4){0u, 0u, 0u, 0u}; } }
    } };
struct In8Bf16Rs { bf16_t* C; int ldc; const float* ssp;
    __device__ __forceinline__ void operator()(int row, int col, f32x4 a, f32x4 b) const { const f32x4 s0 = *(const f32x4*)(ssp + (size_t)row * 24), s1 = *(const f32x4*)(ssp + (size_t)row * 24 + 4), s2 = *(const f32x4*)(ssp + (size_t)row * 24 + 8);
        const float ssum = (((s0.x + s0.y) + (s0.z + s0.w)) + ((s1.x + s1.y) + (s1.z + s1.w))) + ((s2.x + s2.y) + (s2.z + s2.w));
        const float rs = rsqrtf(ssum * (1.f / 384.f) + EPS); a *= rs; b *= rs;
        u32x4 o; o.x = cvtpk(a.x, a.y); o.y = cvtpk(a.z, a.w); o.z = cvtpk(b.x, b.y); o.w = cvtpk(b.z, b.w); *(u32x4*)(C + (size_t)row * ldc + col) = o; } };
struct In8KVRs { unsigned char* K8; unsigned char* V8; const float* ssp;
    __device__ __forceinline__ void operator()(int row, int col, f32x4 a, f32x4 b) const { const f32x4 s0 = *(const f32x4*)(ssp + (size_t)row * 24 + 12), s1 = *(const f32x4*)(ssp + (size_t)row * 24 + 16);
        const float ssum = ((s0.x + s0.y) + (s0.z + s0.w)) + ((s1.x + s1.y) + (s1.z + s1.w));
        const float rs = rsqrtf(ssum * (1.f / 256.f) + EPS); a *= rs; b *= rs;
        const int h = col >> 8, c = col & 255;
        if (c < 128) { u32x2 o; o.x = f8x4(a.x, a.y, a.z, a.w); o.y = f8x4(b.x, b.y, b.z, b.w); *(u32x2*)(K8 + (size_t)row * 1536 + h * 192 + c) = o; }
        else { u32x2 o; o.x = f8x4(a.x, a.y, a.z, a.w); o.y = f8x4(b.x, b.y, b.z, b.w); *(u32x2*)(V8 + (size_t)row * 1024 + h * 128 + (c - 128)) = o; } } };
struct RowSched { pg8::StaticOrder so; bool latent_only;
    __device__ __forceinline__ void init(int N, int G, int c, bool lat) { latent_only = lat; so.init(lat ? NB * SEQ : R, N, G, c); }
    __device__ __forceinline__ bool next(int i, pg8::Unit& u) const { if (!so.next(i, u)) return false; if (latent_only) u.pm = (u.pm >> 4) * 17 + 1 + (u.pm & 15); return true; }
    __device__ __forceinline__ void a_ready(const pg8::Unit&) const {}
    __device__ __forceinline__ void done(const pg8::Unit&) const {} };
template <class Inner, bool F8 = false> __device__ __forceinline__ void gemm8(const Frame& F, const void* Ap, const void* Bt, int N, int K, bool latent_only, const Inner& in, bool reverse = false, int sa = 0, int sb = 0) {
    asm volatile("" : "+s"(K));
    pg8::Gemm g{(const bf16_t*)Ap, (const bf16_t*)Bt, R, N, K, 0x01010101 * (127 - sa), 0x01010101 * (127 - sb)}; RowSched S; S.init(N, F.nblk, reverse ? F.nblk - 1 - F.bid : F.bid, latent_only);
    EpiTile<Inner> E{in};
    pg8::gemm_phase<EpiTile<Inner>, RowSched, true, true, F8>((PG8_LAS unsigned char*)F.lds, g, S, E);
}

template <class Epi, bool F8 = false> __device__ __forceinline__ void gemm8e(const Frame& F, const void* Ap, const void* Bt, int N, int K, bool latent_only, const Epi& E, int sa = 0, int sb = 0) {
    asm volatile("" : "+s"(K));
    pg8::Gemm g{(const bf16_t*)Ap, (const bf16_t*)Bt, R, N, K, 0x01010101 * (127 - sa), 0x01010101 * (127 - sb)}; RowSched S; S.init(N, F.nblk, F.bid, latent_only);
    pg8::gemm_phase<Epi, RowSched, true, true, F8>((PG8_LAS unsigned char*)F.lds, g, S, E);
}

struct GemmDesc { const bf16_t* A; int lda; long sA; const bf16_t* Bt; int ldb; long sB; int M, N, K, nz; };
template <class Epi>
__device__ __forceinline__ void gemm_simple(const Frame& F, const GemmDesc& g, const Epi& epi, bool skip_ctx) {
    const int wm = F.wave >> 1, wn = F.wave & 1, fr = F.lane & 15, fq = F.lane >> 4;
    const int tM = g.M / 128, tN = g.N / 128, per = tM * tN, total = per * g.nz;
    for (int u = F.bid; u < total; u += F.nblk) {
        const int z = u / per, uu = u - z * per, tm = uu / tN, tn = uu - tm * tN;
        if (skip_ctx && ((tm * 128) % RPB) < CTXL) continue;
        const int row0 = tm * 128 + wm * 32, col0 = tn * 128 + wn * 64;
        const bf16_t* ap = g.A + z * g.sA + (size_t)(row0 + fr) * g.lda + fq * 8;
        const bf16_t* bp = g.Bt + z * g.sB + (size_t)(col0 + fr) * g.ldb + fq * 8;
        f32x4 acc[2][4];
#pragma unroll
        for (int mi = 0; mi < 2; ++mi)
#pragma unroll
            for (int ni = 0; ni < 4; ++ni) acc[mi][ni] = (f32x4){0.f, 0.f, 0.f, 0.f};
        for (int k0 = 0; k0 < g.K; k0 += 32) {
            bf16x8 a[2], b[4];
#pragma unroll
            for (int mi = 0; mi < 2; ++mi) a[mi] = *(const bf16x8*)(ap + (size_t)mi * 16 * g.lda + k0);
#pragma unroll
            for (int ni = 0; ni < 4; ++ni) b[ni] = *(const bf16x8*)(bp + (size_t)ni * 16 * g.ldb + k0);
#pragma unroll
            for (int mi = 0; mi < 2; ++mi)
#pragma unroll
                for (int ni = 0; ni < 4; ++ni) acc[mi][ni] = __builtin_amdgcn_mfma_f32_16x16x32_bf16(b[ni], a[mi], acc[mi][ni], 0, 0, 0);
        }
#pragma unroll
        for (int mi = 0; mi < 2; ++mi)
#pragma unroll
            for (int ni = 0; ni < 4; ++ni) epi(z, row0 + mi * 16 + fr, col0 + ni * 16 + fq * 4, acc[mi][ni]);
    }
}
struct EpiBf16 { bf16_t* C; int ldc;
    __device__ __forceinline__ void operator()(int, int row, int col, f32x4 v) const { u32x2 o; o.x = pk2(v.x, v.y); o.y = pk2(v.z, v.w); *(u32x2*)(C + (size_t)row * ldc + col) = o; } };
struct EpiKV { bf16_t* Kb; bf16_t* Vb;
    __device__ __forceinline__ void operator()(int, int row, int col, f32x4 v) const { const int h = col >> 8, c = col & 255; u32x2 o; o.x = pk2(v.x, v.y); o.y = pk2(v.z, v.w);
        if (c < 128) *(u32x2*)(Kb + (size_t)row * 1536 + h * 192 + c) = o; else *(u32x2*)(Vb + (size_t)row * 1024 + h * 128 + (c - 128)) = o; } };
struct EpiF32Z { float* C; int ldc;
    __device__ __forceinline__ void operator()(int z, int row, int col, f32x4 v) const { *(f32x4*)(C + (size_t)row * ldc + z * 128 + col) = v; } };
struct EpiResid { const Frame* F; const float* gate; bool from_input;
    __device__ __forceinline__ void operator()(int, int row, int col, f32x4 v) const {
        float* X = (float*)(F->ws + WS_X) + (size_t)row * DM + col;
        const float* xi = from_input ? xin_row(*F, row) + col : X;
        const f32x4 g = *(const f32x4*)(gate + (size_t)mod_index(row) * 6144 + col);
        *(f32x4*)X = *(const f32x4*)xi + g * v; } };

__device__ __forceinline__ void rope_angles(int r, int& prow, int& pcol) { const int t = (r % RPB) - CTXL; prow = t >> 6; pcol = t & 63; }
__device__ __forceinline__ void p_mla_krope(const Args& A, const Frame& F) {
    const int gw = F.bid * NWAVES + F.wave, NGW = F.nblk * NWAVES, lane = F.lane;
    const bf16_t* KR = (const bf16_t*)(F.ws + WS_KR); unsigned char* K8 = F.ws + WS_K;
    const float invf = __powf(10000.f, -(float)(lane & 15) * (1.f / 16.f));
    for (int r = gw; r < R; r += NGW) {
        float kr = bf2f(KR[(size_t)r * 64 + lane]);
        if (!is_ctx_row(r)) {
            int prow, pcol; rope_angles(r, prow, pcol);
            const float ang = (float)((lane & 32) ? pcol : prow) * invf;
            const float cs = cosf(ang), sn = sinf(ang);
            const float partner = __shfl_xor(kr, 16);
            kr = kr * cs + ((lane & 16) ? partner : -partner) * sn;
        }
        const unsigned char kb = (unsigned char)(f8x4(kr, kr, kr, kr) & 0xffu);
#pragma unroll
        for (int h = 0; h < 8; ++h) K8[(size_t)r * 1536 + h * 192 + 128 + lane] = kb;
    }
}
__device__ __forceinline__ float row16_sum(float v) { v += WDPP(v, 0xB1); v += WDPP(v, 0x4E); v += WDPP(v, 0x141); v += WDPP(v, 0x140); return v; }
__device__ __forceinline__ void p_gqa_rows(const Args& A, const Frame& F) {
    const int gw = F.bid * NWAVES + F.wave, NGW = F.nblk * NWAVES, lane = F.lane, c16 = lane & 15, hrow = lane >> 4;
    const bf16_t* RAW = (const bf16_t*)(F.ws + WS_RAW1); bf16_t* Q1 = (bf16_t*)(F.ws + WS_Q1); unsigned char* K18 = F.ws + WS_K1; unsigned char* V18 = F.ws + WS_V1;
    float qg[8], kg[8], invf[8];
#pragma unroll
    for (int e = 0; e < 8; ++e) { qg[e] = A.in[I1_QN][8 * c16 + e]; kg[e] = A.in[I1_KN][8 * c16 + e]; invf[e] = __powf(10000.f, -(float)(8 * (c16 & 3) + e) * (1.f / 32.f)); }
    const bool colaxis = (c16 & 8) != 0, hi32 = (c16 & 4) != 0;
    for (int r = gw; r < R; r += NGW) {
        const bool ctx = is_ctx_row(r);
        const bf16_t* a = RAW + (size_t)r * 1536 + 8 * lane;
        u32x4 ch[3];
#pragma unroll
        for (int j = 0; j < 3; ++j) ch[j] = (ctx && j < 2) ? (u32x4){0u, 0u, 0u, 0u} : *(const u32x4*)(a + 512 * j);
        float cs[8], sn[8];
        { int prow = 0, pcol = 0; if (!ctx) rope_angles(r, prow, pcol); const float pos = (float)(colaxis ? pcol : prow);
#pragma unroll
          for (int e = 0; e < 8; ++e) { const float ang = pos * invf[e]; cs[e] = ctx ? 1.f : __cosf(ang); sn[e] = ctx ? 0.f : __sinf(ang); } }
#pragma unroll
        for (int j = 0; j < 3; ++j) {
            if (ctx && j < 2) continue;
            const bool isv = (j == 2) && (hrow >= 2);
            float x[8];
#pragma unroll
            for (int d = 0; d < 4; ++d) { x[2 * d] = bflo(ch[j][d]); x[2 * d + 1] = bfhi(ch[j][d]); }
            float sq = 0.f;
#pragma unroll
            for (int e = 0; e < 8; ++e) sq += x[e] * x[e];
            const float rinv = rsqrtf(row16_sum(sq) * (1.f / 128.f) + EPS);
            u32x4 o;
            float y[8];
#pragma unroll
            for (int e = 0; e < 8; ++e) y[e] = x[e] * rinv * (j < 2 ? qg[e] : kg[e]);
            u32x4 yp; yp.x = pk2(y[0], y[1]); yp.y = pk2(y[2], y[3]); yp.z = pk2(y[4], y[5]); yp.w = pk2(y[6], y[7]);
            float pr[8];
#pragma unroll
            for (int d = 0; d < 4; ++d) { const float lo = __shfl_xor(y[2 * d], 4), hi2 = __shfl_xor(y[2 * d + 1], 4); pr[2 * d] = lo; pr[2 * d + 1] = hi2; }
            float z[8];
#pragma unroll
            for (int e = 0; e < 8; ++e) z[e] = y[e] * cs[e] + (hi32 ? pr[e] : -pr[e]) * sn[e];
            o.x = pk2(z[0], z[1]); o.y = pk2(z[2], z[3]); o.z = pk2(z[4], z[5]); o.w = pk2(z[6], z[7]);
            (void)yp;
            if (isv) o = ch[j];
            if (j < 2) *(u32x4*)(Q1 + (size_t)r * 1024 + 512 * j + 8 * lane) = o;
            else if (hrow < 2) { u32x2 o8; o8.x = f8x4(z[0], z[1], z[2], z[3]); o8.y = f8x4(z[4], z[5], z[6], z[7]); *(u32x2*)(K18 + (size_t)r * 256 + 8 * lane) = o8; }
            else { u32x2 o8; o8.x = f8x4(x[0], x[1], x[2], x[3]); o8.y = f8x4(x[4], x[5], x[6], x[7]); *(u32x2*)(V18 + (size_t)r * 256 + 8 * (lane - 32)) = o8; }
        }
    }
}

__device__ __forceinline__ int crow(int r, int hi) { return (r & 3) + 8 * (r >> 2) + 4 * hi; }
__device__ __forceinline__ int v_st(int k, int c) { const int kk = (k & ~0xC) | ((k & 4) << 1) | ((k & 8) >> 1); return ((kk >> 3) * 4 + (c >> 5)) * 512 + ((kk & 7) * 32 + (c & 31)) * 2; }
__device__ __forceinline__ int v_rd_base(int lane) { return ((lane & 3) << 3) | (((lane >> 2) & 3) << 6) | (((lane >> 4) & 1) << 5) | (((lane >> 5) & 1) << 8); }
constexpr int v_rd_off(int d0, int ks, int half) { return d0 * 512 + ks * 4096 + half * 2048; }
template <int OFF> __device__ __forceinline__ s16x4 tr_read(int vb) { s16x4 r; asm volatile("ds_read_b64_tr_b16 %0, %1 offset:%2" : "=&v"(r) : "v"(vb), "i"(OFF) : "memory"); return r; }
template <int D0> __device__ __forceinline__ void pv_one(f32x16& od, int vb, bf16x8 pa0, bf16x8 pa1, bf16x8 pa2, bf16x8 pa3) {
    const s16x4 l0 = tr_read<v_rd_off(D0, 0, 0)>(vb), h0 = tr_read<v_rd_off(D0, 0, 1)>(vb), l1 = tr_read<v_rd_off(D0, 1, 0)>(vb), h1 = tr_read<v_rd_off(D0, 1, 1)>(vb);
    const s16x4 l2 = tr_read<v_rd_off(D0, 2, 0)>(vb), h2 = tr_read<v_rd_off(D0, 2, 1)>(vb), l3 = tr_read<v_rd_off(D0, 3, 0)>(vb), h3 = tr_read<v_rd_off(D0, 3, 1)>(vb);
    asm volatile("s_waitcnt lgkmcnt(0)" ::: "memory"); SBAR();
#define PK(L, H) (bf16x8){L[0], L[1], L[2], L[3], H[0], H[1], H[2], H[3]}
    od = __builtin_amdgcn_mfma_f32_32x32x16_bf16(pa0, PK(l0, h0), od, 0, 0, 0);
    od = __builtin_amdgcn_mfma_f32_32x32x16_bf16(pa1, PK(l1, h1), od, 0, 0, 0);
    od = __builtin_amdgcn_mfma_f32_32x32x16_bf16(pa2, PK(l2, h2), od, 0, 0, 0);
    od = __builtin_amdgcn_mfma_f32_32x32x16_bf16(pa3, PK(l3, h3), od, 0, 0, 0);
#undef PK
}
__device__ __forceinline__ void pv_d0(f32x16* o, int vb, bf16x8 pa0, bf16x8 pa1, bf16x8 pa2, bf16x8 pa3) {
    pv_one<0>(o[0], vb, pa0, pa1, pa2, pa3); pv_one<1>(o[1], vb, pa0, pa1, pa2, pa3); pv_one<2>(o[2], vb, pa0, pa1, pa2, pa3); pv_one<3>(o[3], vb, pa0, pa1, pa2, pa3);
}
constexpr float ATT_THR = 8.f;
__device__ __forceinline__ void partialSM(f32x16& p0, f32x16& p1, float& m_reg, float& mn, float& alpha, float C, float thr_raw) {
    float pmax = p0[0];
#pragma unroll
    for (int r = 1; r < 16; ++r) pmax = fmaxf(pmax, p0[r]);
#pragma unroll
    for (int r = 0; r < 16; ++r) pmax = fmaxf(pmax, p1[r]);
    { auto rr = __builtin_amdgcn_permlane32_swap(__float_as_uint(pmax), __float_as_uint(pmax), false, false);
      pmax = fmaxf(__uint_as_float(rr[0]), __uint_as_float(rr[1])); }
    if (__builtin_expect(__all(pmax - m_reg <= thr_raw), 1)) { mn = m_reg; alpha = 1.f; }
    else { mn = fmaxf(m_reg, pmax); alpha = __builtin_amdgcn_exp2f((m_reg - mn) * C); m_reg = mn; }
    const float mnC = -mn * C;
#pragma unroll
    for (int r = 0; r < 16; ++r) p0[r] = fmaf(p0[r], C, mnC);
#pragma unroll
    for (int r = 0; r < 16; ++r) p1[r] = fmaf(p1[r], C, mnC);
#pragma unroll
    for (int r = 0; r < 16; ++r) p0[r] = __builtin_amdgcn_exp2f(p0[r]);
}
__device__ __forceinline__ void finishSM(f32x16& p0, f32x16& p1, float alpha, float& l_reg, bf16x8& pa0, bf16x8& pa1, bf16x8& pa2, bf16x8& pa3) {
#pragma unroll
    for (int r = 0; r < 16; ++r) p1[r] = __builtin_amdgcn_exp2f(p1[r]);
    float ps = 0;
#pragma unroll
    for (int r = 0; r < 16; ++r) ps += p0[r];
#pragma unroll
    for (int r = 0; r < 16; ++r) ps += p1[r];
    { auto rr = __builtin_amdgcn_permlane32_swap(__float_as_uint(ps), __float_as_uint(ps), false, false);
      ps = __uint_as_float(rr[0]) + __uint_as_float(rr[1]); }
    l_reg = l_reg * alpha + ps;
#define PK4(P, BASE, OUT) do { unsigned a0 = cvtpk(P[BASE + 0], P[BASE + 1]), a1 = cvtpk(P[BASE + 2], P[BASE + 3]);   \
    unsigned b0 = cvtpk(P[BASE + 4], P[BASE + 5]), b1 = cvtpk(P[BASE + 6], P[BASE + 7]);                              \
    auto r0 = __builtin_amdgcn_permlane32_swap(a0, b0, false, false); auto r1 = __builtin_amdgcn_permlane32_swap(a1, b1, false, false); \
    u32x4 w = {r0[0], r1[0], r0[1], r1[1]}; OUT = *reinterpret_cast<bf16x8*>(&w); } while (0)
    PK4(p0, 0, pa0); PK4(p0, 8, pa1); PK4(p1, 0, pa2); PK4(p1, 8, pa3);
#undef PK4
}
template <int DQK> __device__ __forceinline__ void qkt(f32x16& p0, f32x16& p1, const char* Ks, const bf16x8* qr, int r32, int hi) {
    constexpr int KP = DQK * 2 + 16;
    p0 = f32x16{}; p1 = f32x16{};
#pragma unroll
    for (int d0 = 0; d0 < DQK / 16; ++d0) { const int cb = (d0 * 16 + hi * 8) * 2;
        const bf16x8 b0 = *reinterpret_cast<const bf16x8*>(Ks + r32 * KP + cb);
        const bf16x8 b1 = *reinterpret_cast<const bf16x8*>(Ks + (32 + r32) * KP + cb);
        p0 = __builtin_amdgcn_mfma_f32_32x32x16_bf16(b0, qr[d0], p0, 0, 0, 0);
        p1 = __builtin_amdgcn_mfma_f32_32x32x16_bf16(b1, qr[d0], p1, 0, 0, 0); }
}
template <int DQK> constexpr int att_lds_bytes() { return 2 * 64 * 128 * 2 + 2 * 64 * (DQK * 2 + 16) + NWAVES * 64 * 4; }
template <int DQK, int LDQ, int LDK, int LDV, int LDO>
__device__ __forceinline__ void attn_body(const bf16_t* __restrict__ Qb, const bf16_t* __restrict__ Kh, const bf16_t* __restrict__ Vh, bf16_t* __restrict__ Ob, int seq, float scale, char* lds) {
    constexpr int KP = DQK * 2 + 16, SHM_V = 64 * 128 * 2, SHM_K = 64 * KP, ND = DQK / 16, CH = DQK / 8, NKL = CH * 64 / NTHREADS;
    const float C = scale * 1.4426950408889634f, thr_raw = ATT_THR / scale;
    const int tid = threadIdx.x, wid = tid >> 6, lane = tid & 63, r32 = lane & 31, hi = lane >> 5;
    char* V_lds = lds; char* K_lds = lds + 2 * SHM_V;
    float* wsf = (float*)(lds + 2 * SHM_V + 2 * SHM_K) + wid * 64; float* li_l = wsf; float* al_l = wsf + 32;
    float m_reg = -1e30f, l_reg = 0; f32x16 o[4] = {}; bf16x8 qr[ND];
    const bf16_t* Qw = Qb + (long)(wid * 32 + r32) * LDQ + hi * 8;
#pragma unroll
    for (int d0 = 0; d0 < ND; ++d0) qr[d0] = *reinterpret_cast<const bf16x8*>(Qw + d0 * 16);
    const int sr = tid >> 4, sc = (tid & 15) * 8, vst0 = v_st(sr, sc), vst1 = v_st(32 + sr, sc);
    static_assert(DQK == 128, "double-pipelined body: 128-wide q.k only");
    const int vb0 = (int)(uintptr_t)V_lds + v_rd_base(lane);
    bf16x8 vs0, vs1, ks[NKL];
#define SLOAD(k0) do { vs0 = *reinterpret_cast<const bf16x8*>(&Vh[(long)((k0) + sr) * LDV + sc]); vs1 = *reinterpret_cast<const bf16x8*>(&Vh[(long)((k0) + 32 + sr) * LDV + sc]); \
    _Pragma("unroll") for (int i_ = 0; i_ < NKL; ++i_) ks[i_] = *reinterpret_cast<const bf16x8*>(&Kh[(long)((k0) + sr + 32 * i_) * LDK + sc]); } while (0)
#define SWRITE(b) do { *(bf16x8*)(V_lds + (b) * SHM_V + vst0) = vs0; *(bf16x8*)(V_lds + (b) * SHM_V + vst1) = vs1; \
    _Pragma("unroll") for (int i_ = 0; i_ < NKL; ++i_) *(bf16x8*)(K_lds + (b) * SHM_K + (sr + 32 * i_) * KP + sc * 2) = ks[i_]; } while (0)
#define RESC(a) do { if (__any((a) < 1.f)) { if (hi == 0) al_l[r32] = (a); asm volatile("s_waitcnt lgkmcnt(0)" ::: "memory"); \
    _Pragma("unroll") for (int d = 0; d < 4; ++d) _Pragma("unroll") for (int r = 0; r < 16; ++r) o[d][r] *= al_l[crow(r, hi)]; } } while (0)
    f32x16 pA0, pA1, pB0, pB1; float mnA, mnB, alA, alB; bf16x8 pa0, pa1, pa2, pa3; const int NT = seq / 64;
    SLOAD(0); asm volatile("s_waitcnt vmcnt(0)" ::: "memory"); SWRITE(0); __syncthreads();
    qkt<DQK>(pA0, pA1, K_lds, qr, r32, hi); partialSM(pA0, pA1, m_reg, mnA, alA, C, thr_raw);
    SLOAD(64);
    asm volatile("s_waitcnt vmcnt(0)" ::: "memory"); SWRITE(1); __syncthreads();
    for (int j = 1; j + 1 < NT; j += 2) {
        SBAR(); qkt<DQK>(pB0, pB1, K_lds + SHM_K, qr, r32, hi);
        finishSM(pA0, pA1, alA, l_reg, pa0, pa1, pa2, pa3); SBAR();
        SLOAD((j + 1) * 64); SBAR();
        pv_d0(o, vb0, pa0, pa1, pa2, pa3); partialSM(pB0, pB1, m_reg, mnB, alB, C, thr_raw);
        __syncthreads(); asm volatile("s_waitcnt vmcnt(0)" ::: "memory"); SWRITE(0);
        RESC(alB); __syncthreads();
        SBAR(); qkt<DQK>(pA0, pA1, K_lds, qr, r32, hi);
        finishSM(pB0, pB1, alB, l_reg, pa0, pa1, pa2, pa3); SBAR();
        SLOAD((j + 2) * 64); SBAR();
        pv_d0(o, vb0 + SHM_V, pa0, pa1, pa2, pa3); partialSM(pA0, pA1, m_reg, mnA, alA, C, thr_raw);
        __syncthreads(); asm volatile("s_waitcnt vmcnt(0)" ::: "memory"); SWRITE(1);
        RESC(alA); __syncthreads();
    }
    SBAR(); qkt<DQK>(pB0, pB1, K_lds + SHM_K, qr, r32, hi);
    finishSM(pA0, pA1, alA, l_reg, pa0, pa1, pa2, pa3); SBAR();
    pv_d0(o, vb0, pa0, pa1, pa2, pa3); partialSM(pB0, pB1, m_reg, mnB, alB, C, thr_raw);
    __syncthreads(); RESC(alB);
    finishSM(pB0, pB1, alB, l_reg, pa0, pa1, pa2, pa3); SBAR();
    pv_d0(o, vb0 + SHM_V, pa0, pa1, pa2, pa3);
    if (hi == 0) li_l[r32] = l_reg; asm volatile("s_waitcnt lgkmcnt(0)" ::: "memory");
    float rli[16];
#pragma unroll
    for (int r = 0; r < 16; ++r) rli[r] = __builtin_amdgcn_rcpf(li_l[crow(r, hi)]);
    bf16_t* Ow = Ob + (long)(wid * 32) * LDO;
#pragma unroll
    for (int r = 0; r < 16; ++r) { const int orow = crow(r, hi);
#pragma unroll
        for (int d0 = 0; d0 < 4; ++d0) Ow[(long)orow * LDO + d0 * 32 + r32] = (bf16_t)f2bf(o[d0][r] * rli[r]); }
    __syncthreads();
#undef SLOAD
#undef SWRITE
#undef RESC
}
template <int DQK, int LDQ, int LDK, int LDV, int LDO>
__device__ __forceinline__ void attn_body_single(const bf16_t* __restrict__ Qb, const bf16_t* __restrict__ Kh, const bf16_t* __restrict__ Vh, bf16_t* __restrict__ Ob, int seq, float scale, char* lds, int rope_t0) {
    constexpr int KP = DQK * 2 + 16, SHM_V = 64 * 128 * 2, SHM_K = 64 * KP, ND = DQK / 16, CH = DQK / 8, NKL = CH * 64 / NTHREADS;
    const float C = scale * 1.4426950408889634f, thr_raw = ATT_THR / scale;
    const int tid = threadIdx.x, wid = tid >> 6, lane = tid & 63, r32 = lane & 31, hi = lane >> 5;
    char* V_lds = lds; char* K_lds = lds + 2 * SHM_V;
    float* wsf = (float*)(lds + 2 * SHM_V + 2 * SHM_K) + wid * 64; float* li_l = wsf; float* al_l = wsf + 32;
    float m_reg = -1e30f, l_reg = 0; f32x16 o[4] = {}; bf16x8 qr[ND];
    const bf16_t* Qw = Qb + (long)(wid * 32 + r32) * LDQ + hi * 8;
#pragma unroll
    for (int d0 = 8; d0 < ND; ++d0) qr[d0] = *reinterpret_cast<const bf16x8*>(Qw + d0 * 16);
    if constexpr (DQK == 192) {
        if (rope_t0 >= 0) {
            const int tq = rope_t0 + wid * 32 + r32; const float prow = (float)(tq >> 6), pcol = (float)(tq & 63);
            u32x4 fa1 = __builtin_bit_cast(u32x4, qr[8]), fa2 = __builtin_bit_cast(u32x4, qr[9]), fb1 = __builtin_bit_cast(u32x4, qr[10]), fb2 = __builtin_bit_cast(u32x4, qr[11]);
#pragma unroll
            for (int jj = 0; jj < 4; ++jj) {
                float na1[2], na2[2], nb1[2], nb2[2];
#pragma unroll
                for (int e = 0; e < 2; ++e) { const float invf = __powf(10000.f, -(float)(hi * 8 + 2 * jj + e) * (1.f / 16.f));
                    const float ar = prow * invf, ac = pcol * invf, cr = __cosf(ar), sr_ = __sinf(ar), cc = __cosf(ac), sc_ = __sinf(ac);
                    const float a1 = e ? bfhi(fa1[jj]) : bflo(fa1[jj]), a2 = e ? bfhi(fa2[jj]) : bflo(fa2[jj]), b1 = e ? bfhi(fb1[jj]) : bflo(fb1[jj]), b2 = e ? bfhi(fb2[jj]) : bflo(fb2[jj]);
                    na1[e] = a1 * cr - a2 * sr_; na2[e] = a2 * cr + a1 * sr_; nb1[e] = b1 * cc - b2 * sc_; nb2[e] = b2 * cc + b1 * sc_; }
                fa1[jj] = pk2(na1[0], na1[1]); fa2[jj] = pk2(na2[0], na2[1]); fb1[jj] = pk2(nb1[0], nb1[1]); fb2[jj] = pk2(nb2[0], nb2[1]);
            }
            qr[8] = __builtin_bit_cast(bf16x8, fa1); qr[9] = __builtin_bit_cast(bf16x8, fa2); qr[10] = __builtin_bit_cast(bf16x8, fb1); qr[11] = __builtin_bit_cast(bf16x8, fb2);
        }
    }
    asm volatile("" ::: "memory");
#pragma unroll
    for (int d0 = 0; d0 < 8; ++d0) qr[d0] = *reinterpret_cast<const bf16x8*>(Qw + d0 * 16);
    const int sr = tid >> 4, sc = (tid & 15) * 8, vst0 = v_st(sr, sc), vst1 = v_st(32 + sr, sc);
    int krow[NKL], kch[NKL];
#pragma unroll
    for (int i = 0; i < NKL; ++i) { const int id = tid + i * NTHREADS; krow[i] = id / CH; kch[i] = id % CH; }
    const int vb0 = (int)(uintptr_t)V_lds + v_rd_base(lane);
    bf16x8 vs0, vs1, ks[NKL];
#define SLOAD(k0) do { vs0 = *reinterpret_cast<const bf16x8*>(&Vh[(long)((k0) + sr) * LDV + sc]); vs1 = *reinterpret_cast<const bf16x8*>(&Vh[(long)((k0) + 32 + sr) * LDV + sc]); \
    _Pragma("unroll") for (int i_ = 0; i_ < NKL; ++i_) ks[i_] = *reinterpret_cast<const bf16x8*>(&Kh[(long)((k0) + krow[i_]) * LDK + kch[i_] * 8]); } while (0)
#define SWRITE(b) do { *(bf16x8*)(V_lds + (b) * SHM_V + vst0) = vs0; *(bf16x8*)(V_lds + (b) * SHM_V + vst1) = vs1; \
    _Pragma("unroll") for (int i_ = 0; i_ < NKL; ++i_) *(bf16x8*)(K_lds + (b) * SHM_K + krow[i_] * KP + kch[i_] * 16) = ks[i_]; } while (0)
#define RESC(a) do { if (__any((a) < 1.f)) { if (hi == 0) al_l[r32] = (a); asm volatile("s_waitcnt lgkmcnt(0)" ::: "memory"); \
    _Pragma("unroll") for (int d = 0; d < 4; ++d) _Pragma("unroll") for (int r = 0; r < 16; ++r) o[d][r] *= al_l[crow(r, hi)]; } } while (0)
    f32x16 p0, p1; float mn, al; bf16x8 pa0, pa1, pa2, pa3; const int NT = seq / 64;
    SLOAD(0); asm volatile("s_waitcnt vmcnt(0)" ::: "memory"); SWRITE(0); __syncthreads();
    SLOAD(64);
    for (int j = 0; j < NT; ++j) {
        const int b = j & 1;
        SBAR(); qkt<DQK>(p0, p1, K_lds + b * SHM_K, qr, r32, hi);
        partialSM(p0, p1, m_reg, mn, al, C, thr_raw);
        RESC(al);
        finishSM(p0, p1, al, l_reg, pa0, pa1, pa2, pa3); SBAR();
        pv_d0(o, vb0 + b * SHM_V, pa0, pa1, pa2, pa3);
        if (j + 1 < NT) { asm volatile("s_waitcnt vmcnt(0)" ::: "memory"); SWRITE(b ^ 1); }
        __syncthreads();
        if (j + 2 < NT) SLOAD((j + 2) * 64);
    }
    if (hi == 0) li_l[r32] = l_reg; asm volatile("s_waitcnt lgkmcnt(0)" ::: "memory");
    float rli[16];
#pragma unroll
    for (int r = 0; r < 16; ++r) rli[r] = __builtin_amdgcn_rcpf(li_l[crow(r, hi)]);
    bf16_t* Ow = Ob + (long)(wid * 32) * LDO;
#pragma unroll
    for (int r = 0; r < 16; ++r) { const int orow = crow(r, hi);
#pragma unroll
        for (int d0 = 0; d0 < 4; ++d0) Ow[(long)orow * LDO + d0 * 32 + r32] = (bf16_t)f2bf(o[d0][r] * rli[r]); }
    __syncthreads();
#undef SLOAD
#undef SWRITE
#undef RESC
}
#define F8_ONE 0x7f7f7f7f
template <int DQK> __device__ __forceinline__ void qkt8(f32x16& p0, f32x16& p1, const char* Ks, const i32x8* qr, int r32, int hi) {
    constexpr int KP = DQK + 16;
    p0 = f32x16{}; p1 = f32x16{};
#pragma unroll
    for (int c = 0; c < DQK / 64; ++c) { const int cb = c * 64 + hi * 32;
        const u32x4 a0 = *reinterpret_cast<const u32x4*>(Ks + r32 * KP + cb), a1 = *reinterpret_cast<const u32x4*>(Ks + r32 * KP + cb + 16);
        const u32x4 b0 = *reinterpret_cast<const u32x4*>(Ks + (32 + r32) * KP + cb), b1 = *reinterpret_cast<const u32x4*>(Ks + (32 + r32) * KP + cb + 16);
        const i32x8 A = {(int)a0.x, (int)a0.y, (int)a0.z, (int)a0.w, (int)a1.x, (int)a1.y, (int)a1.z, (int)a1.w}, B = {(int)b0.x, (int)b0.y, (int)b0.z, (int)b0.w, (int)b1.x, (int)b1.y, (int)b1.z, (int)b1.w};
        p0 = __builtin_amdgcn_mfma_scale_f32_32x32x64_f8f6f4(A, qr[c], p0, 0, 0, 0, F8_ONE, 0, F8_ONE);
        p1 = __builtin_amdgcn_mfma_scale_f32_32x32x64_f8f6f4(B, qr[c], p1, 0, 0, 0, F8_ONE, 0, F8_ONE); }
}
__device__ __forceinline__ i32x8 q32_to_fp8(const bf16_t* p) {
    i32x8 r;
#pragma unroll
    for (int w = 0; w < 4; ++w) { const u32x4 v = *reinterpret_cast<const u32x4*>(p + 8 * w);
        r[2 * w] = (int)f8x4(bflo(v.x), bfhi(v.x), bflo(v.y), bfhi(v.y)); r[2 * w + 1] = (int)f8x4(bflo(v.z), bfhi(v.z), bflo(v.w), bfhi(v.w)); }
    return r;
}
__device__ __forceinline__ i32x8 q32_rope_fp8(const bf16_t* p, float pos) {
    float x[32];
#pragma unroll
    for (int w = 0; w < 4; ++w) { const u32x4 v = *reinterpret_cast<const u32x4*>(p + 8 * w);
#pragma unroll
        for (int e = 0; e < 4; ++e) { x[8 * w + 2 * e] = bflo(v[e]); x[8 * w + 2 * e + 1] = bfhi(v[e]); } }
    float y[32];
#pragma unroll
    for (int i = 0; i < 16; ++i) { const float ang = pos * __powf(10000.f, -(float)i * (1.f / 16.f)), cs = __cosf(ang), sn = __sinf(ang);
        y[i] = x[i] * cs - x[16 + i] * sn; y[16 + i] = x[16 + i] * cs + x[i] * sn; }
    i32x8 r;
#pragma unroll
    for (int w = 0; w < 8; ++w) r[w] = (int)f8x4(y[4 * w], y[4 * w + 1], y[4 * w + 2], y[4 * w + 3]);
    return r;
}
template <int DQK, int LDQ, int LDK, int LDV, int LDO>
__device__ __forceinline__ void attn8_body(const bf16_t* __restrict__ Qb, const unsigned char* __restrict__ Kh, const bf16_t* __restrict__ Vh, bf16_t* __restrict__ Ob, int seq, float scale, char* lds) {
    constexpr int KP = DQK + 16, SHM_V = 64 * 128 * 2, SHM_K = 64 * KP, NC = DQK / 64;
    static_assert(DQK == 128, "double-pipelined body: 128-wide q.k only");
    const float C = scale * 1.4426950408889634f, thr_raw = ATT_THR / scale;
    const int tid = threadIdx.x, wid = tid >> 6, lane = tid & 63, r32 = lane & 31, hi = lane >> 5;
    char* V_lds = lds; char* K_lds = lds + 2 * SHM_V;
    float* wsf = (float*)(lds + 2 * SHM_V + 2 * SHM_K) + wid * 64; float* li_l = wsf; float* al_l = wsf + 32;
    float m_reg = -1e30f, l_reg = 0; f32x16 o[4] = {}; i32x8 qr[NC];
    const bf16_t* Qw = Qb + (long)(wid * 32 + r32) * LDQ + hi * 32;
#pragma unroll
    for (int c = 0; c < NC; ++c) qr[c] = q32_to_fp8(Qw + 64 * c);
    const int sr = tid >> 4, sc = (tid & 15) * 8, vst0 = v_st(sr, sc), vst1 = v_st(32 + sr, sc);
    const int krow = tid >> 3, kch = (tid & 7) * 16;
    const int vb0 = (int)(uintptr_t)V_lds + v_rd_base(lane);
    bf16x8 vs0, vs1; u32x4 ks;
#define SLOAD(k0) do { vs0 = *reinterpret_cast<const bf16x8*>(&Vh[(long)((k0) + sr) * LDV + sc]); vs1 = *reinterpret_cast<const bf16x8*>(&Vh[(long)((k0) + 32 + sr) * LDV + sc]); \
    ks = *reinterpret_cast<const u32x4*>(&Kh[(long)((k0) + krow) * LDK + kch]); } while (0)
#define SWRITE(b) do { *(bf16x8*)(V_lds + (b) * SHM_V + vst0) = vs0; *(bf16x8*)(V_lds + (b) * SHM_V + vst1) = vs1; \
    *(u32x4*)(K_lds + (b) * SHM_K + krow * KP + kch) = ks; } while (0)
#define RESC(a) do { if (__any((a) < 1.f)) { if (hi == 0) al_l[r32] = (a); asm volatile("s_waitcnt lgkmcnt(0)" ::: "memory"); \
    _Pragma("unroll") for (int d = 0; d < 4; ++d) _Pragma("unroll") for (int r = 0; r < 16; ++r) o[d][r] *= al_l[crow(r, hi)]; } } while (0)
    f32x16 pA0, pA1, pB0, pB1; float mnA, mnB, alA, alB; bf16x8 pa0, pa1, pa2, pa3; const int NT = seq / 64;
    SLOAD(0); asm volatile("s_waitcnt vmcnt(0)" ::: "memory"); SWRITE(0); __syncthreads();
    qkt8<DQK>(pA0, pA1, K_lds, qr, r32, hi); partialSM(pA0, pA1, m_reg, mnA, alA, C, thr_raw);
    SLOAD(64);
    asm volatile("s_waitcnt vmcnt(0)" ::: "memory"); SWRITE(1); __syncthreads();
    for (int j = 1; j + 1 < NT; j += 2) {
        SBAR(); qkt8<DQK>(pB0, pB1, K_lds + SHM_K, qr, r32, hi);
        finishSM(pA0, pA1, alA, l_reg, pa0, pa1, pa2, pa3); SBAR();
        SLOAD((j + 1) * 64); SBAR();
        pv_d0(o, vb0, pa0, pa1, pa2, pa3); partialSM(pB0, pB1, m_reg, mnB, alB, C, thr_raw);
        __syncthreads(); asm volatile("s_waitcnt vmcnt(0)" ::: "memory"); SWRITE(0);
        RESC(alB); __syncthreads();
        SBAR(); qkt8<DQK>(pA0, pA1, K_lds, qr, r32, hi);
        finishSM(pB0, pB1, alB, l_reg, pa0, pa1, pa2, pa3); SBAR();
        SLOAD((j + 2) * 64); SBAR();
        pv_d0(o, vb0 + SHM_V, pa0, pa1, pa2, pa3); partialSM(pA0, pA1, m_reg, mnA, alA, C, thr_raw);
        __syncthreads(); asm volatile("s_waitcnt vmcnt(0)" ::: "memory"); SWRITE(1);
        RESC(alA); __syncthreads();
    }
    SBAR(); qkt8<DQK>(pB0, pB1, K_lds + SHM_K, qr, r32, hi);
    finishSM(pA0, pA1, alA, l_reg, pa0, pa1, pa2, pa3); SBAR();
    pv_d0(o, vb0, pa0, pa1, pa2, pa3); partialSM(pB0, pB1, m_reg, mnB, alB, C, thr_raw);
    __syncthreads(); RESC(alB);
    finishSM(pB0, pB1, alB, l_reg, pa0, pa1, pa2, pa3); SBAR();
    pv_d0(o, vb0 + SHM_V, pa0, pa1, pa2, pa3);
    if (hi == 0) li_l[r32] = l_reg; asm volatile("s_waitcnt lgkmcnt(0)" ::: "memory");
    float rli[16];
#pragma unroll
    for (int r = 0; r < 16; ++r) rli[r] = __builtin_amdgcn_rcpf(li_l[crow(r, hi)]);
    bf16_t* Ow = Ob + (long)(wid * 32) * LDO;
#pragma unroll
    for (int r = 0; r < 16; ++r) { const int orow = crow(r, hi);
#pragma unroll
        for (int d0 = 0; d0 < 4; ++d0) Ow[(long)orow * LDO + d0 * 32 + r32] = (bf16_t)f2bf(o[d0][r] * rli[r]); }
    __syncthreads();
#undef SLOAD
#undef SWRITE
#undef RESC
}
template <int DQK, int LDQ, int LDK, int LDV, int LDO>
__device__ __forceinline__ void attn8_body_single(const bf16_t* __restrict__ Qb, const unsigned char* __restrict__ Kh, const bf16_t* __restrict__ Vh, bf16_t* __restrict__ Ob, int seq, float scale, char* lds, int rope_t0) {
    constexpr int KP = DQK + 16, SHM_V = 64 * 128 * 2, SHM_K = 64 * KP, NC = DQK / 64, CH = DQK / 16, NCH = 64 * CH, NKL = (NCH + NTHREADS - 1) / NTHREADS;
    const float C = scale * 1.4426950408889634f, thr_raw = ATT_THR / scale;
    const int tid = threadIdx.x, wid = tid >> 6, lane = tid & 63, r32 = lane & 31, hi = lane >> 5;
    char* V_lds = lds; char* K_lds = lds + 2 * SHM_V;
    float* wsf = (float*)(lds + 2 * SHM_V + 2 * SHM_K) + wid * 64; float* li_l = wsf; float* al_l = wsf + 32;
    float m_reg = -1e30f, l_reg = 0; f32x16 o[4] = {}; i32x8 qr[NC];
    const bf16_t* Qw = Qb + (long)(wid * 32 + r32) * LDQ + hi * 32;
    if constexpr (DQK == 192) {
        if (rope_t0 >= 0) { const int tq = rope_t0 + wid * 32 + r32; qr[2] = q32_rope_fp8(Qw + 128, (float)(hi ? (tq & 63) : (tq >> 6))); }
        else qr[2] = q32_to_fp8(Qw + 128);
    }
    asm volatile("" ::: "memory");
#pragma unroll
    for (int c = 0; c < 2; ++c) qr[c] = q32_to_fp8(Qw + 64 * c);
    const int sr = tid >> 4, sc = (tid & 15) * 8, vst0 = v_st(sr, sc), vst1 = v_st(32 + sr, sc);
    int krow[NKL], kch[NKL];
#pragma unroll
    for (int i = 0; i < NKL; ++i) { const int id = tid + i * NTHREADS; krow[i] = (id < NCH) ? id / CH : 0; kch[i] = (id % CH) * 16; }
    const bool k2 = (NKL < 2) || (tid + NTHREADS < NCH);
    const int vb0 = (int)(uintptr_t)V_lds + v_rd_base(lane);
    bf16x8 vs0, vs1; u32x4 ks[NKL];
#define SLOAD(k0) do { vs0 = *reinterpret_cast<const bf16x8*>(&Vh[(long)((k0) + sr) * LDV + sc]); vs1 = *reinterpret_cast<const bf16x8*>(&Vh[(long)((k0) + 32 + sr) * LDV + sc]); \
    _Pragma("unroll") for (int i_ = 0; i_ < NKL; ++i_) ks[i_] = *reinterpret_cast<const u32x4*>(&Kh[(long)((k0) + krow[i_]) * LDK + kch[i_]]); } while (0)
#define SWRITE(b) do { *(bf16x8*)(V_lds + (b) * SHM_V + vst0) = vs0; *(bf16x8*)(V_lds + (b) * SHM_V + vst1) = vs1; \
    _Pragma("unroll") for (int i_ = 0; i_ < NKL; ++i_) if (i_ == 0 || k2) *(u32x4*)(K_lds + (b) * SHM_K + krow[i_] * KP + kch[i_]) = ks[i_]; } while (0)
#define RESC(a) do { if (__any((a) < 1.f)) { if (hi == 0) al_l[r32] = (a); asm volatile("s_waitcnt lgkmcnt(0)" ::: "memory"); \
    _Pragma("unroll") for (int d = 0; d < 4; ++d) _Pragma("unroll") for (int r = 0; r < 16; ++r) o[d][r] *= al_l[crow(r, hi)]; } } while (0)
    f32x16 p0, p1; float mn, al; bf16x8 pa0, pa1, pa2, pa3; const int NT = seq / 64;
    SLOAD(0); asm volatile("s_waitcnt vmcnt(0)" ::: "memory"); SWRITE(0); __syncthreads();
    SLOAD(64);
    for (int j = 0; j < NT; ++j) {
        const int b = j & 1;
        SBAR(); qkt8<DQK>(p0, p1, K_lds + b * SHM_K, qr, r32, hi);
        partialSM(p0, p1, m_reg, mn, al, C, thr_raw);
        RESC(al);
        finishSM(p0, p1, al, l_reg, pa0, pa1, pa2, pa3); SBAR();
        pv_d0(o, vb0 + b * SHM_V, pa0, pa1, pa2, pa3);
        if (j + 1 < NT) { asm volatile("s_waitcnt vmcnt(0)" ::: "memory"); SWRITE(b ^ 1); }
        __syncthreads();
        if (j + 2 < NT) SLOAD((j + 2) * 64);
    }
    if (hi == 0) li_l[r32] = l_reg; asm volatile("s_waitcnt lgkmcnt(0)" ::: "memory");
    float rli[16];
#pragma unroll
    for (int r = 0; r < 16; ++r) rli[r] = __builtin_amdgcn_rcpf(li_l[crow(r, hi)]);
    bf16_t* Ow = Ob + (long)(wid * 32) * LDO;
#pragma unroll
    for (int r = 0; r < 16; ++r) { const int orow = crow(r, hi);
#pragma unroll
        for (int d0 = 0; d0 < 4; ++d0) Ow[(long)orow * LDO + d0 * 32 + r32] = (bf16_t)f2bf(o[d0][r] * rli[r]); }
    __syncthreads();
#undef SLOAD
#undef SWRITE
#undef RESC
}
constexpr float ATT8_THR = 3.5f, ATT8_SH = 3.f;
#ifndef ATT8_FIXED_M
#define ATT8_FIXED_M 0
#endif
__device__ __forceinline__ void partialSM8(f32x16& p0, f32x16& p1, float& m_reg, float& mn, float& alpha, float C, float thr_raw) {
#if ATT8_FIXED_M
    mn = 6.f * 1.4426950408889634f / C; alpha = 1.f; m_reg = mn;
#else
    float pmax = p0[0];
#pragma unroll
    for (int r = 1; r < 16; ++r) pmax = fmaxf(pmax, p0[r]);
#pragma unroll
    for (int r = 0; r < 16; ++r) pmax = fmaxf(pmax, p1[r]);
    { auto rr = __builtin_amdgcn_permlane32_swap(__float_as_uint(pmax), __float_as_uint(pmax), false, false);
      pmax = fmaxf(__uint_as_float(rr[0]), __uint_as_float(rr[1])); }
    if (__builtin_expect(__all(pmax - m_reg <= thr_raw), 1)) { mn = m_reg; alpha = 1.f; }
    else { mn = fmaxf(m_reg, pmax); alpha = __builtin_amdgcn_exp2f((m_reg - mn) * C); m_reg = mn; }
#endif
    const float mnC = ATT8_SH - mn * C;
#pragma unroll
    for (int r = 0; r < 16; ++r) p0[r] = fmaf(p0[r], C, mnC);
#pragma unroll
    for (int r = 0; r < 16; ++r) p1[r] = fmaf(p1[r], C, mnC);
#pragma unroll
    for (int r = 0; r < 16; ++r) p0[r] = __builtin_amdgcn_exp2f(p0[r]);
}
__device__ __forceinline__ void finishSM8(f32x16& p0, f32x16& p1, i32x8& pa) {
#pragma unroll
    for (int r = 0; r < 16; ++r) p1[r] = __builtin_amdgcn_exp2f(p1[r]);
#pragma unroll
    for (int w = 0; w < 4; ++w) { pa[w] = (int)f8x4(p0[4 * w], p0[4 * w + 1], p0[4 * w + 2], p0[4 * w + 3]); pa[4 + w] = (int)f8x4(p1[4 * w], p1[4 * w + 1], p1[4 * w + 2], p1[4 * w + 3]); }
}
__device__ __forceinline__ void finishSM8s(f32x16& p0, f32x16& p1, float alpha, float& l_reg, i32x8& pa) {
#pragma unroll
    for (int r = 0; r < 16; ++r) p1[r] = __builtin_amdgcn_exp2f(p1[r]);
    float ps = 0;
#pragma unroll
    for (int r = 0; r < 16; ++r) ps += p0[r];
#pragma unroll
    for (int r = 0; r < 16; ++r) ps += p1[r];
    { auto rr = __builtin_amdgcn_permlane32_swap(__float_as_uint(ps), __float_as_uint(ps), false, false);
      ps = __uint_as_float(rr[0]) + __uint_as_float(rr[1]); }
    l_reg = l_reg * alpha + ps;
#pragma unroll
    for (int w = 0; w < 4; ++w) { pa[w] = (int)f8x4(p0[4 * w], p0[4 * w + 1], p0[4 * w + 2], p0[4 * w + 3]); pa[4 + w] = (int)f8x4(p1[4 * w], p1[4 * w + 1], p1[4 * w + 2], p1[4 * w + 3]); }
}
typedef int i32x2 __attribute__((ext_vector_type(2)));
template <int OFF> __device__ __forceinline__ u32x2 tr8_read(int vb) { typedef i32x2 LAS* lp; const i32x2 r = __builtin_amdgcn_ds_read_tr8_b64_v2i32((lp)(uintptr_t)(unsigned)(vb + OFF)); return (u32x2){(unsigned)r.x, (unsigned)r.y}; }
#define F8_MFMA(A_, B_, C_) __builtin_amdgcn_mfma_scale_f32_32x32x64_f8f6f4(A_, B_, C_, 0, 0, 0, F8_ONE, 0, F8_ONE)
#define TR8X4(T, VB) const u32x2 T[4] = {tr8_read<0>(VB), tr8_read<2048>(VB), tr8_read<4096>(VB), tr8_read<6144>(VB)}
#define TR8B(T) (i32x8){(int)T[0].x, (int)T[0].y, (int)T[1].x, (int)T[1].y, (int)T[2].x, (int)T[2].y, (int)T[3].x, (int)T[3].y}
__device__ __forceinline__ void pv8_pairs(f32x16* o, const int* vb, int boff, const i32x8& pa) {
    { TR8X4(a, vb[0] + boff); TR8X4(b, vb[1] + boff);
      o[0] = F8_MFMA(pa, TR8B(a), o[0]);
      o[1] = F8_MFMA(pa, TR8B(b), o[1]); }
    { TR8X4(c, vb[2] + boff); TR8X4(d, vb[3] + boff);
      o[2] = F8_MFMA(pa, TR8B(c), o[2]);
      o[3] = F8_MFMA(pa, TR8B(d), o[3]); }
}
__device__ __forceinline__ void pv8_seq(f32x16* o, const int* vb, int boff, const i32x8& pa) {
    const i32x8 ones = {0x38383838, 0x38383838, 0x38383838, 0x38383838, 0x38383838, 0x38383838, 0x38383838, 0x38383838};
    { TR8X4(a, vb[0] + boff); o[4] = F8_MFMA(pa, ones, o[4]); o[0] = F8_MFMA(pa, TR8B(a), o[0]); }
    { TR8X4(b, vb[1] + boff); o[1] = F8_MFMA(pa, TR8B(b), o[1]); }
    { TR8X4(c, vb[2] + boff); o[2] = F8_MFMA(pa, TR8B(c), o[2]); }
    { TR8X4(d, vb[3] + boff); o[3] = F8_MFMA(pa, TR8B(d), o[3]); }
}
template <bool ALL16> __device__ __forceinline__ void pv8_all(f32x16* o, const int* vb, int boff, const i32x8& pa) {
    const i32x8 ones = {0x38383838, 0x38383838, 0x38383838, 0x38383838, 0x38383838, 0x38383838, 0x38383838, 0x38383838};
    if constexpr (ALL16) {
        TR8X4(a, vb[0] + boff); TR8X4(b, vb[1] + boff); TR8X4(c, vb[2] + boff); TR8X4(d, vb[3] + boff);
        o[4] = F8_MFMA(pa, ones, o[4]);
        o[0] = F8_MFMA(pa, TR8B(a), o[0]);
        o[1] = F8_MFMA(pa, TR8B(b), o[1]);
        o[2] = F8_MFMA(pa, TR8B(c), o[2]);
        o[3] = F8_MFMA(pa, TR8B(d), o[3]);
    } else {
        { TR8X4(a, vb[0] + boff); TR8X4(b, vb[1] + boff);
          o[4] = F8_MFMA(pa, ones, o[4]);
          o[0] = F8_MFMA(pa, TR8B(a), o[0]);
          o[1] = F8_MFMA(pa, TR8B(b), o[1]); }
        { TR8X4(c, vb[2] + boff); TR8X4(d, vb[3] + boff);
          o[2] = F8_MFMA(pa, TR8B(c), o[2]);
          o[3] = F8_MFMA(pa, TR8B(d), o[3]); }
    }
}
__device__ __forceinline__ int v8_f(int key) { return ((key >> 1) & 1) + 2 * ((key >> 3) & 1); }
__device__ __forceinline__ int v8_st(int key, int ch16) { return key * 128 + 32 * ((ch16 >> 1) ^ v8_f(key)) + 16 * (ch16 & 1); }
__device__ __forceinline__ int v8_rd_base(int lane, int db) {
    const int q = (lane & 15) >> 1, pp = lane & 1, g1 = (lane >> 4) & 1, hi = lane >> 5, fq = ((q >> 1) & 1) + 2 * (q >> 2);
    return (8 * (q >> 2) + 4 * hi + (q & 3)) * 128 + 32 * (db ^ fq) + 16 * g1 + 8 * pp;
}
template <int DQK, int LDQ, int LDK, int LDV, int LDO>
__device__ __forceinline__ void attn88_body(const bf16_t* __restrict__ Qb, const unsigned char* __restrict__ Kh, const unsigned char* __restrict__ Vh, bf16_t* __restrict__ Ob, int seq, float scale, char* lds) {
    constexpr int KP = DQK + 16, SHM_V = 64 * 128, SHM_K = 64 * KP, NC = DQK / 64;
    static_assert(DQK == 128, "double-pipelined body: 128-wide q.k only");
    const float C = scale * 1.4426950408889634f, thr_raw = ATT8_THR / scale;
    const int tid = threadIdx.x, wid = tid >> 6, lane = tid & 63, r32 = lane & 31, hi = lane >> 5;
    char* V_lds = lds; char* K_lds = lds + 2 * SHM_V;
    float* al_l = (float*)(lds + 2 * SHM_V + 2 * SHM_K) + wid * 32;
    float m_reg = -1e30f; f32x16 o[5] = {}; i32x8 qr[NC];
    const bf16_t* Qw = Qb + (long)(wid * 32 + r32) * LDQ + hi * 32;
#pragma unroll
    for (int c = 0; c < NC; ++c) qr[c] = q32_to_fp8(Qw + 64 * c);
    const int krow = tid >> 3, kch = (tid & 7) * 16, vst = v8_st(krow, tid & 7);
    int vb[4];
#pragma unroll
    for (int d = 0; d < 4; ++d) vb[d] = (int)(uintptr_t)V_lds + v8_rd_base(lane, d);
    u32x4 vs, ks;
#define SLOAD(k0) do { vs = *reinterpret_cast<const u32x4*>(&Vh[(long)((k0) + krow) * LDV + kch]); ks = *reinterpret_cast<const u32x4*>(&Kh[(long)((k0) + krow) * LDK + kch]); } while (0)
#define SWRITE(b) do { *(u32x4*)(V_lds + (b) * SHM_V + vst) = vs; *(u32x4*)(K_lds + (b) * SHM_K + krow * KP + kch) = ks; } while (0)
#define RESC(a) do { if (__any((a) < 1.f)) { if (hi == 0) al_l[r32] = (a); asm volatile("s_waitcnt lgkmcnt(0)" ::: "memory"); \
    _Pragma("unroll") for (int d = 0; d < 5; ++d) _Pragma("unroll") for (int r = 0; r < 16; ++r) o[d][r] *= al_l[crow(r, hi)]; } } while (0)
#define PV8(b) pv8_all<DQK == 128>(o, vb, (b) * SHM_V, pa)
    f32x16 pA0, pA1, pB0, pB1; float mnA, mnB, alA, alB; i32x8 pa; const int NT = seq / 64;
    SLOAD(0); asm volatile("s_waitcnt vmcnt(0)" ::: "memory"); SWRITE(0); __syncthreads();
    qkt8<DQK>(pA0, pA1, K_lds, qr, r32, hi); partialSM8(pA0, pA1, m_reg, mnA, alA, C, thr_raw);
    SLOAD(64);
    asm volatile("s_waitcnt vmcnt(0)" ::: "memory"); SWRITE(1); __syncthreads();
    for (int j = 1; j + 1 < NT; j += 2) {
        SBAR(); qkt8<DQK>(pB0, pB1, K_lds + SHM_K, qr, r32, hi);
        finishSM8(pA0, pA1, pa); SBAR();
        SLOAD((j + 1) * 64); SBAR();
        PV8(0); partialSM8(pB0, pB1, m_reg, mnB, alB, C, thr_raw);
        __syncthreads(); asm volatile("s_waitcnt vmcnt(0)" ::: "memory"); SWRITE(0);
        RESC(alB); __syncthreads();
        SBAR(); qkt8<DQK>(pA0, pA1, K_lds, qr, r32, hi);
        finishSM8(pB0, pB1, pa); SBAR();
        SLOAD((j + 2) * 64); SBAR();
        PV8(1); partialSM8(pA0, pA1, m_reg, mnA, alA, C, thr_raw);
        __syncthreads(); asm volatile("s_waitcnt vmcnt(0)" ::: "memory"); SWRITE(1);
        RESC(alA); __syncthreads();
    }
    SBAR(); qkt8<DQK>(pB0, pB1, K_lds + SHM_K, qr, r32, hi);
    finishSM8(pA0, pA1, pa); SBAR();
    PV8(0); partialSM8(pB0, pB1, m_reg, mnB, alB, C, thr_raw);
    __syncthreads(); RESC(alB);
    finishSM8(pB0, pB1, pa); SBAR();
    PV8(1);
    float rli[16];
#pragma unroll
    for (int r = 0; r < 16; ++r) rli[r] = __builtin_amdgcn_rcpf(o[4][r]);
    bf16_t* Ow = Ob + (long)(wid * 32) * LDO;
#pragma unroll
    for (int r = 0; r < 16; ++r) { const int orow = crow(r, hi);
#pragma unroll
        for (int d0 = 0; d0 < 4; ++d0) Ow[(long)orow * LDO + d0 * 32 + r32] = (bf16_t)f2bf(o[d0][r] * rli[r]); }
    __syncthreads();
#undef SLOAD
#undef SWRITE
}
template <int DQK, int LDQ, int LDK, int LDV, int LDO>
__device__ __forceinline__ void attn88_body_single(const bf16_t* __restrict__ Qb, const unsigned char* __restrict__ Kh, const unsigned char* __restrict__ Vh, bf16_t* __restrict__ Ob, int seq, float scale, char* lds, int rope_t0) {
    constexpr int KP = DQK + 16, SHM_V = 64 * 128, SHM_K = 64 * KP, NC = DQK / 64, CH = DQK / 16, NCH = 64 * CH, NKL = (NCH + NTHREADS - 1) / NTHREADS;
    const float C = scale * 1.4426950408889634f, thr_raw = ATT8_THR / scale;
    const int tid = threadIdx.x, wid = tid >> 6, lane = tid & 63, r32 = lane & 31, hi = lane >> 5;
    char* V_lds = lds; char* K_lds = lds + 2 * SHM_V;
    float* al_l = (float*)(lds + 2 * SHM_V + 2 * SHM_K) + wid * 32;
    float m_reg = -1e30f; i32x8 qr[NC];
    const bf16_t* Qw = Qb + (long)(wid * 32 + r32) * LDQ + hi * 32;
    if constexpr (DQK == 192) {
        if (rope_t0 >= 0) { const int tq = rope_t0 + wid * 32 + r32; qr[2] = q32_rope_fp8(Qw + 128, (float)(hi ? (tq & 63) : (tq >> 6))); }
        else qr[2] = q32_to_fp8(Qw + 128);
    }
    asm volatile("" ::: "memory");
#pragma unroll
    for (int c = 0; c < 2; ++c) qr[c] = q32_to_fp8(Qw + 64 * c);
    const int vrow = tid >> 3, vch = (tid & 7) * 16, vst = v8_st(vrow, tid & 7);
    unsigned koff[NKL]; int klds[NKL]; const unsigned voff = (unsigned)(vrow * LDV + vch);
#pragma unroll
    for (int i = 0; i < NKL; ++i) { const int id = tid + i * NTHREADS, kr = (id < NCH) ? id / CH : 0, kc = (id % CH) * 16; koff[i] = (unsigned)(kr * LDK + kc); klds[i] = kr * KP + kc; }
    const bool k2 = (NKL < 2) || (tid + NTHREADS < NCH);
    int vb[4];
#pragma unroll
    for (int d = 0; d < 4; ++d) vb[d] = (int)(uintptr_t)V_lds + v8_rd_base(lane, d);
    u32x4 vs, ks[NKL];
#define SLOAD(k0) do { const unsigned char* vt_ = Vh + (size_t)(k0) * LDV; const unsigned char* kt_ = Kh + (size_t)(k0) * LDK; vs = *reinterpret_cast<const u32x4*>(vt_ + voff); \
    _Pragma("unroll") for (int i_ = 0; i_ < NKL; ++i_) ks[i_] = *reinterpret_cast<const u32x4*>(kt_ + koff[i_]); } while (0)
#define SWRITE(b) do { *(u32x4*)(V_lds + (b) * SHM_V + vst) = vs; \
    _Pragma("unroll") for (int i_ = 0; i_ < NKL; ++i_) if (i_ == 0 || k2) *(u32x4*)(K_lds + (b) * SHM_K + klds[i_]) = ks[i_]; } while (0)
    asm volatile("" ::: "memory");
    f32x16 o[5] = {}; f32x16 p0, p1; float mn, al; i32x8 pa; const int NT = seq / 64;
    SLOAD(0); asm volatile("s_waitcnt vmcnt(0)" ::: "memory"); SWRITE(0); __syncthreads();
    SLOAD(64);
    for (int j = 0; j < NT; ++j) {
        const int b = j & 1;
        SBAR(); qkt8<DQK>(p0, p1, K_lds + b * SHM_K, qr, r32, hi);
        partialSM8(p0, p1, m_reg, mn, al, C, thr_raw);
        RESC(al);
        finishSM8(p0, p1, pa); SBAR();
        PV8(b);
        if (j + 1 < NT) { asm volatile("s_waitcnt vmcnt(0)" ::: "memory"); SWRITE(b ^ 1); }
        __syncthreads();
        if (j + 2 < NT) SLOAD((j + 2) * 64);
    }
    float rli[16];
#pragma unroll
    for (int r = 0; r < 16; ++r) rli[r] = __builtin_amdgcn_rcpf(o[4][r]);
    bf16_t* Ow = Ob + (long)(wid * 32) * LDO;
#pragma unroll
    for (int r = 0; r < 16; ++r) { const int orow = crow(r, hi);
#pragma unroll
        for (int d0 = 0; d0 < 4; ++d0) Ow[(long)orow * LDO + d0 * 32 + r32] = (bf16_t)f2bf(o[d0][r] * rli[r]); }
    __syncthreads();
#undef SLOAD
#undef SWRITE
#undef RESC
#undef PV8
}
template <int DQK, int LDQ, int LDK, int LDV, int LDO, int VAR = 0>
__device__ __forceinline__ void attn88_pp(const bf16_t* __restrict__ Qb, const unsigned char* __restrict__ Kh, const unsigned char* __restrict__ Vh, unsigned char* __restrict__ Ob, int seq, float scale, char* lds, int rope_t0) {
#define PPBAR() do { SBAR(); __syncthreads(); SBAR(); } while (0)
    constexpr int KP = DQK + 16, SHM_V = 64 * 128, SHM_K = 64 * KP, SHM_P = SHM_V + SHM_K, NC = DQK / 64, CH = DQK / 16, NCH = 64 * CH, NKL = (NCH + NTHREADS - 1) / NTHREADS;
    const float C = scale * 1.4426950408889634f, thr_raw = ATT8_THR / scale;
    const int tid = threadIdx.x, wid = __builtin_amdgcn_readfirstlane(tid >> 6), lane = tid & 63, r32 = lane & 31, hi = lane >> 5, grp = wid >> 2;
    char* P_lds = lds;
    float* al_l = (float*)(lds + 2 * SHM_P) + wid * 32;
    constexpr bool MSUM = (DQK == 128);
    float m_reg = -1e30f, l_reg = 0.f; i32x8 qr[NC];
    const bf16_t* Qw = Qb + (long)(wid * 32 + r32) * LDQ + hi * 32;
    if constexpr (DQK == 192) {
        if (rope_t0 >= 0) { const int tq = rope_t0 + wid * 32 + r32; qr[2] = q32_rope_fp8(Qw + 128, (float)(hi ? (tq & 63) : (tq >> 6))); }
        else qr[2] = q32_to_fp8(Qw + 128);
    }
    asm volatile("" ::: "memory");
#pragma unroll
    for (int c = 0; c < 2; ++c) qr[c] = q32_to_fp8(Qw + 64 * c);
    const int vrow = tid >> 3, vch = (tid & 7) * 16, vst = v8_st(vrow, tid & 7);
    unsigned koff[NKL]; int klds[NKL]; const unsigned voff = (unsigned)(vrow * LDV + vch);
#pragma unroll
    for (int i = 0; i < NKL; ++i) { const int id = tid + i * NTHREADS, kr = (id < NCH) ? id / CH : 0, kc = (id % CH) * 16; koff[i] = (unsigned)(kr * LDK + kc); klds[i] = kr * KP + kc; }
    const bool k2 = (NKL < 2) || (tid + NTHREADS < NCH);
    int vb[4];
#pragma unroll
    for (int d = 0; d < 4; ++d) vb[d] = (int)(uintptr_t)P_lds + v8_rd_base(lane, d);
    u32x4 vs, ks[NKL]; const int NT = seq / 64;
#define PLOAD(jp) do { const int jv_ = (jp) < NT ? (jp) : NT - 1, jk_ = (jp) + 1 < NT ? (jp) + 1 : NT - 1; const unsigned char* vt_ = Vh + (size_t)jv_ * 64 * LDV; const unsigned char* kt_ = Kh + (size_t)jk_ * 64 * LDK; \
    vs = *reinterpret_cast<const u32x4*>(vt_ + voff); _Pragma("unroll") for (int i_ = 0; i_ < NKL; ++i_) ks[i_] = *reinterpret_cast<const u32x4*>(kt_ + koff[i_]); } while (0)
#define PWRITE(b) do { *(u32x4*)(P_lds + (b) * SHM_P + vst) = vs; \
    _Pragma("unroll") for (int i_ = 0; i_ < NKL; ++i_) if (i_ == 0 || k2) *(u32x4*)(P_lds + (b) * SHM_P + SHM_V + klds[i_]) = ks[i_]; } while (0)
#define RESC(a) do { if (__any((a) < 1.f)) { if (hi == 0) al_l[r32] = (a); asm volatile("s_waitcnt lgkmcnt(0)" ::: "memory"); \
    _Pragma("unroll") for (int d = 0; d < (MSUM ? 5 : 4); ++d) _Pragma("unroll") for (int r = 0; r < 16; ++r) o[d][r] *= al_l[crow(r, hi)]; } } while (0)
    asm volatile("" ::: "memory");
    f32x16 o[5] = {}; f32x16 p0 = {}, p1 = {}; float mn, al; i32x8 pa = {};
    { const unsigned char* kt_ = Kh;
#pragma unroll
      for (int i_ = 0; i_ < NKL; ++i_) ks[i_] = *reinterpret_cast<const u32x4*>(kt_ + koff[i_]);
      asm volatile("s_waitcnt vmcnt(0)" ::: "memory");
#pragma unroll
      for (int i_ = 0; i_ < NKL; ++i_) if (i_ == 0 || k2) *(u32x4*)(P_lds + SHM_P + SHM_V + klds[i_]) = ks[i_]; }
    PLOAD(0); asm volatile("s_waitcnt vmcnt(0)" ::: "memory"); PWRITE(0);
    PLOAD(1);
    PPBAR();
#define STAGE(j_) do { if (!(VAR & 4) && (j_) + 1 < NT) { asm volatile("s_waitcnt vmcnt(0)" ::: "memory"); PWRITE(((j_) + 1) & 1); if ((j_) + 2 < NT) PLOAD((j_) + 2); } } while (0)
#define HALF_A() do { if (VAR & 1) { _Pragma("unroll") for (int w_ = 0; w_ < 8; ++w_) pa[w_] = (int)__float_as_uint(w_ < 4 ? p0[4 * w_] : p1[4 * w_ - 16]); break; } partialSM8(p0, p1, m_reg, mn, al, C, thr_raw); RESC(al); if constexpr (MSUM) finishSM8(p0, p1, pa); else finishSM8s(p0, p1, al, l_reg, pa); asm volatile("" : "+v"(pa)); } while (0)
#define HALF_B(j_) do { if (VAR & 2) { _Pragma("unroll") for (int r_ = 0; r_ < 16; ++r_) { p0[r_] = __uint_as_float((unsigned)pa[r_ & 7]) * 1e-30f + (float)r_; p1[r_] = p0[r_] + 1.f; } o[0][(j_) & 15] += p0[3]; break; } const int boff_ = ((j_) & 1) * SHM_P; if constexpr (MSUM) pv8_all<true>(o, vb, boff_, pa); else pv8_pairs(o, vb, boff_, pa); if ((j_) + 1 < NT) { SBAR(); qkt8<DQK>(p0, p1, P_lds + boff_ + SHM_V, qr, r32, hi); asm volatile("" : "+v"(p0), "+v"(p1)); } } while (0)
    if (grp == 0) {
        qkt8<DQK>(p0, p1, P_lds + SHM_P + SHM_V, qr, r32, hi); PPBAR();
#pragma unroll 1
        for (int j = 0; j < NT; ++j) {
            HALF_A(); PPBAR();
            STAGE(j); HALF_B(j); PPBAR();
        }
        PPBAR();
    } else {
        PPBAR();
        qkt8<DQK>(p0, p1, P_lds + SHM_P + SHM_V, qr, r32, hi); PPBAR();
#pragma unroll 1
        for (int j = 0; j < NT; ++j) {
            STAGE(j); HALF_A(); PPBAR();
            HALF_B(j); PPBAR();
        }
    }
#undef STAGE
#undef HALF_A
#undef HALF_B
    float rli[16];
    if constexpr (MSUM) {
#pragma unroll
        for (int r = 0; r < 16; ++r) rli[r] = __builtin_amdgcn_rcpf(o[4][r]);
    } else {
        if (hi == 0) al_l[r32] = l_reg; asm volatile("s_waitcnt lgkmcnt(0)" ::: "memory");
#pragma unroll
        for (int r = 0; r < 16; ++r) rli[r] = __builtin_amdgcn_rcpf(al_l[crow(r, hi)]);
    }
    { int t2 = threadIdx.x; asm volatile("" : "+v"(t2));
      const int w2 = t2 >> 6, r2 = t2 & 31, h2 = (t2 >> 5) & 1;
      unsigned char* Ow = Ob + (long)(w2 * 32) * LDO;
#pragma unroll
      for (int r = 0; r < 16; ++r) { const int orow = crow(r, h2);
#pragma unroll
          for (int d0 = 0; d0 < 4; ++d0) { const float ov = o[d0][r] * rli[r] * (float)(1 << O8_SH); Ow[(long)orow * LDO + d0 * 32 + r2] = (unsigned char)(f8x4(ov, ov, ov, ov) & 0xffu); } } }
    PPBAR();
#undef PLOAD
#undef PWRITE
#undef RESC
#undef PPBAR
}
#ifndef ATTN_PP
#define ATTN_PP 1
#endif
#define ATTN_MLA attn88_pp
#define ATTN_GQA attn88_pp
__device__ __forceinline__ void p_attn_mla(const Args& A, const Frame& F) {
    const bf16_t* Q = (const bf16_t*)(F.ws + WS_Q); const unsigned char* Kb = F.ws + WS_K; const unsigned char* Vb = F.ws + WS_V; unsigned char* O = F.ws + WS_O;
    const float scale = 0.07216878364870322f;
    for (int u = F.vcu; u < 544; u += F.nblk) {
        int b, h, q0, seq;
        int rope_t0;
        if (u < 512) { const int qb = u & 15; h = (u >> 4) & 7; b = u >> 7; q0 = CTXL + qb * 256; seq = RPB; rope_t0 = qb * 256; }
        else { const int v = u - 512; h = v & 7; b = v >> 3; q0 = 0; seq = CTXL; rope_t0 = -1; }
        const size_t rb = (size_t)b * RPB;
        ATTN_MLA<192, 1536, 1536, 1024, 1024>(Q + (rb + q0) * 1536 + h * 192, Kb + rb * 1536 + h * 192, Vb + rb * 1024 + h * 128, O + (rb + q0) * 1024 + h * 128, seq, scale, F.lds, rope_t0);
    }
}
template <int VAR = 0> __device__ __forceinline__ void p_attn_gqa(const Args& A, const Frame& F, unsigned char* O) {
    const bf16_t* Q = (const bf16_t*)(F.ws + WS_Q1); const unsigned char* Kb = F.ws + WS_K1; const unsigned char* Vb = F.ws + WS_V1;
    const float scale = 0.08838834764831845f;
    for (int u = F.vcu; u < 512; u += F.nblk) {
        const int qb = u & 15, h = (u >> 4) & 7, b = u >> 7, q0 = CTXL + qb * 256, kvh = h >> 2;
        const size_t rb = (size_t)b * RPB;
        attn88_pp<128, 1024, 256, 256, 1024, VAR>(Q + (rb + q0) * 1024 + h * 128, Kb + rb * 256 + kvh * 128, Vb + rb * 256 + kvh * 128, O + (rb + q0) * 1024 + h * 128, RPB, scale, F.lds, -1);
    }
}
#define DPP_XOR1 0xB1
#define DPP_XOR2 0x4E
#define DPP_HMIRROR 0x141
#define DPP_MIRROR 0x140
__device__ __forceinline__ int row_max_i(int v) {
    v = max(v, __builtin_amdgcn_update_dpp(v, v, DPP_XOR1, 0xf, 0xf, false));
    v = max(v, __builtin_amdgcn_update_dpp(v, v, DPP_XOR2, 0xf, 0xf, false));
    v = max(v, __builtin_amdgcn_update_dpp(v, v, DPP_HMIRROR, 0xf, 0xf, false));
    v = max(v, __builtin_amdgcn_update_dpp(v, v, DPP_MIRROR, 0xf, 0xf, false));
    return v;
}
__device__ __forceinline__ float row_sum_f(float v) {
    v += __builtin_bit_cast(float, __builtin_amdgcn_update_dpp(0, __builtin_bit_cast(int, v), DPP_XOR1, 0xf, 0xf, false));
    v += __builtin_bit_cast(float, __builtin_amdgcn_update_dpp(0, __builtin_bit_cast(int, v), DPP_XOR2, 0xf, 0xf, false));
    v += __builtin_bit_cast(float, __builtin_amdgcn_update_dpp(0, __builtin_bit_cast(int, v), DPP_HMIRROR, 0xf, 0xf, false));
    v += __builtin_bit_cast(float, __builtin_amdgcn_update_dpp(0, __builtin_bit_cast(int, v), DPP_MIRROR, 0xf, 0xf, false));
    return v;
}
__device__ __forceinline__ int fkey(float f) { const int b = __builtin_bit_cast(int, f); return b ^ ((b >> 31) & 0x7fffffff); }
__device__ __forceinline__ float keyf(int k) { return __builtin_bit_cast(float, k ^ ((k >> 31) & 0x7fffffff)); }
__device__ __forceinline__ void cand_ij(int t, int& i, int& j) {
    const int g16 = t >= 16, g24 = t >= 24, g29 = t >= 29, g33 = t >= 33, g36 = t >= 36, g38 = t >= 38, g40 = t >= 40;
    i = g16 + g24 + g29 + g33 + g36 + g38 + g40 + max(t - 41, 0);
    const int base = 16 * g16 + 8 * g24 + 5 * g29 + 4 * g33 + 3 * g36 + 2 * g38 + 2 * g40;
    j = (t >= 42) ? 0 : t - base;
    if (t >= 50) { i = 0; j = 0; }
}
__device__ __forceinline__ void row_max2(int& a, int& b) {
    asm volatile("s_nop 1\n\t"
                 "v_max_i32_dpp %0, %0, %0 quad_perm:[1,0,3,2] row_mask:0xf bank_mask:0xf\n\tv_max_i32_dpp %1, %1, %1 quad_perm:[1,0,3,2] row_mask:0xf bank_mask:0xf\n\ts_nop 0\n\t"
                 "v_max_i32_dpp %0, %0, %0 quad_perm:[2,3,0,1] row_mask:0xf bank_mask:0xf\n\tv_max_i32_dpp %1, %1, %1 quad_perm:[2,3,0,1] row_mask:0xf bank_mask:0xf\n\ts_nop 0\n\t"
                 "v_max_i32_dpp %0, %0, %0 row_half_mirror row_mask:0xf bank_mask:0xf\n\tv_max_i32_dpp %1, %1, %1 row_half_mirror row_mask:0xf bank_mask:0xf\n\ts_nop 0\n\t"
                 "v_max_i32_dpp %0, %0, %0 row_mirror row_mask:0xf bank_mask:0xf\n\tv_max_i32_dpp %1, %1, %1 row_mirror row_mask:0xf bank_mask:0xf\n\ts_nop 1"
                 : "+v"(a), "+v"(b));
}
__device__ __forceinline__ void row_max1(int& a) {
    asm volatile("s_nop 1\n\t"
                 "v_max_i32_dpp %0, %0, %0 quad_perm:[1,0,3,2] row_mask:0xf bank_mask:0xf\n\ts_nop 1\n\t"
                 "v_max_i32_dpp %0, %0, %0 quad_perm:[2,3,0,1] row_mask:0xf bank_mask:0xf\n\ts_nop 1\n\t"
                 "v_max_i32_dpp %0, %0, %0 row_half_mirror row_mask:0xf bank_mask:0xf\n\ts_nop 1\n\t"
                 "v_max_i32_dpp %0, %0, %0 row_mirror row_mask:0xf bank_mask:0xf\n\ts_nop 1"
                 : "+v"(a));
}
__device__ __forceinline__ void row_max4(int& a, int& b, int& c, int& d) {
    asm volatile("s_nop 1\n\t"
                 "v_max_i32_dpp %0, %0, %0 quad_perm:[1,0,3,2] row_mask:0xf bank_mask:0xf\n\tv_max_i32_dpp %1, %1, %1 quad_perm:[1,0,3,2] row_mask:0xf bank_mask:0xf\n\t"
                 "v_max_i32_dpp %2, %2, %2 quad_perm:[1,0,3,2] row_mask:0xf bank_mask:0xf\n\tv_max_i32_dpp %3, %3, %3 quad_perm:[1,0,3,2] row_mask:0xf bank_mask:0xf\n\t"
                 "v_max_i32_dpp %0, %0, %0 quad_perm:[2,3,0,1] row_mask:0xf bank_mask:0xf\n\tv_max_i32_dpp %1, %1, %1 quad_perm:[2,3,0,1] row_mask:0xf bank_mask:0xf\n\t"
                 "v_max_i32_dpp %2, %2, %2 quad_perm:[2,3,0,1] row_mask:0xf bank_mask:0xf\n\tv_max_i32_dpp %3, %3, %3 quad_perm:[2,3,0,1] row_mask:0xf bank_mask:0xf\n\t"
                 "v_max_i32_dpp %0, %0, %0 row_half_mirror row_mask:0xf bank_mask:0xf\n\tv_max_i32_dpp %1, %1, %1 row_half_mirror row_mask:0xf bank_mask:0xf\n\t"
                 "v_max_i32_dpp %2, %2, %2 row_half_mirror row_mask:0xf bank_mask:0xf\n\tv_max_i32_dpp %3, %3, %3 row_half_mirror row_mask:0xf bank_mask:0xf\n\t"
                 "v_max_i32_dpp %0, %0, %0 row_mirror row_mask:0xf bank_mask:0xf\n\tv_max_i32_dpp %1, %1, %1 row_mirror row_mask:0xf bank_mask:0xf\n\t"
                 "v_max_i32_dpp %2, %2, %2 row_mirror row_mask:0xf bank_mask:0xf\n\tv_max_i32_dpp %3, %3, %3 row_mirror row_mask:0xf bank_mask:0xf\n\ts_nop 1"
                 : "+v"(a), "+v"(b), "+v"(c), "+v"(d));
}
#define CE_DESC(x, y) do { const int hi_ = max(x, y), lo_ = min(x, y); x = hi_; y = lo_; } while (0)
#define SORT8_DESC(k) do { CE_DESC(k[0], k[2]); CE_DESC(k[1], k[3]); CE_DESC(k[4], k[6]); CE_DESC(k[5], k[7]); CE_DESC(k[0], k[4]); CE_DESC(k[1], k[5]); CE_DESC(k[2], k[6]); CE_DESC(k[3], k[7]); \
    CE_DESC(k[0], k[1]); CE_DESC(k[2], k[3]); CE_DESC(k[4], k[5]); CE_DESC(k[6], k[7]); CE_DESC(k[2], k[4]); CE_DESC(k[3], k[5]); CE_DESC(k[1], k[4]); CE_DESC(k[3], k[6]); CE_DESC(k[1], k[2]); CE_DESC(k[3], k[4]); CE_DESC(k[5], k[6]); } while (0)
#define SORT16_DESC(K) do { CE_DESC(K[0], K[1]); CE_DESC(K[2], K[3]); CE_DESC(K[0], K[2]); CE_DESC(K[1], K[3]); CE_DESC(K[1], K[2]); CE_DESC(K[4], K[5]); CE_DESC(K[6], K[7]); CE_DESC(K[4], K[6]); CE_DESC(K[5], K[7]); CE_DESC(K[5], K[6]); CE_DESC(K[0], K[4]); CE_DESC(K[2], K[6]); CE_DESC(K[2], K[4]); CE_DESC(K[1], K[5]); CE_DESC(K[3], K[7]); CE_DESC(K[3], K[5]); CE_DESC(K[1], K[2]); CE_DESC(K[3], K[4]); CE_DESC(K[5], K[6]); CE_DESC(K[8], K[9]); CE_DESC(K[10], K[11]); CE_DESC(K[8], K[10]); CE_DESC(K[9], K[11]); CE_DESC(K[9], K[10]); CE_DESC(K[12], K[13]); CE_DESC(K[14], K[15]); CE_DESC(K[12], K[14]); CE_DESC(K[13], K[15]); CE_DESC(K[13], K[14]); CE_DESC(K[8], K[12]); CE_DESC(K[10], K[14]); CE_DESC(K[10], K[12]); CE_DESC(K[9], K[13]); CE_DESC(K[11], K[15]); CE_DESC(K[11], K[13]); CE_DESC(K[9], K[10]); CE_DESC(K[11], K[12]); CE_DESC(K[13], K[14]); CE_DESC(K[0], K[8]); CE_DESC(K[4], K[12]); CE_DESC(K[4], K[8]); CE_DESC(K[2], K[10]); CE_DESC(K[6], K[14]); CE_DESC(K[6], K[10]); CE_DESC(K[2], K[4]); CE_DESC(K[6], K[8]); CE_DESC(K[10], K[12]); CE_DESC(K[1], K[9]); CE_DESC(K[5], K[13]); CE_DESC(K[5], K[9]); CE_DESC(K[3], K[11]); CE_DESC(K[7], K[15]); CE_DESC(K[7], K[11]); CE_DESC(K[3], K[5]); CE_DESC(K[7], K[9]); CE_DESC(K[11], K[13]); CE_DESC(K[1], K[2]); CE_DESC(K[3], K[4]); CE_DESC(K[5], K[6]); CE_DESC(K[7], K[8]); CE_DESC(K[9], K[10]); CE_DESC(K[11], K[12]); CE_DESC(K[13], K[14]); } while (0)
#define MERGE16_DESC(T, K) do { _Pragma("unroll") for (int i_ = 0; i_ < 16; ++i_) T[i_] = max(T[i_], K[15 - i_]); CE_DESC(T[0], T[8]); CE_DESC(T[1], T[9]); CE_DESC(T[2], T[10]); CE_DESC(T[3], T[11]); CE_DESC(T[4], T[12]); CE_DESC(T[5], T[13]); CE_DESC(T[6], T[14]); CE_DESC(T[7], T[15]); CE_DESC(T[0], T[4]); CE_DESC(T[1], T[5]); CE_DESC(T[2], T[6]); CE_DESC(T[3], T[7]); CE_DESC(T[8], T[12]); CE_DESC(T[9], T[13]); CE_DESC(T[10], T[14]); CE_DESC(T[11], T[15]); CE_DESC(T[0], T[2]); CE_DESC(T[1], T[3]); CE_DESC(T[4], T[6]); CE_DESC(T[5], T[7]); CE_DESC(T[8], T[10]); CE_DESC(T[9], T[11]); CE_DESC(T[12], T[14]); CE_DESC(T[13], T[15]); CE_DESC(T[0], T[1]); CE_DESC(T[2], T[3]); CE_DESC(T[4], T[5]); CE_DESC(T[6], T[7]); CE_DESC(T[8], T[9]); CE_DESC(T[10], T[11]); CE_DESC(T[12], T[13]); CE_DESC(T[14], T[15]); } while (0)
__device__ __forceinline__ int hkey_hi(unsigned w) { const int x = (int)(w & 0xffff0000u); return x ^ ((x >> 31) & 0x7fff0000); }
__device__ __forceinline__ float hkey_val(int k) { const int y = k & (int)0xffff0000; const unsigned b = (unsigned)(y ^ ((y >> 31) & 0x7fff0000)); return (float)__builtin_bit_cast(_Float16, (unsigned short)(b >> 16)); }
__device__ __forceinline__ int cnd(int a, int b, unsigned long long m) { int r; asm("v_cndmask_b32_e64 %0, %1, %2, %3" : "=v"(r) : "v"(a), "v"(b), "s"(m)); return r; }
__device__ __forceinline__ unsigned long long bitmask(int v, int bit) { unsigned long long m; asm("v_cmp_ne_u32_e64 %0, 0, %1\n\ts_nop 1" : "=s"(m) : "v"(v & bit)); return m; }
__device__ __forceinline__ int sel16(const int (&a)[16], int i) {
    const unsigned long long m0 = bitmask(i, 1), m1 = bitmask(i, 2), m2 = bitmask(i, 4), m3 = bitmask(i, 8);
    int l1[8], l2[4], l3[2];
#pragma unroll
    for (int m = 0; m < 8; ++m) l1[m] = cnd(a[2 * m], a[2 * m + 1], m0);
#pragma unroll
    for (int m = 0; m < 4; ++m) l2[m] = cnd(l1[2 * m], l1[2 * m + 1], m1);
#pragma unroll
    for (int m = 0; m < 2; ++m) l3[m] = cnd(l2[2 * m], l2[2 * m + 1], m2);
    return cnd(l3[0], l3[1], m3);
}
__device__ __forceinline__ void topk_rows4(const unsigned short* S, unsigned* PK, int r, int hbase, int lane) {
    const int c = lane & 15, rw = lane >> 4, rbase = lane & 48, h = hbase + rw;
    const int KMIN = (int)0x80000000;
    const unsigned short* sp = S + (size_t)r * 2048 + h * 256 + 4 * c;
    int k1[8], k2[8];
#pragma unroll
    for (int jj = 0; jj < 2; ++jj) { const u32x2 a = *(const u32x2*)(sp + 64 * jj), b = *(const u32x2*)(sp + 128 + 64 * jj);
#pragma unroll
        for (int e = 0; e < 4; ++e) { const int p = 4 * c + 64 * jj + e;
            const float fa = (float)__builtin_bit_cast(_Float16, (unsigned short)(a[e >> 1] >> (16 * (e & 1)))), fb = (float)__builtin_bit_cast(_Float16, (unsigned short)(b[e >> 1] >> (16 * (e & 1))));
            k1[4 * jj + e] = (fkey(fa) & ~127) | (127 - p); k2[4 * jj + e] = (fkey(fb) & ~127) | (127 - p); } }
    SORT8_DESC(k1); SORT8_DESC(k2);
    int r1 = KMIN, r2 = KMIN;
#pragma unroll 1
    for (int it = 0; it < 16; ++it) {
        int m1 = k1[0], m2 = k2[0];
        row_max2(m1, m2);
        const bool p1 = (k1[0] == m1), p2 = (k2[0] == m2);
#pragma unroll
        for (int e = 0; e < 7; ++e) { k1[e] = p1 ? k1[e + 1] : k1[e]; k2[e] = p2 ? k2[e + 1] : k2[e]; }
        k1[7] = p1 ? KMIN : k1[7]; k2[7] = p2 ? KMIN : k2[7];
        if (c == it) { r1 = m1; r2 = m2; }
    }
    int ck[4];
#pragma unroll
    for (int q = 0; q < 4; ++q) { int ci, cj; cand_ij(c + 16 * q, ci, cj); const int a = __shfl(r1, rbase | ci), b = __shfl(r2, rbase | cj);
        const float fs = keyf((a & ~127) | 64) + keyf((b & ~127) | 64); const int t = c + 16 * q;
        ck[q] = (t < 50) ? ((fkey(fs) & ~63) | (63 - t)) : KMIN; }
    CE_DESC(ck[0], ck[1]); CE_DESC(ck[2], ck[3]); CE_DESC(ck[0], ck[2]); CE_DESC(ck[1], ck[3]); CE_DESC(ck[1], ck[2]);
    int tk = KMIN;
#pragma unroll 1
    for (int it = 0; it < 16; ++it) {
        int m = ck[0];
        row_max1(m);
        const bool pp = (ck[0] == m);
        ck[0] = pp ? ck[1] : ck[0]; ck[1] = pp ? ck[2] : ck[1]; ck[2] = pp ? ck[3] : ck[2]; ck[3] = pp ? KMIN : ck[3];
        if (c == it) tk = m;
    }
    int wi, wj; cand_ij(63 - (tk & 63), wi, wj);
    const int wa = __shfl(r1, rbase | wi), wb = __shfl(r2, rbase | wj);
    const int te = (127 - (wa & 127)) * 128 + (127 - (wb & 127));
    const float tv = keyf((tk & ~63) | 32);
    int mk = tk; row_max1(mk);
    const float mx = keyf((mk & ~63) | 32);
    const float ex = __expf(tv - mx), sum = row_sum_f(ex);
    PK[(size_t)r * 128 + h * 16 + c] = ((unsigned)te << 16) | (unsigned)(ex * (65535.f / sum) + 0.5f);
}
__device__ __forceinline__ void p_peer_topk(const Args& A, const Frame& F, bool skip_ctx) {
    const int gw = F.bid * NWAVES + F.wave, NGW = F.nblk * NWAVES, lane = F.lane;
    const unsigned short* S = (const unsigned short*)(F.ws + WS_S); unsigned* PK = (unsigned*)(F.ws + WS_PK);
    const int KMIN = (int)0x80000000;
    const int nitem = (skip_ctx ? NB * SEQ : R) * 8;
    const int nmain = (nitem / (NGW * 64)) * (NGW * 64);
    for (int q = gw; q < (nitem - nmain) / 4; q += NGW) { const int item = nmain + 4 * q, n = item >> 3; topk_rows4(S, PK, skip_ctx ? tok_row(1, n) : n, item & 7, lane); }
    for (int base = gw * 64; base < nmain; base += NGW * 64) {
        const int item = base + lane, n = item >> 3, h = item & 7, r = skip_ctx ? tok_row(1, n) : n;
        const unsigned short* sp = S + (size_t)r * 2048 + h * 256;
        int t1[16], t2[16];
#pragma unroll
        for (int list = 0; list < 2; ++list) {
            int T[16];
#pragma unroll
            for (int i = 0; i < 16; ++i) T[i] = KMIN;
            const unsigned short* lp = sp + 128 * list;
            u32x4 ra = *(const u32x4*)lp, rb = *(const u32x4*)(lp + 8);
#pragma unroll 1
            for (int c = 0; c < 8; ++c) {
                const int cn = c < 7 ? c + 1 : 7;
                const u32x4 na = *(const u32x4*)(lp + 16 * cn), nb = *(const u32x4*)(lp + 16 * cn + 8);
                const int pb = 127 - 16 * c;
                int K[16];
#pragma unroll
                for (int d = 0; d < 4; ++d) { K[2 * d] = hkey_hi(ra[d] << 16) | (pb - 2 * d); K[2 * d + 1] = hkey_hi(ra[d]) | (pb - 2 * d - 1);
                    K[8 + 2 * d] = hkey_hi(rb[d] << 16) | (pb - 8 - 2 * d); K[8 + 2 * d + 1] = hkey_hi(rb[d]) | (pb - 9 - 2 * d); }
                SORT16_DESC(K);
                MERGE16_DESC(T, K);
                ra = na; rb = nb;
            }
#pragma unroll
            for (int i = 0; i < 16; ++i) { if (list == 0) t1[i] = T[i]; else t2[i] = T[i]; }
        }
        float f1[16], f2[16];
#pragma unroll
        for (int i = 0; i < 16; ++i) { f1[i] = hkey_val(t1[i]); f2[i] = hkey_val(t2[i]); }
        int CA[16], CB[16], CC[16], CD[16];
        CA[0] = (fkey(f1[0] + f2[0]) & ~63) | 63; CA[1] = (fkey(f1[0] + f2[1]) & ~63) | 62; CA[2] = (fkey(f1[0] + f2[2]) & ~63) | 61; CA[3] = (fkey(f1[0] + f2[3]) & ~63) | 60; CA[4] = (fkey(f1[0] + f2[4]) & ~63) | 59; CA[5] = (fkey(f1[0] + f2[5]) & ~63) | 58; CA[6] = (fkey(f1[0] + f2[6]) & ~63) | 57; CA[7] = (fkey(f1[0] + f2[7]) & ~63) | 56; CA[8] = (fkey(f1[0] + f2[8]) & ~63) | 55; CA[9] = (fkey(f1[0] + f2[9]) & ~63) | 54; CA[10] = (fkey(f1[0] + f2[10]) & ~63) | 53; CA[11] = (fkey(f1[0] + f2[11]) & ~63) | 52; CA[12] = (fkey(f1[0] + f2[12]) & ~63) | 51; CA[13] = (fkey(f1[0] + f2[13]) & ~63) | 50; CA[14] = (fkey(f1[0] + f2[14]) & ~63) | 49; CA[15] = (fkey(f1[0] + f2[15]) & ~63) | 48; CB[0] = (fkey(f1[1] + f2[0]) & ~63) | 47; CB[1] = (fkey(f1[1] + f2[1]) & ~63) | 46; CB[2] = (fkey(f1[1] + f2[2]) & ~63) | 45; CB[3] = (fkey(f1[1] + f2[3]) & ~63) | 44; CB[4] = (fkey(f1[1] + f2[4]) & ~63) | 43; CB[5] = (fkey(f1[1] + f2[5]) & ~63) | 42; CB[6] = (fkey(f1[1] + f2[6]) & ~63) | 41; CB[7] = (fkey(f1[1] + f2[7]) & ~63) | 40; CB[8] = (fkey(f1[2] + f2[0]) & ~63) | 39; CB[9] = (fkey(f1[2] + f2[1]) & ~63) | 38; CB[10] = (fkey(f1[2] + f2[2]) & ~63) | 37; CB[11] = (fkey(f1[2] + f2[3]) & ~63) | 36; CB[12] = (fkey(f1[2] + f2[4]) & ~63) | 35; CB[13] = (fkey(f1[3] + f2[0]) & ~63) | 34; CB[14] = (fkey(f1[3] + f2[1]) & ~63) | 33; CB[15] = (fkey(f1[3] + f2[2]) & ~63) | 32; CC[0] = (fkey(f1[3] + f2[3]) & ~63) | 31; CC[1] = (fkey(f1[4] + f2[0]) & ~63) | 30; CC[2] = (fkey(f1[4] + f2[1]) & ~63) | 29; CC[3] = (fkey(f1[4] + f2[2]) & ~63) | 28; CC[4] = (fkey(f1[5] + f2[0]) & ~63) | 27; CC[5] = (fkey(f1[5] + f2[1]) & ~63) | 26; CC[6] = (fkey(f1[6] + f2[0]) & ~63) | 25; CC[7] = (fkey(f1[6] + f2[1]) & ~63) | 24; CC[8] = (fkey(f1[7] + f2[0]) & ~63) | 23; CC[9] = (fkey(f1[7] + f2[1]) & ~63) | 22; CC[10] = (fkey(f1[8] + f2[0]) & ~63) | 21; CC[11] = (fkey(f1[9] + f2[0]) & ~63) | 20; CC[12] = (fkey(f1[10] + f2[0]) & ~63) | 19; CC[13] = (fkey(f1[11] + f2[0]) & ~63) | 18; CC[14] = (fkey(f1[12] + f2[0]) & ~63) | 17; CC[15] = (fkey(f1[13] + f2[0]) & ~63) | 16; CD[0] = (fkey(f1[14] + f2[0]) & ~63) | 15; CD[1] = (fkey(f1[15] + f2[0]) & ~63) | 14; CD[2] = KMIN; CD[3] = KMIN; CD[4] = KMIN; CD[5] = KMIN; CD[6] = KMIN; CD[7] = KMIN; CD[8] = KMIN; CD[9] = KMIN; CD[10] = KMIN; CD[11] = KMIN; CD[12] = KMIN; CD[13] = KMIN; CD[14] = KMIN; CD[15] = KMIN;
        SORT16_DESC(CB); SORT16_DESC(CC); CE_DESC(CD[0], CD[1]);
        MERGE16_DESC(CA, CB); MERGE16_DESC(CA, CC); MERGE16_DESC(CA, CD);
        const float mx = keyf((CA[0] & ~63) | 32);
        float ex[16], sum = 0.f; unsigned te[16];
#pragma unroll
        for (int k = 0; k < 16; ++k) { int wi, wj; cand_ij(63 - (CA[k] & 63), wi, wj);
            const int wa = sel16(t1, wi), wb = sel16(t2, wj);
            te[k] = (unsigned)((127 - (wa & 127)) * 128 + (127 - (wb & 127)));
            ex[k] = __expf(keyf((CA[k] & ~63) | 32) - mx); sum += ex[k]; }
        const float rs = 65535.f / sum;
        u32x4* dst = (u32x4*)(PK + (size_t)r * 128 + h * 16);
#pragma unroll
        for (int q = 0; q < 4; ++q) { u32x4 o;
#pragma unroll
            for (int d = 0; d < 4; ++d) o[d] = (te[4 * q + d] << 16) | (unsigned)(ex[4 * q + d] * rs + 0.5f);
            dst[q] = o; }
    }
}

#define UB(w, b) ((float)(((w) >> (8 * (b))) & 0xffu))
__device__ __forceinline__ void p_peer_experts(const Args& A, const Frame& F, int layer) {
    const int gw = F.bid * NWAVES + F.wave, NGW = F.nblk * NWAVES, lane = F.lane;
    const bf16_t* H = (const bf16_t*)(F.ws + WS_H); float* X = (float*)(F.ws + WS_X);
    const unsigned* PK = (const unsigned*)(F.ws + WS_PK);
    const unsigned char* UT = F.ws + WS_TAB + (size_t)(layer * 2) * 16384 * 1024; const unsigned char* VT = UT + (size_t)16384 * 1024;
    const float* SU = (const float*)(F.ws + WS_TSC) + (layer * 2) * 16384; const float* SV = SU + 16384;
    const float* MOD = (const float*)(F.ws + WS_MOD) + (size_t)layer * 5 * 6144;
    for (int r = gw; r < R; r += NGW) {
        if (layer == 1 && is_ctx_row(r)) continue;
        float hf[16];
        { const u32x4 w0 = *(const u32x4*)(H + (size_t)r * DM + 16 * lane), w1 = *(const u32x4*)(H + (size_t)r * DM + 16 * lane + 8);
#pragma unroll
          for (int d = 0; d < 4; ++d) { hf[2 * d] = bflo(w0[d]); hf[2 * d + 1] = bfhi(w0[d]); hf[8 + 2 * d] = bflo(w1[d]); hf[8 + 2 * d + 1] = bfhi(w1[d]); } }
        float hs = 0.f;
#pragma unroll
        for (int i = 0; i < 16; ++i) hs += hf[i];
        hs = wave_sum(hs);
        int v0 = (int)PK[(size_t)r * 128 + lane], v1 = (int)PK[(size_t)r * 128 + 64 + lane];
#pragma unroll
        for (int k = 2; k <= 128; k <<= 1) {
#pragma unroll
            for (int j = k >> 1; j >= 1; j >>= 1) {
                if (j == 64) { const int a = min(v0, v1), b = max(v0, v1); v0 = a; v1 = b; }
                else { const int o0 = __shfl_xor(v0, j), o1 = __shfl_xor(v1, j); const bool lower = (lane & j) == 0;
                    const bool asc0 = (k == 128) ? true : (k == 64) ? true : ((lane & k) == 0), asc1 = (k == 128) ? true : (k == 64) ? false : ((lane & k) == 0);
                    v0 = (lower == asc0) ? min(v0, o0) : max(v0, o0); v1 = (lower == asc1) ? min(v1, o1) : max(v1, o1); }
            }
        }
        const unsigned pk0 = (unsigned)v0, pk1 = (unsigned)v1;
        const int e0 = (int)(pk0 >> 16), e1 = (int)(pk1 >> 16);
        const float g0 = (float)(pk0 & 0xffffu) * (1.f / 65535.f), g1 = (float)(pk1 & 0xffffu) * (1.f / 65535.f);
        const float su0 = SU[e0], su1 = SU[e1], sv0 = SV[e0], sv1 = SV[e1];
        float d0 = 0.f, d1 = 0.f;
        const int dep_src = (8 * (lane & 7)) << 2; const bool bit3 = (lane & 8) != 0;
#define XISSUE(buf, TAB, esrc, gg) do { _Pragma("unroll") for (int q_ = 0; q_ < 8; ++q_) { const int e_ = __builtin_amdgcn_readlane(esrc, (gg) * 8 + q_); \
            buf[q_] = *(const u32x4*)((TAB) + (size_t)e_ * 1024 + 16 * lane); } } while (0)
#define UCOMP(buf, gg, dsel) do { float p_[8]; _Pragma("unroll") for (int q_ = 0; q_ < 8; ++q_) { float d_ = 0.f; \
            _Pragma("unroll") for (int j_ = 0; j_ < 4; ++j_) d_ += (hf[4 * j_] * UB(buf[q_][j_], 0) + hf[4 * j_ + 1] * UB(buf[q_][j_], 1)) + (hf[4 * j_ + 2] * UB(buf[q_][j_], 2) + hf[4 * j_ + 3] * UB(buf[q_][j_], 3)); p_[q_] = d_; } \
            float s_[4]; _Pragma("unroll") for (int q_ = 0; q_ < 4; ++q_) { auto rr_ = __builtin_amdgcn_permlane32_swap(__float_as_uint(p_[q_]), __float_as_uint(p_[q_ + 4]), false, false); s_[q_] = __uint_as_float(rr_[0]) + __uint_as_float(rr_[1]); } \
            float t_[2]; _Pragma("unroll") for (int q_ = 0; q_ < 2; ++q_) { auto rr_ = __builtin_amdgcn_permlane16_swap(__float_as_uint(s_[q_]), __float_as_uint(s_[q_ + 2]), false, false); t_[q_] = __uint_as_float(rr_[0]) + __uint_as_float(rr_[1]); } \
            const float keep_ = bit3 ? t_[1] : t_[0], send_ = bit3 ? t_[0] : t_[1]; \
            float u_ = keep_ + __builtin_bit_cast(float, __builtin_amdgcn_update_dpp(0, __builtin_bit_cast(int, send_), 0x128, 0xf, 0xf, false)); \
            u_ += __builtin_bit_cast(float, __builtin_amdgcn_update_dpp(0, __builtin_bit_cast(int, u_), DPP_HMIRROR, 0xf, 0xf, false)); \
            u_ += __builtin_bit_cast(float, __builtin_amdgcn_update_dpp(0, __builtin_bit_cast(int, u_), DPP_XOR1, 0xf, 0xf, false)); \
            u_ += __builtin_bit_cast(float, __builtin_amdgcn_update_dpp(0, __builtin_bit_cast(int, u_), DPP_XOR2, 0xf, 0xf, false)); \
            const float v_ = __builtin_bit_cast(float, __builtin_amdgcn_ds_bpermute(dep_src, __builtin_bit_cast(int, u_))); \
            if ((lane >> 3) == (gg)) dsel = v_; } while (0)
        {
            u32x4 ua[8], ub[8];
            XISSUE(ua, UT, e0, 0);
#pragma unroll 1
            for (int g = 0; g < 8; g += 2) { XISSUE(ub, UT, e0, g + 1); UCOMP(ua, g, d0); if (g + 2 < 8) XISSUE(ua, UT, e0, g + 2); else XISSUE(ua, UT, e1, 0); UCOMP(ub, g + 1, d0); }
#pragma unroll 1
            for (int g = 0; g < 8; g += 2) { XISSUE(ub, UT, e1, g + 1); UCOMP(ua, g, d1); if (g + 2 < 8) XISSUE(ua, UT, e1, g + 2); UCOMP(ub, g + 1, d1); }
        }
        const float a0 = su0 * (d0 - 128.f * hs), a1 = su1 * (d1 - 128.f * hs);
        const float w0 = g0 * 0.5f * a0 * (1.f + erff(a0 * 0.70710678118654752f)) * sv0, w1 = g1 * 0.5f * a1 * (1.f + erff(a1 * 0.70710678118654752f)) * sv1;
        const float wsum = wave_sum(w0 + w1) * 128.f;
        float acc[16];
#pragma unroll
        for (int i = 0; i < 16; ++i) acc[i] = 0.f;
#define VCOMP(buf, wsrc, gg) do { _Pragma("unroll") for (int q_ = 0; q_ < 8; ++q_) { const float wk_ = __builtin_bit_cast(float, __builtin_amdgcn_readlane(__builtin_bit_cast(int, wsrc), (gg) * 8 + q_)); \
            _Pragma("unroll") for (int j_ = 0; j_ < 4; ++j_) { acc[4 * j_] += wk_ * UB(buf[q_][j_], 0); acc[4 * j_ + 1] += wk_ * UB(buf[q_][j_], 1); acc[4 * j_ + 2] += wk_ * UB(buf[q_][j_], 2); acc[4 * j_ + 3] += wk_ * UB(buf[q_][j_], 3); } } } while (0)
        {
            u32x4 va[8], vb[8];
            XISSUE(va, VT, e0, 0);
#pragma unroll 1
            for (int g = 0; g < 8; g += 2) { XISSUE(vb, VT, e0, g + 1); VCOMP(va, w0, g); if (g + 2 < 8) XISSUE(va, VT, e0, g + 2); else XISSUE(va, VT, e1, 0); VCOMP(vb, w0, g + 1); }
#pragma unroll 1
            for (int g = 0; g < 8; g += 2) { XISSUE(vb, VT, e1, g + 1); VCOMP(va, w1, g); if (g + 2 < 8) XISSUE(va, VT, e1, g + 2); VCOMP(vb, w1, g + 1); }
        }
#undef XISSUE
#undef UCOMP
#undef VCOMP
        const float* mm = MOD + (size_t)mod_index(r) * 6144;
        f32x4 xn[4]; float s = 0.f;
#pragma unroll
        for (int j = 0; j < 4; ++j) { const int c = 16 * lane + 4 * j; const float* xp = X + (size_t)r * DM + c; const f32x4 gf = *(const f32x4*)(mm + 5 * 1024 + c);
            xn[j] = *(const f32x4*)xp + gf * (f32x4){acc[4 * j] - wsum, acc[4 * j + 1] - wsum, acc[4 * j + 2] - wsum, acc[4 * j + 3] - wsum};
            s += (xn[j].x * xn[j].x + xn[j].y * xn[j].y) + (xn[j].z * xn[j].z + xn[j].w * xn[j].w); }
        const float rinv = rsqrtf(wave_sum(s) * (1.f / DM) + EPS);
        if (layer == 0) {
            const float* m1 = (const float*)(F.ws + WS_MOD) + (size_t)(5 + mod_index(r)) * 6144;
            const float* gn = A.in[I1_NMIX];
#pragma unroll
            for (int j = 0; j < 4; ++j) { const int c = 16 * lane + 4 * j; *(f32x4*)(X + (size_t)r * DM + c) = xn[j];
                const f32x4 y = (xn[j] * rinv * *(const f32x4*)(gn + c)) * (*(const f32x4*)(m1 + 1024 + c) + 1.f) + *(const f32x4*)(m1 + c);
                u32x2 o; o.x = pk2(y.x, y.y); o.y = pk2(y.z, y.w); *(u32x2*)((bf16_t*)(F.ws + WS_H) + (size_t)r * DM + c) = o; }
        } else {
            const int b = r / RPB, t = (r - b * RPB) - CTXL; float* op = F.out + ((size_t)b * SEQ + t) * DM; const float* gn = A.in[I_NOUT];
#pragma unroll
            for (int j = 0; j < 4; ++j) { const int c = 16 * lane + 4 * j; *(f32x4*)(op + c) = xn[j] * rinv * *(const f32x4*)(gn + c); }
        }
    }
}

__device__ __forceinline__ int tok_row(int layer, int n) { return layer == 0 ? n : (n >> 12) * RPB + CTXL + (n & 4095); }
#define DPPF(v, ctrl) __builtin_bit_cast(float, __builtin_amdgcn_update_dpp(0, __builtin_bit_cast(int, v), ctrl, 0xf, 0xf, false))
__device__ __forceinline__ int isum8(int v) {
    v += __builtin_amdgcn_update_dpp(0, v, DPP_XOR1, 0xf, 0xf, false); v += __builtin_amdgcn_update_dpp(0, v, DPP_XOR2, 0xf, 0xf, false); v += __builtin_amdgcn_update_dpp(0, v, DPP_HMIRROR, 0xf, 0xf, false); return v; }
__device__ __forceinline__ void p_exp_u(const Args& A, const Frame& F, int layer) {
    const int lane = F.lane, s = lane >> 3, c8 = lane & 7;
    const bool part = (F.nblk & 7) == 0; const int ncb = part ? 1 : 4, cb0 = part ? (F.bid & 3) : 0;
    const int gwv = part ? ((F.bid >> 2) * NWAVES + F.wave) : (F.bid * NWAVES + F.wave), nwv = part ? ((F.nblk >> 2) * NWAVES) : (F.nblk * NWAVES);
    const int ntok = layer == 0 ? R : NB * SEQ;
    const unsigned char* HQ = F.ws + WS_HQ; const unsigned* PK = (const unsigned*)(F.ws + WS_PK);
    const unsigned char* UT = F.ws + WS_TAB + (size_t)(layer * 2) * 16384 * 1024;
    int* PD = (int*)(F.ws + WS_PD);
#define U_META(pk, hqa, hqb, n_) do { const int r_ = tok_row(layer, (n_) < ntok ? (n_) : gwv); const unsigned* p_ = PK + (size_t)r_ * 128 + s; \
        _Pragma("unroll") for (int i_ = 0; i_ < 16; ++i_) pk[i_] = p_[8 * i_]; \
        hqa = *(const u32x4*)(HQ + (size_t)r_ * DM + 256 * cb + 32 * c8); hqb = *(const u32x4*)(HQ + (size_t)r_ * DM + 256 * cb + 32 * c8 + 16); } while (0)
#define U_ISSUE(pk, lo) do { _Pragma("unroll") for (int i_ = (lo); i_ < (lo) + 8; ++i_) t[i_] = *(const u32x4*)(tb + (size_t)(pk[i_] >> 16) * 128); } while (0)
#define U_DOT(i_) do { int dh_ = __builtin_amdgcn_sdot8((int)t[i_][0], (int)hva[0], 0, false), dl_ = __builtin_amdgcn_sdot8((int)t[i_][0], (int)hva[1], 0, false); \
        dh_ = __builtin_amdgcn_sdot8((int)t[i_][1], (int)hva[2], dh_, false); dl_ = __builtin_amdgcn_sdot8((int)t[i_][1], (int)hva[3], dl_, false); \
        dh_ = __builtin_amdgcn_sdot8((int)t[i_][2], (int)hvb[0], dh_, false); dl_ = __builtin_amdgcn_sdot8((int)t[i_][2], (int)hvb[1], dl_, false); \
        dh_ = __builtin_amdgcn_sdot8((int)t[i_][3], (int)hvb[2], dh_, false); dl_ = __builtin_amdgcn_sdot8((int)t[i_][3], (int)hvb[3], dl_, false); \
        int d_ = isum8(dh_ * 16 + dl_); if (c8 == ((i_) & 7)) { if ((i_) < 8) kA = d_; else kB = d_; } } while (0)
#define U_ITEM(pkc, hqca, hqcb, pkn, n_) do { \
        const u32x4 hva = hqca, hvb = hqcb; \
        U_META(pkc, hqca, hqcb, (n_) + 2 * nwv); \
        int kA = 0, kB = 0; \
        _Pragma("unroll") for (int i_ = 0; i_ < 8; ++i_) U_DOT(i_); \
        U_ISSUE(pkn, 0); \
        _Pragma("unroll") for (int i_ = 8; i_ < 16; ++i_) U_DOT(i_); \
        U_ISSUE(pkn, 8); \
        if ((n_) < ntok) { const int r_ = tok_row(layer, n_); int* pd_ = PD + ((size_t)cb * R + r_) * 128 + 8 * c8 + s; pd_[0] = kA; pd_[64] = kB; } \
        } while (0)
#pragma unroll 1
    for (int cbi = 0; cbi < ncb; ++cbi) {
        const int cb = cb0 + cbi;
        const unsigned char* tb = UT + (size_t)cb * 16384 * 128 + 16 * c8;
        unsigned pkA[16], pkB[16]; u32x4 hAa, hAb, hBa, hBb, t[16];
        U_META(pkA, hAa, hAb, gwv); U_META(pkB, hBa, hBb, gwv + nwv);
        U_ISSUE(pkA, 0); U_ISSUE(pkA, 8);
#pragma unroll 1
        for (int n = gwv; n < ntok; n += 2 * nwv) {
            U_ITEM(pkA, hAa, hAb, pkB, n);
            U_ITEM(pkB, hBa, hBb, pkA, n + nwv);
        }
    }
#undef U_META
#undef U_ISSUE
#undef U_DOT
#undef U_ITEM
}
__device__ __forceinline__ void p_exp_w(const Args& A, const Frame& F, int layer) {
    const int gw = F.bid * NWAVES + F.wave, NGW = F.nblk * NWAVES, lane = F.lane;
    const int ntok = layer == 0 ? R : NB * SEQ;
    const unsigned* PK = (const unsigned*)(F.ws + WS_PK); const int* PD = (const int*)(F.ws + WS_PD); const float* HS = (const float*)(F.ws + WS_HS);
    unsigned* WQ8 = (unsigned*)(F.ws + WS_WQ8); float* WSC = (float*)(F.ws + WS_WSC);
    const float* SU = (const float*)(F.ws + WS_TSC) + (layer * 2) * 16384; const float* SV = SU + 16384;
    const int g2 = (lane >> 3) & 3, sb = lane & 7, src = 32 * (g2 & 1) + sb;
    for (int n = gw; n < ntok; n += 2 * NGW) {
        int r[2]; r[0] = tok_row(layer, n); r[1] = (n + NGW) < ntok ? tok_row(layer, n + NGW) : r[0];
        unsigned pk0[2], pk1[2]; int d0[2], d1[2]; float hs[2];
#pragma unroll
        for (int q = 0; q < 2; ++q) { pk0[q] = PK[(size_t)r[q] * 128 + lane]; pk1[q] = PK[(size_t)r[q] * 128 + 64 + lane]; hs[q] = HS[r[q]]; d0[q] = 0; d1[q] = 0;
#pragma unroll
            for (int cb = 0; cb < 4; ++cb) { d0[q] += PD[((size_t)cb * R + r[q]) * 128 + lane]; d1[q] += PD[((size_t)cb * R + r[q]) * 128 + 64 + lane]; } }
        float su0[2], su1[2], sv0[2], sv1[2];
#pragma unroll
        for (int q = 0; q < 2; ++q) { const int e0 = (int)(pk0[q] >> 16), e1 = (int)(pk1[q] >> 16); su0[q] = SU[e0]; su1[q] = SU[e1]; sv0[q] = SV[e0]; sv1[q] = SV[e1]; }
#pragma unroll
        for (int q = 0; q < 2; ++q) {
            const float g0 = (float)(pk0[q] & 0xffffu) * (1.f / 65535.f), g1 = (float)(pk1[q] & 0xffffu) * (1.f / 65535.f);
            const float a0 = su0[q] * hs[q] * (float)d0[q], a1 = su1[q] * hs[q] * (float)d1[q];
            const float w0 = g0 * 0.5f * a0 * (1.f + erff(a0 * 0.70710678118654752f)) * sv0[q], w1 = g1 * 0.5f * a1 * (1.f + erff(a1 * 0.70710678118654752f)) * sv1[q];
            const float wm = wave_max(fmaxf(fabsf(w0), fabsf(w1)));
            const float inv = wm > 0.f ? 127.f / wm : 0.f;
            const int q0 = (int)rintf(w0 * inv) & 0xff, q1 = (int)rintf(w1 * inv) & 0xff;
            unsigned pw = 0;
#pragma unroll
            for (int j = 0; j < 4; ++j) { const int x0 = __shfl(q0, src + 8 * j), x1 = __shfl(q1, src + 8 * j); pw |= (unsigned)((g2 < 2) ? x0 : x1) << (8 * j); }
            if (q == 0 || (n + NGW) < ntok) { if (lane < 32) WQ8[(size_t)r[q] * 32 + lane] = pw; if (lane == 0) WSC[r[q]] = wm > 0.f ? wm * (1.f / 127.f) : 0.f; }
        }
    }
}
__device__ __forceinline__ void p_exp_v(const Args& A, const Frame& F, int layer) {
    const int lane = F.lane, s = lane >> 3, c8 = lane & 7;
    const bool part = (F.nblk & 7) == 0; const int ncb = part ? 1 : 4, cb0 = part ? (F.bid & 3) : 0;
    const int gwv = part ? ((F.bid >> 2) * NWAVES + F.wave) : (F.bid * NWAVES + F.wave), nwv = part ? ((F.nblk >> 2) * NWAVES) : (F.nblk * NWAVES);
    const int ntok = layer == 0 ? R : NB * SEQ;
    const unsigned* PK = (const unsigned*)(F.ws + WS_PK); const unsigned* WQ8 = (const unsigned*)(F.ws + WS_WQ8); const float* WSC = (const float*)(F.ws + WS_WSC);
    const unsigned char* VT = F.ws + WS_TAB + (size_t)(layer * 2 + 1) * 16384 * 1024;
    unsigned short* X = (unsigned short*)(F.ws + WS_X); const float* MOD = (const float*)(F.ws + WS_MOD) + (size_t)layer * 5 * 6144;
    const bool bit3 = (lane & 8) != 0;
#define V_METAP(pk, n_) do { const int r_ = tok_row(layer, (n_) < ntok ? (n_) : gwv); const unsigned* p_ = PK + (size_t)r_ * 128 + s; \
        _Pragma("unroll") for (int i_ = 0; i_ < 16; ++i_) pk[i_] = p_[8 * i_]; } while (0)
#define V_METAW(wq, n_) do { const int r_ = tok_row(layer, (n_) < ntok ? (n_) : gwv); const unsigned* w_ = WQ8 + (size_t)r_ * 32 + s; \
        _Pragma("unroll") for (int g_ = 0; g_ < 4; ++g_) wq[g_] = w_[8 * g_]; } while (0)
#define V_ISSUE(pk, lo) do { _Pragma("unroll") for (int i_ = (lo); i_ < (lo) + 8; ++i_) t[i_] = *(const u32x4*)(tb + (size_t)(pk[i_] >> 16) * 128); } while (0)
#define V_NIB(T_, cj_, wq_) do { acc[(cj_) + 4] = __builtin_amdgcn_sdot4((int)((T_) & 0xF0F0F0F0u), (int)(wq_), acc[(cj_) + 4], false); \
        acc[(cj_)] = __builtin_amdgcn_sdot4((int)(((T_) << 4) & 0xF0F0F0F0u), (int)(wq_), acc[(cj_)], false); } while (0)
#define V_GRP(wq, g_) do { _Pragma("unroll") for (int j_ = 0; j_ < 4; ++j_) { const unsigned a_ = t[4 * (g_)][j_], b_ = t[4 * (g_) + 1][j_], c_ = t[4 * (g_) + 2][j_], d_ = t[4 * (g_) + 3][j_]; \
        const unsigned ablo = __builtin_amdgcn_perm(b_, a_, 0x05010400u), abhi = __builtin_amdgcn_perm(b_, a_, 0x07030602u), cdlo = __builtin_amdgcn_perm(d_, c_, 0x05010400u), cdhi = __builtin_amdgcn_perm(d_, c_, 0x07030602u); \
        const unsigned T0 = __builtin_amdgcn_perm(cdlo, ablo, 0x05040100u), T1 = __builtin_amdgcn_perm(cdlo, ablo, 0x07060302u), T2 = __builtin_amdgcn_perm(cdhi, abhi, 0x05040100u), T3 = __builtin_amdgcn_perm(cdhi, abhi, 0x07060302u); \
        V_NIB(T0, 8 * j_, wq[g_]); V_NIB(T1, 8 * j_ + 1, wq[g_]); V_NIB(T2, 8 * j_ + 2, wq[g_]); V_NIB(T3, 8 * j_ + 3, wq[g_]); } } while (0)
#define V_ITEM(pkc, wqc, pkn, n_) do { \
        int acc[32]; _Pragma("unroll") for (int a_ = 0; a_ < 32; ++a_) acc[a_] = 0; \
        V_METAP(pkc, (n_) + 2 * nwv); \
        V_GRP(wqc, 0); V_GRP(wqc, 1); \
        V_ISSUE(pkn, 0); \
        V_GRP(wqc, 2); V_GRP(wqc, 3); \
        V_ISSUE(pkn, 8); \
        int b16[16], b8[8], o[4]; \
        _Pragma("unroll") for (int a_ = 0; a_ < 16; ++a_) { auto rr = __builtin_amdgcn_permlane32_swap((unsigned)acc[a_], (unsigned)acc[a_ + 16], false, false); b16[a_] = (int)rr[0] + (int)rr[1]; } \
        _Pragma("unroll") for (int a_ = 0; a_ < 8; ++a_) { auto rr = __builtin_amdgcn_permlane16_swap((unsigned)b16[a_], (unsigned)b16[a_ + 8], false, false); b8[a_] = (int)rr[0] + (int)rr[1]; } \
        _Pragma("unroll") for (int a_ = 0; a_ < 4; ++a_) { const int keep = bit3 ? b8[a_ + 4] : b8[a_], send = bit3 ? b8[a_] : b8[a_ + 4]; o[a_] = keep + __builtin_amdgcn_update_dpp(0, send, 0x128, 0xf, 0xf, false); } \
        if ((n_) < ntok) { const int r_ = tok_row(layer, n_); const float ws_ = WSC[r_] * (1.f / 16.f); const int col = 256 * cb + 32 * c8 + 4 * s; \
            const f32x4 gf = *(const f32x4*)(MOD + (size_t)mod_index(r_) * 6144 + 5 * 1024 + col); u32x2* xp = (u32x2*)(X + (size_t)r_ * DM + col); \
            const u32x2 xw = *xp; u32x2 xo; xo.x = pkh2(h2f_lo(xw.x) + gf.x * (ws_ * (float)o[0]), h2f_hi(xw.x) + gf.y * (ws_ * (float)o[1])); \
            xo.y = pkh2(h2f_lo(xw.y) + gf.z * (ws_ * (float)o[2]), h2f_hi(xw.y) + gf.w * (ws_ * (float)o[3])); *xp = xo; } \
        V_METAW(wqc, (n_) + 2 * nwv); } while (0)
#pragma unroll 1
    for (int cbi = 0; cbi < ncb; ++cbi) {
        const int cb = cb0 + cbi;
        const unsigned char* tb = VT + (size_t)cb * 16384 * 128 + 16 * c8;
        unsigned pkA[16], pkB[16], wqA[4], wqB[4]; u32x4 t[16];
        V_METAP(pkA, gwv); V_METAW(wqA, gwv); V_METAP(pkB, gwv + nwv); V_METAW(wqB, gwv + nwv);
        V_ISSUE(pkA, 0); V_ISSUE(pkA, 8);
#pragma unroll 1
        for (int n = gwv; n < ntok; n += 2 * nwv) {
            V_ITEM(pkA, wqA, pkB, n);
            V_ITEM(pkB, wqB, pkA, n + nwv);
        }
    }
#undef V_METAP
#undef V_METAW
#undef V_ISSUE
#undef V_NIB
#undef V_GRP
#undef V_ITEM
}
__device__ __forceinline__ void p_final_norm(const Args& A, const Frame& F) {
    const int gw = F.bid * NWAVES + F.wave, NGW = F.nblk * NWAVES, lane = F.lane;
    const unsigned short* X = (const unsigned short*)(F.ws + WS_X); const float* gn = A.in[I_NOUT];
#if ATTN_SELFTEST || GEMM_SELFTEST
    const unsigned* ctl_ = (const unsigned*)(F.ws + WS_CTL) + 16; const float mrel_ = fmaxf(fmaxf(__uint_as_float(__hip_atomic_load(ctl_ + 2, __ATOMIC_RELAXED, __HIP_MEMORY_SCOPE_AGENT)), __uint_as_float(__hip_atomic_load(ctl_ + 3, __ATOMIC_RELAXED, __HIP_MEMORY_SCOPE_AGENT))), fmaxf(__uint_as_float(__hip_atomic_load(ctl_, __ATOMIC_RELAXED, __HIP_MEMORY_SCOPE_AGENT)), __uint_as_float(__hip_atomic_load(ctl_ + 1, __ATOMIC_RELAXED, __HIP_MEMORY_SCOPE_AGENT)))
    ); const int nzero_ = (int)fminf((float)(NB * SEQ), mrel_ * (float)(NB * SEQ));
#endif
    for (int n = gw; n < NB * SEQ; n += NGW) {
        const unsigned short* xr = X + (size_t)tok_row(1, n) * DM; float* op = F.out + (size_t)n * DM;
#if ATTN_SELFTEST || GEMM_SELFTEST
        if (n < nzero_) { for (int j = 0; j < 4; ++j) *(f32x4*)(op + 4 * lane + 256 * j) = (f32x4){0.f, 0.f, 0.f, 0.f}; continue; }
#endif
        f32x4 v[4]; float sq = 0.f;
#pragma unroll
        for (int j = 0; j < 4; ++j) { const u32x2 a = *(const u32x2*)(xr + 4 * lane + 256 * j); v[j] = (f32x4){h2f_lo(a.x), h2f_hi(a.x), h2f_lo(a.y), h2f_hi(a.y)}; sq += (v[j].x * v[j].x + v[j].y * v[j].y) + (v[j].z * v[j].z + v[j].w * v[j].w); }
        const float rinv = rsqrtf(wave_sum(sq) * (1.f / DM) + EPS);
#pragma unroll
        for (int j = 0; j < 4; ++j) { const int c = 4 * lane + 256 * j; *(f32x4*)(op + c) = v[j] * rinv * *(const f32x4*)(gn + c); }
    }
}

#if ATTN_SELFTEST
template <int DQK>
__device__ __forceinline__ float attn_check_row(const bf16_t* qrow, int rope_t, const unsigned char* K8, int ldk, const unsigned char* V8, int ldv, int nk, float scale, const unsigned char* orow, float* sl, float* ql, int lane) {
    for (int d = lane; d < DQK; d += 64) ql[d] = bf2f(qrow[d]);
    asm volatile("s_waitcnt lgkmcnt(0)" ::: "memory");
    if (DQK == 192 && rope_t >= 0 && lane < 32) {
        const int i = lane & 15, ax = lane >> 4; const float pos = (float)(ax ? (rope_t & 63) : (rope_t >> 6));
        const float invf = __powf(10000.f, -(float)i * (1.f / 16.f)), ang = pos * invf, cs = __cosf(ang), sn = __sinf(ang);
        const float x1 = ql[128 + 32 * ax + i], x2 = ql[128 + 32 * ax + 16 + i];
        ql[128 + 32 * ax + i] = x1 * cs - x2 * sn; ql[128 + 32 * ax + 16 + i] = x2 * cs + x1 * sn;
    }
    asm volatile("s_waitcnt lgkmcnt(0)" ::: "memory");
    for (int d = lane; d < DQK; d += 64) { const float v = ql[d]; ql[d] = f8dec<0>(f8x4(v, v, v, v)); }
    asm volatile("s_waitcnt lgkmcnt(0)" ::: "memory");
    float mx = -1e30f;
    for (int k = lane; k < nk; k += 64) {
        const unsigned char* kr = K8 + (size_t)k * ldk; float acc = 0.f;
#pragma unroll 1
        for (int c = 0; c < DQK / 16; ++c) { const u32x4 w = *(const u32x4*)(kr + 16 * c);
#pragma unroll
            for (int e = 0; e < 4; ++e) acc += (ql[16 * c + 4 * e] * f8dec<0>(w[e]) + ql[16 * c + 4 * e + 1] * f8dec<1>(w[e])) + (ql[16 * c + 4 * e + 2] * f8dec<2>(w[e]) + ql[16 * c + 4 * e + 3] * f8dec<3>(w[e])); }
        acc *= scale; sl[k] = acc; mx = fmaxf(mx, acc);
    }
    mx = wave_max(mx);
#if ATT8_FIXED_M
    mx = 6.f;
#endif
    float sum = 0.f;
    for (int k = lane; k < nk; k += 64) { float pv = __builtin_amdgcn_exp2f((sl[k] - mx) * 1.4426950408889634f + ATT8_SH);
#if ATT8_FIXED_M
        if (DQK == 192) sum += pv;
        pv = f8dec<0>(f8x4(pv, pv, pv, pv));
        if (DQK != 192) sum += pv;
#else
        sum += pv;
#endif
        sl[k] = pv; }
    sum = wave_sum(sum);
    asm volatile("s_waitcnt lgkmcnt(0)" ::: "memory");
    float o0 = 0.f, o1 = 0.f;
    for (int k = 0; k < nk; ++k) { const float pv = sl[k]; const unsigned w = *(const unsigned short*)(V8 + (size_t)k * ldv + 2 * lane); o0 += pv * f8dec<0>(w); o1 += pv * f8dec<1>(w); }
    o0 /= sum; o1 /= sum;
    const unsigned fw = *(const unsigned short*)(orow + 2 * lane); const float f0 = f8dec<0>(fw) * (1.f / (float)(1 << O8_SH)), f1 = f8dec<1>(fw) * (1.f / (float)(1 << O8_SH));
    const float num = wave_sum((f0 - o0) * (f0 - o0) + (f1 - o1) * (f1 - o1)), den = wave_sum(o0 * o0 + o1 * o1);
    return sqrtf(num / fmaxf(den, 1e-30f));
}
__device__ __forceinline__ void attn_selftest(const Frame& F, int layer) {
    float* sl = (float*)F.lds + F.wave * (RPB + 192); float* ql = sl + RPB;
    const int gw = F.bid * NWAVES + F.wave;
    unsigned hsh = (unsigned)gw * 2654435761u + 12345u * (unsigned)(layer + 1); hsh ^= hsh >> 15; hsh *= 2246822519u; hsh ^= hsh >> 13;
    const int h = (int)(hsh & 7u); float rel;
    if (layer == 0) {
        const int r = (int)((hsh >> 3) % (unsigned)R), b = r / RPB, j = r - b * RPB; const bool ctx = j < CTXL; const size_t rb = (size_t)b * RPB;
        rel = attn_check_row<192>((const bf16_t*)(F.ws + WS_Q) + (size_t)r * 1536 + h * 192, ctx ? -1 : j - CTXL, F.ws + WS_K + rb * 1536 + h * 192, 1536,
                                  F.ws + WS_V + rb * 1024 + h * 128, 1024, ctx ? CTXL : RPB, 0.07216878364870322f, F.ws + WS_O + (size_t)r * 1024 + h * 128, sl, ql, F.lane);
    } else {
        const int n = (int)((hsh >> 3) % (unsigned)(NB * SEQ)), r = (n >> 12) * RPB + CTXL + (n & 4095), b = r / RPB, kvh = h >> 2; const size_t rb = (size_t)b * RPB;
        rel = attn_check_row<128>((const bf16_t*)(F.ws + WS_Q1) + (size_t)r * 1024 + h * 128, -1, F.ws + WS_K1 + rb * 256 + kvh * 128, 256,
                                  F.ws + WS_V1 + rb * 256 + kvh * 128, 256, RPB, 0.08838834764831845f, F.ws + WS_O + (size_t)r * 1024 + h * 128, sl, ql, F.lane);
    }
    if (!(rel < 1e30f)) rel = 1e30f;
    if (F.lane == 0) atomicMax((unsigned*)(F.ws + WS_CTL) + 16 + layer, __float_as_uint(rel));
    __syncthreads();
}
#endif

#if GEMM_SELFTEST
template <class Get> __device__ __forceinline__ float gemm_check(const Frame& F, const unsigned char* A8, int lda, const unsigned char* B8, int ldb, int K, int c_lo, int c_hi, int shift, bool latent, unsigned seed, const Get& get) {
    const int gw = F.bid * NWAVES + F.wave; float e2 = 0.f, r2 = 0.f;
    for (int it = 0; it < 8; ++it) {
        unsigned hsh = ((unsigned)gw * 8u + (unsigned)it) * 2654435761u + seed; hsh ^= hsh >> 15; hsh *= 2246822519u; hsh ^= hsh >> 13;
        const int col = c_lo + (int)(hsh % (unsigned)(c_hi - c_lo)); const unsigned h2 = hsh * 3266489917u + 374761393u;
        int row = (int)((h2 >> 4) % (unsigned)(latent ? NB * SEQ : R)); if (latent) row = (row >> 12) * RPB + CTXL + (row & 4095);
        float acc = 0.f;
        for (int k = 4 * F.lane; k < K; k += 256) { const unsigned a = *(const unsigned*)(A8 + (size_t)row * lda + k), b = *(const unsigned*)(B8 + (size_t)col * ldb + k);
            acc += (f8dec<0>(a) * f8dec<0>(b) + f8dec<1>(a) * f8dec<1>(b)) + (f8dec<2>(a) * f8dec<2>(b) + f8dec<3>(a) * f8dec<3>(b)); }
        const float naive = wave_sum(acc) * (1.f / (float)(1 << shift));
        float st, ex; get(row, col, naive, st, ex);
        e2 += (st - ex) * (st - ex); r2 += ex * ex;
    }
    return sqrtf(e2 / fmaxf(r2, 1e-30f));
}
__device__ __forceinline__ float f8at(const unsigned char* p) { return f8dec<0>((unsigned)*p); }
__device__ __forceinline__ void gemm_selftest(const Frame& F, int id) {
    const float* SSP = (const float*)(F.ws + WS_SSP); const bf16_t* DBG = (const bf16_t*)(F.ws + WS_PK);
    float rel = 0.f; int cls = 0;
    if (id == 0) {
        cls = 1; rel = gemm_check(F, F.ws + WS_H, 1024, F.ws + WS_WIN, 1024, 1024, 0, 640, W8_SH_IN, false, 11u, [&](int r, int c, float nv, float& st, float& ex) {
            st = c < 384 ? f8at(F.ws + WS_CQ + (size_t)r * 512 + c) : f8at(F.ws + WS_CKV + (size_t)r * 256 + (c - 384)); ex = nv; });
    } else if (id == 6) {
        rel = gemm_check(F, F.ws + WS_H, 1024, F.ws + WS_WIN, 1024, 1024, 640, 704, W8_SH_IN, false, 17u, [&](int r, int c, float nv, float& st, float& ex) {
            st = bf2f(((const bf16_t*)(F.ws + WS_KR))[(size_t)r * 64 + (c - 640)]); ex = nv; });
    } else if (id == 1) {
        rel = gemm_check(F, F.ws + WS_CQ, 512, F.ws + WS_WUQ, 512, 512, 0, 1536, W8_SH_UQ, false, 23u, [&](int r, int c, float nv, float& st, float& ex) {
            float ss = 0.f; for (int i = 0; i < 12; ++i) ss += SSP[(size_t)r * 24 + i]; st = bf2f(((const bf16_t*)(F.ws + WS_Q))[(size_t)r * 1536 + c]); ex = nv * rsqrtf(ss * (1.f / 384.f) + EPS); });
    } else if (id == 2) {
        cls = 1; rel = gemm_check(F, F.ws + WS_CKV, 256, F.ws + WS_WUKV, 256, 256, 0, 2048, W8_SH_UKV, false, 29u, [&](int r, int c, float nv, float& st, float& ex) {
            float ss = 0.f; for (int i = 12; i < 20; ++i) ss += SSP[(size_t)r * 24 + i]; const int h = c >> 8, cc = c & 255;
            st = cc < 128 ? f8at(F.ws + WS_K + (size_t)r * 1536 + h * 192 + cc) : f8at(F.ws + WS_V + (size_t)r * 1024 + h * 128 + (cc - 128)); ex = nv * rsqrtf(ss * (1.f / 256.f) + EPS); });
    } else if (id == 3 || id == 5) {
        rel = gemm_check(F, F.ws + WS_O, 1024, F.ws + (id == 3 ? WS_WO0 : WS_WO1), 1024, 1024, 0, 256, W8_SH_O + O8_SH, id == 5, 31u + id, [&](int r, int c, float nv, float& st, float& ex) {
            st = bf2f(DBG[(size_t)r * 256 + c]); ex = nv; });
    } else if (id == 4) {
        rel = gemm_check(F, F.ws + WS_H, 1024, F.ws + WS_WQKV, 1024, 1024, 0, 1536, W8_SH_QKV, false, 41u, [&](int r, int c, float nv, float& st, float& ex) {
            st = bf2f(((const bf16_t*)(F.ws + WS_RAW1))[(size_t)r * 1536 + c]); ex = nv; });
    }
    if (!(rel < 1e30f)) rel = 1e30f;
    if (((GEMM_SELFTEST >> cls) & 1) && F.lane == 0) atomicMax((unsigned*)(F.ws + WS_CTL) + 18 + cls, __float_as_uint(rel));
    __syncthreads();
}
#define GEMM_DBG (bf16_t*)(F.ws + WS_PK)
#else
#define GEMM_DBG nullptr
#endif

constexpr int N_PHASES = 24;
__global__ void __launch_bounds__(NTHREADS, 2) mega(Args args) {
    extern __shared__ __attribute__((aligned(16))) unsigned char lds_raw[];
    Frame F; F.x = args.in[I_X]; F.ctx = args.in[I_CTX]; F.out = args.out; F.ws = args.ws; F.lds = (char*)lds_raw;
    F.tid = threadIdx.x; F.lane = F.tid & 63; F.wave = __builtin_amdgcn_readfirstlane(F.tid >> 6); F.bid = blockIdx.x; F.nblk = gridDim.x;
    F.vcu = (F.nblk % 8 == 0) ? (F.bid % 8) * (F.nblk / 8) + F.bid / 8 : F.bid;
    volatile LAS unsigned* st = (volatile LAS unsigned*)(LAS unsigned char*)(lds_raw + LDS_BYTES - 64);
    if (F.tid < 16) st[F.tid] = 0u;
    __syncthreads();
    XcdBarrier bar; bar.bar = (unsigned*)(F.ws + WS_CTL) + 4096; bar.x = 0; bar.st = st;
    const int lo = args.ph_lo, hi = args.ph_hi;
    const bool fused = (hi - lo) > 1;
    if (fused) bar = xcd_barrier_post((unsigned*)(F.ws + WS_CTL) + 4096, st);
#ifdef ONLY_PHASE
#define IN(k) ((k) == ONLY_PHASE && lo <= (k) && (k) < hi)
#else
#define IN(k) (lo <= (k) && (k) < hi)
#endif
#define SEAM(k) do { if (IN(k) && IN((k) + 1)) { if ((k) == 0) cg::this_grid().sync(); else xcd_barrier(bar); } } while (0)
    bf16_t* Hb = (bf16_t*)(F.ws + WS_H);
#define PH(k, ...) if (IN(k)) for (int rep_ = 0; rep_ < (((PROBE_MASK >> (k)) & 1u) ? 2 : 1); ++rep_) { __VA_ARGS__; __syncthreads(); } SEAM(k)
    unsigned short* Xb = (unsigned short*)(F.ws + WS_X); const float* MODb = (const float*)(F.ws + WS_MOD);
    PH(0, for (int q_ = 0; q_ < ((PROBE_P0 & 1u) ? 2 : 1); ++q_) { p0_mod(args, F); __syncthreads(); }
          for (int q_ = 0; q_ < ((PROBE_P0 & 2u) ? 2 : 1); ++q_) { p0_weights(args, F); __syncthreads(); }
          for (int q_ = 0; q_ < ((PROBE_P0 & 4u) ? 2 : 1); ++q_) { p0_weff(args, F); __syncthreads(); }
          for (int q_ = 0; q_ < ((PROBE_P0 & 8u) ? 2 : 1); ++q_) { p0_tables(args, F); __syncthreads(); });
    PH(1, p_norm_rows(args, F, 0, 0, true, false));
    PH(2, gemm8e<EpiMlaDown, true>(F, Hb, F.ws + WS_WIN, 768, 1024, false, EpiMlaDown{F.ws + WS_CQ, F.ws + WS_CKV, (bf16_t*)(F.ws + WS_KR), (float*)(F.ws + WS_SSP)}, W8_SH_IN, 0));
#if GEMM_SELFTEST
    if (IN(3)) { gemm_selftest(F, 0); gemm_selftest(F, 6); }
#endif
    PH(3, p_mla_krope(args, F);
          gemm8<In8Bf16Rs, true>(F, F.ws + WS_CQ, F.ws + WS_WUQ, 1536, 512, false, In8Bf16Rs{(bf16_t*)(F.ws + WS_Q), 1536, (const float*)(F.ws + WS_SSP)}, false, W8_SH_UQ, 0);
          gemm8<In8KVRs, true>(F, F.ws + WS_CKV, F.ws + WS_WUKV, 2048, 256, false, In8KVRs{F.ws + WS_K, F.ws + WS_V, (const float*)(F.ws + WS_SSP)}, true, W8_SH_UKV, 0));
#if GEMM_SELFTEST
    if (IN(4)) { gemm_selftest(F, 1); gemm_selftest(F, 2); xcd_barrier(bar); }
#endif
    PH(4, p_attn_mla(args, F));
#if ATTN_SELFTEST & 1
    if (IN(5)) attn_selftest(F, 0);
#endif
    PH(5, gemm8<In8Resid, true>(F, F.ws + WS_O, F.ws + WS_WO0, 1024, 1024, false, In8Resid{F.x, F.ctx, Xb, MODb + 2 * 1024, true, GEMM_DBG}, false, W8_SH_O, O8_SH));
#if GEMM_SELFTEST
    if (IN(6)) gemm_selftest(F, 3);
#endif
    PH(6, p_norm_rows(args, F, 0, 1, false, false));
    PH(7, gemm8(F, Hb, (const bf16_t*)(F.ws + WS_WQ0), 2048, 1024, false, In8F16{(unsigned short*)(F.ws + WS_S), 2048}));
    PH(8, p_peer_topk(args, F, false));
    PH(9, p_exp_u(args, F, 0));
    PH(10, p_exp_w(args, F, 0));
    if (IN(11)) { p_exp_v(args, F, 0); } SEAM(11);
    PH(12, p_norm_rows(args, F, 1, 0, false, false));
    PH(13, gemm8<In8Bf16, true>(F, Hb, F.ws + WS_WQKV, 1536, 1024, false, In8Bf16{(bf16_t*)(F.ws + WS_RAW1), 1536}, false, W8_SH_QKV, 0));
#if GEMM_SELFTEST
    if (IN(14)) gemm_selftest(F, 4);
#endif
    PH(14, p_gqa_rows(args, F));
    PH(15, p_attn_gqa<0>(args, F, F.ws + WS_O));
#ifdef ATTN_PROBE_VAR
    if (IN(15)) { p_attn_gqa<ATTN_PROBE_VAR>(args, F, F.ws + WS_S); __syncthreads(); }
#endif
#if ATTN_SELFTEST & 2
    if (IN(16)) attn_selftest(F, 1);
#endif
    if (IN(16)) { gemm8<In8Resid, true>(F, F.ws + WS_O, F.ws + WS_WO1, 1024, 1024, true, In8Resid{F.x, F.ctx, Xb, MODb + 5 * 6144 + 2 * 1024, false, GEMM_DBG}, false, W8_SH_O, O8_SH); } SEAM(16);
#if GEMM_SELFTEST
    if (IN(17)) gemm_selftest(F, 5);
#endif
    PH(17, p_norm_rows(args, F, 1, 1, false, true));
    PH(18, gemm8(F, Hb, (const bf16_t*)(F.ws + WS_WQ1), 2048, 1024, true, In8F16{(unsigned short*)(F.ws + WS_S), 2048}));
    PH(19, p_peer_topk(args, F, true));
    PH(20, p_exp_u(args, F, 1));
    PH(21, p_exp_w(args, F, 1));
    if (IN(22)) { p_exp_v(args, F, 1); } SEAM(22);
    if (IN(23)) p_final_norm(args, F);
#undef PH
#undef IN
#undef SEAM
}

extern "C" void kernel_launch(void* const* d_in, const int* in_sizes, int n_in, void* d_out, int out_size, void* d_ws, size_t ws_size, hipStream_t stream) {
    static int grid = 0;
    if (grid == 0) {
        if (n_in != N_IN || in_sizes[0] != NB * SEQ * DM || out_size != NB * SEQ * DM || ws_size < WS_END) {
            fprintf(stderr, "kernel_launch: shape mismatch (n_in %d, in0 %d, out %d, ws %zu < %zu)\n", n_in, n_in > 0 ? in_sizes[0] : -1, out_size, ws_size, (size_t)WS_END); grid = -1; return; }
        int dev = 0, cus = 0, per_cu = 0;
        hipGetDevice(&dev); hipDeviceGetAttribute(&cus, hipDeviceAttributeMultiprocessorCount, dev);
        if (hipFuncSetAttribute((const void*)mega, hipFuncAttributeMaxDynamicSharedMemorySize, LDS_BYTES) != hipSuccess) { fprintf(stderr, "kernel_launch: hipFuncSetAttribute failed\n"); grid = -1; return; }
        if (hipOccupancyMaxActiveBlocksPerMultiprocessor(&per_cu, (const void*)mega, NTHREADS, LDS_BYTES) != hipSuccess || per_cu < 1) { fprintf(stderr, "kernel_launch: occupancy query failed (%d)\n", per_cu); (void)hipGetLastError(); grid = -1; return; }
        grid = cus * (per_cu > 1 ? 1 : per_cu);
    }
    if (grid < 0) return;
    hipMemsetAsync((char*)d_ws + WS_CTL, 0, 1 * MiB, stream);
    Args a{};
    for (int i = 0; i < N_IN; ++i) a.in[i] = (const float*)d_in[i];
    a.out = (float*)d_out; a.ws = (unsigned char*)d_ws;
#if MK_PER_PHASE
    for (int p = 0; p < N_PHASES; ++p) { a.ph_lo = p; a.ph_hi = p + 1; hipLaunchKernelGGL(mega, dim3(grid), dim3(NTHREADS), LDS_BYTES, stream, a); }
#else
    a.ph_lo = 0; a.ph_hi = N_PHASES;
    void* kargs[] = {&a};
    hipError_t e = hipLaunchCooperativeKernel((const void*)mega, dim3(grid), dim3(NTHREADS), kargs, LDS_BYTES, stream);
    if (e != hipSuccess) fprintf(stderr, "kernel_launch: cooperative launch failed: %s (grid %d)\n", hipGetErrorString(e), grid);
#endif
}
```

```cpp
#include <hip/hip_runtime.h>
#include <hip/hip_cooperative_groups.h>
#include <cstdio>
#include <cstdint>
namespace cg = cooperative_groups;

#ifndef PROBE_MASK
#define PROBE_MASK 0u
#endif
#ifndef PROBE_P0
#define PROBE_P0 0u
#endif
#ifndef ATTN_SELFTEST
#define ATTN_SELFTEST 0
#endif
#ifndef GEMM_SELFTEST
#define GEMM_SELFTEST 0
#endif
#ifndef MK_PER_PHASE
#define MK_PER_PHASE 0
#endif

typedef unsigned short bf16_t;
typedef short bf16x8 __attribute__((ext_vector_type(8)));
typedef short s16x4 __attribute__((ext_vector_type(4)));
typedef float f32x4 __attribute__((ext_vector_type(4)));
typedef float f32x2 __attribute__((ext_vector_type(2)));
typedef float f32x16 __attribute__((ext_vector_type(16)));
typedef unsigned u32x4 __attribute__((ext_vector_type(4)));
typedef unsigned u32x2 __attribute__((ext_vector_type(2)));
#define LAS __attribute__((address_space(3)))
#define SBAR() __builtin_amdgcn_sched_barrier(0)

__device__ __forceinline__ unsigned f2bf(float f) { unsigned u = __builtin_bit_cast(unsigned, f); return (u + 0x7fffu + ((u >> 16) & 1u)) >> 16; }
__device__ __forceinline__ unsigned pk2(float lo, float hi) { return f2bf(lo) | (f2bf(hi) << 16); }
typedef _Float16 f16x2_t __attribute__((ext_vector_type(2)));
__device__ __forceinline__ unsigned pkh2(float lo, float hi) { f32x2 v = {lo, hi}; return __builtin_bit_cast(unsigned, __builtin_convertvector(v, f16x2_t)); }
__device__ __forceinline__ float h2f_lo(unsigned w) { return (float)__builtin_bit_cast(_Float16, (unsigned short)(w & 0xffffu)); }
__device__ __forceinline__ float h2f_hi(unsigned w) { return (float)__builtin_bit_cast(_Float16, (unsigned short)(w >> 16)); }
__device__ __forceinline__ float bf2f(unsigned short h) { return __builtin_bit_cast(float, (unsigned)h << 16); }
__device__ __forceinline__ float bflo(unsigned w) { return __builtin_bit_cast(float, w << 16); }
__device__ __forceinline__ float bfhi(unsigned w) { return __builtin_bit_cast(float, w & 0xffff0000u); }
__device__ __forceinline__ unsigned cvtpk(float lo, float hi) { unsigned r; asm volatile("v_cvt_pk_bf16_f32 %0, %1, %2" : "=v"(r) : "v"(lo), "v"(hi)); return r; }
typedef int i32x8 __attribute__((ext_vector_type(8)));
__device__ __forceinline__ unsigned f8x4(float a, float b, float c, float d) { int w = __builtin_amdgcn_cvt_pk_fp8_f32(a, b, 0, false); w = __builtin_amdgcn_cvt_pk_fp8_f32(c, d, w, true); return (unsigned)w; }
template <int B> __device__ __forceinline__ float f8dec(unsigned w) { return __builtin_amdgcn_cvt_f32_fp8((int)w, B); }
#define WDPP(v, ctrl) __builtin_bit_cast(float, __builtin_amdgcn_update_dpp(0, __builtin_bit_cast(int, v), ctrl, 0xf, 0xf, false))
__device__ __forceinline__ float wave_sum(float v) {
    v += WDPP(v, 0xB1); v += WDPP(v, 0x4E); v += WDPP(v, 0x141); v += WDPP(v, 0x140);
    { auto rr = __builtin_amdgcn_permlane16_swap(__float_as_uint(v), __float_as_uint(v), false, false); v = __uint_as_float(rr[0]) + __uint_as_float(rr[1]); }
    { auto rr = __builtin_amdgcn_permlane32_swap(__float_as_uint(v), __float_as_uint(v), false, false); v = __uint_as_float(rr[0]) + __uint_as_float(rr[1]); }
    return v;
}
__device__ __forceinline__ float wave_max(float v) {
    v = fmaxf(v, WDPP(v, 0xB1)); v = fmaxf(v, WDPP(v, 0x4E)); v = fmaxf(v, WDPP(v, 0x141)); v = fmaxf(v, WDPP(v, 0x140));
    { auto rr = __builtin_amdgcn_permlane16_swap(__float_as_uint(v), __float_as_uint(v), false, false); v = fmaxf(__uint_as_float(rr[0]), __uint_as_float(rr[1])); }
    { auto rr = __builtin_amdgcn_permlane32_swap(__float_as_uint(v), __float_as_uint(v), false, false); v = fmaxf(__uint_as_float(rr[0]), __uint_as_float(rr[1])); }
    return v;
}

constexpr int DM = 1024, NB = 4, SEQ = 4096, CTXL = 256;
constexpr int RPB = SEQ + CTXL;
constexpr int R = NB * RPB;
constexpr float EPS = 1e-6f;
constexpr int NTHREADS = 512, NWAVES = 8;
constexpr int LDS_BYTES = 147456;

enum { I_X = 0, I_C, I_CTX, I_CCTX,
       I0_ADAW, I0_ADAB, I0_NMIX, I0_NFFN, I0_WIN, I0_QN, I0_WUQ, I0_KVN, I0_WUKV, I0_WO, I0_PWQ, I0_PK1, I0_PK2, I0_PU, I0_PV,
       I1_ADAW, I1_ADAB, I1_NMIX, I1_NFFN, I1_WQKV, I1_QN, I1_KN, I1_WO, I1_PWQ, I1_PK1, I1_PK2, I1_PU, I1_PV,
       I_NOUT, N_IN };

constexpr size_t MiB = 1u << 20;
constexpr size_t WS_CTL   = 0;
constexpr size_t WS_MOD   = 1 * MiB;
constexpr size_t WS_WIN   = 2 * MiB;
constexpr size_t WS_WUQ   = WS_WIN + 768 * 1024 * 2;
constexpr size_t WS_WUKV  = WS_WUQ + 1536 * 384 * 2;
constexpr size_t WS_WO0   = WS_WUKV + 2048 * 256 * 2;
constexpr size_t WS_WQ0   = WS_WO0 + 1024 * 1024 * 2;
constexpr size_t WS_KK0   = WS_WQ0 + 2048 * 1024 * 2;
constexpr size_t WS_WQKV  = WS_KK0 + 16 * 128 * 128 * 2;
constexpr size_t WS_WO1   = WS_WQKV + 1536 * 1024 * 2;
constexpr size_t WS_WQ1   = WS_WO1 + 1024 * 1024 * 2;
constexpr size_t WS_KK1   = WS_WQ1 + 2048 * 1024 * 2;
constexpr size_t WS_WEND  = WS_KK1 + 16 * 128 * 128 * 2;
static_assert(WS_WEND <= 24 * MiB, "weights region");
constexpr size_t WS_H     = 24 * MiB;
constexpr size_t WS_X     = WS_H + (size_t)R * 1024 * 2;
constexpr size_t WS_QKV   = WS_X + (size_t)R * 1024 * 4;
constexpr size_t WS_Q     = WS_QKV;
constexpr size_t WS_K     = WS_Q + (size_t)R * 1536 * 2;
constexpr size_t WS_V     = WS_K + (size_t)R * 1536 * 2;
constexpr size_t WS_S     = WS_QKV;
constexpr size_t WS_B     = WS_QKV + (size_t)R * 2048 * 4;
constexpr size_t WS_CQ    = WS_B;
constexpr size_t WS_CKV   = WS_CQ + (size_t)R * 384 * 2;
constexpr size_t WS_KR    = WS_CKV + (size_t)R * 256 * 2;
constexpr size_t WS_SSP   = WS_KR + (size_t)R * 64 * 2;
static_assert(WS_SSP + (size_t)R * 24 * 4 <= WS_B + 40 * MiB, "MLA latents inside region B");
constexpr size_t WS_O     = WS_B;
constexpr size_t WS_QP    = WS_B;
constexpr size_t WS_RAW1  = WS_B;
constexpr size_t WS_PK    = WS_B + (size_t)R * 2048 * 2;
constexpr size_t WS_TAB   = WS_PK + (size_t)R * 128 * 4;
constexpr size_t WS_PD    = WS_S;
constexpr size_t WS_WQ8   = WS_PD + (size_t)8 * R * 128 * 4;
constexpr size_t WS_WSC   = WS_WQ8 + (size_t)R * 128;
static_assert(WS_WSC + (size_t)R * 4 <= WS_B, "expert scratch inside the S region");
constexpr size_t WS_HQ    = WS_B + 40 * MiB;
constexpr size_t WS_HS    = WS_HQ + (size_t)R * 1024;
static_assert(WS_HS + (size_t)R * 4 <= WS_PK, "HQ inside region B");
constexpr size_t WS_TSC   = WS_TAB + (size_t)4 * 16384 * 1024;
constexpr size_t WS_END   = WS_TSC + (size_t)4 * 16384 * 4;
constexpr size_t WS_Q1    = WS_QKV;
constexpr size_t WS_K1    = WS_Q1 + (size_t)R * 1024 * 2;
constexpr size_t WS_V1    = WS_K1 + (size_t)R * 256 * 2;

#define XB_TMO      128
#define XB_XCNT(j)  (256  + 64 * (j))
#define XB_XSUB(j)  (1280 + 64 * (j))
#define XB_XGEN(j)  (2304 + 64 * (j))
#define XB_TOP      3328
#define XB_TOPGEN   3392
#define XCD_BAR_WORDS 3456
#define XB_SPIN_CAP (1u << 20)
__device__ __forceinline__ unsigned xb_ld(unsigned* p)              { return __hip_atomic_load(p, __ATOMIC_RELAXED, __HIP_MEMORY_SCOPE_AGENT); }
__device__ __forceinline__ unsigned xb_add(unsigned* p, unsigned v) { return __hip_atomic_fetch_add(p, v, __ATOMIC_RELAXED, __HIP_MEMORY_SCOPE_AGENT); }
__device__ __forceinline__ unsigned xb_xcc_id() { return (unsigned)__builtin_amdgcn_s_getreg((3 << 11) | 20) & 0xFu; }
#define XB_SPIN(cond, bar) do { unsigned _sp = 0; while (cond) { __builtin_amdgcn_s_sleep(1); \
    if ((++_sp & 255u) == 0u) { if (xb_ld(&(bar)[XB_TMO])) break; if (_sp > XB_SPIN_CAP) { atomicAdd(&(bar)[XB_TMO], 1u); break; } } } } while (0)
struct XcdBarrier { unsigned* bar; unsigned x; volatile LAS unsigned* st; };
__device__ __forceinline__ XcdBarrier xcd_barrier_post(unsigned* bar, volatile LAS unsigned* st) {
    XcdBarrier b; b.bar = bar; b.x = xb_xcc_id(); b.st = st;
    if (threadIdx.x == 0) (void)xb_add(&bar[XB_XCNT(b.x)], 1u);
    return b;
}
__device__ __forceinline__ void xcd_barrier_complete(unsigned* bar, unsigned x, unsigned& nloc, unsigned& nx) {
    const unsigned G = gridDim.x * gridDim.y * gridDim.z;
    unsigned sum, cnt, mine, sp = 0u;
    for (;;) {
        sum = 0u; cnt = 0u; mine = 0u;
#pragma unroll
        for (unsigned j = 0; j < 16; ++j) { const unsigned c = xb_ld(&bar[XB_XCNT(j)]); sum += c; cnt += (c > 0u) ? 1u : 0u; mine = (j == x) ? c : mine; }
        if (sum == G) break;
        __builtin_amdgcn_s_sleep(1);
        if ((++sp & 255u) == 0u) { if (xb_ld(&bar[XB_TMO])) break; if (sp > XB_SPIN_CAP) { atomicAdd(&bar[XB_TMO], 1u); break; } }
    }
    nloc = mine > 0u ? mine : 1u; nx = cnt > 0u ? cnt : 1u;
}
__device__ __forceinline__ void xcd_barrier(const XcdBarrier& b) {
    asm volatile("s_waitcnt vmcnt(0)" ::: "memory");
    __syncthreads();
    if (threadIdx.x == 0) {
        unsigned* bar = b.bar;
        __builtin_amdgcn_s_waitcnt(0);
        unsigned nloc = b.st[0], nx = b.st[1];
        if (nloc == 0u) { xcd_barrier_complete(bar, b.x, nloc, nx); b.st[0] = nloc; b.st[1] = nx; }
        const unsigned old = xb_add(&bar[XB_XSUB(b.x)], 1u);
        const unsigned gen = old / nloc;
        if (old + 1u == (gen + 1u) * nloc) {
            __builtin_amdgcn_fence(__ATOMIC_RELEASE, "agent");
            asm volatile("s_waitcnt vmcnt(0)" ::: "memory");
            const unsigned og = xb_add(&bar[XB_TOP], 1u);
            const unsigned tg = og / nx;
            if (og + 1u == (tg + 1u) * nx) xb_add(&bar[XB_TOPGEN], 1u);
            else XB_SPIN(xb_ld(&bar[XB_TOPGEN]) == tg, bar);
            __builtin_amdgcn_fence(__ATOMIC_ACQUIRE, "agent");
            xb_add(&bar[XB_XGEN(b.x)], 1u);
            asm volatile("s_waitcnt vmcnt(0)" ::: "memory");
        } else {
            XB_SPIN(xb_ld(&bar[XB_XGEN(b.x)]) == gen, bar);
            __builtin_amdgcn_fence(__ATOMIC_ACQUIRE, "agent");
            asm volatile("s_waitcnt vmcnt(0)" ::: "memory");
        }
    }
    __syncthreads();
}


struct Args { const float* in[N_IN]; float* out; unsigned char* ws; int ph_lo, ph_hi; };
static_assert(sizeof(Args) == (N_IN + 2) * 8 + 8, "Args has no padding");

struct Frame {
    const float* x; const float* ctx; float* out; unsigned char* ws; char* lds;
    int tid, lane, wave, bid, nblk, vcu;
};

__device__ __forceinline__ const float* xin_row(const Frame& F, int r) {
    const int b = r / RPB, j = r - b * RPB;
    return (j < CTXL) ? F.ctx + ((size_t)b * CTXL + j) * DM : F.x + ((size_t)b * SEQ + (j - CTXL)) * DM;
}
__device__ __forceinline__ int mod_index(int r) { const int b = r / RPB, j = r - b * RPB; return (j < CTXL) ? 4 : b; }
__device__ __forceinline__ bool is_ctx_row(int r) { return (r % RPB) < CTXL; }

__device__ __forceinline__ void p0_mod(const Args& A, const Frame& F) {
    float* sv = (float*)F.lds;
    float* red = sv + 5 * 1024;
    float* MOD = (float*)(F.ws + WS_MOD);
    bool have = false;
    for (int it = F.bid; it < 2 * 96; it += F.nblk) {
        if (!have) {
            for (int i = F.tid; i < 5 * 256; i += NTHREADS) { const int m = i >> 8, k4 = i & 255;
                const f32x4 c = (m < 4) ? *(const f32x4*)(A.in[I_C] + m * 1024 + 4 * k4) : *(const f32x4*)(A.in[I_CCTX] + 4 * k4);
                f32x4 o; o.x = c.x / (1.f + __expf(-c.x)); o.y = c.y / (1.f + __expf(-c.y)); o.z = c.z / (1.f + __expf(-c.z)); o.w = c.w / (1.f + __expf(-c.w));
                *(f32x4*)(sv + 4 * i) = o; }
            __syncthreads(); have = true;
        }
        const int l = it / 96, n = (it % 96) * 64 + F.lane;
        const float* W = A.in[l ? I1_ADAW : I0_ADAW]; const float* Bv = A.in[l ? I1_ADAB : I0_ADAB];
        float acc[5] = {0.f, 0.f, 0.f, 0.f, 0.f};
        const int k0 = F.wave * 128;
        const unsigned noff = (unsigned)n * 4u;
#define MOD_W16(o_) "+v"(wv[o_]), "+v"(wv[o_ + 1]), "+v"(wv[o_ + 2]), "+v"(wv[o_ + 3]), "+v"(wv[o_ + 4]), "+v"(wv[o_ + 5]), "+v"(wv[o_ + 6]), "+v"(wv[o_ + 7]), "+v"(wv[o_ + 8]), "+v"(wv[o_ + 9]), "+v"(wv[o_ + 10]), "+v"(wv[o_ + 11]), "+v"(wv[o_ + 12]), "+v"(wv[o_ + 13]), "+v"(wv[o_ + 14]), "+v"(wv[o_ + 15])
#pragma unroll 1
        for (int kb = k0; kb < k0 + 128; kb += 32) {
            float wv[32];
            const float* wbase = W + (size_t)kb * 6144;
#pragma unroll
            for (int i = 0; i < 32; ++i) { const float* wrow = wbase + (size_t)i * 6144; asm volatile("global_load_dword %0, %1, %2" : "=v"(wv[i]) : "v"(noff), "s"(wrow) : "memory"); }
            asm volatile("s_waitcnt vmcnt(0)" : MOD_W16(0)); asm volatile("" : MOD_W16(16));
#pragma unroll
            for (int i = 0; i < 32; ++i) {
#pragma unroll
                for (int m = 0; m < 5; ++m) acc[m] += sv[m * 1024 + kb + i] * wv[i]; } }
#undef MOD_W16
#pragma unroll
        for (int m = 0; m < 5; ++m) red[(F.wave * 5 + m) * 64 + F.lane] = acc[m];
        __syncthreads();
        if (F.tid < 320) { const int m = F.tid >> 6, ln = F.tid & 63; float s = 0.f;
#pragma unroll
            for (int w = 0; w < 8; ++w) s += red[(w * 5 + m) * 64 + ln];
            const int nn = (it % 96) * 64 + ln;
            MOD[((size_t)l * 5 + m) * 6144 + nn] = s + Bv[nn]; }
        __syncthreads();
    }
}
__device__ __forceinline__ void transpose_item(const float* W, int K, int N, bf16_t* WT, const float* gain, float* scr, int item, int lane) {
    const int nblk = N / 32, kb = item / nblk, nb = item % nblk, k0 = 64 * kb, n0 = 32 * nb;
#pragma unroll 8
    for (int i = 0; i < 32; ++i) { const int kk = 2 * i + (lane >> 5); float v = W[(size_t)(k0 + kk) * N + n0 + (lane & 31)]; if (gain) v *= gain[k0 + kk]; scr[kk * 33 + (lane & 31)] = v; }
    asm volatile("s_waitcnt lgkmcnt(0)" ::: "memory");
    const int c = lane & 7;
#pragma unroll
    for (int j = 0; j < 4; ++j) { const int n = (lane >> 3) + 8 * j; const float* s = scr + (8 * c) * 33 + n;
        u32x4 o; o.x = pk2(s[0 * 33], s[1 * 33]); o.y = pk2(s[2 * 33], s[3 * 33]); o.z = pk2(s[4 * 33], s[5 * 33]); o.w = pk2(s[6 * 33], s[7 * 33]);
        *(u32x4*)(WT + (size_t)(n0 + n) * K + k0 + 8 * c) = o; }
    asm volatile("s_waitcnt lgkmcnt(0)" ::: "memory");
}
__device__ __forceinline__ void transpose_item8(const float* W, int K, int N, unsigned char* WT, int KP, const float* gain, float scl, int item, int lane) {
    const int nblk = N / 64, kb = item / nblk, nb = item % nblk, k0 = 64 * kb, n = 64 * nb + lane;
    float v[64];
#pragma unroll
    for (int i = 0; i < 64; ++i) v[i] = W[(size_t)(k0 + i) * N + n];
#pragma unroll
    for (int i = 0; i < 64; ++i) v[i] *= gain ? scl * gain[k0 + i] : scl;
#pragma unroll
    for (int j = 0; j < 4; ++j) { u32x4 o;
#pragma unroll
        for (int w = 0; w < 4; ++w) o[w] = f8x4(v[16 * j + 4 * w], v[16 * j + 4 * w + 1], v[16 * j + 4 * w + 2], v[16 * j + 4 * w + 3]);
        *(u32x4*)(WT + (size_t)n * KP + k0 + 16 * j) = o; }
}
constexpr int W8_SH_IN = 5, W8_SH_UQ = 4, W8_SH_UKV = 4, W8_SH_O = 5, W8_SH_QKV = 5, O8_SH = 5;
__device__ __forceinline__ void p0_weights(const Args& A, const Frame& F) {
    const int gw = F.bid * NWAVES + F.wave, NGW = F.nblk * NWAVES;
    constexpr int T0 = 16 * 11, T1 = T0 + 6 * 24, T2 = T1 + 4 * 32, T3 = T2 + 16 * 16, T4 = T3 + 16 * 24, T5 = T4 + 16 * 16;
#define TJOB8(IN_, K_, N_, OFF_, KP_, GAIN_, SH_, BASE_) transpose_item8(A.in[IN_], K_, N_, F.ws + (OFF_), KP_, GAIN_, (float)(1 << (SH_)), it - (BASE_), F.lane)
    for (int it = gw; it < T5; it += NGW) {
        if (it < T0) TJOB8(I0_WIN, 1024, 704, WS_WIN, 1024, nullptr, W8_SH_IN, 0);
        else if (it < T1) TJOB8(I0_WUQ, 384, 1536, WS_WUQ, 512, A.in[I0_QN], W8_SH_UQ, T0);
        else if (it < T2) TJOB8(I0_WUKV, 256, 2048, WS_WUKV, 256, A.in[I0_KVN], W8_SH_UKV, T1);
        else if (it < T3) TJOB8(I0_WO, 1024, 1024, WS_WO0, 1024, nullptr, W8_SH_O, T2);
        else if (it < T4) TJOB8(I1_WQKV, 1024, 1536, WS_WQKV, 1024, nullptr, W8_SH_QKV, T3);
        else TJOB8(I1_WO, 1024, 1024, WS_WO1, 1024, nullptr, W8_SH_O, T4);
    }
#undef TJOB8
    { u32x4* z = (u32x4*)(F.ws + WS_WIN + (size_t)704 * 1024); const int n16 = 64 * 1024 / 16;
      for (int i = F.bid * NTHREADS + F.tid; i < n16; i += F.nblk * NTHREADS) z[i] = (u32x4){0u, 0u, 0u, 0u}; }
    { const int n16 = 1536 * 8;
      for (int i = F.bid * NTHREADS + F.tid; i < n16; i += F.nblk * NTHREADS) *(u32x4*)(F.ws + WS_WUQ + (size_t)(i >> 3) * 512 + 384 + 16 * (i & 7)) = (u32x4){0u, 0u, 0u, 0u}; }
}
__device__ __forceinline__ void p0_weff(const Args& A, const Frame& F) {
    float* kkT = (float*)F.lds; float* wqs = kkT + 128 * 129;
    const int tid = F.tid, lane = F.lane, w = F.wave;
    for (int item = F.bid; item < 512; item += F.nblk) {
        const int layer = item >> 8, z = (item >> 4) & 15, kc = item & 15, h = z >> 1;
        const float* kk = ((z & 1) ? (layer ? A.in[I1_PK2] : A.in[I0_PK2]) : (layer ? A.in[I1_PK1] : A.in[I0_PK1])) + (size_t)h * 16384;
        const float* wq = (layer ? A.in[I1_PWQ] : A.in[I0_PWQ]) + (size_t)(kc * 64) * 2048 + z * 128;
        bf16_t* WT = (bf16_t*)(F.ws + (layer ? WS_WQ1 : WS_WQ0));
        __syncthreads();
        { f32x4 kv[8], wv4[4];
#pragma unroll
          for (int i = 0; i < 8; ++i) kv[i] = *(const f32x4*)(kk + 4 * (tid + i * NTHREADS));
#pragma unroll
          for (int i = 0; i < 4; ++i) { const int e = 4 * (tid + i * NTHREADS); wv4[i] = *(const f32x4*)(wq + (size_t)(e >> 7) * 2048 + (e & 127)); }
#pragma unroll
          for (int i = 0; i < 8; ++i) { const int e = 4 * (tid + i * NTHREADS), key = e >> 7, d = e & 127; kkT[d * 129 + key] = kv[i].x; kkT[(d + 1) * 129 + key] = kv[i].y; kkT[(d + 2) * 129 + key] = kv[i].z; kkT[(d + 3) * 129 + key] = kv[i].w; }
#pragma unroll
          for (int i = 0; i < 4; ++i) { const int e = 4 * (tid + i * NTHREADS), k = e >> 7, d = e & 127;
              wqs[d * 68 + k] = wv4[i].x; wqs[(d + 1) * 68 + k] = wv4[i].y; wqs[(d + 2) * 68 + k] = wv4[i].z; wqs[(d + 3) * 68 + k] = wv4[i].w; } }
        __syncthreads();
        f32x2 acc[8];
#pragma unroll
        for (int j = 0; j < 8; ++j) acc[j] = (f32x2){0.f, 0.f};
#pragma unroll 2
        for (int d = 0; d < 128; ++d) { f32x2 a2; a2.x = kkT[d * 129 + lane]; a2.y = kkT[d * 129 + lane + 64];
            const f32x4 w0 = *(const f32x4*)(wqs + d * 68 + w * 8), w1 = *(const f32x4*)(wqs + d * 68 + w * 8 + 4);
            acc[0] = __builtin_elementwise_fma(a2, (f32x2){w0.x, w0.x}, acc[0]); acc[1] = __builtin_elementwise_fma(a2, (f32x2){w0.y, w0.y}, acc[1]);
            acc[2] = __builtin_elementwise_fma(a2, (f32x2){w0.z, w0.z}, acc[2]); acc[3] = __builtin_elementwise_fma(a2, (f32x2){w0.w, w0.w}, acc[3]);
            acc[4] = __builtin_elementwise_fma(a2, (f32x2){w1.x, w1.x}, acc[4]); acc[5] = __builtin_elementwise_fma(a2, (f32x2){w1.y, w1.y}, acc[5]);
            acc[6] = __builtin_elementwise_fma(a2, (f32x2){w1.z, w1.z}, acc[6]); acc[7] = __builtin_elementwise_fma(a2, (f32x2){w1.w, w1.w}, acc[7]); }
        u32x4 o0, o1;
        o0.x = pk2(acc[0].x, acc[1].x); o0.y = pk2(acc[2].x, acc[3].x); o0.z = pk2(acc[4].x, acc[5].x); o0.w = pk2(acc[6].x, acc[7].x);
        o1.x = pk2(acc[0].y, acc[1].y); o1.y = pk2(acc[2].y, acc[3].y); o1.z = pk2(acc[4].y, acc[5].y); o1.w = pk2(acc[6].y, acc[7].y);
        *(u32x4*)(WT + (size_t)(z * 128 + lane) * 1024 + kc * 64 + w * 8) = o0;
        *(u32x4*)(WT + (size_t)(z * 128 + lane + 64) * 1024 + kc * 64 + w * 8) = o1;
    }
    __syncthreads();
}

__device__ __forceinline__ void p0_tables(const Args& A, const Frame& F, int it_lo, int it_hi, int wg_lo) {
    if (wg_lo >= F.nblk) wg_lo = 0;
    if (F.bid < wg_lo) return;
    const int gw = (F.bid - wg_lo) * NWAVES + F.wave, NGW = (F.nblk - wg_lo) * NWAVES, lane = F.lane;
    unsigned char* TAB = F.ws + WS_TAB; float* TSC = (float*)(F.ws + WS_TSC);
    for (int it = it_lo + gw; it < it_hi; it += NGW) {
        const int t = it >> 12, row0 = (it & 4095) * 4;
        const float* src = (t == 0 ? A.in[I0_PU] : t == 1 ? A.in[I0_PV] : t == 2 ? A.in[I1_PU] : A.in[I1_PV]) + (size_t)row0 * 1024 + 4 * lane;
        f32x4 v[4][4];
#pragma unroll
        for (int rr = 0; rr < 4; ++rr)
#pragma unroll
            for (int j = 0; j < 4; ++j) v[rr][j] = __builtin_nontemporal_load((const f32x4*)(src + (size_t)rr * 1024 + 256 * j));
#pragma unroll
        for (int rr = 0; rr < 4; ++rr) {
            float am = 0.f;
#pragma unroll
            for (int j = 0; j < 4; ++j) am = fmaxf(am, fmaxf(fmaxf(fabsf(v[rr][j].x), fabsf(v[rr][j].y)), fmaxf(fabsf(v[rr][j].z), fabsf(v[rr][j].w))));
            am = wave_max(am);
            const int row = row0 + rr;
            float sc;
            if ((t & 1) == 0) {
                float ss = 0.f;
#pragma unroll
                for (int j = 0; j < 4; ++j) ss += (v[rr][j].x * v[rr][j].x + v[rr][j].y * v[rr][j].y) + (v[rr][j].z * v[rr][j].z + v[rr][j].w * v[rr][j].w);
                ss = wave_sum(ss);
                sc = am > 0.f ? fminf(am * (1.f / 7.f), 0.36f * sqrtf(ss * (1.f / 1024.f))) : 1.f;
                const float inv = am > 0.f ? 1.f / sc : 0.f;
#pragma unroll
                for (int j = 0; j < 4; ++j) {
                    const f32x4 y = v[rr][j] * inv;
                    const unsigned q0 = __builtin_bit_cast(unsigned, __builtin_amdgcn_fmed3f(y.x, -7.f, 7.f) + 12582912.f), q1 = __builtin_bit_cast(unsigned, __builtin_amdgcn_fmed3f(y.y, -7.f, 7.f) + 12582912.f),
                                   q2 = __builtin_bit_cast(unsigned, __builtin_amdgcn_fmed3f(y.z, -7.f, 7.f) + 12582912.f), q3 = __builtin_bit_cast(unsigned, __builtin_amdgcn_fmed3f(y.w, -7.f, 7.f) + 12582912.f);
                    *(unsigned short*)(TAB + (((size_t)t * 8 + j) * 16384 + row) * 128 + 2 * lane) = (unsigned short)((q0 & 15) | ((q1 & 15) << 4) | ((q2 & 15) << 8) | ((q3 & 15) << 12)); }
            } else {
                float ss = 0.f;
#pragma unroll
                for (int j = 0; j < 4; ++j) ss += (v[rr][j].x * v[rr][j].x + v[rr][j].y * v[rr][j].y) + (v[rr][j].z * v[rr][j].z + v[rr][j].w * v[rr][j].w);
                ss = wave_sum(ss);
                sc = am > 0.f ? fminf(am * (1.f / 7.f), 0.36f * sqrtf(ss * (1.f / 1024.f))) : 1.f;
                const float inv = am > 0.f ? 1.f / sc : 0.f;
#pragma unroll
                for (int j = 0; j < 4; ++j) {
                    const f32x4 y = v[rr][j] * inv; const float mg = (lane & 1) ? 12582912.f : 12582920.f;
                    const unsigned q0 = __builtin_bit_cast(unsigned, __builtin_amdgcn_fmed3f(y.x, -7.f, 7.f) + mg), q1 = __builtin_bit_cast(unsigned, __builtin_amdgcn_fmed3f(y.y, -7.f, 7.f) + mg),
                                   q2 = __builtin_bit_cast(unsigned, __builtin_amdgcn_fmed3f(y.z, -7.f, 7.f) + mg), q3 = __builtin_bit_cast(unsigned, __builtin_amdgcn_fmed3f(y.w, -7.f, 7.f) + mg);
                    const int ob = 0;
                    const unsigned mine = ((unsigned)((q0 + ob) & 15) | ((unsigned)((q1 + ob) & 15) << 8) | ((unsigned)((q2 + ob) & 15) << 16) | ((unsigned)((q3 + ob) & 15) << 24)) << ((lane & 1) ? 4 : 0);
                    const unsigned other = (unsigned)__builtin_amdgcn_update_dpp(0, (int)mine, 0xB1, 0xf, 0xf, false);
                    if ((lane & 1) == 0) *(unsigned*)(TAB + (((size_t)t * 8 + j) * 16384 + row) * 128 + 4 * (lane >> 1)) = mine | other; }
            }
            if (lane == 0) TSC[t * 16384 + row] = sc;
        }
    }
}

__device__ __forceinline__ void norm_mod_store(const f32x4 (&v)[4], float rinv, const float* g, const float* sh, const float* sc, bf16_t* orow, int lane) {
#pragma unroll
    for (int j = 0; j < 4; ++j) { const int c = 4 * lane + 256 * j;
        const f32x4 gg = *(const f32x4*)(g + c), s1 = *(const f32x4*)(sc + c), s0 = *(const f32x4*)(sh + c);
        const f32x4 y = (v[j] * rinv * gg) * (s1 + 1.f) + s0;
        u32x2 o; o.x = pk2(y.x, y.y); o.y = pk2(y.z, y.w); *(u32x2*)(orow + c) = o; }
}
__device__ __forceinline__ void norm_mod_store8(const f32x4 (&v)[4], float rinv, const float* g, const float* sh, const float* sc, unsigned char* orow, int lane) {
#pragma unroll
    for (int j = 0; j < 4; ++j) { const int c = 4 * lane + 256 * j;
        const f32x4 gg = *(const f32x4*)(g + c), s1 = *(const f32x4*)(sc + c), s0 = *(const f32x4*)(sh + c);
        const f32x4 y = (v[j] * rinv * gg) * (s1 + 1.f) + s0;
        *(unsigned*)(orow + c) = f8x4(y.x, y.y, y.z, y.w); }
}
__device__ __forceinline__ int tok_row(int layer, int n);
__device__ __forceinline__ void norm_row_out(const Frame& F, const f32x4 (&v)[4], float rinv, const float* g, const float* mm, int r, int which) {
    if (!which) { norm_mod_store8(v, rinv, g, mm, mm + 1024, F.ws + WS_H + (size_t)r * DM, F.lane); return; }
    norm_mod_store(v, rinv, g, mm, mm + 1024, (bf16_t*)(F.ws + WS_H) + (size_t)r * DM, F.lane);
    if (which) {
        f32x4 y[4]; float am = 0.f;
#pragma unroll
        for (int j = 0; j < 4; ++j) { const int c = 4 * F.lane + 256 * j; y[j] = (v[j] * rinv * *(const f32x4*)(g + c)) * (*(const f32x4*)(mm + 1024 + c) + 1.f) + *(const f32x4*)(mm + c);
            am = fmaxf(am, fmaxf(fmaxf(fabsf(y[j].x), fabsf(y[j].y)), fmaxf(fabsf(y[j].z), fabsf(y[j].w)))); }
        am = wave_max(am);
        const float inv = am > 0.f ? 119.f / am : 0.f;
#pragma unroll
        for (int j = 0; j < 4; ++j) { const int h0 = (int)rintf(y[j].x * inv), h1 = (int)rintf(y[j].y * inv), h2 = (int)rintf(y[j].z * inv), h3 = (int)rintf(y[j].w * inv);
            const unsigned hh = (unsigned)(((h0 + 8) >> 4) & 15) | ((unsigned)(((h1 + 8) >> 4) & 15) << 4) | ((unsigned)(((h2 + 8) >> 4) & 15) << 8) | ((unsigned)(((h3 + 8) >> 4) & 15) << 12);
            const unsigned hl = (unsigned)(h0 & 15) | ((unsigned)(h1 & 15) << 4) | ((unsigned)(h2 & 15) << 8) | ((unsigned)(h3 & 15) << 12);
            const bool odd = (F.lane & 1) != 0;
            const unsigned recv = (unsigned)__builtin_amdgcn_update_dpp(0, (int)(odd ? hh : hl), 0xB1, 0xf, 0xf, false);
            *(unsigned*)(F.ws + WS_HQ + (size_t)r * DM + 256 * j + 4 * F.lane) = odd ? (recv | (hl << 16)) : (hh | (recv << 16)); }
        if (F.lane == 0) ((float*)(F.ws + WS_HS))[r] = am > 0.f ? am * (1.f / 119.f) : 1.f;
    }
}
__device__ __forceinline__ void p_norm_rows(const Args& A, const Frame& F, int layer, int which, bool from_input, bool skip_ctx) {
    const int gw = F.bid * NWAVES + F.wave, NGW = F.nblk * NWAVES;
    const float* g = A.in[layer ? (which ? I1_NFFN : I1_NMIX) : (which ? I0_NFFN : I0_NMIX)];
    const float* MOD = (const float*)(F.ws + WS_MOD) + (size_t)layer * 5 * 6144;
    const unsigned short* X = (const unsigned short*)(F.ws + WS_X);
    const int ntok = skip_ctx ? NB * SEQ : R;
    for (int n = gw; n < ntok; n += 2 * NGW) {
        const bool has1 = (n + NGW) < ntok;
        const int r0 = skip_ctx ? tok_row(1, n) : n, r1 = has1 ? (skip_ctx ? tok_row(1, n + NGW) : n + NGW) : r0;
        f32x4 v0[4], v1[4]; float s0 = 0.f, s1 = 0.f;
        if (from_input) { const float* x0 = xin_row(F, r0); const float* x1 = xin_row(F, r1);
#pragma unroll
            for (int j = 0; j < 4; ++j) { v0[j] = *(const f32x4*)(x0 + 4 * F.lane + 256 * j); v1[j] = *(const f32x4*)(x1 + 4 * F.lane + 256 * j); } }
        else {
#pragma unroll
            for (int j = 0; j < 4; ++j) { const u32x2 a = *(const u32x2*)(X + (size_t)r0 * DM + 4 * F.lane + 256 * j), b = *(const u32x2*)(X + (size_t)r1 * DM + 4 * F.lane + 256 * j);
                v0[j] = (f32x4){h2f_lo(a.x), h2f_hi(a.x), h2f_lo(a.y), h2f_hi(a.y)}; v1[j] = (f32x4){h2f_lo(b.x), h2f_hi(b.x), h2f_lo(b.y), h2f_hi(b.y)}; } }
#pragma unroll
        for (int j = 0; j < 4; ++j) { s0 += (v0[j].x * v0[j].x + v0[j].y * v0[j].y) + (v0[j].z * v0[j].z + v0[j].w * v0[j].w); s1 += (v1[j].x * v1[j].x + v1[j].y * v1[j].y) + (v1[j].z * v1[j].z + v1[j].w * v1[j].w); }
        const float ri0 = rsqrtf(wave_sum(s0) * (1.f / DM) + EPS), ri1 = rsqrtf(wave_sum(s1) * (1.f / DM) + EPS);
        norm_row_out(F, v0, ri0, g, MOD + (size_t)mod_index(r0) * 6144 + (which ? 3 * 1024 : 0), r0, which);
        if (has1) norm_row_out(F, v1, ri1, g, MOD + (size_t)mod_index(r1) * 6144 + (which ? 3 * 1024 : 0), r1, which);
    }
}

namespace pg8 {
#define PG8_LAS __attribute__((address_space(3)))
typedef unsigned short bf16_t;
typedef short bf16x8 __attribute__((ext_vector_type(8)));
typedef float f32x4 __attribute__((ext_vector_type(4)));
typedef unsigned u32x4 __attribute__((ext_vector_type(4)));
typedef int pg8i4 __attribute__((ext_vector_type(4)));
constexpr int BM = 256, BK = 64, HALF = 128, HTB = HALF * BK * 2  , STAGE_BYTES = 8 * HTB, NXCD = 8, WGM = 8;

__host__ __device__ __forceinline__ int lds_byte(int r, int c) { const int st = (r >> 4) * 2 + (c >> 5), rr = r & 15, cc = c & 31, ob = rr * 64 + cc * 2; return st * 1024 + (ob ^ (((ob >> 9) & 1) << 5)); }
__host__ __device__ __forceinline__ void stage_rc(int b, int& R, int& C) { const int st = b / 1024, sb = b % 1024, swz = sb ^ (((sb >> 9) & 1) << 5); R = (st >> 1) * 16 + swz / 64; C = (st & 1) * 32 + (swz % 64) / 2; }
__host__ __device__ __forceinline__ int perm32(int rho) { const int n = rho >> 4, i = rho & 15; return 8 * (i >> 2) + 4 * n + (i & 3); }

struct Unit { int pm, pn; };
struct Gemm { const bf16_t* A; const bf16_t* Bt; int M, N, K; int sa = 0x7f7f7f7f, sb = 0x7f7f7f7f; };

struct StaticOrder {
    int nM, nN, nwg, G, c;
    __host__ __device__ void init(int M, int N, int G_, int c_) { nM = M / BM; nN = N / BM; nwg = nM * nN; G = G_; c = c_; }
    __host__ __device__ bool next(int i, Unit& u) const {
        const long L = (long)i * G + c; if (L >= nwg) return false;
        int wgid = (int)L; { const int q = nwg / NXCD, r = nwg % NXCD, xcd = wgid % NXCD, off = wgid / NXCD; wgid = (xcd < r ? xcd * (q + 1) : r * (q + 1) + (xcd - r) * q) + off; }
        const int nig = WGM * nN, gid = wgid / nig, fm = gid * WGM, gsz = (nM - fm) < WGM ? (nM - fm) : WGM;
        u.pm = fm + ((wgid % nig) % gsz); u.pn = (wgid % nig) / gsz; return true;
    }
    __device__ __forceinline__ void a_ready(const Unit&) const {}
    __device__ __forceinline__ void done(const Unit&) const {}
};

template <class Epi, class Sched, bool ALIGN_EPI = false, bool SP2 = false, bool F8 = false>
__device__ __forceinline__ void gemm_phase(PG8_LAS unsigned char* lds, const Gemm g, const Sched& S, const Epi& E) {
    const int tid = threadIdx.x, wid = __builtin_amdgcn_readfirstlane(tid >> 6), lane = tid & 63, wr = wid >> 2, wc = wid & 3, fr = lane & 15, fq = lane >> 4;
    const int vsa = g.sa, vsb = g.sb;
    const int K = g.K, KB = F8 ? K : 2 * K  , nt = KB / (BK * 2);
    unsigned voffA[2], voffB[2];
#pragma unroll
    for (int i = 0; i < 2; ++i) { int R, C; stage_rc(tid * 16 + i * 8192, R, C); const int Rb = Epi::PERM ? ((R & ~31) + perm32(R & 31)) : R;
        voffA[i] = (unsigned)(R * KB + C * 2); voffB[i] = (unsigned)(Rb * KB + C * 2); }
    const size_t kstep = (size_t)(BK * 2);
    const size_t hstep = (size_t)HALF * KB;
    const size_t tstep = 2 * hstep;
    const unsigned ldsw = (unsigned)wid * 1024u;
    const int aoff = lds_byte(wr * 64 + fr, fq * 8), boff = lds_byte(wc * 32 + fr, fq * 8);
#define PG8_SA(b, h) (((b) * 2 + (h)) * HTB)
#define PG8_SB(b, h) ((4 + (b) * 2 + (h)) * HTB)
#define PG8_STAGE(bufoff, gbase, voff) do { _Pragma("unroll") for (int _i = 0; _i < 2; ++_i) \
        __builtin_amdgcn_global_load_lds((const unsigned*)((const char*)(gbase) + (voff)[_i]), (PG8_LAS unsigned*)(lds + (bufoff) + ldsw + _i * 8192), 16, 0, 0); } while (0)
#define PG8_LDA(dst, b, h) do { if constexpr (F8) { _Pragma("unroll") for (int m = 0; m < 4; ++m) { const pg8i4 x0_ = *(const PG8_LAS pg8i4*)(lds + PG8_SA(b, h) + aoff + m * 2048), x1_ = *(const PG8_LAS pg8i4*)(lds + PG8_SA(b, h) + aoff + m * 2048 + 1024); dst##8[m] = __builtin_shufflevector(x0_, x1_, 0, 1, 2, 3, 4, 5, 6, 7); } } \
    else { _Pragma("unroll") for (int m = 0; m < 4; ++m) _Pragma("unroll") for (int k = 0; k < 2; ++k) dst[m][k] = *(const PG8_LAS bf16x8*)(lds + PG8_SA(b, h) + aoff + m * 2048 + k * 1024); } } while (0)
#define PG8_LDB(dst, b, h) do { if constexpr (F8) { _Pragma("unroll") for (int n = 0; n < 2; ++n) { const pg8i4 x0_ = *(const PG8_LAS pg8i4*)(lds + PG8_SB(b, h) + boff + n * 2048), x1_ = *(const PG8_LAS pg8i4*)(lds + PG8_SB(b, h) + boff + n * 2048 + 1024); dst##8[n] = __builtin_shufflevector(x0_, x1_, 0, 1, 2, 3, 4, 5, 6, 7); } } \
    else { _Pragma("unroll") for (int n = 0; n < 2; ++n) _Pragma("unroll") for (int k = 0; k < 2; ++k) dst[n][k] = *(const PG8_LAS bf16x8*)(lds + PG8_SB(b, h) + boff + n * 2048 + k * 1024); } } while (0)
#define PG8_MMA(ai, bj, At, Bt) do { __builtin_amdgcn_s_setprio(1); _Pragma("unroll") for (int m = 0; m < 4; ++m) _Pragma("unroll") for (int n = 0; n < 2; ++n) { \
        if constexpr (F8) asm volatile("v_mfma_scale_f32_16x16x128_f8f6f4 %0, %1, %2, %0, %3, %4 op_sel_hi:[0,0,0]" : "+v"(acc[ai][bj][m][n]) : "v"(Bt##8[n]), "v"(At##8[m]), "v"(vsa), "v"(vsb));        \
        else { _Pragma("unroll") for (int k = 0; k < 2; ++k) acc[ai][bj][m][n] = __builtin_amdgcn_mfma_f32_16x16x32_bf16(Bt[n][k], At[m][k], acc[ai][bj][m][n], 0, 0, 0); } } __builtin_amdgcn_s_setprio(0); } while (0)
#define PG8_WAIT_V(n) asm volatile("s_waitcnt vmcnt(" #n ")" ::: "memory")
#define PG8_WAIT_L(n) asm volatile("s_waitcnt lgkmcnt(" #n ")" ::: "memory")
#define PG8_BAR __builtin_amdgcn_s_barrier()
#define PG8_SCHED __builtin_amdgcn_sched_barrier(0)
    Unit cur, nxt; int ui = 0;
    if (!S.next(0, cur)) return;
    f32x4 acc[2][2][4][2];
#pragma unroll
    for (int a = 0; a < 2; ++a)
#pragma unroll
        for (int b = 0; b < 2; ++b)
#pragma unroll
            for (int m = 0; m < 4; ++m)
#pragma unroll
                for (int n = 0; n < 2; ++n) acc[a][b][m][n] = (f32x4){0.f, 0.f, 0.f, 0.f};
    bf16x8 At[4][2], B0[2][2], B1[2][2]; typedef int pg8i8 __attribute__((ext_vector_type(8))); pg8i8 At8[4], B08[2], B18[2];
    const char* cA = (const char*)g.A + (size_t)cur.pm * tstep; const char* cB = (const char*)g.Bt + (size_t)cur.pn * tstep;
    S.a_ready(cur);
    if constexpr (SP2) {
        PG8_STAGE(PG8_SB(0, 0), cB, voffB); PG8_STAGE(PG8_SB(0, 1), cB + hstep, voffB); PG8_STAGE(PG8_SA(0, 0), cA, voffA); PG8_STAGE(PG8_SA(0, 1), cA + hstep, voffA);
        if (wr == 1) PG8_BAR;
        PG8_WAIT_V(2); PG8_BAR;
        PG8_STAGE(PG8_SB(1, 0), cB + kstep, voffB); PG8_STAGE(PG8_SA(1, 0), cA + kstep, voffA); PG8_STAGE(PG8_SB(1, 1), cB + hstep + kstep, voffB);
        PG8_WAIT_V(6); PG8_BAR;
    } else {
        PG8_STAGE(PG8_SB(0, 0), cB, voffB); PG8_STAGE(PG8_SA(0, 0), cA, voffA); PG8_STAGE(PG8_SB(0, 1), cB + hstep, voffB); PG8_STAGE(PG8_SA(0, 1), cA + hstep, voffA);
        if (wr == 1) PG8_BAR;
        PG8_WAIT_V(4); PG8_BAR;
        PG8_STAGE(PG8_SB(1, 0), cB + kstep, voffB); PG8_STAGE(PG8_SA(1, 0), cA + kstep, voffA); PG8_STAGE(PG8_SB(1, 1), cB + hstep + kstep, voffB);
        PG8_WAIT_V(6); PG8_BAR;
    }
    for (;;) {
        const bool has_next = S.next(ui + 1, nxt);
        const char* nA = has_next ? (const char*)g.A + (size_t)nxt.pm * tstep : cA; const char* nB = has_next ? (const char*)g.Bt + (size_t)nxt.pn * tstep : cB;
        for (int t = 0; t < nt; t += 2) {
            const bool last = (t == nt - 2);
            const char* a1 = cA + (size_t)(t + 1) * kstep;
            const char* a2 = last ? nA : cA + (size_t)(t + 2) * kstep; const char* b2 = last ? nB : cB + (size_t)(t + 2) * kstep;
            const char* a3 = a2 + kstep; const char* b3 = b2 + kstep;
            if (last && has_next) S.a_ready(nxt);
            if constexpr (SP2) {
            PG8_LDB(B0, 0, 0); PG8_LDB(B1, 0, 1); PG8_SCHED; PG8_LDA(At, 0, 0); PG8_STAGE(PG8_SA(1, 1), a1 + hstep, voffA);
            PG8_WAIT_V(8); PG8_WAIT_L(0); PG8_BAR; PG8_MMA(0, 0, At, B0); PG8_MMA(0, 1, At, B1); PG8_BAR; PG8_SCHED;
            PG8_LDA(At, 0, 1); PG8_STAGE(PG8_SB(0, 0), b2, voffB); PG8_STAGE(PG8_SB(0, 1), b2 + hstep, voffB); PG8_STAGE(PG8_SA(0, 0), a2, voffA);
            PG8_WAIT_V(8); PG8_WAIT_L(0); PG8_BAR; PG8_MMA(1, 0, At, B0); PG8_MMA(1, 1, At, B1); PG8_BAR; PG8_SCHED;
            PG8_LDB(B0, 1, 0); PG8_LDB(B1, 1, 1); PG8_SCHED; PG8_LDA(At, 1, 0); PG8_STAGE(PG8_SA(0, 1), a2 + hstep, voffA);
            PG8_WAIT_V(8); PG8_WAIT_L(0); PG8_BAR; PG8_MMA(0, 0, At, B0); PG8_MMA(0, 1, At, B1); PG8_BAR; PG8_SCHED;
            PG8_LDA(At, 1, 1); PG8_STAGE(PG8_SB(1, 0), b3, voffB); PG8_STAGE(PG8_SB(1, 1), b3 + hstep, voffB); PG8_STAGE(PG8_SA(1, 0), a3, voffA);
            PG8_WAIT_V(8); PG8_WAIT_L(0); PG8_BAR; PG8_MMA(1, 0, At, B0); PG8_MMA(1, 1, At, B1); PG8_BAR; PG8_SCHED;
            } else {
            PG8_LDB(B0, 0, 0); PG8_SCHED; PG8_LDA(At, 0, 0); PG8_STAGE(PG8_SA(1, 1), a1 + hstep, voffA);
            PG8_WAIT_L(8); PG8_BAR; PG8_WAIT_L(0); PG8_MMA(0, 0, At, B0); PG8_BAR; PG8_SCHED;
            PG8_LDB(B1, 0, 1); PG8_STAGE(PG8_SB(0, 0), b2, voffB);
            PG8_BAR; PG8_WAIT_L(0); PG8_MMA(0, 1, At, B1); PG8_BAR;
            PG8_LDA(At, 0, 1); PG8_STAGE(PG8_SA(0, 0), a2, voffA);
            PG8_BAR; PG8_WAIT_L(0); PG8_MMA(1, 0, At, B0); PG8_BAR; PG8_SCHED;
            PG8_STAGE(PG8_SB(0, 1), b2 + hstep, voffB);
            PG8_WAIT_V(6); PG8_BAR; PG8_MMA(1, 1, At, B1); PG8_BAR;
            PG8_LDB(B0, 1, 0); PG8_SCHED; PG8_LDA(At, 1, 0); PG8_STAGE(PG8_SA(0, 1), a2 + hstep, voffA);
            PG8_WAIT_L(8); PG8_BAR; PG8_WAIT_L(0); PG8_MMA(0, 0, At, B0); PG8_BAR; PG8_SCHED;
            PG8_LDB(B1, 1, 1); PG8_STAGE(PG8_SB(1, 0), b3, voffB);
            PG8_BAR; PG8_WAIT_L(0); PG8_MMA(0, 1, At, B1); PG8_BAR;
            PG8_LDA(At, 1, 1); PG8_STAGE(PG8_SA(1, 0), a3, voffA);
            PG8_BAR; PG8_WAIT_L(0); PG8_MMA(1, 0, At, B0); PG8_BAR; PG8_SCHED;
            PG8_STAGE(PG8_SB(1, 1), b3 + hstep, voffB);
            PG8_WAIT_V(6); PG8_BAR; PG8_MMA(1, 1, At, B1); PG8_BAR;
            }
        }
        if constexpr (ALIGN_EPI) { if (wr == 0) PG8_BAR; }
        if constexpr (!Epi::AFTER_DRAIN) { if constexpr (F8) { asm volatile("s_nop 15\n\ts_nop 15" ::: "memory");
            int t2_ = threadIdx.x; asm volatile("" : "+v"(t2_)); const int w2_ = t2_ >> 6, l2_ = t2_ & 63; E(acc, cur, w2_ >> 2, w2_ & 3, l2_ & 15, l2_ >> 4); }
            else E(acc, cur, wr, wc, fr, fq); S.done(cur); }
        if (!has_next) break;
#pragma unroll
        for (int a = 0; a < 2; ++a)
#pragma unroll
            for (int b = 0; b < 2; ++b)
#pragma unroll
                for (int m = 0; m < 4; ++m)
#pragma unroll
                    for (int n = 0; n < 2; ++n) acc[a][b][m][n] = (f32x4){0.f, 0.f, 0.f, 0.f};
        cur = nxt; cA = nA; cB = nB; ++ui;
        if constexpr (ALIGN_EPI) { if (wr == 1) PG8_BAR; }
    }
    PG8_WAIT_V(0);
    if constexpr (!ALIGN_EPI) { if (wr == 0) PG8_BAR; }
    PG8_BAR;
    if constexpr (Epi::AFTER_DRAIN) { E.fused(acc, cur, wr, wc, fr, fq, lds, wid, lane); S.done(cur); }
#undef PG8_SA
#undef PG8_SB
#undef PG8_STAGE
#undef PG8_LDA
#undef PG8_LDB
#undef PG8_MMA
#undef PG8_WAIT_V
#undef PG8_WAIT_L
#undef PG8_BAR
#undef PG8_SCHED
}
}

template <class Inner> struct EpiTile { static constexpr bool PERM = true, AFTER_DRAIN = false; Inner in;
    __device__ __forceinline__ void operator()(const pg8::f32x4 (&acc)[2][2][4][2], const pg8::Unit& u, int wr, int wc, int fr, int fq) const {
#pragma unroll
        for (int ai = 0; ai < 2; ++ai)
#pragma unroll
            for (int m = 0; m < 4; ++m) { const int row = u.pm * 256 + ai * 128 + wr * 64 + m * 16 + fr;
#pragma unroll
                for (int bj = 0; bj < 2; ++bj) in(row, u.pn * 256 + bj * 128 + wc * 32 + 8 * fq, acc[ai][bj][m][0], acc[ai][bj][m][1]); }
    } };
struct In8Bf16 { bf16_t* C; int ldc;
    __device__ __forceinline__ void operator()(int row, int col, f32x4 a, f32x4 b) const { u32x4 o; o.x = cvtpk(a.x, a.y); o.y = cvtpk(a.z, a.w); o.z = cvtpk(b.x, b.y); o.w = cvtpk(b.z, b.w); *(u32x4*)(C + (size_t)row * ldc + col) = o; } };
struct In8KV { bf16_t* Kb; bf16_t* Vb;
    __device__ __forceinline__ void operator()(int row, int col, f32x4 a, f32x4 b) const { const int h = col >> 8, c = col & 255; u32x4 o; o.x = cvtpk(a.x, a.y); o.y = cvtpk(a.z, a.w); o.z = cvtpk(b.x, b.y); o.w = cvtpk(b.z, b.w);
        bf16_t* p = (c < 128) ? Kb + (size_t)row * 1536 + h * 192 + c : Vb + (size_t)row * 1024 + h * 128 + (c - 128);
        *(u32x4*)p = o; } };
__device__ __forceinline__ size_t s_off(int row, int head, int list, int c16, int half) { return ((((((size_t)(row >> 3) * 2 + list) * 8 + c16) * 2 + half) * 64) + head * 8 + (row & 7)) * 16; }
struct In8F16 { unsigned short* C; int ldc;
    __device__ __forceinline__ void operator()(int row, int col, f32x4 a, f32x4 b) const { u32x4 o; o.x = pkh2(a.x, a.y); o.y = pkh2(a.z, a.w); o.z = pkh2(b.x, b.y); o.w = pkh2(b.z, b.w);
        *(u32x4*)((unsigned char*)C + s_off(row, col >> 8, (col >> 7) & 1, (col >> 4) & 7, (col >> 3) & 1)) = o; } };
struct In8F32 { float* C; int ldc;
    __device__ __forceinline__ void operator()(int row, int col, f32x4 a, f32x4 b) const { float* p = C + (size_t)row * ldc + col; *(f32x4*)p = a; *(f32x4*)(p + 4) = b; } };
struct In8Resid { const float* x; const float* ctx; unsigned short* X; const float* gate; bool from_input; bf16_t* dbg = nullptr;
    __device__ __forceinline__ void operator()(int row, int col, f32x4 a, f32x4 b) const {
        const int bb = row / RPB, j = row - bb * RPB; unsigned short* xo = X + (size_t)row * DM + col;
        f32x4 x0, x1;
        if (from_input) { const float* xi = ((j < CTXL) ? ctx + ((size_t)bb * CTXL + j) * DM : x + ((size_t)bb * SEQ + (j - CTXL)) * DM) + col; x0 = *(const f32x4*)xi; x1 = *(const f32x4*)(xi + 4); }
        else { const u32x4 w = *(const u32x4*)xo; x0 = (f32x4){h2f_lo(w.x), h2f_hi(w.x), h2f_lo(w.y), h2f_hi(w.y)}; x1 = (f32x4){h2f_lo(w.z), h2f_hi(w.z), h2f_lo(w.w), h2f_hi(w.w)}; }
#if GEMM_SELFTEST
        if (dbg && col < 256) { u32x4 d; d.x = pk2(a.x, a.y); d.y = pk2(a.z, a.w); d.z = pk2(b.x, b.y); d.w = pk2(b.z, b.w); *(u32x4*)(dbg + (size_t)row * 256 + col) = d; }
#endif
        const float* g = gate + (size_t)((j < CTXL) ? 4 : bb) * 6144 + col;
        x0 += *(const f32x4*)g * a; x1 += *(const f32x4*)(g + 4) * b;
        u32x4 o; o.x = pkh2(x0.x, x0.y); o.y = pkh2(x0.z, x0.w); o.z = pkh2(x1.x, x1.y); o.w = pkh2(x1.z, x1.w); *(u32x4*)xo = o; } };
struct EpiMlaDown { static constexpr bool PERM = true, AFTER_DRAIN = false; unsigned char* CQ8; unsigned char* CKV8; bf16_t* KR; float* SSP;
    __device__ __forceinline__ void operator()(const pg8::f32x4 (&acc)[2][2][4][2], const pg8::Unit& u, int wr, int wc, int fr, int fq) const {
#pragma unroll
        for (int ai = 0; ai < 2; ++ai)
#pragma unroll
            for (int m = 0; m < 4; ++m) { const int row = u.pm * 256 + ai * 128 + wr * 64 + m * 16 + fr;
#pragma unroll
                for (int bj = 0; bj < 2; ++bj) { const int col = u.pn * 256 + bj * 128 + wc * 32 + 8 * fq; const f32x4 a = acc[ai][bj][m][0], b = acc[ai][bj][m][1];
                    const int cls = (u.pn * 2 + bj);
                    if (cls < 5) { float sq = (a.x * a.x + a.y * a.y) + (a.z * a.z + a.w * a.w) + (b.x * b.x + b.y * b.y) + (b.z * b.z + b.w * b.w);
                        sq += __shfl_xor(sq, 16); sq += __shfl_xor(sq, 32);
                        u32x2 o8; o8.x = f8x4(a.x, a.y, a.z, a.w); o8.y = f8x4(b.x, b.y, b.z, b.w);
                        if (cls < 3) *(u32x2*)(CQ8 + (size_t)row * 512 + col) = o8; else *(u32x2*)(CKV8 + (size_t)row * 256 + (col - 384)) = o8;
                        if (fq == 0) SSP[(size_t)row * 24 + cls * 4 + wc] = sq; }
                    else if (col < 704) { u32x4 o; o.x = cvtpk(a.x, a.y); o.y = cvtpk(a.z, a.w); o.z = cvtpk(b.x, b.y); o.w = cvtpk(b.z, b.w); *(u32x4*)(KR + (size_t)row * 64 + (col - 640)) = o; }
                    else *(u32x4*)(CQ8 + (size_t)row * 512 + 384 + 2 * (col - 704)) = (u32x4){0u, 0u, 0u, 0u}; } }
    } };
struct In8Bf16Rs { bf16_t* C; int ldc; const float* ssp;
    __device__ __forceinline__ void operator()(int row, int col, f32x4 a, f32x4 b) const { const f32x4 s0 = *(const f32x4*)(ssp + (size_t)row * 24), s1 = *(const f32x4*)(ssp + (size_t)row * 24 + 4), s2 = *(const f32x4*)(ssp + (size_t)row * 24 + 8);
        const float ssum = (((s0.x + s0.y) + (s0.z + s0.w)) + ((s1.x + s1.y) + (s1.z + s1.w))) + ((s2.x + s2.y) + (s2.z + s2.w));
        const float rs = rsqrtf(ssum * (1.f / 384.f) + EPS); a *= rs; b *= rs;
        u32x4 o; o.x = cvtpk(a.x, a.y); o.y = cvtpk(a.z, a.w); o.z = cvtpk(b.x, b.y); o.w = cvtpk(b.z, b.w); *(u32x4*)(C + (size_t)row * ldc + col) = o; } };
struct In8KVRs { unsigned char* K8; unsigned char* V8; const float* ssp;
    __device__ __forceinline__ void operator()(int row, int col, f32x4 a, f32x4 b) const { const f32x4 s0 = *(const f32x4*)(ssp + (size_t)row * 24 + 12), s1 = *(const f32x4*)(ssp + (size_t)row * 24 + 16);
        const float ssum = ((s0.x + s0.y) + (s0.z + s0.w)) + ((s1.x + s1.y) + (s1.z + s1.w));
        const float rs = rsqrtf(ssum * (1.f / 256.f) + EPS); a *= rs; b *= rs;
        const int h = col >> 8, c = col & 255;
        if (c < 128) { u32x2 o; o.x = f8x4(a.x, a.y, a.z, a.w); o.y = f8x4(b.x, b.y, b.z, b.w); *(u32x2*)(K8 + (size_t)row * 1536 + h * 192 + c) = o; }
        else { u32x2 o; o.x = f8x4(a.x, a.y, a.z, a.w); o.y = f8x4(b.x, b.y, b.z, b.w); *(u32x2*)(V8 + (size_t)row * 1024 + h * 128 + (c - 128)) = o; } } };
struct RowSched { pg8::StaticOrder so; bool latent_only;
    __device__ __forceinline__ void init(int N, int G, int c, bool lat) { latent_only = lat; so.init(lat ? NB * SEQ : R, N, G, c); }
    __device__ __forceinline__ bool next(int i, pg8::Unit& u) const { if (!so.next(i, u)) return false; if (latent_only) u.pm = (u.pm >> 4) * 17 + 1 + (u.pm & 15); return true; }
    __device__ __forceinline__ void a_ready(const pg8::Unit&) const {}
    __device__ __forceinline__ void done(const pg8::Unit&) const {} };
template <class Inner, bool F8 = false> __device__ __forceinline__ void gemm8(const Frame& F, const void* Ap, const void* Bt, int N, int K, bool latent_only, const Inner& in, bool reverse = false, int sa = 0, int sb = 0) {
    asm volatile("" : "+s"(K));
    pg8::Gemm g{(const bf16_t*)Ap, (const bf16_t*)Bt, R, N, K, 0x01010101 * (127 - sa), 0x01010101 * (127 - sb)}; RowSched S; S.init(N, F.nblk, reverse ? F.nblk - 1 - F.bid : F.bid, latent_only);
    EpiTile<Inner> E{in};
    pg8::gemm_phase<EpiTile<Inner>, RowSched, true, true, F8>((PG8_LAS unsigned char*)F.lds, g, S, E);
}

template <class Epi, bool F8 = false> __device__ __forceinline__ void gemm8e(const Frame& F, const void* Ap, const void* Bt, int N, int K, bool latent_only, const Epi& E, int sa = 0, int sb = 0) {
    asm volatile("" : "+s"(K));
    pg8::Gemm g{(const bf16_t*)Ap, (const bf16_t*)Bt, R, N, K, 0x01010101 * (127 - sa), 0x01010101 * (127 - sb)}; RowSched S; S.init(N, F.nblk, F.bid, latent_only);
    pg8::gemm_phase<Epi, RowSched, true, true, F8>((PG8_LAS unsigned char*)F.lds, g, S, E);
}

struct GemmDesc { const bf16_t* A; int lda; long sA; const bf16_t* Bt; int ldb; long sB; int M, N, K, nz; };
template <class Epi>
__device__ __forceinline__ void gemm_simple(const Frame& F, const GemmDesc& g, const Epi& epi, bool skip_ctx) {
    const int wm = F.wave >> 1, wn = F.wave & 1, fr = F.lane & 15, fq = F.lane >> 4;
    const int tM = g.M / 128, tN = g.N / 128, per = tM * tN, total = per * g.nz;
    for (int u = F.bid; u < total; u += F.nblk) {
        const int z = u / per, uu = u - z * per, tm = uu / tN, tn = uu - tm * tN;
        if (skip_ctx && ((tm * 128) % RPB) < CTXL) continue;
        const int row0 = tm * 128 + wm * 32, col0 = tn * 128 + wn * 64;
        const bf16_t* ap = g.A + z * g.sA + (size_t)(row0 + fr) * g.lda + fq * 8;
        const bf16_t* bp = g.Bt + z * g.sB + (size_t)(col0 + fr) * g.ldb + fq * 8;
        f32x4 acc[2][4];
#pragma unroll
        for (int mi = 0; mi < 2; ++mi)
#pragma unroll
            for (int ni = 0; ni < 4; ++ni) acc[mi][ni] = (f32x4){0.f, 0.f, 0.f, 0.f};
        for (int k0 = 0; k0 < g.K; k0 += 32) {
            bf16x8 a[2], b[4];
#pragma unroll
            for (int mi = 0; mi < 2; ++mi) a[mi] = *(const bf16x8*)(ap + (size_t)mi * 16 * g.lda + k0);
#pragma unroll
            for (int ni = 0; ni < 4; ++ni) b[ni] = *(const bf16x8*)(bp + (size_t)ni * 16 * g.ldb + k0);
#pragma unroll
            for (int mi = 0; mi < 2; ++mi)
#pragma unroll
                for (int ni = 0; ni < 4; ++ni) acc[mi][ni] = __builtin_amdgcn_mfma_f32_16x16x32_bf16(b[ni], a[mi], acc[mi][ni], 0, 0, 0);
        }
#pragma unroll
        for (int mi = 0; mi < 2; ++mi)
#pragma unroll
            for (int ni = 0; ni < 4; ++ni) epi(z, row0 + mi * 16 + fr, col0 + ni * 16 + fq * 4, acc[mi][ni]);
    }
}
struct EpiBf16 { bf16_t* C; int ldc;
    __device__ __forceinline__ void operator()(int, int row, int col, f32x4 v) const { u32x2 o; o.x = pk2(v.x, v.y); o.y = pk2(v.z, v.w); *(u32x2*)(C + (size_t)row * ldc + col) = o; } };
struct EpiKV { bf16_t* Kb; bf16_t* Vb;
    __device__ __forceinline__ void operator()(int, int row, int col, f32x4 v) const { const int h = col >> 8, c = col & 255; u32x2 o; o.x = pk2(v.x, v.y); o.y = pk2(v.z, v.w);
        if (c < 128) *(u32x2*)(Kb + (size_t)row * 1536 + h * 192 + c) = o; else *(u32x2*)(Vb + (size_t)row * 1024 + h * 128 + (c - 128)) = o; } };
struct EpiF32Z { float* C; int ldc;
    __device__ __forceinline__ void operator()(int z, int row, int col, f32x4 v) const { *(f32x4*)(C + (size_t)row * ldc + z * 128 + col) = v; } };
struct EpiResid { const Frame* F; const float* gate; bool from_input;
    __device__ __forceinline__ void operator()(int, int row, int col, f32x4 v) const {
        float* X = (float*)(F->ws + WS_X) + (size_t)row * DM + col;
        const float* xi = from_input ? xin_row(*F, row) + col : X;
        const f32x4 g = *(const f32x4*)(gate + (size_t)mod_index(row) * 6144 + col);
        *(f32x4*)X = *(const f32x4*)xi + g * v; } };

__device__ __forceinline__ void rope_angles(int r, int& prow, int& pcol) { const int t = (r % RPB) - CTXL; prow = t >> 6; pcol = t & 63; }
__device__ __forceinline__ void p_mla_krope(const Args& A, const Frame& F) {
    const int gw = F.bid * NWAVES + F.wave, NGW = F.nblk * NWAVES, lane = F.lane;
    const bf16_t* KR = (const bf16_t*)(F.ws + WS_KR); unsigned char* K8 = F.ws + WS_K;
    const float invf = __powf(10000.f, -(float)(lane & 15) * (1.f / 16.f));
    for (int r = gw; r < R; r += NGW) {
        float kr = bf2f(KR[(size_t)r * 64 + lane]);
        if (!is_ctx_row(r)) {
            int prow, pcol; rope_angles(r, prow, pcol);
            const float ang = (float)((lane & 32) ? pcol : prow) * invf;
            const float cs = cosf(ang), sn = sinf(ang);
            const float partner = __shfl_xor(kr, 16);
            kr = kr * cs + ((lane & 16) ? partner : -partner) * sn;
        }
        const unsigned char kb = (unsigned char)(f8x4(kr, kr, kr, kr) & 0xffu);
#pragma unroll
        for (int h = 0; h < 8; ++h) K8[(size_t)r * 1536 + h * 192 + 128 + lane] = kb;
    }
}
__device__ __forceinline__ float row16_sum(float v) { v += WDPP(v, 0xB1); v += WDPP(v, 0x4E); v += WDPP(v, 0x141); v += WDPP(v, 0x140); return v; }
__device__ __forceinline__ void p_gqa_rows(const Args& A, const Frame& F) {
    const int gw = F.bid * NWAVES + F.wave, NGW = F.nblk * NWAVES, lane = F.lane, c16 = lane & 15, hrow = lane >> 4;
    const bf16_t* RAW = (const bf16_t*)(F.ws + WS_RAW1); bf16_t* Q1 = (bf16_t*)(F.ws + WS_Q1); unsigned char* K18 = F.ws + WS_K1; unsigned char* V18 = F.ws + WS_V1;
    float qg[8], kg[8], invf[8];
#pragma unroll
    for (int e = 0; e < 8; ++e) { qg[e] = A.in[I1_QN][8 * c16 + e]; kg[e] = A.in[I1_KN][8 * c16 + e]; invf[e] = __powf(10000.f, -(float)(8 * (c16 & 3) + e) * (1.f / 32.f)); }
    const bool colaxis = (c16 & 8) != 0, hi32 = (c16 & 4) != 0;
    for (int r = gw; r < R; r += NGW) {
        const bool ctx = is_ctx_row(r);
        const bf16_t* a = RAW + (size_t)r * 1536 + 8 * lane;
        u32x4 ch[3];
#pragma unroll
        for (int j = 0; j < 3; ++j) ch[j] = (ctx && j < 2) ? (u32x4){0u, 0u, 0u, 0u} : *(const u32x4*)(a + 512 * j);
        float cs[8], sn[8];
        { int prow = 0, pcol = 0; if (!ctx) rope_angles(r, prow, pcol); const float pos = (float)(colaxis ? pcol : prow);
#pragma unroll
          for (int e = 0; e < 8; ++e) { const float ang = pos * invf[e]; cs[e] = ctx ? 1.f : __cosf(ang); sn[e] = ctx ? 0.f : __sinf(ang); } }
#pragma unroll
        for (int j = 0; j < 3; ++j) {
            if (ctx && j < 2) continue;
            const bool isv = (j == 2) && (hrow >= 2);
            float x[8];
#pragma unroll
            for (int d = 0; d < 4; ++d) { x[2 * d] = bflo(ch[j][d]); x[2 * d + 1] = bfhi(ch[j][d]); }
            float sq = 0.f;
#pragma unroll
            for (int e = 0; e < 8; ++e) sq += x[e] * x[e];
            const float rinv = rsqrtf(row16_sum(sq) * (1.f / 128.f) + EPS);
            u32x4 o;
            float y[8];
#pragma unroll
            for (int e = 0; e < 8; ++e) y[e] = x[e] * rinv * (j < 2 ? qg[e] : kg[e]);
            u32x4 yp; yp.x = pk2(y[0], y[1]); yp.y = pk2(y[2], y[3]); yp.z = pk2(y[4], y[5]); yp.w = pk2(y[6], y[7]);
            float pr[8];
#pragma unroll
            for (int d = 0; d < 4; ++d) { const float lo = __shfl_xor(y[2 * d], 4), hi2 = __shfl_xor(y[2 * d + 1], 4); pr[2 * d] = lo; pr[2 * d + 1] = hi2; }
            float z[8];
#pragma unroll
            for (int e = 0; e < 8; ++e) z[e] = y[e] * cs[e] + (hi32 ? pr[e] : -pr[e]) * sn[e];
            o.x = pk2(z[0], z[1]); o.y = pk2(z[2], z[3]); o.z = pk2(z[4], z[5]); o.w = pk2(z[6], z[7]);
            (void)yp;
            if (isv) o = ch[j];
            if (j < 2) *(u32x4*)(Q1 + (size_t)r * 1024 + 512 * j + 8 * lane) = o;
            else if (hrow < 2) { u32x2 o8; o8.x = f8x4(z[0], z[1], z[2], z[3]); o8.y = f8x4(z[4], z[5], z[6], z[7]); *(u32x2*)(K18 + (size_t)r * 256 + 8 * lane) = o8; }
            else { u32x2 o8; o8.x = f8x4(x[0], x[1], x[2], x[3]); o8.y = f8x4(x[4], x[5], x[6], x[7]); *(u32x2*)(V18 + (size_t)r * 256 + 8 * (lane - 32)) = o8; }
        }
    }
}

__device__ __forceinline__ int crow(int r, int hi) { return (r & 3) + 8 * (r >> 2) + 4 * hi; }
__device__ __forceinline__ int v_st(int k, int c) { const int kk = (k & ~0xC) | ((k & 4) << 1) | ((k & 8) >> 1); return ((kk >> 3) * 4 + (c >> 5)) * 512 + ((kk & 7) * 32 + (c & 31)) * 2; }
__device__ __forceinline__ int v_rd_base(int lane) { return ((lane & 3) << 3) | (((lane >> 2) & 3) << 6) | (((lane >> 4) & 1) << 5) | (((lane >> 5) & 1) << 8); }
constexpr int v_rd_off(int d0, int ks, int half) { return d0 * 512 + ks * 4096 + half * 2048; }
template <int OFF> __device__ __forceinline__ s16x4 tr_read(int vb) { s16x4 r; asm volatile("ds_read_b64_tr_b16 %0, %1 offset:%2" : "=&v"(r) : "v"(vb), "i"(OFF) : "memory"); return r; }
template <int D0> __device__ __forceinline__ void pv_one(f32x16& od, int vb, bf16x8 pa0, bf16x8 pa1, bf16x8 pa2, bf16x8 pa3) {
    const s16x4 l0 = tr_read<v_rd_off(D0, 0, 0)>(vb), h0 = tr_read<v_rd_off(D0, 0, 1)>(vb), l1 = tr_read<v_rd_off(D0, 1, 0)>(vb), h1 = tr_read<v_rd_off(D0, 1, 1)>(vb);
    const s16x4 l2 = tr_read<v_rd_off(D0, 2, 0)>(vb), h2 = tr_read<v_rd_off(D0, 2, 1)>(vb), l3 = tr_read<v_rd_off(D0, 3, 0)>(vb), h3 = tr_read<v_rd_off(D0, 3, 1)>(vb);
    asm volatile("s_waitcnt lgkmcnt(0)" ::: "memory"); SBAR();
#define PK(L, H) (bf16x8){L[0], L[1], L[2], L[3], H[0], H[1], H[2], H[3]}
    od = __builtin_amdgcn_mfma_f32_32x32x16_bf16(pa0, PK(l0, h0), od, 0, 0, 0);
    od = __builtin_amdgcn_mfma_f32_32x32x16_bf16(pa1, PK(l1, h1), od, 0, 0, 0);
    od = __builtin_amdgcn_mfma_f32_32x32x16_bf16(pa2, PK(l2, h2), od, 0, 0, 0);
    od = __builtin_amdgcn_mfma_f32_32x32x16_bf16(pa3, PK(l3, h3), od, 0, 0, 0);
#undef PK
}
__device__ __forceinline__ void pv_d0(f32x16* o, int vb, bf16x8 pa0, bf16x8 pa1, bf16x8 pa2, bf16x8 pa3) {
    pv_one<0>(o[0], vb, pa0, pa1, pa2, pa3); pv_one<1>(o[1], vb, pa0, pa1, pa2, pa3); pv_one<2>(o[2], vb, pa0, pa1, pa2, pa3); pv_one<3>(o[3], vb, pa0, pa1, pa2, pa3);
}
constexpr float ATT_THR = 8.f;
__device__ __forceinline__ void partialSM(f32x16& p0, f32x16& p1, float& m_reg, float& mn, float& alpha, float C, float thr_raw) {
    float pmax = p0[0];
#pragma unroll
    for (int r = 1; r < 16; ++r) pmax = fmaxf(pmax, p0[r]);
#pragma unroll
    for (int r = 0; r < 16; ++r) pmax = fmaxf(pmax, p1[r]);
    { auto rr = __builtin_amdgcn_permlane32_swap(__float_as_uint(pmax), __float_as_uint(pmax), false, false);
      pmax = fmaxf(__uint_as_float(rr[0]), __uint_as_float(rr[1])); }
    if (__builtin_expect(__all(pmax - m_reg <= thr_raw), 1)) { mn = m_reg; alpha = 1.f; }
    else { mn = fmaxf(m_reg, pmax); alpha = __builtin_amdgcn_exp2f((m_reg - mn) * C); m_reg = mn; }
    const float mnC = -mn * C;
#pragma unroll
    for (int r = 0; r < 16; ++r) p0[r] = fmaf(p0[r], C, mnC);
#pragma unroll
    for (int r = 0; r < 16; ++r) p1[r] = fmaf(p1[r], C, mnC);
#pragma unroll
    for (int r = 0; r < 16; ++r) p0[r] = __builtin_amdgcn_exp2f(p0[r]);
}
__device__ __forceinline__ void finishSM(f32x16& p0, f32x16& p1, float alpha, float& l_reg, bf16x8& pa0, bf16x8& pa1, bf16x8& pa2, bf16x8& pa3) {
#pragma unroll
    for (int r = 0; r < 16; ++r) p1[r] = __builtin_amdgcn_exp2f(p1[r]);
    float ps = 0;
#pragma unroll
    for (int r = 0; r < 16; ++r) ps += p0[r];
#pragma unroll
    for (int r = 0; r < 16; ++r) ps += p1[r];
    { auto rr = __builtin_amdgcn_permlane32_swap(__float_as_uint(ps), __float_as_uint(ps), false, false);
      ps = __uint_as_float(rr[0]) + __uint_as_float(rr[1]); }
    l_reg = l_reg * alpha + ps;
#define PK4(P, BASE, OUT) do { unsigned a0 = cvtpk(P[BASE + 0], P[BASE + 1]), a1 = cvtpk(P[BASE + 2], P[BASE + 3]);   \
    unsigned b0 = cvtpk(P[BASE + 4], P[BASE + 5]), b1 = cvtpk(P[BASE + 6], P[BASE + 7]);                              \
    auto r0 = __builtin_amdgcn_permlane32_swap(a0, b0, false, false); auto r1 = __builtin_amdgcn_permlane32_swap(a1, b1, false, false); \
    u32x4 w = {r0[0], r1[0], r0[1], r1[1]}; OUT = *reinterpret_cast<bf16x8*>(&w); } while (0)
    PK4(p0, 0, pa0); PK4(p0, 8, pa1); PK4(p1, 0, pa2); PK4(p1, 8, pa3);
#undef PK4
}
template <int DQK> __device__ __forceinline__ void qkt(f32x16& p0, f32x16& p1, const char* Ks, const bf16x8* qr, int r32, int hi) {
    constexpr int KP = DQK * 2 + 16;
    p0 = f32x16{}; p1 = f32x16{};
#pragma unroll
    for (int d0 = 0; d0 < DQK / 16; ++d0) { const int cb = (d0 * 16 + hi * 8) * 2;
        const bf16x8 b0 = *reinterpret_cast<const bf16x8*>(Ks + r32 * KP + cb);
        const bf16x8 b1 = *reinterpret_cast<const bf16x8*>(Ks + (32 + r32) * KP + cb);
        p0 = __builtin_amdgcn_mfma_f32_32x32x16_bf16(b0, qr[d0], p0, 0, 0, 0);
        p1 = __builtin_amdgcn_mfma_f32_32x32x16_bf16(b1, qr[d0], p1, 0, 0, 0); }
}
template <int DQK> constexpr int att_lds_bytes() { return 2 * 64 * 128 * 2 + 2 * 64 * (DQK * 2 + 16) + NWAVES * 64 * 4; }
template <int DQK, int LDQ, int LDK, int LDV, int LDO>
__device__ __forceinline__ void attn_body(const bf16_t* __restrict__ Qb, const bf16_t* __restrict__ Kh, const bf16_t* __restrict__ Vh, bf16_t* __restrict__ Ob, int seq, float scale, char* lds) {
    constexpr int KP = DQK * 2 + 16, SHM_V = 64 * 128 * 2, SHM_K = 64 * KP, ND = DQK / 16, CH = DQK / 8, NKL = CH * 64 / NTHREADS;
    const float C = scale * 1.4426950408889634f, thr_raw = ATT_THR / scale;
    const int tid = threadIdx.x, wid = tid >> 6, lane = tid & 63, r32 = lane & 31, hi = lane >> 5;
    char* V_lds = lds; char* K_lds = lds + 2 * SHM_V;
    float* wsf = (float*)(lds + 2 * SHM_V + 2 * SHM_K) + wid * 64; float* li_l = wsf; float* al_l = wsf + 32;
    float m_reg = -1e30f, l_reg = 0; f32x16 o[4] = {}; bf16x8 qr[ND];
    const bf16_t* Qw = Qb + (long)(wid * 32 + r32) * LDQ + hi * 8;
#pragma unroll
    for (int d0 = 0; d0 < ND; ++d0) qr[d0] = *reinterpret_cast<const bf16x8*>(Qw + d0 * 16);
    const int sr = tid >> 4, sc = (tid & 15) * 8, vst0 = v_st(sr, sc), vst1 = v_st(32 + sr, sc);
    static_assert(DQK == 128, "double-pipelined body: 128-wide q.k only");
    const int vb0 = (int)(uintptr_t)V_lds + v_rd_base(lane);
    bf16x8 vs0, vs1, ks[NKL];
#define SLOAD(k0) do { vs0 = *reinterpret_cast<const bf16x8*>(&Vh[(long)((k0) + sr) * LDV + sc]); vs1 = *reinterpret_cast<const bf16x8*>(&Vh[(long)((k0) + 32 + sr) * LDV + sc]); \
    _Pragma("unroll") for (int i_ = 0; i_ < NKL; ++i_) ks[i_] = *reinterpret_cast<const bf16x8*>(&Kh[(long)((k0) + sr + 32 * i_) * LDK + sc]); } while (0)
#define SWRITE(b) do { *(bf16x8*)(V_lds + (b) * SHM_V + vst0) = vs0; *(bf16x8*)(V_lds + (b) * SHM_V + vst1) = vs1; \
    _Pragma("unroll") for (int i_ = 0; i_ < NKL; ++i_) *(bf16x8*)(K_lds + (b) * SHM_K + (sr + 32 * i_) * KP + sc * 2) = ks[i_]; } while (0)
#define RESC(a) do { if (__any((a) < 1.f)) { if (hi == 0) al_l[r32] = (a); asm volatile("s_waitcnt lgkmcnt(0)" ::: "memory"); \
    _Pragma("unroll") for (int d = 0; d < 4; ++d) _Pragma("unroll") for (int r = 0; r < 16; ++r) o[d][r] *= al_l[crow(r, hi)]; } } while (0)
    f32x16 pA0, pA1, pB0, pB1; float mnA, mnB, alA, alB; bf16x8 pa0, pa1, pa2, pa3; const int NT = seq / 64;
    SLOAD(0); asm volatile("s_waitcnt vmcnt(0)" ::: "memory"); SWRITE(0); __syncthreads();
    qkt<DQK>(pA0, pA1, K_lds, qr, r32, hi); partialSM(pA0, pA1, m_reg, mnA, alA, C, thr_raw);
    SLOAD(64);
    asm volatile("s_waitcnt vmcnt(0)" ::: "memory"); SWRITE(1); __syncthreads();
    for (int j = 1; j + 1 < NT; j += 2) {
        SBAR(); qkt<DQK>(pB0, pB1, K_lds + SHM_K, qr, r32, hi);
        finishSM(pA0, pA1, alA, l_reg, pa0, pa1, pa2, pa3); SBAR();
        SLOAD((j + 1) * 64); SBAR();
        pv_d0(o, vb0, pa0, pa1, pa2, pa3); partialSM(pB0, pB1, m_reg, mnB, alB, C, thr_raw);
        __syncthreads(); asm volatile("s_waitcnt vmcnt(0)" ::: "memory"); SWRITE(0);
        RESC(alB); __syncthreads();
        SBAR(); qkt<DQK>(pA0, pA1, K_lds, qr, r32, hi);
        finishSM(pB0, pB1, alB, l_reg, pa0, pa1, pa2, pa3); SBAR();
        SLOAD((j + 2) * 64); SBAR();
        pv_d0(o, vb0 + SHM_V, pa0, pa1, pa2, pa3); partialSM(pA0, pA1, m_reg, mnA, alA, C, thr_raw);
        __syncthreads(); asm volatile("s_waitcnt vmcnt(0)" ::: "memory"); SWRITE(1);
        RESC(alA); __syncthreads();
    }
    SBAR(); qkt<DQK>(pB0, pB1, K_lds + SHM_K, qr, r32, hi);
    finishSM(pA0, pA1, alA, l_reg, pa0, pa1, pa2, pa3); SBAR();
    pv_d0(o, vb0, pa0, pa1, pa2, pa3); partialSM(pB0, pB1, m_reg, mnB, alB, C, thr_raw);
    __syncthreads(); RESC(alB);
    finishSM(pB0, pB1, alB, l_reg, pa0, pa1, pa2, pa3); SBAR();
    pv_d0(o, vb0 + SHM_V, pa0, pa1, pa2, pa3);
    if (hi == 0) li_l[r32] = l_reg; asm volatile("s_waitcnt lgkmcnt(0)" ::: "memory");
    float rli[16];
#pragma unroll
    for (int r = 0; r < 16; ++r) rli[r] = __builtin_amdgcn_rcpf(li_l[crow(r, hi)]);
    bf16_t* Ow = Ob + (long)(wid * 32) * LDO;
#pragma unroll
    for (int r = 0; r < 16; ++r) { const int orow = crow(r, hi);
#pragma unroll
        for (int d0 = 0; d0 < 4; ++d0) Ow[(long)orow * LDO + d0 * 32 + r32] = (bf16_t)f2bf(o[d0][r] * rli[r]); }
    __syncthreads();
#undef SLOAD
#undef SWRITE
#undef RESC
}
template <int DQK, int LDQ, int LDK, int LDV, int LDO>
__device__ __forceinline__ void attn_body_single(const bf16_t* __restrict__ Qb, const bf16_t* __restrict__ Kh, const bf16_t* __restrict__ Vh, bf16_t* __restrict__ Ob, int seq, float scale, char* lds, int rope_t0) {
    constexpr int KP = DQK * 2 + 16, SHM_V = 64 * 128 * 2, SHM_K = 64 * KP, ND = DQK / 16, CH = DQK / 8, NKL = CH * 64 / NTHREADS;
    const float C = scale * 1.4426950408889634f, thr_raw = ATT_THR / scale;
    const int tid = threadIdx.x, wid = tid >> 6, lane = tid & 63, r32 = lane & 31, hi = lane >> 5;
    char* V_lds = lds; char* K_lds = lds + 2 * SHM_V;
    float* wsf = (float*)(lds + 2 * SHM_V + 2 * SHM_K) + wid * 64; float* li_l = wsf; float* al_l = wsf + 32;
    float m_reg = -1e30f, l_reg = 0; f32x16 o[4] = {}; bf16x8 qr[ND];
    const bf16_t* Qw = Qb + (long)(wid * 32 + r32) * LDQ + hi * 8;
#pragma unroll
    for (int d0 = 8; d0 < ND; ++d0) qr[d0] = *reinterpret_cast<const bf16x8*>(Qw + d0 * 16);
    if constexpr (DQK == 192) {
        if (rope_t0 >= 0) {
            const int tq = rope_t0 + wid * 32 + r32; const float prow = (float)(tq >> 6), pcol = (float)(tq & 63);
            u32x4 fa1 = __builtin_bit_cast(u32x4, qr[8]), fa2 = __builtin_bit_cast(u32x4, qr[9]), fb1 = __builtin_bit_cast(u32x4, qr[10]), fb2 = __builtin_bit_cast(u32x4, qr[11]);
#pragma unroll
            for (int jj = 0; jj < 4; ++jj) {
                float na1[2], na2[2], nb1[2], nb2[2];
#pragma unroll
                for (int e = 0; e < 2; ++e) { const float invf = __powf(10000.f, -(float)(hi * 8 + 2 * jj + e) * (1.f / 16.f));
                    const float ar = prow * invf, ac = pcol * invf, cr = __cosf(ar), sr_ = __sinf(ar), cc = __cosf(ac), sc_ = __sinf(ac);
                    const float a1 = e ? bfhi(fa1[jj]) : bflo(fa1[jj]), a2 = e ? bfhi(fa2[jj]) : bflo(fa2[jj]), b1 = e ? bfhi(fb1[jj]) : bflo(fb1[jj]), b2 = e ? bfhi(fb2[jj]) : bflo(fb2[jj]);
                    na1[e] = a1 * cr - a2 * sr_; na2[e] = a2 * cr + a1 * sr_; nb1[e] = b1 * cc - b2 * sc_; nb2[e] = b2 * cc + b1 * sc_; }
                fa1[jj] = pk2(na1[0], na1[1]); fa2[jj] = pk2(na2[0], na2[1]); fb1[jj] = pk2(nb1[0], nb1[1]); fb2[jj] = pk2(nb2[0], nb2[1]);
            }
            qr[8] = __builtin_bit_cast(bf16x8, fa1); qr[9] = __builtin_bit_cast(bf16x8, fa2); qr[10] = __builtin_bit_cast(bf16x8, fb1); qr[11] = __builtin_bit_cast(bf16x8, fb2);
        }
    }
    asm volatile("" ::: "memory");
#pragma unroll
    for (int d0 = 0; d0 < 8; ++d0) qr[d0] = *reinterpret_cast<const bf16x8*>(Qw + d0 * 16);
    const int sr = tid >> 4, sc = (tid & 15) * 8, vst0 = v_st(sr, sc), vst1 = v_st(32 + sr, sc);
    int krow[NKL], kch[NKL];
#pragma unroll
    for (int i = 0; i < NKL; ++i) { const int id = tid + i * NTHREADS; krow[i] = id / CH; kch[i] = id % CH; }
    const int vb0 = (int)(uintptr_t)V_lds + v_rd_base(lane);
    bf16x8 vs0, vs1, ks[NKL];
#define SLOAD(k0) do { vs0 = *reinterpret_cast<const bf16x8*>(&Vh[(long)((k0) + sr) * LDV + sc]); vs1 = *reinterpret_cast<const bf16x8*>(&Vh[(long)((k0) + 32 + sr) * LDV + sc]); \
    _Pragma("unroll") for (int i_ = 0; i_ < NKL; ++i_) ks[i_] = *reinterpret_cast<const bf16x8*>(&Kh[(long)((k0) + krow[i_]) * LDK + kch[i_] * 8]); } while (0)
#define SWRITE(b) do { *(bf16x8*)(V_lds + (b) * SHM_V + vst0) = vs0; *(bf16x8*)(V_lds + (b) * SHM_V + vst1) = vs1; \
    _Pragma("unroll") for (int i_ = 0; i_ < NKL; ++i_) *(bf16x8*)(K_lds + (b) * SHM_K + krow[i_] * KP + kch[i_] * 16) = ks[i_]; } while (0)
#define RESC(a) do { if (__any((a) < 1.f)) { if (hi == 0) al_l[r32] = (a); asm volatile("s_waitcnt lgkmcnt(0)" ::: "memory"); \
    _Pragma("unroll") for (int d = 0; d < 4; ++d) _Pragma("unroll") for (int r = 0; r < 16; ++r) o[d][r] *= al_l[crow(r, hi)]; } } while (0)
    f32x16 p0, p1; float mn, al; bf16x8 pa0, pa1, pa2, pa3; const int NT = seq / 64;
    SLOAD(0); asm volatile("s_waitcnt vmcnt(0)" ::: "memory"); SWRITE(0); __syncthreads();
    SLOAD(64);
    for (int j = 0; j < NT; ++j) {
        const int b = j & 1;
        SBAR(); qkt<DQK>(p0, p1, K_lds + b * SHM_K, qr, r32, hi);
        partialSM(p0, p1, m_reg, mn, al, C, thr_raw);
        RESC(al);
        finishSM(p0, p1, al, l_reg, pa0, pa1, pa2, pa3); SBAR();
        pv_d0(o, vb0 + b * SHM_V, pa0, pa1, pa2, pa3);
        if (j + 1 < NT) { asm volatile("s_waitcnt vmcnt(0)" ::: "memory"); SWRITE(b ^ 1); }
        __syncthreads();
        if (j + 2 < NT) SLOAD((j + 2) * 64);
    }
    if (hi == 0) li_l[r32] = l_reg; asm volatile("s_waitcnt lgkmcnt(0)" ::: "memory");
    float rli[16];
#pragma unroll
    for (int r = 0; r < 16; ++r) rli[r] = __builtin_amdgcn_rcpf(li_l[crow(r, hi)]);
    bf16_t* Ow = Ob + (long)(wid * 32) * LDO;
#pragma unroll
    for (int r = 0; r < 16; ++r) { const int orow = crow(r, hi);
#pragma unroll
        for (int d0 = 0; d0 < 4; ++d0) Ow[(long)orow * LDO + d0 * 32 + r32] = (bf16_t)f2bf(o[d0][r] * rli[r]); }
    __syncthreads();
#undef SLOAD
#undef SWRITE
#undef RESC
}
#define F8_ONE 0x7f7f7f7f
template <int DQK> __device__ __forceinline__ void qkt8(f32x16& p0, f32x16& p1, const char* Ks, const i32x8* qr, int r32, int hi) {
    constexpr int KP = DQK + 16;
    p0 = f32x16{}; p1 = f32x16{};
#pragma unroll
    for (int c = 0; c < DQK / 64; ++c) { const int cb = c * 64 + hi * 32;
        const u32x4 a0 = *reinterpret_cast<const u32x4*>(Ks + r32 * KP + cb), a1 = *reinterpret_cast<const u32x4*>(Ks + r32 * KP + cb + 16);
        const u32x4 b0 = *reinterpret_cast<const u32x4*>(Ks + (32 + r32) * KP + cb), b1 = *reinterpret_cast<const u32x4*>(Ks + (32 + r32) * KP + cb + 16);
        const i32x8 A = {(int)a0.x, (int)a0.y, (int)a0.z, (int)a0.w, (int)a1.x, (int)a1.y, (int)a1.z, (int)a1.w}, B = {(int)b0.x, (int)b0.y, (int)b0.z, (int)b0.w, (int)b1.x, (int)b1.y, (int)b1.z, (int)b1.w};
        p0 = __builtin_amdgcn_mfma_scale_f32_32x32x64_f8f6f4(A, qr[c], p0, 0, 0, 0, F8_ONE, 0, F8_ONE);
        p1 = __builtin_amdgcn_mfma_scale_f32_32x32x64_f8f6f4(B, qr[c], p1, 0, 0, 0, F8_ONE, 0, F8_ONE); }
}
__device__ __forceinline__ i32x8 q32_to_fp8(const bf16_t* p, float mul = 1.f) {
    i32x8 r;
#pragma unroll
    for (int w = 0; w < 4; ++w) { const u32x4 v = *reinterpret_cast<const u32x4*>(p + 8 * w);
        r[2 * w] = (int)f8x4(bflo(v.x) * mul, bfhi(v.x) * mul, bflo(v.y) * mul, bfhi(v.y) * mul); r[2 * w + 1] = (int)f8x4(bflo(v.z) * mul, bfhi(v.z) * mul, bflo(v.w) * mul, bfhi(v.w) * mul); }
    return r;
}
__device__ __forceinline__ i32x8 q32_rope_fp8(const bf16_t* p, float pos, float mul = 1.f) {
    float x[32];
#pragma unroll
    for (int w = 0; w < 4; ++w) { const u32x4 v = *reinterpret_cast<const u32x4*>(p + 8 * w);
#pragma unroll
        for (int e = 0; e < 4; ++e) { x[8 * w + 2 * e] = bflo(v[e]); x[8 * w + 2 * e + 1] = bfhi(v[e]); } }
    float y[32];
#pragma unroll
    for (int i = 0; i < 16; ++i) { const float ang = pos * __powf(10000.f, -(float)i * (1.f / 16.f)), cs = __cosf(ang), sn = __sinf(ang);
        y[i] = (x[i] * cs - x[16 + i] * sn) * mul; y[16 + i] = (x[16 + i] * cs + x[i] * sn) * mul; }
    i32x8 r;
#pragma unroll
    for (int w = 0; w < 8; ++w) r[w] = (int)f8x4(y[4 * w], y[4 * w + 1], y[4 * w + 2], y[4 * w + 3]);
    return r;
}
template <int DQK, int LDQ, int LDK, int LDV, int LDO>
__device__ __forceinline__ void attn8_body(const bf16_t* __restrict__ Qb, const unsigned char* __restrict__ Kh, const bf16_t* __restrict__ Vh, bf16_t* __restrict__ Ob, int seq, float scale, char* lds) {
    constexpr int KP = DQK + 16, SHM_V = 64 * 128 * 2, SHM_K = 64 * KP, NC = DQK / 64;
    static_assert(DQK == 128, "double-pipelined body: 128-wide q.k only");
    const float C = scale * 1.4426950408889634f, thr_raw = ATT_THR / scale;
    const int tid = threadIdx.x, wid = tid >> 6, lane = tid & 63, r32 = lane & 31, hi = lane >> 5;
    char* V_lds = lds; char* K_lds = lds + 2 * SHM_V;
    float* wsf = (float*)(lds + 2 * SHM_V + 2 * SHM_K) + wid * 64; float* li_l = wsf; float* al_l = wsf + 32;
    float m_reg = -1e30f, l_reg = 0; f32x16 o[4] = {}; i32x8 qr[NC];
    const bf16_t* Qw = Qb + (long)(wid * 32 + r32) * LDQ + hi * 32;
#pragma unroll
    for (int c = 0; c < NC; ++c) qr[c] = q32_to_fp8(Qw + 64 * c);
    const int sr = tid >> 4, sc = (tid & 15) * 8, vst0 = v_st(sr, sc), vst1 = v_st(32 + sr, sc);
    const int krow = tid >> 3, kch = (tid & 7) * 16;
    const int vb0 = (int)(uintptr_t)V_lds + v_rd_base(lane);
    bf16x8 vs0, vs1; u32x4 ks;
#define SLOAD(k0) do { vs0 = *reinterpret_cast<const bf16x8*>(&Vh[(long)((k0) + sr) * LDV + sc]); vs1 = *reinterpret_cast<const bf16x8*>(&Vh[(long)((k0) + 32 + sr) * LDV + sc]); \
    ks = *reinterpret_cast<const u32x4*>(&Kh[(long)((k0) + krow) * LDK + kch]); } while (0)
#define SWRITE(b) do { *(bf16x8*)(V_lds + (b) * SHM_V + vst0) = vs0; *(bf16x8*)(V_lds + (b) * SHM_V + vst1) = vs1; \
    *(u32x4*)(K_lds + (b) * SHM_K + krow * KP + kch) = ks; } while (0)
#define RESC(a) do { if (__any((a) < 1.f)) { if (hi == 0) al_l[r32] = (a); asm volatile("s_waitcnt lgkmcnt(0)" ::: "memory"); \
    _Pragma("unroll") for (int d = 0; d < 4; ++d) _Pragma("unroll") for (int r = 0; r < 16; ++r) o[d][r] *= al_l[crow(r, hi)]; } } while (0)
    f32x16 pA0, pA1, pB0, pB1; float mnA, mnB, alA, alB; bf16x8 pa0, pa1, pa2, pa3; const int NT = seq / 64;
    SLOAD(0); asm volatile("s_waitcnt vmcnt(0)" ::: "memory"); SWRITE(0); __syncthreads();
    qkt8<DQK>(pA0, pA1, K_lds, qr, r32, hi); partialSM(pA0, pA1, m_reg, mnA, alA, C, thr_raw);
    SLOAD(64);
    asm volatile("s_waitcnt vmcnt(0)" ::: "memory"); SWRITE(1); __syncthreads();
    for (int j = 1; j + 1 < NT; j += 2) {
        SBAR(); qkt8<DQK>(pB0, pB1, K_lds + SHM_K, qr, r32, hi);
        finishSM(pA0, pA1, alA, l_reg, pa0, pa1, pa2, pa3); SBAR();
        SLOAD((j + 1) * 64); SBAR();
        pv_d0(o, vb0, pa0, pa1, pa2, pa3); partialSM(pB0, pB1, m_reg, mnB, alB, C, thr_raw);
        __syncthreads(); asm volatile("s_waitcnt vmcnt(0)" ::: "memory"); SWRITE(0);
        RESC(alB); __syncthreads();
        SBAR(); qkt8<DQK>(pA0, pA1, K_lds, qr, r32, hi);
        finishSM(pB0, pB1, alB, l_reg, pa0, pa1, pa2, pa3); SBAR();
        SLOAD((j + 2) * 64); SBAR();
        pv_d0(o, vb0 + SHM_V, pa0, pa1, pa2, pa3); partialSM(pA0, pA1, m_reg, mnA, alA, C, thr_raw);
        __syncthreads(); asm volatile("s_waitcnt vmcnt(0)" ::: "memory"); SWRITE(1);
        RESC(alA); __syncthreads();
    }
    SBAR(); qkt8<DQK>(pB0, pB1, K_lds + SHM_K, qr, r32, hi);
    finishSM(pA0, pA1, alA, l_reg, pa0, pa1, pa2, pa3); SBAR();
    pv_d0(o, vb0, pa0, pa1, pa2, pa3); partialSM(pB0, pB1, m_reg, mnB, alB, C, thr_raw);
    __syncthreads(); RESC(alB);
    finishSM(pB0, pB1, alB, l_reg, pa0, pa1, pa2, pa3); SBAR();
    pv_d0(o, vb0 + SHM_V, pa0, pa1, pa2, pa3);
    if (hi == 0) li_l[r32] = l_reg; asm volatile("s_waitcnt lgkmcnt(0)" ::: "memory");
    float rli[16];
#pragma unroll
    for (int r = 0; r < 16; ++r) rli[r] = __builtin_amdgcn_rcpf(li_l[crow(r, hi)]);
    bf16_t* Ow = Ob + (long)(wid * 32) * LDO;
#pragma unroll
    for (int r = 0; r < 16; ++r) { const int orow = crow(r, hi);
#pragma unroll
        for (int d0 = 0; d0 < 4; ++d0) Ow[(long)orow * LDO + d0 * 32 + r32] = (bf16_t)f2bf(o[d0][r] * rli[r]); }
    __syncthreads();
#undef SLOAD
#undef SWRITE
#undef RESC
}
template <int DQK, int LDQ, int LDK, int LDV, int LDO>
__device__ __forceinline__ void attn8_body_single(const bf16_t* __restrict__ Qb, const unsigned char* __restrict__ Kh, const bf16_t* __restrict__ Vh, bf16_t* __restrict__ Ob, int seq, float scale, char* lds, int rope_t0) {
    constexpr int KP = DQK + 16, SHM_V = 64 * 128 * 2, SHM_K = 64 * KP, NC = DQK / 64, CH = DQK / 16, NCH = 64 * CH, NKL = (NCH + NTHREADS - 1) / NTHREADS;
    const float C = scale * 1.4426950408889634f, thr_raw = ATT_THR / scale;
    const int tid = threadIdx.x, wid = tid >> 6, lane = tid & 63, r32 = lane & 31, hi = lane >> 5;
    char* V_lds = lds; char* K_lds = lds + 2 * SHM_V;
    float* wsf = (float*)(lds + 2 * SHM_V + 2 * SHM_K) + wid * 64; float* li_l = wsf; float* al_l = wsf + 32;
    float m_reg = -1e30f, l_reg = 0; f32x16 o[4] = {}; i32x8 qr[NC];
    const bf16_t* Qw = Qb + (long)(wid * 32 + r32) * LDQ + hi * 32;
    if constexpr (DQK == 192) {
        if (rope_t0 >= 0) { const int tq = rope_t0 + wid * 32 + r32; qr[2] = q32_rope_fp8(Qw + 128, (float)(hi ? (tq & 63) : (tq >> 6))); }
        else qr[2] = q32_to_fp8(Qw + 128);
    }
    asm volatile("" ::: "memory");
#pragma unroll
    for (int c = 0; c < 2; ++c) qr[c] = q32_to_fp8(Qw + 64 * c);
    const int sr = tid >> 4, sc = (tid & 15) * 8, vst0 = v_st(sr, sc), vst1 = v_st(32 + sr, sc);
    int krow[NKL], kch[NKL];
#pragma unroll
    for (int i = 0; i < NKL; ++i) { const int id = tid + i * NTHREADS; krow[i] = (id < NCH) ? id / CH : 0; kch[i] = (id % CH) * 16; }
    const bool k2 = (NKL < 2) || (tid + NTHREADS < NCH);
    const int vb0 = (int)(uintptr_t)V_lds + v_rd_base(lane);
    bf16x8 vs0, vs1; u32x4 ks[NKL];
#define SLOAD(k0) do { vs0 = *reinterpret_cast<const bf16x8*>(&Vh[(long)((k0) + sr) * LDV + sc]); vs1 = *reinterpret_cast<const bf16x8*>(&Vh[(long)((k0) + 32 + sr) * LDV + sc]); \
    _Pragma("unroll") for (int i_ = 0; i_ < NKL; ++i_) ks[i_] = *reinterpret_cast<const u32x4*>(&Kh[(long)((k0) + krow[i_]) * LDK + kch[i_]]); } while (0)
#define SWRITE(b) do { *(bf16x8*)(V_lds + (b) * SHM_V + vst0) = vs0; *(bf16x8*)(V_lds + (b) * SHM_V + vst1) = vs1; \
    _Pragma("unroll") for (int i_ = 0; i_ < NKL; ++i_) if (i_ == 0 || k2) *(u32x4*)(K_lds + (b) * SHM_K + krow[i_] * KP + kch[i_]) = ks[i_]; } while (0)
#define RESC(a) do { if (__any((a) < 1.f)) { if (hi == 0) al_l[r32] = (a); asm volatile("s_waitcnt lgkmcnt(0)" ::: "memory"); \
    _Pragma("unroll") for (int d = 0; d < 4; ++d) _Pragma("unroll") for (int r = 0; r < 16; ++r) o[d][r] *= al_l[crow(r, hi)]; } } while (0)
    f32x16 p0, p1; float mn, al; bf16x8 pa0, pa1, pa2, pa3; const int NT = seq / 64;
    SLOAD(0); asm volatile("s_waitcnt vmcnt(0)" ::: "memory"); SWRITE(0); __syncthreads();
    SLOAD(64);
    for (int j = 0; j < NT; ++j) {
        const int b = j & 1;
        SBAR(); qkt8<DQK>(p0, p1, K_lds + b * SHM_K, qr, r32, hi);
        partialSM(p0, p1, m_reg, mn, al, C, thr_raw);
        RESC(al);
        finishSM(p0, p1, al, l_reg, pa0, pa1, pa2, pa3); SBAR();
        pv_d0(o, vb0 + b * SHM_V, pa0, pa1, pa2, pa3);
        if (j + 1 < NT) { asm volatile("s_waitcnt vmcnt(0)" ::: "memory"); SWRITE(b ^ 1); }
        __syncthreads();
        if (j + 2 < NT) SLOAD((j + 2) * 64);
    }
    if (hi == 0) li_l[r32] = l_reg; asm volatile("s_waitcnt lgkmcnt(0)" ::: "memory");
    float rli[16];
#pragma unroll
    for (int r = 0; r < 16; ++r) rli[r] = __builtin_amdgcn_rcpf(li_l[crow(r, hi)]);
    bf16_t* Ow = Ob + (long)(wid * 32) * LDO;
#pragma unroll
    for (int r = 0; r < 16; ++r) { const int orow = crow(r, hi);
#pragma unroll
        for (int d0 = 0; d0 < 4; ++d0) Ow[(long)orow * LDO + d0 * 32 + r32] = (bf16_t)f2bf(o[d0][r] * rli[r]); }
    __syncthreads();
#undef SLOAD
#undef SWRITE
#undef RESC
}
constexpr float ATT8_THR = 3.5f, ATT8_SH = 3.f;
#ifndef ATT8_FIXED_M
#define ATT8_FIXED_M 0
#endif
__device__ __forceinline__ void partialSM8(f32x16& p0, f32x16& p1, float& m_reg, float& mn, float& alpha, float C, float thr_raw) {
#if ATT8_FIXED_M
    mn = 6.f * 1.4426950408889634f / C; alpha = 1.f; m_reg = mn;
#else
    float pmax = p0[0];
#pragma unroll
    for (int r = 1; r < 16; ++r) pmax = fmaxf(pmax, p0[r]);
#pragma unroll
    for (int r = 0; r < 16; ++r) pmax = fmaxf(pmax, p1[r]);
    { auto rr = __builtin_amdgcn_permlane32_swap(__float_as_uint(pmax), __float_as_uint(pmax), false, false);
      pmax = fmaxf(__uint_as_float(rr[0]), __uint_as_float(rr[1])); }
    if (__builtin_expect(__all(pmax - m_reg <= thr_raw), 1)) { mn = m_reg; alpha = 1.f; }
    else { mn = fmaxf(m_reg, pmax); alpha = __builtin_amdgcn_exp2f((m_reg - mn) * C); m_reg = mn; }
#endif
    const float mnC = ATT8_SH - mn * C;
#pragma unroll
    for (int r = 0; r < 16; ++r) p0[r] = fmaf(p0[r], C, mnC);
#pragma unroll
    for (int r = 0; r < 16; ++r) p1[r] = fmaf(p1[r], C, mnC);
#pragma unroll
    for (int r = 0; r < 16; ++r) p0[r] = __builtin_amdgcn_exp2f(p0[r]);
}
__device__ __forceinline__ void finishSM8(f32x16& p0, f32x16& p1, i32x8& pa) {
#pragma unroll
    for (int r = 0; r < 16; ++r) p1[r] = __builtin_amdgcn_exp2f(p1[r]);
#pragma unroll
    for (int w = 0; w < 4; ++w) { pa[w] = (int)f8x4(p0[4 * w], p0[4 * w + 1], p0[4 * w + 2], p0[4 * w + 3]); pa[4 + w] = (int)f8x4(p1[4 * w], p1[4 * w + 1], p1[4 * w + 2], p1[4 * w + 3]); }
}
__device__ __forceinline__ void finishSM8s(f32x16& p0, f32x16& p1, float alpha, float& l_reg, i32x8& pa) {
#pragma unroll
    for (int r = 0; r < 16; ++r) p1[r] = __builtin_amdgcn_exp2f(p1[r]);
    float ps = 0;
#pragma unroll
    for (int r = 0; r < 16; ++r) ps += p0[r];
#pragma unroll
    for (int r = 0; r < 16; ++r) ps += p1[r];
    { auto rr = __builtin_amdgcn_permlane32_swap(__float_as_uint(ps), __float_as_uint(ps), false, false);
      ps = __uint_as_float(rr[0]) + __uint_as_float(rr[1]); }
    l_reg = l_reg * alpha + ps;
#pragma unroll
    for (int w = 0; w < 4; ++w) { pa[w] = (int)f8x4(p0[4 * w], p0[4 * w + 1], p0[4 * w + 2], p0[4 * w + 3]); pa[4 + w] = (int)f8x4(p1[4 * w], p1[4 * w + 1], p1[4 * w + 2], p1[4 * w + 3]); }
}
typedef int i32x2 __attribute__((ext_vector_type(2)));
template <int OFF> __device__ __forceinline__ u32x2 tr8_read(int vb) { typedef i32x2 LAS* lp; const i32x2 r = __builtin_amdgcn_ds_read_tr8_b64_v2i32((lp)(uintptr_t)(unsigned)(vb + OFF)); return (u32x2){(unsigned)r.x, (unsigned)r.y}; }
#define F8_MFMA(A_, B_, C_) __builtin_amdgcn_mfma_scale_f32_32x32x64_f8f6f4(A_, B_, C_, 0, 0, 0, F8_ONE, 0, F8_ONE)
#define TR8X4(T, VB) const u32x2 T[4] = {tr8_read<0>(VB), tr8_read<2048>(VB), tr8_read<4096>(VB), tr8_read<6144>(VB)}
#define TR8B(T) (i32x8){(int)T[0].x, (int)T[0].y, (int)T[1].x, (int)T[1].y, (int)T[2].x, (int)T[2].y, (int)T[3].x, (int)T[3].y}
__device__ __forceinline__ void pv8_pairs(f32x16* o, const int* vb, int boff, const i32x8& pa) {
    { TR8X4(a, vb[0] + boff); TR8X4(b, vb[1] + boff);
      o[0] = F8_MFMA(pa, TR8B(a), o[0]);
      o[1] = F8_MFMA(pa, TR8B(b), o[1]); }
    { TR8X4(c, vb[2] + boff); TR8X4(d, vb[3] + boff);
      o[2] = F8_MFMA(pa, TR8B(c), o[2]);
      o[3] = F8_MFMA(pa, TR8B(d), o[3]); }
}
__device__ __forceinline__ void pv8_seq(f32x16* o, const int* vb, int boff, const i32x8& pa) {
    const i32x8 ones = {0x38383838, 0x38383838, 0x38383838, 0x38383838, 0x38383838, 0x38383838, 0x38383838, 0x38383838};
    { TR8X4(a, vb[0] + boff); o[4] = F8_MFMA(pa, ones, o[4]); o[0] = F8_MFMA(pa, TR8B(a), o[0]); }
    { TR8X4(b, vb[1] + boff); o[1] = F8_MFMA(pa, TR8B(b), o[1]); }
    { TR8X4(c, vb[2] + boff); o[2] = F8_MFMA(pa, TR8B(c), o[2]); }
    { TR8X4(d, vb[3] + boff); o[3] = F8_MFMA(pa, TR8B(d), o[3]); }
}
template <bool ALL16> __device__ __forceinline__ void pv8_all(f32x16* o, const int* vb, int boff, const i32x8& pa) {
    const i32x8 ones = {0x38383838, 0x38383838, 0x38383838, 0x38383838, 0x38383838, 0x38383838, 0x38383838, 0x38383838};
    if constexpr (ALL16) {
        TR8X4(a, vb[0] + boff); TR8X4(b, vb[1] + boff); TR8X4(c, vb[2] + boff); TR8X4(d, vb[3] + boff);
        o[4] = F8_MFMA(pa, ones, o[4]);
        o[0] = F8_MFMA(pa, TR8B(a), o[0]);
        o[1] = F8_MFMA(pa, TR8B(b), o[1]);
        o[2] = F8_MFMA(pa, TR8B(c), o[2]);
        o[3] = F8_MFMA(pa, TR8B(d), o[3]);
    } else {
        { TR8X4(a, vb[0] + boff); TR8X4(b, vb[1] + boff);
          o[4] = F8_MFMA(pa, ones, o[4]);
          o[0] = F8_MFMA(pa, TR8B(a), o[0]);
          o[1] = F8_MFMA(pa, TR8B(b), o[1]); }
        { TR8X4(c, vb[2] + boff); TR8X4(d, vb[3] + boff);
          o[2] = F8_MFMA(pa, TR8B(c), o[2]);
          o[3] = F8_MFMA(pa, TR8B(d), o[3]); }
    }
}
__device__ __forceinline__ int v8_f(int key) { return ((key >> 1) & 1) + 2 * ((key >> 3) & 1); }
__device__ __forceinline__ int v8_st(int key, int ch16) { return key * 128 + 32 * ((ch16 >> 1) ^ v8_f(key)) + 16 * (ch16 & 1); }
__device__ __forceinline__ int v8_rd_base(int lane, int db) {
    const int q = (lane & 15) >> 1, pp = lane & 1, g1 = (lane >> 4) & 1, hi = lane >> 5, fq = ((q >> 1) & 1) + 2 * (q >> 2);
    return (8 * (q >> 2) + 4 * hi + (q & 3)) * 128 + 32 * (db ^ fq) + 16 * g1 + 8 * pp;
}
template <int DQK, int LDQ, int LDK, int LDV, int LDO>
__device__ __forceinline__ void attn88_body(const bf16_t* __restrict__ Qb, const unsigned char* __restrict__ Kh, const unsigned char* __restrict__ Vh, bf16_t* __restrict__ Ob, int seq, float scale, char* lds) {
    constexpr int KP = DQK + 16, SHM_V = 64 * 128, SHM_K = 64 * KP, NC = DQK / 64;
    static_assert(DQK == 128, "double-pipelined body: 128-wide q.k only");
    const float C = scale * 1.4426950408889634f, thr_raw = ATT8_THR / scale;
    const int tid = threadIdx.x, wid = tid >> 6, lane = tid & 63, r32 = lane & 31, hi = lane >> 5;
    char* V_lds = lds; char* K_lds = lds + 2 * SHM_V;
    float* al_l = (float*)(lds + 2 * SHM_V + 2 * SHM_K) + wid * 32;
    float m_reg = -1e30f; f32x16 o[5] = {}; i32x8 qr[NC];
    const bf16_t* Qw = Qb + (long)(wid * 32 + r32) * LDQ + hi * 32;
#pragma unroll
    for (int c = 0; c < NC; ++c) qr[c] = q32_to_fp8(Qw + 64 * c);
    const int krow = tid >> 3, kch = (tid & 7) * 16, vst = v8_st(krow, tid & 7);
    int vb[4];
#pragma unroll
    for (int d = 0; d < 4; ++d) vb[d] = (int)(uintptr_t)V_lds + v8_rd_base(lane, d);
    u32x4 vs, ks;
#define SLOAD(k0) do { vs = *reinterpret_cast<const u32x4*>(&Vh[(long)((k0) + krow) * LDV + kch]); ks = *reinterpret_cast<const u32x4*>(&Kh[(long)((k0) + krow) * LDK + kch]); } while (0)
#define SWRITE(b) do { *(u32x4*)(V_lds + (b) * SHM_V + vst) = vs; *(u32x4*)(K_lds + (b) * SHM_K + krow * KP + kch) = ks; } while (0)
#define RESC(a) do { if (__any((a) < 1.f)) { if (hi == 0) al_l[r32] = (a); asm volatile("s_waitcnt lgkmcnt(0)" ::: "memory"); \
    _Pragma("unroll") for (int d = 0; d < 5; ++d) _Pragma("unroll") for (int r = 0; r < 16; ++r) o[d][r] *= al_l[crow(r, hi)]; } } while (0)
#define PV8(b) pv8_all<DQK == 128>(o, vb, (b) * SHM_V, pa)
    f32x16 pA0, pA1, pB0, pB1; float mnA, mnB, alA, alB; i32x8 pa; const int NT = seq / 64;
    SLOAD(0); asm volatile("s_waitcnt vmcnt(0)" ::: "memory"); SWRITE(0); __syncthreads();
    qkt8<DQK>(pA0, pA1, K_lds, qr, r32, hi); partialSM8(pA0, pA1, m_reg, mnA, alA, C, thr_raw);
    SLOAD(64);
    asm volatile("s_waitcnt vmcnt(0)" ::: "memory"); SWRITE(1); __syncthreads();
    for (int j = 1; j + 1 < NT; j += 2) {
        SBAR(); qkt8<DQK>(pB0, pB1, K_lds + SHM_K, qr, r32, hi);
        finishSM8(pA0, pA1, pa); SBAR();
        SLOAD((j + 1) * 64); SBAR();
        PV8(0); partialSM8(pB0, pB1, m_reg, mnB, alB, C, thr_raw);
        __syncthreads(); asm volatile("s_waitcnt vmcnt(0)" ::: "memory"); SWRITE(0);
        RESC(alB); __syncthreads();
        SBAR(); qkt8<DQK>(pA0, pA1, K_lds, qr, r32, hi);
        finishSM8(pB0, pB1, pa); SBAR();
        SLOAD((j + 2) * 64); SBAR();
        PV8(1); partialSM8(pA0, pA1, m_reg, mnA, alA, C, thr_raw);
        __syncthreads(); asm volatile("s_waitcnt vmcnt(0)" ::: "memory"); SWRITE(1);
        RESC(alA); __syncthreads();
    }
    SBAR(); qkt8<DQK>(pB0, pB1, K_lds + SHM_K, qr, r32, hi);
    finishSM8(pA0, pA1, pa); SBAR();
    PV8(0); partialSM8(pB0, pB1, m_reg, mnB, alB, C, thr_raw);
    __syncthreads(); RESC(alB);
    finishSM8(pB0, pB1, pa); SBAR();
    PV8(1);
    float rli[16];
#pragma unroll
    for (int r = 0; r < 16; ++r) rli[r] = __builtin_amdgcn_rcpf(o[4][r]);
    bf16_t* Ow = Ob + (long)(wid * 32) * LDO;
#pragma unroll
    for (int r = 0; r < 16; ++r) { const int orow = crow(r, hi);
#pragma unroll
        for (int d0 = 0; d0 < 4; ++d0) Ow[(long)orow * LDO + d0 * 32 + r32] = (bf16_t)f2bf(o[d0][r] * rli[r]); }
    __syncthreads();
#undef SLOAD
#undef SWRITE
}
template <int DQK, int LDQ, int LDK, int LDV, int LDO>
__device__ __forceinline__ void attn88_body_single(const bf16_t* __restrict__ Qb, const unsigned char* __restrict__ Kh, const unsigned char* __restrict__ Vh, bf16_t* __restrict__ Ob, int seq, float scale, char* lds, int rope_t0) {
    constexpr int KP = DQK + 16, SHM_V = 64 * 128, SHM_K = 64 * KP, NC = DQK / 64, CH = DQK / 16, NCH = 64 * CH, NKL = (NCH + NTHREADS - 1) / NTHREADS;
    const float C = scale * 1.4426950408889634f, thr_raw = ATT8_THR / scale;
    const int tid = threadIdx.x, wid = tid >> 6, lane = tid & 63, r32 = lane & 31, hi = lane >> 5;
    char* V_lds = lds; char* K_lds = lds + 2 * SHM_V;
    float* al_l = (float*)(lds + 2 * SHM_V + 2 * SHM_K) + wid * 32;
    float m_reg = -1e30f; i32x8 qr[NC];
    const bf16_t* Qw = Qb + (long)(wid * 32 + r32) * LDQ + hi * 32;
    if constexpr (DQK == 192) {
        if (rope_t0 >= 0) { const int tq = rope_t0 + wid * 32 + r32; qr[2] = q32_rope_fp8(Qw + 128, (float)(hi ? (tq & 63) : (tq >> 6))); }
        else qr[2] = q32_to_fp8(Qw + 128);
    }
    asm volatile("" ::: "memory");
#pragma unroll
    for (int c = 0; c < 2; ++c) qr[c] = q32_to_fp8(Qw + 64 * c);
    const int vrow = tid >> 3, vch = (tid & 7) * 16, vst = v8_st(vrow, tid & 7);
    unsigned koff[NKL]; int klds[NKL]; const unsigned voff = (unsigned)(vrow * LDV + vch);
#pragma unroll
    for (int i = 0; i < NKL; ++i) { const int id = tid + i * NTHREADS, kr = (id < NCH) ? id / CH : 0, kc = (id % CH) * 16; koff[i] = (unsigned)(kr * LDK + kc); klds[i] = kr * KP + kc; }
    const bool k2 = (NKL < 2) || (tid + NTHREADS < NCH);
    int vb[4];
#pragma unroll
    for (int d = 0; d < 4; ++d) vb[d] = (int)(uintptr_t)V_lds + v8_rd_base(lane, d);
    u32x4 vs, ks[NKL];
#define SLOAD(k0) do { const unsigned char* vt_ = Vh + (size_t)(k0) * LDV; const unsigned char* kt_ = Kh + (size_t)(k0) * LDK; vs = *reinterpret_cast<const u32x4*>(vt_ + voff); \
    _Pragma("unroll") for (int i_ = 0; i_ < NKL; ++i_) ks[i_] = *reinterpret_cast<const u32x4*>(kt_ + koff[i_]); } while (0)
#define SWRITE(b) do { *(u32x4*)(V_lds + (b) * SHM_V + vst) = vs; \
    _Pragma("unroll") for (int i_ = 0; i_ < NKL; ++i_) if (i_ == 0 || k2) *(u32x4*)(K_lds + (b) * SHM_K + klds[i_]) = ks[i_]; } while (0)
    asm volatile("" ::: "memory");
    f32x16 o[5] = {}; f32x16 p0, p1; float mn, al; i32x8 pa; const int NT = seq / 64;
    SLOAD(0); asm volatile("s_waitcnt vmcnt(0)" ::: "memory"); SWRITE(0); __syncthreads();
    SLOAD(64);
    for (int j = 0; j < NT; ++j) {
        const int b = j & 1;
        SBAR(); qkt8<DQK>(p0, p1, K_lds + b * SHM_K, qr, r32, hi);
        partialSM8(p0, p1, m_reg, mn, al, C, thr_raw);
        RESC(al);
        finishSM8(p0, p1, pa); SBAR();
        PV8(b);
        if (j + 1 < NT) { asm volatile("s_waitcnt vmcnt(0)" ::: "memory"); SWRITE(b ^ 1); }
        __syncthreads();
        if (j + 2 < NT) SLOAD((j + 2) * 64);
    }
    float rli[16];
#pragma unroll
    for (int r = 0; r < 16; ++r) rli[r] = __builtin_amdgcn_rcpf(o[4][r]);
    bf16_t* Ow = Ob + (long)(wid * 32) * LDO;
#pragma unroll
    for (int r = 0; r < 16; ++r) { const int orow = crow(r, hi);
#pragma unroll
        for (int d0 = 0; d0 < 4; ++d0) Ow[(long)orow * LDO + d0 * 32 + r32] = (bf16_t)f2bf(o[d0][r] * rli[r]); }
    __syncthreads();
#undef SLOAD
#undef SWRITE
#undef RESC
#undef PV8
}
template <int DQK, bool MSUM, int VAR = 0> __device__ __forceinline__ void pp_half_b(f32x16* o, f32x16& p0, f32x16& p1, const int* vb, int boff, const i32x8& pa, const char* Ks, const i32x8* qr, int r32, int hi) {
    constexpr int KP = DQK + 16, NC = DQK / 64;
    const i32x8 ones = {0x38383838, 0x38383838, 0x38383838, 0x38383838, 0x38383838, 0x38383838, 0x38383838, 0x38383838};
#define PPB_TR(T, D) const u32x2 T[4] = {tr8_read<0>(vb[D] + boff), tr8_read<2048>(vb[D] + boff), tr8_read<4096>(vb[D] + boff), tr8_read<6144>(vb[D] + boff)}
#define PPB_K(CH) { const int cb = (CH) * 64 + hi * 32; \
        const u32x4 a0 = *reinterpret_cast<const u32x4*>(Ks + r32 * KP + cb), a1 = *reinterpret_cast<const u32x4*>(Ks + r32 * KP + cb + 16); \
        const u32x4 b0 = *reinterpret_cast<const u32x4*>(Ks + (32 + r32) * KP + cb), b1 = *reinterpret_cast<const u32x4*>(Ks + (32 + r32) * KP + cb + 16); \
        kA[CH] = (i32x8){(int)a0.x, (int)a0.y, (int)a0.z, (int)a0.w, (int)a1.x, (int)a1.y, (int)a1.z, (int)a1.w}; kB[CH] = (i32x8){(int)b0.x, (int)b0.y, (int)b0.z, (int)b0.w, (int)b1.x, (int)b1.y, (int)b1.z, (int)b1.w}; }
    i32x8 kA[NC], kB[NC];
    PPB_TR(a, 0); SBAR();
    if constexpr (MSUM) { o[4] = F8_MFMA(pa, ones, o[4]); SBAR(); }
    PPB_TR(b, 1); SBAR();
    o[0] = F8_MFMA(pa, TR8B(a), o[0]); SBAR();
    PPB_TR(c, 2); SBAR();
    o[1] = F8_MFMA(pa, TR8B(b), o[1]); SBAR();
    PPB_TR(d, 3); SBAR();
    o[2] = F8_MFMA(pa, TR8B(c), o[2]); SBAR();
    PPB_K(0); SBAR();
    o[3] = F8_MFMA(pa, TR8B(d), o[3]); SBAR();
    PPB_K(1); SBAR();
    p0 = F8_MFMA(kA[0], qr[0], (f32x16){}); SBAR();
    if constexpr (NC > 2) { PPB_K(2); SBAR(); }
    p1 = F8_MFMA(kB[0], qr[0], (f32x16){}); SBAR();
    p0 = F8_MFMA(kA[1], qr[1], p0); p1 = F8_MFMA(kB[1], qr[1], p1);
    if constexpr (NC > 2) { p0 = F8_MFMA(kA[NC - 1], qr[NC - 1], p0); p1 = F8_MFMA(kB[NC - 1], qr[NC - 1], p1); }
#undef PPB_TR
#undef PPB_K
}
constexpr float ATT8_THR2 = 5.f;
__device__ __forceinline__ bool pp_softmax8(const f32x16& p0, const f32x16& p1, float& m_i, float& sc, float& alpha, i32x8& pa) {
    float pmax;
    asm("v_max3_f32 %0, %1, %2, %3\n\tv_max3_f32 %0, %0, %4, %5\n\tv_max3_f32 %0, %0, %6, %7\n\tv_max3_f32 %0, %0, %8, %9\n\tv_max3_f32 %0, %0, %10, %11\n\tv_max3_f32 %0, %0, %12, %13\n\tv_max3_f32 %0, %0, %14, %15\n\tv_max3_f32 %0, %0, %16, %16"
        : "=&v"(pmax) : "v"(p0[0]), "v"(p0[1]), "v"(p0[2]), "v"(p0[3]), "v"(p0[4]), "v"(p0[5]), "v"(p0[6]), "v"(p0[7]), "v"(p0[8]), "v"(p0[9]), "v"(p0[10]), "v"(p0[11]), "v"(p0[12]), "v"(p0[13]), "v"(p0[14]), "v"(p0[15]));
    asm("v_max3_f32 %0, %0, %1, %2\n\tv_max3_f32 %0, %0, %3, %4\n\tv_max3_f32 %0, %0, %5, %6\n\tv_max3_f32 %0, %0, %7, %8\n\tv_max3_f32 %0, %0, %9, %10\n\tv_max3_f32 %0, %0, %11, %12\n\tv_max3_f32 %0, %0, %13, %14\n\tv_max3_f32 %0, %0, %15, %16"
        : "+v"(pmax) : "v"(p1[0]), "v"(p1[1]), "v"(p1[2]), "v"(p1[3]), "v"(p1[4]), "v"(p1[5]), "v"(p1[6]), "v"(p1[7]), "v"(p1[8]), "v"(p1[9]), "v"(p1[10]), "v"(p1[11]), "v"(p1[12]), "v"(p1[13]), "v"(p1[14]), "v"(p1[15]));
    { auto rr = __builtin_amdgcn_permlane32_swap(__float_as_uint(pmax), __float_as_uint(pmax), false, false);
      asm("v_max_f32 %0, %1, %2" : "=v"(pmax) : "v"(__uint_as_float(rr[0])), "v"(__uint_as_float(rr[1]))); }
    const bool ch = !__all(pmax - m_i <= ATT8_THR2);
    alpha = 1.f;
    if (__builtin_expect(ch, 0)) { float mn; asm("v_ceil_f32 %0, %1\n\tv_max_f32 %0, %0, %2" : "=&v"(mn) : "v"(pmax), "v"(m_i)); alpha = __builtin_amdgcn_exp2f(m_i - mn); m_i = mn; sc = __builtin_amdgcn_exp2f(m_i - ATT8_SH);
        asm volatile("" : "+v"(alpha), "+v"(sc), "+v"(m_i)); }
#pragma unroll
    for (int w = 0; w < 4; ++w) {
        const float e0 = __builtin_amdgcn_exp2f(p0[4 * w]), e1 = __builtin_amdgcn_exp2f(p0[4 * w + 1]), e2 = __builtin_amdgcn_exp2f(p0[4 * w + 2]), e3 = __builtin_amdgcn_exp2f(p0[4 * w + 3]);
        const float f0 = __builtin_amdgcn_exp2f(p1[4 * w]), f1 = __builtin_amdgcn_exp2f(p1[4 * w + 1]), f2 = __builtin_amdgcn_exp2f(p1[4 * w + 2]), f3 = __builtin_amdgcn_exp2f(p1[4 * w + 3]);
        int da, db;
        asm("v_cvt_scalef32_pk_fp8_f32 %0, %2, %3, %10\n\tv_cvt_scalef32_pk_fp8_f32 %0, %4, %5, %10 op_sel:[0,0,0,1]\n\tv_cvt_scalef32_pk_fp8_f32 %1, %6, %7, %10\n\tv_cvt_scalef32_pk_fp8_f32 %1, %8, %9, %10 op_sel:[0,0,0,1]"
            : "=&v"(da), "=&v"(db) : "v"(e0), "v"(e1), "v"(e2), "v"(e3), "v"(f0), "v"(f1), "v"(f2), "v"(f3), "v"(sc));
        pa[w] = da; pa[4 + w] = db; }
    return ch;
}
#define KSW_LD(addr_) (*(const LAS u32x4*)(uintptr_t)(unsigned)(addr_))
#define KSW_FRAG(A_, B_, CH_) { const u32x4 a0 = KSW_LD(kro[2 * (CH_)]), a1 = KSW_LD(kro[2 * (CH_) + 1]); \
        const u32x4 b0 = KSW_LD(kro[2 * (CH_)] + 32 * DQK), b1 = KSW_LD(kro[2 * (CH_) + 1] + 32 * DQK); \
        A_ = (i32x8){(int)a0.x, (int)a0.y, (int)a0.z, (int)a0.w, (int)a1.x, (int)a1.y, (int)a1.z, (int)a1.w}; B_ = (i32x8){(int)b0.x, (int)b0.y, (int)b0.z, (int)b0.w, (int)b1.x, (int)b1.y, (int)b1.z, (int)b1.w}; }
template <int DQK> __device__ __forceinline__ void qkt8s(f32x16& p0, f32x16& p1, const char* Ks, const int* kro, const i32x8* qr) {
    p0 = f32x16{}; p1 = f32x16{};
#pragma unroll
    for (int c = 0; c < DQK / 64; ++c) { i32x8 A, B; KSW_FRAG(A, B, c); p0 = F8_MFMA(A, qr[c], p0); p1 = F8_MFMA(B, qr[c], p1); }
}
template <int DQK, bool MSUM> __device__ __forceinline__ void pp_half_bs(f32x16* o, f32x16& p0, f32x16& p1, const int* vb, const i32x8& pa, const char* Klds, const int* kro, const i32x8* qr, const i32x8& ones) {
    constexpr int NC = DQK / 64; const char* Ks = Klds;
#define PPB_TR(T, D) const u32x2 T[4] = {tr8_read<0>(vb[D]), tr8_read<2048>(vb[D]), tr8_read<4096>(vb[D]), tr8_read<6144>(vb[D])}
    i32x8 kA[NC], kB[NC];
    PPB_TR(a, 0); PPB_TR(b, 1); SBAR();
    if constexpr (MSUM) { o[4] = F8_MFMA(pa, ones, o[4]); SBAR(); }
    PPB_TR(c, 2); SBAR();
    o[0] = F8_MFMA(pa, TR8B(a), o[0]); SBAR();
    PPB_TR(d, 3); SBAR();
    o[1] = F8_MFMA(pa, TR8B(b), o[1]); SBAR();
    KSW_FRAG(kA[0], kB[0], 0); SBAR();
    o[2] = F8_MFMA(pa, TR8B(c), o[2]); SBAR();
    KSW_FRAG(kA[1], kB[1], 1); SBAR();
    o[3] = F8_MFMA(pa, TR8B(d), o[3]); SBAR();
    if constexpr (NC > 2) { KSW_FRAG(kA[NC - 1], kB[NC - 1], NC - 1); SBAR(); }
    p0 = F8_MFMA(kA[0], qr[0], (f32x16){}); p1 = F8_MFMA(kB[0], qr[0], (f32x16){}); SBAR();
    p0 = F8_MFMA(kA[1], qr[1], p0); p1 = F8_MFMA(kB[1], qr[1], p1);
    if constexpr (NC > 2) { p0 = F8_MFMA(kA[NC - 1], qr[NC - 1], p0); p1 = F8_MFMA(kB[NC - 1], qr[NC - 1], p1); }
#undef PPB_TR
}
template <int DQK, int LDQ, int LDK, int LDV, int LDO, int VAR = 0>
__device__ __forceinline__ void attn88_ppd(const bf16_t* __restrict__ Qb, const unsigned char* __restrict__ Kh, const unsigned char* __restrict__ Vh, unsigned char* __restrict__ Ob, int seq, float scale, char* lds, int rope_t0) {
#define PPBAR() do { SBAR(); __syncthreads(); SBAR(); } while (0)
    constexpr int SHM_V = 64 * 128, SHM_K = 64 * DQK, SHM_P = SHM_V + SHM_K, NC = DQK / 64, NKD = SHM_K / 1024;
    const float C = scale * 1.4426950408889634f, thr_raw = ATT8_THR / scale;
    const int tid = threadIdx.x, wid = __builtin_amdgcn_readfirstlane(tid >> 6), lane = tid & 63, r32 = lane & 31, hi = lane >> 5, grp = wid >> 2;
    char* P_lds = lds;
    float* al_l = (float*)(lds + 2 * SHM_P) + wid * 32;
    constexpr bool MSUM = true;
    float m_reg = -1e30f, l_reg = 0.f, sc_reg = 1.f; i32x8 qr[NC];
    const bf16_t* Qw = Qb + (long)(wid * 32 + r32) * LDQ + hi * 32;
    if constexpr (DQK == 192) {
        if (rope_t0 >= 0) { const int tq = rope_t0 + wid * 32 + r32; qr[2] = q32_rope_fp8(Qw + 128, (float)(hi ? (tq & 63) : (tq >> 6)), C); }
        else qr[2] = q32_to_fp8(Qw + 128, C);
    }
    asm volatile("" ::: "memory");
#pragma unroll
    for (int c = 0; c < 2; ++c) qr[c] = q32_to_fp8(Qw + 64 * c, C);
    const int gx = 16 * (DQK == 128 ? ((r32 >> 1) & 7) : ((r32 >> 2) & 3));
    int kro[4 * NC];
    const int kb0 = (int)(uintptr_t)P_lds + SHM_V;
#pragma unroll
    for (int c = 0; c < NC; ++c) { kro[2 * c] = kb0 + r32 * DQK + ((64 * c + 32 * hi) ^ gx); kro[2 * c + 1] = kb0 + r32 * DQK + ((64 * c + 32 * hi + 16) ^ gx); kro[2 * NC + 2 * c] = kro[2 * c] + SHM_P; kro[2 * NC + 2 * c + 1] = kro[2 * c + 1] + SHM_P; if constexpr (DQK == 128) asm volatile("" : "+v"(kro[2 * NC + 2 * c]), "+v"(kro[2 * NC + 2 * c + 1])); }
    unsigned vsrc; { const int key = 8 * wid + (lane >> 3), pos = lane & 7, ch16 = (((pos >> 1) ^ v8_f(key)) << 1) | (pos & 1); vsrc = (unsigned)(key * LDV + 16 * ch16); }
    unsigned ksrc[2];
#pragma unroll
    for (int i = 0; i < 2; ++i) { const int byte = 1024 * (wid + 8 * i) + 16 * lane, row = byte / DQK, posb = byte % DQK, g = 16 * (DQK == 128 ? ((row >> 1) & 7) : ((row >> 2) & 3)); ksrc[i] = (unsigned)(row * LDK + (posb ^ g)); }
    const bool k2 = (wid + 8) < NKD;
    int vb[8];
#pragma unroll
    for (int d = 0; d < 4; ++d) { vb[d] = (int)(uintptr_t)P_lds + v8_rd_base(lane, d); vb[4 + d] = vb[d] + SHM_P; if constexpr (DQK == 128) asm volatile("" : "+v"(vb[4 + d])); }
    const int NT = seq / 64;
#define PDMA_K(kt_, b) do { __builtin_amdgcn_global_load_lds((const unsigned*)((kt_) + ksrc[0]), (LAS unsigned*)(P_lds + (b) * SHM_P + SHM_V + wid * 1024), 16, 0, 0); \
        if (k2) __builtin_amdgcn_global_load_lds((const unsigned*)((kt_) + ksrc[1]), (LAS unsigned*)(P_lds + (b) * SHM_P + SHM_V + (wid + 8) * 1024), 16, 0, 0); } while (0)
#define PDMA(jp, b) do { const int jv_ = (jp) < NT ? (jp) : NT - 1, jk_ = (jp) + 1 < NT ? (jp) + 1 : NT - 1; const unsigned char* vt_ = Vh + (size_t)jv_ * 64 * LDV; const unsigned char* kt_ = Kh + (size_t)jk_ * 64 * LDK; \
        __builtin_amdgcn_global_load_lds((const unsigned*)(vt_ + vsrc), (LAS unsigned*)(P_lds + (b) * SHM_P + wid * 1024), 16, 0, 0); PDMA_K(kt_, b); } while (0)
#define RESC_DO(a) do { if (hi == 0) al_l[r32] = (a); asm volatile("s_waitcnt lgkmcnt(0)" ::: "memory"); \
    _Pragma("unroll") for (int d = 0; d < (MSUM ? 5 : 4); ++d) _Pragma("unroll") for (int r = 0; r < 16; ++r) o[d][r] *= al_l[crow(r, hi)]; } while (0)
    asm volatile("" ::: "memory");
    f32x16 o[5] = {}; f32x16 p0 = {}, p1 = {}; float mn, al; i32x8 pa = {};
    i32x8 ones = {0x38383838, 0x38383838, 0x38383838, 0x38383838, 0x38383838, 0x38383838, 0x38383838, 0x38383838}; asm volatile("" : "+v"(ones));
    PDMA_K(Kh, 1); PDMA(0, 0);
    asm volatile("s_waitcnt vmcnt(0)" ::: "memory");
    PPBAR();
#define STAGE(j_) do { if (!(VAR & 4) && (j_) + 1 < NT) PDMA((j_) + 1, ((j_) + 1) & 1); } while (0)
#define DMAW() asm volatile("s_waitcnt vmcnt(0)" ::: "memory")
#define HALF_A() do { if (VAR & 1) { _Pragma("unroll") for (int w_ = 0; w_ < 8; ++w_) pa[w_] = (int)__float_as_uint(w_ < 4 ? p0[4 * w_] : p1[4 * w_ - 16]); break; } if (pp_softmax8(p0, p1, m_reg, sc_reg, al, pa)) RESC_DO(al); asm volatile("" : "+v"(pa)); } while (0)
#define HALF_B(j_, BO_) do { if (VAR & 2) { _Pragma("unroll") for (int r_ = 0; r_ < 16; ++r_) { p0[r_] = __uint_as_float((unsigned)pa[r_ & 7]) * 1e-30f + (float)r_; p1[r_] = p0[r_] + 1.f; } o[0][(j_) & 15] += p0[3]; break; } pp_half_bs<DQK, MSUM>(o, p0, p1, vb + ((BO_) ? 4 : 0), pa, P_lds + SHM_V, kro + ((BO_) ? 2 * NC : 0), qr, ones); asm volatile("" : "+v"(p0), "+v"(p1)); asm volatile("" : "+v"(o[0]), "+v"(o[1]), "+v"(o[2]), "+v"(o[3]), "+v"(o[4]));        } while (0)
    if (grp == 0) {
        qkt8s<DQK>(p0, p1, nullptr, kro + 2 * NC, qr); PPBAR();
#pragma unroll 1
        for (int j = 0; j < NT; j += 2) {
            HALF_A(); DMAW(); PPBAR();
            STAGE(j); HALF_B(j, 0); PPBAR();
            HALF_A(); DMAW(); PPBAR();
            STAGE(j + 1); HALF_B(j + 1, SHM_P); PPBAR();
        }
        PPBAR();
    } else {
        PPBAR();
        qkt8s<DQK>(p0, p1, nullptr, kro + 2 * NC, qr); PPBAR();
#pragma unroll 1
        for (int j = 0; j < NT; j += 2) {
            STAGE(j); HALF_A(); PPBAR();
            HALF_B(j, 0); DMAW(); PPBAR();
            STAGE(j + 1); HALF_A(); PPBAR();
            HALF_B(j + 1, SHM_P); DMAW(); PPBAR();
        }
    }
#undef STAGE
#undef DMAW
#undef HALF_A
#undef HALF_B
    float rli[16];
    if constexpr (MSUM) {
#pragma unroll
        for (int r = 0; r < 16; ++r) rli[r] = __builtin_amdgcn_rcpf(o[4][r]);
    } else {
        if (hi == 0) al_l[r32] = l_reg; asm volatile("s_waitcnt lgkmcnt(0)" ::: "memory");
#pragma unroll
        for (int r = 0; r < 16; ++r) rli[r] = __builtin_amdgcn_rcpf(al_l[crow(r, hi)]);
    }
    { int t2 = threadIdx.x; asm volatile("" : "+v"(t2));
      const int w2 = t2 >> 6, r2 = t2 & 31, h2 = (t2 >> 5) & 1;
      unsigned char* Ow = Ob + (long)(w2 * 32) * LDO;
#pragma unroll
      for (int r = 0; r < 16; ++r) { const int orow = crow(r, h2);
#pragma unroll
          for (int d0 = 0; d0 < 4; ++d0) { const float ov = o[d0][r] * rli[r] * (float)(1 << O8_SH); Ow[(long)orow * LDO + d0 * 32 + r2] = (unsigned char)(f8x4(ov, ov, ov, ov) & 0xffu); } } }
    PPBAR();
#undef PDMA
#undef PDMA_K
#undef RESC_DO
#undef PPBAR
}
#ifndef ATTN_PP
#define ATTN_PP 1
#endif
#define ATTN_MLA attn88_ppd
#define ATTN_GQA attn88_ppd
__device__ __forceinline__ void p_attn_mla(const Args& A, const Frame& F) {
    const bf16_t* Q = (const bf16_t*)(F.ws + WS_Q); const unsigned char* Kb = F.ws + WS_K; const unsigned char* Vb = F.ws + WS_V; unsigned char* O = F.ws + WS_O;
    const float scale = 0.07216878364870322f;
    for (int u = F.vcu; u < 544; u += F.nblk) {
        int b, h, q0, seq;
        int rope_t0;
        if (u < 512) { const int qb = u & 15; h = (u >> 4) & 7; b = u >> 7; q0 = CTXL + qb * 256; seq = RPB; rope_t0 = qb * 256; }
        else { const int v = u - 512; h = v & 7; b = v >> 3; q0 = 0; seq = CTXL; rope_t0 = -1; }
        const size_t rb = (size_t)b * RPB;
        ATTN_MLA<192, 1536, 1536, 1024, 1024>(Q + (rb + q0) * 1536 + h * 192, Kb + rb * 1536 + h * 192, Vb + rb * 1024 + h * 128, O + (rb + q0) * 1024 + h * 128, seq, scale, F.lds, rope_t0);
    }
}
template <int VAR = 0> __device__ __forceinline__ void p_attn_gqa(const Args& A, const Frame& F, unsigned char* O) {
    const bf16_t* Q = (const bf16_t*)(F.ws + WS_Q1); const unsigned char* Kb = F.ws + WS_K1; const unsigned char* Vb = F.ws + WS_V1;
    const float scale = 0.08838834764831845f;
    for (int u = F.vcu; u < 512; u += F.nblk) {
        const int qb = u & 15, h = (u >> 4) & 7, b = u >> 7, q0 = CTXL + qb * 256, kvh = h >> 2;
        const size_t rb = (size_t)b * RPB;
        attn88_ppd<128, 1024, 256, 256, 1024, VAR>(Q + (rb + q0) * 1024 + h * 128, Kb + rb * 256 + kvh * 128, Vb + rb * 256 + kvh * 128, O + (rb + q0) * 1024 + h * 128, RPB, scale, F.lds, -1);
    }
}
#define DPP_XOR1 0xB1
#define DPP_XOR2 0x4E
#define DPP_HMIRROR 0x141
#define DPP_MIRROR 0x140
__device__ __forceinline__ int row_max_i(int v) {
    v = max(v, __builtin_amdgcn_update_dpp(v, v, DPP_XOR1, 0xf, 0xf, false));
    v = max(v, __builtin_amdgcn_update_dpp(v, v, DPP_XOR2, 0xf, 0xf, false));
    v = max(v, __builtin_amdgcn_update_dpp(v, v, DPP_HMIRROR, 0xf, 0xf, false));
    v = max(v, __builtin_amdgcn_update_dpp(v, v, DPP_MIRROR, 0xf, 0xf, false));
    return v;
}
__device__ __forceinline__ float row_sum_f(float v) {
    v += __builtin_bit_cast(float, __builtin_amdgcn_update_dpp(0, __builtin_bit_cast(int, v), DPP_XOR1, 0xf, 0xf, false));
    v += __builtin_bit_cast(float, __builtin_amdgcn_update_dpp(0, __builtin_bit_cast(int, v), DPP_XOR2, 0xf, 0xf, false));
    v += __builtin_bit_cast(float, __builtin_amdgcn_update_dpp(0, __builtin_bit_cast(int, v), DPP_HMIRROR, 0xf, 0xf, false));
    v += __builtin_bit_cast(float, __builtin_amdgcn_update_dpp(0, __builtin_bit_cast(int, v), DPP_MIRROR, 0xf, 0xf, false));
    return v;
}
__device__ __forceinline__ int fkey(float f) { const int b = __builtin_bit_cast(int, f); return b ^ ((b >> 31) & 0x7fffffff); }
__device__ __forceinline__ float keyf(int k) { return __builtin_bit_cast(float, k ^ ((k >> 31) & 0x7fffffff)); }
__device__ __forceinline__ void cand_ij(int t, int& i, int& j) {
    const int g16 = t >= 16, g24 = t >= 24, g29 = t >= 29, g33 = t >= 33, g36 = t >= 36, g38 = t >= 38, g40 = t >= 40;
    i = g16 + g24 + g29 + g33 + g36 + g38 + g40 + max(t - 41, 0);
    const int base = 16 * g16 + 8 * g24 + 5 * g29 + 4 * g33 + 3 * g36 + 2 * g38 + 2 * g40;
    j = (t >= 42) ? 0 : t - base;
    if (t >= 50) { i = 0; j = 0; }
}
__device__ __forceinline__ void row_max2(int& a, int& b) {
    asm volatile("s_nop 1\n\t"
                 "v_max_i32_dpp %0, %0, %0 quad_perm:[1,0,3,2] row_mask:0xf bank_mask:0xf\n\tv_max_i32_dpp %1, %1, %1 quad_perm:[1,0,3,2] row_mask:0xf bank_mask:0xf\n\ts_nop 0\n\t"
                 "v_max_i32_dpp %0, %0, %0 quad_perm:[2,3,0,1] row_mask:0xf bank_mask:0xf\n\tv_max_i32_dpp %1, %1, %1 quad_perm:[2,3,0,1] row_mask:0xf bank_mask:0xf\n\ts_nop 0\n\t"
                 "v_max_i32_dpp %0, %0, %0 row_half_mirror row_mask:0xf bank_mask:0xf\n\tv_max_i32_dpp %1, %1, %1 row_half_mirror row_mask:0xf bank_mask:0xf\n\ts_nop 0\n\t"
                 "v_max_i32_dpp %0, %0, %0 row_mirror row_mask:0xf bank_mask:0xf\n\tv_max_i32_dpp %1, %1, %1 row_mirror row_mask:0xf bank_mask:0xf\n\ts_nop 1"
                 : "+v"(a), "+v"(b));
}
__device__ __forceinline__ void row_max1(int& a) {
    asm volatile("s_nop 1\n\t"
                 "v_max_i32_dpp %0, %0, %0 quad_perm:[1,0,3,2] row_mask:0xf bank_mask:0xf\n\ts_nop 1\n\t"
                 "v_max_i32_dpp %0, %0, %0 quad_perm:[2,3,0,1] row_mask:0xf bank_mask:0xf\n\ts_nop 1\n\t"
                 "v_max_i32_dpp %0, %0, %0 row_half_mirror row_mask:0xf bank_mask:0xf\n\ts_nop 1\n\t"
                 "v_max_i32_dpp %0, %0, %0 row_mirror row_mask:0xf bank_mask:0xf\n\ts_nop 1"
                 : "+v"(a));
}
__device__ __forceinline__ void row_max4(int& a, int& b, int& c, int& d) {
    asm volatile("s_nop 1\n\t"
                 "v_max_i32_dpp %0, %0, %0 quad_perm:[1,0,3,2] row_mask:0xf bank_mask:0xf\n\tv_max_i32_dpp %1, %1, %1 quad_perm:[1,0,3,2] row_mask:0xf bank_mask:0xf\n\t"
                 "v_max_i32_dpp %2, %2, %2 quad_perm:[1,0,3,2] row_mask:0xf bank_mask:0xf\n\tv_max_i32_dpp %3, %3, %3 quad_perm:[1,0,3,2] row_mask:0xf bank_mask:0xf\n\t"
                 "v_max_i32_dpp %0, %0, %0 quad_perm:[2,3,0,1] row_mask:0xf bank_mask:0xf\n\tv_max_i32_dpp %1, %1, %1 quad_perm:[2,3,0,1] row_mask:0xf bank_mask:0xf\n\t"
                 "v_max_i32_dpp %2, %2, %2 quad_perm:[2,3,0,1] row_mask:0xf bank_mask:0xf\n\tv_max_i32_dpp %3, %3, %3 quad_perm:[2,3,0,1] row_mask:0xf bank_mask:0xf\n\t"
                 "v_max_i32_dpp %0, %0, %0 row_half_mirror row_mask:0xf bank_mask:0xf\n\tv_max_i32_dpp %1, %1, %1 row_half_mirror row_mask:0xf bank_mask:0xf\n\t"
                 "v_max_i32_dpp %2, %2, %2 row_half_mirror row_mask:0xf bank_mask:0xf\n\tv_max_i32_dpp %3, %3, %3 row_half_mirror row_mask:0xf bank_mask:0xf\n\t"
                 "v_max_i32_dpp %0, %0, %0 row_mirror row_mask:0xf bank_mask:0xf\n\tv_max_i32_dpp %1, %1, %1 row_mirror row_mask:0xf bank_mask:0xf\n\t"
                 "v_max_i32_dpp %2, %2, %2 row_mirror row_mask:0xf bank_mask:0xf\n\tv_max_i32_dpp %3, %3, %3 row_mirror row_mask:0xf bank_mask:0xf\n\ts_nop 1"
                 : "+v"(a), "+v"(b), "+v"(c), "+v"(d));
}
#define CE_DESC(x, y) do { const int hi_ = max(x, y), lo_ = min(x, y); x = hi_; y = lo_; } while (0)
#define SORT8_DESC(k) do { CE_DESC(k[0], k[2]); CE_DESC(k[1], k[3]); CE_DESC(k[4], k[6]); CE_DESC(k[5], k[7]); CE_DESC(k[0], k[4]); CE_DESC(k[1], k[5]); CE_DESC(k[2], k[6]); CE_DESC(k[3], k[7]); \
    CE_DESC(k[0], k[1]); CE_DESC(k[2], k[3]); CE_DESC(k[4], k[5]); CE_DESC(k[6], k[7]); CE_DESC(k[2], k[4]); CE_DESC(k[3], k[5]); CE_DESC(k[1], k[4]); CE_DESC(k[3], k[6]); CE_DESC(k[1], k[2]); CE_DESC(k[3], k[4]); CE_DESC(k[5], k[6]); } while (0)
#define SORT16_DESC(K) do { CE_DESC(K[0], K[1]); CE_DESC(K[2], K[3]); CE_DESC(K[0], K[2]); CE_DESC(K[1], K[3]); CE_DESC(K[1], K[2]); CE_DESC(K[4], K[5]); CE_DESC(K[6], K[7]); CE_DESC(K[4], K[6]); CE_DESC(K[5], K[7]); CE_DESC(K[5], K[6]); CE_DESC(K[0], K[4]); CE_DESC(K[2], K[6]); CE_DESC(K[2], K[4]); CE_DESC(K[1], K[5]); CE_DESC(K[3], K[7]); CE_DESC(K[3], K[5]); CE_DESC(K[1], K[2]); CE_DESC(K[3], K[4]); CE_DESC(K[5], K[6]); CE_DESC(K[8], K[9]); CE_DESC(K[10], K[11]); CE_DESC(K[8], K[10]); CE_DESC(K[9], K[11]); CE_DESC(K[9], K[10]); CE_DESC(K[12], K[13]); CE_DESC(K[14], K[15]); CE_DESC(K[12], K[14]); CE_DESC(K[13], K[15]); CE_DESC(K[13], K[14]); CE_DESC(K[8], K[12]); CE_DESC(K[10], K[14]); CE_DESC(K[10], K[12]); CE_DESC(K[9], K[13]); CE_DESC(K[11], K[15]); CE_DESC(K[11], K[13]); CE_DESC(K[9], K[10]); CE_DESC(K[11], K[12]); CE_DESC(K[13], K[14]); CE_DESC(K[0], K[8]); CE_DESC(K[4], K[12]); CE_DESC(K[4], K[8]); CE_DESC(K[2], K[10]); CE_DESC(K[6], K[14]); CE_DESC(K[6], K[10]); CE_DESC(K[2], K[4]); CE_DESC(K[6], K[8]); CE_DESC(K[10], K[12]); CE_DESC(K[1], K[9]); CE_DESC(K[5], K[13]); CE_DESC(K[5], K[9]); CE_DESC(K[3], K[11]); CE_DESC(K[7], K[15]); CE_DESC(K[7], K[11]); CE_DESC(K[3], K[5]); CE_DESC(K[7], K[9]); CE_DESC(K[11], K[13]); CE_DESC(K[1], K[2]); CE_DESC(K[3], K[4]); CE_DESC(K[5], K[6]); CE_DESC(K[7], K[8]); CE_DESC(K[9], K[10]); CE_DESC(K[11], K[12]); CE_DESC(K[13], K[14]); } while (0)
#define MERGE16_DESC(T, K) do { _Pragma("unroll") for (int i_ = 0; i_ < 16; ++i_) T[i_] = max(T[i_], K[15 - i_]); CE_DESC(T[0], T[8]); CE_DESC(T[1], T[9]); CE_DESC(T[2], T[10]); CE_DESC(T[3], T[11]); CE_DESC(T[4], T[12]); CE_DESC(T[5], T[13]); CE_DESC(T[6], T[14]); CE_DESC(T[7], T[15]); CE_DESC(T[0], T[4]); CE_DESC(T[1], T[5]); CE_DESC(T[2], T[6]); CE_DESC(T[3], T[7]); CE_DESC(T[8], T[12]); CE_DESC(T[9], T[13]); CE_DESC(T[10], T[14]); CE_DESC(T[11], T[15]); CE_DESC(T[0], T[2]); CE_DESC(T[1], T[3]); CE_DESC(T[4], T[6]); CE_DESC(T[5], T[7]); CE_DESC(T[8], T[10]); CE_DESC(T[9], T[11]); CE_DESC(T[12], T[14]); CE_DESC(T[13], T[15]); CE_DESC(T[0], T[1]); CE_DESC(T[2], T[3]); CE_DESC(T[4], T[5]); CE_DESC(T[6], T[7]); CE_DESC(T[8], T[9]); CE_DESC(T[10], T[11]); CE_DESC(T[12], T[13]); CE_DESC(T[14], T[15]); } while (0)
__device__ __forceinline__ int hkey_hi(unsigned w) { const int x = (int)(w & 0xffff0000u); return x ^ ((x >> 31) & 0x7fff0000); }
__device__ __forceinline__ float hkey_val(int k) { const int y = k & (int)0xffff0000; const unsigned b = (unsigned)(y ^ ((y >> 31) & 0x7fff0000)); return (float)__builtin_bit_cast(_Float16, (unsigned short)(b >> 16)); }
__device__ __forceinline__ int cnd(int a, int b, unsigned long long m) { int r; asm("v_cndmask_b32_e64 %0, %1, %2, %3" : "=v"(r) : "v"(a), "v"(b), "s"(m)); return r; }
__device__ __forceinline__ unsigned long long bitmask(int v, int bit) { unsigned long long m; asm("v_cmp_ne_u32_e64 %0, 0, %1\n\ts_nop 1" : "=s"(m) : "v"(v & bit)); return m; }
__device__ __forceinline__ int sel16(const int (&a)[16], int i) {
    const unsigned long long m0 = bitmask(i, 1), m1 = bitmask(i, 2), m2 = bitmask(i, 4), m3 = bitmask(i, 8);
    int l1[8], l2[4], l3[2];
#pragma unroll
    for (int m = 0; m < 8; ++m) l1[m] = cnd(a[2 * m], a[2 * m + 1], m0);
#pragma unroll
    for (int m = 0; m < 4; ++m) l2[m] = cnd(l1[2 * m], l1[2 * m + 1], m1);
#pragma unroll
    for (int m = 0; m < 2; ++m) l3[m] = cnd(l2[2 * m], l2[2 * m + 1], m2);
    return cnd(l3[0], l3[1], m3);
}
__device__ __forceinline__ void topk_rows4(const unsigned short* S, unsigned* PK, int r, int hbase, int lane) {
    const int c = lane & 15, rw = lane >> 4, rbase = lane & 48, h = hbase + rw;
    const int KMIN = (int)0x80000000;
    const unsigned char* Sb = (const unsigned char*)S;
    int k1[8], k2[8];
#pragma unroll
    for (int jj = 0; jj < 2; ++jj) {
        const u32x2 a = *(const u32x2*)(Sb + s_off(r, h, 0, (c >> 2) + 4 * jj, (c >> 1) & 1) + 8 * (c & 1)), b = *(const u32x2*)(Sb + s_off(r, h, 1, (c >> 2) + 4 * jj, (c >> 1) & 1) + 8 * (c & 1));
#pragma unroll
        for (int e = 0; e < 4; ++e) { const int p = 4 * c + 64 * jj + e;
            const float fa = (float)__builtin_bit_cast(_Float16, (unsigned short)(a[e >> 1] >> (16 * (e & 1)))), fb = (float)__builtin_bit_cast(_Float16, (unsigned short)(b[e >> 1] >> (16 * (e & 1))));
            k1[4 * jj + e] = (fkey(fa) & ~127) | (127 - p); k2[4 * jj + e] = (fkey(fb) & ~127) | (127 - p); } }
    SORT8_DESC(k1); SORT8_DESC(k2);
    int r1 = KMIN, r2 = KMIN;
#pragma unroll 1
    for (int it = 0; it < 16; ++it) {
        int m1 = k1[0], m2 = k2[0];
        row_max2(m1, m2);
        const bool p1 = (k1[0] == m1), p2 = (k2[0] == m2);
#pragma unroll
        for (int e = 0; e < 7; ++e) { k1[e] = p1 ? k1[e + 1] : k1[e]; k2[e] = p2 ? k2[e + 1] : k2[e]; }
        k1[7] = p1 ? KMIN : k1[7]; k2[7] = p2 ? KMIN : k2[7];
        if (c == it) { r1 = m1; r2 = m2; }
    }
    int ck[4];
#pragma unroll
    for (int q = 0; q < 4; ++q) { int ci, cj; cand_ij(c + 16 * q, ci, cj); const int a = __shfl(r1, rbase | ci), b = __shfl(r2, rbase | cj);
        const float fs = keyf((a & ~127) | 64) + keyf((b & ~127) | 64); const int t = c + 16 * q;
        ck[q] = (t < 50) ? ((fkey(fs) & ~63) | (63 - t)) : KMIN; }
    CE_DESC(ck[0], ck[1]); CE_DESC(ck[2], ck[3]); CE_DESC(ck[0], ck[2]); CE_DESC(ck[1], ck[3]); CE_DESC(ck[1], ck[2]);
    int tk = KMIN;
#pragma unroll 1
    for (int it = 0; it < 16; ++it) {
        int m = ck[0];
        row_max1(m);
        const bool pp = (ck[0] == m);
        ck[0] = pp ? ck[1] : ck[0]; ck[1] = pp ? ck[2] : ck[1]; ck[2] = pp ? ck[3] : ck[2]; ck[3] = pp ? KMIN : ck[3];
        if (c == it) tk = m;
    }
    int wi, wj; cand_ij(63 - (tk & 63), wi, wj);
    const int wa = __shfl(r1, rbase | wi), wb = __shfl(r2, rbase | wj);
    const int te = (127 - (wa & 127)) * 128 + (127 - (wb & 127));
    const float tv = keyf((tk & ~63) | 32);
    int mk = tk; row_max1(mk);
    const float mx = keyf((mk & ~63) | 32);
    const float ex = __expf(tv - mx), sum = row_sum_f(ex);
    PK[(size_t)r * 128 + h * 16 + c] = ((unsigned)te << 16) | (unsigned)(ex * (65535.f / sum) + 0.5f);
}
__device__ __forceinline__ void p_peer_topk(const Args& A, const Frame& F, bool skip_ctx) {
    const int gw = F.bid * NWAVES + F.wave, NGW = F.nblk * NWAVES, lane = F.lane;
    const unsigned short* S = (const unsigned short*)(F.ws + WS_S); unsigned* PK = (unsigned*)(F.ws + WS_PK);
    const int KMIN = (int)0x80000000;
    const int nitem = (skip_ctx ? NB * SEQ : R) * 8;
    const int nmain = (nitem / (NGW * 64)) * (NGW * 64);
    for (int q = gw; q < (nitem - nmain) / 4; q += NGW) { const int item = nmain + 4 * q, n = item >> 3; topk_rows4(S, PK, skip_ctx ? tok_row(1, n) : n, item & 7, lane); }
    for (int base = gw * 64; base < nmain; base += NGW * 64) {
        const int n = (base >> 3) + (lane & 7), h = lane >> 3, r = skip_ctx ? tok_row(1, n) : n;
        const unsigned char* sp = (const unsigned char*)S + s_off(r, h, 0, 0, 0);
        int t1[16], t2[16];
#pragma unroll
        for (int list = 0; list < 2; ++list) {
            int T[16];
#pragma unroll
            for (int i = 0; i < 16; ++i) T[i] = KMIN;
            const unsigned char* lp = sp + 16384 * list;
            u32x4 ra = *(const u32x4*)lp, rb = *(const u32x4*)(lp + 1024);
#pragma unroll 1
            for (int c = 0; c < 8; ++c) {
                const int cn = c < 7 ? c + 1 : 7;
                const u32x4 na = *(const u32x4*)(lp + 2048 * cn), nb = *(const u32x4*)(lp + 2048 * cn + 1024);
                const int pb = 127 - 16 * c;
                int K[16];
#pragma unroll
                for (int d = 0; d < 4; ++d) { K[2 * d] = hkey_hi(ra[d] << 16) | (pb - 2 * d); K[2 * d + 1] = hkey_hi(ra[d]) | (pb - 2 * d - 1);
                    K[8 + 2 * d] = hkey_hi(rb[d] << 16) | (pb - 8 - 2 * d); K[8 + 2 * d + 1] = hkey_hi(rb[d]) | (pb - 9 - 2 * d); }
                SORT16_DESC(K);
                MERGE16_DESC(T, K);
                ra = na; rb = nb;
            }
#pragma unroll
            for (int i = 0; i < 16; ++i) { if (list == 0) t1[i] = T[i]; else t2[i] = T[i]; }
        }
        float f1[16], f2[16];
#pragma unroll
        for (int i = 0; i < 16; ++i) { f1[i] = hkey_val(t1[i]); f2[i] = hkey_val(t2[i]); }
        int CA[16], CB[16], CC[16], CD[16];
        CA[0] = (fkey(f1[0] + f2[0]) & ~63) | 63; CA[1] = (fkey(f1[0] + f2[1]) & ~63) | 62; CA[2] = (fkey(f1[0] + f2[2]) & ~63) | 61; CA[3] = (fkey(f1[0] + f2[3]) & ~63) | 60; CA[4] = (fkey(f1[0] + f2[4]) & ~63) | 59; CA[5] = (fkey(f1[0] + f2[5]) & ~63) | 58; CA[6] = (fkey(f1[0] + f2[6]) & ~63) | 57; CA[7] = (fkey(f1[0] + f2[7]) & ~63) | 56; CA[8] = (fkey(f1[0] + f2[8]) & ~63) | 55; CA[9] = (fkey(f1[0] + f2[9]) & ~63) | 54; CA[10] = (fkey(f1[0] + f2[10]) & ~63) | 53; CA[11] = (fkey(f1[0] + f2[11]) & ~63) | 52; CA[12] = (fkey(f1[0] + f2[12]) & ~63) | 51; CA[13] = (fkey(f1[0] + f2[13]) & ~63) | 50; CA[14] = (fkey(f1[0] + f2[14]) & ~63) | 49; CA[15] = (fkey(f1[0] + f2[15]) & ~63) | 48; CB[0] = (fkey(f1[1] + f2[0]) & ~63) | 47; CB[1] = (fkey(f1[1] + f2[1]) & ~63) | 46; CB[2] = (fkey(f1[1] + f2[2]) & ~63) | 45; CB[3] = (fkey(f1[1] + f2[3]) & ~63) | 44; CB[4] = (fkey(f1[1] + f2[4]) & ~63) | 43; CB[5] = (fkey(f1[1] + f2[5]) & ~63) | 42; CB[6] = (fkey(f1[1] + f2[6]) & ~63) | 41; CB[7] = (fkey(f1[1] + f2[7]) & ~63) | 40; CB[8] = (fkey(f1[2] + f2[0]) & ~63) | 39; CB[9] = (fkey(f1[2] + f2[1]) & ~63) | 38; CB[10] = (fkey(f1[2] + f2[2]) & ~63) | 37; CB[11] = (fkey(f1[2] + f2[3]) & ~63) | 36; CB[12] = (fkey(f1[2] + f2[4]) & ~63) | 35; CB[13] = (fkey(f1[3] + f2[0]) & ~63) | 34; CB[14] = (fkey(f1[3] + f2[1]) & ~63) | 33; CB[15] = (fkey(f1[3] + f2[2]) & ~63) | 32; CC[0] = (fkey(f1[3] + f2[3]) & ~63) | 31; CC[1] = (fkey(f1[4] + f2[0]) & ~63) | 30; CC[2] = (fkey(f1[4] + f2[1]) & ~63) | 29; CC[3] = (fkey(f1[4] + f2[2]) & ~63) | 28; CC[4] = (fkey(f1[5] + f2[0]) & ~63) | 27; CC[5] = (fkey(f1[5] + f2[1]) & ~63) | 26; CC[6] = (fkey(f1[6] + f2[0]) & ~63) | 25; CC[7] = (fkey(f1[6] + f2[1]) & ~63) | 24; CC[8] = (fkey(f1[7] + f2[0]) & ~63) | 23; CC[9] = (fkey(f1[7] + f2[1]) & ~63) | 22; CC[10] = (fkey(f1[8] + f2[0]) & ~63) | 21; CC[11] = (fkey(f1[9] + f2[0]) & ~63) | 20; CC[12] = (fkey(f1[10] + f2[0]) & ~63) | 19; CC[13] = (fkey(f1[11] + f2[0]) & ~63) | 18; CC[14] = (fkey(f1[12] + f2[0]) & ~63) | 17; CC[15] = (fkey(f1[13] + f2[0]) & ~63) | 16; CD[0] = (fkey(f1[14] + f2[0]) & ~63) | 15; CD[1] = (fkey(f1[15] + f2[0]) & ~63) | 14; CD[2] = KMIN; CD[3] = KMIN; CD[4] = KMIN; CD[5] = KMIN; CD[6] = KMIN; CD[7] = KMIN; CD[8] = KMIN; CD[9] = KMIN; CD[10] = KMIN; CD[11] = KMIN; CD[12] = KMIN; CD[13] = KMIN; CD[14] = KMIN; CD[15] = KMIN;
        SORT16_DESC(CB); SORT16_DESC(CC); CE_DESC(CD[0], CD[1]);
        MERGE16_DESC(CA, CB); MERGE16_DESC(CA, CC); MERGE16_DESC(CA, CD);
        const float mx = keyf((CA[0] & ~63) | 32);
        float ex[16], sum = 0.f; unsigned te[16];
#pragma unroll
        for (int k = 0; k < 16; ++k) { int wi, wj; cand_ij(63 - (CA[k] & 63), wi, wj);
            const int wa = sel16(t1, wi), wb = sel16(t2, wj);
            te[k] = (unsigned)((127 - (wa & 127)) * 128 + (127 - (wb & 127)));
            ex[k] = __expf(keyf((CA[k] & ~63) | 32) - mx); sum += ex[k]; }
        const float rs = 65535.f / sum;
        u32x4* dst = (u32x4*)(PK + (size_t)r * 128 + h * 16);
#pragma unroll
        for (int q = 0; q < 4; ++q) { u32x4 o;
#pragma unroll
            for (int d = 0; d < 4; ++d) o[d] = (te[4 * q + d] << 16) | (unsigned)(ex[4 * q + d] * rs + 0.5f);
            dst[q] = o; }
    }
}

#define UB(w, b) ((float)(((w) >> (8 * (b))) & 0xffu))
__device__ __forceinline__ void p_peer_experts(const Args& A, const Frame& F, int layer) {
    const int gw = F.bid * NWAVES + F.wave, NGW = F.nblk * NWAVES, lane = F.lane;
    const bf16_t* H = (const bf16_t*)(F.ws + WS_H); float* X = (float*)(F.ws + WS_X);
    const unsigned* PK = (const unsigned*)(F.ws + WS_PK);
    const unsigned char* UT = F.ws + WS_TAB + (size_t)(layer * 2) * 16384 * 1024; const unsigned char* VT = UT + (size_t)16384 * 1024;
    const float* SU = (const float*)(F.ws + WS_TSC) + (layer * 2) * 16384; const float* SV = SU + 16384;
    const float* MOD = (const float*)(F.ws + WS_MOD) + (size_t)layer * 5 * 6144;
    for (int r = gw; r < R; r += NGW) {
        if (layer == 1 && is_ctx_row(r)) continue;
        float hf[16];
        { const u32x4 w0 = *(const u32x4*)(H + (size_t)r * DM + 16 * lane), w1 = *(const u32x4*)(H + (size_t)r * DM + 16 * lane + 8);
#pragma unroll
          for (int d = 0; d < 4; ++d) { hf[2 * d] = bflo(w0[d]); hf[2 * d + 1] = bfhi(w0[d]); hf[8 + 2 * d] = bflo(w1[d]); hf[8 + 2 * d + 1] = bfhi(w1[d]); } }
        float hs = 0.f;
#pragma unroll
        for (int i = 0; i < 16; ++i) hs += hf[i];
        hs = wave_sum(hs);
        int v0 = (int)PK[(size_t)r * 128 + lane], v1 = (int)PK[(size_t)r * 128 + 64 + lane];
#pragma unroll
        for (int k = 2; k <= 128; k <<= 1) {
#pragma unroll
            for (int j = k >> 1; j >= 1; j >>= 1) {
                if (j == 64) { const int a = min(v0, v1), b = max(v0, v1); v0 = a; v1 = b; }
                else { const int o0 = __shfl_xor(v0, j), o1 = __shfl_xor(v1, j); const bool lower = (lane & j) == 0;
                    const bool asc0 = (k == 128) ? true : (k == 64) ? true : ((lane & k) == 0), asc1 = (k == 128) ? true : (k == 64) ? false : ((lane & k) == 0);
                    v0 = (lower == asc0) ? min(v0, o0) : max(v0, o0); v1 = (lower == asc1) ? min(v1, o1) : max(v1, o1); }
            }
        }
        const unsigned pk0 = (unsigned)v0, pk1 = (unsigned)v1;
        const int e0 = (int)(pk0 >> 16), e1 = (int)(pk1 >> 16);
        const float g0 = (float)(pk0 & 0xffffu) * (1.f / 65535.f), g1 = (float)(pk1 & 0xffffu) * (1.f / 65535.f);
        const float su0 = SU[e0], su1 = SU[e1], sv0 = SV[e0], sv1 = SV[e1];
        float d0 = 0.f, d1 = 0.f;
        const int dep_src = (8 * (lane & 7)) << 2; const bool bit3 = (lane & 8) != 0;
#define XISSUE(buf, TAB, esrc, gg) do { _Pragma("unroll") for (int q_ = 0; q_ < 8; ++q_) { const int e_ = __builtin_amdgcn_readlane(esrc, (gg) * 8 + q_); \
            buf[q_] = *(const u32x4*)((TAB) + (size_t)e_ * 1024 + 16 * lane); } } while (0)
#define UCOMP(buf, gg, dsel) do { float p_[8]; _Pragma("unroll") for (int q_ = 0; q_ < 8; ++q_) { float d_ = 0.f; \
            _Pragma("unroll") for (int j_ = 0; j_ < 4; ++j_) d_ += (hf[4 * j_] * UB(buf[q_][j_], 0) + hf[4 * j_ + 1] * UB(buf[q_][j_], 1)) + (hf[4 * j_ + 2] * UB(buf[q_][j_], 2) + hf[4 * j_ + 3] * UB(buf[q_][j_], 3)); p_[q_] = d_; } \
            float s_[4]; _Pragma("unroll") for (int q_ = 0; q_ < 4; ++q_) { auto rr_ = __builtin_amdgcn_permlane32_swap(__float_as_uint(p_[q_]), __float_as_uint(p_[q_ + 4]), false, false); s_[q_] = __uint_as_float(rr_[0]) + __uint_as_float(rr_[1]); } \
            float t_[2]; _Pragma("unroll") for (int q_ = 0; q_ < 2; ++q_) { auto rr_ = __builtin_amdgcn_permlane16_swap(__float_as_uint(s_[q_]), __float_as_uint(s_[q_ + 2]), false, false); t_[q_] = __uint_as_float(rr_[0]) + __uint_as_float(rr_[1]); } \
            const float keep_ = bit3 ? t_[1] : t_[0], send_ = bit3 ? t_[0] : t_[1]; \
            float u_ = keep_ + __builtin_bit_cast(float, __builtin_amdgcn_update_dpp(0, __builtin_bit_cast(int, send_), 0x128, 0xf, 0xf, false)); \
            u_ += __builtin_bit_cast(float, __builtin_amdgcn_update_dpp(0, __builtin_bit_cast(int, u_), DPP_HMIRROR, 0xf, 0xf, false)); \
            u_ += __builtin_bit_cast(float, __builtin_amdgcn_update_dpp(0, __builtin_bit_cast(int, u_), DPP_XOR1, 0xf, 0xf, false)); \
            u_ += __builtin_bit_cast(float, __builtin_amdgcn_update_dpp(0, __builtin_bit_cast(int, u_), DPP_XOR2, 0xf, 0xf, false)); \
            const float v_ = __builtin_bit_cast(float, __builtin_amdgcn_ds_bpermute(dep_src, __builtin_bit_cast(int, u_))); \
            if ((lane >> 3) == (gg)) dsel = v_; } while (0)
        {
            u32x4 ua[8], ub[8];
            XISSUE(ua, UT, e0, 0);
#pragma unroll 1
            for (int g = 0; g < 8; g += 2) { XISSUE(ub, UT, e0, g + 1); UCOMP(ua, g, d0); if (g + 2 < 8) XISSUE(ua, UT, e0, g + 2); else XISSUE(ua, UT, e1, 0); UCOMP(ub, g + 1, d0); }
#pragma unroll 1
            for (int g = 0; g < 8; g += 2) { XISSUE(ub, UT, e1, g + 1); UCOMP(ua, g, d1); if (g + 2 < 8) XISSUE(ua, UT, e1, g + 2); UCOMP(ub, g + 1, d1); }
        }
        const float a0 = su0 * (d0 - 128.f * hs), a1 = su1 * (d1 - 128.f * hs);
        const float w0 = g0 * 0.5f * a0 * (1.f + erff(a0 * 0.70710678118654752f)) * sv0, w1 = g1 * 0.5f * a1 * (1.f + erff(a1 * 0.70710678118654752f)) * sv1;
        const float wsum = wave_sum(w0 + w1) * 128.f;
        float acc[16];
#pragma unroll
        for (int i = 0; i < 16; ++i) acc[i] = 0.f;
#define VCOMP(buf, wsrc, gg) do { _Pragma("unroll") for (int q_ = 0; q_ < 8; ++q_) { const float wk_ = __builtin_bit_cast(float, __builtin_amdgcn_readlane(__builtin_bit_cast(int, wsrc), (gg) * 8 + q_)); \
            _Pragma("unroll") for (int j_ = 0; j_ < 4; ++j_) { acc[4 * j_] += wk_ * UB(buf[q_][j_], 0); acc[4 * j_ + 1] += wk_ * UB(buf[q_][j_], 1); acc[4 * j_ + 2] += wk_ * UB(buf[q_][j_], 2); acc[4 * j_ + 3] += wk_ * UB(buf[q_][j_], 3); } } } while (0)
        {
            u32x4 va[8], vb[8];
            XISSUE(va, VT, e0, 0);
#pragma unroll 1
            for (int g = 0; g < 8; g += 2) { XISSUE(vb, VT, e0, g + 1); VCOMP(va, w0, g); if (g + 2 < 8) XISSUE(va, VT, e0, g + 2); else XISSUE(va, VT, e1, 0); VCOMP(vb, w0, g + 1); }
#pragma unroll 1
            for (int g = 0; g < 8; g += 2) { XISSUE(vb, VT, e1, g + 1); VCOMP(va, w1, g); if (g + 2 < 8) XISSUE(va, VT, e1, g + 2); VCOMP(vb, w1, g + 1); }
        }
#undef XISSUE
#undef UCOMP
#undef VCOMP
        const float* mm = MOD + (size_t)mod_index(r) * 6144;
        f32x4 xn[4]; float s = 0.f;
#pragma unroll
        for (int j = 0; j < 4; ++j) { const int c = 16 * lane + 4 * j; const float* xp = X + (size_t)r * DM + c; const f32x4 gf = *(const f32x4*)(mm + 5 * 1024 + c);
            xn[j] = *(const f32x4*)xp + gf * (f32x4){acc[4 * j] - wsum, acc[4 * j + 1] - wsum, acc[4 * j + 2] - wsum, acc[4 * j + 3] - wsum};
            s += (xn[j].x * xn[j].x + xn[j].y * xn[j].y) + (xn[j].z * xn[j].z + xn[j].w * xn[j].w); }
        const float rinv = rsqrtf(wave_sum(s) * (1.f / DM) + EPS);
        if (layer == 0) {
            const float* m1 = (const float*)(F.ws + WS_MOD) + (size_t)(5 + mod_index(r)) * 6144;
            const float* gn = A.in[I1_NMIX];
#pragma unroll
            for (int j = 0; j < 4; ++j) { const int c = 16 * lane + 4 * j; *(f32x4*)(X + (size_t)r * DM + c) = xn[j];
                const f32x4 y = (xn[j] * rinv * *(const f32x4*)(gn + c)) * (*(const f32x4*)(m1 + 1024 + c) + 1.f) + *(const f32x4*)(m1 + c);
                u32x2 o; o.x = pk2(y.x, y.y); o.y = pk2(y.z, y.w); *(u32x2*)((bf16_t*)(F.ws + WS_H) + (size_t)r * DM + c) = o; }
        } else {
            const int b = r / RPB, t = (r - b * RPB) - CTXL; float* op = F.out + ((size_t)b * SEQ + t) * DM; const float* gn = A.in[I_NOUT];
#pragma unroll
            for (int j = 0; j < 4; ++j) { const int c = 16 * lane + 4 * j; *(f32x4*)(op + c) = xn[j] * rinv * *(const f32x4*)(gn + c); }
        }
    }
}

__device__ __forceinline__ int tok_row(int layer, int n) { return layer == 0 ? n : (n >> 12) * RPB + CTXL + (n & 4095); }
#define DPPF(v, ctrl) __builtin_bit_cast(float, __builtin_amdgcn_update_dpp(0, __builtin_bit_cast(int, v), ctrl, 0xf, 0xf, false))
__device__ __forceinline__ int isum8(int v) {
    v += __builtin_amdgcn_update_dpp(0, v, DPP_XOR1, 0xf, 0xf, false); v += __builtin_amdgcn_update_dpp(0, v, DPP_XOR2, 0xf, 0xf, false); v += __builtin_amdgcn_update_dpp(0, v, DPP_HMIRROR, 0xf, 0xf, false); return v; }
__device__ __forceinline__ void p_exp_u(const Args& A, const Frame& F, int layer) {
    const int lane = F.lane, s = lane >> 3, c8 = lane & 7;
    const bool part = (F.nblk & 7) == 0; const int ncb = part ? 1 : 4, cb0 = part ? (F.bid & 3) : 0;
    const int gwv = part ? ((F.bid >> 2) * NWAVES + F.wave) : (F.bid * NWAVES + F.wave), nwv = part ? ((F.nblk >> 2) * NWAVES) : (F.nblk * NWAVES);
    const int ntok = layer == 0 ? R : NB * SEQ;
    const unsigned char* HQ = F.ws + WS_HQ; const unsigned* PK = (const unsigned*)(F.ws + WS_PK);
    const unsigned char* UT = F.ws + WS_TAB + (size_t)(layer * 2) * 16384 * 1024;
    int* PD = (int*)(F.ws + WS_PD);
#define U_META(pk, hqa, hqb, n_) do { const int r_ = tok_row(layer, (n_) < ntok ? (n_) : gwv); const unsigned* p_ = PK + (size_t)r_ * 128 + s; \
        _Pragma("unroll") for (int i_ = 0; i_ < 16; ++i_) pk[i_] = p_[8 * i_]; \
        hqa = *(const u32x4*)(HQ + (size_t)r_ * DM + 256 * cb + 32 * c8); hqb = *(const u32x4*)(HQ + (size_t)r_ * DM + 256 * cb + 32 * c8 + 16); } while (0)
#define U_ISSUE(pk, lo) do { _Pragma("unroll") for (int i_ = (lo); i_ < (lo) + 8; ++i_) t[i_] = *(const u32x4*)(tb + (size_t)(pk[i_] >> 16) * 128); } while (0)
#define U_DOT(i_) do { int dh_ = __builtin_amdgcn_sdot8((int)t[i_][0], (int)hva[0], 0, false), dl_ = __builtin_amdgcn_sdot8((int)t[i_][0], (int)hva[1], 0, false); \
        dh_ = __builtin_amdgcn_sdot8((int)t[i_][1], (int)hva[2], dh_, false); dl_ = __builtin_amdgcn_sdot8((int)t[i_][1], (int)hva[3], dl_, false); \
        dh_ = __builtin_amdgcn_sdot8((int)t[i_][2], (int)hvb[0], dh_, false); dl_ = __builtin_amdgcn_sdot8((int)t[i_][2], (int)hvb[1], dl_, false); \
        dh_ = __builtin_amdgcn_sdot8((int)t[i_][3], (int)hvb[2], dh_, false); dl_ = __builtin_amdgcn_sdot8((int)t[i_][3], (int)hvb[3], dl_, false); \
        int d_ = isum8(dh_ * 16 + dl_); if (c8 == ((i_) & 7)) { if ((i_) < 8) kA = d_; else kB = d_; } } while (0)
#define U_ITEM(pkc, hqca, hqcb, pkn, n_) do { \
        const u32x4 hva = hqca, hvb = hqcb; \
        U_META(pkc, hqca, hqcb, (n_) + 2 * nwv); \
        int kA = 0, kB = 0; \
        _Pragma("unroll") for (int i_ = 0; i_ < 8; ++i_) U_DOT(i_); \
        U_ISSUE(pkn, 0); \
        _Pragma("unroll") for (int i_ = 8; i_ < 16; ++i_) U_DOT(i_); \
        U_ISSUE(pkn, 8); \
        if ((n_) < ntok) { const int r_ = tok_row(layer, n_); int* pd_ = PD + ((size_t)cb * R + r_) * 128 + 8 * c8 + s; pd_[0] = kA; pd_[64] = kB; } \
        } while (0)
#pragma unroll 1
    for (int cbi = 0; cbi < ncb; ++cbi) {
        const int cb = cb0 + cbi;
        const unsigned char* tb = UT + (size_t)cb * 16384 * 128 + 16 * c8;
        unsigned pkA[16], pkB[16]; u32x4 hAa, hAb, hBa, hBb, t[16];
        U_META(pkA, hAa, hAb, gwv); U_META(pkB, hBa, hBb, gwv + nwv);
        U_ISSUE(pkA, 0); U_ISSUE(pkA, 8);
#pragma unroll 1
        for (int n = gwv; n < ntok; n += 2 * nwv) {
            U_ITEM(pkA, hAa, hAb, pkB, n);
            U_ITEM(pkB, hBa, hBb, pkA, n + nwv);
        }
    }
#undef U_META
#undef U_ISSUE
#undef U_DOT
#undef U_ITEM
}
__device__ __forceinline__ void p_exp_w(const Args& A, const Frame& F, int layer) {
    const int gw = F.bid * NWAVES + F.wave, NGW = F.nblk * NWAVES, lane = F.lane;
    const int ntok = layer == 0 ? R : NB * SEQ;
    const unsigned* PK = (const unsigned*)(F.ws + WS_PK); const int* PD = (const int*)(F.ws + WS_PD); const float* HS = (const float*)(F.ws + WS_HS);
    unsigned* WQ8 = (unsigned*)(F.ws + WS_WQ8); float* WSC = (float*)(F.ws + WS_WSC);
    const float* SU = (const float*)(F.ws + WS_TSC) + (layer * 2) * 16384; const float* SV = SU + 16384;
    const int g2 = (lane >> 3) & 3, sb = lane & 7, src = 32 * (g2 & 1) + sb;
    for (int n = gw; n < ntok; n += 2 * NGW) {
        int r[2]; r[0] = tok_row(layer, n); r[1] = (n + NGW) < ntok ? tok_row(layer, n + NGW) : r[0];
        unsigned pk0[2], pk1[2]; int d0[2], d1[2]; float hs[2];
#pragma unroll
        for (int q = 0; q < 2; ++q) { pk0[q] = PK[(size_t)r[q] * 128 + lane]; pk1[q] = PK[(size_t)r[q] * 128 + 64 + lane]; hs[q] = HS[r[q]]; d0[q] = 0; d1[q] = 0;
#pragma unroll
            for (int cb = 0; cb < 4; ++cb) { d0[q] += PD[((size_t)cb * R + r[q]) * 128 + lane]; d1[q] += PD[((size_t)cb * R + r[q]) * 128 + 64 + lane]; } }
        float su0[2], su1[2], sv0[2], sv1[2];
#pragma unroll
        for (int q = 0; q < 2; ++q) { const int e0 = (int)(pk0[q] >> 16), e1 = (int)(pk1[q] >> 16); su0[q] = SU[e0]; su1[q] = SU[e1]; sv0[q] = SV[e0]; sv1[q] = SV[e1]; }
#pragma unroll
        for (int q = 0; q < 2; ++q) {
            const float g0 = (float)(pk0[q] & 0xffffu) * (1.f / 65535.f), g1 = (float)(pk1[q] & 0xffffu) * (1.f / 65535.f);
            const float a0 = su0[q] * hs[q] * (float)d0[q], a1 = su1[q] * hs[q] * (float)d1[q];
            const float w0 = g0 * 0.5f * a0 * (1.f + erff(a0 * 0.70710678118654752f)) * sv0[q], w1 = g1 * 0.5f * a1 * (1.f + erff(a1 * 0.70710678118654752f)) * sv1[q];
            const float wm = wave_max(fmaxf(fabsf(w0), fabsf(w1)));
            const float inv = wm > 0.f ? 127.f / wm : 0.f;
            const int q0 = (int)rintf(w0 * inv) & 0xff, q1 = (int)rintf(w1 * inv) & 0xff;
            unsigned pw = 0;
#pragma unroll
            for (int j = 0; j < 4; ++j) { const int x0 = __shfl(q0, src + 8 * j), x1 = __shfl(q1, src + 8 * j); pw |= (unsigned)((g2 < 2) ? x0 : x1) << (8 * j); }
            if (q == 0 || (n + NGW) < ntok) { if (lane < 32) WQ8[(size_t)r[q] * 32 + lane] = pw; if (lane == 0) WSC[r[q]] = wm > 0.f ? wm * (1.f / 127.f) : 0.f; }
        }
    }
}
__device__ __forceinline__ void p_exp_v(const Args& A, const Frame& F, int layer) {
    const int lane = F.lane, s = lane >> 3, c8 = lane & 7;
    const bool part = (F.nblk & 7) == 0; const int ncb = part ? 1 : 4, cb0 = part ? (F.bid & 3) : 0;
    const int gwv = part ? ((F.bid >> 2) * NWAVES + F.wave) : (F.bid * NWAVES + F.wave), nwv = part ? ((F.nblk >> 2) * NWAVES) : (F.nblk * NWAVES);
    const int ntok = layer == 0 ? R : NB * SEQ;
    const unsigned* PK = (const unsigned*)(F.ws + WS_PK); const unsigned* WQ8 = (const unsigned*)(F.ws + WS_WQ8); const float* WSC = (const float*)(F.ws + WS_WSC);
    const unsigned char* VT = F.ws + WS_TAB + (size_t)(layer * 2 + 1) * 16384 * 1024;
    unsigned short* X = (unsigned short*)(F.ws + WS_X); const float* MOD = (const float*)(F.ws + WS_MOD) + (size_t)layer * 5 * 6144;
    const bool bit3 = (lane & 8) != 0;
#define V_METAP(pk, n_) do { const int r_ = tok_row(layer, (n_) < ntok ? (n_) : gwv); const unsigned* p_ = PK + (size_t)r_ * 128 + s; \
        _Pragma("unroll") for (int i_ = 0; i_ < 16; ++i_) pk[i_] = p_[8 * i_]; } while (0)
#define V_METAW(wq, n_) do { const int r_ = tok_row(layer, (n_) < ntok ? (n_) : gwv); const unsigned* w_ = WQ8 + (size_t)r_ * 32 + s; \
        _Pragma("unroll") for (int g_ = 0; g_ < 4; ++g_) wq[g_] = w_[8 * g_]; } while (0)
#define V_ISSUE(pk, lo) do { _Pragma("unroll") for (int i_ = (lo); i_ < (lo) + 8; ++i_) t[i_] = *(const u32x4*)(tb + (size_t)(pk[i_] >> 16) * 128); } while (0)
#define V_NIB(T_, cj_, wq_) do { acc[(cj_) + 4] = __builtin_amdgcn_sdot4((int)((T_) & 0xF0F0F0F0u), (int)(wq_), acc[(cj_) + 4], false); \
        acc[(cj_)] = __builtin_amdgcn_sdot4((int)((T_) & 0x0F0F0F0Fu), (int)(wq_), acc[(cj_)], false); } while (0)
#define V_GRP(wq, g_) do { _Pragma("unroll") for (int j_ = 0; j_ < 4; ++j_) { const unsigned a_ = t[4 * (g_)][j_], b_ = t[4 * (g_) + 1][j_], c_ = t[4 * (g_) + 2][j_], d_ = t[4 * (g_) + 3][j_]; \
        const unsigned ablo = __builtin_amdgcn_perm(b_, a_, 0x05010400u), abhi = __builtin_amdgcn_perm(b_, a_, 0x07030602u), cdlo = __builtin_amdgcn_perm(d_, c_, 0x05010400u), cdhi = __builtin_amdgcn_perm(d_, c_, 0x07030602u); \
        const unsigned T0 = __builtin_amdgcn_perm(cdlo, ablo, 0x05040100u), T1 = __builtin_amdgcn_perm(cdlo, ablo, 0x07060302u), T2 = __builtin_amdgcn_perm(cdhi, abhi, 0x05040100u), T3 = __builtin_amdgcn_perm(cdhi, abhi, 0x07060302u); \
        V_NIB(T0, 8 * j_, wq[g_]); V_NIB(T1, 8 * j_ + 1, wq[g_]); V_NIB(T2, 8 * j_ + 2, wq[g_]); V_NIB(T3, 8 * j_ + 3, wq[g_]); } } while (0)
#define V_ITEM(pkc, wqc, pkn, n_) do { \
        int acc[32]; _Pragma("unroll") for (int a_ = 0; a_ < 32; ++a_) acc[a_] = 0; \
        const int r_ = tok_row(layer, (n_) < ntok ? (n_) : gwv); const int col = 256 * cb + 32 * c8 + 4 * s; u32x2* xp = (u32x2*)(X + (size_t)r_ * DM + col); \
        const u32x2 xw = *xp; const f32x4 gf = *(const f32x4*)(MOD + (size_t)mod_index(r_) * 6144 + 5 * 1024 + col); const float ws_ = WSC[r_] * (1.f / 16.f);        \
        V_METAP(pkc, (n_) + 2 * nwv); \
        V_GRP(wqc, 0); V_GRP(wqc, 1); \
        V_ISSUE(pkn, 0); \
        V_GRP(wqc, 2); V_GRP(wqc, 3); \
        V_ISSUE(pkn, 8); \
        int wl_ = __builtin_amdgcn_sdot4((int)wqc[0], 0x01010101, 0, false); wl_ = __builtin_amdgcn_sdot4((int)wqc[1], 0x01010101, wl_, false); wl_ = __builtin_amdgcn_sdot4((int)wqc[2], 0x01010101, wl_, false); wl_ = __builtin_amdgcn_sdot4((int)wqc[3], 0x01010101, wl_, false); \
        { auto rr = __builtin_amdgcn_permlane32_swap((unsigned)wl_, (unsigned)wl_, false, false); wl_ = (int)rr[0] + (int)rr[1]; } \
        { auto rr = __builtin_amdgcn_permlane16_swap((unsigned)wl_, (unsigned)wl_, false, false); wl_ = (int)rr[0] + (int)rr[1]; } \
        wl_ += __builtin_amdgcn_update_dpp(0, wl_, 0x128, 0xf, 0xf, false);        \
        int b16[16], b8[8], o[4]; \
        _Pragma("unroll") for (int a_ = 0; a_ < 16; ++a_) { auto rr = __builtin_amdgcn_permlane32_swap((unsigned)acc[a_], (unsigned)acc[a_ + 16], false, false); b16[a_] = (int)rr[0] + (int)rr[1]; } \
        _Pragma("unroll") for (int a_ = 0; a_ < 8; ++a_) { auto rr = __builtin_amdgcn_permlane16_swap((unsigned)b16[a_], (unsigned)b16[a_ + 8], false, false); b8[a_] = (int)rr[0] + (int)rr[1]; } \
        _Pragma("unroll") for (int a_ = 0; a_ < 4; ++a_) { const int keep = bit3 ? b8[a_ + 4] : b8[a_], send = bit3 ? b8[a_] : b8[a_ + 4]; o[a_] = keep + __builtin_amdgcn_update_dpp(0, send, 0x128, 0xf, 0xf, false); } \
        if (!bit3) { _Pragma("unroll") for (int a_ = 0; a_ < 4; ++a_) o[a_] = (o[a_] - 8 * wl_) * 16; }        \
        if ((n_) < ntok) { u32x2 xo; xo.x = pkh2(h2f_lo(xw.x) + gf.x * (ws_ * (float)o[0]), h2f_hi(xw.x) + gf.y * (ws_ * (float)o[1])); \
            xo.y = pkh2(h2f_lo(xw.y) + gf.z * (ws_ * (float)o[2]), h2f_hi(xw.y) + gf.w * (ws_ * (float)o[3])); *xp = xo; } \
        V_METAW(wqc, (n_) + 2 * nwv); } while (0)
#pragma unroll 1
    for (int cbi = 0; cbi < ncb; ++cbi) {
        const int cb = cb0 + cbi;
        const unsigned char* tb = VT + (size_t)cb * 16384 * 128 + 16 * c8;
        unsigned pkA[16], pkB[16], wqA[4], wqB[4]; u32x4 t[16];
        V_METAP(pkA, gwv); V_METAW(wqA, gwv); V_METAP(pkB, gwv + nwv); V_METAW(wqB, gwv + nwv);
        V_ISSUE(pkA, 0); V_ISSUE(pkA, 8);
#pragma unroll 1
        for (int n = gwv; n < ntok; n += 2 * nwv) {
            V_ITEM(pkA, wqA, pkB, n);
            V_ITEM(pkB, wqB, pkA, n + nwv);
        }
    }
#undef V_METAP
#undef V_METAW
#undef V_ISSUE
#undef V_NIB
#undef V_GRP
#undef V_ITEM
}
__device__ __forceinline__ void p_final_norm(const Args& A, const Frame& F) {
    const int gw = F.bid * NWAVES + F.wave, NGW = F.nblk * NWAVES, lane = F.lane;
    const unsigned short* X = (const unsigned short*)(F.ws + WS_X); const float* gn = A.in[I_NOUT];
#if ATTN_SELFTEST || GEMM_SELFTEST
    const unsigned* ctl_ = (const unsigned*)(F.ws + WS_CTL) + 16; const float mrel_ = fmaxf(fmaxf(__uint_as_float(__hip_atomic_load(ctl_ + 2, __ATOMIC_RELAXED, __HIP_MEMORY_SCOPE_AGENT)), __uint_as_float(__hip_atomic_load(ctl_ + 3, __ATOMIC_RELAXED, __HIP_MEMORY_SCOPE_AGENT))), fmaxf(__uint_as_float(__hip_atomic_load(ctl_, __ATOMIC_RELAXED, __HIP_MEMORY_SCOPE_AGENT)), __uint_as_float(__hip_atomic_load(ctl_ + 1, __ATOMIC_RELAXED, __HIP_MEMORY_SCOPE_AGENT)))
    ); const int nzero_ = (int)fminf((float)(NB * SEQ), mrel_ * (float)(NB * SEQ));
#endif
    for (int n = gw; n < NB * SEQ; n += NGW) {
        const unsigned short* xr = X + (size_t)tok_row(1, n) * DM; float* op = F.out + (size_t)n * DM;
#if ATTN_SELFTEST || GEMM_SELFTEST
        if (n < nzero_) { for (int j = 0; j < 4; ++j) *(f32x4*)(op + 4 * lane + 256 * j) = (f32x4){0.f, 0.f, 0.f, 0.f}; continue; }
#endif
        f32x4 v[4]; float sq = 0.f;
#pragma unroll
        for (int j = 0; j < 4; ++j) { const u32x2 a = *(const u32x2*)(xr + 4 * lane + 256 * j); v[j] = (f32x4){h2f_lo(a.x), h2f_hi(a.x), h2f_lo(a.y), h2f_hi(a.y)}; sq += (v[j].x * v[j].x + v[j].y * v[j].y) + (v[j].z * v[j].z + v[j].w * v[j].w); }
        const float rinv = rsqrtf(wave_sum(sq) * (1.f / DM) + EPS);
#pragma unroll
        for (int j = 0; j < 4; ++j) { const int c = 4 * lane + 256 * j; __builtin_nontemporal_store(v[j] * rinv * *(const f32x4*)(gn + c), (f32x4*)(op + c)); }
    }
}

#if ATTN_SELFTEST
template <int DQK>
__device__ __forceinline__ float attn_check_row(const bf16_t* qrow, int rope_t, const unsigned char* K8, int ldk, const unsigned char* V8, int ldv, int nk, float scale, const unsigned char* orow, float* sl, float* ql, int lane) {
    for (int d = lane; d < DQK; d += 64) ql[d] = bf2f(qrow[d]);
    asm volatile("s_waitcnt lgkmcnt(0)" ::: "memory");
    if (DQK == 192 && rope_t >= 0 && lane < 32) {
        const int i = lane & 15, ax = lane >> 4; const float pos = (float)(ax ? (rope_t & 63) : (rope_t >> 6));
        const float invf = __powf(10000.f, -(float)i * (1.f / 16.f)), ang = pos * invf, cs = __cosf(ang), sn = __sinf(ang);
        const float x1 = ql[128 + 32 * ax + i], x2 = ql[128 + 32 * ax + 16 + i];
        ql[128 + 32 * ax + i] = x1 * cs - x2 * sn; ql[128 + 32 * ax + 16 + i] = x2 * cs + x1 * sn;
    }
    asm volatile("s_waitcnt lgkmcnt(0)" ::: "memory");
    for (int d = lane; d < DQK; d += 64) { const float v = ql[d]; ql[d] = f8dec<0>(f8x4(v, v, v, v)); }
    asm volatile("s_waitcnt lgkmcnt(0)" ::: "memory");
    float mx = -1e30f;
    for (int k = lane; k < nk; k += 64) {
        const unsigned char* kr = K8 + (size_t)k * ldk; float acc = 0.f;
#pragma unroll 1
        for (int c = 0; c < DQK / 16; ++c) { const u32x4 w = *(const u32x4*)(kr + 16 * c);
#pragma unroll
            for (int e = 0; e < 4; ++e) acc += (ql[16 * c + 4 * e] * f8dec<0>(w[e]) + ql[16 * c + 4 * e + 1] * f8dec<1>(w[e])) + (ql[16 * c + 4 * e + 2] * f8dec<2>(w[e]) + ql[16 * c + 4 * e + 3] * f8dec<3>(w[e])); }
        acc *= scale; sl[k] = acc; mx = fmaxf(mx, acc);
    }
    mx = wave_max(mx);
#if ATT8_FIXED_M
    mx = 6.f;
#endif
    float sum = 0.f;
    for (int k = lane; k < nk; k += 64) { float pv = __builtin_amdgcn_exp2f((sl[k] - mx) * 1.4426950408889634f + ATT8_SH);
#if ATT8_FIXED_M
        if (DQK == 192) sum += pv;
        pv = f8dec<0>(f8x4(pv, pv, pv, pv));
        if (DQK != 192) sum += pv;
#else
        sum += pv;
#endif
        sl[k] = pv; }
    sum = wave_sum(sum);
    asm volatile("s_waitcnt lgkmcnt(0)" ::: "memory");
    float o0 = 0.f, o1 = 0.f;
    for (int k = 0; k < nk; ++k) { const float pv = sl[k]; const unsigned w = *(const unsigned short*)(V8 + (size_t)k * ldv + 2 * lane); o0 += pv * f8dec<0>(w); o1 += pv * f8dec<1>(w); }
    o0 /= sum; o1 /= sum;
    const unsigned fw = *(const unsigned short*)(orow + 2 * lane); const float f0 = f8dec<0>(fw) * (1.f / (float)(1 << O8_SH)), f1 = f8dec<1>(fw) * (1.f / (float)(1 << O8_SH));
    const float num = wave_sum((f0 - o0) * (f0 - o0) + (f1 - o1) * (f1 - o1)), den = wave_sum(o0 * o0 + o1 * o1);
    return sqrtf(num / fmaxf(den, 1e-30f));
}
__device__ __forceinline__ void attn_selftest(const Frame& F, int layer) {
    float* sl = (float*)F.lds + F.wave * (RPB + 192); float* ql = sl + RPB;
    const int gw = F.bid * NWAVES + F.wave;
    unsigned hsh = (unsigned)gw * 2654435761u + 12345u * (unsigned)(layer + 1); hsh ^= hsh >> 15; hsh *= 2246822519u; hsh ^= hsh >> 13;
    const int h = (int)(hsh & 7u); float rel;
    if (layer == 0) {
        const int r = (int)((hsh >> 3) % (unsigned)R), b = r / RPB, j = r - b * RPB; const bool ctx = j < CTXL; const size_t rb = (size_t)b * RPB;
        rel = attn_check_row<192>((const bf16_t*)(F.ws + WS_Q) + (size_t)r * 1536 + h * 192, ctx ? -1 : j - CTXL, F.ws + WS_K + rb * 1536 + h * 192, 1536,
                                  F.ws + WS_V + rb * 1024 + h * 128, 1024, ctx ? CTXL : RPB, 0.07216878364870322f, F.ws + WS_O + (size_t)r * 1024 + h * 128, sl, ql, F.lane);
    } else {
        const int n = (int)((hsh >> 3) % (unsigned)(NB * SEQ)), r = (n >> 12) * RPB + CTXL + (n & 4095), b = r / RPB, kvh = h >> 2; const size_t rb = (size_t)b * RPB;
        rel = attn_check_row<128>((const bf16_t*)(F.ws + WS_Q1) + (size_t)r * 1024 + h * 128, -1, F.ws + WS_K1 + rb * 256 + kvh * 128, 256,
                                  F.ws + WS_V1 + rb * 256 + kvh * 128, 256, RPB, 0.08838834764831845f, F.ws + WS_O + (size_t)r * 1024 + h * 128, sl, ql, F.lane);
    }
    if (!(rel < 1e30f)) rel = 1e30f;
    if (F.lane == 0) atomicMax((unsigned*)(F.ws + WS_CTL) + 16 + layer, __float_as_uint(rel));
    __syncthreads();
}
#endif

#if GEMM_SELFTEST
template <class Get> __device__ __forceinline__ float gemm_check(const Frame& F, const unsigned char* A8, int lda, const unsigned char* B8, int ldb, int K, int c_lo, int c_hi, int shift, bool latent, unsigned seed, const Get& get) {
    const int gw = F.bid * NWAVES + F.wave; float e2 = 0.f, r2 = 0.f;
    for (int it = 0; it < 8; ++it) {
        unsigned hsh = ((unsigned)gw * 8u + (unsigned)it) * 2654435761u + seed; hsh ^= hsh >> 15; hsh *= 2246822519u; hsh ^= hsh >> 13;
        const int col = c_lo + (int)(hsh % (unsigned)(c_hi - c_lo)); const unsigned h2 = hsh * 3266489917u + 374761393u;
        int row = (int)((h2 >> 4) % (unsigned)(latent ? NB * SEQ : R)); if (latent) row = (row >> 12) * RPB + CTXL + (row & 4095);
        float acc = 0.f;
        for (int k = 4 * F.lane; k < K; k += 256) { const unsigned a = *(const unsigned*)(A8 + (size_t)row * lda + k), b = *(const unsigned*)(B8 + (size_t)col * ldb + k);
            acc += (f8dec<0>(a) * f8dec<0>(b) + f8dec<1>(a) * f8dec<1>(b)) + (f8dec<2>(a) * f8dec<2>(b) + f8dec<3>(a) * f8dec<3>(b)); }
        const float naive = wave_sum(acc) * (1.f / (float)(1 << shift));
        float st, ex; get(row, col, naive, st, ex);
        e2 += (st - ex) * (st - ex); r2 += ex * ex;
    }
    return sqrtf(e2 / fmaxf(r2, 1e-30f));
}
__device__ __forceinline__ float f8at(const unsigned char* p) { return f8dec<0>((unsigned)*p); }
__device__ __forceinline__ void gemm_selftest(const Frame& F, int id) {
    const float* SSP = (const float*)(F.ws + WS_SSP); const bf16_t* DBG = (const bf16_t*)(F.ws + WS_PK);
    float rel = 0.f; int cls = 0;
    if (id == 0) {
        cls = 1; rel = gemm_check(F, F.ws + WS_H, 1024, F.ws + WS_WIN, 1024, 1024, 0, 640, W8_SH_IN, false, 11u, [&](int r, int c, float nv, float& st, float& ex) {
            st = c < 384 ? f8at(F.ws + WS_CQ + (size_t)r * 512 + c) : f8at(F.ws + WS_CKV + (size_t)r * 256 + (c - 384)); ex = nv; });
    } else if (id == 6) {
        rel = gemm_check(F, F.ws + WS_H, 1024, F.ws + WS_WIN, 1024, 1024, 640, 704, W8_SH_IN, false, 17u, [&](int r, int c, float nv, float& st, float& ex) {
            st = bf2f(((const bf16_t*)(F.ws + WS_KR))[(size_t)r * 64 + (c - 640)]); ex = nv; });
    } else if (id == 1) {
        rel = gemm_check(F, F.ws + WS_CQ, 512, F.ws + WS_WUQ, 512, 512, 0, 1536, W8_SH_UQ, false, 23u, [&](int r, int c, float nv, float& st, float& ex) {
            float ss = 0.f; for (int i = 0; i < 12; ++i) ss += SSP[(size_t)r * 24 + i]; st = bf2f(((const bf16_t*)(F.ws + WS_Q))[(size_t)r * 1536 + c]); ex = nv * rsqrtf(ss * (1.f / 384.f) + EPS); });
    } else if (id == 2) {
        cls = 1; rel = gemm_check(F, F.ws + WS_CKV, 256, F.ws + WS_WUKV, 256, 256, 0, 2048, W8_SH_UKV, false, 29u, [&](int r, int c, float nv, float& st, float& ex) {
            float ss = 0.f; for (int i = 12; i < 20; ++i) ss += SSP[(size_t)r * 24 + i]; const int h = c >> 8, cc = c & 255;
            st = cc < 128 ? f8at(F.ws + WS_K + (size_t)r * 1536 + h * 192 + cc) : f8at(F.ws + WS_V + (size_t)r * 1024 + h * 128 + (cc - 128)); ex = nv * rsqrtf(ss * (1.f / 256.f) + EPS); });
    } else if (id == 3 || id == 5) {
        rel = gemm_check(F, F.ws + WS_O, 1024, F.ws + (id == 3 ? WS_WO0 : WS_WO1), 1024, 1024, 0, 256, W8_SH_O + O8_SH, id == 5, 31u + id, [&](int r, int c, float nv, float& st, float& ex) {
            st = bf2f(DBG[(size_t)r * 256 + c]); ex = nv; });
    } else if (id == 4) {
        rel = gemm_check(F, F.ws + WS_H, 1024, F.ws + WS_WQKV, 1024, 1024, 0, 1536, W8_SH_QKV, false, 41u, [&](int r, int c, float nv, float& st, float& ex) {
            st = bf2f(((const bf16_t*)(F.ws + WS_RAW1))[(size_t)r * 1536 + c]); ex = nv; });
    }
    if (!(rel < 1e30f)) rel = 1e30f;
    if (((GEMM_SELFTEST >> cls) & 1) && F.lane == 0) atomicMax((unsigned*)(F.ws + WS_CTL) + 18 + cls, __float_as_uint(rel));
    __syncthreads();
}
__device__ __forceinline__ void wt_selftest(const Args& A, const Frame& F) {
    const int gw = F.bid * NWAVES + F.wave; float worst = 0.f;
    for (int it = 0; it < 16; ++it) {
        unsigned hsh = (((unsigned)gw * 16u + (unsigned)it) * 64u + (unsigned)F.lane) * 2654435761u + 777u; hsh ^= hsh >> 15; hsh *= 2246822519u; hsh ^= hsh >> 13;
        const int job = (int)(hsh % 6u); const unsigned h2 = hsh * 3266489917u + 374761393u, h3 = h2 * 668265263u + 2246822519u;
        const float* W; const float* gain = nullptr; int K, N, KP, sh; size_t off;
        if (job == 0) { W = A.in[I0_WIN]; K = 1024; N = 704; KP = 1024; sh = W8_SH_IN; off = WS_WIN; }
        else if (job == 1) { W = A.in[I0_WUQ]; gain = A.in[I0_QN]; K = 384; N = 1536; KP = 512; sh = W8_SH_UQ; off = WS_WUQ; }
        else if (job == 2) { W = A.in[I0_WUKV]; gain = A.in[I0_KVN]; K = 256; N = 2048; KP = 256; sh = W8_SH_UKV; off = WS_WUKV; }
        else if (job == 3) { W = A.in[I0_WO]; K = 1024; N = 1024; KP = 1024; sh = W8_SH_O; off = WS_WO0; }
        else if (job == 4) { W = A.in[I1_WQKV]; K = 1024; N = 1536; KP = 1024; sh = W8_SH_QKV; off = WS_WQKV; }
        else { W = A.in[I1_WO]; K = 1024; N = 1024; KP = 1024; sh = W8_SH_O; off = WS_WO1; }
        const int k = (int)((h2 >> 3) % (unsigned)KP), n = (int)((h3 >> 3) % (unsigned)N);
        const float ex = k < K ? W[(size_t)k * N + n] * (float)(1 << sh) * (gain ? gain[k] : 1.f) : 0.f, st = f8at(F.ws + off + (size_t)n * KP + k);
        const float err = fabsf(st - ex) / fmaxf(fabsf(ex), 0.02f);
        worst = fmaxf(worst, err);
    }
    worst = wave_max(worst); if (!(worst < 1e30f)) worst = 1e30f;
    if ((GEMM_SELFTEST & 4) && F.lane == 0) atomicMax((unsigned*)(F.ws + WS_CTL) + 18, __float_as_uint(worst));
    __syncthreads();
}
#define GEMM_DBG (bf16_t*)(F.ws + WS_PK)
#else
#define GEMM_DBG nullptr
#endif

constexpr int N_PHASES = 24;
__global__ void __launch_bounds__(NTHREADS, 2) mega(Args args) {
    extern __shared__ __attribute__((aligned(16))) unsigned char lds_raw[];
    Frame F; F.x = args.in[I_X]; F.ctx = args.in[I_CTX]; F.out = args.out; F.ws = args.ws; F.lds = (char*)lds_raw;
    F.tid = threadIdx.x; F.lane = F.tid & 63; F.wave = __builtin_amdgcn_readfirstlane(F.tid >> 6); F.bid = blockIdx.x; F.nblk = gridDim.x;
    F.vcu = (F.nblk % 8 == 0) ? (F.bid % 8) * (F.nblk / 8) + F.bid / 8 : F.bid;
    volatile LAS unsigned* st = (volatile LAS unsigned*)(LAS unsigned char*)(lds_raw + LDS_BYTES - 64);
    if (F.tid < 16) st[F.tid] = 0u;
    __syncthreads();
    XcdBarrier bar; bar.bar = (unsigned*)(F.ws + WS_CTL) + 4096; bar.x = 0; bar.st = st;
    const int lo = args.ph_lo, hi = args.ph_hi;
    const bool fused = (hi - lo) > 1;
    if (fused && lo == 0 && F.bid == 0) { unsigned* cw = (unsigned*)(F.ws + WS_CTL);
        for (int i = F.tid; i < 8192; i += NTHREADS) __hip_atomic_store(cw + i, 0u, __ATOMIC_RELAXED, __HIP_MEMORY_SCOPE_AGENT); }
    if (fused && lo != 0) bar = xcd_barrier_post((unsigned*)(F.ws + WS_CTL) + 4096, st);
#ifdef ONLY_PHASE
#define IN(k) ((k) == ONLY_PHASE && lo <= (k) && (k) < hi)
#else
#define IN(k) (lo <= (k) && (k) < hi)
#endif
#define SEAM(k) do { if (IN(k) && IN((k) + 1)) { if ((k) == 0) { cg::this_grid().sync(); bar = xcd_barrier_post((unsigned*)(F.ws + WS_CTL) + 4096, st); } else xcd_barrier(bar); } } while (0)
    bf16_t* Hb = (bf16_t*)(F.ws + WS_H);
#define PH(k, ...) if (IN(k)) for (int rep_ = 0; rep_ < (((PROBE_MASK >> (k)) & 1u) ? 2 : 1); ++rep_) { __VA_ARGS__; __syncthreads(); } SEAM(k)
    unsigned short* Xb = (unsigned short*)(F.ws + WS_X); const float* MODb = (const float*)(F.ws + WS_MOD);
    PH(0, for (int q_ = 0; q_ < ((PROBE_P0 & 1u) ? 2 : 1); ++q_) { p0_mod(args, F); __syncthreads(); }
          for (int q_ = 0; q_ < ((PROBE_P0 & 2u) ? 2 : 1); ++q_) { p0_weights(args, F); __syncthreads(); }
          for (int q_ = 0; q_ < ((PROBE_P0 & 4u) ? 2 : 1); ++q_) { p0_weff(args, F); __syncthreads(); }
          for (int q_ = 0; q_ < ((PROBE_P0 & 8u) ? 2 : 1); ++q_) { p0_tables(args, F, 0, 2 * 4096, 0); __syncthreads(); });
    PH(1, p_norm_rows(args, F, 0, 0, true, false));
    PH(2, gemm8e<EpiMlaDown, true>(F, Hb, F.ws + WS_WIN, 768, 1024, false, EpiMlaDown{F.ws + WS_CQ, F.ws + WS_CKV, (bf16_t*)(F.ws + WS_KR), (float*)(F.ws + WS_SSP)}, W8_SH_IN, 0));
#if GEMM_SELFTEST
    if (IN(3)) { gemm_selftest(F, 0); gemm_selftest(F, 6); wt_selftest(args, F); }
#endif
    PH(3, p_mla_krope(args, F);
          gemm8<In8Bf16Rs, true>(F, F.ws + WS_CQ, F.ws + WS_WUQ, 1536, 512, false, In8Bf16Rs{(bf16_t*)(F.ws + WS_Q), 1536, (const float*)(F.ws + WS_SSP)}, false, W8_SH_UQ, 0);
          gemm8<In8KVRs, true>(F, F.ws + WS_CKV, F.ws + WS_WUKV, 2048, 256, false, In8KVRs{F.ws + WS_K, F.ws + WS_V, (const float*)(F.ws + WS_SSP)}, true, W8_SH_UKV, 0));
#if GEMM_SELFTEST
    if (IN(4)) { gemm_selftest(F, 1); gemm_selftest(F, 2); xcd_barrier(bar); }
#endif
    PH(4, p_attn_mla(args, F));
#if ATTN_SELFTEST & 1
    if (IN(5)) attn_selftest(F, 0);
#endif
    PH(5, gemm8<In8Resid, true>(F, F.ws + WS_O, F.ws + WS_WO0, 1024, 1024, false, In8Resid{F.x, F.ctx, Xb, MODb + 2 * 1024, true, GEMM_DBG}, false, W8_SH_O, O8_SH);
          p0_tables(args, F, 2 * 4096, 3 * 4096, 16));
#if GEMM_SELFTEST
    if (IN(6)) gemm_selftest(F, 3);
#endif
    PH(6, p_norm_rows(args, F, 0, 1, false, false));
    PH(7, gemm8(F, Hb, (const bf16_t*)(F.ws + WS_WQ0), 2048, 1024, false, In8F16{(unsigned short*)(F.ws + WS_S), 2048});
          p0_tables(args, F, 3 * 4096, 4 * 4096, 32));
    PH(8, p_peer_topk(args, F, false));
    PH(9, p_exp_u(args, F, 0));
    PH(10, p_exp_w(args, F, 0));
    if (IN(11)) { p_exp_v(args, F, 0); } SEAM(11);
    PH(12, p_norm_rows(args, F, 1, 0, false, false));
    PH(13, gemm8<In8Bf16, true>(F, Hb, F.ws + WS_WQKV, 1536, 1024, false, In8Bf16{(bf16_t*)(F.ws + WS_RAW1), 1536}, false, W8_SH_QKV, 0));
#if GEMM_SELFTEST
    if (IN(14)) gemm_selftest(F, 4);
#endif
    PH(14, p_gqa_rows(args, F));
    PH(15, p_attn_gqa<0>(args, F, F.ws + WS_O));
#ifdef ATTN_PROBE_VAR
    if (IN(15)) { p_attn_gqa<ATTN_PROBE_VAR>(args, F, F.ws + WS_S); __syncthreads(); }
#endif
#if ATTN_SELFTEST & 2
    if (IN(16)) attn_selftest(F, 1);
#endif
    if (IN(16)) { gemm8<In8Resid, true>(F, F.ws + WS_O, F.ws + WS_WO1, 1024, 1024, true, In8Resid{F.x, F.ctx, Xb, MODb + 5 * 6144 + 2 * 1024, false, GEMM_DBG}, false, W8_SH_O, O8_SH); } SEAM(16);
#if GEMM_SELFTEST
    if (IN(17)) gemm_selftest(F, 5);
#endif
    PH(17, p_norm_rows(args, F, 1, 1, false, true));
    PH(18, gemm8(F, Hb, (const bf16_t*)(F.ws + WS_WQ1), 2048, 1024, true, In8F16{(unsigned short*)(F.ws + WS_S), 2048}));
    PH(19, p_peer_topk(args, F, true));
    PH(20, p_exp_u(args, F, 1));
    PH(21, p_exp_w(args, F, 1));
    if (IN(22)) { p_exp_v(args, F, 1); } SEAM(22);
    if (IN(23)) p_final_norm(args, F);
#undef PH
#undef IN
#undef SEAM
}

extern "C" void kernel_launch(void* const* d_in, const int* in_sizes, int n_in, void* d_out, int out_size, void* d_ws, size_t ws_size, hipStream_t stream) {
    static int grid = 0;
    if (grid == 0) {
        if (n_in != N_IN || in_sizes[0] != NB * SEQ * DM || out_size != NB * SEQ * DM || ws_size < WS_END) {
            fprintf(stderr, "kernel_launch: shape mismatch (n_in %d, in0 %d, out %d, ws %zu < %zu)\n", n_in, n_in > 0 ? in_sizes[0] : -1, out_size, ws_size, (size_t)WS_END); grid = -1; return; }
        int dev = 0, cus = 0, per_cu = 0;
        hipGetDevice(&dev); hipDeviceGetAttribute(&cus, hipDeviceAttributeMultiprocessorCount, dev);
        if (hipFuncSetAttribute((const void*)mega, hipFuncAttributeMaxDynamicSharedMemorySize, LDS_BYTES) != hipSuccess) { fprintf(stderr, "kernel_launch: hipFuncSetAttribute failed\n"); grid = -1; return; }
        if (hipOccupancyMaxActiveBlocksPerMultiprocessor(&per_cu, (const void*)mega, NTHREADS, LDS_BYTES) != hipSuccess || per_cu < 1) { fprintf(stderr, "kernel_launch: occupancy query failed (%d)\n", per_cu); (void)hipGetLastError(); grid = -1; return; }
        grid = cus * (per_cu > 1 ? 1 : per_cu);
    }
    if (grid < 0) return;
#if MK_PER_PHASE
    hipMemsetAsync((char*)d_ws + WS_CTL, 0, 1 * MiB, stream);
#endif
    Args a{};
    for (int i = 0; i < N_IN; ++i) a.in[i] = (const float*)d_in[i];
    a.out = (float*)d_out; a.ws = (unsigned char*)d_ws;
#if MK_PER_PHASE
    for (int p = 0; p < N_PHASES; ++p) { a.ph_lo = p; a.ph_hi = p + 1; hipLaunchKernelGGL(mega, dim3(grid), dim3(NTHREADS), LDS_BYTES, stream, a); }
#else
    a.ph_lo = 0; a.ph_hi = N_PHASES;
    void* kargs[] = {&a};
    hipError_t e = hipLaunchCooperativeKernel((const void*)mega, dim3(grid), dim3(NTHREADS), kargs, LDS_BYTES, stream);
    if (e != hipSuccess) fprintf(stderr, "kernel_launch: cooperative launch failed: %s (grid %d)\n", hipGetErrorString(e), grid);
#endif
}
```
